# Optimizing an MI355X kernel written in HIP

```python
import math
import jax, jax.numpy as jnp
from jax import lax
import numpy as np

D_MODEL = 1024
BATCH = 8
SEQ = 4096
DEPTH = 2

HEAD_DIM = 64
NSA_HEADS = 8
NSA_KV_GROUPS = 2
NSA_WIDTH = NSA_HEADS * HEAD_DIM
ROPE_DIM = HEAD_DIM // 4
ROPE_THETA = 500000.0
CMP_LEN = 32
CMP_STRIDE = 16
CMP_HIDDEN = 128
SLC_LEN = 64
SLC_TOP = 16
WINDOW = 512
Q_BLOCK = 64
FORCE_SCORE = 1.0e4
NEG_INF = -1.0e30
SGU_WIDTH = 256
SGU_GROUPS = 4
SGU_CHUNK = 128
S5_WIDTH = 256
S5_GROUP_CH = 16
S5_GROUPS = S5_WIDTH // S5_GROUP_CH
S5_STATE = 64
MOE_GROUPS = 4
MOE_EXPERTS_PER_GROUP = 8
MOE_EXPERTS = MOE_GROUPS * MOE_EXPERTS_PER_GROUP
MOE_TOPK = 2
EXPERT_HIDDEN = 512
MOE_BLOCK = 128

RMS_EPS = 1e-6
KV_WIDTH = NSA_KV_GROUPS * HEAD_DIM
IN_PROJ_WIDTH = NSA_WIDTH + 6 * KV_WIDTH + 3 * NSA_HEADS + 2 * SGU_WIDTH + S5_WIDTH + 3 * D_MODEL

kernel_name = "hybrid_nsa_sgu_s5_hiermoe"


def _in_proj_split_points():
    sizes = (NSA_WIDTH, KV_WIDTH, KV_WIDTH, KV_WIDTH, KV_WIDTH, KV_WIDTH, KV_WIDTH,
             3 * NSA_HEADS, 2 * SGU_WIDTH, S5_WIDTH, 3 * D_MODEL)
    return [int(v) for v in np.cumsum(sizes)[:-1]]


def rms_norm(x, g):
    xf = x.astype(jnp.float32)
    y = xf * lax.rsqrt(jnp.mean(xf * xf, axis=-1, keepdims=True) + RMS_EPS)
    return (y * g.astype(jnp.float32)).astype(x.dtype)


def partial_rope(x, positions):
    half = ROPE_DIM // 2
    inv_freq = ROPE_THETA ** (-jnp.arange(half, dtype=jnp.float32) / half)
    ang = positions.astype(jnp.float32)[..., None] * inv_freq
    shp = ang.shape[:2] + (1,) * (x.ndim - 3) + (half,)
    cos, sin = jnp.cos(ang).reshape(shp), jnp.sin(ang).reshape(shp)
    xr = x[..., :ROPE_DIM].astype(jnp.float32)
    x1, x2 = xr[..., :half], xr[..., half:]
    rot = jnp.concatenate([x1 * cos - x2 * sin, x2 * cos + x1 * sin], axis=-1).astype(x.dtype)
    return jnp.concatenate([rot, x[..., ROPE_DIM:]], axis=-1)


def masked_softmax(scores, mask):
    s = jnp.where(mask, scores.astype(jnp.float32), NEG_INF)
    m = jnp.max(s, axis=-1, keepdims=True)
    e = jnp.where(mask, jnp.exp(s - m), 0.0)
    return e / jnp.maximum(jnp.sum(e, axis=-1, keepdims=True), 1e-30)


def compress_kv(kv, pos_emb, w1, w2):
    B, S, G, dh = kv.shape
    n_cmp = (S - CMP_LEN) // CMP_STRIDE + 1
    idx = np.arange(n_cmp)[:, None] * CMP_STRIDE + np.arange(CMP_LEN)[None, :]
    blocks = kv[:, idx] + pos_emb[None, None, :, None, :]
    flat = blocks.transpose(0, 1, 3, 2, 4).reshape(B, n_cmp, G, CMP_LEN * dh)
    return jax.nn.gelu(flat @ w1) @ w2


def _cmp_to_slc_overlap(n_cmp, n_slc):
    c0 = np.arange(n_cmp)[:, None] * CMP_STRIDE
    s0 = np.arange(n_slc)[None, :] * SLC_LEN
    ov = np.clip(np.minimum(c0 + CMP_LEN, s0 + SLC_LEN) - np.maximum(c0, s0), 0, None)
    return (ov / CMP_LEN).astype(np.float32)


def nsa_attention(q, k_cmp, v_cmp, k_slc, v_slc, k_win, v_win, gates, positions,
                  cmp_pos_k, cmp_pos_v, cmp_k_w1, cmp_k_w2, cmp_v_w1, cmp_v_w2):
    B, S, G, R, dh = q.shape
    scale = dh ** -0.5
    q_rot = partial_rope(q, positions)
    k_slc = partial_rope(k_slc, positions)
    k_win = partial_rope(k_win, positions)
    kc = compress_kv(k_cmp, cmp_pos_k, cmp_k_w1, cmp_k_w2)
    vc = compress_kv(v_cmp, cmp_pos_v, cmp_v_w1, cmp_v_w2)
    n_cmp = kc.shape[1]
    n_slc = S // SLC_LEN
    n_top = min(SLC_TOP, n_slc)
    cmp_end = jnp.asarray(np.arange(n_cmp) * CMP_STRIDE + CMP_LEN - 1, dtype=jnp.int32)
    overlap = jnp.asarray(_cmp_to_slc_overlap(n_cmp, n_slc))
    k_blocks = k_slc.reshape(B, n_slc, SLC_LEN, G, dh).transpose(0, 3, 1, 2, 4)
    v_blocks = v_slc.reshape(B, n_slc, SLC_LEN, G, dh).transpose(0, 3, 1, 2, 4)
    k_win_p = jnp.concatenate([jnp.zeros((B, WINDOW, G, dh), k_win.dtype), k_win], axis=1)
    v_win_p = jnp.concatenate([jnp.zeros((B, WINDOW, G, dh), v_win.dtype), v_win], axis=1)
    b_idx = jnp.arange(B)[:, None, None, None]
    g_idx = jnp.arange(G)[None, None, :, None]
    slc_ids = jnp.arange(n_slc)

    def query_block(i):
        t0 = i * Q_BLOCK
        t = t0 + jnp.arange(Q_BLOCK)
        qb = lax.dynamic_slice_in_dim(q, t0, Q_BLOCK, 1)
        qrb = lax.dynamic_slice_in_dim(q_rot, t0, Q_BLOCK, 1)
        gb = lax.dynamic_slice_in_dim(gates, t0, Q_BLOCK, 1)
        s_c = jnp.einsum('bqgrd,bcgd->bqgrc', qb, kc) * scale
        m_c = (cmp_end[None, :] <= t[:, None])[None, :, None, None, :]
        p_c = masked_softmax(s_c, m_c)
        o_c = jnp.einsum('bqgrc,bcgd->bqgrd', p_c.astype(vc.dtype), vc)
        imp = jnp.einsum('bqgrc,cj->bqgj', p_c, overlap)
        blk_t = (t // SLC_LEN)[:, None]
        causal = slc_ids[None, :] <= blk_t
        forced = (slc_ids[None, :] == 0) | (slc_ids[None, :] == blk_t) | (slc_ids[None, :] == blk_t - 1)
        imp = jnp.where(forced[None, :, None, :], FORCE_SCORE, imp)
        imp = jnp.where(causal[None, :, None, :], imp, NEG_INF)
        top_v, top_i = lax.top_k(imp, n_top)
        kg = k_blocks[b_idx, g_idx, top_i]
        vg = v_blocks[b_idx, g_idx, top_i]
        key_pos = top_i[..., None] * SLC_LEN + jnp.arange(SLC_LEN)
        m_s = (top_v > 0.5 * NEG_INF)[..., None] & (key_pos <= t[None, :, None, None, None])
        s_s = jnp.einsum('bqgrd,bqgnld->bqgrnl', qrb, kg) * scale
        p_s = masked_softmax(s_s.reshape(B, Q_BLOCK, G, R, n_top * SLC_LEN),
                             m_s.reshape(B, Q_BLOCK, G, 1, n_top * SLC_LEN))
        o_s = jnp.einsum('bqgrnl,bqgnld->bqgrd',
                         p_s.reshape(B, Q_BLOCK, G, R, n_top, SLC_LEN).astype(vg.dtype), vg)
        kw = lax.dynamic_slice_in_dim(k_win_p, t0, WINDOW + Q_BLOCK, 1)
        vw = lax.dynamic_slice_in_dim(v_win_p, t0, WINDOW + Q_BLOCK, 1)
        s_pos = t0 - WINDOW + jnp.arange(WINDOW + Q_BLOCK)
        diff = t[:, None] - s_pos[None, :]
        m_w = ((s_pos[None, :] >= 0) & (diff >= 0) & (diff < WINDOW))[None, :, None, None, :]
        s_w = jnp.einsum('bqgrd,bkgd->bqgrk', qrb, kw) * scale
        p_w = masked_softmax(s_w, m_w)
        o_w = jnp.einsum('bqgrk,bkgd->bqgrd', p_w.astype(vw.dtype), vw)
        return gb[..., 0:1] * o_c + gb[..., 1:2] * o_s + gb[..., 2:3] * o_w

    out = lax.map(query_block, jnp.arange(S // Q_BLOCK))
    return jnp.moveaxis(out, 0, 1).reshape(B, S, G * R * dh)


def spatial_gating(uv, norm_g, w_s, b_s):
    z = jax.nn.gelu(uv)
    u, v = jnp.split(z, 2, axis=-1)
    v = rms_norm(v, norm_g)
    B, S, _ = v.shape
    vg = v.reshape(B, S // SGU_CHUNK, SGU_CHUNK, SGU_GROUPS, SGU_WIDTH // SGU_GROUPS)
    tril = jnp.asarray(np.tril(np.ones((SGU_CHUNK, SGU_CHUNK), dtype=bool)))
    w = jnp.where(tril[None], w_s, 0.0).astype(v.dtype)
    mixed = jnp.einsum('gts,bcsgd->bctgd', w, vg) + b_s.T[None, None, :, :, None].astype(v.dtype)
    return u * mixed.reshape(B, S, SGU_WIDTH)


def s5_layer(xs, a_re, a_im, log_step, b_re, b_im, c_re, c_im, d, glu_w, glu_b):
    B, S, _ = xs.shape
    f32 = jnp.float32
    xg = xs.reshape(B, S, S5_GROUPS, S5_GROUP_CH).astype(f32)
    a_re, a_im = a_re.astype(f32), a_im.astype(f32)
    step = jnp.exp(log_step.astype(f32))[:, None]
    mag = jnp.exp(a_re * step)
    abar_re, abar_im = mag * jnp.cos(a_im * step), mag * jnp.sin(a_im * step)
    den = a_re * a_re + a_im * a_im
    nr, ni = abar_re - 1.0, abar_im
    coef_re = (nr * a_re + ni * a_im) / den
    coef_im = (ni * a_re - nr * a_im) / den
    b_re, b_im = b_re.astype(f32), b_im.astype(f32)
    bbar_re = coef_re[..., None] * b_re - coef_im[..., None] * b_im
    bbar_im = coef_re[..., None] * b_im + coef_im[..., None] * b_re
    bu_re = jnp.einsum('bsgh,gph->bsgp', xg, bbar_re)
    bu_im = jnp.einsum('bsgh,gph->bsgp', xg, bbar_im)
    ar = jnp.broadcast_to(abar_re, bu_re.shape)
    ai = jnp.broadcast_to(abar_im, bu_re.shape)

    def combine(e1, e2):
        a1r, a1i, b1r, b1i = e1
        a2r, a2i, b2r, b2i = e2
        return (a2r * a1r - a2i * a1i, a2r * a1i + a2i * a1r,
                a2r * b1r - a2i * b1i + b2r, a2r * b1i + a2i * b1r + b2i)

    _, _, h_re, h_im = lax.associative_scan(combine, (ar, ai, bu_re, bu_im), axis=1)
    y = (jnp.einsum('bsgp,ghp->bsgh', h_re, c_re.astype(f32))
         - jnp.einsum('bsgp,ghp->bsgh', h_im, c_im.astype(f32)))
    y = y + d.astype(f32).reshape(S5_GROUPS, S5_GROUP_CH) * xg
    y = jax.nn.gelu(y.reshape(B, S, S5_WIDTH))
    y = y * jax.nn.sigmoid(y @ glu_w.astype(f32) + glu_b.astype(f32))
    return y.astype(xs.dtype)


def routed_experts(xf, expert, weight, w_gate, w_up, w_down):
    T, D = xf.shape
    TK = expert.shape[0]
    n_exp = w_gate.shape[0]
    order = jnp.argsort(expert)
    e_sorted = expert[order]
    tok_sorted = order // MOE_TOPK
    counts = jnp.bincount(expert, length=n_exp)
    padded = (counts + MOE_BLOCK - 1) // MOE_BLOCK * MOE_BLOCK
    start = jnp.cumsum(counts) - counts
    end_p = jnp.cumsum(padded)
    start_p = end_p - padded
    dest = start_p[e_sorted] + jnp.arange(TK) - start[e_sorted]
    n_rows = TK + n_exp * MOE_BLOCK
    n_blocks = n_rows // MOE_BLOCK
    x_buf = jnp.zeros((n_rows, D), xf.dtype).at[dest].set(xf[tok_sorted])
    blk_exp = jnp.minimum(jnp.searchsorted(end_p, jnp.arange(n_blocks) * MOE_BLOCK, side='right'), n_exp - 1)

    def expert_block(args):
        xb, e = args
        hid = jax.nn.silu(xb @ w_gate[e]) * (xb @ w_up[e])
        return hid @ w_down[e]

    y_buf = lax.map(expert_block, (x_buf.reshape(n_blocks, MOE_BLOCK, D), blk_exp)).reshape(n_rows, D)
    y = y_buf[dest] * weight[order][:, None].astype(y_buf.dtype)
    return jax.ops.segment_sum(y, tok_sorted, num_segments=T)


def hierarchical_moe(h, router_group_w, router_group_b, router_expert_w, router_expert_b,
                     expert_w_gate, expert_w_up, expert_w_down):
    B, S, D = h.shape
    T = B * S
    xf = h.reshape(T, D)
    grp_logits = (xf @ router_group_w).astype(jnp.float32) + router_group_b.astype(jnp.float32)
    grp_prob = jax.nn.softmax(grp_logits, axis=-1)
    grp = jnp.argmax(grp_logits, axis=-1).astype(jnp.int32)
    grp_w = jnp.take_along_axis(grp_prob, grp[:, None], axis=-1)
    exp_logits = ((xf @ router_expert_w).astype(jnp.float32) + router_expert_b.astype(jnp.float32)
                  ).reshape(T, MOE_GROUPS, MOE_EXPERTS_PER_GROUP)
    exp_logits = jnp.take_along_axis(exp_logits, grp[:, None, None], axis=1)[:, 0]
    exp_prob = jax.nn.softmax(exp_logits, axis=-1)
    top_p, top_j = lax.top_k(exp_prob, MOE_TOPK)
    combine = grp_w * top_p / jnp.sum(top_p, axis=-1, keepdims=True)
    expert = grp[:, None] * MOE_EXPERTS_PER_GROUP + top_j.astype(jnp.int32)
    y = routed_experts(xf, expert.reshape(-1), combine.reshape(-1), expert_w_gate, expert_w_up, expert_w_down)
    return y.reshape(B, S, D)


def setup_inputs(seed: int = 0) -> dict:
    key = jax.random.key(seed)
    ks = iter(jax.random.split(key, 48))
    L = DEPTH

    def nrm(shape, scale):
        return jax.random.normal(next(ks), shape, jnp.float32) * scale

    x = nrm((BATCH, SEQ, D_MODEL), 1.0)
    offset = jax.random.randint(next(ks), (BATCH, 1), 0, 1024, dtype=jnp.int32)
    positions = offset + jnp.arange(SEQ, dtype=jnp.int32)[None, :]
    return {
        "x": x,
        "positions": positions,
        "norm_mix_g": 1.0 + nrm((L, D_MODEL), 0.02),
        "w_in": nrm((L, D_MODEL, IN_PROJ_WIDTH), D_MODEL ** -0.5),
        "cmp_pos_k": nrm((L, CMP_LEN, HEAD_DIM), 0.02),
        "cmp_pos_v": nrm((L, CMP_LEN, HEAD_DIM), 0.02),
        "cmp_k_w1": nrm((L, CMP_LEN * HEAD_DIM, CMP_HIDDEN), (CMP_LEN * HEAD_DIM) ** -0.5),
        "cmp_k_w2": nrm((L, CMP_HIDDEN, HEAD_DIM), CMP_HIDDEN ** -0.5),
        "cmp_v_w1": nrm((L, CMP_LEN * HEAD_DIM, CMP_HIDDEN), (CMP_LEN * HEAD_DIM) ** -0.5),
        "cmp_v_w2": nrm((L, CMP_HIDDEN, HEAD_DIM), CMP_HIDDEN ** -0.5),
        "w_attn_o": nrm((L, NSA_WIDTH, D_MODEL), NSA_WIDTH ** -0.5),
        "sgu_norm_g": 1.0 + nrm((L, SGU_WIDTH), 0.02),
        "sgu_w": nrm((L, SGU_GROUPS, SGU_CHUNK, SGU_CHUNK), 0.5 * SGU_CHUNK ** -0.5),
        "sgu_b": 1.0 + nrm((L, SGU_GROUPS, SGU_CHUNK), 0.02),
        "w_sgu_o": nrm((L, SGU_WIDTH, D_MODEL), SGU_WIDTH ** -0.5),
        "s5_a_re": -0.5 + nrm((L, S5_GROUPS, S5_STATE), 0.01),
        "s5_a_im": math.pi * jnp.arange(S5_STATE, dtype=jnp.float32) + nrm((L, S5_GROUPS, S5_STATE), 0.01),
        "s5_log_step": jax.random.uniform(next(ks), (L, S5_GROUPS), jnp.float32, math.log(1e-3), math.log(1e-1)),
        "s5_b_re": nrm((L, S5_GROUPS, S5_STATE, S5_GROUP_CH), (2 * S5_GROUP_CH) ** -0.5),
        "s5_b_im": nrm((L, S5_GROUPS, S5_STATE, S5_GROUP_CH), (2 * S5_GROUP_CH) ** -0.5),
        "s5_c_re": nrm((L, S5_GROUPS, S5_GROUP_CH, S5_STATE), (2 * S5_STATE) ** -0.5),
        "s5_c_im": nrm((L, S5_GROUPS, S5_GROUP_CH, S5_STATE), (2 * S5_STATE) ** -0.5),
        "s5_d": nrm((L, S5_WIDTH), 0.5),
        "s5_glu_w": nrm((L, S5_WIDTH, S5_WIDTH), S5_WIDTH ** -0.5),
        "s5_glu_b": nrm((L, S5_WIDTH), 0.01),
        "w_s5_o": nrm((L, S5_WIDTH, D_MODEL), S5_WIDTH ** -0.5),
        "w_mix_o": nrm((L, D_MODEL, D_MODEL), D_MODEL ** -0.5),
        "norm_ffn_g": 1.0 + nrm((L, D_MODEL), 0.02),
        "router_group_w": nrm((L, D_MODEL, MOE_GROUPS), D_MODEL ** -0.5),
        "router_group_b": nrm((L, MOE_GROUPS), 0.01),
        "router_expert_w": nrm((L, D_MODEL, MOE_EXPERTS), D_MODEL ** -0.5),
        "router_expert_b": nrm((L, MOE_EXPERTS), 0.01),
        "expert_w_gate": nrm((L, MOE_EXPERTS, D_MODEL, EXPERT_HIDDEN), D_MODEL ** -0.5),
        "expert_w_up": nrm((L, MOE_EXPERTS, D_MODEL, EXPERT_HIDDEN), D_MODEL ** -0.5),
        "expert_w_down": nrm((L, MOE_EXPERTS, EXPERT_HIDDEN, D_MODEL), EXPERT_HIDDEN ** -0.5),
        "norm_final_g": 1.0 + nrm((D_MODEL,), 0.02),
    }


def reference(x, positions, norm_mix_g, w_in, cmp_pos_k, cmp_pos_v, cmp_k_w1, cmp_k_w2,
              cmp_v_w1, cmp_v_w2, w_attn_o, sgu_norm_g, sgu_w, sgu_b, w_sgu_o,
              s5_a_re, s5_a_im, s5_log_step, s5_b_re, s5_b_im, s5_c_re, s5_c_im, s5_d,
              s5_glu_w, s5_glu_b, w_s5_o, w_mix_o, norm_ffn_g, router_group_w, router_group_b,
              router_expert_w, router_expert_b, expert_w_gate, expert_w_up, expert_w_down,
              norm_final_g):
    B, S, D = x.shape
    G, R = NSA_KV_GROUPS, NSA_HEADS // NSA_KV_GROUPS
    split_points = _in_proj_split_points()
    for l in range(DEPTH):
        h = rms_norm(x, norm_mix_g[l])
        parts = jnp.split(h @ w_in[l], split_points, axis=-1)
        q, k_c, v_c, k_s, v_s, k_w, v_w, nsa_g, sgu_in, s5_in, branch_g = parts
        q = q.reshape(B, S, G, R, HEAD_DIM)
        kv = [t.reshape(B, S, G, HEAD_DIM) for t in (k_c, v_c, k_s, v_s, k_w, v_w)]
        nsa_gates = jax.nn.sigmoid(nsa_g.astype(jnp.float32)).astype(q.dtype).reshape(B, S, G, R, 3)
        y_a = nsa_attention(q, kv[0], kv[1], kv[2], kv[3], kv[4], kv[5], nsa_gates, positions,
                            cmp_pos_k[l], cmp_pos_v[l], cmp_k_w1[l], cmp_k_w2[l],
                            cmp_v_w1[l], cmp_v_w2[l]) @ w_attn_o[l]
        y_b = spatial_gating(sgu_in, sgu_norm_g[l], sgu_w[l], sgu_b[l]) @ w_sgu_o[l]
        y_c = s5_layer(s5_in, s5_a_re[l], s5_a_im[l], s5_log_step[l], s5_b_re[l], s5_b_im[l],
                       s5_c_re[l], s5_c_im[l], s5_d[l], s5_glu_w[l], s5_glu_b[l]) @ w_s5_o[l]
        g_a, g_b, g_c = jnp.split(jax.nn.sigmoid(branch_g.astype(jnp.float32)), 3, axis=-1)
        merged = (g_a * y_a + g_b * y_b + g_c * y_c).astype(h.dtype)
        x = x + merged @ w_mix_o[l]
        h = rms_norm(x, norm_ffn_g[l])
        x = x + hierarchical_moe(h, router_group_w[l], router_group_b[l], router_expert_w[l],
                                 router_expert_b[l], expert_w_gate[l], expert_w_up[l], expert_w_down[l])
    return rms_norm(x, norm_final_g)
```

```cpp
#include <hip/hip_runtime.h>
#include <hip/hip_cooperative_groups.h>
#include <cstdio>
#include <cstdint>
#include <cmath>
namespace cg = cooperative_groups;

#ifndef ONE_LAUNCH
#define ONE_LAUNCH 1
#endif
#ifndef DBG_MASK
#define DBG_MASK 0x1fffff
#endif
#ifndef DBG_NOCOMBINE
#define DBG_NOCOMBINE 0
#endif
#ifndef DBG_DUMP
#define DBG_DUMP 0
#endif
#ifndef DBG_HASH
#define DBG_HASH 0
#endif
#ifndef DBG_ONLYS5
#define DBG_ONLYS5 0
#endif
#ifndef DBG_NOCSTORE
#define DBG_NOCSTORE 0
#endif
#ifndef DBG_LDSCHK
#define DBG_LDSCHK 0
#endif
#ifndef DBG_TWICE
#define DBG_TWICE 0
#endif
#ifndef DBG_S5CONST
#define DBG_S5CONST 0
#endif
#ifndef DBG_SC1READ
#define DBG_SC1READ 0
#endif
#ifndef DBG_E2
#define DBG_E2 0
#endif
#ifndef DBG_JOBFENCE
#define DBG_JOBFENCE 0
#endif
#ifndef DBG_CONSTOUT
#define DBG_CONSTOUT 0
#endif
#ifndef DBG_QDELAY
#define DBG_QDELAY 0
#endif
#ifndef DBG_PRESPIN
#define DBG_PRESPIN 0
#endif
#ifndef DBG_SGUSPIN
#define DBG_SGUSPIN 0
#endif
#ifndef DBG_PREFLUSH
#define DBG_PREFLUSH 0
#endif
#ifndef DBG_ESC1
#define DBG_ESC1 0
#endif
#ifndef DBG_DELAY
#define DBG_DELAY 0
#endif
#ifndef DBG_IDROT
#define DBG_IDROT 0
#endif
#ifndef DBG_DUMP_REV
#define DBG_DUMP_REV 0
#endif
#ifndef DBG_SGUCUT
#define DBG_SGUCUT 0
#endif
#ifndef DBG_EFILT
#define DBG_EFILT 0
#define DBG_EFILT_LO 0
#define DBG_EFILT_HI 0
#endif
#ifndef DBG_DUMP_OFF
#define DBG_DUMP_OFF 0
#define DBG_DUMP_N 0
#define DBG_DUMP_F32 0
#endif
#ifndef DBG_PH_HI
#define DBG_PH_HI NPHASE
#endif

typedef unsigned short bf16_t;
typedef short bf16x8 __attribute__((ext_vector_type(8)));
typedef float f32x4 __attribute__((ext_vector_type(4)));
typedef unsigned u32x4 __attribute__((ext_vector_type(4)));
typedef unsigned u32x2 __attribute__((ext_vector_type(2)));

constexpr int DM = 1024, NB = 8, SEQ = 4096, NTOK = NB * SEQ, DEPTH = 2;
constexpr int NCMP = 255;
constexpr float RMS_EPS = 1e-6f;
constexpr int NTHR = 256;
constexpr int LDS_BAR = 67584;
constexpr int LDS_BYTES = 67584 + 64;

constexpr size_t OFF_CTL = 0;
constexpr size_t OFF_W = 65536;
constexpr size_t W_IN = 0, W_GB = 4456448, W_A = 10747904, W_S = 11796480, W_5 = 12320768, W_M = 12845056, W_GLU = 14942208,
                 W_C1 = 15073280, W_C2 = 16121856, W_PB = 16154624, W_SGU = 16155648, W_S5A = 16286720, W_S5A256 = 16294912,
                 W_S5B = 16303104, W_S5C = 16434176, W_EG = 16777216, W_EU = 50331648, W_ED = 83886080, W_END = 117440512;
constexpr size_t OFF_H = OFF_W + W_END;
constexpr size_t OFF_M = OFF_H + 67108864;
constexpr size_t OFF_R = OFF_M + 67108864;
constexpr size_t R_Q = 0, R_KC = 33554432, R_VC = 41943040, R_KS = 50331648, R_KW = 58720256, R_VST = 67108864, R_VWT = 75497472,
                 R_NG = 83886080, R_U = 87031808, R_V = 103809024, R_S5IN = 120586240, R_END = 137363456;
constexpr size_t OFF_C = OFF_R + R_END;
constexpr size_t C_ATT = 0, C_SGU = 33554432, C_YG = 50331648, C_S5O = 67108864, C_KCMP = 83886080, C_VCT = 84410368, C_S5E = 84934656, C_END = 85983232;
constexpr size_t OFF_MOE = OFF_C + C_END;
constexpr size_t MOE_LIST = 0, MOE_WS = 4194304, MOE_END = 4456448;
constexpr size_t WS_END = OFF_MOE + MOE_END;
constexpr size_t OFF_HID = OFF_R;
constexpr size_t OFF_YS = OFF_R + 71303168;
static_assert(OFF_YS + 134217728 <= OFF_C + C_KCMP, "alias overflow");

constexpr int CTL_BAR = 0;
constexpr int CTL_MOECNT = 4096;
constexpr int CTL_ATTN = 4096 + 64;
constexpr int CTL_BYTES = 32768;

struct KP {
    const float* in[36];
    float* xbuf;
    unsigned char* ws;
    float inv_freq[8];
    int ph_lo, ph_hi;
    int never;
    int pad;
};

typedef const KP __attribute__((address_space(4))) CKP;

typedef float f32x2_t __attribute__((ext_vector_type(2)));
typedef __bf16 bf16x2_t __attribute__((ext_vector_type(2)));
__device__ __forceinline__ unsigned pk_bf16(float lo, float hi) {
    const f32x2_t v = {lo, hi};
    union { bf16x2_t b; unsigned u; } x; x.b = __builtin_convertvector(v, bf16x2_t); return x.u;
}
__device__ __forceinline__ bf16_t f2bf(float f) { return (bf16_t)(pk_bf16(f, 0.f) & 0xffffu); }
__device__ __forceinline__ float bf2f(bf16_t b) { return __uint_as_float(((unsigned)b) << 16); }
__device__ __forceinline__ float bflo(unsigned u) { return __uint_as_float(u << 16); }
__device__ __forceinline__ float bfhi(unsigned u) { return __uint_as_float(u & 0xffff0000u); }
__device__ __forceinline__ float fexp2(float x) { return __builtin_amdgcn_exp2f(x); }
__device__ __forceinline__ float gelu_tanh(float x) {
    const float u = 0.7978845608028654f * (x + 0.044715f * x * x * x);
    const float e = __expf(2.f * u);
    const float t = 1.f - 2.f / (e + 1.f);
    return 0.5f * x * (1.f + t);
}
__device__ __forceinline__ float sigm(float x) { return 1.f / (1.f + __expf(-x)); }
__device__ __forceinline__ int opaque_tid() { int t = threadIdx.x; asm volatile("" : "+v"(t)); return t; }
__device__ __forceinline__ void job_fence() {
#if DBG_JOBFENCE
    asm volatile("s_waitcnt vmcnt(0) lgkmcnt(0)" ::: "memory");
    __syncthreads();
#endif
}
__device__ __forceinline__ float wave_sum(float v) {
#pragma unroll
    for (int o = 32; o >= 1; o >>= 1) v += __shfl_xor(v, o);
    return v;
}
__device__ __forceinline__ f32x4 mfma16(bf16x8 a, bf16x8 b, f32x4 c) { return __builtin_amdgcn_mfma_f32_16x16x32_bf16(a, b, c, 0, 0, 0); }
__device__ __forceinline__ bf16x8 as_bf8(u32x4 v) { union { u32x4 u; bf16x8 b; } x; x.u = v; return x.b; }
__device__ __forceinline__ void store16bf(bf16_t* dst, const float (&v)[16]) {
    u32x4 a, b;
    a.x = pk_bf16(v[0], v[1]); a.y = pk_bf16(v[2], v[3]); a.z = pk_bf16(v[4], v[5]); a.w = pk_bf16(v[6], v[7]);
    b.x = pk_bf16(v[8], v[9]); b.y = pk_bf16(v[10], v[11]); b.z = pk_bf16(v[12], v[13]); b.w = pk_bf16(v[14], v[15]);
    *(u32x4*)dst = a; *(u32x4*)(dst + 8) = b;
}

#ifndef XB_SCOPE
#define XB_SCOPE "agent"
#endif
#define XB_TMO      128
#define XB_XCNT(j)  (256  + 64 * (j))
#define XB_XSUB(j)  (1280 + 64 * (j))
#define XB_XGEN(j)  (2304 + 64 * (j))
#define XB_TOP      3328
#define XB_TOPGEN   3392
#define XCD_BAR_WORDS 3456
#define XB_SPIN_CAP (1u << 22)
#define LAS __attribute__((address_space(3)))
__device__ __forceinline__ unsigned xb_ld(unsigned* p)              { return __hip_atomic_load(p, __ATOMIC_RELAXED, __HIP_MEMORY_SCOPE_AGENT); }
__device__ __forceinline__ unsigned xb_add(unsigned* p, unsigned v) { return __hip_atomic_fetch_add(p, v, __ATOMIC_RELAXED, __HIP_MEMORY_SCOPE_AGENT); }
__device__ __forceinline__ unsigned xb_xcc_id() { return (unsigned)__builtin_amdgcn_s_getreg((3 << 11) | 20) & 0xFu; }
#define XB_SPIN(cond, bar) do { unsigned _sp = 0; while (cond) { __builtin_amdgcn_s_sleep(1); \
    if ((++_sp & 255u) == 0u) { if (xb_ld(&(bar)[XB_TMO])) break; if (_sp > XB_SPIN_CAP) { atomicAdd(&(bar)[XB_TMO], 1u); break; } } } } while (0)
struct XcdBarrier { unsigned* bar; unsigned x; volatile LAS unsigned* st; };
__device__ __forceinline__ XcdBarrier xcd_barrier_post(unsigned* bar, volatile LAS unsigned* st) {
    XcdBarrier b; b.bar = bar; b.x = xb_xcc_id(); b.st = st;
    if (threadIdx.x == 0) (void)xb_add(&bar[XB_XCNT(b.x)], 1u);
    return b;
}
__device__ __forceinline__ void xcd_barrier_complete(unsigned* bar, unsigned x, unsigned& nloc, unsigned& nx) {
    const unsigned G = gridDim.x * gridDim.y * gridDim.z;
    unsigned sum, cnt, mine, sp = 0u;
    for (;;) {
        sum = 0u; cnt = 0u; mine = 0u;
#pragma unroll
        for (unsigned j = 0; j < 16; ++j) { const unsigned c = xb_ld(&bar[XB_XCNT(j)]); sum += c; cnt += (c > 0u) ? 1u : 0u; mine = (j == x) ? c : mine; }
        if (sum == G) break;
        __builtin_amdgcn_s_sleep(1);
        if ((++sp & 255u) == 0u) { if (xb_ld(&bar[XB_TMO])) break; if (sp > XB_SPIN_CAP) { atomicAdd(&bar[XB_TMO], 1u); break; } }
    }
    nloc = mine > 0u ? mine : 1u; nx = cnt > 0u ? cnt : 1u;
}
__device__ __forceinline__ void xcd_barrier(const XcdBarrier& b) {
    asm volatile("s_waitcnt vmcnt(0)" ::: "memory");
    __syncthreads();
    if (threadIdx.x == 0) {
        unsigned* bar = b.bar;
        __builtin_amdgcn_s_waitcnt(0);
        unsigned nloc = b.st[0], nx = b.st[1];
        if (nloc == 0u) { xcd_barrier_complete(bar, b.x, nloc, nx); b.st[0] = nloc; b.st[1] = nx; }
        const unsigned old = xb_add(&bar[XB_XSUB(b.x)], 1u);
        const unsigned gen = old / nloc;
        if (old + 1u == (gen + 1u) * nloc) {
            __builtin_amdgcn_fence(__ATOMIC_RELEASE, XB_SCOPE);
            asm volatile("s_waitcnt vmcnt(0)" ::: "memory");
            const unsigned og = xb_add(&bar[XB_TOP], 1u);
            const unsigned tg = og / nx;
            if (og + 1u == (tg + 1u) * nx) xb_add(&bar[XB_TOPGEN], 1u);
            else XB_SPIN(xb_ld(&bar[XB_TOPGEN]) == tg, bar);
            __builtin_amdgcn_fence(__ATOMIC_ACQUIRE, XB_SCOPE);
            xb_add(&bar[XB_XGEN(b.x)], 1u);
            asm volatile("s_waitcnt vmcnt(0)" ::: "memory");
        } else {
            XB_SPIN(xb_ld(&bar[XB_XGEN(b.x)]) == gen, bar);
            __builtin_amdgcn_fence(__ATOMIC_ACQUIRE, XB_SCOPE);
            asm volatile("s_waitcnt vmcnt(0)" ::: "memory");
        }
    }
    __syncthreads();
}

__device__ __forceinline__ void tile_coords(int L, int ntm, int ntn, int& tm, int& tn) {
    const int nt = ntm * ntn, q = nt >> 3, r = nt & 7, xcd = L & 7, off = L >> 3;
    const int id = (xcd < r ? xcd * (q + 1) : r * (q + 1) + (xcd - r) * q) + off;
    const int GM = 8, nig = GM * ntn, gid = id / nig, fm = gid * GM, gsz = (ntm - fm) < GM ? (ntm - fm) : GM;
    tm = fm + ((id % nig) % gsz); tn = (id % nig) / gsz;
}

template <class AP, class BP>
__device__ __forceinline__ void gemm_kloop(f32x4 (&acc)[4][4], AP ap, int a_kstep, BP bp, int b_kstep, int nkt, unsigned char* lds, int tid) {
    const int c = tid & 7, r0 = tid >> 3;
    const bf16_t* pa[4]; const bf16_t* pb[4];
#pragma unroll
    for (int i = 0; i < 4; ++i) {
        pa[i] = ap(r0 + 32 * i) + c * 8;
        const int rho = r0 + 32 * i, wn_ = rho >> 6, ni_ = (rho >> 4) & 3, ii = rho & 15;
        pb[i] = bp(64 * wn_ + 16 * (ii >> 2) + 4 * ni_ + (ii & 3)) + c * 8;
    }
    const int woff = r0 * 128 + ((c ^ (r0 & 7)) << 4);
    const int lane = tid & 63, w = tid >> 6, wm = w >> 1, wn = w & 1, fr = lane & 15, fq = lane >> 4;
    const int ra = (64 * wm + fr) * 128, rb = (64 * wn + fr) * 128;
    const int sw0 = ((fq) ^ (fr & 7)) << 4, sw1 = ((4 + fq) ^ (fr & 7)) << 4;
    u32x4 va[4], vb[4];
#pragma unroll
    for (int i = 0; i < 4; ++i) { va[i] = *(const u32x4*)pa[i]; vb[i] = *(const u32x4*)pb[i]; }
    __syncthreads();
#pragma unroll
    for (int i = 0; i < 4; ++i) { *(u32x4*)(lds + woff + i * 4096) = va[i]; *(u32x4*)(lds + 32768 + woff + i * 4096) = vb[i]; }
    __syncthreads();
    for (int kt = 0; kt < nkt; ++kt) {
        const int cur = kt & 1;
        const bool more = (kt + 1 < nkt);
        if (more) {
#pragma unroll
            for (int i = 0; i < 4; ++i) { pa[i] += a_kstep; pb[i] += b_kstep; va[i] = *(const u32x4*)pa[i]; vb[i] = *(const u32x4*)pb[i]; }
        }
        const unsigned char* A = lds + cur * 16384;
        const unsigned char* B = lds + 32768 + cur * 16384;
#pragma unroll
        for (int ks = 0; ks < 2; ++ks) {
            const int sw = ks ? sw1 : sw0;
            bf16x8 af[4], bf[4];
#pragma unroll
            for (int mi = 0; mi < 4; ++mi) af[mi] = *(const bf16x8*)(A + ra + mi * 2048 + sw);
#pragma unroll
            for (int ni = 0; ni < 4; ++ni) bf[ni] = *(const bf16x8*)(B + rb + ni * 2048 + sw);
#pragma unroll
            for (int mi = 0; mi < 4; ++mi)
#pragma unroll
                for (int ni = 0; ni < 4; ++ni) acc[mi][ni] = mfma16(bf[ni], af[mi], acc[mi][ni]);
        }
        if (more) {
            unsigned char* An = lds + (cur ^ 1) * 16384;
#pragma unroll
            for (int i = 0; i < 4; ++i) { *(u32x4*)(An + woff + i * 4096) = va[i]; *(u32x4*)(An + 32768 + woff + i * 4096) = vb[i]; }
        }
        __syncthreads();
    }
}
__device__ __forceinline__ void zero_acc(f32x4 (&acc)[4][4]) {
#pragma unroll
    for (int i = 0; i < 4; ++i)
#pragma unroll
        for (int j = 0; j < 4; ++j) acc[i][j] = (f32x4){0.f, 0.f, 0.f, 0.f};
}

__device__ __forceinline__ void transpose_tile(const float* src, bf16_t* dst, int R, int C, int mode, int tk, int tn, float* tl, int tid) {
    const int k0 = tk * 64, n0 = tn * 64;
    {
        const int j = tid & 63; const int n = n0 + j;
        int col = n;
        if (mode == 1) col = (n < 1304) ? n : ((n < 1408) ? -1 : n - 104);
        else if (mode == 2) col = n + 2072;
#pragma unroll 4
        for (int pp = 0; pp < 16; ++pp) {
            const int i = (tid >> 6) + 4 * pp;
            tl[i * 65 + j] = (col >= 0) ? src[(size_t)(k0 + i) * C + col] : 0.f;
        }
    }
    __syncthreads();
#pragma unroll
    for (int q2 = 0; q2 < 2; ++q2) {
        const int jj = (tid >> 3) + 32 * q2, cc = tid & 7;
        u32x4 o;
        o.x = pk_bf16(tl[(cc * 8 + 0) * 65 + jj], tl[(cc * 8 + 1) * 65 + jj]);
        o.y = pk_bf16(tl[(cc * 8 + 2) * 65 + jj], tl[(cc * 8 + 3) * 65 + jj]);
        o.z = pk_bf16(tl[(cc * 8 + 4) * 65 + jj], tl[(cc * 8 + 5) * 65 + jj]);
        o.w = pk_bf16(tl[(cc * 8 + 6) * 65 + jj], tl[(cc * 8 + 7) * 65 + jj]);
        *(u32x4*)(dst + (size_t)(n0 + jj) * R + k0 + cc * 8) = o;
    }
    __syncthreads();
}

__device__ __forceinline__ void phase_prep(CKP& p, int l, unsigned char* lds) {
    const int tid = opaque_tid(), G = gridDim.x, lane = tid & 63, w = tid >> 6;
    unsigned char* W = p.ws + OFF_W;
    if (l < DEPTH) {
        struct E { const float* src; bf16_t* dst; int R, C, nd, mode, nbatch; };
        constexpr int NE = 14;
        for (int L = blockIdx.x;; L += G) {
            int rem = L; int e = 0; E d{};
            for (; e < NE; ++e) {
                switch (e) {
                    case 0: d = {p.in[3] + (size_t)l * 1024 * 5144, (bf16_t*)(W + W_IN), 1024, 5144, 2176, 1, 1}; break;
                    case 1: d = {p.in[3] + (size_t)l * 1024 * 5144, (bf16_t*)(W + W_GB), 1024, 5144, 3072, 2, 1}; break;
                    case 2: d = {p.in[10] + (size_t)l * 512 * 1024, (bf16_t*)(W + W_A), 512, 1024, 1024, 0, 1}; break;
                    case 3: d = {p.in[14] + (size_t)l * 256 * 1024, (bf16_t*)(W + W_S), 256, 1024, 1024, 0, 1}; break;
                    case 4: d = {p.in[25] + (size_t)l * 256 * 1024, (bf16_t*)(W + W_5), 256, 1024, 1024, 0, 1}; break;
                    case 5: d = {p.in[26] + (size_t)l * 1024 * 1024, (bf16_t*)(W + W_M), 1024, 1024, 1024, 0, 1}; break;
                    case 6: d = {p.in[23] + (size_t)l * 256 * 256, (bf16_t*)(W + W_GLU), 256, 256, 256, 0, 1}; break;
                    case 7: d = {p.in[6] + (size_t)l * 2048 * 128, (bf16_t*)(W + W_C1), 2048, 128, 128, 0, 1}; break;
                    case 8: d = {p.in[8] + (size_t)l * 2048 * 128, (bf16_t*)(W + W_C1) + 128 * 2048, 2048, 128, 128, 0, 1}; break;
                    case 9: d = {p.in[7] + (size_t)l * 128 * 64, (bf16_t*)(W + W_C2), 128, 64, 64, 0, 1}; break;
                    case 10: d = {p.in[9] + (size_t)l * 128 * 64, (bf16_t*)(W + W_C2) + 64 * 128, 128, 64, 64, 0, 1}; break;
                    case 11: d = {p.in[32] + (size_t)l * 32 * 1024 * 512, (bf16_t*)(W + W_EG), 1024, 512, 512, 0, 32}; break;
                    case 12: d = {p.in[33] + (size_t)l * 32 * 1024 * 512, (bf16_t*)(W + W_EU), 1024, 512, 512, 0, 32}; break;
                    default: d = {p.in[34] + (size_t)l * 32 * 512 * 1024, (bf16_t*)(W + W_ED), 512, 1024, 1024, 0, 32}; break;
                }
                const int per = (d.R >> 6) * (d.nd >> 6), tot = per * d.nbatch;
                if (rem < tot) break;
                rem -= tot;
            }
            if (e >= NE) break;
            const int per = (d.R >> 6) * (d.nd >> 6), bi = rem / per, t = rem % per, ntn = d.nd >> 6;
            transpose_tile(d.src + (size_t)bi * d.R * d.C, d.dst + (size_t)bi * d.R * d.nd, d.R, d.C, d.mode, t / ntn, t % ntn, (float*)lds, tid);
        }
        const int gt = blockIdx.x * NTHR + tid, gs = G * NTHR;
        {
            const float* sw = p.in[12] + (size_t)l * 4 * 128 * 128; bf16_t* o = (bf16_t*)(W + W_SGU);
            for (int i = gt; i < 65536; i += gs) { const int t = (i >> 7) & 127, s = i & 127; o[i] = f2bf(s <= t ? sw[i] : 0.f); }
        }
        {
            const float* are = p.in[15] + l * 1024; const float* aim = p.in[16] + l * 1024; const float* ls = p.in[17] + l * 16;
            const float* bre = p.in[18] + (size_t)l * 16384; const float* bim = p.in[19] + (size_t)l * 16384;
            float* oa = (float*)(W + W_S5A); float* oa2 = (float*)(W + W_S5A256); float* ob = (float*)(W + W_S5B);
            for (int i = gt; i < 1024; i += gs) {
                const int g = i >> 6;
                const float step = expf(ls[g]), ar = are[i], ai = aim[i];
                const float mag = expf(ar * step); float sn, cs; sincosf(ai * step, &sn, &cs);
                const float abr = mag * cs, abi = mag * sn;
                const float den = ar * ar + ai * ai, nr = abr - 1.f, ni = abi;
                const float cr = (nr * ar + ni * ai) / den, ci = (ni * ar - nr * ai) / den;
                oa[i * 2] = abr; oa[i * 2 + 1] = abi;
                float pr = abr, pi = abi;
                for (int s = 0; s < 8; ++s) { const float nr2 = pr * pr - pi * pi, ni2 = 2.f * pr * pi; pr = nr2; pi = ni2; }
                oa2[i * 2] = pr; oa2[i * 2 + 1] = pi;
                for (int h = 0; h < 16; ++h) {
                    const float br = bre[i * 16 + h], bi_ = bim[i * 16 + h];
                    ob[i * 32 + h] = cr * br - ci * bi_;
                    ob[i * 32 + 16 + h] = cr * bi_ + ci * br;
                }
            }
            const float* cre = p.in[20] + (size_t)l * 16384; const float* cim = p.in[21] + (size_t)l * 16384; bf16_t* oc = (bf16_t*)(W + W_S5C);
            for (int i = gt; i < 32768; i += gs) {
                const int k = i & 127, gh = i >> 7;
                oc[i] = f2bf(k < 64 ? cre[gh * 64 + k] : -cim[gh * 64 + (k - 64)]);
            }
        }
        {
            float* pb = (float*)(W + W_PB);
            for (int j = blockIdx.x * 4 + w; j < 256; j += G * 4) {
                const int kv = j >> 7, n = j & 127;
                const float* pos = p.in[kv ? 5 : 4] + (size_t)l * 2048; const float* w1 = p.in[kv ? 8 : 6] + (size_t)l * 2048 * 128;
                float s = 0.f;
                for (int k = lane; k < 2048; k += 64) s += pos[k] * w1[(size_t)k * 128 + n];
                s = wave_sum(s);
                if (lane == 0) pb[j] = s;
            }
        }
    }
    {
        const float* gam = (l < DEPTH) ? (p.in[2] + (size_t)l * 1024) : p.in[35];
        bf16_t* hb = (bf16_t*)(p.ws + OFF_H);
        const bf16_t* ys = (const bf16_t*)(p.ws + OFF_YS);
        f32x4 gv[4];
#pragma unroll
        for (int i = 0; i < 4; ++i) gv[i] = *(const f32x4*)(gam + 4 * lane + 256 * i);
        for (int row = blockIdx.x * 4 + w; row < NTOK; row += G * 4) {
            f32x4 xv[4]; float ss = 0.f;
#pragma unroll
            for (int i = 0; i < 4; ++i) {
                const int col = 4 * lane + 256 * i;
                if (l == 0) xv[i] = *(const f32x4*)(p.in[0] + (size_t)row * 1024 + col);
                else if ((DBG_NOCOMBINE >> l) & 1) xv[i] = *(const f32x4*)(p.xbuf + (size_t)row * 1024 + col);
                else {
                    xv[i] = *(const f32x4*)(p.xbuf + (size_t)row * 1024 + col);
                    const u32x2 y0 = *(const u32x2*)(ys + (size_t)(2 * row) * 1024 + col), y1 = *(const u32x2*)(ys + (size_t)(2 * row + 1) * 1024 + col);
                    xv[i][0] += bflo(y0.x) + bflo(y1.x); xv[i][1] += bfhi(y0.x) + bfhi(y1.x);
                    xv[i][2] += bflo(y0.y) + bflo(y1.y); xv[i][3] += bfhi(y0.y) + bfhi(y1.y);
                }
                ss += xv[i][0] * xv[i][0] + xv[i][1] * xv[i][1] + xv[i][2] * xv[i][2] + xv[i][3] * xv[i][3];
            }
            ss = wave_sum(ss);
            const float rstd = rsqrtf(ss * (1.f / 1024.f) + RMS_EPS);
#pragma unroll
            for (int i = 0; i < 4; ++i) {
                const int col = 4 * lane + 256 * i;
                f32x4 hn = xv[i] * rstd * gv[i];
                if (l < DEPTH) {
                    *(f32x4*)(p.xbuf + (size_t)row * 1024 + col) = xv[i];
                    u32x2 o; o.x = pk_bf16(hn[0], hn[1]); o.y = pk_bf16(hn[2], hn[3]);
                    *(u32x2*)(hb + (size_t)row * 1024 + col) = o;
                } else {
                    *(f32x4*)(p.xbuf + (size_t)row * 1024 + col) = hn;
                }
            }
        }
    }
}

__device__ __forceinline__ void phase_inproj(CKP& p, int l, unsigned char* lds) {
    const int tid = opaque_tid(), lane = tid & 63, w = tid >> 6, wm = w >> 1, wn = w & 1, fr = lane & 15, fq = lane >> 4;
    const bf16_t* A = (const bf16_t*)(p.ws + OFF_H);
    const bf16_t* Bt = (const bf16_t*)(p.ws + OFF_W + W_IN);
    unsigned char* R = p.ws + OFF_R;
    const int* pos = (const int*)p.in[1];
    constexpr int NTM = NTOK / 128, NTN = 17;
    for (int L = blockIdx.x; L < NTM * NTN; L += gridDim.x) {
        int tm, tn; tile_coords(L, NTM, NTN, tm, tn);
        const int m0 = tm * 128, n0 = tn * 128;
        f32x4 acc[4][4]; zero_acc(acc);
        gemm_kloop(acc, [&](int r) { return A + (size_t)(m0 + r) * 1024; }, 64, [&](int v) { return Bt + (size_t)(n0 + v) * 1024; }, 64, 16, lds, tid);
#pragma unroll
        for (int mi = 0; mi < 4; ++mi) {
            const int row = m0 + 64 * wm + 16 * mi + fr;
            const int cl = 64 * wn + 16 * fq;
            float v[16];
#pragma unroll
            for (int e = 0; e < 16; ++e) v[e] = acc[mi][e >> 2][e & 3];
            if (tn < 4) {
                store16bf((bf16_t*)(R + R_Q) + (size_t)row * 512 + n0 + cl, v);
            } else if (tn < 10) {
                const int seg = tn - 4;
                if (seg == 2 || seg == 4) {
                    if (fq == 0) {
                        const float ps = (float)pos[row];
#pragma unroll
                        for (int i = 0; i < 8; ++i) {
                            float sn, cs; sincosf(ps * p.inv_freq[i], &sn, &cs);
                            const float x1 = v[i], x2 = v[8 + i];
                            v[i] = x1 * cs - x2 * sn; v[8 + i] = x2 * cs + x1 * sn;
                        }
                    }
                }
                if (seg == 3 || seg == 5) {
                    bf16_t* dst = (bf16_t*)(R + (seg == 3 ? R_VST : R_VWT));
                    const int b = row >> 12, s = row & 4095, g = wn, d0 = 16 * fq;
#pragma unroll
                    for (int e = 0; e < 16; ++e) dst[((size_t)((b * 2 + g) * 64 + d0 + e)) * SEQ + s] = f2bf(v[e]);
                } else {
                    const size_t off = (seg == 0) ? R_KC : (seg == 1) ? R_VC : (seg == 2) ? R_KS : R_KW;
                    store16bf((bf16_t*)(R + off) + (size_t)row * 128 + cl, v);
                }
            } else if (tn == 10) {
                if (cl < 24) {
                    float* ng = (float*)(R + R_NG) + (size_t)row * 24 + cl;
#pragma unroll
                    for (int e = 0; e < 16; ++e) if (cl + e < 24) ng[e] = sigm(v[e]);
                }
            } else if (tn < 15) {
#pragma unroll
                for (int e = 0; e < 16; ++e) v[e] = gelu_tanh(v[e]);
                const int c512 = (tn - 11) * 128 + cl;
                if (c512 < 256) store16bf((bf16_t*)(R + R_U) + (size_t)row * 256 + c512, v);
                else store16bf((bf16_t*)(R + R_V) + (size_t)row * 256 + (c512 - 256), v);
            } else {
                store16bf((bf16_t*)(R + R_S5IN) + (size_t)row * 256 + (tn - 15) * 128 + cl, v);
            }
        }
    }
}

__device__ __forceinline__ void compress_tile(CKP& p, int job, unsigned char* lds) {
    job_fence();
    const int tid = opaque_tid(), lane = tid & 63, w = tid >> 6, wm = w >> 1, wn = w & 1, fr = lane & 15, fq = lane >> 4;
    const int kv = job >> 5, tm = job & 31, m0 = tm * 128;
    unsigned char* W = p.ws + OFF_W;
    const bf16_t* src = (const bf16_t*)(p.ws + OFF_R + (kv ? R_VC : R_KC));
    const bf16_t* W1 = (const bf16_t*)(W + W_C1) + (size_t)kv * 128 * 2048;
    const bf16_t* W2 = (const bf16_t*)(W + W_C2) + (size_t)kv * 64 * 128;
    const float* pb = (const float*)(W + W_PB) + kv * 128;
    f32x4 acc[4][4]; zero_acc(acc);
    gemm_kloop(acc, [&](int r) { int Rr = m0 + r; Rr = Rr < 4080 ? Rr : 4079; const int b = Rr / 510, rem = Rr % 510, c = rem >> 1, g = rem & 1;
                                 return src + ((size_t)(b * SEQ + 16 * c)) * 128 + g * 64; }, 128,
               [&](int v) { return W1 + (size_t)v * 2048; }, 64, 32, lds, tid);
#pragma unroll
    for (int mi = 0; mi < 4; ++mi) {
        const int row = 64 * wm + 16 * mi + fr; const int cb = 16 * fq;
        float v[16];
#pragma unroll
        for (int e = 0; e < 16; ++e) v[e] = gelu_tanh(acc[mi][e >> 2][e & 3] + pb[64 * wn + cb + e]);
        u32x4 a, b;
        a.x = pk_bf16(v[0], v[1]); a.y = pk_bf16(v[2], v[3]); a.z = pk_bf16(v[4], v[5]); a.w = pk_bf16(v[6], v[7]);
        b.x = pk_bf16(v[8], v[9]); b.y = pk_bf16(v[10], v[11]); b.z = pk_bf16(v[12], v[13]); b.w = pk_bf16(v[14], v[15]);
        *(u32x4*)(lds + wn * 16384 + row * 128 + (((2 * fq) ^ (row & 7)) << 4)) = a;
        *(u32x4*)(lds + wn * 16384 + row * 128 + (((2 * fq + 1) ^ (row & 7)) << 4)) = b;
    }
#pragma unroll
    for (int j = 0; j < 4; ++j) {
        const int pid = tid + 256 * j, row = pid >> 4, ch = pid & 15;
        const u32x4 v = *(const u32x4*)(W2 + row * 128 + ch * 8);
        *(u32x4*)(lds + 32768 + (ch >> 3) * 16384 + row * 128 + (((ch & 7) ^ (row & 7)) << 4)) = v;
    }
    __syncthreads();
    f32x4 a2[4][2];
#pragma unroll
    for (int i = 0; i < 4; ++i) { a2[i][0] = (f32x4){0.f, 0.f, 0.f, 0.f}; a2[i][1] = (f32x4){0.f, 0.f, 0.f, 0.f}; }
#pragma unroll
    for (int kt2 = 0; kt2 < 2; ++kt2)
#pragma unroll
        for (int ks = 0; ks < 2; ++ks) {
            bf16x8 af[4], bf[2];
#pragma unroll
            for (int mi = 0; mi < 4; ++mi) { const int row = 64 * wm + 16 * mi + fr; af[mi] = *(const bf16x8*)(lds + kt2 * 16384 + row * 128 + (((4 * ks + fq) ^ (row & 7)) << 4)); }
#pragma unroll
            for (int ni = 0; ni < 2; ++ni) { const int row = 32 * wn + 8 * (fr >> 2) + 4 * ni + (fr & 3); bf[ni] = *(const bf16x8*)(lds + 32768 + kt2 * 16384 + row * 128 + (((4 * ks + fq) ^ (row & 7)) << 4)); }
#pragma unroll
            for (int mi = 0; mi < 4; ++mi)
#pragma unroll
                for (int ni = 0; ni < 2; ++ni) a2[mi][ni] = mfma16(bf[ni], af[mi], a2[mi][ni]);
        }
    bf16_t* kcmp = (bf16_t*)(p.ws + OFF_C + C_KCMP);
    bf16_t* vct = (bf16_t*)(p.ws + OFF_C + C_VCT);
#pragma unroll
    for (int mi = 0; mi < 4; ++mi) {
        const int Rr = m0 + 64 * wm + 16 * mi + fr;
        if (Rr < 4080) {
            const int b = Rr / 510, rem = Rr % 510, c = rem >> 1, g = rem & 1, d0 = 32 * wn + 8 * fq;
            float v[8];
#pragma unroll
            for (int e = 0; e < 8; ++e) v[e] = a2[mi][e >> 2][e & 3];
            if (DBG_NOCSTORE) { if (v[0] == 123.456f) kcmp[0] = 1; }
            else if (kv == 0) {
                u32x4 o; o.x = pk_bf16(v[0], v[1]); o.y = pk_bf16(v[2], v[3]); o.z = pk_bf16(v[4], v[5]); o.w = pk_bf16(v[6], v[7]);
                *(u32x4*)(kcmp + ((size_t)(b * 256 + c)) * 128 + g * 64 + d0) = o;
                if (c == 254) *(u32x4*)(kcmp + ((size_t)(b * 256 + 255)) * 128 + g * 64 + d0) = (u32x4){0u, 0u, 0u, 0u};
            } else {
#pragma unroll
                for (int e = 0; e < 8; ++e) {
                    vct[((size_t)((b * 2 + g) * 64 + d0 + e)) * 256 + c] = f2bf(v[e]);
                    if (c == 254) vct[((size_t)((b * 2 + g) * 64 + d0 + e)) * 256 + 255] = 0;
                }
            }
        }
    }
    __syncthreads();
}

__device__ __forceinline__ void sgu_job(CKP& p, int l, int job, unsigned char* lds) {
    job_fence();
    const int tid = opaque_tid(), lane = tid & 63, w = tid >> 6, fr = lane & 15, fq = lane >> 4;
    const size_t tok0 = (size_t)job * 128;
    const bf16_t* V = (const bf16_t*)(p.ws + OFF_R + R_V) + tok0 * 256;
    const bf16_t* U = (const bf16_t*)(p.ws + OFF_R + R_U) + tok0 * 256;
    bf16_t* O = (bf16_t*)(p.ws + OFF_C + C_SGU) + tok0 * 256;
    const bf16_t* Wt = (const bf16_t*)(p.ws + OFF_W + W_SGU);
    const float* ng = p.in[11] + (size_t)l * 256;
    const float* bs = p.in[13] + (size_t)l * 512;
    __syncthreads();
    if (DBG_SGUCUT != 2) {
        const int s = tid >> 1, half = tid & 1;
        const bf16_t* src = V + (size_t)s * 256 + half * 128;
        float ss = 0.f;
#pragma unroll 4
        for (int j = 0; j < 16; ++j) {
            const u32x4 bb = *(const u32x4*)(src + j * 8);
            const unsigned uu[4] = {bb.x, bb.y, bb.z, bb.w};
#pragma unroll
            for (int q = 0; q < 4; ++q) { const float a = bflo(uu[q]), b2 = bfhi(uu[q]); ss += a * a + b2 * b2; }
        }
        ss += __shfl_xor(ss, 1);
        const float rstd = rsqrtf(ss * (1.f / 256.f) + RMS_EPS);
#pragma unroll 1
        for (int j = 0; j < 16; ++j) {
            const u32x4 bb = *(const u32x4*)(src + j * 8);
            const unsigned uu[4] = {bb.x, bb.y, bb.z, bb.w};
            const int cb = half * 128 + j * 8;
#pragma unroll
            for (int q = 0; q < 4; ++q) {
#pragma unroll
                for (int hh = 0; hh < 2; ++hh) {
                    const int c = cb + q * 2 + hh;
                    const float val = (hh ? bfhi(uu[q]) : bflo(uu[q])) * rstd * ng[c];
                    *(bf16_t*)(lds + c * 256 + ((((s >> 3) ^ (c & 15))) << 4) + (s & 7) * 2) = f2bf(val);
                }
            }
        }
    }
    __syncthreads();
    const int g = w;
#pragma unroll 1
    for (int th = 0; th < (DBG_SGUCUT == 1 ? 0 : 2); ++th) {
        f32x4 acc[4][4];
        zero_acc(acc);
#pragma unroll
        for (int ks = 0; ks < 4; ++ks) {
            if (32 * ks <= 64 * th + 63) {
                bf16x8 vf[4];
#pragma unroll
                for (int di = 0; di < 4; ++di) { const int c = 64 * g + 16 * di + fr; vf[di] = *(const bf16x8*)(lds + c * 256 + (((4 * ks + fq) ^ (c & 15)) << 4)); }
#pragma unroll
                for (int ti = 0; ti < 4; ++ti) {
                    const int t = 64 * th + 16 * ti + fr;
                    if (32 * ks <= 64 * th + 16 * ti + 15) {
                        const bf16x8 wf = *(const bf16x8*)(Wt + ((size_t)(g * 128 + t)) * 128 + 32 * ks + 8 * fq);
#pragma unroll
                        for (int di = 0; di < 4; ++di) acc[ti][di] = mfma16(vf[di], wf, acc[ti][di]);
                    }
                }
            }
        }
#pragma unroll
        for (int ti = 0; ti < 4; ++ti) {
            const int t = 64 * th + 16 * ti + fr; const float bb = bs[g * 128 + t];
#pragma unroll
            for (int di = 0; di < 4; ++di) {
                const int c = 64 * g + 16 * di + 4 * fq;
                const u32x2 uu = *(const u32x2*)(U + (size_t)t * 256 + c);
                u32x2 o;
                o.x = pk_bf16(bflo(uu.x) * (acc[ti][di][0] + bb), bfhi(uu.x) * (acc[ti][di][1] + bb));
                o.y = pk_bf16(bflo(uu.y) * (acc[ti][di][2] + bb), bfhi(uu.y) * (acc[ti][di][3] + bb));
                *(u32x2*)(O + (size_t)t * 256 + c) = o;
            }
        }
    }
    __syncthreads();
}

__device__ __forceinline__ void s5_job(CKP& p, int l, int jb, int pass, unsigned char* lds) {
    job_fence();
    const int tid = opaque_tid(), lane = tid & 63, w = tid >> 6, fr = lane & 15, fq = lane >> 4;
    const int id = ((jb * 4 + w) + DBG_IDROT) & 2047, seq = id >> 4, ch = id & 15, b = seq >> 4, g = seq & 15;
    unsigned char* W = p.ws + OFF_W;
    const float* ab = (const float*)(W + W_S5A) + (g * 64 + lane) * 2;
    float ar = ab[0], ai = ab[1];
    float br[16], bi[16];
    {
        const float* bb = (const float*)(W + W_S5B) + (size_t)(g * 64 + lane) * 32;
#pragma unroll
        for (int h = 0; h < 16; ++h) { br[h] = bb[h]; bi[h] = bb[16 + h]; }
    }
#if DBG_S5CONST >= 2
    { const float q = (float)(lane + 1) * 0.001f; ar = 0.99f - q; ai = 0.05f + q;
      for (int h = 0; h < 16; ++h) { br[h] = 0.01f * (float)(h + 1) + q; bi[h] = -0.02f * (float)(h + 1) + q; } }
#endif
    float* Eb = (float*)(p.ws + OFF_C + C_S5E);
    float hre = 0.f, him = 0.f;
    bf16x8 cf[4]; float dv[4];
    if (pass == 2) {
        const float* a2 = (const float*)(W + W_S5A256) + (g * 64 + lane) * 2;
        const float a2r = a2[0], a2i = a2[1];
        for (int c2 = 0; c2 < ch; ++c2) {
            const float* e = Eb + ((size_t)(seq * 16 + c2) * 64 + lane) * 2;
            const float nr = a2r * hre - a2i * him + e[0], ni = a2r * him + a2i * hre + e[1];
            hre = nr; him = ni;
        }
        const bf16_t* cm = (const bf16_t*)(W + W_S5C) + (size_t)(g * 16 + fr) * 128;
#pragma unroll
        for (int ks = 0; ks < 4; ++ks) cf[ks] = *(const bf16x8*)(cm + 32 * ks + 8 * fq);
#pragma unroll
        for (int r = 0; r < 4; ++r) dv[r] = p.in[22][(size_t)l * 256 + g * 16 + 4 * fq + r];
    }
    const bf16_t* xin = (const bf16_t*)(p.ws + OFF_R + R_S5IN) + ((size_t)(b * SEQ + ch * 256)) * 256 + g * 16;
    bf16_t* yg = (bf16_t*)(p.ws + OFF_C + C_YG) + ((size_t)(b * SEQ + ch * 256)) * 256 + g * 16;
    float* xs = (float*)(lds + w * 10240);
    int ldsbad = 0; (void)ldsbad;
    unsigned char* Hs = lds + w * 10240 + 2048;
#if DBG_TWICE
    float keep_re = 0.f, keep_im = 0.f;
#pragma unroll 1
    for (int rep = 0; rep < 2; ++rep) {
    if (rep == 1) { keep_re = hre; keep_im = him; hre = 0.f; him = 0.f; }
#endif
#pragma unroll 1
    for (int sub = 0; sub < 8; ++sub) {
#if DBG_S5CONST >= 1
        u32x4 xv; { const unsigned q = (unsigned)(sub * 32 + (lane >> 1)) * 2654435761u + (unsigned)id * 40503u + (lane & 1); xv.x = 0x3f803e80u ^ ((q & 0xff) << 16); xv.y = 0x3e003d00u ^ ((q >> 8) & 0x7f); xv.z = 0xbe803f00u ^ ((q >> 16) & 0x3f); xv.w = 0x3d80be00u; }
#else
        const u32x4 xv = *(const u32x4*)(xin + (size_t)(sub * 32 + (lane >> 1)) * 256 + (lane & 1) * 8);
#endif
        __syncthreads();
        f32x4 chk_a = {bflo(xv.x), bfhi(xv.x), bflo(xv.y), bfhi(xv.y)}, chk_c = {bflo(xv.z), bfhi(xv.z), bflo(xv.w), bfhi(xv.w)};
        {
            *(f32x4*)(xs + (lane >> 1) * 16 + (lane & 1) * 8) = chk_a;
            *(f32x4*)(xs + (lane >> 1) * 16 + (lane & 1) * 8 + 4) = chk_c;
        }
        __syncthreads();
#pragma unroll 4
        for (int st = 0; st < 32; ++st) {
#if DBG_S5CONST == 3
            f32x4 x0, x1, x2, x3;
            { const float t = (float)((sub * 32 + st) & 63) * 0.015625f + (float)(id & 7) * 0.125f;
              x0 = (f32x4){t, t * 0.5f, -t, 0.25f}; x1 = (f32x4){0.5f - t, t * t, 0.125f, t}; x2 = (f32x4){-0.25f, t, 0.75f * t, 1.f - t}; x3 = (f32x4){t, -t, 0.5f, 0.3f * t}; }
#else
            const f32x4 x0 = *(const f32x4*)(xs + st * 16), x1 = *(const f32x4*)(xs + st * 16 + 4), x2 = *(const f32x4*)(xs + st * 16 + 8), x3 = *(const f32x4*)(xs + st * 16 + 12);
#endif
            float ur = 0.f, ui = 0.f;
#pragma unroll
            for (int h = 0; h < 4; ++h) {
                ur += br[h] * x0[h]; ui += bi[h] * x0[h];
                ur += br[4 + h] * x1[h]; ui += bi[4 + h] * x1[h];
                ur += br[8 + h] * x2[h]; ui += bi[8 + h] * x2[h];
                ur += br[12 + h] * x3[h]; ui += bi[12 + h] * x3[h];
            }
            const float nr = ar * hre - ai * him + ur, ni = ar * him + ai * hre + ui;
            hre = nr; him = ni;
            if (pass == 2) {
                *(bf16_t*)(Hs + st * 256 + (((lane >> 3) ^ (st & 15)) << 4) + (lane & 7) * 2) = f2bf(hre);
                *(bf16_t*)(Hs + st * 256 + ((((64 + lane) >> 3) ^ (st & 15)) << 4) + (lane & 7) * 2) = f2bf(him);
            }
        }
#if DBG_LDSCHK
        {
            const f32x4 ra = *(volatile f32x4*)(xs + (lane >> 1) * 16 + (lane & 1) * 8), rc = *(volatile f32x4*)(xs + (lane >> 1) * 16 + (lane & 1) * 8 + 4);
            bool bad = false;
            for (int q = 0; q < 4; ++q) bad |= (__float_as_uint(ra[q]) != __float_as_uint(chk_a[q])) | (__float_as_uint(rc[q]) != __float_as_uint(chk_c[q]));
            if (__any(bad)) ldsbad = 1;
        }
#endif
        if (pass == 2) {
            __syncthreads();
#pragma unroll
            for (int tt = 0; tt < 2; ++tt) {
                f32x4 acc = {0.f, 0.f, 0.f, 0.f};
                const int tl = tt * 16 + fr;
#pragma unroll
                for (int ks = 0; ks < 4; ++ks) {
                    const bf16x8 hf = *(const bf16x8*)(Hs + tl * 256 + (((4 * ks + fq) ^ (tl & 15)) << 4));
                    acc = mfma16(cf[ks], hf, acc);
                }
                float y[4];
#pragma unroll
                for (int r = 0; r < 4; ++r) y[r] = gelu_tanh(acc[r] + dv[r] * xs[tl * 16 + 4 * fq + r]);
                u32x2 o; o.x = pk_bf16(y[0], y[1]); o.y = pk_bf16(y[2], y[3]);
                *(u32x2*)(yg + (size_t)(sub * 32 + tl) * 256 + 4 * fq) = o;
            }
        }
    }
#if DBG_TWICE
    }
    if (__float_as_uint(keep_re) != __float_as_uint(hre) || __float_as_uint(keep_im) != __float_as_uint(him)) { hre = __uint_as_float(0x7fc00000u); him = hre; }
#endif
    if (pass == 1) {
        float* e = Eb + ((size_t)(seq * 16 + ch) * 64 + lane) * 2;
#if DBG_LDSCHK
        if (ldsbad) { hre = __uint_as_float(0x7fc00000u); him = hre; }
#endif
#if DBG_ESC1
        { const unsigned long long pk = ((unsigned long long)__float_as_uint(him) << 32) | __float_as_uint(hre);
          __hip_atomic_store((unsigned long long*)e, pk, __ATOMIC_RELAXED, __HIP_MEMORY_SCOPE_AGENT); }
#else
        e[0] = hre; e[1] = him;
#endif
#if DBG_E2
        float* e2 = (float*)(p.ws + OFF_C + C_ATT) + ((size_t)(seq * 16 + ch) * 64 + lane) * 2;
        e2[0] = hre; e2[1] = him;
#endif
    }
    __syncthreads();
}

__device__ __forceinline__ void phase_mid1(CKP& p, int l, unsigned char* lds) {
#if DBG_QDELAY == 2
    if (blockIdx.x >= 320) return;
#elif DBG_QDELAY == 3
    if (blockIdx.x >= 320) {
        const unsigned long long t0 = __builtin_amdgcn_s_memrealtime(); while (__builtin_amdgcn_s_memrealtime() - t0 < 3000ull) __builtin_amdgcn_s_sleep(8);
        s5_job(p, l, blockIdx.x - 320, 1, lds);
        return;
    }
#elif DBG_QDELAY
    if (blockIdx.x >= 320) {
        s5_job(p, l, blockIdx.x - 320, 1, lds);
        const unsigned long long t0 = __builtin_amdgcn_s_memrealtime(); while (__builtin_amdgcn_s_memrealtime() - t0 < 6000ull) __builtin_amdgcn_s_sleep(8);
        return;
    }
#endif
    for (int j = blockIdx.x; j < 64 + 256 + 512; j += gridDim.x) {
#if DBG_ONLYS5 == 1
        if (j >= 320) s5_job(p, l, j - 320, 1, lds);
#elif DBG_ONLYS5 == 2
        if (j < 64) compress_tile(p, j, lds);
        else if (j >= 320) s5_job(p, l, j - 320, 1, lds);
#elif DBG_ONLYS5 == 4
        { const int jj = 831 - j; if (jj < 64) compress_tile(p, jj, lds); else if (jj >= 320) s5_job(p, l, jj - 320, 1, lds); }
#elif DBG_ONLYS5 == 5
        if (j < 64) compress_tile(p, j, lds);
        else if (j >= 320 && j < 512) s5_job(p, l, j - 320, 1, lds);
        else if (j >= 576) s5_job(p, l, j - 320, 1, lds);
        if (j >= 448 && j < 512) s5_job(p, l, j + 64 - 320, 1, lds);
#elif DBG_ONLYS5 == 3
        if (j >= 64 && j < 320) sgu_job(p, l, j - 64, lds);
        else if (j >= 320) s5_job(p, l, j - 320, 1, lds);
#elif DBG_ONLYS5 == 6
        if (j < 512) {
#if DBG_PRESPIN
            { const unsigned long long t0 = __builtin_amdgcn_s_memrealtime(); while (__builtin_amdgcn_s_memrealtime() - t0 < (unsigned long long)DBG_PRESPIN) __builtin_amdgcn_s_sleep(2); }
#endif
            s5_job(p, l, j, 1, lds);
        }
        else if (j < 768) sgu_job(p, l, j - 512, lds);
        else compress_tile(p, j - 768, lds);
#else
        if (j < 64) compress_tile(p, j, lds);
        else if (j < 320) {
#if DBG_SGUSPIN
            { const unsigned long long t0 = __builtin_amdgcn_s_memrealtime(); while (__builtin_amdgcn_s_memrealtime() - t0 < (unsigned long long)DBG_SGUSPIN) __builtin_amdgcn_s_sleep(2); }
#else
            sgu_job(p, l, j - 64, lds);
#endif
        } else {
#if DBG_DELAY
            if (j >= 576) { const unsigned long long t0 = __builtin_amdgcn_s_memrealtime(); while (__builtin_amdgcn_s_memrealtime() - t0 < (unsigned long long)DBG_DELAY) __builtin_amdgcn_s_sleep(8); }
#endif
            s5_job(p, l, j - 320, 1, lds);
        }
#endif
    }
}

constexpr int AL_Q = 0, AL_K = 32768, AL_V = 40960, AL_IMP = 49152, AL_SEL = 65792, AL_UNI = 66304, AL_JOB = 66336;
constexpr float SM_C = 0.125f * 1.4426950408889634f;

__device__ __forceinline__ void attn_load_q(const bf16_t* Qg, const int* pos, const float (&inv_freq)[8], int b, int g, int t0, bool rope, unsigned char* lds, int tid) {
#pragma unroll 1
    for (int j = 0; j < 8; ++j) {
        const int pid = tid + 256 * j, Rr = pid >> 3, ch = pid & 7;
        const int wq = Rr >> 6, r = (Rr >> 4) & 3, q = Rr & 15, t = t0 + 16 * wq + q;
        const bf16_t* src = Qg + ((size_t)(b * SEQ + t)) * 512 + (g * 4 + r) * 64;
        if (!rope || ch >= 2) {
            *(u32x4*)(lds + AL_Q + Rr * 128 + ((ch ^ (Rr & 7)) << 4)) = *(const u32x4*)(src + ch * 8);
        } else if (ch == 0) {
            const u32x4 a = *(const u32x4*)(src), c = *(const u32x4*)(src + 8);
            float x1[8] = {bflo(a.x), bfhi(a.x), bflo(a.y), bfhi(a.y), bflo(a.z), bfhi(a.z), bflo(a.w), bfhi(a.w)};
            float x2[8] = {bflo(c.x), bfhi(c.x), bflo(c.y), bfhi(c.y), bflo(c.z), bfhi(c.z), bflo(c.w), bfhi(c.w)};
            const float ps = (float)pos[b * SEQ + t];
#pragma unroll
            for (int i = 0; i < 8; ++i) {
                float sn, cs; sincosf(ps * inv_freq[i], &sn, &cs);
                const float u = x1[i], v = x2[i];
                x1[i] = u * cs - v * sn; x2[i] = v * cs + u * sn;
            }
            u32x4 o1, o2;
            o1.x = pk_bf16(x1[0], x1[1]); o1.y = pk_bf16(x1[2], x1[3]); o1.z = pk_bf16(x1[4], x1[5]); o1.w = pk_bf16(x1[6], x1[7]);
            o2.x = pk_bf16(x2[0], x2[1]); o2.y = pk_bf16(x2[2], x2[3]); o2.z = pk_bf16(x2[4], x2[5]); o2.w = pk_bf16(x2[6], x2[7]);
            *(u32x4*)(lds + AL_Q + Rr * 128 + ((0 ^ (Rr & 7)) << 4)) = o1;
            *(u32x4*)(lds + AL_Q + Rr * 128 + ((1 ^ (Rr & 7)) << 4)) = o2;
        }
    }
}
__device__ __forceinline__ void attn_load_kv(const bf16_t* Kb, const bf16_t* Vb, int vstride, unsigned char* lds, int tid) {
#pragma unroll
    for (int j = 0; j < 2; ++j) {
        const int pid = tid + 256 * j, row = pid >> 3, ch = pid & 7;
        const u32x4 kk = *(const u32x4*)(Kb + (size_t)row * 128 + ch * 8);
        const u32x4 vv = *(const u32x4*)(Vb + (size_t)row * vstride + ch * 8);
        *(u32x4*)(lds + AL_K + row * 128 + ((ch ^ (row & 7)) << 4)) = kk;
        *(u32x4*)(lds + AL_V + row * 128 + ((ch ^ ((row >> 1) & 7)) << 4)) = vv;
    }
}
__device__ __forceinline__ void attn_qk(f32x4 (&s)[2][4], const unsigned char* lds, int w, int fr, int fq, int hf) {
    const unsigned char* Qw = lds + AL_Q + w * 8192;
    const unsigned char* Kh = lds + AL_K + hf * 4096;
    const int sw0 = ((fq) ^ (fr & 7)) << 4, sw1 = ((4 + fq) ^ (fr & 7)) << 4;
#pragma unroll
    for (int ki = 0; ki < 2; ++ki)
#pragma unroll
        for (int qi = 0; qi < 4; ++qi) s[ki][qi] = (f32x4){0.f, 0.f, 0.f, 0.f};
#pragma unroll
    for (int ds = 0; ds < 2; ++ds) {
        bf16x8 qf[4];
#pragma unroll
        for (int qi = 0; qi < 4; ++qi) qf[qi] = *(const bf16x8*)(Qw + (qi * 16 + fr) * 128 + (ds ? sw1 : sw0));
#pragma unroll
        for (int ki = 0; ki < 2; ++ki) {
            const bf16x8 kf = *(const bf16x8*)(Kh + (ki * 16 + fr) * 128 + (ds ? sw1 : sw0));
#pragma unroll
            for (int qi = 0; qi < 4; ++qi) s[ki][qi] = mfma16(kf, qf[qi], s[ki][qi]);
        }
    }
}
__device__ __forceinline__ void attn_pv(f32x4 (&o)[4][4], const f32x4 (&s)[2][4], const unsigned char* lds, int fr, int fq, int hf) {
    bf16x8 pf[4];
#pragma unroll
    for (int qi = 0; qi < 4; ++qi) {
        u32x4 u;
        u.x = pk_bf16(s[0][qi][0], s[0][qi][1]); u.y = pk_bf16(s[0][qi][2], s[0][qi][3]);
        u.z = pk_bf16(s[1][qi][0], s[1][qi][1]); u.w = pk_bf16(s[1][qi][2], s[1][qi][3]);
        pf[qi] = as_bf8(u);
    }
    const int c0 = 4 * hf + (fq >> 1);
#pragma unroll
    for (int di = 0; di < 4; ++di) {
        const int row = di * 16 + fr, key = (row >> 1) & 7;
        const u32x2 lo = *(const u32x2*)(lds + AL_V + row * 128 + ((c0 ^ key) << 4) + 8 * (fq & 1));
        const u32x2 hi = *(const u32x2*)(lds + AL_V + row * 128 + (((c0 + 2) ^ key) << 4) + 8 * (fq & 1));
        const bf16x8 vf = as_bf8((u32x4){lo.x, lo.y, hi.x, hi.y});
#pragma unroll
        for (int qi = 0; qi < 4; ++qi) o[di][qi] = mfma16(vf, pf[qi], o[di][qi]);
    }
}
__device__ __forceinline__ unsigned attn_vmask(int kb, int fq, int lo, int hi) {
    unsigned vm = 0;
#pragma unroll
    for (int ki = 0; ki < 2; ++ki)
#pragma unroll
        for (int r = 0; r < 4; ++r) { const int key = kb + 16 * ki + 4 * fq + r; if (key >= lo && key <= hi) vm |= 1u << (ki * 4 + r); }
    return vm;
}
__device__ __forceinline__ void attn_softmax(f32x4 (&s)[2][4], f32x4 (&o)[4][4], float (&m)[4], float (&lsum)[4], unsigned vm) {
#pragma unroll
    for (int qi = 0; qi < 4; ++qi) {
        float mx = -1e30f;
#pragma unroll
        for (int ki = 0; ki < 2; ++ki)
#pragma unroll
            for (int r = 0; r < 4; ++r) { const float sv = ((vm >> (ki * 4 + r)) & 1u) ? s[ki][qi][r] * SM_C : -1e30f; s[ki][qi][r] = sv; mx = fmaxf(mx, sv); }
        mx = fmaxf(mx, __shfl_xor(mx, 16)); mx = fmaxf(mx, __shfl_xor(mx, 32));
        const float mn = fmaxf(m[qi], mx), alpha = fexp2(m[qi] - mn);
        m[qi] = mn;
        float ls = 0.f;
#pragma unroll
        for (int ki = 0; ki < 2; ++ki)
#pragma unroll
            for (int r = 0; r < 4; ++r) { const float pv = ((vm >> (ki * 4 + r)) & 1u) ? fexp2(s[ki][qi][r] - mn) : 0.f; s[ki][qi][r] = pv; ls += pv; }
        lsum[qi] = lsum[qi] * alpha + ls;
#pragma unroll
        for (int di = 0; di < 4; ++di) o[di][qi] *= alpha;
    }
}
__device__ __forceinline__ void attn_accum(bf16_t* dst, const f32x4 (&o)[4][4], const float (&lsum)[4], const float (&gate)[4], bool first, int fq) {
#pragma unroll
    for (int qi = 0; qi < 4; ++qi) {
        float lt = lsum[qi]; lt += __shfl_xor(lt, 16); lt += __shfl_xor(lt, 32);
        const float sc = gate[qi] / fmaxf(lt, 1e-30f);
#pragma unroll
        for (int di = 0; di < 4; ++di) {
            u32x2* ptr = (u32x2*)(dst + qi * 64 + 16 * di + 4 * fq);
            float a0 = o[di][qi][0] * sc, a1 = o[di][qi][1] * sc, a2 = o[di][qi][2] * sc, a3 = o[di][qi][3] * sc;
            if (!first) { const u32x2 f = *ptr; a0 += bflo(f.x); a1 += bfhi(f.x); a2 += bflo(f.y); a3 += bfhi(f.y); }
            u32x2 r; r.x = pk_bf16(a0, a1); r.y = pk_bf16(a2, a3);
            *ptr = r;
        }
    }
}

__device__ __forceinline__ void phase_attn(CKP& p, int l, unsigned char* lds, unsigned* ctl) {
    for (int j = blockIdx.x; j < 512; j += gridDim.x) s5_job(p, l, j, 2, lds);

    unsigned char* R = p.ws + OFF_R; unsigned char* C = p.ws + OFF_C;
    const bf16_t* Qg = (const bf16_t*)(R + R_Q);
    const bf16_t* Kc = (const bf16_t*)(C + C_KCMP); const bf16_t* Vc = (const bf16_t*)(C + C_VCT);
    const bf16_t* Ks = (const bf16_t*)(R + R_KS); const bf16_t* Vs = (const bf16_t*)(R + R_VST);
    const bf16_t* Kw = (const bf16_t*)(R + R_KW); const bf16_t* Vw = (const bf16_t*)(R + R_VWT);
    const float* NG = (const float*)(R + R_NG);
    bf16_t* AO = (bf16_t*)(C + C_ATT);
    const int* pos = (const int*)p.in[1];
    unsigned* ctr = ctl + CTL_ATTN + l;
    volatile int* jobp = (volatile int*)(lds + AL_JOB);
    float* imp = (float*)(lds + AL_IMP);
    unsigned long long* selm = (unsigned long long*)(lds + AL_SEL);
    unsigned long long* uni = (unsigned long long*)(lds + AL_UNI);
    float invf[8];
#pragma unroll
    for (int q = 0; q < 8; ++q) invf[q] = p.inv_freq[q];

    for (;;) {
        const int tid = opaque_tid(), lane = tid & 63, w = tid >> 6, fr = lane & 15, fq = lane >> 4;
        __syncthreads();
        if (tid == 0) *jobp = (int)atomicAdd(ctr, 1u);
        __syncthreads();
        const int job = *jobp;
        if (job >= 1024) break;
        const int i = 63 - (job >> 4), bg = job & 15, b = bg >> 1, g = bg & 1, t0 = i * 64;
        const int tq = t0 + 16 * w + fr;
        const size_t kvrow = (size_t)b * SEQ;
        float gate[4];
        bf16_t* dstq = AO + ((size_t)(kvrow + tq)) * 512 + (g * 4) * 64;

        attn_load_q(Qg, pos, invf, b, g, t0, false, lds, tid);
        const int ntc = ((4 * i + 2) >> 6) + 1;
        const int hic = (tq >= 31) ? ((tq - 31) >> 4) : -1;
        float m[4], lsum[4];
#pragma unroll
        for (int qi = 0; qi < 4; ++qi) { m[qi] = -1e30f; lsum[qi] = 0.f; }
        {
#pragma unroll 1
            for (int ct = 0; ct < ntc; ++ct) {
                __syncthreads();
                attn_load_kv(Kc + ((size_t)(b * 256 + ct * 64)) * 128 + g * 64, Vc + ((size_t)((b * 2 + g) * 64)) * 256 + ct * 64, 256, lds, tid);
                __syncthreads();
#pragma unroll 1
                for (int hf = 0; hf < 2; ++hf) {
                    f32x4 s[2][4];
                    attn_qk(s, lds, w, fr, fq, hf);
                    const unsigned vm = attn_vmask(ct * 64 + hf * 32, fq, 0, hic);
#pragma unroll
                    for (int qi = 0; qi < 4; ++qi) {
                        float mx = -1e30f;
#pragma unroll
                        for (int ki = 0; ki < 2; ++ki)
#pragma unroll
                            for (int r = 0; r < 4; ++r) { const float sv = ((vm >> (ki * 4 + r)) & 1u) ? s[ki][qi][r] * SM_C : -1e30f; s[ki][qi][r] = sv; mx = fmaxf(mx, sv); }
                        mx = fmaxf(mx, __shfl_xor(mx, 16)); mx = fmaxf(mx, __shfl_xor(mx, 32));
                        const float mn = fmaxf(m[qi], mx), alpha = fexp2(m[qi] - mn);
                        m[qi] = mn;
                        float ls = 0.f;
#pragma unroll
                        for (int ki = 0; ki < 2; ++ki)
#pragma unroll
                            for (int r = 0; r < 4; ++r) ls += ((vm >> (ki * 4 + r)) & 1u) ? fexp2(s[ki][qi][r] - mn) : 0.f;
                        lsum[qi] = lsum[qi] * alpha + ls;
                    }
                }
            }
        }
        float invl[4];
#pragma unroll
        for (int qi = 0; qi < 4; ++qi) { float lt = lsum[qi]; lt += __shfl_xor(lt, 16); lt += __shfl_xor(lt, 32); invl[qi] = 1.f / fmaxf(lt, 1e-30f); }
        {
            f32x4 o[4][4]; zero_acc(o);
            float carry = 0.f;
#pragma unroll 1
            for (int ct = 0; ct < ntc; ++ct) {
                __syncthreads();
                attn_load_kv(Kc + ((size_t)(b * 256 + ct * 64)) * 128 + g * 64, Vc + ((size_t)((b * 2 + g) * 64)) * 256 + ct * 64, 256, lds, tid);
                __syncthreads();
#pragma unroll 1
                for (int hf = 0; hf < 2; ++hf) {
                    f32x4 s[2][4];
                    attn_qk(s, lds, w, fr, fq, hf);
                    const unsigned vm = attn_vmask(ct * 64 + hf * 32, fq, 0, hic);
#pragma unroll
                    for (int qi = 0; qi < 4; ++qi)
#pragma unroll
                        for (int ki = 0; ki < 2; ++ki)
#pragma unroll
                            for (int r = 0; r < 4; ++r) s[ki][qi][r] = ((vm >> (ki * 4 + r)) & 1u) ? fexp2(s[ki][qi][r] * SM_C - m[qi]) * invl[qi] : 0.f;
#pragma unroll
                    for (int ki = 0; ki < 2; ++ki) {
                        float a = 0.f, bq = 0.f;
#pragma unroll
                        for (int qi = 0; qi < 4; ++qi) { a += s[ki][qi][0] + s[ki][qi][1] + s[ki][qi][2] + 0.5f * s[ki][qi][3]; bq += 0.5f * s[ki][qi][3]; }
                        const float up = __shfl(bq, (lane + 48) & 63);
                        const float wrap = __shfl(carry, (lane + 48) & 63);
                        a += (fq >= 1) ? up : wrap;
                        carry = bq;
                        imp[(16 * w + fr) * 65 + 16 * ct + 8 * hf + 4 * ki + fq] = a;
                    }
                    attn_pv(o, s, lds, fr, fq, hf);
                }
            }
#pragma unroll
            for (int qi = 0; qi < 4; ++qi) gate[qi] = NG[((size_t)(kvrow + tq)) * 24 + (g * 4 + qi) * 3 + 0];
            const float quarter[4] = {0.25f, 0.25f, 0.25f, 0.25f};
            attn_accum(dstq, o, quarter, gate, true, fq);
        }
        __syncthreads();
        {
            const int q = tid >> 2, part = tid & 3;
            unsigned long long mk = 0ull;
            if (i <= 15) { mk = (i == 63) ? ~0ull : ((1ull << (i + 1)) - 1ull); }
            else {
                const float* row = imp + q * 65;
                for (int j = 1 + part; j <= i - 2; j += 4) {
                    const float vj = row[j]; int rank = 0;
                    for (int j2 = 1; j2 <= i - 2; ++j2) { const float v2 = row[j2]; rank += (v2 > vj || (v2 == vj && j2 < j)) ? 1 : 0; }
                    if (rank < 13) mk |= 1ull << j;
                }
                unsigned lo32 = (unsigned)mk, hi32 = (unsigned)(mk >> 32);
                lo32 |= __shfl_xor(lo32, 1); hi32 |= __shfl_xor(hi32, 1);
                lo32 |= __shfl_xor(lo32, 2); hi32 |= __shfl_xor(hi32, 2);
                mk = ((unsigned long long)hi32 << 32) | lo32;
                mk |= 1ull | (1ull << i) | (1ull << (i - 1));
            }
            if (part == 0) selm[q] = mk;
            unsigned lo32 = (unsigned)mk, hi32 = (unsigned)(mk >> 32);
#pragma unroll
            for (int o2 = 32; o2 >= 1; o2 >>= 1) { lo32 |= __shfl_xor(lo32, o2); hi32 |= __shfl_xor(hi32, o2); }
            if (lane == 0) uni[w] = ((unsigned long long)hi32 << 32) | lo32;
        }
        __syncthreads();
        const unsigned long long mymask = selm[16 * w + fr];
        const unsigned long long un = uni[0] | uni[1] | uni[2] | uni[3];
        __syncthreads();
        attn_load_q(Qg, pos, invf, b, g, t0, true, lds, tid);
        {
            f32x4 o[4][4]; zero_acc(o);
#pragma unroll
            for (int qi = 0; qi < 4; ++qi) { m[qi] = -1e30f; lsum[qi] = 0.f; }
#pragma unroll 1
            for (int j = 0; j <= i; ++j) {
                if (!((un >> j) & 1ull)) continue;
                __syncthreads();
                attn_load_kv(Ks + (kvrow + j * 64) * 128 + g * 64, Vs + ((size_t)((b * 2 + g) * 64)) * SEQ + j * 64, SEQ, lds, tid);
                __syncthreads();
                const int hi = ((mymask >> j) & 1ull) ? tq : -1;
#pragma unroll 1
                for (int hf = 0; hf < 2; ++hf) {
                    f32x4 s[2][4];
                    attn_qk(s, lds, w, fr, fq, hf);
                    const unsigned vm = attn_vmask(j * 64 + hf * 32, fq, 0, hi);
                    attn_softmax(s, o, m, lsum, vm);
                    attn_pv(o, s, lds, fr, fq, hf);
                }
            }
#pragma unroll
            for (int qi = 0; qi < 4; ++qi) gate[qi] = NG[((size_t)(kvrow + tq)) * 24 + (g * 4 + qi) * 3 + 1];
            attn_accum(dstq, o, lsum, gate, false, fq);
        }
        {
            f32x4 o[4][4]; zero_acc(o);
#pragma unroll
            for (int qi = 0; qi < 4; ++qi) { m[qi] = -1e30f; lsum[qi] = 0.f; }
            const int j0 = (i >= 8) ? (i - 8) : 0;
#pragma unroll 1
            for (int j = j0; j <= i; ++j) {
                __syncthreads();
                attn_load_kv(Kw + (kvrow + j * 64) * 128 + g * 64, Vw + ((size_t)((b * 2 + g) * 64)) * SEQ + j * 64, SEQ, lds, tid);
                __syncthreads();
#pragma unroll 1
                for (int hf = 0; hf < 2; ++hf) {
                    f32x4 s[2][4];
                    attn_qk(s, lds, w, fr, fq, hf);
                    const unsigned vm = attn_vmask(j * 64 + hf * 32, fq, tq - 511, tq);
                    attn_softmax(s, o, m, lsum, vm);
                    attn_pv(o, s, lds, fr, fq, hf);
                }
            }
#pragma unroll
            for (int qi = 0; qi < 4; ++qi) gate[qi] = NG[((size_t)(kvrow + tq)) * 24 + (g * 4 + qi) * 3 + 2];
            attn_accum(dstq, o, lsum, gate, false, fq);
        }
    }
}

__device__ __forceinline__ void phase_glu(CKP& p, int l, unsigned char* lds) {
    const int tid = opaque_tid(), lane = tid & 63, w = tid >> 6, wm = w >> 1, wn = w & 1, fr = lane & 15, fq = lane >> 4;
    const bf16_t* A = (const bf16_t*)(p.ws + OFF_C + C_YG);
    const bf16_t* Bt = (const bf16_t*)(p.ws + OFF_W + W_GLU);
    bf16_t* O = (bf16_t*)(p.ws + OFF_C + C_S5O);
    const float* gb = p.in[24] + (size_t)l * 256;
    constexpr int NTM = NTOK / 128, NTN = 2;
    for (int L = blockIdx.x; L < NTM * NTN; L += gridDim.x) {
        int tm, tn; tile_coords(L, NTM, NTN, tm, tn);
        const int m0 = tm * 128, n0 = tn * 128;
        f32x4 acc[4][4]; zero_acc(acc);
        gemm_kloop(acc, [&](int r) { return A + (size_t)(m0 + r) * 256; }, 64, [&](int v) { return Bt + (size_t)(n0 + v) * 256; }, 64, 4, lds, tid);
#pragma unroll
        for (int mi = 0; mi < 4; ++mi) {
            const int row = m0 + 64 * wm + 16 * mi + fr, col = n0 + 64 * wn + 16 * fq;
            const u32x4 y0 = *(const u32x4*)(A + (size_t)row * 256 + col), y1 = *(const u32x4*)(A + (size_t)row * 256 + col + 8);
            const unsigned yy[8] = {y0.x, y0.y, y0.z, y0.w, y1.x, y1.y, y1.z, y1.w};
            float v[16];
#pragma unroll
            for (int e = 0; e < 16; ++e) {
                const float y = (e & 1) ? bfhi(yy[e >> 1]) : bflo(yy[e >> 1]);
                v[e] = y * sigm(acc[mi][e >> 2][e & 3] + gb[col + e]);
            }
            store16bf(O + (size_t)row * 256 + col, v);
        }
    }
}

__device__ __forceinline__ void phase_branch(CKP& p, int l, unsigned char* lds) {
    const int tid = opaque_tid(), lane = tid & 63, w = tid >> 6, wm = w >> 1, wn = w & 1, fr = lane & 15, fq = lane >> 4;
    const bf16_t* H = (const bf16_t*)(p.ws + OFF_H);
    const bf16_t* Wgb = (const bf16_t*)(p.ws + OFF_W + W_GB);
    bf16_t* Mg = (bf16_t*)(p.ws + OFF_M);
    bf16_t* Yt = (bf16_t*)(p.ws + OFF_R);
    constexpr int NTM = NTOK / 128, NTN = 8;
    for (int L = blockIdx.x; L < NTM * NTN; L += gridDim.x) {
        int tm, tn; tile_coords(L, NTM, NTN, tm, tn);
        const int m0 = tm * 128, n0 = tn * 128;
#pragma unroll 1
        for (int br = 0; br < 3; ++br) {
            const bf16_t* Ab; const bf16_t* Wb; int Kb;
            if (br == 0) { Ab = (const bf16_t*)(p.ws + OFF_C + C_ATT); Wb = (const bf16_t*)(p.ws + OFF_W + W_A); Kb = 512; }
            else if (br == 1) { Ab = (const bf16_t*)(p.ws + OFF_C + C_SGU); Wb = (const bf16_t*)(p.ws + OFF_W + W_S); Kb = 256; }
            else { Ab = (const bf16_t*)(p.ws + OFF_C + C_S5O); Wb = (const bf16_t*)(p.ws + OFF_W + W_5); Kb = 256; }
            {
                f32x4 acc[4][4]; zero_acc(acc);
                gemm_kloop(acc, [&](int r) { return Ab + (size_t)(m0 + r) * Kb; }, 64, [&](int v) { return Wb + (size_t)(n0 + v) * Kb; }, 64, Kb >> 6, lds, tid);
#pragma unroll
                for (int mi = 0; mi < 4; ++mi) {
                    const int row = m0 + 64 * wm + 16 * mi + fr, col = n0 + 64 * wn + 16 * fq;
                    float v[16];
#pragma unroll
                    for (int e = 0; e < 16; ++e) v[e] = acc[mi][e >> 2][e & 3];
                    store16bf(Yt + (size_t)row * 1024 + col, v);
                }
            }
            {
                f32x4 acc[4][4]; zero_acc(acc);
                gemm_kloop(acc, [&](int r) { return H + (size_t)(m0 + r) * 1024; }, 64, [&](int v) { return Wgb + (size_t)(br * 1024 + n0 + v) * 1024; }, 64, 16, lds, tid);
#pragma unroll
                for (int mi = 0; mi < 4; ++mi) {
                    const int row = m0 + 64 * wm + 16 * mi + fr, col = n0 + 64 * wn + 16 * fq;
                    u32x4* dst = (u32x4*)(Mg + (size_t)row * 1024 + col);
                    const u32x4* ysrc = (const u32x4*)(Yt + (size_t)row * 1024 + col);
                    const u32x4 y0 = ysrc[0], y1 = ysrc[1];
                    const unsigned yy[8] = {y0.x, y0.y, y0.z, y0.w, y1.x, y1.y, y1.z, y1.w};
                    unsigned pp[8] = {0u, 0u, 0u, 0u, 0u, 0u, 0u, 0u};
                    if (br > 0) { const u32x4 p0 = dst[0], p1 = dst[1]; pp[0] = p0.x; pp[1] = p0.y; pp[2] = p0.z; pp[3] = p0.w; pp[4] = p1.x; pp[5] = p1.y; pp[6] = p1.z; pp[7] = p1.w; }
                    unsigned outw[8];
#pragma unroll
                    for (int ni = 0; ni < 4; ++ni) {
                        const float a0 = sigm(acc[mi][ni][0]) * bflo(yy[2 * ni]) + bflo(pp[2 * ni]), a1 = sigm(acc[mi][ni][1]) * bfhi(yy[2 * ni]) + bfhi(pp[2 * ni]);
                        const float a2 = sigm(acc[mi][ni][2]) * bflo(yy[2 * ni + 1]) + bflo(pp[2 * ni + 1]), a3 = sigm(acc[mi][ni][3]) * bfhi(yy[2 * ni + 1]) + bfhi(pp[2 * ni + 1]);
                        outw[2 * ni] = pk_bf16(a0, a1); outw[2 * ni + 1] = pk_bf16(a2, a3);
                    }
                    dst[0] = (u32x4){outw[0], outw[1], outw[2], outw[3]};
                    dst[1] = (u32x4){outw[4], outw[5], outw[6], outw[7]};
                }
            }
        }
    }
}

__device__ __forceinline__ void phase_mix(CKP& p, int l, unsigned char* lds) {
    const int tid = opaque_tid(), lane = tid & 63, w = tid >> 6, wm = w >> 1, wn = w & 1, fr = lane & 15, fq = lane >> 4;
    const bf16_t* A = (const bf16_t*)(p.ws + OFF_M);
    const bf16_t* Bt = (const bf16_t*)(p.ws + OFF_W + W_M);
    constexpr int NTM = NTOK / 128, NTN = 8;
    for (int L = blockIdx.x; L < NTM * NTN; L += gridDim.x) {
        int tm, tn; tile_coords(L, NTM, NTN, tm, tn);
        const int m0 = tm * 128, n0 = tn * 128;
        f32x4 acc[4][4]; zero_acc(acc);
        gemm_kloop(acc, [&](int r) { return A + (size_t)(m0 + r) * 1024; }, 64, [&](int v) { return Bt + (size_t)(n0 + v) * 1024; }, 64, 16, lds, tid);
#pragma unroll
        for (int mi = 0; mi < 4; ++mi) {
            const int row = m0 + 64 * wm + 16 * mi + fr, col = n0 + 64 * wn + 16 * fq;
            float* xp = p.xbuf + (size_t)row * 1024 + col;
#pragma unroll
            for (int ni = 0; ni < 4; ++ni) { f32x4 xv = *(f32x4*)(xp + 4 * ni); xv += acc[mi][ni]; *(f32x4*)(xp + 4 * ni) = xv; }
        }
    }
}

__device__ __forceinline__ void phase_router(CKP& p, int l, unsigned char* lds, unsigned* ctl) {
    const int tid = opaque_tid(), lane = tid & 63, w = tid >> 6;
    const float* gam = p.in[27] + (size_t)l * 1024;
    const float* wg = p.in[28] + (size_t)l * 1024 * 4; const float* bg = p.in[29] + (size_t)l * 4;
    const float* we = p.in[30] + (size_t)l * 1024 * 32; const float* be = p.in[31] + (size_t)l * 32;
    bf16_t* h2 = (bf16_t*)(p.ws + OFF_M);
    unsigned* cnt = ctl + CTL_MOECNT + l * 32;
    int* list = (int*)(p.ws + OFF_MOE + MOE_LIST);
    float* wsl = (float*)(p.ws + OFF_MOE + MOE_WS);
    float* xT = (float*)lds; float* Wc = (float*)(lds + 32768); float* lg = (float*)(lds + 57344);
    float* rs = (float*)(lds + 66560); int* lc = (int*)(lds + 66816); int* gbs = (int*)(lds + 66944);
    for (int tile = blockIdx.x; tile < NTOK / 64; tile += gridDim.x) {
        const int r0 = tile * 64;
        __syncthreads();
        if (tid < 32) lc[tid] = 0;
        {
            f32x4 gv[4];
#pragma unroll
            for (int i = 0; i < 4; ++i) gv[i] = *(const f32x4*)(gam + 4 * lane + 256 * i);
            for (int rr = 0; rr < 16; ++rr) {
                const int row = r0 + w * 16 + rr;
                f32x4 xv[4]; float ss = 0.f;
#pragma unroll
                for (int i = 0; i < 4; ++i) { xv[i] = *(const f32x4*)(p.xbuf + (size_t)row * 1024 + 4 * lane + 256 * i); ss += xv[i][0] * xv[i][0] + xv[i][1] * xv[i][1] + xv[i][2] * xv[i][2] + xv[i][3] * xv[i][3]; }
                ss = wave_sum(ss);
                const float rstd = rsqrtf(ss * (1.f / 1024.f) + RMS_EPS);
                if (lane == 0) rs[w * 16 + rr] = rstd;
#pragma unroll
                for (int i = 0; i < 4; ++i) {
                    const f32x4 hn = xv[i] * rstd * gv[i];
                    u32x2 o; o.x = pk_bf16(hn[0], hn[1]); o.y = pk_bf16(hn[2], hn[3]);
                    *(u32x2*)(h2 + (size_t)row * 1024 + 4 * lane + 256 * i) = o;
                }
            }
        }
        __syncthreads();
        float acc[9];
#pragma unroll
        for (int o = 0; o < 9; ++o) acc[o] = 0.f;
        const int row = tid & 63, og = tid >> 6;
        const float myrs = rs[row];
        for (int kc = 0; kc < 8; ++kc) {
            __syncthreads();
            {
                const float* xp = p.xbuf + (size_t)(r0 + row) * 1024 + kc * 128 + og * 32;
#pragma unroll
                for (int j = 0; j < 8; ++j) {
                    const f32x4 xv = *(const f32x4*)(xp + 4 * j); const f32x4 g4 = *(const f32x4*)(gam + kc * 128 + og * 32 + 4 * j);
#pragma unroll
                    for (int e = 0; e < 4; ++e) xT[(og * 32 + 4 * j + e) * 64 + row] = xv[e] * myrs * g4[e];
                }
                for (int idx = tid; idx < 128 * 36; idx += 256) {
                    const int k = idx / 36, o = idx % 36;
                    const float v = (o < 4) ? wg[(size_t)(kc * 128 + k) * 4 + o] : we[(size_t)(kc * 128 + k) * 32 + (o - 4)];
                    Wc[k * 48 + (o / 9) * 12 + (o % 9)] = v;
                }
            }
            __syncthreads();
#pragma unroll 4
            for (int k = 0; k < 128; ++k) {
                const float xv = xT[k * 64 + row];
                const f32x4 w0 = *(const f32x4*)(Wc + k * 48 + og * 12), w1 = *(const f32x4*)(Wc + k * 48 + og * 12 + 4);
                const float w8 = Wc[k * 48 + og * 12 + 8];
                acc[0] += xv * w0[0]; acc[1] += xv * w0[1]; acc[2] += xv * w0[2]; acc[3] += xv * w0[3];
                acc[4] += xv * w1[0]; acc[5] += xv * w1[1]; acc[6] += xv * w1[2]; acc[7] += xv * w1[3];
                acc[8] += xv * w8;
            }
        }
#pragma unroll
        for (int o = 0; o < 9; ++o) lg[row * 36 + og * 9 + o] = acc[o];
        __syncthreads();
        int e0 = 0, e1 = 0, lr0 = 0, lr1 = 0; float c0 = 0.f, c1 = 0.f;
        if (tid < 64) {
            const float* lrow = lg + tid * 36;
            float gl[4]; int grp = 0; float gm = -3.4e38f;
#pragma unroll
            for (int q = 0; q < 4; ++q) { gl[q] = lrow[q] + bg[q]; if (gl[q] > gm) { gm = gl[q]; grp = q; } }
            float gsum = 0.f;
#pragma unroll
            for (int q = 0; q < 4; ++q) gsum += expf(gl[q] - gm);
            const float grp_w = 1.f / gsum;
            float el[8]; float em = -3.4e38f;
#pragma unroll
            for (int q = 0; q < 8; ++q) { el[q] = lrow[4 + grp * 8 + q] + be[grp * 8 + q]; em = fmaxf(em, el[q]); }
            float esum = 0.f; float ep[8];
#pragma unroll
            for (int q = 0; q < 8; ++q) { ep[q] = expf(el[q] - em); esum += ep[q]; }
            int j0 = 0; float p0 = -1.f;
#pragma unroll
            for (int q = 0; q < 8; ++q) { const float pq = ep[q] / esum; ep[q] = pq; if (pq > p0) { p0 = pq; j0 = q; } }
            int j1 = 0; float p1 = -1.f;
#pragma unroll
            for (int q = 0; q < 8; ++q) { if (q != j0 && ep[q] > p1) { p1 = ep[q]; j1 = q; } }
            const float den = p0 + p1;
            c0 = grp_w * p0 / den; c1 = grp_w * p1 / den;
            e0 = grp * 8 + j0; e1 = grp * 8 + j1;
            lr0 = atomicAdd(&lc[e0], 1); lr1 = atomicAdd(&lc[e1], 1);
        }
        __syncthreads();
        if (tid < 32) { const int n = lc[tid]; gbs[tid] = n ? (int)atomicAdd(&cnt[tid], (unsigned)n) : 0; }
        __syncthreads();
        if (tid < 64) {
            const int tok = r0 + tid;
            list[e0 * 32768 + gbs[e0] + lr0] = tok * 2; list[e1 * 32768 + gbs[e1] + lr1] = tok * 2 + 1;
            wsl[tok * 2] = c0; wsl[tok * 2 + 1] = c1;
        }
    }
}

__device__ __forceinline__ bool moe_tile(const unsigned* cnt, int L, int nsub, int& e, int& mt, int& sub, int& rowbase, int& n) {
    int acc = 0, rb = 0;
    for (int q = 0; q < 32; ++q) {
        const int c = (int)cnt[q], nt = (c + 127) >> 7, tot = nt * nsub;
        if (L < acc + tot) { const int r = L - acc; e = q; mt = r / nsub; sub = r % nsub; rowbase = rb; n = c; return true; }
        acc += tot; rb += nt * 128;
    }
    return false;
}
__device__ __forceinline__ void phase_exp1(CKP& p, int l, unsigned char* lds, unsigned* ctl) {
    const int tid = opaque_tid(), lane = tid & 63, w = tid >> 6, wm = w >> 1, wn = w & 1, fr = lane & 15, fq = lane >> 4;
    const unsigned* cnt = ctl + CTL_MOECNT + l * 32;
    const int* list = (const int*)(p.ws + OFF_MOE + MOE_LIST);
    const bf16_t* h2 = (const bf16_t*)(p.ws + OFF_M);
    bf16_t* hid = (bf16_t*)(p.ws + OFF_HID);
    for (int L = blockIdx.x;; L += gridDim.x) {
        int e, mt, sub, rowbase, n;
        if (!moe_tile(cnt, L, 8, e, mt, sub, rowbase, n)) break;
        const bf16_t* Wg = (const bf16_t*)(p.ws + OFF_W + W_EG) + (size_t)e * 512 * 1024;
        const bf16_t* Wu = (const bf16_t*)(p.ws + OFF_W + W_EU) + (size_t)e * 512 * 1024;
        const int j0 = sub * 64;
        f32x4 acc[4][4]; zero_acc(acc);
        gemm_kloop(acc, [&](int r) { int s = mt * 128 + r; s = s < n ? s : n - 1; const int slot = list[e * 32768 + s]; return h2 + (size_t)(slot >> 1) * 1024; }, 64,
                   [&](int v) { const int wn_ = v >> 6, fq_ = (v >> 4) & 3, ee = v & 15; const int hc = j0 + 32 * wn_ + 8 * fq_ + (ee & 7);
                                return ((ee >> 3) ? Wu : Wg) + (size_t)hc * 1024; }, 64, 16, lds, tid);
#pragma unroll
        for (int mi = 0; mi < 4; ++mi) {
            const int r = mt * 128 + 64 * wm + 16 * mi + fr;
            if (r < n) {
                float gv[8], uv[8];
#pragma unroll
                for (int e2 = 0; e2 < 8; ++e2) { gv[e2] = acc[mi][e2 >> 2][e2 & 3]; uv[e2] = acc[mi][2 + (e2 >> 2)][e2 & 3]; }
                float hv[8];
#pragma unroll
                for (int e2 = 0; e2 < 8; ++e2) hv[e2] = gv[e2] * sigm(gv[e2]) * uv[e2];
                u32x4 o; o.x = pk_bf16(hv[0], hv[1]); o.y = pk_bf16(hv[2], hv[3]); o.z = pk_bf16(hv[4], hv[5]); o.w = pk_bf16(hv[6], hv[7]);
                *(u32x4*)(hid + (size_t)(rowbase + r) * 512 + j0 + 32 * wn + 8 * fq) = o;
            }
        }
    }
}
__device__ __forceinline__ void phase_exp2(CKP& p, int l, unsigned char* lds, unsigned* ctl) {
    const int tid = opaque_tid(), lane = tid & 63, w = tid >> 6, wm = w >> 1, wn = w & 1, fr = lane & 15, fq = lane >> 4;
    const unsigned* cnt = ctl + CTL_MOECNT + l * 32;
    const int* list = (const int*)(p.ws + OFF_MOE + MOE_LIST);
    const float* wsl = (const float*)(p.ws + OFF_MOE + MOE_WS);
    const bf16_t* hid = (const bf16_t*)(p.ws + OFF_HID);
    bf16_t* ys = (bf16_t*)(p.ws + OFF_YS);
    for (int L = blockIdx.x;; L += gridDim.x) {
        int e, mt, sub, rowbase, n;
        if (!moe_tile(cnt, L, 8, e, mt, sub, rowbase, n)) break;
        const bf16_t* Wd = (const bf16_t*)(p.ws + OFF_W + W_ED) + (size_t)e * 1024 * 512;
        const int n0 = sub * 128;
        f32x4 acc[4][4]; zero_acc(acc);
        gemm_kloop(acc, [&](int r) { int s = mt * 128 + r; s = s < n ? s : n - 1; return hid + (size_t)(rowbase + s) * 512; }, 64,
                   [&](int v) { return Wd + (size_t)(n0 + v) * 512; }, 64, 8, lds, tid);
#pragma unroll
        for (int mi = 0; mi < 4; ++mi) {
            const int r = mt * 128 + 64 * wm + 16 * mi + fr;
            if (r < n) {
                const int slot = list[e * 32768 + r]; const float wt = wsl[slot];
                float v[16];
#pragma unroll
                for (int e2 = 0; e2 < 16; ++e2) v[e2] = acc[mi][e2 >> 2][e2 & 3] * wt;
                store16bf(ys + (size_t)slot * 1024 + n0 + 64 * wn + 16 * fq, v);
            }
        }
    }
}

constexpr int PH_PER_LAYER = 10;
constexpr int NPHASE = PH_PER_LAYER * DEPTH + 1;

__global__ void __launch_bounds__(NTHR, 2) mega(KP p_unused) {
    extern __shared__ __attribute__((aligned(16))) unsigned char lds[];
    unsigned* ctl = (unsigned*)(p_unused.ws + OFF_CTL);
#if ONE_LAUNCH
    if (threadIdx.x < 2) ((volatile LAS unsigned*)(lds + LDS_BAR))[threadIdx.x] = 0u;
    __syncthreads();
    XcdBarrier xb = xcd_barrier_post(ctl + CTL_BAR, (volatile LAS unsigned*)(lds + LDS_BAR));
    if (p_unused.never) cg::this_grid().sync();
#if DBG_PREFLUSH
    __builtin_amdgcn_fence(__ATOMIC_RELEASE, "");
    asm volatile("s_waitcnt vmcnt(0)" ::: "memory");
    __builtin_amdgcn_fence(__ATOMIC_ACQUIRE, "");
    asm volatile("s_waitcnt vmcnt(0)" ::: "memory");
    xcd_barrier(xb);
    { const unsigned long long t0 = __builtin_amdgcn_s_memrealtime(); while (__builtin_amdgcn_s_memrealtime() - t0 < 20000ull) __builtin_amdgcn_s_sleep(8); }
    xcd_barrier(xb);
#endif
#endif
    CKP* kp0 = (CKP*)__builtin_amdgcn_kernarg_segment_ptr();
    const int ph_lo = kp0->ph_lo, ph_hi = kp0->ph_hi;
#if ONE_LAUNCH
#define PH_SYNC(PH) if ((PH) + 1 < ph_hi) xcd_barrier(xb);
#else
#define PH_SYNC(PH)
#endif
#define RUN_PHASE(PH, CALL) if (ph_lo <= (PH) && (PH) < ph_hi) { CKP* kp = kp0; asm volatile("" : "+s"(kp)); CKP& p = *kp; CALL; PH_SYNC(PH) }
#define RUN_LAYER(L) \
    RUN_PHASE((L) * 10 + 0, phase_prep(p, (L), lds)) \
    RUN_PHASE((L) * 10 + 1, phase_inproj(p, (L), lds)) \
    RUN_PHASE((L) * 10 + 2, phase_mid1(p, (L), lds)) \
    RUN_PHASE((L) * 10 + 3, phase_attn(p, (L), lds, ctl)) \
    RUN_PHASE((L) * 10 + 4, phase_glu(p, (L), lds)) \
    RUN_PHASE((L) * 10 + 5, phase_branch(p, (L), lds)) \
    RUN_PHASE((L) * 10 + 6, phase_mix(p, (L), lds)) \
    RUN_PHASE((L) * 10 + 7, phase_router(p, (L), lds, ctl)) \
    RUN_PHASE((L) * 10 + 8, phase_exp1(p, (L), lds, ctl)) \
    RUN_PHASE((L) * 10 + 9, phase_exp2(p, (L), lds, ctl))
    RUN_LAYER(0)
    RUN_LAYER(1)
    RUN_PHASE(20, phase_prep(p, 2, lds))
#if ONE_LAUNCH && DBG_DUMP
    {
        xcd_barrier(xb);
        CKP* kp = kp0; asm volatile("" : "+s"(kp)); CKP& p = *kp;
        const size_t NO = (size_t)NTOK * 1024;
        const unsigned char* src = p.ws + DBG_DUMP_OFF;
        for (size_t i = (size_t)blockIdx.x * NTHR + threadIdx.x; i < NO; i += (size_t)gridDim.x * NTHR) {
            float v = 0.f;
            if (i < (size_t)DBG_DUMP_N) {
                if (DBG_DUMP_F32) {
                    const size_t si = DBG_DUMP_REV ? ((size_t)DBG_DUMP_N - 1 - i) : i;
#if DBG_SC1READ
                    const unsigned fu = __hip_atomic_load((const unsigned*)src + si, __ATOMIC_RELAXED, __HIP_MEMORY_SCOPE_SYSTEM); const float f = __uint_as_float(fu);
#else
                    const float f = ((const float*)src)[si];
#endif
                    v = DBG_HASH ? (float)(__float_as_uint(f) & 0x3ff) : f;
#if DBG_EFILT
                    { const int id_ = (int)(((si >> 7) - DBG_IDROT) & 2047), blk = ((id_ >> 2) + 320) & 511; if (!(blk >= DBG_EFILT_LO && blk < DBG_EFILT_HI)) v = 0.f; }
#endif
#if DBG_E2
                    { const float f2 = ((const float*)(p.ws + OFF_C + C_ATT))[i]; v = (__float_as_uint(f2) == __float_as_uint(f)) ? 0.f : 1000.f; if (i == 0) v += 1.f; }
#endif
                }
                else { const bf16_t h = ((const bf16_t*)src)[i]; v = DBG_HASH ? (float)(h & 0x3ff) : bf2f(h); }
            }
#if DBG_CONSTOUT
            v = 1000.f + (float)(i & 1023);
#endif
            p.xbuf[i] = v;
        }
    }
#endif
}

#if DBG_DUMP
__global__ void dbg_dump(const bf16_t* src, size_t n, float* out, size_t nout) {
    for (size_t i = (size_t)blockIdx.x * blockDim.x + threadIdx.x; i < nout; i += (size_t)gridDim.x * blockDim.x)
        out[i] = i < n ? (DBG_HASH ? (float)(src[i] & 0x3ff) : bf2f(src[i])) : 0.f;
}
__global__ void dbg_dump_f32(const float* src, size_t n, float* out, size_t nout) {
    for (size_t i = (size_t)blockIdx.x * blockDim.x + threadIdx.x; i < nout; i += (size_t)gridDim.x * blockDim.x)
        out[i] = i < n ? (DBG_HASH ? (float)(__float_as_uint(src[i]) & 0x3ff) : src[i]) : 0.f;
}
#endif
extern "C" void kernel_launch(void* const* d_in, const int* in_sizes, int n_in, void* d_out, int out_size, void* d_ws, size_t ws_size, hipStream_t stream) {
    static int grid = 0;
    if (grid == 0) {
        if (n_in != 36 || out_size != NTOK * DM || ws_size < WS_END) { fprintf(stderr, "kernel_launch: unexpected shapes n_in %d out %d ws %zu (need %zu)\n", n_in, out_size, ws_size, (size_t)WS_END); grid = -1; return; }
        int dev = 0, cus = 0, per_cu = 0;
        hipGetDevice(&dev);
        hipDeviceGetAttribute(&cus, hipDeviceAttributeMultiprocessorCount, dev);
        hipFuncSetAttribute((const void*)mega, hipFuncAttributeMaxDynamicSharedMemorySize, LDS_BYTES);
        hipOccupancyMaxActiveBlocksPerMultiprocessor(&per_cu, (const void*)mega, NTHR, LDS_BYTES);
        if (per_cu < 1) { fprintf(stderr, "kernel_launch: occupancy query says %d\n", per_cu); per_cu = 1; }
        per_cu = 1;
        grid = cus * per_cu;
        fprintf(stderr, "kernel_launch: grid %d (%d CUs x %d)\n", grid, cus, per_cu);
    }
    if (grid < 0) return;
    hipMemsetAsync((char*)d_ws + OFF_CTL, 0, CTL_BYTES, stream);
    KP p{};
    for (int i = 0; i < 36; ++i) p.in[i] = (const float*)d_in[i];
    p.xbuf = (float*)d_out; p.ws = (unsigned char*)d_ws;
    for (int i = 0; i < 8; ++i) p.inv_freq[i] = (float)pow(500000.0, -(double)i / 8.0);
    p.never = 0; p.pad = 0;
#if ONE_LAUNCH
    p.ph_lo = 0; p.ph_hi = DBG_PH_HI;
    void* args[] = {&p};
    hipError_t e = hipLaunchCooperativeKernel((const void*)mega, dim3(grid), dim3(NTHR), args, LDS_BYTES, stream);
    if (e != hipSuccess) fprintf(stderr, "cooperative launch failed: %s (grid %d)\n", hipGetErrorString(e), grid);
#else
    for (int ph = 0; ph < NPHASE; ++ph) {
        if (!((DBG_MASK >> ph) & 1)) continue;
        p.ph_lo = ph; p.ph_hi = ph + 1;
        hipLaunchKernelGGL(mega, dim3(grid), dim3(NTHR), LDS_BYTES, stream, p);
    }
#if DBG_DUMP
    {
        const unsigned char* w = (const unsigned char*)d_ws; const size_t NO = (size_t)NTOK * 1024;
        size_t off = 0, n = 0; bool f32 = false;
        switch (DBG_DUMP) {
            case 1: off = OFF_C + C_ATT; n = (size_t)NTOK * 512; break;
            case 2: off = OFF_C + C_SGU; n = (size_t)NTOK * 256; break;
            case 3: off = OFF_C + C_S5O; n = (size_t)NTOK * 256; break;
            case 4: off = OFF_M; n = (size_t)NTOK * 1024; break;
            case 5: off = OFF_R + R_Q; n = (size_t)NTOK * 512; break;
            case 6: off = OFF_H; n = (size_t)NTOK * 1024; break;
            case 7: off = OFF_C + C_YG; n = (size_t)NTOK * 256; break;
            case 8: off = OFF_C + C_KCMP; n = (size_t)2 * 524288 / 2; break;
            case 9: off = OFF_R + R_KC; n = (size_t)NTOK * 128 * 6; break;
            case 10: off = OFF_R + R_NG; n = (size_t)NTOK * 24; f32 = true; break;
            case 11: off = OFF_R + R_U; n = (size_t)NTOK * 768; break;
            case 12: off = OFF_C + C_S5E; n = (size_t)128 * 16 * 64 * 2; f32 = true; break;
            case 15: off = 0; n = (size_t)NTOK * 1024; f32 = true; break;
            case 16: off = OFF_W + W_S5A; n = 36864; f32 = true; break;
            case 13: off = OFF_YS; n = (size_t)NTOK * 1024; break;
            case 14: off = OFF_MOE + MOE_WS; n = 65536; f32 = true; break;
            default: break;
        }
        if (DBG_DUMP == 15) hipLaunchKernelGGL(dbg_dump_f32, dim3(2048), dim3(256), 0, stream, (const float*)d_out, n, (float*)d_out, NO);
        else if (f32) hipLaunchKernelGGL(dbg_dump_f32, dim3(2048), dim3(256), 0, stream, (const float*)(w + off), n, (float*)d_out, NO);
        else hipLaunchKernelGGL(dbg_dump, dim3(2048), dim3(256), 0, stream, (const bf16_t*)(w + off), n, (float*)d_out, NO);
    }
#endif
#endif
}
```

```cpp
#include <hip/hip_runtime.h>
#include <hip/hip_cooperative_groups.h>
#include <cstdio>
#include <cstdint>
#include <cmath>
namespace cg = cooperative_groups;

#ifndef ONE_LAUNCH
#define ONE_LAUNCH 1
#endif
#ifndef DBG_MASK
#define DBG_MASK 0x1fffff
#endif
#ifndef DBG_NOCOMBINE
#define DBG_NOCOMBINE 0
#endif
#ifndef DBG_DUMP
#define DBG_DUMP 0
#endif
#ifndef DBG_HASH
#define DBG_HASH 0
#endif
#ifndef DBG_ONLYS5
#define DBG_ONLYS5 0
#endif
#ifndef DBG_NOCSTORE
#define DBG_NOCSTORE 0
#endif
#ifndef DBG_LDSCHK
#define DBG_LDSCHK 0
#endif
#ifndef DBG_TWICE
#define DBG_TWICE 0
#endif
#ifndef DBG_S5CONST
#define DBG_S5CONST 0
#endif
#ifndef DBG_SC1READ
#define DBG_SC1READ 0
#endif
#ifndef DBG_E2
#define DBG_E2 0
#endif
#ifndef DBG_JOBFENCE
#define DBG_JOBFENCE 0
#endif
#ifndef DBG_CONSTOUT
#define DBG_CONSTOUT 0
#endif
#ifndef DBG_QDELAY
#define DBG_QDELAY 0
#endif
#ifndef DBG_SMALLK
#define DBG_SMALLK 0
#endif
#ifndef DBG_REPEAT_PH
#define DBG_REPEAT_PH -1
#endif
#ifndef DBG_TIMEPH
#define DBG_TIMEPH -1
#endif
#ifndef DBG_TIMEPH2
#define DBG_TIMEPH2 (DBG_TIMEPH + 1)
#endif
#ifndef DBG_PRESPIN
#define DBG_PRESPIN 0
#endif
#ifndef DBG_SGUSPIN
#define DBG_SGUSPIN 0
#endif
#ifndef DBG_PREFLUSH
#define DBG_PREFLUSH 0
#endif
#ifndef DBG_ESC1
#define DBG_ESC1 0
#endif
#ifndef DBG_DELAY
#define DBG_DELAY 0
#endif
#ifndef DBG_IDROT
#define DBG_IDROT 0
#endif
#ifndef DBG_DUMP_REV
#define DBG_DUMP_REV 0
#endif
#ifndef DBG_SGUCUT
#define DBG_SGUCUT 0
#endif
#ifndef DBG_EFILT
#define DBG_EFILT 0
#define DBG_EFILT_LO 0
#define DBG_EFILT_HI 0
#endif
#ifndef DBG_DUMP_OFF
#define DBG_DUMP_OFF 0
#define DBG_DUMP_N 0
#define DBG_DUMP_F32 0
#endif
#ifndef DBG_PH_HI
#define DBG_PH_HI NPHASE
#endif

typedef unsigned short bf16_t;
typedef short bf16x8 __attribute__((ext_vector_type(8)));
typedef float f32x4 __attribute__((ext_vector_type(4)));
typedef unsigned u32x4 __attribute__((ext_vector_type(4)));
typedef unsigned u32x2 __attribute__((ext_vector_type(2)));

constexpr int DM = 1024, NB = 8, SEQ = 4096, NTOK = NB * SEQ, DEPTH = 2;
constexpr int NCMP = 255;
constexpr float RMS_EPS = 1e-6f;
constexpr int NTHR = 256;
constexpr int LDS_BAR = 67584;
#ifndef MAX_PER_CU
#define MAX_PER_CU 1
#endif
#ifndef LDS_TOTAL
#define LDS_TOTAL (67584 + 64)
#endif
constexpr int LDS_BYTES = LDS_TOTAL;

constexpr size_t OFF_CTL = 0;
constexpr size_t OFF_W = 65536;
constexpr size_t W_IN = 0, W_GB = 4456448, W_A = 10747904, W_S = 11796480, W_5 = 12320768, W_M = 12845056, W_GLU = 14942208,
                 W_C1 = 15073280, W_C2 = 16121856, W_PB = 16154624, W_SGU = 16155648, W_S5A = 16286720, W_S5A256 = 16294912,
                 W_S5B = 16303104, W_S5C = 16434176, W_EG = 16777216, W_EU = 50331648, W_ED = 83886080, W_END = 117440512;
constexpr size_t OFF_H = OFF_W + W_END;
constexpr size_t OFF_M = OFF_H + 67108864;
constexpr size_t OFF_R = OFF_M + 67108864;
constexpr size_t R_Q = 0, R_KC = 33554432, R_VC = 41943040, R_KS = 50331648, R_KW = 58720256, R_VST = 67108864, R_VWT = 75497472,
                 R_NG = 83886080, R_U = 87031808, R_V = 103809024, R_S5IN = 120586240, R_END = 137363456;
constexpr size_t OFF_C = OFF_R + R_END;
constexpr size_t C_ATT = 0, C_SGU = 33554432, C_YG = 50331648, C_S5O = 67108864, C_KCMP = 83886080, C_VCT = 84410368, C_S5E = 84934656, C_END = 85983232;
constexpr size_t OFF_MOE = OFF_C + C_END;
constexpr size_t MOE_LIST = 0, MOE_WS = 4194304, MOE_END = 4456448;
constexpr size_t WS_END = OFF_MOE + MOE_END;
constexpr size_t OFF_HID = OFF_R;
constexpr size_t OFF_YS = OFF_R + 71303168;
static_assert(OFF_YS + 134217728 <= OFF_C + C_KCMP, "alias overflow");

constexpr int CTL_BAR = 0;
constexpr int CTL_MOECNT = 4096;
constexpr int CTL_ATTN = 4096 + 64;
constexpr int CTL_BYTES = 32768;

struct KP {
    const float* in[36];
    float* xbuf;
    unsigned char* ws;
    float inv_freq[8];
    int ph_lo, ph_hi;
    int never;
    int pad;
};

typedef const KP __attribute__((address_space(4))) CKP;

typedef float f32x2_t __attribute__((ext_vector_type(2)));
typedef __bf16 bf16x2_t __attribute__((ext_vector_type(2)));
__device__ __forceinline__ unsigned pk_bf16(float lo, float hi) {
    const f32x2_t v = {lo, hi};
    union { bf16x2_t b; unsigned u; } x; x.b = __builtin_convertvector(v, bf16x2_t); return x.u;
}
__device__ __forceinline__ bf16_t f2bf(float f) { return (bf16_t)(pk_bf16(f, 0.f) & 0xffffu); }
__device__ __forceinline__ float bf2f(bf16_t b) { return __uint_as_float(((unsigned)b) << 16); }
__device__ __forceinline__ float bflo(unsigned u) { return __uint_as_float(u << 16); }
__device__ __forceinline__ float bfhi(unsigned u) { return __uint_as_float(u & 0xffff0000u); }
__device__ __forceinline__ float fexp2(float x) { return __builtin_amdgcn_exp2f(x); }
__device__ __forceinline__ float gelu_tanh(float x) {
    const float u = 0.7978845608028654f * (x + 0.044715f * x * x * x);
    const float e = __expf(2.f * u);
    const float t = 1.f - 2.f / (e + 1.f);
    return 0.5f * x * (1.f + t);
}
__device__ __forceinline__ float sigm(float x) { return 1.f / (1.f + __expf(-x)); }
__device__ __forceinline__ int opaque_tid() { int t = threadIdx.x; asm volatile("" : "+v"(t)); return t; }
__device__ __forceinline__ void job_fence() {
#if DBG_JOBFENCE
    asm volatile("s_waitcnt vmcnt(0) lgkmcnt(0)" ::: "memory");
    __syncthreads();
#endif
}
__device__ __forceinline__ float wave_sum(float v) {
#pragma unroll
    for (int o = 32; o >= 1; o >>= 1) v += __shfl_xor(v, o);
    return v;
}
__device__ __forceinline__ f32x4 mfma16(bf16x8 a, bf16x8 b, f32x4 c) { return __builtin_amdgcn_mfma_f32_16x16x32_bf16(a, b, c, 0, 0, 0); }
__device__ __forceinline__ bf16x8 as_bf8(u32x4 v) { union { u32x4 u; bf16x8 b; } x; x.u = v; return x.b; }
__device__ __forceinline__ void store16bf(bf16_t* dst, const float (&v)[16]) {
    u32x4 a, b;
    a.x = pk_bf16(v[0], v[1]); a.y = pk_bf16(v[2], v[3]); a.z = pk_bf16(v[4], v[5]); a.w = pk_bf16(v[6], v[7]);
    b.x = pk_bf16(v[8], v[9]); b.y = pk_bf16(v[10], v[11]); b.z = pk_bf16(v[12], v[13]); b.w = pk_bf16(v[14], v[15]);
    *(u32x4*)dst = a; *(u32x4*)(dst + 8) = b;
}

#ifndef XB_SCOPE
#define XB_SCOPE "agent"
#endif
#define XB_TMO      128
#define XB_XCNT(j)  (256  + 64 * (j))
#define XB_XSUB(j)  (1280 + 64 * (j))
#define XB_XGEN(j)  (2304 + 64 * (j))
#define XB_TOP      3328
#define XB_TOPGEN   3392
#define XCD_BAR_WORDS 3456
#define XB_SPIN_CAP (1u << 22)
#define LAS __attribute__((address_space(3)))
__device__ __forceinline__ unsigned xb_ld(unsigned* p)              { return __hip_atomic_load(p, __ATOMIC_RELAXED, __HIP_MEMORY_SCOPE_AGENT); }
__device__ __forceinline__ unsigned xb_add(unsigned* p, unsigned v) { return __hip_atomic_fetch_add(p, v, __ATOMIC_RELAXED, __HIP_MEMORY_SCOPE_AGENT); }
__device__ __forceinline__ unsigned xb_xcc_id() { return (unsigned)__builtin_amdgcn_s_getreg((3 << 11) | 20) & 0xFu; }
#define XB_SPIN(cond, bar) do { unsigned _sp = 0; while (cond) { __builtin_amdgcn_s_sleep(1); \
    if ((++_sp & 255u) == 0u) { if (xb_ld(&(bar)[XB_TMO])) break; if (_sp > XB_SPIN_CAP) { atomicAdd(&(bar)[XB_TMO], 1u); break; } } } } while (0)
struct XcdBarrier { unsigned* bar; unsigned x; volatile LAS unsigned* st; unsigned nloc, nx; };
__device__ __forceinline__ XcdBarrier xcd_barrier_post(unsigned* bar, volatile LAS unsigned* st) {
    XcdBarrier b; b.bar = bar; b.x = xb_xcc_id(); b.st = st; b.nloc = 0u; b.nx = 0u;
    if (threadIdx.x == 0) (void)xb_add(&bar[XB_XCNT(b.x)], 1u);
    return b;
}
__device__ __forceinline__ void xcd_barrier_complete(unsigned* bar, unsigned x, unsigned& nloc, unsigned& nx) {
    const unsigned G = gridDim.x * gridDim.y * gridDim.z;
    unsigned sum, cnt, mine, sp = 0u;
    for (;;) {
        sum = 0u; cnt = 0u; mine = 0u;
#pragma unroll
        for (unsigned j = 0; j < 16; ++j) { const unsigned c = xb_ld(&bar[XB_XCNT(j)]); sum += c; cnt += (c > 0u) ? 1u : 0u; mine = (j == x) ? c : mine; }
        if (sum == G) break;
        __builtin_amdgcn_s_sleep(1);
        if ((++sp & 255u) == 0u) { if (xb_ld(&bar[XB_TMO])) break; if (sp > XB_SPIN_CAP) { atomicAdd(&bar[XB_TMO], 1u); break; } }
    }
    nloc = mine > 0u ? mine : 1u; nx = cnt > 0u ? cnt : 1u;
}
__device__ __forceinline__ void xcd_barrier(XcdBarrier& b) {
    asm volatile("s_waitcnt vmcnt(0)" ::: "memory");
    __syncthreads();
    if (threadIdx.x == 0) {
        unsigned* bar = b.bar;
        __builtin_amdgcn_s_waitcnt(0);
        unsigned nloc = b.nloc, nx = b.nx;
        if (nloc == 0u) { xcd_barrier_complete(bar, b.x, nloc, nx); b.nloc = nloc; b.nx = nx; }
        const unsigned old = xb_add(&bar[XB_XSUB(b.x)], 1u);
        const unsigned gen = old / nloc;
        if (old + 1u == (gen + 1u) * nloc) {
            __builtin_amdgcn_fence(__ATOMIC_RELEASE, XB_SCOPE);
            asm volatile("s_waitcnt vmcnt(0)" ::: "memory");
            const unsigned og = xb_add(&bar[XB_TOP], 1u);
            const unsigned tg = og / nx;
            if (og + 1u == (tg + 1u) * nx) xb_add(&bar[XB_TOPGEN], 1u);
            else XB_SPIN(xb_ld(&bar[XB_TOPGEN]) == tg, bar);
            __builtin_amdgcn_fence(__ATOMIC_ACQUIRE, XB_SCOPE);
            xb_add(&bar[XB_XGEN(b.x)], 1u);
            asm volatile("s_waitcnt vmcnt(0)" ::: "memory");
        } else {
            XB_SPIN(xb_ld(&bar[XB_XGEN(b.x)]) == gen, bar);
            __builtin_amdgcn_fence(__ATOMIC_ACQUIRE, XB_SCOPE);
            asm volatile("s_waitcnt vmcnt(0)" ::: "memory");
        }
    }
    __syncthreads();
}

__device__ __forceinline__ void tile_coords(int L, int ntm, int ntn, int& tm, int& tn) {
    const int nt = ntm * ntn, q = nt >> 3, r = nt & 7, xcd = L & 7, off = L >> 3;
    const int id = (xcd < r ? xcd * (q + 1) : r * (q + 1) + (xcd - r) * q) + off;
    const int GM = 8, nig = GM * ntn, gid = id / nig, fm = gid * GM, gsz = (ntm - fm) < GM ? (ntm - fm) : GM;
    tm = fm + ((id % nig) % gsz); tn = (id % nig) / gsz;
}

template <class AP, class BP>
__device__ __forceinline__ void gemm_kloop(f32x4 (&acc)[4][4], AP ap, int a_kstep, BP bp, int b_kstep, int nkt, unsigned char* lds, int tid) {
    const int c = tid & 7, r0 = tid >> 3;
    const bf16_t* pa[4]; const bf16_t* pb[4];
#pragma unroll
    for (int i = 0; i < 4; ++i) {
        pa[i] = ap(r0 + 32 * i) + c * 8;
        const int rho = r0 + 32 * i, wn_ = rho >> 6, ni_ = (rho >> 4) & 3, ii = rho & 15;
        pb[i] = bp(64 * wn_ + 16 * (ii >> 2) + 4 * ni_ + (ii & 3)) + c * 8;
    }
    const int woff = r0 * 128 + ((c ^ (r0 & 7)) << 4);
    const int lane = tid & 63, w = tid >> 6, wm = w >> 1, wn = w & 1, fr = lane & 15, fq = lane >> 4;
    const int ra = (64 * wm + fr) * 128, rb = (64 * wn + fr) * 128;
    const int sw0 = ((fq) ^ (fr & 7)) << 4, sw1 = ((4 + fq) ^ (fr & 7)) << 4;
    u32x4 xa[4], xb[4], ya[4], yb[4];
    auto ld = [&](u32x4 (&a)[4], u32x4 (&b)[4]) {
#pragma unroll
        for (int i = 0; i < 4; ++i) { a[i] = *(const u32x4*)pa[i]; b[i] = *(const u32x4*)pb[i]; pa[i] += a_kstep; pb[i] += b_kstep; }
    };
    auto st = [&](const u32x4 (&a)[4], const u32x4 (&b)[4], int buf) {
        unsigned char* An = lds + buf * 16384;
#pragma unroll
        for (int i = 0; i < 4; ++i) { *(u32x4*)(An + woff + i * 4096) = a[i]; *(u32x4*)(An + 32768 + woff + i * 4096) = b[i]; }
    };
    auto compute = [&](int buf) {
        const unsigned char* A = lds + buf * 16384;
        const unsigned char* B = lds + 32768 + buf * 16384;
#pragma unroll
        for (int ks = 0; ks < 2; ++ks) {
            const int sw = ks ? sw1 : sw0;
            bf16x8 af[4], bf[4];
#pragma unroll
            for (int mi = 0; mi < 4; ++mi) af[mi] = *(const bf16x8*)(A + ra + mi * 2048 + sw);
#pragma unroll
            for (int ni = 0; ni < 4; ++ni) bf[ni] = *(const bf16x8*)(B + rb + ni * 2048 + sw);
#pragma unroll
            for (int mi = 0; mi < 4; ++mi)
#pragma unroll
                for (int ni = 0; ni < 4; ++ni) acc[mi][ni] = mfma16(bf[ni], af[mi], acc[mi][ni]);
        }
    };
    ld(xa, xb);
    if (nkt > 1) ld(ya, yb);
    __syncthreads();
    st(xa, xb, 0);
    if (nkt > 2) ld(xa, xb);
    __syncthreads();
    for (int kt = 0; kt < nkt; kt += 2) {
        compute(0);
        if (kt + 1 < nkt) st(ya, yb, 1);
        if (kt + 3 < nkt) ld(ya, yb);
        __syncthreads();
        if (kt + 1 < nkt) compute(1);
        if (kt + 2 < nkt) st(xa, xb, 0);
        if (kt + 4 < nkt) ld(xa, xb);
        __syncthreads();
    }
}
__device__ __forceinline__ void zero_acc(f32x4 (&acc)[4][4]) {
#pragma unroll
    for (int i = 0; i < 4; ++i)
#pragma unroll
        for (int j = 0; j < 4; ++j) acc[i][j] = (f32x4){0.f, 0.f, 0.f, 0.f};
}

__device__ __forceinline__ void transpose_tile(const float* src, bf16_t* dst, int R, int C, int mode, int tk, int tn, float* tl, int tid) {
    const int k0 = tk * 64, n0 = tn * 64;
    {
        const int j = tid & 63; const int n = n0 + j;
        int col = n;
        if (mode == 1) col = (n < 1304) ? n : ((n < 1408) ? -1 : n - 104);
        else if (mode == 2) col = n + 2072;
#pragma unroll 4
        for (int pp = 0; pp < 16; ++pp) {
            const int i = (tid >> 6) + 4 * pp;
            tl[i * 65 + j] = (col >= 0) ? src[(size_t)(k0 + i) * C + col] : 0.f;
        }
    }
    __syncthreads();
#pragma unroll
    for (int q2 = 0; q2 < 2; ++q2) {
        const int jj = (tid >> 3) + 32 * q2, cc = tid & 7;
        u32x4 o;
        o.x = pk_bf16(tl[(cc * 8 + 0) * 65 + jj], tl[(cc * 8 + 1) * 65 + jj]);
        o.y = pk_bf16(tl[(cc * 8 + 2) * 65 + jj], tl[(cc * 8 + 3) * 65 + jj]);
        o.z = pk_bf16(tl[(cc * 8 + 4) * 65 + jj], tl[(cc * 8 + 5) * 65 + jj]);
        o.w = pk_bf16(tl[(cc * 8 + 6) * 65 + jj], tl[(cc * 8 + 7) * 65 + jj]);
        *(u32x4*)(dst + (size_t)(n0 + jj) * R + k0 + cc * 8) = o;
    }
    __syncthreads();
}

__device__ __forceinline__ void phase_prep(CKP& p, int l, unsigned char* lds) {
    const int tid = opaque_tid(), G = gridDim.x, lane = tid & 63, w = tid >> 6;
    unsigned char* W = p.ws + OFF_W;
    if (l < DEPTH) {
        struct E { const float* src; bf16_t* dst; int R, C, nd, mode, nbatch; };
        constexpr int NE = 14;
        for (int L = blockIdx.x * 4 + w;; L += G * 4) {
            int rem = L; int e = 0; E d{};
            for (; e < NE; ++e) {
                switch (e) {
                    case 0: d = {p.in[3] + (size_t)l * 1024 * 5144, (bf16_t*)(W + W_IN), 1024, 5144, 2176, 1, 1}; break;
                    case 1: d = {p.in[3] + (size_t)l * 1024 * 5144, (bf16_t*)(W + W_GB), 1024, 5144, 3072, 2, 1}; break;
                    case 2: d = {p.in[10] + (size_t)l * 512 * 1024, (bf16_t*)(W + W_A), 512, 1024, 1024, 0, 1}; break;
                    case 3: d = {p.in[14] + (size_t)l * 256 * 1024, (bf16_t*)(W + W_S), 256, 1024, 1024, 0, 1}; break;
                    case 4: d = {p.in[25] + (size_t)l * 256 * 1024, (bf16_t*)(W + W_5), 256, 1024, 1024, 0, 1}; break;
                    case 5: d = {p.in[26] + (size_t)l * 1024 * 1024, (bf16_t*)(W + W_M), 1024, 1024, 1024, 0, 1}; break;
                    case 6: d = {p.in[23] + (size_t)l * 256 * 256, (bf16_t*)(W + W_GLU), 256, 256, 256, 0, 1}; break;
                    case 7: d = {p.in[6] + (size_t)l * 2048 * 128, (bf16_t*)(W + W_C1), 2048, 128, 128, 0, 1}; break;
                    case 8: d = {p.in[8] + (size_t)l * 2048 * 128, (bf16_t*)(W + W_C1) + 128 * 2048, 2048, 128, 128, 0, 1}; break;
                    case 9: d = {p.in[7] + (size_t)l * 128 * 64, (bf16_t*)(W + W_C2), 128, 64, 64, 0, 1}; break;
                    case 10: d = {p.in[9] + (size_t)l * 128 * 64, (bf16_t*)(W + W_C2) + 64 * 128, 128, 64, 64, 0, 1}; break;
                    case 11: d = {p.in[32] + (size_t)l * 32 * 1024 * 512, (bf16_t*)(W + W_EG), 1024, 512, 512, 0, 32}; break;
                    case 12: d = {p.in[33] + (size_t)l * 32 * 1024 * 512, (bf16_t*)(W + W_EU), 1024, 512, 512, 0, 32}; break;
                    default: d = {p.in[34] + (size_t)l * 32 * 512 * 1024, (bf16_t*)(W + W_ED), 512, 1024, 1024, 0, 32}; break;
                }
                const int per = (d.R >> 6) * (d.nd >> 6), tot = per * d.nbatch;
                if (rem < tot) break;
                rem -= tot;
            }
            if (e >= NE) break;
            const int per = (d.R >> 6) * (d.nd >> 6), bi = rem / per, t = rem % per, ntn = d.nd >> 6;
            const int k0 = (t / ntn) * 64, n = (t % ntn) * 64 + lane;
            int col = n;
            if (d.mode == 1) col = (n < 1304) ? n : ((n < 1408) ? -1 : n - 104);
            else if (d.mode == 2) col = n + 2072;
            const float* sp = d.src + (size_t)bi * d.R * d.C + (size_t)k0 * d.C + (col >= 0 ? col : 0);
            float v[64];
#pragma unroll
            for (int i = 0; i < 64; ++i) v[i] = sp[(size_t)i * d.C];
            if (col < 0) {
#pragma unroll
                for (int i = 0; i < 64; ++i) v[i] = 0.f;
            }
            bf16_t* dp = d.dst + (size_t)bi * d.R * d.nd + (size_t)n * d.R + k0;
#pragma unroll
            for (int q = 0; q < 8; ++q) {
                u32x4 o;
                o.x = pk_bf16(v[8 * q], v[8 * q + 1]); o.y = pk_bf16(v[8 * q + 2], v[8 * q + 3]);
                o.z = pk_bf16(v[8 * q + 4], v[8 * q + 5]); o.w = pk_bf16(v[8 * q + 6], v[8 * q + 7]);
                *(u32x4*)(dp + 8 * q) = o;
            }
        }
        const int gt = blockIdx.x * NTHR + tid, gs = G * NTHR;
        {
            const float* sw = p.in[12] + (size_t)l * 4 * 128 * 128; bf16_t* o = (bf16_t*)(W + W_SGU);
            for (int i = gt; i < 65536; i += gs) { const int t = (i >> 7) & 127, s = i & 127; o[i] = f2bf(s <= t ? sw[i] : 0.f); }
        }
        {
            const float* are = p.in[15] + l * 1024; const float* aim = p.in[16] + l * 1024; const float* ls = p.in[17] + l * 16;
            const float* bre = p.in[18] + (size_t)l * 16384; const float* bim = p.in[19] + (size_t)l * 16384;
            float* oa = (float*)(W + W_S5A); float* oa2 = (float*)(W + W_S5A256); float* ob = (float*)(W + W_S5B);
            for (int i = gt; i < 1024; i += gs) {
                const int g = i >> 6;
                const float step = expf(ls[g]), ar = are[i], ai = aim[i];
                const float mag = expf(ar * step); float sn, cs; sincosf(ai * step, &sn, &cs);
                const float abr = mag * cs, abi = mag * sn;
                const float den = ar * ar + ai * ai, nr = abr - 1.f, ni = abi;
                const float cr = (nr * ar + ni * ai) / den, ci = (ni * ar - nr * ai) / den;
                oa[i * 2] = abr; oa[i * 2 + 1] = abi;
                float pr = abr, pi = abi;
                for (int s = 0; s < 8; ++s) { const float nr2 = pr * pr - pi * pi, ni2 = 2.f * pr * pi; pr = nr2; pi = ni2; }
                oa2[i * 2] = pr; oa2[i * 2 + 1] = pi;
                for (int h = 0; h < 16; ++h) {
                    const float br = bre[i * 16 + h], bi_ = bim[i * 16 + h];
                    ob[i * 32 + h] = cr * br - ci * bi_;
                    ob[i * 32 + 16 + h] = cr * bi_ + ci * br;
                }
            }
            const float* cre = p.in[20] + (size_t)l * 16384; const float* cim = p.in[21] + (size_t)l * 16384; bf16_t* oc = (bf16_t*)(W + W_S5C);
            for (int i = gt; i < 32768; i += gs) {
                const int k = i & 127, gh = i >> 7;
                oc[i] = f2bf(k < 64 ? cre[gh * 64 + k] : -cim[gh * 64 + (k - 64)]);
            }
        }
        {
            float* pb = (float*)(W + W_PB);
            for (int j = blockIdx.x * 4 + w; j < 256; j += G * 4) {
                const int kv = j >> 7, n = j & 127;
                const float* pos = p.in[kv ? 5 : 4] + (size_t)l * 2048; const float* w1 = p.in[kv ? 8 : 6] + (size_t)l * 2048 * 128;
                float s = 0.f;
                for (int k = lane; k < 2048; k += 64) s += pos[k] * w1[(size_t)k * 128 + n];
                s = wave_sum(s);
                if (lane == 0) pb[j] = s;
            }
        }
    }
    {
        const float* gam = (l < DEPTH) ? (p.in[2] + (size_t)l * 1024) : p.in[35];
        bf16_t* hb = (bf16_t*)(p.ws + OFF_H);
        const bf16_t* ys = (const bf16_t*)(p.ws + OFF_YS);
        f32x4 gv[4];
#pragma unroll
        for (int i = 0; i < 4; ++i) gv[i] = *(const f32x4*)(gam + 4 * lane + 256 * i);
        for (int row = blockIdx.x * 4 + w; row < NTOK; row += G * 4) {
            f32x4 xv[4]; float ss = 0.f;
#pragma unroll
            for (int i = 0; i < 4; ++i) {
                const int col = 4 * lane + 256 * i;
                if (l == 0) xv[i] = *(const f32x4*)(p.in[0] + (size_t)row * 1024 + col);
                else if ((DBG_NOCOMBINE >> l) & 1) xv[i] = *(const f32x4*)(p.xbuf + (size_t)row * 1024 + col);
                else {
                    xv[i] = *(const f32x4*)(p.xbuf + (size_t)row * 1024 + col);
                    const u32x2 y0 = *(const u32x2*)(ys + (size_t)(2 * row) * 1024 + col), y1 = *(const u32x2*)(ys + (size_t)(2 * row + 1) * 1024 + col);
                    xv[i][0] += bflo(y0.x) + bflo(y1.x); xv[i][1] += bfhi(y0.x) + bfhi(y1.x);
                    xv[i][2] += bflo(y0.y) + bflo(y1.y); xv[i][3] += bfhi(y0.y) + bfhi(y1.y);
                }
                ss += xv[i][0] * xv[i][0] + xv[i][1] * xv[i][1] + xv[i][2] * xv[i][2] + xv[i][3] * xv[i][3];
            }
            ss = wave_sum(ss);
            const float rstd = rsqrtf(ss * (1.f / 1024.f) + RMS_EPS);
#pragma unroll
            for (int i = 0; i < 4; ++i) {
                const int col = 4 * lane + 256 * i;
                f32x4 hn = xv[i] * rstd * gv[i];
                if (l < DEPTH) {
                    *(f32x4*)(p.xbuf + (size_t)row * 1024 + col) = xv[i];
                    u32x2 o; o.x = pk_bf16(hn[0], hn[1]); o.y = pk_bf16(hn[2], hn[3]);
                    *(u32x2*)(hb + (size_t)row * 1024 + col) = o;
                } else {
#if DBG_TIMEPH >= 0
                    { const unsigned long long* ts = (const unsigned long long*)(p.ws + OFF_CTL + 24576);
                      const float dt_us = (float)(ts[DBG_TIMEPH2] - ts[DBG_TIMEPH]) * 0.01f; hn = hn * (1.f + 1e-3f * dt_us); }
#endif
                    *(f32x4*)(p.xbuf + (size_t)row * 1024 + col) = hn;
                }
            }
        }
    }
}

__device__ __forceinline__ void phase_inproj(CKP& p, int l, unsigned char* lds) {
    const int tid = opaque_tid(), lane = tid & 63, w = tid >> 6, wm = w >> 1, wn = w & 1, fr = lane & 15, fq = lane >> 4;
    const bf16_t* A = (const bf16_t*)(p.ws + OFF_H);
    const bf16_t* Bt = (const bf16_t*)(p.ws + OFF_W + W_IN);
    unsigned char* R = p.ws + OFF_R;
    const int* pos = (const int*)p.in[1];
    constexpr int NTM = NTOK / 128, NTN = 17;
    for (int L = blockIdx.x; L < NTM * NTN; L += gridDim.x) {
        int tm, tn; tile_coords(L, NTM, NTN, tm, tn);
        const int m0 = tm * 128, n0 = tn * 128;
        f32x4 acc[4][4]; zero_acc(acc);
        gemm_kloop(acc, [&](int r) { return A + (size_t)(m0 + r) * 1024; }, 64, [&](int v) { return Bt + (size_t)(n0 + v) * 1024; }, 64, 16, lds, tid);
#pragma unroll
        for (int mi = 0; mi < 4; ++mi) {
            const int row = m0 + 64 * wm + 16 * mi + fr;
            const int cl = 64 * wn + 16 * fq;
            float v[16];
#pragma unroll
            for (int e = 0; e < 16; ++e) v[e] = acc[mi][e >> 2][e & 3];
            if (tn < 4) {
                store16bf((bf16_t*)(R + R_Q) + (size_t)row * 512 + n0 + cl, v);
            } else if (tn < 10) {
                const int seg = tn - 4;
                if (seg == 2 || seg == 4) {
                    if (fq == 0) {
                        const float ps = (float)pos[row];
#pragma unroll
                        for (int i = 0; i < 8; ++i) {
                            float sn, cs; sincosf(ps * p.inv_freq[i], &sn, &cs);
                            const float x1 = v[i], x2 = v[8 + i];
                            v[i] = x1 * cs - x2 * sn; v[8 + i] = x2 * cs + x1 * sn;
                        }
                    }
                }
                if (seg == 3 || seg == 5) {
                    bf16_t* dst = (bf16_t*)(R + (seg == 3 ? R_VST : R_VWT));
                    const int b = row >> 12, s = row & 4095, g = wn, d0 = 16 * fq;
#pragma unroll
                    for (int e = 0; e < 16; ++e) dst[((size_t)((b * 2 + g) * 64 + d0 + e)) * SEQ + s] = f2bf(v[e]);
                } else {
                    const size_t off = (seg == 0) ? R_KC : (seg == 1) ? R_VC : (seg == 2) ? R_KS : R_KW;
                    store16bf((bf16_t*)(R + off) + (size_t)row * 128 + cl, v);
                }
            } else if (tn == 10) {
                if (cl < 24) {
                    float* ng = (float*)(R + R_NG) + (size_t)row * 24 + cl;
#pragma unroll
                    for (int e = 0; e < 16; ++e) if (cl + e < 24) ng[e] = sigm(v[e]);
                }
            } else if (tn < 15) {
#pragma unroll
                for (int e = 0; e < 16; ++e) v[e] = gelu_tanh(v[e]);
                const int c512 = (tn - 11) * 128 + cl;
                if (c512 < 256) store16bf((bf16_t*)(R + R_U) + (size_t)row * 256 + c512, v);
                else store16bf((bf16_t*)(R + R_V) + (size_t)row * 256 + (c512 - 256), v);
            } else {
                store16bf((bf16_t*)(R + R_S5IN) + (size_t)row * 256 + (tn - 15) * 128 + cl, v);
            }
        }
    }
}

__device__ __forceinline__ void compress_tile(CKP& p, int job, unsigned char* lds) {
    job_fence();
    const int tid = opaque_tid(), lane = tid & 63, w = tid >> 6, wm = w >> 1, wn = w & 1, fr = lane & 15, fq = lane >> 4;
    const int kv = job >> 5, tm = job & 31, m0 = tm * 128;
    unsigned char* W = p.ws + OFF_W;
    const bf16_t* src = (const bf16_t*)(p.ws + OFF_R + (kv ? R_VC : R_KC));
    const bf16_t* W1 = (const bf16_t*)(W + W_C1) + (size_t)kv * 128 * 2048;
    const bf16_t* W2 = (const bf16_t*)(W + W_C2) + (size_t)kv * 64 * 128;
    const float* pb = (const float*)(W + W_PB) + kv * 128;
    f32x4 acc[4][4]; zero_acc(acc);
    gemm_kloop(acc, [&](int r) { int Rr = m0 + r; Rr = Rr < 4080 ? Rr : 4079; const int b = Rr / 510, rem = Rr % 510, c = rem >> 1, g = rem & 1;
                                 return src + ((size_t)(b * SEQ + 16 * c)) * 128 + g * 64; }, 128,
               [&](int v) { return W1 + (size_t)v * 2048; }, 64, 32, lds, tid);
#pragma unroll
    for (int mi = 0; mi < 4; ++mi) {
        const int row = 64 * wm + 16 * mi + fr; const int cb = 16 * fq;
        float v[16];
#pragma unroll
        for (int e = 0; e < 16; ++e) v[e] = gelu_tanh(acc[mi][e >> 2][e & 3] + pb[64 * wn + cb + e]);
        u32x4 a, b;
        a.x = pk_bf16(v[0], v[1]); a.y = pk_bf16(v[2], v[3]); a.z = pk_bf16(v[4], v[5]); a.w = pk_bf16(v[6], v[7]);
        b.x = pk_bf16(v[8], v[9]); b.y = pk_bf16(v[10], v[11]); b.z = pk_bf16(v[12], v[13]); b.w = pk_bf16(v[14], v[15]);
        *(u32x4*)(lds + wn * 16384 + row * 128 + (((2 * fq) ^ (row & 7)) << 4)) = a;
        *(u32x4*)(lds + wn * 16384 + row * 128 + (((2 * fq + 1) ^ (row & 7)) << 4)) = b;
    }
#pragma unroll
    for (int j = 0; j < 4; ++j) {
        const int pid = tid + 256 * j, row = pid >> 4, ch = pid & 15;
        const u32x4 v = *(const u32x4*)(W2 + row * 128 + ch * 8);
        *(u32x4*)(lds + 32768 + (ch >> 3) * 16384 + row * 128 + (((ch & 7) ^ (row & 7)) << 4)) = v;
    }
    __syncthreads();
    f32x4 a2[4][2];
#pragma unroll
    for (int i = 0; i < 4; ++i) { a2[i][0] = (f32x4){0.f, 0.f, 0.f, 0.f}; a2[i][1] = (f32x4){0.f, 0.f, 0.f, 0.f}; }
#pragma unroll
    for (int kt2 = 0; kt2 < 2; ++kt2)
#pragma unroll
        for (int ks = 0; ks < 2; ++ks) {
            bf16x8 af[4], bf[2];
#pragma unroll
            for (int mi = 0; mi < 4; ++mi) { const int row = 64 * wm + 16 * mi + fr; af[mi] = *(const bf16x8*)(lds + kt2 * 16384 + row * 128 + (((4 * ks + fq) ^ (row & 7)) << 4)); }
#pragma unroll
            for (int ni = 0; ni < 2; ++ni) { const int row = 32 * wn + 8 * (fr >> 2) + 4 * ni + (fr & 3); bf[ni] = *(const bf16x8*)(lds + 32768 + kt2 * 16384 + row * 128 + (((4 * ks + fq) ^ (row & 7)) << 4)); }
#pragma unroll
            for (int mi = 0; mi < 4; ++mi)
#pragma unroll
                for (int ni = 0; ni < 2; ++ni) a2[mi][ni] = mfma16(bf[ni], af[mi], a2[mi][ni]);
        }
    bf16_t* kcmp = (bf16_t*)(p.ws + OFF_C + C_KCMP);
    bf16_t* vct = (bf16_t*)(p.ws + OFF_C + C_VCT);
#pragma unroll
    for (int mi = 0; mi < 4; ++mi) {
        const int Rr = m0 + 64 * wm + 16 * mi + fr;
        if (Rr < 4080) {
            const int b = Rr / 510, rem = Rr % 510, c = rem >> 1, g = rem & 1, d0 = 32 * wn + 8 * fq;
            float v[8];
#pragma unroll
            for (int e = 0; e < 8; ++e) v[e] = a2[mi][e >> 2][e & 3];
            if (DBG_NOCSTORE) { if (v[0] == 123.456f) kcmp[0] = 1; }
            else if (kv == 0) {
                u32x4 o; o.x = pk_bf16(v[0], v[1]); o.y = pk_bf16(v[2], v[3]); o.z = pk_bf16(v[4], v[5]); o.w = pk_bf16(v[6], v[7]);
                *(u32x4*)(kcmp + ((size_t)(b * 256 + c)) * 128 + g * 64 + d0) = o;
                if (c == 254) *(u32x4*)(kcmp + ((size_t)(b * 256 + 255)) * 128 + g * 64 + d0) = (u32x4){0u, 0u, 0u, 0u};
            } else {
#pragma unroll
                for (int e = 0; e < 8; ++e) {
                    vct[((size_t)((b * 2 + g) * 64 + d0 + e)) * 256 + c] = f2bf(v[e]);
                    if (c == 254) vct[((size_t)((b * 2 + g) * 64 + d0 + e)) * 256 + 255] = 0;
                }
            }
        }
    }
    __syncthreads();
}

__device__ __forceinline__ void sgu_job(CKP& p, int l, int job, unsigned char* lds) {
    job_fence();
    const int tid = opaque_tid(), lane = tid & 63, w = tid >> 6, fr = lane & 15, fq = lane >> 4;
    const size_t tok0 = (size_t)job * 128;
    const bf16_t* V = (const bf16_t*)(p.ws + OFF_R + R_V) + tok0 * 256;
    const bf16_t* U = (const bf16_t*)(p.ws + OFF_R + R_U) + tok0 * 256;
    bf16_t* O = (bf16_t*)(p.ws + OFF_C + C_SGU) + tok0 * 256;
    const bf16_t* Wt = (const bf16_t*)(p.ws + OFF_W + W_SGU);
    const float* ng = p.in[11] + (size_t)l * 256;
    const float* bs = p.in[13] + (size_t)l * 512;
    __syncthreads();
    if (DBG_SGUCUT != 2) {
        const int s = tid >> 1, half = tid & 1;
        const bf16_t* src = V + (size_t)s * 256 + half * 128;
        float ss = 0.f;
#pragma unroll 4
        for (int j = 0; j < 16; ++j) {
            const u32x4 bb = *(const u32x4*)(src + j * 8);
            const unsigned uu[4] = {bb.x, bb.y, bb.z, bb.w};
#pragma unroll
            for (int q = 0; q < 4; ++q) { const float a = bflo(uu[q]), b2 = bfhi(uu[q]); ss += a * a + b2 * b2; }
        }
        ss += __shfl_xor(ss, 1);
        const float rstd = rsqrtf(ss * (1.f / 256.f) + RMS_EPS);
#pragma unroll 1
        for (int j = 0; j < 16; ++j) {
            const u32x4 bb = *(const u32x4*)(src + j * 8);
            const unsigned uu[4] = {bb.x, bb.y, bb.z, bb.w};
            const int cb = half * 128 + j * 8;
#pragma unroll
            for (int q = 0; q < 4; ++q) {
#pragma unroll
                for (int hh = 0; hh < 2; ++hh) {
                    const int c = cb + q * 2 + hh;
                    const float val = (hh ? bfhi(uu[q]) : bflo(uu[q])) * rstd * ng[c];
                    *(bf16_t*)(lds + c * 256 + ((((s >> 3) ^ (c & 15))) << 4) + (s & 7) * 2) = f2bf(val);
                }
            }
        }
    }
    __syncthreads();
    const int g = w;
#pragma unroll 1
    for (int th = 0; th < (DBG_SGUCUT == 1 ? 0 : 2); ++th) {
        f32x4 acc[4][4];
        zero_acc(acc);
#pragma unroll
        for (int ks = 0; ks < 4; ++ks) {
            if (32 * ks <= 64 * th + 63) {
                bf16x8 vf[4];
#pragma unroll
                for (int di = 0; di < 4; ++di) { const int c = 64 * g + 16 * di + fr; vf[di] = *(const bf16x8*)(lds + c * 256 + (((4 * ks + fq) ^ (c & 15)) << 4)); }
#pragma unroll
                for (int ti = 0; ti < 4; ++ti) {
                    const int t = 64 * th + 16 * ti + fr;
                    if (32 * ks <= 64 * th + 16 * ti + 15) {
                        const bf16x8 wf = *(const bf16x8*)(Wt + ((size_t)(g * 128 + t)) * 128 + 32 * ks + 8 * fq);
#pragma unroll
                        for (int di = 0; di < 4; ++di) acc[ti][di] = mfma16(vf[di], wf, acc[ti][di]);
                    }
                }
            }
        }
#pragma unroll
        for (int ti = 0; ti < 4; ++ti) {
            const int t = 64 * th + 16 * ti + fr; const float bb = bs[g * 128 + t];
#pragma unroll
            for (int di = 0; di < 4; ++di) {
                const int c = 64 * g + 16 * di + 4 * fq;
                const u32x2 uu = *(const u32x2*)(U + (size_t)t * 256 + c);
                u32x2 o;
                o.x = pk_bf16(bflo(uu.x) * (acc[ti][di][0] + bb), bfhi(uu.x) * (acc[ti][di][1] + bb));
                o.y = pk_bf16(bflo(uu.y) * (acc[ti][di][2] + bb), bfhi(uu.y) * (acc[ti][di][3] + bb));
                *(u32x2*)(O + (size_t)t * 256 + c) = o;
            }
        }
    }
    __syncthreads();
}

__device__ __forceinline__ void s5_job(CKP& p, int l, int jb, int pass, unsigned char* lds) {
    job_fence();
    const int tid = opaque_tid(), lane = tid & 63, w = tid >> 6, fr = lane & 15, fq = lane >> 4;
    const int id = ((jb * 4 + w) + DBG_IDROT) & 2047, seq = id >> 4, ch = id & 15, b = seq >> 4, g = seq & 15;
    unsigned char* W = p.ws + OFF_W;
    const float* ab = (const float*)(W + W_S5A) + (g * 64 + lane) * 2;
    float ar = ab[0], ai = ab[1];
    float br[16], bi[16];
    {
        const float* bb = (const float*)(W + W_S5B) + (size_t)(g * 64 + lane) * 32;
#pragma unroll
        for (int h = 0; h < 16; ++h) { br[h] = bb[h]; bi[h] = bb[16 + h]; }
    }
#if DBG_S5CONST >= 2
    { const float q = (float)(lane + 1) * 0.001f; ar = 0.99f - q; ai = 0.05f + q;
      for (int h = 0; h < 16; ++h) { br[h] = 0.01f * (float)(h + 1) + q; bi[h] = -0.02f * (float)(h + 1) + q; } }
#endif
    float* Eb = (float*)(p.ws + OFF_C + C_S5E);
    float hre = 0.f, him = 0.f;
    bf16x8 cf[4]; float dv[4];
    if (pass == 2) {
        const float* a2 = (const float*)(W + W_S5A256) + (g * 64 + lane) * 2;
        const float a2r = a2[0], a2i = a2[1];
        for (int c2 = 0; c2 < ch; ++c2) {
            const float* e = Eb + ((size_t)(seq * 16 + c2) * 64 + lane) * 2;
            const float nr = a2r * hre - a2i * him + e[0], ni = a2r * him + a2i * hre + e[1];
            hre = nr; him = ni;
        }
        const bf16_t* cm = (const bf16_t*)(W + W_S5C) + (size_t)(g * 16 + fr) * 128;
#pragma unroll
        for (int ks = 0; ks < 4; ++ks) cf[ks] = *(const bf16x8*)(cm + 32 * ks + 8 * fq);
#pragma unroll
        for (int r = 0; r < 4; ++r) dv[r] = p.in[22][(size_t)l * 256 + g * 16 + 4 * fq + r];
    }
    const bf16_t* xin = (const bf16_t*)(p.ws + OFF_R + R_S5IN) + ((size_t)(b * SEQ + ch * 256)) * 256 + g * 16;
    bf16_t* yg = (bf16_t*)(p.ws + OFF_C + C_YG) + ((size_t)(b * SEQ + ch * 256)) * 256 + g * 16;
    float* xs = (float*)(lds + w * 10240);
    int ldsbad = 0; (void)ldsbad;
    unsigned char* Hs = lds + w * 10240 + 2048;
#if DBG_TWICE
    float keep_re = 0.f, keep_im = 0.f;
#pragma unroll 1
    for (int rep = 0; rep < 2; ++rep) {
    if (rep == 1) { keep_re = hre; keep_im = him; hre = 0.f; him = 0.f; }
#endif
#pragma unroll 1
    for (int sub = 0; sub < 8; ++sub) {
#if DBG_S5CONST >= 1
        u32x4 xv; { const unsigned q = (unsigned)(sub * 32 + (lane >> 1)) * 2654435761u + (unsigned)id * 40503u + (lane & 1); xv.x = 0x3f803e80u ^ ((q & 0xff) << 16); xv.y = 0x3e003d00u ^ ((q >> 8) & 0x7f); xv.z = 0xbe803f00u ^ ((q >> 16) & 0x3f); xv.w = 0x3d80be00u; }
#else
        const u32x4 xv = *(const u32x4*)(xin + (size_t)(sub * 32 + (lane >> 1)) * 256 + (lane & 1) * 8);
#endif
        __syncthreads();
        f32x4 chk_a = {bflo(xv.x), bfhi(xv.x), bflo(xv.y), bfhi(xv.y)}, chk_c = {bflo(xv.z), bfhi(xv.z), bflo(xv.w), bfhi(xv.w)};
        {
            *(f32x4*)(xs + (lane >> 1) * 16 + (lane & 1) * 8) = chk_a;
            *(f32x4*)(xs + (lane >> 1) * 16 + (lane & 1) * 8 + 4) = chk_c;
        }
        __syncthreads();
#pragma unroll 4
        for (int st = 0; st < 32; ++st) {
#if DBG_S5CONST == 3
            f32x4 x0, x1, x2, x3;
            { const float t = (float)((sub * 32 + st) & 63) * 0.015625f + (float)(id & 7) * 0.125f;
              x0 = (f32x4){t, t * 0.5f, -t, 0.25f}; x1 = (f32x4){0.5f - t, t * t, 0.125f, t}; x2 = (f32x4){-0.25f, t, 0.75f * t, 1.f - t}; x3 = (f32x4){t, -t, 0.5f, 0.3f * t}; }
#else
            const f32x4 x0 = *(const f32x4*)(xs + st * 16), x1 = *(const f32x4*)(xs + st * 16 + 4), x2 = *(const f32x4*)(xs + st * 16 + 8), x3 = *(const f32x4*)(xs + st * 16 + 12);
#endif
            float ur = 0.f, ui = 0.f;
#pragma unroll
            for (int h = 0; h < 4; ++h) {
                ur += br[h] * x0[h]; ui += bi[h] * x0[h];
                ur += br[4 + h] * x1[h]; ui += bi[4 + h] * x1[h];
                ur += br[8 + h] * x2[h]; ui += bi[8 + h] * x2[h];
                ur += br[12 + h] * x3[h]; ui += bi[12 + h] * x3[h];
            }
            const float nr = ar * hre - ai * him + ur, ni = ar * him + ai * hre + ui;
            hre = nr; him = ni;
            if (pass == 2) {
                *(bf16_t*)(Hs + st * 256 + (((lane >> 3) ^ (st & 15)) << 4) + (lane & 7) * 2) = f2bf(hre);
                *(bf16_t*)(Hs + st * 256 + ((((64 + lane) >> 3) ^ (st & 15)) << 4) + (lane & 7) * 2) = f2bf(him);
            }
        }
#if DBG_LDSCHK
        {
            const f32x4 ra = *(volatile f32x4*)(xs + (lane >> 1) * 16 + (lane & 1) * 8), rc = *(volatile f32x4*)(xs + (lane >> 1) * 16 + (lane & 1) * 8 + 4);
            bool bad = false;
            for (int q = 0; q < 4; ++q) bad |= (__float_as_uint(ra[q]) != __float_as_uint(chk_a[q])) | (__float_as_uint(rc[q]) != __float_as_uint(chk_c[q]));
            if (__any(bad)) ldsbad = 1;
        }
#endif
        if (pass == 2) {
            __syncthreads();
#pragma unroll
            for (int tt = 0; tt < 2; ++tt) {
                f32x4 acc = {0.f, 0.f, 0.f, 0.f};
                const int tl = tt * 16 + fr;
#pragma unroll
                for (int ks = 0; ks < 4; ++ks) {
                    const bf16x8 hf = *(const bf16x8*)(Hs + tl * 256 + (((4 * ks + fq) ^ (tl & 15)) << 4));
                    acc = mfma16(cf[ks], hf, acc);
                }
                float y[4];
#pragma unroll
                for (int r = 0; r < 4; ++r) y[r] = gelu_tanh(acc[r] + dv[r] * xs[tl * 16 + 4 * fq + r]);
                u32x2 o; o.x = pk_bf16(y[0], y[1]); o.y = pk_bf16(y[2], y[3]);
                *(u32x2*)(yg + (size_t)(sub * 32 + tl) * 256 + 4 * fq) = o;
            }
        }
    }
#if DBG_TWICE
    }
    if (__float_as_uint(keep_re) != __float_as_uint(hre) || __float_as_uint(keep_im) != __float_as_uint(him)) { hre = __uint_as_float(0x7fc00000u); him = hre; }
#endif
    if (pass == 1) {
        float* e = Eb + ((size_t)(seq * 16 + ch) * 64 + lane) * 2;
#if DBG_LDSCHK
        if (ldsbad) { hre = __uint_as_float(0x7fc00000u); him = hre; }
#endif
#if DBG_ESC1
        { const unsigned long long pk = ((unsigned long long)__float_as_uint(him) << 32) | __float_as_uint(hre);
          __hip_atomic_store((unsigned long long*)e, pk, __ATOMIC_RELAXED, __HIP_MEMORY_SCOPE_AGENT); }
#else
        e[0] = hre; e[1] = him;
#endif
#if DBG_E2
        float* e2 = (float*)(p.ws + OFF_C + C_ATT) + ((size_t)(seq * 16 + ch) * 64 + lane) * 2;
        e2[0] = hre; e2[1] = him;
#endif
    }
    __syncthreads();
}

__device__ __forceinline__ void phase_mid1(CKP& p, int l, unsigned char* lds) {
#if DBG_QDELAY == 2
    if (blockIdx.x >= 320) return;
#elif DBG_QDELAY == 3
    if (blockIdx.x >= 320) {
        const unsigned long long t0 = __builtin_amdgcn_s_memrealtime(); while (__builtin_amdgcn_s_memrealtime() - t0 < 3000ull) __builtin_amdgcn_s_sleep(8);
        s5_job(p, l, blockIdx.x - 320, 1, lds);
        return;
    }
#elif DBG_QDELAY
    if (blockIdx.x >= 320) {
        s5_job(p, l, blockIdx.x - 320, 1, lds);
        const unsigned long long t0 = __builtin_amdgcn_s_memrealtime(); while (__builtin_amdgcn_s_memrealtime() - t0 < 6000ull) __builtin_amdgcn_s_sleep(8);
        return;
    }
#endif
    for (int j = blockIdx.x; j < 64 + 256 + 512; j += gridDim.x) {
#if DBG_ONLYS5 == 1
        if (j >= 320) s5_job(p, l, j - 320, 1, lds);
#elif DBG_ONLYS5 == 2
        if (j < 64) compress_tile(p, j, lds);
        else if (j >= 320) s5_job(p, l, j - 320, 1, lds);
#elif DBG_ONLYS5 == 4
        { const int jj = 831 - j; if (jj < 64) compress_tile(p, jj, lds); else if (jj >= 320) s5_job(p, l, jj - 320, 1, lds); }
#elif DBG_ONLYS5 == 5
        if (j < 64) compress_tile(p, j, lds);
        else if (j >= 320 && j < 512) s5_job(p, l, j - 320, 1, lds);
        else if (j >= 576) s5_job(p, l, j - 320, 1, lds);
        if (j >= 448 && j < 512) s5_job(p, l, j + 64 - 320, 1, lds);
#elif DBG_ONLYS5 == 3
        if (j >= 64 && j < 320) sgu_job(p, l, j - 64, lds);
        else if (j >= 320) s5_job(p, l, j - 320, 1, lds);
#elif DBG_ONLYS5 == 6
        if (j < 512) {
#if DBG_PRESPIN
            { const unsigned long long t0 = __builtin_amdgcn_s_memrealtime(); while (__builtin_amdgcn_s_memrealtime() - t0 < (unsigned long long)DBG_PRESPIN) __builtin_amdgcn_s_sleep(2); }
#endif
            s5_job(p, l, j, 1, lds);
        }
        else if (j < 768) sgu_job(p, l, j - 512, lds);
        else compress_tile(p, j - 768, lds);
#else
        if (j < 64) compress_tile(p, j, lds);
        else if (j < 320) {
#if DBG_SGUSPIN
            { const unsigned long long t0 = __builtin_amdgcn_s_memrealtime(); while (__builtin_amdgcn_s_memrealtime() - t0 < (unsigned long long)DBG_SGUSPIN) __builtin_amdgcn_s_sleep(2); }
#else
            sgu_job(p, l, j - 64, lds);
#endif
        } else {
#if DBG_DELAY
            if (j >= 576) { const unsigned long long t0 = __builtin_amdgcn_s_memrealtime(); while (__builtin_amdgcn_s_memrealtime() - t0 < (unsigned long long)DBG_DELAY) __builtin_amdgcn_s_sleep(8); }
#endif
            s5_job(p, l, j - 320, 1, lds);
        }
#endif
    }
}

constexpr int AL_Q = 0, AL_K = 32768, AL_V = 40960, AL_IMP = 49152, AL_SEL = 65792, AL_UNI = 66304, AL_JOB = 66336;
constexpr float SM_C = 0.125f * 1.4426950408889634f;

__device__ __forceinline__ void attn_load_q(const bf16_t* Qg, const int* pos, const float (&inv_freq)[8], int b, int g, int t0, bool rope, unsigned char* lds, int tid) {
#pragma unroll 1
    for (int j = 0; j < 8; ++j) {
        const int pid = tid + 256 * j, Rr = pid >> 3, ch = pid & 7;
        const int wq = Rr >> 6, r = (Rr >> 4) & 3, q = Rr & 15, t = t0 + 16 * wq + q;
        const bf16_t* src = Qg + ((size_t)(b * SEQ + t)) * 512 + (g * 4 + r) * 64;
        if (!rope || ch >= 2) {
            *(u32x4*)(lds + AL_Q + Rr * 128 + ((ch ^ (Rr & 7)) << 4)) = *(const u32x4*)(src + ch * 8);
        } else if (ch == 0) {
            const u32x4 a = *(const u32x4*)(src), c = *(const u32x4*)(src + 8);
            float x1[8] = {bflo(a.x), bfhi(a.x), bflo(a.y), bfhi(a.y), bflo(a.z), bfhi(a.z), bflo(a.w), bfhi(a.w)};
            float x2[8] = {bflo(c.x), bfhi(c.x), bflo(c.y), bfhi(c.y), bflo(c.z), bfhi(c.z), bflo(c.w), bfhi(c.w)};
            const float ps = (float)pos[b * SEQ + t];
#pragma unroll
            for (int i = 0; i < 8; ++i) {
                float sn, cs; sincosf(ps * inv_freq[i], &sn, &cs);
                const float u = x1[i], v = x2[i];
                x1[i] = u * cs - v * sn; x2[i] = v * cs + u * sn;
            }
            u32x4 o1, o2;
            o1.x = pk_bf16(x1[0], x1[1]); o1.y = pk_bf16(x1[2], x1[3]); o1.z = pk_bf16(x1[4], x1[5]); o1.w = pk_bf16(x1[6], x1[7]);
            o2.x = pk_bf16(x2[0], x2[1]); o2.y = pk_bf16(x2[2], x2[3]); o2.z = pk_bf16(x2[4], x2[5]); o2.w = pk_bf16(x2[6], x2[7]);
            *(u32x4*)(lds + AL_Q + Rr * 128 + ((0 ^ (Rr & 7)) << 4)) = o1;
            *(u32x4*)(lds + AL_Q + Rr * 128 + ((1 ^ (Rr & 7)) << 4)) = o2;
        }
    }
}
__device__ __forceinline__ void attn_load_kv(const bf16_t* Kb, const bf16_t* Vb, int vstride, unsigned char* lds, int tid) {
#pragma unroll
    for (int j = 0; j < 2; ++j) {
        const int pid = tid + 256 * j, row = pid >> 3, ch = pid & 7;
        const u32x4 kk = *(const u32x4*)(Kb + (size_t)row * 128 + ch * 8);
        const u32x4 vv = *(const u32x4*)(Vb + (size_t)row * vstride + ch * 8);
        *(u32x4*)(lds + AL_K + row * 128 + ((ch ^ (row & 7)) << 4)) = kk;
        *(u32x4*)(lds + AL_V + row * 128 + ((ch ^ ((row >> 1) & 7)) << 4)) = vv;
    }
}
__device__ __forceinline__ void attn_qk(f32x4 (&s)[2][4], const unsigned char* lds, int w, int fr, int fq, int hf) {
    const unsigned char* Qw = lds + AL_Q + w * 8192;
    const unsigned char* Kh = lds + AL_K + hf * 4096;
    const int sw0 = ((fq) ^ (fr & 7)) << 4, sw1 = ((4 + fq) ^ (fr & 7)) << 4;
#pragma unroll
    for (int ki = 0; ki < 2; ++ki)
#pragma unroll
        for (int qi = 0; qi < 4; ++qi) s[ki][qi] = (f32x4){0.f, 0.f, 0.f, 0.f};
#pragma unroll
    for (int ds = 0; ds < 2; ++ds) {
        bf16x8 qf[4];
#pragma unroll
        for (int qi = 0; qi < 4; ++qi) qf[qi] = *(const bf16x8*)(Qw + (qi * 16 + fr) * 128 + (ds ? sw1 : sw0));
#pragma unroll
        for (int ki = 0; ki < 2; ++ki) {
            const bf16x8 kf = *(const bf16x8*)(Kh + (ki * 16 + fr) * 128 + (ds ? sw1 : sw0));
#pragma unroll
            for (int qi = 0; qi < 4; ++qi) s[ki][qi] = mfma16(kf, qf[qi], s[ki][qi]);
        }
    }
}
__device__ __forceinline__ void attn_pv(f32x4 (&o)[4][4], const f32x4 (&s)[2][4], const unsigned char* lds, int fr, int fq, int hf) {
    bf16x8 pf[4];
#pragma unroll
    for (int qi = 0; qi < 4; ++qi) {
        u32x4 u;
        u.x = pk_bf16(s[0][qi][0], s[0][qi][1]); u.y = pk_bf16(s[0][qi][2], s[0][qi][3]);
        u.z = pk_bf16(s[1][qi][0], s[1][qi][1]); u.w = pk_bf16(s[1][qi][2], s[1][qi][3]);
        pf[qi] = as_bf8(u);
    }
    const int c0 = 4 * hf + (fq >> 1);
#pragma unroll
    for (int di = 0; di < 4; ++di) {
        const int row = di * 16 + fr, key = (row >> 1) & 7;
        const u32x2 lo = *(const u32x2*)(lds + AL_V + row * 128 + ((c0 ^ key) << 4) + 8 * (fq & 1));
        const u32x2 hi = *(const u32x2*)(lds + AL_V + row * 128 + (((c0 + 2) ^ key) << 4) + 8 * (fq & 1));
        const bf16x8 vf = as_bf8((u32x4){lo.x, lo.y, hi.x, hi.y});
#pragma unroll
        for (int qi = 0; qi < 4; ++qi) o[di][qi] = mfma16(vf, pf[qi], o[di][qi]);
    }
}
__device__ __forceinline__ unsigned attn_vmask(int kb, int fq, int lo, int hi) {
    unsigned vm = 0;
#pragma unroll
    for (int ki = 0; ki < 2; ++ki)
#pragma unroll
        for (int r = 0; r < 4; ++r) { const int key = kb + 16 * ki + 4 * fq + r; if (key >= lo && key <= hi) vm |= 1u << (ki * 4 + r); }
    return vm;
}
__device__ __forceinline__ void attn_softmax(f32x4 (&s)[2][4], f32x4 (&o)[4][4], float (&m)[4], float (&lsum)[4], unsigned vm) {
#pragma unroll
    for (int qi = 0; qi < 4; ++qi) {
        float mx = -1e30f;
#pragma unroll
        for (int ki = 0; ki < 2; ++ki)
#pragma unroll
            for (int r = 0; r < 4; ++r) { const float sv = ((vm >> (ki * 4 + r)) & 1u) ? s[ki][qi][r] * SM_C : -1e30f; s[ki][qi][r] = sv; mx = fmaxf(mx, sv); }
        mx = fmaxf(mx, __shfl_xor(mx, 16)); mx = fmaxf(mx, __shfl_xor(mx, 32));
        const float mn = fmaxf(m[qi], mx), alpha = fexp2(m[qi] - mn);
        m[qi] = mn;
        float ls = 0.f;
#pragma unroll
        for (int ki = 0; ki < 2; ++ki)
#pragma unroll
            for (int r = 0; r < 4; ++r) { const float pv = ((vm >> (ki * 4 + r)) & 1u) ? fexp2(s[ki][qi][r] - mn) : 0.f; s[ki][qi][r] = pv; ls += pv; }
        lsum[qi] = lsum[qi] * alpha + ls;
#pragma unroll
        for (int di = 0; di < 4; ++di) o[di][qi] *= alpha;
    }
}
__device__ __forceinline__ void attn_accum(bf16_t* dst, const f32x4 (&o)[4][4], const float (&lsum)[4], const float (&gate)[4], bool first, int fq) {
#pragma unroll
    for (int qi = 0; qi < 4; ++qi) {
        float lt = lsum[qi]; lt += __shfl_xor(lt, 16); lt += __shfl_xor(lt, 32);
        const float sc = gate[qi] / fmaxf(lt, 1e-30f);
#pragma unroll
        for (int di = 0; di < 4; ++di) {
            u32x2* ptr = (u32x2*)(dst + qi * 64 + 16 * di + 4 * fq);
            float a0 = o[di][qi][0] * sc, a1 = o[di][qi][1] * sc, a2 = o[di][qi][2] * sc, a3 = o[di][qi][3] * sc;
            if (!first) { const u32x2 f = *ptr; a0 += bflo(f.x); a1 += bfhi(f.x); a2 += bflo(f.y); a3 += bfhi(f.y); }
            u32x2 r; r.x = pk_bf16(a0, a1); r.y = pk_bf16(a2, a3);
            *ptr = r;
        }
    }
}

__device__ __forceinline__ void phase_attn(CKP& p, int l, unsigned char* lds, unsigned* ctl) {
    for (int j = blockIdx.x; j < 512; j += gridDim.x) s5_job(p, l, j, 2, lds);

    unsigned char* R = p.ws + OFF_R; unsigned char* C = p.ws + OFF_C;
    const bf16_t* Qg = (const bf16_t*)(R + R_Q);
    const bf16_t* Kc = (const bf16_t*)(C + C_KCMP); const bf16_t* Vc = (const bf16_t*)(C + C_VCT);
    const bf16_t* Ks = (const bf16_t*)(R + R_KS); const bf16_t* Vs = (const bf16_t*)(R + R_VST);
    const bf16_t* Kw = (const bf16_t*)(R + R_KW); const bf16_t* Vw = (const bf16_t*)(R + R_VWT);
    const float* NG = (const float*)(R + R_NG);
    bf16_t* AO = (bf16_t*)(C + C_ATT);
    const int* pos = (const int*)p.in[1];
    unsigned* ctr = ctl + CTL_ATTN + l;
    volatile int* jobp = (volatile int*)(lds + AL_JOB);
    float* imp = (float*)(lds + AL_IMP);
    unsigned long long* selm = (unsigned long long*)(lds + AL_SEL);
    unsigned long long* uni = (unsigned long long*)(lds + AL_UNI);
    float invf[8];
#pragma unroll
    for (int q = 0; q < 8; ++q) invf[q] = p.inv_freq[q];

    for (;;) {
        const int tid = opaque_tid(), lane = tid & 63, w = tid >> 6, fr = lane & 15, fq = lane >> 4;
        __syncthreads();
        if (tid == 0) *jobp = (int)atomicAdd(ctr, 1u);
        __syncthreads();
        const int job = *jobp;
        if (job >= 1024) break;
        const int i = 63 - (job >> 4), bg = job & 15, b = bg >> 1, g = bg & 1, t0 = i * 64;
        const int tq = t0 + 16 * w + fr;
        const size_t kvrow = (size_t)b * SEQ;
        float gate[4];
        bf16_t* dstq = AO + ((size_t)(kvrow + tq)) * 512 + (g * 4) * 64;

        attn_load_q(Qg, pos, invf, b, g, t0, false, lds, tid);
        const int ntc = ((4 * i + 2) >> 6) + 1;
        const int hic = (tq >= 31) ? ((tq - 31) >> 4) : -1;
        float m[4], lsum[4];
#pragma unroll
        for (int qi = 0; qi < 4; ++qi) { m[qi] = -1e30f; lsum[qi] = 0.f; }
        {
#pragma unroll 1
            for (int ct = 0; ct < ntc; ++ct) {
                __syncthreads();
                attn_load_kv(Kc + ((size_t)(b * 256 + ct * 64)) * 128 + g * 64, Vc + ((size_t)((b * 2 + g) * 64)) * 256 + ct * 64, 256, lds, tid);
                __syncthreads();
#pragma unroll 1
                for (int hf = 0; hf < 2; ++hf) {
                    f32x4 s[2][4];
                    attn_qk(s, lds, w, fr, fq, hf);
                    const unsigned vm = attn_vmask(ct * 64 + hf * 32, fq, 0, hic);
#pragma unroll
                    for (int qi = 0; qi < 4; ++qi) {
                        float mx = -1e30f;
#pragma unroll
                        for (int ki = 0; ki < 2; ++ki)
#pragma unroll
                            for (int r = 0; r < 4; ++r) { const float sv = ((vm >> (ki * 4 + r)) & 1u) ? s[ki][qi][r] * SM_C : -1e30f; s[ki][qi][r] = sv; mx = fmaxf(mx, sv); }
                        mx = fmaxf(mx, __shfl_xor(mx, 16)); mx = fmaxf(mx, __shfl_xor(mx, 32));
                        const float mn = fmaxf(m[qi], mx), alpha = fexp2(m[qi] - mn);
                        m[qi] = mn;
                        float ls = 0.f;
#pragma unroll
                        for (int ki = 0; ki < 2; ++ki)
#pragma unroll
                            for (int r = 0; r < 4; ++r) ls += ((vm >> (ki * 4 + r)) & 1u) ? fexp2(s[ki][qi][r] - mn) : 0.f;
                        lsum[qi] = lsum[qi] * alpha + ls;
                    }
                }
            }
        }
        float invl[4];
#pragma unroll
        for (int qi = 0; qi < 4; ++qi) { float lt = lsum[qi]; lt += __shfl_xor(lt, 16); lt += __shfl_xor(lt, 32); invl[qi] = 1.f / fmaxf(lt, 1e-30f); }
        {
            f32x4 o[4][4]; zero_acc(o);
            float carry = 0.f;
#pragma unroll 1
            for (int ct = 0; ct < ntc; ++ct) {
                __syncthreads();
                attn_load_kv(Kc + ((size_t)(b * 256 + ct * 64)) * 128 + g * 64, Vc + ((size_t)((b * 2 + g) * 64)) * 256 + ct * 64, 256, lds, tid);
                __syncthreads();
#pragma unroll 1
                for (int hf = 0; hf < 2; ++hf) {
                    f32x4 s[2][4];
                    attn_qk(s, lds, w, fr, fq, hf);
                    const unsigned vm = attn_vmask(ct * 64 + hf * 32, fq, 0, hic);
#pragma unroll
                    for (int qi = 0; qi < 4; ++qi)
#pragma unroll
                        for (int ki = 0; ki < 2; ++ki)
#pragma unroll
                            for (int r = 0; r < 4; ++r) s[ki][qi][r] = ((vm >> (ki * 4 + r)) & 1u) ? fexp2(s[ki][qi][r] * SM_C - m[qi]) * invl[qi] : 0.f;
#pragma unroll
                    for (int ki = 0; ki < 2; ++ki) {
                        float a = 0.f, bq = 0.f;
#pragma unroll
                        for (int qi = 0; qi < 4; ++qi) { a += s[ki][qi][0] + s[ki][qi][1] + s[ki][qi][2] + 0.5f * s[ki][qi][3]; bq += 0.5f * s[ki][qi][3]; }
                        const float up = __shfl(bq, (lane + 48) & 63);
                        const float wrap = __shfl(carry, (lane + 48) & 63);
                        a += (fq >= 1) ? up : wrap;
                        carry = bq;
                        imp[(16 * w + fr) * 65 + 16 * ct + 8 * hf + 4 * ki + fq] = a;
                    }
                    attn_pv(o, s, lds, fr, fq, hf);
                }
            }
#pragma unroll
            for (int qi = 0; qi < 4; ++qi) gate[qi] = NG[((size_t)(kvrow + tq)) * 24 + (g * 4 + qi) * 3 + 0];
            const float quarter[4] = {0.25f, 0.25f, 0.25f, 0.25f};
            attn_accum(dstq, o, quarter, gate, true, fq);
        }
        __syncthreads();
        {
            const int q = tid >> 2, part = tid & 3;
            unsigned long long mk = 0ull;
            if (i <= 15) { mk = (i == 63) ? ~0ull : ((1ull << (i + 1)) - 1ull); }
            else {
                const float* row = imp + q * 65;
                for (int j = 1 + part; j <= i - 2; j += 4) {
                    const float vj = row[j]; int rank = 0;
                    for (int j2 = 1; j2 <= i - 2; ++j2) { const float v2 = row[j2]; rank += (v2 > vj || (v2 == vj && j2 < j)) ? 1 : 0; }
                    if (rank < 13) mk |= 1ull << j;
                }
                unsigned lo32 = (unsigned)mk, hi32 = (unsigned)(mk >> 32);
                lo32 |= __shfl_xor(lo32, 1); hi32 |= __shfl_xor(hi32, 1);
                lo32 |= __shfl_xor(lo32, 2); hi32 |= __shfl_xor(hi32, 2);
                mk = ((unsigned long long)hi32 << 32) | lo32;
                mk |= 1ull | (1ull << i) | (1ull << (i - 1));
            }
            if (part == 0) selm[q] = mk;
            unsigned lo32 = (unsigned)mk, hi32 = (unsigned)(mk >> 32);
#pragma unroll
            for (int o2 = 32; o2 >= 1; o2 >>= 1) { lo32 |= __shfl_xor(lo32, o2); hi32 |= __shfl_xor(hi32, o2); }
            if (lane == 0) uni[w] = ((unsigned long long)hi32 << 32) | lo32;
        }
        __syncthreads();
        const unsigned long long mymask = selm[16 * w + fr];
        const unsigned long long un = uni[0] | uni[1] | uni[2] | uni[3];
        __syncthreads();
        attn_load_q(Qg, pos, invf, b, g, t0, true, lds, tid);
        {
            f32x4 o[4][4]; zero_acc(o);
#pragma unroll
            for (int qi = 0; qi < 4; ++qi) { m[qi] = -1e30f; lsum[qi] = 0.f; }
#pragma unroll 1
            for (int j = 0; j <= i; ++j) {
                if (!((un >> j) & 1ull)) continue;
                __syncthreads();
                attn_load_kv(Ks + (kvrow + j * 64) * 128 + g * 64, Vs + ((size_t)((b * 2 + g) * 64)) * SEQ + j * 64, SEQ, lds, tid);
                __syncthreads();
                const int hi = ((mymask >> j) & 1ull) ? tq : -1;
#pragma unroll 1
                for (int hf = 0; hf < 2; ++hf) {
                    f32x4 s[2][4];
                    attn_qk(s, lds, w, fr, fq, hf);
                    const unsigned vm = attn_vmask(j * 64 + hf * 32, fq, 0, hi);
                    attn_softmax(s, o, m, lsum, vm);
                    attn_pv(o, s, lds, fr, fq, hf);
                }
            }
#pragma unroll
            for (int qi = 0; qi < 4; ++qi) gate[qi] = NG[((size_t)(kvrow + tq)) * 24 + (g * 4 + qi) * 3 + 1];
            attn_accum(dstq, o, lsum, gate, false, fq);
        }
        {
            f32x4 o[4][4]; zero_acc(o);
#pragma unroll
            for (int qi = 0; qi < 4; ++qi) { m[qi] = -1e30f; lsum[qi] = 0.f; }
            const int j0 = (i >= 8) ? (i - 8) : 0;
#pragma unroll 1
            for (int j = j0; j <= i; ++j) {
                __syncthreads();
                attn_load_kv(Kw + (kvrow + j * 64) * 128 + g * 64, Vw + ((size_t)((b * 2 + g) * 64)) * SEQ + j * 64, SEQ, lds, tid);
                __syncthreads();
#pragma unroll 1
                for (int hf = 0; hf < 2; ++hf) {
                    f32x4 s[2][4];
                    attn_qk(s, lds, w, fr, fq, hf);
                    const unsigned vm = attn_vmask(j * 64 + hf * 32, fq, tq - 511, tq);
                    attn_softmax(s, o, m, lsum, vm);
                    attn_pv(o, s, lds, fr, fq, hf);
                }
            }
#pragma unroll
            for (int qi = 0; qi < 4; ++qi) gate[qi] = NG[((size_t)(kvrow + tq)) * 24 + (g * 4 + qi) * 3 + 2];
            attn_accum(dstq, o, lsum, gate, false, fq);
        }
    }
}

__device__ __forceinline__ void phase_glu(CKP& p, int l, unsigned char* lds) {
    const int tid = opaque_tid(), lane = tid & 63, w = tid >> 6, wm = w >> 1, wn = w & 1, fr = lane & 15, fq = lane >> 4;
    const bf16_t* A = (const bf16_t*)(p.ws + OFF_C + C_YG);
    const bf16_t* Bt = (const bf16_t*)(p.ws + OFF_W + W_GLU);
    bf16_t* O = (bf16_t*)(p.ws + OFF_C + C_S5O);
    const float* gb = p.in[24] + (size_t)l * 256;
    constexpr int NTM = NTOK / 128, NTN = 2;
    for (int L = blockIdx.x; L < NTM * NTN; L += gridDim.x) {
        int tm, tn; tile_coords(L, NTM, NTN, tm, tn);
        const int m0 = tm * 128, n0 = tn * 128;
        f32x4 acc[4][4]; zero_acc(acc);
        gemm_kloop(acc, [&](int r) { return A + (size_t)(m0 + r) * 256; }, 64, [&](int v) { return Bt + (size_t)(n0 + v) * 256; }, 64, 4, lds, tid);
#pragma unroll
        for (int mi = 0; mi < 4; ++mi) {
            const int row = m0 + 64 * wm + 16 * mi + fr, col = n0 + 64 * wn + 16 * fq;
            const u32x4 y0 = *(const u32x4*)(A + (size_t)row * 256 + col), y1 = *(const u32x4*)(A + (size_t)row * 256 + col + 8);
            const unsigned yy[8] = {y0.x, y0.y, y0.z, y0.w, y1.x, y1.y, y1.z, y1.w};
            float v[16];
#pragma unroll
            for (int e = 0; e < 16; ++e) {
                const float y = (e & 1) ? bfhi(yy[e >> 1]) : bflo(yy[e >> 1]);
                v[e] = y * sigm(acc[mi][e >> 2][e & 3] + gb[col + e]);
            }
            store16bf(O + (size_t)row * 256 + col, v);
        }
    }
}

__device__ __forceinline__ void phase_branch(CKP& p, int l, unsigned char* lds) {
    const int tid = opaque_tid(), lane = tid & 63, w = tid >> 6, wm = w >> 1, wn = w & 1, fr = lane & 15, fq = lane >> 4;
    const bf16_t* H = (const bf16_t*)(p.ws + OFF_H);
    const bf16_t* Wgb = (const bf16_t*)(p.ws + OFF_W + W_GB);
    bf16_t* Mg = (bf16_t*)(p.ws + OFF_M);
    bf16_t* Yt = (bf16_t*)(p.ws + OFF_R);
    constexpr int NTM = NTOK / 128, NTN = 8;
    for (int L = blockIdx.x; L < NTM * NTN; L += gridDim.x) {
        int tm, tn; tile_coords(L, NTM, NTN, tm, tn);
        const int m0 = tm * 128, n0 = tn * 128;
#pragma unroll 1
        for (int br = 0; br < 3; ++br) {
            const bf16_t* Ab; const bf16_t* Wb; int Kb;
            if (br == 0) { Ab = (const bf16_t*)(p.ws + OFF_C + C_ATT); Wb = (const bf16_t*)(p.ws + OFF_W + W_A); Kb = 512; }
            else if (br == 1) { Ab = (const bf16_t*)(p.ws + OFF_C + C_SGU); Wb = (const bf16_t*)(p.ws + OFF_W + W_S); Kb = 256; }
            else { Ab = (const bf16_t*)(p.ws + OFF_C + C_S5O); Wb = (const bf16_t*)(p.ws + OFF_W + W_5); Kb = 256; }
            {
                f32x4 acc[4][4]; zero_acc(acc);
                gemm_kloop(acc, [&](int r) { return Ab + (size_t)(m0 + r) * Kb; }, 64, [&](int v) { return Wb + (size_t)(n0 + v) * Kb; }, 64, Kb >> 6, lds, tid);
#pragma unroll
                for (int mi = 0; mi < 4; ++mi) {
                    const int row = m0 + 64 * wm + 16 * mi + fr, col = n0 + 64 * wn + 16 * fq;
                    float v[16];
#pragma unroll
                    for (int e = 0; e < 16; ++e) v[e] = acc[mi][e >> 2][e & 3];
                    store16bf(Yt + (size_t)row * 1024 + col, v);
                }
            }
            {
                f32x4 acc[4][4]; zero_acc(acc);
                gemm_kloop(acc, [&](int r) { return H + (size_t)(m0 + r) * 1024; }, 64, [&](int v) { return Wgb + (size_t)(br * 1024 + n0 + v) * 1024; }, 64, 16, lds, tid);
#pragma unroll
                for (int mi = 0; mi < 4; ++mi) {
                    const int row = m0 + 64 * wm + 16 * mi + fr, col = n0 + 64 * wn + 16 * fq;
                    u32x4* dst = (u32x4*)(Mg + (size_t)row * 1024 + col);
                    const u32x4* ysrc = (const u32x4*)(Yt + (size_t)row * 1024 + col);
                    const u32x4 y0 = ysrc[0], y1 = ysrc[1];
                    const unsigned yy[8] = {y0.x, y0.y, y0.z, y0.w, y1.x, y1.y, y1.z, y1.w};
                    unsigned pp[8] = {0u, 0u, 0u, 0u, 0u, 0u, 0u, 0u};
                    if (br > 0) { const u32x4 p0 = dst[0], p1 = dst[1]; pp[0] = p0.x; pp[1] = p0.y; pp[2] = p0.z; pp[3] = p0.w; pp[4] = p1.x; pp[5] = p1.y; pp[6] = p1.z; pp[7] = p1.w; }
                    unsigned outw[8];
#pragma unroll
                    for (int ni = 0; ni < 4; ++ni) {
                        const float a0 = sigm(acc[mi][ni][0]) * bflo(yy[2 * ni]) + bflo(pp[2 * ni]), a1 = sigm(acc[mi][ni][1]) * bfhi(yy[2 * ni]) + bfhi(pp[2 * ni]);
                        const float a2 = sigm(acc[mi][ni][2]) * bflo(yy[2 * ni + 1]) + bflo(pp[2 * ni + 1]), a3 = sigm(acc[mi][ni][3]) * bfhi(yy[2 * ni + 1]) + bfhi(pp[2 * ni + 1]);
                        outw[2 * ni] = pk_bf16(a0, a1); outw[2 * ni + 1] = pk_bf16(a2, a3);
                    }
                    dst[0] = (u32x4){outw[0], outw[1], outw[2], outw[3]};
                    dst[1] = (u32x4){outw[4], outw[5], outw[6], outw[7]};
                }
            }
        }
    }
}

__device__ __forceinline__ void phase_mix(CKP& p, int l, unsigned char* lds) {
    const int tid = opaque_tid(), lane = tid & 63, w = tid >> 6, wm = w >> 1, wn = w & 1, fr = lane & 15, fq = lane >> 4;
    const bf16_t* A = (const bf16_t*)(p.ws + OFF_M);
    const bf16_t* Bt = (const bf16_t*)(p.ws + OFF_W + W_M);
    constexpr int NTM = NTOK / 128, NTN = 8;
    for (int L = blockIdx.x; L < NTM * NTN; L += gridDim.x) {
        int tm, tn; tile_coords(L, NTM, NTN, tm, tn);
        const int m0 = tm * 128, n0 = tn * 128;
        f32x4 acc[4][4]; zero_acc(acc);
        gemm_kloop(acc, [&](int r) { return A + (size_t)(m0 + r) * 1024; }, 64, [&](int v) { return Bt + (size_t)(n0 + v) * 1024; }, 64, 16, lds, tid);
#pragma unroll
        for (int mi = 0; mi < 4; ++mi) {
            const int row = m0 + 64 * wm + 16 * mi + fr, col = n0 + 64 * wn + 16 * fq;
            float* xp = p.xbuf + (size_t)row * 1024 + col;
#pragma unroll
            for (int ni = 0; ni < 4; ++ni) { f32x4 xv = *(f32x4*)(xp + 4 * ni); xv += acc[mi][ni]; *(f32x4*)(xp + 4 * ni) = xv; }
        }
    }
}

__device__ __forceinline__ void phase_router(CKP& p, int l, unsigned char* lds, unsigned* ctl) {
    const int tid = opaque_tid(), lane = tid & 63, w = tid >> 6;
    const float* gam = p.in[27] + (size_t)l * 1024;
    const float* wg = p.in[28] + (size_t)l * 1024 * 4; const float* bg = p.in[29] + (size_t)l * 4;
    const float* we = p.in[30] + (size_t)l * 1024 * 32; const float* be = p.in[31] + (size_t)l * 32;
    bf16_t* h2 = (bf16_t*)(p.ws + OFF_M);
    unsigned* cnt = ctl + CTL_MOECNT + l * 32;
    int* list = (int*)(p.ws + OFF_MOE + MOE_LIST);
    float* wsl = (float*)(p.ws + OFF_MOE + MOE_WS);
    float* xT = (float*)lds; float* Wc = (float*)(lds + 32768); float* lg = (float*)(lds + 57344);
    float* rs = (float*)(lds + 66560); int* lc = (int*)(lds + 66816); int* gbs = (int*)(lds + 66944);
    for (int tile = blockIdx.x; tile < NTOK / 64; tile += gridDim.x) {
        const int r0 = tile * 64;
        __syncthreads();
        if (tid < 32) lc[tid] = 0;
        {
            f32x4 gv[4];
#pragma unroll
            for (int i = 0; i < 4; ++i) gv[i] = *(const f32x4*)(gam + 4 * lane + 256 * i);
            for (int rr = 0; rr < 16; ++rr) {
                const int row = r0 + w * 16 + rr;
                f32x4 xv[4]; float ss = 0.f;
#pragma unroll
                for (int i = 0; i < 4; ++i) { xv[i] = *(const f32x4*)(p.xbuf + (size_t)row * 1024 + 4 * lane + 256 * i); ss += xv[i][0] * xv[i][0] + xv[i][1] * xv[i][1] + xv[i][2] * xv[i][2] + xv[i][3] * xv[i][3]; }
                ss = wave_sum(ss);
                const float rstd = rsqrtf(ss * (1.f / 1024.f) + RMS_EPS);
                if (lane == 0) rs[w * 16 + rr] = rstd;
#pragma unroll
                for (int i = 0; i < 4; ++i) {
                    const f32x4 hn = xv[i] * rstd * gv[i];
                    u32x2 o; o.x = pk_bf16(hn[0], hn[1]); o.y = pk_bf16(hn[2], hn[3]);
                    *(u32x2*)(h2 + (size_t)row * 1024 + 4 * lane + 256 * i) = o;
                }
            }
        }
        __syncthreads();
        float acc[9];
#pragma unroll
        for (int o = 0; o < 9; ++o) acc[o] = 0.f;
        const int row = tid & 63, og = tid >> 6;
        const float myrs = rs[row];
        for (int kc = 0; kc < 8; ++kc) {
            __syncthreads();
            {
                const float* xp = p.xbuf + (size_t)(r0 + row) * 1024 + kc * 128 + og * 32;
#pragma unroll
                for (int j = 0; j < 8; ++j) {
                    const f32x4 xv = *(const f32x4*)(xp + 4 * j); const f32x4 g4 = *(const f32x4*)(gam + kc * 128 + og * 32 + 4 * j);
#pragma unroll
                    for (int e = 0; e < 4; ++e) xT[(og * 32 + 4 * j + e) * 64 + row] = xv[e] * myrs * g4[e];
                }
                for (int idx = tid; idx < 128 * 36; idx += 256) {
                    const int k = idx / 36, o = idx % 36;
                    const float v = (o < 4) ? wg[(size_t)(kc * 128 + k) * 4 + o] : we[(size_t)(kc * 128 + k) * 32 + (o - 4)];
                    Wc[k * 48 + (o / 9) * 12 + (o % 9)] = v;
                }
            }
            __syncthreads();
#pragma unroll 4
            for (int k = 0; k < 128; ++k) {
                const float xv = xT[k * 64 + row];
                const f32x4 w0 = *(const f32x4*)(Wc + k * 48 + og * 12), w1 = *(const f32x4*)(Wc + k * 48 + og * 12 + 4);
                const float w8 = Wc[k * 48 + og * 12 + 8];
                acc[0] += xv * w0[0]; acc[1] += xv * w0[1]; acc[2] += xv * w0[2]; acc[3] += xv * w0[3];
                acc[4] += xv * w1[0]; acc[5] += xv * w1[1]; acc[6] += xv * w1[2]; acc[7] += xv * w1[3];
                acc[8] += xv * w8;
            }
        }
#pragma unroll
        for (int o = 0; o < 9; ++o) lg[row * 36 + og * 9 + o] = acc[o];
        __syncthreads();
        int e0 = 0, e1 = 0, lr0 = 0, lr1 = 0; float c0 = 0.f, c1 = 0.f;
        if (tid < 64) {
            const float* lrow = lg + tid * 36;
            float gl[4]; int grp = 0; float gm = -3.4e38f;
#pragma unroll
            for (int q = 0; q < 4; ++q) { gl[q] = lrow[q] + bg[q]; if (gl[q] > gm) { gm = gl[q]; grp = q; } }
            float gsum = 0.f;
#pragma unroll
            for (int q = 0; q < 4; ++q) gsum += expf(gl[q] - gm);
            const float grp_w = 1.f / gsum;
            float el[8]; float em = -3.4e38f;
#pragma unroll
            for (int q = 0; q < 8; ++q) { el[q] = lrow[4 + grp * 8 + q] + be[grp * 8 + q]; em = fmaxf(em, el[q]); }
            float esum = 0.f; float ep[8];
#pragma unroll
            for (int q = 0; q < 8; ++q) { ep[q] = expf(el[q] - em); esum += ep[q]; }
            int j0 = 0; float p0 = -1.f;
#pragma unroll
            for (int q = 0; q < 8; ++q) { const float pq = ep[q] / esum; ep[q] = pq; if (pq > p0) { p0 = pq; j0 = q; } }
            int j1 = 0; float p1 = -1.f;
#pragma unroll
            for (int q = 0; q < 8; ++q) { if (q != j0 && ep[q] > p1) { p1 = ep[q]; j1 = q; } }
            const float den = p0 + p1;
            c0 = grp_w * p0 / den; c1 = grp_w * p1 / den;
            e0 = grp * 8 + j0; e1 = grp * 8 + j1;
            lr0 = atomicAdd(&lc[e0], 1); lr1 = atomicAdd(&lc[e1], 1);
        }
        __syncthreads();
        if (tid < 32) { const int n = lc[tid]; gbs[tid] = n ? (int)atomicAdd(&cnt[tid], (unsigned)n) : 0; }
        __syncthreads();
        if (tid < 64) {
            const int tok = r0 + tid;
            list[e0 * 32768 + gbs[e0] + lr0] = tok * 2; list[e1 * 32768 + gbs[e1] + lr1] = tok * 2 + 1;
            wsl[tok * 2] = c0; wsl[tok * 2 + 1] = c1;
        }
    }
}

__device__ __forceinline__ bool moe_tile(const unsigned* cnt, int L, int nsub, int& e, int& mt, int& sub, int& rowbase, int& n) {
    int acc = 0, rb = 0;
    for (int q = 0; q < 32; ++q) {
        const int c = (int)cnt[q], nt = (c + 127) >> 7, tot = nt * nsub;
        if (L < acc + tot) { const int r = L - acc; e = q; mt = r / nsub; sub = r % nsub; rowbase = rb; n = c; return true; }
        acc += tot; rb += nt * 128;
    }
    return false;
}
__device__ __forceinline__ void phase_exp1(CKP& p, int l, unsigned char* lds, unsigned* ctl) {
    const int tid = opaque_tid(), lane = tid & 63, w = tid >> 6, wm = w >> 1, wn = w & 1, fr = lane & 15, fq = lane >> 4;
    const unsigned* cnt = ctl + CTL_MOECNT + l * 32;
    const int* list = (const int*)(p.ws + OFF_MOE + MOE_LIST);
    const bf16_t* h2 = (const bf16_t*)(p.ws + OFF_M);
    bf16_t* hid = (bf16_t*)(p.ws + OFF_HID);
    for (int L = blockIdx.x;; L += gridDim.x) {
        int e, mt, sub, rowbase, n;
        if (!moe_tile(cnt, L, 8, e, mt, sub, rowbase, n)) break;
        const bf16_t* Wg = (const bf16_t*)(p.ws + OFF_W + W_EG) + (size_t)e * 512 * 1024;
        const bf16_t* Wu = (const bf16_t*)(p.ws + OFF_W + W_EU) + (size_t)e * 512 * 1024;
        const int j0 = sub * 64;
        f32x4 acc[4][4]; zero_acc(acc);
        gemm_kloop(acc, [&](int r) { int s = mt * 128 + r; s = s < n ? s : n - 1; const int slot = list[e * 32768 + s]; return h2 + (size_t)(slot >> 1) * 1024; }, 64,
                   [&](int v) { const int wn_ = v >> 6, fq_ = (v >> 4) & 3, ee = v & 15; const int hc = j0 + 32 * wn_ + 8 * fq_ + (ee & 7);
                                return ((ee >> 3) ? Wu : Wg) + (size_t)hc * 1024; }, 64, 16, lds, tid);
#pragma unroll
        for (int mi = 0; mi < 4; ++mi) {
            const int r = mt * 128 + 64 * wm + 16 * mi + fr;
            if (r < n) {
                float gv[8], uv[8];
#pragma unroll
                for (int e2 = 0; e2 < 8; ++e2) { gv[e2] = acc[mi][e2 >> 2][e2 & 3]; uv[e2] = acc[mi][2 + (e2 >> 2)][e2 & 3]; }
                float hv[8];
#pragma unroll
                for (int e2 = 0; e2 < 8; ++e2) hv[e2] = gv[e2] * sigm(gv[e2]) * uv[e2];
                u32x4 o; o.x = pk_bf16(hv[0], hv[1]); o.y = pk_bf16(hv[2], hv[3]); o.z = pk_bf16(hv[4], hv[5]); o.w = pk_bf16(hv[6], hv[7]);
                *(u32x4*)(hid + (size_t)(rowbase + r) * 512 + j0 + 32 * wn + 8 * fq) = o;
            }
        }
    }
}
__device__ __forceinline__ void phase_exp2(CKP& p, int l, unsigned char* lds, unsigned* ctl) {
    const int tid = opaque_tid(), lane = tid & 63, w = tid >> 6, wm = w >> 1, wn = w & 1, fr = lane & 15, fq = lane >> 4;
    const unsigned* cnt = ctl + CTL_MOECNT + l * 32;
    const int* list = (const int*)(p.ws + OFF_MOE + MOE_LIST);
    const float* wsl = (const float*)(p.ws + OFF_MOE + MOE_WS);
    const bf16_t* hid = (const bf16_t*)(p.ws + OFF_HID);
    bf16_t* ys = (bf16_t*)(p.ws + OFF_YS);
    for (int L = blockIdx.x;; L += gridDim.x) {
        int e, mt, sub, rowbase, n;
        if (!moe_tile(cnt, L, 8, e, mt, sub, rowbase, n)) break;
        const bf16_t* Wd = (const bf16_t*)(p.ws + OFF_W + W_ED) + (size_t)e * 1024 * 512;
        const int n0 = sub * 128;
        f32x4 acc[4][4]; zero_acc(acc);
        gemm_kloop(acc, [&](int r) { int s = mt * 128 + r; s = s < n ? s : n - 1; return hid + (size_t)(rowbase + s) * 512; }, 64,
                   [&](int v) { return Wd + (size_t)(n0 + v) * 512; }, 64, 8, lds, tid);
#pragma unroll
        for (int mi = 0; mi < 4; ++mi) {
            const int r = mt * 128 + 64 * wm + 16 * mi + fr;
            if (r < n) {
                const int slot = list[e * 32768 + r]; const float wt = wsl[slot];
                float v[16];
#pragma unroll
                for (int e2 = 0; e2 < 16; ++e2) v[e2] = acc[mi][e2 >> 2][e2 & 3] * wt;
                store16bf(ys + (size_t)slot * 1024 + n0 + 64 * wn + 16 * fq, v);
            }
        }
    }
}

constexpr int PH_PER_LAYER = 10;
constexpr int NPHASE = PH_PER_LAYER * DEPTH + 1;

__global__ void __launch_bounds__(NTHR, 1) mega(KP p_unused) {
    extern __shared__ __attribute__((aligned(16))) unsigned char lds[];
    unsigned* ctl = (unsigned*)(p_unused.ws + OFF_CTL);
#if ONE_LAUNCH
    XcdBarrier xb = xcd_barrier_post(ctl + CTL_BAR, (volatile LAS unsigned*)(lds + LDS_BAR));
    if (p_unused.never) cg::this_grid().sync();
#if DBG_PREFLUSH
    __builtin_amdgcn_fence(__ATOMIC_RELEASE, "");
    asm volatile("s_waitcnt vmcnt(0)" ::: "memory");
    __builtin_amdgcn_fence(__ATOMIC_ACQUIRE, "");
    asm volatile("s_waitcnt vmcnt(0)" ::: "memory");
    xcd_barrier(xb);
    { const unsigned long long t0 = __builtin_amdgcn_s_memrealtime(); while (__builtin_amdgcn_s_memrealtime() - t0 < 20000ull) __builtin_amdgcn_s_sleep(8); }
    xcd_barrier(xb);
#endif
#endif
    CKP* kp0 = (CKP*)__builtin_amdgcn_kernarg_segment_ptr();
    const int ph_lo = kp0->ph_lo, ph_hi = kp0->ph_hi;
#if ONE_LAUNCH
#define PH_SYNC(PH) if ((PH) + 1 < ph_hi) xcd_barrier(xb);
#else
#define PH_SYNC(PH)
#endif
#if DBG_TIMEPH >= 0
#define PH_STAMP(PH) if (blockIdx.x == 0 && threadIdx.x == 0) ((unsigned long long*)(kp0->ws + OFF_CTL + 24576))[(PH)] = __builtin_amdgcn_s_memrealtime();
#else
#define PH_STAMP(PH)
#endif
#define RUN_PHASE(PH, CALL) if (ph_lo <= (PH) && (PH) < ph_hi) { PH_STAMP(PH) CKP* kp = kp0; asm volatile("" : "+s"(kp)); CKP& p = *kp; const int rep_ = 0; (void)rep_; CALL; \
    if ((PH) == DBG_REPEAT_PH) { xcd_barrier(xb); const int rep_ = 1; (void)rep_; CALL; } PH_SYNC(PH) }
#define RUN_LAYER(L) \
    RUN_PHASE((L) * 10 + 0, phase_prep(p, (L), lds)) \
    RUN_PHASE((L) * 10 + 1, phase_inproj(p, (L), lds)) \
    RUN_PHASE((L) * 10 + 2, phase_mid1(p, (L), lds)) \
    RUN_PHASE((L) * 10 + 3, phase_attn(p, (L), lds, ctl + 2 * rep_)) \
    RUN_PHASE((L) * 10 + 4, phase_glu(p, (L), lds)) \
    RUN_PHASE((L) * 10 + 5, phase_branch(p, (L), lds)) \
    RUN_PHASE((L) * 10 + 6, phase_mix(p, (L), lds)) \
    RUN_PHASE((L) * 10 + 7, phase_router(p, (L), lds, ctl)) \
    RUN_PHASE((L) * 10 + 8, phase_exp1(p, (L), lds, ctl)) \
    RUN_PHASE((L) * 10 + 9, phase_exp2(p, (L), lds, ctl))
#if DBG_SMALLK
    RUN_PHASE(0, phase_prep(p, 0, lds))
    RUN_PHASE(1, phase_inproj(p, 0, lds))
    RUN_PHASE(2, phase_mid1(p, 0, lds))
#else
    RUN_LAYER(0)
    RUN_LAYER(1)
    RUN_PHASE(20, phase_prep(p, 2, lds))
#endif
#if ONE_LAUNCH && DBG_DUMP
    {
        xcd_barrier(xb);
        CKP* kp = kp0; asm volatile("" : "+s"(kp)); CKP& p = *kp;
        const size_t NO = (size_t)NTOK * 1024;
        const unsigned char* src = p.ws + DBG_DUMP_OFF;
        for (size_t i = (size_t)blockIdx.x * NTHR + threadIdx.x; i < NO; i += (size_t)gridDim.x * NTHR) {
            float v = 0.f;
            if (i < (size_t)DBG_DUMP_N) {
                if (DBG_DUMP_F32) {
                    const size_t si = DBG_DUMP_REV ? ((size_t)DBG_DUMP_N - 1 - i) : i;
#if DBG_SC1READ
                    const unsigned fu = __hip_atomic_load((const unsigned*)src + si, __ATOMIC_RELAXED, __HIP_MEMORY_SCOPE_SYSTEM); const float f = __uint_as_float(fu);
#else
                    const float f = ((const float*)src)[si];
#endif
                    v = DBG_HASH ? (float)(__float_as_uint(f) & 0x3ff) : f;
#if DBG_EFILT
                    { const int id_ = (int)(((si >> 7) - DBG_IDROT) & 2047), blk = ((id_ >> 2) + 320) & 511; if (!(blk >= DBG_EFILT_LO && blk < DBG_EFILT_HI)) v = 0.f; }
#endif
#if DBG_E2
                    { const float f2 = ((const float*)(p.ws + OFF_C + C_ATT))[i]; v = (__float_as_uint(f2) == __float_as_uint(f)) ? 0.f : 1000.f; if (i == 0) v += 1.f; }
#endif
                }
                else { const bf16_t h = ((const bf16_t*)src)[i]; v = DBG_HASH ? (float)(h & 0x3ff) : bf2f(h); }
            }
#if DBG_CONSTOUT
            v = 1000.f + (float)(i & 1023);
#endif
            p.xbuf[i] = v;
        }
    }
#endif
}

#if DBG_DUMP
__global__ void dbg_dump(const bf16_t* src, size_t n, float* out, size_t nout) {
    for (size_t i = (size_t)blockIdx.x * blockDim.x + threadIdx.x; i < nout; i += (size_t)gridDim.x * blockDim.x)
        out[i] = i < n ? (DBG_HASH ? (float)(src[i] & 0x3ff) : bf2f(src[i])) : 0.f;
}
__global__ void dbg_dump_f32(const float* src, size_t n, float* out, size_t nout) {
    for (size_t i = (size_t)blockIdx.x * blockDim.x + threadIdx.x; i < nout; i += (size_t)gridDim.x * blockDim.x)
        out[i] = i < n ? (DBG_HASH ? (float)(__float_as_uint(src[i]) & 0x3ff) : src[i]) : 0.f;
}
#endif
extern "C" void kernel_launch(void* const* d_in, const int* in_sizes, int n_in, void* d_out, int out_size, void* d_ws, size_t ws_size, hipStream_t stream) {
    static int grid = 0;
    if (grid == 0) {
        if (n_in != 36 || out_size != NTOK * DM || ws_size < WS_END) { fprintf(stderr, "kernel_launch: unexpected shapes n_in %d out %d ws %zu (need %zu)\n", n_in, out_size, ws_size, (size_t)WS_END); grid = -1; return; }
        int dev = 0, cus = 0, per_cu = 0;
        hipGetDevice(&dev);
        hipDeviceGetAttribute(&cus, hipDeviceAttributeMultiprocessorCount, dev);
        hipFuncSetAttribute((const void*)mega, hipFuncAttributeMaxDynamicSharedMemorySize, LDS_BYTES);
        hipOccupancyMaxActiveBlocksPerMultiprocessor(&per_cu, (const void*)mega, NTHR, LDS_BYTES);
        if (per_cu < 1) { fprintf(stderr, "kernel_launch: occupancy query says %d\n", per_cu); per_cu = 1; }
        if (per_cu > MAX_PER_CU) per_cu = MAX_PER_CU;
        grid = cus * per_cu;
        fprintf(stderr, "kernel_launch: grid %d (%d CUs x %d)\n", grid, cus, per_cu);
    }
    if (grid < 0) return;
    hipMemsetAsync((char*)d_ws + OFF_CTL, 0, CTL_BYTES, stream);
    KP p{};
    for (int i = 0; i < 36; ++i) p.in[i] = (const float*)d_in[i];
    p.xbuf = (float*)d_out; p.ws = (unsigned char*)d_ws;
    for (int i = 0; i < 8; ++i) p.inv_freq[i] = (float)pow(500000.0, -(double)i / 8.0);
    p.never = 0; p.pad = 0;
#if ONE_LAUNCH
    p.ph_lo = 0; p.ph_hi = DBG_PH_HI;
    void* args[] = {&p};
    hipError_t e = hipLaunchCooperativeKernel((const void*)mega, dim3(grid), dim3(NTHR), args, LDS_BYTES, stream);
    if (e != hipSuccess) fprintf(stderr, "cooperative launch failed: %s (grid %d)\n", hipGetErrorString(e), grid);
#else
    for (int ph = 0; ph < NPHASE; ++ph) {
        if (!((DBG_MASK >> ph) & 1)) continue;
        p.ph_lo = ph; p.ph_hi = ph + 1;
        hipLaunchKernelGGL(mega, dim3(grid), dim3(NTHR), LDS_BYTES, stream, p);
    }
#if DBG_DUMP
    {
        const unsigned char* w = (const unsigned char*)d_ws; const size_t NO = (size_t)NTOK * 1024;
        size_t off = 0, n = 0; bool f32 = false;
        switch (DBG_DUMP) {
            case 1: off = OFF_C + C_ATT; n = (size_t)NTOK * 512; break;
            case 2: off = OFF_C + C_SGU; n = (size_t)NTOK * 256; break;
            case 3: off = OFF_C + C_S5O; n = (size_t)NTOK * 256; break;
            case 4: off = OFF_M; n = (size_t)NTOK * 1024; break;
            case 5: off = OFF_R + R_Q; n = (size_t)NTOK * 512; break;
            case 6: off = OFF_H; n = (size_t)NTOK * 1024; break;
            case 7: off = OFF_C + C_YG; n = (size_t)NTOK * 256; break;
            case 8: off = OFF_C + C_KCMP; n = (size_t)2 * 524288 / 2; break;
            case 9: off = OFF_R + R_KC; n = (size_t)NTOK * 128 * 6; break;
            case 10: off = OFF_R + R_NG; n = (size_t)NTOK * 24; f32 = true; break;
            case 11: off = OFF_R + R_U; n = (size_t)NTOK * 768; break;
            case 12: off = OFF_C + C_S5E; n = (size_t)128 * 16 * 64 * 2; f32 = true; break;
            case 15: off = 0; n = (size_t)NTOK * 1024; f32 = true; break;
            case 16: off = OFF_W + W_S5A; n = 36864; f32 = true; break;
            case 13: off = OFF_YS; n = (size_t)NTOK * 1024; break;
            case 14: off = OFF_MOE + MOE_WS; n = 65536; f32 = true; break;
            default: break;
        }
        if (DBG_DUMP == 15) hipLaunchKernelGGL(dbg_dump_f32, dim3(2048), dim3(256), 0, stream, (const float*)d_out, n, (float*)d_out, NO);
        else if (f32) hipLaunchKernelGGL(dbg_dump_f32, dim3(2048), dim3(256), 0, stream, (const float*)(w + off), n, (float*)d_out, NO);
        else hipLaunchKernelGGL(dbg_dump, dim3(2048), dim3(256), 0, stream, (const bf16_t*)(w + off), n, (float*)d_out, NO);
    }
#endif
#endif
}
```

```cpp
#include <hip/hip_runtime.h>
#include <hip/hip_cooperative_groups.h>
#include <cstdio>
#include <cstdint>
#include <cmath>
namespace cg = cooperative_groups;

#ifndef ONE_LAUNCH
#define ONE_LAUNCH 1
#endif
#ifndef DBG_MASK
#define DBG_MASK 0x1fffff
#endif
#ifndef DBG_NOCOMBINE
#define DBG_NOCOMBINE 0
#endif
#ifndef DBG_DUMP
#define DBG_DUMP 0
#endif
#ifndef DBG_HASH
#define DBG_HASH 0
#endif
#ifndef DBG_ONLYS5
#define DBG_ONLYS5 0
#endif
#ifndef DBG_NOCSTORE
#define DBG_NOCSTORE 0
#endif
#ifndef DBG_LDSCHK
#define DBG_LDSCHK 0
#endif
#ifndef DBG_TWICE
#define DBG_TWICE 0
#endif
#ifndef DBG_S5CONST
#define DBG_S5CONST 0
#endif
#ifndef DBG_SC1READ
#define DBG_SC1READ 0
#endif
#ifndef DBG_E2
#define DBG_E2 0
#endif
#ifndef DBG_JOBFENCE
#define DBG_JOBFENCE 0
#endif
#ifndef DBG_CONSTOUT
#define DBG_CONSTOUT 0
#endif
#ifndef DBG_QDELAY
#define DBG_QDELAY 0
#endif
#ifndef DBG_SMALLK
#define DBG_SMALLK 0
#endif
#ifndef DBG_REPEAT_PH
#define DBG_REPEAT_PH -1
#endif
#ifndef DBG_TIMEPH
#define DBG_TIMEPH -1
#endif
#ifndef DBG_TIMEPH2
#define DBG_TIMEPH2 (DBG_TIMEPH + 1)
#endif
#ifndef DBG_PRESPIN
#define DBG_PRESPIN 0
#endif
#ifndef DBG_SGUSPIN
#define DBG_SGUSPIN 0
#endif
#ifndef DBG_PREFLUSH
#define DBG_PREFLUSH 0
#endif
#ifndef DBG_ESC1
#define DBG_ESC1 0
#endif
#ifndef DBG_DELAY
#define DBG_DELAY 0
#endif
#ifndef DBG_IDROT
#define DBG_IDROT 0
#endif
#ifndef DBG_DUMP_REV
#define DBG_DUMP_REV 0
#endif
#ifndef DBG_SGUCUT
#define DBG_SGUCUT 0
#endif
#ifndef DBG_EFILT
#define DBG_EFILT 0
#define DBG_EFILT_LO 0
#define DBG_EFILT_HI 0
#endif
#ifndef DBG_DUMP_OFF
#define DBG_DUMP_OFF 0
#define DBG_DUMP_N 0
#define DBG_DUMP_F32 0
#endif
#ifndef DBG_PH_HI
#define DBG_PH_HI NPHASE
#endif

typedef unsigned short bf16_t;
typedef short bf16x8 __attribute__((ext_vector_type(8)));
typedef float f32x4 __attribute__((ext_vector_type(4)));
typedef unsigned u32x4 __attribute__((ext_vector_type(4)));
typedef unsigned u32x2 __attribute__((ext_vector_type(2)));

constexpr int DM = 1024, NB = 8, SEQ = 4096, NTOK = NB * SEQ, DEPTH = 2;
constexpr int NCMP = 255;
constexpr float RMS_EPS = 1e-6f;
constexpr int NTHR = 256;
constexpr int LDS_BAR = 67584;
#ifndef MAX_PER_CU
#define MAX_PER_CU 2
#endif
#ifndef LDS_TOTAL
#define LDS_TOTAL (67584 + 64)
#endif
constexpr int LDS_BYTES = LDS_TOTAL;

constexpr size_t OFF_CTL = 0;
constexpr size_t OFF_W = 65536;
constexpr size_t W_IN = 0, W_GB = 4456448, W_A = 10747904, W_S = 11796480, W_5 = 12320768, W_M = 12845056, W_GLU = 14942208,
                 W_C1 = 15073280, W_C2 = 16121856, W_PB = 16154624, W_SGU = 16155648, W_S5A = 16286720, W_S5A256 = 16294912,
                 W_S5B = 16303104, W_S5C = 16434176, W_RH = 16499712, W_RL = 16630784, W_EG = 16777216, W_EU = 50331648, W_ED = 83886080, W_END = 117440512;
constexpr size_t OFF_H = OFF_W + W_END;
constexpr size_t OFF_M = OFF_H + 67108864;
constexpr size_t OFF_R = OFF_M + 67108864;
constexpr size_t R_Q = 0, R_KC = 33554432, R_VC = 41943040, R_KS = 50331648, R_KW = 58720256, R_VST = 67108864, R_VWT = 75497472,
                 R_NG = 83886080, R_U = 87031808, R_V = 103809024, R_S5IN = 120586240, R_END = 137363456;
constexpr size_t OFF_C = OFF_R + R_END;
constexpr size_t C_ATT = 0, C_SGU = 33554432, C_YG = 50331648, C_S5O = 67108864, C_KCMP = 83886080, C_VCT = 84410368, C_S5E = 84934656, C_END = 85983232;
constexpr size_t OFF_MOE = OFF_C + C_END;
constexpr size_t MOE_LIST = 0, MOE_WS = 4194304, MOE_END = 4456448;
constexpr size_t WS_END = OFF_MOE + MOE_END;
constexpr size_t OFF_HID = OFF_R;
constexpr size_t OFF_YS = OFF_R + 71303168;
static_assert(OFF_YS + 134217728 <= OFF_C + C_KCMP, "alias overflow");

constexpr int CTL_BAR = 0;
constexpr int CTL_MOECNT = 4096;
constexpr int CTL_ATTN = 4096 + 64;
constexpr int CTL_BYTES = 32768;

struct KP {
    const float* in[36];
    float* xbuf;
    unsigned char* ws;
    float inv_freq[8];
    int ph_lo, ph_hi;
    int never;
    int pad;
};

typedef const KP __attribute__((address_space(4))) CKP;

typedef float f32x2_t __attribute__((ext_vector_type(2)));
typedef __bf16 bf16x2_t __attribute__((ext_vector_type(2)));
__device__ __forceinline__ unsigned pk_bf16(float lo, float hi) {
    const f32x2_t v = {lo, hi};
    union { bf16x2_t b; unsigned u; } x; x.b = __builtin_convertvector(v, bf16x2_t); return x.u;
}
__device__ __forceinline__ bf16_t f2bf(float f) { return (bf16_t)(pk_bf16(f, 0.f) & 0xffffu); }
__device__ __forceinline__ float bf2f(bf16_t b) { return __uint_as_float(((unsigned)b) << 16); }
__device__ __forceinline__ float bflo(unsigned u) { return __uint_as_float(u << 16); }
__device__ __forceinline__ float bfhi(unsigned u) { return __uint_as_float(u & 0xffff0000u); }
__device__ __forceinline__ float fexp2(float x) { return __builtin_amdgcn_exp2f(x); }
__device__ __forceinline__ float gelu_tanh(float x) {
    const float u = 0.7978845608028654f * (x + 0.044715f * x * x * x);
    const float e = __expf(2.f * u);
    const float t = 1.f - 2.f / (e + 1.f);
    return 0.5f * x * (1.f + t);
}
__device__ __forceinline__ float sigm(float x) { return 1.f / (1.f + __expf(-x)); }
__device__ __forceinline__ int opaque_tid() { int t = threadIdx.x; asm volatile("" : "+v"(t)); return t; }
__device__ __forceinline__ void job_fence() {
#if DBG_JOBFENCE
    asm volatile("s_waitcnt vmcnt(0) lgkmcnt(0)" ::: "memory");
    __syncthreads();
#endif
}
__device__ __forceinline__ float wave_sum(float v) {
#pragma unroll
    for (int o = 32; o >= 1; o >>= 1) v += __shfl_xor(v, o);
    return v;
}
__device__ __forceinline__ f32x4 mfma16(bf16x8 a, bf16x8 b, f32x4 c) { return __builtin_amdgcn_mfma_f32_16x16x32_bf16(a, b, c, 0, 0, 0); }
__device__ __forceinline__ bf16x8 as_bf8(u32x4 v) { union { u32x4 u; bf16x8 b; } x; x.u = v; return x.b; }
__device__ __forceinline__ void store16bf(bf16_t* dst, const float (&v)[16]) {
    u32x4 a, b;
    a.x = pk_bf16(v[0], v[1]); a.y = pk_bf16(v[2], v[3]); a.z = pk_bf16(v[4], v[5]); a.w = pk_bf16(v[6], v[7]);
    b.x = pk_bf16(v[8], v[9]); b.y = pk_bf16(v[10], v[11]); b.z = pk_bf16(v[12], v[13]); b.w = pk_bf16(v[14], v[15]);
    *(u32x4*)dst = a; *(u32x4*)(dst + 8) = b;
}

#ifndef XB_SCOPE
#define XB_SCOPE "agent"
#endif
#define XB_TMO      128
#define XB_XCNT(j)  (256  + 64 * (j))
#define XB_XSUB(j)  (1280 + 64 * (j))
#define XB_XGEN(j)  (2304 + 64 * (j))
#define XB_TOP      3328
#define XB_TOPGEN   3392
#define XCD_BAR_WORDS 3456
#define XB_SPIN_CAP (1u << 22)
#define LAS __attribute__((address_space(3)))
__device__ __forceinline__ unsigned xb_ld(unsigned* p)              { return __hip_atomic_load(p, __ATOMIC_RELAXED, __HIP_MEMORY_SCOPE_AGENT); }
__device__ __forceinline__ unsigned xb_add(unsigned* p, unsigned v) { return __hip_atomic_fetch_add(p, v, __ATOMIC_RELAXED, __HIP_MEMORY_SCOPE_AGENT); }
__device__ __forceinline__ unsigned xb_xcc_id() { return (unsigned)__builtin_amdgcn_s_getreg((3 << 11) | 20) & 0xFu; }
#define XB_SPIN(cond, bar) do { unsigned _sp = 0; while (cond) { __builtin_amdgcn_s_sleep(1); \
    if ((++_sp & 255u) == 0u) { if (xb_ld(&(bar)[XB_TMO])) break; if (_sp > XB_SPIN_CAP) { atomicAdd(&(bar)[XB_TMO], 1u); break; } } } } while (0)
struct XcdBarrier { unsigned* bar; unsigned x; volatile LAS unsigned* st; unsigned nloc, nx; };
__device__ __forceinline__ XcdBarrier xcd_barrier_post(unsigned* bar, volatile LAS unsigned* st) {
    XcdBarrier b; b.bar = bar; b.x = xb_xcc_id(); b.st = st; b.nloc = 0u; b.nx = 0u;
    if (threadIdx.x == 0) (void)xb_add(&bar[XB_XCNT(b.x)], 1u);
    return b;
}
__device__ __forceinline__ void xcd_barrier_complete(unsigned* bar, unsigned x, unsigned& nloc, unsigned& nx) {
    const unsigned G = gridDim.x * gridDim.y * gridDim.z;
    unsigned sum, cnt, mine, sp = 0u;
    for (;;) {
        sum = 0u; cnt = 0u; mine = 0u;
#pragma unroll
        for (unsigned j = 0; j < 16; ++j) { const unsigned c = xb_ld(&bar[XB_XCNT(j)]); sum += c; cnt += (c > 0u) ? 1u : 0u; mine = (j == x) ? c : mine; }
        if (sum == G) break;
        __builtin_amdgcn_s_sleep(1);
        if ((++sp & 255u) == 0u) { if (xb_ld(&bar[XB_TMO])) break; if (sp > XB_SPIN_CAP) { atomicAdd(&bar[XB_TMO], 1u); break; } }
    }
    nloc = mine > 0u ? mine : 1u; nx = cnt > 0u ? cnt : 1u;
}
__device__ __forceinline__ void xcd_barrier(XcdBarrier& b) {
    asm volatile("s_waitcnt vmcnt(0)" ::: "memory");
    __syncthreads();
    if (threadIdx.x == 0) {
        unsigned* bar = b.bar;
        __builtin_amdgcn_s_waitcnt(0);
        unsigned nloc = b.nloc, nx = b.nx;
        if (nloc == 0u) { xcd_barrier_complete(bar, b.x, nloc, nx); b.nloc = nloc; b.nx = nx; }
        const unsigned old = xb_add(&bar[XB_XSUB(b.x)], 1u);
        const unsigned gen = old / nloc;
        if (old + 1u == (gen + 1u) * nloc) {
            __builtin_amdgcn_fence(__ATOMIC_RELEASE, XB_SCOPE);
            asm volatile("s_waitcnt vmcnt(0)" ::: "memory");
            const unsigned og = xb_add(&bar[XB_TOP], 1u);
            const unsigned tg = og / nx;
            if (og + 1u == (tg + 1u) * nx) xb_add(&bar[XB_TOPGEN], 1u);
            else XB_SPIN(xb_ld(&bar[XB_TOPGEN]) == tg, bar);
            __builtin_amdgcn_fence(__ATOMIC_ACQUIRE, XB_SCOPE);
            xb_add(&bar[XB_XGEN(b.x)], 1u);
            asm volatile("s_waitcnt vmcnt(0)" ::: "memory");
        } else {
            XB_SPIN(xb_ld(&bar[XB_XGEN(b.x)]) == gen, bar);
            __builtin_amdgcn_fence(__ATOMIC_ACQUIRE, XB_SCOPE);
            asm volatile("s_waitcnt vmcnt(0)" ::: "memory");
        }
    }
    __syncthreads();
}

__device__ __forceinline__ void tile_coords(int L, int ntm, int ntn, int& tm, int& tn) {
    const int nt = ntm * ntn, q = nt >> 3, r = nt & 7, xcd = L & 7, off = L >> 3;
    const int id = (xcd < r ? xcd * (q + 1) : r * (q + 1) + (xcd - r) * q) + off;
    const int GM = 8, nig = GM * ntn, gid = id / nig, fm = gid * GM, gsz = (ntm - fm) < GM ? (ntm - fm) : GM;
    tm = fm + ((id % nig) % gsz); tn = (id % nig) / gsz;
}

template <class AP, class BP>
__device__ __forceinline__ void gemm_kloop(f32x4 (&acc)[4][4], AP ap, int a_kstep, BP bp, int b_kstep, int nkt, unsigned char* lds, int tid) {
    const int c = tid & 7, r0 = tid >> 3;
    const bf16_t* pa[4]; const bf16_t* pb[4];
#pragma unroll
    for (int i = 0; i < 4; ++i) {
        pa[i] = ap(r0 + 32 * i) + c * 8;
        const int rho = r0 + 32 * i, wn_ = rho >> 6, ni_ = (rho >> 4) & 3, ii = rho & 15;
        pb[i] = bp(64 * wn_ + 16 * (ii >> 2) + 4 * ni_ + (ii & 3)) + c * 8;
    }
    const int woff = r0 * 128 + ((c ^ (r0 & 7)) << 4);
    const int lane = tid & 63, w = tid >> 6, wm = w >> 1, wn = w & 1, fr = lane & 15, fq = lane >> 4;
    const int ra = (64 * wm + fr) * 128, rb = (64 * wn + fr) * 128;
    const int sw0 = ((fq) ^ (fr & 7)) << 4, sw1 = ((4 + fq) ^ (fr & 7)) << 4;
    u32x4 xa[4], xb[4], ya[4], yb[4];
    auto ld = [&](u32x4 (&a)[4], u32x4 (&b)[4]) {
#pragma unroll
        for (int i = 0; i < 4; ++i) { a[i] = *(const u32x4*)pa[i]; b[i] = *(const u32x4*)pb[i]; pa[i] += a_kstep; pb[i] += b_kstep; }
    };
    auto st = [&](const u32x4 (&a)[4], const u32x4 (&b)[4], int buf) {
        unsigned char* An = lds + buf * 16384;
#pragma unroll
        for (int i = 0; i < 4; ++i) { *(u32x4*)(An + woff + i * 4096) = a[i]; *(u32x4*)(An + 32768 + woff + i * 4096) = b[i]; }
    };
    auto compute = [&](int buf) {
        const unsigned char* A = lds + buf * 16384;
        const unsigned char* B = lds + 32768 + buf * 16384;
#pragma unroll
        for (int ks = 0; ks < 2; ++ks) {
            const int sw = ks ? sw1 : sw0;
            bf16x8 af[4], bf[4];
#pragma unroll
            for (int mi = 0; mi < 4; ++mi) af[mi] = *(const bf16x8*)(A + ra + mi * 2048 + sw);
#pragma unroll
            for (int ni = 0; ni < 4; ++ni) bf[ni] = *(const bf16x8*)(B + rb + ni * 2048 + sw);
#pragma unroll
            for (int mi = 0; mi < 4; ++mi)
#pragma unroll
                for (int ni = 0; ni < 4; ++ni) acc[mi][ni] = mfma16(bf[ni], af[mi], acc[mi][ni]);
        }
    };
    ld(xa, xb);
    if (nkt > 1) ld(ya, yb);
    __syncthreads();
    st(xa, xb, 0);
    if (nkt > 2) ld(xa, xb);
    __syncthreads();
    for (int kt = 0; kt < nkt; kt += 2) {
        compute(0);
        if (kt + 1 < nkt) st(ya, yb, 1);
        if (kt + 3 < nkt) ld(ya, yb);
        __syncthreads();
        if (kt + 1 < nkt) compute(1);
        if (kt + 2 < nkt) st(xa, xb, 0);
        if (kt + 4 < nkt) ld(xa, xb);
        __syncthreads();
    }
}
__device__ __forceinline__ void zero_acc(f32x4 (&acc)[4][4]) {
#pragma unroll
    for (int i = 0; i < 4; ++i)
#pragma unroll
        for (int j = 0; j < 4; ++j) acc[i][j] = (f32x4){0.f, 0.f, 0.f, 0.f};
}

__device__ __forceinline__ void transpose_tile(const float* src, bf16_t* dst, int R, int C, int mode, int tk, int tn, float* tl, int tid) {
    const int k0 = tk * 64, n0 = tn * 64;
    {
        const int j = tid & 63; const int n = n0 + j;
        int col = n;
        if (mode == 1) col = (n < 1304) ? n : ((n < 1408) ? -1 : n - 104);
        else if (mode == 2) col = n + 2072;
#pragma unroll 4
        for (int pp = 0; pp < 16; ++pp) {
            const int i = (tid >> 6) + 4 * pp;
            tl[i * 65 + j] = (col >= 0) ? src[(size_t)(k0 + i) * C + col] : 0.f;
        }
    }
    __syncthreads();
#pragma unroll
    for (int q2 = 0; q2 < 2; ++q2) {
        const int jj = (tid >> 3) + 32 * q2, cc = tid & 7;
        u32x4 o;
        o.x = pk_bf16(tl[(cc * 8 + 0) * 65 + jj], tl[(cc * 8 + 1) * 65 + jj]);
        o.y = pk_bf16(tl[(cc * 8 + 2) * 65 + jj], tl[(cc * 8 + 3) * 65 + jj]);
        o.z = pk_bf16(tl[(cc * 8 + 4) * 65 + jj], tl[(cc * 8 + 5) * 65 + jj]);
        o.w = pk_bf16(tl[(cc * 8 + 6) * 65 + jj], tl[(cc * 8 + 7) * 65 + jj]);
        *(u32x4*)(dst + (size_t)(n0 + jj) * R + k0 + cc * 8) = o;
    }
    __syncthreads();
}

__device__ __forceinline__ void phase_prep(CKP& p, int l, unsigned char* lds) {
    const int tid = opaque_tid(), G = gridDim.x, lane = tid & 63, w = tid >> 6;
    unsigned char* W = p.ws + OFF_W;
    if (l < DEPTH) {
        struct E { const float* src; bf16_t* dst; int R, C, nd, mode, nbatch; };
        constexpr int NE = 14;
        for (int L = blockIdx.x * 4 + w;; L += G * 4) {
            int rem = L; int e = 0; E d{};
            for (; e < NE; ++e) {
                switch (e) {
                    case 0: d = {p.in[3] + (size_t)l * 1024 * 5144, (bf16_t*)(W + W_IN), 1024, 5144, 2176, 1, 1}; break;
                    case 1: d = {p.in[3] + (size_t)l * 1024 * 5144, (bf16_t*)(W + W_GB), 1024, 5144, 3072, 2, 1}; break;
                    case 2: d = {p.in[10] + (size_t)l * 512 * 1024, (bf16_t*)(W + W_A), 512, 1024, 1024, 0, 1}; break;
                    case 3: d = {p.in[14] + (size_t)l * 256 * 1024, (bf16_t*)(W + W_S), 256, 1024, 1024, 0, 1}; break;
                    case 4: d = {p.in[25] + (size_t)l * 256 * 1024, (bf16_t*)(W + W_5), 256, 1024, 1024, 0, 1}; break;
                    case 5: d = {p.in[26] + (size_t)l * 1024 * 1024, (bf16_t*)(W + W_M), 1024, 1024, 1024, 0, 1}; break;
                    case 6: d = {p.in[23] + (size_t)l * 256 * 256, (bf16_t*)(W + W_GLU), 256, 256, 256, 0, 1}; break;
                    case 7: d = {p.in[6] + (size_t)l * 2048 * 128, (bf16_t*)(W + W_C1), 2048, 128, 128, 0, 1}; break;
                    case 8: d = {p.in[8] + (size_t)l * 2048 * 128, (bf16_t*)(W + W_C1) + 128 * 2048, 2048, 128, 128, 0, 1}; break;
                    case 9: d = {p.in[7] + (size_t)l * 128 * 64, (bf16_t*)(W + W_C2), 128, 64, 64, 0, 1}; break;
                    case 10: d = {p.in[9] + (size_t)l * 128 * 64, (bf16_t*)(W + W_C2) + 64 * 128, 128, 64, 64, 0, 1}; break;
                    case 11: d = {p.in[32] + (size_t)l * 32 * 1024 * 512, (bf16_t*)(W + W_EG), 1024, 512, 512, 0, 32}; break;
                    case 12: d = {p.in[33] + (size_t)l * 32 * 1024 * 512, (bf16_t*)(W + W_EU), 1024, 512, 512, 0, 32}; break;
                    default: d = {p.in[34] + (size_t)l * 32 * 512 * 1024, (bf16_t*)(W + W_ED), 512, 1024, 1024, 0, 32}; break;
                }
                const int per = (d.R >> 6) * (d.nd >> 6), tot = per * d.nbatch;
                if (rem < tot) break;
                rem -= tot;
            }
            if (e >= NE) break;
            const int per = (d.R >> 6) * (d.nd >> 6), bi = rem / per, t = rem % per, ntn = d.nd >> 6;
            const int k0 = (t / ntn) * 64, n = (t % ntn) * 64 + lane;
            int col = n;
            if (d.mode == 1) col = (n < 1304) ? n : ((n < 1408) ? -1 : n - 104);
            else if (d.mode == 2) col = n + 2072;
            const float* sp = d.src + (size_t)bi * d.R * d.C + (size_t)k0 * d.C + (col >= 0 ? col : 0);
            float v[64];
#pragma unroll
            for (int i = 0; i < 64; ++i) v[i] = sp[(size_t)i * d.C];
            if (col < 0) {
#pragma unroll
                for (int i = 0; i < 64; ++i) v[i] = 0.f;
            }
            bf16_t* dp = d.dst + (size_t)bi * d.R * d.nd + (size_t)n * d.R + k0;
#pragma unroll
            for (int q = 0; q < 8; ++q) {
                u32x4 o;
                o.x = pk_bf16(v[8 * q], v[8 * q + 1]); o.y = pk_bf16(v[8 * q + 2], v[8 * q + 3]);
                o.z = pk_bf16(v[8 * q + 4], v[8 * q + 5]); o.w = pk_bf16(v[8 * q + 6], v[8 * q + 7]);
                *(u32x4*)(dp + 8 * q) = o;
            }
        }
        const int gt = blockIdx.x * NTHR + tid, gs = G * NTHR;
        {
            const float* sw = p.in[12] + (size_t)l * 4 * 128 * 128; bf16_t* o = (bf16_t*)(W + W_SGU);
            for (int i = gt; i < 65536; i += gs) { const int t = (i >> 7) & 127, s = i & 127; o[i] = f2bf(s <= t ? sw[i] : 0.f); }
        }
        {
            const float* are = p.in[15] + l * 1024; const float* aim = p.in[16] + l * 1024; const float* ls = p.in[17] + l * 16;
            const float* bre = p.in[18] + (size_t)l * 16384; const float* bim = p.in[19] + (size_t)l * 16384;
            float* oa = (float*)(W + W_S5A); float* oa2 = (float*)(W + W_S5A256); float* ob = (float*)(W + W_S5B);
            for (int i = gt; i < 1024; i += gs) {
                const int g = i >> 6;
                const float step = expf(ls[g]), ar = are[i], ai = aim[i];
                const float mag = expf(ar * step); float sn, cs; sincosf(ai * step, &sn, &cs);
                const float abr = mag * cs, abi = mag * sn;
                const float den = ar * ar + ai * ai, nr = abr - 1.f, ni = abi;
                const float cr = (nr * ar + ni * ai) / den, ci = (ni * ar - nr * ai) / den;
                oa[i * 2] = abr; oa[i * 2 + 1] = abi;
                float pr = abr, pi = abi;
                for (int s = 0; s < 8; ++s) { const float nr2 = pr * pr - pi * pi, ni2 = 2.f * pr * pi; pr = nr2; pi = ni2; }
                oa2[i * 2] = pr; oa2[i * 2 + 1] = pi;
                for (int h = 0; h < 16; ++h) {
                    const float br = bre[i * 16 + h], bi_ = bim[i * 16 + h];
                    ob[i * 32 + h] = cr * br - ci * bi_;
                    ob[i * 32 + 16 + h] = cr * bi_ + ci * br;
                }
            }
            const float* cre = p.in[20] + (size_t)l * 16384; const float* cim = p.in[21] + (size_t)l * 16384; bf16_t* oc = (bf16_t*)(W + W_S5C);
            for (int i = gt; i < 32768; i += gs) {
                const int k = i & 127, gh = i >> 7;
                oc[i] = f2bf(k < 64 ? cre[gh * 64 + k] : -cim[gh * 64 + (k - 64)]);
            }
        }
        {
            const float* wg = p.in[28] + (size_t)l * 1024 * 4; const float* we = p.in[30] + (size_t)l * 1024 * 32;
            bf16_t* oh = (bf16_t*)(W + W_RH); bf16_t* ol = (bf16_t*)(W + W_RL);
            for (int i = gt; i < 65536; i += gs) {
                const int n = i >> 10, k = i & 1023;
                const float v = (n < 4) ? wg[k * 4 + n] : ((n < 36) ? we[k * 32 + (n - 4)] : 0.f);
                const bf16_t h = f2bf(v);
                oh[i] = h; ol[i] = f2bf(v - bf2f(h));
            }
        }
        {
            float* pb = (float*)(W + W_PB);
            for (int j = blockIdx.x * 4 + w; j < 256; j += G * 4) {
                const int kv = j >> 7, n = j & 127;
                const float* pos = p.in[kv ? 5 : 4] + (size_t)l * 2048; const float* w1 = p.in[kv ? 8 : 6] + (size_t)l * 2048 * 128;
                float s = 0.f;
                for (int k = lane; k < 2048; k += 64) s += pos[k] * w1[(size_t)k * 128 + n];
                s = wave_sum(s);
                if (lane == 0) pb[j] = s;
            }
        }
    }
    {
        const float* gam = (l < DEPTH) ? (p.in[2] + (size_t)l * 1024) : p.in[35];
        bf16_t* hb = (bf16_t*)(p.ws + OFF_H);
        const bf16_t* ys = (const bf16_t*)(p.ws + OFF_YS);
        f32x4 gv[4];
#pragma unroll
        for (int i = 0; i < 4; ++i) gv[i] = *(const f32x4*)(gam + 4 * lane + 256 * i);
        for (int row = blockIdx.x * 4 + w; row < NTOK; row += G * 4) {
            f32x4 xv[4]; float ss = 0.f;
#pragma unroll
            for (int i = 0; i < 4; ++i) {
                const int col = 4 * lane + 256 * i;
                if (l == 0) xv[i] = *(const f32x4*)(p.in[0] + (size_t)row * 1024 + col);
                else if ((DBG_NOCOMBINE >> l) & 1) xv[i] = *(const f32x4*)(p.xbuf + (size_t)row * 1024 + col);
                else {
                    xv[i] = *(const f32x4*)(p.xbuf + (size_t)row * 1024 + col);
                    const u32x2 y0 = *(const u32x2*)(ys + (size_t)(2 * row) * 1024 + col), y1 = *(const u32x2*)(ys + (size_t)(2 * row + 1) * 1024 + col);
                    xv[i][0] += bflo(y0.x) + bflo(y1.x); xv[i][1] += bfhi(y0.x) + bfhi(y1.x);
                    xv[i][2] += bflo(y0.y) + bflo(y1.y); xv[i][3] += bfhi(y0.y) + bfhi(y1.y);
                }
                ss += xv[i][0] * xv[i][0] + xv[i][1] * xv[i][1] + xv[i][2] * xv[i][2] + xv[i][3] * xv[i][3];
            }
            ss = wave_sum(ss);
            const float rstd = rsqrtf(ss * (1.f / 1024.f) + RMS_EPS);
#pragma unroll
            for (int i = 0; i < 4; ++i) {
                const int col = 4 * lane + 256 * i;
                f32x4 hn = xv[i] * rstd * gv[i];
                if (l < DEPTH) {
                    *(f32x4*)(p.xbuf + (size_t)row * 1024 + col) = xv[i];
                    u32x2 o; o.x = pk_bf16(hn[0], hn[1]); o.y = pk_bf16(hn[2], hn[3]);
                    *(u32x2*)(hb + (size_t)row * 1024 + col) = o;
                } else {
#if DBG_TIMEPH >= 0
                    { const unsigned long long* ts = (const unsigned long long*)(p.ws + OFF_CTL + 24576);
                      const float dt_us = (float)(ts[DBG_TIMEPH2] - ts[DBG_TIMEPH]) * 0.01f; hn = hn * (1.f + 1e-3f * dt_us); }
#endif
                    *(f32x4*)(p.xbuf + (size_t)row * 1024 + col) = hn;
                }
            }
        }
    }
}

__device__ __forceinline__ void phase_inproj(CKP& p, int l, unsigned char* lds) {
    const int tid = opaque_tid(), lane = tid & 63, w = tid >> 6, wm = w >> 1, wn = w & 1, fr = lane & 15, fq = lane >> 4;
    const bf16_t* A = (const bf16_t*)(p.ws + OFF_H);
    const bf16_t* Bt = (const bf16_t*)(p.ws + OFF_W + W_IN);
    unsigned char* R = p.ws + OFF_R;
    const int* pos = (const int*)p.in[1];
    constexpr int NTM = NTOK / 128, NTN = 17;
    for (int L = blockIdx.x; L < NTM * NTN; L += gridDim.x) {
        int tm, tn; tile_coords(L, NTM, NTN, tm, tn);
        const int m0 = tm * 128, n0 = tn * 128;
        f32x4 acc[4][4]; zero_acc(acc);
        gemm_kloop(acc, [&](int r) { return A + (size_t)(m0 + r) * 1024; }, 64, [&](int v) { return Bt + (size_t)(n0 + v) * 1024; }, 64, 16, lds, tid);
#pragma unroll
        for (int mi = 0; mi < 4; ++mi) {
            const int row = m0 + 64 * wm + 16 * mi + fr;
            const int cl = 64 * wn + 16 * fq;
            float v[16];
#pragma unroll
            for (int e = 0; e < 16; ++e) v[e] = acc[mi][e >> 2][e & 3];
            if (tn < 4) {
                store16bf((bf16_t*)(R + R_Q) + (size_t)row * 512 + n0 + cl, v);
            } else if (tn < 10) {
                const int seg = tn - 4;
                if (seg == 2 || seg == 4) {
                    if (fq == 0) {
                        const float ps = (float)pos[row];
#pragma unroll
                        for (int i = 0; i < 8; ++i) {
                            float sn, cs; sincosf(ps * p.inv_freq[i], &sn, &cs);
                            const float x1 = v[i], x2 = v[8 + i];
                            v[i] = x1 * cs - x2 * sn; v[8 + i] = x2 * cs + x1 * sn;
                        }
                    }
                }
                if (seg == 3 || seg == 5) {
                    bf16_t* dst = (bf16_t*)(R + (seg == 3 ? R_VST : R_VWT));
                    const int b = row >> 12, s = row & 4095, g = wn, d0 = 16 * fq;
#pragma unroll
                    for (int e = 0; e < 16; ++e) dst[((size_t)((b * 2 + g) * 64 + d0 + e)) * SEQ + s] = f2bf(v[e]);
                } else {
                    const size_t off = (seg == 0) ? R_KC : (seg == 1) ? R_VC : (seg == 2) ? R_KS : R_KW;
                    store16bf((bf16_t*)(R + off) + (size_t)row * 128 + cl, v);
                }
            } else if (tn == 10) {
                if (cl < 24) {
                    float* ng = (float*)(R + R_NG) + (size_t)row * 24 + cl;
#pragma unroll
                    for (int e = 0; e < 16; ++e) if (cl + e < 24) ng[e] = sigm(v[e]);
                }
            } else if (tn < 15) {
#pragma unroll
                for (int e = 0; e < 16; ++e) v[e] = gelu_tanh(v[e]);
                const int c512 = (tn - 11) * 128 + cl;
                if (c512 < 256) store16bf((bf16_t*)(R + R_U) + (size_t)row * 256 + c512, v);
                else store16bf((bf16_t*)(R + R_V) + (size_t)row * 256 + (c512 - 256), v);
            } else {
                store16bf((bf16_t*)(R + R_S5IN) + (size_t)row * 256 + (tn - 15) * 128 + cl, v);
            }
        }
    }
}

__device__ __forceinline__ void compress_tile(CKP& p, int job, unsigned char* lds) {
    job_fence();
    const int tid = opaque_tid(), lane = tid & 63, w = tid >> 6, wm = w >> 1, wn = w & 1, fr = lane & 15, fq = lane >> 4;
    const int kv = job >> 5, tm = job & 31, m0 = tm * 128;
    unsigned char* W = p.ws + OFF_W;
    const bf16_t* src = (const bf16_t*)(p.ws + OFF_R + (kv ? R_VC : R_KC));
    const bf16_t* W1 = (const bf16_t*)(W + W_C1) + (size_t)kv * 128 * 2048;
    const bf16_t* W2 = (const bf16_t*)(W + W_C2) + (size_t)kv * 64 * 128;
    const float* pb = (const float*)(W + W_PB) + kv * 128;
    f32x4 acc[4][4]; zero_acc(acc);
    gemm_kloop(acc, [&](int r) { int Rr = m0 + r; Rr = Rr < 4080 ? Rr : 4079; const int b = Rr / 510, rem = Rr % 510, c = rem >> 1, g = rem & 1;
                                 return src + ((size_t)(b * SEQ + 16 * c)) * 128 + g * 64; }, 128,
               [&](int v) { return W1 + (size_t)v * 2048; }, 64, 32, lds, tid);
#pragma unroll
    for (int mi = 0; mi < 4; ++mi) {
        const int row = 64 * wm + 16 * mi + fr; const int cb = 16 * fq;
        float v[16];
#pragma unroll
        for (int e = 0; e < 16; ++e) v[e] = gelu_tanh(acc[mi][e >> 2][e & 3] + pb[64 * wn + cb + e]);
        u32x4 a, b;
        a.x = pk_bf16(v[0], v[1]); a.y = pk_bf16(v[2], v[3]); a.z = pk_bf16(v[4], v[5]); a.w = pk_bf16(v[6], v[7]);
        b.x = pk_bf16(v[8], v[9]); b.y = pk_bf16(v[10], v[11]); b.z = pk_bf16(v[12], v[13]); b.w = pk_bf16(v[14], v[15]);
        *(u32x4*)(lds + wn * 16384 + row * 128 + (((2 * fq) ^ (row & 7)) << 4)) = a;
        *(u32x4*)(lds + wn * 16384 + row * 128 + (((2 * fq + 1) ^ (row & 7)) << 4)) = b;
    }
#pragma unroll
    for (int j = 0; j < 4; ++j) {
        const int pid = tid + 256 * j, row = pid >> 4, ch = pid & 15;
        const u32x4 v = *(const u32x4*)(W2 + row * 128 + ch * 8);
        *(u32x4*)(lds + 32768 + (ch >> 3) * 16384 + row * 128 + (((ch & 7) ^ (row & 7)) << 4)) = v;
    }
    __syncthreads();
    f32x4 a2[4][2];
#pragma unroll
    for (int i = 0; i < 4; ++i) { a2[i][0] = (f32x4){0.f, 0.f, 0.f, 0.f}; a2[i][1] = (f32x4){0.f, 0.f, 0.f, 0.f}; }
#pragma unroll
    for (int kt2 = 0; kt2 < 2; ++kt2)
#pragma unroll
        for (int ks = 0; ks < 2; ++ks) {
            bf16x8 af[4], bf[2];
#pragma unroll
            for (int mi = 0; mi < 4; ++mi) { const int row = 64 * wm + 16 * mi + fr; af[mi] = *(const bf16x8*)(lds + kt2 * 16384 + row * 128 + (((4 * ks + fq) ^ (row & 7)) << 4)); }
#pragma unroll
            for (int ni = 0; ni < 2; ++ni) { const int row = 32 * wn + 8 * (fr >> 2) + 4 * ni + (fr & 3); bf[ni] = *(const bf16x8*)(lds + 32768 + kt2 * 16384 + row * 128 + (((4 * ks + fq) ^ (row & 7)) << 4)); }
#pragma unroll
            for (int mi = 0; mi < 4; ++mi)
#pragma unroll
                for (int ni = 0; ni < 2; ++ni) a2[mi][ni] = mfma16(bf[ni], af[mi], a2[mi][ni]);
        }
    bf16_t* kcmp = (bf16_t*)(p.ws + OFF_C + C_KCMP);
    bf16_t* vct = (bf16_t*)(p.ws + OFF_C + C_VCT);
#pragma unroll
    for (int mi = 0; mi < 4; ++mi) {
        const int Rr = m0 + 64 * wm + 16 * mi + fr;
        if (Rr < 4080) {
            const int b = Rr / 510, rem = Rr % 510, c = rem >> 1, g = rem & 1, d0 = 32 * wn + 8 * fq;
            float v[8];
#pragma unroll
            for (int e = 0; e < 8; ++e) v[e] = a2[mi][e >> 2][e & 3];
            if (DBG_NOCSTORE) { if (v[0] == 123.456f) kcmp[0] = 1; }
            else if (kv == 0) {
                u32x4 o; o.x = pk_bf16(v[0], v[1]); o.y = pk_bf16(v[2], v[3]); o.z = pk_bf16(v[4], v[5]); o.w = pk_bf16(v[6], v[7]);
                *(u32x4*)(kcmp + ((size_t)(b * 256 + c)) * 128 + g * 64 + d0) = o;
                if (c == 254) *(u32x4*)(kcmp + ((size_t)(b * 256 + 255)) * 128 + g * 64 + d0) = (u32x4){0u, 0u, 0u, 0u};
            } else {
#pragma unroll
                for (int e = 0; e < 8; ++e) {
                    vct[((size_t)((b * 2 + g) * 64 + d0 + e)) * 256 + c] = f2bf(v[e]);
                    if (c == 254) vct[((size_t)((b * 2 + g) * 64 + d0 + e)) * 256 + 255] = 0;
                }
            }
        }
    }
    __syncthreads();
}

__device__ __forceinline__ void sgu_job(CKP& p, int l, int job, unsigned char* lds) {
    job_fence();
    const int tid = opaque_tid(), lane = tid & 63, w = tid >> 6, fr = lane & 15, fq = lane >> 4;
    const size_t tok0 = (size_t)job * 128;
    const bf16_t* V = (const bf16_t*)(p.ws + OFF_R + R_V) + tok0 * 256;
    const bf16_t* U = (const bf16_t*)(p.ws + OFF_R + R_U) + tok0 * 256;
    bf16_t* O = (bf16_t*)(p.ws + OFF_C + C_SGU) + tok0 * 256;
    const bf16_t* Wt = (const bf16_t*)(p.ws + OFF_W + W_SGU);
    const float* ng = p.in[11] + (size_t)l * 256;
    const float* bs = p.in[13] + (size_t)l * 512;
    __syncthreads();
    if (DBG_SGUCUT != 2) {
        const int s = tid >> 1, half = tid & 1;
        const bf16_t* src = V + (size_t)s * 256 + half * 128;
        float ss = 0.f;
#pragma unroll 4
        for (int j = 0; j < 16; ++j) {
            const u32x4 bb = *(const u32x4*)(src + j * 8);
            const unsigned uu[4] = {bb.x, bb.y, bb.z, bb.w};
#pragma unroll
            for (int q = 0; q < 4; ++q) { const float a = bflo(uu[q]), b2 = bfhi(uu[q]); ss += a * a + b2 * b2; }
        }
        ss += __shfl_xor(ss, 1);
        const float rstd = rsqrtf(ss * (1.f / 256.f) + RMS_EPS);
#pragma unroll 1
        for (int j = 0; j < 16; ++j) {
            const u32x4 bb = *(const u32x4*)(src + j * 8);
            const unsigned uu[4] = {bb.x, bb.y, bb.z, bb.w};
            const int cb = half * 128 + j * 8;
#pragma unroll
            for (int q = 0; q < 4; ++q) {
#pragma unroll
                for (int hh = 0; hh < 2; ++hh) {
                    const int c = cb + q * 2 + hh;
                    const float val = (hh ? bfhi(uu[q]) : bflo(uu[q])) * rstd * ng[c];
                    *(bf16_t*)(lds + c * 256 + ((((s >> 3) ^ (c & 15))) << 4) + (s & 7) * 2) = f2bf(val);
                }
            }
        }
    }
    __syncthreads();
    const int g = w;
#pragma unroll 1
    for (int th = 0; th < (DBG_SGUCUT == 1 ? 0 : 2); ++th) {
        f32x4 acc[4][4];
        zero_acc(acc);
#pragma unroll
        for (int ks = 0; ks < 4; ++ks) {
            if (32 * ks <= 64 * th + 63) {
                bf16x8 vf[4];
#pragma unroll
                for (int di = 0; di < 4; ++di) { const int c = 64 * g + 16 * di + fr; vf[di] = *(const bf16x8*)(lds + c * 256 + (((4 * ks + fq) ^ (c & 15)) << 4)); }
#pragma unroll
                for (int ti = 0; ti < 4; ++ti) {
                    const int t = 64 * th + 16 * ti + fr;
                    if (32 * ks <= 64 * th + 16 * ti + 15) {
                        const bf16x8 wf = *(const bf16x8*)(Wt + ((size_t)(g * 128 + t)) * 128 + 32 * ks + 8 * fq);
#pragma unroll
                        for (int di = 0; di < 4; ++di) acc[ti][di] = mfma16(vf[di], wf, acc[ti][di]);
                    }
                }
            }
        }
#pragma unroll
        for (int ti = 0; ti < 4; ++ti) {
            const int t = 64 * th + 16 * ti + fr; const float bb = bs[g * 128 + t];
#pragma unroll
            for (int di = 0; di < 4; ++di) {
                const int c = 64 * g + 16 * di + 4 * fq;
                const u32x2 uu = *(const u32x2*)(U + (size_t)t * 256 + c);
                u32x2 o;
                o.x = pk_bf16(bflo(uu.x) * (acc[ti][di][0] + bb), bfhi(uu.x) * (acc[ti][di][1] + bb));
                o.y = pk_bf16(bflo(uu.y) * (acc[ti][di][2] + bb), bfhi(uu.y) * (acc[ti][di][3] + bb));
                *(u32x2*)(O + (size_t)t * 256 + c) = o;
            }
        }
    }
    __syncthreads();
}

__device__ __forceinline__ void s5_job(CKP& p, int l, int jb, int pass, unsigned char* lds) {
    job_fence();
    const int tid = opaque_tid(), lane = tid & 63, w = tid >> 6, fr = lane & 15, fq = lane >> 4;
    const int id = ((jb * 4 + w) + DBG_IDROT) & 2047, seq = id >> 4, ch = id & 15, b = seq >> 4, g = seq & 15;
    unsigned char* W = p.ws + OFF_W;
    const float* ab = (const float*)(W + W_S5A) + (g * 64 + lane) * 2;
    float ar = ab[0], ai = ab[1];
    float br[16], bi[16];
    {
        const float* bb = (const float*)(W + W_S5B) + (size_t)(g * 64 + lane) * 32;
#pragma unroll
        for (int h = 0; h < 16; ++h) { br[h] = bb[h]; bi[h] = bb[16 + h]; }
    }
#if DBG_S5CONST >= 2
    { const float q = (float)(lane + 1) * 0.001f; ar = 0.99f - q; ai = 0.05f + q;
      for (int h = 0; h < 16; ++h) { br[h] = 0.01f * (float)(h + 1) + q; bi[h] = -0.02f * (float)(h + 1) + q; } }
#endif
    float* Eb = (float*)(p.ws + OFF_C + C_S5E);
    float hre = 0.f, him = 0.f;
    bf16x8 cf[4]; float dv[4];
    if (pass == 2) {
        const float* a2 = (const float*)(W + W_S5A256) + (g * 64 + lane) * 2;
        const float a2r = a2[0], a2i = a2[1];
        for (int c2 = 0; c2 < ch; ++c2) {
            const float* e = Eb + ((size_t)(seq * 16 + c2) * 64 + lane) * 2;
            const float nr = a2r * hre - a2i * him + e[0], ni = a2r * him + a2i * hre + e[1];
            hre = nr; him = ni;
        }
        const bf16_t* cm = (const bf16_t*)(W + W_S5C) + (size_t)(g * 16 + fr) * 128;
#pragma unroll
        for (int ks = 0; ks < 4; ++ks) cf[ks] = *(const bf16x8*)(cm + 32 * ks + 8 * fq);
#pragma unroll
        for (int r = 0; r < 4; ++r) dv[r] = p.in[22][(size_t)l * 256 + g * 16 + 4 * fq + r];
    }
    const bf16_t* xin = (const bf16_t*)(p.ws + OFF_R + R_S5IN) + ((size_t)(b * SEQ + ch * 256)) * 256 + g * 16;
    bf16_t* yg = (bf16_t*)(p.ws + OFF_C + C_YG) + ((size_t)(b * SEQ + ch * 256)) * 256 + g * 16;
    float* xs = (float*)(lds + w * 10240);
    int ldsbad = 0; (void)ldsbad;
    unsigned char* Hs = lds + w * 10240 + 2048;
#if DBG_TWICE
    float keep_re = 0.f, keep_im = 0.f;
#pragma unroll 1
    for (int rep = 0; rep < 2; ++rep) {
    if (rep == 1) { keep_re = hre; keep_im = him; hre = 0.f; him = 0.f; }
#endif
#pragma unroll 1
    for (int sub = 0; sub < 8; ++sub) {
#if DBG_S5CONST >= 1
        u32x4 xv; { const unsigned q = (unsigned)(sub * 32 + (lane >> 1)) * 2654435761u + (unsigned)id * 40503u + (lane & 1); xv.x = 0x3f803e80u ^ ((q & 0xff) << 16); xv.y = 0x3e003d00u ^ ((q >> 8) & 0x7f); xv.z = 0xbe803f00u ^ ((q >> 16) & 0x3f); xv.w = 0x3d80be00u; }
#else
        const u32x4 xv = *(const u32x4*)(xin + (size_t)(sub * 32 + (lane >> 1)) * 256 + (lane & 1) * 8);
#endif
        __syncthreads();
        f32x4 chk_a = {bflo(xv.x), bfhi(xv.x), bflo(xv.y), bfhi(xv.y)}, chk_c = {bflo(xv.z), bfhi(xv.z), bflo(xv.w), bfhi(xv.w)};
        {
            *(f32x4*)(xs + (lane >> 1) * 16 + (lane & 1) * 8) = chk_a;
            *(f32x4*)(xs + (lane >> 1) * 16 + (lane & 1) * 8 + 4) = chk_c;
        }
        __syncthreads();
#pragma unroll 4
        for (int st = 0; st < 32; ++st) {
#if DBG_S5CONST == 3
            f32x4 x0, x1, x2, x3;
            { const float t = (float)((sub * 32 + st) & 63) * 0.015625f + (float)(id & 7) * 0.125f;
              x0 = (f32x4){t, t * 0.5f, -t, 0.25f}; x1 = (f32x4){0.5f - t, t * t, 0.125f, t}; x2 = (f32x4){-0.25f, t, 0.75f * t, 1.f - t}; x3 = (f32x4){t, -t, 0.5f, 0.3f * t}; }
#else
            const f32x4 x0 = *(const f32x4*)(xs + st * 16), x1 = *(const f32x4*)(xs + st * 16 + 4), x2 = *(const f32x4*)(xs + st * 16 + 8), x3 = *(const f32x4*)(xs + st * 16 + 12);
#endif
            float ur = 0.f, ui = 0.f;
#pragma unroll
            for (int h = 0; h < 4; ++h) {
                ur += br[h] * x0[h]; ui += bi[h] * x0[h];
                ur += br[4 + h] * x1[h]; ui += bi[4 + h] * x1[h];
                ur += br[8 + h] * x2[h]; ui += bi[8 + h] * x2[h];
                ur += br[12 + h] * x3[h]; ui += bi[12 + h] * x3[h];
            }
            const float nr = ar * hre - ai * him + ur, ni = ar * him + ai * hre + ui;
            hre = nr; him = ni;
            if (pass == 2) {
                *(bf16_t*)(Hs + st * 256 + (((lane >> 3) ^ (st & 15)) << 4) + (lane & 7) * 2) = f2bf(hre);
                *(bf16_t*)(Hs + st * 256 + ((((64 + lane) >> 3) ^ (st & 15)) << 4) + (lane & 7) * 2) = f2bf(him);
            }
        }
#if DBG_LDSCHK
        {
            const f32x4 ra = *(volatile f32x4*)(xs + (lane >> 1) * 16 + (lane & 1) * 8), rc = *(volatile f32x4*)(xs + (lane >> 1) * 16 + (lane & 1) * 8 + 4);
            bool bad = false;
            for (int q = 0; q < 4; ++q) bad |= (__float_as_uint(ra[q]) != __float_as_uint(chk_a[q])) | (__float_as_uint(rc[q]) != __float_as_uint(chk_c[q]));
            if (__any(bad)) ldsbad = 1;
        }
#endif
        if (pass == 2) {
            __syncthreads();
#pragma unroll
            for (int tt = 0; tt < 2; ++tt) {
                f32x4 acc = {0.f, 0.f, 0.f, 0.f};
                const int tl = tt * 16 + fr;
#pragma unroll
                for (int ks = 0; ks < 4; ++ks) {
                    const bf16x8 hf = *(const bf16x8*)(Hs + tl * 256 + (((4 * ks + fq) ^ (tl & 15)) << 4));
                    acc = mfma16(cf[ks], hf, acc);
                }
                float y[4];
#pragma unroll
                for (int r = 0; r < 4; ++r) y[r] = gelu_tanh(acc[r] + dv[r] * xs[tl * 16 + 4 * fq + r]);
                u32x2 o; o.x = pk_bf16(y[0], y[1]); o.y = pk_bf16(y[2], y[3]);
                *(u32x2*)(yg + (size_t)(sub * 32 + tl) * 256 + 4 * fq) = o;
            }
        }
    }
#if DBG_TWICE
    }
    if (__float_as_uint(keep_re) != __float_as_uint(hre) || __float_as_uint(keep_im) != __float_as_uint(him)) { hre = __uint_as_float(0x7fc00000u); him = hre; }
#endif
    if (pass == 1) {
        float* e = Eb + ((size_t)(seq * 16 + ch) * 64 + lane) * 2;
#if DBG_LDSCHK
        if (ldsbad) { hre = __uint_as_float(0x7fc00000u); him = hre; }
#endif
#if DBG_ESC1
        { const unsigned long long pk = ((unsigned long long)__float_as_uint(him) << 32) | __float_as_uint(hre);
          __hip_atomic_store((unsigned long long*)e, pk, __ATOMIC_RELAXED, __HIP_MEMORY_SCOPE_AGENT); }
#else
        e[0] = hre; e[1] = him;
#endif
#if DBG_E2
        float* e2 = (float*)(p.ws + OFF_C + C_ATT) + ((size_t)(seq * 16 + ch) * 64 + lane) * 2;
        e2[0] = hre; e2[1] = him;
#endif
    }
    __syncthreads();
}

__device__ __forceinline__ void phase_mid1(CKP& p, int l, unsigned char* lds) {
#if DBG_QDELAY == 2
    if (blockIdx.x >= 320) return;
#elif DBG_QDELAY == 3
    if (blockIdx.x >= 320) {
        const unsigned long long t0 = __builtin_amdgcn_s_memrealtime(); while (__builtin_amdgcn_s_memrealtime() - t0 < 3000ull) __builtin_amdgcn_s_sleep(8);
        s5_job(p, l, blockIdx.x - 320, 1, lds);
        return;
    }
#elif DBG_QDELAY
    if (blockIdx.x >= 320) {
        s5_job(p, l, blockIdx.x - 320, 1, lds);
        const unsigned long long t0 = __builtin_amdgcn_s_memrealtime(); while (__builtin_amdgcn_s_memrealtime() - t0 < 6000ull) __builtin_amdgcn_s_sleep(8);
        return;
    }
#endif
    for (int j = blockIdx.x; j < 64 + 256 + 512; j += gridDim.x) {
#if DBG_ONLYS5 == 1
        if (j >= 320) s5_job(p, l, j - 320, 1, lds);
#elif DBG_ONLYS5 == 2
        if (j < 64) compress_tile(p, j, lds);
        else if (j >= 320) s5_job(p, l, j - 320, 1, lds);
#elif DBG_ONLYS5 == 4
        { const int jj = 831 - j; if (jj < 64) compress_tile(p, jj, lds); else if (jj >= 320) s5_job(p, l, jj - 320, 1, lds); }
#elif DBG_ONLYS5 == 5
        if (j < 64) compress_tile(p, j, lds);
        else if (j >= 320 && j < 512) s5_job(p, l, j - 320, 1, lds);
        else if (j >= 576) s5_job(p, l, j - 320, 1, lds);
        if (j >= 448 && j < 512) s5_job(p, l, j + 64 - 320, 1, lds);
#elif DBG_ONLYS5 == 3
        if (j >= 64 && j < 320) sgu_job(p, l, j - 64, lds);
        else if (j >= 320) s5_job(p, l, j - 320, 1, lds);
#elif DBG_ONLYS5 == 6
        if (j < 512) {
#if DBG_PRESPIN
            { const unsigned long long t0 = __builtin_amdgcn_s_memrealtime(); while (__builtin_amdgcn_s_memrealtime() - t0 < (unsigned long long)DBG_PRESPIN) __builtin_amdgcn_s_sleep(2); }
#endif
            s5_job(p, l, j, 1, lds);
        }
        else if (j < 768) sgu_job(p, l, j - 512, lds);
        else compress_tile(p, j - 768, lds);
#else
        if (j < 64) compress_tile(p, j, lds);
        else if (j < 320) {
#if DBG_SGUSPIN
            { const unsigned long long t0 = __builtin_amdgcn_s_memrealtime(); while (__builtin_amdgcn_s_memrealtime() - t0 < (unsigned long long)DBG_SGUSPIN) __builtin_amdgcn_s_sleep(2); }
#else
            sgu_job(p, l, j - 64, lds);
#endif
        } else {
#if DBG_DELAY
            if (j >= 576) { const unsigned long long t0 = __builtin_amdgcn_s_memrealtime(); while (__builtin_amdgcn_s_memrealtime() - t0 < (unsigned long long)DBG_DELAY) __builtin_amdgcn_s_sleep(8); }
#endif
            s5_job(p, l, j - 320, 1, lds);
        }
#endif
    }
}

constexpr int AL_Q = 0, AL_K = 32768, AL_V = 40960, AL_IMP = 49152, AL_SEL = 65792, AL_UNI = 66304, AL_JOB = 66336;
constexpr float SM_C = 0.125f * 1.4426950408889634f;

__device__ __forceinline__ void attn_load_q(const bf16_t* Qg, const int* pos, const float (&inv_freq)[8], int b, int g, int t0, bool rope, unsigned char* lds, int tid) {
#pragma unroll 1
    for (int j = 0; j < 8; ++j) {
        const int pid = tid + 256 * j, Rr = pid >> 3, ch = pid & 7;
        const int wq = Rr >> 6, r = (Rr >> 4) & 3, q = Rr & 15, t = t0 + 16 * wq + q;
        const bf16_t* src = Qg + ((size_t)(b * SEQ + t)) * 512 + (g * 4 + r) * 64;
        if (!rope || ch >= 2) {
            *(u32x4*)(lds + AL_Q + Rr * 128 + ((ch ^ (Rr & 7)) << 4)) = *(const u32x4*)(src + ch * 8);
        } else if (ch == 0) {
            const u32x4 a = *(const u32x4*)(src), c = *(const u32x4*)(src + 8);
            float x1[8] = {bflo(a.x), bfhi(a.x), bflo(a.y), bfhi(a.y), bflo(a.z), bfhi(a.z), bflo(a.w), bfhi(a.w)};
            float x2[8] = {bflo(c.x), bfhi(c.x), bflo(c.y), bfhi(c.y), bflo(c.z), bfhi(c.z), bflo(c.w), bfhi(c.w)};
            const float ps = (float)pos[b * SEQ + t];
#pragma unroll
            for (int i = 0; i < 8; ++i) {
                float sn, cs; sincosf(ps * inv_freq[i], &sn, &cs);
                const float u = x1[i], v = x2[i];
                x1[i] = u * cs - v * sn; x2[i] = v * cs + u * sn;
            }
            u32x4 o1, o2;
            o1.x = pk_bf16(x1[0], x1[1]); o1.y = pk_bf16(x1[2], x1[3]); o1.z = pk_bf16(x1[4], x1[5]); o1.w = pk_bf16(x1[6], x1[7]);
            o2.x = pk_bf16(x2[0], x2[1]); o2.y = pk_bf16(x2[2], x2[3]); o2.z = pk_bf16(x2[4], x2[5]); o2.w = pk_bf16(x2[6], x2[7]);
            *(u32x4*)(lds + AL_Q + Rr * 128 + ((0 ^ (Rr & 7)) << 4)) = o1;
            *(u32x4*)(lds + AL_Q + Rr * 128 + ((1 ^ (Rr & 7)) << 4)) = o2;
        }
    }
}
__device__ __forceinline__ void attn_load_kv(const bf16_t* Kb, const bf16_t* Vb, int vstride, unsigned char* lds, int tid) {
#pragma unroll
    for (int j = 0; j < 2; ++j) {
        const int pid = tid + 256 * j, row = pid >> 3, ch = pid & 7;
        const u32x4 kk = *(const u32x4*)(Kb + (size_t)row * 128 + ch * 8);
        const u32x4 vv = *(const u32x4*)(Vb + (size_t)row * vstride + ch * 8);
        *(u32x4*)(lds + AL_K + row * 128 + ((ch ^ (row & 7)) << 4)) = kk;
        *(u32x4*)(lds + AL_V + row * 128 + ((ch ^ ((row >> 1) & 7)) << 4)) = vv;
    }
}
__device__ __forceinline__ void attn_qk(f32x4 (&s)[2][4], const unsigned char* lds, int w, int fr, int fq, int hf) {
    const unsigned char* Qw = lds + AL_Q + w * 8192;
    const unsigned char* Kh = lds + AL_K + hf * 4096;
    const int sw0 = ((fq) ^ (fr & 7)) << 4, sw1 = ((4 + fq) ^ (fr & 7)) << 4;
#pragma unroll
    for (int ki = 0; ki < 2; ++ki)
#pragma unroll
        for (int qi = 0; qi < 4; ++qi) s[ki][qi] = (f32x4){0.f, 0.f, 0.f, 0.f};
#pragma unroll
    for (int ds = 0; ds < 2; ++ds) {
        bf16x8 qf[4];
#pragma unroll
        for (int qi = 0; qi < 4; ++qi) qf[qi] = *(const bf16x8*)(Qw + (qi * 16 + fr) * 128 + (ds ? sw1 : sw0));
#pragma unroll
        for (int ki = 0; ki < 2; ++ki) {
            const bf16x8 kf = *(const bf16x8*)(Kh + (ki * 16 + fr) * 128 + (ds ? sw1 : sw0));
#pragma unroll
            for (int qi = 0; qi < 4; ++qi) s[ki][qi] = mfma16(kf, qf[qi], s[ki][qi]);
        }
    }
}
__device__ __forceinline__ void attn_pv(f32x4 (&o)[4][4], const f32x4 (&s)[2][4], const unsigned char* lds, int fr, int fq, int hf) {
    bf16x8 pf[4];
#pragma unroll
    for (int qi = 0; qi < 4; ++qi) {
        u32x4 u;
        u.x = pk_bf16(s[0][qi][0], s[0][qi][1]); u.y = pk_bf16(s[0][qi][2], s[0][qi][3]);
        u.z = pk_bf16(s[1][qi][0], s[1][qi][1]); u.w = pk_bf16(s[1][qi][2], s[1][qi][3]);
        pf[qi] = as_bf8(u);
    }
    const int c0 = 4 * hf + (fq >> 1);
#pragma unroll
    for (int di = 0; di < 4; ++di) {
        const int row = di * 16 + fr, key = (row >> 1) & 7;
        const u32x2 lo = *(const u32x2*)(lds + AL_V + row * 128 + ((c0 ^ key) << 4) + 8 * (fq & 1));
        const u32x2 hi = *(const u32x2*)(lds + AL_V + row * 128 + (((c0 + 2) ^ key) << 4) + 8 * (fq & 1));
        const bf16x8 vf = as_bf8((u32x4){lo.x, lo.y, hi.x, hi.y});
#pragma unroll
        for (int qi = 0; qi < 4; ++qi) o[di][qi] = mfma16(vf, pf[qi], o[di][qi]);
    }
}
__device__ __forceinline__ unsigned attn_vmask(int kb, int fq, int lo, int hi) {
    unsigned vm = 0;
#pragma unroll
    for (int ki = 0; ki < 2; ++ki)
#pragma unroll
        for (int r = 0; r < 4; ++r) { const int key = kb + 16 * ki + 4 * fq + r; if (key >= lo && key <= hi) vm |= 1u << (ki * 4 + r); }
    return vm;
}
__device__ __forceinline__ void attn_softmax(f32x4 (&s)[2][4], f32x4 (&o)[4][4], float (&m)[4], float (&lsum)[4], unsigned vm) {
#pragma unroll
    for (int qi = 0; qi < 4; ++qi) {
        float mx = -1e30f;
#pragma unroll
        for (int ki = 0; ki < 2; ++ki)
#pragma unroll
            for (int r = 0; r < 4; ++r) { const float sv = ((vm >> (ki * 4 + r)) & 1u) ? s[ki][qi][r] * SM_C : -1e30f; s[ki][qi][r] = sv; mx = fmaxf(mx, sv); }
        mx = fmaxf(mx, __shfl_xor(mx, 16)); mx = fmaxf(mx, __shfl_xor(mx, 32));
        const float mn = fmaxf(m[qi], mx), alpha = fexp2(m[qi] - mn);
        m[qi] = mn;
        float ls = 0.f;
#pragma unroll
        for (int ki = 0; ki < 2; ++ki)
#pragma unroll
            for (int r = 0; r < 4; ++r) { const float pv = ((vm >> (ki * 4 + r)) & 1u) ? fexp2(s[ki][qi][r] - mn) : 0.f; s[ki][qi][r] = pv; ls += pv; }
        lsum[qi] = lsum[qi] * alpha + ls;
#pragma unroll
        for (int di = 0; di < 4; ++di) o[di][qi] *= alpha;
    }
}
__device__ __forceinline__ void attn_accum(bf16_t* dst, const f32x4 (&o)[4][4], const float (&lsum)[4], const float (&gate)[4], bool first, int fq) {
#pragma unroll
    for (int qi = 0; qi < 4; ++qi) {
        float lt = lsum[qi]; lt += __shfl_xor(lt, 16); lt += __shfl_xor(lt, 32);
        const float sc = gate[qi] / fmaxf(lt, 1e-30f);
#pragma unroll
        for (int di = 0; di < 4; ++di) {
            u32x2* ptr = (u32x2*)(dst + qi * 64 + 16 * di + 4 * fq);
            float a0 = o[di][qi][0] * sc, a1 = o[di][qi][1] * sc, a2 = o[di][qi][2] * sc, a3 = o[di][qi][3] * sc;
            if (!first) { const u32x2 f = *ptr; a0 += bflo(f.x); a1 += bfhi(f.x); a2 += bflo(f.y); a3 += bfhi(f.y); }
            u32x2 r; r.x = pk_bf16(a0, a1); r.y = pk_bf16(a2, a3);
            *ptr = r;
        }
    }
}

__device__ __forceinline__ void phase_attn(CKP& p, int l, unsigned char* lds, unsigned* ctl) {
    for (int j = blockIdx.x; j < 512; j += gridDim.x) s5_job(p, l, j, 2, lds);

    unsigned char* R = p.ws + OFF_R; unsigned char* C = p.ws + OFF_C;
    const bf16_t* Qg = (const bf16_t*)(R + R_Q);
    const bf16_t* Kc = (const bf16_t*)(C + C_KCMP); const bf16_t* Vc = (const bf16_t*)(C + C_VCT);
    const bf16_t* Ks = (const bf16_t*)(R + R_KS); const bf16_t* Vs = (const bf16_t*)(R + R_VST);
    const bf16_t* Kw = (const bf16_t*)(R + R_KW); const bf16_t* Vw = (const bf16_t*)(R + R_VWT);
    const float* NG = (const float*)(R + R_NG);
    bf16_t* AO = (bf16_t*)(C + C_ATT);
    const int* pos = (const int*)p.in[1];
    unsigned* ctr = ctl + CTL_ATTN + l;
    volatile int* jobp = (volatile int*)(lds + AL_JOB);
    float* imp = (float*)(lds + AL_IMP);
    unsigned long long* selm = (unsigned long long*)(lds + AL_SEL);
    unsigned long long* uni = (unsigned long long*)(lds + AL_UNI);
    float invf[8];
#pragma unroll
    for (int q = 0; q < 8; ++q) invf[q] = p.inv_freq[q];

    for (;;) {
        const int tid = opaque_tid(), lane = tid & 63, w = tid >> 6, fr = lane & 15, fq = lane >> 4;
        __syncthreads();
        if (tid == 0) *jobp = (int)atomicAdd(ctr, 1u);
        __syncthreads();
        const int job = *jobp;
        if (job >= 1024) break;
        const int i = 63 - (job >> 4), bg = job & 15, b = bg >> 1, g = bg & 1, t0 = i * 64;
        const int tq = t0 + 16 * w + fr;
        const size_t kvrow = (size_t)b * SEQ;
        float gate[4];
        bf16_t* dstq = AO + ((size_t)(kvrow + tq)) * 512 + (g * 4) * 64;

        attn_load_q(Qg, pos, invf, b, g, t0, false, lds, tid);
        const int ntc = ((4 * i + 2) >> 6) + 1;
        const int hic = (tq >= 31) ? ((tq - 31) >> 4) : -1;
        float m[4], lsum[4];
#pragma unroll
        for (int qi = 0; qi < 4; ++qi) { m[qi] = -1e30f; lsum[qi] = 0.f; }
        {
#pragma unroll 1
            for (int ct = 0; ct < ntc; ++ct) {
                __syncthreads();
                attn_load_kv(Kc + ((size_t)(b * 256 + ct * 64)) * 128 + g * 64, Vc + ((size_t)((b * 2 + g) * 64)) * 256 + ct * 64, 256, lds, tid);
                __syncthreads();
#pragma unroll 1
                for (int hf = 0; hf < 2; ++hf) {
                    f32x4 s[2][4];
                    attn_qk(s, lds, w, fr, fq, hf);
                    const unsigned vm = attn_vmask(ct * 64 + hf * 32, fq, 0, hic);
#pragma unroll
                    for (int qi = 0; qi < 4; ++qi) {
                        float mx = -1e30f;
#pragma unroll
                        for (int ki = 0; ki < 2; ++ki)
#pragma unroll
                            for (int r = 0; r < 4; ++r) { const float sv = ((vm >> (ki * 4 + r)) & 1u) ? s[ki][qi][r] * SM_C : -1e30f; s[ki][qi][r] = sv; mx = fmaxf(mx, sv); }
                        mx = fmaxf(mx, __shfl_xor(mx, 16)); mx = fmaxf(mx, __shfl_xor(mx, 32));
                        const float mn = fmaxf(m[qi], mx), alpha = fexp2(m[qi] - mn);
                        m[qi] = mn;
                        float ls = 0.f;
#pragma unroll
                        for (int ki = 0; ki < 2; ++ki)
#pragma unroll
                            for (int r = 0; r < 4; ++r) ls += ((vm >> (ki * 4 + r)) & 1u) ? fexp2(s[ki][qi][r] - mn) : 0.f;
                        lsum[qi] = lsum[qi] * alpha + ls;
                    }
                }
            }
        }
        float invl[4];
#pragma unroll
        for (int qi = 0; qi < 4; ++qi) { float lt = lsum[qi]; lt += __shfl_xor(lt, 16); lt += __shfl_xor(lt, 32); invl[qi] = 1.f / fmaxf(lt, 1e-30f); }
        {
            f32x4 o[4][4]; zero_acc(o);
            float carry = 0.f;
#pragma unroll 1
            for (int ct = 0; ct < ntc; ++ct) {
                __syncthreads();
                attn_load_kv(Kc + ((size_t)(b * 256 + ct * 64)) * 128 + g * 64, Vc + ((size_t)((b * 2 + g) * 64)) * 256 + ct * 64, 256, lds, tid);
                __syncthreads();
#pragma unroll 1
                for (int hf = 0; hf < 2; ++hf) {
                    f32x4 s[2][4];
                    attn_qk(s, lds, w, fr, fq, hf);
                    const unsigned vm = attn_vmask(ct * 64 + hf * 32, fq, 0, hic);
#pragma unroll
                    for (int qi = 0; qi < 4; ++qi)
#pragma unroll
                        for (int ki = 0; ki < 2; ++ki)
#pragma unroll
                            for (int r = 0; r < 4; ++r) s[ki][qi][r] = ((vm >> (ki * 4 + r)) & 1u) ? fexp2(s[ki][qi][r] * SM_C - m[qi]) * invl[qi] : 0.f;
#pragma unroll
                    for (int ki = 0; ki < 2; ++ki) {
                        float a = 0.f, bq = 0.f;
#pragma unroll
                        for (int qi = 0; qi < 4; ++qi) { a += s[ki][qi][0] + s[ki][qi][1] + s[ki][qi][2] + 0.5f * s[ki][qi][3]; bq += 0.5f * s[ki][qi][3]; }
                        const float up = __shfl(bq, (lane + 48) & 63);
                        const float wrap = __shfl(carry, (lane + 48) & 63);
                        a += (fq >= 1) ? up : wrap;
                        carry = bq;
                        imp[(16 * w + fr) * 65 + 16 * ct + 8 * hf + 4 * ki + fq] = a;
                    }
                    attn_pv(o, s, lds, fr, fq, hf);
                }
            }
#pragma unroll
            for (int qi = 0; qi < 4; ++qi) gate[qi] = NG[((size_t)(kvrow + tq)) * 24 + (g * 4 + qi) * 3 + 0];
            const float quarter[4] = {0.25f, 0.25f, 0.25f, 0.25f};
            attn_accum(dstq, o, quarter, gate, true, fq);
        }
        __syncthreads();
        {
            const int q = tid >> 2, part = tid & 3;
            unsigned long long mk = 0ull;
            if (i <= 15) { mk = (i == 63) ? ~0ull : ((1ull << (i + 1)) - 1ull); }
            else {
                const float* row = imp + q * 65;
                for (int j = 1 + part; j <= i - 2; j += 4) {
                    const float vj = row[j]; int rank = 0;
                    for (int j2 = 1; j2 <= i - 2; ++j2) { const float v2 = row[j2]; rank += (v2 > vj || (v2 == vj && j2 < j)) ? 1 : 0; }
                    if (rank < 13) mk |= 1ull << j;
                }
                unsigned lo32 = (unsigned)mk, hi32 = (unsigned)(mk >> 32);
                lo32 |= __shfl_xor(lo32, 1); hi32 |= __shfl_xor(hi32, 1);
                lo32 |= __shfl_xor(lo32, 2); hi32 |= __shfl_xor(hi32, 2);
                mk = ((unsigned long long)hi32 << 32) | lo32;
                mk |= 1ull | (1ull << i) | (1ull << (i - 1));
            }
            if (part == 0) selm[q] = mk;
            unsigned lo32 = (unsigned)mk, hi32 = (unsigned)(mk >> 32);
#pragma unroll
            for (int o2 = 32; o2 >= 1; o2 >>= 1) { lo32 |= __shfl_xor(lo32, o2); hi32 |= __shfl_xor(hi32, o2); }
            if (lane == 0) uni[w] = ((unsigned long long)hi32 << 32) | lo32;
        }
        __syncthreads();
        const unsigned long long mymask = selm[16 * w + fr];
        const unsigned long long un = uni[0] | uni[1] | uni[2] | uni[3];
        __syncthreads();
        attn_load_q(Qg, pos, invf, b, g, t0, true, lds, tid);
        {
            f32x4 o[4][4]; zero_acc(o);
#pragma unroll
            for (int qi = 0; qi < 4; ++qi) { m[qi] = -1e30f; lsum[qi] = 0.f; }
#pragma unroll 1
            for (int j = 0; j <= i; ++j) {
                if (!((un >> j) & 1ull)) continue;
                __syncthreads();
                attn_load_kv(Ks + (kvrow + j * 64) * 128 + g * 64, Vs + ((size_t)((b * 2 + g) * 64)) * SEQ + j * 64, SEQ, lds, tid);
                __syncthreads();
                const int hi = ((mymask >> j) & 1ull) ? tq : -1;
#pragma unroll 1
                for (int hf = 0; hf < 2; ++hf) {
                    f32x4 s[2][4];
                    attn_qk(s, lds, w, fr, fq, hf);
                    const unsigned vm = attn_vmask(j * 64 + hf * 32, fq, 0, hi);
                    attn_softmax(s, o, m, lsum, vm);
                    attn_pv(o, s, lds, fr, fq, hf);
                }
            }
#pragma unroll
            for (int qi = 0; qi < 4; ++qi) gate[qi] = NG[((size_t)(kvrow + tq)) * 24 + (g * 4 + qi) * 3 + 1];
            attn_accum(dstq, o, lsum, gate, false, fq);
        }
        {
            f32x4 o[4][4]; zero_acc(o);
#pragma unroll
            for (int qi = 0; qi < 4; ++qi) { m[qi] = -1e30f; lsum[qi] = 0.f; }
            const int j0 = (i >= 8) ? (i - 8) : 0;
#pragma unroll 1
            for (int j = j0; j <= i; ++j) {
                __syncthreads();
                attn_load_kv(Kw + (kvrow + j * 64) * 128 + g * 64, Vw + ((size_t)((b * 2 + g) * 64)) * SEQ + j * 64, SEQ, lds, tid);
                __syncthreads();
#pragma unroll 1
                for (int hf = 0; hf < 2; ++hf) {
                    f32x4 s[2][4];
                    attn_qk(s, lds, w, fr, fq, hf);
                    const unsigned vm = attn_vmask(j * 64 + hf * 32, fq, tq - 511, tq);
                    attn_softmax(s, o, m, lsum, vm);
                    attn_pv(o, s, lds, fr, fq, hf);
                }
            }
#pragma unroll
            for (int qi = 0; qi < 4; ++qi) gate[qi] = NG[((size_t)(kvrow + tq)) * 24 + (g * 4 + qi) * 3 + 2];
            attn_accum(dstq, o, lsum, gate, false, fq);
        }
    }
}

__device__ __forceinline__ void phase_glu(CKP& p, int l, unsigned char* lds) {
    const int tid = opaque_tid(), lane = tid & 63, w = tid >> 6, wm = w >> 1, wn = w & 1, fr = lane & 15, fq = lane >> 4;
    const bf16_t* A = (const bf16_t*)(p.ws + OFF_C + C_YG);
    const bf16_t* Bt = (const bf16_t*)(p.ws + OFF_W + W_GLU);
    bf16_t* O = (bf16_t*)(p.ws + OFF_C + C_S5O);
    const float* gb = p.in[24] + (size_t)l * 256;
    constexpr int NTM = NTOK / 128, NTN = 2;
    for (int L = blockIdx.x; L < NTM * NTN; L += gridDim.x) {
        int tm, tn; tile_coords(L, NTM, NTN, tm, tn);
        const int m0 = tm * 128, n0 = tn * 128;
        f32x4 acc[4][4]; zero_acc(acc);
        gemm_kloop(acc, [&](int r) { return A + (size_t)(m0 + r) * 256; }, 64, [&](int v) { return Bt + (size_t)(n0 + v) * 256; }, 64, 4, lds, tid);
#pragma unroll
        for (int mi = 0; mi < 4; ++mi) {
            const int row = m0 + 64 * wm + 16 * mi + fr, col = n0 + 64 * wn + 16 * fq;
            const u32x4 y0 = *(const u32x4*)(A + (size_t)row * 256 + col), y1 = *(const u32x4*)(A + (size_t)row * 256 + col + 8);
            const unsigned yy[8] = {y0.x, y0.y, y0.z, y0.w, y1.x, y1.y, y1.z, y1.w};
            float v[16];
#pragma unroll
            for (int e = 0; e < 16; ++e) {
                const float y = (e & 1) ? bfhi(yy[e >> 1]) : bflo(yy[e >> 1]);
                v[e] = y * sigm(acc[mi][e >> 2][e & 3] + gb[col + e]);
            }
            store16bf(O + (size_t)row * 256 + col, v);
        }
    }
}

__device__ __forceinline__ void phase_branch(CKP& p, int l, unsigned char* lds) {
    const int tid = opaque_tid(), lane = tid & 63, w = tid >> 6, wm = w >> 1, wn = w & 1, fr = lane & 15, fq = lane >> 4;
    const bf16_t* H = (const bf16_t*)(p.ws + OFF_H);
    const bf16_t* Wgb = (const bf16_t*)(p.ws + OFF_W + W_GB);
    bf16_t* Mg = (bf16_t*)(p.ws + OFF_M);
    bf16_t* Yt = (bf16_t*)(p.ws + OFF_R);
    constexpr int NTM = NTOK / 128, NTN = 8;
    for (int L = blockIdx.x; L < NTM * NTN; L += gridDim.x) {
        int tm, tn; tile_coords(L, NTM, NTN, tm, tn);
        const int m0 = tm * 128, n0 = tn * 128;
#pragma unroll 1
        for (int br = 0; br < 3; ++br) {
            const bf16_t* Ab; const bf16_t* Wb; int Kb;
            if (br == 0) { Ab = (const bf16_t*)(p.ws + OFF_C + C_ATT); Wb = (const bf16_t*)(p.ws + OFF_W + W_A); Kb = 512; }
            else if (br == 1) { Ab = (const bf16_t*)(p.ws + OFF_C + C_SGU); Wb = (const bf16_t*)(p.ws + OFF_W + W_S); Kb = 256; }
            else { Ab = (const bf16_t*)(p.ws + OFF_C + C_S5O); Wb = (const bf16_t*)(p.ws + OFF_W + W_5); Kb = 256; }
            {
                f32x4 acc[4][4]; zero_acc(acc);
                gemm_kloop(acc, [&](int r) { return Ab + (size_t)(m0 + r) * Kb; }, 64, [&](int v) { return Wb + (size_t)(n0 + v) * Kb; }, 64, Kb >> 6, lds, tid);
#pragma unroll
                for (int mi = 0; mi < 4; ++mi) {
                    const int row = m0 + 64 * wm + 16 * mi + fr, col = n0 + 64 * wn + 16 * fq;
                    float v[16];
#pragma unroll
                    for (int e = 0; e < 16; ++e) v[e] = acc[mi][e >> 2][e & 3];
                    store16bf(Yt + (size_t)row * 1024 + col, v);
                }
            }
            {
                f32x4 acc[4][4]; zero_acc(acc);
                gemm_kloop(acc, [&](int r) { return H + (size_t)(m0 + r) * 1024; }, 64, [&](int v) { return Wgb + (size_t)(br * 1024 + n0 + v) * 1024; }, 64, 16, lds, tid);
#pragma unroll
                for (int mi = 0; mi < 4; ++mi) {
                    const int row = m0 + 64 * wm + 16 * mi + fr, col = n0 + 64 * wn + 16 * fq;
                    u32x4* dst = (u32x4*)(Mg + (size_t)row * 1024 + col);
                    const u32x4* ysrc = (const u32x4*)(Yt + (size_t)row * 1024 + col);
                    const u32x4 y0 = ysrc[0], y1 = ysrc[1];
                    const unsigned yy[8] = {y0.x, y0.y, y0.z, y0.w, y1.x, y1.y, y1.z, y1.w};
                    unsigned pp[8] = {0u, 0u, 0u, 0u, 0u, 0u, 0u, 0u};
                    if (br > 0) { const u32x4 p0 = dst[0], p1 = dst[1]; pp[0] = p0.x; pp[1] = p0.y; pp[2] = p0.z; pp[3] = p0.w; pp[4] = p1.x; pp[5] = p1.y; pp[6] = p1.z; pp[7] = p1.w; }
                    unsigned outw[8];
#pragma unroll
                    for (int ni = 0; ni < 4; ++ni) {
                        const float a0 = sigm(acc[mi][ni][0]) * bflo(yy[2 * ni]) + bflo(pp[2 * ni]), a1 = sigm(acc[mi][ni][1]) * bfhi(yy[2 * ni]) + bfhi(pp[2 * ni]);
                        const float a2 = sigm(acc[mi][ni][2]) * bflo(yy[2 * ni + 1]) + bflo(pp[2 * ni + 1]), a3 = sigm(acc[mi][ni][3]) * bfhi(yy[2 * ni + 1]) + bfhi(pp[2 * ni + 1]);
                        outw[2 * ni] = pk_bf16(a0, a1); outw[2 * ni + 1] = pk_bf16(a2, a3);
                    }
                    dst[0] = (u32x4){outw[0], outw[1], outw[2], outw[3]};
                    dst[1] = (u32x4){outw[4], outw[5], outw[6], outw[7]};
                }
            }
        }
    }
}

__device__ __forceinline__ void phase_mix(CKP& p, int l, unsigned char* lds) {
    const int tid = opaque_tid(), lane = tid & 63, w = tid >> 6, wm = w >> 1, wn = w & 1, fr = lane & 15, fq = lane >> 4;
    const bf16_t* A = (const bf16_t*)(p.ws + OFF_M);
    const bf16_t* Bt = (const bf16_t*)(p.ws + OFF_W + W_M);
    constexpr int NTM = NTOK / 128, NTN = 8;
    for (int L = blockIdx.x; L < NTM * NTN; L += gridDim.x) {
        int tm, tn; tile_coords(L, NTM, NTN, tm, tn);
        const int m0 = tm * 128, n0 = tn * 128;
        f32x4 acc[4][4]; zero_acc(acc);
        gemm_kloop(acc, [&](int r) { return A + (size_t)(m0 + r) * 1024; }, 64, [&](int v) { return Bt + (size_t)(n0 + v) * 1024; }, 64, 16, lds, tid);
#pragma unroll
        for (int mi = 0; mi < 4; ++mi) {
            const int row = m0 + 64 * wm + 16 * mi + fr, col = n0 + 64 * wn + 16 * fq;
            float* xp = p.xbuf + (size_t)row * 1024 + col;
#pragma unroll
            for (int ni = 0; ni < 4; ++ni) { f32x4 xv = *(f32x4*)(xp + 4 * ni); xv += acc[mi][ni]; *(f32x4*)(xp + 4 * ni) = xv; }
        }
    }
}

__device__ __forceinline__ void phase_router(CKP& p, int l, unsigned char* lds, unsigned* ctl) {
    const int tid = opaque_tid(), lane = tid & 63, w = tid >> 6, wm = w >> 1, wn = w & 1, fr = lane & 15, fq = lane >> 4;
    const float* gam = p.in[27] + (size_t)l * 1024;
    const float* bg = p.in[29] + (size_t)l * 4;
    const float* be = p.in[31] + (size_t)l * 32;
    bf16_t* h2 = (bf16_t*)(p.ws + OFF_M);
    bf16_t* hlo = (bf16_t*)(p.ws + OFF_H);
    const bf16_t* Wh = (const bf16_t*)(p.ws + OFF_W + W_RH);
    const bf16_t* Wl = (const bf16_t*)(p.ws + OFF_W + W_RL);
    unsigned* cnt = ctl + CTL_MOECNT + l * 32;
    int* list = (int*)(p.ws + OFF_MOE + MOE_LIST);
    float* wsl = (float*)(p.ws + OFF_MOE + MOE_WS);
    float* lg = (float*)lds;
    int* lc = (int*)(lds + 18432); int* gbs = (int*)(lds + 18432 + 128);
    for (int tile = blockIdx.x; tile < NTOK / 128; tile += gridDim.x) {
        const int r0 = tile * 128;
        {
            f32x4 gv[4];
#pragma unroll
            for (int i = 0; i < 4; ++i) gv[i] = *(const f32x4*)(gam + 4 * lane + 256 * i);
            for (int rr = 0; rr < 32; rr += 2) {
                const int row = r0 + w * 32 + rr;
                f32x4 xa[4], xb[4]; float sa = 0.f, sb = 0.f;
#pragma unroll
                for (int i = 0; i < 4; ++i) { xa[i] = *(const f32x4*)(p.xbuf + (size_t)row * 1024 + 4 * lane + 256 * i); xb[i] = *(const f32x4*)(p.xbuf + (size_t)(row + 1) * 1024 + 4 * lane + 256 * i); }
#pragma unroll
                for (int i = 0; i < 4; ++i) { sa += xa[i][0] * xa[i][0] + xa[i][1] * xa[i][1] + xa[i][2] * xa[i][2] + xa[i][3] * xa[i][3]; sb += xb[i][0] * xb[i][0] + xb[i][1] * xb[i][1] + xb[i][2] * xb[i][2] + xb[i][3] * xb[i][3]; }
                sa = wave_sum(sa); sb = wave_sum(sb);
                const float ra_ = rsqrtf(sa * (1.f / 1024.f) + RMS_EPS), rb_ = rsqrtf(sb * (1.f / 1024.f) + RMS_EPS);
#pragma unroll
                for (int i = 0; i < 4; ++i) {
                    const f32x4 ha = xa[i] * ra_ * gv[i], hb = xb[i] * rb_ * gv[i];
                    u32x2 oa, ob, la, lb;
                    oa.x = pk_bf16(ha[0], ha[1]); oa.y = pk_bf16(ha[2], ha[3]); ob.x = pk_bf16(hb[0], hb[1]); ob.y = pk_bf16(hb[2], hb[3]);
                    la.x = pk_bf16(ha[0] - bflo(oa.x), ha[1] - bfhi(oa.x)); la.y = pk_bf16(ha[2] - bflo(oa.y), ha[3] - bfhi(oa.y));
                    lb.x = pk_bf16(hb[0] - bflo(ob.x), hb[1] - bfhi(ob.x)); lb.y = pk_bf16(hb[2] - bflo(ob.y), hb[3] - bfhi(ob.y));
                    *(u32x2*)(h2 + (size_t)row * 1024 + 4 * lane + 256 * i) = oa; *(u32x2*)(h2 + (size_t)(row + 1) * 1024 + 4 * lane + 256 * i) = ob;
                    *(u32x2*)(hlo + (size_t)row * 1024 + 4 * lane + 256 * i) = la; *(u32x2*)(hlo + (size_t)(row + 1) * 1024 + 4 * lane + 256 * i) = lb;
                }
            }
        }
        asm volatile("s_waitcnt vmcnt(0)" ::: "memory");
        __syncthreads();
        f32x4 acc[4][4]; zero_acc(acc);
        gemm_kloop(acc, [&](int r) { return h2 + (size_t)(r0 + r) * 1024; }, 64, [&](int v) { return Wh + (size_t)(v < 63 ? v : 63) * 1024; }, 64, 16, lds, tid);
        gemm_kloop(acc, [&](int r) { return h2 + (size_t)(r0 + r) * 1024; }, 64, [&](int v) { return Wl + (size_t)(v < 63 ? v : 63) * 1024; }, 64, 16, lds, tid);
        gemm_kloop(acc, [&](int r) { return hlo + (size_t)(r0 + r) * 1024; }, 64, [&](int v) { return Wh + (size_t)(v < 63 ? v : 63) * 1024; }, 64, 16, lds, tid);
        if (tid < 32) lc[tid] = 0;
        if (wn == 0 && fq < 3) {
#pragma unroll
            for (int mi = 0; mi < 4; ++mi) {
                const int row = 64 * wm + 16 * mi + fr;
#pragma unroll
                for (int e = 0; e < 16; ++e) { const int col = 16 * fq + e; if (col < 36) lg[row * 36 + col] = acc[mi][e >> 2][e & 3]; }
            }
        }
        __syncthreads();
        int e0 = 0, e1 = 0, lr0 = 0, lr1 = 0; float c0 = 0.f, c1 = 0.f;
        if (tid < 128) {
            const float* lrow = lg + tid * 36;
            float gl[4]; int grp = 0; float gm = -3.4e38f;
#pragma unroll
            for (int q = 0; q < 4; ++q) { gl[q] = lrow[q] + bg[q]; if (gl[q] > gm) { gm = gl[q]; grp = q; } }
            float gsum = 0.f;
#pragma unroll
            for (int q = 0; q < 4; ++q) gsum += expf(gl[q] - gm);
            const float grp_w = 1.f / gsum;
            float el[8]; float em = -3.4e38f;
#pragma unroll
            for (int q = 0; q < 8; ++q) { el[q] = lrow[4 + grp * 8 + q] + be[grp * 8 + q]; em = fmaxf(em, el[q]); }
            float esum = 0.f; float ep[8];
#pragma unroll
            for (int q = 0; q < 8; ++q) { ep[q] = expf(el[q] - em); esum += ep[q]; }
            int j0 = 0; float p0 = -1.f;
#pragma unroll
            for (int q = 0; q < 8; ++q) { const float pq = ep[q] / esum; ep[q] = pq; if (pq > p0) { p0 = pq; j0 = q; } }
            int j1 = 0; float p1 = -1.f;
#pragma unroll
            for (int q = 0; q < 8; ++q) { if (q != j0 && ep[q] > p1) { p1 = ep[q]; j1 = q; } }
            const float den = p0 + p1;
            c0 = grp_w * p0 / den; c1 = grp_w * p1 / den;
            e0 = grp * 8 + j0; e1 = grp * 8 + j1;
            lr0 = atomicAdd(&lc[e0], 1); lr1 = atomicAdd(&lc[e1], 1);
        }
        __syncthreads();
        if (tid < 32) { const int n = lc[tid]; gbs[tid] = n ? (int)atomicAdd(&cnt[tid], (unsigned)n) : 0; }
        __syncthreads();
        if (tid < 128) {
            const int tok = r0 + tid;
            list[e0 * 32768 + gbs[e0] + lr0] = tok * 2; list[e1 * 32768 + gbs[e1] + lr1] = tok * 2 + 1;
            wsl[tok * 2] = c0; wsl[tok * 2 + 1] = c1;
        }
        __syncthreads();
    }
}

__device__ __forceinline__ bool moe_tile(const unsigned* cnt, int L, int nsub, int& e, int& mt, int& sub, int& rowbase, int& n) {
    int acc = 0, rb = 0;
    for (int q = 0; q < 32; ++q) {
        const int c = (int)cnt[q], nt = (c + 127) >> 7, tot = nt * nsub;
        if (L < acc + tot) { const int r = L - acc; e = q; mt = r / nsub; sub = r % nsub; rowbase = rb; n = c; return true; }
        acc += tot; rb += nt * 128;
    }
    return false;
}
__device__ __forceinline__ void phase_exp1(CKP& p, int l, unsigned char* lds, unsigned* ctl) {
    const int tid = opaque_tid(), lane = tid & 63, w = tid >> 6, wm = w >> 1, wn = w & 1, fr = lane & 15, fq = lane >> 4;
    const unsigned* cnt = ctl + CTL_MOECNT + l * 32;
    const int* list = (const int*)(p.ws + OFF_MOE + MOE_LIST);
    const bf16_t* h2 = (const bf16_t*)(p.ws + OFF_M);
    bf16_t* hid = (bf16_t*)(p.ws + OFF_HID);
    for (int L = blockIdx.x;; L += gridDim.x) {
        int e, mt, sub, rowbase, n;
        if (!moe_tile(cnt, L, 8, e, mt, sub, rowbase, n)) break;
        const bf16_t* Wg = (const bf16_t*)(p.ws + OFF_W + W_EG) + (size_t)e * 512 * 1024;
        const bf16_t* Wu = (const bf16_t*)(p.ws + OFF_W + W_EU) + (size_t)e * 512 * 1024;
        const int j0 = sub * 64;
        f32x4 acc[4][4]; zero_acc(acc);
        gemm_kloop(acc, [&](int r) { int s = mt * 128 + r; s = s < n ? s : n - 1; const int slot = list[e * 32768 + s]; return h2 + (size_t)(slot >> 1) * 1024; }, 64,
                   [&](int v) { const int wn_ = v >> 6, fq_ = (v >> 4) & 3, ee = v & 15; const int hc = j0 + 32 * wn_ + 8 * fq_ + (ee & 7);
                                return ((ee >> 3) ? Wu : Wg) + (size_t)hc * 1024; }, 64, 16, lds, tid);
#pragma unroll
        for (int mi = 0; mi < 4; ++mi) {
            const int r = mt * 128 + 64 * wm + 16 * mi + fr;
            if (r < n) {
                float gv[8], uv[8];
#pragma unroll
                for (int e2 = 0; e2 < 8; ++e2) { gv[e2] = acc[mi][e2 >> 2][e2 & 3]; uv[e2] = acc[mi][2 + (e2 >> 2)][e2 & 3]; }
                float hv[8];
#pragma unroll
                for (int e2 = 0; e2 < 8; ++e2) hv[e2] = gv[e2] * sigm(gv[e2]) * uv[e2];
                u32x4 o; o.x = pk_bf16(hv[0], hv[1]); o.y = pk_bf16(hv[2], hv[3]); o.z = pk_bf16(hv[4], hv[5]); o.w = pk_bf16(hv[6], hv[7]);
                *(u32x4*)(hid + (size_t)(rowbase + r) * 512 + j0 + 32 * wn + 8 * fq) = o;
            }
        }
    }
}
__device__ __forceinline__ void phase_exp2(CKP& p, int l, unsigned char* lds, unsigned* ctl) {
    const int tid = opaque_tid(), lane = tid & 63, w = tid >> 6, wm = w >> 1, wn = w & 1, fr = lane & 15, fq = lane >> 4;
    const unsigned* cnt = ctl + CTL_MOECNT + l * 32;
    const int* list = (const int*)(p.ws + OFF_MOE + MOE_LIST);
    const float* wsl = (const float*)(p.ws + OFF_MOE + MOE_WS);
    const bf16_t* hid = (const bf16_t*)(p.ws + OFF_HID);
    bf16_t* ys = (bf16_t*)(p.ws + OFF_YS);
    for (int L = blockIdx.x;; L += gridDim.x) {
        int e, mt, sub, rowbase, n;
        if (!moe_tile(cnt, L, 8, e, mt, sub, rowbase, n)) break;
        const bf16_t* Wd = (const bf16_t*)(p.ws + OFF_W + W_ED) + (size_t)e * 1024 * 512;
        const int n0 = sub * 128;
        f32x4 acc[4][4]; zero_acc(acc);
        gemm_kloop(acc, [&](int r) { int s = mt * 128 + r; s = s < n ? s : n - 1; return hid + (size_t)(rowbase + s) * 512; }, 64,
                   [&](int v) { return Wd + (size_t)(n0 + v) * 512; }, 64, 8, lds, tid);
#pragma unroll
        for (int mi = 0; mi < 4; ++mi) {
            const int r = mt * 128 + 64 * wm + 16 * mi + fr;
            if (r < n) {
                const int slot = list[e * 32768 + r]; const float wt = wsl[slot];
                float v[16];
#pragma unroll
                for (int e2 = 0; e2 < 16; ++e2) v[e2] = acc[mi][e2 >> 2][e2 & 3] * wt;
                store16bf(ys + (size_t)slot * 1024 + n0 + 64 * wn + 16 * fq, v);
            }
        }
    }
}

constexpr int PH_PER_LAYER = 10;
constexpr int NPHASE = PH_PER_LAYER * DEPTH + 1;

__global__ __attribute__((target("no-packed-fp32-ops"))) void __launch_bounds__(NTHR, 2) mega(KP p_unused) {
    extern __shared__ __attribute__((aligned(16))) unsigned char lds[];
    unsigned* ctl = (unsigned*)(p_unused.ws + OFF_CTL);
#if ONE_LAUNCH
    XcdBarrier xb = xcd_barrier_post(ctl + CTL_BAR, (volatile LAS unsigned*)(lds + LDS_BAR));
    if (p_unused.never) cg::this_grid().sync();
#if DBG_PREFLUSH
    __builtin_amdgcn_fence(__ATOMIC_RELEASE, "");
    asm volatile("s_waitcnt vmcnt(0)" ::: "memory");
    __builtin_amdgcn_fence(__ATOMIC_ACQUIRE, "");
    asm volatile("s_waitcnt vmcnt(0)" ::: "memory");
    xcd_barrier(xb);
    { const unsigned long long t0 = __builtin_amdgcn_s_memrealtime(); while (__builtin_amdgcn_s_memrealtime() - t0 < 20000ull) __builtin_amdgcn_s_sleep(8); }
    xcd_barrier(xb);
#endif
#endif
    CKP* kp0 = (CKP*)__builtin_amdgcn_kernarg_segment_ptr();
    const int ph_lo = kp0->ph_lo, ph_hi = kp0->ph_hi;
#if ONE_LAUNCH
#define PH_SYNC(PH) if ((PH) + 1 < ph_hi) xcd_barrier(xb);
#else
#define PH_SYNC(PH)
#endif
#if DBG_TIMEPH >= 0
#define PH_STAMP(PH) if (blockIdx.x == 0 && threadIdx.x == 0) ((unsigned long long*)(kp0->ws + OFF_CTL + 24576))[(PH)] = __builtin_amdgcn_s_memrealtime();
#else
#define PH_STAMP(PH)
#endif
#define RUN_PHASE(PH, CALL) if (ph_lo <= (PH) && (PH) < ph_hi) { PH_STAMP(PH) CKP* kp = kp0; asm volatile("" : "+s"(kp)); CKP& p = *kp; const int rep_ = 0; (void)rep_; CALL; \
    if ((PH) == DBG_REPEAT_PH) { xcd_barrier(xb); const int rep_ = 1; (void)rep_; CALL; } PH_SYNC(PH) }
#define RUN_LAYER(L) \
    RUN_PHASE((L) * 10 + 0, phase_prep(p, (L), lds)) \
    RUN_PHASE((L) * 10 + 1, phase_inproj(p, (L), lds)) \
    RUN_PHASE((L) * 10 + 2, phase_mid1(p, (L), lds)) \
    RUN_PHASE((L) * 10 + 3, phase_attn(p, (L), lds, ctl + 2 * rep_)) \
    RUN_PHASE((L) * 10 + 4, phase_glu(p, (L), lds)) \
    RUN_PHASE((L) * 10 + 5, phase_branch(p, (L), lds)) \
    RUN_PHASE((L) * 10 + 6, phase_mix(p, (L), lds)) \
    RUN_PHASE((L) * 10 + 7, phase_router(p, (L), lds, ctl)) \
    RUN_PHASE((L) * 10 + 8, phase_exp1(p, (L), lds, ctl)) \
    RUN_PHASE((L) * 10 + 9, phase_exp2(p, (L), lds, ctl))
#if DBG_SMALLK
    RUN_PHASE(0, phase_prep(p, 0, lds))
    RUN_PHASE(1, phase_inproj(p, 0, lds))
    RUN_PHASE(2, phase_mid1(p, 0, lds))
#else
    RUN_LAYER(0)
    RUN_LAYER(1)
    RUN_PHASE(20, phase_prep(p, 2, lds))
#endif
#if ONE_LAUNCH && DBG_DUMP
    {
        xcd_barrier(xb);
        CKP* kp = kp0; asm volatile("" : "+s"(kp)); CKP& p = *kp;
        const size_t NO = (size_t)NTOK * 1024;
        const unsigned char* src = p.ws + DBG_DUMP_OFF;
        for (size_t i = (size_t)blockIdx.x * NTHR + threadIdx.x; i < NO; i += (size_t)gridDim.x * NTHR) {
            float v = 0.f;
            if (i < (size_t)DBG_DUMP_N) {
                if (DBG_DUMP_F32) {
                    const size_t si = DBG_DUMP_REV ? ((size_t)DBG_DUMP_N - 1 - i) : i;
#if DBG_SC1READ
                    const unsigned fu = __hip_atomic_load((const unsigned*)src + si, __ATOMIC_RELAXED, __HIP_MEMORY_SCOPE_SYSTEM); const float f = __uint_as_float(fu);
#else
                    const float f = ((const float*)src)[si];
#endif
                    v = DBG_HASH ? (float)(__float_as_uint(f) & 0x3ff) : f;
#if DBG_EFILT
                    { const int id_ = (int)(((si >> 7) - DBG_IDROT) & 2047), blk = ((id_ >> 2) + 320) & 511; if (!(blk >= DBG_EFILT_LO && blk < DBG_EFILT_HI)) v = 0.f; }
#endif
#if DBG_E2
                    { const float f2 = ((const float*)(p.ws + OFF_C + C_ATT))[i]; v = (__float_as_uint(f2) == __float_as_uint(f)) ? 0.f : 1000.f; if (i == 0) v += 1.f; }
#endif
                }
                else { const bf16_t h = ((const bf16_t*)src)[i]; v = DBG_HASH ? (float)(h & 0x3ff) : bf2f(h); }
            }
#if DBG_CONSTOUT
            v = 1000.f + (float)(i & 1023);
#endif
            p.xbuf[i] = v;
        }
    }
#endif
}

#if DBG_DUMP
__global__ void dbg_dump(const bf16_t* src, size_t n, float* out, size_t nout) {
    for (size_t i = (size_t)blockIdx.x * blockDim.x + threadIdx.x; i < nout; i += (size_t)gridDim.x * blockDim.x)
        out[i] = i < n ? (DBG_HASH ? (float)(src[i] & 0x3ff) : bf2f(src[i])) : 0.f;
}
__global__ void dbg_dump_f32(const float* src, size_t n, float* out, size_t nout) {
    for (size_t i = (size_t)blockIdx.x * blockDim.x + threadIdx.x; i < nout; i += (size_t)gridDim.x * blockDim.x)
        out[i] = i < n ? (DBG_HASH ? (float)(__float_as_uint(src[i]) & 0x3ff) : src[i]) : 0.f;
}
#endif
extern "C" void kernel_launch(void* const* d_in, const int* in_sizes, int n_in, void* d_out, int out_size, void* d_ws, size_t ws_size, hipStream_t stream) {
    static int grid = 0;
    if (grid == 0) {
        if (n_in != 36 || out_size != NTOK * DM || ws_size < WS_END) { fprintf(stderr, "kernel_launch: unexpected shapes n_in %d out %d ws %zu (need %zu)\n", n_in, out_size, ws_size, (size_t)WS_END); grid = -1; return; }
        int dev = 0, cus = 0, per_cu = 0;
        hipGetDevice(&dev);
        hipDeviceGetAttribute(&cus, hipDeviceAttributeMultiprocessorCount, dev);
        hipFuncSetAttribute((const void*)mega, hipFuncAttributeMaxDynamicSharedMemorySize, LDS_BYTES);
        hipOccupancyMaxActiveBlocksPerMultiprocessor(&per_cu, (const void*)mega, NTHR, LDS_BYTES);
        if (per_cu < 1) { fprintf(stderr, "kernel_launch: occupancy query says %d\n", per_cu); per_cu = 1; }
        if (per_cu > MAX_PER_CU) per_cu = MAX_PER_CU;
        grid = cus * per_cu;
        fprintf(stderr, "kernel_launch: grid %d (%d CUs x %d)\n", grid, cus, per_cu);
    }
    if (grid < 0) return;
    hipMemsetAsync((char*)d_ws + OFF_CTL, 0, CTL_BYTES, stream);
    KP p{};
    for (int i = 0; i < 36; ++i) p.in[i] = (const float*)d_in[i];
    p.xbuf = (float*)d_out; p.ws = (unsigned char*)d_ws;
    for (int i = 0; i < 8; ++i) p.inv_freq[i] = (float)pow(500000.0, -(double)i / 8.0);
    p.never = 0; p.pad = 0;
#if ONE_LAUNCH
    p.ph_lo = 0; p.ph_hi = DBG_PH_HI;
    void* args[] = {&p};
    hipError_t e = hipLaunchCooperativeKernel((const void*)mega, dim3(grid), dim3(NTHR), args, LDS_BYTES, stream);
    if (e != hipSuccess) fprintf(stderr, "cooperative launch failed: %s (grid %d)\n", hipGetErrorString(e), grid);
#else
    for (int ph = 0; ph < NPHASE; ++ph) {
        if (!((DBG_MASK >> ph) & 1)) continue;
        p.ph_lo = ph; p.ph_hi = ph + 1;
        hipLaunchKernelGGL(mega, dim3(grid), dim3(NTHR), LDS_BYTES, stream, p);
    }
#if DBG_DUMP
    {
        const unsigned char* w = (const unsigned char*)d_ws; const size_t NO = (size_t)NTOK * 1024;
        size_t off = 0, n = 0; bool f32 = false;
        switch (DBG_DUMP) {
            case 1: off = OFF_C + C_ATT; n = (size_t)NTOK * 512; break;
            case 2: off = OFF_C + C_SGU; n = (size_t)NTOK * 256; break;
            case 3: off = OFF_C + C_S5O; n = (size_t)NTOK * 256; break;
            case 4: off = OFF_M; n = (size_t)NTOK * 1024; break;
            case 5: off = OFF_R + R_Q; n = (size_t)NTOK * 512; break;
            case 6: off = OFF_H; n = (size_t)NTOK * 1024; break;
            case 7: off = OFF_C + C_YG; n = (size_t)NTOK * 256; break;
            case 8: off = OFF_C + C_KCMP; n = (size_t)2 * 524288 / 2; break;
            case 9: off = OFF_R + R_KC; n = (size_t)NTOK * 128 * 6; break;
            case 10: off = OFF_R + R_NG; n = (size_t)NTOK * 24; f32 = true; break;
            case 11: off = OFF_R + R_U; n = (size_t)NTOK * 768; break;
            case 12: off = OFF_C + C_S5E; n = (size_t)128 * 16 * 64 * 2; f32 = true; break;
            case 15: off = 0; n = (size_t)NTOK * 1024; f32 = true; break;
            case 16: off = OFF_W + W_S5A; n = 36864; f32 = true; break;
            case 13: off = OFF_YS; n = (size_t)NTOK * 1024; break;
            case 14: off = OFF_MOE + MOE_WS; n = 65536; f32 = true; break;
            default: break;
        }
        if (DBG_DUMP == 15) hipLaunchKernelGGL(dbg_dump_f32, dim3(2048), dim3(256), 0, stream, (const float*)d_out, n, (float*)d_out, NO);
        else if (f32) hipLaunchKernelGGL(dbg_dump_f32, dim3(2048), dim3(256), 0, stream, (const float*)(w + off), n, (float*)d_out, NO);
        else hipLaunchKernelGGL(dbg_dump, dim3(2048), dim3(256), 0, stream, (const bf16_t*)(w + off), n, (float*)d_out, NO);
    }
#endif
#endif
}
```

```cpp
#include <hip/hip_runtime.h>
#include <hip/hip_cooperative_groups.h>
#include <cstdio>
#include <cstdint>
#include <cmath>
namespace cg = cooperative_groups;

#ifndef ONE_LAUNCH
#define ONE_LAUNCH 1
#endif
#ifndef DBG_MASK
#define DBG_MASK 0x1fffff
#endif
#ifndef DBG_NOCOMBINE
#define DBG_NOCOMBINE 0
#endif
#ifndef DBG_DUMP
#define DBG_DUMP 0
#endif
#ifndef DBG_HASH
#define DBG_HASH 0
#endif
#ifndef DBG_ONLYS5
#define DBG_ONLYS5 0
#endif
#ifndef DBG_NOCSTORE
#define DBG_NOCSTORE 0
#endif
#ifndef DBG_LDSCHK
#define DBG_LDSCHK 0
#endif
#ifndef DBG_TWICE
#define DBG_TWICE 0
#endif
#ifndef DBG_S5CONST
#define DBG_S5CONST 0
#endif
#ifndef DBG_SC1READ
#define DBG_SC1READ 0
#endif
#ifndef DBG_E2
#define DBG_E2 0
#endif
#ifndef DBG_JOBFENCE
#define DBG_JOBFENCE 0
#endif
#ifndef DBG_CONSTOUT
#define DBG_CONSTOUT 0
#endif
#ifndef DBG_QDELAY
#define DBG_QDELAY 0
#endif
#ifndef DBG_SMALLK
#define DBG_SMALLK 0
#endif
#ifndef DBG_REPEAT_PH
#define DBG_REPEAT_PH -1
#endif
#ifndef DBG_TIMEPH
#define DBG_TIMEPH -1
#endif
#ifndef DBG_TIMEPH2
#define DBG_TIMEPH2 (DBG_TIMEPH + 1)
#endif
#ifndef DBG_PRESPIN
#define DBG_PRESPIN 0
#endif
#ifndef DBG_SGUSPIN
#define DBG_SGUSPIN 0
#endif
#ifndef DBG_PREFLUSH
#define DBG_PREFLUSH 0
#endif
#ifndef DBG_ESC1
#define DBG_ESC1 0
#endif
#ifndef DBG_DELAY
#define DBG_DELAY 0
#endif
#ifndef DBG_IDROT
#define DBG_IDROT 0
#endif
#ifndef DBG_DUMP_REV
#define DBG_DUMP_REV 0
#endif
#ifndef DBG_SGUCUT
#define DBG_SGUCUT 0
#endif
#ifndef DBG_EFILT
#define DBG_EFILT 0
#define DBG_EFILT_LO 0
#define DBG_EFILT_HI 0
#endif
#ifndef DBG_DUMP_OFF
#define DBG_DUMP_OFF 0
#define DBG_DUMP_N 0
#define DBG_DUMP_F32 0
#endif
#ifndef DBG_PH_HI
#define DBG_PH_HI NPHASE
#endif

typedef unsigned short bf16_t;
typedef short bf16x8 __attribute__((ext_vector_type(8)));
typedef float f32x4 __attribute__((ext_vector_type(4)));
typedef unsigned u32x4 __attribute__((ext_vector_type(4)));
typedef unsigned u32x2 __attribute__((ext_vector_type(2)));

constexpr int DM = 1024, NB = 8, SEQ = 4096, NTOK = NB * SEQ, DEPTH = 2;
constexpr int NCMP = 255;
constexpr float RMS_EPS = 1e-6f;
constexpr int NTHR = 256;
constexpr int LDS_BAR = 67584;
#ifndef MAX_PER_CU
#define MAX_PER_CU 2
#endif
#ifndef LDS_TOTAL
#define LDS_TOTAL (67584 + 64)
#endif
constexpr int LDS_BYTES = LDS_TOTAL;

constexpr size_t OFF_CTL = 0;
constexpr size_t OFF_W = 65536;
constexpr size_t W_IN = 0, W_GB = 4456448, W_A = 10747904, W_S = 11796480, W_5 = 12320768, W_M = 12845056, W_GLU = 14942208,
                 W_C1 = 15073280, W_C2 = 16121856, W_PB = 16154624, W_SGU = 16155648, W_S5A = 16286720, W_S5A256 = 16294912,
                 W_S5B = 16303104, W_S5C = 16434176, W_RH = 16499712, W_RL = 16630784, W_EG = 16777216, W_EU = 50331648, W_ED = 83886080, W_END = 117440512;
constexpr size_t OFF_H = OFF_W + W_END;
constexpr size_t OFF_M = OFF_H + 67108864;
constexpr size_t OFF_R = OFF_M + 67108864;
constexpr size_t R_Q = 0, R_KC = 33554432, R_VC = 41943040, R_KS = 50331648, R_KW = 58720256, R_VST = 67108864, R_VWT = 75497472,
                 R_NG = 83886080, R_U = 87031808, R_V = 103809024, R_S5IN = 120586240, R_END = 137363456;
constexpr size_t OFF_C = OFF_R + R_END;
constexpr size_t C_ATT = 0, C_SGU = 33554432, C_YG = 50331648, C_S5O = 67108864, C_KCMP = 83886080, C_VCT = 84410368, C_S5E = 84934656, C_END = 85983232;
constexpr size_t OFF_MOE = OFF_C + C_END;
constexpr size_t MOE_LIST = 0, MOE_WS = 4194304, MOE_END = 4456448;
constexpr size_t WS_END = OFF_MOE + MOE_END;
constexpr size_t OFF_HID = OFF_R;
constexpr size_t OFF_YS = OFF_R + 71303168;
static_assert(OFF_YS + 134217728 <= OFF_C + C_KCMP, "alias overflow");

constexpr int CTL_BAR = 0;
constexpr int CTL_MOECNT = 4096;
constexpr int CTL_ATTN = 4096 + 64;
constexpr int CTL_BYTES = 32768;

struct KP {
    const float* in[36];
    float* xbuf;
    unsigned char* ws;
    float inv_freq[8];
    int ph_lo, ph_hi;
    int never;
    int pad;
};

typedef const KP __attribute__((address_space(4))) CKP;

typedef float f32x2_t __attribute__((ext_vector_type(2)));
typedef __bf16 bf16x2_t __attribute__((ext_vector_type(2)));
__device__ __forceinline__ unsigned pk_bf16(float lo, float hi) {
    const f32x2_t v = {lo, hi};
    union { bf16x2_t b; unsigned u; } x; x.b = __builtin_convertvector(v, bf16x2_t); return x.u;
}
__device__ __forceinline__ bf16_t f2bf(float f) { return (bf16_t)(pk_bf16(f, 0.f) & 0xffffu); }
__device__ __forceinline__ float bf2f(bf16_t b) { return __uint_as_float(((unsigned)b) << 16); }
__device__ __forceinline__ float bflo(unsigned u) { return __uint_as_float(u << 16); }
__device__ __forceinline__ float bfhi(unsigned u) { return __uint_as_float(u & 0xffff0000u); }
__device__ __forceinline__ float fexp2(float x) { return __builtin_amdgcn_exp2f(x); }
__device__ __forceinline__ float gelu_tanh(float x) {
    const float u = 0.7978845608028654f * (x + 0.044715f * x * x * x);
    const float e = __expf(2.f * u);
    const float t = 1.f - 2.f / (e + 1.f);
    return 0.5f * x * (1.f + t);
}
__device__ __forceinline__ float sigm(float x) { return 1.f / (1.f + __expf(-x)); }
__device__ __forceinline__ int opaque_tid() { int t = threadIdx.x; asm volatile("" : "+v"(t)); return t; }
__device__ __forceinline__ void job_fence() {
#if DBG_JOBFENCE
    asm volatile("s_waitcnt vmcnt(0) lgkmcnt(0)" ::: "memory");
    __syncthreads();
#endif
}
__device__ __forceinline__ float wave_sum(float v) {
#pragma unroll
    for (int o = 32; o >= 1; o >>= 1) v += __shfl_xor(v, o);
    return v;
}
__device__ __forceinline__ f32x4 mfma16(bf16x8 a, bf16x8 b, f32x4 c) { return __builtin_amdgcn_mfma_f32_16x16x32_bf16(a, b, c, 0, 0, 0); }
__device__ __forceinline__ bf16x8 as_bf8(u32x4 v) { union { u32x4 u; bf16x8 b; } x; x.u = v; return x.b; }
__device__ __forceinline__ void store16bf(bf16_t* dst, const float (&v)[16]) {
    u32x4 a, b;
    a.x = pk_bf16(v[0], v[1]); a.y = pk_bf16(v[2], v[3]); a.z = pk_bf16(v[4], v[5]); a.w = pk_bf16(v[6], v[7]);
    b.x = pk_bf16(v[8], v[9]); b.y = pk_bf16(v[10], v[11]); b.z = pk_bf16(v[12], v[13]); b.w = pk_bf16(v[14], v[15]);
    *(u32x4*)dst = a; *(u32x4*)(dst + 8) = b;
}

#ifndef XB_SCOPE
#define XB_SCOPE "agent"
#endif
#define XB_TMO      128
#define XB_XCNT(j)  (256  + 64 * (j))
#define XB_XSUB(j)  (1280 + 64 * (j))
#define XB_XGEN(j)  (2304 + 64 * (j))
#define XB_TOP      3328
#define XB_TOPGEN   3392
#define XCD_BAR_WORDS 3456
#define XB_SPIN_CAP (1u << 22)
#define LAS __attribute__((address_space(3)))
__device__ __forceinline__ unsigned xb_ld(unsigned* p)              { return __hip_atomic_load(p, __ATOMIC_RELAXED, __HIP_MEMORY_SCOPE_AGENT); }
__device__ __forceinline__ unsigned xb_add(unsigned* p, unsigned v) { return __hip_atomic_fetch_add(p, v, __ATOMIC_RELAXED, __HIP_MEMORY_SCOPE_AGENT); }
__device__ __forceinline__ unsigned xb_xcc_id() { return (unsigned)__builtin_amdgcn_s_getreg((3 << 11) | 20) & 0xFu; }
#define XB_SPIN(cond, bar) do { unsigned _sp = 0; while (cond) { __builtin_amdgcn_s_sleep(1); \
    if ((++_sp & 255u) == 0u) { if (xb_ld(&(bar)[XB_TMO])) break; if (_sp > XB_SPIN_CAP) { atomicAdd(&(bar)[XB_TMO], 1u); break; } } } } while (0)
struct XcdBarrier { unsigned* bar; unsigned x; volatile LAS unsigned* st; unsigned nloc, nx; };
__device__ __forceinline__ XcdBarrier xcd_barrier_post(unsigned* bar, volatile LAS unsigned* st) {
    XcdBarrier b; b.bar = bar; b.x = xb_xcc_id(); b.st = st; b.nloc = 0u; b.nx = 0u;
    if (threadIdx.x == 0) (void)xb_add(&bar[XB_XCNT(b.x)], 1u);
    return b;
}
__device__ __forceinline__ void xcd_barrier_complete(unsigned* bar, unsigned x, unsigned& nloc, unsigned& nx) {
    const unsigned G = gridDim.x * gridDim.y * gridDim.z;
    unsigned sum, cnt, mine, sp = 0u;
    for (;;) {
        sum = 0u; cnt = 0u; mine = 0u;
#pragma unroll
        for (unsigned j = 0; j < 16; ++j) { const unsigned c = xb_ld(&bar[XB_XCNT(j)]); sum += c; cnt += (c > 0u) ? 1u : 0u; mine = (j == x) ? c : mine; }
        if (sum == G) break;
        __builtin_amdgcn_s_sleep(1);
        if ((++sp & 255u) == 0u) { if (xb_ld(&bar[XB_TMO])) break; if (sp > XB_SPIN_CAP) { atomicAdd(&bar[XB_TMO], 1u); break; } }
    }
    nloc = mine > 0u ? mine : 1u; nx = cnt > 0u ? cnt : 1u;
}
__device__ __forceinline__ void xcd_barrier(XcdBarrier& b) {
    asm volatile("s_waitcnt vmcnt(0)" ::: "memory");
    __syncthreads();
    if (threadIdx.x == 0) {
        unsigned* bar = b.bar;
        __builtin_amdgcn_s_waitcnt(0);
        unsigned nloc = b.nloc, nx = b.nx;
        if (nloc == 0u) { xcd_barrier_complete(bar, b.x, nloc, nx); b.nloc = nloc; b.nx = nx; }
        const unsigned old = xb_add(&bar[XB_XSUB(b.x)], 1u);
        const unsigned gen = old / nloc;
        if (old + 1u == (gen + 1u) * nloc) {
            __builtin_amdgcn_fence(__ATOMIC_RELEASE, XB_SCOPE);
            asm volatile("s_waitcnt vmcnt(0)" ::: "memory");
            const unsigned og = xb_add(&bar[XB_TOP], 1u);
            const unsigned tg = og / nx;
            if (og + 1u == (tg + 1u) * nx) xb_add(&bar[XB_TOPGEN], 1u);
            else XB_SPIN(xb_ld(&bar[XB_TOPGEN]) == tg, bar);
            __builtin_amdgcn_fence(__ATOMIC_ACQUIRE, XB_SCOPE);
            xb_add(&bar[XB_XGEN(b.x)], 1u);
            asm volatile("s_waitcnt vmcnt(0)" ::: "memory");
        } else {
            XB_SPIN(xb_ld(&bar[XB_XGEN(b.x)]) == gen, bar);
            __builtin_amdgcn_fence(__ATOMIC_ACQUIRE, XB_SCOPE);
            asm volatile("s_waitcnt vmcnt(0)" ::: "memory");
        }
    }
    __syncthreads();
}

__device__ __forceinline__ void tile_coords(int L, int ntm, int ntn, int& tm, int& tn) {
    const int nt = ntm * ntn, q = nt >> 3, r = nt & 7, xcd = L & 7, off = L >> 3;
    const int id = (xcd < r ? xcd * (q + 1) : r * (q + 1) + (xcd - r) * q) + off;
    const int GM = 8, nig = GM * ntn, gid = id / nig, fm = gid * GM, gsz = (ntm - fm) < GM ? (ntm - fm) : GM;
    tm = fm + ((id % nig) % gsz); tn = (id % nig) / gsz;
}

template <class AP, class BP>
__device__ __forceinline__ void gemm_kloop(f32x4 (&acc)[4][4], AP ap, int a_kstep, BP bp, int b_kstep, int nkt, unsigned char* lds, int tid) {
    const int lane = tid & 63, w = tid >> 6, wm = w >> 1, wn = w & 1, fr = lane & 15, fq = lane >> 4;
    const int lr = lane >> 3, lc = (lane & 7) ^ lr;
    const bf16_t* pa[4]; const bf16_t* pb[4];
#pragma unroll
    for (int i = 0; i < 4; ++i) {
        const int row = 8 * (w + 4 * i) + lr;
        pa[i] = ap(row) + lc * 8;
        const int wn_ = row >> 6, ni_ = (row >> 4) & 3, ii = row & 15;
        pb[i] = bp(64 * wn_ + 16 * (ii >> 2) + 4 * ni_ + (ii & 3)) + lc * 8;
    }
    const int ra = (64 * wm + fr) * 128, rb = (64 * wn + fr) * 128;
    const int sw0 = ((fq) ^ (fr & 7)) << 4, sw1 = ((4 + fq) ^ (fr & 7)) << 4;
    auto issue = [&](int buf) {
#pragma unroll
        for (int i = 0; i < 4; ++i) {
            __builtin_amdgcn_global_load_lds((const unsigned*)pa[i], (unsigned*)(lds + buf * 16384 + (w + 4 * i) * 1024), 16, 0, 0);
            __builtin_amdgcn_global_load_lds((const unsigned*)pb[i], (unsigned*)(lds + 32768 + buf * 16384 + (w + 4 * i) * 1024), 16, 0, 0);
            pa[i] += a_kstep; pb[i] += b_kstep;
        }
    };
    auto compute = [&](int buf) {
        const unsigned char* A = lds + buf * 16384;
        const unsigned char* B = lds + 32768 + buf * 16384;
#pragma unroll
        for (int ks = 0; ks < 2; ++ks) {
            const int sw = ks ? sw1 : sw0;
            bf16x8 af[4], bf[4];
#pragma unroll
            for (int mi = 0; mi < 4; ++mi) af[mi] = *(const bf16x8*)(A + ra + mi * 2048 + sw);
#pragma unroll
            for (int ni = 0; ni < 4; ++ni) bf[ni] = *(const bf16x8*)(B + rb + ni * 2048 + sw);
#pragma unroll
            for (int mi = 0; mi < 4; ++mi)
#pragma unroll
                for (int ni = 0; ni < 4; ++ni) acc[mi][ni] = mfma16(bf[ni], af[mi], acc[mi][ni]);
        }
    };
    __syncthreads();
    issue(0);
    asm volatile("s_waitcnt vmcnt(0)" ::: "memory");
    __syncthreads();
#pragma unroll 1
    for (int kt = 0; kt < nkt; ++kt) {
        const int cur = kt & 1;
        if (kt + 1 < nkt) issue(cur ^ 1);
        compute(cur);
        asm volatile("s_waitcnt vmcnt(0)" ::: "memory");
        __syncthreads();
    }
}
__device__ __forceinline__ void zero_acc(f32x4 (&acc)[4][4]) {
#pragma unroll
    for (int i = 0; i < 4; ++i)
#pragma unroll
        for (int j = 0; j < 4; ++j) acc[i][j] = (f32x4){0.f, 0.f, 0.f, 0.f};
}

__device__ __forceinline__ void transpose_tile(const float* src, bf16_t* dst, int R, int C, int mode, int tk, int tn, float* tl, int tid) {
    const int k0 = tk * 64, n0 = tn * 64;
    {
        const int j = tid & 63; const int n = n0 + j;
        int col = n;
        if (mode == 1) col = (n < 1304) ? n : ((n < 1408) ? -1 : n - 104);
        else if (mode == 2) col = n + 2072;
#pragma unroll 4
        for (int pp = 0; pp < 16; ++pp) {
            const int i = (tid >> 6) + 4 * pp;
            tl[i * 65 + j] = (col >= 0) ? src[(size_t)(k0 + i) * C + col] : 0.f;
        }
    }
    __syncthreads();
#pragma unroll
    for (int q2 = 0; q2 < 2; ++q2) {
        const int jj = (tid >> 3) + 32 * q2, cc = tid & 7;
        u32x4 o;
        o.x = pk_bf16(tl[(cc * 8 + 0) * 65 + jj], tl[(cc * 8 + 1) * 65 + jj]);
        o.y = pk_bf16(tl[(cc * 8 + 2) * 65 + jj], tl[(cc * 8 + 3) * 65 + jj]);
        o.z = pk_bf16(tl[(cc * 8 + 4) * 65 + jj], tl[(cc * 8 + 5) * 65 + jj]);
        o.w = pk_bf16(tl[(cc * 8 + 6) * 65 + jj], tl[(cc * 8 + 7) * 65 + jj]);
        *(u32x4*)(dst + (size_t)(n0 + jj) * R + k0 + cc * 8) = o;
    }
    __syncthreads();
}

__device__ __forceinline__ void phase_prep(CKP& p, int l, unsigned char* lds) {
    const int tid = opaque_tid(), G = gridDim.x, lane = tid & 63, w = tid >> 6;
    unsigned char* W = p.ws + OFF_W;
    if (l < DEPTH) {
        struct E { const float* src; bf16_t* dst; int R, C, nd, mode, nbatch; };
        constexpr int NE = 14;
        for (int L = blockIdx.x * 4 + w;; L += G * 4) {
            int rem = L; int e = 0; E d{};
            for (; e < NE; ++e) {
                switch (e) {
                    case 0: d = {p.in[3] + (size_t)l * 1024 * 5144, (bf16_t*)(W + W_IN), 1024, 5144, 2176, 1, 1}; break;
                    case 1: d = {p.in[3] + (size_t)l * 1024 * 5144, (bf16_t*)(W + W_GB), 1024, 5144, 3072, 2, 1}; break;
                    case 2: d = {p.in[10] + (size_t)l * 512 * 1024, (bf16_t*)(W + W_A), 512, 1024, 1024, 0, 1}; break;
                    case 3: d = {p.in[14] + (size_t)l * 256 * 1024, (bf16_t*)(W + W_S), 256, 1024, 1024, 0, 1}; break;
                    case 4: d = {p.in[25] + (size_t)l * 256 * 1024, (bf16_t*)(W + W_5), 256, 1024, 1024, 0, 1}; break;
                    case 5: d = {p.in[26] + (size_t)l * 1024 * 1024, (bf16_t*)(W + W_M), 1024, 1024, 1024, 0, 1}; break;
                    case 6: d = {p.in[23] + (size_t)l * 256 * 256, (bf16_t*)(W + W_GLU), 256, 256, 256, 0, 1}; break;
                    case 7: d = {p.in[6] + (size_t)l * 2048 * 128, (bf16_t*)(W + W_C1), 2048, 128, 128, 0, 1}; break;
                    case 8: d = {p.in[8] + (size_t)l * 2048 * 128, (bf16_t*)(W + W_C1) + 128 * 2048, 2048, 128, 128, 0, 1}; break;
                    case 9: d = {p.in[7] + (size_t)l * 128 * 64, (bf16_t*)(W + W_C2), 128, 64, 64, 0, 1}; break;
                    case 10: d = {p.in[9] + (size_t)l * 128 * 64, (bf16_t*)(W + W_C2) + 64 * 128, 128, 64, 64, 0, 1}; break;
                    case 11: d = {p.in[32] + (size_t)l * 32 * 1024 * 512, (bf16_t*)(W + W_EG), 1024, 512, 512, 0, 32}; break;
                    case 12: d = {p.in[33] + (size_t)l * 32 * 1024 * 512, (bf16_t*)(W + W_EU), 1024, 512, 512, 0, 32}; break;
                    default: d = {p.in[34] + (size_t)l * 32 * 512 * 1024, (bf16_t*)(W + W_ED), 512, 1024, 1024, 0, 32}; break;
                }
                const int per = (d.R >> 6) * (d.nd >> 6), tot = per * d.nbatch;
                if (rem < tot) break;
                rem -= tot;
            }
            if (e >= NE) break;
            const int per = (d.R >> 6) * (d.nd >> 6), bi = rem / per, t = rem % per, ntn = d.nd >> 6;
            const int k0 = (t / ntn) * 64, n = (t % ntn) * 64 + lane;
            int col = n;
            if (d.mode == 1) col = (n < 1304) ? n : ((n < 1408) ? -1 : n - 104);
            else if (d.mode == 2) col = n + 2072;
            const float* sp = d.src + (size_t)bi * d.R * d.C + (size_t)k0 * d.C + (col >= 0 ? col : 0);
            float v[64];
#pragma unroll
            for (int i = 0; i < 64; ++i) v[i] = sp[(size_t)i * d.C];
            if (col < 0) {
#pragma unroll
                for (int i = 0; i < 64; ++i) v[i] = 0.f;
            }
            bf16_t* dp = d.dst + (size_t)bi * d.R * d.nd + (size_t)n * d.R + k0;
#pragma unroll
            for (int q = 0; q < 8; ++q) {
                u32x4 o;
                o.x = pk_bf16(v[8 * q], v[8 * q + 1]); o.y = pk_bf16(v[8 * q + 2], v[8 * q + 3]);
                o.z = pk_bf16(v[8 * q + 4], v[8 * q + 5]); o.w = pk_bf16(v[8 * q + 6], v[8 * q + 7]);
                *(u32x4*)(dp + 8 * q) = o;
            }
        }
        const int gt = blockIdx.x * NTHR + tid, gs = G * NTHR;
        {
            const float* sw = p.in[12] + (size_t)l * 4 * 128 * 128; bf16_t* o = (bf16_t*)(W + W_SGU);
            for (int i = gt; i < 65536; i += gs) { const int t = (i >> 7) & 127, s = i & 127; o[i] = f2bf(s <= t ? sw[i] : 0.f); }
        }
        {
            const float* are = p.in[15] + l * 1024; const float* aim = p.in[16] + l * 1024; const float* ls = p.in[17] + l * 16;
            const float* bre = p.in[18] + (size_t)l * 16384; const float* bim = p.in[19] + (size_t)l * 16384;
            float* oa = (float*)(W + W_S5A); float* oa2 = (float*)(W + W_S5A256); float* ob = (float*)(W + W_S5B);
            for (int i = gt; i < 1024; i += gs) {
                const int g = i >> 6;
                const float step = expf(ls[g]), ar = are[i], ai = aim[i];
                const float mag = expf(ar * step); float sn, cs; sincosf(ai * step, &sn, &cs);
                const float abr = mag * cs, abi = mag * sn;
                const float den = ar * ar + ai * ai, nr = abr - 1.f, ni = abi;
                const float cr = (nr * ar + ni * ai) / den, ci = (ni * ar - nr * ai) / den;
                oa[i * 2] = abr; oa[i * 2 + 1] = abi;
                float pr = abr, pi = abi;
                for (int s = 0; s < 8; ++s) { const float nr2 = pr * pr - pi * pi, ni2 = 2.f * pr * pi; pr = nr2; pi = ni2; }
                oa2[i * 2] = pr; oa2[i * 2 + 1] = pi;
                for (int h = 0; h < 16; ++h) {
                    const float br = bre[i * 16 + h], bi_ = bim[i * 16 + h];
                    ob[i * 32 + h] = cr * br - ci * bi_;
                    ob[i * 32 + 16 + h] = cr * bi_ + ci * br;
                }
            }
            const float* cre = p.in[20] + (size_t)l * 16384; const float* cim = p.in[21] + (size_t)l * 16384; bf16_t* oc = (bf16_t*)(W + W_S5C);
            for (int i = gt; i < 32768; i += gs) {
                const int k = i & 127, gh = i >> 7;
                oc[i] = f2bf(k < 64 ? cre[gh * 64 + k] : -cim[gh * 64 + (k - 64)]);
            }
        }
        {
            const float* wg = p.in[28] + (size_t)l * 1024 * 4; const float* we = p.in[30] + (size_t)l * 1024 * 32;
            bf16_t* oh = (bf16_t*)(W + W_RH); bf16_t* ol = (bf16_t*)(W + W_RL);
            for (int i = gt; i < 65536; i += gs) {
                const int n = i >> 10, k = i & 1023;
                const float v = (n < 4) ? wg[k * 4 + n] : ((n < 36) ? we[k * 32 + (n - 4)] : 0.f);
                const bf16_t h = f2bf(v);
                oh[i] = h; ol[i] = f2bf(v - bf2f(h));
            }
        }
        {
            float* pb = (float*)(W + W_PB);
            for (int j = blockIdx.x * 4 + w; j < 256; j += G * 4) {
                const int kv = j >> 7, n = j & 127;
                const float* pos = p.in[kv ? 5 : 4] + (size_t)l * 2048; const float* w1 = p.in[kv ? 8 : 6] + (size_t)l * 2048 * 128;
                float s = 0.f;
                for (int k = lane; k < 2048; k += 64) s += pos[k] * w1[(size_t)k * 128 + n];
                s = wave_sum(s);
                if (lane == 0) pb[j] = s;
            }
        }
    }
    {
        const float* gam = (l < DEPTH) ? (p.in[2] + (size_t)l * 1024) : p.in[35];
        bf16_t* hb = (bf16_t*)(p.ws + OFF_H);
        const bf16_t* ys = (const bf16_t*)(p.ws + OFF_YS);
        f32x4 gv[4];
#pragma unroll
        for (int i = 0; i < 4; ++i) gv[i] = *(const f32x4*)(gam + 4 * lane + 256 * i);
        for (int row = blockIdx.x * 4 + w; row < NTOK; row += G * 4) {
            f32x4 xv[4]; float ss = 0.f;
#pragma unroll
            for (int i = 0; i < 4; ++i) {
                const int col = 4 * lane + 256 * i;
                if (l == 0) xv[i] = *(const f32x4*)(p.in[0] + (size_t)row * 1024 + col);
                else if ((DBG_NOCOMBINE >> l) & 1) xv[i] = *(const f32x4*)(p.xbuf + (size_t)row * 1024 + col);
                else {
                    xv[i] = *(const f32x4*)(p.xbuf + (size_t)row * 1024 + col);
                    const u32x2 y0 = *(const u32x2*)(ys + (size_t)(2 * row) * 1024 + col), y1 = *(const u32x2*)(ys + (size_t)(2 * row + 1) * 1024 + col);
                    xv[i][0] += bflo(y0.x) + bflo(y1.x); xv[i][1] += bfhi(y0.x) + bfhi(y1.x);
                    xv[i][2] += bflo(y0.y) + bflo(y1.y); xv[i][3] += bfhi(y0.y) + bfhi(y1.y);
                }
                ss += xv[i][0] * xv[i][0] + xv[i][1] * xv[i][1] + xv[i][2] * xv[i][2] + xv[i][3] * xv[i][3];
            }
            ss = wave_sum(ss);
            const float rstd = rsqrtf(ss * (1.f / 1024.f) + RMS_EPS);
#pragma unroll
            for (int i = 0; i < 4; ++i) {
                const int col = 4 * lane + 256 * i;
                f32x4 hn = xv[i] * rstd * gv[i];
                if (l < DEPTH) {
                    *(f32x4*)(p.xbuf + (size_t)row * 1024 + col) = xv[i];
                    u32x2 o; o.x = pk_bf16(hn[0], hn[1]); o.y = pk_bf16(hn[2], hn[3]);
                    *(u32x2*)(hb + (size_t)row * 1024 + col) = o;
                } else {
#if DBG_TIMEPH >= 0
                    { const unsigned long long* ts = (const unsigned long long*)(p.ws + OFF_CTL + 24576);
                      const float dt_us = (float)(ts[DBG_TIMEPH2] - ts[DBG_TIMEPH]) * 0.01f; hn = hn * (1.f + 1e-3f * dt_us); }
#endif
                    *(f32x4*)(p.xbuf + (size_t)row * 1024 + col) = hn;
                }
            }
        }
    }
}

__device__ __forceinline__ void phase_inproj(CKP& p, int l, unsigned char* lds) {
    const int tid = opaque_tid(), lane = tid & 63, w = tid >> 6, wm = w >> 1, wn = w & 1, fr = lane & 15, fq = lane >> 4;
    const bf16_t* A = (const bf16_t*)(p.ws + OFF_H);
    const bf16_t* Bt = (const bf16_t*)(p.ws + OFF_W + W_IN);
    unsigned char* R = p.ws + OFF_R;
    const int* pos = (const int*)p.in[1];
    constexpr int NTM = NTOK / 128, NTN = 17;
    for (int L = blockIdx.x; L < NTM * NTN; L += gridDim.x) {
        int tm, tn; tile_coords(L, NTM, NTN, tm, tn);
        const int m0 = tm * 128, n0 = tn * 128;
        f32x4 acc[4][4]; zero_acc(acc);
        gemm_kloop(acc, [&](int r) { return A + (size_t)(m0 + r) * 1024; }, 64, [&](int v) { return Bt + (size_t)(n0 + v) * 1024; }, 64, 16, lds, tid);
#pragma unroll
        for (int mi = 0; mi < 4; ++mi) {
            const int row = m0 + 64 * wm + 16 * mi + fr;
            const int cl = 64 * wn + 16 * fq;
            float v[16];
#pragma unroll
            for (int e = 0; e < 16; ++e) v[e] = acc[mi][e >> 2][e & 3];
            if (tn < 4) {
                store16bf((bf16_t*)(R + R_Q) + (size_t)row * 512 + n0 + cl, v);
            } else if (tn < 10) {
                const int seg = tn - 4;
                if (seg == 2 || seg == 4) {
                    if (fq == 0) {
                        const float ps = (float)pos[row];
#pragma unroll
                        for (int i = 0; i < 8; ++i) {
                            float sn, cs; sincosf(ps * p.inv_freq[i], &sn, &cs);
                            const float x1 = v[i], x2 = v[8 + i];
                            v[i] = x1 * cs - x2 * sn; v[8 + i] = x2 * cs + x1 * sn;
                        }
                    }
                }
                if (seg == 3 || seg == 5) {
                    bf16_t* dst = (bf16_t*)(R + (seg == 3 ? R_VST : R_VWT));
                    const int b = row >> 12, s = row & 4095, g = wn, d0 = 16 * fq;
#pragma unroll
                    for (int e = 0; e < 16; ++e) dst[((size_t)((b * 2 + g) * 64 + d0 + e)) * SEQ + s] = f2bf(v[e]);
                } else {
                    const size_t off = (seg == 0) ? R_KC : (seg == 1) ? R_VC : (seg == 2) ? R_KS : R_KW;
                    store16bf((bf16_t*)(R + off) + (size_t)row * 128 + cl, v);
                }
            } else if (tn == 10) {
                if (cl < 24) {
                    float* ng = (float*)(R + R_NG) + (size_t)row * 24 + cl;
#pragma unroll
                    for (int e = 0; e < 16; ++e) if (cl + e < 24) ng[e] = sigm(v[e]);
                }
            } else if (tn < 15) {
#pragma unroll
                for (int e = 0; e < 16; ++e) v[e] = gelu_tanh(v[e]);
                const int c512 = (tn - 11) * 128 + cl;
                if (c512 < 256) store16bf((bf16_t*)(R + R_U) + (size_t)row * 256 + c512, v);
                else store16bf((bf16_t*)(R + R_V) + (size_t)row * 256 + (c512 - 256), v);
            } else {
                store16bf((bf16_t*)(R + R_S5IN) + (size_t)row * 256 + (tn - 15) * 128 + cl, v);
            }
        }
    }
}

__device__ __forceinline__ void compress_tile(CKP& p, int job, unsigned char* lds) {
    job_fence();
    const int tid = opaque_tid(), lane = tid & 63, w = tid >> 6, wm = w >> 1, wn = w & 1, fr = lane & 15, fq = lane >> 4;
    const int kv = job >> 5, tm = job & 31, m0 = tm * 128;
    unsigned char* W = p.ws + OFF_W;
    const bf16_t* src = (const bf16_t*)(p.ws + OFF_R + (kv ? R_VC : R_KC));
    const bf16_t* W1 = (const bf16_t*)(W + W_C1) + (size_t)kv * 128 * 2048;
    const bf16_t* W2 = (const bf16_t*)(W + W_C2) + (size_t)kv * 64 * 128;
    const float* pb = (const float*)(W + W_PB) + kv * 128;
    f32x4 acc[4][4]; zero_acc(acc);
    gemm_kloop(acc, [&](int r) { int Rr = m0 + r; Rr = Rr < 4080 ? Rr : 4079; const int b = Rr / 510, rem = Rr % 510, c = rem >> 1, g = rem & 1;
                                 return src + ((size_t)(b * SEQ + 16 * c)) * 128 + g * 64; }, 128,
               [&](int v) { return W1 + (size_t)v * 2048; }, 64, 32, lds, tid);
#pragma unroll
    for (int mi = 0; mi < 4; ++mi) {
        const int row = 64 * wm + 16 * mi + fr; const int cb = 16 * fq;
        float v[16];
#pragma unroll
        for (int e = 0; e < 16; ++e) v[e] = gelu_tanh(acc[mi][e >> 2][e & 3] + pb[64 * wn + cb + e]);
        u32x4 a, b;
        a.x = pk_bf16(v[0], v[1]); a.y = pk_bf16(v[2], v[3]); a.z = pk_bf16(v[4], v[5]); a.w = pk_bf16(v[6], v[7]);
        b.x = pk_bf16(v[8], v[9]); b.y = pk_bf16(v[10], v[11]); b.z = pk_bf16(v[12], v[13]); b.w = pk_bf16(v[14], v[15]);
        *(u32x4*)(lds + wn * 16384 + row * 128 + (((2 * fq) ^ (row & 7)) << 4)) = a;
        *(u32x4*)(lds + wn * 16384 + row * 128 + (((2 * fq + 1) ^ (row & 7)) << 4)) = b;
    }
#pragma unroll
    for (int j = 0; j < 4; ++j) {
        const int pid = tid + 256 * j, row = pid >> 4, ch = pid & 15;
        const u32x4 v = *(const u32x4*)(W2 + row * 128 + ch * 8);
        *(u32x4*)(lds + 32768 + (ch >> 3) * 16384 + row * 128 + (((ch & 7) ^ (row & 7)) << 4)) = v;
    }
    __syncthreads();
    f32x4 a2[4][2];
#pragma unroll
    for (int i = 0; i < 4; ++i) { a2[i][0] = (f32x4){0.f, 0.f, 0.f, 0.f}; a2[i][1] = (f32x4){0.f, 0.f, 0.f, 0.f}; }
#pragma unroll
    for (int kt2 = 0; kt2 < 2; ++kt2)
#pragma unroll
        for (int ks = 0; ks < 2; ++ks) {
            bf16x8 af[4], bf[2];
#pragma unroll
            for (int mi = 0; mi < 4; ++mi) { const int row = 64 * wm + 16 * mi + fr; af[mi] = *(const bf16x8*)(lds + kt2 * 16384 + row * 128 + (((4 * ks + fq) ^ (row & 7)) << 4)); }
#pragma unroll
            for (int ni = 0; ni < 2; ++ni) { const int row = 32 * wn + 8 * (fr >> 2) + 4 * ni + (fr & 3); bf[ni] = *(const bf16x8*)(lds + 32768 + kt2 * 16384 + row * 128 + (((4 * ks + fq) ^ (row & 7)) << 4)); }
#pragma unroll
            for (int mi = 0; mi < 4; ++mi)
#pragma unroll
                for (int ni = 0; ni < 2; ++ni) a2[mi][ni] = mfma16(bf[ni], af[mi], a2[mi][ni]);
        }
    bf16_t* kcmp = (bf16_t*)(p.ws + OFF_C + C_KCMP);
    bf16_t* vct = (bf16_t*)(p.ws + OFF_C + C_VCT);
#pragma unroll
    for (int mi = 0; mi < 4; ++mi) {
        const int Rr = m0 + 64 * wm + 16 * mi + fr;
        if (Rr < 4080) {
            const int b = Rr / 510, rem = Rr % 510, c = rem >> 1, g = rem & 1, d0 = 32 * wn + 8 * fq;
            float v[8];
#pragma unroll
            for (int e = 0; e < 8; ++e) v[e] = a2[mi][e >> 2][e & 3];
            if (DBG_NOCSTORE) { if (v[0] == 123.456f) kcmp[0] = 1; }
            else if (kv == 0) {
                u32x4 o; o.x = pk_bf16(v[0], v[1]); o.y = pk_bf16(v[2], v[3]); o.z = pk_bf16(v[4], v[5]); o.w = pk_bf16(v[6], v[7]);
                *(u32x4*)(kcmp + ((size_t)(b * 256 + c)) * 128 + g * 64 + d0) = o;
                if (c == 254) *(u32x4*)(kcmp + ((size_t)(b * 256 + 255)) * 128 + g * 64 + d0) = (u32x4){0u, 0u, 0u, 0u};
            } else {
#pragma unroll
                for (int e = 0; e < 8; ++e) {
                    vct[((size_t)((b * 2 + g) * 64 + d0 + e)) * 256 + c] = f2bf(v[e]);
                    if (c == 254) vct[((size_t)((b * 2 + g) * 64 + d0 + e)) * 256 + 255] = 0;
                }
            }
        }
    }
    __syncthreads();
}

__device__ __forceinline__ void sgu_job(CKP& p, int l, int job, unsigned char* lds) {
    job_fence();
    const int tid = opaque_tid(), lane = tid & 63, w = tid >> 6, fr = lane & 15, fq = lane >> 4;
    const size_t tok0 = (size_t)job * 128;
    const bf16_t* V = (const bf16_t*)(p.ws + OFF_R + R_V) + tok0 * 256;
    const bf16_t* U = (const bf16_t*)(p.ws + OFF_R + R_U) + tok0 * 256;
    bf16_t* O = (bf16_t*)(p.ws + OFF_C + C_SGU) + tok0 * 256;
    const bf16_t* Wt = (const bf16_t*)(p.ws + OFF_W + W_SGU);
    const float* ng = p.in[11] + (size_t)l * 256;
    const float* bs = p.in[13] + (size_t)l * 512;
    __syncthreads();
    if (DBG_SGUCUT != 2) {
        const int s = tid >> 1, half = tid & 1;
        const bf16_t* src = V + (size_t)s * 256 + half * 128;
        float ss = 0.f;
#pragma unroll 4
        for (int j = 0; j < 16; ++j) {
            const u32x4 bb = *(const u32x4*)(src + j * 8);
            const unsigned uu[4] = {bb.x, bb.y, bb.z, bb.w};
#pragma unroll
            for (int q = 0; q < 4; ++q) { const float a = bflo(uu[q]), b2 = bfhi(uu[q]); ss += a * a + b2 * b2; }
        }
        ss += __shfl_xor(ss, 1);
        const float rstd = rsqrtf(ss * (1.f / 256.f) + RMS_EPS);
#pragma unroll 1
        for (int j = 0; j < 16; ++j) {
            const u32x4 bb = *(const u32x4*)(src + j * 8);
            const unsigned uu[4] = {bb.x, bb.y, bb.z, bb.w};
            const int cb = half * 128 + j * 8;
#pragma unroll
            for (int q = 0; q < 4; ++q) {
#pragma unroll
                for (int hh = 0; hh < 2; ++hh) {
                    const int c = cb + q * 2 + hh;
                    const float val = (hh ? bfhi(uu[q]) : bflo(uu[q])) * rstd * ng[c];
                    *(bf16_t*)(lds + c * 256 + ((((s >> 3) ^ (c & 15))) << 4) + (s & 7) * 2) = f2bf(val);
                }
            }
        }
    }
    __syncthreads();
    const int g = w;
#pragma unroll 1
    for (int th = 0; th < (DBG_SGUCUT == 1 ? 0 : 2); ++th) {
        f32x4 acc[4][4];
        zero_acc(acc);
#pragma unroll
        for (int ks = 0; ks < 4; ++ks) {
            if (32 * ks <= 64 * th + 63) {
                bf16x8 vf[4];
#pragma unroll
                for (int di = 0; di < 4; ++di) { const int c = 64 * g + 16 * di + fr; vf[di] = *(const bf16x8*)(lds + c * 256 + (((4 * ks + fq) ^ (c & 15)) << 4)); }
#pragma unroll
                for (int ti = 0; ti < 4; ++ti) {
                    const int t = 64 * th + 16 * ti + fr;
                    if (32 * ks <= 64 * th + 16 * ti + 15) {
                        const bf16x8 wf = *(const bf16x8*)(Wt + ((size_t)(g * 128 + t)) * 128 + 32 * ks + 8 * fq);
#pragma unroll
                        for (int di = 0; di < 4; ++di) acc[ti][di] = mfma16(vf[di], wf, acc[ti][di]);
                    }
                }
            }
        }
#pragma unroll
        for (int ti = 0; ti < 4; ++ti) {
            const int t = 64 * th + 16 * ti + fr; const float bb = bs[g * 128 + t];
#pragma unroll
            for (int di = 0; di < 4; ++di) {
                const int c = 64 * g + 16 * di + 4 * fq;
                const u32x2 uu = *(const u32x2*)(U + (size_t)t * 256 + c);
                u32x2 o;
                o.x = pk_bf16(bflo(uu.x) * (acc[ti][di][0] + bb), bfhi(uu.x) * (acc[ti][di][1] + bb));
                o.y = pk_bf16(bflo(uu.y) * (acc[ti][di][2] + bb), bfhi(uu.y) * (acc[ti][di][3] + bb));
                *(u32x2*)(O + (size_t)t * 256 + c) = o;
            }
        }
    }
    __syncthreads();
}

__device__ __forceinline__ void s5_job(CKP& p, int l, int jb, int pass, unsigned char* lds) {
    job_fence();
    const int tid = opaque_tid(), lane = tid & 63, w = tid >> 6, fr = lane & 15, fq = lane >> 4;
    const int id = ((jb * 4 + w) + DBG_IDROT) & 2047, seq = id >> 4, ch = id & 15, b = seq >> 4, g = seq & 15;
    unsigned char* W = p.ws + OFF_W;
    const float* ab = (const float*)(W + W_S5A) + (g * 64 + lane) * 2;
    float ar = ab[0], ai = ab[1];
    float br[16], bi[16];
    {
        const float* bb = (const float*)(W + W_S5B) + (size_t)(g * 64 + lane) * 32;
#pragma unroll
        for (int h = 0; h < 16; ++h) { br[h] = bb[h]; bi[h] = bb[16 + h]; }
    }
#if DBG_S5CONST >= 2
    { const float q = (float)(lane + 1) * 0.001f; ar = 0.99f - q; ai = 0.05f + q;
      for (int h = 0; h < 16; ++h) { br[h] = 0.01f * (float)(h + 1) + q; bi[h] = -0.02f * (float)(h + 1) + q; } }
#endif
    float* Eb = (float*)(p.ws + OFF_C + C_S5E);
    float hre = 0.f, him = 0.f;
    bf16x8 cf[4]; float dv[4];
    if (pass == 2) {
        const float* a2 = (const float*)(W + W_S5A256) + (g * 64 + lane) * 2;
        const float a2r = a2[0], a2i = a2[1];
        for (int c2 = 0; c2 < ch; ++c2) {
            const float* e = Eb + ((size_t)(seq * 16 + c2) * 64 + lane) * 2;
            const float nr = a2r * hre - a2i * him + e[0], ni = a2r * him + a2i * hre + e[1];
            hre = nr; him = ni;
        }
        const bf16_t* cm = (const bf16_t*)(W + W_S5C) + (size_t)(g * 16 + fr) * 128;
#pragma unroll
        for (int ks = 0; ks < 4; ++ks) cf[ks] = *(const bf16x8*)(cm + 32 * ks + 8 * fq);
#pragma unroll
        for (int r = 0; r < 4; ++r) dv[r] = p.in[22][(size_t)l * 256 + g * 16 + 4 * fq + r];
    }
    const bf16_t* xin = (const bf16_t*)(p.ws + OFF_R + R_S5IN) + ((size_t)(b * SEQ + ch * 256)) * 256 + g * 16;
    bf16_t* yg = (bf16_t*)(p.ws + OFF_C + C_YG) + ((size_t)(b * SEQ + ch * 256)) * 256 + g * 16;
    float* xs = (float*)(lds + w * 10240);
    int ldsbad = 0; (void)ldsbad;
    unsigned char* Hs = lds + w * 10240 + 2048;
#if DBG_TWICE
    float keep_re = 0.f, keep_im = 0.f;
#pragma unroll 1
    for (int rep = 0; rep < 2; ++rep) {
    if (rep == 1) { keep_re = hre; keep_im = him; hre = 0.f; him = 0.f; }
#endif
#pragma unroll 1
    for (int sub = 0; sub < 8; ++sub) {
#if DBG_S5CONST >= 1
        u32x4 xv; { const unsigned q = (unsigned)(sub * 32 + (lane >> 1)) * 2654435761u + (unsigned)id * 40503u + (lane & 1); xv.x = 0x3f803e80u ^ ((q & 0xff) << 16); xv.y = 0x3e003d00u ^ ((q >> 8) & 0x7f); xv.z = 0xbe803f00u ^ ((q >> 16) & 0x3f); xv.w = 0x3d80be00u; }
#else
        const u32x4 xv = *(const u32x4*)(xin + (size_t)(sub * 32 + (lane >> 1)) * 256 + (lane & 1) * 8);
#endif
        __syncthreads();
        f32x4 chk_a = {bflo(xv.x), bfhi(xv.x), bflo(xv.y), bfhi(xv.y)}, chk_c = {bflo(xv.z), bfhi(xv.z), bflo(xv.w), bfhi(xv.w)};
        {
            *(f32x4*)(xs + (lane >> 1) * 16 + (lane & 1) * 8) = chk_a;
            *(f32x4*)(xs + (lane >> 1) * 16 + (lane & 1) * 8 + 4) = chk_c;
        }
        __syncthreads();
#pragma unroll 4
        for (int st = 0; st < 32; ++st) {
#if DBG_S5CONST == 3
            f32x4 x0, x1, x2, x3;
            { const float t = (float)((sub * 32 + st) & 63) * 0.015625f + (float)(id & 7) * 0.125f;
              x0 = (f32x4){t, t * 0.5f, -t, 0.25f}; x1 = (f32x4){0.5f - t, t * t, 0.125f, t}; x2 = (f32x4){-0.25f, t, 0.75f * t, 1.f - t}; x3 = (f32x4){t, -t, 0.5f, 0.3f * t}; }
#else
            const f32x4 x0 = *(const f32x4*)(xs + st * 16), x1 = *(const f32x4*)(xs + st * 16 + 4), x2 = *(const f32x4*)(xs + st * 16 + 8), x3 = *(const f32x4*)(xs + st * 16 + 12);
#endif
            float ur = 0.f, ui = 0.f;
#pragma unroll
            for (int h = 0; h < 4; ++h) {
                ur += br[h] * x0[h]; ui += bi[h] * x0[h];
                ur += br[4 + h] * x1[h]; ui += bi[4 + h] * x1[h];
                ur += br[8 + h] * x2[h]; ui += bi[8 + h] * x2[h];
                ur += br[12 + h] * x3[h]; ui += bi[12 + h] * x3[h];
            }
            const float nr = ar * hre - ai * him + ur, ni = ar * him + ai * hre + ui;
            hre = nr; him = ni;
            if (pass == 2) {
                *(bf16_t*)(Hs + st * 256 + (((lane >> 3) ^ (st & 15)) << 4) + (lane & 7) * 2) = f2bf(hre);
                *(bf16_t*)(Hs + st * 256 + ((((64 + lane) >> 3) ^ (st & 15)) << 4) + (lane & 7) * 2) = f2bf(him);
            }
        }
#if DBG_LDSCHK
        {
            const f32x4 ra = *(volatile f32x4*)(xs + (lane >> 1) * 16 + (lane & 1) * 8), rc = *(volatile f32x4*)(xs + (lane >> 1) * 16 + (lane & 1) * 8 + 4);
            bool bad = false;
            for (int q = 0; q < 4; ++q) bad |= (__float_as_uint(ra[q]) != __float_as_uint(chk_a[q])) | (__float_as_uint(rc[q]) != __float_as_uint(chk_c[q]));
            if (__any(bad)) ldsbad = 1;
        }
#endif
        if (pass == 2) {
            __syncthreads();
#pragma unroll
            for (int tt = 0; tt < 2; ++tt) {
                f32x4 acc = {0.f, 0.f, 0.f, 0.f};
                const int tl = tt * 16 + fr;
#pragma unroll
                for (int ks = 0; ks < 4; ++ks) {
                    const bf16x8 hf = *(const bf16x8*)(Hs + tl * 256 + (((4 * ks + fq) ^ (tl & 15)) << 4));
                    acc = mfma16(cf[ks], hf, acc);
                }
                float y[4];
#pragma unroll
                for (int r = 0; r < 4; ++r) y[r] = gelu_tanh(acc[r] + dv[r] * xs[tl * 16 + 4 * fq + r]);
                u32x2 o; o.x = pk_bf16(y[0], y[1]); o.y = pk_bf16(y[2], y[3]);
                *(u32x2*)(yg + (size_t)(sub * 32 + tl) * 256 + 4 * fq) = o;
            }
        }
    }
#if DBG_TWICE
    }
    if (__float_as_uint(keep_re) != __float_as_uint(hre) || __float_as_uint(keep_im) != __float_as_uint(him)) { hre = __uint_as_float(0x7fc00000u); him = hre; }
#endif
    if (pass == 1) {
        float* e = Eb + ((size_t)(seq * 16 + ch) * 64 + lane) * 2;
#if DBG_LDSCHK
        if (ldsbad) { hre = __uint_as_float(0x7fc00000u); him = hre; }
#endif
#if DBG_ESC1
        { const unsigned long long pk = ((unsigned long long)__float_as_uint(him) << 32) | __float_as_uint(hre);
          __hip_atomic_store((unsigned long long*)e, pk, __ATOMIC_RELAXED, __HIP_MEMORY_SCOPE_AGENT); }
#else
        e[0] = hre; e[1] = him;
#endif
#if DBG_E2
        float* e2 = (float*)(p.ws + OFF_C + C_ATT) + ((size_t)(seq * 16 + ch) * 64 + lane) * 2;
        e2[0] = hre; e2[1] = him;
#endif
    }
    __syncthreads();
}

__device__ __forceinline__ void phase_mid1(CKP& p, int l, unsigned char* lds) {
#if DBG_QDELAY == 2
    if (blockIdx.x >= 320) return;
#elif DBG_QDELAY == 3
    if (blockIdx.x >= 320) {
        const unsigned long long t0 = __builtin_amdgcn_s_memrealtime(); while (__builtin_amdgcn_s_memrealtime() - t0 < 3000ull) __builtin_amdgcn_s_sleep(8);
        s5_job(p, l, blockIdx.x - 320, 1, lds);
        return;
    }
#elif DBG_QDELAY
    if (blockIdx.x >= 320) {
        s5_job(p, l, blockIdx.x - 320, 1, lds);
        const unsigned long long t0 = __builtin_amdgcn_s_memrealtime(); while (__builtin_amdgcn_s_memrealtime() - t0 < 6000ull) __builtin_amdgcn_s_sleep(8);
        return;
    }
#endif
    for (int j = blockIdx.x; j < 64 + 256 + 512; j += gridDim.x) {
#if DBG_ONLYS5 == 1
        if (j >= 320) s5_job(p, l, j - 320, 1, lds);
#elif DBG_ONLYS5 == 2
        if (j < 64) compress_tile(p, j, lds);
        else if (j >= 320) s5_job(p, l, j - 320, 1, lds);
#elif DBG_ONLYS5 == 4
        { const int jj = 831 - j; if (jj < 64) compress_tile(p, jj, lds); else if (jj >= 320) s5_job(p, l, jj - 320, 1, lds); }
#elif DBG_ONLYS5 == 5
        if (j < 64) compress_tile(p, j, lds);
        else if (j >= 320 && j < 512) s5_job(p, l, j - 320, 1, lds);
        else if (j >= 576) s5_job(p, l, j - 320, 1, lds);
        if (j >= 448 && j < 512) s5_job(p, l, j + 64 - 320, 1, lds);
#elif DBG_ONLYS5 == 3
        if (j >= 64 && j < 320) sgu_job(p, l, j - 64, lds);
        else if (j >= 320) s5_job(p, l, j - 320, 1, lds);
#elif DBG_ONLYS5 == 6
        if (j < 512) {
#if DBG_PRESPIN
            { const unsigned long long t0 = __builtin_amdgcn_s_memrealtime(); while (__builtin_amdgcn_s_memrealtime() - t0 < (unsigned long long)DBG_PRESPIN) __builtin_amdgcn_s_sleep(2); }
#endif
            s5_job(p, l, j, 1, lds);
        }
        else if (j < 768) sgu_job(p, l, j - 512, lds);
        else compress_tile(p, j - 768, lds);
#else
        if (j < 64) compress_tile(p, j, lds);
        else if (j < 320) {
#if DBG_SGUSPIN
            { const unsigned long long t0 = __builtin_amdgcn_s_memrealtime(); while (__builtin_amdgcn_s_memrealtime() - t0 < (unsigned long long)DBG_SGUSPIN) __builtin_amdgcn_s_sleep(2); }
#else
            sgu_job(p, l, j - 64, lds);
#endif
        } else {
#if DBG_DELAY
            if (j >= 576) { const unsigned long long t0 = __builtin_amdgcn_s_memrealtime(); while (__builtin_amdgcn_s_memrealtime() - t0 < (unsigned long long)DBG_DELAY) __builtin_amdgcn_s_sleep(8); }
#endif
            s5_job(p, l, j - 320, 1, lds);
        }
#endif
    }
}

constexpr int AL_Q = 0, AL_K = 32768, AL_V = 40960, AL_IMP = 49152, AL_SEL = 65792, AL_UNI = 66304, AL_JOB = 66336;
constexpr float SM_C = 0.125f * 1.4426950408889634f;

__device__ __forceinline__ void attn_load_q(const bf16_t* Qg, const int* pos, const float (&inv_freq)[8], int b, int g, int t0, bool rope, unsigned char* lds, int tid) {
#pragma unroll 1
    for (int j = 0; j < 8; ++j) {
        const int pid = tid + 256 * j, Rr = pid >> 3, ch = pid & 7;
        const int wq = Rr >> 6, r = (Rr >> 4) & 3, q = Rr & 15, t = t0 + 16 * wq + q;
        const bf16_t* src = Qg + ((size_t)(b * SEQ + t)) * 512 + (g * 4 + r) * 64;
        if (!rope || ch >= 2) {
            *(u32x4*)(lds + AL_Q + Rr * 128 + ((ch ^ (Rr & 7)) << 4)) = *(const u32x4*)(src + ch * 8);
        } else if (ch == 0) {
            const u32x4 a = *(const u32x4*)(src), c = *(const u32x4*)(src + 8);
            float x1[8] = {bflo(a.x), bfhi(a.x), bflo(a.y), bfhi(a.y), bflo(a.z), bfhi(a.z), bflo(a.w), bfhi(a.w)};
            float x2[8] = {bflo(c.x), bfhi(c.x), bflo(c.y), bfhi(c.y), bflo(c.z), bfhi(c.z), bflo(c.w), bfhi(c.w)};
            const float ps = (float)pos[b * SEQ + t];
#pragma unroll
            for (int i = 0; i < 8; ++i) {
                float sn, cs; sincosf(ps * inv_freq[i], &sn, &cs);
                const float u = x1[i], v = x2[i];
                x1[i] = u * cs - v * sn; x2[i] = v * cs + u * sn;
            }
            u32x4 o1, o2;
            o1.x = pk_bf16(x1[0], x1[1]); o1.y = pk_bf16(x1[2], x1[3]); o1.z = pk_bf16(x1[4], x1[5]); o1.w = pk_bf16(x1[6], x1[7]);
            o2.x = pk_bf16(x2[0], x2[1]); o2.y = pk_bf16(x2[2], x2[3]); o2.z = pk_bf16(x2[4], x2[5]); o2.w = pk_bf16(x2[6], x2[7]);
            *(u32x4*)(lds + AL_Q + Rr * 128 + ((0 ^ (Rr & 7)) << 4)) = o1;
            *(u32x4*)(lds + AL_Q + Rr * 128 + ((1 ^ (Rr & 7)) << 4)) = o2;
        }
    }
}
__device__ __forceinline__ void attn_load_kv(const bf16_t* Kb, const bf16_t* Vb, int vstride, unsigned char* lds, int tid) {
#pragma unroll
    for (int j = 0; j < 2; ++j) {
        const int pid = tid + 256 * j, row = pid >> 3, ch = pid & 7;
        const u32x4 kk = *(const u32x4*)(Kb + (size_t)row * 128 + ch * 8);
        const u32x4 vv = *(const u32x4*)(Vb + (size_t)row * vstride + ch * 8);
        *(u32x4*)(lds + AL_K + row * 128 + ((ch ^ (row & 7)) << 4)) = kk;
        *(u32x4*)(lds + AL_V + row * 128 + ((ch ^ ((row >> 1) & 7)) << 4)) = vv;
    }
}
__device__ __forceinline__ void attn_qk(f32x4 (&s)[2][4], const unsigned char* lds, int w, int fr, int fq, int hf) {
    const unsigned char* Qw = lds + AL_Q + w * 8192;
    const unsigned char* Kh = lds + AL_K + hf * 4096;
    const int sw0 = ((fq) ^ (fr & 7)) << 4, sw1 = ((4 + fq) ^ (fr & 7)) << 4;
#pragma unroll
    for (int ki = 0; ki < 2; ++ki)
#pragma unroll
        for (int qi = 0; qi < 4; ++qi) s[ki][qi] = (f32x4){0.f, 0.f, 0.f, 0.f};
#pragma unroll
    for (int ds = 0; ds < 2; ++ds) {
        bf16x8 qf[4];
#pragma unroll
        for (int qi = 0; qi < 4; ++qi) qf[qi] = *(const bf16x8*)(Qw + (qi * 16 + fr) * 128 + (ds ? sw1 : sw0));
#pragma unroll
        for (int ki = 0; ki < 2; ++ki) {
            const bf16x8 kf = *(const bf16x8*)(Kh + (ki * 16 + fr) * 128 + (ds ? sw1 : sw0));
#pragma unroll
            for (int qi = 0; qi < 4; ++qi) s[ki][qi] = mfma16(kf, qf[qi], s[ki][qi]);
        }
    }
}
__device__ __forceinline__ void attn_pv(f32x4 (&o)[4][4], const f32x4 (&s)[2][4], const unsigned char* lds, int fr, int fq, int hf) {
    bf16x8 pf[4];
#pragma unroll
    for (int qi = 0; qi < 4; ++qi) {
        u32x4 u;
        u.x = pk_bf16(s[0][qi][0], s[0][qi][1]); u.y = pk_bf16(s[0][qi][2], s[0][qi][3]);
        u.z = pk_bf16(s[1][qi][0], s[1][qi][1]); u.w = pk_bf16(s[1][qi][2], s[1][qi][3]);
        pf[qi] = as_bf8(u);
    }
    const int c0 = 4 * hf + (fq >> 1);
#pragma unroll
    for (int di = 0; di < 4; ++di) {
        const int row = di * 16 + fr, key = (row >> 1) & 7;
        const u32x2 lo = *(const u32x2*)(lds + AL_V + row * 128 + ((c0 ^ key) << 4) + 8 * (fq & 1));
        const u32x2 hi = *(const u32x2*)(lds + AL_V + row * 128 + (((c0 + 2) ^ key) << 4) + 8 * (fq & 1));
        const bf16x8 vf = as_bf8((u32x4){lo.x, lo.y, hi.x, hi.y});
#pragma unroll
        for (int qi = 0; qi < 4; ++qi) o[di][qi] = mfma16(vf, pf[qi], o[di][qi]);
    }
}
__device__ __forceinline__ unsigned attn_vmask(int kb, int fq, int lo, int hi) {
    unsigned vm = 0;
#pragma unroll
    for (int ki = 0; ki < 2; ++ki)
#pragma unroll
        for (int r = 0; r < 4; ++r) { const int key = kb + 16 * ki + 4 * fq + r; if (key >= lo && key <= hi) vm |= 1u << (ki * 4 + r); }
    return vm;
}
__device__ __forceinline__ void attn_softmax(f32x4 (&s)[2][4], f32x4 (&o)[4][4], float (&m)[4], float (&lsum)[4], unsigned vm) {
#pragma unroll
    for (int qi = 0; qi < 4; ++qi) {
        float mx = -1e30f;
#pragma unroll
        for (int ki = 0; ki < 2; ++ki)
#pragma unroll
            for (int r = 0; r < 4; ++r) { const float sv = ((vm >> (ki * 4 + r)) & 1u) ? s[ki][qi][r] * SM_C : -1e30f; s[ki][qi][r] = sv; mx = fmaxf(mx, sv); }
        mx = fmaxf(mx, __shfl_xor(mx, 16)); mx = fmaxf(mx, __shfl_xor(mx, 32));
        const float mn = fmaxf(m[qi], mx), alpha = fexp2(m[qi] - mn);
        m[qi] = mn;
        float ls = 0.f;
#pragma unroll
        for (int ki = 0; ki < 2; ++ki)
#pragma unroll
            for (int r = 0; r < 4; ++r) { const float pv = ((vm >> (ki * 4 + r)) & 1u) ? fexp2(s[ki][qi][r] - mn) : 0.f; s[ki][qi][r] = pv; ls += pv; }
        lsum[qi] = lsum[qi] * alpha + ls;
#pragma unroll
        for (int di = 0; di < 4; ++di) o[di][qi] *= alpha;
    }
}
__device__ __forceinline__ void attn_accum(bf16_t* dst, const f32x4 (&o)[4][4], const float (&lsum)[4], const float (&gate)[4], bool first, int fq) {
#pragma unroll
    for (int qi = 0; qi < 4; ++qi) {
        float lt = lsum[qi]; lt += __shfl_xor(lt, 16); lt += __shfl_xor(lt, 32);
        const float sc = gate[qi] / fmaxf(lt, 1e-30f);
#pragma unroll
        for (int di = 0; di < 4; ++di) {
            u32x2* ptr = (u32x2*)(dst + qi * 64 + 16 * di + 4 * fq);
            float a0 = o[di][qi][0] * sc, a1 = o[di][qi][1] * sc, a2 = o[di][qi][2] * sc, a3 = o[di][qi][3] * sc;
            if (!first) { const u32x2 f = *ptr; a0 += bflo(f.x); a1 += bfhi(f.x); a2 += bflo(f.y); a3 += bfhi(f.y); }
            u32x2 r; r.x = pk_bf16(a0, a1); r.y = pk_bf16(a2, a3);
            *ptr = r;
        }
    }
}

__device__ __forceinline__ void phase_attn(CKP& p, int l, unsigned char* lds, unsigned* ctl) {
    for (int j = blockIdx.x; j < 512; j += gridDim.x) s5_job(p, l, j, 2, lds);

    unsigned char* R = p.ws + OFF_R; unsigned char* C = p.ws + OFF_C;
    const bf16_t* Qg = (const bf16_t*)(R + R_Q);
    const bf16_t* Kc = (const bf16_t*)(C + C_KCMP); const bf16_t* Vc = (const bf16_t*)(C + C_VCT);
    const bf16_t* Ks = (const bf16_t*)(R + R_KS); const bf16_t* Vs = (const bf16_t*)(R + R_VST);
    const bf16_t* Kw = (const bf16_t*)(R + R_KW); const bf16_t* Vw = (const bf16_t*)(R + R_VWT);
    const float* NG = (const float*)(R + R_NG);
    bf16_t* AO = (bf16_t*)(C + C_ATT);
    const int* pos = (const int*)p.in[1];
    unsigned* ctr = ctl + CTL_ATTN + l;
    volatile int* jobp = (volatile int*)(lds + AL_JOB);
    float* imp = (float*)(lds + AL_IMP);
    unsigned long long* selm = (unsigned long long*)(lds + AL_SEL);
    unsigned long long* uni = (unsigned long long*)(lds + AL_UNI);
    float invf[8];
#pragma unroll
    for (int q = 0; q < 8; ++q) invf[q] = p.inv_freq[q];

    for (;;) {
        const int tid = opaque_tid(), lane = tid & 63, w = tid >> 6, fr = lane & 15, fq = lane >> 4;
        __syncthreads();
        if (tid == 0) *jobp = (int)atomicAdd(ctr, 1u);
        __syncthreads();
        const int job = *jobp;
        if (job >= 1024) break;
        const int i = 63 - (job >> 4), bg = job & 15, b = bg >> 1, g = bg & 1, t0 = i * 64;
        const int tq = t0 + 16 * w + fr;
        const size_t kvrow = (size_t)b * SEQ;
        float gate[4];
        bf16_t* dstq = AO + ((size_t)(kvrow + tq)) * 512 + (g * 4) * 64;

        attn_load_q(Qg, pos, invf, b, g, t0, false, lds, tid);
        const int ntc = ((4 * i + 2) >> 6) + 1;
        const int hic = (tq >= 31) ? ((tq - 31) >> 4) : -1;
        float m[4], lsum[4];
#pragma unroll
        for (int qi = 0; qi < 4; ++qi) { m[qi] = -1e30f; lsum[qi] = 0.f; }
        {
#pragma unroll 1
            for (int ct = 0; ct < ntc; ++ct) {
                __syncthreads();
                attn_load_kv(Kc + ((size_t)(b * 256 + ct * 64)) * 128 + g * 64, Vc + ((size_t)((b * 2 + g) * 64)) * 256 + ct * 64, 256, lds, tid);
                __syncthreads();
#pragma unroll 1
                for (int hf = 0; hf < 2; ++hf) {
                    f32x4 s[2][4];
                    attn_qk(s, lds, w, fr, fq, hf);
                    const unsigned vm = attn_vmask(ct * 64 + hf * 32, fq, 0, hic);
#pragma unroll
                    for (int qi = 0; qi < 4; ++qi) {
                        float mx = -1e30f;
#pragma unroll
                        for (int ki = 0; ki < 2; ++ki)
#pragma unroll
                            for (int r = 0; r < 4; ++r) { const float sv = ((vm >> (ki * 4 + r)) & 1u) ? s[ki][qi][r] * SM_C : -1e30f; s[ki][qi][r] = sv; mx = fmaxf(mx, sv); }
                        mx = fmaxf(mx, __shfl_xor(mx, 16)); mx = fmaxf(mx, __shfl_xor(mx, 32));
                        const float mn = fmaxf(m[qi], mx), alpha = fexp2(m[qi] - mn);
                        m[qi] = mn;
                        float ls = 0.f;
#pragma unroll
                        for (int ki = 0; ki < 2; ++ki)
#pragma unroll
                            for (int r = 0; r < 4; ++r) ls += ((vm >> (ki * 4 + r)) & 1u) ? fexp2(s[ki][qi][r] - mn) : 0.f;
                        lsum[qi] = lsum[qi] * alpha + ls;
                    }
                }
            }
        }
        float invl[4];
#pragma unroll
        for (int qi = 0; qi < 4; ++qi) { float lt = lsum[qi]; lt += __shfl_xor(lt, 16); lt += __shfl_xor(lt, 32); invl[qi] = 1.f / fmaxf(lt, 1e-30f); }
        {
            f32x4 o[4][4]; zero_acc(o);
            float carry = 0.f;
#pragma unroll 1
            for (int ct = 0; ct < ntc; ++ct) {
                __syncthreads();
                attn_load_kv(Kc + ((size_t)(b * 256 + ct * 64)) * 128 + g * 64, Vc + ((size_t)((b * 2 + g) * 64)) * 256 + ct * 64, 256, lds, tid);
                __syncthreads();
#pragma unroll 1
                for (int hf = 0; hf < 2; ++hf) {
                    f32x4 s[2][4];
                    attn_qk(s, lds, w, fr, fq, hf);
                    const unsigned vm = attn_vmask(ct * 64 + hf * 32, fq, 0, hic);
#pragma unroll
                    for (int qi = 0; qi < 4; ++qi)
#pragma unroll
                        for (int ki = 0; ki < 2; ++ki)
#pragma unroll
                            for (int r = 0; r < 4; ++r) s[ki][qi][r] = ((vm >> (ki * 4 + r)) & 1u) ? fexp2(s[ki][qi][r] * SM_C - m[qi]) * invl[qi] : 0.f;
#pragma unroll
                    for (int ki = 0; ki < 2; ++ki) {
                        float a = 0.f, bq = 0.f;
#pragma unroll
                        for (int qi = 0; qi < 4; ++qi) { a += s[ki][qi][0] + s[ki][qi][1] + s[ki][qi][2] + 0.5f * s[ki][qi][3]; bq += 0.5f * s[ki][qi][3]; }
                        const float up = __shfl(bq, (lane + 48) & 63);
                        const float wrap = __shfl(carry, (lane + 48) & 63);
                        a += (fq >= 1) ? up : wrap;
                        carry = bq;
                        imp[(16 * w + fr) * 65 + 16 * ct + 8 * hf + 4 * ki + fq] = a;
                    }
                    attn_pv(o, s, lds, fr, fq, hf);
                }
            }
#pragma unroll
            for (int qi = 0; qi < 4; ++qi) gate[qi] = NG[((size_t)(kvrow + tq)) * 24 + (g * 4 + qi) * 3 + 0];
            const float quarter[4] = {0.25f, 0.25f, 0.25f, 0.25f};
            attn_accum(dstq, o, quarter, gate, true, fq);
        }
        __syncthreads();
        {
            const int q = tid >> 2, part = tid & 3;
            unsigned long long mk = 0ull;
            if (i <= 15) { mk = (i == 63) ? ~0ull : ((1ull << (i + 1)) - 1ull); }
            else {
                const float* row = imp + q * 65;
                for (int j = 1 + part; j <= i - 2; j += 4) {
                    const float vj = row[j]; int rank = 0;
                    for (int j2 = 1; j2 <= i - 2; ++j2) { const float v2 = row[j2]; rank += (v2 > vj || (v2 == vj && j2 < j)) ? 1 : 0; }
                    if (rank < 13) mk |= 1ull << j;
                }
                unsigned lo32 = (unsigned)mk, hi32 = (unsigned)(mk >> 32);
                lo32 |= __shfl_xor(lo32, 1); hi32 |= __shfl_xor(hi32, 1);
                lo32 |= __shfl_xor(lo32, 2); hi32 |= __shfl_xor(hi32, 2);
                mk = ((unsigned long long)hi32 << 32) | lo32;
                mk |= 1ull | (1ull << i) | (1ull << (i - 1));
            }
            if (part == 0) selm[q] = mk;
            unsigned lo32 = (unsigned)mk, hi32 = (unsigned)(mk >> 32);
#pragma unroll
            for (int o2 = 32; o2 >= 1; o2 >>= 1) { lo32 |= __shfl_xor(lo32, o2); hi32 |= __shfl_xor(hi32, o2); }
            if (lane == 0) uni[w] = ((unsigned long long)hi32 << 32) | lo32;
        }
        __syncthreads();
        const unsigned long long mymask = selm[16 * w + fr];
        const unsigned long long un = uni[0] | uni[1] | uni[2] | uni[3];
        __syncthreads();
        attn_load_q(Qg, pos, invf, b, g, t0, true, lds, tid);
        {
            f32x4 o[4][4]; zero_acc(o);
#pragma unroll
            for (int qi = 0; qi < 4; ++qi) { m[qi] = -1e30f; lsum[qi] = 0.f; }
#pragma unroll 1
            for (int j = 0; j <= i; ++j) {
                if (!((un >> j) & 1ull)) continue;
                __syncthreads();
                attn_load_kv(Ks + (kvrow + j * 64) * 128 + g * 64, Vs + ((size_t)((b * 2 + g) * 64)) * SEQ + j * 64, SEQ, lds, tid);
                __syncthreads();
                const int hi = ((mymask >> j) & 1ull) ? tq : -1;
#pragma unroll 1
                for (int hf = 0; hf < 2; ++hf) {
                    f32x4 s[2][4];
                    attn_qk(s, lds, w, fr, fq, hf);
                    const unsigned vm = attn_vmask(j * 64 + hf * 32, fq, 0, hi);
                    attn_softmax(s, o, m, lsum, vm);
                    attn_pv(o, s, lds, fr, fq, hf);
                }
            }
#pragma unroll
            for (int qi = 0; qi < 4; ++qi) gate[qi] = NG[((size_t)(kvrow + tq)) * 24 + (g * 4 + qi) * 3 + 1];
            attn_accum(dstq, o, lsum, gate, false, fq);
        }
        {
            f32x4 o[4][4]; zero_acc(o);
#pragma unroll
            for (int qi = 0; qi < 4; ++qi) { m[qi] = -1e30f; lsum[qi] = 0.f; }
            const int j0 = (i >= 8) ? (i - 8) : 0;
#pragma unroll 1
            for (int j = j0; j <= i; ++j) {
                __syncthreads();
                attn_load_kv(Kw + (kvrow + j * 64) * 128 + g * 64, Vw + ((size_t)((b * 2 + g) * 64)) * SEQ + j * 64, SEQ, lds, tid);
                __syncthreads();
#pragma unroll 1
                for (int hf = 0; hf < 2; ++hf) {
                    f32x4 s[2][4];
                    attn_qk(s, lds, w, fr, fq, hf);
                    const unsigned vm = attn_vmask(j * 64 + hf * 32, fq, tq - 511, tq);
                    attn_softmax(s, o, m, lsum, vm);
                    attn_pv(o, s, lds, fr, fq, hf);
                }
            }
#pragma unroll
            for (int qi = 0; qi < 4; ++qi) gate[qi] = NG[((size_t)(kvrow + tq)) * 24 + (g * 4 + qi) * 3 + 2];
            attn_accum(dstq, o, lsum, gate, false, fq);
        }
    }
}

__device__ __forceinline__ void phase_glu(CKP& p, int l, unsigned char* lds) {
    const int tid = opaque_tid(), lane = tid & 63, w = tid >> 6, wm = w >> 1, wn = w & 1, fr = lane & 15, fq = lane >> 4;
    const bf16_t* A = (const bf16_t*)(p.ws + OFF_C + C_YG);
    const bf16_t* Bt = (const bf16_t*)(p.ws + OFF_W + W_GLU);
    bf16_t* O = (bf16_t*)(p.ws + OFF_C + C_S5O);
    const float* gb = p.in[24] + (size_t)l * 256;
    constexpr int NTM = NTOK / 128, NTN = 2;
    for (int L = blockIdx.x; L < NTM * NTN; L += gridDim.x) {
        int tm, tn; tile_coords(L, NTM, NTN, tm, tn);
        const int m0 = tm * 128, n0 = tn * 128;
        f32x4 acc[4][4]; zero_acc(acc);
        gemm_kloop(acc, [&](int r) { return A + (size_t)(m0 + r) * 256; }, 64, [&](int v) { return Bt + (size_t)(n0 + v) * 256; }, 64, 4, lds, tid);
#pragma unroll
        for (int mi = 0; mi < 4; ++mi) {
            const int row = m0 + 64 * wm + 16 * mi + fr, col = n0 + 64 * wn + 16 * fq;
            const u32x4 y0 = *(const u32x4*)(A + (size_t)row * 256 + col), y1 = *(const u32x4*)(A + (size_t)row * 256 + col + 8);
            const unsigned yy[8] = {y0.x, y0.y, y0.z, y0.w, y1.x, y1.y, y1.z, y1.w};
            float v[16];
#pragma unroll
            for (int e = 0; e < 16; ++e) {
                const float y = (e & 1) ? bfhi(yy[e >> 1]) : bflo(yy[e >> 1]);
                v[e] = y * sigm(acc[mi][e >> 2][e & 3] + gb[col + e]);
            }
            store16bf(O + (size_t)row * 256 + col, v);
        }
    }
}

__device__ __forceinline__ void phase_branch(CKP& p, int l, unsigned char* lds) {
    const int tid = opaque_tid(), lane = tid & 63, w = tid >> 6, wm = w >> 1, wn = w & 1, fr = lane & 15, fq = lane >> 4;
    const bf16_t* H = (const bf16_t*)(p.ws + OFF_H);
    const bf16_t* Wgb = (const bf16_t*)(p.ws + OFF_W + W_GB);
    bf16_t* Mg = (bf16_t*)(p.ws + OFF_M);
    bf16_t* Yt = (bf16_t*)(p.ws + OFF_R);
    constexpr int NTM = NTOK / 128, NTN = 8;
    for (int L = blockIdx.x; L < NTM * NTN; L += gridDim.x) {
        int tm, tn; tile_coords(L, NTM, NTN, tm, tn);
        const int m0 = tm * 128, n0 = tn * 128;
#pragma unroll 1
        for (int br = 0; br < 3; ++br) {
            const bf16_t* Ab; const bf16_t* Wb; int Kb;
            if (br == 0) { Ab = (const bf16_t*)(p.ws + OFF_C + C_ATT); Wb = (const bf16_t*)(p.ws + OFF_W + W_A); Kb = 512; }
            else if (br == 1) { Ab = (const bf16_t*)(p.ws + OFF_C + C_SGU); Wb = (const bf16_t*)(p.ws + OFF_W + W_S); Kb = 256; }
            else { Ab = (const bf16_t*)(p.ws + OFF_C + C_S5O); Wb = (const bf16_t*)(p.ws + OFF_W + W_5); Kb = 256; }
            {
                f32x4 acc[4][4]; zero_acc(acc);
                gemm_kloop(acc, [&](int r) { return Ab + (size_t)(m0 + r) * Kb; }, 64, [&](int v) { return Wb + (size_t)(n0 + v) * Kb; }, 64, Kb >> 6, lds, tid);
#pragma unroll
                for (int mi = 0; mi < 4; ++mi) {
                    const int row = m0 + 64 * wm + 16 * mi + fr, col = n0 + 64 * wn + 16 * fq;
                    float v[16];
#pragma unroll
                    for (int e = 0; e < 16; ++e) v[e] = acc[mi][e >> 2][e & 3];
                    store16bf(Yt + (size_t)row * 1024 + col, v);
                }
            }
            {
                f32x4 acc[4][4]; zero_acc(acc);
                gemm_kloop(acc, [&](int r) { return H + (size_t)(m0 + r) * 1024; }, 64, [&](int v) { return Wgb + (size_t)(br * 1024 + n0 + v) * 1024; }, 64, 16, lds, tid);
#pragma unroll
                for (int mi = 0; mi < 4; ++mi) {
                    const int row = m0 + 64 * wm + 16 * mi + fr, col = n0 + 64 * wn + 16 * fq;
                    u32x4* dst = (u32x4*)(Mg + (size_t)row * 1024 + col);
                    const u32x4* ysrc = (const u32x4*)(Yt + (size_t)row * 1024 + col);
                    const u32x4 y0 = ysrc[0], y1 = ysrc[1];
                    const unsigned yy[8] = {y0.x, y0.y, y0.z, y0.w, y1.x, y1.y, y1.z, y1.w};
                    unsigned pp[8] = {0u, 0u, 0u, 0u, 0u, 0u, 0u, 0u};
                    if (br > 0) { const u32x4 p0 = dst[0], p1 = dst[1]; pp[0] = p0.x; pp[1] = p0.y; pp[2] = p0.z; pp[3] = p0.w; pp[4] = p1.x; pp[5] = p1.y; pp[6] = p1.z; pp[7] = p1.w; }
                    unsigned outw[8];
#pragma unroll
                    for (int ni = 0; ni < 4; ++ni) {
                        const float a0 = sigm(acc[mi][ni][0]) * bflo(yy[2 * ni]) + bflo(pp[2 * ni]), a1 = sigm(acc[mi][ni][1]) * bfhi(yy[2 * ni]) + bfhi(pp[2 * ni]);
                        const float a2 = sigm(acc[mi][ni][2]) * bflo(yy[2 * ni + 1]) + bflo(pp[2 * ni + 1]), a3 = sigm(acc[mi][ni][3]) * bfhi(yy[2 * ni + 1]) + bfhi(pp[2 * ni + 1]);
                        outw[2 * ni] = pk_bf16(a0, a1); outw[2 * ni + 1] = pk_bf16(a2, a3);
                    }
                    dst[0] = (u32x4){outw[0], outw[1], outw[2], outw[3]};
                    dst[1] = (u32x4){outw[4], outw[5], outw[6], outw[7]};
                }
            }
        }
    }
}

__device__ __forceinline__ void phase_mix(CKP& p, int l, unsigned char* lds) {
    const int tid = opaque_tid(), lane = tid & 63, w = tid >> 6, wm = w >> 1, wn = w & 1, fr = lane & 15, fq = lane >> 4;
    const bf16_t* A = (const bf16_t*)(p.ws + OFF_M);
    const bf16_t* Bt = (const bf16_t*)(p.ws + OFF_W + W_M);
    constexpr int NTM = NTOK / 128, NTN = 8;
    for (int L = blockIdx.x; L < NTM * NTN; L += gridDim.x) {
        int tm, tn; tile_coords(L, NTM, NTN, tm, tn);
        const int m0 = tm * 128, n0 = tn * 128;
        f32x4 acc[4][4]; zero_acc(acc);
        gemm_kloop(acc, [&](int r) { return A + (size_t)(m0 + r) * 1024; }, 64, [&](int v) { return Bt + (size_t)(n0 + v) * 1024; }, 64, 16, lds, tid);
#pragma unroll
        for (int mi = 0; mi < 4; ++mi) {
            const int row = m0 + 64 * wm + 16 * mi + fr, col = n0 + 64 * wn + 16 * fq;
            float* xp = p.xbuf + (size_t)row * 1024 + col;
#pragma unroll
            for (int ni = 0; ni < 4; ++ni) { f32x4 xv = *(f32x4*)(xp + 4 * ni); xv += acc[mi][ni]; *(f32x4*)(xp + 4 * ni) = xv; }
        }
    }
}

__device__ __forceinline__ void phase_router(CKP& p, int l, unsigned char* lds, unsigned* ctl) {
    const int tid = opaque_tid(), lane = tid & 63, w = tid >> 6, wm = w >> 1, wn = w & 1, fr = lane & 15, fq = lane >> 4;
    const float* gam = p.in[27] + (size_t)l * 1024;
    const float* bg = p.in[29] + (size_t)l * 4;
    const float* be = p.in[31] + (size_t)l * 32;
    bf16_t* h2 = (bf16_t*)(p.ws + OFF_M);
    bf16_t* hlo = (bf16_t*)(p.ws + OFF_H);
    const bf16_t* Wh = (const bf16_t*)(p.ws + OFF_W + W_RH);
    const bf16_t* Wl = (const bf16_t*)(p.ws + OFF_W + W_RL);
    unsigned* cnt = ctl + CTL_MOECNT + l * 32;
    int* list = (int*)(p.ws + OFF_MOE + MOE_LIST);
    float* wsl = (float*)(p.ws + OFF_MOE + MOE_WS);
    float* lg = (float*)lds;
    int* lc = (int*)(lds + 18432); int* gbs = (int*)(lds + 18432 + 128);
    for (int tile = blockIdx.x; tile < NTOK / 128; tile += gridDim.x) {
        const int r0 = tile * 128;
        {
            f32x4 gv[4];
#pragma unroll
            for (int i = 0; i < 4; ++i) gv[i] = *(const f32x4*)(gam + 4 * lane + 256 * i);
            for (int rr = 0; rr < 32; rr += 2) {
                const int row = r0 + w * 32 + rr;
                f32x4 xa[4], xb[4]; float sa = 0.f, sb = 0.f;
#pragma unroll
                for (int i = 0; i < 4; ++i) { xa[i] = *(const f32x4*)(p.xbuf + (size_t)row * 1024 + 4 * lane + 256 * i); xb[i] = *(const f32x4*)(p.xbuf + (size_t)(row + 1) * 1024 + 4 * lane + 256 * i); }
#pragma unroll
                for (int i = 0; i < 4; ++i) { sa += xa[i][0] * xa[i][0] + xa[i][1] * xa[i][1] + xa[i][2] * xa[i][2] + xa[i][3] * xa[i][3]; sb += xb[i][0] * xb[i][0] + xb[i][1] * xb[i][1] + xb[i][2] * xb[i][2] + xb[i][3] * xb[i][3]; }
                sa = wave_sum(sa); sb = wave_sum(sb);
                const float ra_ = rsqrtf(sa * (1.f / 1024.f) + RMS_EPS), rb_ = rsqrtf(sb * (1.f / 1024.f) + RMS_EPS);
#pragma unroll
                for (int i = 0; i < 4; ++i) {
                    const f32x4 ha = xa[i] * ra_ * gv[i], hb = xb[i] * rb_ * gv[i];
                    u32x2 oa, ob, la, lb;
                    oa.x = pk_bf16(ha[0], ha[1]); oa.y = pk_bf16(ha[2], ha[3]); ob.x = pk_bf16(hb[0], hb[1]); ob.y = pk_bf16(hb[2], hb[3]);
                    la.x = pk_bf16(ha[0] - bflo(oa.x), ha[1] - bfhi(oa.x)); la.y = pk_bf16(ha[2] - bflo(oa.y), ha[3] - bfhi(oa.y));
                    lb.x = pk_bf16(hb[0] - bflo(ob.x), hb[1] - bfhi(ob.x)); lb.y = pk_bf16(hb[2] - bflo(ob.y), hb[3] - bfhi(ob.y));
                    *(u32x2*)(h2 + (size_t)row * 1024 + 4 * lane + 256 * i) = oa; *(u32x2*)(h2 + (size_t)(row + 1) * 1024 + 4 * lane + 256 * i) = ob;
                    *(u32x2*)(hlo + (size_t)row * 1024 + 4 * lane + 256 * i) = la; *(u32x2*)(hlo + (size_t)(row + 1) * 1024 + 4 * lane + 256 * i) = lb;
                }
            }
        }
        asm volatile("s_waitcnt vmcnt(0)" ::: "memory");
        __syncthreads();
        f32x4 acc[4][4]; zero_acc(acc);
        gemm_kloop(acc, [&](int r) { return h2 + (size_t)(r0 + r) * 1024; }, 64, [&](int v) { return Wh + (size_t)(v < 63 ? v : 63) * 1024; }, 64, 16, lds, tid);
        gemm_kloop(acc, [&](int r) { return h2 + (size_t)(r0 + r) * 1024; }, 64, [&](int v) { return Wl + (size_t)(v < 63 ? v : 63) * 1024; }, 64, 16, lds, tid);
        gemm_kloop(acc, [&](int r) { return hlo + (size_t)(r0 + r) * 1024; }, 64, [&](int v) { return Wh + (size_t)(v < 63 ? v : 63) * 1024; }, 64, 16, lds, tid);
        if (tid < 32) lc[tid] = 0;
        if (wn == 0 && fq < 3) {
#pragma unroll
            for (int mi = 0; mi < 4; ++mi) {
                const int row = 64 * wm + 16 * mi + fr;
#pragma unroll
                for (int e = 0; e < 16; ++e) { const int col = 16 * fq + e; if (col < 36) lg[row * 36 + col] = acc[mi][e >> 2][e & 3]; }
            }
        }
        __syncthreads();
        int e0 = 0, e1 = 0, lr0 = 0, lr1 = 0; float c0 = 0.f, c1 = 0.f;
        if (tid < 128) {
            const float* lrow = lg + tid * 36;
            float gl[4]; int grp = 0; float gm = -3.4e38f;
#pragma unroll
            for (int q = 0; q < 4; ++q) { gl[q] = lrow[q] + bg[q]; if (gl[q] > gm) { gm = gl[q]; grp = q; } }
            float gsum = 0.f;
#pragma unroll
            for (int q = 0; q < 4; ++q) gsum += expf(gl[q] - gm);
            const float grp_w = 1.f / gsum;
            float el[8]; float em = -3.4e38f;
#pragma unroll
            for (int q = 0; q < 8; ++q) { el[q] = lrow[4 + grp * 8 + q] + be[grp * 8 + q]; em = fmaxf(em, el[q]); }
            float esum = 0.f; float ep[8];
#pragma unroll
            for (int q = 0; q < 8; ++q) { ep[q] = expf(el[q] - em); esum += ep[q]; }
            int j0 = 0; float p0 = -1.f;
#pragma unroll
            for (int q = 0; q < 8; ++q) { const float pq = ep[q] / esum; ep[q] = pq; if (pq > p0) { p0 = pq; j0 = q; } }
            int j1 = 0; float p1 = -1.f;
#pragma unroll
            for (int q = 0; q < 8; ++q) { if (q != j0 && ep[q] > p1) { p1 = ep[q]; j1 = q; } }
            const float den = p0 + p1;
            c0 = grp_w * p0 / den; c1 = grp_w * p1 / den;
            e0 = grp * 8 + j0; e1 = grp * 8 + j1;
            lr0 = atomicAdd(&lc[e0], 1); lr1 = atomicAdd(&lc[e1], 1);
        }
        __syncthreads();
        if (tid < 32) { const int n = lc[tid]; gbs[tid] = n ? (int)atomicAdd(&cnt[tid], (unsigned)n) : 0; }
        __syncthreads();
        if (tid < 128) {
            const int tok = r0 + tid;
            list[e0 * 32768 + gbs[e0] + lr0] = tok * 2; list[e1 * 32768 + gbs[e1] + lr1] = tok * 2 + 1;
            wsl[tok * 2] = c0; wsl[tok * 2 + 1] = c1;
        }
        __syncthreads();
    }
}

__device__ __forceinline__ bool moe_tile(const unsigned* cnt, int L, int nsub, int& e, int& mt, int& sub, int& rowbase, int& n) {
    const int lane = threadIdx.x & 63;
    const int c = (lane < 32) ? (int)cnt[lane] : 0;
    const int nt = (c + 127) >> 7;
    int pre = nt;
#pragma unroll
    for (int o = 1; o < 32; o <<= 1) { const int v = __shfl_up(pre, o); if (lane >= o) pre += v; }
    const int excl = pre - nt;
    const bool mine = (lane < 32) && (L >= excl * nsub) && (L < pre * nsub);
    const unsigned long long bal = __ballot(mine);
    if (bal == 0ull) return false;
    e = __ffsll((long long)bal) - 1;
    const int ex = __shfl(excl, e);
    n = __shfl(c, e);
    const int r = L - ex * nsub;
    mt = r / nsub; sub = r % nsub; rowbase = ex * 128;
    return true;
}
__device__ __forceinline__ void phase_exp1(CKP& p, int l, unsigned char* lds, unsigned* ctl) {
    const int tid = opaque_tid(), lane = tid & 63, w = tid >> 6, wm = w >> 1, wn = w & 1, fr = lane & 15, fq = lane >> 4;
    const unsigned* cnt = ctl + CTL_MOECNT + l * 32;
    const int* list = (const int*)(p.ws + OFF_MOE + MOE_LIST);
    const bf16_t* h2 = (const bf16_t*)(p.ws + OFF_M);
    bf16_t* hid = (bf16_t*)(p.ws + OFF_HID);
    for (int L = blockIdx.x;; L += gridDim.x) {
        int e, mt, sub, rowbase, n;
        if (!moe_tile(cnt, L, 8, e, mt, sub, rowbase, n)) break;
        const bf16_t* Wg = (const bf16_t*)(p.ws + OFF_W + W_EG) + (size_t)e * 512 * 1024;
        const bf16_t* Wu = (const bf16_t*)(p.ws + OFF_W + W_EU) + (size_t)e * 512 * 1024;
        const int j0 = sub * 64;
        f32x4 acc[4][4]; zero_acc(acc);
        gemm_kloop(acc, [&](int r) { int s = mt * 128 + r; s = s < n ? s : n - 1; const int slot = list[e * 32768 + s]; return h2 + (size_t)(slot >> 1) * 1024; }, 64,
                   [&](int v) { const int wn_ = v >> 6, fq_ = (v >> 4) & 3, ee = v & 15; const int hc = j0 + 32 * wn_ + 8 * fq_ + (ee & 7);
                                return ((ee >> 3) ? Wu : Wg) + (size_t)hc * 1024; }, 64, 16, lds, tid);
#pragma unroll
        for (int mi = 0; mi < 4; ++mi) {
            const int r = mt * 128 + 64 * wm + 16 * mi + fr;
            if (r < n) {
                float gv[8], uv[8];
#pragma unroll
                for (int e2 = 0; e2 < 8; ++e2) { gv[e2] = acc[mi][e2 >> 2][e2 & 3]; uv[e2] = acc[mi][2 + (e2 >> 2)][e2 & 3]; }
                float hv[8];
#pragma unroll
                for (int e2 = 0; e2 < 8; ++e2) hv[e2] = gv[e2] * sigm(gv[e2]) * uv[e2];
                u32x4 o; o.x = pk_bf16(hv[0], hv[1]); o.y = pk_bf16(hv[2], hv[3]); o.z = pk_bf16(hv[4], hv[5]); o.w = pk_bf16(hv[6], hv[7]);
                *(u32x4*)(hid + (size_t)(rowbase + r) * 512 + j0 + 32 * wn + 8 * fq) = o;
            }
        }
    }
}
__device__ __forceinline__ void phase_exp2(CKP& p, int l, unsigned char* lds, unsigned* ctl) {
    const int tid = opaque_tid(), lane = tid & 63, w = tid >> 6, wm = w >> 1, wn = w & 1, fr = lane & 15, fq = lane >> 4;
    const unsigned* cnt = ctl + CTL_MOECNT + l * 32;
    const int* list = (const int*)(p.ws + OFF_MOE + MOE_LIST);
    const float* wsl = (const float*)(p.ws + OFF_MOE + MOE_WS);
    const bf16_t* hid = (const bf16_t*)(p.ws + OFF_HID);
    bf16_t* ys = (bf16_t*)(p.ws + OFF_YS);
    for (int L = blockIdx.x;; L += gridDim.x) {
        int e, mt, sub, rowbase, n;
        if (!moe_tile(cnt, L, 8, e, mt, sub, rowbase, n)) break;
        const bf16_t* Wd = (const bf16_t*)(p.ws + OFF_W + W_ED) + (size_t)e * 1024 * 512;
        const int n0 = sub * 128;
        f32x4 acc[4][4]; zero_acc(acc);
        gemm_kloop(acc, [&](int r) { int s = mt * 128 + r; s = s < n ? s : n - 1; return hid + (size_t)(rowbase + s) * 512; }, 64,
                   [&](int v) { return Wd + (size_t)(n0 + v) * 512; }, 64, 8, lds, tid);
#pragma unroll
        for (int mi = 0; mi < 4; ++mi) {
            const int r = mt * 128 + 64 * wm + 16 * mi + fr;
            if (r < n) {
                const int slot = list[e * 32768 + r]; const float wt = wsl[slot];
                float v[16];
#pragma unroll
                for (int e2 = 0; e2 < 16; ++e2) v[e2] = acc[mi][e2 >> 2][e2 & 3] * wt;
                store16bf(ys + (size_t)slot * 1024 + n0 + 64 * wn + 16 * fq, v);
            }
        }
    }
}

constexpr int PH_PER_LAYER = 10;
constexpr int NPHASE = PH_PER_LAYER * DEPTH + 1;

__global__ __attribute__((target("no-packed-fp32-ops"))) void __launch_bounds__(NTHR, 2) mega(KP p_unused) {
    extern __shared__ __attribute__((aligned(16))) unsigned char lds[];
    unsigned* ctl = (unsigned*)(p_unused.ws + OFF_CTL);
#if ONE_LAUNCH
    XcdBarrier xb = xcd_barrier_post(ctl + CTL_BAR, (volatile LAS unsigned*)(lds + LDS_BAR));
    if (p_unused.never) cg::this_grid().sync();
#if DBG_PREFLUSH
    __builtin_amdgcn_fence(__ATOMIC_RELEASE, "");
    asm volatile("s_waitcnt vmcnt(0)" ::: "memory");
    __builtin_amdgcn_fence(__ATOMIC_ACQUIRE, "");
    asm volatile("s_waitcnt vmcnt(0)" ::: "memory");
    xcd_barrier(xb);
    { const unsigned long long t0 = __builtin_amdgcn_s_memrealtime(); while (__builtin_amdgcn_s_memrealtime() - t0 < 20000ull) __builtin_amdgcn_s_sleep(8); }
    xcd_barrier(xb);
#endif
#endif
    CKP* kp0 = (CKP*)__builtin_amdgcn_kernarg_segment_ptr();
    const int ph_lo = kp0->ph_lo, ph_hi = kp0->ph_hi;
#if ONE_LAUNCH
#define PH_SYNC(PH) if ((PH) + 1 < ph_hi) xcd_barrier(xb);
#else
#define PH_SYNC(PH)
#endif
#if DBG_TIMEPH >= 0
#define PH_STAMP(PH) if (blockIdx.x == 0 && threadIdx.x == 0) ((unsigned long long*)(kp0->ws + OFF_CTL + 24576))[(PH)] = __builtin_amdgcn_s_memrealtime();
#else
#define PH_STAMP(PH)
#endif
#define RUN_PHASE(PH, CALL) if (ph_lo <= (PH) && (PH) < ph_hi) { PH_STAMP(PH) CKP* kp = kp0; asm volatile("" : "+s"(kp)); CKP& p = *kp; const int rep_ = 0; (void)rep_; CALL; \
    if ((PH) == DBG_REPEAT_PH) { xcd_barrier(xb); const int rep_ = 1; (void)rep_; CALL; } PH_SYNC(PH) }
#define RUN_LAYER(L) \
    RUN_PHASE((L) * 10 + 0, phase_prep(p, (L), lds)) \
    RUN_PHASE((L) * 10 + 1, phase_inproj(p, (L), lds)) \
    RUN_PHASE((L) * 10 + 2, phase_mid1(p, (L), lds)) \
    RUN_PHASE((L) * 10 + 3, phase_attn(p, (L), lds, ctl + 2 * rep_)) \
    RUN_PHASE((L) * 10 + 4, phase_glu(p, (L), lds)) \
    RUN_PHASE((L) * 10 + 5, phase_branch(p, (L), lds)) \
    RUN_PHASE((L) * 10 + 6, phase_mix(p, (L), lds)) \
    RUN_PHASE((L) * 10 + 7, phase_router(p, (L), lds, ctl)) \
    RUN_PHASE((L) * 10 + 8, phase_exp1(p, (L), lds, ctl)) \
    RUN_PHASE((L) * 10 + 9, phase_exp2(p, (L), lds, ctl))
#if DBG_SMALLK
    RUN_PHASE(0, phase_prep(p, 0, lds))
    RUN_PHASE(1, phase_inproj(p, 0, lds))
    RUN_PHASE(2, phase_mid1(p, 0, lds))
#else
    RUN_LAYER(0)
    RUN_LAYER(1)
    RUN_PHASE(20, phase_prep(p, 2, lds))
#endif
#if ONE_LAUNCH && DBG_DUMP
    {
        xcd_barrier(xb);
        CKP* kp = kp0; asm volatile("" : "+s"(kp)); CKP& p = *kp;
        const size_t NO = (size_t)NTOK * 1024;
        const unsigned char* src = p.ws + DBG_DUMP_OFF;
        for (size_t i = (size_t)blockIdx.x * NTHR + threadIdx.x; i < NO; i += (size_t)gridDim.x * NTHR) {
            float v = 0.f;
            if (i < (size_t)DBG_DUMP_N) {
                if (DBG_DUMP_F32) {
                    const size_t si = DBG_DUMP_REV ? ((size_t)DBG_DUMP_N - 1 - i) : i;
#if DBG_SC1READ
                    const unsigned fu = __hip_atomic_load((const unsigned*)src + si, __ATOMIC_RELAXED, __HIP_MEMORY_SCOPE_SYSTEM); const float f = __uint_as_float(fu);
#else
                    const float f = ((const float*)src)[si];
#endif
                    v = DBG_HASH ? (float)(__float_as_uint(f) & 0x3ff) : f;
#if DBG_EFILT
                    { const int id_ = (int)(((si >> 7) - DBG_IDROT) & 2047), blk = ((id_ >> 2) + 320) & 511; if (!(blk >= DBG_EFILT_LO && blk < DBG_EFILT_HI)) v = 0.f; }
#endif
#if DBG_E2
                    { const float f2 = ((const float*)(p.ws + OFF_C + C_ATT))[i]; v = (__float_as_uint(f2) == __float_as_uint(f)) ? 0.f : 1000.f; if (i == 0) v += 1.f; }
#endif
                }
                else { const bf16_t h = ((const bf16_t*)src)[i]; v = DBG_HASH ? (float)(h & 0x3ff) : bf2f(h); }
            }
#if DBG_CONSTOUT
            v = 1000.f + (float)(i & 1023);
#endif
            p.xbuf[i] = v;
        }
    }
#endif
}

#if DBG_DUMP
__global__ void dbg_dump(const bf16_t* src, size_t n, float* out, size_t nout) {
    for (size_t i = (size_t)blockIdx.x * blockDim.x + threadIdx.x; i < nout; i += (size_t)gridDim.x * blockDim.x)
        out[i] = i < n ? (DBG_HASH ? (float)(src[i] & 0x3ff) : bf2f(src[i])) : 0.f;
}
__global__ void dbg_dump_f32(const float* src, size_t n, float* out, size_t nout) {
    for (size_t i = (size_t)blockIdx.x * blockDim.x + threadIdx.x; i < nout; i += (size_t)gridDim.x * blockDim.x)
        out[i] = i < n ? (DBG_HASH ? (float)(__float_as_uint(src[i]) & 0x3ff) : src[i]) : 0.f;
}
#endif
extern "C" void kernel_launch(void* const* d_in, const int* in_sizes, int n_in, void* d_out, int out_size, void* d_ws, size_t ws_size, hipStream_t stream) {
    static int grid = 0;
    if (grid == 0) {
        if (n_in != 36 || out_size != NTOK * DM || ws_size < WS_END) { fprintf(stderr, "kernel_launch: unexpected shapes n_in %d out %d ws %zu (need %zu)\n", n_in, out_size, ws_size, (size_t)WS_END); grid = -1; return; }
        int dev = 0, cus = 0, per_cu = 0;
        hipGetDevice(&dev);
        hipDeviceGetAttribute(&cus, hipDeviceAttributeMultiprocessorCount, dev);
        hipFuncSetAttribute((const void*)mega, hipFuncAttributeMaxDynamicSharedMemorySize, LDS_BYTES);
        hipOccupancyMaxActiveBlocksPerMultiprocessor(&per_cu, (const void*)mega, NTHR, LDS_BYTES);
        if (per_cu < 1) { fprintf(stderr, "kernel_launch: occupancy query says %d\n", per_cu); per_cu = 1; }
        if (per_cu > MAX_PER_CU) per_cu = MAX_PER_CU;
        grid = cus * per_cu;
        fprintf(stderr, "kernel_launch: grid %d (%d CUs x %d)\n", grid, cus, per_cu);
    }
    if (grid < 0) return;
    hipMemsetAsync((char*)d_ws + OFF_CTL, 0, CTL_BYTES, stream);
    KP p{};
    for (int i = 0; i < 36; ++i) p.in[i] = (const float*)d_in[i];
    p.xbuf = (float*)d_out; p.ws = (unsigned char*)d_ws;
    for (int i = 0; i < 8; ++i) p.inv_freq[i] = (float)pow(500000.0, -(double)i / 8.0);
    p.never = 0; p.pad = 0;
#if ONE_LAUNCH
    p.ph_lo = 0; p.ph_hi = DBG_PH_HI;
    void* args[] = {&p};
    hipError_t e = hipLaunchCooperativeKernel((const void*)mega, dim3(grid), dim3(NTHR), args, LDS_BYTES, stream);
    if (e != hipSuccess) fprintf(stderr, "cooperative launch failed: %s (grid %d)\n", hipGetErrorString(e), grid);
#else
    for (int ph = 0; ph < NPHASE; ++ph) {
        if (!((DBG_MASK >> ph) & 1)) continue;
        p.ph_lo = ph; p.ph_hi = ph + 1;
        hipLaunchKernelGGL(mega, dim3(grid), dim3(NTHR), LDS_BYTES, stream, p);
    }
#if DBG_DUMP
    {
        const unsigned char* w = (const unsigned char*)d_ws; const size_t NO = (size_t)NTOK * 1024;
        size_t off = 0, n = 0; bool f32 = false;
        switch (DBG_DUMP) {
            case 1: off = OFF_C + C_ATT; n = (size_t)NTOK * 512; break;
            case 2: off = OFF_C + C_SGU; n = (size_t)NTOK * 256; break;
            case 3: off = OFF_C + C_S5O; n = (size_t)NTOK * 256; break;
            case 4: off = OFF_M; n = (size_t)NTOK * 1024; break;
            case 5: off = OFF_R + R_Q; n = (size_t)NTOK * 512; break;
            case 6: off = OFF_H; n = (size_t)NTOK * 1024; break;
            case 7: off = OFF_C + C_YG; n = (size_t)NTOK * 256; break;
            case 8: off = OFF_C + C_KCMP; n = (size_t)2 * 524288 / 2; break;
            case 9: off = OFF_R + R_KC; n = (size_t)NTOK * 128 * 6; break;
            case 10: off = OFF_R + R_NG; n = (size_t)NTOK * 24; f32 = true; break;
            case 11: off = OFF_R + R_U; n = (size_t)NTOK * 768; break;
            case 12: off = OFF_C + C_S5E; n = (size_t)128 * 16 * 64 * 2; f32 = true; break;
            case 15: off = 0; n = (size_t)NTOK * 1024; f32 = true; break;
            case 16: off = OFF_W + W_S5A; n = 36864; f32 = true; break;
            case 13: off = OFF_YS; n = (size_t)NTOK * 1024; break;
            case 14: off = OFF_MOE + MOE_WS; n = 65536; f32 = true; break;
            default: break;
        }
        if (DBG_DUMP == 15) hipLaunchKernelGGL(dbg_dump_f32, dim3(2048), dim3(256), 0, stream, (const float*)d_out, n, (float*)d_out, NO);
        else if (f32) hipLaunchKernelGGL(dbg_dump_f32, dim3(2048), dim3(256), 0, stream, (const float*)(w + off), n, (float*)d_out, NO);
        else hipLaunchKernelGGL(dbg_dump, dim3(2048), dim3(256), 0, stream, (const bf16_t*)(w + off), n, (float*)d_out, NO);
    }
#endif
#endif
}
```

```cpp
#include <hip/hip_runtime.h>
#include <hip/hip_cooperative_groups.h>
#include <cstdio>
#include <cstdint>
#include <cmath>
namespace cg = cooperative_groups;

#ifndef ONE_LAUNCH
#define ONE_LAUNCH 1
#endif
#ifndef DBG_MASK
#define DBG_MASK 0x1fffff
#endif
#ifndef DBG_NOCOMBINE
#define DBG_NOCOMBINE 0
#endif
#ifndef DBG_DUMP
#define DBG_DUMP 0
#endif
#ifndef DBG_HASH
#define DBG_HASH 0
#endif
#ifndef DBG_ONLYS5
#define DBG_ONLYS5 0
#endif
#ifndef DBG_NOCSTORE
#define DBG_NOCSTORE 0
#endif
#ifndef DBG_LDSCHK
#define DBG_LDSCHK 0
#endif
#ifndef DBG_TWICE
#define DBG_TWICE 0
#endif
#ifndef DBG_S5CONST
#define DBG_S5CONST 0
#endif
#ifndef DBG_SC1READ
#define DBG_SC1READ 0
#endif
#ifndef DBG_E2
#define DBG_E2 0
#endif
#ifndef DBG_JOBFENCE
#define DBG_JOBFENCE 0
#endif
#ifndef DBG_CONSTOUT
#define DBG_CONSTOUT 0
#endif
#ifndef DBG_QDELAY
#define DBG_QDELAY 0
#endif
#ifndef DBG_SMALLK
#define DBG_SMALLK 0
#endif
#ifndef DBG_REPEAT_PH
#define DBG_REPEAT_PH -1
#endif
#ifndef DBG_TIMEPH
#define DBG_TIMEPH -1
#endif
#ifndef DBG_TIMEPH2
#define DBG_TIMEPH2 (DBG_TIMEPH + 1)
#endif
#ifndef DBG_PRESPIN
#define DBG_PRESPIN 0
#endif
#ifndef DBG_SGUSPIN
#define DBG_SGUSPIN 0
#endif
#ifndef DBG_PREFLUSH
#define DBG_PREFLUSH 0
#endif
#ifndef DBG_ESC1
#define DBG_ESC1 0
#endif
#ifndef DBG_DELAY
#define DBG_DELAY 0
#endif
#ifndef DBG_IDROT
#define DBG_IDROT 0
#endif
#ifndef DBG_DUMP_REV
#define DBG_DUMP_REV 0
#endif
#ifndef DBG_SGUCUT
#define DBG_SGUCUT 0
#endif
#ifndef DBG_EFILT
#define DBG_EFILT 0
#define DBG_EFILT_LO 0
#define DBG_EFILT_HI 0
#endif
#ifndef DBG_DUMP_OFF
#define DBG_DUMP_OFF 0
#define DBG_DUMP_N 0
#define DBG_DUMP_F32 0
#endif
#ifndef DBG_PH_HI
#define DBG_PH_HI NPHASE
#endif

typedef unsigned short bf16_t;
typedef short bf16x8 __attribute__((ext_vector_type(8)));
typedef float f32x4 __attribute__((ext_vector_type(4)));
typedef unsigned u32x4 __attribute__((ext_vector_type(4)));
typedef unsigned u32x2 __attribute__((ext_vector_type(2)));

constexpr int DM = 1024, NB = 8, SEQ = 4096, NTOK = NB * SEQ, DEPTH = 2;
constexpr int NCMP = 255;
constexpr float RMS_EPS = 1e-6f;
constexpr int NTHR = 256;
constexpr int LDS_BAR = 67584;
#ifndef MAX_PER_CU
#define MAX_PER_CU 2
#endif
#ifndef LDS_TOTAL
#define LDS_TOTAL (67584 + 64)
#endif
constexpr int LDS_BYTES = LDS_TOTAL;

constexpr size_t OFF_CTL = 0;
constexpr size_t OFF_W = 65536;
constexpr size_t W_IN = 0, W_GB = 4456448, W_A = 10747904, W_S = 11796480, W_5 = 12320768, W_M = 12845056, W_GLU = 14942208,
                 W_C1 = 15073280, W_C2 = 16121856, W_PB = 16154624, W_SGU = 16155648, W_S5A = 16286720, W_S5A256 = 16294912,
                 W_S5B = 16303104, W_S5C = 16434176, W_RH = 16499712, W_RL = 16630784, W_EG = 16777216, W_EU = 50331648, W_ED = 83886080, W_END = 117440512;
constexpr size_t OFF_H = OFF_W + W_END;
constexpr size_t OFF_M = OFF_H + 67108864;
constexpr size_t OFF_R = OFF_M + 67108864;
constexpr size_t R_Q = 0, R_KC = 33554432, R_VC = 41943040, R_KS = 50331648, R_KW = 58720256, R_VST = 67108864, R_VWT = 75497472,
                 R_NG = 83886080, R_U = 87031808, R_V = 103809024, R_S5IN = 120586240, R_QR = 137363456, R_END = 170917888;
constexpr size_t OFF_C = OFF_R + R_END;
constexpr size_t C_ATT = 0, C_SGU = 33554432, C_YG = 50331648, C_S5O = 67108864, C_KCMP = 83886080, C_VCT = 84410368, C_S5E = 84934656, C_END = 85983232;
constexpr size_t OFF_MOE = OFF_C + C_END;
constexpr size_t MOE_LIST = 0, MOE_WS = 4194304, MOE_END = 4456448;
constexpr size_t WS_END = OFF_MOE + MOE_END;
constexpr size_t OFF_HID = OFF_R;
constexpr size_t OFF_YS = OFF_R + 71303168;
static_assert(OFF_YS + 134217728 <= OFF_C + C_KCMP, "alias overflow");

constexpr int CTL_BAR = 0;
constexpr int CTL_MOECNT = 4096;
constexpr int CTL_ATTN = 4096 + 64;
constexpr int CTL_BYTES = 32768;

struct KP {
    const float* in[36];
    float* xbuf;
    unsigned char* ws;
    float inv_freq[8];
    int ph_lo, ph_hi;
    int never;
    int pad;
};

typedef const KP __attribute__((address_space(4))) CKP;

typedef float f32x2_t __attribute__((ext_vector_type(2)));
typedef __bf16 bf16x2_t __attribute__((ext_vector_type(2)));
__device__ __forceinline__ unsigned pk_bf16(float lo, float hi) {
    const f32x2_t v = {lo, hi};
    union { bf16x2_t b; unsigned u; } x; x.b = __builtin_convertvector(v, bf16x2_t); return x.u;
}
__device__ __forceinline__ bf16_t f2bf(float f) { return (bf16_t)(pk_bf16(f, 0.f) & 0xffffu); }
__device__ __forceinline__ float bf2f(bf16_t b) { return __uint_as_float(((unsigned)b) << 16); }
__device__ __forceinline__ float bflo(unsigned u) { return __uint_as_float(u << 16); }
__device__ __forceinline__ float bfhi(unsigned u) { return __uint_as_float(u & 0xffff0000u); }
__device__ __forceinline__ float fexp2(float x) { return __builtin_amdgcn_exp2f(x); }
__device__ __forceinline__ float gelu_tanh(float x) {
    const float u = 0.7978845608028654f * (x + 0.044715f * x * x * x);
    const float e = fexp2(2.885390081777927f * u);
    const float t = 1.f - 2.f * __builtin_amdgcn_rcpf(e + 1.f);
    return 0.5f * x * (1.f + t);
}
__device__ __forceinline__ float sigm(float x) { return __builtin_amdgcn_rcpf(1.f + fexp2(-1.4426950408889634f * x)); }
__device__ __forceinline__ int opaque_tid() { int t = threadIdx.x; asm volatile("" : "+v"(t)); return t; }
__device__ __forceinline__ void job_fence() {
#if DBG_JOBFENCE
    asm volatile("s_waitcnt vmcnt(0) lgkmcnt(0)" ::: "memory");
    __syncthreads();
#endif
}
__device__ __forceinline__ float wave_sum(float v) {
#pragma unroll
    for (int o = 32; o >= 1; o >>= 1) v += __shfl_xor(v, o);
    return v;
}
__device__ __forceinline__ float xmax16(float x) { const unsigned u = __float_as_uint(x); auto r = __builtin_amdgcn_permlane16_swap(u, u, false, false); return fmaxf(__uint_as_float(r[0]), __uint_as_float(r[1])); }
__device__ __forceinline__ float xmax32(float x) { const unsigned u = __float_as_uint(x); auto r = __builtin_amdgcn_permlane32_swap(u, u, false, false); return fmaxf(__uint_as_float(r[0]), __uint_as_float(r[1])); }
__device__ __forceinline__ float xsum16(float x) { const unsigned u = __float_as_uint(x); auto r = __builtin_amdgcn_permlane16_swap(u, u, false, false); return __uint_as_float(r[0]) + __uint_as_float(r[1]); }
__device__ __forceinline__ float xsum32(float x) { const unsigned u = __float_as_uint(x); auto r = __builtin_amdgcn_permlane32_swap(u, u, false, false); return __uint_as_float(r[0]) + __uint_as_float(r[1]); }
__device__ __forceinline__ f32x4 mfma16(bf16x8 a, bf16x8 b, f32x4 c) { return __builtin_amdgcn_mfma_f32_16x16x32_bf16(a, b, c, 0, 0, 0); }
__device__ __forceinline__ bf16x8 as_bf8(u32x4 v) { union { u32x4 u; bf16x8 b; } x; x.u = v; return x.b; }
__device__ __forceinline__ void store16bf(bf16_t* dst, const float (&v)[16]) {
    u32x4 a, b;
    a.x = pk_bf16(v[0], v[1]); a.y = pk_bf16(v[2], v[3]); a.z = pk_bf16(v[4], v[5]); a.w = pk_bf16(v[6], v[7]);
    b.x = pk_bf16(v[8], v[9]); b.y = pk_bf16(v[10], v[11]); b.z = pk_bf16(v[12], v[13]); b.w = pk_bf16(v[14], v[15]);
    *(u32x4*)dst = a; *(u32x4*)(dst + 8) = b;
}

#ifndef XB_SCOPE
#define XB_SCOPE "agent"
#endif
#define XB_TMO      128
#define XB_XCNT(j)  (256  + 64 * (j))
#define XB_XSUB(j)  (1280 + 64 * (j))
#define XB_XGEN(j)  (2304 + 64 * (j))
#define XB_TOP      3328
#define XB_TOPGEN   3392
#define XCD_BAR_WORDS 3456
#define XB_SPIN_CAP (1u << 22)
#define LAS __attribute__((address_space(3)))
__device__ __forceinline__ unsigned xb_ld(unsigned* p)              { return __hip_atomic_load(p, __ATOMIC_RELAXED, __HIP_MEMORY_SCOPE_AGENT); }
__device__ __forceinline__ unsigned xb_add(unsigned* p, unsigned v) { return __hip_atomic_fetch_add(p, v, __ATOMIC_RELAXED, __HIP_MEMORY_SCOPE_AGENT); }
__device__ __forceinline__ unsigned xb_xcc_id() { return (unsigned)__builtin_amdgcn_s_getreg((3 << 11) | 20) & 0xFu; }
#define XB_SPIN(cond, bar) do { unsigned _sp = 0; while (cond) { __builtin_amdgcn_s_sleep(1); \
    if ((++_sp & 255u) == 0u) { if (xb_ld(&(bar)[XB_TMO])) break; if (_sp > XB_SPIN_CAP) { atomicAdd(&(bar)[XB_TMO], 1u); break; } } } } while (0)
struct XcdBarrier { unsigned* bar; unsigned x; volatile LAS unsigned* st; unsigned nloc, nx; };
__device__ __forceinline__ XcdBarrier xcd_barrier_post(unsigned* bar, volatile LAS unsigned* st) {
    XcdBarrier b; b.bar = bar; b.x = xb_xcc_id(); b.st = st; b.nloc = 0u; b.nx = 0u;
    if (threadIdx.x == 0) (void)xb_add(&bar[XB_XCNT(b.x)], 1u);
    return b;
}
__device__ __forceinline__ void xcd_barrier_complete(unsigned* bar, unsigned x, unsigned& nloc, unsigned& nx) {
    const unsigned G = gridDim.x * gridDim.y * gridDim.z;
    unsigned sum, cnt, mine, sp = 0u;
    for (;;) {
        sum = 0u; cnt = 0u; mine = 0u;
#pragma unroll
        for (unsigned j = 0; j < 16; ++j) { const unsigned c = xb_ld(&bar[XB_XCNT(j)]); sum += c; cnt += (c > 0u) ? 1u : 0u; mine = (j == x) ? c : mine; }
        if (sum == G) break;
        __builtin_amdgcn_s_sleep(1);
        if ((++sp & 255u) == 0u) { if (xb_ld(&bar[XB_TMO])) break; if (sp > XB_SPIN_CAP) { atomicAdd(&bar[XB_TMO], 1u); break; } }
    }
    nloc = mine > 0u ? mine : 1u; nx = cnt > 0u ? cnt : 1u;
}
__device__ __forceinline__ void xcd_barrier(XcdBarrier& b) {
    asm volatile("s_waitcnt vmcnt(0)" ::: "memory");
    __syncthreads();
    if (threadIdx.x == 0) {
        unsigned* bar = b.bar;
        __builtin_amdgcn_s_waitcnt(0);
        unsigned nloc = b.nloc, nx = b.nx;
        if (nloc == 0u) { xcd_barrier_complete(bar, b.x, nloc, nx); b.nloc = nloc; b.nx = nx; }
        const unsigned old = xb_add(&bar[XB_XSUB(b.x)], 1u);
        const unsigned gen = old / nloc;
        if (old + 1u == (gen + 1u) * nloc) {
            __builtin_amdgcn_fence(__ATOMIC_RELEASE, XB_SCOPE);
            asm volatile("s_waitcnt vmcnt(0)" ::: "memory");
            const unsigned og = xb_add(&bar[XB_TOP], 1u);
            const unsigned tg = og / nx;
            if (og + 1u == (tg + 1u) * nx) xb_add(&bar[XB_TOPGEN], 1u);
            else XB_SPIN(xb_ld(&bar[XB_TOPGEN]) == tg, bar);
            __builtin_amdgcn_fence(__ATOMIC_ACQUIRE, XB_SCOPE);
            xb_add(&bar[XB_XGEN(b.x)], 1u);
            asm volatile("s_waitcnt vmcnt(0)" ::: "memory");
        } else {
            XB_SPIN(xb_ld(&bar[XB_XGEN(b.x)]) == gen, bar);
            __builtin_amdgcn_fence(__ATOMIC_ACQUIRE, XB_SCOPE);
            asm volatile("s_waitcnt vmcnt(0)" ::: "memory");
        }
    }
    __syncthreads();
}

__device__ __forceinline__ void tile_coords(int L, int ntm, int ntn, int& tm, int& tn) {
    const int nt = ntm * ntn, q = nt >> 3, r = nt & 7, xcd = L & 7, off = L >> 3;
    const int id = (xcd < r ? xcd * (q + 1) : r * (q + 1) + (xcd - r) * q) + off;
    const int GM = 8, nig = GM * ntn, gid = id / nig, fm = gid * GM, gsz = (ntm - fm) < GM ? (ntm - fm) : GM;
    tm = fm + ((id % nig) % gsz); tn = (id % nig) / gsz;
}

template <class AP, class BP>
__device__ __forceinline__ void gemm_kloop(f32x4 (&acc)[4][4], AP ap, int a_kstep, BP bp, int b_kstep, int nkt, unsigned char* lds, int tid) {
    const int lane = tid & 63, w = tid >> 6, wm = w >> 1, wn = w & 1, fr = lane & 15, fq = lane >> 4;
    const int lr = lane >> 3, lc = (lane & 7) ^ lr;
    const bf16_t* pa[4]; const bf16_t* pb[4];
#pragma unroll
    for (int i = 0; i < 4; ++i) {
        const int row = 8 * (w + 4 * i) + lr;
        pa[i] = ap(row) + lc * 8;
        const int wn_ = row >> 6, ni_ = (row >> 4) & 3, ii = row & 15;
        pb[i] = bp(64 * wn_ + 16 * (ii >> 2) + 4 * ni_ + (ii & 3)) + lc * 8;
    }
    const int ra = (64 * wm + fr) * 128, rb = (64 * wn + fr) * 128;
    const int sw0 = ((fq) ^ (fr & 7)) << 4, sw1 = ((4 + fq) ^ (fr & 7)) << 4;
    auto issue = [&](int buf) {
#pragma unroll
        for (int i = 0; i < 4; ++i) {
            __builtin_amdgcn_global_load_lds((const unsigned*)pa[i], (unsigned*)(lds + buf * 16384 + (w + 4 * i) * 1024), 16, 0, 0);
            __builtin_amdgcn_global_load_lds((const unsigned*)pb[i], (unsigned*)(lds + 32768 + buf * 16384 + (w + 4 * i) * 1024), 16, 0, 0);
            pa[i] += a_kstep; pb[i] += b_kstep;
        }
    };
    auto compute = [&](int buf) {
        const unsigned char* A = lds + buf * 16384;
        const unsigned char* B = lds + 32768 + buf * 16384;
#pragma unroll
        for (int ks = 0; ks < 2; ++ks) {
            const int sw = ks ? sw1 : sw0;
            bf16x8 af[4], bf[4];
#pragma unroll
            for (int mi = 0; mi < 4; ++mi) af[mi] = *(const bf16x8*)(A + ra + mi * 2048 + sw);
#pragma unroll
            for (int ni = 0; ni < 4; ++ni) bf[ni] = *(const bf16x8*)(B + rb + ni * 2048 + sw);
#pragma unroll
            for (int mi = 0; mi < 4; ++mi)
#pragma unroll
                for (int ni = 0; ni < 4; ++ni) acc[mi][ni] = mfma16(bf[ni], af[mi], acc[mi][ni]);
        }
    };
    __syncthreads();
    issue(0);
    asm volatile("s_waitcnt vmcnt(0)" ::: "memory");
    __syncthreads();
#pragma unroll 1
    for (int kt = 0; kt < nkt; ++kt) {
        const int cur = kt & 1;
        if (kt + 1 < nkt) issue(cur ^ 1);
        compute(cur);
        asm volatile("s_waitcnt vmcnt(0)" ::: "memory");
        __syncthreads();
    }
}
__device__ __forceinline__ void zero_acc(f32x4 (&acc)[4][4]) {
#pragma unroll
    for (int i = 0; i < 4; ++i)
#pragma unroll
        for (int j = 0; j < 4; ++j) acc[i][j] = (f32x4){0.f, 0.f, 0.f, 0.f};
}

__device__ __forceinline__ void transpose_tile(const float* src, bf16_t* dst, int R, int C, int mode, int tk, int tn, float* tl, int tid) {
    const int k0 = tk * 64, n0 = tn * 64;
    {
        const int j = tid & 63; const int n = n0 + j;
        int col = n;
        if (mode == 1) col = (n < 1304) ? n : ((n < 1408) ? -1 : n - 104);
        else if (mode == 2) col = n + 2072;
#pragma unroll 4
        for (int pp = 0; pp < 16; ++pp) {
            const int i = (tid >> 6) + 4 * pp;
            tl[i * 65 + j] = (col >= 0) ? src[(size_t)(k0 + i) * C + col] : 0.f;
        }
    }
    __syncthreads();
#pragma unroll
    for (int q2 = 0; q2 < 2; ++q2) {
        const int jj = (tid >> 3) + 32 * q2, cc = tid & 7;
        u32x4 o;
        o.x = pk_bf16(tl[(cc * 8 + 0) * 65 + jj], tl[(cc * 8 + 1) * 65 + jj]);
        o.y = pk_bf16(tl[(cc * 8 + 2) * 65 + jj], tl[(cc * 8 + 3) * 65 + jj]);
        o.z = pk_bf16(tl[(cc * 8 + 4) * 65 + jj], tl[(cc * 8 + 5) * 65 + jj]);
        o.w = pk_bf16(tl[(cc * 8 + 6) * 65 + jj], tl[(cc * 8 + 7) * 65 + jj]);
        *(u32x4*)(dst + (size_t)(n0 + jj) * R + k0 + cc * 8) = o;
    }
    __syncthreads();
}

__device__ __forceinline__ void phase_prep(CKP& p, int l, unsigned char* lds) {
    const int tid = opaque_tid(), G = gridDim.x, lane = tid & 63, w = tid >> 6;
    unsigned char* W = p.ws + OFF_W;
    if (l < DEPTH) {
        struct E { const float* src; bf16_t* dst; int R, C, nd, mode, nbatch; };
        constexpr int NE = 14;
        for (int L = blockIdx.x * 4 + w;; L += G * 4) {
            int rem = L; int e = 0; E d{};
            for (; e < NE; ++e) {
                switch (e) {
                    case 0: d = {p.in[3] + (size_t)l * 1024 * 5144, (bf16_t*)(W + W_IN), 1024, 5144, 2176, 1, 1}; break;
                    case 1: d = {p.in[3] + (size_t)l * 1024 * 5144, (bf16_t*)(W + W_GB), 1024, 5144, 3072, 2, 1}; break;
                    case 2: d = {p.in[10] + (size_t)l * 512 * 1024, (bf16_t*)(W + W_A), 512, 1024, 1024, 0, 1}; break;
                    case 3: d = {p.in[14] + (size_t)l * 256 * 1024, (bf16_t*)(W + W_S), 256, 1024, 1024, 0, 1}; break;
                    case 4: d = {p.in[25] + (size_t)l * 256 * 1024, (bf16_t*)(W + W_5), 256, 1024, 1024, 0, 1}; break;
                    case 5: d = {p.in[26] + (size_t)l * 1024 * 1024, (bf16_t*)(W + W_M), 1024, 1024, 1024, 0, 1}; break;
                    case 6: d = {p.in[23] + (size_t)l * 256 * 256, (bf16_t*)(W + W_GLU), 256, 256, 256, 0, 1}; break;
                    case 7: d = {p.in[6] + (size_t)l * 2048 * 128, (bf16_t*)(W + W_C1), 2048, 128, 128, 0, 1}; break;
                    case 8: d = {p.in[8] + (size_t)l * 2048 * 128, (bf16_t*)(W + W_C1) + 128 * 2048, 2048, 128, 128, 0, 1}; break;
                    case 9: d = {p.in[7] + (size_t)l * 128 * 64, (bf16_t*)(W + W_C2), 128, 64, 64, 0, 1}; break;
                    case 10: d = {p.in[9] + (size_t)l * 128 * 64, (bf16_t*)(W + W_C2) + 64 * 128, 128, 64, 64, 0, 1}; break;
                    case 11: d = {p.in[32] + (size_t)l * 32 * 1024 * 512, (bf16_t*)(W + W_EG), 1024, 512, 512, 0, 32}; break;
                    case 12: d = {p.in[33] + (size_t)l * 32 * 1024 * 512, (bf16_t*)(W + W_EU), 1024, 512, 512, 0, 32}; break;
                    default: d = {p.in[34] + (size_t)l * 32 * 512 * 1024, (bf16_t*)(W + W_ED), 512, 1024, 1024, 0, 32}; break;
                }
                const int per = (d.R >> 6) * (d.nd >> 6), tot = per * d.nbatch;
                if (rem < tot) break;
                rem -= tot;
            }
            if (e >= NE) break;
            const int per = (d.R >> 6) * (d.nd >> 6), bi = rem / per, t = rem % per, ntn = d.nd >> 6;
            const int k0 = (t / ntn) * 64, n = (t % ntn) * 64 + lane;
            int col = n;
            if (d.mode == 1) col = (n < 1304) ? n : ((n < 1408) ? -1 : n - 104);
            else if (d.mode == 2) col = n + 2072;
            const float* sp = d.src + (size_t)bi * d.R * d.C + (size_t)k0 * d.C + (col >= 0 ? col : 0);
            float v[64];
#pragma unroll
            for (int i = 0; i < 64; ++i) v[i] = sp[(size_t)i * d.C];
            if (col < 0) {
#pragma unroll
                for (int i = 0; i < 64; ++i) v[i] = 0.f;
            }
            bf16_t* dp = d.dst + (size_t)bi * d.R * d.nd + (size_t)n * d.R + k0;
#pragma unroll
            for (int q = 0; q < 8; ++q) {
                u32x4 o;
                o.x = pk_bf16(v[8 * q], v[8 * q + 1]); o.y = pk_bf16(v[8 * q + 2], v[8 * q + 3]);
                o.z = pk_bf16(v[8 * q + 4], v[8 * q + 5]); o.w = pk_bf16(v[8 * q + 6], v[8 * q + 7]);
                *(u32x4*)(dp + 8 * q) = o;
            }
        }
        const int gt = blockIdx.x * NTHR + tid, gs = G * NTHR;
        {
            const float* sw = p.in[12] + (size_t)l * 4 * 128 * 128; bf16_t* o = (bf16_t*)(W + W_SGU);
            for (int i = gt; i < 65536; i += gs) { const int t = (i >> 7) & 127, s = i & 127; o[i] = f2bf(s <= t ? sw[i] : 0.f); }
        }
        {
            const float* are = p.in[15] + l * 1024; const float* aim = p.in[16] + l * 1024; const float* ls = p.in[17] + l * 16;
            const float* bre = p.in[18] + (size_t)l * 16384; const float* bim = p.in[19] + (size_t)l * 16384;
            float* oa = (float*)(W + W_S5A); float* oa2 = (float*)(W + W_S5A256); float* ob = (float*)(W + W_S5B);
            for (int i = gt; i < 1024; i += gs) {
                const int g = i >> 6;
                const float step = expf(ls[g]), ar = are[i], ai = aim[i];
                const float mag = expf(ar * step); float sn, cs; sincosf(ai * step, &sn, &cs);
                const float abr = mag * cs, abi = mag * sn;
                const float den = ar * ar + ai * ai, nr = abr - 1.f, ni = abi;
                const float cr = (nr * ar + ni * ai) / den, ci = (ni * ar - nr * ai) / den;
                oa[i * 2] = abr; oa[i * 2 + 1] = abi;
                float pr = abr, pi = abi;
                for (int s = 0; s < 8; ++s) { const float nr2 = pr * pr - pi * pi, ni2 = 2.f * pr * pi; pr = nr2; pi = ni2; }
                oa2[i * 2] = pr; oa2[i * 2 + 1] = pi;
                for (int h = 0; h < 16; ++h) {
                    const float br = bre[i * 16 + h], bi_ = bim[i * 16 + h];
                    ob[i * 32 + h] = cr * br - ci * bi_;
                    ob[i * 32 + 16 + h] = cr * bi_ + ci * br;
                }
            }
            const float* cre = p.in[20] + (size_t)l * 16384; const float* cim = p.in[21] + (size_t)l * 16384; bf16_t* oc = (bf16_t*)(W + W_S5C);
            for (int i = gt; i < 32768; i += gs) {
                const int k = i & 127, gh = i >> 7;
                oc[i] = f2bf(k < 64 ? cre[gh * 64 + k] : -cim[gh * 64 + (k - 64)]);
            }
        }
        {
            const float* wg = p.in[28] + (size_t)l * 1024 * 4; const float* we = p.in[30] + (size_t)l * 1024 * 32;
            bf16_t* oh = (bf16_t*)(W + W_RH); bf16_t* ol = (bf16_t*)(W + W_RL);
            for (int i = gt; i < 65536; i += gs) {
                const int n = i >> 10, k = i & 1023;
                const float v = (n < 4) ? wg[k * 4 + n] : ((n < 36) ? we[k * 32 + (n - 4)] : 0.f);
                const bf16_t h = f2bf(v);
                oh[i] = h; ol[i] = f2bf(v - bf2f(h));
            }
        }
        {
            float* pb = (float*)(W + W_PB);
            for (int j = blockIdx.x * 4 + w; j < 256; j += G * 4) {
                const int kv = j >> 7, n = j & 127;
                const float* pos = p.in[kv ? 5 : 4] + (size_t)l * 2048; const float* w1 = p.in[kv ? 8 : 6] + (size_t)l * 2048 * 128;
                float s = 0.f;
                for (int k = lane; k < 2048; k += 64) s += pos[k] * w1[(size_t)k * 128 + n];
                s = wave_sum(s);
                if (lane == 0) pb[j] = s;
            }
        }
    }
    {
        const float* gam = (l < DEPTH) ? (p.in[2] + (size_t)l * 1024) : p.in[35];
        bf16_t* hb = (bf16_t*)(p.ws + OFF_H);
        const bf16_t* ys = (const bf16_t*)(p.ws + OFF_YS);
        f32x4 gv[4];
#pragma unroll
        for (int i = 0; i < 4; ++i) gv[i] = *(const f32x4*)(gam + 4 * lane + 256 * i);
        for (int row = blockIdx.x * 4 + w; row < NTOK; row += G * 4) {
            f32x4 xv[4]; float ss = 0.f;
#pragma unroll
            for (int i = 0; i < 4; ++i) {
                const int col = 4 * lane + 256 * i;
                if (l == 0) xv[i] = *(const f32x4*)(p.in[0] + (size_t)row * 1024 + col);
                else if ((DBG_NOCOMBINE >> l) & 1) xv[i] = *(const f32x4*)(p.xbuf + (size_t)row * 1024 + col);
                else {
                    xv[i] = *(const f32x4*)(p.xbuf + (size_t)row * 1024 + col);
                    const u32x2 y0 = *(const u32x2*)(ys + (size_t)(2 * row) * 1024 + col), y1 = *(const u32x2*)(ys + (size_t)(2 * row + 1) * 1024 + col);
                    xv[i][0] += bflo(y0.x) + bflo(y1.x); xv[i][1] += bfhi(y0.x) + bfhi(y1.x);
                    xv[i][2] += bflo(y0.y) + bflo(y1.y); xv[i][3] += bfhi(y0.y) + bfhi(y1.y);
                }
                ss += xv[i][0] * xv[i][0] + xv[i][1] * xv[i][1] + xv[i][2] * xv[i][2] + xv[i][3] * xv[i][3];
            }
            ss = wave_sum(ss);
            const float rstd = rsqrtf(ss * (1.f / 1024.f) + RMS_EPS);
#pragma unroll
            for (int i = 0; i < 4; ++i) {
                const int col = 4 * lane + 256 * i;
                f32x4 hn = xv[i] * rstd * gv[i];
                if (l < DEPTH) {
                    *(f32x4*)(p.xbuf + (size_t)row * 1024 + col) = xv[i];
                    u32x2 o; o.x = pk_bf16(hn[0], hn[1]); o.y = pk_bf16(hn[2], hn[3]);
                    *(u32x2*)(hb + (size_t)row * 1024 + col) = o;
                } else {
#if DBG_TIMEPH >= 0
                    { const unsigned long long* ts = (const unsigned long long*)(p.ws + OFF_CTL + 24576);
                      const float dt_us = (float)(ts[DBG_TIMEPH2] - ts[DBG_TIMEPH]) * 0.01f; hn = hn * (1.f + 1e-3f * dt_us); }
#endif
                    *(f32x4*)(p.xbuf + (size_t)row * 1024 + col) = hn;
                }
            }
        }
    }
}

__device__ __forceinline__ void phase_inproj(CKP& p, int l, unsigned char* lds) {
    const int tid = opaque_tid(), lane = tid & 63, w = tid >> 6, wm = w >> 1, wn = w & 1, fr = lane & 15, fq = lane >> 4;
    const bf16_t* A = (const bf16_t*)(p.ws + OFF_H);
    const bf16_t* Bt = (const bf16_t*)(p.ws + OFF_W + W_IN);
    unsigned char* R = p.ws + OFF_R;
    const int* pos = (const int*)p.in[1];
    constexpr int NTM = NTOK / 128, NTN = 17;
    for (int L = blockIdx.x; L < NTM * NTN; L += gridDim.x) {
        int tm, tn; tile_coords(L, NTM, NTN, tm, tn);
        const int m0 = tm * 128, n0 = tn * 128;
        f32x4 acc[4][4]; zero_acc(acc);
        gemm_kloop(acc, [&](int r) { return A + (size_t)(m0 + r) * 1024; }, 64, [&](int v) { return Bt + (size_t)(n0 + v) * 1024; }, 64, 16, lds, tid);
#pragma unroll
        for (int mi = 0; mi < 4; ++mi) {
            const int row = m0 + 64 * wm + 16 * mi + fr;
            const int cl = 64 * wn + 16 * fq;
            float v[16];
#pragma unroll
            for (int e = 0; e < 16; ++e) v[e] = acc[mi][e >> 2][e & 3];
            if (tn < 4) {
                store16bf((bf16_t*)(R + R_Q) + (size_t)row * 512 + n0 + cl, v);
                if (fq == 0) {
                    const float ps = (float)pos[row];
#pragma unroll
                    for (int i = 0; i < 8; ++i) {
                        float sn, cs; sincosf(ps * p.inv_freq[i], &sn, &cs);
                        const float x1 = v[i], x2 = v[8 + i];
                        v[i] = x1 * cs - x2 * sn; v[8 + i] = x2 * cs + x1 * sn;
                    }
                }
                store16bf((bf16_t*)(R + R_QR) + (size_t)row * 512 + n0 + cl, v);
            } else if (tn < 10) {
                const int seg = tn - 4;
                if (seg == 2 || seg == 4) {
                    if (fq == 0) {
                        const float ps = (float)pos[row];
#pragma unroll
                        for (int i = 0; i < 8; ++i) {
                            float sn, cs; sincosf(ps * p.inv_freq[i], &sn, &cs);
                            const float x1 = v[i], x2 = v[8 + i];
                            v[i] = x1 * cs - x2 * sn; v[8 + i] = x2 * cs + x1 * sn;
                        }
                    }
                }
                if (seg == 3 || seg == 5) {
                    bf16_t* dst = (bf16_t*)(R + (seg == 3 ? R_VST : R_VWT));
                    const int b = row >> 12, s = row & 4095, g = wn, d0 = 16 * fq;
#pragma unroll
                    for (int e = 0; e < 16; ++e) dst[((size_t)((b * 2 + g) * 64 + d0 + e)) * SEQ + s] = f2bf(v[e]);
                } else {
                    const size_t off = (seg == 0) ? R_KC : (seg == 1) ? R_VC : (seg == 2) ? R_KS : R_KW;
                    store16bf((bf16_t*)(R + off) + (size_t)row * 128 + cl, v);
                }
            } else if (tn == 10) {
                if (cl < 24) {
                    float* ng = (float*)(R + R_NG) + (size_t)row * 24 + cl;
#pragma unroll
                    for (int e = 0; e < 16; ++e) if (cl + e < 24) ng[e] = sigm(v[e]);
                }
            } else if (tn < 15) {
#pragma unroll
                for (int e = 0; e < 16; ++e) v[e] = gelu_tanh(v[e]);
                const int c512 = (tn - 11) * 128 + cl;
                if (c512 < 256) store16bf((bf16_t*)(R + R_U) + (size_t)row * 256 + c512, v);
                else store16bf((bf16_t*)(R + R_V) + (size_t)row * 256 + (c512 - 256), v);
            } else {
                store16bf((bf16_t*)(R + R_S5IN) + (size_t)row * 256 + (tn - 15) * 128 + cl, v);
            }
        }
    }
}

__device__ __forceinline__ void compress_tile(CKP& p, int job, unsigned char* lds) {
    job_fence();
    const int tid = opaque_tid(), lane = tid & 63, w = tid >> 6, wm = w >> 1, wn = w & 1, fr = lane & 15, fq = lane >> 4;
    const int kv = job >> 5, tm = job & 31, m0 = tm * 128;
    unsigned char* W = p.ws + OFF_W;
    const bf16_t* src = (const bf16_t*)(p.ws + OFF_R + (kv ? R_VC : R_KC));
    const bf16_t* W1 = (const bf16_t*)(W + W_C1) + (size_t)kv * 128 * 2048;
    const bf16_t* W2 = (const bf16_t*)(W + W_C2) + (size_t)kv * 64 * 128;
    const float* pb = (const float*)(W + W_PB) + kv * 128;
    f32x4 acc[4][4]; zero_acc(acc);
    gemm_kloop(acc, [&](int r) { int Rr = m0 + r; Rr = Rr < 4080 ? Rr : 4079; const int b = Rr / 510, rem = Rr % 510, c = rem >> 1, g = rem & 1;
                                 return src + ((size_t)(b * SEQ + 16 * c)) * 128 + g * 64; }, 128,
               [&](int v) { return W1 + (size_t)v * 2048; }, 64, 32, lds, tid);
#pragma unroll
    for (int mi = 0; mi < 4; ++mi) {
        const int row = 64 * wm + 16 * mi + fr; const int cb = 16 * fq;
        float v[16];
#pragma unroll
        for (int e = 0; e < 16; ++e) v[e] = gelu_tanh(acc[mi][e >> 2][e & 3] + pb[64 * wn + cb + e]);
        u32x4 a, b;
        a.x = pk_bf16(v[0], v[1]); a.y = pk_bf16(v[2], v[3]); a.z = pk_bf16(v[4], v[5]); a.w = pk_bf16(v[6], v[7]);
        b.x = pk_bf16(v[8], v[9]); b.y = pk_bf16(v[10], v[11]); b.z = pk_bf16(v[12], v[13]); b.w = pk_bf16(v[14], v[15]);
        *(u32x4*)(lds + wn * 16384 + row * 128 + (((2 * fq) ^ (row & 7)) << 4)) = a;
        *(u32x4*)(lds + wn * 16384 + row * 128 + (((2 * fq + 1) ^ (row & 7)) << 4)) = b;
    }
#pragma unroll
    for (int j = 0; j < 4; ++j) {
        const int pid = tid + 256 * j, row = pid >> 4, ch = pid & 15;
        const u32x4 v = *(const u32x4*)(W2 + row * 128 + ch * 8);
        *(u32x4*)(lds + 32768 + (ch >> 3) * 16384 + row * 128 + (((ch & 7) ^ (row & 7)) << 4)) = v;
    }
    __syncthreads();
    f32x4 a2[4][2];
#pragma unroll
    for (int i = 0; i < 4; ++i) { a2[i][0] = (f32x4){0.f, 0.f, 0.f, 0.f}; a2[i][1] = (f32x4){0.f, 0.f, 0.f, 0.f}; }
#pragma unroll
    for (int kt2 = 0; kt2 < 2; ++kt2)
#pragma unroll
        for (int ks = 0; ks < 2; ++ks) {
            bf16x8 af[4], bf[2];
#pragma unroll
            for (int mi = 0; mi < 4; ++mi) { const int row = 64 * wm + 16 * mi + fr; af[mi] = *(const bf16x8*)(lds + kt2 * 16384 + row * 128 + (((4 * ks + fq) ^ (row & 7)) << 4)); }
#pragma unroll
            for (int ni = 0; ni < 2; ++ni) { const int row = 32 * wn + 8 * (fr >> 2) + 4 * ni + (fr & 3); bf[ni] = *(const bf16x8*)(lds + 32768 + kt2 * 16384 + row * 128 + (((4 * ks + fq) ^ (row & 7)) << 4)); }
#pragma unroll
            for (int mi = 0; mi < 4; ++mi)
#pragma unroll
                for (int ni = 0; ni < 2; ++ni) a2[mi][ni] = mfma16(bf[ni], af[mi], a2[mi][ni]);
        }
    bf16_t* kcmp = (bf16_t*)(p.ws + OFF_C + C_KCMP);
    bf16_t* vct = (bf16_t*)(p.ws + OFF_C + C_VCT);
#pragma unroll
    for (int mi = 0; mi < 4; ++mi) {
        const int Rr = m0 + 64 * wm + 16 * mi + fr;
        if (Rr < 4080) {
            const int b = Rr / 510, rem = Rr % 510, c = rem >> 1, g = rem & 1, d0 = 32 * wn + 8 * fq;
            float v[8];
#pragma unroll
            for (int e = 0; e < 8; ++e) v[e] = a2[mi][e >> 2][e & 3];
            if (DBG_NOCSTORE) { if (v[0] == 123.456f) kcmp[0] = 1; }
            else if (kv == 0) {
                u32x4 o; o.x = pk_bf16(v[0], v[1]); o.y = pk_bf16(v[2], v[3]); o.z = pk_bf16(v[4], v[5]); o.w = pk_bf16(v[6], v[7]);
                *(u32x4*)(kcmp + ((size_t)(b * 256 + c)) * 128 + g * 64 + d0) = o;
                if (c == 254) *(u32x4*)(kcmp + ((size_t)(b * 256 + 255)) * 128 + g * 64 + d0) = (u32x4){0u, 0u, 0u, 0u};
            } else {
#pragma unroll
                for (int e = 0; e < 8; ++e) {
                    vct[((size_t)((b * 2 + g) * 64 + d0 + e)) * 256 + c] = f2bf(v[e]);
                    if (c == 254) vct[((size_t)((b * 2 + g) * 64 + d0 + e)) * 256 + 255] = 0;
                }
            }
        }
    }
    __syncthreads();
}

__device__ __forceinline__ void sgu_job(CKP& p, int l, int job, unsigned char* lds) {
    job_fence();
    const int tid = opaque_tid(), lane = tid & 63, w = tid >> 6, fr = lane & 15, fq = lane >> 4;
    const size_t tok0 = (size_t)job * 128;
    const bf16_t* V = (const bf16_t*)(p.ws + OFF_R + R_V) + tok0 * 256;
    const bf16_t* U = (const bf16_t*)(p.ws + OFF_R + R_U) + tok0 * 256;
    bf16_t* O = (bf16_t*)(p.ws + OFF_C + C_SGU) + tok0 * 256;
    const bf16_t* Wt = (const bf16_t*)(p.ws + OFF_W + W_SGU);
    const float* ng = p.in[11] + (size_t)l * 256;
    const float* bs = p.in[13] + (size_t)l * 512;
    __syncthreads();
    if (DBG_SGUCUT != 2) {
        const int s = tid >> 1, half = tid & 1;
        const bf16_t* src = V + (size_t)s * 256 + half * 128;
        float ss = 0.f;
#pragma unroll 4
        for (int j = 0; j < 16; ++j) {
            const u32x4 bb = *(const u32x4*)(src + j * 8);
            const unsigned uu[4] = {bb.x, bb.y, bb.z, bb.w};
#pragma unroll
            for (int q = 0; q < 4; ++q) { const float a = bflo(uu[q]), b2 = bfhi(uu[q]); ss += a * a + b2 * b2; }
        }
        ss += __shfl_xor(ss, 1);
        const float rstd = rsqrtf(ss * (1.f / 256.f) + RMS_EPS);
#pragma unroll 1
        for (int j = 0; j < 16; ++j) {
            const u32x4 bb = *(const u32x4*)(src + j * 8);
            const unsigned uu[4] = {bb.x, bb.y, bb.z, bb.w};
            const int cb = half * 128 + j * 8;
#pragma unroll
            for (int q = 0; q < 4; ++q) {
#pragma unroll
                for (int hh = 0; hh < 2; ++hh) {
                    const int c = cb + q * 2 + hh;
                    const float val = (hh ? bfhi(uu[q]) : bflo(uu[q])) * rstd * ng[c];
                    *(bf16_t*)(lds + c * 256 + ((((s >> 3) ^ (c & 15))) << 4) + (s & 7) * 2) = f2bf(val);
                }
            }
        }
    }
    __syncthreads();
    const int g = w;
#pragma unroll 1
    for (int th = 0; th < (DBG_SGUCUT == 1 ? 0 : 2); ++th) {
        f32x4 acc[4][4];
        zero_acc(acc);
#pragma unroll
        for (int ks = 0; ks < 4; ++ks) {
            if (32 * ks <= 64 * th + 63) {
                bf16x8 vf[4];
#pragma unroll
                for (int di = 0; di < 4; ++di) { const int c = 64 * g + 16 * di + fr; vf[di] = *(const bf16x8*)(lds + c * 256 + (((4 * ks + fq) ^ (c & 15)) << 4)); }
#pragma unroll
                for (int ti = 0; ti < 4; ++ti) {
                    const int t = 64 * th + 16 * ti + fr;
                    if (32 * ks <= 64 * th + 16 * ti + 15) {
                        const bf16x8 wf = *(const bf16x8*)(Wt + ((size_t)(g * 128 + t)) * 128 + 32 * ks + 8 * fq);
#pragma unroll
                        for (int di = 0; di < 4; ++di) acc[ti][di] = mfma16(vf[di], wf, acc[ti][di]);
                    }
                }
            }
        }
#pragma unroll
        for (int ti = 0; ti < 4; ++ti) {
            const int t = 64 * th + 16 * ti + fr; const float bb = bs[g * 128 + t];
#pragma unroll
            for (int di = 0; di < 4; ++di) {
                const int c = 64 * g + 16 * di + 4 * fq;
                const u32x2 uu = *(const u32x2*)(U + (size_t)t * 256 + c);
                u32x2 o;
                o.x = pk_bf16(bflo(uu.x) * (acc[ti][di][0] + bb), bfhi(uu.x) * (acc[ti][di][1] + bb));
                o.y = pk_bf16(bflo(uu.y) * (acc[ti][di][2] + bb), bfhi(uu.y) * (acc[ti][di][3] + bb));
                *(u32x2*)(O + (size_t)t * 256 + c) = o;
            }
        }
    }
    __syncthreads();
}

__device__ __forceinline__ void s5_job(CKP& p, int l, int jb, int pass, unsigned char* lds) {
    job_fence();
    const int tid = opaque_tid(), lane = tid & 63, w = tid >> 6, fr = lane & 15, fq = lane >> 4;
    const int id = ((jb * 4 + w) + DBG_IDROT) & 2047, seq = id >> 4, ch = id & 15, b = seq >> 4, g = seq & 15;
    unsigned char* W = p.ws + OFF_W;
    const float* ab = (const float*)(W + W_S5A) + (g * 64 + lane) * 2;
    float ar = ab[0], ai = ab[1];
    float br[16], bi[16];
    {
        const float* bb = (const float*)(W + W_S5B) + (size_t)(g * 64 + lane) * 32;
#pragma unroll
        for (int h = 0; h < 16; ++h) { br[h] = bb[h]; bi[h] = bb[16 + h]; }
    }
#if DBG_S5CONST >= 2
    { const float q = (float)(lane + 1) * 0.001f; ar = 0.99f - q; ai = 0.05f + q;
      for (int h = 0; h < 16; ++h) { br[h] = 0.01f * (float)(h + 1) + q; bi[h] = -0.02f * (float)(h + 1) + q; } }
#endif
    float* Eb = (float*)(p.ws + OFF_C + C_S5E);
    float hre = 0.f, him = 0.f;
    bf16x8 cf[4]; float dv[4];
    if (pass == 2) {
        const float* a2 = (const float*)(W + W_S5A256) + (g * 64 + lane) * 2;
        const float a2r = a2[0], a2i = a2[1];
        for (int c2 = 0; c2 < ch; ++c2) {
            const float* e = Eb + ((size_t)(seq * 16 + c2) * 64 + lane) * 2;
            const float nr = a2r * hre - a2i * him + e[0], ni = a2r * him + a2i * hre + e[1];
            hre = nr; him = ni;
        }
        const bf16_t* cm = (const bf16_t*)(W + W_S5C) + (size_t)(g * 16 + fr) * 128;
#pragma unroll
        for (int ks = 0; ks < 4; ++ks) cf[ks] = *(const bf16x8*)(cm + 32 * ks + 8 * fq);
#pragma unroll
        for (int r = 0; r < 4; ++r) dv[r] = p.in[22][(size_t)l * 256 + g * 16 + 4 * fq + r];
    }
    const bf16_t* xin = (const bf16_t*)(p.ws + OFF_R + R_S5IN) + ((size_t)(b * SEQ + ch * 256)) * 256 + g * 16;
    bf16_t* yg = (bf16_t*)(p.ws + OFF_C + C_YG) + ((size_t)(b * SEQ + ch * 256)) * 256 + g * 16;
    float* xs = (float*)(lds + w * 10240);
    int ldsbad = 0; (void)ldsbad;
    unsigned char* Hs = lds + w * 10240 + 2048;
#if DBG_TWICE
    float keep_re = 0.f, keep_im = 0.f;
#pragma unroll 1
    for (int rep = 0; rep < 2; ++rep) {
    if (rep == 1) { keep_re = hre; keep_im = him; hre = 0.f; him = 0.f; }
#endif
#pragma unroll 1
    for (int sub = 0; sub < 8; ++sub) {
#if DBG_S5CONST >= 1
        u32x4 xv; { const unsigned q = (unsigned)(sub * 32 + (lane >> 1)) * 2654435761u + (unsigned)id * 40503u + (lane & 1); xv.x = 0x3f803e80u ^ ((q & 0xff) << 16); xv.y = 0x3e003d00u ^ ((q >> 8) & 0x7f); xv.z = 0xbe803f00u ^ ((q >> 16) & 0x3f); xv.w = 0x3d80be00u; }
#else
        const u32x4 xv = *(const u32x4*)(xin + (size_t)(sub * 32 + (lane >> 1)) * 256 + (lane & 1) * 8);
#endif
        __syncthreads();
        f32x4 chk_a = {bflo(xv.x), bfhi(xv.x), bflo(xv.y), bfhi(xv.y)}, chk_c = {bflo(xv.z), bfhi(xv.z), bflo(xv.w), bfhi(xv.w)};
        {
            *(f32x4*)(xs + (lane >> 1) * 16 + (lane & 1) * 8) = chk_a;
            *(f32x4*)(xs + (lane >> 1) * 16 + (lane & 1) * 8 + 4) = chk_c;
        }
        __syncthreads();
#pragma unroll 4
        for (int st = 0; st < 32; ++st) {
#if DBG_S5CONST == 3
            f32x4 x0, x1, x2, x3;
            { const float t = (float)((sub * 32 + st) & 63) * 0.015625f + (float)(id & 7) * 0.125f;
              x0 = (f32x4){t, t * 0.5f, -t, 0.25f}; x1 = (f32x4){0.5f - t, t * t, 0.125f, t}; x2 = (f32x4){-0.25f, t, 0.75f * t, 1.f - t}; x3 = (f32x4){t, -t, 0.5f, 0.3f * t}; }
#else
            const f32x4 x0 = *(const f32x4*)(xs + st * 16), x1 = *(const f32x4*)(xs + st * 16 + 4), x2 = *(const f32x4*)(xs + st * 16 + 8), x3 = *(const f32x4*)(xs + st * 16 + 12);
#endif
            float ur = 0.f, ui = 0.f;
#pragma unroll
            for (int h = 0; h < 4; ++h) {
                ur += br[h] * x0[h]; ui += bi[h] * x0[h];
                ur += br[4 + h] * x1[h]; ui += bi[4 + h] * x1[h];
                ur += br[8 + h] * x2[h]; ui += bi[8 + h] * x2[h];
                ur += br[12 + h] * x3[h]; ui += bi[12 + h] * x3[h];
            }
            const float nr = ar * hre - ai * him + ur, ni = ar * him + ai * hre + ui;
            hre = nr; him = ni;
            if (pass == 2) {
                *(bf16_t*)(Hs + st * 256 + (((lane >> 3) ^ (st & 15)) << 4) + (lane & 7) * 2) = f2bf(hre);
                *(bf16_t*)(Hs + st * 256 + ((((64 + lane) >> 3) ^ (st & 15)) << 4) + (lane & 7) * 2) = f2bf(him);
            }
        }
#if DBG_LDSCHK
        {
            const f32x4 ra = *(volatile f32x4*)(xs + (lane >> 1) * 16 + (lane & 1) * 8), rc = *(volatile f32x4*)(xs + (lane >> 1) * 16 + (lane & 1) * 8 + 4);
            bool bad = false;
            for (int q = 0; q < 4; ++q) bad |= (__float_as_uint(ra[q]) != __float_as_uint(chk_a[q])) | (__float_as_uint(rc[q]) != __float_as_uint(chk_c[q]));
            if (__any(bad)) ldsbad = 1;
        }
#endif
        if (pass == 2) {
            __syncthreads();
#pragma unroll
            for (int tt = 0; tt < 2; ++tt) {
                f32x4 acc = {0.f, 0.f, 0.f, 0.f};
                const int tl = tt * 16 + fr;
#pragma unroll
                for (int ks = 0; ks < 4; ++ks) {
                    const bf16x8 hf = *(const bf16x8*)(Hs + tl * 256 + (((4 * ks + fq) ^ (tl & 15)) << 4));
                    acc = mfma16(cf[ks], hf, acc);
                }
                float y[4];
#pragma unroll
                for (int r = 0; r < 4; ++r) y[r] = gelu_tanh(acc[r] + dv[r] * xs[tl * 16 + 4 * fq + r]);
                u32x2 o; o.x = pk_bf16(y[0], y[1]); o.y = pk_bf16(y[2], y[3]);
                *(u32x2*)(yg + (size_t)(sub * 32 + tl) * 256 + 4 * fq) = o;
            }
        }
    }
#if DBG_TWICE
    }
    if (__float_as_uint(keep_re) != __float_as_uint(hre) || __float_as_uint(keep_im) != __float_as_uint(him)) { hre = __uint_as_float(0x7fc00000u); him = hre; }
#endif
    if (pass == 1) {
        float* e = Eb + ((size_t)(seq * 16 + ch) * 64 + lane) * 2;
#if DBG_LDSCHK
        if (ldsbad) { hre = __uint_as_float(0x7fc00000u); him = hre; }
#endif
#if DBG_ESC1
        { const unsigned long long pk = ((unsigned long long)__float_as_uint(him) << 32) | __float_as_uint(hre);
          __hip_atomic_store((unsigned long long*)e, pk, __ATOMIC_RELAXED, __HIP_MEMORY_SCOPE_AGENT); }
#else
        e[0] = hre; e[1] = him;
#endif
#if DBG_E2
        float* e2 = (float*)(p.ws + OFF_C + C_ATT) + ((size_t)(seq * 16 + ch) * 64 + lane) * 2;
        e2[0] = hre; e2[1] = him;
#endif
    }
    __syncthreads();
}

__device__ __forceinline__ void phase_mid1(CKP& p, int l, unsigned char* lds) {
#if DBG_QDELAY == 2
    if (blockIdx.x >= 320) return;
#elif DBG_QDELAY == 3
    if (blockIdx.x >= 320) {
        const unsigned long long t0 = __builtin_amdgcn_s_memrealtime(); while (__builtin_amdgcn_s_memrealtime() - t0 < 3000ull) __builtin_amdgcn_s_sleep(8);
        s5_job(p, l, blockIdx.x - 320, 1, lds);
        return;
    }
#elif DBG_QDELAY
    if (blockIdx.x >= 320) {
        s5_job(p, l, blockIdx.x - 320, 1, lds);
        const unsigned long long t0 = __builtin_amdgcn_s_memrealtime(); while (__builtin_amdgcn_s_memrealtime() - t0 < 6000ull) __builtin_amdgcn_s_sleep(8);
        return;
    }
#endif
    for (int j = blockIdx.x; j < 64 + 256 + 512; j += gridDim.x) {
#if DBG_ONLYS5 == 1
        if (j >= 320) s5_job(p, l, j - 320, 1, lds);
#elif DBG_ONLYS5 == 2
        if (j < 64) compress_tile(p, j, lds);
        else if (j >= 320) s5_job(p, l, j - 320, 1, lds);
#elif DBG_ONLYS5 == 4
        { const int jj = 831 - j; if (jj < 64) compress_tile(p, jj, lds); else if (jj >= 320) s5_job(p, l, jj - 320, 1, lds); }
#elif DBG_ONLYS5 == 5
        if (j < 64) compress_tile(p, j, lds);
        else if (j >= 320 && j < 512) s5_job(p, l, j - 320, 1, lds);
        else if (j >= 576) s5_job(p, l, j - 320, 1, lds);
        if (j >= 448 && j < 512) s5_job(p, l, j + 64 - 320, 1, lds);
#elif DBG_ONLYS5 == 3
        if (j >= 64 && j < 320) sgu_job(p, l, j - 64, lds);
        else if (j >= 320) s5_job(p, l, j - 320, 1, lds);
#elif DBG_ONLYS5 == 6
        if (j < 512) {
#if DBG_PRESPIN
            { const unsigned long long t0 = __builtin_amdgcn_s_memrealtime(); while (__builtin_amdgcn_s_memrealtime() - t0 < (unsigned long long)DBG_PRESPIN) __builtin_amdgcn_s_sleep(2); }
#endif
            s5_job(p, l, j, 1, lds);
        }
        else if (j < 768) sgu_job(p, l, j - 512, lds);
        else compress_tile(p, j - 768, lds);
#else
        if (j < 64) compress_tile(p, j, lds);
        else if (j < 320) {
#if DBG_SGUSPIN
            { const unsigned long long t0 = __builtin_amdgcn_s_memrealtime(); while (__builtin_amdgcn_s_memrealtime() - t0 < (unsigned long long)DBG_SGUSPIN) __builtin_amdgcn_s_sleep(2); }
#else
            sgu_job(p, l, j - 64, lds);
#endif
        } else {
#if DBG_DELAY
            if (j >= 576) { const unsigned long long t0 = __builtin_amdgcn_s_memrealtime(); while (__builtin_amdgcn_s_memrealtime() - t0 < (unsigned long long)DBG_DELAY) __builtin_amdgcn_s_sleep(8); }
#endif
            s5_job(p, l, j - 320, 1, lds);
        }
#endif
    }
}

constexpr int AL_Q = 0, AL_KV = 32768, AL_IMP = 49152, AL_SEL = 65792, AL_UNI = 66304, AL_JOB = 66336;
constexpr float SM_C = 0.125f * 1.4426950408889634f;

__device__ __forceinline__ void attn_load_q(const bf16_t* Qg, const int* pos, const float (&inv_freq)[8], int b, int g, int t0, bool rope, unsigned char* lds, int tid) {
#pragma unroll 1
    for (int j = 0; j < 8; ++j) {
        const int pid = tid + 256 * j, Rr = pid >> 3, ch = pid & 7;
        const int wq = Rr >> 6, r = (Rr >> 4) & 3, q = Rr & 15, t = t0 + 16 * wq + q;
        const bf16_t* src = Qg + ((size_t)(b * SEQ + t)) * 512 + (g * 4 + r) * 64;
        if (!rope || ch >= 2) {
            *(u32x4*)(lds + AL_Q + Rr * 128 + ((ch ^ (Rr & 7)) << 4)) = *(const u32x4*)(src + ch * 8);
        } else if (ch == 0) {
            const u32x4 a = *(const u32x4*)(src), c = *(const u32x4*)(src + 8);
            float x1[8] = {bflo(a.x), bfhi(a.x), bflo(a.y), bfhi(a.y), bflo(a.z), bfhi(a.z), bflo(a.w), bfhi(a.w)};
            float x2[8] = {bflo(c.x), bfhi(c.x), bflo(c.y), bfhi(c.y), bflo(c.z), bfhi(c.z), bflo(c.w), bfhi(c.w)};
            const float ps = (float)pos[b * SEQ + t];
#pragma unroll
            for (int i = 0; i < 8; ++i) {
                float sn, cs; sincosf(ps * inv_freq[i], &sn, &cs);
                const float u = x1[i], v = x2[i];
                x1[i] = u * cs - v * sn; x2[i] = v * cs + u * sn;
            }
            u32x4 o1, o2;
            o1.x = pk_bf16(x1[0], x1[1]); o1.y = pk_bf16(x1[2], x1[3]); o1.z = pk_bf16(x1[4], x1[5]); o1.w = pk_bf16(x1[6], x1[7]);
            o2.x = pk_bf16(x2[0], x2[1]); o2.y = pk_bf16(x2[2], x2[3]); o2.z = pk_bf16(x2[4], x2[5]); o2.w = pk_bf16(x2[6], x2[7]);
            *(u32x4*)(lds + AL_Q + Rr * 128 + ((0 ^ (Rr & 7)) << 4)) = o1;
            *(u32x4*)(lds + AL_Q + Rr * 128 + ((1 ^ (Rr & 7)) << 4)) = o2;
        }
    }
}
__device__ __forceinline__ void attn_ldg(u32x4 (&kk)[2], u32x4 (&vv)[2], const bf16_t* Kb, const bf16_t* Vb, int vstride, int tid) {
#pragma unroll
    for (int j = 0; j < 2; ++j) {
        const int pid = tid + 256 * j, row = pid >> 3, ch = pid & 7;
        kk[j] = *(const u32x4*)(Kb + (size_t)row * 128 + ch * 8);
        vv[j] = *(const u32x4*)(Vb + (size_t)row * vstride + ch * 8);
    }
}
__device__ __forceinline__ void attn_stl(const u32x4 (&kk)[2], const u32x4 (&vv)[2], unsigned char* lds, int kvoff, int tid) {
#pragma unroll
    for (int j = 0; j < 2; ++j) {
        const int pid = tid + 256 * j, row = pid >> 3, ch = pid & 7;
        *(u32x4*)(lds + kvoff + row * 128 + ((ch ^ (row & 7)) << 4)) = kk[j];
        *(u32x4*)(lds + kvoff + 8192 + row * 128 + ((ch ^ ((row >> 1) & 7)) << 4)) = vv[j];
    }
}
__device__ __forceinline__ void attn_qk(f32x4 (&s)[2][4], const unsigned char* lds, int kvoff, int w, int fr, int fq, int hf) {
    const unsigned char* Qw = lds + AL_Q + w * 8192;
    const unsigned char* Kh = lds + kvoff + hf * 4096;
    const int sw0 = ((fq) ^ (fr & 7)) << 4, sw1 = ((4 + fq) ^ (fr & 7)) << 4;
#pragma unroll
    for (int ki = 0; ki < 2; ++ki)
#pragma unroll
        for (int qi = 0; qi < 4; ++qi) s[ki][qi] = (f32x4){0.f, 0.f, 0.f, 0.f};
#pragma unroll
    for (int ds = 0; ds < 2; ++ds) {
        bf16x8 qf[4];
#pragma unroll
        for (int qi = 0; qi < 4; ++qi) qf[qi] = *(const bf16x8*)(Qw + (qi * 16 + fr) * 128 + (ds ? sw1 : sw0));
#pragma unroll
        for (int ki = 0; ki < 2; ++ki) {
            const bf16x8 kf = *(const bf16x8*)(Kh + (ki * 16 + fr) * 128 + (ds ? sw1 : sw0));
#pragma unroll
            for (int qi = 0; qi < 4; ++qi) s[ki][qi] = mfma16(kf, qf[qi], s[ki][qi]);
        }
    }
}
__device__ __forceinline__ void attn_pv(f32x4 (&o)[4][4], const f32x4 (&s)[2][4], const unsigned char* lds, int kvoff, int fr, int fq, int hf) {
    bf16x8 pf[4];
#pragma unroll
    for (int qi = 0; qi < 4; ++qi) {
        u32x4 u;
        u.x = pk_bf16(s[0][qi][0], s[0][qi][1]); u.y = pk_bf16(s[0][qi][2], s[0][qi][3]);
        u.z = pk_bf16(s[1][qi][0], s[1][qi][1]); u.w = pk_bf16(s[1][qi][2], s[1][qi][3]);
        pf[qi] = as_bf8(u);
    }
    const int c0 = 4 * hf + (fq >> 1);
    const unsigned char* Vt = lds + kvoff + 8192;
#pragma unroll
    for (int di = 0; di < 4; ++di) {
        const int row = di * 16 + fr, key = (row >> 1) & 7;
        const u32x2 lo = *(const u32x2*)(Vt + row * 128 + ((c0 ^ key) << 4) + 8 * (fq & 1));
        const u32x2 hi = *(const u32x2*)(Vt + row * 128 + (((c0 + 2) ^ key) << 4) + 8 * (fq & 1));
        const bf16x8 vf = as_bf8((u32x4){lo.x, lo.y, hi.x, hi.y});
#pragma unroll
        for (int qi = 0; qi < 4; ++qi) o[di][qi] = mfma16(vf, pf[qi], o[di][qi]);
    }
}
__device__ __forceinline__ unsigned attn_vmask(int kb, int fq, int lo, int hi) {
    unsigned vm = 0;
#pragma unroll
    for (int ki = 0; ki < 2; ++ki)
#pragma unroll
        for (int r = 0; r < 4; ++r) { const int key = kb + 16 * ki + 4 * fq + r; if (key >= lo && key <= hi) vm |= 1u << (ki * 4 + r); }
    return vm;
}
__device__ __forceinline__ void attn_softmax(f32x4 (&s)[2][4], f32x4 (&o)[4][4], float (&m)[4], float (&lsum)[4], unsigned vm) {
#pragma unroll
    for (int qi = 0; qi < 4; ++qi) {
        float mx = -1e30f;
#pragma unroll
        for (int ki = 0; ki < 2; ++ki)
#pragma unroll
            for (int r = 0; r < 4; ++r) { const float sv = ((vm >> (ki * 4 + r)) & 1u) ? s[ki][qi][r] * SM_C : -1e30f; s[ki][qi][r] = sv; mx = fmaxf(mx, sv); }
        mx = xmax16(mx); mx = xmax32(mx);
        const float mn = fmaxf(m[qi], mx), alpha = fexp2(m[qi] - mn);
        m[qi] = mn;
        float ls = 0.f;
#pragma unroll
        for (int ki = 0; ki < 2; ++ki)
#pragma unroll
            for (int r = 0; r < 4; ++r) { const float pv = ((vm >> (ki * 4 + r)) & 1u) ? fexp2(s[ki][qi][r] - mn) : 0.f; s[ki][qi][r] = pv; ls += pv; }
        lsum[qi] = lsum[qi] * alpha + ls;
        if (__any(alpha != 1.f)) {
#pragma unroll
            for (int di = 0; di < 4; ++di) o[di][qi] *= alpha;
        }
    }
}
__device__ __forceinline__ void attn_softmax_full(f32x4 (&s)[2][4], f32x4 (&o)[4][4], float (&m)[4], float (&lsum)[4], bool lsel) {
#pragma unroll
    for (int qi = 0; qi < 4; ++qi) {
        float mx = fmaxf(fmaxf(fmaxf(s[0][qi][0], s[0][qi][1]), fmaxf(s[0][qi][2], s[0][qi][3])), fmaxf(fmaxf(s[1][qi][0], s[1][qi][1]), fmaxf(s[1][qi][2], s[1][qi][3])));
        mx = xmax16(mx); mx = xmax32(mx);
        const float mn = fmaxf(m[qi], mx * SM_C);
        const float mnew = lsel ? mn : m[qi];
        const float alpha = fexp2(m[qi] - mnew);
        m[qi] = mnew;
        const float neg = lsel ? -mn : -1e30f;
        float ls = 0.f;
#pragma unroll
        for (int ki = 0; ki < 2; ++ki)
#pragma unroll
            for (int r = 0; r < 4; ++r) { const float pv = fexp2(fmaf(s[ki][qi][r], SM_C, neg)); s[ki][qi][r] = pv; ls += pv; }
        lsum[qi] = lsum[qi] * alpha + ls;
        if (__any(alpha != 1.f)) {
#pragma unroll
            for (int di = 0; di < 4; ++di) o[di][qi] *= alpha;
        }
    }
}
__device__ __forceinline__ void attn_accum(bf16_t* dst, const f32x4 (&o)[4][4], const float (&lsum)[4], const float (&gate)[4], bool first, int fq) {
#pragma unroll
    for (int qi = 0; qi < 4; ++qi) {
        float lt = lsum[qi]; lt = xsum16(lt); lt = xsum32(lt);
        const float sc = gate[qi] / fmaxf(lt, 1e-30f);
#pragma unroll
        for (int di = 0; di < 4; ++di) {
            u32x2* ptr = (u32x2*)(dst + qi * 64 + 16 * di + 4 * fq);
            float a0 = o[di][qi][0] * sc, a1 = o[di][qi][1] * sc, a2 = o[di][qi][2] * sc, a3 = o[di][qi][3] * sc;
            if (!first) { const u32x2 f = *ptr; a0 += bflo(f.x); a1 += bfhi(f.x); a2 += bflo(f.y); a3 += bfhi(f.y); }
            u32x2 r; r.x = pk_bf16(a0, a1); r.y = pk_bf16(a2, a3);
            *ptr = r;
        }
    }
}
template <class NextF, class PtrF, class BodyF>
__device__ __forceinline__ void attn_tiles(int first, NextF next, PtrF ptrs, BodyF body, unsigned char* lds, int tid) {
    u32x4 kk[2], vv[2];
    const bf16_t* Kb; const bf16_t* Vb; int vs;
    ptrs(first, Kb, Vb, vs);
    attn_ldg(kk, vv, Kb, Vb, vs, tid);
    int cur = first;
    while (cur >= 0) {
        __syncthreads();
        attn_stl(kk, vv, lds, AL_KV, tid);
        __syncthreads();
        const int nx = next(cur);
        if (nx >= 0) { ptrs(nx, Kb, Vb, vs); attn_ldg(kk, vv, Kb, Vb, vs, tid); }
        body(cur, AL_KV);
        cur = nx;
    }
}

__device__ __forceinline__ void phase_attn(CKP& p, int l, unsigned char* lds, unsigned* ctl) {
    for (int j = blockIdx.x; j < 512; j += gridDim.x) s5_job(p, l, j, 2, lds);

    unsigned char* R = p.ws + OFF_R; unsigned char* C = p.ws + OFF_C;
    const bf16_t* Qg = (const bf16_t*)(R + R_Q);
    const bf16_t* Kc = (const bf16_t*)(C + C_KCMP); const bf16_t* Vc = (const bf16_t*)(C + C_VCT);
    const bf16_t* Ks = (const bf16_t*)(R + R_KS); const bf16_t* Vs = (const bf16_t*)(R + R_VST);
    const bf16_t* Kw = (const bf16_t*)(R + R_KW); const bf16_t* Vw = (const bf16_t*)(R + R_VWT);
    const float* NG = (const float*)(R + R_NG);
    bf16_t* AO = (bf16_t*)(C + C_ATT);
    const int* pos = (const int*)p.in[1];
    unsigned* ctr = ctl + CTL_ATTN + l;
    volatile int* jobp = (volatile int*)(lds + AL_JOB);
    float* imp = (float*)(lds + AL_IMP);
    unsigned long long* selm = (unsigned long long*)(lds + AL_SEL);
    unsigned long long* uni = (unsigned long long*)(lds + AL_UNI);
    float invf[8];
#pragma unroll
    for (int q = 0; q < 8; ++q) invf[q] = p.inv_freq[q];

    for (;;) {
        const int tid = opaque_tid(), lane = tid & 63, w = tid >> 6, fr = lane & 15, fq = lane >> 4;
        __syncthreads();
        if (tid == 0) *jobp = (int)atomicAdd(ctr, 1u);
        __syncthreads();
        const int job = *jobp;
        if (job >= 1024) break;
        const int i = 63 - (job >> 4), bg = job & 15, b = bg >> 1, g = bg & 1, t0 = i * 64;
        const int tq = t0 + 16 * w + fr;
        const size_t kvrow = (size_t)b * SEQ;
        float gate[4];
        bf16_t* dstq = AO + ((size_t)(kvrow + tq)) * 512 + (g * 4) * 64;

        attn_load_q(Qg, pos, invf, b, g, t0, false, lds, tid);
        const int ntc = ((4 * i + 2) >> 6) + 1;
        const int hic = (tq >= 31) ? ((tq - 31) >> 4) : -1;
        float m[4], lsum[4];
#pragma unroll
        for (int qi = 0; qi < 4; ++qi) { m[qi] = -1e30f; lsum[qi] = 0.f; }
        auto cmp_next = [&](int ct) { return (ct + 1 < ntc) ? ct + 1 : -1; };
        auto cmp_ptrs = [&](int ct, const bf16_t*& Kb, const bf16_t*& Vb, int& vs) {
            Kb = Kc + ((size_t)(b * 256 + ct * 64)) * 128 + g * 64; Vb = Vc + ((size_t)((b * 2 + g) * 64)) * 256 + ct * 64; vs = 256; };
        attn_tiles(0, cmp_next, cmp_ptrs, [&](int ct, int kvoff) {
#pragma unroll 1
            for (int hf = 0; hf < 2; ++hf) {
                f32x4 s[2][4];
                attn_qk(s, lds, kvoff, w, fr, fq, hf);
                const unsigned vm = attn_vmask(ct * 64 + hf * 32, fq, 0, hic);
#pragma unroll
                for (int qi = 0; qi < 4; ++qi) {
                    float mx = -1e30f;
#pragma unroll
                    for (int ki = 0; ki < 2; ++ki)
#pragma unroll
                        for (int r = 0; r < 4; ++r) { const float sv = ((vm >> (ki * 4 + r)) & 1u) ? s[ki][qi][r] * SM_C : -1e30f; s[ki][qi][r] = sv; mx = fmaxf(mx, sv); }
                    mx = xmax16(mx); mx = xmax32(mx);
                    const float mn = fmaxf(m[qi], mx), alpha = fexp2(m[qi] - mn);
                    m[qi] = mn;
                    float ls = 0.f;
#pragma unroll
                    for (int ki = 0; ki < 2; ++ki)
#pragma unroll
                        for (int r = 0; r < 4; ++r) ls += ((vm >> (ki * 4 + r)) & 1u) ? fexp2(s[ki][qi][r] - mn) : 0.f;
                    lsum[qi] = lsum[qi] * alpha + ls;
                }
            }
        }, lds, tid);
        float invl[4];
#pragma unroll
        for (int qi = 0; qi < 4; ++qi) { float lt = lsum[qi]; lt = xsum16(lt); lt = xsum32(lt); invl[qi] = 1.f / fmaxf(lt, 1e-30f); }
        {
            f32x4 o[4][4]; zero_acc(o);
            float carry = 0.f;
            attn_tiles(0, cmp_next, cmp_ptrs, [&](int ct, int kvoff) {
#pragma unroll 1
                for (int hf = 0; hf < 2; ++hf) {
                    f32x4 s[2][4];
                    attn_qk(s, lds, kvoff, w, fr, fq, hf);
                    const unsigned vm = attn_vmask(ct * 64 + hf * 32, fq, 0, hic);
#pragma unroll
                    for (int qi = 0; qi < 4; ++qi)
#pragma unroll
                        for (int ki = 0; ki < 2; ++ki)
#pragma unroll
                            for (int r = 0; r < 4; ++r) s[ki][qi][r] = ((vm >> (ki * 4 + r)) & 1u) ? fexp2(s[ki][qi][r] * SM_C - m[qi]) * invl[qi] : 0.f;
#pragma unroll
                    for (int ki = 0; ki < 2; ++ki) {
                        float a = 0.f, bq = 0.f;
#pragma unroll
                        for (int qi = 0; qi < 4; ++qi) { a += s[ki][qi][0] + s[ki][qi][1] + s[ki][qi][2] + 0.5f * s[ki][qi][3]; bq += 0.5f * s[ki][qi][3]; }
                        const float up = __shfl(bq, (lane + 48) & 63);
                        const float wrap = __shfl(carry, (lane + 48) & 63);
                        a += (fq >= 1) ? up : wrap;
                        carry = bq;
                        imp[(16 * w + fr) * 65 + 16 * ct + 8 * hf + 4 * ki + fq] = a;
                    }
                    attn_pv(o, s, lds, kvoff, fr, fq, hf);
                }
            }, lds, tid);
#pragma unroll
            for (int qi = 0; qi < 4; ++qi) gate[qi] = NG[((size_t)(kvrow + tq)) * 24 + (g * 4 + qi) * 3 + 0];
            const float quarter[4] = {0.25f, 0.25f, 0.25f, 0.25f};
            attn_accum(dstq, o, quarter, gate, true, fq);
        }
        __syncthreads();
        {
            const int q = tid >> 2, part = tid & 3;
            unsigned long long mk = 0ull;
            if (i <= 15) { mk = (i == 63) ? ~0ull : ((1ull << (i + 1)) - 1ull); }
            else {
                const float* row = imp + q * 65;
                for (int j = 1 + part; j <= i - 2; j += 4) {
                    const float vj = row[j]; int rank = 0;
                    for (int j2 = 1; j2 <= i - 2; ++j2) { const float v2 = row[j2]; rank += (v2 > vj || (v2 == vj && j2 < j)) ? 1 : 0; }
                    if (rank < 13) mk |= 1ull << j;
                }
                unsigned lo32 = (unsigned)mk, hi32 = (unsigned)(mk >> 32);
                lo32 |= __shfl_xor(lo32, 1); hi32 |= __shfl_xor(hi32, 1);
                lo32 |= __shfl_xor(lo32, 2); hi32 |= __shfl_xor(hi32, 2);
                mk = ((unsigned long long)hi32 << 32) | lo32;
                mk |= 1ull | (1ull << i) | (1ull << (i - 1));
            }
            if (part == 0) selm[q] = mk;
            unsigned lo32 = (unsigned)mk, hi32 = (unsigned)(mk >> 32);
#pragma unroll
            for (int o2 = 32; o2 >= 1; o2 >>= 1) { lo32 |= __shfl_xor(lo32, o2); hi32 |= __shfl_xor(hi32, o2); }
            if (lane == 0) uni[w] = ((unsigned long long)hi32 << 32) | lo32;
        }
        __syncthreads();
        const unsigned long long mymask = selm[16 * w + fr];
        const unsigned long long un = uni[0] | uni[1] | uni[2] | uni[3];
        __syncthreads();
        attn_load_q((const bf16_t*)(R + R_QR), pos, invf, b, g, t0, false, lds, tid);
        {
            f32x4 o[4][4]; zero_acc(o);
#pragma unroll
            for (int qi = 0; qi < 4; ++qi) { m[qi] = -1e30f; lsum[qi] = 0.f; }
            attn_tiles(0,
                [&](int j) { const unsigned long long rest = (j >= 63) ? 0ull : (un >> (j + 1)); return rest ? (j + 1 + (int)__ffsll((long long)rest) - 1) : -1; },
                [&](int j, const bf16_t*& Kb, const bf16_t*& Vb, int& vs) { Kb = Ks + (kvrow + j * 64) * 128 + g * 64; Vb = Vs + ((size_t)((b * 2 + g) * 64)) * SEQ + j * 64; vs = SEQ; },
                [&](int j, int kvoff) {
                    const bool lsel = ((mymask >> j) & 1ull) != 0ull;
                    const int hi = lsel ? tq : -1;
#pragma unroll 1
                    for (int hf = 0; hf < 2; ++hf) {
                        f32x4 s[2][4];
                        attn_qk(s, lds, kvoff, w, fr, fq, hf);
                        if (j < i) attn_softmax_full(s, o, m, lsum, lsel);
                        else { const unsigned vm = attn_vmask(j * 64 + hf * 32, fq, 0, hi); attn_softmax(s, o, m, lsum, vm); }
                        attn_pv(o, s, lds, kvoff, fr, fq, hf);
                    }
                }, lds, tid);
#pragma unroll
            for (int qi = 0; qi < 4; ++qi) gate[qi] = NG[((size_t)(kvrow + tq)) * 24 + (g * 4 + qi) * 3 + 1];
            attn_accum(dstq, o, lsum, gate, false, fq);
        }
        {
            f32x4 o[4][4]; zero_acc(o);
#pragma unroll
            for (int qi = 0; qi < 4; ++qi) { m[qi] = -1e30f; lsum[qi] = 0.f; }
            const int j0 = (i >= 8) ? (i - 8) : 0;
            attn_tiles(j0,
                [&](int j) { return (j + 1 <= i) ? j + 1 : -1; },
                [&](int j, const bf16_t*& Kb, const bf16_t*& Vb, int& vs) { Kb = Kw + (kvrow + j * 64) * 128 + g * 64; Vb = Vw + ((size_t)((b * 2 + g) * 64)) * SEQ + j * 64; vs = SEQ; },
                [&](int j, int kvoff) {
#pragma unroll 1
                    for (int hf = 0; hf < 2; ++hf) {
                        f32x4 s[2][4];
                        attn_qk(s, lds, kvoff, w, fr, fq, hf);
                        if (j >= i - 7 && j < i) attn_softmax_full(s, o, m, lsum, true);
                        else { const unsigned vm = attn_vmask(j * 64 + hf * 32, fq, tq - 511, tq); attn_softmax(s, o, m, lsum, vm); }
                        attn_pv(o, s, lds, kvoff, fr, fq, hf);
                    }
                }, lds, tid);
#pragma unroll
            for (int qi = 0; qi < 4; ++qi) gate[qi] = NG[((size_t)(kvrow + tq)) * 24 + (g * 4 + qi) * 3 + 2];
            attn_accum(dstq, o, lsum, gate, false, fq);
        }
    }
}

__device__ __forceinline__ void phase_glu(CKP& p, int l, unsigned char* lds) {
    const int tid = opaque_tid(), lane = tid & 63, w = tid >> 6, wm = w >> 1, wn = w & 1, fr = lane & 15, fq = lane >> 4;
    const bf16_t* A = (const bf16_t*)(p.ws + OFF_C + C_YG);
    const bf16_t* Bt = (const bf16_t*)(p.ws + OFF_W + W_GLU);
    bf16_t* O = (bf16_t*)(p.ws + OFF_C + C_S5O);
    const float* gb = p.in[24] + (size_t)l * 256;
    constexpr int NTM = NTOK / 128, NTN = 2;
    for (int L = blockIdx.x; L < NTM * NTN; L += gridDim.x) {
        int tm, tn; tile_coords(L, NTM, NTN, tm, tn);
        const int m0 = tm * 128, n0 = tn * 128;
        f32x4 acc[4][4]; zero_acc(acc);
        gemm_kloop(acc, [&](int r) { return A + (size_t)(m0 + r) * 256; }, 64, [&](int v) { return Bt + (size_t)(n0 + v) * 256; }, 64, 4, lds, tid);
#pragma unroll
        for (int mi = 0; mi < 4; ++mi) {
            const int row = m0 + 64 * wm + 16 * mi + fr, col = n0 + 64 * wn + 16 * fq;
            const u32x4 y0 = *(const u32x4*)(A + (size_t)row * 256 + col), y1 = *(const u32x4*)(A + (size_t)row * 256 + col + 8);
            const unsigned yy[8] = {y0.x, y0.y, y0.z, y0.w, y1.x, y1.y, y1.z, y1.w};
            float v[16];
#pragma unroll
            for (int e = 0; e < 16; ++e) {
                const float y = (e & 1) ? bfhi(yy[e >> 1]) : bflo(yy[e >> 1]);
                v[e] = y * sigm(acc[mi][e >> 2][e & 3] + gb[col + e]);
            }
            store16bf(O + (size_t)row * 256 + col, v);
        }
    }
}

__device__ __forceinline__ void phase_branch(CKP& p, int l, unsigned char* lds) {
    const int tid = opaque_tid(), lane = tid & 63, w = tid >> 6, wm = w >> 1, wn = w & 1, fr = lane & 15, fq = lane >> 4;
    const bf16_t* H = (const bf16_t*)(p.ws + OFF_H);
    const bf16_t* Wgb = (const bf16_t*)(p.ws + OFF_W + W_GB);
    bf16_t* Mg = (bf16_t*)(p.ws + OFF_M);
    bf16_t* Yt = (bf16_t*)(p.ws + OFF_R);
    constexpr int NTM = NTOK / 128, NTN = 8;
    for (int L = blockIdx.x; L < NTM * NTN; L += gridDim.x) {
        int tm, tn; tile_coords(L, NTM, NTN, tm, tn);
        const int m0 = tm * 128, n0 = tn * 128;
#pragma unroll 1
        for (int br = 0; br < 3; ++br) {
            const bf16_t* Ab; const bf16_t* Wb; int Kb;
            if (br == 0) { Ab = (const bf16_t*)(p.ws + OFF_C + C_ATT); Wb = (const bf16_t*)(p.ws + OFF_W + W_A); Kb = 512; }
            else if (br == 1) { Ab = (const bf16_t*)(p.ws + OFF_C + C_SGU); Wb = (const bf16_t*)(p.ws + OFF_W + W_S); Kb = 256; }
            else { Ab = (const bf16_t*)(p.ws + OFF_C + C_S5O); Wb = (const bf16_t*)(p.ws + OFF_W + W_5); Kb = 256; }
            {
                f32x4 acc[4][4]; zero_acc(acc);
                gemm_kloop(acc, [&](int r) { return Ab + (size_t)(m0 + r) * Kb; }, 64, [&](int v) { return Wb + (size_t)(n0 + v) * Kb; }, 64, Kb >> 6, lds, tid);
#pragma unroll
                for (int mi = 0; mi < 4; ++mi) {
                    const int row = m0 + 64 * wm + 16 * mi + fr, col = n0 + 64 * wn + 16 * fq;
                    float v[16];
#pragma unroll
                    for (int e = 0; e < 16; ++e) v[e] = acc[mi][e >> 2][e & 3];
                    store16bf(Yt + (size_t)row * 1024 + col, v);
                }
            }
            {
                f32x4 acc[4][4]; zero_acc(acc);
                gemm_kloop(acc, [&](int r) { return H + (size_t)(m0 + r) * 1024; }, 64, [&](int v) { return Wgb + (size_t)(br * 1024 + n0 + v) * 1024; }, 64, 16, lds, tid);
#pragma unroll
                for (int mi = 0; mi < 4; ++mi) {
                    const int row = m0 + 64 * wm + 16 * mi + fr, col = n0 + 64 * wn + 16 * fq;
                    u32x4* dst = (u32x4*)(Mg + (size_t)row * 1024 + col);
                    const u32x4* ysrc = (const u32x4*)(Yt + (size_t)row * 1024 + col);
                    const u32x4 y0 = ysrc[0], y1 = ysrc[1];
                    const unsigned yy[8] = {y0.x, y0.y, y0.z, y0.w, y1.x, y1.y, y1.z, y1.w};
                    unsigned pp[8] = {0u, 0u, 0u, 0u, 0u, 0u, 0u, 0u};
                    if (br > 0) { const u32x4 p0 = dst[0], p1 = dst[1]; pp[0] = p0.x; pp[1] = p0.y; pp[2] = p0.z; pp[3] = p0.w; pp[4] = p1.x; pp[5] = p1.y; pp[6] = p1.z; pp[7] = p1.w; }
                    unsigned outw[8];
#pragma unroll
                    for (int ni = 0; ni < 4; ++ni) {
                        const float a0 = sigm(acc[mi][ni][0]) * bflo(yy[2 * ni]) + bflo(pp[2 * ni]), a1 = sigm(acc[mi][ni][1]) * bfhi(yy[2 * ni]) + bfhi(pp[2 * ni]);
                        const float a2 = sigm(acc[mi][ni][2]) * bflo(yy[2 * ni + 1]) + bflo(pp[2 * ni + 1]), a3 = sigm(acc[mi][ni][3]) * bfhi(yy[2 * ni + 1]) + bfhi(pp[2 * ni + 1]);
                        outw[2 * ni] = pk_bf16(a0, a1); outw[2 * ni + 1] = pk_bf16(a2, a3);
                    }
                    dst[0] = (u32x4){outw[0], outw[1], outw[2], outw[3]};
                    dst[1] = (u32x4){outw[4], outw[5], outw[6], outw[7]};
                }
            }
        }
    }
}

__device__ __forceinline__ void phase_mix(CKP& p, int l, unsigned char* lds) {
    const int tid = opaque_tid(), lane = tid & 63, w = tid >> 6, wm = w >> 1, wn = w & 1, fr = lane & 15, fq = lane >> 4;
    const bf16_t* A = (const bf16_t*)(p.ws + OFF_M);
    const bf16_t* Bt = (const bf16_t*)(p.ws + OFF_W + W_M);
    constexpr int NTM = NTOK / 128, NTN = 8;
    for (int L = blockIdx.x; L < NTM * NTN; L += gridDim.x) {
        int tm, tn; tile_coords(L, NTM, NTN, tm, tn);
        const int m0 = tm * 128, n0 = tn * 128;
        f32x4 acc[4][4]; zero_acc(acc);
        gemm_kloop(acc, [&](int r) { return A + (size_t)(m0 + r) * 1024; }, 64, [&](int v) { return Bt + (size_t)(n0 + v) * 1024; }, 64, 16, lds, tid);
#pragma unroll
        for (int mi = 0; mi < 4; ++mi) {
            const int row = m0 + 64 * wm + 16 * mi + fr, col = n0 + 64 * wn + 16 * fq;
            float* xp = p.xbuf + (size_t)row * 1024 + col;
#pragma unroll
            for (int ni = 0; ni < 4; ++ni) { f32x4 xv = *(f32x4*)(xp + 4 * ni); xv += acc[mi][ni]; *(f32x4*)(xp + 4 * ni) = xv; }
        }
    }
}

__device__ __forceinline__ void phase_router(CKP& p, int l, unsigned char* lds, unsigned* ctl) {
    const int tid = opaque_tid(), lane = tid & 63, w = tid >> 6, wm = w >> 1, wn = w & 1, fr = lane & 15, fq = lane >> 4;
    const float* gam = p.in[27] + (size_t)l * 1024;
    const float* bg = p.in[29] + (size_t)l * 4;
    const float* be = p.in[31] + (size_t)l * 32;
    bf16_t* h2 = (bf16_t*)(p.ws + OFF_M);
    bf16_t* hlo = (bf16_t*)(p.ws + OFF_H);
    const bf16_t* Wh = (const bf16_t*)(p.ws + OFF_W + W_RH);
    const bf16_t* Wl = (const bf16_t*)(p.ws + OFF_W + W_RL);
    unsigned* cnt = ctl + CTL_MOECNT + l * 32;
    int* list = (int*)(p.ws + OFF_MOE + MOE_LIST);
    float* wsl = (float*)(p.ws + OFF_MOE + MOE_WS);
    float* lg = (float*)lds;
    int* lc = (int*)(lds + 18432); int* gbs = (int*)(lds + 18432 + 128);
    for (int tile = blockIdx.x; tile < NTOK / 128; tile += gridDim.x) {
        const int r0 = tile * 128;
        {
            f32x4 gv[4];
#pragma unroll
            for (int i = 0; i < 4; ++i) gv[i] = *(const f32x4*)(gam + 4 * lane + 256 * i);
            for (int rr = 0; rr < 32; rr += 2) {
                const int row = r0 + w * 32 + rr;
                f32x4 xa[4], xb[4]; float sa = 0.f, sb = 0.f;
#pragma unroll
                for (int i = 0; i < 4; ++i) { xa[i] = *(const f32x4*)(p.xbuf + (size_t)row * 1024 + 4 * lane + 256 * i); xb[i] = *(const f32x4*)(p.xbuf + (size_t)(row + 1) * 1024 + 4 * lane + 256 * i); }
#pragma unroll
                for (int i = 0; i < 4; ++i) { sa += xa[i][0] * xa[i][0] + xa[i][1] * xa[i][1] + xa[i][2] * xa[i][2] + xa[i][3] * xa[i][3]; sb += xb[i][0] * xb[i][0] + xb[i][1] * xb[i][1] + xb[i][2] * xb[i][2] + xb[i][3] * xb[i][3]; }
                sa = wave_sum(sa); sb = wave_sum(sb);
                const float ra_ = rsqrtf(sa * (1.f / 1024.f) + RMS_EPS), rb_ = rsqrtf(sb * (1.f / 1024.f) + RMS_EPS);
#pragma unroll
                for (int i = 0; i < 4; ++i) {
                    const f32x4 ha = xa[i] * ra_ * gv[i], hb = xb[i] * rb_ * gv[i];
                    u32x2 oa, ob, la, lb;
                    oa.x = pk_bf16(ha[0], ha[1]); oa.y = pk_bf16(ha[2], ha[3]); ob.x = pk_bf16(hb[0], hb[1]); ob.y = pk_bf16(hb[2], hb[3]);
                    la.x = pk_bf16(ha[0] - bflo(oa.x), ha[1] - bfhi(oa.x)); la.y = pk_bf16(ha[2] - bflo(oa.y), ha[3] - bfhi(oa.y));
                    lb.x = pk_bf16(hb[0] - bflo(ob.x), hb[1] - bfhi(ob.x)); lb.y = pk_bf16(hb[2] - bflo(ob.y), hb[3] - bfhi(ob.y));
                    *(u32x2*)(h2 + (size_t)row * 1024 + 4 * lane + 256 * i) = oa; *(u32x2*)(h2 + (size_t)(row + 1) * 1024 + 4 * lane + 256 * i) = ob;
                    *(u32x2*)(hlo + (size_t)row * 1024 + 4 * lane + 256 * i) = la; *(u32x2*)(hlo + (size_t)(row + 1) * 1024 + 4 * lane + 256 * i) = lb;
                }
            }
        }
        asm volatile("s_waitcnt vmcnt(0)" ::: "memory");
        __syncthreads();
        f32x4 acc[4][4]; zero_acc(acc);
        gemm_kloop(acc, [&](int r) { return h2 + (size_t)(r0 + r) * 1024; }, 64, [&](int v) { return Wh + (size_t)(v < 63 ? v : 63) * 1024; }, 64, 16, lds, tid);
        gemm_kloop(acc, [&](int r) { return h2 + (size_t)(r0 + r) * 1024; }, 64, [&](int v) { return Wl + (size_t)(v < 63 ? v : 63) * 1024; }, 64, 16, lds, tid);
        gemm_kloop(acc, [&](int r) { return hlo + (size_t)(r0 + r) * 1024; }, 64, [&](int v) { return Wh + (size_t)(v < 63 ? v : 63) * 1024; }, 64, 16, lds, tid);
        if (tid < 32) lc[tid] = 0;
        if (wn == 0 && fq < 3) {
#pragma unroll
            for (int mi = 0; mi < 4; ++mi) {
                const int row = 64 * wm + 16 * mi + fr;
#pragma unroll
                for (int e = 0; e < 16; ++e) { const int col = 16 * fq + e; if (col < 36) lg[row * 36 + col] = acc[mi][e >> 2][e & 3]; }
            }
        }
        __syncthreads();
        int e0 = 0, e1 = 0, lr0 = 0, lr1 = 0; float c0 = 0.f, c1 = 0.f;
        if (tid < 128) {
            const float* lrow = lg + tid * 36;
            float gl[4]; int grp = 0; float gm = -3.4e38f;
#pragma unroll
            for (int q = 0; q < 4; ++q) { gl[q] = lrow[q] + bg[q]; if (gl[q] > gm) { gm = gl[q]; grp = q; } }
            float gsum = 0.f;
#pragma unroll
            for (int q = 0; q < 4; ++q) gsum += expf(gl[q] - gm);
            const float grp_w = 1.f / gsum;
            float el[8]; float em = -3.4e38f;
#pragma unroll
            for (int q = 0; q < 8; ++q) { el[q] = lrow[4 + grp * 8 + q] + be[grp * 8 + q]; em = fmaxf(em, el[q]); }
            float esum = 0.f; float ep[8];
#pragma unroll
            for (int q = 0; q < 8; ++q) { ep[q] = expf(el[q] - em); esum += ep[q]; }
            int j0 = 0; float p0 = -1.f;
#pragma unroll
            for (int q = 0; q < 8; ++q) { const float pq = ep[q] / esum; ep[q] = pq; if (pq > p0) { p0 = pq; j0 = q; } }
            int j1 = 0; float p1 = -1.f;
#pragma unroll
            for (int q = 0; q < 8; ++q) { if (q != j0 && ep[q] > p1) { p1 = ep[q]; j1 = q; } }
            const float den = p0 + p1;
            c0 = grp_w * p0 / den; c1 = grp_w * p1 / den;
            e0 = grp * 8 + j0; e1 = grp * 8 + j1;
            lr0 = atomicAdd(&lc[e0], 1); lr1 = atomicAdd(&lc[e1], 1);
        }
        __syncthreads();
        if (tid < 32) { const int n = lc[tid]; gbs[tid] = n ? (int)atomicAdd(&cnt[tid], (unsigned)n) : 0; }
        __syncthreads();
        if (tid < 128) {
            const int tok = r0 + tid;
            list[e0 * 32768 + gbs[e0] + lr0] = tok * 2; list[e1 * 32768 + gbs[e1] + lr1] = tok * 2 + 1;
            wsl[tok * 2] = c0; wsl[tok * 2 + 1] = c1;
        }
        __syncthreads();
    }
}

__device__ __forceinline__ bool moe_tile(const unsigned* cnt, int L, int nsub, int& e, int& mt, int& sub, int& rowbase, int& n) {
    const int lane = threadIdx.x & 63;
    const int c = (lane < 32) ? (int)cnt[lane] : 0;
    const int nt = (c + 127) >> 7;
    int pre = nt;
#pragma unroll
    for (int o = 1; o < 32; o <<= 1) { const int v = __shfl_up(pre, o); if (lane >= o) pre += v; }
    const int excl = pre - nt;
    const bool mine = (lane < 32) && (L >= excl * nsub) && (L < pre * nsub);
    const unsigned long long bal = __ballot(mine);
    if (bal == 0ull) return false;
    e = __ffsll((long long)bal) - 1;
    const int ex = __shfl(excl, e);
    n = __shfl(c, e);
    const int r = L - ex * nsub;
    mt = r / nsub; sub = r % nsub; rowbase = ex * 128;
    return true;
}
__device__ __forceinline__ void phase_exp1(CKP& p, int l, unsigned char* lds, unsigned* ctl) {
    const int tid = opaque_tid(), lane = tid & 63, w = tid >> 6, wm = w >> 1, wn = w & 1, fr = lane & 15, fq = lane >> 4;
    const unsigned* cnt = ctl + CTL_MOECNT + l * 32;
    const int* list = (const int*)(p.ws + OFF_MOE + MOE_LIST);
    const bf16_t* h2 = (const bf16_t*)(p.ws + OFF_M);
    bf16_t* hid = (bf16_t*)(p.ws + OFF_HID);
    for (int L = blockIdx.x;; L += gridDim.x) {
        int e, mt, sub, rowbase, n;
        if (!moe_tile(cnt, L, 8, e, mt, sub, rowbase, n)) break;
        const bf16_t* Wg = (const bf16_t*)(p.ws + OFF_W + W_EG) + (size_t)e * 512 * 1024;
        const bf16_t* Wu = (const bf16_t*)(p.ws + OFF_W + W_EU) + (size_t)e * 512 * 1024;
        const int j0 = sub * 64;
        f32x4 acc[4][4]; zero_acc(acc);
        gemm_kloop(acc, [&](int r) { int s = mt * 128 + r; s = s < n ? s : n - 1; const int slot = list[e * 32768 + s]; return h2 + (size_t)(slot >> 1) * 1024; }, 64,
                   [&](int v) { const int wn_ = v >> 6, fq_ = (v >> 4) & 3, ee = v & 15; const int hc = j0 + 32 * wn_ + 8 * fq_ + (ee & 7);
                                return ((ee >> 3) ? Wu : Wg) + (size_t)hc * 1024; }, 64, 16, lds, tid);
#pragma unroll
        for (int mi = 0; mi < 4; ++mi) {
            const int r = mt * 128 + 64 * wm + 16 * mi + fr;
            if (r < n) {
                float gv[8], uv[8];
#pragma unroll
                for (int e2 = 0; e2 < 8; ++e2) { gv[e2] = acc[mi][e2 >> 2][e2 & 3]; uv[e2] = acc[mi][2 + (e2 >> 2)][e2 & 3]; }
                float hv[8];
#pragma unroll
                for (int e2 = 0; e2 < 8; ++e2) hv[e2] = gv[e2] * sigm(gv[e2]) * uv[e2];
                u32x4 o; o.x = pk_bf16(hv[0], hv[1]); o.y = pk_bf16(hv[2], hv[3]); o.z = pk_bf16(hv[4], hv[5]); o.w = pk_bf16(hv[6], hv[7]);
                *(u32x4*)(hid + (size_t)(rowbase + r) * 512 + j0 + 32 * wn + 8 * fq) = o;
            }
        }
    }
}
__device__ __forceinline__ void phase_exp2(CKP& p, int l, unsigned char* lds, unsigned* ctl) {
    const int tid = opaque_tid(), lane = tid & 63, w = tid >> 6, wm = w >> 1, wn = w & 1, fr = lane & 15, fq = lane >> 4;
    const unsigned* cnt = ctl + CTL_MOECNT + l * 32;
    const int* list = (const int*)(p.ws + OFF_MOE + MOE_LIST);
    const float* wsl = (const float*)(p.ws + OFF_MOE + MOE_WS);
    const bf16_t* hid = (const bf16_t*)(p.ws + OFF_HID);
    bf16_t* ys = (bf16_t*)(p.ws + OFF_YS);
    for (int L = blockIdx.x;; L += gridDim.x) {
        int e, mt, sub, rowbase, n;
        if (!moe_tile(cnt, L, 8, e, mt, sub, rowbase, n)) break;
        const bf16_t* Wd = (const bf16_t*)(p.ws + OFF_W + W_ED) + (size_t)e * 1024 * 512;
        const int n0 = sub * 128;
        f32x4 acc[4][4]; zero_acc(acc);
        gemm_kloop(acc, [&](int r) { int s = mt * 128 + r; s = s < n ? s : n - 1; return hid + (size_t)(rowbase + s) * 512; }, 64,
                   [&](int v) { return Wd + (size_t)(n0 + v) * 512; }, 64, 8, lds, tid);
#pragma unroll
        for (int mi = 0; mi < 4; ++mi) {
            const int r = mt * 128 + 64 * wm + 16 * mi + fr;
            if (r < n) {
                const int slot = list[e * 32768 + r]; const float wt = wsl[slot];
                float v[16];
#pragma unroll
                for (int e2 = 0; e2 < 16; ++e2) v[e2] = acc[mi][e2 >> 2][e2 & 3] * wt;
                store16bf(ys + (size_t)slot * 1024 + n0 + 64 * wn + 16 * fq, v);
            }
        }
    }
}

constexpr int PH_PER_LAYER = 10;
constexpr int NPHASE = PH_PER_LAYER * DEPTH + 1;

__global__ __attribute__((target("no-packed-fp32-ops"))) void __launch_bounds__(NTHR, 2) mega(KP p_unused) {
    extern __shared__ __attribute__((aligned(16))) unsigned char lds[];
    unsigned* ctl = (unsigned*)(p_unused.ws + OFF_CTL);
#if ONE_LAUNCH
    XcdBarrier xb = xcd_barrier_post(ctl + CTL_BAR, (volatile LAS unsigned*)(lds + LDS_BAR));
    if (p_unused.never) cg::this_grid().sync();
#if DBG_PREFLUSH
    __builtin_amdgcn_fence(__ATOMIC_RELEASE, "");
    asm volatile("s_waitcnt vmcnt(0)" ::: "memory");
    __builtin_amdgcn_fence(__ATOMIC_ACQUIRE, "");
    asm volatile("s_waitcnt vmcnt(0)" ::: "memory");
    xcd_barrier(xb);
    { const unsigned long long t0 = __builtin_amdgcn_s_memrealtime(); while (__builtin_amdgcn_s_memrealtime() - t0 < 20000ull) __builtin_amdgcn_s_sleep(8); }
    xcd_barrier(xb);
#endif
#endif
    CKP* kp0 = (CKP*)__builtin_amdgcn_kernarg_segment_ptr();
    const int ph_lo = kp0->ph_lo, ph_hi = kp0->ph_hi;
#if ONE_LAUNCH
#define PH_SYNC(PH) if ((PH) + 1 < ph_hi) xcd_barrier(xb);
#else
#define PH_SYNC(PH)
#endif
#if DBG_TIMEPH >= 0
#define PH_STAMP(PH) if (blockIdx.x == 0 && threadIdx.x == 0) ((unsigned long long*)(kp0->ws + OFF_CTL + 24576))[(PH)] = __builtin_amdgcn_s_memrealtime();
#else
#define PH_STAMP(PH)
#endif
#define RUN_PHASE(PH, CALL) if (ph_lo <= (PH) && (PH) < ph_hi) { PH_STAMP(PH) CKP* kp = kp0; asm volatile("" : "+s"(kp)); CKP& p = *kp; const int rep_ = 0; (void)rep_; CALL; \
    if ((PH) == DBG_REPEAT_PH) { xcd_barrier(xb); const int rep_ = 1; (void)rep_; CALL; } PH_SYNC(PH) }
#define RUN_LAYER(L) \
    RUN_PHASE((L) * 10 + 0, phase_prep(p, (L), lds)) \
    RUN_PHASE((L) * 10 + 1, phase_inproj(p, (L), lds)) \
    RUN_PHASE((L) * 10 + 2, phase_mid1(p, (L), lds)) \
    RUN_PHASE((L) * 10 + 3, phase_attn(p, (L), lds, ctl + 2 * rep_)) \
    RUN_PHASE((L) * 10 + 4, phase_glu(p, (L), lds)) \
    RUN_PHASE((L) * 10 + 5, phase_branch(p, (L), lds)) \
    RUN_PHASE((L) * 10 + 6, phase_mix(p, (L), lds)) \
    RUN_PHASE((L) * 10 + 7, phase_router(p, (L), lds, ctl)) \
    RUN_PHASE((L) * 10 + 8, phase_exp1(p, (L), lds, ctl)) \
    RUN_PHASE((L) * 10 + 9, phase_exp2(p, (L), lds, ctl))
#if DBG_SMALLK
    RUN_PHASE(0, phase_prep(p, 0, lds))
    RUN_PHASE(1, phase_inproj(p, 0, lds))
    RUN_PHASE(2, phase_mid1(p, 0, lds))
#else
    RUN_LAYER(0)
    RUN_LAYER(1)
    RUN_PHASE(20, phase_prep(p, 2, lds))
#endif
#if ONE_LAUNCH && DBG_DUMP
    {
        xcd_barrier(xb);
        CKP* kp = kp0; asm volatile("" : "+s"(kp)); CKP& p = *kp;
        const size_t NO = (size_t)NTOK * 1024;
        const unsigned char* src = p.ws + DBG_DUMP_OFF;
        for (size_t i = (size_t)blockIdx.x * NTHR + threadIdx.x; i < NO; i += (size_t)gridDim.x * NTHR) {
            float v = 0.f;
            if (i < (size_t)DBG_DUMP_N) {
                if (DBG_DUMP_F32) {
                    const size_t si = DBG_DUMP_REV ? ((size_t)DBG_DUMP_N - 1 - i) : i;
#if DBG_SC1READ
                    const unsigned fu = __hip_atomic_load((const unsigned*)src + si, __ATOMIC_RELAXED, __HIP_MEMORY_SCOPE_SYSTEM); const float f = __uint_as_float(fu);
#else
                    const float f = ((const float*)src)[si];
#endif
                    v = DBG_HASH ? (float)(__float_as_uint(f) & 0x3ff) : f;
#if DBG_EFILT
                    { const int id_ = (int)(((si >> 7) - DBG_IDROT) & 2047), blk = ((id_ >> 2) + 320) & 511; if (!(blk >= DBG_EFILT_LO && blk < DBG_EFILT_HI)) v = 0.f; }
#endif
#if DBG_E2
                    { const float f2 = ((const float*)(p.ws + OFF_C + C_ATT))[i]; v = (__float_as_uint(f2) == __float_as_uint(f)) ? 0.f : 1000.f; if (i == 0) v += 1.f; }
#endif
                }
                else { const bf16_t h = ((const bf16_t*)src)[i]; v = DBG_HASH ? (float)(h & 0x3ff) : bf2f(h); }
            }
#if DBG_CONSTOUT
            v = 1000.f + (float)(i & 1023);
#endif
            p.xbuf[i] = v;
        }
    }
#endif
}

#if DBG_DUMP
__global__ void dbg_dump(const bf16_t* src, size_t n, float* out, size_t nout) {
    for (size_t i = (size_t)blockIdx.x * blockDim.x + threadIdx.x; i < nout; i += (size_t)gridDim.x * blockDim.x)
        out[i] = i < n ? (DBG_HASH ? (float)(src[i] & 0x3ff) : bf2f(src[i])) : 0.f;
}
__global__ void dbg_dump_f32(const float* src, size_t n, float* out, size_t nout) {
    for (size_t i = (size_t)blockIdx.x * blockDim.x + threadIdx.x; i < nout; i += (size_t)gridDim.x * blockDim.x)
        out[i] = i < n ? (DBG_HASH ? (float)(__float_as_uint(src[i]) & 0x3ff) : src[i]) : 0.f;
}
#endif
extern "C" void kernel_launch(void* const* d_in, const int* in_sizes, int n_in, void* d_out, int out_size, void* d_ws, size_t ws_size, hipStream_t stream) {
    static int grid = 0;
    if (grid == 0) {
        if (n_in != 36 || out_size != NTOK * DM || ws_size < WS_END) { fprintf(stderr, "kernel_launch: unexpected shapes n_in %d out %d ws %zu (need %zu)\n", n_in, out_size, ws_size, (size_t)WS_END); grid = -1; return; }
        int dev = 0, cus = 0, per_cu = 0;
        hipGetDevice(&dev);
        hipDeviceGetAttribute(&cus, hipDeviceAttributeMultiprocessorCount, dev);
        hipFuncSetAttribute((const void*)mega, hipFuncAttributeMaxDynamicSharedMemorySize, LDS_BYTES);
        hipOccupancyMaxActiveBlocksPerMultiprocessor(&per_cu, (const void*)mega, NTHR, LDS_BYTES);
        if (per_cu < 1) { fprintf(stderr, "kernel_launch: occupancy query says %d\n", per_cu); per_cu = 1; }
        if (per_cu > MAX_PER_CU) per_cu = MAX_PER_CU;
        grid = cus * per_cu;
        fprintf(stderr, "kernel_launch: grid %d (%d CUs x %d)\n", grid, cus, per_cu);
    }
    if (grid < 0) return;
    hipMemsetAsync((char*)d_ws + OFF_CTL, 0, CTL_BYTES, stream);
    KP p{};
    for (int i = 0; i < 36; ++i) p.in[i] = (const float*)d_in[i];
    p.xbuf = (float*)d_out; p.ws = (unsigned char*)d_ws;
    for (int i = 0; i < 8; ++i) p.inv_freq[i] = (float)pow(500000.0, -(double)i / 8.0);
    p.never = 0; p.pad = 0;
#if ONE_LAUNCH
    p.ph_lo = 0; p.ph_hi = DBG_PH_HI;
    void* args[] = {&p};
    hipError_t e = hipLaunchCooperativeKernel((const void*)mega, dim3(grid), dim3(NTHR), args, LDS_BYTES, stream);
    if (e != hipSuccess) fprintf(stderr, "cooperative launch failed: %s (grid %d)\n", hipGetErrorString(e), grid);
#else
    for (int ph = 0; ph < NPHASE; ++ph) {
        if (!((DBG_MASK >> ph) & 1)) continue;
        p.ph_lo = ph; p.ph_hi = ph + 1;
        hipLaunchKernelGGL(mega, dim3(grid), dim3(NTHR), LDS_BYTES, stream, p);
    }
#if DBG_DUMP
    {
        const unsigned char* w = (const unsigned char*)d_ws; const size_t NO = (size_t)NTOK * 1024;
        size_t off = 0, n = 0; bool f32 = false;
        switch (DBG_DUMP) {
            case 1: off = OFF_C + C_ATT; n = (size_t)NTOK * 512; break;
            case 2: off = OFF_C + C_SGU; n = (size_t)NTOK * 256; break;
            case 3: off = OFF_C + C_S5O; n = (size_t)NTOK * 256; break;
            case 4: off = OFF_M; n = (size_t)NTOK * 1024; break;
            case 5: off = OFF_R + R_Q; n = (size_t)NTOK * 512; break;
            case 6: off = OFF_H; n = (size_t)NTOK * 1024; break;
            case 7: off = OFF_C + C_YG; n = (size_t)NTOK * 256; break;
            case 8: off = OFF_C + C_KCMP; n = (size_t)2 * 524288 / 2; break;
            case 9: off = OFF_R + R_KC; n = (size_t)NTOK * 128 * 6; break;
            case 10: off = OFF_R + R_NG; n = (size_t)NTOK * 24; f32 = true; break;
            case 11: off = OFF_R + R_U; n = (size_t)NTOK * 768; break;
            case 12: off = OFF_C + C_S5E; n = (size_t)128 * 16 * 64 * 2; f32 = true; break;
            case 15: off = 0; n = (size_t)NTOK * 1024; f32 = true; break;
            case 16: off = OFF_W + W_S5A; n = 36864; f32 = true; break;
            case 13: off = OFF_YS; n = (size_t)NTOK * 1024; break;
            case 14: off = OFF_MOE + MOE_WS; n = 65536; f32 = true; break;
            default: break;
        }
        if (DBG_DUMP == 15) hipLaunchKernelGGL(dbg_dump_f32, dim3(2048), dim3(256), 0, stream, (const float*)d_out, n, (float*)d_out, NO);
        else if (f32) hipLaunchKernelGGL(dbg_dump_f32, dim3(2048), dim3(256), 0, stream, (const float*)(w + off), n, (float*)d_out, NO);
        else hipLaunchKernelGGL(dbg_dump, dim3(2048), dim3(256), 0, stream, (const bf16_t*)(w + off), n, (float*)d_out, NO);
    }
#endif
#endif
}
```

```cpp
#include <hip/hip_runtime.h>
#include <hip/hip_cooperative_groups.h>
#include <cstdio>
#include <cstdint>
#include <cmath>
namespace cg = cooperative_groups;

#ifndef ONE_LAUNCH
#define ONE_LAUNCH 1
#endif
#ifndef DBG_MASK
#define DBG_MASK 0x1fffff
#endif
#ifndef DBG_NOCOMBINE
#define DBG_NOCOMBINE 0
#endif
#ifndef DBG_DUMP
#define DBG_DUMP 0
#endif
#ifndef DBG_HASH
#define DBG_HASH 0
#endif
#ifndef DBG_ONLYS5
#define DBG_ONLYS5 0
#endif
#ifndef DBG_NOCSTORE
#define DBG_NOCSTORE 0
#endif
#ifndef DBG_LDSCHK
#define DBG_LDSCHK 0
#endif
#ifndef DBG_TWICE
#define DBG_TWICE 0
#endif
#ifndef DBG_S5CONST
#define DBG_S5CONST 0
#endif
#ifndef DBG_SC1READ
#define DBG_SC1READ 0
#endif
#ifndef DBG_E2
#define DBG_E2 0
#endif
#ifndef DBG_JOBFENCE
#define DBG_JOBFENCE 0
#endif
#ifndef DBG_CONSTOUT
#define DBG_CONSTOUT 0
#endif
#ifndef DBG_QDELAY
#define DBG_QDELAY 0
#endif
#ifndef DBG_SMALLK
#define DBG_SMALLK 0
#endif
#ifndef DBG_REPEAT_PH
#define DBG_REPEAT_PH -1
#endif
#ifndef DBG_TIMEPH
#define DBG_TIMEPH -1
#endif
#ifndef DBG_TIMEPH2
#define DBG_TIMEPH2 (DBG_TIMEPH + 1)
#endif
#ifndef DBG_PRESPIN
#define DBG_PRESPIN 0
#endif
#ifndef DBG_SGUSPIN
#define DBG_SGUSPIN 0
#endif
#ifndef DBG_PREFLUSH
#define DBG_PREFLUSH 0
#endif
#ifndef DBG_ESC1
#define DBG_ESC1 0
#endif
#ifndef DBG_DELAY
#define DBG_DELAY 0
#endif
#ifndef DBG_IDROT
#define DBG_IDROT 0
#endif
#ifndef DBG_DUMP_REV
#define DBG_DUMP_REV 0
#endif
#ifndef DBG_SGUCUT
#define DBG_SGUCUT 0
#endif
#ifndef DBG_EFILT
#define DBG_EFILT 0
#define DBG_EFILT_LO 0
#define DBG_EFILT_HI 0
#endif
#ifndef DBG_DUMP_OFF
#define DBG_DUMP_OFF 0
#define DBG_DUMP_N 0
#define DBG_DUMP_F32 0
#endif
#ifndef DBG_PH_HI
#define DBG_PH_HI NPHASE
#endif

typedef unsigned short bf16_t;
typedef short bf16x8 __attribute__((ext_vector_type(8)));
typedef float f32x4 __attribute__((ext_vector_type(4)));
typedef unsigned u32x4 __attribute__((ext_vector_type(4)));
typedef unsigned u32x2 __attribute__((ext_vector_type(2)));

constexpr int DM = 1024, NB = 8, SEQ = 4096, NTOK = NB * SEQ, DEPTH = 2;
constexpr int NCMP = 255;
constexpr float RMS_EPS = 1e-6f;
constexpr int NTHR = 256;
constexpr int LDS_BAR = 67584;
#ifndef MAX_PER_CU
#define MAX_PER_CU 2
#endif
#ifndef LDS_TOTAL
#define LDS_TOTAL (67584 + 64)
#endif
constexpr int LDS_BYTES = LDS_TOTAL;

constexpr size_t OFF_CTL = 0;
constexpr size_t OFF_W = 65536;
constexpr size_t W_IN = 0, W_GB = 4456448, W_A = 10747904, W_S = 11796480, W_5 = 12320768, W_M = 12845056, W_GLU = 14942208,
                 W_C1 = 15073280, W_C2 = 16121856, W_PB = 16154624, W_SGU = 16155648, W_S5A = 16286720, W_S5A256 = 16294912,
                 W_S5B = 16303104, W_S5C = 16434176, W_RH = 16499712, W_RL = 16630784, W_EG = 16777216, W_EU = 50331648, W_ED = 83886080, W_END = 117440512;
constexpr size_t OFF_H = OFF_W + W_END;
constexpr size_t OFF_M = OFF_H + 67108864;
constexpr size_t OFF_R = OFF_M + 67108864;
constexpr size_t R_Q = 0, R_KC = 33554432, R_VC = 41943040, R_KS = 50331648, R_KW = 58720256, R_VST = 67108864, R_VWT = 75497472,
                 R_NG = 83886080, R_U = 87031808, R_V = 103809024, R_S5IN = 120586240, R_QR = 137363456, R_END = 170917888;
constexpr size_t OFF_C = OFF_R + R_END;
constexpr size_t C_ATT = 0, C_SGU = 33554432, C_YG = 50331648, C_S5O = 67108864, C_KCMP = 83886080, C_VCT = 84410368, C_S5E = 84934656, C_END = 85983232;
constexpr size_t OFF_MOE = OFF_C + C_END;
constexpr size_t MOE_LIST = 0, MOE_WS = 4194304, MOE_END = 4456448;
constexpr size_t WS_END = OFF_MOE + MOE_END;
constexpr size_t OFF_HID = OFF_R;
constexpr size_t OFF_YS = OFF_R + 71303168;
static_assert(OFF_YS + 134217728 <= OFF_C + C_KCMP, "alias overflow");

constexpr int CTL_BAR = 0;
constexpr int CTL_MOECNT = 4096;
constexpr int CTL_ATTN = 4096 + 64;
constexpr int CTL_BYTES = 32768;

struct KP {
    const float* in[36];
    float* xbuf;
    unsigned char* ws;
    float inv_freq[8];
    int ph_lo, ph_hi;
    int never;
    int pad;
};

typedef const KP __attribute__((address_space(4))) CKP;

typedef float f32x2_t __attribute__((ext_vector_type(2)));
typedef __bf16 bf16x2_t __attribute__((ext_vector_type(2)));
__device__ __forceinline__ unsigned pk_bf16(float lo, float hi) {
    const f32x2_t v = {lo, hi};
    union { bf16x2_t b; unsigned u; } x; x.b = __builtin_convertvector(v, bf16x2_t); return x.u;
}
__device__ __forceinline__ bf16_t f2bf(float f) { return (bf16_t)(pk_bf16(f, 0.f) & 0xffffu); }
__device__ __forceinline__ float bf2f(bf16_t b) { return __uint_as_float(((unsigned)b) << 16); }
__device__ __forceinline__ float bflo(unsigned u) { return __uint_as_float(u << 16); }
__device__ __forceinline__ float bfhi(unsigned u) { return __uint_as_float(u & 0xffff0000u); }
__device__ __forceinline__ float fexp2(float x) { return __builtin_amdgcn_exp2f(x); }
__device__ __forceinline__ float gelu_tanh(float x) {
    const float u = 0.7978845608028654f * (x + 0.044715f * x * x * x);
    const float e = fexp2(2.885390081777927f * u);
    const float t = 1.f - 2.f * __builtin_amdgcn_rcpf(e + 1.f);
    return 0.5f * x * (1.f + t);
}
__device__ __forceinline__ float sigm(float x) { return __builtin_amdgcn_rcpf(1.f + fexp2(-1.4426950408889634f * x)); }
__device__ __forceinline__ int opaque_tid() { int t = threadIdx.x; asm volatile("" : "+v"(t)); return t; }
__device__ __forceinline__ void job_fence() {
#if DBG_JOBFENCE
    asm volatile("s_waitcnt vmcnt(0) lgkmcnt(0)" ::: "memory");
    __syncthreads();
#endif
}
__device__ __forceinline__ float wave_sum(float v) {
#pragma unroll
    for (int o = 32; o >= 1; o >>= 1) v += __shfl_xor(v, o);
    return v;
}
__device__ __forceinline__ float xmax16(float x) { const unsigned u = __float_as_uint(x); auto r = __builtin_amdgcn_permlane16_swap(u, u, false, false); return fmaxf(__uint_as_float(r[0]), __uint_as_float(r[1])); }
__device__ __forceinline__ float xmax32(float x) { const unsigned u = __float_as_uint(x); auto r = __builtin_amdgcn_permlane32_swap(u, u, false, false); return fmaxf(__uint_as_float(r[0]), __uint_as_float(r[1])); }
__device__ __forceinline__ float xsum16(float x) { const unsigned u = __float_as_uint(x); auto r = __builtin_amdgcn_permlane16_swap(u, u, false, false); return __uint_as_float(r[0]) + __uint_as_float(r[1]); }
__device__ __forceinline__ float xsum32(float x) { const unsigned u = __float_as_uint(x); auto r = __builtin_amdgcn_permlane32_swap(u, u, false, false); return __uint_as_float(r[0]) + __uint_as_float(r[1]); }
__device__ __forceinline__ f32x4 mfma16(bf16x8 a, bf16x8 b, f32x4 c) { return __builtin_amdgcn_mfma_f32_16x16x32_bf16(a, b, c, 0, 0, 0); }
__device__ __forceinline__ bf16x8 as_bf8(u32x4 v) { union { u32x4 u; bf16x8 b; } x; x.u = v; return x.b; }
__device__ __forceinline__ void store16bf(bf16_t* dst, const float (&v)[16]) {
    u32x4 a, b;
    a.x = pk_bf16(v[0], v[1]); a.y = pk_bf16(v[2], v[3]); a.z = pk_bf16(v[4], v[5]); a.w = pk_bf16(v[6], v[7]);
    b.x = pk_bf16(v[8], v[9]); b.y = pk_bf16(v[10], v[11]); b.z = pk_bf16(v[12], v[13]); b.w = pk_bf16(v[14], v[15]);
    *(u32x4*)dst = a; *(u32x4*)(dst + 8) = b;
}

#ifndef XB_SCOPE
#define XB_SCOPE "agent"
#endif
#define XB_TMO      128
#define XB_XCNT(j)  (256  + 64 * (j))
#define XB_XSUB(j)  (1280 + 64 * (j))
#define XB_XGEN(j)  (2304 + 64 * (j))
#define XB_TOP      3328
#define XB_TOPGEN   3392
#define XCD_BAR_WORDS 3456
#define XB_SPIN_CAP (1u << 22)
#define LAS __attribute__((address_space(3)))
__device__ __forceinline__ unsigned xb_ld(unsigned* p)              { return __hip_atomic_load(p, __ATOMIC_RELAXED, __HIP_MEMORY_SCOPE_AGENT); }
__device__ __forceinline__ unsigned xb_add(unsigned* p, unsigned v) { return __hip_atomic_fetch_add(p, v, __ATOMIC_RELAXED, __HIP_MEMORY_SCOPE_AGENT); }
__device__ __forceinline__ unsigned xb_xcc_id() { return (unsigned)__builtin_amdgcn_s_getreg((3 << 11) | 20) & 0xFu; }
#define XB_SPIN(cond, bar) do { unsigned _sp = 0; while (cond) { __builtin_amdgcn_s_sleep(1); \
    if ((++_sp & 255u) == 0u) { if (xb_ld(&(bar)[XB_TMO])) break; if (_sp > XB_SPIN_CAP) { atomicAdd(&(bar)[XB_TMO], 1u); break; } } } } while (0)
struct XcdBarrier { unsigned* bar; unsigned x; volatile LAS unsigned* st; unsigned nloc, nx; };
__device__ __forceinline__ XcdBarrier xcd_barrier_post(unsigned* bar, volatile LAS unsigned* st) {
    XcdBarrier b; b.bar = bar; b.x = xb_xcc_id(); b.st = st; b.nloc = 0u; b.nx = 0u;
    if (threadIdx.x == 0) (void)xb_add(&bar[XB_XCNT(b.x)], 1u);
    return b;
}
__device__ __forceinline__ void xcd_barrier_complete(unsigned* bar, unsigned x, unsigned& nloc, unsigned& nx) {
    const unsigned G = gridDim.x * gridDim.y * gridDim.z;
    unsigned sum, cnt, mine, sp = 0u;
    for (;;) {
        sum = 0u; cnt = 0u; mine = 0u;
#pragma unroll
        for (unsigned j = 0; j < 16; ++j) { const unsigned c = xb_ld(&bar[XB_XCNT(j)]); sum += c; cnt += (c > 0u) ? 1u : 0u; mine = (j == x) ? c : mine; }
        if (sum == G) break;
        __builtin_amdgcn_s_sleep(1);
        if ((++sp & 255u) == 0u) { if (xb_ld(&bar[XB_TMO])) break; if (sp > XB_SPIN_CAP) { atomicAdd(&bar[XB_TMO], 1u); break; } }
    }
    nloc = mine > 0u ? mine : 1u; nx = cnt > 0u ? cnt : 1u;
}
__device__ __forceinline__ void xcd_barrier(XcdBarrier& b) {
    asm volatile("s_waitcnt vmcnt(0)" ::: "memory");
    __syncthreads();
    if (threadIdx.x == 0) {
        unsigned* bar = b.bar;
        __builtin_amdgcn_s_waitcnt(0);
        unsigned nloc = b.nloc, nx = b.nx;
        if (nloc == 0u) { xcd_barrier_complete(bar, b.x, nloc, nx); b.nloc = nloc; b.nx = nx; }
        const unsigned old = xb_add(&bar[XB_XSUB(b.x)], 1u);
        const unsigned gen = old / nloc;
        if (old + 1u == (gen + 1u) * nloc) {
            __builtin_amdgcn_fence(__ATOMIC_RELEASE, XB_SCOPE);
            asm volatile("s_waitcnt vmcnt(0)" ::: "memory");
            const unsigned og = xb_add(&bar[XB_TOP], 1u);
            const unsigned tg = og / nx;
            if (og + 1u == (tg + 1u) * nx) xb_add(&bar[XB_TOPGEN], 1u);
            else XB_SPIN(xb_ld(&bar[XB_TOPGEN]) == tg, bar);
            __builtin_amdgcn_fence(__ATOMIC_ACQUIRE, XB_SCOPE);
            xb_add(&bar[XB_XGEN(b.x)], 1u);
            asm volatile("s_waitcnt vmcnt(0)" ::: "memory");
        } else {
            XB_SPIN(xb_ld(&bar[XB_XGEN(b.x)]) == gen, bar);
            __builtin_amdgcn_fence(__ATOMIC_ACQUIRE, XB_SCOPE);
            asm volatile("s_waitcnt vmcnt(0)" ::: "memory");
        }
    }
    __syncthreads();
}

__device__ __forceinline__ void tile_coords(int L, int ntm, int ntn, int& tm, int& tn) {
    const int nt = ntm * ntn, q = nt >> 3, r = nt & 7, xcd = L & 7, off = L >> 3;
    const int id = (xcd < r ? xcd * (q + 1) : r * (q + 1) + (xcd - r) * q) + off;
    const int GM = 8, nig = GM * ntn, gid = id / nig, fm = gid * GM, gsz = (ntm - fm) < GM ? (ntm - fm) : GM;
    tm = fm + ((id % nig) % gsz); tn = (id % nig) / gsz;
}

template <class AP, class BP>
__device__ __forceinline__ void gemm_kloop(f32x4 (&acc)[4][4], AP ap, int a_kstep, BP bp, int b_kstep, int nkt, unsigned char* lds, int tid) {
    const int lane = tid & 63, w = tid >> 6, wm = w >> 1, wn = w & 1, fr = lane & 15, fq = lane >> 4;
    const int lr = lane >> 3, lc = (lane & 7) ^ lr;
    const bf16_t* pa[4]; const bf16_t* pb[4];
#pragma unroll
    for (int i = 0; i < 4; ++i) {
        const int row = 8 * (w + 4 * i) + lr;
        pa[i] = ap(row) + lc * 8;
        const int wn_ = row >> 6, ni_ = (row >> 4) & 3, ii = row & 15;
        pb[i] = bp(64 * wn_ + 16 * (ii >> 2) + 4 * ni_ + (ii & 3)) + lc * 8;
    }
    const int ra = (64 * wm + fr) * 128, rb = (64 * wn + fr) * 128;
    const int sw0 = ((fq) ^ (fr & 7)) << 4, sw1 = ((4 + fq) ^ (fr & 7)) << 4;
    auto issue = [&](int buf) {
#pragma unroll
        for (int i = 0; i < 4; ++i) {
            __builtin_amdgcn_global_load_lds((const unsigned*)pa[i], (unsigned*)(lds + buf * 16384 + (w + 4 * i) * 1024), 16, 0, 0);
            __builtin_amdgcn_global_load_lds((const unsigned*)pb[i], (unsigned*)(lds + 32768 + buf * 16384 + (w + 4 * i) * 1024), 16, 0, 0);
            pa[i] += a_kstep; pb[i] += b_kstep;
        }
    };
    auto compute = [&](int buf) {
        const unsigned char* A = lds + buf * 16384;
        const unsigned char* B = lds + 32768 + buf * 16384;
#pragma unroll
        for (int ks = 0; ks < 2; ++ks) {
            const int sw = ks ? sw1 : sw0;
            bf16x8 af[4], bf[4];
#pragma unroll
            for (int mi = 0; mi < 4; ++mi) af[mi] = *(const bf16x8*)(A + ra + mi * 2048 + sw);
#pragma unroll
            for (int ni = 0; ni < 4; ++ni) bf[ni] = *(const bf16x8*)(B + rb + ni * 2048 + sw);
#pragma unroll
            for (int mi = 0; mi < 4; ++mi)
#pragma unroll
                for (int ni = 0; ni < 4; ++ni) acc[mi][ni] = mfma16(bf[ni], af[mi], acc[mi][ni]);
        }
    };
    __syncthreads();
    issue(0);
    asm volatile("s_waitcnt vmcnt(0)" ::: "memory");
    __syncthreads();
#pragma unroll 1
    for (int kt = 0; kt < nkt; ++kt) {
        const int cur = kt & 1;
        if (kt + 1 < nkt) issue(cur ^ 1);
        compute(cur);
        asm volatile("s_waitcnt vmcnt(0)" ::: "memory");
        __syncthreads();
    }
}
__device__ __forceinline__ void zero_acc(f32x4 (&acc)[4][4]) {
#pragma unroll
    for (int i = 0; i < 4; ++i)
#pragma unroll
        for (int j = 0; j < 4; ++j) acc[i][j] = (f32x4){0.f, 0.f, 0.f, 0.f};
}

__device__ __forceinline__ void transpose_tile(const float* src, bf16_t* dst, int R, int C, int mode, int tk, int tn, float* tl, int tid) {
    const int k0 = tk * 64, n0 = tn * 64;
    {
        const int j = tid & 63; const int n = n0 + j;
        int col = n;
        if (mode == 1) col = (n < 1304) ? n : ((n < 1408) ? -1 : n - 104);
        else if (mode == 2) col = n + 2072;
#pragma unroll 4
        for (int pp = 0; pp < 16; ++pp) {
            const int i = (tid >> 6) + 4 * pp;
            tl[i * 65 + j] = (col >= 0) ? src[(size_t)(k0 + i) * C + col] : 0.f;
        }
    }
    __syncthreads();
#pragma unroll
    for (int q2 = 0; q2 < 2; ++q2) {
        const int jj = (tid >> 3) + 32 * q2, cc = tid & 7;
        u32x4 o;
        o.x = pk_bf16(tl[(cc * 8 + 0) * 65 + jj], tl[(cc * 8 + 1) * 65 + jj]);
        o.y = pk_bf16(tl[(cc * 8 + 2) * 65 + jj], tl[(cc * 8 + 3) * 65 + jj]);
        o.z = pk_bf16(tl[(cc * 8 + 4) * 65 + jj], tl[(cc * 8 + 5) * 65 + jj]);
        o.w = pk_bf16(tl[(cc * 8 + 6) * 65 + jj], tl[(cc * 8 + 7) * 65 + jj]);
        *(u32x4*)(dst + (size_t)(n0 + jj) * R + k0 + cc * 8) = o;
    }
    __syncthreads();
}

__device__ __forceinline__ void convert_tiles(CKP& p, int l, int e_lo, int e_hi, int first, int stride, int lane) {
    unsigned char* W = p.ws + OFF_W;
    struct E { const float* src; bf16_t* dst; int R, C, nd, mode, nbatch; };
    const int NE = e_hi;
        for (int L = first;; L += stride) {
            int rem = L; int e = e_lo; E d{};
            for (; e < NE; ++e) {
                switch (e) {
                    case 0: d = {p.in[3] + (size_t)l * 1024 * 5144, (bf16_t*)(W + W_IN), 1024, 5144, 2176, 1, 1}; break;
                    case 1: d = {p.in[3] + (size_t)l * 1024 * 5144, (bf16_t*)(W + W_GB), 1024, 5144, 3072, 2, 1}; break;
                    case 2: d = {p.in[10] + (size_t)l * 512 * 1024, (bf16_t*)(W + W_A), 512, 1024, 1024, 0, 1}; break;
                    case 3: d = {p.in[14] + (size_t)l * 256 * 1024, (bf16_t*)(W + W_S), 256, 1024, 1024, 0, 1}; break;
                    case 4: d = {p.in[25] + (size_t)l * 256 * 1024, (bf16_t*)(W + W_5), 256, 1024, 1024, 0, 1}; break;
                    case 5: d = {p.in[26] + (size_t)l * 1024 * 1024, (bf16_t*)(W + W_M), 1024, 1024, 1024, 0, 1}; break;
                    case 6: d = {p.in[23] + (size_t)l * 256 * 256, (bf16_t*)(W + W_GLU), 256, 256, 256, 0, 1}; break;
                    case 7: d = {p.in[6] + (size_t)l * 2048 * 128, (bf16_t*)(W + W_C1), 2048, 128, 128, 0, 1}; break;
                    case 8: d = {p.in[8] + (size_t)l * 2048 * 128, (bf16_t*)(W + W_C1) + 128 * 2048, 2048, 128, 128, 0, 1}; break;
                    case 9: d = {p.in[7] + (size_t)l * 128 * 64, (bf16_t*)(W + W_C2), 128, 64, 64, 0, 1}; break;
                    case 10: d = {p.in[9] + (size_t)l * 128 * 64, (bf16_t*)(W + W_C2) + 64 * 128, 128, 64, 64, 0, 1}; break;
                    case 11: d = {p.in[32] + (size_t)l * 32 * 1024 * 512, (bf16_t*)(W + W_EG), 1024, 512, 512, 0, 32}; break;
                    case 12: d = {p.in[33] + (size_t)l * 32 * 1024 * 512, (bf16_t*)(W + W_EU), 1024, 512, 512, 0, 32}; break;
                    default: d = {p.in[34] + (size_t)l * 32 * 512 * 1024, (bf16_t*)(W + W_ED), 512, 1024, 1024, 0, 32}; break;
                }
                const int per = (d.R >> 6) * (d.nd >> 6), tot = per * d.nbatch;
                if (rem < tot) break;
                rem -= tot;
            }
            if (e >= NE) break;
            const int per = (d.R >> 6) * (d.nd >> 6), bi = rem / per, t = rem % per, ntn = d.nd >> 6;
            const int k0 = (t / ntn) * 64, n = (t % ntn) * 64 + lane;
            int col = n;
            if (d.mode == 1) col = (n < 1304) ? n : ((n < 1408) ? -1 : n - 104);
            else if (d.mode == 2) col = n + 2072;
            const float* sp = d.src + (size_t)bi * d.R * d.C + (size_t)k0 * d.C + (col >= 0 ? col : 0);
            float v[64];
#pragma unroll
            for (int i = 0; i < 64; ++i) v[i] = sp[(size_t)i * d.C];
            if (col < 0) {
#pragma unroll
                for (int i = 0; i < 64; ++i) v[i] = 0.f;
            }
            bf16_t* dp = d.dst + (size_t)bi * d.R * d.nd + (size_t)n * d.R + k0;
#pragma unroll
            for (int q = 0; q < 8; ++q) {
                u32x4 o;
                o.x = pk_bf16(v[8 * q], v[8 * q + 1]); o.y = pk_bf16(v[8 * q + 2], v[8 * q + 3]);
                o.z = pk_bf16(v[8 * q + 4], v[8 * q + 5]); o.w = pk_bf16(v[8 * q + 6], v[8 * q + 7]);
                *(u32x4*)(dp + 8 * q) = o;
            }
        }
}

__device__ __forceinline__ void phase_prep(CKP& p, int l, unsigned char* lds) {
    const int tid = opaque_tid(), G = gridDim.x, lane = tid & 63, w = tid >> 6;
    unsigned char* W = p.ws + OFF_W;
    if (l < DEPTH) {
        convert_tiles(p, l, 0, 11, blockIdx.x * 4 + w, G * 4, lane);
        const int gt = blockIdx.x * NTHR + tid, gs = G * NTHR;
        {
            const float* sw = p.in[12] + (size_t)l * 4 * 128 * 128; bf16_t* o = (bf16_t*)(W + W_SGU);
            for (int i = gt; i < 65536; i += gs) { const int t = (i >> 7) & 127, s = i & 127; o[i] = f2bf(s <= t ? sw[i] : 0.f); }
        }
        {
            const float* are = p.in[15] + l * 1024; const float* aim = p.in[16] + l * 1024; const float* ls = p.in[17] + l * 16;
            const float* bre = p.in[18] + (size_t)l * 16384; const float* bim = p.in[19] + (size_t)l * 16384;
            float* oa = (float*)(W + W_S5A); float* oa2 = (float*)(W + W_S5A256); float* ob = (float*)(W + W_S5B);
            for (int i = gt; i < 1024; i += gs) {
                const int g = i >> 6;
                const float step = expf(ls[g]), ar = are[i], ai = aim[i];
                const float mag = expf(ar * step); float sn, cs; sincosf(ai * step, &sn, &cs);
                const float abr = mag * cs, abi = mag * sn;
                const float den = ar * ar + ai * ai, nr = abr - 1.f, ni = abi;
                const float cr = (nr * ar + ni * ai) / den, ci = (ni * ar - nr * ai) / den;
                oa[i * 2] = abr; oa[i * 2 + 1] = abi;
                float pr = abr, pi = abi;
                for (int s = 0; s < 8; ++s) { const float nr2 = pr * pr - pi * pi, ni2 = 2.f * pr * pi; pr = nr2; pi = ni2; }
                oa2[i * 2] = pr; oa2[i * 2 + 1] = pi;
                for (int h = 0; h < 16; ++h) {
                    const float br = bre[i * 16 + h], bi_ = bim[i * 16 + h];
                    ob[i * 32 + h] = cr * br - ci * bi_;
                    ob[i * 32 + 16 + h] = cr * bi_ + ci * br;
                }
            }
            const float* cre = p.in[20] + (size_t)l * 16384; const float* cim = p.in[21] + (size_t)l * 16384; bf16_t* oc = (bf16_t*)(W + W_S5C);
            for (int i = gt; i < 32768; i += gs) {
                const int k = i & 127, gh = i >> 7;
                oc[i] = f2bf(k < 64 ? cre[gh * 64 + k] : -cim[gh * 64 + (k - 64)]);
            }
        }
        {
            const float* wg = p.in[28] + (size_t)l * 1024 * 4; const float* we = p.in[30] + (size_t)l * 1024 * 32;
            bf16_t* oh = (bf16_t*)(W + W_RH); bf16_t* ol = (bf16_t*)(W + W_RL);
            for (int i = gt; i < 65536; i += gs) {
                const int n = i >> 10, k = i & 1023;
                const float v = (n < 4) ? wg[k * 4 + n] : ((n < 36) ? we[k * 32 + (n - 4)] : 0.f);
                const bf16_t h = f2bf(v);
                oh[i] = h; ol[i] = f2bf(v - bf2f(h));
            }
        }
        {
            float* pb = (float*)(W + W_PB);
            for (int j = blockIdx.x * 4 + w; j < 256; j += G * 4) {
                const int kv = j >> 7, n = j & 127;
                const float* pos = p.in[kv ? 5 : 4] + (size_t)l * 2048; const float* w1 = p.in[kv ? 8 : 6] + (size_t)l * 2048 * 128;
                float s = 0.f;
                for (int k = lane; k < 2048; k += 64) s += pos[k] * w1[(size_t)k * 128 + n];
                s = wave_sum(s);
                if (lane == 0) pb[j] = s;
            }
        }
    }
    {
        const float* gam = (l < DEPTH) ? (p.in[2] + (size_t)l * 1024) : p.in[35];
        bf16_t* hb = (bf16_t*)(p.ws + OFF_H);
        const bf16_t* ys = (const bf16_t*)(p.ws + OFF_YS);
        f32x4 gv[4];
#pragma unroll
        for (int i = 0; i < 4; ++i) gv[i] = *(const f32x4*)(gam + 4 * lane + 256 * i);
        for (int row = blockIdx.x * 4 + w; row < NTOK; row += G * 4) {
            f32x4 xv[4]; float ss = 0.f;
#pragma unroll
            for (int i = 0; i < 4; ++i) {
                const int col = 4 * lane + 256 * i;
                if (l == 0) xv[i] = *(const f32x4*)(p.in[0] + (size_t)row * 1024 + col);
                else if ((DBG_NOCOMBINE >> l) & 1) xv[i] = *(const f32x4*)(p.xbuf + (size_t)row * 1024 + col);
                else {
                    xv[i] = *(const f32x4*)(p.xbuf + (size_t)row * 1024 + col);
                    const u32x2 y0 = *(const u32x2*)(ys + (size_t)(2 * row) * 1024 + col), y1 = *(const u32x2*)(ys + (size_t)(2 * row + 1) * 1024 + col);
                    xv[i][0] += bflo(y0.x) + bflo(y1.x); xv[i][1] += bfhi(y0.x) + bfhi(y1.x);
                    xv[i][2] += bflo(y0.y) + bflo(y1.y); xv[i][3] += bfhi(y0.y) + bfhi(y1.y);
                }
                ss += xv[i][0] * xv[i][0] + xv[i][1] * xv[i][1] + xv[i][2] * xv[i][2] + xv[i][3] * xv[i][3];
            }
            ss = wave_sum(ss);
            const float rstd = rsqrtf(ss * (1.f / 1024.f) + RMS_EPS);
#pragma unroll
            for (int i = 0; i < 4; ++i) {
                const int col = 4 * lane + 256 * i;
                f32x4 hn = xv[i] * rstd * gv[i];
                if (l < DEPTH) {
                    *(f32x4*)(p.xbuf + (size_t)row * 1024 + col) = xv[i];
                    u32x2 o; o.x = pk_bf16(hn[0], hn[1]); o.y = pk_bf16(hn[2], hn[3]);
                    *(u32x2*)(hb + (size_t)row * 1024 + col) = o;
                } else {
#if DBG_TIMEPH >= 0
                    { const unsigned long long* ts = (const unsigned long long*)(p.ws + OFF_CTL + 24576);
                      const float dt_us = (float)(ts[DBG_TIMEPH2] - ts[DBG_TIMEPH]) * 0.01f; hn = hn * (1.f + 1e-3f * dt_us); }
#endif
                    *(f32x4*)(p.xbuf + (size_t)row * 1024 + col) = hn;
                }
            }
        }
    }
}

__device__ __forceinline__ void phase_inproj(CKP& p, int l, unsigned char* lds) {
    const int tid = opaque_tid(), lane = tid & 63, w = tid >> 6, wm = w >> 1, wn = w & 1, fr = lane & 15, fq = lane >> 4;
    const bf16_t* A = (const bf16_t*)(p.ws + OFF_H);
    const bf16_t* Bt = (const bf16_t*)(p.ws + OFF_W + W_IN);
    unsigned char* R = p.ws + OFF_R;
    const int* pos = (const int*)p.in[1];
    constexpr int NTM = NTOK / 128, NTN = 17;
    for (int L = blockIdx.x; L < NTM * NTN; L += gridDim.x) {
        int tm, tn; tile_coords(L, NTM, NTN, tm, tn);
        const int m0 = tm * 128, n0 = tn * 128;
        f32x4 acc[4][4]; zero_acc(acc);
        gemm_kloop(acc, [&](int r) { return A + (size_t)(m0 + r) * 1024; }, 64, [&](int v) { return Bt + (size_t)(n0 + v) * 1024; }, 64, 16, lds, tid);
#pragma unroll
        for (int mi = 0; mi < 4; ++mi) {
            const int row = m0 + 64 * wm + 16 * mi + fr;
            const int cl = 64 * wn + 16 * fq;
            float v[16];
#pragma unroll
            for (int e = 0; e < 16; ++e) v[e] = acc[mi][e >> 2][e & 3];
            if (tn < 4) {
                store16bf((bf16_t*)(R + R_Q) + (size_t)row * 512 + n0 + cl, v);
                if (fq == 0) {
                    const float ps = (float)pos[row];
#pragma unroll
                    for (int i = 0; i < 8; ++i) {
                        float sn, cs; sincosf(ps * p.inv_freq[i], &sn, &cs);
                        const float x1 = v[i], x2 = v[8 + i];
                        v[i] = x1 * cs - x2 * sn; v[8 + i] = x2 * cs + x1 * sn;
                    }
                }
                store16bf((bf16_t*)(R + R_QR) + (size_t)row * 512 + n0 + cl, v);
            } else if (tn < 10) {
                const int seg = tn - 4;
                if (seg == 2 || seg == 4) {
                    if (fq == 0) {
                        const float ps = (float)pos[row];
#pragma unroll
                        for (int i = 0; i < 8; ++i) {
                            float sn, cs; sincosf(ps * p.inv_freq[i], &sn, &cs);
                            const float x1 = v[i], x2 = v[8 + i];
                            v[i] = x1 * cs - x2 * sn; v[8 + i] = x2 * cs + x1 * sn;
                        }
                    }
                }
                if (seg == 3 || seg == 5) {
                    bf16_t* dst = (bf16_t*)(R + (seg == 3 ? R_VST : R_VWT));
                    const int b = row >> 12, s = row & 4095, g = wn, d0 = 16 * fq;
#pragma unroll
                    for (int e = 0; e < 16; ++e) dst[((size_t)((b * 2 + g) * 64 + d0 + e)) * SEQ + s] = f2bf(v[e]);
                } else {
                    const size_t off = (seg == 0) ? R_KC : (seg == 1) ? R_VC : (seg == 2) ? R_KS : R_KW;
                    store16bf((bf16_t*)(R + off) + (size_t)row * 128 + cl, v);
                }
            } else if (tn == 10) {
                if (cl < 24) {
                    float* ng = (float*)(R + R_NG) + (size_t)row * 24 + cl;
#pragma unroll
                    for (int e = 0; e < 16; ++e) if (cl + e < 24) ng[e] = sigm(v[e]);
                }
            } else if (tn < 15) {
#pragma unroll
                for (int e = 0; e < 16; ++e) v[e] = gelu_tanh(v[e]);
                const int c512 = (tn - 11) * 128 + cl;
                if (c512 < 256) store16bf((bf16_t*)(R + R_U) + (size_t)row * 256 + c512, v);
                else store16bf((bf16_t*)(R + R_V) + (size_t)row * 256 + (c512 - 256), v);
            } else {
                store16bf((bf16_t*)(R + R_S5IN) + (size_t)row * 256 + (tn - 15) * 128 + cl, v);
            }
        }
    }
}

__device__ __forceinline__ void compress_tile(CKP& p, int job, unsigned char* lds) {
    job_fence();
    const int tid = opaque_tid(), lane = tid & 63, w = tid >> 6, wm = w >> 1, wn = w & 1, fr = lane & 15, fq = lane >> 4;
    const int kv = job >> 5, tm = job & 31, m0 = tm * 128;
    unsigned char* W = p.ws + OFF_W;
    const bf16_t* src = (const bf16_t*)(p.ws + OFF_R + (kv ? R_VC : R_KC));
    const bf16_t* W1 = (const bf16_t*)(W + W_C1) + (size_t)kv * 128 * 2048;
    const bf16_t* W2 = (const bf16_t*)(W + W_C2) + (size_t)kv * 64 * 128;
    const float* pb = (const float*)(W + W_PB) + kv * 128;
    f32x4 acc[4][4]; zero_acc(acc);
    gemm_kloop(acc, [&](int r) { int Rr = m0 + r; Rr = Rr < 4080 ? Rr : 4079; const int b = Rr / 510, rem = Rr % 510, c = rem >> 1, g = rem & 1;
                                 return src + ((size_t)(b * SEQ + 16 * c)) * 128 + g * 64; }, 128,
               [&](int v) { return W1 + (size_t)v * 2048; }, 64, 32, lds, tid);
#pragma unroll
    for (int mi = 0; mi < 4; ++mi) {
        const int row = 64 * wm + 16 * mi + fr; const int cb = 16 * fq;
        float v[16];
#pragma unroll
        for (int e = 0; e < 16; ++e) v[e] = gelu_tanh(acc[mi][e >> 2][e & 3] + pb[64 * wn + cb + e]);
        u32x4 a, b;
        a.x = pk_bf16(v[0], v[1]); a.y = pk_bf16(v[2], v[3]); a.z = pk_bf16(v[4], v[5]); a.w = pk_bf16(v[6], v[7]);
        b.x = pk_bf16(v[8], v[9]); b.y = pk_bf16(v[10], v[11]); b.z = pk_bf16(v[12], v[13]); b.w = pk_bf16(v[14], v[15]);
        *(u32x4*)(lds + wn * 16384 + row * 128 + (((2 * fq) ^ (row & 7)) << 4)) = a;
        *(u32x4*)(lds + wn * 16384 + row * 128 + (((2 * fq + 1) ^ (row & 7)) << 4)) = b;
    }
#pragma unroll
    for (int j = 0; j < 4; ++j) {
        const int pid = tid + 256 * j, row = pid >> 4, ch = pid & 15;
        const u32x4 v = *(const u32x4*)(W2 + row * 128 + ch * 8);
        *(u32x4*)(lds + 32768 + (ch >> 3) * 16384 + row * 128 + (((ch & 7) ^ (row & 7)) << 4)) = v;
    }
    __syncthreads();
    f32x4 a2[4][2];
#pragma unroll
    for (int i = 0; i < 4; ++i) { a2[i][0] = (f32x4){0.f, 0.f, 0.f, 0.f}; a2[i][1] = (f32x4){0.f, 0.f, 0.f, 0.f}; }
#pragma unroll
    for (int kt2 = 0; kt2 < 2; ++kt2)
#pragma unroll
        for (int ks = 0; ks < 2; ++ks) {
            bf16x8 af[4], bf[2];
#pragma unroll
            for (int mi = 0; mi < 4; ++mi) { const int row = 64 * wm + 16 * mi + fr; af[mi] = *(const bf16x8*)(lds + kt2 * 16384 + row * 128 + (((4 * ks + fq) ^ (row & 7)) << 4)); }
#pragma unroll
            for (int ni = 0; ni < 2; ++ni) { const int row = 32 * wn + 8 * (fr >> 2) + 4 * ni + (fr & 3); bf[ni] = *(const bf16x8*)(lds + 32768 + kt2 * 16384 + row * 128 + (((4 * ks + fq) ^ (row & 7)) << 4)); }
#pragma unroll
            for (int mi = 0; mi < 4; ++mi)
#pragma unroll
                for (int ni = 0; ni < 2; ++ni) a2[mi][ni] = mfma16(bf[ni], af[mi], a2[mi][ni]);
        }
    bf16_t* kcmp = (bf16_t*)(p.ws + OFF_C + C_KCMP);
    bf16_t* vct = (bf16_t*)(p.ws + OFF_C + C_VCT);
#pragma unroll
    for (int mi = 0; mi < 4; ++mi) {
        const int Rr = m0 + 64 * wm + 16 * mi + fr;
        if (Rr < 4080) {
            const int b = Rr / 510, rem = Rr % 510, c = rem >> 1, g = rem & 1, d0 = 32 * wn + 8 * fq;
            float v[8];
#pragma unroll
            for (int e = 0; e < 8; ++e) v[e] = a2[mi][e >> 2][e & 3];
            if (DBG_NOCSTORE) { if (v[0] == 123.456f) kcmp[0] = 1; }
            else if (kv == 0) {
                u32x4 o; o.x = pk_bf16(v[0], v[1]); o.y = pk_bf16(v[2], v[3]); o.z = pk_bf16(v[4], v[5]); o.w = pk_bf16(v[6], v[7]);
                *(u32x4*)(kcmp + ((size_t)(b * 256 + c)) * 128 + g * 64 + d0) = o;
                if (c == 254) *(u32x4*)(kcmp + ((size_t)(b * 256 + 255)) * 128 + g * 64 + d0) = (u32x4){0u, 0u, 0u, 0u};
            } else {
#pragma unroll
                for (int e = 0; e < 8; ++e) {
                    vct[((size_t)((b * 2 + g) * 64 + d0 + e)) * 256 + c] = f2bf(v[e]);
                    if (c == 254) vct[((size_t)((b * 2 + g) * 64 + d0 + e)) * 256 + 255] = 0;
                }
            }
        }
    }
    __syncthreads();
}

__device__ __forceinline__ void sgu_job(CKP& p, int l, int job, unsigned char* lds) {
    job_fence();
    const int tid = opaque_tid(), lane = tid & 63, w = tid >> 6, fr = lane & 15, fq = lane >> 4;
    const size_t tok0 = (size_t)job * 128;
    const bf16_t* V = (const bf16_t*)(p.ws + OFF_R + R_V) + tok0 * 256;
    const bf16_t* U = (const bf16_t*)(p.ws + OFF_R + R_U) + tok0 * 256;
    bf16_t* O = (bf16_t*)(p.ws + OFF_C + C_SGU) + tok0 * 256;
    const bf16_t* Wt = (const bf16_t*)(p.ws + OFF_W + W_SGU);
    const float* ng = p.in[11] + (size_t)l * 256;
    const float* bs = p.in[13] + (size_t)l * 512;
    __syncthreads();
    if (DBG_SGUCUT != 2) {
        const int s = tid >> 1, half = tid & 1;
        const bf16_t* src = V + (size_t)s * 256 + half * 128;
        float ss = 0.f;
#pragma unroll 4
        for (int j = 0; j < 16; ++j) {
            const u32x4 bb = *(const u32x4*)(src + j * 8);
            const unsigned uu[4] = {bb.x, bb.y, bb.z, bb.w};
#pragma unroll
            for (int q = 0; q < 4; ++q) { const float a = bflo(uu[q]), b2 = bfhi(uu[q]); ss += a * a + b2 * b2; }
        }
        ss += __shfl_xor(ss, 1);
        const float rstd = rsqrtf(ss * (1.f / 256.f) + RMS_EPS);
#pragma unroll 1
        for (int j = 0; j < 16; ++j) {
            const u32x4 bb = *(const u32x4*)(src + j * 8);
            const unsigned uu[4] = {bb.x, bb.y, bb.z, bb.w};
            const int cb = half * 128 + j * 8;
#pragma unroll
            for (int q = 0; q < 4; ++q) {
#pragma unroll
                for (int hh = 0; hh < 2; ++hh) {
                    const int c = cb + q * 2 + hh;
                    const float val = (hh ? bfhi(uu[q]) : bflo(uu[q])) * rstd * ng[c];
                    *(bf16_t*)(lds + c * 256 + ((((s >> 3) ^ (c & 15))) << 4) + (s & 7) * 2) = f2bf(val);
                }
            }
        }
    }
    __syncthreads();
    const int g = w;
#pragma unroll 1
    for (int th = 0; th < (DBG_SGUCUT == 1 ? 0 : 2); ++th) {
        f32x4 acc[4][4];
        zero_acc(acc);
#pragma unroll
        for (int ks = 0; ks < 4; ++ks) {
            if (32 * ks <= 64 * th + 63) {
                bf16x8 vf[4];
#pragma unroll
                for (int di = 0; di < 4; ++di) { const int c = 64 * g + 16 * di + fr; vf[di] = *(const bf16x8*)(lds + c * 256 + (((4 * ks + fq) ^ (c & 15)) << 4)); }
#pragma unroll
                for (int ti = 0; ti < 4; ++ti) {
                    const int t = 64 * th + 16 * ti + fr;
                    if (32 * ks <= 64 * th + 16 * ti + 15) {
                        const bf16x8 wf = *(const bf16x8*)(Wt + ((size_t)(g * 128 + t)) * 128 + 32 * ks + 8 * fq);
#pragma unroll
                        for (int di = 0; di < 4; ++di) acc[ti][di] = mfma16(vf[di], wf, acc[ti][di]);
                    }
                }
            }
        }
#pragma unroll
        for (int ti = 0; ti < 4; ++ti) {
            const int t = 64 * th + 16 * ti + fr; const float bb = bs[g * 128 + t];
#pragma unroll
            for (int di = 0; di < 4; ++di) {
                const int c = 64 * g + 16 * di + 4 * fq;
                const u32x2 uu = *(const u32x2*)(U + (size_t)t * 256 + c);
                u32x2 o;
                o.x = pk_bf16(bflo(uu.x) * (acc[ti][di][0] + bb), bfhi(uu.x) * (acc[ti][di][1] + bb));
                o.y = pk_bf16(bflo(uu.y) * (acc[ti][di][2] + bb), bfhi(uu.y) * (acc[ti][di][3] + bb));
                *(u32x2*)(O + (size_t)t * 256 + c) = o;
            }
        }
    }
    __syncthreads();
}

__device__ __forceinline__ void s5_job(CKP& p, int l, int jb, int pass, unsigned char* lds) {
    job_fence();
    const int tid = opaque_tid(), lane = tid & 63, w = tid >> 6, fr = lane & 15, fq = lane >> 4;
    const int id = ((jb * 4 + w) + DBG_IDROT) & 2047, seq = id >> 4, ch = id & 15, b = seq >> 4, g = seq & 15;
    unsigned char* W = p.ws + OFF_W;
    const float* ab = (const float*)(W + W_S5A) + (g * 64 + lane) * 2;
    float ar = ab[0], ai = ab[1];
    float br[16], bi[16];
    {
        const float* bb = (const float*)(W + W_S5B) + (size_t)(g * 64 + lane) * 32;
#pragma unroll
        for (int h = 0; h < 16; ++h) { br[h] = bb[h]; bi[h] = bb[16 + h]; }
    }
#if DBG_S5CONST >= 2
    { const float q = (float)(lane + 1) * 0.001f; ar = 0.99f - q; ai = 0.05f + q;
      for (int h = 0; h < 16; ++h) { br[h] = 0.01f * (float)(h + 1) + q; bi[h] = -0.02f * (float)(h + 1) + q; } }
#endif
    float* Eb = (float*)(p.ws + OFF_C + C_S5E);
    float hre = 0.f, him = 0.f;
    bf16x8 cf[4]; float dv[4];
    if (pass == 2) {
        const float* a2 = (const float*)(W + W_S5A256) + (g * 64 + lane) * 2;
        const float a2r = a2[0], a2i = a2[1];
        for (int c2 = 0; c2 < ch; ++c2) {
            const float* e = Eb + ((size_t)(seq * 16 + c2) * 64 + lane) * 2;
            const float nr = a2r * hre - a2i * him + e[0], ni = a2r * him + a2i * hre + e[1];
            hre = nr; him = ni;
        }
        const bf16_t* cm = (const bf16_t*)(W + W_S5C) + (size_t)(g * 16 + fr) * 128;
#pragma unroll
        for (int ks = 0; ks < 4; ++ks) cf[ks] = *(const bf16x8*)(cm + 32 * ks + 8 * fq);
#pragma unroll
        for (int r = 0; r < 4; ++r) dv[r] = p.in[22][(size_t)l * 256 + g * 16 + 4 * fq + r];
    }
    const bf16_t* xin = (const bf16_t*)(p.ws + OFF_R + R_S5IN) + ((size_t)(b * SEQ + ch * 256)) * 256 + g * 16;
    bf16_t* yg = (bf16_t*)(p.ws + OFF_C + C_YG) + ((size_t)(b * SEQ + ch * 256)) * 256 + g * 16;
    float* xs = (float*)(lds + w * 10240);
    int ldsbad = 0; (void)ldsbad;
    unsigned char* Hs = lds + w * 10240 + 2048;
#if DBG_TWICE
    float keep_re = 0.f, keep_im = 0.f;
#pragma unroll 1
    for (int rep = 0; rep < 2; ++rep) {
    if (rep == 1) { keep_re = hre; keep_im = him; hre = 0.f; him = 0.f; }
#endif
#pragma unroll 1
    for (int sub = 0; sub < 8; ++sub) {
#if DBG_S5CONST >= 1
        u32x4 xv; { const unsigned q = (unsigned)(sub * 32 + (lane >> 1)) * 2654435761u + (unsigned)id * 40503u + (lane & 1); xv.x = 0x3f803e80u ^ ((q & 0xff) << 16); xv.y = 0x3e003d00u ^ ((q >> 8) & 0x7f); xv.z = 0xbe803f00u ^ ((q >> 16) & 0x3f); xv.w = 0x3d80be00u; }
#else
        const u32x4 xv = *(const u32x4*)(xin + (size_t)(sub * 32 + (lane >> 1)) * 256 + (lane & 1) * 8);
#endif
        __syncthreads();
        f32x4 chk_a = {bflo(xv.x), bfhi(xv.x), bflo(xv.y), bfhi(xv.y)}, chk_c = {bflo(xv.z), bfhi(xv.z), bflo(xv.w), bfhi(xv.w)};
        {
            *(f32x4*)(xs + (lane >> 1) * 16 + (lane & 1) * 8) = chk_a;
            *(f32x4*)(xs + (lane >> 1) * 16 + (lane & 1) * 8 + 4) = chk_c;
        }
        __syncthreads();
#pragma unroll 4
        for (int st = 0; st < 32; ++st) {
#if DBG_S5CONST == 3
            f32x4 x0, x1, x2, x3;
            { const float t = (float)((sub * 32 + st) & 63) * 0.015625f + (float)(id & 7) * 0.125f;
              x0 = (f32x4){t, t * 0.5f, -t, 0.25f}; x1 = (f32x4){0.5f - t, t * t, 0.125f, t}; x2 = (f32x4){-0.25f, t, 0.75f * t, 1.f - t}; x3 = (f32x4){t, -t, 0.5f, 0.3f * t}; }
#else
            const f32x4 x0 = *(const f32x4*)(xs + st * 16), x1 = *(const f32x4*)(xs + st * 16 + 4), x2 = *(const f32x4*)(xs + st * 16 + 8), x3 = *(const f32x4*)(xs + st * 16 + 12);
#endif
            float ur = 0.f, ui = 0.f;
#pragma unroll
            for (int h = 0; h < 4; ++h) {
                ur += br[h] * x0[h]; ui += bi[h] * x0[h];
                ur += br[4 + h] * x1[h]; ui += bi[4 + h] * x1[h];
                ur += br[8 + h] * x2[h]; ui += bi[8 + h] * x2[h];
                ur += br[12 + h] * x3[h]; ui += bi[12 + h] * x3[h];
            }
            const float nr = ar * hre - ai * him + ur, ni = ar * him + ai * hre + ui;
            hre = nr; him = ni;
            if (pass == 2) {
                *(bf16_t*)(Hs + st * 256 + (((lane >> 3) ^ (st & 15)) << 4) + (lane & 7) * 2) = f2bf(hre);
                *(bf16_t*)(Hs + st * 256 + ((((64 + lane) >> 3) ^ (st & 15)) << 4) + (lane & 7) * 2) = f2bf(him);
            }
        }
#if DBG_LDSCHK
        {
            const f32x4 ra = *(volatile f32x4*)(xs + (lane >> 1) * 16 + (lane & 1) * 8), rc = *(volatile f32x4*)(xs + (lane >> 1) * 16 + (lane & 1) * 8 + 4);
            bool bad = false;
            for (int q = 0; q < 4; ++q) bad |= (__float_as_uint(ra[q]) != __float_as_uint(chk_a[q])) | (__float_as_uint(rc[q]) != __float_as_uint(chk_c[q]));
            if (__any(bad)) ldsbad = 1;
        }
#endif
        if (pass == 2) {
            __syncthreads();
#pragma unroll
            for (int tt = 0; tt < 2; ++tt) {
                f32x4 acc = {0.f, 0.f, 0.f, 0.f};
                const int tl = tt * 16 + fr;
#pragma unroll
                for (int ks = 0; ks < 4; ++ks) {
                    const bf16x8 hf = *(const bf16x8*)(Hs + tl * 256 + (((4 * ks + fq) ^ (tl & 15)) << 4));
                    acc = mfma16(cf[ks], hf, acc);
                }
                float y[4];
#pragma unroll
                for (int r = 0; r < 4; ++r) y[r] = gelu_tanh(acc[r] + dv[r] * xs[tl * 16 + 4 * fq + r]);
                u32x2 o; o.x = pk_bf16(y[0], y[1]); o.y = pk_bf16(y[2], y[3]);
                *(u32x2*)(yg + (size_t)(sub * 32 + tl) * 256 + 4 * fq) = o;
            }
        }
    }
#if DBG_TWICE
    }
    if (__float_as_uint(keep_re) != __float_as_uint(hre) || __float_as_uint(keep_im) != __float_as_uint(him)) { hre = __uint_as_float(0x7fc00000u); him = hre; }
#endif
    if (pass == 1) {
        float* e = Eb + ((size_t)(seq * 16 + ch) * 64 + lane) * 2;
#if DBG_LDSCHK
        if (ldsbad) { hre = __uint_as_float(0x7fc00000u); him = hre; }
#endif
#if DBG_ESC1
        { const unsigned long long pk = ((unsigned long long)__float_as_uint(him) << 32) | __float_as_uint(hre);
          __hip_atomic_store((unsigned long long*)e, pk, __ATOMIC_RELAXED, __HIP_MEMORY_SCOPE_AGENT); }
#else
        e[0] = hre; e[1] = him;
#endif
#if DBG_E2
        float* e2 = (float*)(p.ws + OFF_C + C_ATT) + ((size_t)(seq * 16 + ch) * 64 + lane) * 2;
        e2[0] = hre; e2[1] = him;
#endif
    }
    __syncthreads();
}

__device__ __forceinline__ void phase_mid1(CKP& p, int l, unsigned char* lds) {
#if DBG_QDELAY == 2
    if (blockIdx.x >= 320) return;
#elif DBG_QDELAY == 3
    if (blockIdx.x >= 320) {
        const unsigned long long t0 = __builtin_amdgcn_s_memrealtime(); while (__builtin_amdgcn_s_memrealtime() - t0 < 3000ull) __builtin_amdgcn_s_sleep(8);
        s5_job(p, l, blockIdx.x - 320, 1, lds);
        return;
    }
#elif DBG_QDELAY
    if (blockIdx.x >= 320) {
        s5_job(p, l, blockIdx.x - 320, 1, lds);
        const unsigned long long t0 = __builtin_amdgcn_s_memrealtime(); while (__builtin_amdgcn_s_memrealtime() - t0 < 6000ull) __builtin_amdgcn_s_sleep(8);
        return;
    }
#endif
    for (int j = blockIdx.x; j < 64 + 256 + 512; j += gridDim.x) {
#if DBG_ONLYS5 == 1
        if (j >= 320) s5_job(p, l, j - 320, 1, lds);
#elif DBG_ONLYS5 == 2
        if (j < 64) compress_tile(p, j, lds);
        else if (j >= 320) s5_job(p, l, j - 320, 1, lds);
#elif DBG_ONLYS5 == 4
        { const int jj = 831 - j; if (jj < 64) compress_tile(p, jj, lds); else if (jj >= 320) s5_job(p, l, jj - 320, 1, lds); }
#elif DBG_ONLYS5 == 5
        if (j < 64) compress_tile(p, j, lds);
        else if (j >= 320 && j < 512) s5_job(p, l, j - 320, 1, lds);
        else if (j >= 576) s5_job(p, l, j - 320, 1, lds);
        if (j >= 448 && j < 512) s5_job(p, l, j + 64 - 320, 1, lds);
#elif DBG_ONLYS5 == 3
        if (j >= 64 && j < 320) sgu_job(p, l, j - 64, lds);
        else if (j >= 320) s5_job(p, l, j - 320, 1, lds);
#elif DBG_ONLYS5 == 6
        if (j < 512) {
#if DBG_PRESPIN
            { const unsigned long long t0 = __builtin_amdgcn_s_memrealtime(); while (__builtin_amdgcn_s_memrealtime() - t0 < (unsigned long long)DBG_PRESPIN) __builtin_amdgcn_s_sleep(2); }
#endif
            s5_job(p, l, j, 1, lds);
        }
        else if (j < 768) sgu_job(p, l, j - 512, lds);
        else compress_tile(p, j - 768, lds);
#else
        if (j < 64) compress_tile(p, j, lds);
        else if (j < 320) {
#if DBG_SGUSPIN
            { const unsigned long long t0 = __builtin_amdgcn_s_memrealtime(); while (__builtin_amdgcn_s_memrealtime() - t0 < (unsigned long long)DBG_SGUSPIN) __builtin_amdgcn_s_sleep(2); }
#else
            sgu_job(p, l, j - 64, lds);
#endif
        } else {
#if DBG_DELAY
            if (j >= 576) { const unsigned long long t0 = __builtin_amdgcn_s_memrealtime(); while (__builtin_amdgcn_s_memrealtime() - t0 < (unsigned long long)DBG_DELAY) __builtin_amdgcn_s_sleep(8); }
#endif
            s5_job(p, l, j - 320, 1, lds);
        }
#endif
    }    if (blockIdx.x >= 64) {
        const int tid = opaque_tid();
        convert_tiles(p, l, 11, 14, ((int)blockIdx.x - 64) * 4 + (tid >> 6), ((int)gridDim.x - 64) * 4, tid & 63);
    }
}

constexpr int AL_Q = 0, AL_KV = 32768, AL_IMP = 49152, AL_SEL = 65792, AL_UNI = 66304, AL_JOB = 66336;
constexpr float SM_C = 0.125f * 1.4426950408889634f;

__device__ __forceinline__ void attn_load_q(const bf16_t* Qg, const int* pos, const float (&inv_freq)[8], int b, int g, int t0, bool rope, unsigned char* lds, int tid) {
#pragma unroll 1
    for (int j = 0; j < 8; ++j) {
        const int pid = tid + 256 * j, Rr = pid >> 3, ch = pid & 7;
        const int wq = Rr >> 6, r = (Rr >> 4) & 3, q = Rr & 15, t = t0 + 16 * wq + q;
        const bf16_t* src = Qg + ((size_t)(b * SEQ + t)) * 512 + (g * 4 + r) * 64;
        if (!rope || ch >= 2) {
            *(u32x4*)(lds + AL_Q + Rr * 128 + ((ch ^ (Rr & 7)) << 4)) = *(const u32x4*)(src + ch * 8);
        } else if (ch == 0) {
            const u32x4 a = *(const u32x4*)(src), c = *(const u32x4*)(src + 8);
            float x1[8] = {bflo(a.x), bfhi(a.x), bflo(a.y), bfhi(a.y), bflo(a.z), bfhi(a.z), bflo(a.w), bfhi(a.w)};
            float x2[8] = {bflo(c.x), bfhi(c.x), bflo(c.y), bfhi(c.y), bflo(c.z), bfhi(c.z), bflo(c.w), bfhi(c.w)};
            const float ps = (float)pos[b * SEQ + t];
#pragma unroll
            for (int i = 0; i < 8; ++i) {
                float sn, cs; sincosf(ps * inv_freq[i], &sn, &cs);
                const float u = x1[i], v = x2[i];
                x1[i] = u * cs - v * sn; x2[i] = v * cs + u * sn;
            }
            u32x4 o1, o2;
            o1.x = pk_bf16(x1[0], x1[1]); o1.y = pk_bf16(x1[2], x1[3]); o1.z = pk_bf16(x1[4], x1[5]); o1.w = pk_bf16(x1[6], x1[7]);
            o2.x = pk_bf16(x2[0], x2[1]); o2.y = pk_bf16(x2[2], x2[3]); o2.z = pk_bf16(x2[4], x2[5]); o2.w = pk_bf16(x2[6], x2[7]);
            *(u32x4*)(lds + AL_Q + Rr * 128 + ((0 ^ (Rr & 7)) << 4)) = o1;
            *(u32x4*)(lds + AL_Q + Rr * 128 + ((1 ^ (Rr & 7)) << 4)) = o2;
        }
    }
}
__device__ __forceinline__ void attn_ldg(u32x4 (&kk)[2], u32x4 (&vv)[2], const bf16_t* Kb, const bf16_t* Vb, int vstride, int tid) {
#pragma unroll
    for (int j = 0; j < 2; ++j) {
        const int pid = tid + 256 * j, row = pid >> 3, ch = pid & 7;
        kk[j] = *(const u32x4*)(Kb + (size_t)row * 128 + ch * 8);
        vv[j] = *(const u32x4*)(Vb + (size_t)row * vstride + ch * 8);
    }
}
__device__ __forceinline__ void attn_stl(const u32x4 (&kk)[2], const u32x4 (&vv)[2], unsigned char* lds, int kvoff, int tid) {
#pragma unroll
    for (int j = 0; j < 2; ++j) {
        const int pid = tid + 256 * j, row = pid >> 3, ch = pid & 7;
        *(u32x4*)(lds + kvoff + row * 128 + ((ch ^ (row & 7)) << 4)) = kk[j];
        *(u32x4*)(lds + kvoff + 8192 + row * 128 + ((ch ^ ((row >> 1) & 7)) << 4)) = vv[j];
    }
}
__device__ __forceinline__ void attn_qk(f32x4 (&s)[2][4], const unsigned char* lds, int kvoff, int w, int fr, int fq, int hf) {
    const unsigned char* Qw = lds + AL_Q + w * 8192;
    const unsigned char* Kh = lds + kvoff + hf * 4096;
    const int sw0 = ((fq) ^ (fr & 7)) << 4, sw1 = ((4 + fq) ^ (fr & 7)) << 4;
#pragma unroll
    for (int ki = 0; ki < 2; ++ki)
#pragma unroll
        for (int qi = 0; qi < 4; ++qi) s[ki][qi] = (f32x4){0.f, 0.f, 0.f, 0.f};
#pragma unroll
    for (int ds = 0; ds < 2; ++ds) {
        bf16x8 qf[4];
#pragma unroll
        for (int qi = 0; qi < 4; ++qi) qf[qi] = *(const bf16x8*)(Qw + (qi * 16 + fr) * 128 + (ds ? sw1 : sw0));
#pragma unroll
        for (int ki = 0; ki < 2; ++ki) {
            const bf16x8 kf = *(const bf16x8*)(Kh + (ki * 16 + fr) * 128 + (ds ? sw1 : sw0));
#pragma unroll
            for (int qi = 0; qi < 4; ++qi) s[ki][qi] = mfma16(kf, qf[qi], s[ki][qi]);
        }
    }
}
__device__ __forceinline__ void attn_pv(f32x4 (&o)[4][4], const f32x4 (&s)[2][4], const unsigned char* lds, int kvoff, int fr, int fq, int hf) {
    bf16x8 pf[4];
#pragma unroll
    for (int qi = 0; qi < 4; ++qi) {
        u32x4 u;
        u.x = pk_bf16(s[0][qi][0], s[0][qi][1]); u.y = pk_bf16(s[0][qi][2], s[0][qi][3]);
        u.z = pk_bf16(s[1][qi][0], s[1][qi][1]); u.w = pk_bf16(s[1][qi][2], s[1][qi][3]);
        pf[qi] = as_bf8(u);
    }
    const int c0 = 4 * hf + (fq >> 1);
    const unsigned char* Vt = lds + kvoff + 8192;
#pragma unroll
    for (int di = 0; di < 4; ++di) {
        const int row = di * 16 + fr, key = (row >> 1) & 7;
        const u32x2 lo = *(const u32x2*)(Vt + row * 128 + ((c0 ^ key) << 4) + 8 * (fq & 1));
        const u32x2 hi = *(const u32x2*)(Vt + row * 128 + (((c0 + 2) ^ key) << 4) + 8 * (fq & 1));
        const bf16x8 vf = as_bf8((u32x4){lo.x, lo.y, hi.x, hi.y});
#pragma unroll
        for (int qi = 0; qi < 4; ++qi) o[di][qi] = mfma16(vf, pf[qi], o[di][qi]);
    }
}
__device__ __forceinline__ unsigned attn_vmask(int kb, int fq, int lo, int hi) {
    unsigned vm = 0;
#pragma unroll
    for (int ki = 0; ki < 2; ++ki)
#pragma unroll
        for (int r = 0; r < 4; ++r) { const int key = kb + 16 * ki + 4 * fq + r; if (key >= lo && key <= hi) vm |= 1u << (ki * 4 + r); }
    return vm;
}
__device__ __forceinline__ void attn_softmax(f32x4 (&s)[2][4], f32x4 (&o)[4][4], float (&m)[4], float (&lsum)[4], unsigned vm) {
#pragma unroll
    for (int qi = 0; qi < 4; ++qi) {
        float mx = -1e30f;
#pragma unroll
        for (int ki = 0; ki < 2; ++ki)
#pragma unroll
            for (int r = 0; r < 4; ++r) { const float sv = ((vm >> (ki * 4 + r)) & 1u) ? s[ki][qi][r] * SM_C : -1e30f; s[ki][qi][r] = sv; mx = fmaxf(mx, sv); }
        mx = xmax16(mx); mx = xmax32(mx);
        const float mn = fmaxf(m[qi], mx), alpha = fexp2(m[qi] - mn);
        m[qi] = mn;
        float ls = 0.f;
#pragma unroll
        for (int ki = 0; ki < 2; ++ki)
#pragma unroll
            for (int r = 0; r < 4; ++r) { const float pv = ((vm >> (ki * 4 + r)) & 1u) ? fexp2(s[ki][qi][r] - mn) : 0.f; s[ki][qi][r] = pv; ls += pv; }
        lsum[qi] = lsum[qi] * alpha + ls;
        if (__any(alpha != 1.f)) {
#pragma unroll
            for (int di = 0; di < 4; ++di) o[di][qi] *= alpha;
        }
    }
}
__device__ __forceinline__ void attn_softmax_full(f32x4 (&s)[2][4], f32x4 (&o)[4][4], float (&m)[4], float (&lsum)[4], bool lsel) {
#pragma unroll
    for (int qi = 0; qi < 4; ++qi) {
        float mx = fmaxf(fmaxf(fmaxf(s[0][qi][0], s[0][qi][1]), fmaxf(s[0][qi][2], s[0][qi][3])), fmaxf(fmaxf(s[1][qi][0], s[1][qi][1]), fmaxf(s[1][qi][2], s[1][qi][3])));
        mx = xmax16(mx); mx = xmax32(mx);
        const float mn = fmaxf(m[qi], mx * SM_C);
        const float mnew = lsel ? mn : m[qi];
        const float alpha = fexp2(m[qi] - mnew);
        m[qi] = mnew;
        const float neg = lsel ? -mn : -1e30f;
        float ls = 0.f;
#pragma unroll
        for (int ki = 0; ki < 2; ++ki)
#pragma unroll
            for (int r = 0; r < 4; ++r) { const float pv = fexp2(fmaf(s[ki][qi][r], SM_C, neg)); s[ki][qi][r] = pv; ls += pv; }
        lsum[qi] = lsum[qi] * alpha + ls;
        if (__any(alpha != 1.f)) {
#pragma unroll
            for (int di = 0; di < 4; ++di) o[di][qi] *= alpha;
        }
    }
}
__device__ __forceinline__ void attn_accum(bf16_t* dst, const f32x4 (&o)[4][4], const float (&lsum)[4], const float (&gate)[4], bool first, int fq) {
#pragma unroll
    for (int qi = 0; qi < 4; ++qi) {
        float lt = lsum[qi]; lt = xsum16(lt); lt = xsum32(lt);
        const float sc = gate[qi] / fmaxf(lt, 1e-30f);
#pragma unroll
        for (int di = 0; di < 4; ++di) {
            u32x2* ptr = (u32x2*)(dst + qi * 64 + 16 * di + 4 * fq);
            float a0 = o[di][qi][0] * sc, a1 = o[di][qi][1] * sc, a2 = o[di][qi][2] * sc, a3 = o[di][qi][3] * sc;
            if (!first) { const u32x2 f = *ptr; a0 += bflo(f.x); a1 += bfhi(f.x); a2 += bflo(f.y); a3 += bfhi(f.y); }
            u32x2 r; r.x = pk_bf16(a0, a1); r.y = pk_bf16(a2, a3);
            *ptr = r;
        }
    }
}
template <class NextF, class PtrF, class BodyF>
__device__ __forceinline__ void attn_tiles(int first, NextF next, PtrF ptrs, BodyF body, unsigned char* lds, int tid) {
    u32x4 kk[2], vv[2];
    const bf16_t* Kb; const bf16_t* Vb; int vs;
    ptrs(first, Kb, Vb, vs);
    attn_ldg(kk, vv, Kb, Vb, vs, tid);
    int cur = first;
    while (cur >= 0) {
        __syncthreads();
        attn_stl(kk, vv, lds, AL_KV, tid);
        __syncthreads();
        const int nx = next(cur);
        if (nx >= 0) { ptrs(nx, Kb, Vb, vs); attn_ldg(kk, vv, Kb, Vb, vs, tid); }
        body(cur, AL_KV);
        cur = nx;
    }
}

__device__ __forceinline__ void phase_attn(CKP& p, int l, unsigned char* lds, unsigned* ctl) {
    for (int j = blockIdx.x; j < 512; j += gridDim.x) s5_job(p, l, j, 2, lds);

    unsigned char* R = p.ws + OFF_R; unsigned char* C = p.ws + OFF_C;
    const bf16_t* Qg = (const bf16_t*)(R + R_Q);
    const bf16_t* Kc = (const bf16_t*)(C + C_KCMP); const bf16_t* Vc = (const bf16_t*)(C + C_VCT);
    const bf16_t* Ks = (const bf16_t*)(R + R_KS); const bf16_t* Vs = (const bf16_t*)(R + R_VST);
    const bf16_t* Kw = (const bf16_t*)(R + R_KW); const bf16_t* Vw = (const bf16_t*)(R + R_VWT);
    const float* NG = (const float*)(R + R_NG);
    bf16_t* AO = (bf16_t*)(C + C_ATT);
    const int* pos = (const int*)p.in[1];
    unsigned* ctr = ctl + CTL_ATTN + l;
    volatile int* jobp = (volatile int*)(lds + AL_JOB);
    float* imp = (float*)(lds + AL_IMP);
    unsigned long long* selm = (unsigned long long*)(lds + AL_SEL);
    unsigned long long* uni = (unsigned long long*)(lds + AL_UNI);
    float invf[8];
#pragma unroll
    for (int q = 0; q < 8; ++q) invf[q] = p.inv_freq[q];

    for (;;) {
        const int tid = opaque_tid(), lane = tid & 63, w = tid >> 6, fr = lane & 15, fq = lane >> 4;
        __syncthreads();
        if (tid == 0) *jobp = (int)atomicAdd(ctr, 1u);
        __syncthreads();
        const int job = *jobp;
        if (job >= 1024) break;
        const int i = 63 - (job >> 4), bg = job & 15, b = bg >> 1, g = bg & 1, t0 = i * 64;
        const int tq = t0 + 16 * w + fr;
        const size_t kvrow = (size_t)b * SEQ;
        float gate[4];
        bf16_t* dstq = AO + ((size_t)(kvrow + tq)) * 512 + (g * 4) * 64;

        attn_load_q(Qg, pos, invf, b, g, t0, false, lds, tid);
        const int ntc = ((4 * i + 2) >> 6) + 1;
        const int hic = (tq >= 31) ? ((tq - 31) >> 4) : -1;
        float m[4], lsum[4];
#pragma unroll
        for (int qi = 0; qi < 4; ++qi) { m[qi] = -1e30f; lsum[qi] = 0.f; }
        auto cmp_next = [&](int ct) { return (ct + 1 < ntc) ? ct + 1 : -1; };
        auto cmp_ptrs = [&](int ct, const bf16_t*& Kb, const bf16_t*& Vb, int& vs) {
            Kb = Kc + ((size_t)(b * 256 + ct * 64)) * 128 + g * 64; Vb = Vc + ((size_t)((b * 2 + g) * 64)) * 256 + ct * 64; vs = 256; };
        attn_tiles(0, cmp_next, cmp_ptrs, [&](int ct, int kvoff) {
#pragma unroll 1
            for (int hf = 0; hf < 2; ++hf) {
                f32x4 s[2][4];
                attn_qk(s, lds, kvoff, w, fr, fq, hf);
                const unsigned vm = attn_vmask(ct * 64 + hf * 32, fq, 0, hic);
#pragma unroll
                for (int qi = 0; qi < 4; ++qi) {
                    float mx = -1e30f;
#pragma unroll
                    for (int ki = 0; ki < 2; ++ki)
#pragma unroll
                        for (int r = 0; r < 4; ++r) { const float sv = ((vm >> (ki * 4 + r)) & 1u) ? s[ki][qi][r] * SM_C : -1e30f; s[ki][qi][r] = sv; mx = fmaxf(mx, sv); }
                    mx = xmax16(mx); mx = xmax32(mx);
                    const float mn = fmaxf(m[qi], mx), alpha = fexp2(m[qi] - mn);
                    m[qi] = mn;
                    float ls = 0.f;
#pragma unroll
                    for (int ki = 0; ki < 2; ++ki)
#pragma unroll
                        for (int r = 0; r < 4; ++r) ls += ((vm >> (ki * 4 + r)) & 1u) ? fexp2(s[ki][qi][r] - mn) : 0.f;
                    lsum[qi] = lsum[qi] * alpha + ls;
                }
            }
        }, lds, tid);
        float invl[4];
#pragma unroll
        for (int qi = 0; qi < 4; ++qi) { float lt = lsum[qi]; lt = xsum16(lt); lt = xsum32(lt); invl[qi] = 1.f / fmaxf(lt, 1e-30f); }
        {
            f32x4 o[4][4]; zero_acc(o);
            float carry = 0.f;
            attn_tiles(0, cmp_next, cmp_ptrs, [&](int ct, int kvoff) {
#pragma unroll 1
                for (int hf = 0; hf < 2; ++hf) {
                    f32x4 s[2][4];
                    attn_qk(s, lds, kvoff, w, fr, fq, hf);
                    const unsigned vm = attn_vmask(ct * 64 + hf * 32, fq, 0, hic);
#pragma unroll
                    for (int qi = 0; qi < 4; ++qi)
#pragma unroll
                        for (int ki = 0; ki < 2; ++ki)
#pragma unroll
                            for (int r = 0; r < 4; ++r) s[ki][qi][r] = ((vm >> (ki * 4 + r)) & 1u) ? fexp2(s[ki][qi][r] * SM_C - m[qi]) * invl[qi] : 0.f;
#pragma unroll
                    for (int ki = 0; ki < 2; ++ki) {
                        float a = 0.f, bq = 0.f;
#pragma unroll
                        for (int qi = 0; qi < 4; ++qi) { a += s[ki][qi][0] + s[ki][qi][1] + s[ki][qi][2] + 0.5f * s[ki][qi][3]; bq += 0.5f * s[ki][qi][3]; }
                        const float up = __shfl(bq, (lane + 48) & 63);
                        const float wrap = __shfl(carry, (lane + 48) & 63);
                        a += (fq >= 1) ? up : wrap;
                        carry = bq;
                        imp[(16 * w + fr) * 65 + 16 * ct + 8 * hf + 4 * ki + fq] = a;
                    }
                    attn_pv(o, s, lds, kvoff, fr, fq, hf);
                }
            }, lds, tid);
#pragma unroll
            for (int qi = 0; qi < 4; ++qi) gate[qi] = NG[((size_t)(kvrow + tq)) * 24 + (g * 4 + qi) * 3 + 0];
            const float quarter[4] = {0.25f, 0.25f, 0.25f, 0.25f};
            attn_accum(dstq, o, quarter, gate, true, fq);
        }
        __syncthreads();
        {
            const int q = tid >> 2, part = tid & 3;
            unsigned long long mk = 0ull;
            if (i <= 15) { mk = (i == 63) ? ~0ull : ((1ull << (i + 1)) - 1ull); }
            else {
                const float* row = imp + q * 65;
                for (int j = 1 + part; j <= i - 2; j += 4) {
                    const float vj = row[j]; int rank = 0;
                    for (int j2 = 1; j2 <= i - 2; ++j2) { const float v2 = row[j2]; rank += (v2 > vj || (v2 == vj && j2 < j)) ? 1 : 0; }
                    if (rank < 13) mk |= 1ull << j;
                }
                unsigned lo32 = (unsigned)mk, hi32 = (unsigned)(mk >> 32);
                lo32 |= __shfl_xor(lo32, 1); hi32 |= __shfl_xor(hi32, 1);
                lo32 |= __shfl_xor(lo32, 2); hi32 |= __shfl_xor(hi32, 2);
                mk = ((unsigned long long)hi32 << 32) | lo32;
                mk |= 1ull | (1ull << i) | (1ull << (i - 1));
            }
            if (part == 0) selm[q] = mk;
            unsigned lo32 = (unsigned)mk, hi32 = (unsigned)(mk >> 32);
#pragma unroll
            for (int o2 = 32; o2 >= 1; o2 >>= 1) { lo32 |= __shfl_xor(lo32, o2); hi32 |= __shfl_xor(hi32, o2); }
            if (lane == 0) uni[w] = ((unsigned long long)hi32 << 32) | lo32;
        }
        __syncthreads();
        const unsigned long long mymask = selm[16 * w + fr];
        const unsigned long long un = uni[0] | uni[1] | uni[2] | uni[3];
        __syncthreads();
        attn_load_q((const bf16_t*)(R + R_QR), pos, invf, b, g, t0, false, lds, tid);
        {
            f32x4 o[4][4]; zero_acc(o);
#pragma unroll
            for (int qi = 0; qi < 4; ++qi) { m[qi] = -1e30f; lsum[qi] = 0.f; }
            attn_tiles(0,
                [&](int j) { const unsigned long long rest = (j >= 63) ? 0ull : (un >> (j + 1)); return rest ? (j + 1 + (int)__ffsll((long long)rest) - 1) : -1; },
                [&](int j, const bf16_t*& Kb, const bf16_t*& Vb, int& vs) { Kb = Ks + (kvrow + j * 64) * 128 + g * 64; Vb = Vs + ((size_t)((b * 2 + g) * 64)) * SEQ + j * 64; vs = SEQ; },
                [&](int j, int kvoff) {
                    const bool lsel = ((mymask >> j) & 1ull) != 0ull;
                    const int hi = lsel ? tq : -1;
#pragma unroll 1
                    for (int hf = 0; hf < 2; ++hf) {
                        f32x4 s[2][4];
                        attn_qk(s, lds, kvoff, w, fr, fq, hf);
                        if (j < i) attn_softmax_full(s, o, m, lsum, lsel);
                        else { const unsigned vm = attn_vmask(j * 64 + hf * 32, fq, 0, hi); attn_softmax(s, o, m, lsum, vm); }
                        attn_pv(o, s, lds, kvoff, fr, fq, hf);
                    }
                }, lds, tid);
#pragma unroll
            for (int qi = 0; qi < 4; ++qi) gate[qi] = NG[((size_t)(kvrow + tq)) * 24 + (g * 4 + qi) * 3 + 1];
            attn_accum(dstq, o, lsum, gate, false, fq);
        }
        {
            f32x4 o[4][4]; zero_acc(o);
#pragma unroll
            for (int qi = 0; qi < 4; ++qi) { m[qi] = -1e30f; lsum[qi] = 0.f; }
            const int j0 = (i >= 8) ? (i - 8) : 0;
            attn_tiles(j0,
                [&](int j) { return (j + 1 <= i) ? j + 1 : -1; },
                [&](int j, const bf16_t*& Kb, const bf16_t*& Vb, int& vs) { Kb = Kw + (kvrow + j * 64) * 128 + g * 64; Vb = Vw + ((size_t)((b * 2 + g) * 64)) * SEQ + j * 64; vs = SEQ; },
                [&](int j, int kvoff) {
#pragma unroll 1
                    for (int hf = 0; hf < 2; ++hf) {
                        f32x4 s[2][4];
                        attn_qk(s, lds, kvoff, w, fr, fq, hf);
                        if (j >= i - 7 && j < i) attn_softmax_full(s, o, m, lsum, true);
                        else { const unsigned vm = attn_vmask(j * 64 + hf * 32, fq, tq - 511, tq); attn_softmax(s, o, m, lsum, vm); }
                        attn_pv(o, s, lds, kvoff, fr, fq, hf);
                    }
                }, lds, tid);
#pragma unroll
            for (int qi = 0; qi < 4; ++qi) gate[qi] = NG[((size_t)(kvrow + tq)) * 24 + (g * 4 + qi) * 3 + 2];
            attn_accum(dstq, o, lsum, gate, false, fq);
        }
    }
}

__device__ __forceinline__ void phase_glu(CKP& p, int l, unsigned char* lds) {
    const int tid = opaque_tid(), lane = tid & 63, w = tid >> 6, wm = w >> 1, wn = w & 1, fr = lane & 15, fq = lane >> 4;
    const bf16_t* A = (const bf16_t*)(p.ws + OFF_C + C_YG);
    const bf16_t* Bt = (const bf16_t*)(p.ws + OFF_W + W_GLU);
    bf16_t* O = (bf16_t*)(p.ws + OFF_C + C_S5O);
    const float* gb = p.in[24] + (size_t)l * 256;
    constexpr int NTM = NTOK / 128, NTN = 2;
    for (int L = blockIdx.x; L < NTM * NTN; L += gridDim.x) {
        int tm, tn; tile_coords(L, NTM, NTN, tm, tn);
        const int m0 = tm * 128, n0 = tn * 128;
        f32x4 acc[4][4]; zero_acc(acc);
        gemm_kloop(acc, [&](int r) { return A + (size_t)(m0 + r) * 256; }, 64, [&](int v) { return Bt + (size_t)(n0 + v) * 256; }, 64, 4, lds, tid);
#pragma unroll
        for (int mi = 0; mi < 4; ++mi) {
            const int row = m0 + 64 * wm + 16 * mi + fr, col = n0 + 64 * wn + 16 * fq;
            const u32x4 y0 = *(const u32x4*)(A + (size_t)row * 256 + col), y1 = *(const u32x4*)(A + (size_t)row * 256 + col + 8);
            const unsigned yy[8] = {y0.x, y0.y, y0.z, y0.w, y1.x, y1.y, y1.z, y1.w};
            float v[16];
#pragma unroll
            for (int e = 0; e < 16; ++e) {
                const float y = (e & 1) ? bfhi(yy[e >> 1]) : bflo(yy[e >> 1]);
                v[e] = y * sigm(acc[mi][e >> 2][e & 3] + gb[col + e]);
            }
            store16bf(O + (size_t)row * 256 + col, v);
        }
    }
}

__device__ __forceinline__ void phase_branch(CKP& p, int l, unsigned char* lds) {
    const int tid = opaque_tid(), lane = tid & 63, w = tid >> 6, wm = w >> 1, wn = w & 1, fr = lane & 15, fq = lane >> 4;
    const bf16_t* H = (const bf16_t*)(p.ws + OFF_H);
    const bf16_t* Wgb = (const bf16_t*)(p.ws + OFF_W + W_GB);
    bf16_t* Mg = (bf16_t*)(p.ws + OFF_M);
    bf16_t* Yt = (bf16_t*)(p.ws + OFF_R);
    constexpr int NTM = NTOK / 128, NTN = 8;
    for (int L = blockIdx.x; L < NTM * NTN; L += gridDim.x) {
        int tm, tn; tile_coords(L, NTM, NTN, tm, tn);
        const int m0 = tm * 128, n0 = tn * 128;
#pragma unroll 1
        for (int br = 0; br < 3; ++br) {
            const bf16_t* Ab; const bf16_t* Wb; int Kb;
            if (br == 0) { Ab = (const bf16_t*)(p.ws + OFF_C + C_ATT); Wb = (const bf16_t*)(p.ws + OFF_W + W_A); Kb = 512; }
            else if (br == 1) { Ab = (const bf16_t*)(p.ws + OFF_C + C_SGU); Wb = (const bf16_t*)(p.ws + OFF_W + W_S); Kb = 256; }
            else { Ab = (const bf16_t*)(p.ws + OFF_C + C_S5O); Wb = (const bf16_t*)(p.ws + OFF_W + W_5); Kb = 256; }
            {
                f32x4 acc[4][4]; zero_acc(acc);
                gemm_kloop(acc, [&](int r) { return Ab + (size_t)(m0 + r) * Kb; }, 64, [&](int v) { return Wb + (size_t)(n0 + v) * Kb; }, 64, Kb >> 6, lds, tid);
#pragma unroll
                for (int mi = 0; mi < 4; ++mi) {
                    const int row = m0 + 64 * wm + 16 * mi + fr, col = n0 + 64 * wn + 16 * fq;
                    float v[16];
#pragma unroll
                    for (int e = 0; e < 16; ++e) v[e] = acc[mi][e >> 2][e & 3];
                    store16bf(Yt + (size_t)row * 1024 + col, v);
                }
            }
            {
                f32x4 acc[4][4]; zero_acc(acc);
                gemm_kloop(acc, [&](int r) { return H + (size_t)(m0 + r) * 1024; }, 64, [&](int v) { return Wgb + (size_t)(br * 1024 + n0 + v) * 1024; }, 64, 16, lds, tid);
#pragma unroll
                for (int mi = 0; mi < 4; ++mi) {
                    const int row = m0 + 64 * wm + 16 * mi + fr, col = n0 + 64 * wn + 16 * fq;
                    u32x4* dst = (u32x4*)(Mg + (size_t)row * 1024 + col);
                    const u32x4* ysrc = (const u32x4*)(Yt + (size_t)row * 1024 + col);
                    const u32x4 y0 = ysrc[0], y1 = ysrc[1];
                    const unsigned yy[8] = {y0.x, y0.y, y0.z, y0.w, y1.x, y1.y, y1.z, y1.w};
                    unsigned pp[8] = {0u, 0u, 0u, 0u, 0u, 0u, 0u, 0u};
                    if (br > 0) { const u32x4 p0 = dst[0], p1 = dst[1]; pp[0] = p0.x; pp[1] = p0.y; pp[2] = p0.z; pp[3] = p0.w; pp[4] = p1.x; pp[5] = p1.y; pp[6] = p1.z; pp[7] = p1.w; }
                    unsigned outw[8];
#pragma unroll
                    for (int ni = 0; ni < 4; ++ni) {
                        const float a0 = sigm(acc[mi][ni][0]) * bflo(yy[2 * ni]) + bflo(pp[2 * ni]), a1 = sigm(acc[mi][ni][1]) * bfhi(yy[2 * ni]) + bfhi(pp[2 * ni]);
                        const float a2 = sigm(acc[mi][ni][2]) * bflo(yy[2 * ni + 1]) + bflo(pp[2 * ni + 1]), a3 = sigm(acc[mi][ni][3]) * bfhi(yy[2 * ni + 1]) + bfhi(pp[2 * ni + 1]);
                        outw[2 * ni] = pk_bf16(a0, a1); outw[2 * ni + 1] = pk_bf16(a2, a3);
                    }
                    dst[0] = (u32x4){outw[0], outw[1], outw[2], outw[3]};
                    dst[1] = (u32x4){outw[4], outw[5], outw[6], outw[7]};
                }
            }
        }
    }
}

__device__ __forceinline__ void phase_mix(CKP& p, int l, unsigned char* lds) {
    const int tid = opaque_tid(), lane = tid & 63, w = tid >> 6, wm = w >> 1, wn = w & 1, fr = lane & 15, fq = lane >> 4;
    const bf16_t* A = (const bf16_t*)(p.ws + OFF_M);
    const bf16_t* Bt = (const bf16_t*)(p.ws + OFF_W + W_M);
    constexpr int NTM = NTOK / 128, NTN = 8;
    for (int L = blockIdx.x; L < NTM * NTN; L += gridDim.x) {
        int tm, tn; tile_coords(L, NTM, NTN, tm, tn);
        const int m0 = tm * 128, n0 = tn * 128;
        f32x4 acc[4][4]; zero_acc(acc);
        gemm_kloop(acc, [&](int r) { return A + (size_t)(m0 + r) * 1024; }, 64, [&](int v) { return Bt + (size_t)(n0 + v) * 1024; }, 64, 16, lds, tid);
#pragma unroll
        for (int mi = 0; mi < 4; ++mi) {
            const int row = m0 + 64 * wm + 16 * mi + fr, col = n0 + 64 * wn + 16 * fq;
            float* xp = p.xbuf + (size_t)row * 1024 + col;
#pragma unroll
            for (int ni = 0; ni < 4; ++ni) { f32x4 xv = *(f32x4*)(xp + 4 * ni); xv += acc[mi][ni]; *(f32x4*)(xp + 4 * ni) = xv; }
        }
    }
}

__device__ __forceinline__ void phase_router(CKP& p, int l, unsigned char* lds, unsigned* ctl) {
    const int tid = opaque_tid(), lane = tid & 63, w = tid >> 6, wm = w >> 1, wn = w & 1, fr = lane & 15, fq = lane >> 4;
    const float* gam = p.in[27] + (size_t)l * 1024;
    const float* bg = p.in[29] + (size_t)l * 4;
    const float* be = p.in[31] + (size_t)l * 32;
    bf16_t* h2 = (bf16_t*)(p.ws + OFF_M);
    bf16_t* hlo = (bf16_t*)(p.ws + OFF_H);
    const bf16_t* Wh = (const bf16_t*)(p.ws + OFF_W + W_RH);
    const bf16_t* Wl = (const bf16_t*)(p.ws + OFF_W + W_RL);
    unsigned* cnt = ctl + CTL_MOECNT + l * 32;
    int* list = (int*)(p.ws + OFF_MOE + MOE_LIST);
    float* wsl = (float*)(p.ws + OFF_MOE + MOE_WS);
    float* lg = (float*)lds;
    int* lc = (int*)(lds + 18432); int* gbs = (int*)(lds + 18432 + 128);
    for (int tile = blockIdx.x; tile < NTOK / 128; tile += gridDim.x) {
        const int r0 = tile * 128;
        {
            f32x4 gv[4];
#pragma unroll
            for (int i = 0; i < 4; ++i) gv[i] = *(const f32x4*)(gam + 4 * lane + 256 * i);
            for (int rr = 0; rr < 32; rr += 2) {
                const int row = r0 + w * 32 + rr;
                f32x4 xa[4], xb[4]; float sa = 0.f, sb = 0.f;
#pragma unroll
                for (int i = 0; i < 4; ++i) { xa[i] = *(const f32x4*)(p.xbuf + (size_t)row * 1024 + 4 * lane + 256 * i); xb[i] = *(const f32x4*)(p.xbuf + (size_t)(row + 1) * 1024 + 4 * lane + 256 * i); }
#pragma unroll
                for (int i = 0; i < 4; ++i) { sa += xa[i][0] * xa[i][0] + xa[i][1] * xa[i][1] + xa[i][2] * xa[i][2] + xa[i][3] * xa[i][3]; sb += xb[i][0] * xb[i][0] + xb[i][1] * xb[i][1] + xb[i][2] * xb[i][2] + xb[i][3] * xb[i][3]; }
                sa = wave_sum(sa); sb = wave_sum(sb);
                const float ra_ = rsqrtf(sa * (1.f / 1024.f) + RMS_EPS), rb_ = rsqrtf(sb * (1.f / 1024.f) + RMS_EPS);
#pragma unroll
                for (int i = 0; i < 4; ++i) {
                    const f32x4 ha = xa[i] * ra_ * gv[i], hb = xb[i] * rb_ * gv[i];
                    u32x2 oa, ob, la, lb;
                    oa.x = pk_bf16(ha[0], ha[1]); oa.y = pk_bf16(ha[2], ha[3]); ob.x = pk_bf16(hb[0], hb[1]); ob.y = pk_bf16(hb[2], hb[3]);
                    la.x = pk_bf16(ha[0] - bflo(oa.x), ha[1] - bfhi(oa.x)); la.y = pk_bf16(ha[2] - bflo(oa.y), ha[3] - bfhi(oa.y));
                    lb.x = pk_bf16(hb[0] - bflo(ob.x), hb[1] - bfhi(ob.x)); lb.y = pk_bf16(hb[2] - bflo(ob.y), hb[3] - bfhi(ob.y));
                    *(u32x2*)(h2 + (size_t)row * 1024 + 4 * lane + 256 * i) = oa; *(u32x2*)(h2 + (size_t)(row + 1) * 1024 + 4 * lane + 256 * i) = ob;
                    *(u32x2*)(hlo + (size_t)row * 1024 + 4 * lane + 256 * i) = la; *(u32x2*)(hlo + (size_t)(row + 1) * 1024 + 4 * lane + 256 * i) = lb;
                }
            }
        }
        asm volatile("s_waitcnt vmcnt(0)" ::: "memory");
        __syncthreads();
        f32x4 acc[4][4]; zero_acc(acc);
        gemm_kloop(acc, [&](int r) { return h2 + (size_t)(r0 + r) * 1024; }, 64, [&](int v) { return Wh + (size_t)(v < 63 ? v : 63) * 1024; }, 64, 16, lds, tid);
        gemm_kloop(acc, [&](int r) { return h2 + (size_t)(r0 + r) * 1024; }, 64, [&](int v) { return Wl + (size_t)(v < 63 ? v : 63) * 1024; }, 64, 16, lds, tid);
        gemm_kloop(acc, [&](int r) { return hlo + (size_t)(r0 + r) * 1024; }, 64, [&](int v) { return Wh + (size_t)(v < 63 ? v : 63) * 1024; }, 64, 16, lds, tid);
        if (tid < 32) lc[tid] = 0;
        if (wn == 0 && fq < 3) {
#pragma unroll
            for (int mi = 0; mi < 4; ++mi) {
                const int row = 64 * wm + 16 * mi + fr;
#pragma unroll
                for (int e = 0; e < 16; ++e) { const int col = 16 * fq + e; if (col < 36) lg[row * 36 + col] = acc[mi][e >> 2][e & 3]; }
            }
        }
        __syncthreads();
        int e0 = 0, e1 = 0, lr0 = 0, lr1 = 0; float c0 = 0.f, c1 = 0.f;
        if (tid < 128) {
            const float* lrow = lg + tid * 36;
            float gl[4]; int grp = 0; float gm = -3.4e38f;
#pragma unroll
            for (int q = 0; q < 4; ++q) { gl[q] = lrow[q] + bg[q]; if (gl[q] > gm) { gm = gl[q]; grp = q; } }
            float gsum = 0.f;
#pragma unroll
            for (int q = 0; q < 4; ++q) gsum += expf(gl[q] - gm);
            const float grp_w = 1.f / gsum;
            float el[8]; float em = -3.4e38f;
#pragma unroll
            for (int q = 0; q < 8; ++q) { el[q] = lrow[4 + grp * 8 + q] + be[grp * 8 + q]; em = fmaxf(em, el[q]); }
            float esum = 0.f; float ep[8];
#pragma unroll
            for (int q = 0; q < 8; ++q) { ep[q] = expf(el[q] - em); esum += ep[q]; }
            int j0 = 0; float p0 = -1.f;
#pragma unroll
            for (int q = 0; q < 8; ++q) { const float pq = ep[q] / esum; ep[q] = pq; if (pq > p0) { p0 = pq; j0 = q; } }
            int j1 = 0; float p1 = -1.f;
#pragma unroll
            for (int q = 0; q < 8; ++q) { if (q != j0 && ep[q] > p1) { p1 = ep[q]; j1 = q; } }
            const float den = p0 + p1;
            c0 = grp_w * p0 / den; c1 = grp_w * p1 / den;
            e0 = grp * 8 + j0; e1 = grp * 8 + j1;
            lr0 = atomicAdd(&lc[e0], 1); lr1 = atomicAdd(&lc[e1], 1);
        }
        __syncthreads();
        if (tid < 32) { const int n = lc[tid]; gbs[tid] = n ? (int)atomicAdd(&cnt[tid], (unsigned)n) : 0; }
        __syncthreads();
        if (tid < 128) {
            const int tok = r0 + tid;
            list[e0 * 32768 + gbs[e0] + lr0] = tok * 2; list[e1 * 32768 + gbs[e1] + lr1] = tok * 2 + 1;
            wsl[tok * 2] = c0; wsl[tok * 2 + 1] = c1;
        }
        __syncthreads();
    }
}

__device__ __forceinline__ bool moe_tile(const unsigned* cnt, int L, int nsub, int& e, int& mt, int& sub, int& rowbase, int& n) {
    const int lane = threadIdx.x & 63;
    const int c = (lane < 32) ? (int)cnt[lane] : 0;
    const int nt = (c + 127) >> 7;
    int pre = nt;
#pragma unroll
    for (int o = 1; o < 32; o <<= 1) { const int v = __shfl_up(pre, o); if (lane >= o) pre += v; }
    const int excl = pre - nt;
    const bool mine = (lane < 32) && (L >= excl * nsub) && (L < pre * nsub);
    const unsigned long long bal = __ballot(mine);
    if (bal == 0ull) return false;
    e = __ffsll((long long)bal) - 1;
    const int ex = __shfl(excl, e);
    n = __shfl(c, e);
    const int r = L - ex * nsub;
    mt = r / nsub; sub = r % nsub; rowbase = ex * 128;
    return true;
}
__device__ __forceinline__ void phase_exp1(CKP& p, int l, unsigned char* lds, unsigned* ctl) {
    const int tid = opaque_tid(), lane = tid & 63, w = tid >> 6, wm = w >> 1, wn = w & 1, fr = lane & 15, fq = lane >> 4;
    const unsigned* cnt = ctl + CTL_MOECNT + l * 32;
    const int* list = (const int*)(p.ws + OFF_MOE + MOE_LIST);
    const bf16_t* h2 = (const bf16_t*)(p.ws + OFF_M);
    bf16_t* hid = (bf16_t*)(p.ws + OFF_HID);
    for (int L = blockIdx.x;; L += gridDim.x) {
        int e, mt, sub, rowbase, n;
        if (!moe_tile(cnt, L, 8, e, mt, sub, rowbase, n)) break;
        const bf16_t* Wg = (const bf16_t*)(p.ws + OFF_W + W_EG) + (size_t)e * 512 * 1024;
        const bf16_t* Wu = (const bf16_t*)(p.ws + OFF_W + W_EU) + (size_t)e * 512 * 1024;
        const int j0 = sub * 64;
        f32x4 acc[4][4]; zero_acc(acc);
        gemm_kloop(acc, [&](int r) { int s = mt * 128 + r; s = s < n ? s : n - 1; const int slot = list[e * 32768 + s]; return h2 + (size_t)(slot >> 1) * 1024; }, 64,
                   [&](int v) { const int wn_ = v >> 6, fq_ = (v >> 4) & 3, ee = v & 15; const int hc = j0 + 32 * wn_ + 8 * fq_ + (ee & 7);
                                return ((ee >> 3) ? Wu : Wg) + (size_t)hc * 1024; }, 64, 16, lds, tid);
#pragma unroll
        for (int mi = 0; mi < 4; ++mi) {
            const int r = mt * 128 + 64 * wm + 16 * mi + fr;
            if (r < n) {
                float gv[8], uv[8];
#pragma unroll
                for (int e2 = 0; e2 < 8; ++e2) { gv[e2] = acc[mi][e2 >> 2][e2 & 3]; uv[e2] = acc[mi][2 + (e2 >> 2)][e2 & 3]; }
                float hv[8];
#pragma unroll
                for (int e2 = 0; e2 < 8; ++e2) hv[e2] = gv[e2] * sigm(gv[e2]) * uv[e2];
                u32x4 o; o.x = pk_bf16(hv[0], hv[1]); o.y = pk_bf16(hv[2], hv[3]); o.z = pk_bf16(hv[4], hv[5]); o.w = pk_bf16(hv[6], hv[7]);
                *(u32x4*)(hid + (size_t)(rowbase + r) * 512 + j0 + 32 * wn + 8 * fq) = o;
            }
        }
    }
}
__device__ __forceinline__ void phase_exp2(CKP& p, int l, unsigned char* lds, unsigned* ctl) {
    const int tid = opaque_tid(), lane = tid & 63, w = tid >> 6, wm = w >> 1, wn = w & 1, fr = lane & 15, fq = lane >> 4;
    const unsigned* cnt = ctl + CTL_MOECNT + l * 32;
    const int* list = (const int*)(p.ws + OFF_MOE + MOE_LIST);
    const float* wsl = (const float*)(p.ws + OFF_MOE + MOE_WS);
    const bf16_t* hid = (const bf16_t*)(p.ws + OFF_HID);
    bf16_t* ys = (bf16_t*)(p.ws + OFF_YS);
    for (int L = blockIdx.x;; L += gridDim.x) {
        int e, mt, sub, rowbase, n;
        if (!moe_tile(cnt, L, 8, e, mt, sub, rowbase, n)) break;
        const bf16_t* Wd = (const bf16_t*)(p.ws + OFF_W + W_ED) + (size_t)e * 1024 * 512;
        const int n0 = sub * 128;
        f32x4 acc[4][4]; zero_acc(acc);
        gemm_kloop(acc, [&](int r) { int s = mt * 128 + r; s = s < n ? s : n - 1; return hid + (size_t)(rowbase + s) * 512; }, 64,
                   [&](int v) { return Wd + (size_t)(n0 + v) * 512; }, 64, 8, lds, tid);
#pragma unroll
        for (int mi = 0; mi < 4; ++mi) {
            const int r = mt * 128 + 64 * wm + 16 * mi + fr;
            if (r < n) {
                const int slot = list[e * 32768 + r]; const float wt = wsl[slot];
                float v[16];
#pragma unroll
                for (int e2 = 0; e2 < 16; ++e2) v[e2] = acc[mi][e2 >> 2][e2 & 3] * wt;
                store16bf(ys + (size_t)slot * 1024 + n0 + 64 * wn + 16 * fq, v);
            }
        }
    }
}

constexpr int PH_PER_LAYER = 10;
constexpr int NPHASE = PH_PER_LAYER * DEPTH + 1;

__global__ __attribute__((target("no-packed-fp32-ops"))) void __launch_bounds__(NTHR, 2) mega(KP p_unused) {
    extern __shared__ __attribute__((aligned(16))) unsigned char lds[];
    unsigned* ctl = (unsigned*)(p_unused.ws + OFF_CTL);
#if ONE_LAUNCH
    XcdBarrier xb = xcd_barrier_post(ctl + CTL_BAR, (volatile LAS unsigned*)(lds + LDS_BAR));
    if (p_unused.never) cg::this_grid().sync();
#if DBG_PREFLUSH
    __builtin_amdgcn_fence(__ATOMIC_RELEASE, "");
    asm volatile("s_waitcnt vmcnt(0)" ::: "memory");
    __builtin_amdgcn_fence(__ATOMIC_ACQUIRE, "");
    asm volatile("s_waitcnt vmcnt(0)" ::: "memory");
    xcd_barrier(xb);
    { const unsigned long long t0 = __builtin_amdgcn_s_memrealtime(); while (__builtin_amdgcn_s_memrealtime() - t0 < 20000ull) __builtin_amdgcn_s_sleep(8); }
    xcd_barrier(xb);
#endif
#endif
    CKP* kp0 = (CKP*)__builtin_amdgcn_kernarg_segment_ptr();
    const int ph_lo = kp0->ph_lo, ph_hi = kp0->ph_hi;
#if ONE_LAUNCH
#define PH_SYNC(PH) if ((PH) + 1 < ph_hi) xcd_barrier(xb);
#else
#define PH_SYNC(PH)
#endif
#if DBG_TIMEPH >= 0
#define PH_STAMP(PH) if (blockIdx.x == 0 && threadIdx.x == 0) ((unsigned long long*)(kp0->ws + OFF_CTL + 24576))[(PH)] = __builtin_amdgcn_s_memrealtime();
#else
#define PH_STAMP(PH)
#endif
#define RUN_PHASE(PH, CALL) if (ph_lo <= (PH) && (PH) < ph_hi) { PH_STAMP(PH) CKP* kp = kp0; asm volatile("" : "+s"(kp)); CKP& p = *kp; const int rep_ = 0; (void)rep_; CALL; \
    if ((PH) == DBG_REPEAT_PH) { xcd_barrier(xb); const int rep_ = 1; (void)rep_; CALL; } PH_SYNC(PH) }
#define RUN_LAYER(L) \
    RUN_PHASE((L) * 10 + 0, phase_prep(p, (L), lds)) \
    RUN_PHASE((L) * 10 + 1, phase_inproj(p, (L), lds)) \
    RUN_PHASE((L) * 10 + 2, phase_mid1(p, (L), lds)) \
    RUN_PHASE((L) * 10 + 3, phase_attn(p, (L), lds, ctl + 2 * rep_)) \
    RUN_PHASE((L) * 10 + 4, phase_glu(p, (L), lds)) \
    RUN_PHASE((L) * 10 + 5, phase_branch(p, (L), lds)) \
    RUN_PHASE((L) * 10 + 6, phase_mix(p, (L), lds)) \
    RUN_PHASE((L) * 10 + 7, phase_router(p, (L), lds, ctl)) \
    RUN_PHASE((L) * 10 + 8, phase_exp1(p, (L), lds, ctl)) \
    RUN_PHASE((L) * 10 + 9, phase_exp2(p, (L), lds, ctl))
#if DBG_SMALLK
    RUN_PHASE(0, phase_prep(p, 0, lds))
    RUN_PHASE(1, phase_inproj(p, 0, lds))
    RUN_PHASE(2, phase_mid1(p, 0, lds))
#else
    RUN_LAYER(0)
    RUN_LAYER(1)
    RUN_PHASE(20, phase_prep(p, 2, lds))
#endif
#if ONE_LAUNCH && DBG_DUMP
    {
        xcd_barrier(xb);
        CKP* kp = kp0; asm volatile("" : "+s"(kp)); CKP& p = *kp;
        const size_t NO = (size_t)NTOK * 1024;
        const unsigned char* src = p.ws + DBG_DUMP_OFF;
        for (size_t i = (size_t)blockIdx.x * NTHR + threadIdx.x; i < NO; i += (size_t)gridDim.x * NTHR) {
            float v = 0.f;
            if (i < (size_t)DBG_DUMP_N) {
                if (DBG_DUMP_F32) {
                    const size_t si = DBG_DUMP_REV ? ((size_t)DBG_DUMP_N - 1 - i) : i;
#if DBG_SC1READ
                    const unsigned fu = __hip_atomic_load((const unsigned*)src + si, __ATOMIC_RELAXED, __HIP_MEMORY_SCOPE_SYSTEM); const float f = __uint_as_float(fu);
#else
                    const float f = ((const float*)src)[si];
#endif
                    v = DBG_HASH ? (float)(__float_as_uint(f) & 0x3ff) : f;
#if DBG_EFILT
                    { const int id_ = (int)(((si >> 7) - DBG_IDROT) & 2047), blk = ((id_ >> 2) + 320) & 511; if (!(blk >= DBG_EFILT_LO && blk < DBG_EFILT_HI)) v = 0.f; }
#endif
#if DBG_E2
                    { const float f2 = ((const float*)(p.ws + OFF_C + C_ATT))[i]; v = (__float_as_uint(f2) == __float_as_uint(f)) ? 0.f : 1000.f; if (i == 0) v += 1.f; }
#endif
                }
                else { const bf16_t h = ((const bf16_t*)src)[i]; v = DBG_HASH ? (float)(h & 0x3ff) : bf2f(h); }
            }
#if DBG_CONSTOUT
            v = 1000.f + (float)(i & 1023);
#endif
            p.xbuf[i] = v;
        }
    }
#endif
}

#if DBG_DUMP
__global__ void dbg_dump(const bf16_t* src, size_t n, float* out, size_t nout) {
    for (size_t i = (size_t)blockIdx.x * blockDim.x + threadIdx.x; i < nout; i += (size_t)gridDim.x * blockDim.x)
        out[i] = i < n ? (DBG_HASH ? (float)(src[i] & 0x3ff) : bf2f(src[i])) : 0.f;
}
__global__ void dbg_dump_f32(const float* src, size_t n, float* out, size_t nout) {
    for (size_t i = (size_t)blockIdx.x * blockDim.x + threadIdx.x; i < nout; i += (size_t)gridDim.x * blockDim.x)
        out[i] = i < n ? (DBG_HASH ? (float)(__float_as_uint(src[i]) & 0x3ff) : src[i]) : 0.f;
}
#endif
extern "C" void kernel_launch(void* const* d_in, const int* in_sizes, int n_in, void* d_out, int out_size, void* d_ws, size_t ws_size, hipStream_t stream) {
    static int grid = 0;
    if (grid == 0) {
        if (n_in != 36 || out_size != NTOK * DM || ws_size < WS_END) { fprintf(stderr, "kernel_launch: unexpected shapes n_in %d out %d ws %zu (need %zu)\n", n_in, out_size, ws_size, (size_t)WS_END); grid = -1; return; }
        int dev = 0, cus = 0, per_cu = 0;
        hipGetDevice(&dev);
        hipDeviceGetAttribute(&cus, hipDeviceAttributeMultiprocessorCount, dev);
        hipFuncSetAttribute((const void*)mega, hipFuncAttributeMaxDynamicSharedMemorySize, LDS_BYTES);
        hipOccupancyMaxActiveBlocksPerMultiprocessor(&per_cu, (const void*)mega, NTHR, LDS_BYTES);
        if (per_cu < 1) { fprintf(stderr, "kernel_launch: occupancy query says %d\n", per_cu); per_cu = 1; }
        if (per_cu > MAX_PER_CU) per_cu = MAX_PER_CU;
        grid = cus * per_cu;
        fprintf(stderr, "kernel_launch: grid %d (%d CUs x %d)\n", grid, cus, per_cu);
    }
    if (grid < 0) return;
    hipMemsetAsync((char*)d_ws + OFF_CTL, 0, CTL_BYTES, stream);
    KP p{};
    for (int i = 0; i < 36; ++i) p.in[i] = (const float*)d_in[i];
    p.xbuf = (float*)d_out; p.ws = (unsigned char*)d_ws;
    for (int i = 0; i < 8; ++i) p.inv_freq[i] = (float)pow(500000.0, -(double)i / 8.0);
    p.never = 0; p.pad = 0;
#if ONE_LAUNCH
    p.ph_lo = 0; p.ph_hi = DBG_PH_HI;
    void* args[] = {&p};
    hipError_t e = hipLaunchCooperativeKernel((const void*)mega, dim3(grid), dim3(NTHR), args, LDS_BYTES, stream);
    if (e != hipSuccess) fprintf(stderr, "cooperative launch failed: %s (grid %d)\n", hipGetErrorString(e), grid);
#else
    for (int ph = 0; ph < NPHASE; ++ph) {
        if (!((DBG_MASK >> ph) & 1)) continue;
        p.ph_lo = ph; p.ph_hi = ph + 1;
        hipLaunchKernelGGL(mega, dim3(grid), dim3(NTHR), LDS_BYTES, stream, p);
    }
#if DBG_DUMP
    {
        const unsigned char* w = (const unsigned char*)d_ws; const size_t NO = (size_t)NTOK * 1024;
        size_t off = 0, n = 0; bool f32 = false;
        switch (DBG_DUMP) {
            case 1: off = OFF_C + C_ATT; n = (size_t)NTOK * 512; break;
            case 2: off = OFF_C + C_SGU; n = (size_t)NTOK * 256; break;
            case 3: off = OFF_C + C_S5O; n = (size_t)NTOK * 256; break;
            case 4: off = OFF_M; n = (size_t)NTOK * 1024; break;
            case 5: off = OFF_R + R_Q; n = (size_t)NTOK * 512; break;
            case 6: off = OFF_H; n = (size_t)NTOK * 1024; break;
            case 7: off = OFF_C + C_YG; n = (size_t)NTOK * 256; break;
            case 8: off = OFF_C + C_KCMP; n = (size_t)2 * 524288 / 2; break;
            case 9: off = OFF_R + R_KC; n = (size_t)NTOK * 128 * 6; break;
            case 10: off = OFF_R + R_NG; n = (size_t)NTOK * 24; f32 = true; break;
            case 11: off = OFF_R + R_U; n = (size_t)NTOK * 768; break;
            case 12: off = OFF_C + C_S5E; n = (size_t)128 * 16 * 64 * 2; f32 = true; break;
            case 15: off = 0; n = (size_t)NTOK * 1024; f32 = true; break;
            case 16: off = OFF_W + W_S5A; n = 36864; f32 = true; break;
            case 13: off = OFF_YS; n = (size_t)NTOK * 1024; break;
            case 14: off = OFF_MOE + MOE_WS; n = 65536; f32 = true; break;
            default: break;
        }
        if (DBG_DUMP == 15) hipLaunchKernelGGL(dbg_dump_f32, dim3(2048), dim3(256), 0, stream, (const float*)d_out, n, (float*)d_out, NO);
        else if (f32) hipLaunchKernelGGL(dbg_dump_f32, dim3(2048), dim3(256), 0, stream, (const float*)(w + off), n, (float*)d_out, NO);
        else hipLaunchKernelGGL(dbg_dump, dim3(2048), dim3(256), 0, stream, (const bf16_t*)(w + off), n, (float*)d_out, NO);
    }
#endif
#endif
}
```

```cpp
#include <hip/hip_runtime.h>
#include <hip/hip_cooperative_groups.h>
#include <cstdio>
#include <cstdint>
#include <cmath>
namespace cg = cooperative_groups;

#ifndef ONE_LAUNCH
#define ONE_LAUNCH 1
#endif
#ifndef DBG_MASK
#define DBG_MASK 0x1fffff
#endif
#ifndef DBG_NOCOMBINE
#define DBG_NOCOMBINE 0
#endif
#ifndef DBG_DUMP
#define DBG_DUMP 0
#endif
#ifndef DBG_HASH
#define DBG_HASH 0
#endif
#ifndef DBG_ONLYS5
#define DBG_ONLYS5 0
#endif
#ifndef DBG_NOCSTORE
#define DBG_NOCSTORE 0
#endif
#ifndef DBG_LDSCHK
#define DBG_LDSCHK 0
#endif
#ifndef DBG_TWICE
#define DBG_TWICE 0
#endif
#ifndef DBG_S5CONST
#define DBG_S5CONST 0
#endif
#ifndef DBG_SC1READ
#define DBG_SC1READ 0
#endif
#ifndef DBG_E2
#define DBG_E2 0
#endif
#ifndef DBG_JOBFENCE
#define DBG_JOBFENCE 0
#endif
#ifndef DBG_CONSTOUT
#define DBG_CONSTOUT 0
#endif
#ifndef DBG_QDELAY
#define DBG_QDELAY 0
#endif
#ifndef DBG_SMALLK
#define DBG_SMALLK 0
#endif
#ifndef DBG_REPEAT_PH
#define DBG_REPEAT_PH -1
#endif
#ifndef DBG_TIMEPH
#define DBG_TIMEPH -1
#endif
#ifndef DBG_TIMEPH2
#define DBG_TIMEPH2 (DBG_TIMEPH + 1)
#endif
#ifndef DBG_PRESPIN
#define DBG_PRESPIN 0
#endif
#ifndef DBG_SGUSPIN
#define DBG_SGUSPIN 0
#endif
#ifndef DBG_PREFLUSH
#define DBG_PREFLUSH 0
#endif
#ifndef DBG_ESC1
#define DBG_ESC1 0
#endif
#ifndef DBG_DELAY
#define DBG_DELAY 0
#endif
#ifndef DBG_IDROT
#define DBG_IDROT 0
#endif
#ifndef DBG_DUMP_REV
#define DBG_DUMP_REV 0
#endif
#ifndef DBG_SGUCUT
#define DBG_SGUCUT 0
#endif
#ifndef DBG_EFILT
#define DBG_EFILT 0
#define DBG_EFILT_LO 0
#define DBG_EFILT_HI 0
#endif
#ifndef DBG_DUMP_OFF
#define DBG_DUMP_OFF 0
#define DBG_DUMP_N 0
#define DBG_DUMP_F32 0
#endif
#ifndef DBG_PH_HI
#define DBG_PH_HI NPHASE
#endif

typedef unsigned short bf16_t;
typedef short bf16x8 __attribute__((ext_vector_type(8)));
typedef float f32x4 __attribute__((ext_vector_type(4)));
typedef unsigned u32x4 __attribute__((ext_vector_type(4)));
typedef unsigned u32x2 __attribute__((ext_vector_type(2)));

constexpr int DM = 1024, NB = 8, SEQ = 4096, NTOK = NB * SEQ, DEPTH = 2;
constexpr int NCMP = 255;
constexpr float RMS_EPS = 1e-6f;
constexpr int NTHR = 256;
constexpr int NTHR_HW = 512;
constexpr int VB_LDS = 68096;
constexpr int LDS_BAR = 67584;
#ifndef MAX_PER_CU
#define MAX_PER_CU 1
#endif
#ifndef LDS_TOTAL
#define LDS_TOTAL (2 * 68096 + 128)
#endif
constexpr int LDS_BYTES = LDS_TOTAL;

constexpr size_t OFF_CTL = 0;
constexpr size_t OFF_W = 65536;
constexpr size_t W_IN = 0, W_GB = 4456448, W_A = 10747904, W_S = 11796480, W_5 = 12320768, W_M = 12845056, W_GLU = 14942208,
                 W_C1 = 15073280, W_C2 = 16121856, W_PB = 16154624, W_SGU = 16155648, W_S5A = 16286720, W_S5A256 = 16294912,
                 W_S5B = 16303104, W_S5C = 16434176, W_RH = 16499712, W_RL = 16630784, W_EG = 16777216, W_EU = 50331648, W_ED = 83886080, W_END = 117440512;
constexpr size_t OFF_H = OFF_W + W_END;
constexpr size_t OFF_M = OFF_H + 67108864;
constexpr size_t OFF_R = OFF_M + 67108864;
constexpr size_t R_Q = 0, R_KC = 33554432, R_VC = 41943040, R_KS = 50331648, R_KW = 58720256, R_VST = 67108864, R_VWT = 75497472,
                 R_NG = 83886080, R_U = 87031808, R_V = 103809024, R_S5IN = 120586240, R_QR = 137363456, R_END = 170917888;
constexpr size_t OFF_C = OFF_R + R_END;
constexpr size_t C_ATT = 0, C_SGU = 33554432, C_YG = 50331648, C_S5O = 67108864, C_KCMP = 83886080, C_VCT = 84410368, C_S5E = 84934656, C_END = 85983232;
constexpr size_t OFF_MOE = OFF_C + C_END;
constexpr size_t MOE_LIST = 0, MOE_WS = 4194304, MOE_END = 4456448;
constexpr size_t WS_END = OFF_MOE + MOE_END;
constexpr size_t OFF_HID = OFF_R;
constexpr size_t OFF_YS = OFF_R + 71303168;
static_assert(OFF_YS + 134217728 <= OFF_C + C_KCMP, "alias overflow");

constexpr int CTL_BAR = 0;
constexpr int CTL_MOECNT = 4096;
constexpr int CTL_ATTN = 4096 + 64;
constexpr int CTL_BYTES = 32768;

struct KP {
    const float* in[36];
    float* xbuf;
    unsigned char* ws;
    float inv_freq[8];
    int ph_lo, ph_hi;
    int never;
    int pad;
};

typedef const KP __attribute__((address_space(4))) CKP;

typedef float f32x2_t __attribute__((ext_vector_type(2)));
typedef __bf16 bf16x2_t __attribute__((ext_vector_type(2)));
__device__ __forceinline__ unsigned pk_bf16(float lo, float hi) {
    const f32x2_t v = {lo, hi};
    union { bf16x2_t b; unsigned u; } x; x.b = __builtin_convertvector(v, bf16x2_t); return x.u;
}
__device__ __forceinline__ bf16_t f2bf(float f) { return (bf16_t)(pk_bf16(f, 0.f) & 0xffffu); }
__device__ __forceinline__ float bf2f(bf16_t b) { return __uint_as_float(((unsigned)b) << 16); }
__device__ __forceinline__ float bflo(unsigned u) { return __uint_as_float(u << 16); }
__device__ __forceinline__ float bfhi(unsigned u) { return __uint_as_float(u & 0xffff0000u); }
__device__ __forceinline__ float fexp2(float x) { return __builtin_amdgcn_exp2f(x); }
__device__ __forceinline__ float gelu_tanh(float x) {
    const float u = 0.7978845608028654f * (x + 0.044715f * x * x * x);
    const float e = fexp2(2.885390081777927f * u);
    const float t = 1.f - 2.f * __builtin_amdgcn_rcpf(e + 1.f);
    return 0.5f * x * (1.f + t);
}
__device__ __forceinline__ float sigm(float x) { return __builtin_amdgcn_rcpf(1.f + fexp2(-1.4426950408889634f * x)); }
__device__ __forceinline__ int opaque_tid() { int t = threadIdx.x & 255; asm volatile("" : "+v"(t)); return t; }
__device__ __forceinline__ int VBID() { return (int)blockIdx.x * 2 + (int)(threadIdx.x >> 8); }
__device__ __forceinline__ int VGRID() { return (int)gridDim.x * 2; }
constexpr int VB_CTR = 2 * 68096;
__device__ __forceinline__ unsigned char* lds_base() { extern __shared__ __attribute__((aligned(16))) unsigned char lds_all_[]; return lds_all_; }
__device__ __forceinline__ unsigned char* vb_lds() { int t = threadIdx.x; asm volatile("" : "+v"(t)); return lds_base() + (t >> 8) * VB_LDS; }
__device__ __forceinline__ void vb_sync(unsigned char* lds) {
    asm volatile("s_waitcnt lgkmcnt(0)" ::: "memory");
    if ((threadIdx.x & 63) == 0) {
        __attribute__((address_space(3))) unsigned* c = (__attribute__((address_space(3))) unsigned*)(lds_base() + VB_CTR + ((threadIdx.x >> 8) << 6));
        const unsigned old = __hip_atomic_fetch_add(c, 1u, __ATOMIC_RELAXED, __HIP_MEMORY_SCOPE_WORKGROUP);
        const unsigned target = (old & ~3u) + 4u;
        while ((int)(__hip_atomic_load(c, __ATOMIC_RELAXED, __HIP_MEMORY_SCOPE_WORKGROUP) - target) < 0) { }
    }
    asm volatile("" ::: "memory");
}
__device__ __forceinline__ void job_fence() {
#if DBG_JOBFENCE
#endif
}
__device__ __forceinline__ float wave_sum(float v) {
#pragma unroll
    for (int o = 32; o >= 1; o >>= 1) v += __shfl_xor(v, o);
    return v;
}
__device__ __forceinline__ float xmax16(float x) { const unsigned u = __float_as_uint(x); auto r = __builtin_amdgcn_permlane16_swap(u, u, false, false); return fmaxf(__uint_as_float(r[0]), __uint_as_float(r[1])); }
__device__ __forceinline__ float xmax32(float x) { const unsigned u = __float_as_uint(x); auto r = __builtin_amdgcn_permlane32_swap(u, u, false, false); return fmaxf(__uint_as_float(r[0]), __uint_as_float(r[1])); }
__device__ __forceinline__ float xsum16(float x) { const unsigned u = __float_as_uint(x); auto r = __builtin_amdgcn_permlane16_swap(u, u, false, false); return __uint_as_float(r[0]) + __uint_as_float(r[1]); }
__device__ __forceinline__ float xsum32(float x) { const unsigned u = __float_as_uint(x); auto r = __builtin_amdgcn_permlane32_swap(u, u, false, false); return __uint_as_float(r[0]) + __uint_as_float(r[1]); }
__device__ __forceinline__ f32x4 mfma16(bf16x8 a, bf16x8 b, f32x4 c) { return __builtin_amdgcn_mfma_f32_16x16x32_bf16(a, b, c, 0, 0, 0); }
__device__ __forceinline__ bf16x8 as_bf8(u32x4 v) { union { u32x4 u; bf16x8 b; } x; x.u = v; return x.b; }
__device__ __forceinline__ void store16bf(bf16_t* dst, const float (&v)[16]) {
    u32x4 a, b;
    a.x = pk_bf16(v[0], v[1]); a.y = pk_bf16(v[2], v[3]); a.z = pk_bf16(v[4], v[5]); a.w = pk_bf16(v[6], v[7]);
    b.x = pk_bf16(v[8], v[9]); b.y = pk_bf16(v[10], v[11]); b.z = pk_bf16(v[12], v[13]); b.w = pk_bf16(v[14], v[15]);
    *(u32x4*)dst = a; *(u32x4*)(dst + 8) = b;
}

#ifndef XB_SCOPE
#define XB_SCOPE "agent"
#endif
#define XB_TMO      128
#define XB_XCNT(j)  (256  + 64 * (j))
#define XB_XSUB(j)  (1280 + 64 * (j))
#define XB_XGEN(j)  (2304 + 64 * (j))
#define XB_TOP      3328
#define XB_TOPGEN   3392
#define XCD_BAR_WORDS 3456
#define XB_SPIN_CAP (1u << 22)
#define LAS __attribute__((address_space(3)))
__device__ __forceinline__ unsigned xb_ld(unsigned* p)              { return __hip_atomic_load(p, __ATOMIC_RELAXED, __HIP_MEMORY_SCOPE_AGENT); }
__device__ __forceinline__ unsigned xb_add(unsigned* p, unsigned v) { return __hip_atomic_fetch_add(p, v, __ATOMIC_RELAXED, __HIP_MEMORY_SCOPE_AGENT); }
__device__ __forceinline__ unsigned xb_xcc_id() { return (unsigned)__builtin_amdgcn_s_getreg((3 << 11) | 20) & 0xFu; }
#define XB_SPIN(cond, bar) do { unsigned _sp = 0; while (cond) { __builtin_amdgcn_s_sleep(1); \
    if ((++_sp & 255u) == 0u) { if (xb_ld(&(bar)[XB_TMO])) break; if (_sp > XB_SPIN_CAP) { atomicAdd(&(bar)[XB_TMO], 1u); break; } } } } while (0)
struct XcdBarrier { unsigned* bar; unsigned x; volatile LAS unsigned* st; unsigned nloc, nx; };
__device__ __forceinline__ XcdBarrier xcd_barrier_post(unsigned* bar, volatile LAS unsigned* st) {
    XcdBarrier b; b.bar = bar; b.x = xb_xcc_id(); b.st = st; b.nloc = 0u; b.nx = 0u;
    if (threadIdx.x == 0) (void)xb_add(&bar[XB_XCNT(b.x)], 1u);
    return b;
}
__device__ __forceinline__ void xcd_barrier_complete(unsigned* bar, unsigned x, unsigned& nloc, unsigned& nx) {
    const unsigned G = gridDim.x * gridDim.y * gridDim.z;
    unsigned sum, cnt, mine, sp = 0u;
    for (;;) {
        sum = 0u; cnt = 0u; mine = 0u;
#pragma unroll
        for (unsigned j = 0; j < 16; ++j) { const unsigned c = xb_ld(&bar[XB_XCNT(j)]); sum += c; cnt += (c > 0u) ? 1u : 0u; mine = (j == x) ? c : mine; }
        if (sum == G) break;
        __builtin_amdgcn_s_sleep(1);
        if ((++sp & 255u) == 0u) { if (xb_ld(&bar[XB_TMO])) break; if (sp > XB_SPIN_CAP) { atomicAdd(&bar[XB_TMO], 1u); break; } }
    }
    nloc = mine > 0u ? mine : 1u; nx = cnt > 0u ? cnt : 1u;
}
__device__ __forceinline__ void xcd_barrier(XcdBarrier& b) {
    asm volatile("s_waitcnt vmcnt(0)" ::: "memory");
    __syncthreads();
    if (threadIdx.x == 0) {
        unsigned* bar = b.bar;
        __builtin_amdgcn_s_waitcnt(0);
        unsigned nloc = b.nloc, nx = b.nx;
        if (nloc == 0u) { xcd_barrier_complete(bar, b.x, nloc, nx); b.nloc = nloc; b.nx = nx; }
        const unsigned old = xb_add(&bar[XB_XSUB(b.x)], 1u);
        const unsigned gen = old / nloc;
        if (old + 1u == (gen + 1u) * nloc) {
            __builtin_amdgcn_fence(__ATOMIC_RELEASE, XB_SCOPE);
            asm volatile("s_waitcnt vmcnt(0)" ::: "memory");
            const unsigned og = xb_add(&bar[XB_TOP], 1u);
            const unsigned tg = og / nx;
            if (og + 1u == (tg + 1u) * nx) xb_add(&bar[XB_TOPGEN], 1u);
            else XB_SPIN(xb_ld(&bar[XB_TOPGEN]) == tg, bar);
            __builtin_amdgcn_fence(__ATOMIC_ACQUIRE, XB_SCOPE);
            xb_add(&bar[XB_XGEN(b.x)], 1u);
            asm volatile("s_waitcnt vmcnt(0)" ::: "memory");
        } else {
            XB_SPIN(xb_ld(&bar[XB_XGEN(b.x)]) == gen, bar);
            __builtin_amdgcn_fence(__ATOMIC_ACQUIRE, XB_SCOPE);
            asm volatile("s_waitcnt vmcnt(0)" ::: "memory");
        }
    }
    __syncthreads();
}

__device__ __forceinline__ void tile_coords(int L, int ntm, int ntn, int& tm, int& tn) {
    const int nt = ntm * ntn, q = nt >> 3, r = nt & 7, xcd = L & 7, off = L >> 3;
    const int id = (xcd < r ? xcd * (q + 1) : r * (q + 1) + (xcd - r) * q) + off;
    const int GM = 8, nig = GM * ntn, gid = id / nig, fm = gid * GM, gsz = (ntm - fm) < GM ? (ntm - fm) : GM;
    tm = fm + ((id % nig) % gsz); tn = (id % nig) / gsz;
}

template <class AP, class BP>
__device__ __forceinline__ void gemm_kloop(f32x4 (&acc)[4][4], AP ap, int a_kstep, BP bp, int b_kstep, int nkt, unsigned char* lds, int tid) {
    const int lane = tid & 63, w = tid >> 6, wm = w >> 1, wn = w & 1, fr = lane & 15, fq = lane >> 4;
    const int lr = lane >> 3, lc = (lane & 7) ^ lr;
    const bf16_t* pa[4]; const bf16_t* pb[4];
#pragma unroll
    for (int i = 0; i < 4; ++i) {
        const int row = 8 * (w + 4 * i) + lr;
        pa[i] = ap(row) + lc * 8;
        const int wn_ = row >> 6, ni_ = (row >> 4) & 3, ii = row & 15;
        pb[i] = bp(64 * wn_ + 16 * (ii >> 2) + 4 * ni_ + (ii & 3)) + lc * 8;
    }
    const int ra = (64 * wm + fr) * 128, rb = (64 * wn + fr) * 128;
    const int sw0 = ((fq) ^ (fr & 7)) << 4, sw1 = ((4 + fq) ^ (fr & 7)) << 4;
    auto issue = [&](int buf) {
#pragma unroll
        for (int i = 0; i < 4; ++i) {
            __builtin_amdgcn_global_load_lds((const unsigned*)pa[i], (unsigned*)(lds + buf * 16384 + (w + 4 * i) * 1024), 16, 0, 0);
            __builtin_amdgcn_global_load_lds((const unsigned*)pb[i], (unsigned*)(lds + 32768 + buf * 16384 + (w + 4 * i) * 1024), 16, 0, 0);
            pa[i] += a_kstep; pb[i] += b_kstep;
        }
    };
    auto compute = [&](int buf) {
        const unsigned char* A = lds + buf * 16384;
        const unsigned char* B = lds + 32768 + buf * 16384;
#pragma unroll
        for (int ks = 0; ks < 2; ++ks) {
            const int sw = ks ? sw1 : sw0;
            bf16x8 af[4], bf[4];
#pragma unroll
            for (int mi = 0; mi < 4; ++mi) af[mi] = *(const bf16x8*)(A + ra + mi * 2048 + sw);
#pragma unroll
            for (int ni = 0; ni < 4; ++ni) bf[ni] = *(const bf16x8*)(B + rb + ni * 2048 + sw);
#pragma unroll
            for (int mi = 0; mi < 4; ++mi)
#pragma unroll
                for (int ni = 0; ni < 4; ++ni) acc[mi][ni] = mfma16(bf[ni], af[mi], acc[mi][ni]);
        }
    };
    vb_sync(lds);
    issue(0);
    asm volatile("s_waitcnt vmcnt(0)" ::: "memory");
    vb_sync(lds);
#pragma unroll 1
    for (int kt = 0; kt < nkt; ++kt) {
        const int cur = kt & 1;
        if (kt + 1 < nkt) issue(cur ^ 1);
        compute(cur);
        asm volatile("s_waitcnt vmcnt(0)" ::: "memory");
        vb_sync(lds);
    }
}
__device__ __forceinline__ void zero_acc(f32x4 (&acc)[4][4]) {
#pragma unroll
    for (int i = 0; i < 4; ++i)
#pragma unroll
        for (int j = 0; j < 4; ++j) acc[i][j] = (f32x4){0.f, 0.f, 0.f, 0.f};
}

constexpr int G8_HTB = 16384;
__device__ __forceinline__ int g8_lds_byte(int r, int c) { const int st = (r >> 4) * 2 + (c >> 5), rr = r & 15, cc = c & 31, ob = rr * 64 + cc * 2; return st * 1024 + (ob ^ (((ob >> 9) & 1) << 5)); }
__device__ __forceinline__ void g8_stage_rc(int b, int& R, int& C) { const int st = b / 1024, sb = b % 1024, swz = sb ^ (((sb >> 9) & 1) << 5); R = (st >> 1) * 16 + swz / 64; C = (st & 1) * 32 + (swz % 64) / 2; }
__device__ __forceinline__ int g8_perm32(int rho) { const int n = rho >> 4, i = rho & 15; return 8 * (i >> 2) + 4 * n + (i & 3); }
struct G8Unit {
    const char* A0; const char* A1; const char* B0; const char* B1;
    unsigned K2;
    int nt;
    int x0, x1, x2, x3, n;
    unsigned ao[2][2];
};
typedef f32x4 G8Acc[2][2][4][2];
template <class Sched, class Epi>
__device__ __forceinline__ void g8_phase(Sched& S, Epi& E) {
    LAS unsigned char* lds = (LAS unsigned char*)lds_base();
    int tid = threadIdx.x; asm volatile("" : "+v"(tid));
    const int wid = __builtin_amdgcn_readfirstlane(tid >> 6), lane = tid & 63, wr = wid >> 2, wc = wid & 3, fr = lane & 15, fq = lane >> 4;
#define G8_GEOM(R, C2, Rb) int R[2]; unsigned C2[2], Rb[2]; { int _t = threadIdx.x; asm volatile("" : "+v"(_t)); _Pragma("unroll") for (int _i = 0; _i < 2; ++_i) { int _r, _c; g8_stage_rc(_t * 16 + _i * 8192, _r, _c); \
        R[_i] = _r; C2[_i] = (unsigned)_c * 2u; Rb[_i] = (unsigned)((_r & ~31) + g8_perm32(_r & 31)); } }
    const unsigned ldsw = (unsigned)wid * 1024u;
    const int aoff = g8_lds_byte(wr * 64 + fr, fq * 8), boff = g8_lds_byte(wc * 32 + fr, fq * 8);
#define G8_SA(b, h) (((b) * 2 + (h)) * G8_HTB)
#define G8_SB(b, h) ((4 + (b) * 2 + (h)) * G8_HTB)
#define G8_STAGE(bufoff, gbase, voff) do { _Pragma("unroll") for (int _i = 0; _i < 2; ++_i) { unsigned _o = (voff)[_i]; asm volatile("" : "+v"(_o)); \
        __builtin_amdgcn_global_load_lds((const unsigned*)((const char*)(gbase) + _o), (LAS unsigned*)(lds + (bufoff) + ldsw + _i * 8192), 16, 0, 0); } } while (0)
#define G8_BOFF(u, bo) do { _Pragma("unroll") for (int _i = 0; _i < 2; ++_i) bo[_i] = Rb_[_i] * (u).K2 + C2_[_i]; } while (0)
#define G8_LDA(dst, b, h) do { _Pragma("unroll") for (int m = 0; m < 4; ++m) _Pragma("unroll") for (int k = 0; k < 2; ++k) dst[m][k] = *(const LAS bf16x8*)(lds + G8_SA(b, h) + aoff + m * 2048 + k * 1024); } while (0)
#define G8_LDB(dst, b, h) do { _Pragma("unroll") for (int n = 0; n < 2; ++n) _Pragma("unroll") for (int k = 0; k < 2; ++k) dst[n][k] = *(const LAS bf16x8*)(lds + G8_SB(b, h) + boff + n * 2048 + k * 1024); } while (0)
#define G8_MMA(ai, bj, At, Bt) do { __builtin_amdgcn_s_setprio(1); _Pragma("unroll") for (int m = 0; m < 4; ++m) _Pragma("unroll") for (int n = 0; n < 2; ++n) _Pragma("unroll") for (int k = 0; k < 2; ++k) \
        acc[ai][bj][m][n] = __builtin_amdgcn_mfma_f32_16x16x32_bf16(Bt[n][k], At[m][k], acc[ai][bj][m][n], 0, 0, 0); __builtin_amdgcn_s_setprio(0); } while (0)
#define G8_WAIT_V(n) asm volatile("s_waitcnt vmcnt(" #n ")" ::: "memory")
#define G8_WAIT_L(n) asm volatile("s_waitcnt lgkmcnt(" #n ")" ::: "memory")
#define G8_BAR __builtin_amdgcn_s_barrier()
#define G8_SCHED __builtin_amdgcn_sched_barrier(0)
    G8Unit cur, nxt; int ui = 0; unsigned cbo[2], nbo[2];
    { G8_GEOM(R_, C2_, Rb_) if (!S.next(0, cur, R_, C2_)) return; G8_BOFF(cur, cbo); }
    G8Acc acc;
#pragma unroll
    for (int a = 0; a < 2; ++a)
#pragma unroll
        for (int b = 0; b < 2; ++b)
#pragma unroll
            for (int m = 0; m < 4; ++m)
#pragma unroll
                for (int n = 0; n < 2; ++n) acc[a][b][m][n] = (f32x4){0.f, 0.f, 0.f, 0.f};
    bf16x8 At[4][2], B0[2][2], B1[2][2];
    G8_STAGE(G8_SB(0, 0), cur.B0, cbo); G8_STAGE(G8_SA(0, 0), cur.A0, cur.ao[0]); G8_STAGE(G8_SB(0, 1), cur.B1, cbo); G8_STAGE(G8_SA(0, 1), cur.A1, cur.ao[1]);
    if (wr == 1) G8_BAR;
    G8_WAIT_V(4); G8_BAR;
    G8_STAGE(G8_SB(1, 0), cur.B0 + 128, cbo); G8_STAGE(G8_SA(1, 0), cur.A0 + 128, cur.ao[0]); G8_STAGE(G8_SB(1, 1), cur.B1 + 128, cbo);
    G8_WAIT_V(6); G8_BAR;
    for (;;) {
        bool has_next;
        { G8_GEOM(R_, C2_, Rb_) has_next = S.next(ui + 1, nxt, R_, C2_);
          if (!has_next) nxt = cur;
          G8_BOFF(nxt, nbo); }
        const int nt = cur.nt;
#pragma unroll 1
        for (int t = 0; t < nt; t += 2) {
            const bool last = (t == nt - 2);
            const size_t k1 = (size_t)(t + 1) * 128, k2 = (size_t)(t + 2) * 128;
            const char* a2h0 = last ? nxt.A0 : cur.A0 + k2; const char* a2h1 = last ? nxt.A1 : cur.A1 + k2;
            const char* b2h0 = last ? nxt.B0 : cur.B0 + k2; const char* b2h1 = last ? nxt.B1 : cur.B1 + k2;
            unsigned ao0[2], ao1[2], bo2[2];
#pragma unroll
            for (int i = 0; i < 2; ++i) { ao0[i] = last ? nxt.ao[0][i] : cur.ao[0][i]; ao1[i] = last ? nxt.ao[1][i] : cur.ao[1][i]; bo2[i] = last ? nbo[i] : cbo[i]; }
            G8_LDB(B0, 0, 0); G8_SCHED; G8_LDA(At, 0, 0); G8_STAGE(G8_SA(1, 1), cur.A1 + k1, cur.ao[1]);
            G8_WAIT_L(8); G8_BAR; G8_WAIT_L(0); G8_MMA(0, 0, At, B0); G8_BAR; G8_SCHED;
            G8_LDB(B1, 0, 1); G8_STAGE(G8_SB(0, 0), b2h0, bo2);
            G8_BAR; G8_WAIT_L(0); G8_MMA(0, 1, At, B1); G8_BAR;
            G8_LDA(At, 0, 1); G8_STAGE(G8_SA(0, 0), a2h0, ao0);
            G8_BAR; G8_WAIT_L(0); G8_MMA(1, 0, At, B0); G8_BAR; G8_SCHED;
            G8_STAGE(G8_SB(0, 1), b2h1, bo2);
            G8_WAIT_V(6); G8_BAR; G8_MMA(1, 1, At, B1); G8_BAR;
            G8_LDB(B0, 1, 0); G8_SCHED; G8_LDA(At, 1, 0); G8_STAGE(G8_SA(0, 1), a2h1, ao1);
            G8_WAIT_L(8); G8_BAR; G8_WAIT_L(0); G8_MMA(0, 0, At, B0); G8_BAR; G8_SCHED;
            G8_LDB(B1, 1, 1); G8_STAGE(G8_SB(1, 0), b2h0 + 128, bo2);
            G8_BAR; G8_WAIT_L(0); G8_MMA(0, 1, At, B1); G8_BAR;
            G8_LDA(At, 1, 1); G8_STAGE(G8_SA(1, 0), a2h0 + 128, ao0);
            G8_BAR; G8_WAIT_L(0); G8_MMA(1, 0, At, B0); G8_BAR; G8_SCHED;
            G8_STAGE(G8_SB(1, 1), b2h1 + 128, bo2);
            G8_WAIT_V(6); G8_BAR; G8_MMA(1, 1, At, B1); G8_BAR;
        }
        { int t_ = threadIdx.x; asm volatile("" : "+v"(t_)); const int w_ = __builtin_amdgcn_readfirstlane(t_ >> 6); E(acc, cur, w_ >> 2, w_ & 3, t_ & 15, (t_ >> 4) & 3); }
        if (!has_next) break;
#pragma unroll
        for (int a = 0; a < 2; ++a)
#pragma unroll
            for (int b = 0; b < 2; ++b)
#pragma unroll
                for (int m = 0; m < 4; ++m)
#pragma unroll
                    for (int n = 0; n < 2; ++n) acc[a][b][m][n] = (f32x4){0.f, 0.f, 0.f, 0.f};
        cur = nxt; ++ui; cbo[0] = nbo[0]; cbo[1] = nbo[1];
    }
    G8_WAIT_V(0);
    if (wr == 0) G8_BAR;
    G8_BAR;
}
struct G8Plain {
    static constexpr bool GATHER = false;
    const char* A; const char* B; unsigned K2; int nt, nM, nN;
    __device__ __forceinline__ bool next(int i, G8Unit& u, const int (&R)[2], const unsigned (&C2)[2]) const {
        const int L = i * (int)gridDim.x + (int)blockIdx.x; if (L >= nM * nN) return false;
        int pm, pn; tile_coords(L, nM, nN, pm, pn); pm = __builtin_amdgcn_readfirstlane(pm); pn = __builtin_amdgcn_readfirstlane(pn);
        u.A0 = A + (size_t)pm * 256 * K2; u.A1 = u.A0 + (size_t)128 * K2; u.B0 = B + (size_t)pn * 256 * K2; u.B1 = u.B0 + (size_t)128 * K2;
        u.K2 = K2; u.nt = nt; u.x0 = pm; u.x1 = pn; u.x2 = 0; u.x3 = 0;
#pragma unroll
        for (int h = 0; h < 2; ++h)
#pragma unroll
            for (int k = 0; k < 2; ++k) u.ao[h][k] = (unsigned)R[k] * u.K2 + C2[k];
        return true;
    }
};

__device__ __forceinline__ void convert_tiles(CKP& p, int l, int e_lo, int e_hi, int first, int stride, int lane) {
    unsigned char* W = p.ws + OFF_W;
    struct E { const float* src; bf16_t* dst; int R, C, nd, mode, nbatch; };
    const int NE = e_hi;
        for (int L = first;; L += stride) {
            int rem = L; int e = e_lo; E d{};
            for (; e < NE; ++e) {
                switch (e) {
                    case 0: d = {p.in[3] + (size_t)l * 1024 * 5144, (bf16_t*)(W + W_IN), 1024, 5144, 2176, 1, 1}; break;
                    case 1: d = {p.in[3] + (size_t)l * 1024 * 5144, (bf16_t*)(W + W_GB), 1024, 5144, 3072, 2, 1}; break;
                    case 2: d = {p.in[10] + (size_t)l * 512 * 1024, (bf16_t*)(W + W_A), 512, 1024, 1024, 0, 1}; break;
                    case 3: d = {p.in[14] + (size_t)l * 256 * 1024, (bf16_t*)(W + W_S), 256, 1024, 1024, 0, 1}; break;
                    case 4: d = {p.in[25] + (size_t)l * 256 * 1024, (bf16_t*)(W + W_5), 256, 1024, 1024, 0, 1}; break;
                    case 5: d = {p.in[26] + (size_t)l * 1024 * 1024, (bf16_t*)(W + W_M), 1024, 1024, 1024, 0, 1}; break;
                    case 6: d = {p.in[23] + (size_t)l * 256 * 256, (bf16_t*)(W + W_GLU), 256, 256, 256, 0, 1}; break;
                    case 7: d = {p.in[6] + (size_t)l * 2048 * 128, (bf16_t*)(W + W_C1), 2048, 128, 128, 0, 1}; break;
                    case 8: d = {p.in[8] + (size_t)l * 2048 * 128, (bf16_t*)(W + W_C1) + 128 * 2048, 2048, 128, 128, 0, 1}; break;
                    case 9: d = {p.in[7] + (size_t)l * 128 * 64, (bf16_t*)(W + W_C2), 128, 64, 64, 0, 1}; break;
                    case 10: d = {p.in[9] + (size_t)l * 128 * 64, (bf16_t*)(W + W_C2) + 64 * 128, 128, 64, 64, 0, 1}; break;
                    case 11: d = {p.in[32] + (size_t)l * 32 * 1024 * 512, (bf16_t*)(W + W_EG), 1024, 512, 512, 0, 32}; break;
                    case 12: d = {p.in[33] + (size_t)l * 32 * 1024 * 512, (bf16_t*)(W + W_EU), 1024, 512, 512, 0, 32}; break;
                    default: d = {p.in[34] + (size_t)l * 32 * 512 * 1024, (bf16_t*)(W + W_ED), 512, 1024, 1024, 0, 32}; break;
                }
                const int per = (d.R >> 6) * (d.nd >> 6), tot = per * d.nbatch;
                if (rem < tot) break;
                rem -= tot;
            }
            if (e >= NE) break;
            const int per = (d.R >> 6) * (d.nd >> 6), bi = rem / per, t = rem % per, ntn = d.nd >> 6;
            const int k0 = (t / ntn) * 64, n = (t % ntn) * 64 + lane;
            int col = n;
            if (d.mode == 1) col = (n < 1304) ? n : ((n < 1408) ? -1 : n - 104);
            else if (d.mode == 2) col = n + 2072;
            const float* sp = d.src + (size_t)bi * d.R * d.C + (size_t)k0 * d.C + (col >= 0 ? col : 0);
            float v[64];
#pragma unroll
            for (int i = 0; i < 64; ++i) v[i] = sp[(size_t)i * d.C];
            if (col < 0) {
#pragma unroll
                for (int i = 0; i < 64; ++i) v[i] = 0.f;
            }
            bf16_t* dp = d.dst + (size_t)bi * d.R * d.nd + (size_t)n * d.R + k0;
#pragma unroll
            for (int q = 0; q < 8; ++q) {
                u32x4 o;
                o.x = pk_bf16(v[8 * q], v[8 * q + 1]); o.y = pk_bf16(v[8 * q + 2], v[8 * q + 3]);
                o.z = pk_bf16(v[8 * q + 4], v[8 * q + 5]); o.w = pk_bf16(v[8 * q + 6], v[8 * q + 7]);
                *(u32x4*)(dp + 8 * q) = o;
            }
        }
}

__device__ __forceinline__ void phase_prep(CKP& p, int l, unsigned char* lds) {
    const int tid = opaque_tid(), G = VGRID(), lane = tid & 63, w = tid >> 6;
    unsigned char* W = p.ws + OFF_W;
    if (l < DEPTH) {
        convert_tiles(p, l, 0, 11, VBID() * 4 + w, G * 4, lane);
        const int gt = VBID() * NTHR + tid, gs = G * NTHR;
        {
            const float* sw = p.in[12] + (size_t)l * 4 * 128 * 128; bf16_t* o = (bf16_t*)(W + W_SGU);
            for (int i = gt; i < 65536; i += gs) { const int t = (i >> 7) & 127, s = i & 127; o[i] = f2bf(s <= t ? sw[i] : 0.f); }
        }
        {
            const float* are = p.in[15] + l * 1024; const float* aim = p.in[16] + l * 1024; const float* ls = p.in[17] + l * 16;
            const float* bre = p.in[18] + (size_t)l * 16384; const float* bim = p.in[19] + (size_t)l * 16384;
            float* oa = (float*)(W + W_S5A); float* oa2 = (float*)(W + W_S5A256); float* ob = (float*)(W + W_S5B);
            for (int i = gt; i < 1024; i += gs) {
                const int g = i >> 6;
                const float step = expf(ls[g]), ar = are[i], ai = aim[i];
                const float mag = expf(ar * step); float sn, cs; sincosf(ai * step, &sn, &cs);
                const float abr = mag * cs, abi = mag * sn;
                const float den = ar * ar + ai * ai, nr = abr - 1.f, ni = abi;
                const float cr = (nr * ar + ni * ai) / den, ci = (ni * ar - nr * ai) / den;
                oa[i * 2] = abr; oa[i * 2 + 1] = abi;
                float pr = abr, pi = abi;
                for (int s = 0; s < 8; ++s) { const float nr2 = pr * pr - pi * pi, ni2 = 2.f * pr * pi; pr = nr2; pi = ni2; }
                oa2[i * 2] = pr; oa2[i * 2 + 1] = pi;
                for (int h = 0; h < 16; ++h) {
                    const float br = bre[i * 16 + h], bi_ = bim[i * 16 + h];
                    ob[i * 32 + h] = cr * br - ci * bi_;
                    ob[i * 32 + 16 + h] = cr * bi_ + ci * br;
                }
            }
            const float* cre = p.in[20] + (size_t)l * 16384; const float* cim = p.in[21] + (size_t)l * 16384; bf16_t* oc = (bf16_t*)(W + W_S5C);
            for (int i = gt; i < 32768; i += gs) {
                const int k = i & 127, gh = i >> 7;
                oc[i] = f2bf(k < 64 ? cre[gh * 64 + k] : -cim[gh * 64 + (k - 64)]);
            }
        }
        {
            const float* wg = p.in[28] + (size_t)l * 1024 * 4; const float* we = p.in[30] + (size_t)l * 1024 * 32;
            bf16_t* oh = (bf16_t*)(W + W_RH); bf16_t* ol = (bf16_t*)(W + W_RL);
            for (int i = gt; i < 65536; i += gs) {
                const int n = i >> 10, k = i & 1023;
                const float v = (n < 4) ? wg[k * 4 + n] : ((n < 36) ? we[k * 32 + (n - 4)] : 0.f);
                const bf16_t h = f2bf(v);
                oh[i] = h; ol[i] = f2bf(v - bf2f(h));
            }
        }
        {
            float* pb = (float*)(W + W_PB);
            for (int j = VBID() * 4 + w; j < 256; j += G * 4) {
                const int kv = j >> 7, n = j & 127;
                const float* pos = p.in[kv ? 5 : 4] + (size_t)l * 2048; const float* w1 = p.in[kv ? 8 : 6] + (size_t)l * 2048 * 128;
                float s = 0.f;
                for (int k = lane; k < 2048; k += 64) s += pos[k] * w1[(size_t)k * 128 + n];
                s = wave_sum(s);
                if (lane == 0) pb[j] = s;
            }
        }
    }
    {
        const float* gam = (l < DEPTH) ? (p.in[2] + (size_t)l * 1024) : p.in[35];
        bf16_t* hb = (bf16_t*)(p.ws + OFF_H);
        const bf16_t* ys = (const bf16_t*)(p.ws + OFF_YS);
        f32x4 gv[4];
#pragma unroll
        for (int i = 0; i < 4; ++i) gv[i] = *(const f32x4*)(gam + 4 * lane + 256 * i);
        for (int row = VBID() * 4 + w; row < NTOK; row += G * 4) {
            f32x4 xv[4]; float ss = 0.f;
#pragma unroll
            for (int i = 0; i < 4; ++i) {
                const int col = 4 * lane + 256 * i;
                if (l == 0) xv[i] = *(const f32x4*)(p.in[0] + (size_t)row * 1024 + col);
                else if ((DBG_NOCOMBINE >> l) & 1) xv[i] = *(const f32x4*)(p.xbuf + (size_t)row * 1024 + col);
                else {
                    xv[i] = *(const f32x4*)(p.xbuf + (size_t)row * 1024 + col);
                    const u32x2 y0 = *(const u32x2*)(ys + (size_t)(2 * row) * 1024 + col), y1 = *(const u32x2*)(ys + (size_t)(2 * row + 1) * 1024 + col);
                    xv[i][0] += bflo(y0.x) + bflo(y1.x); xv[i][1] += bfhi(y0.x) + bfhi(y1.x);
                    xv[i][2] += bflo(y0.y) + bflo(y1.y); xv[i][3] += bfhi(y0.y) + bfhi(y1.y);
                }
                ss += xv[i][0] * xv[i][0] + xv[i][1] * xv[i][1] + xv[i][2] * xv[i][2] + xv[i][3] * xv[i][3];
            }
            ss = wave_sum(ss);
            const float rstd = rsqrtf(ss * (1.f / 1024.f) + RMS_EPS);
#pragma unroll
            for (int i = 0; i < 4; ++i) {
                const int col = 4 * lane + 256 * i;
                f32x4 hn = xv[i] * rstd * gv[i];
                if (l < DEPTH) {
                    *(f32x4*)(p.xbuf + (size_t)row * 1024 + col) = xv[i];
                    u32x2 o; o.x = pk_bf16(hn[0], hn[1]); o.y = pk_bf16(hn[2], hn[3]);
                    *(u32x2*)(hb + (size_t)row * 1024 + col) = o;
                } else {
#if DBG_TIMEPH >= 0
                    { const unsigned long long* ts = (const unsigned long long*)(p.ws + OFF_CTL + 24576);
                      const float dt_us = (float)(ts[DBG_TIMEPH2] - ts[DBG_TIMEPH]) * 0.01f; hn = hn * (1.f + 1e-3f * dt_us); }
#endif
                    *(f32x4*)(p.xbuf + (size_t)row * 1024 + col) = hn;
                }
            }
        }
    }
}

__device__ __forceinline__ void phase_inproj(CKP& p, int l, unsigned char* lds) {
    const int tid = opaque_tid(), lane = tid & 63, w = tid >> 6, wm = w >> 1, wn = w & 1, fr = lane & 15, fq = lane >> 4;
    const bf16_t* A = (const bf16_t*)(p.ws + OFF_H);
    const bf16_t* Bt = (const bf16_t*)(p.ws + OFF_W + W_IN);
    unsigned char* R = p.ws + OFF_R;
    const int* pos = (const int*)p.in[1];
    constexpr int NTM = NTOK / 128, NTN = 17;
    for (int L = VBID(); L < NTM * NTN; L += VGRID()) {
        int tm, tn; tile_coords(L, NTM, NTN, tm, tn);
        const int m0 = tm * 128, n0 = tn * 128;
        f32x4 acc[4][4]; zero_acc(acc);
        gemm_kloop(acc, [&](int r) { return A + (size_t)(m0 + r) * 1024; }, 64, [&](int v) { return Bt + (size_t)(n0 + v) * 1024; }, 64, 16, lds, tid);
#pragma unroll
        for (int mi = 0; mi < 4; ++mi) {
            const int row = m0 + 64 * wm + 16 * mi + fr;
            const int cl = 64 * wn + 16 * fq;
            float v[16];
#pragma unroll
            for (int e = 0; e < 16; ++e) v[e] = acc[mi][e >> 2][e & 3];
            if (tn < 4) {
                store16bf((bf16_t*)(R + R_Q) + (size_t)row * 512 + n0 + cl, v);
                if (fq == 0) {
                    const float ps = (float)pos[row];
#pragma unroll
                    for (int i = 0; i < 8; ++i) {
                        float sn, cs; sincosf(ps * p.inv_freq[i], &sn, &cs);
                        const float x1 = v[i], x2 = v[8 + i];
                        v[i] = x1 * cs - x2 * sn; v[8 + i] = x2 * cs + x1 * sn;
                    }
                }
                store16bf((bf16_t*)(R + R_QR) + (size_t)row * 512 + n0 + cl, v);
            } else if (tn < 10) {
                const int seg = tn - 4;
                if (seg == 2 || seg == 4) {
                    if (fq == 0) {
                        const float ps = (float)pos[row];
#pragma unroll
                        for (int i = 0; i < 8; ++i) {
                            float sn, cs; sincosf(ps * p.inv_freq[i], &sn, &cs);
                            const float x1 = v[i], x2 = v[8 + i];
                            v[i] = x1 * cs - x2 * sn; v[8 + i] = x2 * cs + x1 * sn;
                        }
                    }
                }
                if (seg == 3 || seg == 5) {
                    bf16_t* dst = (bf16_t*)(R + (seg == 3 ? R_VST : R_VWT));
                    const int b = row >> 12, s = row & 4095, g = wn, d0 = 16 * fq;
#pragma unroll
                    for (int e = 0; e < 16; ++e) dst[((size_t)((b * 2 + g) * 64 + d0 + e)) * SEQ + s] = f2bf(v[e]);
                } else {
                    const size_t off = (seg == 0) ? R_KC : (seg == 1) ? R_VC : (seg == 2) ? R_KS : R_KW;
                    store16bf((bf16_t*)(R + off) + (size_t)row * 128 + cl, v);
                }
            } else if (tn == 10) {
                if (cl < 24) {
                    float* ng = (float*)(R + R_NG) + (size_t)row * 24 + cl;
#pragma unroll
                    for (int e = 0; e < 16; ++e) if (cl + e < 24) ng[e] = sigm(v[e]);
                }
            } else if (tn < 15) {
#pragma unroll
                for (int e = 0; e < 16; ++e) v[e] = gelu_tanh(v[e]);
                const int c512 = (tn - 11) * 128 + cl;
                if (c512 < 256) store16bf((bf16_t*)(R + R_U) + (size_t)row * 256 + c512, v);
                else store16bf((bf16_t*)(R + R_V) + (size_t)row * 256 + (c512 - 256), v);
            } else {
                store16bf((bf16_t*)(R + R_S5IN) + (size_t)row * 256 + (tn - 15) * 128 + cl, v);
            }
        }
    }
}

__device__ __forceinline__ void compress_tile(CKP& p, int job, unsigned char* lds) {
    job_fence();
    const int tid = opaque_tid(), lane = tid & 63, w = tid >> 6, wm = w >> 1, wn = w & 1, fr = lane & 15, fq = lane >> 4;
    const int kv = job >> 5, tm = job & 31, m0 = tm * 128;
    unsigned char* W = p.ws + OFF_W;
    const bf16_t* src = (const bf16_t*)(p.ws + OFF_R + (kv ? R_VC : R_KC));
    const bf16_t* W1 = (const bf16_t*)(W + W_C1) + (size_t)kv * 128 * 2048;
    const bf16_t* W2 = (const bf16_t*)(W + W_C2) + (size_t)kv * 64 * 128;
    const float* pb = (const float*)(W + W_PB) + kv * 128;
    f32x4 acc[4][4]; zero_acc(acc);
    gemm_kloop(acc, [&](int r) { int Rr = m0 + r; Rr = Rr < 4080 ? Rr : 4079; const int b = Rr / 510, rem = Rr % 510, c = rem >> 1, g = rem & 1;
                                 return src + ((size_t)(b * SEQ + 16 * c)) * 128 + g * 64; }, 128,
               [&](int v) { return W1 + (size_t)v * 2048; }, 64, 32, lds, tid);
#pragma unroll
    for (int mi = 0; mi < 4; ++mi) {
        const int row = 64 * wm + 16 * mi + fr; const int cb = 16 * fq;
        float v[16];
#pragma unroll
        for (int e = 0; e < 16; ++e) v[e] = gelu_tanh(acc[mi][e >> 2][e & 3] + pb[64 * wn + cb + e]);
        u32x4 a, b;
        a.x = pk_bf16(v[0], v[1]); a.y = pk_bf16(v[2], v[3]); a.z = pk_bf16(v[4], v[5]); a.w = pk_bf16(v[6], v[7]);
        b.x = pk_bf16(v[8], v[9]); b.y = pk_bf16(v[10], v[11]); b.z = pk_bf16(v[12], v[13]); b.w = pk_bf16(v[14], v[15]);
        *(u32x4*)(lds + wn * 16384 + row * 128 + (((2 * fq) ^ (row & 7)) << 4)) = a;
        *(u32x4*)(lds + wn * 16384 + row * 128 + (((2 * fq + 1) ^ (row & 7)) << 4)) = b;
    }
#pragma unroll
    for (int j = 0; j < 4; ++j) {
        const int pid = tid + 256 * j, row = pid >> 4, ch = pid & 15;
        const u32x4 v = *(const u32x4*)(W2 + row * 128 + ch * 8);
        *(u32x4*)(lds + 32768 + (ch >> 3) * 16384 + row * 128 + (((ch & 7) ^ (row & 7)) << 4)) = v;
    }
    vb_sync(lds);
    f32x4 a2[4][2];
#pragma unroll
    for (int i = 0; i < 4; ++i) { a2[i][0] = (f32x4){0.f, 0.f, 0.f, 0.f}; a2[i][1] = (f32x4){0.f, 0.f, 0.f, 0.f}; }
#pragma unroll
    for (int kt2 = 0; kt2 < 2; ++kt2)
#pragma unroll
        for (int ks = 0; ks < 2; ++ks) {
            bf16x8 af[4], bf[2];
#pragma unroll
            for (int mi = 0; mi < 4; ++mi) { const int row = 64 * wm + 16 * mi + fr; af[mi] = *(const bf16x8*)(lds + kt2 * 16384 + row * 128 + (((4 * ks + fq) ^ (row & 7)) << 4)); }
#pragma unroll
            for (int ni = 0; ni < 2; ++ni) { const int row = 32 * wn + 8 * (fr >> 2) + 4 * ni + (fr & 3); bf[ni] = *(const bf16x8*)(lds + 32768 + kt2 * 16384 + row * 128 + (((4 * ks + fq) ^ (row & 7)) << 4)); }
#pragma unroll
            for (int mi = 0; mi < 4; ++mi)
#pragma unroll
                for (int ni = 0; ni < 2; ++ni) a2[mi][ni] = mfma16(bf[ni], af[mi], a2[mi][ni]);
        }
    bf16_t* kcmp = (bf16_t*)(p.ws + OFF_C + C_KCMP);
    bf16_t* vct = (bf16_t*)(p.ws + OFF_C + C_VCT);
#pragma unroll
    for (int mi = 0; mi < 4; ++mi) {
        const int Rr = m0 + 64 * wm + 16 * mi + fr;
        if (Rr < 4080) {
            const int b = Rr / 510, rem = Rr % 510, c = rem >> 1, g = rem & 1, d0 = 32 * wn + 8 * fq;
            float v[8];
#pragma unroll
            for (int e = 0; e < 8; ++e) v[e] = a2[mi][e >> 2][e & 3];
            if (DBG_NOCSTORE) { if (v[0] == 123.456f) kcmp[0] = 1; }
            else if (kv == 0) {
                u32x4 o; o.x = pk_bf16(v[0], v[1]); o.y = pk_bf16(v[2], v[3]); o.z = pk_bf16(v[4], v[5]); o.w = pk_bf16(v[6], v[7]);
                *(u32x4*)(kcmp + ((size_t)(b * 256 + c)) * 128 + g * 64 + d0) = o;
                if (c == 254) *(u32x4*)(kcmp + ((size_t)(b * 256 + 255)) * 128 + g * 64 + d0) = (u32x4){0u, 0u, 0u, 0u};
            } else {
#pragma unroll
                for (int e = 0; e < 8; ++e) {
                    vct[((size_t)((b * 2 + g) * 64 + d0 + e)) * 256 + c] = f2bf(v[e]);
                    if (c == 254) vct[((size_t)((b * 2 + g) * 64 + d0 + e)) * 256 + 255] = 0;
                }
            }
        }
    }
    vb_sync(lds);
}

__device__ __forceinline__ void sgu_job(CKP& p, int l, int job, unsigned char* lds) {
    job_fence();
    const int tid = opaque_tid(), lane = tid & 63, w = tid >> 6, fr = lane & 15, fq = lane >> 4;
    const size_t tok0 = (size_t)job * 128;
    const bf16_t* V = (const bf16_t*)(p.ws + OFF_R + R_V) + tok0 * 256;
    const bf16_t* U = (const bf16_t*)(p.ws + OFF_R + R_U) + tok0 * 256;
    bf16_t* O = (bf16_t*)(p.ws + OFF_C + C_SGU) + tok0 * 256;
    const bf16_t* Wt = (const bf16_t*)(p.ws + OFF_W + W_SGU);
    const float* ng = p.in[11] + (size_t)l * 256;
    const float* bs = p.in[13] + (size_t)l * 512;
    vb_sync(lds);
    if (DBG_SGUCUT != 2) {
        const int s = tid >> 1, half = tid & 1;
        const bf16_t* src = V + (size_t)s * 256 + half * 128;
        float ss = 0.f;
#pragma unroll 4
        for (int j = 0; j < 16; ++j) {
            const u32x4 bb = *(const u32x4*)(src + j * 8);
            const unsigned uu[4] = {bb.x, bb.y, bb.z, bb.w};
#pragma unroll
            for (int q = 0; q < 4; ++q) { const float a = bflo(uu[q]), b2 = bfhi(uu[q]); ss += a * a + b2 * b2; }
        }
        ss += __shfl_xor(ss, 1);
        const float rstd = rsqrtf(ss * (1.f / 256.f) + RMS_EPS);
#pragma unroll 1
        for (int j = 0; j < 16; ++j) {
            const u32x4 bb = *(const u32x4*)(src + j * 8);
            const unsigned uu[4] = {bb.x, bb.y, bb.z, bb.w};
            const int cb = half * 128 + j * 8;
#pragma unroll
            for (int q = 0; q < 4; ++q) {
#pragma unroll
                for (int hh = 0; hh < 2; ++hh) {
                    const int c = cb + q * 2 + hh;
                    const float val = (hh ? bfhi(uu[q]) : bflo(uu[q])) * rstd * ng[c];
                    *(bf16_t*)(lds + c * 256 + ((((s >> 3) ^ (c & 15))) << 4) + (s & 7) * 2) = f2bf(val);
                }
            }
        }
    }
    vb_sync(lds);
    const int g = w;
#pragma unroll 1
    for (int th = 0; th < (DBG_SGUCUT == 1 ? 0 : 2); ++th) {
        f32x4 acc[4][4];
        zero_acc(acc);
#pragma unroll
        for (int ks = 0; ks < 4; ++ks) {
            if (32 * ks <= 64 * th + 63) {
                bf16x8 vf[4];
#pragma unroll
                for (int di = 0; di < 4; ++di) { const int c = 64 * g + 16 * di + fr; vf[di] = *(const bf16x8*)(lds + c * 256 + (((4 * ks + fq) ^ (c & 15)) << 4)); }
#pragma unroll
                for (int ti = 0; ti < 4; ++ti) {
                    const int t = 64 * th + 16 * ti + fr;
                    if (32 * ks <= 64 * th + 16 * ti + 15) {
                        const bf16x8 wf = *(const bf16x8*)(Wt + ((size_t)(g * 128 + t)) * 128 + 32 * ks + 8 * fq);
#pragma unroll
                        for (int di = 0; di < 4; ++di) acc[ti][di] = mfma16(vf[di], wf, acc[ti][di]);
                    }
                }
            }
        }
#pragma unroll
        for (int ti = 0; ti < 4; ++ti) {
            const int t = 64 * th + 16 * ti + fr; const float bb = bs[g * 128 + t];
#pragma unroll
            for (int di = 0; di < 4; ++di) {
                const int c = 64 * g + 16 * di + 4 * fq;
                const u32x2 uu = *(const u32x2*)(U + (size_t)t * 256 + c);
                u32x2 o;
                o.x = pk_bf16(bflo(uu.x) * (acc[ti][di][0] + bb), bfhi(uu.x) * (acc[ti][di][1] + bb));
                o.y = pk_bf16(bflo(uu.y) * (acc[ti][di][2] + bb), bfhi(uu.y) * (acc[ti][di][3] + bb));
                *(u32x2*)(O + (size_t)t * 256 + c) = o;
            }
        }
    }
    vb_sync(lds);
}

__device__ __forceinline__ void s5_job(CKP& p, int l, int jb, int pass, unsigned char* lds) {
    job_fence();
    const int tid = opaque_tid(), lane = tid & 63, w = tid >> 6, fr = lane & 15, fq = lane >> 4;
    const int id = ((jb * 4 + w) + DBG_IDROT) & 2047, seq = id >> 4, ch = id & 15, b = seq >> 4, g = seq & 15;
    unsigned char* W = p.ws + OFF_W;
    const float* ab = (const float*)(W + W_S5A) + (g * 64 + lane) * 2;
    float ar = ab[0], ai = ab[1];
    float br[16], bi[16];
    {
        const float* bb = (const float*)(W + W_S5B) + (size_t)(g * 64 + lane) * 32;
#pragma unroll
        for (int h = 0; h < 16; ++h) { br[h] = bb[h]; bi[h] = bb[16 + h]; }
    }
#if DBG_S5CONST >= 2
    { const float q = (float)(lane + 1) * 0.001f; ar = 0.99f - q; ai = 0.05f + q;
      for (int h = 0; h < 16; ++h) { br[h] = 0.01f * (float)(h + 1) + q; bi[h] = -0.02f * (float)(h + 1) + q; } }
#endif
    float* Eb = (float*)(p.ws + OFF_C + C_S5E);
    float hre = 0.f, him = 0.f;
    bf16x8 cf[4]; float dv[4];
    if (pass == 2) {
        const float* a2 = (const float*)(W + W_S5A256) + (g * 64 + lane) * 2;
        const float a2r = a2[0], a2i = a2[1];
        for (int c2 = 0; c2 < ch; ++c2) {
            const float* e = Eb + ((size_t)(seq * 16 + c2) * 64 + lane) * 2;
            const float nr = a2r * hre - a2i * him + e[0], ni = a2r * him + a2i * hre + e[1];
            hre = nr; him = ni;
        }
        const bf16_t* cm = (const bf16_t*)(W + W_S5C) + (size_t)(g * 16 + fr) * 128;
#pragma unroll
        for (int ks = 0; ks < 4; ++ks) cf[ks] = *(const bf16x8*)(cm + 32 * ks + 8 * fq);
#pragma unroll
        for (int r = 0; r < 4; ++r) dv[r] = p.in[22][(size_t)l * 256 + g * 16 + 4 * fq + r];
    }
    const bf16_t* xin = (const bf16_t*)(p.ws + OFF_R + R_S5IN) + ((size_t)(b * SEQ + ch * 256)) * 256 + g * 16;
    bf16_t* yg = (bf16_t*)(p.ws + OFF_C + C_YG) + ((size_t)(b * SEQ + ch * 256)) * 256 + g * 16;
    float* xs = (float*)(lds + w * 10240);
    int ldsbad = 0; (void)ldsbad;
    unsigned char* Hs = lds + w * 10240 + 2048;
#if DBG_TWICE
    float keep_re = 0.f, keep_im = 0.f;
#pragma unroll 1
    for (int rep = 0; rep < 2; ++rep) {
    if (rep == 1) { keep_re = hre; keep_im = him; hre = 0.f; him = 0.f; }
#endif
#pragma unroll 1
    for (int sub = 0; sub < 8; ++sub) {
#if DBG_S5CONST >= 1
        u32x4 xv; { const unsigned q = (unsigned)(sub * 32 + (lane >> 1)) * 2654435761u + (unsigned)id * 40503u + (lane & 1); xv.x = 0x3f803e80u ^ ((q & 0xff) << 16); xv.y = 0x3e003d00u ^ ((q >> 8) & 0x7f); xv.z = 0xbe803f00u ^ ((q >> 16) & 0x3f); xv.w = 0x3d80be00u; }
#else
        const u32x4 xv = *(const u32x4*)(xin + (size_t)(sub * 32 + (lane >> 1)) * 256 + (lane & 1) * 8);
#endif
        vb_sync(lds);
        f32x4 chk_a = {bflo(xv.x), bfhi(xv.x), bflo(xv.y), bfhi(xv.y)}, chk_c = {bflo(xv.z), bfhi(xv.z), bflo(xv.w), bfhi(xv.w)};
        {
            *(f32x4*)(xs + (lane >> 1) * 16 + (lane & 1) * 8) = chk_a;
            *(f32x4*)(xs + (lane >> 1) * 16 + (lane & 1) * 8 + 4) = chk_c;
        }
        vb_sync(lds);
#pragma unroll 4
        for (int st = 0; st < 32; ++st) {
#if DBG_S5CONST == 3
            f32x4 x0, x1, x2, x3;
            { const float t = (float)((sub * 32 + st) & 63) * 0.015625f + (float)(id & 7) * 0.125f;
              x0 = (f32x4){t, t * 0.5f, -t, 0.25f}; x1 = (f32x4){0.5f - t, t * t, 0.125f, t}; x2 = (f32x4){-0.25f, t, 0.75f * t, 1.f - t}; x3 = (f32x4){t, -t, 0.5f, 0.3f * t}; }
#else
            const f32x4 x0 = *(const f32x4*)(xs + st * 16), x1 = *(const f32x4*)(xs + st * 16 + 4), x2 = *(const f32x4*)(xs + st * 16 + 8), x3 = *(const f32x4*)(xs + st * 16 + 12);
#endif
            float ur = 0.f, ui = 0.f;
#pragma unroll
            for (int h = 0; h < 4; ++h) {
                ur += br[h] * x0[h]; ui += bi[h] * x0[h];
                ur += br[4 + h] * x1[h]; ui += bi[4 + h] * x1[h];
                ur += br[8 + h] * x2[h]; ui += bi[8 + h] * x2[h];
                ur += br[12 + h] * x3[h]; ui += bi[12 + h] * x3[h];
            }
            const float nr = ar * hre - ai * him + ur, ni = ar * him + ai * hre + ui;
            hre = nr; him = ni;
            if (pass == 2) {
                *(bf16_t*)(Hs + st * 256 + (((lane >> 3) ^ (st & 15)) << 4) + (lane & 7) * 2) = f2bf(hre);
                *(bf16_t*)(Hs + st * 256 + ((((64 + lane) >> 3) ^ (st & 15)) << 4) + (lane & 7) * 2) = f2bf(him);
            }
        }
#if DBG_LDSCHK
        {
            const f32x4 ra = *(volatile f32x4*)(xs + (lane >> 1) * 16 + (lane & 1) * 8), rc = *(volatile f32x4*)(xs + (lane >> 1) * 16 + (lane & 1) * 8 + 4);
            bool bad = false;
            for (int q = 0; q < 4; ++q) bad |= (__float_as_uint(ra[q]) != __float_as_uint(chk_a[q])) | (__float_as_uint(rc[q]) != __float_as_uint(chk_c[q]));
            if (__any(bad)) ldsbad = 1;
        }
#endif
        if (pass == 2) {
            vb_sync(lds);
#pragma unroll
            for (int tt = 0; tt < 2; ++tt) {
                f32x4 acc = {0.f, 0.f, 0.f, 0.f};
                const int tl = tt * 16 + fr;
#pragma unroll
                for (int ks = 0; ks < 4; ++ks) {
                    const bf16x8 hf = *(const bf16x8*)(Hs + tl * 256 + (((4 * ks + fq) ^ (tl & 15)) << 4));
                    acc = mfma16(cf[ks], hf, acc);
                }
                float y[4];
#pragma unroll
                for (int r = 0; r < 4; ++r) y[r] = gelu_tanh(acc[r] + dv[r] * xs[tl * 16 + 4 * fq + r]);
                u32x2 o; o.x = pk_bf16(y[0], y[1]); o.y = pk_bf16(y[2], y[3]);
                *(u32x2*)(yg + (size_t)(sub * 32 + tl) * 256 + 4 * fq) = o;
            }
        }
    }
#if DBG_TWICE
    }
    if (__float_as_uint(keep_re) != __float_as_uint(hre) || __float_as_uint(keep_im) != __float_as_uint(him)) { hre = __uint_as_float(0x7fc00000u); him = hre; }
#endif
    if (pass == 1) {
        float* e = Eb + ((size_t)(seq * 16 + ch) * 64 + lane) * 2;
#if DBG_LDSCHK
        if (ldsbad) { hre = __uint_as_float(0x7fc00000u); him = hre; }
#endif
#if DBG_ESC1
        { const unsigned long long pk = ((unsigned long long)__float_as_uint(him) << 32) | __float_as_uint(hre);
          __hip_atomic_store((unsigned long long*)e, pk, __ATOMIC_RELAXED, __HIP_MEMORY_SCOPE_AGENT); }
#else
        e[0] = hre; e[1] = him;
#endif
#if DBG_E2
        float* e2 = (float*)(p.ws + OFF_C + C_ATT) + ((size_t)(seq * 16 + ch) * 64 + lane) * 2;
        e2[0] = hre; e2[1] = him;
#endif
    }
    vb_sync(lds);
}

__device__ __forceinline__ void phase_mid1(CKP& p, int l, unsigned char* lds) {
#if DBG_QDELAY == 2
    if (VBID() >= 320) return;
#elif DBG_QDELAY == 3
    if (VBID() >= 320) {
        const unsigned long long t0 = __builtin_amdgcn_s_memrealtime(); while (__builtin_amdgcn_s_memrealtime() - t0 < 3000ull) __builtin_amdgcn_s_sleep(8);
        s5_job(p, l, VBID() - 320, 1, lds);
        return;
    }
#elif DBG_QDELAY
    if (VBID() >= 320) {
        s5_job(p, l, VBID() - 320, 1, lds);
        const unsigned long long t0 = __builtin_amdgcn_s_memrealtime(); while (__builtin_amdgcn_s_memrealtime() - t0 < 6000ull) __builtin_amdgcn_s_sleep(8);
        return;
    }
#endif
    for (int j = VBID(); j < 64 + 256 + 512; j += VGRID()) {
#if DBG_ONLYS5 == 1
        if (j >= 320) s5_job(p, l, j - 320, 1, lds);
#elif DBG_ONLYS5 == 2
        if (j < 64) compress_tile(p, j, lds);
        else if (j >= 320) s5_job(p, l, j - 320, 1, lds);
#elif DBG_ONLYS5 == 4
        { const int jj = 831 - j; if (jj < 64) compress_tile(p, jj, lds); else if (jj >= 320) s5_job(p, l, jj - 320, 1, lds); }
#elif DBG_ONLYS5 == 5
        if (j < 64) compress_tile(p, j, lds);
        else if (j >= 320 && j < 512) s5_job(p, l, j - 320, 1, lds);
        else if (j >= 576) s5_job(p, l, j - 320, 1, lds);
        if (j >= 448 && j < 512) s5_job(p, l, j + 64 - 320, 1, lds);
#elif DBG_ONLYS5 == 3
        if (j >= 64 && j < 320) sgu_job(p, l, j - 64, lds);
        else if (j >= 320) s5_job(p, l, j - 320, 1, lds);
#elif DBG_ONLYS5 == 6
        if (j < 512) {
#if DBG_PRESPIN
            { const unsigned long long t0 = __builtin_amdgcn_s_memrealtime(); while (__builtin_amdgcn_s_memrealtime() - t0 < (unsigned long long)DBG_PRESPIN) __builtin_amdgcn_s_sleep(2); }
#endif
            s5_job(p, l, j, 1, lds);
        }
        else if (j < 768) sgu_job(p, l, j - 512, lds);
        else compress_tile(p, j - 768, lds);
#else
        if (j < 64) compress_tile(p, j, lds);
        else if (j < 320) {
#if DBG_SGUSPIN
            { const unsigned long long t0 = __builtin_amdgcn_s_memrealtime(); while (__builtin_amdgcn_s_memrealtime() - t0 < (unsigned long long)DBG_SGUSPIN) __builtin_amdgcn_s_sleep(2); }
#else
            sgu_job(p, l, j - 64, lds);
#endif
        } else {
#if DBG_DELAY
            if (j >= 576) { const unsigned long long t0 = __builtin_amdgcn_s_memrealtime(); while (__builtin_amdgcn_s_memrealtime() - t0 < (unsigned long long)DBG_DELAY) __builtin_amdgcn_s_sleep(8); }
#endif
            s5_job(p, l, j - 320, 1, lds);
        }
#endif
    }
    if (VBID() >= 64) {
        const int tid = opaque_tid();
        convert_tiles(p, l, 11, 14, (VBID() - 64) * 4 + (tid >> 6), (VGRID() - 64) * 4, tid & 63);
    }
}

constexpr int AL_Q = 0, AL_KV = 32768, AL_IMP = 49152, AL_SEL = 65792, AL_UNI = 66304, AL_JOB = 66336;
constexpr float SM_C = 0.125f * 1.4426950408889634f;

__device__ __forceinline__ void attn_load_q(const bf16_t* Qg, const int* pos, const float (&inv_freq)[8], int b, int g, int t0, bool rope, unsigned char* lds, int tid) {
#pragma unroll 1
    for (int j = 0; j < 8; ++j) {
        const int pid = tid + 256 * j, Rr = pid >> 3, ch = pid & 7;
        const int wq = Rr >> 6, r = (Rr >> 4) & 3, q = Rr & 15, t = t0 + 16 * wq + q;
        const bf16_t* src = Qg + ((size_t)(b * SEQ + t)) * 512 + (g * 4 + r) * 64;
        if (!rope || ch >= 2) {
            *(u32x4*)(lds + AL_Q + Rr * 128 + ((ch ^ (Rr & 7)) << 4)) = *(const u32x4*)(src + ch * 8);
        } else if (ch == 0) {
            const u32x4 a = *(const u32x4*)(src), c = *(const u32x4*)(src + 8);
            float x1[8] = {bflo(a.x), bfhi(a.x), bflo(a.y), bfhi(a.y), bflo(a.z), bfhi(a.z), bflo(a.w), bfhi(a.w)};
            float x2[8] = {bflo(c.x), bfhi(c.x), bflo(c.y), bfhi(c.y), bflo(c.z), bfhi(c.z), bflo(c.w), bfhi(c.w)};
            const float ps = (float)pos[b * SEQ + t];
#pragma unroll
            for (int i = 0; i < 8; ++i) {
                float sn, cs; sincosf(ps * inv_freq[i], &sn, &cs);
                const float u = x1[i], v = x2[i];
                x1[i] = u * cs - v * sn; x2[i] = v * cs + u * sn;
            }
            u32x4 o1, o2;
            o1.x = pk_bf16(x1[0], x1[1]); o1.y = pk_bf16(x1[2], x1[3]); o1.z = pk_bf16(x1[4], x1[5]); o1.w = pk_bf16(x1[6], x1[7]);
            o2.x = pk_bf16(x2[0], x2[1]); o2.y = pk_bf16(x2[2], x2[3]); o2.z = pk_bf16(x2[4], x2[5]); o2.w = pk_bf16(x2[6], x2[7]);
            *(u32x4*)(lds + AL_Q + Rr * 128 + ((0 ^ (Rr & 7)) << 4)) = o1;
            *(u32x4*)(lds + AL_Q + Rr * 128 + ((1 ^ (Rr & 7)) << 4)) = o2;
        }
    }
}
__device__ __forceinline__ void attn_ldg(u32x4 (&kk)[2], u32x4 (&vv)[2], const bf16_t* Kb, const bf16_t* Vb, int vstride, int tid) {
#pragma unroll
    for (int j = 0; j < 2; ++j) {
        const int pid = tid + 256 * j, row = pid >> 3, ch = pid & 7;
        kk[j] = *(const u32x4*)(Kb + (size_t)row * 128 + ch * 8);
        vv[j] = *(const u32x4*)(Vb + (size_t)row * vstride + ch * 8);
    }
}
__device__ __forceinline__ void attn_stl(const u32x4 (&kk)[2], const u32x4 (&vv)[2], unsigned char* lds, int kvoff, int tid) {
#pragma unroll
    for (int j = 0; j < 2; ++j) {
        const int pid = tid + 256 * j, row = pid >> 3, ch = pid & 7;
        *(u32x4*)(lds + kvoff + row * 128 + ((ch ^ (row & 7)) << 4)) = kk[j];
        *(u32x4*)(lds + kvoff + 8192 + row * 128 + ((ch ^ ((row >> 1) & 7)) << 4)) = vv[j];
    }
}
__device__ __forceinline__ void attn_qk(f32x4 (&s)[2][4], const unsigned char* lds, int kvoff, int w, int fr, int fq, int hf) {
    const unsigned char* Qw = lds + AL_Q + w * 8192;
    const unsigned char* Kh = lds + kvoff + hf * 4096;
    const int sw0 = ((fq) ^ (fr & 7)) << 4, sw1 = ((4 + fq) ^ (fr & 7)) << 4;
#pragma unroll
    for (int ki = 0; ki < 2; ++ki)
#pragma unroll
        for (int qi = 0; qi < 4; ++qi) s[ki][qi] = (f32x4){0.f, 0.f, 0.f, 0.f};
#pragma unroll
    for (int ds = 0; ds < 2; ++ds) {
        bf16x8 qf[4];
#pragma unroll
        for (int qi = 0; qi < 4; ++qi) qf[qi] = *(const bf16x8*)(Qw + (qi * 16 + fr) * 128 + (ds ? sw1 : sw0));
#pragma unroll
        for (int ki = 0; ki < 2; ++ki) {
            const bf16x8 kf = *(const bf16x8*)(Kh + (ki * 16 + fr) * 128 + (ds ? sw1 : sw0));
#pragma unroll
            for (int qi = 0; qi < 4; ++qi) s[ki][qi] = mfma16(kf, qf[qi], s[ki][qi]);
        }
    }
}
__device__ __forceinline__ void attn_pv(f32x4 (&o)[4][4], const f32x4 (&s)[2][4], const unsigned char* lds, int kvoff, int fr, int fq, int hf) {
    bf16x8 pf[4];
#pragma unroll
    for (int qi = 0; qi < 4; ++qi) {
        u32x4 u;
        u.x = pk_bf16(s[0][qi][0], s[0][qi][1]); u.y = pk_bf16(s[0][qi][2], s[0][qi][3]);
        u.z = pk_bf16(s[1][qi][0], s[1][qi][1]); u.w = pk_bf16(s[1][qi][2], s[1][qi][3]);
        pf[qi] = as_bf8(u);
    }
    const int c0 = 4 * hf + (fq >> 1);
    const unsigned char* Vt = lds + kvoff + 8192;
#pragma unroll
    for (int di = 0; di < 4; ++di) {
        const int row = di * 16 + fr, key = (row >> 1) & 7;
        const u32x2 lo = *(const u32x2*)(Vt + row * 128 + ((c0 ^ key) << 4) + 8 * (fq & 1));
        const u32x2 hi = *(const u32x2*)(Vt + row * 128 + (((c0 + 2) ^ key) << 4) + 8 * (fq & 1));
        const bf16x8 vf = as_bf8((u32x4){lo.x, lo.y, hi.x, hi.y});
#pragma unroll
        for (int qi = 0; qi < 4; ++qi) o[di][qi] = mfma16(vf, pf[qi], o[di][qi]);
    }
}
__device__ __forceinline__ unsigned attn_vmask(int kb, int fq, int lo, int hi) {
    unsigned vm = 0;
#pragma unroll
    for (int ki = 0; ki < 2; ++ki)
#pragma unroll
        for (int r = 0; r < 4; ++r) { const int key = kb + 16 * ki + 4 * fq + r; if (key >= lo && key <= hi) vm |= 1u << (ki * 4 + r); }
    return vm;
}
__device__ __forceinline__ void attn_softmax(f32x4 (&s)[2][4], f32x4 (&o)[4][4], float (&m)[4], float (&lsum)[4], unsigned vm) {
#pragma unroll
    for (int qi = 0; qi < 4; ++qi) {
        float mx = -1e30f;
#pragma unroll
        for (int ki = 0; ki < 2; ++ki)
#pragma unroll
            for (int r = 0; r < 4; ++r) { const float sv = ((vm >> (ki * 4 + r)) & 1u) ? s[ki][qi][r] * SM_C : -1e30f; s[ki][qi][r] = sv; mx = fmaxf(mx, sv); }
        mx = xmax16(mx); mx = xmax32(mx);
        const float mn = fmaxf(m[qi], mx), alpha = fexp2(m[qi] - mn);
        m[qi] = mn;
        float ls = 0.f;
#pragma unroll
        for (int ki = 0; ki < 2; ++ki)
#pragma unroll
            for (int r = 0; r < 4; ++r) { const float pv = ((vm >> (ki * 4 + r)) & 1u) ? fexp2(s[ki][qi][r] - mn) : 0.f; s[ki][qi][r] = pv; ls += pv; }
        lsum[qi] = lsum[qi] * alpha + ls;
        if (__any(alpha != 1.f)) {
#pragma unroll
            for (int di = 0; di < 4; ++di) o[di][qi] *= alpha;
        }
    }
}
__device__ __forceinline__ void attn_softmax_full(f32x4 (&s)[2][4], f32x4 (&o)[4][4], float (&m)[4], float (&lsum)[4], bool lsel) {
#pragma unroll
    for (int qi = 0; qi < 4; ++qi) {
        float mx = fmaxf(fmaxf(fmaxf(s[0][qi][0], s[0][qi][1]), fmaxf(s[0][qi][2], s[0][qi][3])), fmaxf(fmaxf(s[1][qi][0], s[1][qi][1]), fmaxf(s[1][qi][2], s[1][qi][3])));
        mx = xmax16(mx); mx = xmax32(mx);
        const float mn = fmaxf(m[qi], mx * SM_C);
        const float mnew = lsel ? mn : m[qi];
        const float alpha = fexp2(m[qi] - mnew);
        m[qi] = mnew;
        const float neg = lsel ? -mn : -1e30f;
        float ls = 0.f;
#pragma unroll
        for (int ki = 0; ki < 2; ++ki)
#pragma unroll
            for (int r = 0; r < 4; ++r) { const float pv = fexp2(fmaf(s[ki][qi][r], SM_C, neg)); s[ki][qi][r] = pv; ls += pv; }
        lsum[qi] = lsum[qi] * alpha + ls;
        if (__any(alpha != 1.f)) {
#pragma unroll
            for (int di = 0; di < 4; ++di) o[di][qi] *= alpha;
        }
    }
}
__device__ __forceinline__ void attn_accum(bf16_t* dst, const f32x4 (&o)[4][4], const float (&lsum)[4], const float (&gate)[4], bool first, int fq) {
#pragma unroll
    for (int qi = 0; qi < 4; ++qi) {
        float lt = lsum[qi]; lt = xsum16(lt); lt = xsum32(lt);
        const float sc = gate[qi] / fmaxf(lt, 1e-30f);
#pragma unroll
        for (int di = 0; di < 4; ++di) {
            u32x2* ptr = (u32x2*)(dst + qi * 64 + 16 * di + 4 * fq);
            float a0 = o[di][qi][0] * sc, a1 = o[di][qi][1] * sc, a2 = o[di][qi][2] * sc, a3 = o[di][qi][3] * sc;
            if (!first) { const u32x2 f = *ptr; a0 += bflo(f.x); a1 += bfhi(f.x); a2 += bflo(f.y); a3 += bfhi(f.y); }
            u32x2 r; r.x = pk_bf16(a0, a1); r.y = pk_bf16(a2, a3);
            *ptr = r;
        }
    }
}
template <class NextF, class PtrF, class BodyF>
__device__ __forceinline__ void attn_tiles(int first, NextF next, PtrF ptrs, BodyF body, unsigned char* lds, int tid) {
    u32x4 kk[2], vv[2];
    const bf16_t* Kb; const bf16_t* Vb; int vs;
    ptrs(first, Kb, Vb, vs);
    attn_ldg(kk, vv, Kb, Vb, vs, tid);
    int cur = first;
    while (cur >= 0) {
        vb_sync(lds);
        attn_stl(kk, vv, lds, AL_KV, tid);
        vb_sync(lds);
        const int nx = next(cur);
        if (nx >= 0) { ptrs(nx, Kb, Vb, vs); attn_ldg(kk, vv, Kb, Vb, vs, tid); }
        body(cur, AL_KV);
        cur = nx;
    }
}

__device__ __forceinline__ void phase_attn(CKP& p, int l, unsigned char* lds, unsigned* ctl) {
    for (int j = VBID(); j < 512; j += VGRID()) s5_job(p, l, j, 2, lds);

    unsigned char* R = p.ws + OFF_R; unsigned char* C = p.ws + OFF_C;
    const bf16_t* Qg = (const bf16_t*)(R + R_Q);
    const bf16_t* Kc = (const bf16_t*)(C + C_KCMP); const bf16_t* Vc = (const bf16_t*)(C + C_VCT);
    const bf16_t* Ks = (const bf16_t*)(R + R_KS); const bf16_t* Vs = (const bf16_t*)(R + R_VST);
    const bf16_t* Kw = (const bf16_t*)(R + R_KW); const bf16_t* Vw = (const bf16_t*)(R + R_VWT);
    const float* NG = (const float*)(R + R_NG);
    bf16_t* AO = (bf16_t*)(C + C_ATT);
    const int* pos = (const int*)p.in[1];
    unsigned* ctr = ctl + CTL_ATTN + l;
    volatile int* jobp = (volatile int*)(lds + AL_JOB);
    float* imp = (float*)(lds + AL_IMP);
    unsigned long long* selm = (unsigned long long*)(lds + AL_SEL);
    unsigned long long* uni = (unsigned long long*)(lds + AL_UNI);
    float invf[8];
#pragma unroll
    for (int q = 0; q < 8; ++q) invf[q] = p.inv_freq[q];

    for (;;) {
        const int tid = opaque_tid(), lane = tid & 63, w = tid >> 6, fr = lane & 15, fq = lane >> 4;
        vb_sync(lds);
        if (tid == 0) *jobp = (int)atomicAdd(ctr, 1u);
        vb_sync(lds);
        const int job = *jobp;
        if (job >= 1024) break;
        const int i = 63 - (job >> 4), bg = job & 15, b = bg >> 1, g = bg & 1, t0 = i * 64;
        const int tq = t0 + 16 * w + fr;
        const size_t kvrow = (size_t)b * SEQ;
        float gate[4];
        bf16_t* dstq = AO + ((size_t)(kvrow + tq)) * 512 + (g * 4) * 64;

        attn_load_q(Qg, pos, invf, b, g, t0, false, lds, tid);
        const int ntc = ((4 * i + 2) >> 6) + 1;
        const int hic = (tq >= 31) ? ((tq - 31) >> 4) : -1;
        float m[4], lsum[4];
#pragma unroll
        for (int qi = 0; qi < 4; ++qi) { m[qi] = -1e30f; lsum[qi] = 0.f; }
        auto cmp_next = [&](int ct) { return (ct + 1 < ntc) ? ct + 1 : -1; };
        auto cmp_ptrs = [&](int ct, const bf16_t*& Kb, const bf16_t*& Vb, int& vs) {
            Kb = Kc + ((size_t)(b * 256 + ct * 64)) * 128 + g * 64; Vb = Vc + ((size_t)((b * 2 + g) * 64)) * 256 + ct * 64; vs = 256; };
        attn_tiles(0, cmp_next, cmp_ptrs, [&](int ct, int kvoff) {
#pragma unroll 1
            for (int hf = 0; hf < 2; ++hf) {
                f32x4 s[2][4];
                attn_qk(s, lds, kvoff, w, fr, fq, hf);
                const unsigned vm = attn_vmask(ct * 64 + hf * 32, fq, 0, hic);
#pragma unroll
                for (int qi = 0; qi < 4; ++qi) {
                    float mx = -1e30f;
#pragma unroll
                    for (int ki = 0; ki < 2; ++ki)
#pragma unroll
                        for (int r = 0; r < 4; ++r) { const float sv = ((vm >> (ki * 4 + r)) & 1u) ? s[ki][qi][r] * SM_C : -1e30f; s[ki][qi][r] = sv; mx = fmaxf(mx, sv); }
                    mx = xmax16(mx); mx = xmax32(mx);
                    const float mn = fmaxf(m[qi], mx), alpha = fexp2(m[qi] - mn);
                    m[qi] = mn;
                    float ls = 0.f;
#pragma unroll
                    for (int ki = 0; ki < 2; ++ki)
#pragma unroll
                        for (int r = 0; r < 4; ++r) ls += ((vm >> (ki * 4 + r)) & 1u) ? fexp2(s[ki][qi][r] - mn) : 0.f;
                    lsum[qi] = lsum[qi] * alpha + ls;
                }
            }
        }, lds, tid);
        float invl[4];
#pragma unroll
        for (int qi = 0; qi < 4; ++qi) { float lt = lsum[qi]; lt = xsum16(lt); lt = xsum32(lt); invl[qi] = 1.f / fmaxf(lt, 1e-30f); }
        {
            f32x4 o[4][4]; zero_acc(o);
            float carry = 0.f;
            attn_tiles(0, cmp_next, cmp_ptrs, [&](int ct, int kvoff) {
#pragma unroll 1
                for (int hf = 0; hf < 2; ++hf) {
                    f32x4 s[2][4];
                    attn_qk(s, lds, kvoff, w, fr, fq, hf);
                    const unsigned vm = attn_vmask(ct * 64 + hf * 32, fq, 0, hic);
#pragma unroll
                    for (int qi = 0; qi < 4; ++qi)
#pragma unroll
                        for (int ki = 0; ki < 2; ++ki)
#pragma unroll
                            for (int r = 0; r < 4; ++r) s[ki][qi][r] = ((vm >> (ki * 4 + r)) & 1u) ? fexp2(s[ki][qi][r] * SM_C - m[qi]) * invl[qi] : 0.f;
#pragma unroll
                    for (int ki = 0; ki < 2; ++ki) {
                        float a = 0.f, bq = 0.f;
#pragma unroll
                        for (int qi = 0; qi < 4; ++qi) { a += s[ki][qi][0] + s[ki][qi][1] + s[ki][qi][2] + 0.5f * s[ki][qi][3]; bq += 0.5f * s[ki][qi][3]; }
                        const float up = __shfl(bq, (lane + 48) & 63);
                        const float wrap = __shfl(carry, (lane + 48) & 63);
                        a += (fq >= 1) ? up : wrap;
                        carry = bq;
                        imp[(16 * w + fr) * 65 + 16 * ct + 8 * hf + 4 * ki + fq] = a;
                    }
                    attn_pv(o, s, lds, kvoff, fr, fq, hf);
                }
            }, lds, tid);
#pragma unroll
            for (int qi = 0; qi < 4; ++qi) gate[qi] = NG[((size_t)(kvrow + tq)) * 24 + (g * 4 + qi) * 3 + 0];
            const float quarter[4] = {0.25f, 0.25f, 0.25f, 0.25f};
            attn_accum(dstq, o, quarter, gate, true, fq);
        }
        vb_sync(lds);
        {
            const int q = tid >> 2, part = tid & 3;
            unsigned long long mk = 0ull;
            if (i <= 15) { mk = (i == 63) ? ~0ull : ((1ull << (i + 1)) - 1ull); }
            else {
                const float* row = imp + q * 65;
                for (int j = 1 + part; j <= i - 2; j += 4) {
                    const float vj = row[j]; int rank = 0;
                    for (int j2 = 1; j2 <= i - 2; ++j2) { const float v2 = row[j2]; rank += (v2 > vj || (v2 == vj && j2 < j)) ? 1 : 0; }
                    if (rank < 13) mk |= 1ull << j;
                }
                unsigned lo32 = (unsigned)mk, hi32 = (unsigned)(mk >> 32);
                lo32 |= __shfl_xor(lo32, 1); hi32 |= __shfl_xor(hi32, 1);
                lo32 |= __shfl_xor(lo32, 2); hi32 |= __shfl_xor(hi32, 2);
                mk = ((unsigned long long)hi32 << 32) | lo32;
                mk |= 1ull | (1ull << i) | (1ull << (i - 1));
            }
            if (part == 0) selm[q] = mk;
            unsigned lo32 = (unsigned)mk, hi32 = (unsigned)(mk >> 32);
#pragma unroll
            for (int o2 = 32; o2 >= 1; o2 >>= 1) { lo32 |= __shfl_xor(lo32, o2); hi32 |= __shfl_xor(hi32, o2); }
            if (lane == 0) uni[w] = ((unsigned long long)hi32 << 32) | lo32;
        }
        vb_sync(lds);
        const unsigned long long mymask = selm[16 * w + fr];
        const unsigned long long un = uni[0] | uni[1] | uni[2] | uni[3];
        vb_sync(lds);
        attn_load_q((const bf16_t*)(R + R_QR), pos, invf, b, g, t0, false, lds, tid);
        {
            f32x4 o[4][4]; zero_acc(o);
#pragma unroll
            for (int qi = 0; qi < 4; ++qi) { m[qi] = -1e30f; lsum[qi] = 0.f; }
            attn_tiles(0,
                [&](int j) { const unsigned long long rest = (j >= 63) ? 0ull : (un >> (j + 1)); return rest ? (j + 1 + (int)__ffsll((long long)rest) - 1) : -1; },
                [&](int j, const bf16_t*& Kb, const bf16_t*& Vb, int& vs) { Kb = Ks + (kvrow + j * 64) * 128 + g * 64; Vb = Vs + ((size_t)((b * 2 + g) * 64)) * SEQ + j * 64; vs = SEQ; },
                [&](int j, int kvoff) {
                    const bool lsel = ((mymask >> j) & 1ull) != 0ull;
                    const int hi = lsel ? tq : -1;
#pragma unroll 1
                    for (int hf = 0; hf < 2; ++hf) {
                        f32x4 s[2][4];
                        attn_qk(s, lds, kvoff, w, fr, fq, hf);
                        if (j < i) attn_softmax_full(s, o, m, lsum, lsel);
                        else { const unsigned vm = attn_vmask(j * 64 + hf * 32, fq, 0, hi); attn_softmax(s, o, m, lsum, vm); }
                        attn_pv(o, s, lds, kvoff, fr, fq, hf);
                    }
                }, lds, tid);
#pragma unroll
            for (int qi = 0; qi < 4; ++qi) gate[qi] = NG[((size_t)(kvrow + tq)) * 24 + (g * 4 + qi) * 3 + 1];
            attn_accum(dstq, o, lsum, gate, false, fq);
        }
        {
            f32x4 o[4][4]; zero_acc(o);
#pragma unroll
            for (int qi = 0; qi < 4; ++qi) { m[qi] = -1e30f; lsum[qi] = 0.f; }
            const int j0 = (i >= 8) ? (i - 8) : 0;
            attn_tiles(j0,
                [&](int j) { return (j + 1 <= i) ? j + 1 : -1; },
                [&](int j, const bf16_t*& Kb, const bf16_t*& Vb, int& vs) { Kb = Kw + (kvrow + j * 64) * 128 + g * 64; Vb = Vw + ((size_t)((b * 2 + g) * 64)) * SEQ + j * 64; vs = SEQ; },
                [&](int j, int kvoff) {
#pragma unroll 1
                    for (int hf = 0; hf < 2; ++hf) {
                        f32x4 s[2][4];
                        attn_qk(s, lds, kvoff, w, fr, fq, hf);
                        if (j >= i - 7 && j < i) attn_softmax_full(s, o, m, lsum, true);
                        else { const unsigned vm = attn_vmask(j * 64 + hf * 32, fq, tq - 511, tq); attn_softmax(s, o, m, lsum, vm); }
                        attn_pv(o, s, lds, kvoff, fr, fq, hf);
                    }
                }, lds, tid);
#pragma unroll
            for (int qi = 0; qi < 4; ++qi) gate[qi] = NG[((size_t)(kvrow + tq)) * 24 + (g * 4 + qi) * 3 + 2];
            attn_accum(dstq, o, lsum, gate, false, fq);
        }
    }
}

__device__ __forceinline__ void phase_glu(CKP& p, int l, unsigned char* lds) {
    const int tid = opaque_tid(), lane = tid & 63, w = tid >> 6, wm = w >> 1, wn = w & 1, fr = lane & 15, fq = lane >> 4;
    const bf16_t* A = (const bf16_t*)(p.ws + OFF_C + C_YG);
    const bf16_t* Bt = (const bf16_t*)(p.ws + OFF_W + W_GLU);
    bf16_t* O = (bf16_t*)(p.ws + OFF_C + C_S5O);
    const float* gb = p.in[24] + (size_t)l * 256;
    constexpr int NTM = NTOK / 128, NTN = 2;
    for (int L = VBID(); L < NTM * NTN; L += VGRID()) {
        int tm, tn; tile_coords(L, NTM, NTN, tm, tn);
        const int m0 = tm * 128, n0 = tn * 128;
        f32x4 acc[4][4]; zero_acc(acc);
        gemm_kloop(acc, [&](int r) { return A + (size_t)(m0 + r) * 256; }, 64, [&](int v) { return Bt + (size_t)(n0 + v) * 256; }, 64, 4, lds, tid);
#pragma unroll
        for (int mi = 0; mi < 4; ++mi) {
            const int row = m0 + 64 * wm + 16 * mi + fr, col = n0 + 64 * wn + 16 * fq;
            const u32x4 y0 = *(const u32x4*)(A + (size_t)row * 256 + col), y1 = *(const u32x4*)(A + (size_t)row * 256 + col + 8);
            const unsigned yy[8] = {y0.x, y0.y, y0.z, y0.w, y1.x, y1.y, y1.z, y1.w};
            float v[16];
#pragma unroll
            for (int e = 0; e < 16; ++e) {
                const float y = (e & 1) ? bfhi(yy[e >> 1]) : bflo(yy[e >> 1]);
                v[e] = y * sigm(acc[mi][e >> 2][e & 3] + gb[col + e]);
            }
            store16bf(O + (size_t)row * 256 + col, v);
        }
    }
}

struct G8Branch {
    static constexpr bool GATHER = false;
    const char* ws;
    __device__ __forceinline__ bool next(int i, G8Unit& u, const int (&R)[2], const unsigned (&C2)[2]) const {
        const int T = i / 6, sub = i - T * 6, L = T * (int)gridDim.x + (int)blockIdx.x;
        if (L >= (NTOK / 256) * 4) return false;
        int pm, pn; tile_coords(L, NTOK / 256, 4, pm, pn); pm = __builtin_amdgcn_readfirstlane(pm); pn = __builtin_amdgcn_readfirstlane(pn);
        const int br = sub >> 1;
        if (sub & 1) { u.K2 = 2048u; u.nt = 16; u.A0 = ws + OFF_H + (size_t)pm * 256 * 2048; u.B0 = ws + OFF_W + W_GB + (size_t)(br * 1024 + pn * 256) * 2048; }
        else {
            const unsigned k2 = br == 0 ? 1024u : 512u; u.K2 = k2; u.nt = br == 0 ? 8 : 4;
            const size_t b1 = (size_t)(br == 1), b2 = (size_t)(br == 2);
            const char* a = ws + (size_t)(OFF_C + C_ATT) + b1 * (size_t)(C_SGU - C_ATT) + b2 * (size_t)(C_S5O - C_ATT);
            const char* w = ws + (size_t)(OFF_W + W_A) + b1 * (size_t)(W_S - W_A) + b2 * (size_t)(W_5 - W_A);
            u.A0 = a + (size_t)pm * 256 * k2; u.B0 = w + (size_t)pn * 256 * k2;
        }
        u.A1 = u.A0 + (size_t)128 * u.K2; u.B1 = u.B0 + (size_t)128 * u.K2;
        u.x0 = pm; u.x1 = pn; u.x2 = sub; u.x3 = 0;
#pragma unroll
        for (int h = 0; h < 2; ++h)
#pragma unroll
            for (int k = 0; k < 2; ++k) u.ao[h][k] = (unsigned)R[k] * u.K2 + C2[k];
        return true;
    }
};
struct EpiBranch {
    bf16_t* Yt; bf16_t* Mg;
    __device__ __forceinline__ void operator()(const G8Acc& acc, const G8Unit& u, int wr, int wc, int fr, int fq) const {
        const int sub = u.x2;
        const size_t off0 = (size_t)(u.x0 * 256 + wr * 64 + fr) * 1024 + u.x1 * 256 + wc * 32 + 8 * fq;
        if (!(sub & 1)) {
#pragma unroll
            for (int ai = 0; ai < 2; ++ai)
#pragma unroll
                for (int m = 0; m < 4; ++m)
#pragma unroll
                    for (int bj = 0; bj < 2; ++bj) {
                        const f32x4 v0 = acc[ai][bj][m][0], v1 = acc[ai][bj][m][1];
                        u32x4 o; o.x = pk_bf16(v0[0], v0[1]); o.y = pk_bf16(v0[2], v0[3]); o.z = pk_bf16(v1[0], v1[1]); o.w = pk_bf16(v1[2], v1[3]);
                        *(u32x4*)(Yt + off0 + (size_t)(ai * 128 + m * 16) * 1024 + bj * 128) = o;
                    }
        } else {
#pragma unroll
            for (int ai = 0; ai < 2; ++ai) {
                u32x4 y[4][2], pv[4][2];
#pragma unroll
                for (int m = 0; m < 4; ++m)
#pragma unroll
                    for (int bj = 0; bj < 2; ++bj) {
                        const size_t off = off0 + (size_t)(ai * 128 + m * 16) * 1024 + bj * 128;
                        y[m][bj] = *(const u32x4*)(Yt + off);
                        pv[m][bj] = (u32x4){0u, 0u, 0u, 0u};
                        if (sub > 1) pv[m][bj] = *(const u32x4*)(Mg + off);
                    }
#pragma unroll
                for (int m = 0; m < 4; ++m)
#pragma unroll
                    for (int bj = 0; bj < 2; ++bj) {
                        const f32x4 v0 = acc[ai][bj][m][0], v1 = acc[ai][bj][m][1];
                        const u32x4 yy = y[m][bj], pp = pv[m][bj];
                        u32x4 o;
                        o.x = pk_bf16(sigm(v0[0]) * bflo(yy.x) + bflo(pp.x), sigm(v0[1]) * bfhi(yy.x) + bfhi(pp.x));
                        o.y = pk_bf16(sigm(v0[2]) * bflo(yy.y) + bflo(pp.y), sigm(v0[3]) * bfhi(yy.y) + bfhi(pp.y));
                        o.z = pk_bf16(sigm(v1[0]) * bflo(yy.z) + bflo(pp.z), sigm(v1[1]) * bfhi(yy.z) + bfhi(pp.z));
                        o.w = pk_bf16(sigm(v1[2]) * bflo(yy.w) + bflo(pp.w), sigm(v1[3]) * bfhi(yy.w) + bfhi(pp.w));
                        *(u32x4*)(Mg + off0 + (size_t)(ai * 128 + m * 16) * 1024 + bj * 128) = o;
                    }
            }
        }
    }
};
__device__ __forceinline__ void phase_branch(CKP& p, int l, unsigned char* lds) {
    G8Branch S{(const char*)p.ws};
    EpiBranch E{(bf16_t*)(p.ws + OFF_R), (bf16_t*)(p.ws + OFF_M)};
    g8_phase(S, E);
}

struct EpiMix {
    float* x;
    __device__ __forceinline__ void operator()(const G8Acc& acc, const G8Unit& u, int wr, int wc, int fr, int fq) const {
        float* xp0 = x + (size_t)(u.x0 * 256 + wr * 64 + fr) * 1024 + u.x1 * 256 + wc * 32 + 8 * fq;
#pragma unroll
        for (int ai = 0; ai < 2; ++ai) {
            f32x4 xv[4][2][2];
#pragma unroll
            for (int m = 0; m < 4; ++m)
#pragma unroll
                for (int bj = 0; bj < 2; ++bj)
#pragma unroll
                    for (int n = 0; n < 2; ++n) xv[m][bj][n] = *(const f32x4*)(xp0 + (size_t)(ai * 128 + m * 16) * 1024 + bj * 128 + 4 * n);
#pragma unroll
            for (int m = 0; m < 4; ++m)
#pragma unroll
                for (int bj = 0; bj < 2; ++bj)
#pragma unroll
                    for (int n = 0; n < 2; ++n) *(f32x4*)(xp0 + (size_t)(ai * 128 + m * 16) * 1024 + bj * 128 + 4 * n) = xv[m][bj][n] + acc[ai][bj][m][n];
        }
    }
};
__device__ __forceinline__ void phase_mix(CKP& p, int l, unsigned char* lds) {
    G8Plain S{(const char*)(p.ws + OFF_M), (const char*)(p.ws + OFF_W + W_M), 2048u, 16, NTOK / 256, 4};
    EpiMix E{p.xbuf};
    g8_phase(S, E);
}

__device__ __forceinline__ void phase_router(CKP& p, int l, unsigned char* lds, unsigned* ctl) {
    const int tid = opaque_tid(), lane = tid & 63, w = tid >> 6, wm = w >> 1, wn = w & 1, fr = lane & 15, fq = lane >> 4;
    const float* gam = p.in[27] + (size_t)l * 1024;
    const float* bg = p.in[29] + (size_t)l * 4;
    const float* be = p.in[31] + (size_t)l * 32;
    bf16_t* h2 = (bf16_t*)(p.ws + OFF_M);
    bf16_t* hlo = (bf16_t*)(p.ws + OFF_H);
    const bf16_t* Wh = (const bf16_t*)(p.ws + OFF_W + W_RH);
    const bf16_t* Wl = (const bf16_t*)(p.ws + OFF_W + W_RL);
    unsigned* cnt = ctl + CTL_MOECNT + l * 32;
    int* list = (int*)(p.ws + OFF_MOE + MOE_LIST);
    float* wsl = (float*)(p.ws + OFF_MOE + MOE_WS);
    float* lg = (float*)lds;
    int* lc = (int*)(lds + 18432); int* gbs = (int*)(lds + 18432 + 128);
    for (int tile = VBID(); tile < NTOK / 128; tile += VGRID()) {
        const int r0 = tile * 128;
        {
            f32x4 gv[4];
#pragma unroll
            for (int i = 0; i < 4; ++i) gv[i] = *(const f32x4*)(gam + 4 * lane + 256 * i);
            for (int rr = 0; rr < 32; rr += 2) {
                const int row = r0 + w * 32 + rr;
                f32x4 xa[4], xb[4]; float sa = 0.f, sb = 0.f;
#pragma unroll
                for (int i = 0; i < 4; ++i) { xa[i] = *(const f32x4*)(p.xbuf + (size_t)row * 1024 + 4 * lane + 256 * i); xb[i] = *(const f32x4*)(p.xbuf + (size_t)(row + 1) * 1024 + 4 * lane + 256 * i); }
#pragma unroll
                for (int i = 0; i < 4; ++i) { sa += xa[i][0] * xa[i][0] + xa[i][1] * xa[i][1] + xa[i][2] * xa[i][2] + xa[i][3] * xa[i][3]; sb += xb[i][0] * xb[i][0] + xb[i][1] * xb[i][1] + xb[i][2] * xb[i][2] + xb[i][3] * xb[i][3]; }
                sa = wave_sum(sa); sb = wave_sum(sb);
                const float ra_ = rsqrtf(sa * (1.f / 1024.f) + RMS_EPS), rb_ = rsqrtf(sb * (1.f / 1024.f) + RMS_EPS);
#pragma unroll
                for (int i = 0; i < 4; ++i) {
                    const f32x4 ha = xa[i] * ra_ * gv[i], hb = xb[i] * rb_ * gv[i];
                    u32x2 oa, ob, la, lb;
                    oa.x = pk_bf16(ha[0], ha[1]); oa.y = pk_bf16(ha[2], ha[3]); ob.x = pk_bf16(hb[0], hb[1]); ob.y = pk_bf16(hb[2], hb[3]);
                    la.x = pk_bf16(ha[0] - bflo(oa.x), ha[1] - bfhi(oa.x)); la.y = pk_bf16(ha[2] - bflo(oa.y), ha[3] - bfhi(oa.y));
                    lb.x = pk_bf16(hb[0] - bflo(ob.x), hb[1] - bfhi(ob.x)); lb.y = pk_bf16(hb[2] - bflo(ob.y), hb[3] - bfhi(ob.y));
                    *(u32x2*)(h2 + (size_t)row * 1024 + 4 * lane + 256 * i) = oa; *(u32x2*)(h2 + (size_t)(row + 1) * 1024 + 4 * lane + 256 * i) = ob;
                    *(u32x2*)(hlo + (size_t)row * 1024 + 4 * lane + 256 * i) = la; *(u32x2*)(hlo + (size_t)(row + 1) * 1024 + 4 * lane + 256 * i) = lb;
                }
            }
        }
        asm volatile("s_waitcnt vmcnt(0)" ::: "memory");
        vb_sync(lds);
        f32x4 acc[4][4]; zero_acc(acc);
        gemm_kloop(acc, [&](int r) { return h2 + (size_t)(r0 + r) * 1024; }, 64, [&](int v) { return Wh + (size_t)(v < 63 ? v : 63) * 1024; }, 64, 16, lds, tid);
        gemm_kloop(acc, [&](int r) { return h2 + (size_t)(r0 + r) * 1024; }, 64, [&](int v) { return Wl + (size_t)(v < 63 ? v : 63) * 1024; }, 64, 16, lds, tid);
        gemm_kloop(acc, [&](int r) { return hlo + (size_t)(r0 + r) * 1024; }, 64, [&](int v) { return Wh + (size_t)(v < 63 ? v : 63) * 1024; }, 64, 16, lds, tid);
        if (tid < 32) lc[tid] = 0;
        if (wn == 0 && fq < 3) {
#pragma unroll
            for (int mi = 0; mi < 4; ++mi) {
                const int row = 64 * wm + 16 * mi + fr;
#pragma unroll
                for (int e = 0; e < 16; ++e) { const int col = 16 * fq + e; if (col < 36) lg[row * 36 + col] = acc[mi][e >> 2][e & 3]; }
            }
        }
        vb_sync(lds);
        int e0 = 0, e1 = 0, lr0 = 0, lr1 = 0; float c0 = 0.f, c1 = 0.f;
        if (tid < 128) {
            const float* lrow = lg + tid * 36;
            float gl[4]; int grp = 0; float gm = -3.4e38f;
#pragma unroll
            for (int q = 0; q < 4; ++q) { gl[q] = lrow[q] + bg[q]; if (gl[q] > gm) { gm = gl[q]; grp = q; } }
            float gsum = 0.f;
#pragma unroll
            for (int q = 0; q < 4; ++q) gsum += expf(gl[q] - gm);
            const float grp_w = 1.f / gsum;
            float el[8]; float em = -3.4e38f;
#pragma unroll
            for (int q = 0; q < 8; ++q) { el[q] = lrow[4 + grp * 8 + q] + be[grp * 8 + q]; em = fmaxf(em, el[q]); }
            float esum = 0.f; float ep[8];
#pragma unroll
            for (int q = 0; q < 8; ++q) { ep[q] = expf(el[q] - em); esum += ep[q]; }
            int j0 = 0; float p0 = -1.f;
#pragma unroll
            for (int q = 0; q < 8; ++q) { const float pq = ep[q] / esum; ep[q] = pq; if (pq > p0) { p0 = pq; j0 = q; } }
            int j1 = 0; float p1 = -1.f;
#pragma unroll
            for (int q = 0; q < 8; ++q) { if (q != j0 && ep[q] > p1) { p1 = ep[q]; j1 = q; } }
            const float den = p0 + p1;
            c0 = grp_w * p0 / den; c1 = grp_w * p1 / den;
            e0 = grp * 8 + j0; e1 = grp * 8 + j1;
            lr0 = atomicAdd(&lc[e0], 1); lr1 = atomicAdd(&lc[e1], 1);
        }
        vb_sync(lds);
        if (tid < 32) { const int n = lc[tid]; gbs[tid] = n ? (int)atomicAdd(&cnt[tid], (unsigned)n) : 0; }
        vb_sync(lds);
        if (tid < 128) {
            const int tok = r0 + tid;
            list[e0 * 32768 + gbs[e0] + lr0] = tok * 2; list[e1 * 32768 + gbs[e1] + lr1] = tok * 2 + 1;
            wsl[tok * 2] = c0; wsl[tok * 2 + 1] = c1;
        }
        vb_sync(lds);
    }
}

__device__ __forceinline__ bool moe_unit(const unsigned* cnt, int i, int& e, int& mt, int& sub, int& rowbase, int& n) {
    int lane = threadIdx.x & 63; asm volatile("" : "+v"(lane));
    const int c = (lane < 32) ? (int)cnt[lane] : 0;
    const int nt = (c + 255) >> 8, nt128 = (c + 127) >> 7;
    int pre = nt, pre128 = nt128;
#pragma unroll
    for (int o = 1; o < 32; o <<= 1) {
        const int src = (lane - o) << 2;
        const int v = __builtin_amdgcn_ds_bpermute(src, pre), v2 = __builtin_amdgcn_ds_bpermute(src, pre128);
        if (lane >= o) { pre += v; pre128 += v2; }
    }
    const int total = __builtin_amdgcn_readlane(pre, 31) * 4;
    const int Lp = i * (int)gridDim.x + (int)blockIdx.x, q = (total + 7) >> 3, off = Lp >> 3;
    const int L = (Lp & 7) * q + off;
    if (off >= q || L >= total) return false;
    const int excl = pre - nt;
    const bool mine = (lane < 32) && (L >= excl * 4) && (L < pre * 4);
    const unsigned long long bal = __ballot(mine);
    if (bal == 0ull) return false;
    const int ee = __builtin_amdgcn_readfirstlane(__ffsll((long long)bal) - 1);
    e = ee;
    n = __builtin_amdgcn_readlane(c, ee);
    rowbase = __builtin_amdgcn_readlane(pre128 - nt128, ee) * 128;
    const int r = L - __builtin_amdgcn_readlane(excl, ee) * 4;
    mt = r >> 2; sub = r & 3;
    return true;
}
struct G8Exp1 {
    static constexpr bool GATHER = true;
    const unsigned* cnt; const int* list; const char* h2; const char* Wg; const char* Wu;
    __device__ __forceinline__ bool next(int i, G8Unit& u, const int (&R)[2], const unsigned (&C2)[2]) const {
        int e, mt, sub, rowbase, n;
        if (!moe_unit(cnt, i, e, mt, sub, rowbase, n)) return false;
        u.A0 = h2; u.A1 = h2; u.K2 = 2048u; u.nt = 16;
        u.B0 = Wg + ((size_t)e * 512 + sub * 128) * 2048; u.B1 = Wu + ((size_t)e * 512 + sub * 128) * 2048;
        u.x0 = e; u.x1 = mt; u.x2 = sub; u.x3 = rowbase; u.n = n;
#pragma unroll
        for (int h = 0; h < 2; ++h)
#pragma unroll
            for (int k = 0; k < 2; ++k) { int sidx = mt * 256 + h * 128 + R[k]; sidx = sidx < n ? sidx : n - 1; u.ao[h][k] = (unsigned)(list[e * 32768 + sidx] >> 1) * 2048u + C2[k]; }
        return true;
    }
};
struct EpiExp1 {
    bf16_t* hid;
    __device__ __forceinline__ void operator()(const G8Acc& acc, const G8Unit& u, int wr, int wc, int fr, int fq) const {
#pragma unroll
        for (int ai = 0; ai < 2; ++ai)
#pragma unroll
            for (int m = 0; m < 4; ++m) {
                const int r = u.x1 * 256 + ai * 128 + wr * 64 + m * 16 + fr;
                if (r < u.n) {
                    float hv[8];
#pragma unroll
                    for (int j = 0; j < 8; ++j) { const float g = acc[ai][0][m][j >> 2][j & 3], up = acc[ai][1][m][j >> 2][j & 3]; hv[j] = g * sigm(g) * up; }
                    u32x4 o; o.x = pk_bf16(hv[0], hv[1]); o.y = pk_bf16(hv[2], hv[3]); o.z = pk_bf16(hv[4], hv[5]); o.w = pk_bf16(hv[6], hv[7]);
                    *(u32x4*)(hid + (size_t)(u.x3 + r) * 512 + u.x2 * 128 + wc * 32 + 8 * fq) = o;
                }
            }
    }
};
__device__ __forceinline__ void phase_exp1(CKP& p, int l, unsigned char* lds, unsigned* ctl) {
    G8Exp1 S{ctl + CTL_MOECNT + l * 32, (const int*)(p.ws + OFF_MOE + MOE_LIST), (const char*)(p.ws + OFF_M), (const char*)(p.ws + OFF_W + W_EG), (const char*)(p.ws + OFF_W + W_EU)};
    EpiExp1 E{(bf16_t*)(p.ws + OFF_HID)};
    g8_phase(S, E);
}
struct G8Exp2 {
    static constexpr bool GATHER = true;
    const unsigned* cnt; const char* hid; const char* Wd;
    __device__ __forceinline__ bool next(int i, G8Unit& u, const int (&R)[2], const unsigned (&C2)[2]) const {
        int e, mt, sub, rowbase, n;
        if (!moe_unit(cnt, i, e, mt, sub, rowbase, n)) return false;
        u.A0 = hid + (size_t)(rowbase + mt * 256) * 1024; u.A1 = u.A0; u.K2 = 1024u; u.nt = 8;
        u.B0 = Wd + ((size_t)e * 1024 + sub * 256) * 1024; u.B1 = u.B0 + (size_t)128 * 1024;
        u.x0 = e; u.x1 = mt; u.x2 = sub; u.x3 = rowbase; u.n = n;
        const int lim = n - mt * 256 - 1;
#pragma unroll
        for (int h = 0; h < 2; ++h)
#pragma unroll
            for (int k = 0; k < 2; ++k) { const int rr = h * 128 + R[k]; u.ao[h][k] = (unsigned)(rr < lim ? rr : lim) * 1024u + C2[k]; }
        return true;
    }
};
struct EpiExp2 {
    const int* list; const float* wsl; bf16_t* ys;
    __device__ __forceinline__ void operator()(const G8Acc& acc, const G8Unit& u, int wr, int wc, int fr, int fq) const {
        int slot[2][4]; float wt[2][4];
#pragma unroll
        for (int ai = 0; ai < 2; ++ai)
#pragma unroll
            for (int m = 0; m < 4; ++m) { int r = u.x1 * 256 + ai * 128 + wr * 64 + m * 16 + fr; r = r < u.n ? r : u.n - 1; slot[ai][m] = list[u.x0 * 32768 + r]; }
#pragma unroll
        for (int ai = 0; ai < 2; ++ai)
#pragma unroll
            for (int m = 0; m < 4; ++m) wt[ai][m] = wsl[slot[ai][m]];
#pragma unroll
        for (int ai = 0; ai < 2; ++ai)
#pragma unroll
            for (int m = 0; m < 4; ++m) {
                const int r = u.x1 * 256 + ai * 128 + wr * 64 + m * 16 + fr;
                if (r < u.n) {
                    bf16_t* dst = ys + (size_t)slot[ai][m] * 1024 + u.x2 * 256 + wc * 32 + 8 * fq;
                    const float w = wt[ai][m];
#pragma unroll
                    for (int bj = 0; bj < 2; ++bj) {
                        const f32x4 v0 = acc[ai][bj][m][0] * w, v1 = acc[ai][bj][m][1] * w;
                        u32x4 o; o.x = pk_bf16(v0[0], v0[1]); o.y = pk_bf16(v0[2], v0[3]); o.z = pk_bf16(v1[0], v1[1]); o.w = pk_bf16(v1[2], v1[3]);
                        *(u32x4*)(dst + bj * 128) = o;
                    }
                }
            }
    }
};
__device__ __forceinline__ void phase_exp2(CKP& p, int l, unsigned char* lds, unsigned* ctl) {
    G8Exp2 S{ctl + CTL_MOECNT + l * 32, (const char*)(p.ws + OFF_HID), (const char*)(p.ws + OFF_W + W_ED)};
    EpiExp2 E{(const int*)(p.ws + OFF_MOE + MOE_LIST), (const float*)(p.ws + OFF_MOE + MOE_WS), (bf16_t*)(p.ws + OFF_YS)};
    g8_phase(S, E);
}

constexpr int PH_PER_LAYER = 10;
constexpr int NPHASE = PH_PER_LAYER * DEPTH + 1;

__global__ __attribute__((target("no-packed-fp32-ops"))) void __launch_bounds__(NTHR_HW, 1) mega(KP p_unused) {
    extern __shared__ __attribute__((aligned(16))) unsigned char lds_all[];
    if ((threadIdx.x & 255) == 0) *(volatile unsigned*)(lds_all + VB_CTR + ((threadIdx.x >> 8) << 6)) = 0u;
    __syncthreads();
    unsigned* ctl = (unsigned*)(p_unused.ws + OFF_CTL);
#if ONE_LAUNCH
    XcdBarrier xb = xcd_barrier_post(ctl + CTL_BAR, (volatile LAS unsigned*)(lds_all + 2 * VB_LDS - 16));
    if (p_unused.never) cg::this_grid().sync();
#if DBG_PREFLUSH
    __builtin_amdgcn_fence(__ATOMIC_RELEASE, "");
    asm volatile("s_waitcnt vmcnt(0)" ::: "memory");
    __builtin_amdgcn_fence(__ATOMIC_ACQUIRE, "");
    asm volatile("s_waitcnt vmcnt(0)" ::: "memory");
    xcd_barrier(xb);
    { const unsigned long long t0 = __builtin_amdgcn_s_memrealtime(); while (__builtin_amdgcn_s_memrealtime() - t0 < 20000ull) __builtin_amdgcn_s_sleep(8); }
    xcd_barrier(xb);
#endif
#endif
    CKP* kp0 = (CKP*)__builtin_amdgcn_kernarg_segment_ptr();
    const int ph_lo = kp0->ph_lo, ph_hi = kp0->ph_hi;
#if ONE_LAUNCH
#define PH_SYNC(PH) if ((PH) + 1 < ph_hi) xcd_barrier(xb);
#else
#define PH_SYNC(PH)
#endif
#if DBG_TIMEPH >= 0
#define PH_STAMP(PH) if (blockIdx.x == 0 && threadIdx.x == 0) ((unsigned long long*)(kp0->ws + OFF_CTL + 24576))[(PH)] = __builtin_amdgcn_s_memrealtime();
#else
#define PH_STAMP(PH)
#endif
#define RUN_PHASE(PH, CALL) if (ph_lo <= (PH) && (PH) < ph_hi) { PH_STAMP(PH) CKP* kp = kp0; asm volatile("" : "+s"(kp)); CKP& p = *kp; const int rep_ = 0; (void)rep_; unsigned char* lds = vb_lds(); CALL; \
    if ((PH) == DBG_REPEAT_PH) { xcd_barrier(xb); const int rep_ = 1; (void)rep_; CALL; } PH_SYNC(PH) }
#define RUN_LAYER(L) \
    RUN_PHASE((L) * 10 + 0, phase_prep(p, (L), lds)) \
    RUN_PHASE((L) * 10 + 1, phase_inproj(p, (L), lds)) \
    RUN_PHASE((L) * 10 + 2, phase_mid1(p, (L), lds)) \
    RUN_PHASE((L) * 10 + 3, phase_attn(p, (L), lds, ctl + 2 * rep_)) \
    RUN_PHASE((L) * 10 + 4, phase_glu(p, (L), lds)) \
    RUN_PHASE((L) * 10 + 5, phase_branch(p, (L), lds)) \
    RUN_PHASE((L) * 10 + 6, phase_mix(p, (L), lds)) \
    RUN_PHASE((L) * 10 + 7, phase_router(p, (L), lds, ctl)) \
    RUN_PHASE((L) * 10 + 8, phase_exp1(p, (L), lds, ctl)) \
    RUN_PHASE((L) * 10 + 9, phase_exp2(p, (L), lds, ctl))
#if DBG_SMALLK
    RUN_PHASE(0, phase_prep(p, 0, lds))
    RUN_PHASE(1, phase_inproj(p, 0, lds))
    RUN_PHASE(2, phase_mid1(p, 0, lds))
#else
    RUN_LAYER(0)
    RUN_LAYER(1)
    RUN_PHASE(20, phase_prep(p, 2, lds))
#endif
#if ONE_LAUNCH && DBG_DUMP
    {
        xcd_barrier(xb);
        CKP* kp = kp0; asm volatile("" : "+s"(kp)); CKP& p = *kp;
        const size_t NO = (size_t)NTOK * 1024;
        const unsigned char* src = p.ws + DBG_DUMP_OFF;
        for (size_t i = (size_t)blockIdx.x * NTHR_HW + threadIdx.x; i < NO; i += (size_t)gridDim.x * NTHR_HW) {
            float v = 0.f;
            if (i < (size_t)DBG_DUMP_N) {
                if (DBG_DUMP_F32) {
                    const size_t si = DBG_DUMP_REV ? ((size_t)DBG_DUMP_N - 1 - i) : i;
#if DBG_SC1READ
                    const unsigned fu = __hip_atomic_load((const unsigned*)src + si, __ATOMIC_RELAXED, __HIP_MEMORY_SCOPE_SYSTEM); const float f = __uint_as_float(fu);
#else
                    const float f = ((const float*)src)[si];
#endif
                    v = DBG_HASH ? (float)(__float_as_uint(f) & 0x3ff) : f;
#if DBG_EFILT
                    { const int id_ = (int)(((si >> 7) - DBG_IDROT) & 2047), blk = ((id_ >> 2) + 320) & 511; if (!(blk >= DBG_EFILT_LO && blk < DBG_EFILT_HI)) v = 0.f; }
#endif
#if DBG_E2
                    { const float f2 = ((const float*)(p.ws + OFF_C + C_ATT))[i]; v = (__float_as_uint(f2) == __float_as_uint(f)) ? 0.f : 1000.f; if (i == 0) v += 1.f; }
#endif
                }
                else { const bf16_t h = ((const bf16_t*)src)[i]; v = DBG_HASH ? (float)(h & 0x3ff) : bf2f(h); }
            }
#if DBG_CONSTOUT
            v = 1000.f + (float)(i & 1023);
#endif
            p.xbuf[i] = v;
        }
    }
#endif
}

#if DBG_DUMP
__global__ void dbg_dump(const bf16_t* src, size_t n, float* out, size_t nout) {
    for (size_t i = (size_t)blockIdx.x * blockDim.x + threadIdx.x; i < nout; i += (size_t)gridDim.x * blockDim.x)
        out[i] = i < n ? (DBG_HASH ? (float)(src[i] & 0x3ff) : bf2f(src[i])) : 0.f;
}
__global__ void dbg_dump_f32(const float* src, size_t n, float* out, size_t nout) {
    for (size_t i = (size_t)blockIdx.x * blockDim.x + threadIdx.x; i < nout; i += (size_t)gridDim.x * blockDim.x)
        out[i] = i < n ? (DBG_HASH ? (float)(__float_as_uint(src[i]) & 0x3ff) : src[i]) : 0.f;
}
#endif
extern "C" void kernel_launch(void* const* d_in, const int* in_sizes, int n_in, void* d_out, int out_size, void* d_ws, size_t ws_size, hipStream_t stream) {
    static int grid = 0;
    if (grid == 0) {
        if (n_in != 36 || out_size != NTOK * DM || ws_size < WS_END) { fprintf(stderr, "kernel_launch: unexpected shapes n_in %d out %d ws %zu (need %zu)\n", n_in, out_size, ws_size, (size_t)WS_END); grid = -1; return; }
        int dev = 0, cus = 0, per_cu = 0;
        hipGetDevice(&dev);
        hipDeviceGetAttribute(&cus, hipDeviceAttributeMultiprocessorCount, dev);
        hipFuncSetAttribute((const void*)mega, hipFuncAttributeMaxDynamicSharedMemorySize, LDS_BYTES);
        hipOccupancyMaxActiveBlocksPerMultiprocessor(&per_cu, (const void*)mega, NTHR_HW, LDS_BYTES);
        if (per_cu < 1) { fprintf(stderr, "kernel_launch: occupancy query says %d\n", per_cu); per_cu = 1; }
        if (per_cu > MAX_PER_CU) per_cu = MAX_PER_CU;
        grid = cus * per_cu;
        fprintf(stderr, "kernel_launch: grid %d (%d CUs x %d)\n", grid, cus, per_cu);
    }
    if (grid < 0) return;
    hipMemsetAsync((char*)d_ws + OFF_CTL, 0, CTL_BYTES, stream);
    KP p{};
    for (int i = 0; i < 36; ++i) p.in[i] = (const float*)d_in[i];
    p.xbuf = (float*)d_out; p.ws = (unsigned char*)d_ws;
    for (int i = 0; i < 8; ++i) p.inv_freq[i] = (float)pow(500000.0, -(double)i / 8.0);
    p.never = 0; p.pad = 0;
#if ONE_LAUNCH
    p.ph_lo = 0; p.ph_hi = DBG_PH_HI;
    void* args[] = {&p};
    hipError_t e = hipLaunchCooperativeKernel((const void*)mega, dim3(grid), dim3(NTHR_HW), args, LDS_BYTES, stream);
    if (e != hipSuccess) fprintf(stderr, "cooperative launch failed: %s (grid %d)\n", hipGetErrorString(e), grid);
#else
    for (int ph = 0; ph < NPHASE; ++ph) {
        if (!((DBG_MASK >> ph) & 1)) continue;
        p.ph_lo = ph; p.ph_hi = ph + 1;
        hipLaunchKernelGGL(mega, dim3(grid), dim3(NTHR_HW), LDS_BYTES, stream, p);
    }
#if DBG_DUMP
    {
        const unsigned char* w = (const unsigned char*)d_ws; const size_t NO = (size_t)NTOK * 1024;
        size_t off = 0, n = 0; bool f32 = false;
        switch (DBG_DUMP) {
            case 1: off = OFF_C + C_ATT; n = (size_t)NTOK * 512; break;
            case 2: off = OFF_C + C_SGU; n = (size_t)NTOK * 256; break;
            case 3: off = OFF_C + C_S5O; n = (size_t)NTOK * 256; break;
            case 4: off = OFF_M; n = (size_t)NTOK * 1024; break;
            case 5: off = OFF_R + R_Q; n = (size_t)NTOK * 512; break;
            case 6: off = OFF_H; n = (size_t)NTOK * 1024; break;
            case 7: off = OFF_C + C_YG; n = (size_t)NTOK * 256; break;
            case 8: off = OFF_C + C_KCMP; n = (size_t)2 * 524288 / 2; break;
            case 9: off = OFF_R + R_KC; n = (size_t)NTOK * 128 * 6; break;
            case 10: off = OFF_R + R_NG; n = (size_t)NTOK * 24; f32 = true; break;
            case 11: off = OFF_R + R_U; n = (size_t)NTOK * 768; break;
            case 12: off = OFF_C + C_S5E; n = (size_t)128 * 16 * 64 * 2; f32 = true; break;
            case 15: off = 0; n = (size_t)NTOK * 1024; f32 = true; break;
            case 16: off = OFF_W + W_S5A; n = 36864; f32 = true; break;
            case 13: off = OFF_YS; n = (size_t)NTOK * 1024; break;
            case 14: off = OFF_MOE + MOE_WS; n = 65536; f32 = true; break;
            default: break;
        }
        if (DBG_DUMP == 15) hipLaunchKernelGGL(dbg_dump_f32, dim3(2048), dim3(256), 0, stream, (const float*)d_out, n, (float*)d_out, NO);
        else if (f32) hipLaunchKernelGGL(dbg_dump_f32, dim3(2048), dim3(256), 0, stream, (const float*)(w + off), n, (float*)d_out, NO);
        else hipLaunchKernelGGL(dbg_dump, dim3(2048), dim3(256), 0, stream, (const bf16_t*)(w + off), n, (float*)d_out, NO);
    }
#endif
#endif
}
```

```cpp
#include <hip/hip_runtime.h>
#include <hip/hip_cooperative_groups.h>
#include <cstdio>
#include <cstdint>
#include <cmath>
namespace cg = cooperative_groups;

#ifndef ONE_LAUNCH
#define ONE_LAUNCH 1
#endif
#ifndef DBG_MASK
#define DBG_MASK 0x1fffff
#endif
#ifndef DBG_NOCOMBINE
#define DBG_NOCOMBINE 0
#endif
#ifndef DBG_DUMP
#define DBG_DUMP 0
#endif
#ifndef DBG_HASH
#define DBG_HASH 0
#endif
#ifndef DBG_ONLYS5
#define DBG_ONLYS5 0
#endif
#ifndef DBG_NOCSTORE
#define DBG_NOCSTORE 0
#endif
#ifndef DBG_LDSCHK
#define DBG_LDSCHK 0
#endif
#ifndef DBG_TWICE
#define DBG_TWICE 0
#endif
#ifndef DBG_S5CONST
#define DBG_S5CONST 0
#endif
#ifndef DBG_SC1READ
#define DBG_SC1READ 0
#endif
#ifndef DBG_E2
#define DBG_E2 0
#endif
#ifndef DBG_JOBFENCE
#define DBG_JOBFENCE 0
#endif
#ifndef DBG_CONSTOUT
#define DBG_CONSTOUT 0
#endif
#ifndef DBG_QDELAY
#define DBG_QDELAY 0
#endif
#ifndef DBG_SMALLK
#define DBG_SMALLK 0
#endif
#ifndef DBG_REPEAT_PH
#define DBG_REPEAT_PH -1
#endif
#ifndef DBG_TIMEPH
#define DBG_TIMEPH -1
#endif
#ifndef DBG_TIMEPH2
#define DBG_TIMEPH2 (DBG_TIMEPH + 1)
#endif
#ifndef DBG_PRESPIN
#define DBG_PRESPIN 0
#endif
#ifndef DBG_SGUSPIN
#define DBG_SGUSPIN 0
#endif
#ifndef DBG_PREFLUSH
#define DBG_PREFLUSH 0
#endif
#ifndef DBG_ESC1
#define DBG_ESC1 0
#endif
#ifndef DBG_DELAY
#define DBG_DELAY 0
#endif
#ifndef DBG_IDROT
#define DBG_IDROT 0
#endif
#ifndef DBG_DUMP_REV
#define DBG_DUMP_REV 0
#endif
#ifndef DBG_SGUCUT
#define DBG_SGUCUT 0
#endif
#ifndef DBG_EFILT
#define DBG_EFILT 0
#define DBG_EFILT_LO 0
#define DBG_EFILT_HI 0
#endif
#ifndef DBG_DUMP_OFF
#define DBG_DUMP_OFF 0
#define DBG_DUMP_N 0
#define DBG_DUMP_F32 0
#endif
#ifndef DBG_PH_HI
#define DBG_PH_HI NPHASE
#endif

typedef unsigned short bf16_t;
typedef short bf16x8 __attribute__((ext_vector_type(8)));
typedef float f32x4 __attribute__((ext_vector_type(4)));
typedef unsigned u32x4 __attribute__((ext_vector_type(4)));
typedef unsigned u32x2 __attribute__((ext_vector_type(2)));

constexpr int DM = 1024, NB = 8, SEQ = 4096, NTOK = NB * SEQ, DEPTH = 2;
constexpr int NCMP = 255;
constexpr float RMS_EPS = 1e-6f;
constexpr int NTHR = 256;
constexpr int NTHR_HW = 512;
constexpr int VB_LDS = 68096;
constexpr int LDS_BAR = 67584;
#ifndef MAX_PER_CU
#define MAX_PER_CU 1
#endif
#ifndef LDS_TOTAL
#define LDS_TOTAL (2 * 68096 + 128)
#endif
constexpr int LDS_BYTES = LDS_TOTAL;

constexpr size_t OFF_CTL = 0;
constexpr size_t OFF_W = 65536;
constexpr size_t W_IN = 0, W_GB = 4456448, W_A = 10747904, W_S = 11796480, W_5 = 12320768, W_M = 12845056, W_GLU = 14942208,
                 W_C1 = 15073280, W_C2 = 16121856, W_PB = 16154624, W_SGU = 16155648, W_S5A = 16286720, W_S5A256 = 16294912,
                 W_S5B = 16303104, W_S5C = 16434176, W_RH = 16499712, W_RL = 16630784, W_EG = 16777216, W_EU = 50331648, W_ED = 83886080, W_END = 117440512;
constexpr size_t OFF_H = OFF_W + W_END;
constexpr size_t OFF_M = OFF_H + 67108864;
constexpr size_t OFF_R = OFF_M + 67108864;
constexpr size_t R_Q = 0, R_KC = 33554432, R_VC = 41943040, R_KS = 50331648, R_KW = 58720256, R_VST = 67108864, R_VWT = 75497472,
                 R_NG = 83886080, R_U = 87031808, R_V = 103809024, R_S5IN = 120586240, R_QR = 137363456, R_END = 170917888;
constexpr size_t OFF_C = OFF_R + R_END;
constexpr size_t C_ATT = 0, C_SGU = 33554432, C_YG = 50331648, C_S5O = 67108864, C_KCMP = 83886080, C_VCT = 84410368, C_S5E = 84934656, C_END = 85983232;
constexpr size_t OFF_MOE = OFF_C + C_END;
constexpr size_t MOE_LIST = 0, MOE_WS = 4194304, MOE_END = 4456448;
constexpr size_t OFF_ROPE = OFF_MOE + MOE_END;
constexpr size_t WS_END = OFF_ROPE + (size_t)NTOK * 64;
constexpr size_t OFF_HID = OFF_R;
constexpr size_t OFF_YS = OFF_R + 71303168;
static_assert(OFF_YS + 134217728 <= OFF_C + C_KCMP, "alias overflow");

constexpr int CTL_BAR = 0;
constexpr int CTL_MOECNT = 4096;
constexpr int CTL_ATTN = 4096 + 64;
constexpr int CTL_BYTES = 32768;

struct KP {
    const float* in[36];
    float* xbuf;
    unsigned char* ws;
    float inv_freq[8];
    int ph_lo, ph_hi;
    int never;
    int pad;
};

typedef const KP __attribute__((address_space(4))) CKP;

typedef float f32x2_t __attribute__((ext_vector_type(2)));
typedef __bf16 bf16x2_t __attribute__((ext_vector_type(2)));
__device__ __forceinline__ unsigned pk_bf16(float lo, float hi) {
    const f32x2_t v = {lo, hi};
    union { bf16x2_t b; unsigned u; } x; x.b = __builtin_convertvector(v, bf16x2_t); return x.u;
}
__device__ __forceinline__ bf16_t f2bf(float f) { return (bf16_t)(pk_bf16(f, 0.f) & 0xffffu); }
__device__ __forceinline__ float bf2f(bf16_t b) { return __uint_as_float(((unsigned)b) << 16); }
__device__ __forceinline__ float bflo(unsigned u) { return __uint_as_float(u << 16); }
__device__ __forceinline__ float bfhi(unsigned u) { return __uint_as_float(u & 0xffff0000u); }
__device__ __forceinline__ float fexp2(float x) { return __builtin_amdgcn_exp2f(x); }
__device__ __forceinline__ float gelu_tanh(float x) {
    const float u = 0.7978845608028654f * (x + 0.044715f * x * x * x);
    const float e = fexp2(2.885390081777927f * u);
    const float t = 1.f - 2.f * __builtin_amdgcn_rcpf(e + 1.f);
    return 0.5f * x * (1.f + t);
}
__device__ __forceinline__ float sigm(float x) { return __builtin_amdgcn_rcpf(1.f + fexp2(-1.4426950408889634f * x)); }
__device__ __forceinline__ int opaque_tid() { int t = threadIdx.x & 255; asm volatile("" : "+v"(t)); return t; }
__device__ __forceinline__ int VBID() { return (int)blockIdx.x * 2 + (int)(threadIdx.x >> 8); }
__device__ __forceinline__ int VGRID() { return (int)gridDim.x * 2; }
constexpr int VB_CTR = 2 * 68096;
__device__ __forceinline__ unsigned char* lds_base() { extern __shared__ __attribute__((aligned(16))) unsigned char lds_all_[]; return lds_all_; }
__device__ __forceinline__ unsigned char* vb_lds() { int t = threadIdx.x; asm volatile("" : "+v"(t)); return lds_base() + (t >> 8) * VB_LDS; }
__device__ __forceinline__ void vb_sync(unsigned char* lds) {
    asm volatile("s_waitcnt lgkmcnt(0)" ::: "memory");
    if ((threadIdx.x & 63) == 0) {
        __attribute__((address_space(3))) unsigned* c = (__attribute__((address_space(3))) unsigned*)(lds_base() + VB_CTR + ((threadIdx.x >> 8) << 6));
        const unsigned old = __hip_atomic_fetch_add(c, 1u, __ATOMIC_RELAXED, __HIP_MEMORY_SCOPE_WORKGROUP);
        const unsigned target = (old & ~3u) + 4u;
        while ((int)(__hip_atomic_load(c, __ATOMIC_RELAXED, __HIP_MEMORY_SCOPE_WORKGROUP) - target) < 0) { }
    }
    asm volatile("" ::: "memory");
}
__device__ __forceinline__ void job_fence() {
#if DBG_JOBFENCE
#endif
}
__device__ __forceinline__ float wave_sum(float v) {
#pragma unroll
    for (int o = 32; o >= 1; o >>= 1) v += __shfl_xor(v, o);
    return v;
}
__device__ __forceinline__ float xmax16(float x) { const unsigned u = __float_as_uint(x); auto r = __builtin_amdgcn_permlane16_swap(u, u, false, false); return fmaxf(__uint_as_float(r[0]), __uint_as_float(r[1])); }
__device__ __forceinline__ float xmax32(float x) { const unsigned u = __float_as_uint(x); auto r = __builtin_amdgcn_permlane32_swap(u, u, false, false); return fmaxf(__uint_as_float(r[0]), __uint_as_float(r[1])); }
__device__ __forceinline__ float xsum16(float x) { const unsigned u = __float_as_uint(x); auto r = __builtin_amdgcn_permlane16_swap(u, u, false, false); return __uint_as_float(r[0]) + __uint_as_float(r[1]); }
__device__ __forceinline__ float xsum32(float x) { const unsigned u = __float_as_uint(x); auto r = __builtin_amdgcn_permlane32_swap(u, u, false, false); return __uint_as_float(r[0]) + __uint_as_float(r[1]); }
__device__ __forceinline__ f32x4 mfma16(bf16x8 a, bf16x8 b, f32x4 c) { return __builtin_amdgcn_mfma_f32_16x16x32_bf16(a, b, c, 0, 0, 0); }
__device__ __forceinline__ bf16x8 as_bf8(u32x4 v) { union { u32x4 u; bf16x8 b; } x; x.u = v; return x.b; }
__device__ __forceinline__ void store16bf(bf16_t* dst, const float (&v)[16]) {
    u32x4 a, b;
    a.x = pk_bf16(v[0], v[1]); a.y = pk_bf16(v[2], v[3]); a.z = pk_bf16(v[4], v[5]); a.w = pk_bf16(v[6], v[7]);
    b.x = pk_bf16(v[8], v[9]); b.y = pk_bf16(v[10], v[11]); b.z = pk_bf16(v[12], v[13]); b.w = pk_bf16(v[14], v[15]);
    *(u32x4*)dst = a; *(u32x4*)(dst + 8) = b;
}

#ifndef XB_SCOPE
#define XB_SCOPE "agent"
#endif
#define XB_TMO      128
#define XB_XCNT(j)  (256  + 64 * (j))
#define XB_XSUB(j)  (1280 + 64 * (j))
#define XB_XGEN(j)  (2304 + 64 * (j))
#define XB_TOP      3328
#define XB_TOPGEN   3392
#define XCD_BAR_WORDS 3456
#define XB_SPIN_CAP (1u << 22)
#define LAS __attribute__((address_space(3)))
__device__ __forceinline__ unsigned xb_ld(unsigned* p)              { return __hip_atomic_load(p, __ATOMIC_RELAXED, __HIP_MEMORY_SCOPE_AGENT); }
__device__ __forceinline__ unsigned xb_add(unsigned* p, unsigned v) { return __hip_atomic_fetch_add(p, v, __ATOMIC_RELAXED, __HIP_MEMORY_SCOPE_AGENT); }
__device__ __forceinline__ unsigned xb_xcc_id() { return (unsigned)__builtin_amdgcn_s_getreg((3 << 11) | 20) & 0xFu; }
#define XB_SPIN(cond, bar) do { unsigned _sp = 0; while (cond) { __builtin_amdgcn_s_sleep(1); \
    if ((++_sp & 255u) == 0u) { if (xb_ld(&(bar)[XB_TMO])) break; if (_sp > XB_SPIN_CAP) { atomicAdd(&(bar)[XB_TMO], 1u); break; } } } } while (0)
struct XcdBarrier { unsigned* bar; unsigned x; volatile LAS unsigned* st; unsigned nloc, nx; };
__device__ __forceinline__ XcdBarrier xcd_barrier_post(unsigned* bar, volatile LAS unsigned* st) {
    XcdBarrier b; b.bar = bar; b.x = xb_xcc_id(); b.st = st; b.nloc = 0u; b.nx = 0u;
    if (threadIdx.x == 0) (void)xb_add(&bar[XB_XCNT(b.x)], 1u);
    return b;
}
__device__ __forceinline__ void xcd_barrier_complete(unsigned* bar, unsigned x, unsigned& nloc, unsigned& nx) {
    const unsigned G = gridDim.x * gridDim.y * gridDim.z;
    unsigned sum, cnt, mine, sp = 0u;
    for (;;) {
        sum = 0u; cnt = 0u; mine = 0u;
#pragma unroll
        for (unsigned j = 0; j < 16; ++j) { const unsigned c = xb_ld(&bar[XB_XCNT(j)]); sum += c; cnt += (c > 0u) ? 1u : 0u; mine = (j == x) ? c : mine; }
        if (sum == G) break;
        __builtin_amdgcn_s_sleep(1);
        if ((++sp & 255u) == 0u) { if (xb_ld(&bar[XB_TMO])) break; if (sp > XB_SPIN_CAP) { atomicAdd(&bar[XB_TMO], 1u); break; } }
    }
    nloc = mine > 0u ? mine : 1u; nx = cnt > 0u ? cnt : 1u;
}
__device__ __forceinline__ void xcd_barrier(XcdBarrier& b) {
    asm volatile("s_waitcnt vmcnt(0)" ::: "memory");
    __syncthreads();
    if (threadIdx.x == 0) {
        unsigned* bar = b.bar;
        __builtin_amdgcn_s_waitcnt(0);
        unsigned nloc = b.nloc, nx = b.nx;
        if (nloc == 0u) { xcd_barrier_complete(bar, b.x, nloc, nx); b.nloc = nloc; b.nx = nx; }
        const unsigned old = xb_add(&bar[XB_XSUB(b.x)], 1u);
        const unsigned gen = old / nloc;
        if (old + 1u == (gen + 1u) * nloc) {
            __builtin_amdgcn_fence(__ATOMIC_RELEASE, XB_SCOPE);
            asm volatile("s_waitcnt vmcnt(0)" ::: "memory");
            const unsigned og = xb_add(&bar[XB_TOP], 1u);
            const unsigned tg = og / nx;
            if (og + 1u == (tg + 1u) * nx) xb_add(&bar[XB_TOPGEN], 1u);
            else XB_SPIN(xb_ld(&bar[XB_TOPGEN]) == tg, bar);
            __builtin_amdgcn_fence(__ATOMIC_ACQUIRE, XB_SCOPE);
            xb_add(&bar[XB_XGEN(b.x)], 1u);
            asm volatile("s_waitcnt vmcnt(0)" ::: "memory");
        } else {
            XB_SPIN(xb_ld(&bar[XB_XGEN(b.x)]) == gen, bar);
            __builtin_amdgcn_fence(__ATOMIC_ACQUIRE, XB_SCOPE);
            asm volatile("s_waitcnt vmcnt(0)" ::: "memory");
        }
    }
    __syncthreads();
}

__device__ __forceinline__ void tile_coords(int L, int ntm, int ntn, int& tm, int& tn) {
    const int nt = ntm * ntn, q = nt >> 3, r = nt & 7, xcd = L & 7, off = L >> 3;
    const int id = (xcd < r ? xcd * (q + 1) : r * (q + 1) + (xcd - r) * q) + off;
    const int GM = 8, nig = GM * ntn, gid = id / nig, fm = gid * GM, gsz = (ntm - fm) < GM ? (ntm - fm) : GM;
    tm = fm + ((id % nig) % gsz); tn = (id % nig) / gsz;
}

template <class AP, class BP>
__device__ __forceinline__ void gemm_kloop(f32x4 (&acc)[4][4], AP ap, int a_kstep, BP bp, int b_kstep, int nkt, unsigned char* lds, int tid) {
    const int lane = tid & 63, w = tid >> 6, wm = w >> 1, wn = w & 1, fr = lane & 15, fq = lane >> 4;
    const int lr = lane >> 3, lc = (lane & 7) ^ lr;
    const bf16_t* pa[4]; const bf16_t* pb[4];
#pragma unroll
    for (int i = 0; i < 4; ++i) {
        const int row = 8 * (w + 4 * i) + lr;
        pa[i] = ap(row) + lc * 8;
        const int wn_ = row >> 6, ni_ = (row >> 4) & 3, ii = row & 15;
        pb[i] = bp(64 * wn_ + 16 * (ii >> 2) + 4 * ni_ + (ii & 3)) + lc * 8;
    }
    const int ra = (64 * wm + fr) * 128, rb = (64 * wn + fr) * 128;
    const int sw0 = ((fq) ^ (fr & 7)) << 4, sw1 = ((4 + fq) ^ (fr & 7)) << 4;
    auto issue = [&](int buf) {
#pragma unroll
        for (int i = 0; i < 4; ++i) {
            __builtin_amdgcn_global_load_lds((const unsigned*)pa[i], (unsigned*)(lds + buf * 16384 + (w + 4 * i) * 1024), 16, 0, 0);
            __builtin_amdgcn_global_load_lds((const unsigned*)pb[i], (unsigned*)(lds + 32768 + buf * 16384 + (w + 4 * i) * 1024), 16, 0, 0);
            pa[i] += a_kstep; pb[i] += b_kstep;
        }
    };
    auto compute = [&](int buf) {
        const unsigned char* A = lds + buf * 16384;
        const unsigned char* B = lds + 32768 + buf * 16384;
#pragma unroll
        for (int ks = 0; ks < 2; ++ks) {
            const int sw = ks ? sw1 : sw0;
            bf16x8 af[4], bf[4];
#pragma unroll
            for (int mi = 0; mi < 4; ++mi) af[mi] = *(const bf16x8*)(A + ra + mi * 2048 + sw);
#pragma unroll
            for (int ni = 0; ni < 4; ++ni) bf[ni] = *(const bf16x8*)(B + rb + ni * 2048 + sw);
#pragma unroll
            for (int mi = 0; mi < 4; ++mi)
#pragma unroll
                for (int ni = 0; ni < 4; ++ni) acc[mi][ni] = mfma16(bf[ni], af[mi], acc[mi][ni]);
        }
    };
    vb_sync(lds);
    issue(0);
    asm volatile("s_waitcnt vmcnt(0)" ::: "memory");
    vb_sync(lds);
#pragma unroll 1
    for (int kt = 0; kt < nkt; ++kt) {
        const int cur = kt & 1;
        if (kt + 1 < nkt) issue(cur ^ 1);
        compute(cur);
        asm volatile("s_waitcnt vmcnt(0)" ::: "memory");
        vb_sync(lds);
    }
}
__device__ __forceinline__ void zero_acc(f32x4 (&acc)[4][4]) {
#pragma unroll
    for (int i = 0; i < 4; ++i)
#pragma unroll
        for (int j = 0; j < 4; ++j) acc[i][j] = (f32x4){0.f, 0.f, 0.f, 0.f};
}

constexpr int G8_HTB = 16384;
__device__ __forceinline__ int g8_lds_byte(int r, int c) { const int st = (r >> 4) * 2 + (c >> 5), rr = r & 15, cc = c & 31, ob = rr * 64 + cc * 2; return st * 1024 + (ob ^ (((ob >> 9) & 1) << 5)); }
__device__ __forceinline__ void g8_stage_rc(int b, int& R, int& C) { const int st = b / 1024, sb = b % 1024, swz = sb ^ (((sb >> 9) & 1) << 5); R = (st >> 1) * 16 + swz / 64; C = (st & 1) * 32 + (swz % 64) / 2; }
__device__ __forceinline__ int g8_perm32(int rho) { const int n = rho >> 4, i = rho & 15; return 8 * (i >> 2) + 4 * n + (i & 3); }
struct G8Unit {
    const char* A0; const char* A1; const char* B0; const char* B1;
    unsigned K2;
    int nt;
    int x0, x1, x2, x3, n;
    unsigned ao[2][2];
};
typedef f32x4 G8Acc[2][2][4][2];
template <class Sched, class Epi>
__device__ __forceinline__ void g8_phase(Sched& S, Epi& E) {
    LAS unsigned char* lds = (LAS unsigned char*)lds_base();
    int tid = threadIdx.x; asm volatile("" : "+v"(tid));
    const int wid = __builtin_amdgcn_readfirstlane(tid >> 6), lane = tid & 63, wr = wid >> 2, wc = wid & 3, fr = lane & 15, fq = lane >> 4;
#define G8_GEOM(R, C2, Rb) int R[2]; unsigned C2[2], Rb[2]; { int _t = threadIdx.x; asm volatile("" : "+v"(_t)); _Pragma("unroll") for (int _i = 0; _i < 2; ++_i) { int _r, _c; g8_stage_rc(_t * 16 + _i * 8192, _r, _c); \
        R[_i] = _r; C2[_i] = (unsigned)_c * 2u; Rb[_i] = (unsigned)((_r & ~31) + g8_perm32(_r & 31)); } }
    const unsigned ldsw = (unsigned)wid * 1024u;
    const int aoff = g8_lds_byte(wr * 64 + fr, fq * 8), boff = g8_lds_byte(wc * 32 + fr, fq * 8);
#define G8_SA(b, h) (((b) * 2 + (h)) * G8_HTB)
#define G8_SB(b, h) ((4 + (b) * 2 + (h)) * G8_HTB)
#define G8_STAGE(bufoff, gbase, voff) do { _Pragma("unroll") for (int _i = 0; _i < 2; ++_i) { unsigned _o = (voff)[_i]; asm volatile("" : "+v"(_o)); \
        __builtin_amdgcn_global_load_lds((const unsigned*)((const char*)(gbase) + _o), (LAS unsigned*)(lds + (bufoff) + ldsw + _i * 8192), 16, 0, 0); } } while (0)
#define G8_BOFF(u, bo) do { _Pragma("unroll") for (int _i = 0; _i < 2; ++_i) bo[_i] = Rb_[_i] * (u).K2 + C2_[_i]; } while (0)
#define G8_LDA(dst, b, h) do { _Pragma("unroll") for (int m = 0; m < 4; ++m) _Pragma("unroll") for (int k = 0; k < 2; ++k) dst[m][k] = *(const LAS bf16x8*)(lds + G8_SA(b, h) + aoff + m * 2048 + k * 1024); } while (0)
#define G8_LDB(dst, b, h) do { _Pragma("unroll") for (int n = 0; n < 2; ++n) _Pragma("unroll") for (int k = 0; k < 2; ++k) dst[n][k] = *(const LAS bf16x8*)(lds + G8_SB(b, h) + boff + n * 2048 + k * 1024); } while (0)
#define G8_MMA(ai, bj, At, Bt) do { __builtin_amdgcn_s_setprio(1); _Pragma("unroll") for (int m = 0; m < 4; ++m) _Pragma("unroll") for (int n = 0; n < 2; ++n) _Pragma("unroll") for (int k = 0; k < 2; ++k) \
        acc[ai][bj][m][n] = __builtin_amdgcn_mfma_f32_16x16x32_bf16(Bt[n][k], At[m][k], acc[ai][bj][m][n], 0, 0, 0); __builtin_amdgcn_s_setprio(0); } while (0)
#define G8_WAIT_V(n) asm volatile("s_waitcnt vmcnt(" #n ")" ::: "memory")
#define G8_WAIT_L(n) asm volatile("s_waitcnt lgkmcnt(" #n ")" ::: "memory")
#define G8_BAR __builtin_amdgcn_s_barrier()
#define G8_SCHED __builtin_amdgcn_sched_barrier(0)
    G8Unit cur, nxt; int ui = 0; unsigned cbo[2], nbo[2];
    { G8_GEOM(R_, C2_, Rb_) if (!S.next(0, cur, R_, C2_)) return; G8_BOFF(cur, cbo); }
    G8Acc acc;
#pragma unroll
    for (int a = 0; a < 2; ++a)
#pragma unroll
        for (int b = 0; b < 2; ++b)
#pragma unroll
            for (int m = 0; m < 4; ++m)
#pragma unroll
                for (int n = 0; n < 2; ++n) acc[a][b][m][n] = (f32x4){0.f, 0.f, 0.f, 0.f};
    bf16x8 At[4][2], B0[2][2], B1[2][2];
    G8_STAGE(G8_SB(0, 0), cur.B0, cbo); G8_STAGE(G8_SA(0, 0), cur.A0, cur.ao[0]); G8_STAGE(G8_SB(0, 1), cur.B1, cbo); G8_STAGE(G8_SA(0, 1), cur.A1, cur.ao[1]);
    if (wr == 1) G8_BAR;
    G8_WAIT_V(4); G8_BAR;
    G8_STAGE(G8_SB(1, 0), cur.B0 + 128, cbo); G8_STAGE(G8_SA(1, 0), cur.A0 + 128, cur.ao[0]); G8_STAGE(G8_SB(1, 1), cur.B1 + 128, cbo);
    G8_WAIT_V(6); G8_BAR;
    for (;;) {
        bool has_next;
        { G8_GEOM(R_, C2_, Rb_) has_next = S.next(ui + 1, nxt, R_, C2_);
          if (!has_next) nxt = cur;
          G8_BOFF(nxt, nbo); }
        const int nt = cur.nt;
#pragma unroll 1
        for (int t = 0; t < nt; t += 2) {
            const bool last = (t == nt - 2);
            const size_t k1 = (size_t)(t + 1) * 128, k2 = (size_t)(t + 2) * 128;
            const char* a2h0 = last ? nxt.A0 : cur.A0 + k2; const char* a2h1 = last ? nxt.A1 : cur.A1 + k2;
            const char* b2h0 = last ? nxt.B0 : cur.B0 + k2; const char* b2h1 = last ? nxt.B1 : cur.B1 + k2;
            unsigned ao0[2], ao1[2], bo2[2];
#pragma unroll
            for (int i = 0; i < 2; ++i) { ao0[i] = last ? nxt.ao[0][i] : cur.ao[0][i]; ao1[i] = last ? nxt.ao[1][i] : cur.ao[1][i]; bo2[i] = last ? nbo[i] : cbo[i]; }
            G8_LDB(B0, 0, 0); G8_SCHED; G8_LDA(At, 0, 0); G8_STAGE(G8_SA(1, 1), cur.A1 + k1, cur.ao[1]);
            G8_WAIT_L(8); G8_BAR; G8_WAIT_L(0); G8_MMA(0, 0, At, B0); G8_BAR; G8_SCHED;
            G8_LDB(B1, 0, 1); G8_STAGE(G8_SB(0, 0), b2h0, bo2);
            G8_BAR; G8_WAIT_L(0); G8_MMA(0, 1, At, B1); G8_BAR;
            G8_LDA(At, 0, 1); G8_STAGE(G8_SA(0, 0), a2h0, ao0);
            G8_BAR; G8_WAIT_L(0); G8_MMA(1, 0, At, B0); G8_BAR; G8_SCHED;
            G8_STAGE(G8_SB(0, 1), b2h1, bo2);
            G8_WAIT_V(6); G8_BAR; G8_MMA(1, 1, At, B1); G8_BAR;
            G8_LDB(B0, 1, 0); G8_SCHED; G8_LDA(At, 1, 0); G8_STAGE(G8_SA(0, 1), a2h1, ao1);
            G8_WAIT_L(8); G8_BAR; G8_WAIT_L(0); G8_MMA(0, 0, At, B0); G8_BAR; G8_SCHED;
            G8_LDB(B1, 1, 1); G8_STAGE(G8_SB(1, 0), b2h0 + 128, bo2);
            G8_BAR; G8_WAIT_L(0); G8_MMA(0, 1, At, B1); G8_BAR;
            G8_LDA(At, 1, 1); G8_STAGE(G8_SA(1, 0), a2h0 + 128, ao0);
            G8_BAR; G8_WAIT_L(0); G8_MMA(1, 0, At, B0); G8_BAR; G8_SCHED;
            G8_STAGE(G8_SB(1, 1), b2h1 + 128, bo2);
            G8_WAIT_V(6); G8_BAR; G8_MMA(1, 1, At, B1); G8_BAR;
        }
        { int t_ = threadIdx.x; asm volatile("" : "+v"(t_)); const int w_ = __builtin_amdgcn_readfirstlane(t_ >> 6); E(acc, cur, w_ >> 2, w_ & 3, t_ & 15, (t_ >> 4) & 3); }
        if (!has_next) break;
#pragma unroll
        for (int a = 0; a < 2; ++a)
#pragma unroll
            for (int b = 0; b < 2; ++b)
#pragma unroll
                for (int m = 0; m < 4; ++m)
#pragma unroll
                    for (int n = 0; n < 2; ++n) acc[a][b][m][n] = (f32x4){0.f, 0.f, 0.f, 0.f};
        cur = nxt; ++ui; cbo[0] = nbo[0]; cbo[1] = nbo[1];
    }
    G8_WAIT_V(0);
    if (wr == 0) G8_BAR;
    G8_BAR;
}
struct G8Plain {
    static constexpr bool GATHER = false;
    const char* A; const char* B; unsigned K2; int nt, nM, nN;
    __device__ __forceinline__ bool next(int i, G8Unit& u, const int (&R)[2], const unsigned (&C2)[2]) const {
        const int L = i * (int)gridDim.x + (int)blockIdx.x; if (L >= nM * nN) return false;
        int pm, pn; tile_coords(L, nM, nN, pm, pn); pm = __builtin_amdgcn_readfirstlane(pm); pn = __builtin_amdgcn_readfirstlane(pn);
        u.A0 = A + (size_t)pm * 256 * K2; u.A1 = u.A0 + (size_t)128 * K2; u.B0 = B + (size_t)pn * 256 * K2; u.B1 = u.B0 + (size_t)128 * K2;
        u.K2 = K2; u.nt = nt; u.x0 = pm; u.x1 = pn; u.x2 = 0; u.x3 = 0;
#pragma unroll
        for (int h = 0; h < 2; ++h)
#pragma unroll
            for (int k = 0; k < 2; ++k) u.ao[h][k] = (unsigned)R[k] * u.K2 + C2[k];
        return true;
    }
};

__device__ __forceinline__ void convert_tiles(CKP& p, int l, int e_lo, int e_hi, int first, int stride, int lane) {
    unsigned char* W = p.ws + OFF_W;
    struct E { const float* src; bf16_t* dst; int R, C, nd, mode, nbatch; };
    const int NE = e_hi;
        for (int L = first;; L += stride) {
            int rem = L; int e = e_lo; E d{};
            for (; e < NE; ++e) {
                switch (e) {
                    case 0: d = {p.in[3] + (size_t)l * 1024 * 5144, (bf16_t*)(W + W_IN), 1024, 5144, 2176, 1, 1}; break;
                    case 1: d = {p.in[3] + (size_t)l * 1024 * 5144, (bf16_t*)(W + W_GB), 1024, 5144, 3072, 2, 1}; break;
                    case 2: d = {p.in[10] + (size_t)l * 512 * 1024, (bf16_t*)(W + W_A), 512, 1024, 1024, 0, 1}; break;
                    case 3: d = {p.in[14] + (size_t)l * 256 * 1024, (bf16_t*)(W + W_S), 256, 1024, 1024, 0, 1}; break;
                    case 4: d = {p.in[25] + (size_t)l * 256 * 1024, (bf16_t*)(W + W_5), 256, 1024, 1024, 0, 1}; break;
                    case 5: d = {p.in[26] + (size_t)l * 1024 * 1024, (bf16_t*)(W + W_M), 1024, 1024, 1024, 0, 1}; break;
                    case 6: d = {p.in[23] + (size_t)l * 256 * 256, (bf16_t*)(W + W_GLU), 256, 256, 256, 0, 1}; break;
                    case 7: d = {p.in[6] + (size_t)l * 2048 * 128, (bf16_t*)(W + W_C1), 2048, 128, 128, 0, 1}; break;
                    case 8: d = {p.in[8] + (size_t)l * 2048 * 128, (bf16_t*)(W + W_C1) + 128 * 2048, 2048, 128, 128, 0, 1}; break;
                    case 9: d = {p.in[7] + (size_t)l * 128 * 64, (bf16_t*)(W + W_C2), 128, 64, 64, 0, 1}; break;
                    case 10: d = {p.in[9] + (size_t)l * 128 * 64, (bf16_t*)(W + W_C2) + 64 * 128, 128, 64, 64, 0, 1}; break;
                    case 11: d = {p.in[32] + (size_t)l * 32 * 1024 * 512, (bf16_t*)(W + W_EG), 1024, 512, 512, 0, 32}; break;
                    case 12: d = {p.in[33] + (size_t)l * 32 * 1024 * 512, (bf16_t*)(W + W_EU), 1024, 512, 512, 0, 32}; break;
                    default: d = {p.in[34] + (size_t)l * 32 * 512 * 1024, (bf16_t*)(W + W_ED), 512, 1024, 1024, 0, 32}; break;
                }
                const int per = (d.R >> 6) * (d.nd >> 6), tot = per * d.nbatch;
                if (rem < tot) break;
                rem -= tot;
            }
            if (e >= NE) break;
            const int per = (d.R >> 6) * (d.nd >> 6), bi = rem / per, t = rem % per, ntn = d.nd >> 6;
            const int k0 = (t / ntn) * 64, n = (t % ntn) * 64 + lane;
            int col = n;
            if (d.mode == 1) col = (n < 1280) ? n : ((n < 2048) ? n + 24 : ((n < 2072) ? n - 768 : -1));
            else if (d.mode == 2) col = n + 2072;
            const float* sp = d.src + (size_t)bi * d.R * d.C + (size_t)k0 * d.C + (col >= 0 ? col : 0);
            float v[64];
#pragma unroll
            for (int i = 0; i < 64; ++i) v[i] = sp[(size_t)i * d.C];
            if (col < 0) {
#pragma unroll
                for (int i = 0; i < 64; ++i) v[i] = 0.f;
            }
            bf16_t* dp = d.dst + (size_t)bi * d.R * d.nd + (size_t)n * d.R + k0;
#pragma unroll
            for (int q = 0; q < 8; ++q) {
                u32x4 o;
                o.x = pk_bf16(v[8 * q], v[8 * q + 1]); o.y = pk_bf16(v[8 * q + 2], v[8 * q + 3]);
                o.z = pk_bf16(v[8 * q + 4], v[8 * q + 5]); o.w = pk_bf16(v[8 * q + 6], v[8 * q + 7]);
                *(u32x4*)(dp + 8 * q) = o;
            }
        }
}

__device__ __forceinline__ void phase_prep(CKP& p, int l, unsigned char* lds) {
    const int tid = opaque_tid(), G = VGRID(), lane = tid & 63, w = tid >> 6;
    unsigned char* W = p.ws + OFF_W;
    if (l < DEPTH) {
        convert_tiles(p, l, 0, 11, VBID() * 4 + w, G * 4, lane);
        const int gt = VBID() * NTHR + tid, gs = G * NTHR;
        if (l == 0) {
            const int* pos = (const int*)p.in[1]; float* rt = (float*)(p.ws + OFF_ROPE);
            for (int i = gt; i < NTOK * 8; i += gs) { float sn, cs; sincosf((float)pos[i >> 3] * p.inv_freq[i & 7], &sn, &cs); rt[(i >> 3) * 16 + (i & 7)] = cs; rt[(i >> 3) * 16 + 8 + (i & 7)] = sn; }
        }
        {
            const float* sw = p.in[12] + (size_t)l * 4 * 128 * 128; bf16_t* o = (bf16_t*)(W + W_SGU);
            for (int i = gt; i < 65536; i += gs) { const int t = (i >> 7) & 127, s = i & 127; o[i] = f2bf(s <= t ? sw[i] : 0.f); }
        }
        {
            const float* are = p.in[15] + l * 1024; const float* aim = p.in[16] + l * 1024; const float* ls = p.in[17] + l * 16;
            const float* bre = p.in[18] + (size_t)l * 16384; const float* bim = p.in[19] + (size_t)l * 16384;
            float* oa = (float*)(W + W_S5A); float* oa2 = (float*)(W + W_S5A256); float* ob = (float*)(W + W_S5B);
            for (int i = gt; i < 1024; i += gs) {
                const int g = i >> 6;
                const float step = expf(ls[g]), ar = are[i], ai = aim[i];
                const float mag = expf(ar * step); float sn, cs; sincosf(ai * step, &sn, &cs);
                const float abr = mag * cs, abi = mag * sn;
                const float den = ar * ar + ai * ai, nr = abr - 1.f, ni = abi;
                const float cr = (nr * ar + ni * ai) / den, ci = (ni * ar - nr * ai) / den;
                oa[i * 2] = abr; oa[i * 2 + 1] = abi;
                float pr = abr, pi = abi;
                for (int s = 0; s < 8; ++s) { const float nr2 = pr * pr - pi * pi, ni2 = 2.f * pr * pi; pr = nr2; pi = ni2; }
                oa2[i * 2] = pr; oa2[i * 2 + 1] = pi;
                for (int h = 0; h < 16; ++h) {
                    const float br = bre[i * 16 + h], bi_ = bim[i * 16 + h];
                    ob[i * 32 + h] = cr * br - ci * bi_;
                    ob[i * 32 + 16 + h] = cr * bi_ + ci * br;
                }
            }
            const float* cre = p.in[20] + (size_t)l * 16384; const float* cim = p.in[21] + (size_t)l * 16384; bf16_t* oc = (bf16_t*)(W + W_S5C);
            for (int i = gt; i < 32768; i += gs) {
                const int k = i & 127, gh = i >> 7;
                oc[i] = f2bf(k < 64 ? cre[gh * 64 + k] : -cim[gh * 64 + (k - 64)]);
            }
        }
        {
            const float* wg = p.in[28] + (size_t)l * 1024 * 4; const float* we = p.in[30] + (size_t)l * 1024 * 32;
            bf16_t* oh = (bf16_t*)(W + W_RH); bf16_t* ol = (bf16_t*)(W + W_RL);
            for (int i = gt; i < 65536; i += gs) {
                const int n = i >> 10, k = i & 1023;
                const float v = (n < 4) ? wg[k * 4 + n] : ((n < 36) ? we[k * 32 + (n - 4)] : 0.f);
                const bf16_t h = f2bf(v);
                oh[i] = h; ol[i] = f2bf(v - bf2f(h));
            }
        }
        {
            float* pb = (float*)(W + W_PB);
            for (int j = VBID() * 4 + w; j < 256; j += G * 4) {
                const int kv = j >> 7, n = j & 127;
                const float* pos = p.in[kv ? 5 : 4] + (size_t)l * 2048; const float* w1 = p.in[kv ? 8 : 6] + (size_t)l * 2048 * 128;
                float s = 0.f;
                for (int k = lane; k < 2048; k += 64) s += pos[k] * w1[(size_t)k * 128 + n];
                s = wave_sum(s);
                if (lane == 0) pb[j] = s;
            }
        }
    }
    {
        const float* gam = (l < DEPTH) ? (p.in[2] + (size_t)l * 1024) : p.in[35];
        bf16_t* hb = (bf16_t*)(p.ws + OFF_H);
        const bf16_t* ys = (const bf16_t*)(p.ws + OFF_YS);
        f32x4 gv[4];
#pragma unroll
        for (int i = 0; i < 4; ++i) gv[i] = *(const f32x4*)(gam + 4 * lane + 256 * i);
        for (int row = VBID() * 4 + w; row < NTOK; row += G * 4) {
            f32x4 xv[4]; float ss = 0.f;
#pragma unroll
            for (int i = 0; i < 4; ++i) {
                const int col = 4 * lane + 256 * i;
                if (l == 0) xv[i] = *(const f32x4*)(p.in[0] + (size_t)row * 1024 + col);
                else if ((DBG_NOCOMBINE >> l) & 1) xv[i] = *(const f32x4*)(p.xbuf + (size_t)row * 1024 + col);
                else {
                    xv[i] = *(const f32x4*)(p.xbuf + (size_t)row * 1024 + col);
                    const u32x2 y0 = *(const u32x2*)(ys + (size_t)(2 * row) * 1024 + col), y1 = *(const u32x2*)(ys + (size_t)(2 * row + 1) * 1024 + col);
                    xv[i][0] += bflo(y0.x) + bflo(y1.x); xv[i][1] += bfhi(y0.x) + bfhi(y1.x);
                    xv[i][2] += bflo(y0.y) + bflo(y1.y); xv[i][3] += bfhi(y0.y) + bfhi(y1.y);
                }
                ss += xv[i][0] * xv[i][0] + xv[i][1] * xv[i][1] + xv[i][2] * xv[i][2] + xv[i][3] * xv[i][3];
            }
            ss = wave_sum(ss);
            const float rstd = rsqrtf(ss * (1.f / 1024.f) + RMS_EPS);
#pragma unroll
            for (int i = 0; i < 4; ++i) {
                const int col = 4 * lane + 256 * i;
                f32x4 hn = xv[i] * rstd * gv[i];
                if (l < DEPTH) {
                    *(f32x4*)(p.xbuf + (size_t)row * 1024 + col) = xv[i];
                    u32x2 o; o.x = pk_bf16(hn[0], hn[1]); o.y = pk_bf16(hn[2], hn[3]);
                    *(u32x2*)(hb + (size_t)row * 1024 + col) = o;
                } else {
#if DBG_TIMEPH >= 0
                    { const unsigned long long* ts = (const unsigned long long*)(p.ws + OFF_CTL + 24576);
                      const float dt_us = (float)(ts[DBG_TIMEPH2] - ts[DBG_TIMEPH]) * 0.01f; hn = hn * (1.f + 1e-3f * dt_us); }
#endif
                    *(f32x4*)(p.xbuf + (size_t)row * 1024 + col) = hn;
                }
            }
        }
    }
}

struct EpiInproj {
    unsigned char* Rb_; const float* rope;
    __device__ __forceinline__ void operator()(const G8Acc& acc, const G8Unit& u, int wr, int wc, int fr, int fq) const {
        unsigned char* R = Rb_;
#pragma unroll
        for (int bj = 0; bj < 2; ++bj) {
            const int tn = u.x1 * 2 + bj;
            const int cl = 32 * wc + 8 * fq;
#pragma unroll
            for (int ai = 0; ai < 2; ++ai)
#pragma unroll
                for (int m = 0; m < 4; ++m) {
                    const int row = u.x0 * 256 + ai * 128 + wr * 64 + m * 16 + fr;
                    float v[8];
#pragma unroll
                    for (int e = 0; e < 8; ++e) v[e] = acc[ai][bj][m][e >> 2][e & 3];
                    const bool roped = (tn < 4) || tn == 6 || tn == 8;
                    if (tn < 4) { u32x4 o; o.x = pk_bf16(v[0], v[1]); o.y = pk_bf16(v[2], v[3]); o.z = pk_bf16(v[4], v[5]); o.w = pk_bf16(v[6], v[7]);
                                  *(u32x4*)((bf16_t*)(R + R_Q) + (size_t)row * 512 + tn * 128 + cl) = o; }
                    if (roped && !(wc & 1)) {
                        float xo[8];
#pragma unroll
                        for (int i = 0; i < 8; ++i) xo[i] = __shfl_xor(v[i], 16);
                        if (fq < 2) {
                            const float* rt = rope + (size_t)row * 16;
                            const f32x4 c0 = *(const f32x4*)rt, c1 = *(const f32x4*)(rt + 4), s0 = *(const f32x4*)(rt + 8), s1 = *(const f32x4*)(rt + 12);
#pragma unroll
                            for (int i = 0; i < 8; ++i) {
                                const float cs = i < 4 ? c0[i & 3] : c1[i & 3], sn = i < 4 ? s0[i & 3] : s1[i & 3];
                                v[i] = fq == 0 ? (v[i] * cs - xo[i] * sn) : (v[i] * cs + xo[i] * sn);
                            }
                        }
                    }
                    u32x4 o; o.x = pk_bf16(v[0], v[1]); o.y = pk_bf16(v[2], v[3]); o.z = pk_bf16(v[4], v[5]); o.w = pk_bf16(v[6], v[7]);
                    if (tn < 4) *(u32x4*)((bf16_t*)(R + R_QR) + (size_t)row * 512 + tn * 128 + cl) = o;
                    else if (tn == 7 || tn == 9) {
                        bf16_t* dst = (bf16_t*)(R + (tn == 7 ? R_VST : R_VWT));
                        const int b = row >> 12, s_ = row & 4095, g = wc >> 1, d0 = 32 * (wc & 1) + 8 * fq;
#pragma unroll
                        for (int e = 0; e < 8; ++e) dst[((size_t)((b * 2 + g) * 64 + d0 + e)) * SEQ + s_] = f2bf(v[e]);
                    } else if (tn < 10) {
                        const size_t off = (tn == 4) ? R_KC : (tn == 5) ? R_VC : (tn == 6) ? R_KS : R_KW;
                        *(u32x4*)((bf16_t*)(R + off) + (size_t)row * 128 + cl) = o;
                    } else if (tn < 14) {
#pragma unroll
                        for (int e = 0; e < 8; ++e) v[e] = gelu_tanh(v[e]);
                        u32x4 og; og.x = pk_bf16(v[0], v[1]); og.y = pk_bf16(v[2], v[3]); og.z = pk_bf16(v[4], v[5]); og.w = pk_bf16(v[6], v[7]);
                        const int c512 = (tn - 10) * 128 + cl;
                        if (c512 < 256) *(u32x4*)((bf16_t*)(R + R_U) + (size_t)row * 256 + c512) = og;
                        else *(u32x4*)((bf16_t*)(R + R_V) + (size_t)row * 256 + (c512 - 256)) = og;
                    } else {
                        *(u32x4*)((bf16_t*)(R + R_S5IN) + (size_t)row * 256 + (tn - 14) * 128 + cl) = o;
                    }
                }
        }
    }
};
__device__ __forceinline__ void phase_inproj(CKP& p, int l, unsigned char* lds) {
    {
        G8Plain S{(const char*)(p.ws + OFF_H), (const char*)(p.ws + OFF_W + W_IN), 2048u, 16, NTOK / 256, 8};
        EpiInproj E{p.ws + OFF_R, (const float*)(p.ws + OFF_ROPE)};
        g8_phase(S, E);
    }
    const int tid = opaque_tid(), lane = tid & 63, w = tid >> 6, wm = w >> 1, wn = w & 1, fr = lane & 15, fq = lane >> 4;
    const int half = (int)(threadIdx.x >> 8);
    const bf16_t* A = (const bf16_t*)(p.ws + OFF_H);
    const bf16_t* Bt = (const bf16_t*)(p.ws + OFF_W + W_IN) + (size_t)2048 * 1024;
    unsigned char* R = p.ws + OFF_R;
    float* xch = (float*)(lds_base() + VB_LDS);
    for (int tm = blockIdx.x; tm < NTOK / 128; tm += gridDim.x) {
        const int m0 = tm * 128;
        f32x4 acc[4][4]; zero_acc(acc);
        gemm_kloop(acc, [&](int r) { return A + (size_t)(m0 + r) * 1024 + half * 512; }, 64, [&](int v) { return Bt + (size_t)v * 1024 + half * 512; }, 64, 8, lds, tid);
        __syncthreads();
        if (half == 1 && wn == 0 && fq < 2) {
#pragma unroll
            for (int mi = 0; mi < 4; ++mi) {
                const int r = 64 * wm + 16 * mi + fr;
#pragma unroll
                for (int ni = 0; ni < 4; ++ni) *(f32x4*)(xch + r * 32 + 16 * fq + 4 * ni) = acc[mi][ni];
            }
        }
        __syncthreads();
        if (half == 0 && wn == 0 && fq < 2) {
#pragma unroll
            for (int mi = 0; mi < 4; ++mi) {
                const int r = 64 * wm + 16 * mi + fr;
                float* ng = (float*)(R + R_NG) + (size_t)(m0 + r) * 24 + 16 * fq;
#pragma unroll
                for (int ni = 0; ni < 4; ++ni) {
                    const f32x4 o = *(const f32x4*)(xch + r * 32 + 16 * fq + 4 * ni);
#pragma unroll
                    for (int j = 0; j < 4; ++j) if (16 * fq + 4 * ni + j < 24) ng[4 * ni + j] = sigm(acc[mi][ni][j] + o[j]);
                }
            }
        }
        __syncthreads();
    }
}

__device__ __forceinline__ void compress_tile(CKP& p, int job, unsigned char* lds) {
    job_fence();
    const int tid = opaque_tid(), lane = tid & 63, w = tid >> 6, wm = w >> 1, wn = w & 1, fr = lane & 15, fq = lane >> 4;
    const int kv = job >> 5, tm = job & 31, m0 = tm * 128;
    unsigned char* W = p.ws + OFF_W;
    const bf16_t* src = (const bf16_t*)(p.ws + OFF_R + (kv ? R_VC : R_KC));
    const bf16_t* W1 = (const bf16_t*)(W + W_C1) + (size_t)kv * 128 * 2048;
    const bf16_t* W2 = (const bf16_t*)(W + W_C2) + (size_t)kv * 64 * 128;
    const float* pb = (const float*)(W + W_PB) + kv * 128;
    f32x4 acc[4][4]; zero_acc(acc);
    gemm_kloop(acc, [&](int r) { int Rr = m0 + r; Rr = Rr < 4080 ? Rr : 4079; const int b = Rr / 510, rem = Rr % 510, c = rem >> 1, g = rem & 1;
                                 return src + ((size_t)(b * SEQ + 16 * c)) * 128 + g * 64; }, 128,
               [&](int v) { return W1 + (size_t)v * 2048; }, 64, 32, lds, tid);
#pragma unroll
    for (int mi = 0; mi < 4; ++mi) {
        const int row = 64 * wm + 16 * mi + fr; const int cb = 16 * fq;
        float v[16];
#pragma unroll
        for (int e = 0; e < 16; ++e) v[e] = gelu_tanh(acc[mi][e >> 2][e & 3] + pb[64 * wn + cb + e]);
        u32x4 a, b;
        a.x = pk_bf16(v[0], v[1]); a.y = pk_bf16(v[2], v[3]); a.z = pk_bf16(v[4], v[5]); a.w = pk_bf16(v[6], v[7]);
        b.x = pk_bf16(v[8], v[9]); b.y = pk_bf16(v[10], v[11]); b.z = pk_bf16(v[12], v[13]); b.w = pk_bf16(v[14], v[15]);
        *(u32x4*)(lds + wn * 16384 + row * 128 + (((2 * fq) ^ (row & 7)) << 4)) = a;
        *(u32x4*)(lds + wn * 16384 + row * 128 + (((2 * fq + 1) ^ (row & 7)) << 4)) = b;
    }
#pragma unroll
    for (int j = 0; j < 4; ++j) {
        const int pid = tid + 256 * j, row = pid >> 4, ch = pid & 15;
        const u32x4 v = *(const u32x4*)(W2 + row * 128 + ch * 8);
        *(u32x4*)(lds + 32768 + (ch >> 3) * 16384 + row * 128 + (((ch & 7) ^ (row & 7)) << 4)) = v;
    }
    vb_sync(lds);
    f32x4 a2[4][2];
#pragma unroll
    for (int i = 0; i < 4; ++i) { a2[i][0] = (f32x4){0.f, 0.f, 0.f, 0.f}; a2[i][1] = (f32x4){0.f, 0.f, 0.f, 0.f}; }
#pragma unroll
    for (int kt2 = 0; kt2 < 2; ++kt2)
#pragma unroll
        for (int ks = 0; ks < 2; ++ks) {
            bf16x8 af[4], bf[2];
#pragma unroll
            for (int mi = 0; mi < 4; ++mi) { const int row = 64 * wm + 16 * mi + fr; af[mi] = *(const bf16x8*)(lds + kt2 * 16384 + row * 128 + (((4 * ks + fq) ^ (row & 7)) << 4)); }
#pragma unroll
            for (int ni = 0; ni < 2; ++ni) { const int row = 32 * wn + 8 * (fr >> 2) + 4 * ni + (fr & 3); bf[ni] = *(const bf16x8*)(lds + 32768 + kt2 * 16384 + row * 128 + (((4 * ks + fq) ^ (row & 7)) << 4)); }
#pragma unroll
            for (int mi = 0; mi < 4; ++mi)
#pragma unroll
                for (int ni = 0; ni < 2; ++ni) a2[mi][ni] = mfma16(bf[ni], af[mi], a2[mi][ni]);
        }
    bf16_t* kcmp = (bf16_t*)(p.ws + OFF_C + C_KCMP);
    bf16_t* vct = (bf16_t*)(p.ws + OFF_C + C_VCT);
#pragma unroll
    for (int mi = 0; mi < 4; ++mi) {
        const int Rr = m0 + 64 * wm + 16 * mi + fr;
        if (Rr < 4080) {
            const int b = Rr / 510, rem = Rr % 510, c = rem >> 1, g = rem & 1, d0 = 32 * wn + 8 * fq;
            float v[8];
#pragma unroll
            for (int e = 0; e < 8; ++e) v[e] = a2[mi][e >> 2][e & 3];
            if (DBG_NOCSTORE) { if (v[0] == 123.456f) kcmp[0] = 1; }
            else if (kv == 0) {
                u32x4 o; o.x = pk_bf16(v[0], v[1]); o.y = pk_bf16(v[2], v[3]); o.z = pk_bf16(v[4], v[5]); o.w = pk_bf16(v[6], v[7]);
                *(u32x4*)(kcmp + ((size_t)(b * 256 + c)) * 128 + g * 64 + d0) = o;
                if (c == 254) *(u32x4*)(kcmp + ((size_t)(b * 256 + 255)) * 128 + g * 64 + d0) = (u32x4){0u, 0u, 0u, 0u};
            } else {
#pragma unroll
                for (int e = 0; e < 8; ++e) {
                    vct[((size_t)((b * 2 + g) * 64 + d0 + e)) * 256 + c] = f2bf(v[e]);
                    if (c == 254) vct[((size_t)((b * 2 + g) * 64 + d0 + e)) * 256 + 255] = 0;
                }
            }
        }
    }
    vb_sync(lds);
}

__device__ __forceinline__ void sgu_job(CKP& p, int l, int job, unsigned char* lds) {
    job_fence();
    const int tid = opaque_tid(), lane = tid & 63, w = tid >> 6, fr = lane & 15, fq = lane >> 4;
    const size_t tok0 = (size_t)job * 128;
    const bf16_t* V = (const bf16_t*)(p.ws + OFF_R + R_V) + tok0 * 256;
    const bf16_t* U = (const bf16_t*)(p.ws + OFF_R + R_U) + tok0 * 256;
    bf16_t* O = (bf16_t*)(p.ws + OFF_C + C_SGU) + tok0 * 256;
    const bf16_t* Wt = (const bf16_t*)(p.ws + OFF_W + W_SGU);
    const float* ng = p.in[11] + (size_t)l * 256;
    const float* bs = p.in[13] + (size_t)l * 512;
    vb_sync(lds);
    if (DBG_SGUCUT != 2) {
        const int s = tid >> 1, half = tid & 1;
        const bf16_t* src = V + (size_t)s * 256 + half * 128;
        float ss = 0.f;
#pragma unroll 4
        for (int j = 0; j < 16; ++j) {
            const u32x4 bb = *(const u32x4*)(src + j * 8);
            const unsigned uu[4] = {bb.x, bb.y, bb.z, bb.w};
#pragma unroll
            for (int q = 0; q < 4; ++q) { const float a = bflo(uu[q]), b2 = bfhi(uu[q]); ss += a * a + b2 * b2; }
        }
        ss += __shfl_xor(ss, 1);
        const float rstd = rsqrtf(ss * (1.f / 256.f) + RMS_EPS);
#pragma unroll 1
        for (int j = 0; j < 16; ++j) {
            const u32x4 bb = *(const u32x4*)(src + j * 8);
            const unsigned uu[4] = {bb.x, bb.y, bb.z, bb.w};
            const int cb = half * 128 + j * 8;
#pragma unroll
            for (int q = 0; q < 4; ++q) {
#pragma unroll
                for (int hh = 0; hh < 2; ++hh) {
                    const int c = cb + q * 2 + hh;
                    const float val = (hh ? bfhi(uu[q]) : bflo(uu[q])) * rstd * ng[c];
                    *(bf16_t*)(lds + c * 256 + ((((s >> 3) ^ (c & 15))) << 4) + (s & 7) * 2) = f2bf(val);
                }
            }
        }
    }
    vb_sync(lds);
    const int g = w;
#pragma unroll 1
    for (int th = 0; th < (DBG_SGUCUT == 1 ? 0 : 2); ++th) {
        f32x4 acc[4][4];
        zero_acc(acc);
#pragma unroll
        for (int ks = 0; ks < 4; ++ks) {
            if (32 * ks <= 64 * th + 63) {
                bf16x8 vf[4];
#pragma unroll
                for (int di = 0; di < 4; ++di) { const int c = 64 * g + 16 * di + fr; vf[di] = *(const bf16x8*)(lds + c * 256 + (((4 * ks + fq) ^ (c & 15)) << 4)); }
#pragma unroll
                for (int ti = 0; ti < 4; ++ti) {
                    const int t = 64 * th + 16 * ti + fr;
                    if (32 * ks <= 64 * th + 16 * ti + 15) {
                        const bf16x8 wf = *(const bf16x8*)(Wt + ((size_t)(g * 128 + t)) * 128 + 32 * ks + 8 * fq);
#pragma unroll
                        for (int di = 0; di < 4; ++di) acc[ti][di] = mfma16(vf[di], wf, acc[ti][di]);
                    }
                }
            }
        }
#pragma unroll
        for (int ti = 0; ti < 4; ++ti) {
            const int t = 64 * th + 16 * ti + fr; const float bb = bs[g * 128 + t];
#pragma unroll
            for (int di = 0; di < 4; ++di) {
                const int c = 64 * g + 16 * di + 4 * fq;
                const u32x2 uu = *(const u32x2*)(U + (size_t)t * 256 + c);
                u32x2 o;
                o.x = pk_bf16(bflo(uu.x) * (acc[ti][di][0] + bb), bfhi(uu.x) * (acc[ti][di][1] + bb));
                o.y = pk_bf16(bflo(uu.y) * (acc[ti][di][2] + bb), bfhi(uu.y) * (acc[ti][di][3] + bb));
                *(u32x2*)(O + (size_t)t * 256 + c) = o;
            }
        }
    }
    vb_sync(lds);
}

__device__ __forceinline__ void s5_job(CKP& p, int l, int jb, int pass, unsigned char* lds) {
    job_fence();
    const int tid = opaque_tid(), lane = tid & 63, w = tid >> 6, fr = lane & 15, fq = lane >> 4;
    const int id = ((jb * 4 + w) + DBG_IDROT) & 2047, seq = id >> 4, ch = id & 15, b = seq >> 4, g = seq & 15;
    unsigned char* W = p.ws + OFF_W;
    const float* ab = (const float*)(W + W_S5A) + (g * 64 + lane) * 2;
    float ar = ab[0], ai = ab[1];
    float br[16], bi[16];
    {
        const float* bb = (const float*)(W + W_S5B) + (size_t)(g * 64 + lane) * 32;
#pragma unroll
        for (int h = 0; h < 16; ++h) { br[h] = bb[h]; bi[h] = bb[16 + h]; }
    }
#if DBG_S5CONST >= 2
    { const float q = (float)(lane + 1) * 0.001f; ar = 0.99f - q; ai = 0.05f + q;
      for (int h = 0; h < 16; ++h) { br[h] = 0.01f * (float)(h + 1) + q; bi[h] = -0.02f * (float)(h + 1) + q; } }
#endif
    float* Eb = (float*)(p.ws + OFF_C + C_S5E);
    float hre = 0.f, him = 0.f;
    bf16x8 cf[4]; float dv[4];
    if (pass == 2) {
        const float* a2 = (const float*)(W + W_S5A256) + (g * 64 + lane) * 2;
        const float a2r = a2[0], a2i = a2[1];
        for (int c2 = 0; c2 < ch; ++c2) {
            const float* e = Eb + ((size_t)(seq * 16 + c2) * 64 + lane) * 2;
            const float nr = a2r * hre - a2i * him + e[0], ni = a2r * him + a2i * hre + e[1];
            hre = nr; him = ni;
        }
        const bf16_t* cm = (const bf16_t*)(W + W_S5C) + (size_t)(g * 16 + fr) * 128;
#pragma unroll
        for (int ks = 0; ks < 4; ++ks) cf[ks] = *(const bf16x8*)(cm + 32 * ks + 8 * fq);
#pragma unroll
        for (int r = 0; r < 4; ++r) dv[r] = p.in[22][(size_t)l * 256 + g * 16 + 4 * fq + r];
    }
    const bf16_t* xin = (const bf16_t*)(p.ws + OFF_R + R_S5IN) + ((size_t)(b * SEQ + ch * 256)) * 256 + g * 16;
    bf16_t* yg = (bf16_t*)(p.ws + OFF_C + C_YG) + ((size_t)(b * SEQ + ch * 256)) * 256 + g * 16;
    float* xs = (float*)(lds + w * 10240);
    int ldsbad = 0; (void)ldsbad;
    unsigned char* Hs = lds + w * 10240 + 2048;
#if DBG_TWICE
    float keep_re = 0.f, keep_im = 0.f;
#pragma unroll 1
    for (int rep = 0; rep < 2; ++rep) {
    if (rep == 1) { keep_re = hre; keep_im = him; hre = 0.f; him = 0.f; }
#endif
#pragma unroll 1
    for (int sub = 0; sub < 8; ++sub) {
#if DBG_S5CONST >= 1
        u32x4 xv; { const unsigned q = (unsigned)(sub * 32 + (lane >> 1)) * 2654435761u + (unsigned)id * 40503u + (lane & 1); xv.x = 0x3f803e80u ^ ((q & 0xff) << 16); xv.y = 0x3e003d00u ^ ((q >> 8) & 0x7f); xv.z = 0xbe803f00u ^ ((q >> 16) & 0x3f); xv.w = 0x3d80be00u; }
#else
        const u32x4 xv = *(const u32x4*)(xin + (size_t)(sub * 32 + (lane >> 1)) * 256 + (lane & 1) * 8);
#endif
        vb_sync(lds);
        f32x4 chk_a = {bflo(xv.x), bfhi(xv.x), bflo(xv.y), bfhi(xv.y)}, chk_c = {bflo(xv.z), bfhi(xv.z), bflo(xv.w), bfhi(xv.w)};
        {
            *(f32x4*)(xs + (lane >> 1) * 16 + (lane & 1) * 8) = chk_a;
            *(f32x4*)(xs + (lane >> 1) * 16 + (lane & 1) * 8 + 4) = chk_c;
        }
        vb_sync(lds);
#pragma unroll 4
        for (int st = 0; st < 32; ++st) {
#if DBG_S5CONST == 3
            f32x4 x0, x1, x2, x3;
            { const float t = (float)((sub * 32 + st) & 63) * 0.015625f + (float)(id & 7) * 0.125f;
              x0 = (f32x4){t, t * 0.5f, -t, 0.25f}; x1 = (f32x4){0.5f - t, t * t, 0.125f, t}; x2 = (f32x4){-0.25f, t, 0.75f * t, 1.f - t}; x3 = (f32x4){t, -t, 0.5f, 0.3f * t}; }
#else
            const f32x4 x0 = *(const f32x4*)(xs + st * 16), x1 = *(const f32x4*)(xs + st * 16 + 4), x2 = *(const f32x4*)(xs + st * 16 + 8), x3 = *(const f32x4*)(xs + st * 16 + 12);
#endif
            float ur = 0.f, ui = 0.f;
#pragma unroll
            for (int h = 0; h < 4; ++h) {
                ur += br[h] * x0[h]; ui += bi[h] * x0[h];
                ur += br[4 + h] * x1[h]; ui += bi[4 + h] * x1[h];
                ur += br[8 + h] * x2[h]; ui += bi[8 + h] * x2[h];
                ur += br[12 + h] * x3[h]; ui += bi[12 + h] * x3[h];
            }
            const float nr = ar * hre - ai * him + ur, ni = ar * him + ai * hre + ui;
            hre = nr; him = ni;
            if (pass == 2) {
                *(bf16_t*)(Hs + st * 256 + (((lane >> 3) ^ (st & 15)) << 4) + (lane & 7) * 2) = f2bf(hre);
                *(bf16_t*)(Hs + st * 256 + ((((64 + lane) >> 3) ^ (st & 15)) << 4) + (lane & 7) * 2) = f2bf(him);
            }
        }
#if DBG_LDSCHK
        {
            const f32x4 ra = *(volatile f32x4*)(xs + (lane >> 1) * 16 + (lane & 1) * 8), rc = *(volatile f32x4*)(xs + (lane >> 1) * 16 + (lane & 1) * 8 + 4);
            bool bad = false;
            for (int q = 0; q < 4; ++q) bad |= (__float_as_uint(ra[q]) != __float_as_uint(chk_a[q])) | (__float_as_uint(rc[q]) != __float_as_uint(chk_c[q]));
            if (__any(bad)) ldsbad = 1;
        }
#endif
        if (pass == 2) {
            vb_sync(lds);
#pragma unroll
            for (int tt = 0; tt < 2; ++tt) {
                f32x4 acc = {0.f, 0.f, 0.f, 0.f};
                const int tl = tt * 16 + fr;
#pragma unroll
                for (int ks = 0; ks < 4; ++ks) {
                    const bf16x8 hf = *(const bf16x8*)(Hs + tl * 256 + (((4 * ks + fq) ^ (tl & 15)) << 4));
                    acc = mfma16(cf[ks], hf, acc);
                }
                float y[4];
#pragma unroll
                for (int r = 0; r < 4; ++r) y[r] = gelu_tanh(acc[r] + dv[r] * xs[tl * 16 + 4 * fq + r]);
                u32x2 o; o.x = pk_bf16(y[0], y[1]); o.y = pk_bf16(y[2], y[3]);
                *(u32x2*)(yg + (size_t)(sub * 32 + tl) * 256 + 4 * fq) = o;
            }
        }
    }
#if DBG_TWICE
    }
    if (__float_as_uint(keep_re) != __float_as_uint(hre) || __float_as_uint(keep_im) != __float_as_uint(him)) { hre = __uint_as_float(0x7fc00000u); him = hre; }
#endif
    if (pass == 1) {
        float* e = Eb + ((size_t)(seq * 16 + ch) * 64 + lane) * 2;
#if DBG_LDSCHK
        if (ldsbad) { hre = __uint_as_float(0x7fc00000u); him = hre; }
#endif
#if DBG_ESC1
        { const unsigned long long pk = ((unsigned long long)__float_as_uint(him) << 32) | __float_as_uint(hre);
          __hip_atomic_store((unsigned long long*)e, pk, __ATOMIC_RELAXED, __HIP_MEMORY_SCOPE_AGENT); }
#else
        e[0] = hre; e[1] = him;
#endif
#if DBG_E2
        float* e2 = (float*)(p.ws + OFF_C + C_ATT) + ((size_t)(seq * 16 + ch) * 64 + lane) * 2;
        e2[0] = hre; e2[1] = him;
#endif
    }
    vb_sync(lds);
}

__device__ __forceinline__ void phase_mid1(CKP& p, int l, unsigned char* lds) {
#if DBG_QDELAY == 2
    if (VBID() >= 320) return;
#elif DBG_QDELAY == 3
    if (VBID() >= 320) {
        const unsigned long long t0 = __builtin_amdgcn_s_memrealtime(); while (__builtin_amdgcn_s_memrealtime() - t0 < 3000ull) __builtin_amdgcn_s_sleep(8);
        s5_job(p, l, VBID() - 320, 1, lds);
        return;
    }
#elif DBG_QDELAY
    if (VBID() >= 320) {
        s5_job(p, l, VBID() - 320, 1, lds);
        const unsigned long long t0 = __builtin_amdgcn_s_memrealtime(); while (__builtin_amdgcn_s_memrealtime() - t0 < 6000ull) __builtin_amdgcn_s_sleep(8);
        return;
    }
#endif
    for (int j = VBID(); j < 64 + 256 + 512; j += VGRID()) {
#if DBG_ONLYS5 == 1
        if (j >= 320) s5_job(p, l, j - 320, 1, lds);
#elif DBG_ONLYS5 == 2
        if (j < 64) compress_tile(p, j, lds);
        else if (j >= 320) s5_job(p, l, j - 320, 1, lds);
#elif DBG_ONLYS5 == 4
        { const int jj = 831 - j; if (jj < 64) compress_tile(p, jj, lds); else if (jj >= 320) s5_job(p, l, jj - 320, 1, lds); }
#elif DBG_ONLYS5 == 5
        if (j < 64) compress_tile(p, j, lds);
        else if (j >= 320 && j < 512) s5_job(p, l, j - 320, 1, lds);
        else if (j >= 576) s5_job(p, l, j - 320, 1, lds);
        if (j >= 448 && j < 512) s5_job(p, l, j + 64 - 320, 1, lds);
#elif DBG_ONLYS5 == 3
        if (j >= 64 && j < 320) sgu_job(p, l, j - 64, lds);
        else if (j >= 320) s5_job(p, l, j - 320, 1, lds);
#elif DBG_ONLYS5 == 6
        if (j < 512) {
#if DBG_PRESPIN
            { const unsigned long long t0 = __builtin_amdgcn_s_memrealtime(); while (__builtin_amdgcn_s_memrealtime() - t0 < (unsigned long long)DBG_PRESPIN) __builtin_amdgcn_s_sleep(2); }
#endif
            s5_job(p, l, j, 1, lds);
        }
        else if (j < 768) sgu_job(p, l, j - 512, lds);
        else compress_tile(p, j - 768, lds);
#else
        if (j < 64) compress_tile(p, j, lds);
        else if (j < 320) {
#if DBG_SGUSPIN
            { const unsigned long long t0 = __builtin_amdgcn_s_memrealtime(); while (__builtin_amdgcn_s_memrealtime() - t0 < (unsigned long long)DBG_SGUSPIN) __builtin_amdgcn_s_sleep(2); }
#else
            sgu_job(p, l, j - 64, lds);
#endif
        } else {
#if DBG_DELAY
            if (j >= 576) { const unsigned long long t0 = __builtin_amdgcn_s_memrealtime(); while (__builtin_amdgcn_s_memrealtime() - t0 < (unsigned long long)DBG_DELAY) __builtin_amdgcn_s_sleep(8); }
#endif
            s5_job(p, l, j - 320, 1, lds);
        }
#endif
    }
    if (VBID() >= 64) {
        const int tid = opaque_tid();
        convert_tiles(p, l, 11, 14, (VBID() - 64) * 4 + (tid >> 6), (VGRID() - 64) * 4, tid & 63);
    }
}

constexpr int AL_Q = 0, AL_KV = 32768, AL_IMP = 49152, AL_SEL = 65792, AL_UNI = 66304, AL_JOB = 66336;
constexpr float SM_C = 0.125f * 1.4426950408889634f;

__device__ __forceinline__ void attn_load_q(const bf16_t* Qg, const int* pos, const float (&inv_freq)[8], int b, int g, int t0, bool rope, unsigned char* lds, int tid) {
#pragma unroll 1
    for (int j = 0; j < 8; ++j) {
        const int pid = tid + 256 * j, Rr = pid >> 3, ch = pid & 7;
        const int wq = Rr >> 6, r = (Rr >> 4) & 3, q = Rr & 15, t = t0 + 16 * wq + q;
        const bf16_t* src = Qg + ((size_t)(b * SEQ + t)) * 512 + (g * 4 + r) * 64;
        if (!rope || ch >= 2) {
            *(u32x4*)(lds + AL_Q + Rr * 128 + ((ch ^ (Rr & 7)) << 4)) = *(const u32x4*)(src + ch * 8);
        } else if (ch == 0) {
            const u32x4 a = *(const u32x4*)(src), c = *(const u32x4*)(src + 8);
            float x1[8] = {bflo(a.x), bfhi(a.x), bflo(a.y), bfhi(a.y), bflo(a.z), bfhi(a.z), bflo(a.w), bfhi(a.w)};
            float x2[8] = {bflo(c.x), bfhi(c.x), bflo(c.y), bfhi(c.y), bflo(c.z), bfhi(c.z), bflo(c.w), bfhi(c.w)};
            const float ps = (float)pos[b * SEQ + t];
#pragma unroll
            for (int i = 0; i < 8; ++i) {
                float sn, cs; sincosf(ps * inv_freq[i], &sn, &cs);
                const float u = x1[i], v = x2[i];
                x1[i] = u * cs - v * sn; x2[i] = v * cs + u * sn;
            }
            u32x4 o1, o2;
            o1.x = pk_bf16(x1[0], x1[1]); o1.y = pk_bf16(x1[2], x1[3]); o1.z = pk_bf16(x1[4], x1[5]); o1.w = pk_bf16(x1[6], x1[7]);
            o2.x = pk_bf16(x2[0], x2[1]); o2.y = pk_bf16(x2[2], x2[3]); o2.z = pk_bf16(x2[4], x2[5]); o2.w = pk_bf16(x2[6], x2[7]);
            *(u32x4*)(lds + AL_Q + Rr * 128 + ((0 ^ (Rr & 7)) << 4)) = o1;
            *(u32x4*)(lds + AL_Q + Rr * 128 + ((1 ^ (Rr & 7)) << 4)) = o2;
        }
    }
}
__device__ __forceinline__ void attn_ldg(u32x4 (&kk)[2], u32x4 (&vv)[2], const bf16_t* Kb, const bf16_t* Vb, int vstride, int tid) {
#pragma unroll
    for (int j = 0; j < 2; ++j) {
        const int pid = tid + 256 * j, row = pid >> 3, ch = pid & 7;
        kk[j] = *(const u32x4*)(Kb + (size_t)row * 128 + ch * 8);
        vv[j] = *(const u32x4*)(Vb + (size_t)row * vstride + ch * 8);
    }
}
__device__ __forceinline__ void attn_stl(const u32x4 (&kk)[2], const u32x4 (&vv)[2], unsigned char* lds, int kvoff, int tid) {
#pragma unroll
    for (int j = 0; j < 2; ++j) {
        const int pid = tid + 256 * j, row = pid >> 3, ch = pid & 7;
        *(u32x4*)(lds + kvoff + row * 128 + ((ch ^ (row & 7)) << 4)) = kk[j];
        *(u32x4*)(lds + kvoff + 8192 + row * 128 + ((ch ^ ((row >> 1) & 7)) << 4)) = vv[j];
    }
}
__device__ __forceinline__ void attn_qk(f32x4 (&s)[2][4], const unsigned char* lds, int kvoff, int w, int fr, int fq, int hf) {
    const unsigned char* Qw = lds + AL_Q + w * 8192;
    const unsigned char* Kh = lds + kvoff + hf * 4096;
    const int sw0 = ((fq) ^ (fr & 7)) << 4, sw1 = ((4 + fq) ^ (fr & 7)) << 4;
#pragma unroll
    for (int ki = 0; ki < 2; ++ki)
#pragma unroll
        for (int qi = 0; qi < 4; ++qi) s[ki][qi] = (f32x4){0.f, 0.f, 0.f, 0.f};
#pragma unroll
    for (int ds = 0; ds < 2; ++ds) {
        bf16x8 qf[4];
#pragma unroll
        for (int qi = 0; qi < 4; ++qi) qf[qi] = *(const bf16x8*)(Qw + (qi * 16 + fr) * 128 + (ds ? sw1 : sw0));
#pragma unroll
        for (int ki = 0; ki < 2; ++ki) {
            const bf16x8 kf = *(const bf16x8*)(Kh + (ki * 16 + fr) * 128 + (ds ? sw1 : sw0));
#pragma unroll
            for (int qi = 0; qi < 4; ++qi) s[ki][qi] = mfma16(kf, qf[qi], s[ki][qi]);
        }
    }
}
__device__ __forceinline__ void attn_pv(f32x4 (&o)[4][4], const f32x4 (&s)[2][4], const unsigned char* lds, int kvoff, int fr, int fq, int hf) {
    bf16x8 pf[4];
#pragma unroll
    for (int qi = 0; qi < 4; ++qi) {
        u32x4 u;
        u.x = pk_bf16(s[0][qi][0], s[0][qi][1]); u.y = pk_bf16(s[0][qi][2], s[0][qi][3]);
        u.z = pk_bf16(s[1][qi][0], s[1][qi][1]); u.w = pk_bf16(s[1][qi][2], s[1][qi][3]);
        pf[qi] = as_bf8(u);
    }
    const int c0 = 4 * hf + (fq >> 1);
    const unsigned char* Vt = lds + kvoff + 8192;
#pragma unroll
    for (int di = 0; di < 4; ++di) {
        const int row = di * 16 + fr, key = (row >> 1) & 7;
        const u32x2 lo = *(const u32x2*)(Vt + row * 128 + ((c0 ^ key) << 4) + 8 * (fq & 1));
        const u32x2 hi = *(const u32x2*)(Vt + row * 128 + (((c0 + 2) ^ key) << 4) + 8 * (fq & 1));
        const bf16x8 vf = as_bf8((u32x4){lo.x, lo.y, hi.x, hi.y});
#pragma unroll
        for (int qi = 0; qi < 4; ++qi) o[di][qi] = mfma16(vf, pf[qi], o[di][qi]);
    }
}
__device__ __forceinline__ unsigned attn_vmask(int kb, int fq, int lo, int hi) {
    unsigned vm = 0;
#pragma unroll
    for (int ki = 0; ki < 2; ++ki)
#pragma unroll
        for (int r = 0; r < 4; ++r) { const int key = kb + 16 * ki + 4 * fq + r; if (key >= lo && key <= hi) vm |= 1u << (ki * 4 + r); }
    return vm;
}
__device__ __forceinline__ void attn_softmax(f32x4 (&s)[2][4], f32x4 (&o)[4][4], float (&m)[4], float (&lsum)[4], unsigned vm) {
#pragma unroll
    for (int qi = 0; qi < 4; ++qi) {
        float mx = -1e30f;
#pragma unroll
        for (int ki = 0; ki < 2; ++ki)
#pragma unroll
            for (int r = 0; r < 4; ++r) { const float sv = ((vm >> (ki * 4 + r)) & 1u) ? s[ki][qi][r] * SM_C : -1e30f; s[ki][qi][r] = sv; mx = fmaxf(mx, sv); }
        mx = xmax16(mx); mx = xmax32(mx);
        const float mn = fmaxf(m[qi], mx), alpha = fexp2(m[qi] - mn);
        m[qi] = mn;
        float ls = 0.f;
#pragma unroll
        for (int ki = 0; ki < 2; ++ki)
#pragma unroll
            for (int r = 0; r < 4; ++r) { const float pv = ((vm >> (ki * 4 + r)) & 1u) ? fexp2(s[ki][qi][r] - mn) : 0.f; s[ki][qi][r] = pv; ls += pv; }
        lsum[qi] = lsum[qi] * alpha + ls;
        if (__any(alpha != 1.f)) {
#pragma unroll
            for (int di = 0; di < 4; ++di) o[di][qi] *= alpha;
        }
    }
}
__device__ __forceinline__ void attn_softmax_full(f32x4 (&s)[2][4], f32x4 (&o)[4][4], float (&m)[4], float (&lsum)[4], bool lsel) {
#pragma unroll
    for (int qi = 0; qi < 4; ++qi) {
        float mx = fmaxf(fmaxf(fmaxf(s[0][qi][0], s[0][qi][1]), fmaxf(s[0][qi][2], s[0][qi][3])), fmaxf(fmaxf(s[1][qi][0], s[1][qi][1]), fmaxf(s[1][qi][2], s[1][qi][3])));
        mx = xmax16(mx); mx = xmax32(mx);
        const float mn = fmaxf(m[qi], mx * SM_C);
        const float mnew = lsel ? mn : m[qi];
        const float alpha = fexp2(m[qi] - mnew);
        m[qi] = mnew;
        const float neg = lsel ? -mn : -1e30f;
        float ls = 0.f;
#pragma unroll
        for (int ki = 0; ki < 2; ++ki)
#pragma unroll
            for (int r = 0; r < 4; ++r) { const float pv = fexp2(fmaf(s[ki][qi][r], SM_C, neg)); s[ki][qi][r] = pv; ls += pv; }
        lsum[qi] = lsum[qi] * alpha + ls;
        if (__any(alpha != 1.f)) {
#pragma unroll
            for (int di = 0; di < 4; ++di) o[di][qi] *= alpha;
        }
    }
}
__device__ __forceinline__ void attn_accum(bf16_t* dst, const f32x4 (&o)[4][4], const float (&lsum)[4], const float (&gate)[4], bool first, int fq) {
#pragma unroll
    for (int qi = 0; qi < 4; ++qi) {
        float lt = lsum[qi]; lt = xsum16(lt); lt = xsum32(lt);
        const float sc = gate[qi] / fmaxf(lt, 1e-30f);
#pragma unroll
        for (int di = 0; di < 4; ++di) {
            u32x2* ptr = (u32x2*)(dst + qi * 64 + 16 * di + 4 * fq);
            float a0 = o[di][qi][0] * sc, a1 = o[di][qi][1] * sc, a2 = o[di][qi][2] * sc, a3 = o[di][qi][3] * sc;
            if (!first) { const u32x2 f = *ptr; a0 += bflo(f.x); a1 += bfhi(f.x); a2 += bflo(f.y); a3 += bfhi(f.y); }
            u32x2 r; r.x = pk_bf16(a0, a1); r.y = pk_bf16(a2, a3);
            *ptr = r;
        }
    }
}
template <class NextF, class PtrF, class BodyF>
__device__ __forceinline__ void attn_tiles(int first, NextF next, PtrF ptrs, BodyF body, unsigned char* lds, int tid) {
    u32x4 kk[2], vv[2];
    const bf16_t* Kb; const bf16_t* Vb; int vs;
    ptrs(first, Kb, Vb, vs);
    attn_ldg(kk, vv, Kb, Vb, vs, tid);
    int cur = first;
    while (cur >= 0) {
        vb_sync(lds);
        attn_stl(kk, vv, lds, AL_KV, tid);
        vb_sync(lds);
        const int nx = next(cur);
        if (nx >= 0) { ptrs(nx, Kb, Vb, vs); attn_ldg(kk, vv, Kb, Vb, vs, tid); }
        body(cur, AL_KV);
        cur = nx;
    }
}

__device__ __forceinline__ void phase_attn(CKP& p, int l, unsigned char* lds, unsigned* ctl) {
    for (int j = VBID(); j < 512; j += VGRID()) s5_job(p, l, j, 2, lds);

    unsigned char* R = p.ws + OFF_R; unsigned char* C = p.ws + OFF_C;
    const bf16_t* Qg = (const bf16_t*)(R + R_Q);
    const bf16_t* Kc = (const bf16_t*)(C + C_KCMP); const bf16_t* Vc = (const bf16_t*)(C + C_VCT);
    const bf16_t* Ks = (const bf16_t*)(R + R_KS); const bf16_t* Vs = (const bf16_t*)(R + R_VST);
    const bf16_t* Kw = (const bf16_t*)(R + R_KW); const bf16_t* Vw = (const bf16_t*)(R + R_VWT);
    const float* NG = (const float*)(R + R_NG);
    bf16_t* AO = (bf16_t*)(C + C_ATT);
    const int* pos = (const int*)p.in[1];
    unsigned* ctr = ctl + CTL_ATTN + l;
    volatile int* jobp = (volatile int*)(lds + AL_JOB);
    float* imp = (float*)(lds + AL_IMP);
    unsigned long long* selm = (unsigned long long*)(lds + AL_SEL);
    unsigned long long* uni = (unsigned long long*)(lds + AL_UNI);
    float invf[8];
#pragma unroll
    for (int q = 0; q < 8; ++q) invf[q] = p.inv_freq[q];

    for (;;) {
        const int tid = opaque_tid(), lane = tid & 63, w = tid >> 6, fr = lane & 15, fq = lane >> 4;
        vb_sync(lds);
        if (tid == 0) *jobp = (int)atomicAdd(ctr, 1u);
        vb_sync(lds);
        const int job = *jobp;
        if (job >= 1024) break;
        const int i = 63 - (job >> 4), bg = job & 15, b = bg >> 1, g = bg & 1, t0 = i * 64;
        const int tq = t0 + 16 * w + fr;
        const size_t kvrow = (size_t)b * SEQ;
        float gate[4];
        bf16_t* dstq = AO + ((size_t)(kvrow + tq)) * 512 + (g * 4) * 64;

        attn_load_q(Qg, pos, invf, b, g, t0, false, lds, tid);
        const int ntc = ((4 * i + 2) >> 6) + 1;
        const int hic = (tq >= 31) ? ((tq - 31) >> 4) : -1;
        float m[4], lsum[4];
#pragma unroll
        for (int qi = 0; qi < 4; ++qi) { m[qi] = -1e30f; lsum[qi] = 0.f; }
        auto cmp_next = [&](int ct) { return (ct + 1 < ntc) ? ct + 1 : -1; };
        auto cmp_ptrs = [&](int ct, const bf16_t*& Kb, const bf16_t*& Vb, int& vs) {
            Kb = Kc + ((size_t)(b * 256 + ct * 64)) * 128 + g * 64; Vb = Vc + ((size_t)((b * 2 + g) * 64)) * 256 + ct * 64; vs = 256; };
        attn_tiles(0, cmp_next, cmp_ptrs, [&](int ct, int kvoff) {
#pragma unroll 1
            for (int hf = 0; hf < 2; ++hf) {
                f32x4 s[2][4];
                attn_qk(s, lds, kvoff, w, fr, fq, hf);
                const unsigned vm = attn_vmask(ct * 64 + hf * 32, fq, 0, hic);
#pragma unroll
                for (int qi = 0; qi < 4; ++qi) {
                    float mx = -1e30f;
#pragma unroll
                    for (int ki = 0; ki < 2; ++ki)
#pragma unroll
                        for (int r = 0; r < 4; ++r) { const float sv = ((vm >> (ki * 4 + r)) & 1u) ? s[ki][qi][r] * SM_C : -1e30f; s[ki][qi][r] = sv; mx = fmaxf(mx, sv); }
                    mx = xmax16(mx); mx = xmax32(mx);
                    const float mn = fmaxf(m[qi], mx), alpha = fexp2(m[qi] - mn);
                    m[qi] = mn;
                    float ls = 0.f;
#pragma unroll
                    for (int ki = 0; ki < 2; ++ki)
#pragma unroll
                        for (int r = 0; r < 4; ++r) ls += ((vm >> (ki * 4 + r)) & 1u) ? fexp2(s[ki][qi][r] - mn) : 0.f;
                    lsum[qi] = lsum[qi] * alpha + ls;
                }
            }
        }, lds, tid);
        float invl[4];
#pragma unroll
        for (int qi = 0; qi < 4; ++qi) { float lt = lsum[qi]; lt = xsum16(lt); lt = xsum32(lt); invl[qi] = 1.f / fmaxf(lt, 1e-30f); }
        {
            f32x4 o[4][4]; zero_acc(o);
            float carry = 0.f;
            attn_tiles(0, cmp_next, cmp_ptrs, [&](int ct, int kvoff) {
#pragma unroll 1
                for (int hf = 0; hf < 2; ++hf) {
                    f32x4 s[2][4];
                    attn_qk(s, lds, kvoff, w, fr, fq, hf);
                    const unsigned vm = attn_vmask(ct * 64 + hf * 32, fq, 0, hic);
#pragma unroll
                    for (int qi = 0; qi < 4; ++qi)
#pragma unroll
                        for (int ki = 0; ki < 2; ++ki)
#pragma unroll
                            for (int r = 0; r < 4; ++r) s[ki][qi][r] = ((vm >> (ki * 4 + r)) & 1u) ? fexp2(s[ki][qi][r] * SM_C - m[qi]) * invl[qi] : 0.f;
#pragma unroll
                    for (int ki = 0; ki < 2; ++ki) {
                        float a = 0.f, bq = 0.f;
#pragma unroll
                        for (int qi = 0; qi < 4; ++qi) { a += s[ki][qi][0] + s[ki][qi][1] + s[ki][qi][2] + 0.5f * s[ki][qi][3]; bq += 0.5f * s[ki][qi][3]; }
                        const float up = __shfl(bq, (lane + 48) & 63);
                        const float wrap = __shfl(carry, (lane + 48) & 63);
                        a += (fq >= 1) ? up : wrap;
                        carry = bq;
                        imp[(16 * w + fr) * 65 + 16 * ct + 8 * hf + 4 * ki + fq] = a;
                    }
                    attn_pv(o, s, lds, kvoff, fr, fq, hf);
                }
            }, lds, tid);
#pragma unroll
            for (int qi = 0; qi < 4; ++qi) gate[qi] = NG[((size_t)(kvrow + tq)) * 24 + (g * 4 + qi) * 3 + 0];
            const float quarter[4] = {0.25f, 0.25f, 0.25f, 0.25f};
            attn_accum(dstq, o, quarter, gate, true, fq);
        }
        vb_sync(lds);
        {
            const int q = tid >> 2, part = tid & 3;
            unsigned long long mk = 0ull;
            if (i <= 15) { mk = (i == 63) ? ~0ull : ((1ull << (i + 1)) - 1ull); }
            else {
                const float* row = imp + q * 65;
                for (int j = 1 + part; j <= i - 2; j += 4) {
                    const float vj = row[j]; int rank = 0;
                    for (int j2 = 1; j2 <= i - 2; ++j2) { const float v2 = row[j2]; rank += (v2 > vj || (v2 == vj && j2 < j)) ? 1 : 0; }
                    if (rank < 13) mk |= 1ull << j;
                }
                unsigned lo32 = (unsigned)mk, hi32 = (unsigned)(mk >> 32);
                lo32 |= __shfl_xor(lo32, 1); hi32 |= __shfl_xor(hi32, 1);
                lo32 |= __shfl_xor(lo32, 2); hi32 |= __shfl_xor(hi32, 2);
                mk = ((unsigned long long)hi32 << 32) | lo32;
                mk |= 1ull | (1ull << i) | (1ull << (i - 1));
            }
            if (part == 0) selm[q] = mk;
            unsigned lo32 = (unsigned)mk, hi32 = (unsigned)(mk >> 32);
#pragma unroll
            for (int o2 = 32; o2 >= 1; o2 >>= 1) { lo32 |= __shfl_xor(lo32, o2); hi32 |= __shfl_xor(hi32, o2); }
            if (lane == 0) uni[w] = ((unsigned long long)hi32 << 32) | lo32;
        }
        vb_sync(lds);
        const unsigned long long mymask = selm[16 * w + fr];
        const unsigned long long un = uni[0] | uni[1] | uni[2] | uni[3];
        vb_sync(lds);
        attn_load_q((const bf16_t*)(R + R_QR), pos, invf, b, g, t0, false, lds, tid);
        {
            f32x4 o[4][4]; zero_acc(o);
#pragma unroll
            for (int qi = 0; qi < 4; ++qi) { m[qi] = -1e30f; lsum[qi] = 0.f; }
            attn_tiles(0,
                [&](int j) { const unsigned long long rest = (j >= 63) ? 0ull : (un >> (j + 1)); return rest ? (j + 1 + (int)__ffsll((long long)rest) - 1) : -1; },
                [&](int j, const bf16_t*& Kb, const bf16_t*& Vb, int& vs) { Kb = Ks + (kvrow + j * 64) * 128 + g * 64; Vb = Vs + ((size_t)((b * 2 + g) * 64)) * SEQ + j * 64; vs = SEQ; },
                [&](int j, int kvoff) {
                    const bool lsel = ((mymask >> j) & 1ull) != 0ull;
                    const int hi = lsel ? tq : -1;
#pragma unroll 1
                    for (int hf = 0; hf < 2; ++hf) {
                        f32x4 s[2][4];
                        attn_qk(s, lds, kvoff, w, fr, fq, hf);
                        if (j < i) attn_softmax_full(s, o, m, lsum, lsel);
                        else { const unsigned vm = attn_vmask(j * 64 + hf * 32, fq, 0, hi); attn_softmax(s, o, m, lsum, vm); }
                        attn_pv(o, s, lds, kvoff, fr, fq, hf);
                    }
                }, lds, tid);
#pragma unroll
            for (int qi = 0; qi < 4; ++qi) gate[qi] = NG[((size_t)(kvrow + tq)) * 24 + (g * 4 + qi) * 3 + 1];
            attn_accum(dstq, o, lsum, gate, false, fq);
        }
        {
            f32x4 o[4][4]; zero_acc(o);
#pragma unroll
            for (int qi = 0; qi < 4; ++qi) { m[qi] = -1e30f; lsum[qi] = 0.f; }
            const int j0 = (i >= 8) ? (i - 8) : 0;
            attn_tiles(j0,
                [&](int j) { return (j + 1 <= i) ? j + 1 : -1; },
                [&](int j, const bf16_t*& Kb, const bf16_t*& Vb, int& vs) { Kb = Kw + (kvrow + j * 64) * 128 + g * 64; Vb = Vw + ((size_t)((b * 2 + g) * 64)) * SEQ + j * 64; vs = SEQ; },
                [&](int j, int kvoff) {
#pragma unroll 1
                    for (int hf = 0; hf < 2; ++hf) {
                        f32x4 s[2][4];
                        attn_qk(s, lds, kvoff, w, fr, fq, hf);
                        if (j >= i - 7 && j < i) attn_softmax_full(s, o, m, lsum, true);
                        else { const unsigned vm = attn_vmask(j * 64 + hf * 32, fq, tq - 511, tq); attn_softmax(s, o, m, lsum, vm); }
                        attn_pv(o, s, lds, kvoff, fr, fq, hf);
                    }
                }, lds, tid);
#pragma unroll
            for (int qi = 0; qi < 4; ++qi) gate[qi] = NG[((size_t)(kvrow + tq)) * 24 + (g * 4 + qi) * 3 + 2];
            attn_accum(dstq, o, lsum, gate, false, fq);
        }
    }
}

__device__ __forceinline__ void phase_glu(CKP& p, int l, unsigned char* lds) {
    const int tid = opaque_tid(), lane = tid & 63, w = tid >> 6, wm = w >> 1, wn = w & 1, fr = lane & 15, fq = lane >> 4;
    const bf16_t* A = (const bf16_t*)(p.ws + OFF_C + C_YG);
    const bf16_t* Bt = (const bf16_t*)(p.ws + OFF_W + W_GLU);
    bf16_t* O = (bf16_t*)(p.ws + OFF_C + C_S5O);
    const float* gb = p.in[24] + (size_t)l * 256;
    constexpr int NTM = NTOK / 128, NTN = 2;
    for (int L = VBID(); L < NTM * NTN; L += VGRID()) {
        int tm, tn; tile_coords(L, NTM, NTN, tm, tn);
        const int m0 = tm * 128, n0 = tn * 128;
        f32x4 acc[4][4]; zero_acc(acc);
        gemm_kloop(acc, [&](int r) { return A + (size_t)(m0 + r) * 256; }, 64, [&](int v) { return Bt + (size_t)(n0 + v) * 256; }, 64, 4, lds, tid);
#pragma unroll
        for (int mi = 0; mi < 4; ++mi) {
            const int row = m0 + 64 * wm + 16 * mi + fr, col = n0 + 64 * wn + 16 * fq;
            const u32x4 y0 = *(const u32x4*)(A + (size_t)row * 256 + col), y1 = *(const u32x4*)(A + (size_t)row * 256 + col + 8);
            const unsigned yy[8] = {y0.x, y0.y, y0.z, y0.w, y1.x, y1.y, y1.z, y1.w};
            float v[16];
#pragma unroll
            for (int e = 0; e < 16; ++e) {
                const float y = (e & 1) ? bfhi(yy[e >> 1]) : bflo(yy[e >> 1]);
                v[e] = y * sigm(acc[mi][e >> 2][e & 3] + gb[col + e]);
            }
            store16bf(O + (size_t)row * 256 + col, v);
        }
    }
}

struct G8Branch {
    static constexpr bool GATHER = false;
    const char* ws;
    __device__ __forceinline__ bool next(int i, G8Unit& u, const int (&R)[2], const unsigned (&C2)[2]) const {
        const int T = i / 6, sub = i - T * 6, L = T * (int)gridDim.x + (int)blockIdx.x;
        if (L >= (NTOK / 256) * 4) return false;
        int pm, pn; tile_coords(L, NTOK / 256, 4, pm, pn); pm = __builtin_amdgcn_readfirstlane(pm); pn = __builtin_amdgcn_readfirstlane(pn);
        const int br = sub >> 1;
        if (sub & 1) { u.K2 = 2048u; u.nt = 16; u.A0 = ws + OFF_H + (size_t)pm * 256 * 2048; u.B0 = ws + OFF_W + W_GB + (size_t)(br * 1024 + pn * 256) * 2048; }
        else {
            const unsigned k2 = br == 0 ? 1024u : 512u; u.K2 = k2; u.nt = br == 0 ? 8 : 4;
            const size_t b1 = (size_t)(br == 1), b2 = (size_t)(br == 2);
            const char* a = ws + (size_t)(OFF_C + C_ATT) + b1 * (size_t)(C_SGU - C_ATT) + b2 * (size_t)(C_S5O - C_ATT);
            const char* w = ws + (size_t)(OFF_W + W_A) + b1 * (size_t)(W_S - W_A) + b2 * (size_t)(W_5 - W_A);
            u.A0 = a + (size_t)pm * 256 * k2; u.B0 = w + (size_t)pn * 256 * k2;
        }
        u.A1 = u.A0 + (size_t)128 * u.K2; u.B1 = u.B0 + (size_t)128 * u.K2;
        u.x0 = pm; u.x1 = pn; u.x2 = sub; u.x3 = 0;
#pragma unroll
        for (int h = 0; h < 2; ++h)
#pragma unroll
            for (int k = 0; k < 2; ++k) u.ao[h][k] = (unsigned)R[k] * u.K2 + C2[k];
        return true;
    }
};
struct EpiBranch {
    bf16_t* Yt; bf16_t* Mg;
    __device__ __forceinline__ void operator()(const G8Acc& acc, const G8Unit& u, int wr, int wc, int fr, int fq) const {
        const int sub = u.x2;
        const size_t off0 = (size_t)(u.x0 * 256 + wr * 64 + fr) * 1024 + u.x1 * 256 + wc * 32 + 8 * fq;
        if (!(sub & 1)) {
#pragma unroll
            for (int ai = 0; ai < 2; ++ai)
#pragma unroll
                for (int m = 0; m < 4; ++m)
#pragma unroll
                    for (int bj = 0; bj < 2; ++bj) {
                        const f32x4 v0 = acc[ai][bj][m][0], v1 = acc[ai][bj][m][1];
                        u32x4 o; o.x = pk_bf16(v0[0], v0[1]); o.y = pk_bf16(v0[2], v0[3]); o.z = pk_bf16(v1[0], v1[1]); o.w = pk_bf16(v1[2], v1[3]);
                        *(u32x4*)(Yt + off0 + (size_t)(ai * 128 + m * 16) * 1024 + bj * 128) = o;
                    }
        } else {
#pragma unroll
            for (int ai = 0; ai < 2; ++ai) {
                u32x4 y[4][2], pv[4][2];
#pragma unroll
                for (int m = 0; m < 4; ++m)
#pragma unroll
                    for (int bj = 0; bj < 2; ++bj) {
                        const size_t off = off0 + (size_t)(ai * 128 + m * 16) * 1024 + bj * 128;
                        y[m][bj] = *(const u32x4*)(Yt + off);
                        pv[m][bj] = (u32x4){0u, 0u, 0u, 0u};
                        if (sub > 1) pv[m][bj] = *(const u32x4*)(Mg + off);
                    }
#pragma unroll
                for (int m = 0; m < 4; ++m)
#pragma unroll
                    for (int bj = 0; bj < 2; ++bj) {
                        const f32x4 v0 = acc[ai][bj][m][0], v1 = acc[ai][bj][m][1];
                        const u32x4 yy = y[m][bj], pp = pv[m][bj];
                        u32x4 o;
                        o.x = pk_bf16(sigm(v0[0]) * bflo(yy.x) + bflo(pp.x), sigm(v0[1]) * bfhi(yy.x) + bfhi(pp.x));
                        o.y = pk_bf16(sigm(v0[2]) * bflo(yy.y) + bflo(pp.y), sigm(v0[3]) * bfhi(yy.y) + bfhi(pp.y));
                        o.z = pk_bf16(sigm(v1[0]) * bflo(yy.z) + bflo(pp.z), sigm(v1[1]) * bfhi(yy.z) + bfhi(pp.z));
                        o.w = pk_bf16(sigm(v1[2]) * bflo(yy.w) + bflo(pp.w), sigm(v1[3]) * bfhi(yy.w) + bfhi(pp.w));
                        *(u32x4*)(Mg + off0 + (size_t)(ai * 128 + m * 16) * 1024 + bj * 128) = o;
                    }
            }
        }
    }
};
__device__ __forceinline__ void phase_branch(CKP& p, int l, unsigned char* lds) {
    G8Branch S{(const char*)p.ws};
    EpiBranch E{(bf16_t*)(p.ws + OFF_R), (bf16_t*)(p.ws + OFF_M)};
    g8_phase(S, E);
}

struct EpiMix {
    float* x;
    __device__ __forceinline__ void operator()(const G8Acc& acc, const G8Unit& u, int wr, int wc, int fr, int fq) const {
        float* xp0 = x + (size_t)(u.x0 * 256 + wr * 64 + fr) * 1024 + u.x1 * 256 + wc * 32 + 8 * fq;
#pragma unroll
        for (int ai = 0; ai < 2; ++ai) {
            f32x4 xv[4][2][2];
#pragma unroll
            for (int m = 0; m < 4; ++m)
#pragma unroll
                for (int bj = 0; bj < 2; ++bj)
#pragma unroll
                    for (int n = 0; n < 2; ++n) xv[m][bj][n] = *(const f32x4*)(xp0 + (size_t)(ai * 128 + m * 16) * 1024 + bj * 128 + 4 * n);
#pragma unroll
            for (int m = 0; m < 4; ++m)
#pragma unroll
                for (int bj = 0; bj < 2; ++bj)
#pragma unroll
                    for (int n = 0; n < 2; ++n) *(f32x4*)(xp0 + (size_t)(ai * 128 + m * 16) * 1024 + bj * 128 + 4 * n) = xv[m][bj][n] + acc[ai][bj][m][n];
        }
    }
};
__device__ __forceinline__ void phase_mix(CKP& p, int l, unsigned char* lds) {
    G8Plain S{(const char*)(p.ws + OFF_M), (const char*)(p.ws + OFF_W + W_M), 2048u, 16, NTOK / 256, 4};
    EpiMix E{p.xbuf};
    g8_phase(S, E);
}

__device__ __forceinline__ void phase_router(CKP& p, int l, unsigned char* lds, unsigned* ctl) {
    const int tid = opaque_tid(), lane = tid & 63, w = tid >> 6, wm = w >> 1, wn = w & 1, fr = lane & 15, fq = lane >> 4;
    const float* gam = p.in[27] + (size_t)l * 1024;
    const float* bg = p.in[29] + (size_t)l * 4;
    const float* be = p.in[31] + (size_t)l * 32;
    bf16_t* h2 = (bf16_t*)(p.ws + OFF_M);
    bf16_t* hlo = (bf16_t*)(p.ws + OFF_H);
    const bf16_t* Wh = (const bf16_t*)(p.ws + OFF_W + W_RH);
    const bf16_t* Wl = (const bf16_t*)(p.ws + OFF_W + W_RL);
    unsigned* cnt = ctl + CTL_MOECNT + l * 32;
    int* list = (int*)(p.ws + OFF_MOE + MOE_LIST);
    float* wsl = (float*)(p.ws + OFF_MOE + MOE_WS);
    float* lg = (float*)lds;
    int* lc = (int*)(lds + 18432); int* gbs = (int*)(lds + 18432 + 128);
    for (int tile = VBID(); tile < NTOK / 128; tile += VGRID()) {
        const int r0 = tile * 128;
        {
            f32x4 gv[4];
#pragma unroll
            for (int i = 0; i < 4; ++i) gv[i] = *(const f32x4*)(gam + 4 * lane + 256 * i);
            for (int rr = 0; rr < 32; rr += 2) {
                const int row = r0 + w * 32 + rr;
                f32x4 xa[4], xb[4]; float sa = 0.f, sb = 0.f;
#pragma unroll
                for (int i = 0; i < 4; ++i) { xa[i] = *(const f32x4*)(p.xbuf + (size_t)row * 1024 + 4 * lane + 256 * i); xb[i] = *(const f32x4*)(p.xbuf + (size_t)(row + 1) * 1024 + 4 * lane + 256 * i); }
#pragma unroll
                for (int i = 0; i < 4; ++i) { sa += xa[i][0] * xa[i][0] + xa[i][1] * xa[i][1] + xa[i][2] * xa[i][2] + xa[i][3] * xa[i][3]; sb += xb[i][0] * xb[i][0] + xb[i][1] * xb[i][1] + xb[i][2] * xb[i][2] + xb[i][3] * xb[i][3]; }
                sa = wave_sum(sa); sb = wave_sum(sb);
                const float ra_ = rsqrtf(sa * (1.f / 1024.f) + RMS_EPS), rb_ = rsqrtf(sb * (1.f / 1024.f) + RMS_EPS);
#pragma unroll
                for (int i = 0; i < 4; ++i) {
                    const f32x4 ha = xa[i] * ra_ * gv[i], hb = xb[i] * rb_ * gv[i];
                    u32x2 oa, ob, la, lb;
                    oa.x = pk_bf16(ha[0], ha[1]); oa.y = pk_bf16(ha[2], ha[3]); ob.x = pk_bf16(hb[0], hb[1]); ob.y = pk_bf16(hb[2], hb[3]);
                    la.x = pk_bf16(ha[0] - bflo(oa.x), ha[1] - bfhi(oa.x)); la.y = pk_bf16(ha[2] - bflo(oa.y), ha[3] - bfhi(oa.y));
                    lb.x = pk_bf16(hb[0] - bflo(ob.x), hb[1] - bfhi(ob.x)); lb.y = pk_bf16(hb[2] - bflo(ob.y), hb[3] - bfhi(ob.y));
                    *(u32x2*)(h2 + (size_t)row * 1024 + 4 * lane + 256 * i) = oa; *(u32x2*)(h2 + (size_t)(row + 1) * 1024 + 4 * lane + 256 * i) = ob;
                    *(u32x2*)(hlo + (size_t)row * 1024 + 4 * lane + 256 * i) = la; *(u32x2*)(hlo + (size_t)(row + 1) * 1024 + 4 * lane + 256 * i) = lb;
                }
            }
        }
        asm volatile("s_waitcnt vmcnt(0)" ::: "memory");
        vb_sync(lds);
        f32x4 acc[4][4]; zero_acc(acc);
        gemm_kloop(acc, [&](int r) { return h2 + (size_t)(r0 + r) * 1024; }, 64, [&](int v) { return Wh + (size_t)(v < 63 ? v : 63) * 1024; }, 64, 16, lds, tid);
        gemm_kloop(acc, [&](int r) { return h2 + (size_t)(r0 + r) * 1024; }, 64, [&](int v) { return Wl + (size_t)(v < 63 ? v : 63) * 1024; }, 64, 16, lds, tid);
        gemm_kloop(acc, [&](int r) { return hlo + (size_t)(r0 + r) * 1024; }, 64, [&](int v) { return Wh + (size_t)(v < 63 ? v : 63) * 1024; }, 64, 16, lds, tid);
        if (tid < 32) lc[tid] = 0;
        if (wn == 0 && fq < 3) {
#pragma unroll
            for (int mi = 0; mi < 4; ++mi) {
                const int row = 64 * wm + 16 * mi + fr;
#pragma unroll
                for (int e = 0; e < 16; ++e) { const int col = 16 * fq + e; if (col < 36) lg[row * 36 + col] = acc[mi][e >> 2][e & 3]; }
            }
        }
        vb_sync(lds);
        int e0 = 0, e1 = 0, lr0 = 0, lr1 = 0; float c0 = 0.f, c1 = 0.f;
        if (tid < 128) {
            const float* lrow = lg + tid * 36;
            float gl[4]; int grp = 0; float gm = -3.4e38f;
#pragma unroll
            for (int q = 0; q < 4; ++q) { gl[q] = lrow[q] + bg[q]; if (gl[q] > gm) { gm = gl[q]; grp = q; } }
            float gsum = 0.f;
#pragma unroll
            for (int q = 0; q < 4; ++q) gsum += expf(gl[q] - gm);
            const float grp_w = 1.f / gsum;
            float el[8]; float em = -3.4e38f;
#pragma unroll
            for (int q = 0; q < 8; ++q) { el[q] = lrow[4 + grp * 8 + q] + be[grp * 8 + q]; em = fmaxf(em, el[q]); }
            float esum = 0.f; float ep[8];
#pragma unroll
            for (int q = 0; q < 8; ++q) { ep[q] = expf(el[q] - em); esum += ep[q]; }
            int j0 = 0; float p0 = -1.f;
#pragma unroll
            for (int q = 0; q < 8; ++q) { const float pq = ep[q] / esum; ep[q] = pq; if (pq > p0) { p0 = pq; j0 = q; } }
            int j1 = 0; float p1 = -1.f;
#pragma unroll
            for (int q = 0; q < 8; ++q) { if (q != j0 && ep[q] > p1) { p1 = ep[q]; j1 = q; } }
            const float den = p0 + p1;
            c0 = grp_w * p0 / den; c1 = grp_w * p1 / den;
            e0 = grp * 8 + j0; e1 = grp * 8 + j1;
            lr0 = atomicAdd(&lc[e0], 1); lr1 = atomicAdd(&lc[e1], 1);
        }
        vb_sync(lds);
        if (tid < 32) { const int n = lc[tid]; gbs[tid] = n ? (int)atomicAdd(&cnt[tid], (unsigned)n) : 0; }
        vb_sync(lds);
        if (tid < 128) {
            const int tok = r0 + tid;
            list[e0 * 32768 + gbs[e0] + lr0] = tok * 2; list[e1 * 32768 + gbs[e1] + lr1] = tok * 2 + 1;
            wsl[tok * 2] = c0; wsl[tok * 2 + 1] = c1;
        }
        vb_sync(lds);
    }
}

__device__ __forceinline__ bool moe_unit(const unsigned* cnt, int i, int& e, int& mt, int& sub, int& rowbase, int& n) {
    int lane = threadIdx.x & 63; asm volatile("" : "+v"(lane));
    const int c = (lane < 32) ? (int)cnt[lane] : 0;
    const int nt = (c + 255) >> 8, nt128 = (c + 127) >> 7;
    int pre = nt, pre128 = nt128;
#pragma unroll
    for (int o = 1; o < 32; o <<= 1) {
        const int src = (lane - o) << 2;
        const int v = __builtin_amdgcn_ds_bpermute(src, pre), v2 = __builtin_amdgcn_ds_bpermute(src, pre128);
        if (lane >= o) { pre += v; pre128 += v2; }
    }
    const int total = __builtin_amdgcn_readlane(pre, 31) * 4;
    const int Lp = i * (int)gridDim.x + (int)blockIdx.x, q = (total + 7) >> 3, off = Lp >> 3;
    const int L = (Lp & 7) * q + off;
    if (off >= q || L >= total) return false;
    const int excl = pre - nt;
    const bool mine = (lane < 32) && (L >= excl * 4) && (L < pre * 4);
    const unsigned long long bal = __ballot(mine);
    if (bal == 0ull) return false;
    const int ee = __builtin_amdgcn_readfirstlane(__ffsll((long long)bal) - 1);
    e = ee;
    n = __builtin_amdgcn_readlane(c, ee);
    rowbase = __builtin_amdgcn_readlane(pre128 - nt128, ee) * 128;
    const int r = L - __builtin_amdgcn_readlane(excl, ee) * 4;
    mt = r >> 2; sub = r & 3;
    return true;
}
struct G8Exp1 {
    static constexpr bool GATHER = true;
    const unsigned* cnt; const int* list; const char* h2; const char* Wg; const char* Wu;
    __device__ __forceinline__ bool next(int i, G8Unit& u, const int (&R)[2], const unsigned (&C2)[2]) const {
        int e, mt, sub, rowbase, n;
        if (!moe_unit(cnt, i, e, mt, sub, rowbase, n)) return false;
        u.A0 = h2; u.A1 = h2; u.K2 = 2048u; u.nt = 16;
        u.B0 = Wg + ((size_t)e * 512 + sub * 128) * 2048; u.B1 = Wu + ((size_t)e * 512 + sub * 128) * 2048;
        u.x0 = e; u.x1 = mt; u.x2 = sub; u.x3 = rowbase; u.n = n;
#pragma unroll
        for (int h = 0; h < 2; ++h)
#pragma unroll
            for (int k = 0; k < 2; ++k) { int sidx = mt * 256 + h * 128 + R[k]; sidx = sidx < n ? sidx : n - 1; u.ao[h][k] = (unsigned)(list[e * 32768 + sidx] >> 1) * 2048u + C2[k]; }
        return true;
    }
};
struct EpiExp1 {
    bf16_t* hid;
    __device__ __forceinline__ void operator()(const G8Acc& acc, const G8Unit& u, int wr, int wc, int fr, int fq) const {
#pragma unroll
        for (int ai = 0; ai < 2; ++ai)
#pragma unroll
            for (int m = 0; m < 4; ++m) {
                const int r = u.x1 * 256 + ai * 128 + wr * 64 + m * 16 + fr;
                if (r < u.n) {
                    float hv[8];
#pragma unroll
                    for (int j = 0; j < 8; ++j) { const float g = acc[ai][0][m][j >> 2][j & 3], up = acc[ai][1][m][j >> 2][j & 3]; hv[j] = g * sigm(g) * up; }
                    u32x4 o; o.x = pk_bf16(hv[0], hv[1]); o.y = pk_bf16(hv[2], hv[3]); o.z = pk_bf16(hv[4], hv[5]); o.w = pk_bf16(hv[6], hv[7]);
                    *(u32x4*)(hid + (size_t)(u.x3 + r) * 512 + u.x2 * 128 + wc * 32 + 8 * fq) = o;
                }
            }
    }
};
__device__ __forceinline__ void phase_exp1(CKP& p, int l, unsigned char* lds, unsigned* ctl) {
    G8Exp1 S{ctl + CTL_MOECNT + l * 32, (const int*)(p.ws + OFF_MOE + MOE_LIST), (const char*)(p.ws + OFF_M), (const char*)(p.ws + OFF_W + W_EG), (const char*)(p.ws + OFF_W + W_EU)};
    EpiExp1 E{(bf16_t*)(p.ws + OFF_HID)};
    g8_phase(S, E);
}
struct G8Exp2 {
    static constexpr bool GATHER = true;
    const unsigned* cnt; const char* hid; const char* Wd;
    __device__ __forceinline__ bool next(int i, G8Unit& u, const int (&R)[2], const unsigned (&C2)[2]) const {
        int e, mt, sub, rowbase, n;
        if (!moe_unit(cnt, i, e, mt, sub, rowbase, n)) return false;
        u.A0 = hid + (size_t)(rowbase + mt * 256) * 1024; u.A1 = u.A0; u.K2 = 1024u; u.nt = 8;
        u.B0 = Wd + ((size_t)e * 1024 + sub * 256) * 1024; u.B1 = u.B0 + (size_t)128 * 1024;
        u.x0 = e; u.x1 = mt; u.x2 = sub; u.x3 = rowbase; u.n = n;
        const int lim = n - mt * 256 - 1;
#pragma unroll
        for (int h = 0; h < 2; ++h)
#pragma unroll
            for (int k = 0; k < 2; ++k) { const int rr = h * 128 + R[k]; u.ao[h][k] = (unsigned)(rr < lim ? rr : lim) * 1024u + C2[k]; }
        return true;
    }
};
struct EpiExp2 {
    const int* list; const float* wsl; bf16_t* ys;
    __device__ __forceinline__ void operator()(const G8Acc& acc, const G8Unit& u, int wr, int wc, int fr, int fq) const {
        int slot[2][4]; float wt[2][4];
#pragma unroll
        for (int ai = 0; ai < 2; ++ai)
#pragma unroll
            for (int m = 0; m < 4; ++m) { int r = u.x1 * 256 + ai * 128 + wr * 64 + m * 16 + fr; r = r < u.n ? r : u.n - 1; slot[ai][m] = list[u.x0 * 32768 + r]; }
#pragma unroll
        for (int ai = 0; ai < 2; ++ai)
#pragma unroll
            for (int m = 0; m < 4; ++m) wt[ai][m] = wsl[slot[ai][m]];
#pragma unroll
        for (int ai = 0; ai < 2; ++ai)
#pragma unroll
            for (int m = 0; m < 4; ++m) {
                const int r = u.x1 * 256 + ai * 128 + wr * 64 + m * 16 + fr;
                if (r < u.n) {
                    bf16_t* dst = ys + (size_t)slot[ai][m] * 1024 + u.x2 * 256 + wc * 32 + 8 * fq;
                    const float w = wt[ai][m];
#pragma unroll
                    for (int bj = 0; bj < 2; ++bj) {
                        const f32x4 v0 = acc[ai][bj][m][0] * w, v1 = acc[ai][bj][m][1] * w;
                        u32x4 o; o.x = pk_bf16(v0[0], v0[1]); o.y = pk_bf16(v0[2], v0[3]); o.z = pk_bf16(v1[0], v1[1]); o.w = pk_bf16(v1[2], v1[3]);
                        *(u32x4*)(dst + bj * 128) = o;
                    }
                }
            }
    }
};
__device__ __forceinline__ void phase_exp2(CKP& p, int l, unsigned char* lds, unsigned* ctl) {
    G8Exp2 S{ctl + CTL_MOECNT + l * 32, (const char*)(p.ws + OFF_HID), (const char*)(p.ws + OFF_W + W_ED)};
    EpiExp2 E{(const int*)(p.ws + OFF_MOE + MOE_LIST), (const float*)(p.ws + OFF_MOE + MOE_WS), (bf16_t*)(p.ws + OFF_YS)};
    g8_phase(S, E);
}

constexpr int PH_PER_LAYER = 10;
constexpr int NPHASE = PH_PER_LAYER * DEPTH + 1;

__global__ __attribute__((target("no-packed-fp32-ops"))) void __launch_bounds__(NTHR_HW, 1) mega(KP p_unused) {
    extern __shared__ __attribute__((aligned(16))) unsigned char lds_all[];
    if ((threadIdx.x & 255) == 0) *(volatile unsigned*)(lds_all + VB_CTR + ((threadIdx.x >> 8) << 6)) = 0u;
    __syncthreads();
    unsigned* ctl = (unsigned*)(p_unused.ws + OFF_CTL);
#if ONE_LAUNCH
    XcdBarrier xb = xcd_barrier_post(ctl + CTL_BAR, (volatile LAS unsigned*)(lds_all + 2 * VB_LDS - 16));
    if (p_unused.never) cg::this_grid().sync();
#if DBG_PREFLUSH
    __builtin_amdgcn_fence(__ATOMIC_RELEASE, "");
    asm volatile("s_waitcnt vmcnt(0)" ::: "memory");
    __builtin_amdgcn_fence(__ATOMIC_ACQUIRE, "");
    asm volatile("s_waitcnt vmcnt(0)" ::: "memory");
    xcd_barrier(xb);
    { const unsigned long long t0 = __builtin_amdgcn_s_memrealtime(); while (__builtin_amdgcn_s_memrealtime() - t0 < 20000ull) __builtin_amdgcn_s_sleep(8); }
    xcd_barrier(xb);
#endif
#endif
    CKP* kp0 = (CKP*)__builtin_amdgcn_kernarg_segment_ptr();
    const int ph_lo = kp0->ph_lo, ph_hi = kp0->ph_hi;
#if ONE_LAUNCH
#define PH_SYNC(PH) if ((PH) + 1 < ph_hi) xcd_barrier(xb);
#else
#define PH_SYNC(PH)
#endif
#if DBG_TIMEPH >= 0
#define PH_STAMP(PH) if (blockIdx.x == 0 && threadIdx.x == 0) ((unsigned long long*)(kp0->ws + OFF_CTL + 24576))[(PH)] = __builtin_amdgcn_s_memrealtime();
#else
#define PH_STAMP(PH)
#endif
#define RUN_PHASE(PH, CALL) if (ph_lo <= (PH) && (PH) < ph_hi) { PH_STAMP(PH) CKP* kp = kp0; asm volatile("" : "+s"(kp)); CKP& p = *kp; const int rep_ = 0; (void)rep_; unsigned char* lds = vb_lds(); CALL; \
    if ((PH) == DBG_REPEAT_PH) { xcd_barrier(xb); const int rep_ = 1; (void)rep_; CALL; } PH_SYNC(PH) }
#define RUN_LAYER(L) \
    RUN_PHASE((L) * 10 + 0, phase_prep(p, (L), lds)) \
    RUN_PHASE((L) * 10 + 1, phase_inproj(p, (L), lds)) \
    RUN_PHASE((L) * 10 + 2, phase_mid1(p, (L), lds)) \
    RUN_PHASE((L) * 10 + 3, phase_attn(p, (L), lds, ctl + 2 * rep_)) \
    RUN_PHASE((L) * 10 + 4, phase_glu(p, (L), lds)) \
    RUN_PHASE((L) * 10 + 5, phase_branch(p, (L), lds)) \
    RUN_PHASE((L) * 10 + 6, phase_mix(p, (L), lds)) \
    RUN_PHASE((L) * 10 + 7, phase_router(p, (L), lds, ctl)) \
    RUN_PHASE((L) * 10 + 8, phase_exp1(p, (L), lds, ctl)) \
    RUN_PHASE((L) * 10 + 9, phase_exp2(p, (L), lds, ctl))
#if DBG_SMALLK
    RUN_PHASE(0, phase_prep(p, 0, lds))
    RUN_PHASE(1, phase_inproj(p, 0, lds))
    RUN_PHASE(2, phase_mid1(p, 0, lds))
#else
    RUN_LAYER(0)
    RUN_LAYER(1)
    RUN_PHASE(20, phase_prep(p, 2, lds))
#endif
#if ONE_LAUNCH && DBG_DUMP
    {
        xcd_barrier(xb);
        CKP* kp = kp0; asm volatile("" : "+s"(kp)); CKP& p = *kp;
        const size_t NO = (size_t)NTOK * 1024;
        const unsigned char* src = p.ws + DBG_DUMP_OFF;
        for (size_t i = (size_t)blockIdx.x * NTHR_HW + threadIdx.x; i < NO; i += (size_t)gridDim.x * NTHR_HW) {
            float v = 0.f;
            if (i < (size_t)DBG_DUMP_N) {
                if (DBG_DUMP_F32) {
                    const size_t si = DBG_DUMP_REV ? ((size_t)DBG_DUMP_N - 1 - i) : i;
#if DBG_SC1READ
                    const unsigned fu = __hip_atomic_load((const unsigned*)src + si, __ATOMIC_RELAXED, __HIP_MEMORY_SCOPE_SYSTEM); const float f = __uint_as_float(fu);
#else
                    const float f = ((const float*)src)[si];
#endif
                    v = DBG_HASH ? (float)(__float_as_uint(f) & 0x3ff) : f;
#if DBG_EFILT
                    { const int id_ = (int)(((si >> 7) - DBG_IDROT) & 2047), blk = ((id_ >> 2) + 320) & 511; if (!(blk >= DBG_EFILT_LO && blk < DBG_EFILT_HI)) v = 0.f; }
#endif
#if DBG_E2
                    { const float f2 = ((const float*)(p.ws + OFF_C + C_ATT))[i]; v = (__float_as_uint(f2) == __float_as_uint(f)) ? 0.f : 1000.f; if (i == 0) v += 1.f; }
#endif
                }
                else { const bf16_t h = ((const bf16_t*)src)[i]; v = DBG_HASH ? (float)(h & 0x3ff) : bf2f(h); }
            }
#if DBG_CONSTOUT
            v = 1000.f + (float)(i & 1023);
#endif
            p.xbuf[i] = v;
        }
    }
#endif
}

#if DBG_DUMP
__global__ void dbg_dump(const bf16_t* src, size_t n, float* out, size_t nout) {
    for (size_t i = (size_t)blockIdx.x * blockDim.x + threadIdx.x; i < nout; i += (size_t)gridDim.x * blockDim.x)
        out[i] = i < n ? (DBG_HASH ? (float)(src[i] & 0x3ff) : bf2f(src[i])) : 0.f;
}
__global__ void dbg_dump_f32(const float* src, size_t n, float* out, size_t nout) {
    for (size_t i = (size_t)blockIdx.x * blockDim.x + threadIdx.x; i < nout; i += (size_t)gridDim.x * blockDim.x)
        out[i] = i < n ? (DBG_HASH ? (float)(__float_as_uint(src[i]) & 0x3ff) : src[i]) : 0.f;
}
#endif
extern "C" void kernel_launch(void* const* d_in, const int* in_sizes, int n_in, void* d_out, int out_size, void* d_ws, size_t ws_size, hipStream_t stream) {
    static int grid = 0;
    if (grid == 0) {
        if (n_in != 36 || out_size != NTOK * DM || ws_size < WS_END) { fprintf(stderr, "kernel_launch: unexpected shapes n_in %d out %d ws %zu (need %zu)\n", n_in, out_size, ws_size, (size_t)WS_END); grid = -1; return; }
        int dev = 0, cus = 0, per_cu = 0;
        hipGetDevice(&dev);
        hipDeviceGetAttribute(&cus, hipDeviceAttributeMultiprocessorCount, dev);
        hipFuncSetAttribute((const void*)mega, hipFuncAttributeMaxDynamicSharedMemorySize, LDS_BYTES);
        hipOccupancyMaxActiveBlocksPerMultiprocessor(&per_cu, (const void*)mega, NTHR_HW, LDS_BYTES);
        if (per_cu < 1) { fprintf(stderr, "kernel_launch: occupancy query says %d\n", per_cu); per_cu = 1; }
        if (per_cu > MAX_PER_CU) per_cu = MAX_PER_CU;
        grid = cus * per_cu;
        fprintf(stderr, "kernel_launch: grid %d (%d CUs x %d)\n", grid, cus, per_cu);
    }
    if (grid < 0) return;
    hipMemsetAsync((char*)d_ws + OFF_CTL, 0, CTL_BYTES, stream);
    KP p{};
    for (int i = 0; i < 36; ++i) p.in[i] = (const float*)d_in[i];
    p.xbuf = (float*)d_out; p.ws = (unsigned char*)d_ws;
    for (int i = 0; i < 8; ++i) p.inv_freq[i] = (float)pow(500000.0, -(double)i / 8.0);
    p.never = 0; p.pad = 0;
#if ONE_LAUNCH
    p.ph_lo = 0; p.ph_hi = DBG_PH_HI;
    void* args[] = {&p};
    hipError_t e = hipLaunchCooperativeKernel((const void*)mega, dim3(grid), dim3(NTHR_HW), args, LDS_BYTES, stream);
    if (e != hipSuccess) fprintf(stderr, "cooperative launch failed: %s (grid %d)\n", hipGetErrorString(e), grid);
#else
    for (int ph = 0; ph < NPHASE; ++ph) {
        if (!((DBG_MASK >> ph) & 1)) continue;
        p.ph_lo = ph; p.ph_hi = ph + 1;
        hipLaunchKernelGGL(mega, dim3(grid), dim3(NTHR_HW), LDS_BYTES, stream, p);
    }
#if DBG_DUMP
    {
        const unsigned char* w = (const unsigned char*)d_ws; const size_t NO = (size_t)NTOK * 1024;
        size_t off = 0, n = 0; bool f32 = false;
        switch (DBG_DUMP) {
            case 1: off = OFF_C + C_ATT; n = (size_t)NTOK * 512; break;
            case 2: off = OFF_C + C_SGU; n = (size_t)NTOK * 256; break;
            case 3: off = OFF_C + C_S5O; n = (size_t)NTOK * 256; break;
            case 4: off = OFF_M; n = (size_t)NTOK * 1024; break;
            case 5: off = OFF_R + R_Q; n = (size_t)NTOK * 512; break;
            case 6: off = OFF_H; n = (size_t)NTOK * 1024; break;
            case 7: off = OFF_C + C_YG; n = (size_t)NTOK * 256; break;
            case 8: off = OFF_C + C_KCMP; n = (size_t)2 * 524288 / 2; break;
            case 9: off = OFF_R + R_KC; n = (size_t)NTOK * 128 * 6; break;
            case 10: off = OFF_R + R_NG; n = (size_t)NTOK * 24; f32 = true; break;
            case 11: off = OFF_R + R_U; n = (size_t)NTOK * 768; break;
            case 12: off = OFF_C + C_S5E; n = (size_t)128 * 16 * 64 * 2; f32 = true; break;
            case 15: off = 0; n = (size_t)NTOK * 1024; f32 = true; break;
            case 16: off = OFF_W + W_S5A; n = 36864; f32 = true; break;
            case 13: off = OFF_YS; n = (size_t)NTOK * 1024; break;
            case 14: off = OFF_MOE + MOE_WS; n = 65536; f32 = true; break;
            default: break;
        }
        if (DBG_DUMP == 15) hipLaunchKernelGGL(dbg_dump_f32, dim3(2048), dim3(256), 0, stream, (const float*)d_out, n, (float*)d_out, NO);
        else if (f32) hipLaunchKernelGGL(dbg_dump_f32, dim3(2048), dim3(256), 0, stream, (const float*)(w + off), n, (float*)d_out, NO);
        else hipLaunchKernelGGL(dbg_dump, dim3(2048), dim3(256), 0, stream, (const bf16_t*)(w + off), n, (float*)d_out, NO);
    }
#endif
#endif
}
```

```cpp
#include <hip/hip_runtime.h>
#include <hip/hip_cooperative_groups.h>
#include <cstdio>
#include <cstdint>
#include <cmath>
namespace cg = cooperative_groups;

#ifndef ONE_LAUNCH
#define ONE_LAUNCH 1
#endif
#ifndef DBG_MASK
#define DBG_MASK 0x1fffff
#endif
#ifndef DBG_NOCOMBINE
#define DBG_NOCOMBINE 0
#endif
#ifndef DBG_DUMP
#define DBG_DUMP 0
#endif
#ifndef DBG_HASH
#define DBG_HASH 0
#endif
#ifndef DBG_ONLYS5
#define DBG_ONLYS5 0
#endif
#ifndef DBG_NOCSTORE
#define DBG_NOCSTORE 0
#endif
#ifndef DBG_LDSCHK
#define DBG_LDSCHK 0
#endif
#ifndef DBG_TWICE
#define DBG_TWICE 0
#endif
#ifndef DBG_S5CONST
#define DBG_S5CONST 0
#endif
#ifndef DBG_SC1READ
#define DBG_SC1READ 0
#endif
#ifndef DBG_E2
#define DBG_E2 0
#endif
#ifndef DBG_JOBFENCE
#define DBG_JOBFENCE 0
#endif
#ifndef DBG_CONSTOUT
#define DBG_CONSTOUT 0
#endif
#ifndef DBG_QDELAY
#define DBG_QDELAY 0
#endif
#ifndef DBG_SMALLK
#define DBG_SMALLK 0
#endif
#ifndef DBG_REPEAT_PH
#define DBG_REPEAT_PH -1
#endif
#ifndef DBG_TIMEPH
#define DBG_TIMEPH -1
#endif
#ifndef DBG_TIMEPH2
#define DBG_TIMEPH2 (DBG_TIMEPH + 1)
#endif
#ifndef DBG_PRESPIN
#define DBG_PRESPIN 0
#endif
#ifndef DBG_SGUSPIN
#define DBG_SGUSPIN 0
#endif
#ifndef DBG_PREFLUSH
#define DBG_PREFLUSH 0
#endif
#ifndef DBG_ESC1
#define DBG_ESC1 0
#endif
#ifndef DBG_DELAY
#define DBG_DELAY 0
#endif
#ifndef DBG_IDROT
#define DBG_IDROT 0
#endif
#ifndef DBG_DUMP_REV
#define DBG_DUMP_REV 0
#endif
#ifndef DBG_SGUCUT
#define DBG_SGUCUT 0
#endif
#ifndef DBG_EFILT
#define DBG_EFILT 0
#define DBG_EFILT_LO 0
#define DBG_EFILT_HI 0
#endif
#ifndef DBG_DUMP_OFF
#define DBG_DUMP_OFF 0
#define DBG_DUMP_N 0
#define DBG_DUMP_F32 0
#endif
#ifndef DBG_PH_HI
#define DBG_PH_HI NPHASE
#endif

typedef unsigned short bf16_t;
typedef short bf16x8 __attribute__((ext_vector_type(8)));
typedef float f32x4 __attribute__((ext_vector_type(4)));
typedef unsigned u32x4 __attribute__((ext_vector_type(4)));
typedef unsigned u32x2 __attribute__((ext_vector_type(2)));

constexpr int DM = 1024, NB = 8, SEQ = 4096, NTOK = NB * SEQ, DEPTH = 2;
constexpr int NCMP = 255;
constexpr float RMS_EPS = 1e-6f;
constexpr int NTHR = 256;
constexpr int NTHR_HW = 512;
constexpr int VB_LDS = 68096;
constexpr int LDS_BAR = 67584;
#ifndef MAX_PER_CU
#define MAX_PER_CU 1
#endif
#ifndef LDS_TOTAL
#define LDS_TOTAL (2 * 68096 + 192)
#endif
constexpr int LDS_BYTES = LDS_TOTAL;

constexpr size_t OFF_CTL = 0;
constexpr size_t OFF_W = 65536;
constexpr size_t W_IN = 0, W_GB = 4456448, W_A = 10747904, W_S = 11796480, W_5 = 12320768, W_M = 12845056, W_GLU = 14942208,
                 W_C1 = 15073280, W_C2 = 16121856, W_PB = 16154624, W_SGU = 16155648, W_S5A = 16286720, W_S5A256 = 16294912,
                 W_S5B = 16303104, W_S5C = 16434176, W_RH = 16499712, W_RL = 16630784, W_EG = 16777216, W_EU = 50331648, W_ED = 83886080, W_END = 117440512;
constexpr size_t OFF_H = OFF_W + W_END;
constexpr size_t OFF_M = OFF_H + 67108864;
constexpr size_t OFF_R = OFF_M + 67108864;
constexpr size_t R_Q = 0, R_KC = 33554432, R_VC = 41943040, R_KS = 50331648, R_KW = 58720256, R_VST = 67108864, R_VWT = 75497472,
                 R_NG = 83886080, R_U = 87031808, R_V = 103809024, R_S5IN = 120586240, R_QR = 137363456, R_END = 170917888;
constexpr size_t OFF_C = OFF_R + R_END;
constexpr size_t C_ATT = 0, C_SGU = 33554432, C_YG = 50331648, C_S5O = 67108864, C_KCMP = 83886080, C_VCT = 84410368, C_S5E = 84934656, C_END = 85983232;
constexpr size_t OFF_MOE = OFF_C + C_END;
constexpr size_t MOE_LIST = 0, MOE_WS = 4194304, MOE_END = 4456448;
constexpr size_t OFF_ROPE = OFF_MOE + MOE_END;
constexpr size_t OFF_X = OFF_ROPE + (size_t)NTOK * 64;
constexpr size_t WS_END = OFF_X + (size_t)NTOK * 2048;
constexpr size_t OFF_HID = OFF_R;
constexpr size_t OFF_YS = OFF_R + 71303168;
static_assert(OFF_YS + 134217728 <= OFF_C + C_KCMP, "alias overflow");

constexpr int CTL_BAR = 0;
constexpr int CTL_MOECNT = 4096;
constexpr int CTL_ATTN = 4096 + 64;
constexpr int CTL_BYTES = 32768;

struct KP {
    const float* in[36];
    float* xbuf;
    unsigned char* ws;
    float inv_freq[8];
    int ph_lo, ph_hi;
    int never;
    int pad;
};

typedef const KP __attribute__((address_space(4))) CKP;

typedef float f32x2_t __attribute__((ext_vector_type(2)));
typedef __bf16 bf16x2_t __attribute__((ext_vector_type(2)));
__device__ __forceinline__ unsigned pk_bf16(float lo, float hi) {
    const f32x2_t v = {lo, hi};
    union { bf16x2_t b; unsigned u; } x; x.b = __builtin_convertvector(v, bf16x2_t); return x.u;
}
__device__ __forceinline__ bf16_t f2bf(float f) { return (bf16_t)(pk_bf16(f, 0.f) & 0xffffu); }
__device__ __forceinline__ float bf2f(bf16_t b) { return __uint_as_float(((unsigned)b) << 16); }
__device__ __forceinline__ float bflo(unsigned u) { return __uint_as_float(u << 16); }
__device__ __forceinline__ float bfhi(unsigned u) { return __uint_as_float(u & 0xffff0000u); }
__device__ __forceinline__ float fexp2(float x) { return __builtin_amdgcn_exp2f(x); }
__device__ __forceinline__ float gelu_tanh(float x) {
    const float u = 0.7978845608028654f * (x + 0.044715f * x * x * x);
    const float e = fexp2(2.885390081777927f * u);
    const float t = 1.f - 2.f * __builtin_amdgcn_rcpf(e + 1.f);
    return 0.5f * x * (1.f + t);
}
__device__ __forceinline__ float sigm(float x) { return __builtin_amdgcn_rcpf(1.f + fexp2(-1.4426950408889634f * x)); }
__device__ __forceinline__ int opaque_tid() { int t = threadIdx.x & 255; asm volatile("" : "+v"(t)); return t; }
__device__ __forceinline__ int VBID() { return (int)blockIdx.x * 2 + (int)(threadIdx.x >> 8); }
__device__ __forceinline__ int VGRID() { return (int)gridDim.x * 2; }
constexpr int VB_CTR = 2 * 68096;
__device__ __forceinline__ unsigned char* lds_base() { extern __shared__ __attribute__((aligned(16))) unsigned char lds_all_[]; return lds_all_; }
__device__ __forceinline__ unsigned char* vb_lds() { int t = threadIdx.x; asm volatile("" : "+v"(t)); return lds_base() + (t >> 8) * VB_LDS; }
__device__ __forceinline__ void vb_sync(unsigned char* lds) {
    asm volatile("s_waitcnt lgkmcnt(0)" ::: "memory");
    if ((threadIdx.x & 63) == 0) {
        __attribute__((address_space(3))) unsigned* c = (__attribute__((address_space(3))) unsigned*)(lds_base() + VB_CTR + ((threadIdx.x >> 8) << 6));
        const unsigned old = __hip_atomic_fetch_add(c, 1u, __ATOMIC_RELAXED, __HIP_MEMORY_SCOPE_WORKGROUP);
        const unsigned target = (old & ~3u) + 4u;
        while ((int)(__hip_atomic_load(c, __ATOMIC_RELAXED, __HIP_MEMORY_SCOPE_WORKGROUP) - target) < 0) { }
    }
    asm volatile("" ::: "memory");
}
__device__ __forceinline__ void job_fence() {
#if DBG_JOBFENCE
#endif
}
__device__ __forceinline__ float wave_sum(float v) {
#pragma unroll
    for (int o = 32; o >= 1; o >>= 1) v += __shfl_xor(v, o);
    return v;
}
__device__ __forceinline__ float xmax16(float x) { const unsigned u = __float_as_uint(x); auto r = __builtin_amdgcn_permlane16_swap(u, u, false, false); return fmaxf(__uint_as_float(r[0]), __uint_as_float(r[1])); }
__device__ __forceinline__ float xmax32(float x) { const unsigned u = __float_as_uint(x); auto r = __builtin_amdgcn_permlane32_swap(u, u, false, false); return fmaxf(__uint_as_float(r[0]), __uint_as_float(r[1])); }
__device__ __forceinline__ float xsum16(float x) { const unsigned u = __float_as_uint(x); auto r = __builtin_amdgcn_permlane16_swap(u, u, false, false); return __uint_as_float(r[0]) + __uint_as_float(r[1]); }
__device__ __forceinline__ float xsum32(float x) { const unsigned u = __float_as_uint(x); auto r = __builtin_amdgcn_permlane32_swap(u, u, false, false); return __uint_as_float(r[0]) + __uint_as_float(r[1]); }
__device__ __forceinline__ f32x4 mfma16(bf16x8 a, bf16x8 b, f32x4 c) { return __builtin_amdgcn_mfma_f32_16x16x32_bf16(a, b, c, 0, 0, 0); }
__device__ __forceinline__ bf16x8 as_bf8(u32x4 v) { union { u32x4 u; bf16x8 b; } x; x.u = v; return x.b; }
__device__ __forceinline__ void store16bf(bf16_t* dst, const float (&v)[16]) {
    u32x4 a, b;
    a.x = pk_bf16(v[0], v[1]); a.y = pk_bf16(v[2], v[3]); a.z = pk_bf16(v[4], v[5]); a.w = pk_bf16(v[6], v[7]);
    b.x = pk_bf16(v[8], v[9]); b.y = pk_bf16(v[10], v[11]); b.z = pk_bf16(v[12], v[13]); b.w = pk_bf16(v[14], v[15]);
    *(u32x4*)dst = a; *(u32x4*)(dst + 8) = b;
}

#ifndef XB_SCOPE
#define XB_SCOPE "agent"
#endif
#define XB_TMO      128
#define XB_XCNT(j)  (256  + 64 * (j))
#define XB_XSUB(j)  (1280 + 64 * (j))
#define XB_XGEN(j)  (2304 + 64 * (j))
#define XB_TOP      3328
#define XB_TOPGEN   3392
#define XCD_BAR_WORDS 3456
#define XB_SPIN_CAP (1u << 22)
#define LAS __attribute__((address_space(3)))
__device__ __forceinline__ unsigned xb_ld(unsigned* p)              { return __hip_atomic_load(p, __ATOMIC_RELAXED, __HIP_MEMORY_SCOPE_AGENT); }
__device__ __forceinline__ unsigned xb_add(unsigned* p, unsigned v) { return __hip_atomic_fetch_add(p, v, __ATOMIC_RELAXED, __HIP_MEMORY_SCOPE_AGENT); }
__device__ __forceinline__ unsigned xb_xcc_id() { return (unsigned)__builtin_amdgcn_s_getreg((3 << 11) | 20) & 0xFu; }
#define XB_SPIN(cond, bar) do { unsigned _sp = 0; while (cond) { __builtin_amdgcn_s_sleep(1); \
    if ((++_sp & 255u) == 0u) { if (xb_ld(&(bar)[XB_TMO])) break; if (_sp > XB_SPIN_CAP) { atomicAdd(&(bar)[XB_TMO], 1u); break; } } } } while (0)
struct XcdBarrier { unsigned* bar; unsigned x; volatile LAS unsigned* st; };
__device__ __forceinline__ XcdBarrier xcd_barrier_post(unsigned* bar, volatile LAS unsigned* st) {
    XcdBarrier b; b.bar = bar; b.x = xb_xcc_id(); b.st = st;
    if (threadIdx.x == 0) { st[0] = 0u; st[1] = 0u; (void)xb_add(&bar[XB_XCNT(b.x)], 1u); }
    return b;
}
__device__ __forceinline__ void xcd_barrier_complete(unsigned* bar, unsigned x, unsigned& nloc, unsigned& nx) {
    const unsigned G = gridDim.x * gridDim.y * gridDim.z;
    unsigned sum, cnt, mine, sp = 0u;
    for (;;) {
        sum = 0u; cnt = 0u; mine = 0u;
#pragma unroll
        for (unsigned j = 0; j < 16; ++j) { const unsigned c = xb_ld(&bar[XB_XCNT(j)]); sum += c; cnt += (c > 0u) ? 1u : 0u; mine = (j == x) ? c : mine; }
        if (sum == G) break;
        __builtin_amdgcn_s_sleep(1);
        if ((++sp & 255u) == 0u) { if (xb_ld(&bar[XB_TMO])) break; if (sp > XB_SPIN_CAP) { atomicAdd(&bar[XB_TMO], 1u); break; } }
    }
    nloc = mine > 0u ? mine : 1u; nx = cnt > 0u ? cnt : 1u;
}
__device__ __forceinline__ void xcd_barrier(XcdBarrier& b) {
    asm volatile("s_waitcnt vmcnt(0)" ::: "memory");
    __syncthreads();
    if (threadIdx.x == 0) {
        unsigned* bar = b.bar;
        __builtin_amdgcn_s_waitcnt(0);
        unsigned nloc = b.st[0], nx = b.st[1];
        if (nloc == 0u) { xcd_barrier_complete(bar, b.x, nloc, nx); b.st[0] = nloc; b.st[1] = nx; }
        const unsigned old = xb_add(&bar[XB_XSUB(b.x)], 1u);
        const unsigned gen = old / nloc;
        if (old + 1u == (gen + 1u) * nloc) {
            __builtin_amdgcn_fence(__ATOMIC_RELEASE, XB_SCOPE);
            asm volatile("s_waitcnt vmcnt(0)" ::: "memory");
            const unsigned og = xb_add(&bar[XB_TOP], 1u);
            const unsigned tg = og / nx;
            if (og + 1u == (tg + 1u) * nx) xb_add(&bar[XB_TOPGEN], 1u);
            else XB_SPIN(xb_ld(&bar[XB_TOPGEN]) == tg, bar);
            __builtin_amdgcn_fence(__ATOMIC_ACQUIRE, XB_SCOPE);
            xb_add(&bar[XB_XGEN(b.x)], 1u);
            asm volatile("s_waitcnt vmcnt(0)" ::: "memory");
        } else {
            XB_SPIN(xb_ld(&bar[XB_XGEN(b.x)]) == gen, bar);
            __builtin_amdgcn_fence(__ATOMIC_ACQUIRE, XB_SCOPE);
            asm volatile("s_waitcnt vmcnt(0)" ::: "memory");
        }
    }
    __syncthreads();
}

__device__ __forceinline__ void tile_coords(int L, int ntm, int ntn, int& tm, int& tn) {
    const int nt = ntm * ntn, q = nt >> 3, r = nt & 7, xcd = L & 7, off = L >> 3;
    const int id = (xcd < r ? xcd * (q + 1) : r * (q + 1) + (xcd - r) * q) + off;
    const int GM = 8, nig = GM * ntn, gid = id / nig, fm = gid * GM, gsz = (ntm - fm) < GM ? (ntm - fm) : GM;
    tm = fm + ((id % nig) % gsz); tn = (id % nig) / gsz;
}

template <class AP, class BP>
__device__ __forceinline__ void gemm_kloop(f32x4 (&acc)[4][4], AP ap, int a_kstep, BP bp, int b_kstep, int nkt, unsigned char* lds, int tid) {
    const int lane = tid & 63, w = tid >> 6, wm = w >> 1, wn = w & 1, fr = lane & 15, fq = lane >> 4;
    const int lr = lane >> 3, lc = (lane & 7) ^ lr;
    const bf16_t* pa[4]; const bf16_t* pb[4];
#pragma unroll
    for (int i = 0; i < 4; ++i) {
        const int row = 8 * (w + 4 * i) + lr;
        pa[i] = ap(row) + lc * 8;
        const int wn_ = row >> 6, ni_ = (row >> 4) & 3, ii = row & 15;
        pb[i] = bp(64 * wn_ + 16 * (ii >> 2) + 4 * ni_ + (ii & 3)) + lc * 8;
    }
    const int ra = (64 * wm + fr) * 128, rb = (64 * wn + fr) * 128;
    const int sw0 = ((fq) ^ (fr & 7)) << 4, sw1 = ((4 + fq) ^ (fr & 7)) << 4;
    auto issue = [&](int buf) {
#pragma unroll
        for (int i = 0; i < 4; ++i) {
            __builtin_amdgcn_global_load_lds((const unsigned*)pa[i], (unsigned*)(lds + buf * 16384 + (w + 4 * i) * 1024), 16, 0, 0);
            __builtin_amdgcn_global_load_lds((const unsigned*)pb[i], (unsigned*)(lds + 32768 + buf * 16384 + (w + 4 * i) * 1024), 16, 0, 0);
            pa[i] += a_kstep; pb[i] += b_kstep;
        }
    };
    auto compute = [&](int buf) {
        const unsigned char* A = lds + buf * 16384;
        const unsigned char* B = lds + 32768 + buf * 16384;
#pragma unroll
        for (int ks = 0; ks < 2; ++ks) {
            const int sw = ks ? sw1 : sw0;
            bf16x8 af[4], bf[4];
#pragma unroll
            for (int mi = 0; mi < 4; ++mi) af[mi] = *(const bf16x8*)(A + ra + mi * 2048 + sw);
#pragma unroll
            for (int ni = 0; ni < 4; ++ni) bf[ni] = *(const bf16x8*)(B + rb + ni * 2048 + sw);
#pragma unroll
            for (int mi = 0; mi < 4; ++mi)
#pragma unroll
                for (int ni = 0; ni < 4; ++ni) acc[mi][ni] = mfma16(bf[ni], af[mi], acc[mi][ni]);
        }
    };
    vb_sync(lds);
    issue(0);
    asm volatile("s_waitcnt vmcnt(0)" ::: "memory");
    vb_sync(lds);
#pragma unroll 1
    for (int kt = 0; kt < nkt; ++kt) {
        const int cur = kt & 1;
        if (kt + 1 < nkt) issue(cur ^ 1);
        compute(cur);
        asm volatile("s_waitcnt vmcnt(0)" ::: "memory");
        vb_sync(lds);
    }
}
__device__ __forceinline__ void zero_acc(f32x4 (&acc)[4][4]) {
#pragma unroll
    for (int i = 0; i < 4; ++i)
#pragma unroll
        for (int j = 0; j < 4; ++j) acc[i][j] = (f32x4){0.f, 0.f, 0.f, 0.f};
}

constexpr int G8_HTB = 16384;
__device__ __forceinline__ int g8_lds_byte(int r, int c) { const int st = (r >> 4) * 2 + (c >> 5), rr = r & 15, cc = c & 31, ob = rr * 64 + cc * 2; return st * 1024 + (ob ^ (((ob >> 9) & 1) << 5)); }
__device__ __forceinline__ void g8_stage_rc(int b, int& R, int& C) { const int st = b / 1024, sb = b % 1024, swz = sb ^ (((sb >> 9) & 1) << 5); R = (st >> 1) * 16 + swz / 64; C = (st & 1) * 32 + (swz % 64) / 2; }
__device__ __forceinline__ int g8_perm32(int rho) { const int n = rho >> 4, i = rho & 15; return 8 * (i >> 2) + 4 * n + (i & 3); }
struct G8Unit {
    const char* A0; const char* A1; const char* B0; const char* B1;
    unsigned K2;
    int nt;
    int x0, x1, x2, x3, n;
    unsigned ao[2][2];
};
typedef f32x4 G8Acc[2][2][4][2];
template <class Sched, class Epi>
__device__ __forceinline__ void g8_phase(Sched& S, Epi& E) {
    LAS unsigned char* lds = (LAS unsigned char*)lds_base();
    int tid = threadIdx.x; asm volatile("" : "+v"(tid));
    const int wid = __builtin_amdgcn_readfirstlane(tid >> 6), lane = tid & 63, wr = wid >> 2, wc = wid & 3, fr = lane & 15, fq = lane >> 4;
#define G8_GEOM(R, C2, Rb) int R[2]; unsigned C2[2], Rb[2]; { int _t = threadIdx.x; asm volatile("" : "+v"(_t)); _Pragma("unroll") for (int _i = 0; _i < 2; ++_i) { int _r, _c; g8_stage_rc(_t * 16 + _i * 8192, _r, _c); \
        R[_i] = _r; C2[_i] = (unsigned)_c * 2u; Rb[_i] = (unsigned)((_r & ~31) + g8_perm32(_r & 31)); } }
    const unsigned ldsw = (unsigned)wid * 1024u;
    const int aoff = g8_lds_byte(wr * 64 + fr, fq * 8), boff = g8_lds_byte(wc * 32 + fr, fq * 8);
#define G8_SA(b, h) (((b) * 2 + (h)) * G8_HTB)
#define G8_SB(b, h) ((4 + (b) * 2 + (h)) * G8_HTB)
#define G8_STAGE(bufoff, gbase, voff) do { _Pragma("unroll") for (int _i = 0; _i < 2; ++_i) { unsigned _o = (voff)[_i]; asm volatile("" : "+v"(_o)); \
        __builtin_amdgcn_global_load_lds((const unsigned*)((const char*)(gbase) + _o), (LAS unsigned*)(lds + (bufoff) + ldsw + _i * 8192), 16, 0, 0); } } while (0)
#define G8_BOFF(u, bo) do { _Pragma("unroll") for (int _i = 0; _i < 2; ++_i) bo[_i] = Rb_[_i] * (u).K2 + C2_[_i]; } while (0)
#define G8_LDA(dst, b, h) do { _Pragma("unroll") for (int m = 0; m < 4; ++m) _Pragma("unroll") for (int k = 0; k < 2; ++k) dst[m][k] = *(const LAS bf16x8*)(lds + G8_SA(b, h) + aoff + m * 2048 + k * 1024); } while (0)
#define G8_LDB(dst, b, h) do { _Pragma("unroll") for (int n = 0; n < 2; ++n) _Pragma("unroll") for (int k = 0; k < 2; ++k) dst[n][k] = *(const LAS bf16x8*)(lds + G8_SB(b, h) + boff + n * 2048 + k * 1024); } while (0)
#define G8_MMA(ai, bj, At, Bt) do { __builtin_amdgcn_s_setprio(1); _Pragma("unroll") for (int m = 0; m < 4; ++m) _Pragma("unroll") for (int n = 0; n < 2; ++n) _Pragma("unroll") for (int k = 0; k < 2; ++k) \
        acc[ai][bj][m][n] = __builtin_amdgcn_mfma_f32_16x16x32_bf16(Bt[n][k], At[m][k], acc[ai][bj][m][n], 0, 0, 0); __builtin_amdgcn_s_setprio(0); } while (0)
#define G8_WAIT_V(n) asm volatile("s_waitcnt vmcnt(" #n ")" ::: "memory")
#define G8_WAIT_L(n) asm volatile("s_waitcnt lgkmcnt(" #n ")" ::: "memory")
#define G8_BAR __builtin_amdgcn_s_barrier()
#define G8_SCHED __builtin_amdgcn_sched_barrier(0)
    G8Unit cur, nxt; int ui = 0; unsigned cbo[2], nbo[2];
    { G8_GEOM(R_, C2_, Rb_) if (!S.next(0, cur, R_, C2_)) return; G8_BOFF(cur, cbo); }
    G8Acc acc;
#pragma unroll
    for (int a = 0; a < 2; ++a)
#pragma unroll
        for (int b = 0; b < 2; ++b)
#pragma unroll
            for (int m = 0; m < 4; ++m)
#pragma unroll
                for (int n = 0; n < 2; ++n) acc[a][b][m][n] = (f32x4){0.f, 0.f, 0.f, 0.f};
    bf16x8 At[4][2], B0[2][2], B1[2][2];
    G8_STAGE(G8_SB(0, 0), cur.B0, cbo); G8_STAGE(G8_SA(0, 0), cur.A0, cur.ao[0]); G8_STAGE(G8_SB(0, 1), cur.B1, cbo); G8_STAGE(G8_SA(0, 1), cur.A1, cur.ao[1]);
    if (wr == 1) G8_BAR;
    G8_WAIT_V(4); G8_BAR;
    G8_STAGE(G8_SB(1, 0), cur.B0 + 128, cbo); G8_STAGE(G8_SA(1, 0), cur.A0 + 128, cur.ao[0]); G8_STAGE(G8_SB(1, 1), cur.B1 + 128, cbo);
    G8_WAIT_V(6); G8_BAR;
    for (;;) {
        bool has_next;
        { G8_GEOM(R_, C2_, Rb_) has_next = S.next(ui + 1, nxt, R_, C2_);
          if (!has_next) nxt = cur;
          G8_BOFF(nxt, nbo); }
        const int nt = cur.nt;
#pragma unroll 1
        for (int t = 0; t < nt; t += 2) {
            const bool last = (t == nt - 2);
            const size_t k1 = (size_t)(t + 1) * 128, k2 = (size_t)(t + 2) * 128;
            const char* a2h0 = last ? nxt.A0 : cur.A0 + k2; const char* a2h1 = last ? nxt.A1 : cur.A1 + k2;
            const char* b2h0 = last ? nxt.B0 : cur.B0 + k2; const char* b2h1 = last ? nxt.B1 : cur.B1 + k2;
            unsigned ao0[2], ao1[2], bo2[2];
#pragma unroll
            for (int i = 0; i < 2; ++i) { ao0[i] = last ? nxt.ao[0][i] : cur.ao[0][i]; ao1[i] = last ? nxt.ao[1][i] : cur.ao[1][i]; bo2[i] = last ? nbo[i] : cbo[i]; }
            G8_LDB(B0, 0, 0); G8_SCHED; G8_LDA(At, 0, 0); G8_STAGE(G8_SA(1, 1), cur.A1 + k1, cur.ao[1]);
            G8_WAIT_L(8); G8_BAR; G8_WAIT_L(0); G8_MMA(0, 0, At, B0); G8_BAR; G8_SCHED;
            G8_LDB(B1, 0, 1); G8_STAGE(G8_SB(0, 0), b2h0, bo2);
            G8_BAR; G8_WAIT_L(0); G8_MMA(0, 1, At, B1); G8_BAR;
            G8_LDA(At, 0, 1); G8_STAGE(G8_SA(0, 0), a2h0, ao0);
            G8_BAR; G8_WAIT_L(0); G8_MMA(1, 0, At, B0); G8_BAR; G8_SCHED;
            G8_STAGE(G8_SB(0, 1), b2h1, bo2);
            G8_WAIT_V(6); G8_BAR; G8_MMA(1, 1, At, B1); G8_BAR;
            G8_LDB(B0, 1, 0); G8_SCHED; G8_LDA(At, 1, 0); G8_STAGE(G8_SA(0, 1), a2h1, ao1);
            G8_WAIT_L(8); G8_BAR; G8_WAIT_L(0); G8_MMA(0, 0, At, B0); G8_BAR; G8_SCHED;
            G8_LDB(B1, 1, 1); G8_STAGE(G8_SB(1, 0), b2h0 + 128, bo2);
            G8_BAR; G8_WAIT_L(0); G8_MMA(0, 1, At, B1); G8_BAR;
            G8_LDA(At, 1, 1); G8_STAGE(G8_SA(1, 0), a2h0 + 128, ao0);
            G8_BAR; G8_WAIT_L(0); G8_MMA(1, 0, At, B0); G8_BAR; G8_SCHED;
            G8_STAGE(G8_SB(1, 1), b2h1 + 128, bo2);
            G8_WAIT_V(6); G8_BAR; G8_MMA(1, 1, At, B1); G8_BAR;
        }
        { int t_ = threadIdx.x; asm volatile("" : "+v"(t_)); const int w_ = __builtin_amdgcn_readfirstlane(t_ >> 6); E(acc, cur, w_ >> 2, w_ & 3, t_ & 15, (t_ >> 4) & 3); }
        if (!has_next) break;
#pragma unroll
        for (int a = 0; a < 2; ++a)
#pragma unroll
            for (int b = 0; b < 2; ++b)
#pragma unroll
                for (int m = 0; m < 4; ++m)
#pragma unroll
                    for (int n = 0; n < 2; ++n) acc[a][b][m][n] = (f32x4){0.f, 0.f, 0.f, 0.f};
        cur = nxt; ++ui; cbo[0] = nbo[0]; cbo[1] = nbo[1];
    }
    G8_WAIT_V(0);
    if (wr == 0) G8_BAR;
    G8_BAR;
}
struct G8Plain {
    static constexpr bool GATHER = false;
    const char* A; const char* B; unsigned K2; int nt, nM, nN;
    __device__ __forceinline__ bool next(int i, G8Unit& u, const int (&R)[2], const unsigned (&C2)[2]) const {
        const int L = i * (int)gridDim.x + (int)blockIdx.x; if (L >= nM * nN) return false;
        int pm, pn; tile_coords(L, nM, nN, pm, pn); pm = __builtin_amdgcn_readfirstlane(pm); pn = __builtin_amdgcn_readfirstlane(pn);
        u.A0 = A + (size_t)pm * 256 * K2; u.A1 = u.A0 + (size_t)128 * K2; u.B0 = B + (size_t)pn * 256 * K2; u.B1 = u.B0 + (size_t)128 * K2;
        u.K2 = K2; u.nt = nt; u.x0 = pm; u.x1 = pn; u.x2 = 0; u.x3 = 0;
#pragma unroll
        for (int h = 0; h < 2; ++h)
#pragma unroll
            for (int k = 0; k < 2; ++k) u.ao[h][k] = (unsigned)R[k] * u.K2 + C2[k];
        return true;
    }
};

__device__ __forceinline__ void convert_tiles(CKP& p, int l, int e_lo, int e_hi, int first, int stride, int lane) {
    unsigned char* W = p.ws + OFF_W;
    struct E { const float* src; bf16_t* dst; int R, C, nd, mode, nbatch; };
    const int NE = e_hi;
        for (int L = first;; L += stride) {
            int rem = L; int e = e_lo; E d{};
            for (; e < NE; ++e) {
                switch (e) {
                    case 0: d = {p.in[3] + (size_t)l * 1024 * 5144, (bf16_t*)(W + W_IN), 1024, 5144, 2176, 1, 1}; break;
                    case 1: d = {p.in[3] + (size_t)l * 1024 * 5144, (bf16_t*)(W + W_GB), 1024, 5144, 3072, 2, 1}; break;
                    case 2: d = {p.in[10] + (size_t)l * 512 * 1024, (bf16_t*)(W + W_A), 512, 1024, 1024, 0, 1}; break;
                    case 3: d = {p.in[14] + (size_t)l * 256 * 1024, (bf16_t*)(W + W_S), 256, 1024, 1024, 0, 1}; break;
                    case 4: d = {p.in[25] + (size_t)l * 256 * 1024, (bf16_t*)(W + W_5), 256, 1024, 1024, 0, 1}; break;
                    case 5: d = {p.in[26] + (size_t)l * 1024 * 1024, (bf16_t*)(W + W_M), 1024, 1024, 1024, 0, 1}; break;
                    case 6: d = {p.in[23] + (size_t)l * 256 * 256, (bf16_t*)(W + W_GLU), 256, 256, 256, 0, 1}; break;
                    case 7: d = {p.in[6] + (size_t)l * 2048 * 128, (bf16_t*)(W + W_C1), 2048, 128, 128, 0, 1}; break;
                    case 8: d = {p.in[8] + (size_t)l * 2048 * 128, (bf16_t*)(W + W_C1) + 128 * 2048, 2048, 128, 128, 0, 1}; break;
                    case 9: d = {p.in[7] + (size_t)l * 128 * 64, (bf16_t*)(W + W_C2), 128, 64, 64, 0, 1}; break;
                    case 10: d = {p.in[9] + (size_t)l * 128 * 64, (bf16_t*)(W + W_C2) + 64 * 128, 128, 64, 64, 0, 1}; break;
                    case 11: d = {p.in[32] + (size_t)l * 32 * 1024 * 512, (bf16_t*)(W + W_EG), 1024, 512, 512, 0, 32}; break;
                    case 12: d = {p.in[33] + (size_t)l * 32 * 1024 * 512, (bf16_t*)(W + W_EU), 1024, 512, 512, 0, 32}; break;
                    default: d = {p.in[34] + (size_t)l * 32 * 512 * 1024, (bf16_t*)(W + W_ED), 512, 1024, 1024, 0, 32}; break;
                }
                const int per = (d.R >> 6) * (d.nd >> 6), tot = per * d.nbatch;
                if (rem < tot) break;
                rem -= tot;
            }
            if (e >= NE) break;
            const int per = (d.R >> 6) * (d.nd >> 6), bi = rem / per, t = rem % per, ntn = d.nd >> 6;
            const int k0 = (t / ntn) * 64, n = (t % ntn) * 64 + lane;
            int col = n;
            if (d.mode == 1) col = (n < 1280) ? n : ((n < 2048) ? n + 24 : ((n < 2072) ? n - 768 : -1));
            else if (d.mode == 2) col = n + 2072;
            const float* sp = d.src + (size_t)bi * d.R * d.C + (size_t)k0 * d.C + (col >= 0 ? col : 0);
            float v[64];
#pragma unroll
            for (int i = 0; i < 64; ++i) v[i] = sp[(size_t)i * d.C];
            if (col < 0) {
#pragma unroll
                for (int i = 0; i < 64; ++i) v[i] = 0.f;
            }
            bf16_t* dp = d.dst + (size_t)bi * d.R * d.nd + (size_t)n * d.R + k0;
#pragma unroll
            for (int q = 0; q < 8; ++q) {
                u32x4 o;
                o.x = pk_bf16(v[8 * q], v[8 * q + 1]); o.y = pk_bf16(v[8 * q + 2], v[8 * q + 3]);
                o.z = pk_bf16(v[8 * q + 4], v[8 * q + 5]); o.w = pk_bf16(v[8 * q + 6], v[8 * q + 7]);
                *(u32x4*)(dp + 8 * q) = o;
            }
        }
}

__device__ __forceinline__ void phase_prep(CKP& p, int l, unsigned char* lds) {
    const int tid = opaque_tid(), G = VGRID(), lane = tid & 63, w = tid >> 6;
    unsigned char* W = p.ws + OFF_W;
    if (l < DEPTH) {
        convert_tiles(p, l, 0, 11, VBID() * 4 + w, G * 4, lane);
        const int gt = VBID() * NTHR + tid, gs = G * NTHR;
        if (l == 0) {
            const int* pos = (const int*)p.in[1]; float* rt = (float*)(p.ws + OFF_ROPE);
            for (int i = gt; i < NTOK * 8; i += gs) { float sn, cs; sincosf((float)pos[i >> 3] * p.inv_freq[i & 7], &sn, &cs); rt[(i >> 3) * 16 + (i & 7)] = cs; rt[(i >> 3) * 16 + 8 + (i & 7)] = sn; }
        }
        {
            const float* sw = p.in[12] + (size_t)l * 4 * 128 * 128; bf16_t* o = (bf16_t*)(W + W_SGU);
            for (int i = gt; i < 65536; i += gs) { const int t = (i >> 7) & 127, s = i & 127; o[i] = f2bf(s <= t ? sw[i] : 0.f); }
        }
        {
            const float* are = p.in[15] + l * 1024; const float* aim = p.in[16] + l * 1024; const float* ls = p.in[17] + l * 16;
            const float* bre = p.in[18] + (size_t)l * 16384; const float* bim = p.in[19] + (size_t)l * 16384;
            float* oa = (float*)(W + W_S5A); float* oa2 = (float*)(W + W_S5A256); float* ob = (float*)(W + W_S5B);
            for (int i = gt; i < 1024; i += gs) {
                const int g = i >> 6;
                const float step = expf(ls[g]), ar = are[i], ai = aim[i];
                const float mag = expf(ar * step); float sn, cs; sincosf(ai * step, &sn, &cs);
                const float abr = mag * cs, abi = mag * sn;
                const float den = ar * ar + ai * ai, nr = abr - 1.f, ni = abi;
                const float cr = (nr * ar + ni * ai) / den, ci = (ni * ar - nr * ai) / den;
                oa[i * 2] = abr; oa[i * 2 + 1] = abi;
                float pr = abr, pi = abi;
                for (int s = 0; s < 8; ++s) { const float nr2 = pr * pr - pi * pi, ni2 = 2.f * pr * pi; pr = nr2; pi = ni2; }
                oa2[i * 2] = pr; oa2[i * 2 + 1] = pi;
                for (int h = 0; h < 16; ++h) {
                    const float br = bre[i * 16 + h], bi_ = bim[i * 16 + h];
                    ob[i * 32 + h] = cr * br - ci * bi_;
                    ob[i * 32 + 16 + h] = cr * bi_ + ci * br;
                }
            }
            const float* cre = p.in[20] + (size_t)l * 16384; const float* cim = p.in[21] + (size_t)l * 16384; bf16_t* oc = (bf16_t*)(W + W_S5C);
            for (int i = gt; i < 32768; i += gs) {
                const int k = i & 127, gh = i >> 7;
                oc[i] = f2bf(k < 64 ? cre[gh * 64 + k] : -cim[gh * 64 + (k - 64)]);
            }
        }
        {
            const float* wg = p.in[28] + (size_t)l * 1024 * 4; const float* we = p.in[30] + (size_t)l * 1024 * 32;
            bf16_t* oh = (bf16_t*)(W + W_RH); bf16_t* ol = (bf16_t*)(W + W_RL);
            for (int i = gt; i < 65536; i += gs) {
                const int n = i >> 10, k = i & 1023;
                const float v = (n < 4) ? wg[k * 4 + n] : ((n < 36) ? we[k * 32 + (n - 4)] : 0.f);
                const bf16_t h = f2bf(v);
                oh[i] = h; ol[i] = f2bf(v - bf2f(h));
            }
        }
        {
            float* pb = (float*)(W + W_PB);
            for (int j = VBID() * 4 + w; j < 256; j += G * 4) {
                const int kv = j >> 7, n = j & 127;
                const float* pos = p.in[kv ? 5 : 4] + (size_t)l * 2048; const float* w1 = p.in[kv ? 8 : 6] + (size_t)l * 2048 * 128;
                float s = 0.f;
                for (int k = lane; k < 2048; k += 64) s += pos[k] * w1[(size_t)k * 128 + n];
                s = wave_sum(s);
                if (lane == 0) pb[j] = s;
            }
        }
    }
    {
        const float* gam = (l < DEPTH) ? (p.in[2] + (size_t)l * 1024) : p.in[35];
        bf16_t* hb = (bf16_t*)(p.ws + OFF_H);
        const bf16_t* ys = (const bf16_t*)(p.ws + OFF_YS);
        bf16_t* xres = (bf16_t*)(p.ws + OFF_X);
        f32x4 gv[4];
#pragma unroll
        for (int i = 0; i < 4; ++i) gv[i] = *(const f32x4*)(gam + 4 * lane + 256 * i);
        for (int row = VBID() * 4 + w; row < NTOK; row += G * 4) {
            f32x4 xv[4]; float ss = 0.f;
#pragma unroll
            for (int i = 0; i < 4; ++i) {
                const int col = 4 * lane + 256 * i;
                if (l == 0) xv[i] = *(const f32x4*)(p.in[0] + (size_t)row * 1024 + col);
                else {
                    { const u32x2 xx = *(const u32x2*)(xres + (size_t)row * 1024 + col); xv[i] = (f32x4){bflo(xx.x), bfhi(xx.x), bflo(xx.y), bfhi(xx.y)}; }
                    const u32x2 y0 = *(const u32x2*)(ys + (size_t)(2 * row) * 1024 + col), y1 = *(const u32x2*)(ys + (size_t)(2 * row + 1) * 1024 + col);
                    xv[i][0] += bflo(y0.x) + bflo(y1.x); xv[i][1] += bfhi(y0.x) + bfhi(y1.x);
                    xv[i][2] += bflo(y0.y) + bflo(y1.y); xv[i][3] += bfhi(y0.y) + bfhi(y1.y);
                }
                ss += xv[i][0] * xv[i][0] + xv[i][1] * xv[i][1] + xv[i][2] * xv[i][2] + xv[i][3] * xv[i][3];
            }
            ss = wave_sum(ss);
            const float rstd = rsqrtf(ss * (1.f / 1024.f) + RMS_EPS);
#pragma unroll
            for (int i = 0; i < 4; ++i) {
                const int col = 4 * lane + 256 * i;
                f32x4 hn = xv[i] * rstd * gv[i];
                if (l < DEPTH) {
                    { u32x2 xo; xo.x = pk_bf16(xv[i][0], xv[i][1]); xo.y = pk_bf16(xv[i][2], xv[i][3]); *(u32x2*)(xres + (size_t)row * 1024 + col) = xo; }
                    u32x2 o; o.x = pk_bf16(hn[0], hn[1]); o.y = pk_bf16(hn[2], hn[3]);
                    *(u32x2*)(hb + (size_t)row * 1024 + col) = o;
                } else {
#if DBG_TIMEPH >= 0
                    { const unsigned long long* ts = (const unsigned long long*)(p.ws + OFF_CTL + 24576);
                      const float dt_us = (float)(ts[DBG_TIMEPH2] - ts[DBG_TIMEPH]) * 0.01f; hn = hn * (1.f + 1e-3f * dt_us); }
#endif
                    *(f32x4*)(p.xbuf + (size_t)row * 1024 + col) = hn;
                }
            }
        }
    }
}

struct EpiInproj {
    unsigned char* Rb_; const float* rope;
    __device__ __forceinline__ void operator()(const G8Acc& acc, const G8Unit& u, int wr, int wc, int fr, int fq) const {
        unsigned char* R = Rb_;
#pragma unroll
        for (int bj = 0; bj < 2; ++bj) {
            const int tn = u.x1 * 2 + bj;
            const int cl = 32 * wc + 8 * fq;
#pragma unroll
            for (int ai = 0; ai < 2; ++ai)
#pragma unroll
                for (int m = 0; m < 4; ++m) {
                    const int row = u.x0 * 256 + ai * 128 + wr * 64 + m * 16 + fr;
                    float v[8];
#pragma unroll
                    for (int e = 0; e < 8; ++e) v[e] = acc[ai][bj][m][e >> 2][e & 3];
                    const bool roped = (tn < 4) || tn == 6 || tn == 8;
                    if (tn < 4) { u32x4 o; o.x = pk_bf16(v[0], v[1]); o.y = pk_bf16(v[2], v[3]); o.z = pk_bf16(v[4], v[5]); o.w = pk_bf16(v[6], v[7]);
                                  *(u32x4*)((bf16_t*)(R + R_Q) + (size_t)row * 512 + tn * 128 + cl) = o; }
                    if (roped && !(wc & 1)) {
                        float xo[8];
#pragma unroll
                        for (int i = 0; i < 8; ++i) xo[i] = __shfl_xor(v[i], 16);
                        if (fq < 2) {
                            const float* rt = rope + (size_t)row * 16;
                            const f32x4 c0 = *(const f32x4*)rt, c1 = *(const f32x4*)(rt + 4), s0 = *(const f32x4*)(rt + 8), s1 = *(const f32x4*)(rt + 12);
#pragma unroll
                            for (int i = 0; i < 8; ++i) {
                                const float cs = i < 4 ? c0[i & 3] : c1[i & 3], sn = i < 4 ? s0[i & 3] : s1[i & 3];
                                v[i] = fq == 0 ? (v[i] * cs - xo[i] * sn) : (v[i] * cs + xo[i] * sn);
                            }
                        }
                    }
                    u32x4 o; o.x = pk_bf16(v[0], v[1]); o.y = pk_bf16(v[2], v[3]); o.z = pk_bf16(v[4], v[5]); o.w = pk_bf16(v[6], v[7]);
                    if (tn < 4) *(u32x4*)((bf16_t*)(R + R_QR) + (size_t)row * 512 + tn * 128 + cl) = o;
                    else if (tn == 7 || tn == 9) {
                        bf16_t* dst = (bf16_t*)(R + (tn == 7 ? R_VST : R_VWT));
                        const int b = row >> 12, s_ = row & 4095, g = wc >> 1, d0 = 32 * (wc & 1) + 8 * fq;
#pragma unroll
                        for (int e = 0; e < 8; ++e) dst[((size_t)((b * 2 + g) * 64 + d0 + e)) * SEQ + s_] = f2bf(v[e]);
                    } else if (tn < 10) {
                        const size_t off = (tn == 4) ? R_KC : (tn == 5) ? R_VC : (tn == 6) ? R_KS : R_KW;
                        *(u32x4*)((bf16_t*)(R + off) + (size_t)row * 128 + cl) = o;
                    } else if (tn < 14) {
#pragma unroll
                        for (int e = 0; e < 8; ++e) v[e] = gelu_tanh(v[e]);
                        u32x4 og; og.x = pk_bf16(v[0], v[1]); og.y = pk_bf16(v[2], v[3]); og.z = pk_bf16(v[4], v[5]); og.w = pk_bf16(v[6], v[7]);
                        const int c512 = (tn - 10) * 128 + cl;
                        if (c512 < 256) *(u32x4*)((bf16_t*)(R + R_U) + (size_t)row * 256 + c512) = og;
                        else *(u32x4*)((bf16_t*)(R + R_V) + (size_t)row * 256 + (c512 - 256)) = og;
                    } else {
                        *(u32x4*)((bf16_t*)(R + R_S5IN) + (size_t)row * 256 + (tn - 14) * 128 + cl) = o;
                    }
                }
        }
    }
};
__device__ __forceinline__ void phase_inproj(CKP& p, int l, unsigned char* lds) {
    {
        G8Plain S{(const char*)(p.ws + OFF_H), (const char*)(p.ws + OFF_W + W_IN), 2048u, 16, NTOK / 256, 8};
        EpiInproj E{p.ws + OFF_R, (const float*)(p.ws + OFF_ROPE)};
        g8_phase(S, E);
    }
    const int tid = opaque_tid(), lane = tid & 63, w = tid >> 6, wm = w >> 1, wn = w & 1, fr = lane & 15, fq = lane >> 4;
    const int half = (int)(threadIdx.x >> 8);
    const bf16_t* A = (const bf16_t*)(p.ws + OFF_H);
    const bf16_t* Bt = (const bf16_t*)(p.ws + OFF_W + W_IN) + (size_t)2048 * 1024;
    unsigned char* R = p.ws + OFF_R;
    float* xch = (float*)(lds_base() + VB_LDS);
    for (int tm = blockIdx.x; tm < NTOK / 128; tm += gridDim.x) {
        const int m0 = tm * 128;
        f32x4 acc[4][4]; zero_acc(acc);
        gemm_kloop(acc, [&](int r) { return A + (size_t)(m0 + r) * 1024 + half * 512; }, 64, [&](int v) { return Bt + (size_t)v * 1024 + half * 512; }, 64, 8, lds, tid);
        __syncthreads();
        if (half == 1 && wn == 0 && fq < 2) {
#pragma unroll
            for (int mi = 0; mi < 4; ++mi) {
                const int r = 64 * wm + 16 * mi + fr;
#pragma unroll
                for (int ni = 0; ni < 4; ++ni) *(f32x4*)(xch + r * 32 + 16 * fq + 4 * ni) = acc[mi][ni];
            }
        }
        __syncthreads();
        if (half == 0 && wn == 0 && fq < 2) {
#pragma unroll
            for (int mi = 0; mi < 4; ++mi) {
                const int r = 64 * wm + 16 * mi + fr;
                float* ng = (float*)(R + R_NG) + (size_t)(m0 + r) * 24 + 16 * fq;
#pragma unroll
                for (int ni = 0; ni < 4; ++ni) {
                    const f32x4 o = *(const f32x4*)(xch + r * 32 + 16 * fq + 4 * ni);
#pragma unroll
                    for (int j = 0; j < 4; ++j) if (16 * fq + 4 * ni + j < 24) ng[4 * ni + j] = sigm(acc[mi][ni][j] + o[j]);
                }
            }
        }
        __syncthreads();
    }
}

__device__ __forceinline__ void compress_tile(CKP& p, int job, unsigned char* lds) {
    job_fence();
    const int tid = opaque_tid(), lane = tid & 63, w = tid >> 6, wm = w >> 1, wn = w & 1, fr = lane & 15, fq = lane >> 4;
    const int kv = job >> 5, tm = job & 31, m0 = tm * 128;
    unsigned char* W = p.ws + OFF_W;
    const bf16_t* src = (const bf16_t*)(p.ws + OFF_R + (kv ? R_VC : R_KC));
    const bf16_t* W1 = (const bf16_t*)(W + W_C1) + (size_t)kv * 128 * 2048;
    const bf16_t* W2 = (const bf16_t*)(W + W_C2) + (size_t)kv * 64 * 128;
    const float* pb = (const float*)(W + W_PB) + kv * 128;
    f32x4 acc[4][4]; zero_acc(acc);
    int t512 = threadIdx.x; asm volatile("" : "+v"(t512));
    const int half = t512 >> 8;
    gemm_kloop(acc, [&](int r) { int Rr = m0 + r; Rr = Rr < 4080 ? Rr : 4079; const int b = Rr / 510, rem = Rr % 510, c = rem >> 1, g = rem & 1;
                                 return src + ((size_t)(b * SEQ + 16 * c + 16 * half)) * 128 + g * 64; }, 128,
               [&](int v) { return W1 + (size_t)v * 2048 + half * 1024; }, 64, 16, lds, tid);
    {
        float* xch = (float*)(lds_base() + VB_LDS);
        __syncthreads();
        if (half == 1) {
#pragma unroll
            for (int mi = 0; mi < 4; ++mi)
#pragma unroll
                for (int ni = 0; ni < 4; ++ni) *(f32x4*)(xch + ((mi * 4 + ni) * 256 + tid) * 4) = acc[mi][ni];
        }
        __syncthreads();
        if (half == 0) {
#pragma unroll
            for (int mi = 0; mi < 4; ++mi)
#pragma unroll
                for (int ni = 0; ni < 4; ++ni) acc[mi][ni] += *(const f32x4*)(xch + ((mi * 4 + ni) * 256 + tid) * 4);
        }
        __syncthreads();
        if (half == 1) return;
    }
#pragma unroll
    for (int mi = 0; mi < 4; ++mi) {
        const int row = 64 * wm + 16 * mi + fr; const int cb = 16 * fq;
        float v[16];
#pragma unroll
        for (int e = 0; e < 16; ++e) v[e] = gelu_tanh(acc[mi][e >> 2][e & 3] + pb[64 * wn + cb + e]);
        u32x4 a, b;
        a.x = pk_bf16(v[0], v[1]); a.y = pk_bf16(v[2], v[3]); a.z = pk_bf16(v[4], v[5]); a.w = pk_bf16(v[6], v[7]);
        b.x = pk_bf16(v[8], v[9]); b.y = pk_bf16(v[10], v[11]); b.z = pk_bf16(v[12], v[13]); b.w = pk_bf16(v[14], v[15]);
        *(u32x4*)(lds + wn * 16384 + row * 128 + (((2 * fq) ^ (row & 7)) << 4)) = a;
        *(u32x4*)(lds + wn * 16384 + row * 128 + (((2 * fq + 1) ^ (row & 7)) << 4)) = b;
    }
#pragma unroll
    for (int j = 0; j < 4; ++j) {
        const int pid = tid + 256 * j, row = pid >> 4, ch = pid & 15;
        const u32x4 v = *(const u32x4*)(W2 + row * 128 + ch * 8);
        *(u32x4*)(lds + 32768 + (ch >> 3) * 16384 + row * 128 + (((ch & 7) ^ (row & 7)) << 4)) = v;
    }
    vb_sync(lds);
    f32x4 a2[4][2];
#pragma unroll
    for (int i = 0; i < 4; ++i) { a2[i][0] = (f32x4){0.f, 0.f, 0.f, 0.f}; a2[i][1] = (f32x4){0.f, 0.f, 0.f, 0.f}; }
#pragma unroll
    for (int kt2 = 0; kt2 < 2; ++kt2)
#pragma unroll
        for (int ks = 0; ks < 2; ++ks) {
            bf16x8 af[4], bf[2];
#pragma unroll
            for (int mi = 0; mi < 4; ++mi) { const int row = 64 * wm + 16 * mi + fr; af[mi] = *(const bf16x8*)(lds + kt2 * 16384 + row * 128 + (((4 * ks + fq) ^ (row & 7)) << 4)); }
#pragma unroll
            for (int ni = 0; ni < 2; ++ni) { const int row = 32 * wn + 8 * (fr >> 2) + 4 * ni + (fr & 3); bf[ni] = *(const bf16x8*)(lds + 32768 + kt2 * 16384 + row * 128 + (((4 * ks + fq) ^ (row & 7)) << 4)); }
#pragma unroll
            for (int mi = 0; mi < 4; ++mi)
#pragma unroll
                for (int ni = 0; ni < 2; ++ni) a2[mi][ni] = mfma16(bf[ni], af[mi], a2[mi][ni]);
        }
    bf16_t* kcmp = (bf16_t*)(p.ws + OFF_C + C_KCMP);
    bf16_t* vct = (bf16_t*)(p.ws + OFF_C + C_VCT);
#pragma unroll
    for (int mi = 0; mi < 4; ++mi) {
        const int Rr = m0 + 64 * wm + 16 * mi + fr;
        if (Rr < 4080) {
            const int b = Rr / 510, rem = Rr % 510, c = rem >> 1, g = rem & 1, d0 = 32 * wn + 8 * fq;
            float v[8];
#pragma unroll
            for (int e = 0; e < 8; ++e) v[e] = a2[mi][e >> 2][e & 3];
            if (DBG_NOCSTORE) { if (v[0] == 123.456f) kcmp[0] = 1; }
            else if (kv == 0) {
                u32x4 o; o.x = pk_bf16(v[0], v[1]); o.y = pk_bf16(v[2], v[3]); o.z = pk_bf16(v[4], v[5]); o.w = pk_bf16(v[6], v[7]);
                *(u32x4*)(kcmp + ((size_t)(b * 256 + c)) * 128 + g * 64 + d0) = o;
                if (c == 254) *(u32x4*)(kcmp + ((size_t)(b * 256 + 255)) * 128 + g * 64 + d0) = (u32x4){0u, 0u, 0u, 0u};
            } else {
#pragma unroll
                for (int e = 0; e < 8; ++e) {
                    vct[((size_t)((b * 2 + g) * 64 + d0 + e)) * 256 + c] = f2bf(v[e]);
                    if (c == 254) vct[((size_t)((b * 2 + g) * 64 + d0 + e)) * 256 + 255] = 0;
                }
            }
        }
    }
    vb_sync(lds);
}

__device__ __forceinline__ void sgu_job(CKP& p, int l, int job, unsigned char* lds) {
    job_fence();
    const int tid = opaque_tid(), lane = tid & 63, w = tid >> 6, fr = lane & 15, fq = lane >> 4;
    const size_t tok0 = (size_t)job * 128;
    const bf16_t* V = (const bf16_t*)(p.ws + OFF_R + R_V) + tok0 * 256;
    const bf16_t* U = (const bf16_t*)(p.ws + OFF_R + R_U) + tok0 * 256;
    bf16_t* O = (bf16_t*)(p.ws + OFF_C + C_SGU) + tok0 * 256;
    const bf16_t* Wt = (const bf16_t*)(p.ws + OFF_W + W_SGU);
    const float* ng = p.in[11] + (size_t)l * 256;
    const float* bs = p.in[13] + (size_t)l * 512;
    vb_sync(lds);
    if (DBG_SGUCUT != 2) {
        const int s = tid >> 1, half = tid & 1;
        const bf16_t* src = V + (size_t)s * 256 + half * 128;
        float ss = 0.f;
#pragma unroll 4
        for (int j = 0; j < 16; ++j) {
            const u32x4 bb = *(const u32x4*)(src + j * 8);
            const unsigned uu[4] = {bb.x, bb.y, bb.z, bb.w};
#pragma unroll
            for (int q = 0; q < 4; ++q) { const float a = bflo(uu[q]), b2 = bfhi(uu[q]); ss += a * a + b2 * b2; }
        }
        ss += __shfl_xor(ss, 1);
        const float rstd = rsqrtf(ss * (1.f / 256.f) + RMS_EPS);
#pragma unroll 1
        for (int j = 0; j < 16; ++j) {
            const u32x4 bb = *(const u32x4*)(src + j * 8);
            const unsigned uu[4] = {bb.x, bb.y, bb.z, bb.w};
            const int cb = half * 128 + j * 8;
#pragma unroll
            for (int q = 0; q < 4; ++q) {
#pragma unroll
                for (int hh = 0; hh < 2; ++hh) {
                    const int c = cb + q * 2 + hh;
                    const float val = (hh ? bfhi(uu[q]) : bflo(uu[q])) * rstd * ng[c];
                    *(bf16_t*)(lds + c * 256 + ((((s >> 3) ^ (c & 15))) << 4) + (s & 7) * 2) = f2bf(val);
                }
            }
        }
    }
    vb_sync(lds);
    const int g = w;
#pragma unroll 1
    for (int th = 0; th < (DBG_SGUCUT == 1 ? 0 : 2); ++th) {
        f32x4 acc[4][4];
        zero_acc(acc);
#pragma unroll
        for (int ks = 0; ks < 4; ++ks) {
            if (32 * ks <= 64 * th + 63) {
                bf16x8 vf[4];
#pragma unroll
                for (int di = 0; di < 4; ++di) { const int c = 64 * g + 16 * di + fr; vf[di] = *(const bf16x8*)(lds + c * 256 + (((4 * ks + fq) ^ (c & 15)) << 4)); }
#pragma unroll
                for (int ti = 0; ti < 4; ++ti) {
                    const int t = 64 * th + 16 * ti + fr;
                    if (32 * ks <= 64 * th + 16 * ti + 15) {
                        const bf16x8 wf = *(const bf16x8*)(Wt + ((size_t)(g * 128 + t)) * 128 + 32 * ks + 8 * fq);
#pragma unroll
                        for (int di = 0; di < 4; ++di) acc[ti][di] = mfma16(vf[di], wf, acc[ti][di]);
                    }
                }
            }
        }
#pragma unroll
        for (int ti = 0; ti < 4; ++ti) {
            const int t = 64 * th + 16 * ti + fr; const float bb = bs[g * 128 + t];
#pragma unroll
            for (int di = 0; di < 4; ++di) {
                const int c = 64 * g + 16 * di + 4 * fq;
                const u32x2 uu = *(const u32x2*)(U + (size_t)t * 256 + c);
                u32x2 o;
                o.x = pk_bf16(bflo(uu.x) * (acc[ti][di][0] + bb), bfhi(uu.x) * (acc[ti][di][1] + bb));
                o.y = pk_bf16(bflo(uu.y) * (acc[ti][di][2] + bb), bfhi(uu.y) * (acc[ti][di][3] + bb));
                *(u32x2*)(O + (size_t)t * 256 + c) = o;
            }
        }
    }
    vb_sync(lds);
}

__device__ __forceinline__ void s5_job(CKP& p, int l, int jb, int pass, unsigned char* lds) {
    job_fence();
    const int tid = opaque_tid(), lane = tid & 63, w = tid >> 6, fr = lane & 15, fq = lane >> 4;
    const int id = ((jb * 4 + w) + DBG_IDROT) & 2047, seq = id >> 4, ch = id & 15, b = seq >> 4, g = seq & 15;
    unsigned char* W = p.ws + OFF_W;
    const float* ab = (const float*)(W + W_S5A) + (g * 64 + lane) * 2;
    float ar = ab[0], ai = ab[1];
    float br[16], bi[16];
    {
        const float* bb = (const float*)(W + W_S5B) + (size_t)(g * 64 + lane) * 32;
#pragma unroll
        for (int h = 0; h < 16; ++h) { br[h] = bb[h]; bi[h] = bb[16 + h]; }
    }
#if DBG_S5CONST >= 2
    { const float q = (float)(lane + 1) * 0.001f; ar = 0.99f - q; ai = 0.05f + q;
      for (int h = 0; h < 16; ++h) { br[h] = 0.01f * (float)(h + 1) + q; bi[h] = -0.02f * (float)(h + 1) + q; } }
#endif
    float* Eb = (float*)(p.ws + OFF_C + C_S5E);
    float hre = 0.f, him = 0.f;
    bf16x8 cf[4]; float dv[4];
    if (pass == 2) {
        const float* a2 = (const float*)(W + W_S5A256) + (g * 64 + lane) * 2;
        const float a2r = a2[0], a2i = a2[1];
        for (int c2 = 0; c2 < ch; ++c2) {
            const float* e = Eb + ((size_t)(seq * 16 + c2) * 64 + lane) * 2;
            const float nr = a2r * hre - a2i * him + e[0], ni = a2r * him + a2i * hre + e[1];
            hre = nr; him = ni;
        }
        const bf16_t* cm = (const bf16_t*)(W + W_S5C) + (size_t)(g * 16 + fr) * 128;
#pragma unroll
        for (int ks = 0; ks < 4; ++ks) cf[ks] = *(const bf16x8*)(cm + 32 * ks + 8 * fq);
#pragma unroll
        for (int r = 0; r < 4; ++r) dv[r] = p.in[22][(size_t)l * 256 + g * 16 + 4 * fq + r];
    }
    const bf16_t* xin = (const bf16_t*)(p.ws + OFF_R + R_S5IN) + ((size_t)(b * SEQ + ch * 256)) * 256 + g * 16;
    bf16_t* yg = (bf16_t*)(p.ws + OFF_C + C_YG) + ((size_t)(b * SEQ + ch * 256)) * 256 + g * 16;
    float* xs = (float*)(lds + w * 10240);
    int ldsbad = 0; (void)ldsbad;
    unsigned char* Hs = lds + w * 10240 + 2048;
#if DBG_TWICE
    float keep_re = 0.f, keep_im = 0.f;
#pragma unroll 1
    for (int rep = 0; rep < 2; ++rep) {
    if (rep == 1) { keep_re = hre; keep_im = him; hre = 0.f; him = 0.f; }
#endif
#pragma unroll 1
    for (int sub = 0; sub < 8; ++sub) {
#if DBG_S5CONST >= 1
        u32x4 xv; { const unsigned q = (unsigned)(sub * 32 + (lane >> 1)) * 2654435761u + (unsigned)id * 40503u + (lane & 1); xv.x = 0x3f803e80u ^ ((q & 0xff) << 16); xv.y = 0x3e003d00u ^ ((q >> 8) & 0x7f); xv.z = 0xbe803f00u ^ ((q >> 16) & 0x3f); xv.w = 0x3d80be00u; }
#else
        const u32x4 xv = *(const u32x4*)(xin + (size_t)(sub * 32 + (lane >> 1)) * 256 + (lane & 1) * 8);
#endif
        vb_sync(lds);
        f32x4 chk_a = {bflo(xv.x), bfhi(xv.x), bflo(xv.y), bfhi(xv.y)}, chk_c = {bflo(xv.z), bfhi(xv.z), bflo(xv.w), bfhi(xv.w)};
        {
            *(f32x4*)(xs + (lane >> 1) * 16 + (lane & 1) * 8) = chk_a;
            *(f32x4*)(xs + (lane >> 1) * 16 + (lane & 1) * 8 + 4) = chk_c;
        }
        vb_sync(lds);
#pragma unroll 4
        for (int st = 0; st < 32; ++st) {
#if DBG_S5CONST == 3
            f32x4 x0, x1, x2, x3;
            { const float t = (float)((sub * 32 + st) & 63) * 0.015625f + (float)(id & 7) * 0.125f;
              x0 = (f32x4){t, t * 0.5f, -t, 0.25f}; x1 = (f32x4){0.5f - t, t * t, 0.125f, t}; x2 = (f32x4){-0.25f, t, 0.75f * t, 1.f - t}; x3 = (f32x4){t, -t, 0.5f, 0.3f * t}; }
#else
            const f32x4 x0 = *(const f32x4*)(xs + st * 16), x1 = *(const f32x4*)(xs + st * 16 + 4), x2 = *(const f32x4*)(xs + st * 16 + 8), x3 = *(const f32x4*)(xs + st * 16 + 12);
#endif
            float ur = 0.f, ui = 0.f;
#pragma unroll
            for (int h = 0; h < 4; ++h) {
                ur += br[h] * x0[h]; ui += bi[h] * x0[h];
                ur += br[4 + h] * x1[h]; ui += bi[4 + h] * x1[h];
                ur += br[8 + h] * x2[h]; ui += bi[8 + h] * x2[h];
                ur += br[12 + h] * x3[h]; ui += bi[12 + h] * x3[h];
            }
            const float nr = ar * hre - ai * him + ur, ni = ar * him + ai * hre + ui;
            hre = nr; him = ni;
            if (pass == 2) {
                *(bf16_t*)(Hs + st * 256 + (((lane >> 3) ^ (st & 15)) << 4) + (lane & 7) * 2) = f2bf(hre);
                *(bf16_t*)(Hs + st * 256 + ((((64 + lane) >> 3) ^ (st & 15)) << 4) + (lane & 7) * 2) = f2bf(him);
            }
        }
#if DBG_LDSCHK
        {
            const f32x4 ra = *(volatile f32x4*)(xs + (lane >> 1) * 16 + (lane & 1) * 8), rc = *(volatile f32x4*)(xs + (lane >> 1) * 16 + (lane & 1) * 8 + 4);
            bool bad = false;
            for (int q = 0; q < 4; ++q) bad |= (__float_as_uint(ra[q]) != __float_as_uint(chk_a[q])) | (__float_as_uint(rc[q]) != __float_as_uint(chk_c[q]));
            if (__any(bad)) ldsbad = 1;
        }
#endif
        if (pass == 2) {
            vb_sync(lds);
#pragma unroll
            for (int tt = 0; tt < 2; ++tt) {
                f32x4 acc = {0.f, 0.f, 0.f, 0.f};
                const int tl = tt * 16 + fr;
#pragma unroll
                for (int ks = 0; ks < 4; ++ks) {
                    const bf16x8 hf = *(const bf16x8*)(Hs + tl * 256 + (((4 * ks + fq) ^ (tl & 15)) << 4));
                    acc = mfma16(cf[ks], hf, acc);
                }
                float y[4];
#pragma unroll
                for (int r = 0; r < 4; ++r) y[r] = gelu_tanh(acc[r] + dv[r] * xs[tl * 16 + 4 * fq + r]);
                u32x2 o; o.x = pk_bf16(y[0], y[1]); o.y = pk_bf16(y[2], y[3]);
                *(u32x2*)(yg + (size_t)(sub * 32 + tl) * 256 + 4 * fq) = o;
            }
        }
    }
#if DBG_TWICE
    }
    if (__float_as_uint(keep_re) != __float_as_uint(hre) || __float_as_uint(keep_im) != __float_as_uint(him)) { hre = __uint_as_float(0x7fc00000u); him = hre; }
#endif
    if (pass == 1) {
        float* e = Eb + ((size_t)(seq * 16 + ch) * 64 + lane) * 2;
#if DBG_LDSCHK
        if (ldsbad) { hre = __uint_as_float(0x7fc00000u); him = hre; }
#endif
#if DBG_ESC1
        { const unsigned long long pk = ((unsigned long long)__float_as_uint(him) << 32) | __float_as_uint(hre);
          __hip_atomic_store((unsigned long long*)e, pk, __ATOMIC_RELAXED, __HIP_MEMORY_SCOPE_AGENT); }
#else
        e[0] = hre; e[1] = him;
#endif
#if DBG_E2
        float* e2 = (float*)(p.ws + OFF_C + C_ATT) + ((size_t)(seq * 16 + ch) * 64 + lane) * 2;
        e2[0] = hre; e2[1] = him;
#endif
    }
    vb_sync(lds);
}

__device__ __forceinline__ void phase_mid1(CKP& p, int l, unsigned char* lds) {
    if (blockIdx.x < 64) { compress_tile(p, (int)blockIdx.x, lds); return; }
    for (int j = VBID() - 128; j < 768; j += VGRID() - 128) {
        if (j < 256) sgu_job(p, l, j, lds);
        else s5_job(p, l, j - 256, 1, lds);
    }
}

constexpr int AL_Q = 0, AL_KV = 32768, AL_IMP = 49152, AL_SEL = 65792, AL_UNI = 66304, AL_JOB = 66336;
constexpr float SM_C = 0.125f * 1.4426950408889634f;

__device__ __forceinline__ void attn_load_q(const bf16_t* Qg, const int* pos, const float (&inv_freq)[8], int b, int g, int t0, bool rope, unsigned char* lds, int tid) {
#pragma unroll 1
    for (int j = 0; j < 8; ++j) {
        const int pid = tid + 256 * j, Rr = pid >> 3, ch = pid & 7;
        const int wq = Rr >> 6, r = (Rr >> 4) & 3, q = Rr & 15, t = t0 + 16 * wq + q;
        const bf16_t* src = Qg + ((size_t)(b * SEQ + t)) * 512 + (g * 4 + r) * 64;
        if (!rope || ch >= 2) {
            *(u32x4*)(lds + AL_Q + Rr * 128 + ((ch ^ (Rr & 7)) << 4)) = *(const u32x4*)(src + ch * 8);
        } else if (ch == 0) {
            const u32x4 a = *(const u32x4*)(src), c = *(const u32x4*)(src + 8);
            float x1[8] = {bflo(a.x), bfhi(a.x), bflo(a.y), bfhi(a.y), bflo(a.z), bfhi(a.z), bflo(a.w), bfhi(a.w)};
            float x2[8] = {bflo(c.x), bfhi(c.x), bflo(c.y), bfhi(c.y), bflo(c.z), bfhi(c.z), bflo(c.w), bfhi(c.w)};
            const float ps = (float)pos[b * SEQ + t];
#pragma unroll
            for (int i = 0; i < 8; ++i) {
                float sn, cs; sincosf(ps * inv_freq[i], &sn, &cs);
                const float u = x1[i], v = x2[i];
                x1[i] = u * cs - v * sn; x2[i] = v * cs + u * sn;
            }
            u32x4 o1, o2;
            o1.x = pk_bf16(x1[0], x1[1]); o1.y = pk_bf16(x1[2], x1[3]); o1.z = pk_bf16(x1[4], x1[5]); o1.w = pk_bf16(x1[6], x1[7]);
            o2.x = pk_bf16(x2[0], x2[1]); o2.y = pk_bf16(x2[2], x2[3]); o2.z = pk_bf16(x2[4], x2[5]); o2.w = pk_bf16(x2[6], x2[7]);
            *(u32x4*)(lds + AL_Q + Rr * 128 + ((0 ^ (Rr & 7)) << 4)) = o1;
            *(u32x4*)(lds + AL_Q + Rr * 128 + ((1 ^ (Rr & 7)) << 4)) = o2;
        }
    }
}
__device__ __forceinline__ void attn_ldg(u32x4 (&kk)[2], u32x4 (&vv)[2], const bf16_t* Kb, const bf16_t* Vb, int vstride, int tid) {
#pragma unroll
    for (int j = 0; j < 2; ++j) {
        const int pid = tid + 256 * j, row = pid >> 3, ch = pid & 7;
        kk[j] = *(const u32x4*)(Kb + (size_t)row * 128 + ch * 8);
        vv[j] = *(const u32x4*)(Vb + (size_t)row * vstride + ch * 8);
    }
}
__device__ __forceinline__ void attn_stl(const u32x4 (&kk)[2], const u32x4 (&vv)[2], unsigned char* lds, int kvoff, int tid) {
#pragma unroll
    for (int j = 0; j < 2; ++j) {
        const int pid = tid + 256 * j, row = pid >> 3, ch = pid & 7;
        *(u32x4*)(lds + kvoff + row * 128 + ((ch ^ (row & 7)) << 4)) = kk[j];
        *(u32x4*)(lds + kvoff + 8192 + row * 128 + ((ch ^ ((row >> 1) & 7)) << 4)) = vv[j];
    }
}
__device__ __forceinline__ void attn_qk(f32x4 (&s)[2][4], const unsigned char* lds, int kvoff, int w, int fr, int fq, int hf) {
    const unsigned char* Qw = lds + AL_Q + w * 8192;
    const unsigned char* Kh = lds + kvoff + hf * 4096;
    const int sw0 = ((fq) ^ (fr & 7)) << 4, sw1 = ((4 + fq) ^ (fr & 7)) << 4;
#pragma unroll
    for (int ki = 0; ki < 2; ++ki)
#pragma unroll
        for (int qi = 0; qi < 4; ++qi) s[ki][qi] = (f32x4){0.f, 0.f, 0.f, 0.f};
#pragma unroll
    for (int ds = 0; ds < 2; ++ds) {
        bf16x8 qf[4];
#pragma unroll
        for (int qi = 0; qi < 4; ++qi) qf[qi] = *(const bf16x8*)(Qw + (qi * 16 + fr) * 128 + (ds ? sw1 : sw0));
#pragma unroll
        for (int ki = 0; ki < 2; ++ki) {
            const bf16x8 kf = *(const bf16x8*)(Kh + (ki * 16 + fr) * 128 + (ds ? sw1 : sw0));
#pragma unroll
            for (int qi = 0; qi < 4; ++qi) s[ki][qi] = mfma16(kf, qf[qi], s[ki][qi]);
        }
    }
}
__device__ __forceinline__ void attn_pv(f32x4 (&o)[4][4], const f32x4 (&s)[2][4], const unsigned char* lds, int kvoff, int fr, int fq, int hf) {
    bf16x8 pf[4];
#pragma unroll
    for (int qi = 0; qi < 4; ++qi) {
        u32x4 u;
        u.x = pk_bf16(s[0][qi][0], s[0][qi][1]); u.y = pk_bf16(s[0][qi][2], s[0][qi][3]);
        u.z = pk_bf16(s[1][qi][0], s[1][qi][1]); u.w = pk_bf16(s[1][qi][2], s[1][qi][3]);
        pf[qi] = as_bf8(u);
    }
    const int c0 = 4 * hf + (fq >> 1);
    const unsigned char* Vt = lds + kvoff + 8192;
#pragma unroll
    for (int di = 0; di < 4; ++di) {
        const int row = di * 16 + fr, key = (row >> 1) & 7;
        const u32x2 lo = *(const u32x2*)(Vt + row * 128 + ((c0 ^ key) << 4) + 8 * (fq & 1));
        const u32x2 hi = *(const u32x2*)(Vt + row * 128 + (((c0 + 2) ^ key) << 4) + 8 * (fq & 1));
        const bf16x8 vf = as_bf8((u32x4){lo.x, lo.y, hi.x, hi.y});
#pragma unroll
        for (int qi = 0; qi < 4; ++qi) o[di][qi] = mfma16(vf, pf[qi], o[di][qi]);
    }
}
__device__ __forceinline__ unsigned attn_vmask(int kb, int fq, int lo, int hi) {
    unsigned vm = 0;
#pragma unroll
    for (int ki = 0; ki < 2; ++ki)
#pragma unroll
        for (int r = 0; r < 4; ++r) { const int key = kb + 16 * ki + 4 * fq + r; if (key >= lo && key <= hi) vm |= 1u << (ki * 4 + r); }
    return vm;
}
__device__ __forceinline__ void attn_softmax(f32x4 (&s)[2][4], f32x4 (&o)[4][4], float (&m)[4], float (&lsum)[4], unsigned vm) {
#pragma unroll
    for (int qi = 0; qi < 4; ++qi) {
        float mx = -1e30f;
#pragma unroll
        for (int ki = 0; ki < 2; ++ki)
#pragma unroll
            for (int r = 0; r < 4; ++r) { const float sv = ((vm >> (ki * 4 + r)) & 1u) ? s[ki][qi][r] * SM_C : -1e30f; s[ki][qi][r] = sv; mx = fmaxf(mx, sv); }
        mx = xmax16(mx); mx = xmax32(mx);
        const float mn = fmaxf(m[qi], mx), alpha = fexp2(m[qi] - mn);
        m[qi] = mn;
        float ls = 0.f;
#pragma unroll
        for (int ki = 0; ki < 2; ++ki)
#pragma unroll
            for (int r = 0; r < 4; ++r) { const float pv = ((vm >> (ki * 4 + r)) & 1u) ? fexp2(s[ki][qi][r] - mn) : 0.f; s[ki][qi][r] = pv; ls += pv; }
        lsum[qi] = lsum[qi] * alpha + ls;
        if (__any(alpha != 1.f)) {
#pragma unroll
            for (int di = 0; di < 4; ++di) o[di][qi] *= alpha;
        }
    }
}
__device__ __forceinline__ void attn_softmax_full(f32x4 (&s)[2][4], f32x4 (&o)[4][4], float (&m)[4], float (&lsum)[4], bool lsel) {
#pragma unroll
    for (int qi = 0; qi < 4; ++qi) {
        float mx = fmaxf(fmaxf(fmaxf(s[0][qi][0], s[0][qi][1]), fmaxf(s[0][qi][2], s[0][qi][3])), fmaxf(fmaxf(s[1][qi][0], s[1][qi][1]), fmaxf(s[1][qi][2], s[1][qi][3])));
        mx = xmax16(mx); mx = xmax32(mx);
        const float mn = fmaxf(m[qi], mx * SM_C);
        const float mnew = lsel ? mn : m[qi];
        const float alpha = fexp2(m[qi] - mnew);
        m[qi] = mnew;
        const float neg = lsel ? -mn : -1e30f;
        float ls = 0.f;
#pragma unroll
        for (int ki = 0; ki < 2; ++ki)
#pragma unroll
            for (int r = 0; r < 4; ++r) { const float pv = fexp2(fmaf(s[ki][qi][r], SM_C, neg)); s[ki][qi][r] = pv; ls += pv; }
        lsum[qi] = lsum[qi] * alpha + ls;
        if (__any(alpha != 1.f)) {
#pragma unroll
            for (int di = 0; di < 4; ++di) o[di][qi] *= alpha;
        }
    }
}
__device__ __forceinline__ void attn_accum(bf16_t* dst, const f32x4 (&o)[4][4], const float (&lsum)[4], const float (&gate)[4], bool first, int fq) {
#pragma unroll
    for (int qi = 0; qi < 4; ++qi) {
        float lt = lsum[qi]; lt = xsum16(lt); lt = xsum32(lt);
        const float sc = gate[qi] / fmaxf(lt, 1e-30f);
#pragma unroll
        for (int di = 0; di < 4; ++di) {
            u32x2* ptr = (u32x2*)(dst + qi * 64 + 16 * di + 4 * fq);
            float a0 = o[di][qi][0] * sc, a1 = o[di][qi][1] * sc, a2 = o[di][qi][2] * sc, a3 = o[di][qi][3] * sc;
            if (!first) { const u32x2 f = *ptr; a0 += bflo(f.x); a1 += bfhi(f.x); a2 += bflo(f.y); a3 += bfhi(f.y); }
            u32x2 r; r.x = pk_bf16(a0, a1); r.y = pk_bf16(a2, a3);
            *ptr = r;
        }
    }
}
template <class NextF, class PtrF, class BodyF>
__device__ __forceinline__ void attn_tiles(int first, NextF next, PtrF ptrs, BodyF body, unsigned char* lds, int tid) {
    u32x4 kk[2], vv[2];
    const bf16_t* Kb; const bf16_t* Vb; int vs;
    ptrs(first, Kb, Vb, vs);
    attn_ldg(kk, vv, Kb, Vb, vs, tid);
    int cur = first;
    while (cur >= 0) {
        vb_sync(lds);
        attn_stl(kk, vv, lds, AL_KV, tid);
        vb_sync(lds);
        const int nx = next(cur);
        if (nx >= 0) { ptrs(nx, Kb, Vb, vs); attn_ldg(kk, vv, Kb, Vb, vs, tid); }
        body(cur, AL_KV);
        cur = nx;
    }
}

__device__ __forceinline__ void phase_attn(CKP& p, int l, unsigned char* lds, unsigned* ctl) {
    for (int j = VBID(); j < 512; j += VGRID()) s5_job(p, l, j, 2, lds);

    unsigned char* R = p.ws + OFF_R; unsigned char* C = p.ws + OFF_C;
    const bf16_t* Qg = (const bf16_t*)(R + R_Q);
    const bf16_t* Kc = (const bf16_t*)(C + C_KCMP); const bf16_t* Vc = (const bf16_t*)(C + C_VCT);
    const bf16_t* Ks = (const bf16_t*)(R + R_KS); const bf16_t* Vs = (const bf16_t*)(R + R_VST);
    const bf16_t* Kw = (const bf16_t*)(R + R_KW); const bf16_t* Vw = (const bf16_t*)(R + R_VWT);
    const float* NG = (const float*)(R + R_NG);
    bf16_t* AO = (bf16_t*)(C + C_ATT);
    const int* pos = (const int*)p.in[1];
    unsigned* ctr = ctl + CTL_ATTN + l;
    volatile int* jobp = (volatile int*)(lds + AL_JOB);
    float* imp = (float*)(lds + AL_IMP);
    unsigned long long* selm = (unsigned long long*)(lds + AL_SEL);
    unsigned long long* uni = (unsigned long long*)(lds + AL_UNI);
    float invf[8];
#pragma unroll
    for (int q = 0; q < 8; ++q) invf[q] = p.inv_freq[q];

    if (opaque_tid() == 0) *(volatile int*)(lds + AL_JOB + 8) = 0;
    for (;;) {
        const int tid = opaque_tid(), lane = tid & 63, w = tid >> 6, fr = lane & 15, fq = lane >> 4;
        vb_sync(lds);
        if (tid == 0) { *jobp = (int)atomicAdd(ctr, 1u); *(volatile int*)(lds + AL_JOB + 8) += 1; }
        vb_sync(lds);
        const int job = *jobp, grabs = *(volatile int*)(lds + AL_JOB + 8);
        if (grabs == 2 || (job >= 1024 && grabs == 1)) convert_tiles(p, l, 11, 14, VBID() * 4 + w, VGRID() * 4, lane);
        if (job >= 1024) break;
        const int i = 63 - (job >> 4), bg = job & 15, b = bg >> 1, g = bg & 1, t0 = i * 64;
        const int tq = t0 + 16 * w + fr;
        const size_t kvrow = (size_t)b * SEQ;
        float gate[4];
        bf16_t* dstq = AO + ((size_t)(kvrow + tq)) * 512 + (g * 4) * 64;

        attn_load_q(Qg, pos, invf, b, g, t0, false, lds, tid);
        const int ntc = ((4 * i + 2) >> 6) + 1;
        const int hic = (tq >= 31) ? ((tq - 31) >> 4) : -1;
        float m[4], lsum[4];
#pragma unroll
        for (int qi = 0; qi < 4; ++qi) { m[qi] = -1e30f; lsum[qi] = 0.f; }
        auto cmp_next = [&](int ct) { return (ct + 1 < ntc) ? ct + 1 : -1; };
        auto cmp_ptrs = [&](int ct, const bf16_t*& Kb, const bf16_t*& Vb, int& vs) {
            Kb = Kc + ((size_t)(b * 256 + ct * 64)) * 128 + g * 64; Vb = Vc + ((size_t)((b * 2 + g) * 64)) * 256 + ct * 64; vs = 256; };
        attn_tiles(0, cmp_next, cmp_ptrs, [&](int ct, int kvoff) {
#pragma unroll 1
            for (int hf = 0; hf < 2; ++hf) {
                f32x4 s[2][4];
                attn_qk(s, lds, kvoff, w, fr, fq, hf);
                const unsigned vm = attn_vmask(ct * 64 + hf * 32, fq, 0, hic);
#pragma unroll
                for (int qi = 0; qi < 4; ++qi) {
                    float mx = -1e30f;
#pragma unroll
                    for (int ki = 0; ki < 2; ++ki)
#pragma unroll
                        for (int r = 0; r < 4; ++r) { const float sv = ((vm >> (ki * 4 + r)) & 1u) ? s[ki][qi][r] * SM_C : -1e30f; s[ki][qi][r] = sv; mx = fmaxf(mx, sv); }
                    mx = xmax16(mx); mx = xmax32(mx);
                    const float mn = fmaxf(m[qi], mx), alpha = fexp2(m[qi] - mn);
                    m[qi] = mn;
                    float ls = 0.f;
#pragma unroll
                    for (int ki = 0; ki < 2; ++ki)
#pragma unroll
                        for (int r = 0; r < 4; ++r) ls += ((vm >> (ki * 4 + r)) & 1u) ? fexp2(s[ki][qi][r] - mn) : 0.f;
                    lsum[qi] = lsum[qi] * alpha + ls;
                }
            }
        }, lds, tid);
        float invl[4];
#pragma unroll
        for (int qi = 0; qi < 4; ++qi) { float lt = lsum[qi]; lt = xsum16(lt); lt = xsum32(lt); invl[qi] = 1.f / fmaxf(lt, 1e-30f); }
        {
            f32x4 o[4][4]; zero_acc(o);
            float carry = 0.f;
            attn_tiles(0, cmp_next, cmp_ptrs, [&](int ct, int kvoff) {
#pragma unroll 1
                for (int hf = 0; hf < 2; ++hf) {
                    f32x4 s[2][4];
                    attn_qk(s, lds, kvoff, w, fr, fq, hf);
                    const unsigned vm = attn_vmask(ct * 64 + hf * 32, fq, 0, hic);
#pragma unroll
                    for (int qi = 0; qi < 4; ++qi)
#pragma unroll
                        for (int ki = 0; ki < 2; ++ki)
#pragma unroll
                            for (int r = 0; r < 4; ++r) s[ki][qi][r] = ((vm >> (ki * 4 + r)) & 1u) ? fexp2(s[ki][qi][r] * SM_C - m[qi]) * invl[qi] : 0.f;
#pragma unroll
                    for (int ki = 0; ki < 2; ++ki) {
                        float a = 0.f, bq = 0.f;
#pragma unroll
                        for (int qi = 0; qi < 4; ++qi) { a += s[ki][qi][0] + s[ki][qi][1] + s[ki][qi][2] + 0.5f * s[ki][qi][3]; bq += 0.5f * s[ki][qi][3]; }
                        const float up = __shfl(bq, (lane + 48) & 63);
                        const float wrap = __shfl(carry, (lane + 48) & 63);
                        a += (fq >= 1) ? up : wrap;
                        carry = bq;
                        imp[(16 * w + fr) * 65 + 16 * ct + 8 * hf + 4 * ki + fq] = a;
                    }
                    attn_pv(o, s, lds, kvoff, fr, fq, hf);
                }
            }, lds, tid);
#pragma unroll
            for (int qi = 0; qi < 4; ++qi) gate[qi] = NG[((size_t)(kvrow + tq)) * 24 + (g * 4 + qi) * 3 + 0];
            const float quarter[4] = {0.25f, 0.25f, 0.25f, 0.25f};
            attn_accum(dstq, o, quarter, gate, true, fq);
        }
        vb_sync(lds);
        {
            const int q = tid >> 2, part = tid & 3;
            unsigned long long mk = 0ull;
            if (i <= 15) { mk = (i == 63) ? ~0ull : ((1ull << (i + 1)) - 1ull); }
            else {
                const float* row = imp + q * 65;
                for (int j = 1 + part; j <= i - 2; j += 4) {
                    const float vj = row[j]; int rank = 0;
                    for (int j2 = 1; j2 <= i - 2; ++j2) { const float v2 = row[j2]; rank += (v2 > vj || (v2 == vj && j2 < j)) ? 1 : 0; }
                    if (rank < 13) mk |= 1ull << j;
                }
                unsigned lo32 = (unsigned)mk, hi32 = (unsigned)(mk >> 32);
                lo32 |= __shfl_xor(lo32, 1); hi32 |= __shfl_xor(hi32, 1);
                lo32 |= __shfl_xor(lo32, 2); hi32 |= __shfl_xor(hi32, 2);
                mk = ((unsigned long long)hi32 << 32) | lo32;
                mk |= 1ull | (1ull << i) | (1ull << (i - 1));
            }
            if (part == 0) selm[q] = mk;
            unsigned lo32 = (unsigned)mk, hi32 = (unsigned)(mk >> 32);
#pragma unroll
            for (int o2 = 32; o2 >= 1; o2 >>= 1) { lo32 |= __shfl_xor(lo32, o2); hi32 |= __shfl_xor(hi32, o2); }
            if (lane == 0) uni[w] = ((unsigned long long)hi32 << 32) | lo32;
        }
        vb_sync(lds);
        const unsigned long long mymask = selm[16 * w + fr];
        const unsigned long long un = uni[0] | uni[1] | uni[2] | uni[3];
        vb_sync(lds);
        attn_load_q((const bf16_t*)(R + R_QR), pos, invf, b, g, t0, false, lds, tid);
        {
            f32x4 o[4][4]; zero_acc(o);
#pragma unroll
            for (int qi = 0; qi < 4; ++qi) { m[qi] = -1e30f; lsum[qi] = 0.f; }
            attn_tiles(0,
                [&](int j) { const unsigned long long rest = (j >= 63) ? 0ull : (un >> (j + 1)); return rest ? (j + 1 + (int)__ffsll((long long)rest) - 1) : -1; },
                [&](int j, const bf16_t*& Kb, const bf16_t*& Vb, int& vs) { Kb = Ks + (kvrow + j * 64) * 128 + g * 64; Vb = Vs + ((size_t)((b * 2 + g) * 64)) * SEQ + j * 64; vs = SEQ; },
                [&](int j, int kvoff) {
                    const bool lsel = ((mymask >> j) & 1ull) != 0ull;
                    const int hi = lsel ? tq : -1;
#pragma unroll 1
                    for (int hf = 0; hf < 2; ++hf) {
                        f32x4 s[2][4];
                        attn_qk(s, lds, kvoff, w, fr, fq, hf);
                        if (j < i) attn_softmax_full(s, o, m, lsum, lsel);
                        else { const unsigned vm = attn_vmask(j * 64 + hf * 32, fq, 0, hi); attn_softmax(s, o, m, lsum, vm); }
                        attn_pv(o, s, lds, kvoff, fr, fq, hf);
                    }
                }, lds, tid);
#pragma unroll
            for (int qi = 0; qi < 4; ++qi) gate[qi] = NG[((size_t)(kvrow + tq)) * 24 + (g * 4 + qi) * 3 + 1];
            attn_accum(dstq, o, lsum, gate, false, fq);
        }
        {
            f32x4 o[4][4]; zero_acc(o);
#pragma unroll
            for (int qi = 0; qi < 4; ++qi) { m[qi] = -1e30f; lsum[qi] = 0.f; }
            const int j0 = (i >= 8) ? (i - 8) : 0;
            attn_tiles(j0,
                [&](int j) { return (j + 1 <= i) ? j + 1 : -1; },
                [&](int j, const bf16_t*& Kb, const bf16_t*& Vb, int& vs) { Kb = Kw + (kvrow + j * 64) * 128 + g * 64; Vb = Vw + ((size_t)((b * 2 + g) * 64)) * SEQ + j * 64; vs = SEQ; },
                [&](int j, int kvoff) {
#pragma unroll 1
                    for (int hf = 0; hf < 2; ++hf) {
                        f32x4 s[2][4];
                        attn_qk(s, lds, kvoff, w, fr, fq, hf);
                        if (j >= i - 7 && j < i) attn_softmax_full(s, o, m, lsum, true);
                        else { const unsigned vm = attn_vmask(j * 64 + hf * 32, fq, tq - 511, tq); attn_softmax(s, o, m, lsum, vm); }
                        attn_pv(o, s, lds, kvoff, fr, fq, hf);
                    }
                }, lds, tid);
#pragma unroll
            for (int qi = 0; qi < 4; ++qi) gate[qi] = NG[((size_t)(kvrow + tq)) * 24 + (g * 4 + qi) * 3 + 2];
            attn_accum(dstq, o, lsum, gate, false, fq);
        }
    }
}

__device__ __forceinline__ void phase_glu(CKP& p, int l, unsigned char* lds) {
    const int tid = opaque_tid(), lane = tid & 63, w = tid >> 6, wm = w >> 1, wn = w & 1, fr = lane & 15, fq = lane >> 4;
    const bf16_t* A = (const bf16_t*)(p.ws + OFF_C + C_YG);
    const bf16_t* Bt = (const bf16_t*)(p.ws + OFF_W + W_GLU);
    bf16_t* O = (bf16_t*)(p.ws + OFF_C + C_S5O);
    const float* gb = p.in[24] + (size_t)l * 256;
    constexpr int NTM = NTOK / 128, NTN = 2;
    for (int L = VBID(); L < NTM * NTN; L += VGRID()) {
        int tm, tn; tile_coords(L, NTM, NTN, tm, tn);
        const int m0 = tm * 128, n0 = tn * 128;
        f32x4 acc[4][4]; zero_acc(acc);
        gemm_kloop(acc, [&](int r) { return A + (size_t)(m0 + r) * 256; }, 64, [&](int v) { return Bt + (size_t)(n0 + v) * 256; }, 64, 4, lds, tid);
#pragma unroll
        for (int mi = 0; mi < 4; ++mi) {
            const int row = m0 + 64 * wm + 16 * mi + fr, col = n0 + 64 * wn + 16 * fq;
            const u32x4 y0 = *(const u32x4*)(A + (size_t)row * 256 + col), y1 = *(const u32x4*)(A + (size_t)row * 256 + col + 8);
            const unsigned yy[8] = {y0.x, y0.y, y0.z, y0.w, y1.x, y1.y, y1.z, y1.w};
            float v[16];
#pragma unroll
            for (int e = 0; e < 16; ++e) {
                const float y = (e & 1) ? bfhi(yy[e >> 1]) : bflo(yy[e >> 1]);
                v[e] = y * sigm(acc[mi][e >> 2][e & 3] + gb[col + e]);
            }
            store16bf(O + (size_t)row * 256 + col, v);
        }
    }
}

struct G8Branch {
    static constexpr bool GATHER = false;
    const char* ws;
    __device__ __forceinline__ bool next(int i, G8Unit& u, const int (&R)[2], const unsigned (&C2)[2]) const {
        const int T = i / 6, sub = i - T * 6, L = T * (int)gridDim.x + (int)blockIdx.x;
        if (L >= (NTOK / 256) * 4) return false;
        int pm, pn; tile_coords(L, NTOK / 256, 4, pm, pn); pm = __builtin_amdgcn_readfirstlane(pm); pn = __builtin_amdgcn_readfirstlane(pn);
        const int br = sub >> 1;
        if (sub & 1) { u.K2 = 2048u; u.nt = 16; u.A0 = ws + OFF_H + (size_t)pm * 256 * 2048; u.B0 = ws + OFF_W + W_GB + (size_t)(br * 1024 + pn * 256) * 2048; }
        else {
            const unsigned k2 = br == 0 ? 1024u : 512u; u.K2 = k2; u.nt = br == 0 ? 8 : 4;
            const size_t b1 = (size_t)(br == 1), b2 = (size_t)(br == 2);
            const char* a = ws + (size_t)(OFF_C + C_ATT) + b1 * (size_t)(C_SGU - C_ATT) + b2 * (size_t)(C_S5O - C_ATT);
            const char* w = ws + (size_t)(OFF_W + W_A) + b1 * (size_t)(W_S - W_A) + b2 * (size_t)(W_5 - W_A);
            u.A0 = a + (size_t)pm * 256 * k2; u.B0 = w + (size_t)pn * 256 * k2;
        }
        u.A1 = u.A0 + (size_t)128 * u.K2; u.B1 = u.B0 + (size_t)128 * u.K2;
        u.x0 = pm; u.x1 = pn; u.x2 = sub; u.x3 = 0;
#pragma unroll
        for (int h = 0; h < 2; ++h)
#pragma unroll
            for (int k = 0; k < 2; ++k) u.ao[h][k] = (unsigned)R[k] * u.K2 + C2[k];
        return true;
    }
};
struct EpiBranch {
    bf16_t* Yt; bf16_t* Mg;
    __device__ __forceinline__ void operator()(const G8Acc& acc, const G8Unit& u, int wr, int wc, int fr, int fq) const {
        const int sub = u.x2;
        const size_t off0 = (size_t)(u.x0 * 256 + wr * 64 + fr) * 1024 + u.x1 * 256 + wc * 32 + 8 * fq;
        if (!(sub & 1)) {
#pragma unroll
            for (int ai = 0; ai < 2; ++ai)
#pragma unroll
                for (int m = 0; m < 4; ++m)
#pragma unroll
                    for (int bj = 0; bj < 2; ++bj) {
                        const f32x4 v0 = acc[ai][bj][m][0], v1 = acc[ai][bj][m][1];
                        u32x4 o; o.x = pk_bf16(v0[0], v0[1]); o.y = pk_bf16(v0[2], v0[3]); o.z = pk_bf16(v1[0], v1[1]); o.w = pk_bf16(v1[2], v1[3]);
                        *(u32x4*)(Yt + off0 + (size_t)(ai * 128 + m * 16) * 1024 + bj * 128) = o;
                    }
        } else {
#pragma unroll
            for (int ai = 0; ai < 2; ++ai) {
                u32x4 y[4][2], pv[4][2];
#pragma unroll
                for (int m = 0; m < 4; ++m)
#pragma unroll
                    for (int bj = 0; bj < 2; ++bj) {
                        const size_t off = off0 + (size_t)(ai * 128 + m * 16) * 1024 + bj * 128;
                        y[m][bj] = *(const u32x4*)(Yt + off);
                        pv[m][bj] = (u32x4){0u, 0u, 0u, 0u};
                        if (sub > 1) pv[m][bj] = *(const u32x4*)(Mg + off);
                    }
#pragma unroll
                for (int m = 0; m < 4; ++m)
#pragma unroll
                    for (int bj = 0; bj < 2; ++bj) {
                        const f32x4 v0 = acc[ai][bj][m][0], v1 = acc[ai][bj][m][1];
                        const u32x4 yy = y[m][bj], pp = pv[m][bj];
                        u32x4 o;
                        o.x = pk_bf16(sigm(v0[0]) * bflo(yy.x) + bflo(pp.x), sigm(v0[1]) * bfhi(yy.x) + bfhi(pp.x));
                        o.y = pk_bf16(sigm(v0[2]) * bflo(yy.y) + bflo(pp.y), sigm(v0[3]) * bfhi(yy.y) + bfhi(pp.y));
                        o.z = pk_bf16(sigm(v1[0]) * bflo(yy.z) + bflo(pp.z), sigm(v1[1]) * bfhi(yy.z) + bfhi(pp.z));
                        o.w = pk_bf16(sigm(v1[2]) * bflo(yy.w) + bflo(pp.w), sigm(v1[3]) * bfhi(yy.w) + bfhi(pp.w));
                        *(u32x4*)(Mg + off0 + (size_t)(ai * 128 + m * 16) * 1024 + bj * 128) = o;
                    }
            }
        }
    }
};
__device__ __forceinline__ void phase_branch(CKP& p, int l, unsigned char* lds) {
    G8Branch S{(const char*)p.ws};
    EpiBranch E{(bf16_t*)(p.ws + OFF_R), (bf16_t*)(p.ws + OFF_M)};
    g8_phase(S, E);
}

struct EpiMix {
    bf16_t* x;
    __device__ __forceinline__ void operator()(const G8Acc& acc, const G8Unit& u, int wr, int wc, int fr, int fq) const {
        bf16_t* xp0 = x + (size_t)(u.x0 * 256 + wr * 64 + fr) * 1024 + u.x1 * 256 + wc * 32 + 8 * fq;
#pragma unroll
        for (int ai = 0; ai < 2; ++ai) {
            u32x4 xv[4][2];
#pragma unroll
            for (int m = 0; m < 4; ++m)
#pragma unroll
                for (int bj = 0; bj < 2; ++bj) xv[m][bj] = *(const u32x4*)(xp0 + (size_t)(ai * 128 + m * 16) * 1024 + bj * 128);
#pragma unroll
            for (int m = 0; m < 4; ++m)
#pragma unroll
                for (int bj = 0; bj < 2; ++bj) {
                    const f32x4 a0 = acc[ai][bj][m][0], a1 = acc[ai][bj][m][1]; const u32x4 xx = xv[m][bj];
                    u32x4 o;
                    o.x = pk_bf16(bflo(xx.x) + a0[0], bfhi(xx.x) + a0[1]); o.y = pk_bf16(bflo(xx.y) + a0[2], bfhi(xx.y) + a0[3]);
                    o.z = pk_bf16(bflo(xx.z) + a1[0], bfhi(xx.z) + a1[1]); o.w = pk_bf16(bflo(xx.w) + a1[2], bfhi(xx.w) + a1[3]);
                    *(u32x4*)(xp0 + (size_t)(ai * 128 + m * 16) * 1024 + bj * 128) = o;
                }
        }
    }
};
__device__ __forceinline__ void phase_mix(CKP& p, int l, unsigned char* lds) {
    G8Plain S{(const char*)(p.ws + OFF_M), (const char*)(p.ws + OFF_W + W_M), 2048u, 16, NTOK / 256, 4};
    EpiMix E{(bf16_t*)(p.ws + OFF_X)};
    g8_phase(S, E);
}

__device__ __forceinline__ void phase_router(CKP& p, int l, unsigned char* lds, unsigned* ctl) {
    const int tid = opaque_tid(), lane = tid & 63, w = tid >> 6, wm = w >> 1, wn = w & 1, fr = lane & 15, fq = lane >> 4;
    int t512 = threadIdx.x; asm volatile("" : "+v"(t512));
    const int half = t512 >> 8, w8 = t512 >> 6;
    const float* gam = p.in[27] + (size_t)l * 1024;
    const float* bg = p.in[29] + (size_t)l * 4;
    const float* be = p.in[31] + (size_t)l * 32;
    const bf16_t* xres = (const bf16_t*)(p.ws + OFF_X);
    bf16_t* h2 = (bf16_t*)(p.ws + OFF_M);
    bf16_t* hlo = (bf16_t*)(p.ws + OFF_H);
    const bf16_t* Wh = (const bf16_t*)(p.ws + OFF_W + W_RH);
    const bf16_t* Wl = (const bf16_t*)(p.ws + OFF_W + W_RL);
    unsigned* cnt = ctl + CTL_MOECNT + l * 32;
    int* list = (int*)(p.ws + OFF_MOE + MOE_LIST);
    float* wsl = (float*)(p.ws + OFF_MOE + MOE_WS);
    unsigned char* lds0 = lds_base();
    float* lg = (float*)lds0;
    float* xch = (float*)(lds0 + VB_LDS);
    int* lc = (int*)(lds0 + 18432); int* gbs = (int*)(lds0 + 18432 + 128);
    for (int tile = blockIdx.x; tile < NTOK / 128; tile += gridDim.x) {
        const int r0 = tile * 128;
        {
            f32x4 gv[4];
#pragma unroll
            for (int i = 0; i < 4; ++i) gv[i] = *(const f32x4*)(gam + 4 * lane + 256 * i);
            for (int rr = 0; rr < 16; rr += 2) {
                const int row = r0 + w8 * 16 + rr;
                f32x4 xa[4], xb[4]; float sa = 0.f, sb = 0.f;
#pragma unroll
                for (int i = 0; i < 4; ++i) { const u32x2 ua = *(const u32x2*)(xres + (size_t)row * 1024 + 4 * lane + 256 * i), ub = *(const u32x2*)(xres + (size_t)(row + 1) * 1024 + 4 * lane + 256 * i);
                                              xa[i] = (f32x4){bflo(ua.x), bfhi(ua.x), bflo(ua.y), bfhi(ua.y)}; xb[i] = (f32x4){bflo(ub.x), bfhi(ub.x), bflo(ub.y), bfhi(ub.y)}; }
#pragma unroll
                for (int i = 0; i < 4; ++i) { sa += xa[i][0] * xa[i][0] + xa[i][1] * xa[i][1] + xa[i][2] * xa[i][2] + xa[i][3] * xa[i][3]; sb += xb[i][0] * xb[i][0] + xb[i][1] * xb[i][1] + xb[i][2] * xb[i][2] + xb[i][3] * xb[i][3]; }
                sa = wave_sum(sa); sb = wave_sum(sb);
                const float ra_ = rsqrtf(sa * (1.f / 1024.f) + RMS_EPS), rb_ = rsqrtf(sb * (1.f / 1024.f) + RMS_EPS);
#pragma unroll
                for (int i = 0; i < 4; ++i) {
                    const f32x4 ha = xa[i] * ra_ * gv[i], hb = xb[i] * rb_ * gv[i];
                    u32x2 oa, ob, la, lb;
                    oa.x = pk_bf16(ha[0], ha[1]); oa.y = pk_bf16(ha[2], ha[3]); ob.x = pk_bf16(hb[0], hb[1]); ob.y = pk_bf16(hb[2], hb[3]);
                    la.x = pk_bf16(ha[0] - bflo(oa.x), ha[1] - bfhi(oa.x)); la.y = pk_bf16(ha[2] - bflo(oa.y), ha[3] - bfhi(oa.y));
                    lb.x = pk_bf16(hb[0] - bflo(ob.x), hb[1] - bfhi(ob.x)); lb.y = pk_bf16(hb[2] - bflo(ob.y), hb[3] - bfhi(ob.y));
                    *(u32x2*)(h2 + (size_t)row * 1024 + 4 * lane + 256 * i) = oa; *(u32x2*)(h2 + (size_t)(row + 1) * 1024 + 4 * lane + 256 * i) = ob;
                    *(u32x2*)(hlo + (size_t)row * 1024 + 4 * lane + 256 * i) = la; *(u32x2*)(hlo + (size_t)(row + 1) * 1024 + 4 * lane + 256 * i) = lb;
                }
            }
        }
        asm volatile("s_waitcnt vmcnt(0)" ::: "memory");
        __syncthreads();
        f32x4 acc[4][4]; zero_acc(acc);
        {
            const bf16_t* A1 = half ? hlo : h2;
            gemm_kloop(acc, [&](int r) { return A1 + (size_t)(r0 + r) * 1024; }, 64, [&](int v) { return Wh + (size_t)(v < 63 ? v : 63) * 1024; }, 64, 16, lds, tid);
            const int ko = half * 512;
            gemm_kloop(acc, [&](int r) { return h2 + (size_t)(r0 + r) * 1024 + ko; }, 64, [&](int v) { return Wl + (size_t)(v < 63 ? v : 63) * 1024 + ko; }, 64, 8, lds, tid);
        }
        __syncthreads();
        int lbase = (64 * wm + fr) * 36 + 16 * fq; asm volatile("" : "+v"(lbase));
        if (half == 1 && wn == 0 && fq < 3) {
#pragma unroll
            for (int mi = 0; mi < 4; ++mi)
#pragma unroll
                for (int e = 0; e < 16; ++e) if (e < 4 || fq < 2) xch[lbase + mi * 576 + e] = acc[mi][e >> 2][e & 3];
        }
        __syncthreads();
        if (half == 0 && tid < 32) lc[tid] = 0;
        if (half == 0 && wn == 0 && fq < 3) {
#pragma unroll
            for (int mi = 0; mi < 4; ++mi)
#pragma unroll
                for (int e = 0; e < 16; ++e) if (e < 4 || fq < 2) lg[lbase + mi * 576 + e] = acc[mi][e >> 2][e & 3] + xch[lbase + mi * 576 + e];
        }
        __syncthreads();
        int e0 = 0, e1 = 0, lr0 = 0, lr1 = 0; float c0 = 0.f, c1 = 0.f;
        if (half == 0 && tid < 128) {
            const float* lrow = lg + tid * 36;
            float gl[4]; int grp = 0; float gm = -3.4e38f;
#pragma unroll
            for (int q = 0; q < 4; ++q) { gl[q] = lrow[q] + bg[q]; if (gl[q] > gm) { gm = gl[q]; grp = q; } }
            float gsum = 0.f;
#pragma unroll
            for (int q = 0; q < 4; ++q) gsum += expf(gl[q] - gm);
            const float grp_w = 1.f / gsum;
            float el[8]; float em = -3.4e38f;
#pragma unroll
            for (int q = 0; q < 8; ++q) { el[q] = lrow[4 + grp * 8 + q] + be[grp * 8 + q]; em = fmaxf(em, el[q]); }
            float esum = 0.f; float ep[8];
#pragma unroll
            for (int q = 0; q < 8; ++q) { ep[q] = expf(el[q] - em); esum += ep[q]; }
            int j0 = 0; float p0 = -1.f;
#pragma unroll
            for (int q = 0; q < 8; ++q) { const float pq = ep[q] / esum; ep[q] = pq; if (pq > p0) { p0 = pq; j0 = q; } }
            int j1 = 0; float p1 = -1.f;
#pragma unroll
            for (int q = 0; q < 8; ++q) { if (q != j0 && ep[q] > p1) { p1 = ep[q]; j1 = q; } }
            const float den = p0 + p1;
            c0 = grp_w * p0 / den; c1 = grp_w * p1 / den;
            e0 = grp * 8 + j0; e1 = grp * 8 + j1;
            lr0 = atomicAdd(&lc[e0], 1); lr1 = atomicAdd(&lc[e1], 1);
        }
        __syncthreads();
        if (half == 0 && tid < 32) { const int n = lc[tid]; gbs[tid] = n ? (int)atomicAdd(&cnt[tid], (unsigned)n) : 0; }
        __syncthreads();
        if (half == 0 && tid < 128) {
            const int tok = r0 + tid;
            list[e0 * 32768 + gbs[e0] + lr0] = tok * 2; list[e1 * 32768 + gbs[e1] + lr1] = tok * 2 + 1;
            wsl[tok * 2] = c0; wsl[tok * 2 + 1] = c1;
        }
        __syncthreads();
    }
}

__device__ __forceinline__ bool moe_unit(const unsigned* cnt, int i, int& e, int& mt, int& sub, int& rowbase, int& n) {
    int lane = threadIdx.x & 63; asm volatile("" : "+v"(lane));
    const int c = (lane < 32) ? (int)cnt[lane] : 0;
    const int nt = (c + 255) >> 8, nt128 = (c + 127) >> 7;
    int pre = nt, pre128 = nt128;
#pragma unroll
    for (int o = 1; o < 32; o <<= 1) {
        const int src = (lane - o) << 2;
        const int v = __builtin_amdgcn_ds_bpermute(src, pre), v2 = __builtin_amdgcn_ds_bpermute(src, pre128);
        if (lane >= o) { pre += v; pre128 += v2; }
    }
    const int total = __builtin_amdgcn_readlane(pre, 31) * 4;
    const int Lp = i * (int)gridDim.x + (int)blockIdx.x, q = (total + 7) >> 3, off = Lp >> 3;
    const int L = (Lp & 7) * q + off;
    if (off >= q || L >= total) return false;
    const int excl = pre - nt;
    const bool mine = (lane < 32) && (L >= excl * 4) && (L < pre * 4);
    const unsigned long long bal = __ballot(mine);
    if (bal == 0ull) return false;
    const int ee = __builtin_amdgcn_readfirstlane(__ffsll((long long)bal) - 1);
    e = ee;
    n = __builtin_amdgcn_readlane(c, ee);
    rowbase = __builtin_amdgcn_readlane(pre128 - nt128, ee) * 128;
    const int r = L - __builtin_amdgcn_readlane(excl, ee) * 4;
    mt = r >> 2; sub = r & 3;
    return true;
}
struct G8Exp1 {
    static constexpr bool GATHER = true;
    const unsigned* cnt; const int* list; const char* h2; const char* Wg; const char* Wu;
    __device__ __forceinline__ bool next(int i, G8Unit& u, const int (&R)[2], const unsigned (&C2)[2]) const {
        int e, mt, sub, rowbase, n;
        if (!moe_unit(cnt, i, e, mt, sub, rowbase, n)) return false;
        u.A0 = h2; u.A1 = h2; u.K2 = 2048u; u.nt = 16;
        u.B0 = Wg + ((size_t)e * 512 + sub * 128) * 2048; u.B1 = Wu + ((size_t)e * 512 + sub * 128) * 2048;
        u.x0 = e; u.x1 = mt; u.x2 = sub; u.x3 = rowbase; u.n = n;
#pragma unroll
        for (int h = 0; h < 2; ++h)
#pragma unroll
            for (int k = 0; k < 2; ++k) { int sidx = mt * 256 + h * 128 + R[k]; sidx = sidx < n ? sidx : n - 1; u.ao[h][k] = (unsigned)(list[e * 32768 + sidx] >> 1) * 2048u + C2[k]; }
        return true;
    }
};
struct EpiExp1 {
    bf16_t* hid;
    __device__ __forceinline__ void operator()(const G8Acc& acc, const G8Unit& u, int wr, int wc, int fr, int fq) const {
#pragma unroll
        for (int ai = 0; ai < 2; ++ai)
#pragma unroll
            for (int m = 0; m < 4; ++m) {
                const int r = u.x1 * 256 + ai * 128 + wr * 64 + m * 16 + fr;
                if (r < u.n) {
                    float hv[8];
#pragma unroll
                    for (int j = 0; j < 8; ++j) { const float g = acc[ai][0][m][j >> 2][j & 3], up = acc[ai][1][m][j >> 2][j & 3]; hv[j] = g * sigm(g) * up; }
                    u32x4 o; o.x = pk_bf16(hv[0], hv[1]); o.y = pk_bf16(hv[2], hv[3]); o.z = pk_bf16(hv[4], hv[5]); o.w = pk_bf16(hv[6], hv[7]);
                    *(u32x4*)(hid + (size_t)(u.x3 + r) * 512 + u.x2 * 128 + wc * 32 + 8 * fq) = o;
                }
            }
    }
};
__device__ __forceinline__ void phase_exp1(CKP& p, int l, unsigned char* lds, unsigned* ctl) {
    G8Exp1 S{ctl + CTL_MOECNT + l * 32, (const int*)(p.ws + OFF_MOE + MOE_LIST), (const char*)(p.ws + OFF_M), (const char*)(p.ws + OFF_W + W_EG), (const char*)(p.ws + OFF_W + W_EU)};
    EpiExp1 E{(bf16_t*)(p.ws + OFF_HID)};
    g8_phase(S, E);
}
struct G8Exp2 {
    static constexpr bool GATHER = true;
    const unsigned* cnt; const char* hid; const char* Wd;
    __device__ __forceinline__ bool next(int i, G8Unit& u, const int (&R)[2], const unsigned (&C2)[2]) const {
        int e, mt, sub, rowbase, n;
        if (!moe_unit(cnt, i, e, mt, sub, rowbase, n)) return false;
        u.A0 = hid + (size_t)(rowbase + mt * 256) * 1024; u.A1 = u.A0; u.K2 = 1024u; u.nt = 8;
        u.B0 = Wd + ((size_t)e * 1024 + sub * 256) * 1024; u.B1 = u.B0 + (size_t)128 * 1024;
        u.x0 = e; u.x1 = mt; u.x2 = sub; u.x3 = rowbase; u.n = n;
        const int lim = n - mt * 256 - 1;
#pragma unroll
        for (int h = 0; h < 2; ++h)
#pragma unroll
            for (int k = 0; k < 2; ++k) { const int rr = h * 128 + R[k]; u.ao[h][k] = (unsigned)(rr < lim ? rr : lim) * 1024u + C2[k]; }
        return true;
    }
};
struct EpiExp2 {
    const int* list; const float* wsl; bf16_t* ys;
    __device__ __forceinline__ void operator()(const G8Acc& acc, const G8Unit& u, int wr, int wc, int fr, int fq) const {
        int slot[2][4]; float wt[2][4];
#pragma unroll
        for (int ai = 0; ai < 2; ++ai)
#pragma unroll
            for (int m = 0; m < 4; ++m) { int r = u.x1 * 256 + ai * 128 + wr * 64 + m * 16 + fr; r = r < u.n ? r : u.n - 1; slot[ai][m] = list[u.x0 * 32768 + r]; }
#pragma unroll
        for (int ai = 0; ai < 2; ++ai)
#pragma unroll
            for (int m = 0; m < 4; ++m) wt[ai][m] = wsl[slot[ai][m]];
#pragma unroll
        for (int ai = 0; ai < 2; ++ai)
#pragma unroll
            for (int m = 0; m < 4; ++m) {
                const int r = u.x1 * 256 + ai * 128 + wr * 64 + m * 16 + fr;
                if (r < u.n) {
                    bf16_t* dst = ys + (size_t)slot[ai][m] * 1024 + u.x2 * 256 + wc * 32 + 8 * fq;
                    const float w = wt[ai][m];
#pragma unroll
                    for (int bj = 0; bj < 2; ++bj) {
                        const f32x4 v0 = acc[ai][bj][m][0] * w, v1 = acc[ai][bj][m][1] * w;
                        u32x4 o; o.x = pk_bf16(v0[0], v0[1]); o.y = pk_bf16(v0[2], v0[3]); o.z = pk_bf16(v1[0], v1[1]); o.w = pk_bf16(v1[2], v1[3]);
                        *(u32x4*)(dst + bj * 128) = o;
                    }
                }
            }
    }
};
__device__ __forceinline__ void phase_exp2(CKP& p, int l, unsigned char* lds, unsigned* ctl) {
    G8Exp2 S{ctl + CTL_MOECNT + l * 32, (const char*)(p.ws + OFF_HID), (const char*)(p.ws + OFF_W + W_ED)};
    EpiExp2 E{(const int*)(p.ws + OFF_MOE + MOE_LIST), (const float*)(p.ws + OFF_MOE + MOE_WS), (bf16_t*)(p.ws + OFF_YS)};
    g8_phase(S, E);
}

constexpr int PH_PER_LAYER = 10;
constexpr int NPHASE = PH_PER_LAYER * DEPTH + 1;

__global__ __attribute__((target("no-packed-fp32-ops"))) void __launch_bounds__(NTHR_HW, 1) mega(KP p_unused) {
    extern __shared__ __attribute__((aligned(16))) unsigned char lds_all[];
    if ((threadIdx.x & 255) == 0) *(volatile unsigned*)(lds_all + VB_CTR + ((threadIdx.x >> 8) << 6)) = 0u;
    __syncthreads();
    unsigned* ctl = (unsigned*)(p_unused.ws + OFF_CTL);
#if ONE_LAUNCH
    XcdBarrier xb = xcd_barrier_post(ctl + CTL_BAR, (volatile LAS unsigned*)(lds_all + VB_CTR + 128));
    if (p_unused.never) cg::this_grid().sync();
#if DBG_PREFLUSH
    __builtin_amdgcn_fence(__ATOMIC_RELEASE, "");
    asm volatile("s_waitcnt vmcnt(0)" ::: "memory");
    __builtin_amdgcn_fence(__ATOMIC_ACQUIRE, "");
    asm volatile("s_waitcnt vmcnt(0)" ::: "memory");
    xcd_barrier(xb);
    { const unsigned long long t0 = __builtin_amdgcn_s_memrealtime(); while (__builtin_amdgcn_s_memrealtime() - t0 < 20000ull) __builtin_amdgcn_s_sleep(8); }
    xcd_barrier(xb);
#endif
#endif
    CKP* kp0 = (CKP*)__builtin_amdgcn_kernarg_segment_ptr();
    const int ph_lo = kp0->ph_lo, ph_hi = kp0->ph_hi;
#if ONE_LAUNCH
#define PH_SYNC(PH) if ((PH) + 1 < ph_hi) xcd_barrier(xb);
#else
#define PH_SYNC(PH)
#endif
#if DBG_TIMEPH >= 0
#define PH_STAMP(PH) if (blockIdx.x == 0 && threadIdx.x == 0) ((unsigned long long*)(kp0->ws + OFF_CTL + 24576))[(PH)] = __builtin_amdgcn_s_memrealtime();
#else
#define PH_STAMP(PH)
#endif
#define RUN_PHASE(PH, CALL) if (ph_lo <= (PH) && (PH) < ph_hi) { PH_STAMP(PH) CKP* kp = kp0; asm volatile("" : "+s"(kp)); CKP& p = *kp; const int rep_ = 0; (void)rep_; unsigned char* lds = vb_lds(); CALL; \
    if ((PH) == DBG_REPEAT_PH) { xcd_barrier(xb); const int rep_ = 1; (void)rep_; CALL; } PH_SYNC(PH) }
#define RUN_LAYER(L) \
    RUN_PHASE((L) * 10 + 0, phase_prep(p, (L), lds)) \
    RUN_PHASE((L) * 10 + 1, phase_inproj(p, (L), lds)) \
    RUN_PHASE((L) * 10 + 2, phase_mid1(p, (L), lds)) \
    RUN_PHASE((L) * 10 + 3, phase_attn(p, (L), lds, ctl + 2 * rep_)) \
    RUN_PHASE((L) * 10 + 4, phase_glu(p, (L), lds)) \
    RUN_PHASE((L) * 10 + 5, phase_branch(p, (L), lds)) \
    RUN_PHASE((L) * 10 + 6, phase_mix(p, (L), lds)) \
    RUN_PHASE((L) * 10 + 7, phase_router(p, (L), lds, ctl)) \
    RUN_PHASE((L) * 10 + 8, phase_exp1(p, (L), lds, ctl)) \
    RUN_PHASE((L) * 10 + 9, phase_exp2(p, (L), lds, ctl))
#if DBG_SMALLK
    RUN_PHASE(0, phase_prep(p, 0, lds))
    RUN_PHASE(1, phase_inproj(p, 0, lds))
    RUN_PHASE(2, phase_mid1(p, 0, lds))
#else
    RUN_LAYER(0)
    RUN_LAYER(1)
    RUN_PHASE(20, phase_prep(p, 2, lds))
#endif
#if ONE_LAUNCH && DBG_DUMP
    {
        xcd_barrier(xb);
        CKP* kp = kp0; asm volatile("" : "+s"(kp)); CKP& p = *kp;
        const size_t NO = (size_t)NTOK * 1024;
        const unsigned char* src = p.ws + DBG_DUMP_OFF;
        for (size_t i = (size_t)blockIdx.x * NTHR_HW + threadIdx.x; i < NO; i += (size_t)gridDim.x * NTHR_HW) {
            float v = 0.f;
            if (i < (size_t)DBG_DUMP_N) {
                if (DBG_DUMP_F32) {
                    const size_t si = DBG_DUMP_REV ? ((size_t)DBG_DUMP_N - 1 - i) : i;
#if DBG_SC1READ
                    const unsigned fu = __hip_atomic_load((const unsigned*)src + si, __ATOMIC_RELAXED, __HIP_MEMORY_SCOPE_SYSTEM); const float f = __uint_as_float(fu);
#else
                    const float f = ((const float*)src)[si];
#endif
                    v = DBG_HASH ? (float)(__float_as_uint(f) & 0x3ff) : f;
#if DBG_EFILT
                    { const int id_ = (int)(((si >> 7) - DBG_IDROT) & 2047), blk = ((id_ >> 2) + 320) & 511; if (!(blk >= DBG_EFILT_LO && blk < DBG_EFILT_HI)) v = 0.f; }
#endif
#if DBG_E2
                    { const float f2 = ((const float*)(p.ws + OFF_C + C_ATT))[i]; v = (__float_as_uint(f2) == __float_as_uint(f)) ? 0.f : 1000.f; if (i == 0) v += 1.f; }
#endif
                }
                else { const bf16_t h = ((const bf16_t*)src)[i]; v = DBG_HASH ? (float)(h & 0x3ff) : bf2f(h); }
            }
#if DBG_CONSTOUT
            v = 1000.f + (float)(i & 1023);
#endif
            p.xbuf[i] = v;
        }
    }
#endif
}

#if DBG_DUMP
__global__ void dbg_dump(const bf16_t* src, size_t n, float* out, size_t nout) {
    for (size_t i = (size_t)blockIdx.x * blockDim.x + threadIdx.x; i < nout; i += (size_t)gridDim.x * blockDim.x)
        out[i] = i < n ? (DBG_HASH ? (float)(src[i] & 0x3ff) : bf2f(src[i])) : 0.f;
}
__global__ void dbg_dump_f32(const float* src, size_t n, float* out, size_t nout) {
    for (size_t i = (size_t)blockIdx.x * blockDim.x + threadIdx.x; i < nout; i += (size_t)gridDim.x * blockDim.x)
        out[i] = i < n ? (DBG_HASH ? (float)(__float_as_uint(src[i]) & 0x3ff) : src[i]) : 0.f;
}
#endif
extern "C" void kernel_launch(void* const* d_in, const int* in_sizes, int n_in, void* d_out, int out_size, void* d_ws, size_t ws_size, hipStream_t stream) {
    static int grid = 0;
    if (grid == 0) {
        if (n_in != 36 || out_size != NTOK * DM || ws_size < WS_END) { fprintf(stderr, "kernel_launch: unexpected shapes n_in %d out %d ws %zu (need %zu)\n", n_in, out_size, ws_size, (size_t)WS_END); grid = -1; return; }
        int dev = 0, cus = 0, per_cu = 0;
        hipGetDevice(&dev);
        hipDeviceGetAttribute(&cus, hipDeviceAttributeMultiprocessorCount, dev);
        hipFuncSetAttribute((const void*)mega, hipFuncAttributeMaxDynamicSharedMemorySize, LDS_BYTES);
        hipOccupancyMaxActiveBlocksPerMultiprocessor(&per_cu, (const void*)mega, NTHR_HW, LDS_BYTES);
        if (per_cu < 1) { fprintf(stderr, "kernel_launch: occupancy query says %d\n", per_cu); per_cu = 1; }
        if (per_cu > MAX_PER_CU) per_cu = MAX_PER_CU;
        grid = cus * per_cu;
        fprintf(stderr, "kernel_launch: grid %d (%d CUs x %d)\n", grid, cus, per_cu);
    }
    if (grid < 0) return;
    hipMemsetAsync((char*)d_ws + OFF_CTL, 0, CTL_BYTES, stream);
    KP p{};
    for (int i = 0; i < 36; ++i) p.in[i] = (const float*)d_in[i];
    p.xbuf = (float*)d_out; p.ws = (unsigned char*)d_ws;
    for (int i = 0; i < 8; ++i) p.inv_freq[i] = (float)pow(500000.0, -(double)i / 8.0);
    p.never = 0; p.pad = 0;
#if ONE_LAUNCH
    p.ph_lo = 0; p.ph_hi = DBG_PH_HI;
    void* args[] = {&p};
    hipError_t e = hipLaunchCooperativeKernel((const void*)mega, dim3(grid), dim3(NTHR_HW), args, LDS_BYTES, stream);
    if (e != hipSuccess) fprintf(stderr, "cooperative launch failed: %s (grid %d)\n", hipGetErrorString(e), grid);
#else
    for (int ph = 0; ph < NPHASE; ++ph) {
        if (!((DBG_MASK >> ph) & 1)) continue;
        p.ph_lo = ph; p.ph_hi = ph + 1;
        hipLaunchKernelGGL(mega, dim3(grid), dim3(NTHR_HW), LDS_BYTES, stream, p);
    }
#if DBG_DUMP
    {
        const unsigned char* w = (const unsigned char*)d_ws; const size_t NO = (size_t)NTOK * 1024;
        size_t off = 0, n = 0; bool f32 = false;
        switch (DBG_DUMP) {
            case 1: off = OFF_C + C_ATT; n = (size_t)NTOK * 512; break;
            case 2: off = OFF_C + C_SGU; n = (size_t)NTOK * 256; break;
            case 3: off = OFF_C + C_S5O; n = (size_t)NTOK * 256; break;
            case 4: off = OFF_M; n = (size_t)NTOK * 1024; break;
            case 5: off = OFF_R + R_Q; n = (size_t)NTOK * 512; break;
            case 6: off = OFF_H; n = (size_t)NTOK * 1024; break;
            case 7: off = OFF_C + C_YG; n = (size_t)NTOK * 256; break;
            case 8: off = OFF_C + C_KCMP; n = (size_t)2 * 524288 / 2; break;
            case 9: off = OFF_R + R_KC; n = (size_t)NTOK * 128 * 6; break;
            case 10: off = OFF_R + R_NG; n = (size_t)NTOK * 24; f32 = true; break;
            case 11: off = OFF_R + R_U; n = (size_t)NTOK * 768; break;
            case 12: off = OFF_C + C_S5E; n = (size_t)128 * 16 * 64 * 2; f32 = true; break;
            case 15: off = 0; n = (size_t)NTOK * 1024; f32 = true; break;
            case 16: off = OFF_W + W_S5A; n = 36864; f32 = true; break;
            case 13: off = OFF_YS; n = (size_t)NTOK * 1024; break;
            case 14: off = OFF_MOE + MOE_WS; n = 65536; f32 = true; break;
            default: break;
        }
        if (DBG_DUMP == 15) hipLaunchKernelGGL(dbg_dump_f32, dim3(2048), dim3(256), 0, stream, (const float*)d_out, n, (float*)d_out, NO);
        else if (f32) hipLaunchKernelGGL(dbg_dump_f32, dim3(2048), dim3(256), 0, stream, (const float*)(w + off), n, (float*)d_out, NO);
        else hipLaunchKernelGGL(dbg_dump, dim3(2048), dim3(256), 0, stream, (const bf16_t*)(w + off), n, (float*)d_out, NO);
    }
#endif
#endif
}
```

```cpp
#include <hip/hip_runtime.h>
#include <hip/hip_cooperative_groups.h>
#include <cstdio>
#include <cstdint>
#include <cmath>
#include <type_traits>
namespace cg = cooperative_groups;

#ifndef ONE_LAUNCH
#define ONE_LAUNCH 1
#endif
#ifndef DBG_MASK
#define DBG_MASK 0x1fffff
#endif
#ifndef DBG_NOCOMBINE
#define DBG_NOCOMBINE 0
#endif
#ifndef DBG_DUMP
#define DBG_DUMP 0
#endif
#ifndef DBG_HASH
#define DBG_HASH 0
#endif
#ifndef DBG_ONLYS5
#define DBG_ONLYS5 0
#endif
#ifndef DBG_NOCSTORE
#define DBG_NOCSTORE 0
#endif
#ifndef DBG_LDSCHK
#define DBG_LDSCHK 0
#endif
#ifndef DBG_TWICE
#define DBG_TWICE 0
#endif
#ifndef DBG_S5CONST
#define DBG_S5CONST 0
#endif
#ifndef DBG_SC1READ
#define DBG_SC1READ 0
#endif
#ifndef DBG_E2
#define DBG_E2 0
#endif
#ifndef DBG_JOBFENCE
#define DBG_JOBFENCE 0
#endif
#ifndef DBG_CONSTOUT
#define DBG_CONSTOUT 0
#endif
#ifndef DBG_QDELAY
#define DBG_QDELAY 0
#endif
#ifndef DBG_SMALLK
#define DBG_SMALLK 0
#endif
#ifndef DBG_REPEAT_PH
#define DBG_REPEAT_PH -1
#endif
#ifndef DBG_TIMEPH
#define DBG_TIMEPH -1
#endif
#ifndef DBG_TIMEPH2
#define DBG_TIMEPH2 (DBG_TIMEPH + 1)
#endif
#ifndef DBG_PRESPIN
#define DBG_PRESPIN 0
#endif
#ifndef DBG_SGUSPIN
#define DBG_SGUSPIN 0
#endif
#ifndef DBG_PREFLUSH
#define DBG_PREFLUSH 0
#endif
#ifndef DBG_ESC1
#define DBG_ESC1 0
#endif
#ifndef DBG_DELAY
#define DBG_DELAY 0
#endif
#ifndef DBG_IDROT
#define DBG_IDROT 0
#endif
#ifndef DBG_DUMP_REV
#define DBG_DUMP_REV 0
#endif
#ifndef DBG_SGUCUT
#define DBG_SGUCUT 0
#endif
#ifndef DBG_EFILT
#define DBG_EFILT 0
#define DBG_EFILT_LO 0
#define DBG_EFILT_HI 0
#endif
#ifndef DBG_DUMP_OFF
#define DBG_DUMP_OFF 0
#define DBG_DUMP_N 0
#define DBG_DUMP_F32 0
#endif
#ifndef DBG_PH_HI
#define DBG_PH_HI NPHASE
#endif

typedef unsigned short bf16_t;
typedef short bf16x8 __attribute__((ext_vector_type(8)));
typedef float f32x4 __attribute__((ext_vector_type(4)));
typedef unsigned u32x4 __attribute__((ext_vector_type(4)));
typedef unsigned u32x2 __attribute__((ext_vector_type(2)));

constexpr int DM = 1024, NB = 8, SEQ = 4096, NTOK = NB * SEQ, DEPTH = 2;
constexpr int NCMP = 255;
constexpr float RMS_EPS = 1e-6f;
constexpr int NTHR = 256;
constexpr int NTHR_HW = 512;
constexpr int VB_LDS = 68096;
constexpr int LDS_BAR = 67584;
#ifndef MAX_PER_CU
#define MAX_PER_CU 1
#endif
#ifndef LDS_TOTAL
#define LDS_TOTAL (2 * 68096 + 256)
#endif
constexpr int LDS_BYTES = LDS_TOTAL;

constexpr size_t OFF_CTL = 0;
constexpr size_t OFF_W = 65536;
constexpr size_t W_IN = 0, W_GB = 4456448, W_A = 10747904, W_S = 11796480, W_5 = 12320768, W_M = 12845056, W_GLU = 14942208,
                 W_C1 = 15073280, W_C2 = 16121856, W_PB = 16154624, W_SGU = 16155648, W_S5A = 16286720, W_S5A256 = 16294912,
                 W_S5B = 16303104, W_S5C = 16434176, W_RH = 16499712, W_RL = 16630784, W_EG = 16777216, W_EU = 50331648, W_ED = 83886080, W_END = 117440512;
constexpr size_t OFF_H = OFF_W + W_END;
constexpr size_t OFF_M = OFF_H + 67108864;
constexpr size_t OFF_R = OFF_M + 67108864;
constexpr size_t R_Q = 0, R_KC = 33554432, R_VC = 41943040, R_KS = 50331648, R_KW = 58720256, R_VST = 67108864, R_VWT = 75497472,
                 R_NG = 83886080, R_U = 87031808, R_V = 103809024, R_S5IN = 120586240, R_QR = 137363456, R_END = 170917888;
constexpr size_t OFF_C = OFF_R + R_END;
constexpr size_t C_ATT = 0, C_SGU = 33554432, C_YG = 50331648, C_S5O = 67108864, C_KCMP = 83886080, C_VCT = 84410368, C_S5E = 84934656, C_END = 85983232;
constexpr size_t OFF_MOE = OFF_C + C_END;
constexpr size_t MOE_LIST = 0, MOE_WS = 4194304, MOE_END = 4456448;
constexpr size_t OFF_ROPE = OFF_MOE + MOE_END;
constexpr size_t OFF_X = OFF_ROPE + (size_t)NTOK * 64;
constexpr size_t WS_END = OFF_X + (size_t)NTOK * 2048;
constexpr size_t OFF_HID = OFF_R;
constexpr size_t OFF_YS = OFF_R + 71303168;
static_assert(OFF_YS + 134217728 <= OFF_C + C_KCMP, "alias overflow");

constexpr int CTL_BAR = 0;
constexpr int CTL_MOECNT = 4096;
constexpr int CTL_ATTN = 4096 + 64;
constexpr int CTL_BYTES = 32768;

struct KP {
    const float* in[36];
    float* xbuf;
    unsigned char* ws;
    float inv_freq[8];
    int ph_lo, ph_hi;
    int never;
    int pad;
};

typedef const KP __attribute__((address_space(4))) CKP;

typedef float f32x2_t __attribute__((ext_vector_type(2)));
typedef __bf16 bf16x2_t __attribute__((ext_vector_type(2)));
__device__ __forceinline__ unsigned pk_bf16(float lo, float hi) {
    const f32x2_t v = {lo, hi};
    union { bf16x2_t b; unsigned u; } x; x.b = __builtin_convertvector(v, bf16x2_t); return x.u;
}
__device__ __forceinline__ bf16_t f2bf(float f) { return (bf16_t)(pk_bf16(f, 0.f) & 0xffffu); }
__device__ __forceinline__ float bf2f(bf16_t b) { return __uint_as_float(((unsigned)b) << 16); }
__device__ __forceinline__ float bflo(unsigned u) { return __uint_as_float(u << 16); }
__device__ __forceinline__ float bfhi(unsigned u) { return __uint_as_float(u & 0xffff0000u); }
__device__ __forceinline__ float fexp2(float x) { return __builtin_amdgcn_exp2f(x); }
__device__ __forceinline__ float gelu_tanh(float x) {
    const float u = 0.7978845608028654f * (x + 0.044715f * x * x * x);
    const float e = fexp2(2.885390081777927f * u);
    const float t = 1.f - 2.f * __builtin_amdgcn_rcpf(e + 1.f);
    return 0.5f * x * (1.f + t);
}
__device__ __forceinline__ float sigm(float x) { return __builtin_amdgcn_rcpf(1.f + fexp2(-1.4426950408889634f * x)); }
__device__ __forceinline__ unsigned char* lds_base();
__device__ __forceinline__ int lane_id() { unsigned z = 0u; asm volatile("" : "+v"(z)); return (int)__builtin_amdgcn_mbcnt_hi(~0u, __builtin_amdgcn_mbcnt_lo(~0u, z)); }
__device__ __forceinline__ int hw_wave_key() { return (int)(__builtin_amdgcn_s_getreg((5 << 11) | 4) & 63u); }
__device__ __forceinline__ int TIDX();
__device__ __forceinline__ unsigned bperm_u(int srclane, unsigned v) { return (unsigned)__builtin_amdgcn_ds_bpermute(srclane << 2, (int)v); }
__device__ __forceinline__ float bperm_f(int srclane, float v) { return __uint_as_float(bperm_u(srclane, __float_as_uint(v))); }
__device__ __forceinline__ int opaque_tid() { int t = TIDX() & 255; asm volatile("" : "+v"(t)); return t; }
__device__ __forceinline__ int VBID() { return (int)blockIdx.x * 2 + (TIDX() >> 8); }
__device__ __forceinline__ int VGRID() { return (int)gridDim.x * 2; }
constexpr int VB_CTR = 2 * 68096;
__device__ __forceinline__ unsigned char* lds_base() { extern __shared__ __attribute__((aligned(16))) unsigned char lds_all_[]; return lds_all_; }
__device__ __forceinline__ int TIDX() { const int wv = __builtin_amdgcn_readfirstlane((int)*(volatile unsigned char*)(lds_base() + VB_CTR + 192 + hw_wave_key())); return wv * 64 + lane_id(); }
__device__ __forceinline__ unsigned char* vb_lds() { int t = TIDX(); asm volatile("" : "+v"(t)); return lds_base() + (t >> 8) * VB_LDS; }
__device__ __forceinline__ void vb_sync(unsigned char* lds) {
    asm volatile("s_waitcnt lgkmcnt(0)" ::: "memory");
    if (lane_id() == 0) {
        __attribute__((address_space(3))) unsigned* c = (__attribute__((address_space(3))) unsigned*)(lds_base() + VB_CTR + ((lds != lds_base()) ? 64 : 0));
        const unsigned old = __hip_atomic_fetch_add(c, 1u, __ATOMIC_RELAXED, __HIP_MEMORY_SCOPE_WORKGROUP);
        const unsigned target = (old & ~3u) + 4u;
        while ((int)(__hip_atomic_load(c, __ATOMIC_RELAXED, __HIP_MEMORY_SCOPE_WORKGROUP) - target) < 0) { }
    }
    asm volatile("" ::: "memory");
}
__device__ __forceinline__ void job_fence() {
#if DBG_JOBFENCE
#endif
}
__device__ __forceinline__ float wave_sum(float v) {
#pragma unroll
    for (int o = 32; o >= 1; o >>= 1) v += __shfl_xor(v, o);
    return v;
}
__device__ __forceinline__ float xmax16(float x) { const unsigned u = __float_as_uint(x); auto r = __builtin_amdgcn_permlane16_swap(u, u, false, false); return fmaxf(__uint_as_float(r[0]), __uint_as_float(r[1])); }
__device__ __forceinline__ float xmax32(float x) { const unsigned u = __float_as_uint(x); auto r = __builtin_amdgcn_permlane32_swap(u, u, false, false); return fmaxf(__uint_as_float(r[0]), __uint_as_float(r[1])); }
__device__ __forceinline__ float xsum16(float x) { const unsigned u = __float_as_uint(x); auto r = __builtin_amdgcn_permlane16_swap(u, u, false, false); return __uint_as_float(r[0]) + __uint_as_float(r[1]); }
__device__ __forceinline__ float xsum32(float x) { const unsigned u = __float_as_uint(x); auto r = __builtin_amdgcn_permlane32_swap(u, u, false, false); return __uint_as_float(r[0]) + __uint_as_float(r[1]); }
__device__ __forceinline__ f32x4 mfma16(bf16x8 a, bf16x8 b, f32x4 c) { return __builtin_amdgcn_mfma_f32_16x16x32_bf16(a, b, c, 0, 0, 0); }
__device__ __forceinline__ bf16x8 as_bf8(u32x4 v) { union { u32x4 u; bf16x8 b; } x; x.u = v; return x.b; }
__device__ __forceinline__ void store16bf(bf16_t* dst, const float (&v)[16]) {
    u32x4 a, b;
    a.x = pk_bf16(v[0], v[1]); a.y = pk_bf16(v[2], v[3]); a.z = pk_bf16(v[4], v[5]); a.w = pk_bf16(v[6], v[7]);
    b.x = pk_bf16(v[8], v[9]); b.y = pk_bf16(v[10], v[11]); b.z = pk_bf16(v[12], v[13]); b.w = pk_bf16(v[14], v[15]);
    *(u32x4*)dst = a; *(u32x4*)(dst + 8) = b;
}

#ifndef XB_SCOPE
#define XB_SCOPE "agent"
#endif
#define XB_TMO      128
#define XB_XCNT(j)  (256  + 64 * (j))
#define XB_XSUB(j)  (1280 + 64 * (j))
#define XB_XGEN(j)  (2304 + 64 * (j))
#define XB_TOP      3328
#define XB_TOPGEN   3392
#define XCD_BAR_WORDS 3456
#define XB_SPIN_CAP (1u << 22)
#define LAS __attribute__((address_space(3)))
__device__ __forceinline__ unsigned xb_ld(unsigned* p)              { return __hip_atomic_load(p, __ATOMIC_RELAXED, __HIP_MEMORY_SCOPE_AGENT); }
__device__ __forceinline__ unsigned xb_add(unsigned* p, unsigned v) { return __hip_atomic_fetch_add(p, v, __ATOMIC_RELAXED, __HIP_MEMORY_SCOPE_AGENT); }
__device__ __forceinline__ unsigned xb_xcc_id() { return (unsigned)__builtin_amdgcn_s_getreg((3 << 11) | 20) & 0xFu; }
#define XB_SPIN(cond, bar) do { unsigned _sp = 0; while (cond) { __builtin_amdgcn_s_sleep(1); \
    if ((++_sp & 255u) == 0u) { if (xb_ld(&(bar)[XB_TMO])) break; if (_sp > XB_SPIN_CAP) { atomicAdd(&(bar)[XB_TMO], 1u); break; } } } } while (0)
struct XcdBarrier { unsigned* bar; unsigned x; volatile LAS unsigned* st; };
__device__ __forceinline__ XcdBarrier xcd_barrier_post(unsigned* bar, volatile LAS unsigned* st) {
    XcdBarrier b; b.bar = bar; b.x = xb_xcc_id(); b.st = st;
    if (TIDX() == 0) { st[0] = 0u; st[1] = 0u; (void)xb_add(&bar[XB_XCNT(b.x)], 1u); }
    return b;
}
__device__ __forceinline__ void xcd_barrier_complete(unsigned* bar, unsigned x, unsigned& nloc, unsigned& nx) {
    const unsigned G = gridDim.x * gridDim.y * gridDim.z;
    unsigned sum, cnt, mine, sp = 0u;
    for (;;) {
        sum = 0u; cnt = 0u; mine = 0u;
#pragma unroll
        for (unsigned j = 0; j < 16; ++j) { const unsigned c = xb_ld(&bar[XB_XCNT(j)]); sum += c; cnt += (c > 0u) ? 1u : 0u; mine = (j == x) ? c : mine; }
        if (sum == G) break;
        __builtin_amdgcn_s_sleep(1);
        if ((++sp & 255u) == 0u) { if (xb_ld(&bar[XB_TMO])) break; if (sp > XB_SPIN_CAP) { atomicAdd(&bar[XB_TMO], 1u); break; } }
    }
    nloc = mine > 0u ? mine : 1u; nx = cnt > 0u ? cnt : 1u;
}
__device__ __forceinline__ void xcd_barrier(XcdBarrier& b) {
    asm volatile("s_waitcnt vmcnt(0)" ::: "memory");
    __syncthreads();
    if (TIDX() == 0) {
        unsigned* bar = b.bar;
        __builtin_amdgcn_s_waitcnt(0);
        unsigned nloc = b.st[0], nx = b.st[1];
        if (nloc == 0u) { xcd_barrier_complete(bar, b.x, nloc, nx); b.st[0] = nloc; b.st[1] = nx; }
        const unsigned old = xb_add(&bar[XB_XSUB(b.x)], 1u);
        const unsigned gen = old / nloc;
        if (old + 1u == (gen + 1u) * nloc) {
            __builtin_amdgcn_fence(__ATOMIC_RELEASE, XB_SCOPE);
            asm volatile("s_waitcnt vmcnt(0)" ::: "memory");
            const unsigned og = xb_add(&bar[XB_TOP], 1u);
            const unsigned tg = og / nx;
            if (og + 1u == (tg + 1u) * nx) xb_add(&bar[XB_TOPGEN], 1u);
            else XB_SPIN(xb_ld(&bar[XB_TOPGEN]) == tg, bar);
            __builtin_amdgcn_fence(__ATOMIC_ACQUIRE, XB_SCOPE);
            xb_add(&bar[XB_XGEN(b.x)], 1u);
            asm volatile("s_waitcnt vmcnt(0)" ::: "memory");
        } else {
            XB_SPIN(xb_ld(&bar[XB_XGEN(b.x)]) == gen, bar);
            __builtin_amdgcn_fence(__ATOMIC_ACQUIRE, XB_SCOPE);
            asm volatile("s_waitcnt vmcnt(0)" ::: "memory");
        }
    }
    __syncthreads();
}

__device__ __forceinline__ void tile_coords(int L, int ntm, int ntn, int& tm, int& tn) {
    const int nt = ntm * ntn, q = nt >> 3, r = nt & 7, xcd = L & 7, off = L >> 3;
    const int id = (xcd < r ? xcd * (q + 1) : r * (q + 1) + (xcd - r) * q) + off;
    const int GM = 8, nig = GM * ntn, gid = id / nig, fm = gid * GM, gsz = (ntm - fm) < GM ? (ntm - fm) : GM;
    tm = fm + ((id % nig) % gsz); tn = (id % nig) / gsz;
}

template <class AP, class BP>
__device__ __forceinline__ void gemm_kloop(f32x4 (&acc)[4][4], AP ap, int a_kstep, BP bp, int b_kstep, int nkt, unsigned char* lds, int tid) {
    const int lane = tid & 63, w = tid >> 6, wm = w >> 1, wn = w & 1, fr = lane & 15, fq = lane >> 4;
    const int lr = lane >> 3, lc = (lane & 7) ^ lr;
    const bf16_t* pa[4]; const bf16_t* pb[4];
#pragma unroll
    for (int i = 0; i < 4; ++i) {
        const int row = 8 * (w + 4 * i) + lr;
        pa[i] = ap(row) + lc * 8;
        const int wn_ = row >> 6, ni_ = (row >> 4) & 3, ii = row & 15;
        pb[i] = bp(64 * wn_ + 16 * (ii >> 2) + 4 * ni_ + (ii & 3)) + lc * 8;
    }
    const int ra = (64 * wm + fr) * 128, rb = (64 * wn + fr) * 128;
    const int sw0 = ((fq) ^ (fr & 7)) << 4, sw1 = ((4 + fq) ^ (fr & 7)) << 4;
    auto issue = [&](int buf) {
#pragma unroll
        for (int i = 0; i < 4; ++i) {
            __builtin_amdgcn_global_load_lds((const unsigned*)pa[i], (unsigned*)(lds + buf * 16384 + (w + 4 * i) * 1024), 16, 0, 0);
            __builtin_amdgcn_global_load_lds((const unsigned*)pb[i], (unsigned*)(lds + 32768 + buf * 16384 + (w + 4 * i) * 1024), 16, 0, 0);
            pa[i] += a_kstep; pb[i] += b_kstep;
        }
    };
    auto compute = [&](int buf) {
        const unsigned char* A = lds + buf * 16384;
        const unsigned char* B = lds + 32768 + buf * 16384;
#pragma unroll
        for (int ks = 0; ks < 2; ++ks) {
            const int sw = ks ? sw1 : sw0;
            bf16x8 af[4], bf[4];
#pragma unroll
            for (int mi = 0; mi < 4; ++mi) af[mi] = *(const bf16x8*)(A + ra + mi * 2048 + sw);
#pragma unroll
            for (int ni = 0; ni < 4; ++ni) bf[ni] = *(const bf16x8*)(B + rb + ni * 2048 + sw);
#pragma unroll
            for (int mi = 0; mi < 4; ++mi)
#pragma unroll
                for (int ni = 0; ni < 4; ++ni) acc[mi][ni] = mfma16(bf[ni], af[mi], acc[mi][ni]);
        }
    };
    vb_sync(lds);
    issue(0);
    asm volatile("s_waitcnt vmcnt(0)" ::: "memory");
    vb_sync(lds);
#pragma unroll 1
    for (int kt = 0; kt < nkt; ++kt) {
        const int cur = kt & 1;
        if (kt + 1 < nkt) issue(cur ^ 1);
        compute(cur);
        asm volatile("s_waitcnt vmcnt(0)" ::: "memory");
        vb_sync(lds);
    }
}
__device__ __forceinline__ void zero_acc(f32x4 (&acc)[4][4]) {
#pragma unroll
    for (int i = 0; i < 4; ++i)
#pragma unroll
        for (int j = 0; j < 4; ++j) acc[i][j] = (f32x4){0.f, 0.f, 0.f, 0.f};
}

constexpr int G8_HTB = 16384;
__device__ __forceinline__ int g8_lds_byte(int r, int c) { const int st = (r >> 4) * 2 + (c >> 5), rr = r & 15, cc = c & 31, ob = rr * 64 + cc * 2; return st * 1024 + (ob ^ (((ob >> 9) & 1) << 5)); }
__device__ __forceinline__ void g8_stage_rc(int b, int& R, int& C) { const int st = b / 1024, sb = b % 1024, swz = sb ^ (((sb >> 9) & 1) << 5); R = (st >> 1) * 16 + swz / 64; C = (st & 1) * 32 + (swz % 64) / 2; }
__device__ __forceinline__ int g8_perm32(int rho) { const int n = rho >> 4, i = rho & 15; return 8 * (i >> 2) + 4 * n + (i & 3); }
struct G8Unit {
    const char* A0; const char* A1; const char* B0; const char* B1;
    unsigned K2;
    int nt;
    int x0, x1, x2, x3, n;
    unsigned ao[2][2];
};
typedef f32x4 G8Acc[2][2][4][2];
template <class Sched, class Epi>
__device__ __forceinline__ void g8_phase(Sched& S, Epi& E) {
    LAS unsigned char* lds = (LAS unsigned char*)lds_base();
    int tid = TIDX(); asm volatile("" : "+v"(tid));
    const int wid = __builtin_amdgcn_readfirstlane(tid >> 6), lane = tid & 63, wr = wid >> 2, wc = wid & 3, fr = lane & 15, fq = lane >> 4;
#define G8_GEOM(R, C2, Rb) int R[2]; unsigned C2[2], Rb[2]; { int _t = TIDX(); asm volatile("" : "+v"(_t)); _Pragma("unroll") for (int _i = 0; _i < 2; ++_i) { int _r, _c; g8_stage_rc(_t * 16 + _i * 8192, _r, _c); \
        R[_i] = _r; C2[_i] = (unsigned)_c * 2u; Rb[_i] = (unsigned)((_r & ~31) + g8_perm32(_r & 31)); } }
    const unsigned ldsw = (unsigned)wid * 1024u;
    const int aoff = g8_lds_byte(wr * 64 + fr, fq * 8), boff = g8_lds_byte(wc * 32 + fr, fq * 8);
#define G8_SA(b, h) (((b) * 2 + (h)) * G8_HTB)
#define G8_SB(b, h) ((4 + (b) * 2 + (h)) * G8_HTB)
#define G8_STAGE(bufoff, gbase, voff) do { _Pragma("unroll") for (int _i = 0; _i < 2; ++_i) { unsigned _o = (voff)[_i]; asm volatile("" : "+v"(_o)); \
        __builtin_amdgcn_global_load_lds((const unsigned*)((const char*)(gbase) + _o), (LAS unsigned*)(lds + (bufoff) + ldsw + _i * 8192), 16, 0, 0); } } while (0)
#define G8_BOFF(u, bo) do { _Pragma("unroll") for (int _i = 0; _i < 2; ++_i) bo[_i] = Rb_[_i] * (u).K2 + C2_[_i]; } while (0)
#define G8_LDA(dst, b, h) do { _Pragma("unroll") for (int m = 0; m < 4; ++m) _Pragma("unroll") for (int k = 0; k < 2; ++k) dst[m][k] = *(const LAS bf16x8*)(lds + G8_SA(b, h) + aoff + m * 2048 + k * 1024); } while (0)
#define G8_LDB(dst, b, h) do { _Pragma("unroll") for (int n = 0; n < 2; ++n) _Pragma("unroll") for (int k = 0; k < 2; ++k) dst[n][k] = *(const LAS bf16x8*)(lds + G8_SB(b, h) + boff + n * 2048 + k * 1024); } while (0)
#define G8_MMA(ai, bj, At, Bt) do { __builtin_amdgcn_s_setprio(1); _Pragma("unroll") for (int m = 0; m < 4; ++m) _Pragma("unroll") for (int n = 0; n < 2; ++n) _Pragma("unroll") for (int k = 0; k < 2; ++k) \
        acc[ai][bj][m][n] = __builtin_amdgcn_mfma_f32_16x16x32_bf16(Bt[n][k], At[m][k], acc[ai][bj][m][n], 0, 0, 0); __builtin_amdgcn_s_setprio(0); } while (0)
#define G8_WAIT_V(n) asm volatile("s_waitcnt vmcnt(" #n ")" ::: "memory")
#define G8_WAIT_L(n) asm volatile("s_waitcnt lgkmcnt(" #n ")" ::: "memory")
#define G8_BAR __builtin_amdgcn_s_barrier()
#define G8_SCHED __builtin_amdgcn_sched_barrier(0)
    G8Unit cur, nxt; int ui = 0; unsigned cbo[2], nbo[2];
    { G8_GEOM(R_, C2_, Rb_) if (!S.next(0, cur, R_, C2_)) return; G8_BOFF(cur, cbo); }
    G8Acc acc;
#pragma unroll
    for (int a = 0; a < 2; ++a)
#pragma unroll
        for (int b = 0; b < 2; ++b)
#pragma unroll
            for (int m = 0; m < 4; ++m)
#pragma unroll
                for (int n = 0; n < 2; ++n) acc[a][b][m][n] = (f32x4){0.f, 0.f, 0.f, 0.f};
    bf16x8 At[4][2], B0[2][2], B1[2][2];
    G8_STAGE(G8_SB(0, 0), cur.B0, cbo); G8_STAGE(G8_SA(0, 0), cur.A0, cur.ao[0]); G8_STAGE(G8_SB(0, 1), cur.B1, cbo); G8_STAGE(G8_SA(0, 1), cur.A1, cur.ao[1]);
    if (wr == 1) G8_BAR;
    G8_WAIT_V(4); G8_BAR;
    G8_STAGE(G8_SB(1, 0), cur.B0 + 128, cbo); G8_STAGE(G8_SA(1, 0), cur.A0 + 128, cur.ao[0]); G8_STAGE(G8_SB(1, 1), cur.B1 + 128, cbo);
    G8_WAIT_V(6); G8_BAR;
    for (;;) {
        bool has_next;
        { G8_GEOM(R_, C2_, Rb_) has_next = S.next(ui + 1, nxt, R_, C2_);
          if (!has_next) nxt = cur;
          G8_BOFF(nxt, nbo); }
        const int nt = cur.nt;
#pragma unroll 1
        for (int t = 0; t < nt; t += 2) {
            const bool last = (t == nt - 2);
            const size_t k1 = (size_t)(t + 1) * 128, k2 = (size_t)(t + 2) * 128;
            const char* a2h0 = last ? nxt.A0 : cur.A0 + k2; const char* a2h1 = last ? nxt.A1 : cur.A1 + k2;
            const char* b2h0 = last ? nxt.B0 : cur.B0 + k2; const char* b2h1 = last ? nxt.B1 : cur.B1 + k2;
            unsigned ao0[2], ao1[2], bo2[2];
#pragma unroll
            for (int i = 0; i < 2; ++i) { ao0[i] = last ? nxt.ao[0][i] : cur.ao[0][i]; ao1[i] = last ? nxt.ao[1][i] : cur.ao[1][i]; bo2[i] = last ? nbo[i] : cbo[i]; }
            G8_LDB(B0, 0, 0); G8_SCHED; G8_LDA(At, 0, 0); G8_STAGE(G8_SA(1, 1), cur.A1 + k1, cur.ao[1]);
            G8_WAIT_L(8); G8_BAR; G8_WAIT_L(0); G8_MMA(0, 0, At, B0); G8_BAR; G8_SCHED;
            G8_LDB(B1, 0, 1); G8_STAGE(G8_SB(0, 0), b2h0, bo2);
            G8_BAR; G8_WAIT_L(0); G8_MMA(0, 1, At, B1); G8_BAR;
            G8_LDA(At, 0, 1); G8_STAGE(G8_SA(0, 0), a2h0, ao0);
            G8_BAR; G8_WAIT_L(0); G8_MMA(1, 0, At, B0); G8_BAR; G8_SCHED;
            G8_STAGE(G8_SB(0, 1), b2h1, bo2);
            G8_WAIT_V(6); G8_BAR; G8_MMA(1, 1, At, B1); G8_BAR;
            G8_LDB(B0, 1, 0); G8_SCHED; G8_LDA(At, 1, 0); G8_STAGE(G8_SA(0, 1), a2h1, ao1);
            G8_WAIT_L(8); G8_BAR; G8_WAIT_L(0); G8_MMA(0, 0, At, B0); G8_BAR; G8_SCHED;
            G8_LDB(B1, 1, 1); G8_STAGE(G8_SB(1, 0), b2h0 + 128, bo2);
            G8_BAR; G8_WAIT_L(0); G8_MMA(0, 1, At, B1); G8_BAR;
            G8_LDA(At, 1, 1); G8_STAGE(G8_SA(1, 0), a2h0 + 128, ao0);
            G8_BAR; G8_WAIT_L(0); G8_MMA(1, 0, At, B0); G8_BAR; G8_SCHED;
            G8_STAGE(G8_SB(1, 1), b2h1 + 128, bo2);
            G8_WAIT_V(6); G8_BAR; G8_MMA(1, 1, At, B1); G8_BAR;
        }
        { int t_ = TIDX(); asm volatile("" : "+v"(t_)); const int w_ = __builtin_amdgcn_readfirstlane(t_ >> 6); E(acc, cur, w_ >> 2, w_ & 3, t_ & 15, (t_ >> 4) & 3); }
        if (!has_next) break;
#pragma unroll
        for (int a = 0; a < 2; ++a)
#pragma unroll
            for (int b = 0; b < 2; ++b)
#pragma unroll
                for (int m = 0; m < 4; ++m)
#pragma unroll
                    for (int n = 0; n < 2; ++n) acc[a][b][m][n] = (f32x4){0.f, 0.f, 0.f, 0.f};
        cur = nxt; ++ui; cbo[0] = nbo[0]; cbo[1] = nbo[1];
    }
    G8_WAIT_V(0);
    if (wr == 0) G8_BAR;
    G8_BAR;
}
struct G8Plain {
    static constexpr bool GATHER = false;
    const char* A; const char* B; unsigned K2; int nt, nM, nN;
    __device__ __forceinline__ bool next(int i, G8Unit& u, const int (&R)[2], const unsigned (&C2)[2]) const {
        const int L = i * (int)gridDim.x + (int)blockIdx.x; if (L >= nM * nN) return false;
        int pm, pn; tile_coords(L, nM, nN, pm, pn); pm = __builtin_amdgcn_readfirstlane(pm); pn = __builtin_amdgcn_readfirstlane(pn);
        u.A0 = A + (size_t)pm * 256 * K2; u.A1 = u.A0 + (size_t)128 * K2; u.B0 = B + (size_t)pn * 256 * K2; u.B1 = u.B0 + (size_t)128 * K2;
        u.K2 = K2; u.nt = nt; u.x0 = pm; u.x1 = pn; u.x2 = 0; u.x3 = 0;
#pragma unroll
        for (int h = 0; h < 2; ++h)
#pragma unroll
            for (int k = 0; k < 2; ++k) u.ao[h][k] = (unsigned)R[k] * u.K2 + C2[k];
        return true;
    }
};

__device__ __forceinline__ void convert_tiles(CKP& p, int l, int e_lo, int e_hi, int first, int stride, int lane) {
    unsigned char* W = p.ws + OFF_W;
    struct E { const float* src; bf16_t* dst; int R, C, nd, mode, nbatch; };
    const int NE = e_hi;
        for (int L = first;; L += stride) {
            int rem = L; int e = e_lo; E d{};
            for (; e < NE; ++e) {
                switch (e) {
                    case 0: d = {p.in[3] + (size_t)l * 1024 * 5144, (bf16_t*)(W + W_IN), 1024, 5144, 2176, 1, 1}; break;
                    case 1: d = {p.in[3] + (size_t)l * 1024 * 5144, (bf16_t*)(W + W_GB), 1024, 5144, 3072, 2, 1}; break;
                    case 2: d = {p.in[10] + (size_t)l * 512 * 1024, (bf16_t*)(W + W_A), 512, 1024, 1024, 0, 1}; break;
                    case 3: d = {p.in[14] + (size_t)l * 256 * 1024, (bf16_t*)(W + W_S), 256, 1024, 1024, 0, 1}; break;
                    case 4: d = {p.in[25] + (size_t)l * 256 * 1024, (bf16_t*)(W + W_5), 256, 1024, 1024, 0, 1}; break;
                    case 5: d = {p.in[26] + (size_t)l * 1024 * 1024, (bf16_t*)(W + W_M), 1024, 1024, 1024, 0, 1}; break;
                    case 6: d = {p.in[23] + (size_t)l * 256 * 256, (bf16_t*)(W + W_GLU), 256, 256, 256, 0, 1}; break;
                    case 7: d = {p.in[6] + (size_t)l * 2048 * 128, (bf16_t*)(W + W_C1), 2048, 128, 128, 0, 1}; break;
                    case 8: d = {p.in[8] + (size_t)l * 2048 * 128, (bf16_t*)(W + W_C1) + 128 * 2048, 2048, 128, 128, 0, 1}; break;
                    case 9: d = {p.in[7] + (size_t)l * 128 * 64, (bf16_t*)(W + W_C2), 128, 64, 64, 0, 1}; break;
                    case 10: d = {p.in[9] + (size_t)l * 128 * 64, (bf16_t*)(W + W_C2) + 64 * 128, 128, 64, 64, 0, 1}; break;
                    case 11: d = {p.in[32] + (size_t)l * 32 * 1024 * 512, (bf16_t*)(W + W_EG), 1024, 512, 512, 0, 32}; break;
                    case 12: d = {p.in[33] + (size_t)l * 32 * 1024 * 512, (bf16_t*)(W + W_EU), 1024, 512, 512, 0, 32}; break;
                    default: d = {p.in[34] + (size_t)l * 32 * 512 * 1024, (bf16_t*)(W + W_ED), 512, 1024, 1024, 0, 32}; break;
                }
                const int per = (d.R >> 6) * (d.nd >> 6), tot = per * d.nbatch;
                if (rem < tot) break;
                rem -= tot;
            }
            if (e >= NE) break;
            const int per = (d.R >> 6) * (d.nd >> 6), bi = rem / per, t = rem % per, ntn = d.nd >> 6;
            const int k0 = (t / ntn) * 64, n = (t % ntn) * 64 + lane;
            int col = n;
            if (d.mode == 1) col = (n < 1280) ? n : ((n < 2048) ? n + 24 : ((n < 2072) ? n - 768 : -1));
            else if (d.mode == 2) col = n + 2072;
            const float* sp = d.src + (size_t)bi * d.R * d.C + (size_t)k0 * d.C + (col >= 0 ? col : 0);
            float v[64];
#pragma unroll
            for (int i = 0; i < 64; ++i) v[i] = sp[(size_t)i * d.C];
            if (col < 0) {
#pragma unroll
                for (int i = 0; i < 64; ++i) v[i] = 0.f;
            }
            bf16_t* dp = d.dst + (size_t)bi * d.R * d.nd + (size_t)n * d.R + k0;
#pragma unroll
            for (int q = 0; q < 8; ++q) {
                u32x4 o;
                o.x = pk_bf16(v[8 * q], v[8 * q + 1]); o.y = pk_bf16(v[8 * q + 2], v[8 * q + 3]);
                o.z = pk_bf16(v[8 * q + 4], v[8 * q + 5]); o.w = pk_bf16(v[8 * q + 6], v[8 * q + 7]);
                *(u32x4*)(dp + 8 * q) = o;
            }
        }
}

__device__ __forceinline__ void phase_prep(CKP& p, int l, unsigned char* lds) {
    const int tid = opaque_tid(), G = VGRID(), lane = tid & 63, w = tid >> 6;
    unsigned char* W = p.ws + OFF_W;
    if (l < DEPTH) {
        convert_tiles(p, l, 0, 11, VBID() * 4 + w, G * 4, lane);
        const int gt = VBID() * NTHR + tid, gs = G * NTHR;
        if (l == 0) {
            const int* pos = (const int*)p.in[1]; float* rt = (float*)(p.ws + OFF_ROPE);
            for (int i = gt; i < NTOK * 8; i += gs) { float sn, cs; sincosf((float)pos[i >> 3] * p.inv_freq[i & 7], &sn, &cs); rt[(i >> 3) * 16 + (i & 7)] = cs; rt[(i >> 3) * 16 + 8 + (i & 7)] = sn; }
        }
        {
            const float* sw = p.in[12] + (size_t)l * 4 * 128 * 128; bf16_t* o = (bf16_t*)(W + W_SGU);
            for (int i = gt; i < 65536; i += gs) { const int t = (i >> 7) & 127, s = i & 127; o[i] = f2bf(s <= t ? sw[i] : 0.f); }
        }
        {
            const float* are = p.in[15] + l * 1024; const float* aim = p.in[16] + l * 1024; const float* ls = p.in[17] + l * 16;
            const float* bre = p.in[18] + (size_t)l * 16384; const float* bim = p.in[19] + (size_t)l * 16384;
            float* oa = (float*)(W + W_S5A); float* oa2 = (float*)(W + W_S5A256); float* ob = (float*)(W + W_S5B);
            for (int i = gt; i < 1024; i += gs) {
                const int g = i >> 6;
                const float step = expf(ls[g]), ar = are[i], ai = aim[i];
                const float mag = expf(ar * step); float sn, cs; sincosf(ai * step, &sn, &cs);
                const float abr = mag * cs, abi = mag * sn;
                const float den = ar * ar + ai * ai, nr = abr - 1.f, ni = abi;
                const float cr = (nr * ar + ni * ai) / den, ci = (ni * ar - nr * ai) / den;
                oa[i * 2] = abr; oa[i * 2 + 1] = abi;
                float pr = abr, pi = abi;
                for (int s = 0; s < 8; ++s) { const float nr2 = pr * pr - pi * pi, ni2 = 2.f * pr * pi; pr = nr2; pi = ni2; }
                oa2[i * 2] = pr; oa2[i * 2 + 1] = pi;
                for (int h = 0; h < 16; ++h) {
                    const float br = bre[i * 16 + h], bi_ = bim[i * 16 + h];
                    ob[i * 32 + h] = cr * br - ci * bi_;
                    ob[i * 32 + 16 + h] = cr * bi_ + ci * br;
                }
            }
            const float* cre = p.in[20] + (size_t)l * 16384; const float* cim = p.in[21] + (size_t)l * 16384; bf16_t* oc = (bf16_t*)(W + W_S5C);
            for (int i = gt; i < 32768; i += gs) {
                const int k = i & 127, gh = i >> 7;
                oc[i] = f2bf(k < 64 ? cre[gh * 64 + k] : -cim[gh * 64 + (k - 64)]);
            }
        }
        {
            const float* wg = p.in[28] + (size_t)l * 1024 * 4; const float* we = p.in[30] + (size_t)l * 1024 * 32;
            bf16_t* oh = (bf16_t*)(W + W_RH); bf16_t* ol = (bf16_t*)(W + W_RL);
            for (int i = gt; i < 65536; i += gs) {
                const int n = i >> 10, k = i & 1023;
                const float v = (n < 4) ? wg[k * 4 + n] : ((n < 36) ? we[k * 32 + (n - 4)] : 0.f);
                const bf16_t h = f2bf(v);
                oh[i] = h; ol[i] = f2bf(v - bf2f(h));
            }
        }
        {
            float* pb = (float*)(W + W_PB);
            for (int j = VBID() * 4 + w; j < 256; j += G * 4) {
                const int kv = j >> 7, n = j & 127;
                const float* pos = p.in[kv ? 5 : 4] + (size_t)l * 2048; const float* w1 = p.in[kv ? 8 : 6] + (size_t)l * 2048 * 128;
                float s = 0.f;
                for (int k = lane; k < 2048; k += 64) s += pos[k] * w1[(size_t)k * 128 + n];
                s = wave_sum(s);
                if (lane == 0) pb[j] = s;
            }
        }
    }
    {
        const float* gam = (l < DEPTH) ? (p.in[2] + (size_t)l * 1024) : p.in[35];
        bf16_t* hb = (bf16_t*)(p.ws + OFF_H);
        const bf16_t* ys = (const bf16_t*)(p.ws + OFF_YS);
        bf16_t* xres = (bf16_t*)(p.ws + OFF_X);
        f32x4 gv[4];
#pragma unroll
        for (int i = 0; i < 4; ++i) gv[i] = *(const f32x4*)(gam + 4 * lane + 256 * i);
        for (int row = VBID() * 4 + w; row < NTOK; row += G * 4) {
            f32x4 xv[4]; float ss = 0.f;
#pragma unroll
            for (int i = 0; i < 4; ++i) {
                const int col = 4 * lane + 256 * i;
                if (l == 0) xv[i] = *(const f32x4*)(p.in[0] + (size_t)row * 1024 + col);
                else {
                    { const u32x2 xx = *(const u32x2*)(xres + (size_t)row * 1024 + col); xv[i] = (f32x4){bflo(xx.x), bfhi(xx.x), bflo(xx.y), bfhi(xx.y)}; }
                    const u32x2 y0 = *(const u32x2*)(ys + (size_t)(2 * row) * 1024 + col), y1 = *(const u32x2*)(ys + (size_t)(2 * row + 1) * 1024 + col);
                    xv[i][0] += bflo(y0.x) + bflo(y1.x); xv[i][1] += bfhi(y0.x) + bfhi(y1.x);
                    xv[i][2] += bflo(y0.y) + bflo(y1.y); xv[i][3] += bfhi(y0.y) + bfhi(y1.y);
                }
                ss += xv[i][0] * xv[i][0] + xv[i][1] * xv[i][1] + xv[i][2] * xv[i][2] + xv[i][3] * xv[i][3];
            }
            ss = wave_sum(ss);
            const float rstd = rsqrtf(ss * (1.f / 1024.f) + RMS_EPS);
#pragma unroll
            for (int i = 0; i < 4; ++i) {
                const int col = 4 * lane + 256 * i;
                f32x4 hn = xv[i] * rstd * gv[i];
                if (l < DEPTH) {
                    { u32x2 xo; xo.x = pk_bf16(xv[i][0], xv[i][1]); xo.y = pk_bf16(xv[i][2], xv[i][3]); *(u32x2*)(xres + (size_t)row * 1024 + col) = xo; }
                    u32x2 o; o.x = pk_bf16(hn[0], hn[1]); o.y = pk_bf16(hn[2], hn[3]);
                    *(u32x2*)(hb + (size_t)row * 1024 + col) = o;
                } else {
#if DBG_TIMEPH >= 0
                    { const unsigned long long* ts = (const unsigned long long*)(p.ws + OFF_CTL + 24576);
                      const float dt_us = (float)(ts[DBG_TIMEPH2] - ts[DBG_TIMEPH]) * 0.01f; hn = hn * (1.f + 1e-3f * dt_us); }
#endif
                    *(f32x4*)(p.xbuf + (size_t)row * 1024 + col) = hn;
                }
            }
        }
    }
}

struct EpiInproj {
    unsigned char* Rb_; const float* rope;
    __device__ __forceinline__ void operator()(const G8Acc& acc, const G8Unit& u, int wr, int wc, int fr, int fq) const {
        unsigned char* R = Rb_;
#pragma unroll
        for (int bj = 0; bj < 2; ++bj) {
            const int tn = u.x1 * 2 + bj;
            const int cl = 32 * wc + 8 * fq;
#pragma unroll
            for (int ai = 0; ai < 2; ++ai)
#pragma unroll
                for (int m = 0; m < 4; ++m) {
                    const int row = u.x0 * 256 + ai * 128 + wr * 64 + m * 16 + fr;
                    float v[8];
#pragma unroll
                    for (int e = 0; e < 8; ++e) v[e] = acc[ai][bj][m][e >> 2][e & 3];
                    const bool roped = (tn < 4) || tn == 6 || tn == 8;
                    if (tn < 4) { u32x4 o; o.x = pk_bf16(v[0], v[1]); o.y = pk_bf16(v[2], v[3]); o.z = pk_bf16(v[4], v[5]); o.w = pk_bf16(v[6], v[7]);
                                  *(u32x4*)((bf16_t*)(R + R_Q) + (size_t)row * 512 + tn * 128 + cl) = o; }
                    if (roped && !(wc & 1)) {
                        float xo[8];
#pragma unroll
                        for (int i = 0; i < 8; ++i) xo[i] = __shfl_xor(v[i], 16);
                        if (fq < 2) {
                            const float* rt = rope + (size_t)row * 16;
                            const f32x4 c0 = *(const f32x4*)rt, c1 = *(const f32x4*)(rt + 4), s0 = *(const f32x4*)(rt + 8), s1 = *(const f32x4*)(rt + 12);
#pragma unroll
                            for (int i = 0; i < 8; ++i) {
                                const float cs = i < 4 ? c0[i & 3] : c1[i & 3], sn = i < 4 ? s0[i & 3] : s1[i & 3];
                                v[i] = fq == 0 ? (v[i] * cs - xo[i] * sn) : (v[i] * cs + xo[i] * sn);
                            }
                        }
                    }
                    u32x4 o; o.x = pk_bf16(v[0], v[1]); o.y = pk_bf16(v[2], v[3]); o.z = pk_bf16(v[4], v[5]); o.w = pk_bf16(v[6], v[7]);
                    if (tn < 4) *(u32x4*)((bf16_t*)(R + R_QR) + (size_t)row * 512 + tn * 128 + cl) = o;
                    else if (tn == 7 || tn == 9) {
                        bf16_t* dst = (bf16_t*)(R + (tn == 7 ? R_VST : R_VWT));
                        const int b = row >> 12, s_ = row & 4095, g = wc >> 1, d0 = 32 * (wc & 1) + 8 * fq;
#pragma unroll
                        for (int e = 0; e < 8; ++e) dst[((size_t)((b * 2 + g) * 64 + d0 + e)) * SEQ + s_] = f2bf(v[e]);
                    } else if (tn < 10) {
                        const size_t off = (tn == 4) ? R_KC : (tn == 5) ? R_VC : (tn == 6) ? R_KS : R_KW;
                        *(u32x4*)((bf16_t*)(R + off) + (size_t)row * 128 + cl) = o;
                    } else if (tn < 14) {
#pragma unroll
                        for (int e = 0; e < 8; ++e) v[e] = gelu_tanh(v[e]);
                        u32x4 og; og.x = pk_bf16(v[0], v[1]); og.y = pk_bf16(v[2], v[3]); og.z = pk_bf16(v[4], v[5]); og.w = pk_bf16(v[6], v[7]);
                        const int c512 = (tn - 10) * 128 + cl;
                        if (c512 < 256) *(u32x4*)((bf16_t*)(R + R_U) + (size_t)row * 256 + c512) = og;
                        else *(u32x4*)((bf16_t*)(R + R_V) + (size_t)row * 256 + (c512 - 256)) = og;
                    } else {
                        *(u32x4*)((bf16_t*)(R + R_S5IN) + (size_t)row * 256 + (tn - 14) * 128 + cl) = o;
                    }
                }
        }
    }
};
__device__ __forceinline__ void phase_inproj(CKP& p, int l, unsigned char* lds) {
    {
        G8Plain S{(const char*)(p.ws + OFF_H), (const char*)(p.ws + OFF_W + W_IN), 2048u, 16, NTOK / 256, 8};
        EpiInproj E{p.ws + OFF_R, (const float*)(p.ws + OFF_ROPE)};
        g8_phase(S, E);
    }
    const int tid = opaque_tid(), lane = tid & 63, w = tid >> 6, wm = w >> 1, wn = w & 1, fr = lane & 15, fq = lane >> 4;
    const int half = TIDX() >> 8;
    const bf16_t* A = (const bf16_t*)(p.ws + OFF_H);
    const bf16_t* Bt = (const bf16_t*)(p.ws + OFF_W + W_IN) + (size_t)2048 * 1024;
    unsigned char* R = p.ws + OFF_R;
    float* xch = (float*)(lds_base() + VB_LDS);
    for (int tm = blockIdx.x; tm < NTOK / 128; tm += gridDim.x) {
        const int m0 = tm * 128;
        f32x4 acc[4][4]; zero_acc(acc);
        gemm_kloop(acc, [&](int r) { return A + (size_t)(m0 + r) * 1024 + half * 512; }, 64, [&](int v) { return Bt + (size_t)v * 1024 + half * 512; }, 64, 8, lds, tid);
        __syncthreads();
        if (half == 1 && wn == 0 && fq < 2) {
#pragma unroll
            for (int mi = 0; mi < 4; ++mi) {
                const int r = 64 * wm + 16 * mi + fr;
#pragma unroll
                for (int ni = 0; ni < 4; ++ni) *(f32x4*)(xch + r * 32 + 16 * fq + 4 * ni) = acc[mi][ni];
            }
        }
        __syncthreads();
        if (half == 0 && wn == 0 && fq < 2) {
#pragma unroll
            for (int mi = 0; mi < 4; ++mi) {
                const int r = 64 * wm + 16 * mi + fr;
                float* ng = (float*)(R + R_NG) + (size_t)(m0 + r) * 24 + 16 * fq;
#pragma unroll
                for (int ni = 0; ni < 4; ++ni) {
                    const f32x4 o = *(const f32x4*)(xch + r * 32 + 16 * fq + 4 * ni);
#pragma unroll
                    for (int j = 0; j < 4; ++j) if (16 * fq + 4 * ni + j < 24) ng[4 * ni + j] = sigm(acc[mi][ni][j] + o[j]);
                }
            }
        }
        __syncthreads();
    }
}

__device__ __forceinline__ void compress_tile(CKP& p, int job, unsigned char* lds) {
    job_fence();
    const int tid = opaque_tid(), lane = tid & 63, w = tid >> 6, wm = w >> 1, wn = w & 1, fr = lane & 15, fq = lane >> 4;
    const int kv = job >> 5, tm = job & 31, m0 = tm * 128;
    unsigned char* W = p.ws + OFF_W;
    const bf16_t* src = (const bf16_t*)(p.ws + OFF_R + (kv ? R_VC : R_KC));
    const bf16_t* W1 = (const bf16_t*)(W + W_C1) + (size_t)kv * 128 * 2048;
    const bf16_t* W2 = (const bf16_t*)(W + W_C2) + (size_t)kv * 64 * 128;
    const float* pb = (const float*)(W + W_PB) + kv * 128;
    f32x4 acc[4][4]; zero_acc(acc);
    int t512 = TIDX(); asm volatile("" : "+v"(t512));
    const int half = t512 >> 8;
    gemm_kloop(acc, [&](int r) { int Rr = m0 + r; Rr = Rr < 4080 ? Rr : 4079; const int b = Rr / 510, rem = Rr % 510, c = rem >> 1, g = rem & 1;
                                 return src + ((size_t)(b * SEQ + 16 * c + 16 * half)) * 128 + g * 64; }, 128,
               [&](int v) { return W1 + (size_t)v * 2048 + half * 1024; }, 64, 16, lds, tid);
    {
        float* xch = (float*)(lds_base() + VB_LDS);
        __syncthreads();
        if (half == 1) {
#pragma unroll
            for (int mi = 0; mi < 4; ++mi)
#pragma unroll
                for (int ni = 0; ni < 4; ++ni) *(f32x4*)(xch + ((mi * 4 + ni) * 256 + tid) * 4) = acc[mi][ni];
        }
        __syncthreads();
        if (half == 0) {
#pragma unroll
            for (int mi = 0; mi < 4; ++mi)
#pragma unroll
                for (int ni = 0; ni < 4; ++ni) acc[mi][ni] += *(const f32x4*)(xch + ((mi * 4 + ni) * 256 + tid) * 4);
        }
        __syncthreads();
        if (half == 1) return;
    }
#pragma unroll
    for (int mi = 0; mi < 4; ++mi) {
        const int row = 64 * wm + 16 * mi + fr; const int cb = 16 * fq;
        float v[16];
#pragma unroll
        for (int e = 0; e < 16; ++e) v[e] = gelu_tanh(acc[mi][e >> 2][e & 3] + pb[64 * wn + cb + e]);
        u32x4 a, b;
        a.x = pk_bf16(v[0], v[1]); a.y = pk_bf16(v[2], v[3]); a.z = pk_bf16(v[4], v[5]); a.w = pk_bf16(v[6], v[7]);
        b.x = pk_bf16(v[8], v[9]); b.y = pk_bf16(v[10], v[11]); b.z = pk_bf16(v[12], v[13]); b.w = pk_bf16(v[14], v[15]);
        *(u32x4*)(lds + wn * 16384 + row * 128 + (((2 * fq) ^ (row & 7)) << 4)) = a;
        *(u32x4*)(lds + wn * 16384 + row * 128 + (((2 * fq + 1) ^ (row & 7)) << 4)) = b;
    }
#pragma unroll
    for (int j = 0; j < 4; ++j) {
        const int pid = tid + 256 * j, row = pid >> 4, ch = pid & 15;
        const u32x4 v = *(const u32x4*)(W2 + row * 128 + ch * 8);
        *(u32x4*)(lds + 32768 + (ch >> 3) * 16384 + row * 128 + (((ch & 7) ^ (row & 7)) << 4)) = v;
    }
    vb_sync(lds);
    f32x4 a2[4][2];
#pragma unroll
    for (int i = 0; i < 4; ++i) { a2[i][0] = (f32x4){0.f, 0.f, 0.f, 0.f}; a2[i][1] = (f32x4){0.f, 0.f, 0.f, 0.f}; }
#pragma unroll
    for (int kt2 = 0; kt2 < 2; ++kt2)
#pragma unroll
        for (int ks = 0; ks < 2; ++ks) {
            bf16x8 af[4], bf[2];
#pragma unroll
            for (int mi = 0; mi < 4; ++mi) { const int row = 64 * wm + 16 * mi + fr; af[mi] = *(const bf16x8*)(lds + kt2 * 16384 + row * 128 + (((4 * ks + fq) ^ (row & 7)) << 4)); }
#pragma unroll
            for (int ni = 0; ni < 2; ++ni) { const int row = 32 * wn + 8 * (fr >> 2) + 4 * ni + (fr & 3); bf[ni] = *(const bf16x8*)(lds + 32768 + kt2 * 16384 + row * 128 + (((4 * ks + fq) ^ (row & 7)) << 4)); }
#pragma unroll
            for (int mi = 0; mi < 4; ++mi)
#pragma unroll
                for (int ni = 0; ni < 2; ++ni) a2[mi][ni] = mfma16(bf[ni], af[mi], a2[mi][ni]);
        }
    bf16_t* kcmp = (bf16_t*)(p.ws + OFF_C + C_KCMP);
    bf16_t* vct = (bf16_t*)(p.ws + OFF_C + C_VCT);
#pragma unroll
    for (int mi = 0; mi < 4; ++mi) {
        const int Rr = m0 + 64 * wm + 16 * mi + fr;
        if (Rr < 4080) {
            const int b = Rr / 510, rem = Rr % 510, c = rem >> 1, g = rem & 1, d0 = 32 * wn + 8 * fq;
            float v[8];
#pragma unroll
            for (int e = 0; e < 8; ++e) v[e] = a2[mi][e >> 2][e & 3];
            if (DBG_NOCSTORE) { if (v[0] == 123.456f) kcmp[0] = 1; }
            else if (kv == 0) {
                u32x4 o; o.x = pk_bf16(v[0], v[1]); o.y = pk_bf16(v[2], v[3]); o.z = pk_bf16(v[4], v[5]); o.w = pk_bf16(v[6], v[7]);
                *(u32x4*)(kcmp + ((size_t)(b * 256 + c)) * 128 + g * 64 + d0) = o;
                if (c == 254) *(u32x4*)(kcmp + ((size_t)(b * 256 + 255)) * 128 + g * 64 + d0) = (u32x4){0u, 0u, 0u, 0u};
            } else {
#pragma unroll
                for (int e = 0; e < 8; ++e) {
                    vct[((size_t)((b * 2 + g) * 64 + d0 + e)) * 256 + c] = f2bf(v[e]);
                    if (c == 254) vct[((size_t)((b * 2 + g) * 64 + d0 + e)) * 256 + 255] = 0;
                }
            }
        }
    }
    vb_sync(lds);
}

__device__ __forceinline__ void sgu_job(CKP& p, int l, int job, unsigned char* lds) {
    job_fence();
    const int tid = opaque_tid(), lane = tid & 63, w = tid >> 6, fr = lane & 15, fq = lane >> 4;
    const size_t tok0 = (size_t)job * 128;
    const bf16_t* V = (const bf16_t*)(p.ws + OFF_R + R_V) + tok0 * 256;
    const bf16_t* U = (const bf16_t*)(p.ws + OFF_R + R_U) + tok0 * 256;
    bf16_t* O = (bf16_t*)(p.ws + OFF_C + C_SGU) + tok0 * 256;
    const bf16_t* Wt = (const bf16_t*)(p.ws + OFF_W + W_SGU);
    const float* ng = p.in[11] + (size_t)l * 256;
    const float* bs = p.in[13] + (size_t)l * 512;
    vb_sync(lds);
    if (DBG_SGUCUT != 2) {
        const int s = tid >> 1, half = tid & 1;
        const bf16_t* src = V + (size_t)s * 256 + half * 128;
        float ss = 0.f;
#pragma unroll 4
        for (int j = 0; j < 16; ++j) {
            const u32x4 bb = *(const u32x4*)(src + j * 8);
            const unsigned uu[4] = {bb.x, bb.y, bb.z, bb.w};
#pragma unroll
            for (int q = 0; q < 4; ++q) { const float a = bflo(uu[q]), b2 = bfhi(uu[q]); ss += a * a + b2 * b2; }
        }
        ss += __shfl_xor(ss, 1);
        const float rstd = rsqrtf(ss * (1.f / 256.f) + RMS_EPS);
#pragma unroll 1
        for (int j = 0; j < 16; ++j) {
            const u32x4 bb = *(const u32x4*)(src + j * 8);
            const unsigned uu[4] = {bb.x, bb.y, bb.z, bb.w};
            const int cb = half * 128 + j * 8;
#pragma unroll
            for (int q = 0; q < 4; ++q) {
#pragma unroll
                for (int hh = 0; hh < 2; ++hh) {
                    const int c = cb + q * 2 + hh;
                    const float val = (hh ? bfhi(uu[q]) : bflo(uu[q])) * rstd * ng[c];
                    *(bf16_t*)(lds + c * 256 + ((((s >> 3) ^ (c & 15))) << 4) + (s & 7) * 2) = f2bf(val);
                }
            }
        }
    }
    vb_sync(lds);
    const int g = w;
#pragma unroll 1
    for (int th = 0; th < (DBG_SGUCUT == 1 ? 0 : 2); ++th) {
        f32x4 acc[4][4];
        zero_acc(acc);
#pragma unroll
        for (int ks = 0; ks < 4; ++ks) {
            if (32 * ks <= 64 * th + 63) {
                bf16x8 vf[4];
#pragma unroll
                for (int di = 0; di < 4; ++di) { const int c = 64 * g + 16 * di + fr; vf[di] = *(const bf16x8*)(lds + c * 256 + (((4 * ks + fq) ^ (c & 15)) << 4)); }
#pragma unroll
                for (int ti = 0; ti < 4; ++ti) {
                    const int t = 64 * th + 16 * ti + fr;
                    if (32 * ks <= 64 * th + 16 * ti + 15) {
                        const bf16x8 wf = *(const bf16x8*)(Wt + ((size_t)(g * 128 + t)) * 128 + 32 * ks + 8 * fq);
#pragma unroll
                        for (int di = 0; di < 4; ++di) acc[ti][di] = mfma16(vf[di], wf, acc[ti][di]);
                    }
                }
            }
        }
#pragma unroll
        for (int ti = 0; ti < 4; ++ti) {
            const int t = 64 * th + 16 * ti + fr; const float bb = bs[g * 128 + t];
#pragma unroll
            for (int di = 0; di < 4; ++di) {
                const int c = 64 * g + 16 * di + 4 * fq;
                const u32x2 uu = *(const u32x2*)(U + (size_t)t * 256 + c);
                u32x2 o;
                o.x = pk_bf16(bflo(uu.x) * (acc[ti][di][0] + bb), bfhi(uu.x) * (acc[ti][di][1] + bb));
                o.y = pk_bf16(bflo(uu.y) * (acc[ti][di][2] + bb), bfhi(uu.y) * (acc[ti][di][3] + bb));
                *(u32x2*)(O + (size_t)t * 256 + c) = o;
            }
        }
    }
    vb_sync(lds);
}

__device__ __forceinline__ void s5_job(CKP& p, int l, int jb, int pass, unsigned char* lds) {
    job_fence();
    const int tid = opaque_tid(), lane = tid & 63, w = tid >> 6, fr = lane & 15, fq = lane >> 4;
    const int id = ((jb * 4 + w) + DBG_IDROT) & 2047, seq = id >> 4, ch = id & 15, b = seq >> 4, g = seq & 15;
    unsigned char* W = p.ws + OFF_W;
    const float* ab = (const float*)(W + W_S5A) + (g * 64 + lane) * 2;
    float ar = ab[0], ai = ab[1];
    float br[16], bi[16];
    {
        const float* bb = (const float*)(W + W_S5B) + (size_t)(g * 64 + lane) * 32;
#pragma unroll
        for (int h = 0; h < 16; ++h) { br[h] = bb[h]; bi[h] = bb[16 + h]; }
    }
#if DBG_S5CONST >= 2
    { const float q = (float)(lane + 1) * 0.001f; ar = 0.99f - q; ai = 0.05f + q;
      for (int h = 0; h < 16; ++h) { br[h] = 0.01f * (float)(h + 1) + q; bi[h] = -0.02f * (float)(h + 1) + q; } }
#endif
    float* Eb = (float*)(p.ws + OFF_C + C_S5E);
    float hre = 0.f, him = 0.f;
    bf16x8 cf[4]; float dv[4];
    if (pass == 2) {
        const float* a2 = (const float*)(W + W_S5A256) + (g * 64 + lane) * 2;
        const float a2r = a2[0], a2i = a2[1];
        for (int c2 = 0; c2 < ch; ++c2) {
            const float* e = Eb + ((size_t)(seq * 16 + c2) * 64 + lane) * 2;
            const float nr = a2r * hre - a2i * him + e[0], ni = a2r * him + a2i * hre + e[1];
            hre = nr; him = ni;
        }
        const bf16_t* cm = (const bf16_t*)(W + W_S5C) + (size_t)(g * 16 + fr) * 128;
#pragma unroll
        for (int ks = 0; ks < 4; ++ks) cf[ks] = *(const bf16x8*)(cm + 32 * ks + 8 * fq);
#pragma unroll
        for (int r = 0; r < 4; ++r) dv[r] = p.in[22][(size_t)l * 256 + g * 16 + 4 * fq + r];
    }
    const bf16_t* xin = (const bf16_t*)(p.ws + OFF_R + R_S5IN) + ((size_t)(b * SEQ + ch * 256)) * 256 + g * 16;
    bf16_t* yg = (bf16_t*)(p.ws + OFF_C + C_YG) + ((size_t)(b * SEQ + ch * 256)) * 256 + g * 16;
    float* xs = (float*)(lds + w * 10240);
    int ldsbad = 0; (void)ldsbad;
    unsigned char* Hs = lds + w * 10240 + 2048;
#if DBG_TWICE
    float keep_re = 0.f, keep_im = 0.f;
#pragma unroll 1
    for (int rep = 0; rep < 2; ++rep) {
    if (rep == 1) { keep_re = hre; keep_im = him; hre = 0.f; him = 0.f; }
#endif
#pragma unroll 1
    for (int sub = 0; sub < 8; ++sub) {
#if DBG_S5CONST >= 1
        u32x4 xv; { const unsigned q = (unsigned)(sub * 32 + (lane >> 1)) * 2654435761u + (unsigned)id * 40503u + (lane & 1); xv.x = 0x3f803e80u ^ ((q & 0xff) << 16); xv.y = 0x3e003d00u ^ ((q >> 8) & 0x7f); xv.z = 0xbe803f00u ^ ((q >> 16) & 0x3f); xv.w = 0x3d80be00u; }
#else
        const u32x4 xv = *(const u32x4*)(xin + (size_t)(sub * 32 + (lane >> 1)) * 256 + (lane & 1) * 8);
#endif
        vb_sync(lds);
        f32x4 chk_a = {bflo(xv.x), bfhi(xv.x), bflo(xv.y), bfhi(xv.y)}, chk_c = {bflo(xv.z), bfhi(xv.z), bflo(xv.w), bfhi(xv.w)};
        {
            *(f32x4*)(xs + (lane >> 1) * 16 + (lane & 1) * 8) = chk_a;
            *(f32x4*)(xs + (lane >> 1) * 16 + (lane & 1) * 8 + 4) = chk_c;
        }
        vb_sync(lds);
#pragma unroll 4
        for (int st = 0; st < 32; ++st) {
#if DBG_S5CONST == 3
            f32x4 x0, x1, x2, x3;
            { const float t = (float)((sub * 32 + st) & 63) * 0.015625f + (float)(id & 7) * 0.125f;
              x0 = (f32x4){t, t * 0.5f, -t, 0.25f}; x1 = (f32x4){0.5f - t, t * t, 0.125f, t}; x2 = (f32x4){-0.25f, t, 0.75f * t, 1.f - t}; x3 = (f32x4){t, -t, 0.5f, 0.3f * t}; }
#else
            const f32x4 x0 = *(const f32x4*)(xs + st * 16), x1 = *(const f32x4*)(xs + st * 16 + 4), x2 = *(const f32x4*)(xs + st * 16 + 8), x3 = *(const f32x4*)(xs + st * 16 + 12);
#endif
            float ur = 0.f, ui = 0.f;
#pragma unroll
            for (int h = 0; h < 4; ++h) {
                ur += br[h] * x0[h]; ui += bi[h] * x0[h];
                ur += br[4 + h] * x1[h]; ui += bi[4 + h] * x1[h];
                ur += br[8 + h] * x2[h]; ui += bi[8 + h] * x2[h];
                ur += br[12 + h] * x3[h]; ui += bi[12 + h] * x3[h];
            }
            const float nr = ar * hre - ai * him + ur, ni = ar * him + ai * hre + ui;
            hre = nr; him = ni;
            if (pass == 2) {
                *(bf16_t*)(Hs + st * 256 + (((lane >> 3) ^ (st & 15)) << 4) + (lane & 7) * 2) = f2bf(hre);
                *(bf16_t*)(Hs + st * 256 + ((((64 + lane) >> 3) ^ (st & 15)) << 4) + (lane & 7) * 2) = f2bf(him);
            }
        }
#if DBG_LDSCHK
        {
            const f32x4 ra = *(volatile f32x4*)(xs + (lane >> 1) * 16 + (lane & 1) * 8), rc = *(volatile f32x4*)(xs + (lane >> 1) * 16 + (lane & 1) * 8 + 4);
            bool bad = false;
            for (int q = 0; q < 4; ++q) bad |= (__float_as_uint(ra[q]) != __float_as_uint(chk_a[q])) | (__float_as_uint(rc[q]) != __float_as_uint(chk_c[q]));
            if (__any(bad)) ldsbad = 1;
        }
#endif
        if (pass == 2) {
            vb_sync(lds);
#pragma unroll
            for (int tt = 0; tt < 2; ++tt) {
                f32x4 acc = {0.f, 0.f, 0.f, 0.f};
                const int tl = tt * 16 + fr;
#pragma unroll
                for (int ks = 0; ks < 4; ++ks) {
                    const bf16x8 hf = *(const bf16x8*)(Hs + tl * 256 + (((4 * ks + fq) ^ (tl & 15)) << 4));
                    acc = mfma16(cf[ks], hf, acc);
                }
                float y[4];
#pragma unroll
                for (int r = 0; r < 4; ++r) y[r] = gelu_tanh(acc[r] + dv[r] * xs[tl * 16 + 4 * fq + r]);
                u32x2 o; o.x = pk_bf16(y[0], y[1]); o.y = pk_bf16(y[2], y[3]);
                *(u32x2*)(yg + (size_t)(sub * 32 + tl) * 256 + 4 * fq) = o;
            }
        }
    }
#if DBG_TWICE
    }
    if (__float_as_uint(keep_re) != __float_as_uint(hre) || __float_as_uint(keep_im) != __float_as_uint(him)) { hre = __uint_as_float(0x7fc00000u); him = hre; }
#endif
    if (pass == 1) {
        float* e = Eb + ((size_t)(seq * 16 + ch) * 64 + lane) * 2;
#if DBG_LDSCHK
        if (ldsbad) { hre = __uint_as_float(0x7fc00000u); him = hre; }
#endif
#if DBG_ESC1
        { const unsigned long long pk = ((unsigned long long)__float_as_uint(him) << 32) | __float_as_uint(hre);
          __hip_atomic_store((unsigned long long*)e, pk, __ATOMIC_RELAXED, __HIP_MEMORY_SCOPE_AGENT); }
#else
        e[0] = hre; e[1] = him;
#endif
#if DBG_E2
        float* e2 = (float*)(p.ws + OFF_C + C_ATT) + ((size_t)(seq * 16 + ch) * 64 + lane) * 2;
        e2[0] = hre; e2[1] = him;
#endif
    }
    vb_sync(lds);
}

__device__ __forceinline__ void phase_mid1(CKP& p, int l, unsigned char* lds) {
    if (blockIdx.x < 64) { compress_tile(p, (int)blockIdx.x, lds); return; }
    for (int j = VBID() - 128; j < 768; j += VGRID() - 128) {
        if (j < 256) sgu_job(p, l, j, lds);
        else s5_job(p, l, j - 256, 1, lds);
    }
}

constexpr int AL_Q = 0, AL_KV = 32768, AL_IMP = 49152, AL_SEL = 65792, AL_UNI = 66304, AL_JOB = 66336;
constexpr float SM_C = 0.125f * 1.4426950408889634f;

__device__ __forceinline__ void attn_load_q(const bf16_t* Qg, const int* pos, const float (&inv_freq)[8], int b, int g, int t0, bool rope, unsigned char* lds, int tid) {
#pragma unroll 1
    for (int j = 0; j < 8; ++j) {
        const int pid = tid + 256 * j, Rr = pid >> 3, ch = pid & 7;
        const int wq = Rr >> 6, r = (Rr >> 4) & 3, q = Rr & 15, t = t0 + 16 * wq + q;
        const bf16_t* src = Qg + ((size_t)(b * SEQ + t)) * 512 + (g * 4 + r) * 64;
        if (!rope || ch >= 2) {
            *(u32x4*)(lds + AL_Q + Rr * 128 + ((ch ^ (Rr & 7)) << 4)) = *(const u32x4*)(src + ch * 8);
        } else if (ch == 0) {
            const u32x4 a = *(const u32x4*)(src), c = *(const u32x4*)(src + 8);
            float x1[8] = {bflo(a.x), bfhi(a.x), bflo(a.y), bfhi(a.y), bflo(a.z), bfhi(a.z), bflo(a.w), bfhi(a.w)};
            float x2[8] = {bflo(c.x), bfhi(c.x), bflo(c.y), bfhi(c.y), bflo(c.z), bfhi(c.z), bflo(c.w), bfhi(c.w)};
            const float ps = (float)pos[b * SEQ + t];
#pragma unroll
            for (int i = 0; i < 8; ++i) {
                float sn, cs; sincosf(ps * inv_freq[i], &sn, &cs);
                const float u = x1[i], v = x2[i];
                x1[i] = u * cs - v * sn; x2[i] = v * cs + u * sn;
            }
            u32x4 o1, o2;
            o1.x = pk_bf16(x1[0], x1[1]); o1.y = pk_bf16(x1[2], x1[3]); o1.z = pk_bf16(x1[4], x1[5]); o1.w = pk_bf16(x1[6], x1[7]);
            o2.x = pk_bf16(x2[0], x2[1]); o2.y = pk_bf16(x2[2], x2[3]); o2.z = pk_bf16(x2[4], x2[5]); o2.w = pk_bf16(x2[6], x2[7]);
            *(u32x4*)(lds + AL_Q + Rr * 128 + ((0 ^ (Rr & 7)) << 4)) = o1;
            *(u32x4*)(lds + AL_Q + Rr * 128 + ((1 ^ (Rr & 7)) << 4)) = o2;
        }
    }
}
__device__ __forceinline__ void attn_ldg(u32x4 (&kk)[2], u32x4 (&vv)[2], const bf16_t* Kb, const bf16_t* Vb, int vstride, int tid) {
#pragma unroll
    for (int j = 0; j < 2; ++j) {
        const int pid = tid + 256 * j, row = pid >> 3, ch = pid & 7;
        kk[j] = *(const u32x4*)(Kb + (size_t)row * 128 + ch * 8);
        vv[j] = *(const u32x4*)(Vb + (size_t)row * vstride + ch * 8);
    }
}
__device__ __forceinline__ void attn_stl(const u32x4 (&kk)[2], const u32x4 (&vv)[2], unsigned char* lds, int kvoff, int tid) {
#pragma unroll
    for (int j = 0; j < 2; ++j) {
        const int pid = tid + 256 * j, row = pid >> 3, ch = pid & 7;
        *(u32x4*)(lds + kvoff + row * 128 + ((ch ^ (row & 7)) << 4)) = kk[j];
        *(u32x4*)(lds + kvoff + 8192 + row * 128 + ((ch ^ ((row >> 1) & 7)) << 4)) = vv[j];
    }
}
__device__ __forceinline__ void attn_qk(f32x4 (&s)[2][4], const unsigned char* lds, int kvoff, int w, int fr, int fq, int hf) {
    const unsigned char* Qw = lds + AL_Q + w * 8192;
    const unsigned char* Kh = lds + kvoff + hf * 4096;
    const int sw0 = ((fq) ^ (fr & 7)) << 4, sw1 = ((4 + fq) ^ (fr & 7)) << 4;
#pragma unroll
    for (int ki = 0; ki < 2; ++ki)
#pragma unroll
        for (int qi = 0; qi < 4; ++qi) s[ki][qi] = (f32x4){0.f, 0.f, 0.f, 0.f};
#pragma unroll
    for (int ds = 0; ds < 2; ++ds) {
        bf16x8 qf[4];
#pragma unroll
        for (int qi = 0; qi < 4; ++qi) qf[qi] = *(const bf16x8*)(Qw + (qi * 16 + fr) * 128 + (ds ? sw1 : sw0));
#pragma unroll
        for (int ki = 0; ki < 2; ++ki) {
            const bf16x8 kf = *(const bf16x8*)(Kh + (ki * 16 + fr) * 128 + (ds ? sw1 : sw0));
#pragma unroll
            for (int qi = 0; qi < 4; ++qi) s[ki][qi] = mfma16(kf, qf[qi], s[ki][qi]);
        }
    }
}
__device__ __forceinline__ void attn_pv(f32x4 (&o)[4][4], const f32x4 (&s)[2][4], const unsigned char* lds, int kvoff, int fr, int fq, int hf) {
    bf16x8 pf[4];
#pragma unroll
    for (int qi = 0; qi < 4; ++qi) {
        u32x4 u;
        u.x = pk_bf16(s[0][qi][0], s[0][qi][1]); u.y = pk_bf16(s[0][qi][2], s[0][qi][3]);
        u.z = pk_bf16(s[1][qi][0], s[1][qi][1]); u.w = pk_bf16(s[1][qi][2], s[1][qi][3]);
        pf[qi] = as_bf8(u);
    }
    const int c0 = 4 * hf + (fq >> 1);
    const unsigned char* Vt = lds + kvoff + 8192;
#pragma unroll
    for (int di = 0; di < 4; ++di) {
        const int row = di * 16 + fr, key = (row >> 1) & 7;
        const u32x2 lo = *(const u32x2*)(Vt + row * 128 + ((c0 ^ key) << 4) + 8 * (fq & 1));
        const u32x2 hi = *(const u32x2*)(Vt + row * 128 + (((c0 + 2) ^ key) << 4) + 8 * (fq & 1));
        const bf16x8 vf = as_bf8((u32x4){lo.x, lo.y, hi.x, hi.y});
#pragma unroll
        for (int qi = 0; qi < 4; ++qi) o[di][qi] = mfma16(vf, pf[qi], o[di][qi]);
    }
}
__device__ __forceinline__ unsigned attn_vmask(int kb, int fq, int lo, int hi) {
    unsigned vm = 0;
#pragma unroll
    for (int ki = 0; ki < 2; ++ki)
#pragma unroll
        for (int r = 0; r < 4; ++r) { const int key = kb + 16 * ki + 4 * fq + r; if (key >= lo && key <= hi) vm |= 1u << (ki * 4 + r); }
    return vm;
}
__device__ __forceinline__ void attn_softmax(f32x4 (&s)[2][4], f32x4 (&o)[4][4], float (&m)[4], float (&lsum)[4], unsigned vm) {
#pragma unroll
    for (int qi = 0; qi < 4; ++qi) {
        float mx = -1e30f;
#pragma unroll
        for (int ki = 0; ki < 2; ++ki)
#pragma unroll
            for (int r = 0; r < 4; ++r) { const float sv = ((vm >> (ki * 4 + r)) & 1u) ? s[ki][qi][r] * SM_C : -1e30f; s[ki][qi][r] = sv; mx = fmaxf(mx, sv); }
        mx = xmax16(mx); mx = xmax32(mx);
        const float mn = fmaxf(m[qi], mx), alpha = fexp2(m[qi] - mn);
        m[qi] = mn;
        float ls = 0.f;
#pragma unroll
        for (int ki = 0; ki < 2; ++ki)
#pragma unroll
            for (int r = 0; r < 4; ++r) { const float pv = ((vm >> (ki * 4 + r)) & 1u) ? fexp2(s[ki][qi][r] - mn) : 0.f; s[ki][qi][r] = pv; ls += pv; }
        lsum[qi] = lsum[qi] * alpha + ls;
        if (__any(alpha != 1.f)) {
#pragma unroll
            for (int di = 0; di < 4; ++di) o[di][qi] *= alpha;
        }
    }
}
__device__ __forceinline__ void attn_softmax_full(f32x4 (&s)[2][4], f32x4 (&o)[4][4], float (&m)[4], float (&lsum)[4], bool lsel) {
#pragma unroll
    for (int qi = 0; qi < 4; ++qi) {
        float mx = fmaxf(fmaxf(fmaxf(s[0][qi][0], s[0][qi][1]), fmaxf(s[0][qi][2], s[0][qi][3])), fmaxf(fmaxf(s[1][qi][0], s[1][qi][1]), fmaxf(s[1][qi][2], s[1][qi][3])));
        mx = xmax16(mx); mx = xmax32(mx);
        const float mn = fmaxf(m[qi], mx * SM_C);
        const float mnew = lsel ? mn : m[qi];
        const float alpha = fexp2(m[qi] - mnew);
        m[qi] = mnew;
        const float neg = lsel ? -mn : -1e30f;
        float ls = 0.f;
#pragma unroll
        for (int ki = 0; ki < 2; ++ki)
#pragma unroll
            for (int r = 0; r < 4; ++r) { const float pv = fexp2(fmaf(s[ki][qi][r], SM_C, neg)); s[ki][qi][r] = pv; ls += pv; }
        lsum[qi] = lsum[qi] * alpha + ls;
        if (__any(alpha != 1.f)) {
#pragma unroll
            for (int di = 0; di < 4; ++di) o[di][qi] *= alpha;
        }
    }
}
__device__ __forceinline__ void attn_softmax_fast(f32x4 (&s)[2][4], const float (&m)[4], float (&lsum)[4], unsigned vm, bool& ovf) {
#pragma unroll
    for (int qi = 0; qi < 4; ++qi) {
        const float neg = -m[qi]; float l = 0.f;
#pragma unroll
        for (int ki = 0; ki < 2; ++ki)
#pragma unroll
            for (int r = 0; r < 4; ++r) { const float pv = ((vm >> (ki * 4 + r)) & 1u) ? fexp2(fmaf(s[ki][qi][r], SM_C, neg)) : 0.f; s[ki][qi][r] = pv; l += pv; }
        lsum[qi] += l; ovf |= !(l < 1.0e12f);
    }
}
__device__ __forceinline__ void attn_accum(bf16_t* dst, const f32x4 (&o)[4][4], const float (&lsum)[4], const float (&gate)[4], bool first, int fq) {
#pragma unroll
    for (int qi = 0; qi < 4; ++qi) {
        float lt = lsum[qi]; lt = xsum16(lt); lt = xsum32(lt);
        const float sc = gate[qi] / fmaxf(lt, 1e-30f);
#pragma unroll
        for (int di = 0; di < 4; ++di) {
            u32x2* ptr = (u32x2*)(dst + qi * 64 + 16 * di + 4 * fq);
            float a0 = o[di][qi][0] * sc, a1 = o[di][qi][1] * sc, a2 = o[di][qi][2] * sc, a3 = o[di][qi][3] * sc;
            if (!first) { const u32x2 f = *ptr; a0 += bflo(f.x); a1 += bfhi(f.x); a2 += bflo(f.y); a3 += bfhi(f.y); }
            u32x2 r; r.x = pk_bf16(a0, a1); r.y = pk_bf16(a2, a3);
            *ptr = r;
        }
    }
}
__device__ __forceinline__ bool attn_retry(bool ovf, unsigned char* lds, int tid) {
    volatile LAS int* flag = (volatile LAS int*)(LAS unsigned char*)(lds + AL_JOB + 4);
    if (__any(ovf) && (tid & 63) == 0) *flag = 1;
    vb_sync(lds);
    const int rf = *flag;
    vb_sync(lds);
    if (rf && tid == 0) *flag = 0;
    return rf != 0;
}
template <class NextF, class PtrF, class BodyF>
__device__ __forceinline__ void attn_tiles(int first, NextF next, PtrF ptrs, BodyF body, unsigned char* lds, int tid) {
    u32x4 kk[2], vv[2];
    const bf16_t* Kb; const bf16_t* Vb; int vs;
    ptrs(first, Kb, Vb, vs);
    attn_ldg(kk, vv, Kb, Vb, vs, tid);
    int cur = first;
    while (cur >= 0) {
        vb_sync(lds);
        attn_stl(kk, vv, lds, AL_KV, tid);
        vb_sync(lds);
        const int nx = next(cur);
        if (nx >= 0) { ptrs(nx, Kb, Vb, vs); attn_ldg(kk, vv, Kb, Vb, vs, tid); }
        body(cur, AL_KV);
        cur = nx;
    }
}

__device__ __forceinline__ void phase_attn(CKP& p, int l, unsigned char* lds, unsigned* ctl) {
    for (int j = VBID(); j < 512; j += VGRID()) s5_job(p, l, j, 2, lds);

    unsigned char* R = p.ws + OFF_R; unsigned char* C = p.ws + OFF_C;
    const bf16_t* Qg = (const bf16_t*)(R + R_Q);
    const bf16_t* Kc = (const bf16_t*)(C + C_KCMP); const bf16_t* Vc = (const bf16_t*)(C + C_VCT);
    const bf16_t* Ks = (const bf16_t*)(R + R_KS); const bf16_t* Vs = (const bf16_t*)(R + R_VST);
    const bf16_t* Kw = (const bf16_t*)(R + R_KW); const bf16_t* Vw = (const bf16_t*)(R + R_VWT);
    const float* NG = (const float*)(R + R_NG);
    bf16_t* AO = (bf16_t*)(C + C_ATT);
    const int* pos = (const int*)p.in[1];
    unsigned* ctr = ctl + CTL_ATTN + l;
    float invf[8];
#pragma unroll
    for (int q = 0; q < 8; ++q) invf[q] = p.inv_freq[q];

    if (opaque_tid() == 0) { *(volatile int*)(lds + AL_JOB + 8) = 0; *(volatile int*)(lds + AL_JOB + 4) = 0; }
    for (;;) {
        lds = vb_lds();
        volatile int* jobp = (volatile int*)(lds + AL_JOB);
        float* imp = (float*)(lds + AL_IMP);
        unsigned long long* selm = (unsigned long long*)(lds + AL_SEL);
        unsigned long long* uni = (unsigned long long*)(lds + AL_UNI);
        const int tid = opaque_tid(), lane = tid & 63, w = tid >> 6, fr = lane & 15, fq = lane >> 4;
        vb_sync(lds);
        if (tid == 0) { *jobp = (int)atomicAdd(ctr, 1u); *(volatile int*)(lds + AL_JOB + 8) += 1; }
        vb_sync(lds);
        const int job = *jobp, grabs = *(volatile int*)(lds + AL_JOB + 8);
        if (grabs == 2 || (job >= 1024 && grabs == 1)) convert_tiles(p, l, 11, 14, VBID() * 4 + w, VGRID() * 4, lane);
        if (job >= 1024) break;
        const int i = 63 - (job >> 4), bg = job & 15, b = bg >> 1, g = bg & 1, t0 = i * 64;
        const int tq = t0 + 16 * w + fr;
        const size_t kvrow = (size_t)b * SEQ;
        float gate[4]; bf16_t* dstq_;

        attn_load_q(Qg, pos, invf, b, g, t0, false, lds, tid);
        const int ntc = ((4 * i + 2) >> 6) + 1;
        const int hic = (tq >= 31) ? ((tq - 31) >> 4) : -1;
        float m[4], lsum[4];
#pragma unroll
        for (int qi = 0; qi < 4; ++qi) { m[qi] = -1e30f; lsum[qi] = 0.f; }
        auto cmp_next = [&](int ct) { return (ct + 1 < ntc) ? ct + 1 : -1; };
        auto cmp_ptrs = [&](int ct, const bf16_t*& Kb, const bf16_t*& Vb, int& vs) {
            Kb = Kc + ((size_t)(b * 256 + ct * 64)) * 128 + g * 64; Vb = Vc + ((size_t)((b * 2 + g) * 64)) * 256 + ct * 64; vs = 256; };
        attn_tiles(0, cmp_next, cmp_ptrs, [&](int ct, int kvoff) {
#pragma unroll 1
            for (int hf = 0; hf < 2; ++hf) {
                f32x4 s[2][4];
                attn_qk(s, lds, kvoff, w, fr, fq, hf);
                const unsigned vm = attn_vmask(ct * 64 + hf * 32, fq, 0, hic);
#pragma unroll
                for (int qi = 0; qi < 4; ++qi) {
                    float mx = -1e30f;
#pragma unroll
                    for (int ki = 0; ki < 2; ++ki)
#pragma unroll
                        for (int r = 0; r < 4; ++r) { const float sv = ((vm >> (ki * 4 + r)) & 1u) ? s[ki][qi][r] * SM_C : -1e30f; s[ki][qi][r] = sv; mx = fmaxf(mx, sv); }
                    mx = xmax16(mx); mx = xmax32(mx);
                    const float mn = fmaxf(m[qi], mx), alpha = fexp2(m[qi] - mn);
                    m[qi] = mn;
                    float ls = 0.f;
#pragma unroll
                    for (int ki = 0; ki < 2; ++ki)
#pragma unroll
                        for (int r = 0; r < 4; ++r) ls += ((vm >> (ki * 4 + r)) & 1u) ? fexp2(s[ki][qi][r] - mn) : 0.f;
                    lsum[qi] = lsum[qi] * alpha + ls;
                }
            }
        }, lds, tid);
        float invl[4];
#pragma unroll
        for (int qi = 0; qi < 4; ++qi) { float lt = lsum[qi]; lt = xsum16(lt); lt = xsum32(lt); invl[qi] = 1.f / fmaxf(lt, 1e-30f); }
        {
            f32x4 o[4][4]; zero_acc(o);
            float carry = 0.f;
            attn_tiles(0, cmp_next, cmp_ptrs, [&](int ct, int kvoff) {
#pragma unroll 1
                for (int hf = 0; hf < 2; ++hf) {
                    f32x4 s[2][4];
                    attn_qk(s, lds, kvoff, w, fr, fq, hf);
                    const unsigned vm = attn_vmask(ct * 64 + hf * 32, fq, 0, hic);
#pragma unroll
                    for (int qi = 0; qi < 4; ++qi)
#pragma unroll
                        for (int ki = 0; ki < 2; ++ki)
#pragma unroll
                            for (int r = 0; r < 4; ++r) s[ki][qi][r] = ((vm >> (ki * 4 + r)) & 1u) ? fexp2(s[ki][qi][r] * SM_C - m[qi]) * invl[qi] : 0.f;
#pragma unroll
                    for (int ki = 0; ki < 2; ++ki) {
                        float a = 0.f, bq = 0.f;
#pragma unroll
                        for (int qi = 0; qi < 4; ++qi) { a += s[ki][qi][0] + s[ki][qi][1] + s[ki][qi][2] + 0.5f * s[ki][qi][3]; bq += 0.5f * s[ki][qi][3]; }
                        const float up = bperm_f((lane + 48) & 63, bq);
                        const float wrap = bperm_f((lane + 48) & 63, carry);
                        a += (fq >= 1) ? up : wrap;
                        carry = bq;
                        imp[(16 * w + fr) * 65 + 16 * ct + 8 * hf + 4 * ki + fq] = a;
                    }
                    attn_pv(o, s, lds, kvoff, fr, fq, hf);
                }
            }, lds, tid);
#pragma unroll
            for (int qi = 0; qi < 4; ++qi) { int rq = (int)kvrow + tq; asm volatile("" : "+v"(rq)); gate[qi] = NG[(size_t)rq * 24 + (g * 4 + qi) * 3 + 0]; }
            const float quarter[4] = {0.25f, 0.25f, 0.25f, 0.25f};
            { int rq2 = (int)kvrow + tq; asm volatile("" : "+v"(rq2)); dstq_ = AO + (size_t)rq2 * 512 + (g * 4) * 64; } attn_accum(dstq_, o, quarter, gate, true, fq);
        }
        vb_sync(lds);
        {
            const int q = tid >> 2, part = tid & 3;
            unsigned long long mk = 0ull;
            if (i <= 15) { mk = (i == 63) ? ~0ull : ((1ull << (i + 1)) - 1ull); }
            else {
                const float* row = imp + q * 65;
                for (int j = 1 + part; j <= i - 2; j += 4) {
                    const float vj = row[j]; int rank = 0;
                    for (int j2 = 1; j2 <= i - 2; ++j2) { const float v2 = row[j2]; rank += (v2 > vj || (v2 == vj && j2 < j)) ? 1 : 0; }
                    if (rank < 13) mk |= 1ull << j;
                }
                unsigned lo32 = (unsigned)mk, hi32 = (unsigned)(mk >> 32);
                lo32 |= bperm_u(lane ^ 1, lo32); hi32 |= bperm_u(lane ^ 1, hi32);
                lo32 |= bperm_u(lane ^ 2, lo32); hi32 |= bperm_u(lane ^ 2, hi32);
                mk = ((unsigned long long)hi32 << 32) | lo32;
                mk |= 1ull | (1ull << i) | (1ull << (i - 1));
            }
            if (part == 0) selm[q] = mk;
            unsigned lo32 = (unsigned)mk, hi32 = (unsigned)(mk >> 32);
#pragma unroll
            for (int o2 = 32; o2 >= 1; o2 >>= 1) { lo32 |= bperm_u(lane ^ o2, lo32); hi32 |= bperm_u(lane ^ o2, hi32); }
            if (lane == 0) uni[w] = ((unsigned long long)hi32 << 32) | lo32;
        }
        vb_sync(lds);
        const unsigned long long mymask = selm[16 * w + fr];
        const unsigned long long un = uni[0] | uni[1] | uni[2] | uni[3];
        vb_sync(lds);
        attn_load_q((const bf16_t*)(R + R_QR), pos, invf, b, g, t0, false, lds, tid);
        auto sel_branch = [&](auto mode_c) -> bool {
            constexpr int mode = decltype(mode_c)::value;
            int kvr = (int)kvrow, bl = b, gl = g; asm volatile("" : "+v"(kvr), "+v"(bl), "+v"(gl));
            f32x4 o[4][4]; zero_acc(o);
#pragma unroll
            for (int qi = 0; qi < 4; ++qi) { m[qi] = -1e30f; lsum[qi] = 0.f; }
            bool ovf = false;
            attn_tiles(0,
                [&](int j) { const unsigned long long rest = (j >= 63) ? 0ull : (un >> (j + 1)); return rest ? (j + 1 + (int)__ffsll((long long)rest) - 1) : -1; },
                [&](int j, const bf16_t*& Kb, const bf16_t*& Vb, int& vs) { Kb = Ks + ((size_t)kvr + j * 64) * 128 + gl * 64; Vb = Vs + ((size_t)((bl * 2 + gl) * 64)) * SEQ + j * 64; vs = SEQ; },
                [&](int j, int kvoff) {
                    const bool lsel = ((mymask >> j) & 1ull) != 0ull;
                    const int hi = lsel ? tq : -1;
#pragma unroll 1
                    for (int hf = 0; hf < 2; ++hf) {
                        f32x4 s[2][4];
                        attn_qk(s, lds, kvoff, w, fr, fq, hf);
                        if (j == 0 || mode) { if (j < i) attn_softmax_full(s, o, m, lsum, lsel); else { const unsigned vm = attn_vmask(j * 64 + hf * 32, fq, 0, hi); attn_softmax(s, o, m, lsum, vm); } }
                        else { const unsigned vm = (j < i) ? (lsel ? 0xffu : 0u) : attn_vmask(j * 64 + hf * 32, fq, 0, hi); attn_softmax_fast(s, m, lsum, vm, ovf); }
                        attn_pv(o, s, lds, kvoff, fr, fq, hf);
                    }
                }, lds, tid);
            if (mode == 0 && attn_retry(ovf, lds, tid)) return true;
#pragma unroll
            for (int qi = 0; qi < 4; ++qi) { int rq = (int)kvrow + tq; asm volatile("" : "+v"(rq)); gate[qi] = NG[(size_t)rq * 24 + (g * 4 + qi) * 3 + 1]; }
            { int rq2 = (int)kvrow + tq; asm volatile("" : "+v"(rq2)); dstq_ = AO + (size_t)rq2 * 512 + (g * 4) * 64; } attn_accum(dstq_, o, lsum, gate, false, fq);
            return false;
        };
        if (sel_branch(std::integral_constant<int, 0>{})) (void)sel_branch(std::integral_constant<int, 1>{});
        auto win_branch = [&](auto mode_c) -> bool {
            constexpr int mode = decltype(mode_c)::value;
            int kvr = (int)kvrow, bl = b, gl = g; asm volatile("" : "+v"(kvr), "+v"(bl), "+v"(gl));
            f32x4 o[4][4]; zero_acc(o);
#pragma unroll
            for (int qi = 0; qi < 4; ++qi) { m[qi] = -1e30f; lsum[qi] = 0.f; }
            const int j0 = (i >= 8) ? (i - 8) : 0;
            bool ovf = false;
            attn_tiles(j0,
                [&](int j) { return (j + 1 <= i) ? j + 1 : -1; },
                [&](int j, const bf16_t*& Kb, const bf16_t*& Vb, int& vs) { Kb = Kw + ((size_t)kvr + j * 64) * 128 + gl * 64; Vb = Vw + ((size_t)((bl * 2 + gl) * 64)) * SEQ + j * 64; vs = SEQ; },
                [&](int j, int kvoff) {
#pragma unroll 1
                    for (int hf = 0; hf < 2; ++hf) {
                        f32x4 s[2][4];
                        attn_qk(s, lds, kvoff, w, fr, fq, hf);
                        if (j <= j0 + 1 || mode) { const unsigned vm = attn_vmask(j * 64 + hf * 32, fq, tq - 511, tq); attn_softmax(s, o, m, lsum, vm); }
                        else { const unsigned vm = (j >= i - 7 && j < i) ? 0xffu : attn_vmask(j * 64 + hf * 32, fq, tq - 511, tq); attn_softmax_fast(s, m, lsum, vm, ovf); }
                        attn_pv(o, s, lds, kvoff, fr, fq, hf);
                    }
                }, lds, tid);
            if (mode == 0 && attn_retry(ovf, lds, tid)) return true;
#pragma unroll
            for (int qi = 0; qi < 4; ++qi) { int rq = (int)kvrow + tq; asm volatile("" : "+v"(rq)); gate[qi] = NG[(size_t)rq * 24 + (g * 4 + qi) * 3 + 2]; }
            { int rq2 = (int)kvrow + tq; asm volatile("" : "+v"(rq2)); dstq_ = AO + (size_t)rq2 * 512 + (g * 4) * 64; } attn_accum(dstq_, o, lsum, gate, false, fq);
            return false;
        };
        if (win_branch(std::integral_constant<int, 0>{})) (void)win_branch(std::integral_constant<int, 1>{});
    }
}

__device__ __forceinline__ void phase_glu(CKP& p, int l, unsigned char* lds) {
    const int tid = opaque_tid(), lane = tid & 63, w = tid >> 6, wm = w >> 1, wn = w & 1, fr = lane & 15, fq = lane >> 4;
    const bf16_t* A = (const bf16_t*)(p.ws + OFF_C + C_YG);
    const bf16_t* Bt = (const bf16_t*)(p.ws + OFF_W + W_GLU);
    bf16_t* O = (bf16_t*)(p.ws + OFF_C + C_S5O);
    const float* gb = p.in[24] + (size_t)l * 256;
    constexpr int NTM = NTOK / 128, NTN = 2;
    for (int L = VBID(); L < NTM * NTN; L += VGRID()) {
        int tm, tn; tile_coords(L, NTM, NTN, tm, tn);
        const int m0 = tm * 128, n0 = tn * 128;
        f32x4 acc[4][4]; zero_acc(acc);
        gemm_kloop(acc, [&](int r) { return A + (size_t)(m0 + r) * 256; }, 64, [&](int v) { return Bt + (size_t)(n0 + v) * 256; }, 64, 4, lds, tid);
#pragma unroll
        for (int mi = 0; mi < 4; ++mi) {
            const int row = m0 + 64 * wm + 16 * mi + fr, col = n0 + 64 * wn + 16 * fq;
            const u32x4 y0 = *(const u32x4*)(A + (size_t)row * 256 + col), y1 = *(const u32x4*)(A + (size_t)row * 256 + col + 8);
            const unsigned yy[8] = {y0.x, y0.y, y0.z, y0.w, y1.x, y1.y, y1.z, y1.w};
            float v[16];
#pragma unroll
            for (int e = 0; e < 16; ++e) {
                const float y = (e & 1) ? bfhi(yy[e >> 1]) : bflo(yy[e >> 1]);
                v[e] = y * sigm(acc[mi][e >> 2][e & 3] + gb[col + e]);
            }
            store16bf(O + (size_t)row * 256 + col, v);
        }
    }
}

struct G8Branch {
    static constexpr bool GATHER = false;
    const char* ws;
    __device__ __forceinline__ bool next(int i, G8Unit& u, const int (&R)[2], const unsigned (&C2)[2]) const {
        const int T = i / 6, sub = i - T * 6, L = T * (int)gridDim.x + (int)blockIdx.x;
        if (L >= (NTOK / 256) * 4) return false;
        int pm, pn; tile_coords(L, NTOK / 256, 4, pm, pn); pm = __builtin_amdgcn_readfirstlane(pm); pn = __builtin_amdgcn_readfirstlane(pn);
        const int br = sub >> 1;
        if (sub & 1) { u.K2 = 2048u; u.nt = 16; u.A0 = ws + OFF_H + (size_t)pm * 256 * 2048; u.B0 = ws + OFF_W + W_GB + (size_t)(br * 1024 + pn * 256) * 2048; }
        else {
            const unsigned k2 = br == 0 ? 1024u : 512u; u.K2 = k2; u.nt = br == 0 ? 8 : 4;
            const size_t b1 = (size_t)(br == 1), b2 = (size_t)(br == 2);
            const char* a = ws + (size_t)(OFF_C + C_ATT) + b1 * (size_t)(C_SGU - C_ATT) + b2 * (size_t)(C_S5O - C_ATT);
            const char* w = ws + (size_t)(OFF_W + W_A) + b1 * (size_t)(W_S - W_A) + b2 * (size_t)(W_5 - W_A);
            u.A0 = a + (size_t)pm * 256 * k2; u.B0 = w + (size_t)pn * 256 * k2;
        }
        u.A1 = u.A0 + (size_t)128 * u.K2; u.B1 = u.B0 + (size_t)128 * u.K2;
        u.x0 = pm; u.x1 = pn; u.x2 = sub; u.x3 = 0;
#pragma unroll
        for (int h = 0; h < 2; ++h)
#pragma unroll
            for (int k = 0; k < 2; ++k) u.ao[h][k] = (unsigned)R[k] * u.K2 + C2[k];
        return true;
    }
};
struct EpiBranch {
    bf16_t* Yt; bf16_t* Mg;
    __device__ __forceinline__ void operator()(const G8Acc& acc, const G8Unit& u, int wr, int wc, int fr, int fq) const {
        const int sub = u.x2;
        const size_t off0 = (size_t)(u.x0 * 256 + wr * 64 + fr) * 1024 + u.x1 * 256 + wc * 32 + 8 * fq;
        if (!(sub & 1)) {
#pragma unroll
            for (int ai = 0; ai < 2; ++ai)
#pragma unroll
                for (int m = 0; m < 4; ++m)
#pragma unroll
                    for (int bj = 0; bj < 2; ++bj) {
                        const f32x4 v0 = acc[ai][bj][m][0], v1 = acc[ai][bj][m][1];
                        u32x4 o; o.x = pk_bf16(v0[0], v0[1]); o.y = pk_bf16(v0[2], v0[3]); o.z = pk_bf16(v1[0], v1[1]); o.w = pk_bf16(v1[2], v1[3]);
                        *(u32x4*)(Yt + off0 + (size_t)(ai * 128 + m * 16) * 1024 + bj * 128) = o;
                    }
        } else {
#pragma unroll
            for (int ai = 0; ai < 2; ++ai) {
                u32x4 y[4][2], pv[4][2];
#pragma unroll
                for (int m = 0; m < 4; ++m)
#pragma unroll
                    for (int bj = 0; bj < 2; ++bj) {
                        const size_t off = off0 + (size_t)(ai * 128 + m * 16) * 1024 + bj * 128;
                        y[m][bj] = *(const u32x4*)(Yt + off);
                        pv[m][bj] = (u32x4){0u, 0u, 0u, 0u};
                        if (sub > 1) pv[m][bj] = *(const u32x4*)(Mg + off);
                    }
#pragma unroll
                for (int m = 0; m < 4; ++m)
#pragma unroll
                    for (int bj = 0; bj < 2; ++bj) {
                        const f32x4 v0 = acc[ai][bj][m][0], v1 = acc[ai][bj][m][1];
                        const u32x4 yy = y[m][bj], pp = pv[m][bj];
                        u32x4 o;
                        o.x = pk_bf16(sigm(v0[0]) * bflo(yy.x) + bflo(pp.x), sigm(v0[1]) * bfhi(yy.x) + bfhi(pp.x));
                        o.y = pk_bf16(sigm(v0[2]) * bflo(yy.y) + bflo(pp.y), sigm(v0[3]) * bfhi(yy.y) + bfhi(pp.y));
                        o.z = pk_bf16(sigm(v1[0]) * bflo(yy.z) + bflo(pp.z), sigm(v1[1]) * bfhi(yy.z) + bfhi(pp.z));
                        o.w = pk_bf16(sigm(v1[2]) * bflo(yy.w) + bflo(pp.w), sigm(v1[3]) * bfhi(yy.w) + bfhi(pp.w));
                        *(u32x4*)(Mg + off0 + (size_t)(ai * 128 + m * 16) * 1024 + bj * 128) = o;
                    }
            }
        }
    }
};
__device__ __forceinline__ void phase_branch(CKP& p, int l, unsigned char* lds) {
    G8Branch S{(const char*)p.ws};
    EpiBranch E{(bf16_t*)(p.ws + OFF_R), (bf16_t*)(p.ws + OFF_M)};
    g8_phase(S, E);
}

struct EpiMix {
    bf16_t* x;
    __device__ __forceinline__ void operator()(const G8Acc& acc, const G8Unit& u, int wr, int wc, int fr, int fq) const {
        bf16_t* xp0 = x + (size_t)(u.x0 * 256 + wr * 64 + fr) * 1024 + u.x1 * 256 + wc * 32 + 8 * fq;
#pragma unroll
        for (int ai = 0; ai < 2; ++ai) {
            u32x4 xv[4][2];
#pragma unroll
            for (int m = 0; m < 4; ++m)
#pragma unroll
                for (int bj = 0; bj < 2; ++bj) xv[m][bj] = *(const u32x4*)(xp0 + (size_t)(ai * 128 + m * 16) * 1024 + bj * 128);
#pragma unroll
            for (int m = 0; m < 4; ++m)
#pragma unroll
                for (int bj = 0; bj < 2; ++bj) {
                    const f32x4 a0 = acc[ai][bj][m][0], a1 = acc[ai][bj][m][1]; const u32x4 xx = xv[m][bj];
                    u32x4 o;
                    o.x = pk_bf16(bflo(xx.x) + a0[0], bfhi(xx.x) + a0[1]); o.y = pk_bf16(bflo(xx.y) + a0[2], bfhi(xx.y) + a0[3]);
                    o.z = pk_bf16(bflo(xx.z) + a1[0], bfhi(xx.z) + a1[1]); o.w = pk_bf16(bflo(xx.w) + a1[2], bfhi(xx.w) + a1[3]);
                    *(u32x4*)(xp0 + (size_t)(ai * 128 + m * 16) * 1024 + bj * 128) = o;
                }
        }
    }
};
__device__ __forceinline__ void phase_mix(CKP& p, int l, unsigned char* lds) {
    G8Plain S{(const char*)(p.ws + OFF_M), (const char*)(p.ws + OFF_W + W_M), 2048u, 16, NTOK / 256, 4};
    EpiMix E{(bf16_t*)(p.ws + OFF_X)};
    g8_phase(S, E);
}

__device__ __forceinline__ void phase_router(CKP& p, int l, unsigned char* lds, unsigned* ctl) {
    const int tid = opaque_tid(), lane = tid & 63, w = tid >> 6, wm = w >> 1, wn = w & 1, fr = lane & 15, fq = lane >> 4;
    int t512 = TIDX(); asm volatile("" : "+v"(t512));
    const int half = t512 >> 8, w8 = t512 >> 6;
    const float* gam = p.in[27] + (size_t)l * 1024;
    const float* bg = p.in[29] + (size_t)l * 4;
    const float* be = p.in[31] + (size_t)l * 32;
    const bf16_t* xres = (const bf16_t*)(p.ws + OFF_X);
    bf16_t* h2 = (bf16_t*)(p.ws + OFF_M);
    bf16_t* hlo = (bf16_t*)(p.ws + OFF_H);
    const bf16_t* Wh = (const bf16_t*)(p.ws + OFF_W + W_RH);
    const bf16_t* Wl = (const bf16_t*)(p.ws + OFF_W + W_RL);
    unsigned* cnt = ctl + CTL_MOECNT + l * 32;
    int* list = (int*)(p.ws + OFF_MOE + MOE_LIST);
    float* wsl = (float*)(p.ws + OFF_MOE + MOE_WS);
    unsigned char* lds0 = lds_base();
    float* lg = (float*)lds0;
    float* xch = (float*)(lds0 + VB_LDS);
    int* lc = (int*)(lds0 + 18432); int* gbs = (int*)(lds0 + 18432 + 128);
    for (int tile = blockIdx.x; tile < NTOK / 128; tile += gridDim.x) {
        const int r0 = tile * 128;
        {
            f32x4 gv[4];
#pragma unroll
            for (int i = 0; i < 4; ++i) gv[i] = *(const f32x4*)(gam + 4 * lane + 256 * i);
            for (int rr = 0; rr < 16; rr += 2) {
                const int row = r0 + w8 * 16 + rr;
                f32x4 xa[4], xb[4]; float sa = 0.f, sb = 0.f;
#pragma unroll
                for (int i = 0; i < 4; ++i) { const u32x2 ua = *(const u32x2*)(xres + (size_t)row * 1024 + 4 * lane + 256 * i), ub = *(const u32x2*)(xres + (size_t)(row + 1) * 1024 + 4 * lane + 256 * i);
                                              xa[i] = (f32x4){bflo(ua.x), bfhi(ua.x), bflo(ua.y), bfhi(ua.y)}; xb[i] = (f32x4){bflo(ub.x), bfhi(ub.x), bflo(ub.y), bfhi(ub.y)}; }
#pragma unroll
                for (int i = 0; i < 4; ++i) { sa += xa[i][0] * xa[i][0] + xa[i][1] * xa[i][1] + xa[i][2] * xa[i][2] + xa[i][3] * xa[i][3]; sb += xb[i][0] * xb[i][0] + xb[i][1] * xb[i][1] + xb[i][2] * xb[i][2] + xb[i][3] * xb[i][3]; }
                sa = wave_sum(sa); sb = wave_sum(sb);
                const float ra_ = rsqrtf(sa * (1.f / 1024.f) + RMS_EPS), rb_ = rsqrtf(sb * (1.f / 1024.f) + RMS_EPS);
#pragma unroll
                for (int i = 0; i < 4; ++i) {
                    const f32x4 ha = xa[i] * ra_ * gv[i], hb = xb[i] * rb_ * gv[i];
                    u32x2 oa, ob, la, lb;
                    oa.x = pk_bf16(ha[0], ha[1]); oa.y = pk_bf16(ha[2], ha[3]); ob.x = pk_bf16(hb[0], hb[1]); ob.y = pk_bf16(hb[2], hb[3]);
                    la.x = pk_bf16(ha[0] - bflo(oa.x), ha[1] - bfhi(oa.x)); la.y = pk_bf16(ha[2] - bflo(oa.y), ha[3] - bfhi(oa.y));
                    lb.x = pk_bf16(hb[0] - bflo(ob.x), hb[1] - bfhi(ob.x)); lb.y = pk_bf16(hb[2] - bflo(ob.y), hb[3] - bfhi(ob.y));
                    *(u32x2*)(h2 + (size_t)row * 1024 + 4 * lane + 256 * i) = oa; *(u32x2*)(h2 + (size_t)(row + 1) * 1024 + 4 * lane + 256 * i) = ob;
                    *(u32x2*)(hlo + (size_t)row * 1024 + 4 * lane + 256 * i) = la; *(u32x2*)(hlo + (size_t)(row + 1) * 1024 + 4 * lane + 256 * i) = lb;
                }
            }
        }
        asm volatile("s_waitcnt vmcnt(0)" ::: "memory");
        __syncthreads();
        f32x4 acc[4][4]; zero_acc(acc);
        {
            const bf16_t* A1 = half ? hlo : h2;
            gemm_kloop(acc, [&](int r) { return A1 + (size_t)(r0 + r) * 1024; }, 64, [&](int v) { return Wh + (size_t)(v < 63 ? v : 63) * 1024; }, 64, 16, lds, tid);
            const int ko = half * 512;
            gemm_kloop(acc, [&](int r) { return h2 + (size_t)(r0 + r) * 1024 + ko; }, 64, [&](int v) { return Wl + (size_t)(v < 63 ? v : 63) * 1024 + ko; }, 64, 8, lds, tid);
        }
        __syncthreads();
        int lbase = (64 * wm + fr) * 36 + 16 * fq; asm volatile("" : "+v"(lbase));
        if (half == 1 && wn == 0 && fq < 3) {
#pragma unroll
            for (int mi = 0; mi < 4; ++mi)
#pragma unroll
                for (int e = 0; e < 16; ++e) if (e < 4 || fq < 2) xch[lbase + mi * 576 + e] = acc[mi][e >> 2][e & 3];
        }
        __syncthreads();
        if (half == 0 && tid < 32) lc[tid] = 0;
        if (half == 0 && wn == 0 && fq < 3) {
#pragma unroll
            for (int mi = 0; mi < 4; ++mi)
#pragma unroll
                for (int e = 0; e < 16; ++e) if (e < 4 || fq < 2) lg[lbase + mi * 576 + e] = acc[mi][e >> 2][e & 3] + xch[lbase + mi * 576 + e];
        }
        __syncthreads();
        int e0 = 0, e1 = 0, lr0 = 0, lr1 = 0; float c0 = 0.f, c1 = 0.f;
        if (half == 0 && tid < 128) {
            const float* lrow = lg + tid * 36;
            float gl[4]; int grp = 0; float gm = -3.4e38f;
#pragma unroll
            for (int q = 0; q < 4; ++q) { gl[q] = lrow[q] + bg[q]; if (gl[q] > gm) { gm = gl[q]; grp = q; } }
            float gsum = 0.f;
#pragma unroll
            for (int q = 0; q < 4; ++q) gsum += expf(gl[q] - gm);
            const float grp_w = 1.f / gsum;
            float el[8]; float em = -3.4e38f;
#pragma unroll
            for (int q = 0; q < 8; ++q) { el[q] = lrow[4 + grp * 8 + q] + be[grp * 8 + q]; em = fmaxf(em, el[q]); }
            float esum = 0.f; float ep[8];
#pragma unroll
            for (int q = 0; q < 8; ++q) { ep[q] = expf(el[q] - em); esum += ep[q]; }
            int j0 = 0; float p0 = -1.f;
#pragma unroll
            for (int q = 0; q < 8; ++q) { const float pq = ep[q] / esum; ep[q] = pq; if (pq > p0) { p0 = pq; j0 = q; } }
            int j1 = 0; float p1 = -1.f;
#pragma unroll
            for (int q = 0; q < 8; ++q) { if (q != j0 && ep[q] > p1) { p1 = ep[q]; j1 = q; } }
            const float den = p0 + p1;
            c0 = grp_w * p0 / den; c1 = grp_w * p1 / den;
            e0 = grp * 8 + j0; e1 = grp * 8 + j1;
            lr0 = atomicAdd(&lc[e0], 1); lr1 = atomicAdd(&lc[e1], 1);
        }
        __syncthreads();
        if (half == 0 && tid < 32) { const int n = lc[tid]; gbs[tid] = n ? (int)atomicAdd(&cnt[tid], (unsigned)n) : 0; }
        __syncthreads();
        if (half == 0 && tid < 128) {
            const int tok = r0 + tid;
            list[e0 * 32768 + gbs[e0] + lr0] = tok * 2; list[e1 * 32768 + gbs[e1] + lr1] = tok * 2 + 1;
            wsl[tok * 2] = c0; wsl[tok * 2 + 1] = c1;
        }
        __syncthreads();
    }
}

__device__ __forceinline__ bool moe_unit(const unsigned* cnt, int i, int& e, int& mt, int& sub, int& rowbase, int& n) {
    int lane = lane_id(); asm volatile("" : "+v"(lane));
    const int c = (lane < 32) ? (int)cnt[lane] : 0;
    const int nt = (c + 255) >> 8, nt128 = (c + 127) >> 7;
    int pre = nt, pre128 = nt128;
#pragma unroll
    for (int o = 1; o < 32; o <<= 1) {
        const int src = (lane - o) << 2;
        const int v = __builtin_amdgcn_ds_bpermute(src, pre), v2 = __builtin_amdgcn_ds_bpermute(src, pre128);
        if (lane >= o) { pre += v; pre128 += v2; }
    }
    const int total = __builtin_amdgcn_readlane(pre, 31) * 4;
    const int Lp = i * (int)gridDim.x + (int)blockIdx.x, q = (total + 7) >> 3, off = Lp >> 3;
    const int L = (Lp & 7) * q + off;
    if (off >= q || L >= total) return false;
    const int excl = pre - nt;
    const bool mine = (lane < 32) && (L >= excl * 4) && (L < pre * 4);
    const unsigned long long bal = __ballot(mine);
    if (bal == 0ull) return false;
    const int ee = __builtin_amdgcn_readfirstlane(__ffsll((long long)bal) - 1);
    e = ee;
    n = __builtin_amdgcn_readlane(c, ee);
    rowbase = __builtin_amdgcn_readlane(pre128 - nt128, ee) * 128;
    const int r = L - __builtin_amdgcn_readlane(excl, ee) * 4;
    mt = r >> 2; sub = r & 3;
    return true;
}
struct G8Exp1 {
    static constexpr bool GATHER = true;
    const unsigned* cnt; const int* list; const char* h2; const char* Wg; const char* Wu;
    __device__ __forceinline__ bool next(int i, G8Unit& u, const int (&R)[2], const unsigned (&C2)[2]) const {
        int e, mt, sub, rowbase, n;
        if (!moe_unit(cnt, i, e, mt, sub, rowbase, n)) return false;
        u.A0 = h2; u.A1 = h2; u.K2 = 2048u; u.nt = 16;
        u.B0 = Wg + ((size_t)e * 512 + sub * 128) * 2048; u.B1 = Wu + ((size_t)e * 512 + sub * 128) * 2048;
        u.x0 = e; u.x1 = mt; u.x2 = sub; u.x3 = rowbase; u.n = n;
#pragma unroll
        for (int h = 0; h < 2; ++h)
#pragma unroll
            for (int k = 0; k < 2; ++k) { int sidx = mt * 256 + h * 128 + R[k]; sidx = sidx < n ? sidx : n - 1; u.ao[h][k] = (unsigned)(list[e * 32768 + sidx] >> 1) * 2048u + C2[k]; }
        return true;
    }
};
struct EpiExp1 {
    bf16_t* hid;
    __device__ __forceinline__ void operator()(const G8Acc& acc, const G8Unit& u, int wr, int wc, int fr, int fq) const {
#pragma unroll
        for (int ai = 0; ai < 2; ++ai)
#pragma unroll
            for (int m = 0; m < 4; ++m) {
                const int r = u.x1 * 256 + ai * 128 + wr * 64 + m * 16 + fr;
                if (r < u.n) {
                    float hv[8];
#pragma unroll
                    for (int j = 0; j < 8; ++j) { const float g = acc[ai][0][m][j >> 2][j & 3], up = acc[ai][1][m][j >> 2][j & 3]; hv[j] = g * sigm(g) * up; }
                    u32x4 o; o.x = pk_bf16(hv[0], hv[1]); o.y = pk_bf16(hv[2], hv[3]); o.z = pk_bf16(hv[4], hv[5]); o.w = pk_bf16(hv[6], hv[7]);
                    *(u32x4*)(hid + (size_t)(u.x3 + r) * 512 + u.x2 * 128 + wc * 32 + 8 * fq) = o;
                }
            }
    }
};
__device__ __forceinline__ void phase_exp1(CKP& p, int l, unsigned char* lds, unsigned* ctl) {
    G8Exp1 S{ctl + CTL_MOECNT + l * 32, (const int*)(p.ws + OFF_MOE + MOE_LIST), (const char*)(p.ws + OFF_M), (const char*)(p.ws + OFF_W + W_EG), (const char*)(p.ws + OFF_W + W_EU)};
    EpiExp1 E{(bf16_t*)(p.ws + OFF_HID)};
    g8_phase(S, E);
}
struct G8Exp2 {
    static constexpr bool GATHER = true;
    const unsigned* cnt; const char* hid; const char* Wd;
    __device__ __forceinline__ bool next(int i, G8Unit& u, const int (&R)[2], const unsigned (&C2)[2]) const {
        int e, mt, sub, rowbase, n;
        if (!moe_unit(cnt, i, e, mt, sub, rowbase, n)) return false;
        u.A0 = hid + (size_t)(rowbase + mt * 256) * 1024; u.A1 = u.A0; u.K2 = 1024u; u.nt = 8;
        u.B0 = Wd + ((size_t)e * 1024 + sub * 256) * 1024; u.B1 = u.B0 + (size_t)128 * 1024;
        u.x0 = e; u.x1 = mt; u.x2 = sub; u.x3 = rowbase; u.n = n;
        const int lim = n - mt * 256 - 1;
#pragma unroll
        for (int h = 0; h < 2; ++h)
#pragma unroll
            for (int k = 0; k < 2; ++k) { const int rr = h * 128 + R[k]; u.ao[h][k] = (unsigned)(rr < lim ? rr : lim) * 1024u + C2[k]; }
        return true;
    }
};
struct EpiExp2 {
    const int* list; const float* wsl; bf16_t* ys;
    __device__ __forceinline__ void operator()(const G8Acc& acc, const G8Unit& u, int wr, int wc, int fr, int fq) const {
        int slot[2][4]; float wt[2][4];
#pragma unroll
        for (int ai = 0; ai < 2; ++ai)
#pragma unroll
            for (int m = 0; m < 4; ++m) { int r = u.x1 * 256 + ai * 128 + wr * 64 + m * 16 + fr; r = r < u.n ? r : u.n - 1; slot[ai][m] = list[u.x0 * 32768 + r]; }
#pragma unroll
        for (int ai = 0; ai < 2; ++ai)
#pragma unroll
            for (int m = 0; m < 4; ++m) wt[ai][m] = wsl[slot[ai][m]];
#pragma unroll
        for (int ai = 0; ai < 2; ++ai)
#pragma unroll
            for (int m = 0; m < 4; ++m) {
                const int r = u.x1 * 256 + ai * 128 + wr * 64 + m * 16 + fr;
                if (r < u.n) {
                    bf16_t* dst = ys + (size_t)slot[ai][m] * 1024 + u.x2 * 256 + wc * 32 + 8 * fq;
                    const float w = wt[ai][m];
#pragma unroll
                    for (int bj = 0; bj < 2; ++bj) {
                        const f32x4 v0 = acc[ai][bj][m][0] * w, v1 = acc[ai][bj][m][1] * w;
                        u32x4 o; o.x = pk_bf16(v0[0], v0[1]); o.y = pk_bf16(v0[2], v0[3]); o.z = pk_bf16(v1[0], v1[1]); o.w = pk_bf16(v1[2], v1[3]);
                        *(u32x4*)(dst + bj * 128) = o;
                    }
                }
            }
    }
};
__device__ __forceinline__ void phase_exp2(CKP& p, int l, unsigned char* lds, unsigned* ctl) {
    G8Exp2 S{ctl + CTL_MOECNT + l * 32, (const char*)(p.ws + OFF_HID), (const char*)(p.ws + OFF_W + W_ED)};
    EpiExp2 E{(const int*)(p.ws + OFF_MOE + MOE_LIST), (const float*)(p.ws + OFF_MOE + MOE_WS), (bf16_t*)(p.ws + OFF_YS)};
    g8_phase(S, E);
}

constexpr int PH_PER_LAYER = 10;
constexpr int NPHASE = PH_PER_LAYER * DEPTH + 1;

__global__ __attribute__((target("no-packed-fp32-ops"))) void __launch_bounds__(NTHR_HW, 1) mega(KP p_unused) {
    extern __shared__ __attribute__((aligned(16))) unsigned char lds_all[];
    if ((threadIdx.x & 255) == 0) *(volatile unsigned*)(lds_all + VB_CTR + ((threadIdx.x >> 8) << 6)) = 0u;
    if ((threadIdx.x & 63) == 0) *(volatile unsigned char*)(lds_all + VB_CTR + 192 + hw_wave_key()) = (unsigned char)(threadIdx.x >> 6);
    __syncthreads();
    unsigned* ctl = (unsigned*)(p_unused.ws + OFF_CTL);
#if ONE_LAUNCH
    XcdBarrier xb = xcd_barrier_post(ctl + CTL_BAR, (volatile LAS unsigned*)(lds_all + VB_CTR + 128));
    if (p_unused.never) cg::this_grid().sync();
#if DBG_PREFLUSH
    __builtin_amdgcn_fence(__ATOMIC_RELEASE, "");
    asm volatile("s_waitcnt vmcnt(0)" ::: "memory");
    __builtin_amdgcn_fence(__ATOMIC_ACQUIRE, "");
    asm volatile("s_waitcnt vmcnt(0)" ::: "memory");
    xcd_barrier(xb);
    { const unsigned long long t0 = __builtin_amdgcn_s_memrealtime(); while (__builtin_amdgcn_s_memrealtime() - t0 < 20000ull) __builtin_amdgcn_s_sleep(8); }
    xcd_barrier(xb);
#endif
#endif
    CKP* kp0 = (CKP*)__builtin_amdgcn_kernarg_segment_ptr();
    const int ph_lo = kp0->ph_lo, ph_hi = kp0->ph_hi;
#if ONE_LAUNCH
#define PH_SYNC(PH) if ((PH) + 1 < ph_hi) xcd_barrier(xb);
#else
#define PH_SYNC(PH)
#endif
#if DBG_TIMEPH >= 0
#define PH_STAMP(PH) if (blockIdx.x == 0 && TIDX() == 0) ((unsigned long long*)(kp0->ws + OFF_CTL + 24576))[(PH)] = __builtin_amdgcn_s_memrealtime();
#else
#define PH_STAMP(PH)
#endif
#define RUN_PHASE(PH, CALL) if (ph_lo <= (PH) && (PH) < ph_hi) { PH_STAMP(PH) CKP* kp = kp0; asm volatile("" : "+s"(kp)); CKP& p = *kp; const int rep_ = 0; (void)rep_; unsigned char* lds = vb_lds(); CALL; \
    if ((PH) == DBG_REPEAT_PH) { xcd_barrier(xb); const int rep_ = 1; (void)rep_; CALL; } PH_SYNC(PH) }
#define RUN_LAYER(L) \
    RUN_PHASE((L) * 10 + 0, phase_prep(p, (L), lds)) \
    RUN_PHASE((L) * 10 + 1, phase_inproj(p, (L), lds)) \
    RUN_PHASE((L) * 10 + 2, phase_mid1(p, (L), lds)) \
    RUN_PHASE((L) * 10 + 3, phase_attn(p, (L), lds, ctl + 2 * rep_)) \
    RUN_PHASE((L) * 10 + 4, phase_glu(p, (L), lds)) \
    RUN_PHASE((L) * 10 + 5, phase_branch(p, (L), lds)) \
    RUN_PHASE((L) * 10 + 6, phase_mix(p, (L), lds)) \
    RUN_PHASE((L) * 10 + 7, phase_router(p, (L), lds, ctl)) \
    RUN_PHASE((L) * 10 + 8, phase_exp1(p, (L), lds, ctl)) \
    RUN_PHASE((L) * 10 + 9, phase_exp2(p, (L), lds, ctl))
#if DBG_SMALLK
    RUN_PHASE(0, phase_prep(p, 0, lds))
    RUN_PHASE(1, phase_inproj(p, 0, lds))
    RUN_PHASE(2, phase_mid1(p, 0, lds))
#else
    RUN_LAYER(0)
    RUN_LAYER(1)
    RUN_PHASE(20, phase_prep(p, 2, lds))
#endif
#if ONE_LAUNCH && DBG_DUMP
    {
        xcd_barrier(xb);
        CKP* kp = kp0; asm volatile("" : "+s"(kp)); CKP& p = *kp;
        const size_t NO = (size_t)NTOK * 1024;
        const unsigned char* src = p.ws + DBG_DUMP_OFF;
        for (size_t i = (size_t)blockIdx.x * NTHR_HW + threadIdx.x; i < NO; i += (size_t)gridDim.x * NTHR_HW) {
            float v = 0.f;
            if (i < (size_t)DBG_DUMP_N) {
                if (DBG_DUMP_F32) {
                    const size_t si = DBG_DUMP_REV ? ((size_t)DBG_DUMP_N - 1 - i) : i;
#if DBG_SC1READ
                    const unsigned fu = __hip_atomic_load((const unsigned*)src + si, __ATOMIC_RELAXED, __HIP_MEMORY_SCOPE_SYSTEM); const float f = __uint_as_float(fu);
#else
                    const float f = ((const float*)src)[si];
#endif
                    v = DBG_HASH ? (float)(__float_as_uint(f) & 0x3ff) : f;
#if DBG_EFILT
                    { const int id_ = (int)(((si >> 7) - DBG_IDROT) & 2047), blk = ((id_ >> 2) + 320) & 511; if (!(blk >= DBG_EFILT_LO && blk < DBG_EFILT_HI)) v = 0.f; }
#endif
#if DBG_E2
                    { const float f2 = ((const float*)(p.ws + OFF_C + C_ATT))[i]; v = (__float_as_uint(f2) == __float_as_uint(f)) ? 0.f : 1000.f; if (i == 0) v += 1.f; }
#endif
                }
                else { const bf16_t h = ((const bf16_t*)src)[i]; v = DBG_HASH ? (float)(h & 0x3ff) : bf2f(h); }
            }
#if DBG_CONSTOUT
            v = 1000.f + (float)(i & 1023);
#endif
            p.xbuf[i] = v;
        }
    }
#endif
}

#if DBG_DUMP
__global__ void dbg_dump(const bf16_t* src, size_t n, float* out, size_t nout) {
    for (size_t i = (size_t)blockIdx.x * blockDim.x + threadIdx.x; i < nout; i += (size_t)gridDim.x * blockDim.x)
        out[i] = i < n ? (DBG_HASH ? (float)(src[i] & 0x3ff) : bf2f(src[i])) : 0.f;
}
__global__ void dbg_dump_f32(const float* src, size_t n, float* out, size_t nout) {
    for (size_t i = (size_t)blockIdx.x * blockDim.x + threadIdx.x; i < nout; i += (size_t)gridDim.x * blockDim.x)
        out[i] = i < n ? (DBG_HASH ? (float)(__float_as_uint(src[i]) & 0x3ff) : src[i]) : 0.f;
}
#endif
extern "C" void kernel_launch(void* const* d_in, const int* in_sizes, int n_in, void* d_out, int out_size, void* d_ws, size_t ws_size, hipStream_t stream) {
    static int grid = 0;
    if (grid == 0) {
        if (n_in != 36 || out_size != NTOK * DM || ws_size < WS_END) { fprintf(stderr, "kernel_launch: unexpected shapes n_in %d out %d ws %zu (need %zu)\n", n_in, out_size, ws_size, (size_t)WS_END); grid = -1; return; }
        int dev = 0, cus = 0, per_cu = 0;
        hipGetDevice(&dev);
        hipDeviceGetAttribute(&cus, hipDeviceAttributeMultiprocessorCount, dev);
        hipFuncSetAttribute((const void*)mega, hipFuncAttributeMaxDynamicSharedMemorySize, LDS_BYTES);
        hipOccupancyMaxActiveBlocksPerMultiprocessor(&per_cu, (const void*)mega, NTHR_HW, LDS_BYTES);
        if (per_cu < 1) { fprintf(stderr, "kernel_launch: occupancy query says %d\n", per_cu); per_cu = 1; }
        if (per_cu > MAX_PER_CU) per_cu = MAX_PER_CU;
        grid = cus * per_cu;
        fprintf(stderr, "kernel_launch: grid %d (%d CUs x %d)\n", grid, cus, per_cu);
    }
    if (grid < 0) return;
    hipMemsetAsync((char*)d_ws + OFF_CTL, 0, CTL_BYTES, stream);
    KP p{};
    for (int i = 0; i < 36; ++i) p.in[i] = (const float*)d_in[i];
    p.xbuf = (float*)d_out; p.ws = (unsigned char*)d_ws;
    for (int i = 0; i < 8; ++i) p.inv_freq[i] = (float)pow(500000.0, -(double)i / 8.0);
    p.never = 0; p.pad = 0;
#if ONE_LAUNCH
    p.ph_lo = 0; p.ph_hi = DBG_PH_HI;
    void* args[] = {&p};
    hipError_t e = hipLaunchCooperativeKernel((const void*)mega, dim3(grid), dim3(NTHR_HW), args, LDS_BYTES, stream);
    if (e != hipSuccess) fprintf(stderr, "cooperative launch failed: %s (grid %d)\n", hipGetErrorString(e), grid);
#else
    for (int ph = 0; ph < NPHASE; ++ph) {
        if (!((DBG_MASK >> ph) & 1)) continue;
        p.ph_lo = ph; p.ph_hi = ph + 1;
        hipLaunchKernelGGL(mega, dim3(grid), dim3(NTHR_HW), LDS_BYTES, stream, p);
    }
#if DBG_DUMP
    {
        const unsigned char* w = (const unsigned char*)d_ws; const size_t NO = (size_t)NTOK * 1024;
        size_t off = 0, n = 0; bool f32 = false;
        switch (DBG_DUMP) {
            case 1: off = OFF_C + C_ATT; n = (size_t)NTOK * 512; break;
            case 2: off = OFF_C + C_SGU; n = (size_t)NTOK * 256; break;
            case 3: off = OFF_C + C_S5O; n = (size_t)NTOK * 256; break;
            case 4: off = OFF_M; n = (size_t)NTOK * 1024; break;
            case 5: off = OFF_R + R_Q; n = (size_t)NTOK * 512; break;
            case 6: off = OFF_H; n = (size_t)NTOK * 1024; break;
            case 7: off = OFF_C + C_YG; n = (size_t)NTOK * 256; break;
            case 8: off = OFF_C + C_KCMP; n = (size_t)2 * 524288 / 2; break;
            case 9: off = OFF_R + R_KC; n = (size_t)NTOK * 128 * 6; break;
            case 10: off = OFF_R + R_NG; n = (size_t)NTOK * 24; f32 = true; break;
            case 11: off = OFF_R + R_U; n = (size_t)NTOK * 768; break;
            case 12: off = OFF_C + C_S5E; n = (size_t)128 * 16 * 64 * 2; f32 = true; break;
            case 15: off = 0; n = (size_t)NTOK * 1024; f32 = true; break;
            case 16: off = OFF_W + W_S5A; n = 36864; f32 = true; break;
            case 13: off = OFF_YS; n = (size_t)NTOK * 1024; break;
            case 14: off = OFF_MOE + MOE_WS; n = 65536; f32 = true; break;
            default: break;
        }
        if (DBG_DUMP == 15) hipLaunchKernelGGL(dbg_dump_f32, dim3(2048), dim3(256), 0, stream, (const float*)d_out, n, (float*)d_out, NO);
        else if (f32) hipLaunchKernelGGL(dbg_dump_f32, dim3(2048), dim3(256), 0, stream, (const float*)(w + off), n, (float*)d_out, NO);
        else hipLaunchKernelGGL(dbg_dump, dim3(2048), dim3(256), 0, stream, (const bf16_t*)(w + off), n, (float*)d_out, NO);
    }
#endif
#endif
}
```

```cpp
#include <hip/hip_runtime.h>
#include <hip/hip_cooperative_groups.h>
#include <cstdio>
#include <cstdint>
#include <cmath>
#include <type_traits>
namespace cg = cooperative_groups;

#ifndef ONE_LAUNCH
#define ONE_LAUNCH 1
#endif
#ifndef DBG_MASK
#define DBG_MASK 0x1fffff
#endif
#ifndef DBG_NOCOMBINE
#define DBG_NOCOMBINE 0
#endif
#ifndef DBG_DUMP
#define DBG_DUMP 0
#endif
#ifndef DBG_HASH
#define DBG_HASH 0
#endif
#ifndef DBG_ONLYS5
#define DBG_ONLYS5 0
#endif
#ifndef DBG_NOCSTORE
#define DBG_NOCSTORE 0
#endif
#ifndef DBG_LDSCHK
#define DBG_LDSCHK 0
#endif
#ifndef DBG_TWICE
#define DBG_TWICE 0
#endif
#ifndef DBG_S5CONST
#define DBG_S5CONST 0
#endif
#ifndef DBG_SC1READ
#define DBG_SC1READ 0
#endif
#ifndef DBG_E2
#define DBG_E2 0
#endif
#ifndef DBG_JOBFENCE
#define DBG_JOBFENCE 0
#endif
#ifndef DBG_CONSTOUT
#define DBG_CONSTOUT 0
#endif
#ifndef DBG_QDELAY
#define DBG_QDELAY 0
#endif
#ifndef DBG_SMALLK
#define DBG_SMALLK 0
#endif
#ifndef DBG_REPEAT_PH
#define DBG_REPEAT_PH -1
#endif
#ifndef DBG_TIMEPH
#define DBG_TIMEPH -1
#endif
#ifndef DBG_TIMEPH2
#define DBG_TIMEPH2 (DBG_TIMEPH + 1)
#endif
#ifndef DBG_PRESPIN
#define DBG_PRESPIN 0
#endif
#ifndef DBG_SGUSPIN
#define DBG_SGUSPIN 0
#endif
#ifndef DBG_PREFLUSH
#define DBG_PREFLUSH 0
#endif
#ifndef DBG_ESC1
#define DBG_ESC1 0
#endif
#ifndef DBG_DELAY
#define DBG_DELAY 0
#endif
#ifndef DBG_IDROT
#define DBG_IDROT 0
#endif
#ifndef DBG_DUMP_REV
#define DBG_DUMP_REV 0
#endif
#ifndef DBG_SGUCUT
#define DBG_SGUCUT 0
#endif
#ifndef DBG_EFILT
#define DBG_EFILT 0
#define DBG_EFILT_LO 0
#define DBG_EFILT_HI 0
#endif
#ifndef DBG_DUMP_OFF
#define DBG_DUMP_OFF 0
#define DBG_DUMP_N 0
#define DBG_DUMP_F32 0
#endif
#ifndef DBG_PH_HI
#define DBG_PH_HI NPHASE
#endif

typedef unsigned short bf16_t;
typedef short bf16x8 __attribute__((ext_vector_type(8)));
typedef float f32x4 __attribute__((ext_vector_type(4)));
typedef unsigned u32x4 __attribute__((ext_vector_type(4)));
typedef unsigned u32x2 __attribute__((ext_vector_type(2)));

constexpr int DM = 1024, NB = 8, SEQ = 4096, NTOK = NB * SEQ, DEPTH = 2;
constexpr int NCMP = 255;
constexpr float RMS_EPS = 1e-6f;
constexpr int NTHR = 256;
constexpr int NTHR_HW = 512;
constexpr int VB_LDS = 68096;
constexpr int LDS_BAR = 67584;
#ifndef MAX_PER_CU
#define MAX_PER_CU 1
#endif
#ifndef LDS_TOTAL
#define LDS_TOTAL (2 * 68096 + 256)
#endif
constexpr int LDS_BYTES = LDS_TOTAL;

constexpr size_t OFF_CTL = 0;
constexpr size_t OFF_W = 65536;
constexpr size_t W_IN = 0, W_GB = 4456448, W_A = 10747904, W_S = 11796480, W_5 = 12320768, W_M = 12845056, W_GLU = 14942208,
                 W_C1 = 15073280, W_C2 = 16121856, W_PB = 16154624, W_SGU = 16155648, W_S5A = 16286720, W_S5A256 = 16294912,
                 W_S5B = 16303104, W_S5C = 16434176, W_RH = 16499712, W_RL = 16630784, W_EG = 16777216, W_EU = 50331648, W_ED = 83886080, W_END = 117440512;
constexpr size_t OFF_H = OFF_W + W_END;
constexpr size_t OFF_M = OFF_H + 67108864;
constexpr size_t OFF_R = OFF_M + 67108864;
constexpr size_t R_Q = 0, R_KC = 33554432, R_VC = 41943040, R_KS = 50331648, R_KW = 58720256, R_VST = 67108864, R_VWT = 75497472,
                 R_NG = 83886080, R_U = 87031808, R_V = 103809024, R_S5IN = 120586240, R_QR = 137363456, R_END = 170917888;
constexpr size_t OFF_C = OFF_R + R_END;
constexpr size_t C_ATT = 0, C_SGU = 33554432, C_YG = 50331648, C_S5O = 67108864, C_KCMP = 83886080, C_VCT = 84410368, C_S5E = 84934656, C_END = 85983232;
constexpr size_t OFF_MOE = OFF_C + C_END;
constexpr size_t MOE_LIST = 0, MOE_WS = 4194304, MOE_RS = 4456448, MOE_END = 8650752;
constexpr size_t OFF_ROPE = OFF_MOE + MOE_END;
constexpr size_t OFF_X = OFF_ROPE + (size_t)NTOK * 64;
constexpr size_t OFF_RS1 = OFF_X + (size_t)NTOK * 2048;
constexpr size_t WS_END = OFF_RS1 + (size_t)NTOK * 4;
constexpr size_t OFF_HID = OFF_R;
constexpr size_t OFF_YS = OFF_R + 71303168;
static_assert(OFF_YS + 134217728 <= OFF_C + C_KCMP, "alias overflow");

constexpr int CTL_BAR = 0;
constexpr int CTL_MOECNT = 4096;
constexpr int CTL_ATTN = 4096 + 64;
constexpr int CTL_BYTES = 32768;

struct KP {
    const float* in[36];
    float* xbuf;
    unsigned char* ws;
    float inv_freq[8];
    int ph_lo, ph_hi;
    int never;
    int pad;
};

typedef const KP __attribute__((address_space(4))) CKP;

typedef float f32x2_t __attribute__((ext_vector_type(2)));
typedef __bf16 bf16x2_t __attribute__((ext_vector_type(2)));
__device__ __forceinline__ unsigned pk_bf16(float lo, float hi) {
    const f32x2_t v = {lo, hi};
    union { bf16x2_t b; unsigned u; } x; x.b = __builtin_convertvector(v, bf16x2_t); return x.u;
}
__device__ __forceinline__ bf16_t f2bf(float f) { return (bf16_t)(pk_bf16(f, 0.f) & 0xffffu); }
__device__ __forceinline__ float bf2f(bf16_t b) { return __uint_as_float(((unsigned)b) << 16); }
__device__ __forceinline__ float bflo(unsigned u) { return __uint_as_float(u << 16); }
__device__ __forceinline__ float bfhi(unsigned u) { return __uint_as_float(u & 0xffff0000u); }
__device__ __forceinline__ float fexp2(float x) { return __builtin_amdgcn_exp2f(x); }
__device__ __forceinline__ float gelu_tanh(float x) {
    const float u = 0.7978845608028654f * (x + 0.044715f * x * x * x);
    const float e = fexp2(2.885390081777927f * u);
    const float t = 1.f - 2.f * __builtin_amdgcn_rcpf(e + 1.f);
    return 0.5f * x * (1.f + t);
}
__device__ __forceinline__ float sigm(float x) { return __builtin_amdgcn_rcpf(1.f + fexp2(-1.4426950408889634f * x)); }
__device__ __forceinline__ unsigned char* lds_base();
__device__ __forceinline__ int lane_id() { unsigned z = 0u; asm volatile("" : "+v"(z)); return (int)__builtin_amdgcn_mbcnt_hi(~0u, __builtin_amdgcn_mbcnt_lo(~0u, z)); }
__device__ __forceinline__ int hw_wave_key() { return (int)(__builtin_amdgcn_s_getreg((5 << 11) | 4) & 63u); }
__device__ __forceinline__ int TIDX();
__device__ __forceinline__ unsigned bperm_u(int srclane, unsigned v) { return (unsigned)__builtin_amdgcn_ds_bpermute(srclane << 2, (int)v); }
__device__ __forceinline__ float bperm_f(int srclane, float v) { return __uint_as_float(bperm_u(srclane, __float_as_uint(v))); }
__device__ __forceinline__ int opaque_tid() { int t = TIDX() & 255; asm volatile("" : "+v"(t)); return t; }
__device__ __forceinline__ int VBID() { return (int)blockIdx.x * 2 + (TIDX() >> 8); }
__device__ __forceinline__ int VGRID() { return (int)gridDim.x * 2; }
constexpr int VB_CTR = 2 * 68096;
__device__ __forceinline__ unsigned char* lds_base() { extern __shared__ __attribute__((aligned(16))) unsigned char lds_all_[]; return lds_all_; }
__device__ __forceinline__ int TIDX() { const int wv = __builtin_amdgcn_readfirstlane((int)*(volatile unsigned char*)(lds_base() + VB_CTR + 192 + hw_wave_key())); return wv * 64 + lane_id(); }
__device__ __forceinline__ unsigned char* vb_lds() { int t = TIDX(); asm volatile("" : "+v"(t)); return lds_base() + (t >> 8) * VB_LDS; }
__device__ __forceinline__ void vb_sync(unsigned char* lds) {
    asm volatile("s_waitcnt lgkmcnt(0)" ::: "memory");
    if (lane_id() == 0) {
        __attribute__((address_space(3))) unsigned* c = (__attribute__((address_space(3))) unsigned*)(lds_base() + VB_CTR + ((lds != lds_base()) ? 64 : 0));
        const unsigned old = __hip_atomic_fetch_add(c, 1u, __ATOMIC_RELAXED, __HIP_MEMORY_SCOPE_WORKGROUP);
        const unsigned target = (old & ~3u) + 4u;
        while ((int)(__hip_atomic_load(c, __ATOMIC_RELAXED, __HIP_MEMORY_SCOPE_WORKGROUP) - target) < 0) { }
    }
    asm volatile("" ::: "memory");
}
__device__ __forceinline__ void job_fence() {
#if DBG_JOBFENCE
#endif
}
__device__ __forceinline__ float wave_sum(float v) {
#pragma unroll
    for (int o = 32; o >= 1; o >>= 1) v += __shfl_xor(v, o);
    return v;
}
__device__ __forceinline__ float xmax16(float x) { const unsigned u = __float_as_uint(x); auto r = __builtin_amdgcn_permlane16_swap(u, u, false, false); return fmaxf(__uint_as_float(r[0]), __uint_as_float(r[1])); }
__device__ __forceinline__ float xmax32(float x) { const unsigned u = __float_as_uint(x); auto r = __builtin_amdgcn_permlane32_swap(u, u, false, false); return fmaxf(__uint_as_float(r[0]), __uint_as_float(r[1])); }
__device__ __forceinline__ float xsum16(float x) { const unsigned u = __float_as_uint(x); auto r = __builtin_amdgcn_permlane16_swap(u, u, false, false); return __uint_as_float(r[0]) + __uint_as_float(r[1]); }
__device__ __forceinline__ float xsum32(float x) { const unsigned u = __float_as_uint(x); auto r = __builtin_amdgcn_permlane32_swap(u, u, false, false); return __uint_as_float(r[0]) + __uint_as_float(r[1]); }
__device__ __forceinline__ f32x4 mfma16(bf16x8 a, bf16x8 b, f32x4 c) { return __builtin_amdgcn_mfma_f32_16x16x32_bf16(a, b, c, 0, 0, 0); }
__device__ __forceinline__ bf16x8 as_bf8(u32x4 v) { union { u32x4 u; bf16x8 b; } x; x.u = v; return x.b; }
__device__ __forceinline__ void store16bf(bf16_t* dst, const float (&v)[16]) {
    u32x4 a, b;
    a.x = pk_bf16(v[0], v[1]); a.y = pk_bf16(v[2], v[3]); a.z = pk_bf16(v[4], v[5]); a.w = pk_bf16(v[6], v[7]);
    b.x = pk_bf16(v[8], v[9]); b.y = pk_bf16(v[10], v[11]); b.z = pk_bf16(v[12], v[13]); b.w = pk_bf16(v[14], v[15]);
    *(u32x4*)dst = a; *(u32x4*)(dst + 8) = b;
}

#ifndef XB_SCOPE
#define XB_SCOPE "agent"
#endif
#define XB_TMO      128
#define XB_XCNT(j)  (256  + 64 * (j))
#define XB_XSUB(j)  (1280 + 64 * (j))
#define XB_XGEN(j)  (2304 + 64 * (j))
#define XB_TOP      3328
#define XB_TOPGEN   3392
#define XCD_BAR_WORDS 3456
#define XB_SPIN_CAP (1u << 22)
#define LAS __attribute__((address_space(3)))
__device__ __forceinline__ unsigned xb_ld(unsigned* p)              { return __hip_atomic_load(p, __ATOMIC_RELAXED, __HIP_MEMORY_SCOPE_AGENT); }
__device__ __forceinline__ unsigned xb_add(unsigned* p, unsigned v) { return __hip_atomic_fetch_add(p, v, __ATOMIC_RELAXED, __HIP_MEMORY_SCOPE_AGENT); }
__device__ __forceinline__ unsigned xb_xcc_id() { return (unsigned)__builtin_amdgcn_s_getreg((3 << 11) | 20) & 0xFu; }
#define XB_SPIN(cond, bar) do { unsigned _sp = 0; while (cond) { __builtin_amdgcn_s_sleep(1); \
    if ((++_sp & 255u) == 0u) { if (xb_ld(&(bar)[XB_TMO])) break; if (_sp > XB_SPIN_CAP) { atomicAdd(&(bar)[XB_TMO], 1u); break; } } } } while (0)
struct XcdBarrier { unsigned* bar; unsigned x; volatile LAS unsigned* st; };
__device__ __forceinline__ XcdBarrier xcd_barrier_post(unsigned* bar, volatile LAS unsigned* st) {
    XcdBarrier b; b.bar = bar; b.x = xb_xcc_id(); b.st = st;
    if (TIDX() == 0) { st[0] = 0u; st[1] = 0u; (void)xb_add(&bar[XB_XCNT(b.x)], 1u); }
    return b;
}
__device__ __forceinline__ void xcd_barrier_complete(unsigned* bar, unsigned x, unsigned& nloc, unsigned& nx) {
    const unsigned G = gridDim.x * gridDim.y * gridDim.z;
    unsigned sum, cnt, mine, sp = 0u;
    for (;;) {
        sum = 0u; cnt = 0u; mine = 0u;
#pragma unroll
        for (unsigned j = 0; j < 16; ++j) { const unsigned c = xb_ld(&bar[XB_XCNT(j)]); sum += c; cnt += (c > 0u) ? 1u : 0u; mine = (j == x) ? c : mine; }
        if (sum == G) break;
        __builtin_amdgcn_s_sleep(1);
        if ((++sp & 255u) == 0u) { if (xb_ld(&bar[XB_TMO])) break; if (sp > XB_SPIN_CAP) { atomicAdd(&bar[XB_TMO], 1u); break; } }
    }
    nloc = mine > 0u ? mine : 1u; nx = cnt > 0u ? cnt : 1u;
}
__device__ __forceinline__ void xcd_barrier(XcdBarrier& b) {
    asm volatile("s_waitcnt vmcnt(0)" ::: "memory");
    __syncthreads();
    if (TIDX() == 0) {
        unsigned* bar = b.bar;
        __builtin_amdgcn_s_waitcnt(0);
        unsigned nloc = b.st[0], nx = b.st[1];
        if (nloc == 0u) { xcd_barrier_complete(bar, b.x, nloc, nx); b.st[0] = nloc; b.st[1] = nx; }
        const unsigned old = xb_add(&bar[XB_XSUB(b.x)], 1u);
        const unsigned gen = old / nloc;
        if (old + 1u == (gen + 1u) * nloc) {
            __builtin_amdgcn_fence(__ATOMIC_RELEASE, XB_SCOPE);
            asm volatile("s_waitcnt vmcnt(0)" ::: "memory");
            const unsigned og = xb_add(&bar[XB_TOP], 1u);
            const unsigned tg = og / nx;
            if (og + 1u == (tg + 1u) * nx) xb_add(&bar[XB_TOPGEN], 1u);
            else XB_SPIN(xb_ld(&bar[XB_TOPGEN]) == tg, bar);
            __builtin_amdgcn_fence(__ATOMIC_ACQUIRE, XB_SCOPE);
            xb_add(&bar[XB_XGEN(b.x)], 1u);
            asm volatile("s_waitcnt vmcnt(0)" ::: "memory");
        } else {
            XB_SPIN(xb_ld(&bar[XB_XGEN(b.x)]) == gen, bar);
            __builtin_amdgcn_fence(__ATOMIC_ACQUIRE, XB_SCOPE);
            asm volatile("s_waitcnt vmcnt(0)" ::: "memory");
        }
    }
    __syncthreads();
}

__device__ __forceinline__ void tile_coords(int L, int ntm, int ntn, int& tm, int& tn) {
    const int nt = ntm * ntn, q = nt >> 3, r = nt & 7, xcd = L & 7, off = L >> 3;
    const int id = (xcd < r ? xcd * (q + 1) : r * (q + 1) + (xcd - r) * q) + off;
    const int GM = 8, nig = GM * ntn, gid = id / nig, fm = gid * GM, gsz = (ntm - fm) < GM ? (ntm - fm) : GM;
    tm = fm + ((id % nig) % gsz); tn = (id % nig) / gsz;
}

template <class AP, class BP>
__device__ __forceinline__ void gemm_kloop(f32x4 (&acc)[4][4], AP ap, int a_kstep, BP bp, int b_kstep, int nkt, unsigned char* lds, int tid) {
    const int lane = tid & 63, w = tid >> 6, wm = w >> 1, wn = w & 1, fr = lane & 15, fq = lane >> 4;
    const int lr = lane >> 3, lc = (lane & 7) ^ lr;
    const bf16_t* pa[4]; const bf16_t* pb[4];
#pragma unroll
    for (int i = 0; i < 4; ++i) {
        const int row = 8 * (w + 4 * i) + lr;
        pa[i] = ap(row) + lc * 8;
        const int wn_ = row >> 6, ni_ = (row >> 4) & 3, ii = row & 15;
        pb[i] = bp(64 * wn_ + 16 * (ii >> 2) + 4 * ni_ + (ii & 3)) + lc * 8;
    }
    const int ra = (64 * wm + fr) * 128, rb = (64 * wn + fr) * 128;
    const int sw0 = ((fq) ^ (fr & 7)) << 4, sw1 = ((4 + fq) ^ (fr & 7)) << 4;
    auto issue = [&](int buf) {
#pragma unroll
        for (int i = 0; i < 4; ++i) {
            __builtin_amdgcn_global_load_lds((const unsigned*)pa[i], (unsigned*)(lds + buf * 16384 + (w + 4 * i) * 1024), 16, 0, 0);
            __builtin_amdgcn_global_load_lds((const unsigned*)pb[i], (unsigned*)(lds + 32768 + buf * 16384 + (w + 4 * i) * 1024), 16, 0, 0);
            pa[i] += a_kstep; pb[i] += b_kstep;
        }
    };
    auto compute = [&](int buf) {
        const unsigned char* A = lds + buf * 16384;
        const unsigned char* B = lds + 32768 + buf * 16384;
#pragma unroll
        for (int ks = 0; ks < 2; ++ks) {
            const int sw = ks ? sw1 : sw0;
            bf16x8 af[4], bf[4];
#pragma unroll
            for (int mi = 0; mi < 4; ++mi) af[mi] = *(const bf16x8*)(A + ra + mi * 2048 + sw);
#pragma unroll
            for (int ni = 0; ni < 4; ++ni) bf[ni] = *(const bf16x8*)(B + rb + ni * 2048 + sw);
#pragma unroll
            for (int mi = 0; mi < 4; ++mi)
#pragma unroll
                for (int ni = 0; ni < 4; ++ni) acc[mi][ni] = mfma16(bf[ni], af[mi], acc[mi][ni]);
        }
    };
    vb_sync(lds);
    issue(0);
    asm volatile("s_waitcnt vmcnt(0)" ::: "memory");
    vb_sync(lds);
#pragma unroll 1
    for (int kt = 0; kt < nkt; ++kt) {
        const int cur = kt & 1;
        if (kt + 1 < nkt) issue(cur ^ 1);
        compute(cur);
        asm volatile("s_waitcnt vmcnt(0)" ::: "memory");
        vb_sync(lds);
    }
}
__device__ __forceinline__ void zero_acc(f32x4 (&acc)[4][4]) {
#pragma unroll
    for (int i = 0; i < 4; ++i)
#pragma unroll
        for (int j = 0; j < 4; ++j) acc[i][j] = (f32x4){0.f, 0.f, 0.f, 0.f};
}

constexpr int G8_HTB = 16384;
__device__ __forceinline__ int g8_lds_byte(int r, int c) { const int st = (r >> 4) * 2 + (c >> 5), rr = r & 15, cc = c & 31, ob = rr * 64 + cc * 2; return st * 1024 + (ob ^ (((ob >> 9) & 1) << 5)); }
__device__ __forceinline__ void g8_stage_rc(int b, int& R, int& C) { const int st = b / 1024, sb = b % 1024, swz = sb ^ (((sb >> 9) & 1) << 5); R = (st >> 1) * 16 + swz / 64; C = (st & 1) * 32 + (swz % 64) / 2; }
__device__ __forceinline__ int g8_perm32(int rho) { const int n = rho >> 4, i = rho & 15; return 8 * (i >> 2) + 4 * n + (i & 3); }
struct G8Unit {
    const char* A0; const char* A1; const char* B0; const char* B1;
    unsigned K2;
    int nt;
    int x0, x1, x2, x3, n;
    unsigned ao[2][2];
};
typedef f32x4 G8Acc[2][2][4][2];
template <class Sched, class Epi>
__device__ __forceinline__ void g8_phase(Sched& S, Epi& E) {
    LAS unsigned char* lds = (LAS unsigned char*)lds_base();
    int tid = TIDX(); asm volatile("" : "+v"(tid));
    const int wid = __builtin_amdgcn_readfirstlane(tid >> 6), lane = tid & 63, wr = wid >> 2, wc = wid & 3, fr = lane & 15, fq = lane >> 4;
#define G8_GEOM(R, C2, Rb) int R[2]; unsigned C2[2], Rb[2]; { int _t = TIDX(); asm volatile("" : "+v"(_t)); _Pragma("unroll") for (int _i = 0; _i < 2; ++_i) { int _r, _c; g8_stage_rc(_t * 16 + _i * 8192, _r, _c); \
        R[_i] = _r; C2[_i] = (unsigned)_c * 2u; Rb[_i] = (unsigned)((_r & ~31) + g8_perm32(_r & 31)); } }
    const unsigned ldsw = (unsigned)wid * 1024u;
    const int aoff = g8_lds_byte(wr * 64 + fr, fq * 8), boff = g8_lds_byte(wc * 32 + fr, fq * 8);
#define G8_SA(b, h) (((b) * 2 + (h)) * G8_HTB)
#define G8_SB(b, h) ((4 + (b) * 2 + (h)) * G8_HTB)
#define G8_STAGE(bufoff, gbase, voff) do { _Pragma("unroll") for (int _i = 0; _i < 2; ++_i) { unsigned _o = (voff)[_i]; asm volatile("" : "+v"(_o)); \
        __builtin_amdgcn_global_load_lds((const unsigned*)((const char*)(gbase) + _o), (LAS unsigned*)(lds + (bufoff) + ldsw + _i * 8192), 16, 0, 0); } } while (0)
#define G8_BOFF(u, bo) do { _Pragma("unroll") for (int _i = 0; _i < 2; ++_i) bo[_i] = Rb_[_i] * (u).K2 + C2_[_i]; } while (0)
#define G8_LDA(dst, b, h) do { _Pragma("unroll") for (int m = 0; m < 4; ++m) _Pragma("unroll") for (int k = 0; k < 2; ++k) dst[m][k] = *(const LAS bf16x8*)(lds + G8_SA(b, h) + aoff + m * 2048 + k * 1024); } while (0)
#define G8_LDB(dst, b, h) do { _Pragma("unroll") for (int n = 0; n < 2; ++n) _Pragma("unroll") for (int k = 0; k < 2; ++k) dst[n][k] = *(const LAS bf16x8*)(lds + G8_SB(b, h) + boff + n * 2048 + k * 1024); } while (0)
#define G8_MMA(ai, bj, At, Bt) do { __builtin_amdgcn_s_setprio(1); _Pragma("unroll") for (int m = 0; m < 4; ++m) _Pragma("unroll") for (int n = 0; n < 2; ++n) _Pragma("unroll") for (int k = 0; k < 2; ++k) \
        acc[ai][bj][m][n] = __builtin_amdgcn_mfma_f32_16x16x32_bf16(Bt[n][k], At[m][k], acc[ai][bj][m][n], 0, 0, 0); __builtin_amdgcn_s_setprio(0); } while (0)
#define G8_WAIT_V(n) asm volatile("s_waitcnt vmcnt(" #n ")" ::: "memory")
#define G8_WAIT_L(n) asm volatile("s_waitcnt lgkmcnt(" #n ")" ::: "memory")
#define G8_BAR __builtin_amdgcn_s_barrier()
#define G8_SCHED __builtin_amdgcn_sched_barrier(0)
    G8Unit cur, nxt; int ui = 0; unsigned cbo[2], nbo[2];
    { G8_GEOM(R_, C2_, Rb_) if (!S.next(0, cur, R_, C2_)) return; G8_BOFF(cur, cbo); }
    G8Acc acc;
#pragma unroll
    for (int a = 0; a < 2; ++a)
#pragma unroll
        for (int b = 0; b < 2; ++b)
#pragma unroll
            for (int m = 0; m < 4; ++m)
#pragma unroll
                for (int n = 0; n < 2; ++n) acc[a][b][m][n] = (f32x4){0.f, 0.f, 0.f, 0.f};
    bf16x8 At[4][2], B0[2][2], B1[2][2];
    G8_STAGE(G8_SB(0, 0), cur.B0, cbo); G8_STAGE(G8_SA(0, 0), cur.A0, cur.ao[0]); G8_STAGE(G8_SB(0, 1), cur.B1, cbo); G8_STAGE(G8_SA(0, 1), cur.A1, cur.ao[1]);
    if (wr == 1) G8_BAR;
    G8_WAIT_V(4); G8_BAR;
    G8_STAGE(G8_SB(1, 0), cur.B0 + 128, cbo); G8_STAGE(G8_SA(1, 0), cur.A0 + 128, cur.ao[0]); G8_STAGE(G8_SB(1, 1), cur.B1 + 128, cbo);
    G8_WAIT_V(6); G8_BAR;
    for (;;) {
        bool has_next;
        { G8_GEOM(R_, C2_, Rb_) has_next = S.next(ui + 1, nxt, R_, C2_);
          if (!has_next) nxt = cur;
          G8_BOFF(nxt, nbo); }
        const int nt = cur.nt;
#pragma unroll 1
        for (int t = 0; t < nt; t += 2) {
            const bool last = (t == nt - 2);
            const size_t k1 = (size_t)(t + 1) * 128, k2 = (size_t)(t + 2) * 128;
            const char* a2h0 = last ? nxt.A0 : cur.A0 + k2; const char* a2h1 = last ? nxt.A1 : cur.A1 + k2;
            const char* b2h0 = last ? nxt.B0 : cur.B0 + k2; const char* b2h1 = last ? nxt.B1 : cur.B1 + k2;
            unsigned ao0[2], ao1[2], bo2[2];
#pragma unroll
            for (int i = 0; i < 2; ++i) { ao0[i] = last ? nxt.ao[0][i] : cur.ao[0][i]; ao1[i] = last ? nxt.ao[1][i] : cur.ao[1][i]; bo2[i] = last ? nbo[i] : cbo[i]; }
            G8_LDB(B0, 0, 0); G8_SCHED; G8_LDA(At, 0, 0); G8_STAGE(G8_SA(1, 1), cur.A1 + k1, cur.ao[1]);
            G8_WAIT_L(8); G8_BAR; G8_WAIT_L(0); G8_MMA(0, 0, At, B0); G8_BAR; G8_SCHED;
            G8_LDB(B1, 0, 1); G8_STAGE(G8_SB(0, 0), b2h0, bo2);
            G8_BAR; G8_WAIT_L(0); G8_MMA(0, 1, At, B1); G8_BAR;
            G8_LDA(At, 0, 1); G8_STAGE(G8_SA(0, 0), a2h0, ao0);
            G8_BAR; G8_WAIT_L(0); G8_MMA(1, 0, At, B0); G8_BAR; G8_SCHED;
            G8_STAGE(G8_SB(0, 1), b2h1, bo2);
            G8_WAIT_V(6); G8_BAR; G8_MMA(1, 1, At, B1); G8_BAR;
            G8_LDB(B0, 1, 0); G8_SCHED; G8_LDA(At, 1, 0); G8_STAGE(G8_SA(0, 1), a2h1, ao1);
            G8_WAIT_L(8); G8_BAR; G8_WAIT_L(0); G8_MMA(0, 0, At, B0); G8_BAR; G8_SCHED;
            G8_LDB(B1, 1, 1); G8_STAGE(G8_SB(1, 0), b2h0 + 128, bo2);
            G8_BAR; G8_WAIT_L(0); G8_MMA(0, 1, At, B1); G8_BAR;
            G8_LDA(At, 1, 1); G8_STAGE(G8_SA(1, 0), a2h0 + 128, ao0);
            G8_BAR; G8_WAIT_L(0); G8_MMA(1, 0, At, B0); G8_BAR; G8_SCHED;
            G8_STAGE(G8_SB(1, 1), b2h1 + 128, bo2);
            G8_WAIT_V(6); G8_BAR; G8_MMA(1, 1, At, B1); G8_BAR;
        }
        { int t_ = TIDX(); asm volatile("" : "+v"(t_)); const int w_ = __builtin_amdgcn_readfirstlane(t_ >> 6); E(acc, cur, w_ >> 2, w_ & 3, t_ & 15, (t_ >> 4) & 3); }
        if (!has_next) break;
#pragma unroll
        for (int a = 0; a < 2; ++a)
#pragma unroll
            for (int b = 0; b < 2; ++b)
#pragma unroll
                for (int m = 0; m < 4; ++m)
#pragma unroll
                    for (int n = 0; n < 2; ++n) acc[a][b][m][n] = (f32x4){0.f, 0.f, 0.f, 0.f};
        cur = nxt; ++ui; cbo[0] = nbo[0]; cbo[1] = nbo[1];
    }
    G8_WAIT_V(0);
    if (wr == 0) G8_BAR;
    G8_BAR;
}
struct G8Plain {
    static constexpr bool GATHER = false;
    const char* A; const char* B; unsigned K2; int nt, nM, nN;
    __device__ __forceinline__ bool next(int i, G8Unit& u, const int (&R)[2], const unsigned (&C2)[2]) const {
        const int L = i * (int)gridDim.x + (int)blockIdx.x; if (L >= nM * nN) return false;
        int pm, pn; tile_coords(L, nM, nN, pm, pn); pm = __builtin_amdgcn_readfirstlane(pm); pn = __builtin_amdgcn_readfirstlane(pn);
        u.A0 = A + (size_t)pm * 256 * K2; u.A1 = u.A0 + (size_t)128 * K2; u.B0 = B + (size_t)pn * 256 * K2; u.B1 = u.B0 + (size_t)128 * K2;
        u.K2 = K2; u.nt = nt; u.x0 = pm; u.x1 = pn; u.x2 = 0; u.x3 = 0;
#pragma unroll
        for (int h = 0; h < 2; ++h)
#pragma unroll
            for (int k = 0; k < 2; ++k) u.ao[h][k] = (unsigned)R[k] * u.K2 + C2[k];
        return true;
    }
};

__device__ __forceinline__ void convert_tiles(CKP& p, int l, int e_lo, int e_hi, int first, int stride, int lane) {
    unsigned char* W = p.ws + OFF_W;
    struct E { const float* src; bf16_t* dst; int R, C, nd, mode, nbatch; };
    const int NE = e_hi;
        for (int L = first;; L += stride) {
            int rem = L; int e = e_lo; E d{};
            for (; e < NE; ++e) {
                switch (e) {
                    case 0: d = {p.in[3] + (size_t)l * 1024 * 5144, (bf16_t*)(W + W_IN), 1024, 5144, 2176, 1, 1}; break;
                    case 1: d = {p.in[3] + (size_t)l * 1024 * 5144, (bf16_t*)(W + W_GB), 1024, 5144, 3072, 2, 1}; break;
                    case 2: d = {p.in[10] + (size_t)l * 512 * 1024, (bf16_t*)(W + W_A), 512, 1024, 1024, 0, 1}; break;
                    case 3: d = {p.in[14] + (size_t)l * 256 * 1024, (bf16_t*)(W + W_S), 256, 1024, 1024, 0, 1}; break;
                    case 4: d = {p.in[25] + (size_t)l * 256 * 1024, (bf16_t*)(W + W_5), 256, 1024, 1024, 0, 1}; break;
                    case 5: d = {p.in[26] + (size_t)l * 1024 * 1024, (bf16_t*)(W + W_M), 1024, 1024, 1024, 0, 1}; break;
                    case 6: d = {p.in[23] + (size_t)l * 256 * 256, (bf16_t*)(W + W_GLU), 256, 256, 256, 0, 1}; break;
                    case 7: d = {p.in[6] + (size_t)l * 2048 * 128, (bf16_t*)(W + W_C1), 2048, 128, 128, 0, 1}; break;
                    case 8: d = {p.in[8] + (size_t)l * 2048 * 128, (bf16_t*)(W + W_C1) + 128 * 2048, 2048, 128, 128, 0, 1}; break;
                    case 9: d = {p.in[7] + (size_t)l * 128 * 64, (bf16_t*)(W + W_C2), 128, 64, 64, 0, 1}; break;
                    case 10: d = {p.in[9] + (size_t)l * 128 * 64, (bf16_t*)(W + W_C2) + 64 * 128, 128, 64, 64, 0, 1}; break;
                    case 11: d = {p.in[32] + (size_t)l * 32 * 1024 * 512, (bf16_t*)(W + W_EG), 1024, 512, 512, 3, 32}; break;
                    case 12: d = {p.in[33] + (size_t)l * 32 * 1024 * 512, (bf16_t*)(W + W_EU), 1024, 512, 512, 3, 32}; break;
                    default: d = {p.in[34] + (size_t)l * 32 * 512 * 1024, (bf16_t*)(W + W_ED), 512, 1024, 1024, 0, 32}; break;
                }
                const int per = (d.R >> 6) * (d.nd >> 6), tot = per * d.nbatch;
                if (rem < tot) break;
                rem -= tot;
            }
            if (e >= NE) break;
            const int per = (d.R >> 6) * (d.nd >> 6), bi = rem / per, t = rem % per, ntn = d.nd >> 6;
            const int k0 = (t / ntn) * 64, n = (t % ntn) * 64 + lane;
            int col = n;
            if (d.mode == 1) col = (n < 1280) ? n : ((n < 2048) ? n + 24 : ((n < 2072) ? n - 768 : -1));
            else if (d.mode == 2) col = n + 2072;
            const float* sp = d.src + (size_t)bi * d.R * d.C + (size_t)k0 * d.C + (col >= 0 ? col : 0);
            float v[64];
#pragma unroll
            for (int i = 0; i < 64; ++i) v[i] = sp[(size_t)i * d.C];
            if (d.mode == 1 || d.mode == 2) {
                const float* g1 = p.in[2] + (size_t)l * 1024 + k0;
#pragma unroll
                for (int i = 0; i < 64; ++i) v[i] *= g1[i];
            }
            if (d.mode == 3) {
                const float* g2 = p.in[27] + (size_t)l * 1024 + k0;
#pragma unroll
                for (int i = 0; i < 64; ++i) v[i] *= g2[i];
            }
            if (col < 0) {
#pragma unroll
                for (int i = 0; i < 64; ++i) v[i] = 0.f;
            }
            bf16_t* dp = d.dst + (size_t)bi * d.R * d.nd + (size_t)n * d.R + k0;
#pragma unroll
            for (int q = 0; q < 8; ++q) {
                u32x4 o;
                o.x = pk_bf16(v[8 * q], v[8 * q + 1]); o.y = pk_bf16(v[8 * q + 2], v[8 * q + 3]);
                o.z = pk_bf16(v[8 * q + 4], v[8 * q + 5]); o.w = pk_bf16(v[8 * q + 6], v[8 * q + 7]);
                *(u32x4*)(dp + 8 * q) = o;
            }
        }
}

__device__ __forceinline__ void phase_prep(CKP& p, int l, unsigned char* lds) {
    const int tid = opaque_tid(), G = VGRID(), lane = tid & 63, w = tid >> 6;
    unsigned char* W = p.ws + OFF_W;
    if (l < DEPTH) {
        convert_tiles(p, l, 0, 11, VBID() * 4 + w, G * 4, lane);
        const int gt = VBID() * NTHR + tid, gs = G * NTHR;
        if (l == 0) {
            const int* pos = (const int*)p.in[1]; float* rt = (float*)(p.ws + OFF_ROPE);
            for (int i = gt; i < NTOK * 8; i += gs) { float sn, cs; sincosf((float)pos[i >> 3] * p.inv_freq[i & 7], &sn, &cs); rt[(i >> 3) * 16 + (i & 7)] = cs; rt[(i >> 3) * 16 + 8 + (i & 7)] = sn; }
        }
        {
            const float* sw = p.in[12] + (size_t)l * 4 * 128 * 128; bf16_t* o = (bf16_t*)(W + W_SGU);
            for (int i = gt; i < 65536; i += gs) { const int t = (i >> 7) & 127, s = i & 127; o[i] = f2bf(s <= t ? sw[i] : 0.f); }
        }
        {
            const float* are = p.in[15] + l * 1024; const float* aim = p.in[16] + l * 1024; const float* ls = p.in[17] + l * 16;
            const float* bre = p.in[18] + (size_t)l * 16384; const float* bim = p.in[19] + (size_t)l * 16384;
            float* oa = (float*)(W + W_S5A); float* oa2 = (float*)(W + W_S5A256); float* ob = (float*)(W + W_S5B);
            for (int i = gt; i < 1024; i += gs) {
                const int g = i >> 6;
                const float step = expf(ls[g]), ar = are[i], ai = aim[i];
                const float mag = expf(ar * step); float sn, cs; sincosf(ai * step, &sn, &cs);
                const float abr = mag * cs, abi = mag * sn;
                const float den = ar * ar + ai * ai, nr = abr - 1.f, ni = abi;
                const float cr = (nr * ar + ni * ai) / den, ci = (ni * ar - nr * ai) / den;
                oa[i * 2] = abr; oa[i * 2 + 1] = abi;
                float pr = abr, pi = abi;
                for (int s = 0; s < 8; ++s) { const float nr2 = pr * pr - pi * pi, ni2 = 2.f * pr * pi; pr = nr2; pi = ni2; }
                oa2[i * 2] = pr; oa2[i * 2 + 1] = pi;
                for (int h = 0; h < 16; ++h) {
                    const float br = bre[i * 16 + h], bi_ = bim[i * 16 + h];
                    ob[i * 32 + h] = cr * br - ci * bi_;
                    ob[i * 32 + 16 + h] = cr * bi_ + ci * br;
                }
            }
            const float* cre = p.in[20] + (size_t)l * 16384; const float* cim = p.in[21] + (size_t)l * 16384; bf16_t* oc = (bf16_t*)(W + W_S5C);
            for (int i = gt; i < 32768; i += gs) {
                const int k = i & 127, gh = i >> 7;
                oc[i] = f2bf(k < 64 ? cre[gh * 64 + k] : -cim[gh * 64 + (k - 64)]);
            }
        }
        {
            const float* wg = p.in[28] + (size_t)l * 1024 * 4; const float* we = p.in[30] + (size_t)l * 1024 * 32;
            bf16_t* oh = (bf16_t*)(W + W_RH); bf16_t* ol = (bf16_t*)(W + W_RL);
            for (int i = gt; i < 65536; i += gs) {
                const int n = i >> 10, k = i & 1023;
                const float v = ((n < 4) ? wg[k * 4 + n] : ((n < 36) ? we[k * 32 + (n - 4)] : 0.f)) * p.in[27][(size_t)l * 1024 + k];
                const bf16_t h = f2bf(v);
                oh[i] = h; ol[i] = f2bf(v - bf2f(h));
            }
        }
        {
            float* pb = (float*)(W + W_PB);
            for (int j = VBID() * 4 + w; j < 256; j += G * 4) {
                const int kv = j >> 7, n = j & 127;
                const float* pos = p.in[kv ? 5 : 4] + (size_t)l * 2048; const float* w1 = p.in[kv ? 8 : 6] + (size_t)l * 2048 * 128;
                float s = 0.f;
                for (int k = lane; k < 2048; k += 64) s += pos[k] * w1[(size_t)k * 128 + n];
                s = wave_sum(s);
                if (lane == 0) pb[j] = s;
            }
        }
    }
    {
        const float* gam = (l < DEPTH) ? (p.in[2] + (size_t)l * 1024) : p.in[35];
        bf16_t* hb = (bf16_t*)(p.ws + OFF_H);
        const bf16_t* ys = (const bf16_t*)(p.ws + OFF_YS);
        bf16_t* xres = (bf16_t*)(p.ws + OFF_X);
        f32x4 gv[4];
#pragma unroll
        for (int i = 0; i < 4; ++i) gv[i] = *(const f32x4*)(gam + 4 * lane + 256 * i);
        for (int row = VBID() * 4 + w; row < NTOK; row += G * 4) {
            f32x4 xv[4]; float ss = 0.f;
#pragma unroll
            for (int i = 0; i < 4; ++i) {
                const int col = 4 * lane + 256 * i;
                if (l == 0) xv[i] = *(const f32x4*)(p.in[0] + (size_t)row * 1024 + col);
                else {
                    { const u32x2 xx = *(const u32x2*)(xres + (size_t)row * 1024 + col); xv[i] = (f32x4){bflo(xx.x), bfhi(xx.x), bflo(xx.y), bfhi(xx.y)}; }
                    const u32x2 y0 = *(const u32x2*)(ys + (size_t)(2 * row) * 1024 + col), y1 = *(const u32x2*)(ys + (size_t)(2 * row + 1) * 1024 + col);
                    xv[i][0] += bflo(y0.x) + bflo(y1.x); xv[i][1] += bfhi(y0.x) + bfhi(y1.x);
                    xv[i][2] += bflo(y0.y) + bflo(y1.y); xv[i][3] += bfhi(y0.y) + bfhi(y1.y);
                }
                ss += xv[i][0] * xv[i][0] + xv[i][1] * xv[i][1] + xv[i][2] * xv[i][2] + xv[i][3] * xv[i][3];
            }
            ss = wave_sum(ss);
            const float rstd = rsqrtf(ss * (1.f / 1024.f) + RMS_EPS);
#pragma unroll
            for (int i = 0; i < 4; ++i) {
                const int col = 4 * lane + 256 * i;
                f32x4 hn = xv[i] * rstd * gv[i];
                if (l < DEPTH) {
                    { u32x2 xo; xo.x = pk_bf16(xv[i][0], xv[i][1]); xo.y = pk_bf16(xv[i][2], xv[i][3]); *(u32x2*)(xres + (size_t)row * 1024 + col) = xo; }
                    if (i == 0 && lane == 0) ((float*)(p.ws + OFF_RS1))[row] = rstd;
                } else {
#if DBG_TIMEPH >= 0
                    { const unsigned long long* ts = (const unsigned long long*)(p.ws + OFF_CTL + 24576);
                      const float dt_us = (float)(ts[DBG_TIMEPH2] - ts[DBG_TIMEPH]) * 0.01f; hn = hn * (1.f + 1e-3f * dt_us); }
#endif
                    *(f32x4*)(p.xbuf + (size_t)row * 1024 + col) = hn;
                }
            }
        }
    }
}

struct EpiInproj {
    unsigned char* Rb_; const float* rope; const float* rs1;
    __device__ __forceinline__ void operator()(const G8Acc& acc, const G8Unit& u, int wr, int wc, int fr, int fq) const {
        unsigned char* R = Rb_;
        float rsv[2][4];
#pragma unroll
        for (int ai = 0; ai < 2; ++ai)
#pragma unroll
            for (int m = 0; m < 4; ++m) rsv[ai][m] = rs1[u.x0 * 256 + ai * 128 + wr * 64 + m * 16 + fr];
#pragma unroll
        for (int bj = 0; bj < 2; ++bj) {
            const int tn = u.x1 * 2 + bj;
            const int cl = 32 * wc + 8 * fq;
#pragma unroll
            for (int ai = 0; ai < 2; ++ai)
#pragma unroll
                for (int m = 0; m < 4; ++m) {
                    const int row = u.x0 * 256 + ai * 128 + wr * 64 + m * 16 + fr;
                    float v[8];
#pragma unroll
                    for (int e = 0; e < 8; ++e) v[e] = acc[ai][bj][m][e >> 2][e & 3] * rsv[ai][m];
                    const bool roped = (tn < 4) || tn == 6 || tn == 8;
                    if (tn < 4) { u32x4 o; o.x = pk_bf16(v[0], v[1]); o.y = pk_bf16(v[2], v[3]); o.z = pk_bf16(v[4], v[5]); o.w = pk_bf16(v[6], v[7]);
                                  *(u32x4*)((bf16_t*)(R + R_Q) + (size_t)row * 512 + tn * 128 + cl) = o; }
                    if (roped && !(wc & 1)) {
                        float xo[8];
#pragma unroll
                        for (int i = 0; i < 8; ++i) xo[i] = __shfl_xor(v[i], 16);
                        if (fq < 2) {
                            const float* rt = rope + (size_t)row * 16;
                            const f32x4 c0 = *(const f32x4*)rt, c1 = *(const f32x4*)(rt + 4), s0 = *(const f32x4*)(rt + 8), s1 = *(const f32x4*)(rt + 12);
#pragma unroll
                            for (int i = 0; i < 8; ++i) {
                                const float cs = i < 4 ? c0[i & 3] : c1[i & 3], sn = i < 4 ? s0[i & 3] : s1[i & 3];
                                v[i] = fq == 0 ? (v[i] * cs - xo[i] * sn) : (v[i] * cs + xo[i] * sn);
                            }
                        }
                    }
                    u32x4 o; o.x = pk_bf16(v[0], v[1]); o.y = pk_bf16(v[2], v[3]); o.z = pk_bf16(v[4], v[5]); o.w = pk_bf16(v[6], v[7]);
                    if (tn < 4) *(u32x4*)((bf16_t*)(R + R_QR) + (size_t)row * 512 + tn * 128 + cl) = o;
                    else if (tn == 7 || tn == 9) {
                        bf16_t* dst = (bf16_t*)(R + (tn == 7 ? R_VST : R_VWT));
                        const int b = row >> 12, s_ = row & 4095, g = wc >> 1, d0 = 32 * (wc & 1) + 8 * fq;
#pragma unroll
                        for (int e = 0; e < 8; ++e) dst[((size_t)((b * 2 + g) * 64 + d0 + e)) * SEQ + s_] = f2bf(v[e]);
                    } else if (tn < 10) {
                        const size_t off = (tn == 4) ? R_KC : (tn == 5) ? R_VC : (tn == 6) ? R_KS : R_KW;
                        *(u32x4*)((bf16_t*)(R + off) + (size_t)row * 128 + cl) = o;
                    } else if (tn < 14) {
#pragma unroll
                        for (int e = 0; e < 8; ++e) v[e] = gelu_tanh(v[e]);
                        u32x4 og; og.x = pk_bf16(v[0], v[1]); og.y = pk_bf16(v[2], v[3]); og.z = pk_bf16(v[4], v[5]); og.w = pk_bf16(v[6], v[7]);
                        const int c512 = (tn - 10) * 128 + cl;
                        if (c512 < 256) *(u32x4*)((bf16_t*)(R + R_U) + (size_t)row * 256 + c512) = og;
                        else *(u32x4*)((bf16_t*)(R + R_V) + (size_t)row * 256 + (c512 - 256)) = og;
                    } else {
                        *(u32x4*)((bf16_t*)(R + R_S5IN) + (size_t)row * 256 + (tn - 14) * 128 + cl) = o;
                    }
                }
        }
    }
};
__device__ __forceinline__ void phase_inproj(CKP& p, int l, unsigned char* lds) {
    {
        G8Plain S{(const char*)(p.ws + OFF_X), (const char*)(p.ws + OFF_W + W_IN), 2048u, 16, NTOK / 256, 8};
        EpiInproj E{p.ws + OFF_R, (const float*)(p.ws + OFF_ROPE), (const float*)(p.ws + OFF_RS1)};
        g8_phase(S, E);
    }
    const int tid = opaque_tid(), lane = tid & 63, w = tid >> 6, wm = w >> 1, wn = w & 1, fr = lane & 15, fq = lane >> 4;
    const int half = TIDX() >> 8;
    const bf16_t* A = (const bf16_t*)(p.ws + OFF_X);
    const float* rs1 = (const float*)(p.ws + OFF_RS1);
    const bf16_t* Bt = (const bf16_t*)(p.ws + OFF_W + W_IN) + (size_t)2048 * 1024;
    unsigned char* R = p.ws + OFF_R;
    float* xch = (float*)(lds_base() + VB_LDS);
    for (int tm = blockIdx.x; tm < NTOK / 128; tm += gridDim.x) {
        const int m0 = tm * 128;
        f32x4 acc[4][4]; zero_acc(acc);
        gemm_kloop(acc, [&](int r) { return A + (size_t)(m0 + r) * 1024 + half * 512; }, 64, [&](int v) { return Bt + (size_t)v * 1024 + half * 512; }, 64, 8, lds, tid);
        __syncthreads();
        if (half == 1 && wn == 0 && fq < 2) {
#pragma unroll
            for (int mi = 0; mi < 4; ++mi) {
                const int r = 64 * wm + 16 * mi + fr;
#pragma unroll
                for (int ni = 0; ni < 4; ++ni) *(f32x4*)(xch + r * 32 + 16 * fq + 4 * ni) = acc[mi][ni];
            }
        }
        __syncthreads();
        if (half == 0 && wn == 0 && fq < 2) {
#pragma unroll
            for (int mi = 0; mi < 4; ++mi) {
                const int r = 64 * wm + 16 * mi + fr;
                float* ng = (float*)(R + R_NG) + (size_t)(m0 + r) * 24 + 16 * fq;
#pragma unroll
                for (int ni = 0; ni < 4; ++ni) {
                    const f32x4 o = *(const f32x4*)(xch + r * 32 + 16 * fq + 4 * ni);
#pragma unroll
                    for (int j = 0; j < 4; ++j) if (16 * fq + 4 * ni + j < 24) ng[4 * ni + j] = sigm((acc[mi][ni][j] + o[j]) * rs1[m0 + r]);
                }
            }
        }
        __syncthreads();
    }
}

__device__ __forceinline__ void compress_tile(CKP& p, int job, unsigned char* lds) {
    job_fence();
    const int tid = opaque_tid(), lane = tid & 63, w = tid >> 6, wm = w >> 1, wn = w & 1, fr = lane & 15, fq = lane >> 4;
    const int kv = job >> 5, tm = job & 31, m0 = tm * 128;
    unsigned char* W = p.ws + OFF_W;
    const bf16_t* src = (const bf16_t*)(p.ws + OFF_R + (kv ? R_VC : R_KC));
    const bf16_t* W1 = (const bf16_t*)(W + W_C1) + (size_t)kv * 128 * 2048;
    const bf16_t* W2 = (const bf16_t*)(W + W_C2) + (size_t)kv * 64 * 128;
    const float* pb = (const float*)(W + W_PB) + kv * 128;
    f32x4 acc[4][4]; zero_acc(acc);
    int t512 = TIDX(); asm volatile("" : "+v"(t512));
    const int half = t512 >> 8;
    gemm_kloop(acc, [&](int r) { int Rr = m0 + r; Rr = Rr < 4080 ? Rr : 4079; const int b = Rr / 510, rem = Rr % 510, c = rem >> 1, g = rem & 1;
                                 return src + ((size_t)(b * SEQ + 16 * c + 16 * half)) * 128 + g * 64; }, 128,
               [&](int v) { return W1 + (size_t)v * 2048 + half * 1024; }, 64, 16, lds, tid);
    {
        float* xch = (float*)(lds_base() + VB_LDS);
        __syncthreads();
        if (half == 1) {
#pragma unroll
            for (int mi = 0; mi < 4; ++mi)
#pragma unroll
                for (int ni = 0; ni < 4; ++ni) *(f32x4*)(xch + ((mi * 4 + ni) * 256 + tid) * 4) = acc[mi][ni];
        }
        __syncthreads();
        if (half == 0) {
#pragma unroll
            for (int mi = 0; mi < 4; ++mi)
#pragma unroll
                for (int ni = 0; ni < 4; ++ni) acc[mi][ni] += *(const f32x4*)(xch + ((mi * 4 + ni) * 256 + tid) * 4);
        }
        __syncthreads();
        if (half == 1) return;
    }
#pragma unroll
    for (int mi = 0; mi < 4; ++mi) {
        const int row = 64 * wm + 16 * mi + fr; const int cb = 16 * fq;
        float v[16];
#pragma unroll
        for (int e = 0; e < 16; ++e) v[e] = gelu_tanh(acc[mi][e >> 2][e & 3] + pb[64 * wn + cb + e]);
        u32x4 a, b;
        a.x = pk_bf16(v[0], v[1]); a.y = pk_bf16(v[2], v[3]); a.z = pk_bf16(v[4], v[5]); a.w = pk_bf16(v[6], v[7]);
        b.x = pk_bf16(v[8], v[9]); b.y = pk_bf16(v[10], v[11]); b.z = pk_bf16(v[12], v[13]); b.w = pk_bf16(v[14], v[15]);
        *(u32x4*)(lds + wn * 16384 + row * 128 + (((2 * fq) ^ (row & 7)) << 4)) = a;
        *(u32x4*)(lds + wn * 16384 + row * 128 + (((2 * fq + 1) ^ (row & 7)) << 4)) = b;
    }
#pragma unroll
    for (int j = 0; j < 4; ++j) {
        const int pid = tid + 256 * j, row = pid >> 4, ch = pid & 15;
        const u32x4 v = *(const u32x4*)(W2 + row * 128 + ch * 8);
        *(u32x4*)(lds + 32768 + (ch >> 3) * 16384 + row * 128 + (((ch & 7) ^ (row & 7)) << 4)) = v;
    }
    vb_sync(lds);
    f32x4 a2[4][2];
#pragma unroll
    for (int i = 0; i < 4; ++i) { a2[i][0] = (f32x4){0.f, 0.f, 0.f, 0.f}; a2[i][1] = (f32x4){0.f, 0.f, 0.f, 0.f}; }
#pragma unroll
    for (int kt2 = 0; kt2 < 2; ++kt2)
#pragma unroll
        for (int ks = 0; ks < 2; ++ks) {
            bf16x8 af[4], bf[2];
#pragma unroll
            for (int mi = 0; mi < 4; ++mi) { const int row = 64 * wm + 16 * mi + fr; af[mi] = *(const bf16x8*)(lds + kt2 * 16384 + row * 128 + (((4 * ks + fq) ^ (row & 7)) << 4)); }
#pragma unroll
            for (int ni = 0; ni < 2; ++ni) { const int row = 32 * wn + 8 * (fr >> 2) + 4 * ni + (fr & 3); bf[ni] = *(const bf16x8*)(lds + 32768 + kt2 * 16384 + row * 128 + (((4 * ks + fq) ^ (row & 7)) << 4)); }
#pragma unroll
            for (int mi = 0; mi < 4; ++mi)
#pragma unroll
                for (int ni = 0; ni < 2; ++ni) a2[mi][ni] = mfma16(bf[ni], af[mi], a2[mi][ni]);
        }
    bf16_t* kcmp = (bf16_t*)(p.ws + OFF_C + C_KCMP);
    bf16_t* vct = (bf16_t*)(p.ws + OFF_C + C_VCT);
#pragma unroll
    for (int mi = 0; mi < 4; ++mi) {
        const int Rr = m0 + 64 * wm + 16 * mi + fr;
        if (Rr < 4080) {
            const int b = Rr / 510, rem = Rr % 510, c = rem >> 1, g = rem & 1, d0 = 32 * wn + 8 * fq;
            float v[8];
#pragma unroll
            for (int e = 0; e < 8; ++e) v[e] = a2[mi][e >> 2][e & 3];
            if (DBG_NOCSTORE) { if (v[0] == 123.456f) kcmp[0] = 1; }
            else if (kv == 0) {
                u32x4 o; o.x = pk_bf16(v[0], v[1]); o.y = pk_bf16(v[2], v[3]); o.z = pk_bf16(v[4], v[5]); o.w = pk_bf16(v[6], v[7]);
                *(u32x4*)(kcmp + ((size_t)(b * 256 + c)) * 128 + g * 64 + d0) = o;
                if (c == 254) *(u32x4*)(kcmp + ((size_t)(b * 256 + 255)) * 128 + g * 64 + d0) = (u32x4){0u, 0u, 0u, 0u};
            } else {
#pragma unroll
                for (int e = 0; e < 8; ++e) {
                    vct[((size_t)((b * 2 + g) * 64 + d0 + e)) * 256 + c] = f2bf(v[e]);
                    if (c == 254) vct[((size_t)((b * 2 + g) * 64 + d0 + e)) * 256 + 255] = 0;
                }
            }
        }
    }
    vb_sync(lds);
}

__device__ __forceinline__ void sgu_job(CKP& p, int l, int job, unsigned char* lds) {
    job_fence();
    const int tid = opaque_tid(), lane = tid & 63, w = tid >> 6, fr = lane & 15, fq = lane >> 4;
    const size_t tok0 = (size_t)job * 128;
    const bf16_t* V = (const bf16_t*)(p.ws + OFF_R + R_V) + tok0 * 256;
    const bf16_t* U = (const bf16_t*)(p.ws + OFF_R + R_U) + tok0 * 256;
    bf16_t* O = (bf16_t*)(p.ws + OFF_C + C_SGU) + tok0 * 256;
    const bf16_t* Wt = (const bf16_t*)(p.ws + OFF_W + W_SGU);
    const float* ng = p.in[11] + (size_t)l * 256;
    const float* bs = p.in[13] + (size_t)l * 512;
    vb_sync(lds);
    if (DBG_SGUCUT != 2) {
        const int s = tid >> 1, half = tid & 1;
        const bf16_t* src = V + (size_t)s * 256 + half * 128;
        float ss = 0.f;
#pragma unroll 4
        for (int j = 0; j < 16; ++j) {
            const u32x4 bb = *(const u32x4*)(src + j * 8);
            const unsigned uu[4] = {bb.x, bb.y, bb.z, bb.w};
#pragma unroll
            for (int q = 0; q < 4; ++q) { const float a = bflo(uu[q]), b2 = bfhi(uu[q]); ss += a * a + b2 * b2; }
        }
        ss += __shfl_xor(ss, 1);
        const float rstd = rsqrtf(ss * (1.f / 256.f) + RMS_EPS);
#pragma unroll 1
        for (int j = 0; j < 16; ++j) {
            const u32x4 bb = *(const u32x4*)(src + j * 8);
            const unsigned uu[4] = {bb.x, bb.y, bb.z, bb.w};
            const int cb = half * 128 + j * 8;
#pragma unroll
            for (int q = 0; q < 4; ++q) {
#pragma unroll
                for (int hh = 0; hh < 2; ++hh) {
                    const int c = cb + q * 2 + hh;
                    const float val = (hh ? bfhi(uu[q]) : bflo(uu[q])) * rstd * ng[c];
                    *(bf16_t*)(lds + c * 256 + ((((s >> 3) ^ (c & 15))) << 4) + (s & 7) * 2) = f2bf(val);
                }
            }
        }
    }
    vb_sync(lds);
    const int g = w;
#pragma unroll 1
    for (int th = 0; th < (DBG_SGUCUT == 1 ? 0 : 2); ++th) {
        f32x4 acc[4][4];
        zero_acc(acc);
#pragma unroll
        for (int ks = 0; ks < 4; ++ks) {
            if (32 * ks <= 64 * th + 63) {
                bf16x8 vf[4];
#pragma unroll
                for (int di = 0; di < 4; ++di) { const int c = 64 * g + 16 * di + fr; vf[di] = *(const bf16x8*)(lds + c * 256 + (((4 * ks + fq) ^ (c & 15)) << 4)); }
#pragma unroll
                for (int ti = 0; ti < 4; ++ti) {
                    const int t = 64 * th + 16 * ti + fr;
                    if (32 * ks <= 64 * th + 16 * ti + 15) {
                        const bf16x8 wf = *(const bf16x8*)(Wt + ((size_t)(g * 128 + t)) * 128 + 32 * ks + 8 * fq);
#pragma unroll
                        for (int di = 0; di < 4; ++di) acc[ti][di] = mfma16(vf[di], wf, acc[ti][di]);
                    }
                }
            }
        }
#pragma unroll
        for (int ti = 0; ti < 4; ++ti) {
            const int t = 64 * th + 16 * ti + fr; const float bb = bs[g * 128 + t];
#pragma unroll
            for (int di = 0; di < 4; ++di) {
                const int c = 64 * g + 16 * di + 4 * fq;
                const u32x2 uu = *(const u32x2*)(U + (size_t)t * 256 + c);
                u32x2 o;
                o.x = pk_bf16(bflo(uu.x) * (acc[ti][di][0] + bb), bfhi(uu.x) * (acc[ti][di][1] + bb));
                o.y = pk_bf16(bflo(uu.y) * (acc[ti][di][2] + bb), bfhi(uu.y) * (acc[ti][di][3] + bb));
                *(u32x2*)(O + (size_t)t * 256 + c) = o;
            }
        }
    }
    vb_sync(lds);
}

__device__ __forceinline__ void s5_job(CKP& p, int l, int jb, int pass, unsigned char* lds) {
    job_fence();
    const int tid = opaque_tid(), lane = tid & 63, w = tid >> 6, fr = lane & 15, fq = lane >> 4;
    const int id = ((jb * 4 + w) + DBG_IDROT) & 2047, seq = id >> 4, ch = id & 15, b = seq >> 4, g = seq & 15;
    unsigned char* W = p.ws + OFF_W;
    const float* ab = (const float*)(W + W_S5A) + (g * 64 + lane) * 2;
    float ar = ab[0], ai = ab[1];
    float br[16], bi[16];
    {
        const float* bb = (const float*)(W + W_S5B) + (size_t)(g * 64 + lane) * 32;
#pragma unroll
        for (int h = 0; h < 16; ++h) { br[h] = bb[h]; bi[h] = bb[16 + h]; }
    }
#if DBG_S5CONST >= 2
    { const float q = (float)(lane + 1) * 0.001f; ar = 0.99f - q; ai = 0.05f + q;
      for (int h = 0; h < 16; ++h) { br[h] = 0.01f * (float)(h + 1) + q; bi[h] = -0.02f * (float)(h + 1) + q; } }
#endif
    float* Eb = (float*)(p.ws + OFF_C + C_S5E);
    float hre = 0.f, him = 0.f;
    bf16x8 cf[4]; float dv[4];
    if (pass == 2) {
        const float* a2 = (const float*)(W + W_S5A256) + (g * 64 + lane) * 2;
        const float a2r = a2[0], a2i = a2[1];
        for (int c2 = 0; c2 < ch; ++c2) {
            const float* e = Eb + ((size_t)(seq * 16 + c2) * 64 + lane) * 2;
            const float nr = a2r * hre - a2i * him + e[0], ni = a2r * him + a2i * hre + e[1];
            hre = nr; him = ni;
        }
        const bf16_t* cm = (const bf16_t*)(W + W_S5C) + (size_t)(g * 16 + fr) * 128;
#pragma unroll
        for (int ks = 0; ks < 4; ++ks) cf[ks] = *(const bf16x8*)(cm + 32 * ks + 8 * fq);
#pragma unroll
        for (int r = 0; r < 4; ++r) dv[r] = p.in[22][(size_t)l * 256 + g * 16 + 4 * fq + r];
    }
    const bf16_t* xin = (const bf16_t*)(p.ws + OFF_R + R_S5IN) + ((size_t)(b * SEQ + ch * 256)) * 256 + g * 16;
    bf16_t* yg = (bf16_t*)(p.ws + OFF_C + C_YG) + ((size_t)(b * SEQ + ch * 256)) * 256 + g * 16;
    float* xs = (float*)(lds + w * 10240);
    int ldsbad = 0; (void)ldsbad;
    unsigned char* Hs = lds + w * 10240 + 2048;
#if DBG_TWICE
    float keep_re = 0.f, keep_im = 0.f;
#pragma unroll 1
    for (int rep = 0; rep < 2; ++rep) {
    if (rep == 1) { keep_re = hre; keep_im = him; hre = 0.f; him = 0.f; }
#endif
#pragma unroll 1
    for (int sub = 0; sub < 8; ++sub) {
#if DBG_S5CONST >= 1
        u32x4 xv; { const unsigned q = (unsigned)(sub * 32 + (lane >> 1)) * 2654435761u + (unsigned)id * 40503u + (lane & 1); xv.x = 0x3f803e80u ^ ((q & 0xff) << 16); xv.y = 0x3e003d00u ^ ((q >> 8) & 0x7f); xv.z = 0xbe803f00u ^ ((q >> 16) & 0x3f); xv.w = 0x3d80be00u; }
#else
        const u32x4 xv = *(const u32x4*)(xin + (size_t)(sub * 32 + (lane >> 1)) * 256 + (lane & 1) * 8);
#endif
        vb_sync(lds);
        f32x4 chk_a = {bflo(xv.x), bfhi(xv.x), bflo(xv.y), bfhi(xv.y)}, chk_c = {bflo(xv.z), bfhi(xv.z), bflo(xv.w), bfhi(xv.w)};
        {
            *(f32x4*)(xs + (lane >> 1) * 16 + (lane & 1) * 8) = chk_a;
            *(f32x4*)(xs + (lane >> 1) * 16 + (lane & 1) * 8 + 4) = chk_c;
        }
        vb_sync(lds);
#pragma unroll 4
        for (int st = 0; st < 32; ++st) {
#if DBG_S5CONST == 3
            f32x4 x0, x1, x2, x3;
            { const float t = (float)((sub * 32 + st) & 63) * 0.015625f + (float)(id & 7) * 0.125f;
              x0 = (f32x4){t, t * 0.5f, -t, 0.25f}; x1 = (f32x4){0.5f - t, t * t, 0.125f, t}; x2 = (f32x4){-0.25f, t, 0.75f * t, 1.f - t}; x3 = (f32x4){t, -t, 0.5f, 0.3f * t}; }
#else
            const f32x4 x0 = *(const f32x4*)(xs + st * 16), x1 = *(const f32x4*)(xs + st * 16 + 4), x2 = *(const f32x4*)(xs + st * 16 + 8), x3 = *(const f32x4*)(xs + st * 16 + 12);
#endif
            float ur = 0.f, ui = 0.f;
#pragma unroll
            for (int h = 0; h < 4; ++h) {
                ur += br[h] * x0[h]; ui += bi[h] * x0[h];
                ur += br[4 + h] * x1[h]; ui += bi[4 + h] * x1[h];
                ur += br[8 + h] * x2[h]; ui += bi[8 + h] * x2[h];
                ur += br[12 + h] * x3[h]; ui += bi[12 + h] * x3[h];
            }
            const float nr = ar * hre - ai * him + ur, ni = ar * him + ai * hre + ui;
            hre = nr; him = ni;
            if (pass == 2) {
                *(bf16_t*)(Hs + st * 256 + (((lane >> 3) ^ (st & 15)) << 4) + (lane & 7) * 2) = f2bf(hre);
                *(bf16_t*)(Hs + st * 256 + ((((64 + lane) >> 3) ^ (st & 15)) << 4) + (lane & 7) * 2) = f2bf(him);
            }
        }
#if DBG_LDSCHK
        {
            const f32x4 ra = *(volatile f32x4*)(xs + (lane >> 1) * 16 + (lane & 1) * 8), rc = *(volatile f32x4*)(xs + (lane >> 1) * 16 + (lane & 1) * 8 + 4);
            bool bad = false;
            for (int q = 0; q < 4; ++q) bad |= (__float_as_uint(ra[q]) != __float_as_uint(chk_a[q])) | (__float_as_uint(rc[q]) != __float_as_uint(chk_c[q]));
            if (__any(bad)) ldsbad = 1;
        }
#endif
        if (pass == 2) {
            vb_sync(lds);
#pragma unroll
            for (int tt = 0; tt < 2; ++tt) {
                f32x4 acc = {0.f, 0.f, 0.f, 0.f};
                const int tl = tt * 16 + fr;
#pragma unroll
                for (int ks = 0; ks < 4; ++ks) {
                    const bf16x8 hf = *(const bf16x8*)(Hs + tl * 256 + (((4 * ks + fq) ^ (tl & 15)) << 4));
                    acc = mfma16(cf[ks], hf, acc);
                }
                float y[4];
#pragma unroll
                for (int r = 0; r < 4; ++r) y[r] = gelu_tanh(acc[r] + dv[r] * xs[tl * 16 + 4 * fq + r]);
                u32x2 o; o.x = pk_bf16(y[0], y[1]); o.y = pk_bf16(y[2], y[3]);
                *(u32x2*)(yg + (size_t)(sub * 32 + tl) * 256 + 4 * fq) = o;
            }
        }
    }
#if DBG_TWICE
    }
    if (__float_as_uint(keep_re) != __float_as_uint(hre) || __float_as_uint(keep_im) != __float_as_uint(him)) { hre = __uint_as_float(0x7fc00000u); him = hre; }
#endif
    if (pass == 1) {
        float* e = Eb + ((size_t)(seq * 16 + ch) * 64 + lane) * 2;
#if DBG_LDSCHK
        if (ldsbad) { hre = __uint_as_float(0x7fc00000u); him = hre; }
#endif
#if DBG_ESC1
        { const unsigned long long pk = ((unsigned long long)__float_as_uint(him) << 32) | __float_as_uint(hre);
          __hip_atomic_store((unsigned long long*)e, pk, __ATOMIC_RELAXED, __HIP_MEMORY_SCOPE_AGENT); }
#else
        e[0] = hre; e[1] = him;
#endif
#if DBG_E2
        float* e2 = (float*)(p.ws + OFF_C + C_ATT) + ((size_t)(seq * 16 + ch) * 64 + lane) * 2;
        e2[0] = hre; e2[1] = him;
#endif
    }
    vb_sync(lds);
}

__device__ __forceinline__ void phase_mid1(CKP& p, int l, unsigned char* lds) {
    if (blockIdx.x < 64) { compress_tile(p, (int)blockIdx.x, lds); return; }
    for (int j = VBID() - 128; j < 768; j += VGRID() - 128) {
        if (j < 256) sgu_job(p, l, j, lds);
        else s5_job(p, l, j - 256, 1, lds);
    }
}

constexpr int AL_Q = 0, AL_KV = 32768, AL_IMP = 49152, AL_SEL = 65792, AL_UNI = 66304, AL_JOB = 66336;
constexpr float SM_C = 0.125f * 1.4426950408889634f;

__device__ __forceinline__ void attn_load_q(const bf16_t* Qg, const int* pos, const float (&inv_freq)[8], int b, int g, int t0, bool rope, unsigned char* lds, int tid) {
#pragma unroll 1
    for (int j = 0; j < 8; ++j) {
        const int pid = tid + 256 * j, Rr = pid >> 3, ch = pid & 7;
        const int wq = Rr >> 6, r = (Rr >> 4) & 3, q = Rr & 15, t = t0 + 16 * wq + q;
        const bf16_t* src = Qg + ((size_t)(b * SEQ + t)) * 512 + (g * 4 + r) * 64;
        if (!rope || ch >= 2) {
            *(u32x4*)(lds + AL_Q + Rr * 128 + ((ch ^ (Rr & 7)) << 4)) = *(const u32x4*)(src + ch * 8);
        } else if (ch == 0) {
            const u32x4 a = *(const u32x4*)(src), c = *(const u32x4*)(src + 8);
            float x1[8] = {bflo(a.x), bfhi(a.x), bflo(a.y), bfhi(a.y), bflo(a.z), bfhi(a.z), bflo(a.w), bfhi(a.w)};
            float x2[8] = {bflo(c.x), bfhi(c.x), bflo(c.y), bfhi(c.y), bflo(c.z), bfhi(c.z), bflo(c.w), bfhi(c.w)};
            const float ps = (float)pos[b * SEQ + t];
#pragma unroll
            for (int i = 0; i < 8; ++i) {
                float sn, cs; sincosf(ps * inv_freq[i], &sn, &cs);
                const float u = x1[i], v = x2[i];
                x1[i] = u * cs - v * sn; x2[i] = v * cs + u * sn;
            }
            u32x4 o1, o2;
            o1.x = pk_bf16(x1[0], x1[1]); o1.y = pk_bf16(x1[2], x1[3]); o1.z = pk_bf16(x1[4], x1[5]); o1.w = pk_bf16(x1[6], x1[7]);
            o2.x = pk_bf16(x2[0], x2[1]); o2.y = pk_bf16(x2[2], x2[3]); o2.z = pk_bf16(x2[4], x2[5]); o2.w = pk_bf16(x2[6], x2[7]);
            *(u32x4*)(lds + AL_Q + Rr * 128 + ((0 ^ (Rr & 7)) << 4)) = o1;
            *(u32x4*)(lds + AL_Q + Rr * 128 + ((1 ^ (Rr & 7)) << 4)) = o2;
        }
    }
}
__device__ __forceinline__ void attn_ldg(u32x4 (&kk)[2], u32x4 (&vv)[2], const bf16_t* Kb, const bf16_t* Vb, int vstride, int tid) {
#pragma unroll
    for (int j = 0; j < 2; ++j) {
        const int pid = tid + 256 * j, row = pid >> 3, ch = pid & 7;
        kk[j] = *(const u32x4*)(Kb + (size_t)row * 128 + ch * 8);
        vv[j] = *(const u32x4*)(Vb + (size_t)row * vstride + ch * 8);
    }
}
__device__ __forceinline__ void attn_stl(const u32x4 (&kk)[2], const u32x4 (&vv)[2], unsigned char* lds, int kvoff, int tid) {
#pragma unroll
    for (int j = 0; j < 2; ++j) {
        const int pid = tid + 256 * j, row = pid >> 3, ch = pid & 7;
        *(u32x4*)(lds + kvoff + row * 128 + ((ch ^ (row & 7)) << 4)) = kk[j];
        *(u32x4*)(lds + kvoff + 8192 + row * 128 + ((ch ^ ((row >> 1) & 7)) << 4)) = vv[j];
    }
}
__device__ __forceinline__ void attn_qk(f32x4 (&s)[2][4], const unsigned char* lds, int kvoff, int w, int fr, int fq, int hf) {
    const unsigned char* Qw = lds + AL_Q + w * 8192;
    const unsigned char* Kh = lds + kvoff + hf * 4096;
    const int sw0 = ((fq) ^ (fr & 7)) << 4, sw1 = ((4 + fq) ^ (fr & 7)) << 4;
#pragma unroll
    for (int ki = 0; ki < 2; ++ki)
#pragma unroll
        for (int qi = 0; qi < 4; ++qi) s[ki][qi] = (f32x4){0.f, 0.f, 0.f, 0.f};
#pragma unroll
    for (int ds = 0; ds < 2; ++ds) {
        bf16x8 qf[4];
#pragma unroll
        for (int qi = 0; qi < 4; ++qi) qf[qi] = *(const bf16x8*)(Qw + (qi * 16 + fr) * 128 + (ds ? sw1 : sw0));
#pragma unroll
        for (int ki = 0; ki < 2; ++ki) {
            const bf16x8 kf = *(const bf16x8*)(Kh + (ki * 16 + fr) * 128 + (ds ? sw1 : sw0));
#pragma unroll
            for (int qi = 0; qi < 4; ++qi) s[ki][qi] = mfma16(kf, qf[qi], s[ki][qi]);
        }
    }
}
__device__ __forceinline__ void attn_pv(f32x4 (&o)[4][4], const f32x4 (&s)[2][4], const unsigned char* lds, int kvoff, int fr, int fq, int hf) {
    bf16x8 pf[4];
#pragma unroll
    for (int qi = 0; qi < 4; ++qi) {
        u32x4 u;
        u.x = pk_bf16(s[0][qi][0], s[0][qi][1]); u.y = pk_bf16(s[0][qi][2], s[0][qi][3]);
        u.z = pk_bf16(s[1][qi][0], s[1][qi][1]); u.w = pk_bf16(s[1][qi][2], s[1][qi][3]);
        pf[qi] = as_bf8(u);
    }
    const int c0 = 4 * hf + (fq >> 1);
    const unsigned char* Vt = lds + kvoff + 8192;
#pragma unroll
    for (int di = 0; di < 4; ++di) {
        const int row = di * 16 + fr, key = (row >> 1) & 7;
        const u32x2 lo = *(const u32x2*)(Vt + row * 128 + ((c0 ^ key) << 4) + 8 * (fq & 1));
        const u32x2 hi = *(const u32x2*)(Vt + row * 128 + (((c0 + 2) ^ key) << 4) + 8 * (fq & 1));
        const bf16x8 vf = as_bf8((u32x4){lo.x, lo.y, hi.x, hi.y});
#pragma unroll
        for (int qi = 0; qi < 4; ++qi) o[di][qi] = mfma16(vf, pf[qi], o[di][qi]);
    }
}
__device__ __forceinline__ unsigned attn_vmask(int kb, int fq, int lo, int hi) {
    unsigned vm = 0;
#pragma unroll
    for (int ki = 0; ki < 2; ++ki)
#pragma unroll
        for (int r = 0; r < 4; ++r) { const int key = kb + 16 * ki + 4 * fq + r; if (key >= lo && key <= hi) vm |= 1u << (ki * 4 + r); }
    return vm;
}
__device__ __forceinline__ void attn_softmax(f32x4 (&s)[2][4], f32x4 (&o)[4][4], float (&m)[4], float (&lsum)[4], unsigned vm) {
#pragma unroll
    for (int qi = 0; qi < 4; ++qi) {
        float mx = -1e30f;
#pragma unroll
        for (int ki = 0; ki < 2; ++ki)
#pragma unroll
            for (int r = 0; r < 4; ++r) { const float sv = ((vm >> (ki * 4 + r)) & 1u) ? s[ki][qi][r] * SM_C : -1e30f; s[ki][qi][r] = sv; mx = fmaxf(mx, sv); }
        mx = xmax16(mx); mx = xmax32(mx);
        const float mn = fmaxf(m[qi], mx), alpha = fexp2(m[qi] - mn);
        m[qi] = mn;
        float ls = 0.f;
#pragma unroll
        for (int ki = 0; ki < 2; ++ki)
#pragma unroll
            for (int r = 0; r < 4; ++r) { const float pv = ((vm >> (ki * 4 + r)) & 1u) ? fexp2(s[ki][qi][r] - mn) : 0.f; s[ki][qi][r] = pv; ls += pv; }
        lsum[qi] = lsum[qi] * alpha + ls;
        if (__any(alpha != 1.f)) {
#pragma unroll
            for (int di = 0; di < 4; ++di) o[di][qi] *= alpha;
        }
    }
}
__device__ __forceinline__ void attn_softmax_full(f32x4 (&s)[2][4], f32x4 (&o)[4][4], float (&m)[4], float (&lsum)[4], bool lsel) {
#pragma unroll
    for (int qi = 0; qi < 4; ++qi) {
        float mx = fmaxf(fmaxf(fmaxf(s[0][qi][0], s[0][qi][1]), fmaxf(s[0][qi][2], s[0][qi][3])), fmaxf(fmaxf(s[1][qi][0], s[1][qi][1]), fmaxf(s[1][qi][2], s[1][qi][3])));
        mx = xmax16(mx); mx = xmax32(mx);
        const float mn = fmaxf(m[qi], mx * SM_C);
        const float mnew = lsel ? mn : m[qi];
        const float alpha = fexp2(m[qi] - mnew);
        m[qi] = mnew;
        const float neg = lsel ? -mn : -1e30f;
        float ls = 0.f;
#pragma unroll
        for (int ki = 0; ki < 2; ++ki)
#pragma unroll
            for (int r = 0; r < 4; ++r) { const float pv = fexp2(fmaf(s[ki][qi][r], SM_C, neg)); s[ki][qi][r] = pv; ls += pv; }
        lsum[qi] = lsum[qi] * alpha + ls;
        if (__any(alpha != 1.f)) {
#pragma unroll
            for (int di = 0; di < 4; ++di) o[di][qi] *= alpha;
        }
    }
}
__device__ __forceinline__ void attn_softmax_fast(f32x4 (&s)[2][4], const float (&m)[4], float (&lsum)[4], unsigned vm, bool& ovf) {
#pragma unroll
    for (int qi = 0; qi < 4; ++qi) {
        const float neg = -m[qi]; float l = 0.f;
#pragma unroll
        for (int ki = 0; ki < 2; ++ki)
#pragma unroll
            for (int r = 0; r < 4; ++r) { const float pv = ((vm >> (ki * 4 + r)) & 1u) ? fexp2(fmaf(s[ki][qi][r], SM_C, neg)) : 0.f; s[ki][qi][r] = pv; l += pv; }
        lsum[qi] += l; ovf |= !(l < 1.0e12f);
    }
}
__device__ __forceinline__ void attn_accum(bf16_t* dst, const f32x4 (&o)[4][4], const float (&lsum)[4], const float (&gate)[4], bool first, int fq) {
#pragma unroll
    for (int qi = 0; qi < 4; ++qi) {
        float lt = lsum[qi]; lt = xsum16(lt); lt = xsum32(lt);
        const float sc = gate[qi] / fmaxf(lt, 1e-30f);
#pragma unroll
        for (int di = 0; di < 4; ++di) {
            u32x2* ptr = (u32x2*)(dst + qi * 64 + 16 * di + 4 * fq);
            float a0 = o[di][qi][0] * sc, a1 = o[di][qi][1] * sc, a2 = o[di][qi][2] * sc, a3 = o[di][qi][3] * sc;
            if (!first) { const u32x2 f = *ptr; a0 += bflo(f.x); a1 += bfhi(f.x); a2 += bflo(f.y); a3 += bfhi(f.y); }
            u32x2 r; r.x = pk_bf16(a0, a1); r.y = pk_bf16(a2, a3);
            *ptr = r;
        }
    }
}
__device__ __forceinline__ bool attn_retry(bool ovf, unsigned char* lds, int tid) {
    volatile LAS int* flag = (volatile LAS int*)(LAS unsigned char*)(lds + AL_JOB + 4);
    if (__any(ovf) && (tid & 63) == 0) *flag = 1;
    vb_sync(lds);
    const int rf = *flag;
    vb_sync(lds);
    if (rf && tid == 0) *flag = 0;
    return rf != 0;
}
template <class NextF, class PtrF, class BodyF>
__device__ __forceinline__ void attn_tiles(int first, NextF next, PtrF ptrs, BodyF body, unsigned char* lds, int tid) {
    u32x4 kk[2], vv[2];
    const bf16_t* Kb; const bf16_t* Vb; int vs;
    ptrs(first, Kb, Vb, vs);
    attn_ldg(kk, vv, Kb, Vb, vs, tid);
    int cur = first;
    while (cur >= 0) {
        vb_sync(lds);
        attn_stl(kk, vv, lds, AL_KV, tid);
        vb_sync(lds);
        const int nx = next(cur);
        if (nx >= 0) { ptrs(nx, Kb, Vb, vs); attn_ldg(kk, vv, Kb, Vb, vs, tid); }
        body(cur, AL_KV);
        cur = nx;
    }
}

__device__ __forceinline__ void phase_attn(CKP& p, int l, unsigned char* lds, unsigned* ctl) {
    for (int j = VBID(); j < 512; j += VGRID()) s5_job(p, l, j, 2, lds);

    unsigned char* R = p.ws + OFF_R; unsigned char* C = p.ws + OFF_C;
    const bf16_t* Qg = (const bf16_t*)(R + R_Q);
    const bf16_t* Kc = (const bf16_t*)(C + C_KCMP); const bf16_t* Vc = (const bf16_t*)(C + C_VCT);
    const bf16_t* Ks = (const bf16_t*)(R + R_KS); const bf16_t* Vs = (const bf16_t*)(R + R_VST);
    const bf16_t* Kw = (const bf16_t*)(R + R_KW); const bf16_t* Vw = (const bf16_t*)(R + R_VWT);
    const float* NG = (const float*)(R + R_NG);
    bf16_t* AO = (bf16_t*)(C + C_ATT);
    const int* pos = (const int*)p.in[1];
    unsigned* ctr = ctl + CTL_ATTN + l;
    float invf[8];
#pragma unroll
    for (int q = 0; q < 8; ++q) invf[q] = p.inv_freq[q];

    if (opaque_tid() == 0) { *(volatile int*)(lds + AL_JOB + 8) = 0; *(volatile int*)(lds + AL_JOB + 4) = 0; }
    for (;;) {
        lds = vb_lds();
        volatile int* jobp = (volatile int*)(lds + AL_JOB);
        float* imp = (float*)(lds + AL_IMP);
        unsigned long long* selm = (unsigned long long*)(lds + AL_SEL);
        unsigned long long* uni = (unsigned long long*)(lds + AL_UNI);
        const int tid = opaque_tid(), lane = tid & 63, w = tid >> 6, fr = lane & 15, fq = lane >> 4;
        vb_sync(lds);
        if (tid == 0) { *jobp = (int)atomicAdd(ctr, 1u); *(volatile int*)(lds + AL_JOB + 8) += 1; }
        vb_sync(lds);
        const int job = *jobp, grabs = *(volatile int*)(lds + AL_JOB + 8);
        if (grabs == 2 || (job >= 1024 && grabs == 1)) convert_tiles(p, l, 11, 14, VBID() * 4 + w, VGRID() * 4, lane);
        if (job >= 1024) break;
        const int i = 63 - (job >> 4), bg = job & 15, b = bg >> 1, g = bg & 1, t0 = i * 64;
        const int tq = t0 + 16 * w + fr;
        const size_t kvrow = (size_t)b * SEQ;
        float gate[4]; bf16_t* dstq_;

        attn_load_q(Qg, pos, invf, b, g, t0, false, lds, tid);
        const int ntc = ((4 * i + 2) >> 6) + 1;
        const int hic = (tq >= 31) ? ((tq - 31) >> 4) : -1;
        float m[4], lsum[4];
#pragma unroll
        for (int qi = 0; qi < 4; ++qi) { m[qi] = -1e30f; lsum[qi] = 0.f; }
        auto cmp_next = [&](int ct) { return (ct + 1 < ntc) ? ct + 1 : -1; };
        auto cmp_ptrs = [&](int ct, const bf16_t*& Kb, const bf16_t*& Vb, int& vs) {
            Kb = Kc + ((size_t)(b * 256 + ct * 64)) * 128 + g * 64; Vb = Vc + ((size_t)((b * 2 + g) * 64)) * 256 + ct * 64; vs = 256; };
        attn_tiles(0, cmp_next, cmp_ptrs, [&](int ct, int kvoff) {
#pragma unroll 1
            for (int hf = 0; hf < 2; ++hf) {
                f32x4 s[2][4];
                attn_qk(s, lds, kvoff, w, fr, fq, hf);
                const unsigned vm = attn_vmask(ct * 64 + hf * 32, fq, 0, hic);
#pragma unroll
                for (int qi = 0; qi < 4; ++qi) {
                    float mx = -1e30f;
#pragma unroll
                    for (int ki = 0; ki < 2; ++ki)
#pragma unroll
                        for (int r = 0; r < 4; ++r) { const float sv = ((vm >> (ki * 4 + r)) & 1u) ? s[ki][qi][r] * SM_C : -1e30f; s[ki][qi][r] = sv; mx = fmaxf(mx, sv); }
                    mx = xmax16(mx); mx = xmax32(mx);
                    const float mn = fmaxf(m[qi], mx), alpha = fexp2(m[qi] - mn);
                    m[qi] = mn;
                    float ls = 0.f;
#pragma unroll
                    for (int ki = 0; ki < 2; ++ki)
#pragma unroll
                        for (int r = 0; r < 4; ++r) ls += ((vm >> (ki * 4 + r)) & 1u) ? fexp2(s[ki][qi][r] - mn) : 0.f;
                    lsum[qi] = lsum[qi] * alpha + ls;
                }
            }
        }, lds, tid);
        float invl[4];
#pragma unroll
        for (int qi = 0; qi < 4; ++qi) { float lt = lsum[qi]; lt = xsum16(lt); lt = xsum32(lt); invl[qi] = 1.f / fmaxf(lt, 1e-30f); }
        {
            f32x4 o[4][4]; zero_acc(o);
            float carry = 0.f;
            attn_tiles(0, cmp_next, cmp_ptrs, [&](int ct, int kvoff) {
#pragma unroll 1
                for (int hf = 0; hf < 2; ++hf) {
                    f32x4 s[2][4];
                    attn_qk(s, lds, kvoff, w, fr, fq, hf);
                    const unsigned vm = attn_vmask(ct * 64 + hf * 32, fq, 0, hic);
#pragma unroll
                    for (int qi = 0; qi < 4; ++qi)
#pragma unroll
                        for (int ki = 0; ki < 2; ++ki)
#pragma unroll
                            for (int r = 0; r < 4; ++r) s[ki][qi][r] = ((vm >> (ki * 4 + r)) & 1u) ? fexp2(s[ki][qi][r] * SM_C - m[qi]) * invl[qi] : 0.f;
#pragma unroll
                    for (int ki = 0; ki < 2; ++ki) {
                        float a = 0.f, bq = 0.f;
#pragma unroll
                        for (int qi = 0; qi < 4; ++qi) { a += s[ki][qi][0] + s[ki][qi][1] + s[ki][qi][2] + 0.5f * s[ki][qi][3]; bq += 0.5f * s[ki][qi][3]; }
                        const float up = bperm_f((lane + 48) & 63, bq);
                        const float wrap = bperm_f((lane + 48) & 63, carry);
                        a += (fq >= 1) ? up : wrap;
                        carry = bq;
                        imp[(16 * w + fr) * 65 + 16 * ct + 8 * hf + 4 * ki + fq] = a;
                    }
                    attn_pv(o, s, lds, kvoff, fr, fq, hf);
                }
            }, lds, tid);
#pragma unroll
            for (int qi = 0; qi < 4; ++qi) { int rq = (int)kvrow + tq; asm volatile("" : "+v"(rq)); gate[qi] = NG[(size_t)rq * 24 + (g * 4 + qi) * 3 + 0]; }
            const float quarter[4] = {0.25f, 0.25f, 0.25f, 0.25f};
            { int rq2 = (int)kvrow + tq; asm volatile("" : "+v"(rq2)); dstq_ = AO + (size_t)rq2 * 512 + (g * 4) * 64; } attn_accum(dstq_, o, quarter, gate, true, fq);
        }
        vb_sync(lds);
        {
            const int q = tid >> 2, part = tid & 3;
            unsigned long long mk = 0ull;
            if (i <= 15) { mk = (i == 63) ? ~0ull : ((1ull << (i + 1)) - 1ull); }
            else {
                const float* row = imp + q * 65;
                for (int j = 1 + part; j <= i - 2; j += 4) {
                    const float vj = row[j]; int rank = 0;
                    for (int j2 = 1; j2 <= i - 2; ++j2) { const float v2 = row[j2]; rank += (v2 > vj || (v2 == vj && j2 < j)) ? 1 : 0; }
                    if (rank < 13) mk |= 1ull << j;
                }
                unsigned lo32 = (unsigned)mk, hi32 = (unsigned)(mk >> 32);
                lo32 |= bperm_u(lane ^ 1, lo32); hi32 |= bperm_u(lane ^ 1, hi32);
                lo32 |= bperm_u(lane ^ 2, lo32); hi32 |= bperm_u(lane ^ 2, hi32);
                mk = ((unsigned long long)hi32 << 32) | lo32;
                mk |= 1ull | (1ull << i) | (1ull << (i - 1));
            }
            if (part == 0) selm[q] = mk;
            unsigned lo32 = (unsigned)mk, hi32 = (unsigned)(mk >> 32);
#pragma unroll
            for (int o2 = 32; o2 >= 1; o2 >>= 1) { lo32 |= bperm_u(lane ^ o2, lo32); hi32 |= bperm_u(lane ^ o2, hi32); }
            if (lane == 0) uni[w] = ((unsigned long long)hi32 << 32) | lo32;
        }
        vb_sync(lds);
        const unsigned long long mymask = selm[16 * w + fr];
        const unsigned long long un = uni[0] | uni[1] | uni[2] | uni[3];
        vb_sync(lds);
        attn_load_q((const bf16_t*)(R + R_QR), pos, invf, b, g, t0, false, lds, tid);
        auto sel_branch = [&](auto mode_c) -> bool {
            constexpr int mode = decltype(mode_c)::value;
            int kvr = (int)kvrow, bl = b, gl = g; asm volatile("" : "+v"(kvr), "+v"(bl), "+v"(gl));
            f32x4 o[4][4]; zero_acc(o);
#pragma unroll
            for (int qi = 0; qi < 4; ++qi) { m[qi] = -1e30f; lsum[qi] = 0.f; }
            bool ovf = false;
            attn_tiles(0,
                [&](int j) { const unsigned long long rest = (j >= 63) ? 0ull : (un >> (j + 1)); return rest ? (j + 1 + (int)__ffsll((long long)rest) - 1) : -1; },
                [&](int j, const bf16_t*& Kb, const bf16_t*& Vb, int& vs) { Kb = Ks + ((size_t)kvr + j * 64) * 128 + gl * 64; Vb = Vs + ((size_t)((bl * 2 + gl) * 64)) * SEQ + j * 64; vs = SEQ; },
                [&](int j, int kvoff) {
                    const bool lsel = ((mymask >> j) & 1ull) != 0ull;
                    const int hi = lsel ? tq : -1;
#pragma unroll 1
                    for (int hf = 0; hf < 2; ++hf) {
                        f32x4 s[2][4];
                        attn_qk(s, lds, kvoff, w, fr, fq, hf);
                        if (j == 0 || mode) { if (j < i) attn_softmax_full(s, o, m, lsum, lsel); else { const unsigned vm = attn_vmask(j * 64 + hf * 32, fq, 0, hi); attn_softmax(s, o, m, lsum, vm); } }
                        else { const unsigned vm = (j < i) ? (lsel ? 0xffu : 0u) : attn_vmask(j * 64 + hf * 32, fq, 0, hi); attn_softmax_fast(s, m, lsum, vm, ovf); }
                        attn_pv(o, s, lds, kvoff, fr, fq, hf);
                    }
                }, lds, tid);
            if (mode == 0 && attn_retry(ovf, lds, tid)) return true;
#pragma unroll
            for (int qi = 0; qi < 4; ++qi) { int rq = (int)kvrow + tq; asm volatile("" : "+v"(rq)); gate[qi] = NG[(size_t)rq * 24 + (g * 4 + qi) * 3 + 1]; }
            { int rq2 = (int)kvrow + tq; asm volatile("" : "+v"(rq2)); dstq_ = AO + (size_t)rq2 * 512 + (g * 4) * 64; } attn_accum(dstq_, o, lsum, gate, false, fq);
            return false;
        };
        if (sel_branch(std::integral_constant<int, 0>{})) (void)sel_branch(std::integral_constant<int, 1>{});
        auto win_branch = [&](auto mode_c) -> bool {
            constexpr int mode = decltype(mode_c)::value;
            int kvr = (int)kvrow, bl = b, gl = g; asm volatile("" : "+v"(kvr), "+v"(bl), "+v"(gl));
            f32x4 o[4][4]; zero_acc(o);
#pragma unroll
            for (int qi = 0; qi < 4; ++qi) { m[qi] = -1e30f; lsum[qi] = 0.f; }
            const int j0 = (i >= 8) ? (i - 8) : 0;
            bool ovf = false;
            attn_tiles(j0,
                [&](int j) { return (j + 1 <= i) ? j + 1 : -1; },
                [&](int j, const bf16_t*& Kb, const bf16_t*& Vb, int& vs) { Kb = Kw + ((size_t)kvr + j * 64) * 128 + gl * 64; Vb = Vw + ((size_t)((bl * 2 + gl) * 64)) * SEQ + j * 64; vs = SEQ; },
                [&](int j, int kvoff) {
#pragma unroll 1
                    for (int hf = 0; hf < 2; ++hf) {
                        f32x4 s[2][4];
                        attn_qk(s, lds, kvoff, w, fr, fq, hf);
                        if (j <= j0 + 1 || mode) { const unsigned vm = attn_vmask(j * 64 + hf * 32, fq, tq - 511, tq); attn_softmax(s, o, m, lsum, vm); }
                        else { const unsigned vm = (j >= i - 7 && j < i) ? 0xffu : attn_vmask(j * 64 + hf * 32, fq, tq - 511, tq); attn_softmax_fast(s, m, lsum, vm, ovf); }
                        attn_pv(o, s, lds, kvoff, fr, fq, hf);
                    }
                }, lds, tid);
            if (mode == 0 && attn_retry(ovf, lds, tid)) return true;
#pragma unroll
            for (int qi = 0; qi < 4; ++qi) { int rq = (int)kvrow + tq; asm volatile("" : "+v"(rq)); gate[qi] = NG[(size_t)rq * 24 + (g * 4 + qi) * 3 + 2]; }
            { int rq2 = (int)kvrow + tq; asm volatile("" : "+v"(rq2)); dstq_ = AO + (size_t)rq2 * 512 + (g * 4) * 64; } attn_accum(dstq_, o, lsum, gate, false, fq);
            return false;
        };
        if (win_branch(std::integral_constant<int, 0>{})) (void)win_branch(std::integral_constant<int, 1>{});
    }
}

__device__ __forceinline__ void phase_glu(CKP& p, int l, unsigned char* lds) {
    const int tid = opaque_tid(), lane = tid & 63, w = tid >> 6, wm = w >> 1, wn = w & 1, fr = lane & 15, fq = lane >> 4;
    const bf16_t* A = (const bf16_t*)(p.ws + OFF_C + C_YG);
    const bf16_t* Bt = (const bf16_t*)(p.ws + OFF_W + W_GLU);
    bf16_t* O = (bf16_t*)(p.ws + OFF_C + C_S5O);
    const float* gb = p.in[24] + (size_t)l * 256;
    constexpr int NTM = NTOK / 128, NTN = 2;
    for (int L = VBID(); L < NTM * NTN; L += VGRID()) {
        int tm, tn; tile_coords(L, NTM, NTN, tm, tn);
        const int m0 = tm * 128, n0 = tn * 128;
        f32x4 acc[4][4]; zero_acc(acc);
        gemm_kloop(acc, [&](int r) { return A + (size_t)(m0 + r) * 256; }, 64, [&](int v) { return Bt + (size_t)(n0 + v) * 256; }, 64, 4, lds, tid);
#pragma unroll
        for (int mi = 0; mi < 4; ++mi) {
            const int row = m0 + 64 * wm + 16 * mi + fr, col = n0 + 64 * wn + 16 * fq;
            const u32x4 y0 = *(const u32x4*)(A + (size_t)row * 256 + col), y1 = *(const u32x4*)(A + (size_t)row * 256 + col + 8);
            const unsigned yy[8] = {y0.x, y0.y, y0.z, y0.w, y1.x, y1.y, y1.z, y1.w};
            float v[16];
#pragma unroll
            for (int e = 0; e < 16; ++e) {
                const float y = (e & 1) ? bfhi(yy[e >> 1]) : bflo(yy[e >> 1]);
                v[e] = y * sigm(acc[mi][e >> 2][e & 3] + gb[col + e]);
            }
            store16bf(O + (size_t)row * 256 + col, v);
        }
    }
}

struct G8Branch {
    static constexpr bool GATHER = false;
    const char* ws;
    __device__ __forceinline__ bool next(int i, G8Unit& u, const int (&R)[2], const unsigned (&C2)[2]) const {
        const int T = i / 6, sub = i - T * 6, L = T * (int)gridDim.x + (int)blockIdx.x;
        if (L >= (NTOK / 256) * 4) return false;
        int pm, pn; tile_coords(L, NTOK / 256, 4, pm, pn); pm = __builtin_amdgcn_readfirstlane(pm); pn = __builtin_amdgcn_readfirstlane(pn);
        const int br = sub >> 1;
        if (sub & 1) { u.K2 = 2048u; u.nt = 16; u.A0 = ws + OFF_X + (size_t)pm * 256 * 2048; u.B0 = ws + OFF_W + W_GB + (size_t)(br * 1024 + pn * 256) * 2048; }
        else {
            const unsigned k2 = br == 0 ? 1024u : 512u; u.K2 = k2; u.nt = br == 0 ? 8 : 4;
            const size_t b1 = (size_t)(br == 1), b2 = (size_t)(br == 2);
            const char* a = ws + (size_t)(OFF_C + C_ATT) + b1 * (size_t)(C_SGU - C_ATT) + b2 * (size_t)(C_S5O - C_ATT);
            const char* w = ws + (size_t)(OFF_W + W_A) + b1 * (size_t)(W_S - W_A) + b2 * (size_t)(W_5 - W_A);
            u.A0 = a + (size_t)pm * 256 * k2; u.B0 = w + (size_t)pn * 256 * k2;
        }
        u.A1 = u.A0 + (size_t)128 * u.K2; u.B1 = u.B0 + (size_t)128 * u.K2;
        u.x0 = pm; u.x1 = pn; u.x2 = sub; u.x3 = 0;
#pragma unroll
        for (int h = 0; h < 2; ++h)
#pragma unroll
            for (int k = 0; k < 2; ++k) u.ao[h][k] = (unsigned)R[k] * u.K2 + C2[k];
        return true;
    }
};
struct EpiBranch {
    bf16_t* Yt; bf16_t* Mg; const float* rs1;
    __device__ __forceinline__ void operator()(const G8Acc& acc, const G8Unit& u, int wr, int wc, int fr, int fq) const {
        const int sub = u.x2;
        const size_t off0 = (size_t)(u.x0 * 256 + wr * 64 + fr) * 1024 + u.x1 * 256 + wc * 32 + 8 * fq;
        if (!(sub & 1)) {
#pragma unroll
            for (int ai = 0; ai < 2; ++ai)
#pragma unroll
                for (int m = 0; m < 4; ++m)
#pragma unroll
                    for (int bj = 0; bj < 2; ++bj) {
                        const f32x4 v0 = acc[ai][bj][m][0], v1 = acc[ai][bj][m][1];
                        u32x4 o; o.x = pk_bf16(v0[0], v0[1]); o.y = pk_bf16(v0[2], v0[3]); o.z = pk_bf16(v1[0], v1[1]); o.w = pk_bf16(v1[2], v1[3]);
                        *(u32x4*)(Yt + off0 + (size_t)(ai * 128 + m * 16) * 1024 + bj * 128) = o;
                    }
        } else {
#pragma unroll
            for (int ai = 0; ai < 2; ++ai) {
                float rsv[4];
#pragma unroll
                for (int m = 0; m < 4; ++m) rsv[m] = rs1[u.x0 * 256 + ai * 128 + wr * 64 + m * 16 + fr];
                u32x4 y[4][2], pv[4][2];
#pragma unroll
                for (int m = 0; m < 4; ++m)
#pragma unroll
                    for (int bj = 0; bj < 2; ++bj) {
                        const size_t off = off0 + (size_t)(ai * 128 + m * 16) * 1024 + bj * 128;
                        y[m][bj] = *(const u32x4*)(Yt + off);
                        pv[m][bj] = (u32x4){0u, 0u, 0u, 0u};
                        if (sub > 1) pv[m][bj] = *(const u32x4*)(Mg + off);
                    }
#pragma unroll
                for (int m = 0; m < 4; ++m)
#pragma unroll
                    for (int bj = 0; bj < 2; ++bj) {
                        const f32x4 v0 = acc[ai][bj][m][0] * rsv[m], v1 = acc[ai][bj][m][1] * rsv[m];
                        const u32x4 yy = y[m][bj], pp = pv[m][bj];
                        u32x4 o;
                        o.x = pk_bf16(sigm(v0[0]) * bflo(yy.x) + bflo(pp.x), sigm(v0[1]) * bfhi(yy.x) + bfhi(pp.x));
                        o.y = pk_bf16(sigm(v0[2]) * bflo(yy.y) + bflo(pp.y), sigm(v0[3]) * bfhi(yy.y) + bfhi(pp.y));
                        o.z = pk_bf16(sigm(v1[0]) * bflo(yy.z) + bflo(pp.z), sigm(v1[1]) * bfhi(yy.z) + bfhi(pp.z));
                        o.w = pk_bf16(sigm(v1[2]) * bflo(yy.w) + bflo(pp.w), sigm(v1[3]) * bfhi(yy.w) + bfhi(pp.w));
                        *(u32x4*)(Mg + off0 + (size_t)(ai * 128 + m * 16) * 1024 + bj * 128) = o;
                    }
            }
        }
    }
};
__device__ __forceinline__ void phase_branch(CKP& p, int l, unsigned char* lds) {
    G8Branch S{(const char*)p.ws};
    EpiBranch E{(bf16_t*)(p.ws + OFF_R), (bf16_t*)(p.ws + OFF_M), (const float*)(p.ws + OFF_RS1)};
    g8_phase(S, E);
}

struct EpiMix {
    bf16_t* x;
    __device__ __forceinline__ void operator()(const G8Acc& acc, const G8Unit& u, int wr, int wc, int fr, int fq) const {
        bf16_t* xp0 = x + (size_t)(u.x0 * 256 + wr * 64 + fr) * 1024 + u.x1 * 256 + wc * 32 + 8 * fq;
#pragma unroll
        for (int ai = 0; ai < 2; ++ai) {
            u32x4 xv[4][2];
#pragma unroll
            for (int m = 0; m < 4; ++m)
#pragma unroll
                for (int bj = 0; bj < 2; ++bj) xv[m][bj] = *(const u32x4*)(xp0 + (size_t)(ai * 128 + m * 16) * 1024 + bj * 128);
#pragma unroll
            for (int m = 0; m < 4; ++m)
#pragma unroll
                for (int bj = 0; bj < 2; ++bj) {
                    const f32x4 a0 = acc[ai][bj][m][0], a1 = acc[ai][bj][m][1]; const u32x4 xx = xv[m][bj];
                    u32x4 o;
                    o.x = pk_bf16(bflo(xx.x) + a0[0], bfhi(xx.x) + a0[1]); o.y = pk_bf16(bflo(xx.y) + a0[2], bfhi(xx.y) + a0[3]);
                    o.z = pk_bf16(bflo(xx.z) + a1[0], bfhi(xx.z) + a1[1]); o.w = pk_bf16(bflo(xx.w) + a1[2], bfhi(xx.w) + a1[3]);
                    *(u32x4*)(xp0 + (size_t)(ai * 128 + m * 16) * 1024 + bj * 128) = o;
                }
        }
    }
};
__device__ __forceinline__ void phase_mix(CKP& p, int l, unsigned char* lds) {
    G8Plain S{(const char*)(p.ws + OFF_M), (const char*)(p.ws + OFF_W + W_M), 2048u, 16, NTOK / 256, 4};
    EpiMix E{(bf16_t*)(p.ws + OFF_X)};
    g8_phase(S, E);
}

__device__ __forceinline__ void phase_router(CKP& p, int l, unsigned char* lds, unsigned* ctl) {
    const int tid = opaque_tid(), lane = tid & 63, w = tid >> 6, wm = w >> 1, wn = w & 1, fr = lane & 15, fq = lane >> 4;
    int t512 = TIDX(); asm volatile("" : "+v"(t512));
    const int half = t512 >> 8, w8 = t512 >> 6;
    const float* gam = p.in[27] + (size_t)l * 1024;
    const float* bg = p.in[29] + (size_t)l * 4;
    const float* be = p.in[31] + (size_t)l * 32;
    const bf16_t* xres = (const bf16_t*)(p.ws + OFF_X);
    bf16_t* h2 = (bf16_t*)(p.ws + OFF_M);
    bf16_t* hlo = (bf16_t*)(p.ws + OFF_H);
    const bf16_t* Wh = (const bf16_t*)(p.ws + OFF_W + W_RH);
    const bf16_t* Wl = (const bf16_t*)(p.ws + OFF_W + W_RL);
    unsigned* cnt = ctl + CTL_MOECNT + l * 32;
    int* list = (int*)(p.ws + OFF_MOE + MOE_LIST);
    float* wsl = (float*)(p.ws + OFF_MOE + MOE_WS);
    unsigned char* lds0 = lds_base();
    float* lg = (float*)lds0;
    float* xch = (float*)(lds0 + VB_LDS);
    int* lc = (int*)(lds0 + 18432); int* gbs = (int*)(lds0 + 18432 + 128);
    float* rs = (float*)(lds0 + 65536);
    float* rsl = (float*)(p.ws + OFF_MOE + MOE_RS);
    for (int tile = blockIdx.x; tile < NTOK / 128; tile += gridDim.x) {
        const int r0 = tile * 128;
        {
            for (int rr = 0; rr < 16; rr += 2) {
                const int row = r0 + w8 * 16 + rr;
                float sa = 0.f, sb = 0.f;
#pragma unroll
                for (int i = 0; i < 4; ++i) { const u32x2 ua = *(const u32x2*)(xres + (size_t)row * 1024 + 4 * lane + 256 * i), ub = *(const u32x2*)(xres + (size_t)(row + 1) * 1024 + 4 * lane + 256 * i);
                                              sa += bflo(ua.x) * bflo(ua.x) + bfhi(ua.x) * bfhi(ua.x) + bflo(ua.y) * bflo(ua.y) + bfhi(ua.y) * bfhi(ua.y);
                                              sb += bflo(ub.x) * bflo(ub.x) + bfhi(ub.x) * bfhi(ub.x) + bflo(ub.y) * bflo(ub.y) + bfhi(ub.y) * bfhi(ub.y); }
                sa = wave_sum(sa); sb = wave_sum(sb);
                if (lane == 0) { rs[w8 * 16 + rr] = rsqrtf(sa * (1.f / 1024.f) + RMS_EPS); rs[w8 * 16 + rr + 1] = rsqrtf(sb * (1.f / 1024.f) + RMS_EPS); }
            }
        }
        __syncthreads();
        f32x4 acc[4][4]; zero_acc(acc);
        {
            const bf16_t* Wx = half ? Wl : Wh;
            gemm_kloop(acc, [&](int r) { return xres + (size_t)(r0 + r) * 1024; }, 64, [&](int v) { return Wx + (size_t)(v < 63 ? v : 63) * 1024; }, 64, 16, lds, tid);
        }
        __syncthreads();
        int lbase = (64 * wm + fr) * 36 + 16 * fq; asm volatile("" : "+v"(lbase));
        if (half == 1 && wn == 0 && fq < 3) {
#pragma unroll
            for (int mi = 0; mi < 4; ++mi)
#pragma unroll
                for (int e = 0; e < 16; ++e) if (e < 4 || fq < 2) xch[lbase + mi * 576 + e] = acc[mi][e >> 2][e & 3];
        }
        __syncthreads();
        if (half == 0 && tid < 32) lc[tid] = 0;
        if (half == 0 && wn == 0 && fq < 3) {
#pragma unroll
            for (int mi = 0; mi < 4; ++mi)
#pragma unroll
                for (int e = 0; e < 16; ++e) if (e < 4 || fq < 2) lg[lbase + mi * 576 + e] = (acc[mi][e >> 2][e & 3] + xch[lbase + mi * 576 + e]) * rs[64 * wm + 16 * mi + fr];
        }
        __syncthreads();
        int e0 = 0, e1 = 0, lr0 = 0, lr1 = 0; float c0 = 0.f, c1 = 0.f;
        if (half == 0 && tid < 128) {
            const float* lrow = lg + tid * 36;
            float gl[4]; int grp = 0; float gm = -3.4e38f;
#pragma unroll
            for (int q = 0; q < 4; ++q) { gl[q] = lrow[q] + bg[q]; if (gl[q] > gm) { gm = gl[q]; grp = q; } }
            float gsum = 0.f;
#pragma unroll
            for (int q = 0; q < 4; ++q) gsum += expf(gl[q] - gm);
            const float grp_w = 1.f / gsum;
            float el[8]; float em = -3.4e38f;
#pragma unroll
            for (int q = 0; q < 8; ++q) { el[q] = lrow[4 + grp * 8 + q] + be[grp * 8 + q]; em = fmaxf(em, el[q]); }
            float esum = 0.f; float ep[8];
#pragma unroll
            for (int q = 0; q < 8; ++q) { ep[q] = expf(el[q] - em); esum += ep[q]; }
            int j0 = 0; float p0 = -1.f;
#pragma unroll
            for (int q = 0; q < 8; ++q) { const float pq = ep[q] / esum; ep[q] = pq; if (pq > p0) { p0 = pq; j0 = q; } }
            int j1 = 0; float p1 = -1.f;
#pragma unroll
            for (int q = 0; q < 8; ++q) { if (q != j0 && ep[q] > p1) { p1 = ep[q]; j1 = q; } }
            const float den = p0 + p1;
            c0 = grp_w * p0 / den; c1 = grp_w * p1 / den;
            e0 = grp * 8 + j0; e1 = grp * 8 + j1;
            lr0 = atomicAdd(&lc[e0], 1); lr1 = atomicAdd(&lc[e1], 1);
        }
        __syncthreads();
        if (half == 0 && tid < 32) { const int n = lc[tid]; gbs[tid] = n ? (int)atomicAdd(&cnt[tid], (unsigned)n) : 0; }
        __syncthreads();
        if (half == 0 && tid < 128) {
            const int tok = r0 + tid;
            list[e0 * 32768 + gbs[e0] + lr0] = tok * 2; list[e1 * 32768 + gbs[e1] + lr1] = tok * 2 + 1;
            rsl[e0 * 32768 + gbs[e0] + lr0] = rs[tid]; rsl[e1 * 32768 + gbs[e1] + lr1] = rs[tid];
            wsl[tok * 2] = c0; wsl[tok * 2 + 1] = c1;
        }
        __syncthreads();
    }
}

__device__ __forceinline__ bool moe_unit(const unsigned* cnt, int i, int& e, int& mt, int& sub, int& rowbase, int& n) {
    int lane = lane_id(); asm volatile("" : "+v"(lane));
    const int c = (lane < 32) ? (int)cnt[lane] : 0;
    const int nt = (c + 255) >> 8, nt128 = (c + 127) >> 7;
    int pre = nt, pre128 = nt128;
#pragma unroll
    for (int o = 1; o < 32; o <<= 1) {
        const int src = (lane - o) << 2;
        const int v = __builtin_amdgcn_ds_bpermute(src, pre), v2 = __builtin_amdgcn_ds_bpermute(src, pre128);
        if (lane >= o) { pre += v; pre128 += v2; }
    }
    const int total = __builtin_amdgcn_readlane(pre, 31) * 4;
    const int Lp = i * (int)gridDim.x + (int)blockIdx.x, q = (total + 7) >> 3, off = Lp >> 3;
    const int L = (Lp & 7) * q + off;
    if (off >= q || L >= total) return false;
    const int excl = pre - nt;
    const bool mine = (lane < 32) && (L >= excl * 4) && (L < pre * 4);
    const unsigned long long bal = __ballot(mine);
    if (bal == 0ull) return false;
    const int ee = __builtin_amdgcn_readfirstlane(__ffsll((long long)bal) - 1);
    e = ee;
    n = __builtin_amdgcn_readlane(c, ee);
    rowbase = __builtin_amdgcn_readlane(pre128 - nt128, ee) * 128;
    const int r = L - __builtin_amdgcn_readlane(excl, ee) * 4;
    mt = r >> 2; sub = r & 3;
    return true;
}
struct G8Exp1 {
    static constexpr bool GATHER = true;
    const unsigned* cnt; const int* list; const char* h2; const char* Wg; const char* Wu;
    __device__ __forceinline__ bool next(int i, G8Unit& u, const int (&R)[2], const unsigned (&C2)[2]) const {
        int e, mt, sub, rowbase, n;
        if (!moe_unit(cnt, i, e, mt, sub, rowbase, n)) return false;
        u.A0 = h2; u.A1 = h2; u.K2 = 2048u; u.nt = 16;
        u.B0 = Wg + ((size_t)e * 512 + sub * 128) * 2048; u.B1 = Wu + ((size_t)e * 512 + sub * 128) * 2048;
        u.x0 = e; u.x1 = mt; u.x2 = sub; u.x3 = rowbase; u.n = n;
#pragma unroll
        for (int h = 0; h < 2; ++h)
#pragma unroll
            for (int k = 0; k < 2; ++k) { int sidx = mt * 256 + h * 128 + R[k]; sidx = sidx < n ? sidx : n - 1; u.ao[h][k] = (unsigned)(list[e * 32768 + sidx] >> 1) * 2048u + C2[k]; }
        return true;
    }
};
struct EpiExp1 {
    bf16_t* hid; const float* rsl;
    __device__ __forceinline__ void operator()(const G8Acc& acc, const G8Unit& u, int wr, int wc, int fr, int fq) const {
        float rsv[2][4];
#pragma unroll
        for (int ai = 0; ai < 2; ++ai)
#pragma unroll
            for (int m = 0; m < 4; ++m) { int r = u.x1 * 256 + ai * 128 + wr * 64 + m * 16 + fr; r = r < u.n ? r : u.n - 1; rsv[ai][m] = rsl[u.x0 * 32768 + r]; }
#pragma unroll
        for (int ai = 0; ai < 2; ++ai)
#pragma unroll
            for (int m = 0; m < 4; ++m) {
                const int r = u.x1 * 256 + ai * 128 + wr * 64 + m * 16 + fr;
                if (r < u.n) {
                    const float rs = rsv[ai][m];
                    float hv[8];
#pragma unroll
                    for (int j = 0; j < 8; ++j) { const float g = acc[ai][0][m][j >> 2][j & 3] * rs, up = acc[ai][1][m][j >> 2][j & 3] * rs; hv[j] = g * sigm(g) * up; }
                    u32x4 o; o.x = pk_bf16(hv[0], hv[1]); o.y = pk_bf16(hv[2], hv[3]); o.z = pk_bf16(hv[4], hv[5]); o.w = pk_bf16(hv[6], hv[7]);
                    *(u32x4*)(hid + (size_t)(u.x3 + r) * 512 + u.x2 * 128 + wc * 32 + 8 * fq) = o;
                }
            }
    }
};
__device__ __forceinline__ void phase_exp1(CKP& p, int l, unsigned char* lds, unsigned* ctl) {
    G8Exp1 S{ctl + CTL_MOECNT + l * 32, (const int*)(p.ws + OFF_MOE + MOE_LIST), (const char*)(p.ws + OFF_X), (const char*)(p.ws + OFF_W + W_EG), (const char*)(p.ws + OFF_W + W_EU)};
    EpiExp1 E{(bf16_t*)(p.ws + OFF_HID), (const float*)(p.ws + OFF_MOE + MOE_RS)};
    g8_phase(S, E);
}
struct G8Exp2 {
    static constexpr bool GATHER = true;
    const unsigned* cnt; const char* hid; const char* Wd;
    __device__ __forceinline__ bool next(int i, G8Unit& u, const int (&R)[2], const unsigned (&C2)[2]) const {
        int e, mt, sub, rowbase, n;
        if (!moe_unit(cnt, i, e, mt, sub, rowbase, n)) return false;
        u.A0 = hid + (size_t)(rowbase + mt * 256) * 1024; u.A1 = u.A0; u.K2 = 1024u; u.nt = 8;
        u.B0 = Wd + ((size_t)e * 1024 + sub * 256) * 1024; u.B1 = u.B0 + (size_t)128 * 1024;
        u.x0 = e; u.x1 = mt; u.x2 = sub; u.x3 = rowbase; u.n = n;
        const int lim = n - mt * 256 - 1;
#pragma unroll
        for (int h = 0; h < 2; ++h)
#pragma unroll
            for (int k = 0; k < 2; ++k) { const int rr = h * 128 + R[k]; u.ao[h][k] = (unsigned)(rr < lim ? rr : lim) * 1024u + C2[k]; }
        return true;
    }
};
struct EpiExp2 {
    const int* list; const float* wsl; bf16_t* ys;
    __device__ __forceinline__ void operator()(const G8Acc& acc, const G8Unit& u, int wr, int wc, int fr, int fq) const {
        int slot[2][4]; float wt[2][4];
#pragma unroll
        for (int ai = 0; ai < 2; ++ai)
#pragma unroll
            for (int m = 0; m < 4; ++m) { int r = u.x1 * 256 + ai * 128 + wr * 64 + m * 16 + fr; r = r < u.n ? r : u.n - 1; slot[ai][m] = list[u.x0 * 32768 + r]; }
#pragma unroll
        for (int ai = 0; ai < 2; ++ai)
#pragma unroll
            for (int m = 0; m < 4; ++m) wt[ai][m] = wsl[slot[ai][m]];
#pragma unroll
        for (int ai = 0; ai < 2; ++ai)
#pragma unroll
            for (int m = 0; m < 4; ++m) {
                const int r = u.x1 * 256 + ai * 128 + wr * 64 + m * 16 + fr;
                if (r < u.n) {
                    bf16_t* dst = ys + (size_t)slot[ai][m] * 1024 + u.x2 * 256 + wc * 32 + 8 * fq;
                    const float w = wt[ai][m];
#pragma unroll
                    for (int bj = 0; bj < 2; ++bj) {
                        const f32x4 v0 = acc[ai][bj][m][0] * w, v1 = acc[ai][bj][m][1] * w;
                        u32x4 o; o.x = pk_bf16(v0[0], v0[1]); o.y = pk_bf16(v0[2], v0[3]); o.z = pk_bf16(v1[0], v1[1]); o.w = pk_bf16(v1[2], v1[3]);
                        *(u32x4*)(dst + bj * 128) = o;
                    }
                }
            }
    }
};
__device__ __forceinline__ void phase_exp2(CKP& p, int l, unsigned char* lds, unsigned* ctl) {
    G8Exp2 S{ctl + CTL_MOECNT + l * 32, (const char*)(p.ws + OFF_HID), (const char*)(p.ws + OFF_W + W_ED)};
    EpiExp2 E{(const int*)(p.ws + OFF_MOE + MOE_LIST), (const float*)(p.ws + OFF_MOE + MOE_WS), (bf16_t*)(p.ws + OFF_YS)};
    g8_phase(S, E);
}

constexpr int PH_PER_LAYER = 10;
constexpr int NPHASE = PH_PER_LAYER * DEPTH + 1;

__global__ __attribute__((target("no-packed-fp32-ops"))) void __launch_bounds__(NTHR_HW, 1) mega(KP p_unused) {
    extern __shared__ __attribute__((aligned(16))) unsigned char lds_all[];
    if ((threadIdx.x & 255) == 0) *(volatile unsigned*)(lds_all + VB_CTR + ((threadIdx.x >> 8) << 6)) = 0u;
    if ((threadIdx.x & 63) == 0) *(volatile unsigned char*)(lds_all + VB_CTR + 192 + hw_wave_key()) = (unsigned char)(threadIdx.x >> 6);
    __syncthreads();
    unsigned* ctl = (unsigned*)(p_unused.ws + OFF_CTL);
#if ONE_LAUNCH
    XcdBarrier xb = xcd_barrier_post(ctl + CTL_BAR, (volatile LAS unsigned*)(lds_all + VB_CTR + 128));
    if (p_unused.never) cg::this_grid().sync();
#if DBG_PREFLUSH
    __builtin_amdgcn_fence(__ATOMIC_RELEASE, "");
    asm volatile("s_waitcnt vmcnt(0)" ::: "memory");
    __builtin_amdgcn_fence(__ATOMIC_ACQUIRE, "");
    asm volatile("s_waitcnt vmcnt(0)" ::: "memory");
    xcd_barrier(xb);
    { const unsigned long long t0 = __builtin_amdgcn_s_memrealtime(); while (__builtin_amdgcn_s_memrealtime() - t0 < 20000ull) __builtin_amdgcn_s_sleep(8); }
    xcd_barrier(xb);
#endif
#endif
    CKP* kp0 = (CKP*)__builtin_amdgcn_kernarg_segment_ptr();
    const int ph_lo = kp0->ph_lo, ph_hi = kp0->ph_hi;
#if ONE_LAUNCH
#define PH_SYNC(PH) if ((PH) + 1 < ph_hi) xcd_barrier(xb);
#else
#define PH_SYNC(PH)
#endif
#if DBG_TIMEPH >= 0
#define PH_STAMP(PH) if (blockIdx.x == 0 && TIDX() == 0) ((unsigned long long*)(kp0->ws + OFF_CTL + 24576))[(PH)] = __builtin_amdgcn_s_memrealtime();
#else
#define PH_STAMP(PH)
#endif
#define RUN_PHASE(PH, CALL) if (ph_lo <= (PH) && (PH) < ph_hi) { PH_STAMP(PH) CKP* kp = kp0; asm volatile("" : "+s"(kp)); CKP& p = *kp; const int rep_ = 0; (void)rep_; unsigned char* lds = vb_lds(); CALL; \
    if ((PH) == DBG_REPEAT_PH) { xcd_barrier(xb); const int rep_ = 1; (void)rep_; CALL; } PH_SYNC(PH) }
#define RUN_LAYER(L) \
    RUN_PHASE((L) * 10 + 0, phase_prep(p, (L), lds)) \
    RUN_PHASE((L) * 10 + 1, phase_inproj(p, (L), lds)) \
    RUN_PHASE((L) * 10 + 2, phase_mid1(p, (L), lds)) \
    RUN_PHASE((L) * 10 + 3, phase_attn(p, (L), lds, ctl + 2 * rep_)) \
    RUN_PHASE((L) * 10 + 4, phase_glu(p, (L), lds)) \
    RUN_PHASE((L) * 10 + 5, phase_branch(p, (L), lds)) \
    RUN_PHASE((L) * 10 + 6, phase_mix(p, (L), lds)) \
    RUN_PHASE((L) * 10 + 7, phase_router(p, (L), lds, ctl)) \
    RUN_PHASE((L) * 10 + 8, phase_exp1(p, (L), lds, ctl)) \
    RUN_PHASE((L) * 10 + 9, phase_exp2(p, (L), lds, ctl))
#if DBG_SMALLK
    RUN_PHASE(0, phase_prep(p, 0, lds))
    RUN_PHASE(1, phase_inproj(p, 0, lds))
    RUN_PHASE(2, phase_mid1(p, 0, lds))
#else
    RUN_LAYER(0)
    RUN_LAYER(1)
    RUN_PHASE(20, phase_prep(p, 2, lds))
#endif
#if ONE_LAUNCH && DBG_DUMP
    {
        xcd_barrier(xb);
        CKP* kp = kp0; asm volatile("" : "+s"(kp)); CKP& p = *kp;
        const size_t NO = (size_t)NTOK * 1024;
        const unsigned char* src = p.ws + DBG_DUMP_OFF;
        for (size_t i = (size_t)blockIdx.x * NTHR_HW + threadIdx.x; i < NO; i += (size_t)gridDim.x * NTHR_HW) {
            float v = 0.f;
            if (i < (size_t)DBG_DUMP_N) {
                if (DBG_DUMP_F32) {
                    const size_t si = DBG_DUMP_REV ? ((size_t)DBG_DUMP_N - 1 - i) : i;
#if DBG_SC1READ
                    const unsigned fu = __hip_atomic_load((const unsigned*)src + si, __ATOMIC_RELAXED, __HIP_MEMORY_SCOPE_SYSTEM); const float f = __uint_as_float(fu);
#else
                    const float f = ((const float*)src)[si];
#endif
                    v = DBG_HASH ? (float)(__float_as_uint(f) & 0x3ff) : f;
#if DBG_EFILT
                    { const int id_ = (int)(((si >> 7) - DBG_IDROT) & 2047), blk = ((id_ >> 2) + 320) & 511; if (!(blk >= DBG_EFILT_LO && blk < DBG_EFILT_HI)) v = 0.f; }
#endif
#if DBG_E2
                    { const float f2 = ((const float*)(p.ws + OFF_C + C_ATT))[i]; v = (__float_as_uint(f2) == __float_as_uint(f)) ? 0.f : 1000.f; if (i == 0) v += 1.f; }
#endif
                }
                else { const bf16_t h = ((const bf16_t*)src)[i]; v = DBG_HASH ? (float)(h & 0x3ff) : bf2f(h); }
            }
#if DBG_CONSTOUT
            v = 1000.f + (float)(i & 1023);
#endif
            p.xbuf[i] = v;
        }
    }
#endif
}

#if DBG_DUMP
__global__ void dbg_dump(const bf16_t* src, size_t n, float* out, size_t nout) {
    for (size_t i = (size_t)blockIdx.x * blockDim.x + threadIdx.x; i < nout; i += (size_t)gridDim.x * blockDim.x)
        out[i] = i < n ? (DBG_HASH ? (float)(src[i] & 0x3ff) : bf2f(src[i])) : 0.f;
}
__global__ void dbg_dump_f32(const float* src, size_t n, float* out, size_t nout) {
    for (size_t i = (size_t)blockIdx.x * blockDim.x + threadIdx.x; i < nout; i += (size_t)gridDim.x * blockDim.x)
        out[i] = i < n ? (DBG_HASH ? (float)(__float_as_uint(src[i]) & 0x3ff) : src[i]) : 0.f;
}
#endif
extern "C" void kernel_launch(void* const* d_in, const int* in_sizes, int n_in, void* d_out, int out_size, void* d_ws, size_t ws_size, hipStream_t stream) {
    static int grid = 0;
    if (grid == 0) {
        if (n_in != 36 || out_size != NTOK * DM || ws_size < WS_END) { fprintf(stderr, "kernel_launch: unexpected shapes n_in %d out %d ws %zu (need %zu)\n", n_in, out_size, ws_size, (size_t)WS_END); grid = -1; return; }
        int dev = 0, cus = 0, per_cu = 0;
        hipGetDevice(&dev);
        hipDeviceGetAttribute(&cus, hipDeviceAttributeMultiprocessorCount, dev);
        hipFuncSetAttribute((const void*)mega, hipFuncAttributeMaxDynamicSharedMemorySize, LDS_BYTES);
        hipOccupancyMaxActiveBlocksPerMultiprocessor(&per_cu, (const void*)mega, NTHR_HW, LDS_BYTES);
        if (per_cu < 1) { fprintf(stderr, "kernel_launch: occupancy query says %d\n", per_cu); per_cu = 1; }
        if (per_cu > MAX_PER_CU) per_cu = MAX_PER_CU;
        grid = cus * per_cu;
        fprintf(stderr, "kernel_launch: grid %d (%d CUs x %d)\n", grid, cus, per_cu);
    }
    if (grid < 0) return;
    hipMemsetAsync((char*)d_ws + OFF_CTL, 0, CTL_BYTES, stream);
    KP p{};
    for (int i = 0; i < 36; ++i) p.in[i] = (const float*)d_in[i];
    p.xbuf = (float*)d_out; p.ws = (unsigned char*)d_ws;
    for (int i = 0; i < 8; ++i) p.inv_freq[i] = (float)pow(500000.0, -(double)i / 8.0);
    p.never = 0; p.pad = 0;
#if ONE_LAUNCH
    p.ph_lo = 0; p.ph_hi = DBG_PH_HI;
    void* args[] = {&p};
    hipError_t e = hipLaunchCooperativeKernel((const void*)mega, dim3(grid), dim3(NTHR_HW), args, LDS_BYTES, stream);
    if (e != hipSuccess) fprintf(stderr, "cooperative launch failed: %s (grid %d)\n", hipGetErrorString(e), grid);
#else
    for (int ph = 0; ph < NPHASE; ++ph) {
        if (!((DBG_MASK >> ph) & 1)) continue;
        p.ph_lo = ph; p.ph_hi = ph + 1;
        hipLaunchKernelGGL(mega, dim3(grid), dim3(NTHR_HW), LDS_BYTES, stream, p);
    }
#if DBG_DUMP
    {
        const unsigned char* w = (const unsigned char*)d_ws; const size_t NO = (size_t)NTOK * 1024;
        size_t off = 0, n = 0; bool f32 = false;
        switch (DBG_DUMP) {
            case 1: off = OFF_C + C_ATT; n = (size_t)NTOK * 512; break;
            case 2: off = OFF_C + C_SGU; n = (size_t)NTOK * 256; break;
            case 3: off = OFF_C + C_S5O; n = (size_t)NTOK * 256; break;
            case 4: off = OFF_M; n = (size_t)NTOK * 1024; break;
            case 5: off = OFF_R + R_Q; n = (size_t)NTOK * 512; break;
            case 6: off = OFF_H; n = (size_t)NTOK * 1024; break;
            case 7: off = OFF_C + C_YG; n = (size_t)NTOK * 256; break;
            case 8: off = OFF_C + C_KCMP; n = (size_t)2 * 524288 / 2; break;
            case 9: off = OFF_R + R_KC; n = (size_t)NTOK * 128 * 6; break;
            case 10: off = OFF_R + R_NG; n = (size_t)NTOK * 24; f32 = true; break;
            case 11: off = OFF_R + R_U; n = (size_t)NTOK * 768; break;
            case 12: off = OFF_C + C_S5E; n = (size_t)128 * 16 * 64 * 2; f32 = true; break;
            case 15: off = 0; n = (size_t)NTOK * 1024; f32 = true; break;
            case 16: off = OFF_W + W_S5A; n = 36864; f32 = true; break;
            case 13: off = OFF_YS; n = (size_t)NTOK * 1024; break;
            case 14: off = OFF_MOE + MOE_WS; n = 65536; f32 = true; break;
            default: break;
        }
        if (DBG_DUMP == 15) hipLaunchKernelGGL(dbg_dump_f32, dim3(2048), dim3(256), 0, stream, (const float*)d_out, n, (float*)d_out, NO);
        else if (f32) hipLaunchKernelGGL(dbg_dump_f32, dim3(2048), dim3(256), 0, stream, (const float*)(w + off), n, (float*)d_out, NO);
        else hipLaunchKernelGGL(dbg_dump, dim3(2048), dim3(256), 0, stream, (const bf16_t*)(w + off), n, (float*)d_out, NO);
    }
#endif
#endif
}
```

```cpp
#include <hip/hip_runtime.h>
#include <hip/hip_cooperative_groups.h>
#include <cstdio>
#include <cstdint>
#include <cmath>
#include <type_traits>
namespace cg = cooperative_groups;

#ifndef ONE_LAUNCH
#define ONE_LAUNCH 1
#endif
#ifndef DBG_MASK
#define DBG_MASK 0x1fffff
#endif
#ifndef DBG_NOCOMBINE
#define DBG_NOCOMBINE 0
#endif
#ifndef DBG_DUMP
#define DBG_DUMP 0
#endif
#ifndef DBG_HASH
#define DBG_HASH 0
#endif
#ifndef DBG_ONLYS5
#define DBG_ONLYS5 0
#endif
#ifndef DBG_NOCSTORE
#define DBG_NOCSTORE 0
#endif
#ifndef DBG_LDSCHK
#define DBG_LDSCHK 0
#endif
#ifndef DBG_TWICE
#define DBG_TWICE 0
#endif
#ifndef DBG_S5CONST
#define DBG_S5CONST 0
#endif
#ifndef DBG_SC1READ
#define DBG_SC1READ 0
#endif
#ifndef DBG_E2
#define DBG_E2 0
#endif
#ifndef DBG_JOBFENCE
#define DBG_JOBFENCE 0
#endif
#ifndef DBG_CONSTOUT
#define DBG_CONSTOUT 0
#endif
#ifndef DBG_QDELAY
#define DBG_QDELAY 0
#endif
#ifndef DBG_SMALLK
#define DBG_SMALLK 0
#endif
#ifndef DBG_REPEAT_PH
#define DBG_REPEAT_PH -1
#endif
#ifndef DBG_TIMEPH
#define DBG_TIMEPH -1
#endif
#ifndef DBG_TIMEPH2
#define DBG_TIMEPH2 (DBG_TIMEPH + 1)
#endif
#ifndef DBG_PRESPIN
#define DBG_PRESPIN 0
#endif
#ifndef DBG_SGUSPIN
#define DBG_SGUSPIN 0
#endif
#ifndef DBG_PREFLUSH
#define DBG_PREFLUSH 0
#endif
#ifndef DBG_ESC1
#define DBG_ESC1 0
#endif
#ifndef DBG_DELAY
#define DBG_DELAY 0
#endif
#ifndef DBG_IDROT
#define DBG_IDROT 0
#endif
#ifndef DBG_DUMP_REV
#define DBG_DUMP_REV 0
#endif
#ifndef DBG_SGUCUT
#define DBG_SGUCUT 0
#endif
#ifndef DBG_EFILT
#define DBG_EFILT 0
#define DBG_EFILT_LO 0
#define DBG_EFILT_HI 0
#endif
#ifndef DBG_DUMP_OFF
#define DBG_DUMP_OFF 0
#define DBG_DUMP_N 0
#define DBG_DUMP_F32 0
#endif
#ifndef DBG_PH_HI
#define DBG_PH_HI NPHASE
#endif

typedef unsigned short bf16_t;
typedef short bf16x8 __attribute__((ext_vector_type(8)));
typedef float f32x4 __attribute__((ext_vector_type(4)));
typedef unsigned u32x4 __attribute__((ext_vector_type(4)));
typedef unsigned u32x2 __attribute__((ext_vector_type(2)));

constexpr int DM = 1024, NB = 8, SEQ = 4096, NTOK = NB * SEQ, DEPTH = 2;
constexpr int NCMP = 255;
constexpr float RMS_EPS = 1e-6f;
constexpr int NTHR = 256;
constexpr int NTHR_HW = 512;
constexpr int VB_LDS = 68096;
constexpr int LDS_BAR = 67584;
#ifndef MAX_PER_CU
#define MAX_PER_CU 1
#endif
#ifndef LDS_TOTAL
#define LDS_TOTAL (2 * 68096 + 256)
#endif
constexpr int LDS_BYTES = LDS_TOTAL;

constexpr size_t OFF_CTL = 0;
constexpr size_t OFF_W = 65536;
constexpr size_t W_IN = 0, W_GB = 4456448, W_A = 10747904, W_S = 11796480, W_5 = 12320768, W_M = 12845056, W_GLU = 14942208,
                 W_C1 = 15073280, W_C2 = 16121856, W_PB = 16154624, W_SGU = 16155648, W_S5A = 16286720, W_S5A256 = 16294912,
                 W_S5B = 16303104, W_S5C = 16434176, W_RH = 16499712, W_RL = 16630784, W_EG = 16777216, W_EU = 50331648, W_ED = 83886080, W_END = 117440512;
constexpr size_t OFF_H = OFF_W + W_END;
constexpr size_t OFF_M = OFF_H + 67108864;
constexpr size_t OFF_R = OFF_M + 67108864;
constexpr size_t R_Q = 0, R_KC = 33554432, R_VC = 41943040, R_KS = 50331648, R_KW = 58720256, R_VST = 67108864, R_VWT = 75497472,
                 R_NG = 83886080, R_U = 87031808, R_V = 103809024, R_S5IN = 120586240, R_QR = 137363456, R_END = 170917888;
constexpr size_t OFF_C = OFF_R + R_END;
constexpr size_t C_ATT = 0, C_SGU = 33554432, C_YG = 50331648, C_S5O = 67108864, C_KCMP = 83886080, C_VCT = 84410368, C_S5E = 84934656, C_END = 85983232;
constexpr size_t OFF_MOE = OFF_C + C_END;
constexpr size_t MOE_LIST = 0, MOE_WS = 4194304, MOE_RS = 4456448, MOE_END = 8650752;
constexpr size_t OFF_ROPE = OFF_MOE + MOE_END;
constexpr size_t OFF_X = OFF_ROPE + (size_t)NTOK * 64;
constexpr size_t OFF_RS1 = OFF_X + (size_t)NTOK * 2048;
constexpr size_t WS_END = OFF_RS1 + (size_t)NTOK * 4;
constexpr size_t OFF_HID = OFF_R;
constexpr size_t OFF_YS = OFF_R + 71303168;
static_assert(OFF_YS + 134217728 <= OFF_C + C_KCMP, "alias overflow");

constexpr int CTL_BAR = 0;
constexpr int CTL_MOECNT = 4096;
constexpr int CTL_ATTN = 4096 + 64;
constexpr int CTL_BYTES = 32768;

struct KP {
    const float* in[36];
    float* xbuf;
    unsigned char* ws;
    float inv_freq[8];
    int ph_lo, ph_hi;
    int never;
    int pad;
};

typedef const KP __attribute__((address_space(4))) CKP;

typedef float f32x2_t __attribute__((ext_vector_type(2)));
typedef __bf16 bf16x2_t __attribute__((ext_vector_type(2)));
__device__ __forceinline__ unsigned pk_bf16(float lo, float hi) {
    const f32x2_t v = {lo, hi};
    union { bf16x2_t b; unsigned u; } x; x.b = __builtin_convertvector(v, bf16x2_t); return x.u;
}
__device__ __forceinline__ bf16_t f2bf(float f) { return (bf16_t)(pk_bf16(f, 0.f) & 0xffffu); }
__device__ __forceinline__ float bf2f(bf16_t b) { return __uint_as_float(((unsigned)b) << 16); }
__device__ __forceinline__ float bflo(unsigned u) { return __uint_as_float(u << 16); }
__device__ __forceinline__ float bfhi(unsigned u) { return __uint_as_float(u & 0xffff0000u); }
__device__ __forceinline__ float fexp2(float x) { return __builtin_amdgcn_exp2f(x); }
__device__ __forceinline__ float gelu_tanh(float x) {
    const float u = 0.7978845608028654f * (x + 0.044715f * x * x * x);
    const float e = fexp2(2.885390081777927f * u);
    const float t = 1.f - 2.f * __builtin_amdgcn_rcpf(e + 1.f);
    return 0.5f * x * (1.f + t);
}
__device__ __forceinline__ float sigm(float x) { return __builtin_amdgcn_rcpf(1.f + fexp2(-1.4426950408889634f * x)); }
__device__ __forceinline__ unsigned char* lds_base();
__device__ __forceinline__ int lane_id() { unsigned z = 0u; asm volatile("" : "+v"(z)); return (int)__builtin_amdgcn_mbcnt_hi(~0u, __builtin_amdgcn_mbcnt_lo(~0u, z)); }
__device__ __forceinline__ int hw_wave_key() { return (int)(__builtin_amdgcn_s_getreg((5 << 11) | 4) & 63u); }
__device__ __forceinline__ int TIDX();
__device__ __forceinline__ unsigned bperm_u(int srclane, unsigned v) { return (unsigned)__builtin_amdgcn_ds_bpermute(srclane << 2, (int)v); }
__device__ __forceinline__ float bperm_f(int srclane, float v) { return __uint_as_float(bperm_u(srclane, __float_as_uint(v))); }
__device__ __forceinline__ int opaque_tid() { int t = TIDX() & 255; asm volatile("" : "+v"(t)); return t; }
__device__ __forceinline__ int VBID() { return (int)blockIdx.x * 2 + (TIDX() >> 8); }
__device__ __forceinline__ int VGRID() { return (int)gridDim.x * 2; }
constexpr int VB_CTR = 2 * 68096;
__device__ __forceinline__ unsigned char* lds_base() { extern __shared__ __attribute__((aligned(16))) unsigned char lds_all_[]; return lds_all_; }
__device__ __forceinline__ int TIDX() { const int wv = __builtin_amdgcn_readfirstlane((int)*(volatile unsigned char*)(lds_base() + VB_CTR + 192 + hw_wave_key())); return wv * 64 + lane_id(); }
__device__ __forceinline__ unsigned char* vb_lds() { int t = TIDX(); asm volatile("" : "+v"(t)); return lds_base() + (t >> 8) * VB_LDS; }
__device__ __forceinline__ void vb_sync(unsigned char* lds) {
    asm volatile("s_waitcnt lgkmcnt(0)" ::: "memory");
    if (lane_id() == 0) {
        __attribute__((address_space(3))) unsigned* c = (__attribute__((address_space(3))) unsigned*)(lds_base() + VB_CTR + ((lds != lds_base()) ? 64 : 0));
        const unsigned old = __hip_atomic_fetch_add(c, 1u, __ATOMIC_RELAXED, __HIP_MEMORY_SCOPE_WORKGROUP);
        const unsigned target = (old & ~3u) + 4u;
        while ((int)(__hip_atomic_load(c, __ATOMIC_RELAXED, __HIP_MEMORY_SCOPE_WORKGROUP) - target) < 0) { }
    }
    asm volatile("" ::: "memory");
}
__device__ __forceinline__ void job_fence() {
#if DBG_JOBFENCE
#endif
}
__device__ __forceinline__ float wave_sum(float v) {
#pragma unroll
    for (int o = 32; o >= 1; o >>= 1) v += __shfl_xor(v, o);
    return v;
}
__device__ __forceinline__ float xmax16(float x) { const unsigned u = __float_as_uint(x); auto r = __builtin_amdgcn_permlane16_swap(u, u, false, false); return fmaxf(__uint_as_float(r[0]), __uint_as_float(r[1])); }
__device__ __forceinline__ float xmax32(float x) { const unsigned u = __float_as_uint(x); auto r = __builtin_amdgcn_permlane32_swap(u, u, false, false); return fmaxf(__uint_as_float(r[0]), __uint_as_float(r[1])); }
__device__ __forceinline__ float xsum16(float x) { const unsigned u = __float_as_uint(x); auto r = __builtin_amdgcn_permlane16_swap(u, u, false, false); return __uint_as_float(r[0]) + __uint_as_float(r[1]); }
__device__ __forceinline__ float xsum32(float x) { const unsigned u = __float_as_uint(x); auto r = __builtin_amdgcn_permlane32_swap(u, u, false, false); return __uint_as_float(r[0]) + __uint_as_float(r[1]); }
__device__ __forceinline__ f32x4 mfma16(bf16x8 a, bf16x8 b, f32x4 c) { return __builtin_amdgcn_mfma_f32_16x16x32_bf16(a, b, c, 0, 0, 0); }
__device__ __forceinline__ bf16x8 as_bf8(u32x4 v) { union { u32x4 u; bf16x8 b; } x; x.u = v; return x.b; }
__device__ __forceinline__ void store16bf(bf16_t* dst, const float (&v)[16]) {
    u32x4 a, b;
    a.x = pk_bf16(v[0], v[1]); a.y = pk_bf16(v[2], v[3]); a.z = pk_bf16(v[4], v[5]); a.w = pk_bf16(v[6], v[7]);
    b.x = pk_bf16(v[8], v[9]); b.y = pk_bf16(v[10], v[11]); b.z = pk_bf16(v[12], v[13]); b.w = pk_bf16(v[14], v[15]);
    *(u32x4*)dst = a; *(u32x4*)(dst + 8) = b;
}

#ifndef XB_SCOPE
#define XB_SCOPE "agent"
#endif
#define XB_TMO      128
#define XB_XCNT(j)  (256  + 64 * (j))
#define XB_XSUB(j)  (1280 + 64 * (j))
#define XB_XGEN(j)  (2304 + 64 * (j))
#define XB_TOP      3328
#define XB_TOPGEN   3392
#define XCD_BAR_WORDS 3456
#define XB_SPIN_CAP (1u << 22)
#define LAS __attribute__((address_space(3)))
__device__ __forceinline__ unsigned xb_ld(unsigned* p)              { return __hip_atomic_load(p, __ATOMIC_RELAXED, __HIP_MEMORY_SCOPE_AGENT); }
__device__ __forceinline__ unsigned xb_add(unsigned* p, unsigned v) { return __hip_atomic_fetch_add(p, v, __ATOMIC_RELAXED, __HIP_MEMORY_SCOPE_AGENT); }
__device__ __forceinline__ unsigned xb_xcc_id() { return (unsigned)__builtin_amdgcn_s_getreg((3 << 11) | 20) & 0xFu; }
#define XB_SPIN(cond, bar) do { unsigned _sp = 0; while (cond) { __builtin_amdgcn_s_sleep(1); \
    if ((++_sp & 255u) == 0u) { if (xb_ld(&(bar)[XB_TMO])) break; if (_sp > XB_SPIN_CAP) { atomicAdd(&(bar)[XB_TMO], 1u); break; } } } } while (0)
struct XcdBarrier { unsigned* bar; unsigned x; volatile LAS unsigned* st; };
__device__ __forceinline__ XcdBarrier xcd_barrier_post(unsigned* bar, volatile LAS unsigned* st) {
    XcdBarrier b; b.bar = bar; b.x = xb_xcc_id(); b.st = st;
    if (TIDX() == 0) { st[0] = 0u; st[1] = 0u; (void)xb_add(&bar[XB_XCNT(b.x)], 1u); }
    return b;
}
__device__ __forceinline__ void xcd_barrier_complete(unsigned* bar, unsigned x, unsigned& nloc, unsigned& nx) {
    const unsigned G = gridDim.x * gridDim.y * gridDim.z;
    unsigned sum, cnt, mine, sp = 0u;
    for (;;) {
        sum = 0u; cnt = 0u; mine = 0u;
#pragma unroll
        for (unsigned j = 0; j < 16; ++j) { const unsigned c = xb_ld(&bar[XB_XCNT(j)]); sum += c; cnt += (c > 0u) ? 1u : 0u; mine = (j == x) ? c : mine; }
        if (sum == G) break;
        __builtin_amdgcn_s_sleep(1);
        if ((++sp & 255u) == 0u) { if (xb_ld(&bar[XB_TMO])) break; if (sp > XB_SPIN_CAP) { atomicAdd(&bar[XB_TMO], 1u); break; } }
    }
    nloc = mine > 0u ? mine : 1u; nx = cnt > 0u ? cnt : 1u;
}
__device__ __forceinline__ void xcd_barrier(XcdBarrier& b) {
    asm volatile("s_waitcnt vmcnt(0)" ::: "memory");
    __syncthreads();
    if (TIDX() == 0) {
        unsigned* bar = b.bar;
        __builtin_amdgcn_s_waitcnt(0);
        unsigned nloc = b.st[0], nx = b.st[1];
        if (nloc == 0u) { xcd_barrier_complete(bar, b.x, nloc, nx); b.st[0] = nloc; b.st[1] = nx; }
        const unsigned old = xb_add(&bar[XB_XSUB(b.x)], 1u);
        const unsigned gen = old / nloc;
        if (old + 1u == (gen + 1u) * nloc) {
            __builtin_amdgcn_fence(__ATOMIC_RELEASE, XB_SCOPE);
            asm volatile("s_waitcnt vmcnt(0)" ::: "memory");
            const unsigned og = xb_add(&bar[XB_TOP], 1u);
            const unsigned tg = og / nx;
            if (og + 1u == (tg + 1u) * nx) xb_add(&bar[XB_TOPGEN], 1u);
            else XB_SPIN(xb_ld(&bar[XB_TOPGEN]) == tg, bar);
            __builtin_amdgcn_fence(__ATOMIC_ACQUIRE, XB_SCOPE);
            xb_add(&bar[XB_XGEN(b.x)], 1u);
            asm volatile("s_waitcnt vmcnt(0)" ::: "memory");
        } else {
            XB_SPIN(xb_ld(&bar[XB_XGEN(b.x)]) == gen, bar);
            __builtin_amdgcn_fence(__ATOMIC_ACQUIRE, XB_SCOPE);
            asm volatile("s_waitcnt vmcnt(0)" ::: "memory");
        }
    }
    __syncthreads();
}

__device__ __forceinline__ void tile_coords(int L, int ntm, int ntn, int& tm, int& tn) {
    const int nt = ntm * ntn, q = nt >> 3, r = nt & 7, xcd = L & 7, off = L >> 3;
    const int id = (xcd < r ? xcd * (q + 1) : r * (q + 1) + (xcd - r) * q) + off;
    const int GM = 8, nig = GM * ntn, gid = id / nig, fm = gid * GM, gsz = (ntm - fm) < GM ? (ntm - fm) : GM;
    tm = fm + ((id % nig) % gsz); tn = (id % nig) / gsz;
}

template <class AP, class BP>
__device__ __forceinline__ void gemm_kloop(f32x4 (&acc)[4][4], AP ap, int a_kstep, BP bp, int b_kstep, int nkt, unsigned char* lds, int tid) {
    const int lane = tid & 63, w = tid >> 6, wm = w >> 1, wn = w & 1, fr = lane & 15, fq = lane >> 4;
    const int lr = lane >> 3, lc = (lane & 7) ^ lr;
    const bf16_t* pa[4]; const bf16_t* pb[4];
#pragma unroll
    for (int i = 0; i < 4; ++i) {
        const int row = 8 * (w + 4 * i) + lr;
        pa[i] = ap(row) + lc * 8;
        const int wn_ = row >> 6, ni_ = (row >> 4) & 3, ii = row & 15;
        pb[i] = bp(64 * wn_ + 16 * (ii >> 2) + 4 * ni_ + (ii & 3)) + lc * 8;
    }
    const int ra = (64 * wm + fr) * 128, rb = (64 * wn + fr) * 128;
    const int sw0 = ((fq) ^ (fr & 7)) << 4, sw1 = ((4 + fq) ^ (fr & 7)) << 4;
    auto issue = [&](int buf) {
#pragma unroll
        for (int i = 0; i < 4; ++i) {
            __builtin_amdgcn_global_load_lds((const unsigned*)pa[i], (unsigned*)(lds + buf * 16384 + (w + 4 * i) * 1024), 16, 0, 0);
            __builtin_amdgcn_global_load_lds((const unsigned*)pb[i], (unsigned*)(lds + 32768 + buf * 16384 + (w + 4 * i) * 1024), 16, 0, 0);
            pa[i] += a_kstep; pb[i] += b_kstep;
        }
    };
    auto compute = [&](int buf) {
        const unsigned char* A = lds + buf * 16384;
        const unsigned char* B = lds + 32768 + buf * 16384;
#pragma unroll
        for (int ks = 0; ks < 2; ++ks) {
            const int sw = ks ? sw1 : sw0;
            bf16x8 af[4], bf[4];
#pragma unroll
            for (int mi = 0; mi < 4; ++mi) af[mi] = *(const bf16x8*)(A + ra + mi * 2048 + sw);
#pragma unroll
            for (int ni = 0; ni < 4; ++ni) bf[ni] = *(const bf16x8*)(B + rb + ni * 2048 + sw);
#pragma unroll
            for (int mi = 0; mi < 4; ++mi)
#pragma unroll
                for (int ni = 0; ni < 4; ++ni) acc[mi][ni] = mfma16(bf[ni], af[mi], acc[mi][ni]);
        }
    };
    vb_sync(lds);
    issue(0);
    asm volatile("s_waitcnt vmcnt(0)" ::: "memory");
    vb_sync(lds);
#pragma unroll 1
    for (int kt = 0; kt < nkt; ++kt) {
        const int cur = kt & 1;
        if (kt + 1 < nkt) issue(cur ^ 1);
        compute(cur);
        asm volatile("s_waitcnt vmcnt(0)" ::: "memory");
        vb_sync(lds);
    }
}
__device__ __forceinline__ void zero_acc(f32x4 (&acc)[4][4]) {
#pragma unroll
    for (int i = 0; i < 4; ++i)
#pragma unroll
        for (int j = 0; j < 4; ++j) acc[i][j] = (f32x4){0.f, 0.f, 0.f, 0.f};
}

constexpr int G8_HTB = 16384;
__device__ __forceinline__ int g8_lds_byte(int r, int c) { const int st = (r >> 4) * 2 + (c >> 5), rr = r & 15, cc = c & 31, ob = rr * 64 + cc * 2; return st * 1024 + (ob ^ (((ob >> 9) & 1) << 5)); }
__device__ __forceinline__ void g8_stage_rc(int b, int& R, int& C) { const int st = b / 1024, sb = b % 1024, swz = sb ^ (((sb >> 9) & 1) << 5); R = (st >> 1) * 16 + swz / 64; C = (st & 1) * 32 + (swz % 64) / 2; }
__device__ __forceinline__ int g8_perm32(int rho) { const int n = rho >> 4, i = rho & 15; return 8 * (i >> 2) + 4 * n + (i & 3); }
struct G8Unit {
    const char* A0; const char* A1; const char* B0; const char* B1;
    unsigned K2;
    int nt;
    int x0, x1, x2, x3, n;
    unsigned ao[2][2];
};
typedef f32x4 G8Acc[2][2][4][2];
template <class Sched, class Epi>
__device__ __forceinline__ void g8_phase(Sched& S, Epi& E) {
    LAS unsigned char* lds = (LAS unsigned char*)lds_base();
    int tid = TIDX(); asm volatile("" : "+v"(tid));
    const int wid = __builtin_amdgcn_readfirstlane(tid >> 6), lane = tid & 63, wr = wid >> 2, wc = wid & 3, fr = lane & 15, fq = lane >> 4;
#define G8_GEOM(R, C2, Rb) int R[2]; unsigned C2[2], Rb[2]; { int _t = TIDX(); asm volatile("" : "+v"(_t)); _Pragma("unroll") for (int _i = 0; _i < 2; ++_i) { int _r, _c; g8_stage_rc(_t * 16 + _i * 8192, _r, _c); \
        R[_i] = _r; C2[_i] = (unsigned)_c * 2u; Rb[_i] = (unsigned)((_r & ~31) + g8_perm32(_r & 31)); } }
    const unsigned ldsw = (unsigned)wid * 1024u;
    const int aoff = g8_lds_byte(wr * 64 + fr, fq * 8), boff = g8_lds_byte(wc * 32 + fr, fq * 8);
#define G8_SA(b, h) (((b) * 2 + (h)) * G8_HTB)
#define G8_SB(b, h) ((4 + (b) * 2 + (h)) * G8_HTB)
#define G8_STAGE(bufoff, gbase, voff) do { _Pragma("unroll") for (int _i = 0; _i < 2; ++_i) { unsigned _o = (voff)[_i]; asm volatile("" : "+v"(_o)); \
        __builtin_amdgcn_global_load_lds((const unsigned*)((const char*)(gbase) + _o), (LAS unsigned*)(lds + (bufoff) + ldsw + _i * 8192), 16, 0, 0); } } while (0)
#define G8_BOFF(u, bo) do { _Pragma("unroll") for (int _i = 0; _i < 2; ++_i) bo[_i] = Rb_[_i] * (u).K2 + C2_[_i]; } while (0)
#define G8_LDA(dst, b, h) do { _Pragma("unroll") for (int m = 0; m < 4; ++m) _Pragma("unroll") for (int k = 0; k < 2; ++k) dst[m][k] = *(const LAS bf16x8*)(lds + G8_SA(b, h) + aoff + m * 2048 + k * 1024); } while (0)
#define G8_LDB(dst, b, h) do { _Pragma("unroll") for (int n = 0; n < 2; ++n) _Pragma("unroll") for (int k = 0; k < 2; ++k) dst[n][k] = *(const LAS bf16x8*)(lds + G8_SB(b, h) + boff + n * 2048 + k * 1024); } while (0)
#define G8_MMA(ai, bj, At, Bt) do { __builtin_amdgcn_s_setprio(1); _Pragma("unroll") for (int m = 0; m < 4; ++m) _Pragma("unroll") for (int n = 0; n < 2; ++n) _Pragma("unroll") for (int k = 0; k < 2; ++k) \
        acc[ai][bj][m][n] = __builtin_amdgcn_mfma_f32_16x16x32_bf16(Bt[n][k], At[m][k], acc[ai][bj][m][n], 0, 0, 0); __builtin_amdgcn_s_setprio(0); } while (0)
#define G8_WAIT_V(n) asm volatile("s_waitcnt vmcnt(" #n ")" ::: "memory")
#define G8_WAIT_L(n) asm volatile("s_waitcnt lgkmcnt(" #n ")" ::: "memory")
#define G8_BAR __builtin_amdgcn_s_barrier()
#define G8_SCHED __builtin_amdgcn_sched_barrier(0)
    G8Unit cur, nxt; int ui = 0; unsigned cbo[2], nbo[2];
    { G8_GEOM(R_, C2_, Rb_) if (!S.next(0, cur, R_, C2_)) return; G8_BOFF(cur, cbo); }
    G8Acc acc;
#pragma unroll
    for (int a = 0; a < 2; ++a)
#pragma unroll
        for (int b = 0; b < 2; ++b)
#pragma unroll
            for (int m = 0; m < 4; ++m)
#pragma unroll
                for (int n = 0; n < 2; ++n) acc[a][b][m][n] = (f32x4){0.f, 0.f, 0.f, 0.f};
    bf16x8 At[4][2], B0[2][2], B1[2][2];
    G8_STAGE(G8_SB(0, 0), cur.B0, cbo); G8_STAGE(G8_SA(0, 0), cur.A0, cur.ao[0]); G8_STAGE(G8_SB(0, 1), cur.B1, cbo); G8_STAGE(G8_SA(0, 1), cur.A1, cur.ao[1]);
    if (wr == 1) G8_BAR;
    G8_WAIT_V(4); G8_BAR;
    G8_STAGE(G8_SB(1, 0), cur.B0 + 128, cbo); G8_STAGE(G8_SA(1, 0), cur.A0 + 128, cur.ao[0]); G8_STAGE(G8_SB(1, 1), cur.B1 + 128, cbo);
    G8_WAIT_V(6); G8_BAR;
    for (;;) {
        bool has_next;
        { G8_GEOM(R_, C2_, Rb_) has_next = S.next(ui + 1, nxt, R_, C2_);
          if (!has_next) nxt = cur;
          G8_BOFF(nxt, nbo); }
        const int nt = cur.nt;
#pragma unroll 1
        for (int t = 0; t < nt; t += 2) {
            const bool last = (t == nt - 2);
            const size_t k1 = (size_t)(t + 1) * 128, k2 = (size_t)(t + 2) * 128;
            const char* a2h0 = last ? nxt.A0 : cur.A0 + k2; const char* a2h1 = last ? nxt.A1 : cur.A1 + k2;
            const char* b2h0 = last ? nxt.B0 : cur.B0 + k2; const char* b2h1 = last ? nxt.B1 : cur.B1 + k2;
            unsigned ao0[2], ao1[2], bo2[2];
#pragma unroll
            for (int i = 0; i < 2; ++i) { ao0[i] = last ? nxt.ao[0][i] : cur.ao[0][i]; ao1[i] = last ? nxt.ao[1][i] : cur.ao[1][i]; bo2[i] = last ? nbo[i] : cbo[i]; }
            G8_LDB(B0, 0, 0); G8_SCHED; G8_LDA(At, 0, 0); G8_STAGE(G8_SA(1, 1), cur.A1 + k1, cur.ao[1]);
            G8_WAIT_L(8); G8_BAR; G8_WAIT_L(0); G8_MMA(0, 0, At, B0); G8_BAR; G8_SCHED;
            G8_LDB(B1, 0, 1); G8_STAGE(G8_SB(0, 0), b2h0, bo2);
            G8_BAR; G8_WAIT_L(0); G8_MMA(0, 1, At, B1); G8_BAR;
            G8_LDA(At, 0, 1); G8_STAGE(G8_SA(0, 0), a2h0, ao0);
            G8_BAR; G8_WAIT_L(0); G8_MMA(1, 0, At, B0); G8_BAR; G8_SCHED;
            G8_STAGE(G8_SB(0, 1), b2h1, bo2);
            G8_WAIT_V(6); G8_BAR; G8_MMA(1, 1, At, B1); G8_BAR;
            G8_LDB(B0, 1, 0); G8_SCHED; G8_LDA(At, 1, 0); G8_STAGE(G8_SA(0, 1), a2h1, ao1);
            G8_WAIT_L(8); G8_BAR; G8_WAIT_L(0); G8_MMA(0, 0, At, B0); G8_BAR; G8_SCHED;
            G8_LDB(B1, 1, 1); G8_STAGE(G8_SB(1, 0), b2h0 + 128, bo2);
            G8_BAR; G8_WAIT_L(0); G8_MMA(0, 1, At, B1); G8_BAR;
            G8_LDA(At, 1, 1); G8_STAGE(G8_SA(1, 0), a2h0 + 128, ao0);
            G8_BAR; G8_WAIT_L(0); G8_MMA(1, 0, At, B0); G8_BAR; G8_SCHED;
            G8_STAGE(G8_SB(1, 1), b2h1 + 128, bo2);
            G8_WAIT_V(6); G8_BAR; G8_MMA(1, 1, At, B1); G8_BAR;
        }
        { int t_ = TIDX(); asm volatile("" : "+v"(t_)); const int w_ = __builtin_amdgcn_readfirstlane(t_ >> 6); E(acc, cur, w_ >> 2, w_ & 3, t_ & 15, (t_ >> 4) & 3); }
        if (!has_next) break;
#pragma unroll
        for (int a = 0; a < 2; ++a)
#pragma unroll
            for (int b = 0; b < 2; ++b)
#pragma unroll
                for (int m = 0; m < 4; ++m)
#pragma unroll
                    for (int n = 0; n < 2; ++n) acc[a][b][m][n] = (f32x4){0.f, 0.f, 0.f, 0.f};
        cur = nxt; ++ui; cbo[0] = nbo[0]; cbo[1] = nbo[1];
    }
    G8_WAIT_V(0);
    if (wr == 0) G8_BAR;
    G8_BAR;
}
struct G8Plain {
    static constexpr bool GATHER = false;
    const char* A; const char* B; unsigned K2; int nt, nM, nN;
    __device__ __forceinline__ bool next(int i, G8Unit& u, const int (&R)[2], const unsigned (&C2)[2]) const {
        const int L = i * (int)gridDim.x + (int)blockIdx.x; if (L >= nM * nN) return false;
        int pm, pn; tile_coords(L, nM, nN, pm, pn); pm = __builtin_amdgcn_readfirstlane(pm); pn = __builtin_amdgcn_readfirstlane(pn);
        u.A0 = A + (size_t)pm * 256 * K2; u.A1 = u.A0 + (size_t)128 * K2; u.B0 = B + (size_t)pn * 256 * K2; u.B1 = u.B0 + (size_t)128 * K2;
        u.K2 = K2; u.nt = nt; u.x0 = pm; u.x1 = pn; u.x2 = 0; u.x3 = 0;
#pragma unroll
        for (int h = 0; h < 2; ++h)
#pragma unroll
            for (int k = 0; k < 2; ++k) u.ao[h][k] = (unsigned)R[k] * u.K2 + C2[k];
        return true;
    }
};

__device__ __forceinline__ void convert_tiles(CKP& p, int l, int e_lo, int e_hi, int first, int stride, int lane) {
    unsigned char* W = p.ws + OFF_W;
    struct E { const float* src; bf16_t* dst; int R, C, nd, mode, nbatch; };
    const int NE = e_hi;
        for (int L = first;; L += stride) {
            int rem = L; int e = e_lo; E d{};
            for (; e < NE; ++e) {
                switch (e) {
                    case 0: d = {p.in[3] + (size_t)l * 1024 * 5144, (bf16_t*)(W + W_IN), 1024, 5144, 2176, 1, 1}; break;
                    case 1: d = {p.in[3] + (size_t)l * 1024 * 5144, (bf16_t*)(W + W_GB), 1024, 5144, 3072, 2, 1}; break;
                    case 2: d = {p.in[10] + (size_t)l * 512 * 1024, (bf16_t*)(W + W_A), 512, 1024, 1024, 0, 1}; break;
                    case 3: d = {p.in[14] + (size_t)l * 256 * 1024, (bf16_t*)(W + W_S), 256, 1024, 1024, 0, 1}; break;
                    case 4: d = {p.in[25] + (size_t)l * 256 * 1024, (bf16_t*)(W + W_5), 256, 1024, 1024, 0, 1}; break;
                    case 5: d = {p.in[26] + (size_t)l * 1024 * 1024, (bf16_t*)(W + W_M), 1024, 1024, 1024, 0, 1}; break;
                    case 6: d = {p.in[23] + (size_t)l * 256 * 256, (bf16_t*)(W + W_GLU), 256, 256, 256, 0, 1}; break;
                    case 7: d = {p.in[6] + (size_t)l * 2048 * 128, (bf16_t*)(W + W_C1), 2048, 128, 128, 0, 1}; break;
                    case 8: d = {p.in[8] + (size_t)l * 2048 * 128, (bf16_t*)(W + W_C1) + 128 * 2048, 2048, 128, 128, 0, 1}; break;
                    case 9: d = {p.in[7] + (size_t)l * 128 * 64, (bf16_t*)(W + W_C2), 128, 64, 64, 0, 1}; break;
                    case 10: d = {p.in[9] + (size_t)l * 128 * 64, (bf16_t*)(W + W_C2) + 64 * 128, 128, 64, 64, 0, 1}; break;
                    case 11: d = {p.in[32] + (size_t)l * 32 * 1024 * 512, (bf16_t*)(W + W_EG), 1024, 512, 512, 3, 32}; break;
                    case 12: d = {p.in[33] + (size_t)l * 32 * 1024 * 512, (bf16_t*)(W + W_EU), 1024, 512, 512, 3, 32}; break;
                    default: d = {p.in[34] + (size_t)l * 32 * 512 * 1024, (bf16_t*)(W + W_ED), 512, 1024, 1024, 0, 32}; break;
                }
                const int per = (d.R >> 6) * (d.nd >> 6), tot = per * d.nbatch;
                if (rem < tot) break;
                rem -= tot;
            }
            if (e >= NE) break;
            const int per = (d.R >> 6) * (d.nd >> 6), bi = rem / per, t = rem % per, ntn = d.nd >> 6;
            const int k0 = (t / ntn) * 64, n = (t % ntn) * 64 + lane;
            int col = n;
            if (d.mode == 1) col = (n < 1280) ? n : ((n < 2048) ? n + 24 : ((n < 2072) ? n - 768 : -1));
            else if (d.mode == 2) col = n + 2072;
            const float* sp = d.src + (size_t)bi * d.R * d.C + (size_t)k0 * d.C + (col >= 0 ? col : 0);
            float v[64];
#pragma unroll
            for (int i = 0; i < 64; ++i) v[i] = sp[(size_t)i * d.C];
            if (d.mode == 1 || d.mode == 2) {
                const float* g1 = p.in[2] + (size_t)l * 1024 + k0;
#pragma unroll
                for (int i = 0; i < 64; ++i) v[i] *= g1[i];
            }
            if (d.mode == 3) {
                const float* g2 = p.in[27] + (size_t)l * 1024 + k0;
#pragma unroll
                for (int i = 0; i < 64; ++i) v[i] *= g2[i];
            }
            if (col < 0) {
#pragma unroll
                for (int i = 0; i < 64; ++i) v[i] = 0.f;
            }
            bf16_t* dp = d.dst + (size_t)bi * d.R * d.nd + (size_t)n * d.R + k0;
#pragma unroll
            for (int q = 0; q < 8; ++q) {
                u32x4 o;
                o.x = pk_bf16(v[8 * q], v[8 * q + 1]); o.y = pk_bf16(v[8 * q + 2], v[8 * q + 3]);
                o.z = pk_bf16(v[8 * q + 4], v[8 * q + 5]); o.w = pk_bf16(v[8 * q + 6], v[8 * q + 7]);
                *(u32x4*)(dp + 8 * q) = o;
            }
        }
}

__device__ __forceinline__ void phase_prep(CKP& p, int l, unsigned char* lds) {
    const int tid = opaque_tid(), G = VGRID(), lane = tid & 63, w = tid >> 6;
    unsigned char* W = p.ws + OFF_W;
    if (l < DEPTH) {
        convert_tiles(p, l, 0, 11, VBID() * 4 + w, G * 4, lane);
        const int gt = VBID() * NTHR + tid, gs = G * NTHR;
        if (l == 0) {
            const int* pos = (const int*)p.in[1]; float* rt = (float*)(p.ws + OFF_ROPE);
            for (int i = gt; i < NTOK * 8; i += gs) { float sn, cs; sincosf((float)pos[i >> 3] * p.inv_freq[i & 7], &sn, &cs); rt[(i >> 3) * 16 + (i & 7)] = cs; rt[(i >> 3) * 16 + 8 + (i & 7)] = sn; }
        }
        {
            const float* sw = p.in[12] + (size_t)l * 4 * 128 * 128; bf16_t* o = (bf16_t*)(W + W_SGU);
            for (int i = gt; i < 65536; i += gs) { const int t = (i >> 7) & 127, s = i & 127; o[i] = f2bf(s <= t ? sw[i] : 0.f); }
        }
        {
            const float* are = p.in[15] + l * 1024; const float* aim = p.in[16] + l * 1024; const float* ls = p.in[17] + l * 16;
            const float* bre = p.in[18] + (size_t)l * 16384; const float* bim = p.in[19] + (size_t)l * 16384;
            float* oa = (float*)(W + W_S5A); float* oa2 = (float*)(W + W_S5A256); float* ob = (float*)(W + W_S5B);
            for (int i = gt; i < 1024; i += gs) {
                const int g = i >> 6;
                const float step = expf(ls[g]), ar = are[i], ai = aim[i];
                const float mag = expf(ar * step); float sn, cs; sincosf(ai * step, &sn, &cs);
                const float abr = mag * cs, abi = mag * sn;
                const float den = ar * ar + ai * ai, nr = abr - 1.f, ni = abi;
                const float cr = (nr * ar + ni * ai) / den, ci = (ni * ar - nr * ai) / den;
                oa[i * 2] = abr; oa[i * 2 + 1] = abi;
                float pr = abr, pi = abi;
                for (int s = 0; s < 8; ++s) { const float nr2 = pr * pr - pi * pi, ni2 = 2.f * pr * pi; pr = nr2; pi = ni2; }
                oa2[i * 2] = pr; oa2[i * 2 + 1] = pi;
                for (int h = 0; h < 16; ++h) {
                    const float br = bre[i * 16 + h], bi_ = bim[i * 16 + h];
                    ob[i * 32 + h] = cr * br - ci * bi_;
                    ob[i * 32 + 16 + h] = cr * bi_ + ci * br;
                }
            }
            const float* cre = p.in[20] + (size_t)l * 16384; const float* cim = p.in[21] + (size_t)l * 16384; bf16_t* oc = (bf16_t*)(W + W_S5C);
            for (int i = gt; i < 32768; i += gs) {
                const int k = i & 127, gh = i >> 7;
                oc[i] = f2bf(k < 64 ? cre[gh * 64 + k] : -cim[gh * 64 + (k - 64)]);
            }
        }
        {
            const float* wg = p.in[28] + (size_t)l * 1024 * 4; const float* we = p.in[30] + (size_t)l * 1024 * 32;
            bf16_t* oh = (bf16_t*)(W + W_RH); bf16_t* ol = (bf16_t*)(W + W_RL);
            for (int i = gt; i < 65536; i += gs) {
                const int n = i >> 10, k = i & 1023;
                const float v = ((n < 4) ? wg[k * 4 + n] : ((n < 36) ? we[k * 32 + (n - 4)] : 0.f)) * p.in[27][(size_t)l * 1024 + k];
                const bf16_t h = f2bf(v);
                oh[i] = h; ol[i] = f2bf(v - bf2f(h));
            }
        }
        {
            float* pb = (float*)(W + W_PB);
            for (int j = VBID() * 4 + w; j < 256; j += G * 4) {
                const int kv = j >> 7, n = j & 127;
                const float* pos = p.in[kv ? 5 : 4] + (size_t)l * 2048; const float* w1 = p.in[kv ? 8 : 6] + (size_t)l * 2048 * 128;
                float s = 0.f;
                for (int k = lane; k < 2048; k += 64) s += pos[k] * w1[(size_t)k * 128 + n];
                s = wave_sum(s);
                if (lane == 0) pb[j] = s;
            }
        }
    }
    {
        const float* gam = (l < DEPTH) ? (p.in[2] + (size_t)l * 1024) : p.in[35];
        bf16_t* hb = (bf16_t*)(p.ws + OFF_H);
        const bf16_t* ys = (const bf16_t*)(p.ws + OFF_YS);
        bf16_t* xres = (bf16_t*)(p.ws + OFF_X);
        f32x4 gv[4];
#pragma unroll
        for (int i = 0; i < 4; ++i) gv[i] = *(const f32x4*)(gam + 4 * lane + 256 * i);
        for (int row = VBID() * 4 + w; row < NTOK; row += G * 4) {
            f32x4 xv[4]; float ss = 0.f;
#pragma unroll
            for (int i = 0; i < 4; ++i) {
                const int col = 4 * lane + 256 * i;
                if (l == 0) xv[i] = *(const f32x4*)(p.in[0] + (size_t)row * 1024 + col);
                else {
                    { const u32x2 xx = *(const u32x2*)(xres + (size_t)row * 1024 + col); xv[i] = (f32x4){bflo(xx.x), bfhi(xx.x), bflo(xx.y), bfhi(xx.y)}; }
                    const u32x2 y0 = *(const u32x2*)(ys + (size_t)(2 * row) * 1024 + col), y1 = *(const u32x2*)(ys + (size_t)(2 * row + 1) * 1024 + col);
                    xv[i][0] += bflo(y0.x) + bflo(y1.x); xv[i][1] += bfhi(y0.x) + bfhi(y1.x);
                    xv[i][2] += bflo(y0.y) + bflo(y1.y); xv[i][3] += bfhi(y0.y) + bfhi(y1.y);
                }
                ss += xv[i][0] * xv[i][0] + xv[i][1] * xv[i][1] + xv[i][2] * xv[i][2] + xv[i][3] * xv[i][3];
            }
            ss = wave_sum(ss);
            const float rstd = rsqrtf(ss * (1.f / 1024.f) + RMS_EPS);
#pragma unroll
            for (int i = 0; i < 4; ++i) {
                const int col = 4 * lane + 256 * i;
                f32x4 hn = xv[i] * rstd * gv[i];
                if (l < DEPTH) {
                    { u32x2 xo; xo.x = pk_bf16(xv[i][0], xv[i][1]); xo.y = pk_bf16(xv[i][2], xv[i][3]); *(u32x2*)(xres + (size_t)row * 1024 + col) = xo; }
                    if (i == 0 && lane == 0) ((float*)(p.ws + OFF_RS1))[row] = rstd;
                } else {
#if DBG_TIMEPH >= 0
                    { const unsigned long long* ts = (const unsigned long long*)(p.ws + OFF_CTL + 24576);
                      const float dt_us = (float)(ts[DBG_TIMEPH2] - ts[DBG_TIMEPH]) * 0.01f; hn = hn * (1.f + 1e-3f * dt_us); }
#endif
                    *(f32x4*)(p.xbuf + (size_t)row * 1024 + col) = hn;
                }
            }
        }
    }
}

struct EpiInproj {
    unsigned char* Rb_; const float* rope; const float* rs1;
    __device__ __forceinline__ void operator()(const G8Acc& acc, const G8Unit& u, int wr, int wc, int fr, int fq) const {
        unsigned char* R = Rb_;
        float rsv[2][4];
#pragma unroll
        for (int ai = 0; ai < 2; ++ai)
#pragma unroll
            for (int m = 0; m < 4; ++m) rsv[ai][m] = rs1[u.x0 * 256 + ai * 128 + wr * 64 + m * 16 + fr];
#pragma unroll
        for (int bj = 0; bj < 2; ++bj) {
            const int tn = u.x1 * 2 + bj;
            const int cl = 32 * wc + 8 * fq;
#pragma unroll
            for (int ai = 0; ai < 2; ++ai)
#pragma unroll
                for (int m = 0; m < 4; ++m) {
                    const int row = u.x0 * 256 + ai * 128 + wr * 64 + m * 16 + fr;
                    float v[8];
#pragma unroll
                    for (int e = 0; e < 8; ++e) v[e] = acc[ai][bj][m][e >> 2][e & 3] * rsv[ai][m];
                    const bool roped = (tn < 4) || tn == 6 || tn == 8;
                    if (tn < 4) { u32x4 o; o.x = pk_bf16(v[0], v[1]); o.y = pk_bf16(v[2], v[3]); o.z = pk_bf16(v[4], v[5]); o.w = pk_bf16(v[6], v[7]);
                                  *(u32x4*)((bf16_t*)(R + R_Q) + (size_t)row * 512 + tn * 128 + cl) = o; }
                    if (roped && !(wc & 1)) {
                        float xo[8];
#pragma unroll
                        for (int i = 0; i < 8; ++i) xo[i] = __shfl_xor(v[i], 16);
                        if (fq < 2) {
                            const float* rt = rope + (size_t)row * 16;
                            const f32x4 c0 = *(const f32x4*)rt, c1 = *(const f32x4*)(rt + 4), s0 = *(const f32x4*)(rt + 8), s1 = *(const f32x4*)(rt + 12);
#pragma unroll
                            for (int i = 0; i < 8; ++i) {
                                const float cs = i < 4 ? c0[i & 3] : c1[i & 3], sn = i < 4 ? s0[i & 3] : s1[i & 3];
                                v[i] = fq == 0 ? (v[i] * cs - xo[i] * sn) : (v[i] * cs + xo[i] * sn);
                            }
                        }
                    }
                    u32x4 o; o.x = pk_bf16(v[0], v[1]); o.y = pk_bf16(v[2], v[3]); o.z = pk_bf16(v[4], v[5]); o.w = pk_bf16(v[6], v[7]);
                    if (tn < 4) *(u32x4*)((bf16_t*)(R + R_QR) + (size_t)row * 512 + tn * 128 + cl) = o;
                    else if (tn == 7 || tn == 9) {
                        bf16_t* dst = (bf16_t*)(R + (tn == 7 ? R_VST : R_VWT));
                        const int b = row >> 12, s_ = row & 4095, g = wc >> 1, d0 = 32 * (wc & 1) + 8 * fq;
#pragma unroll
                        for (int e = 0; e < 8; ++e) dst[((size_t)((b * 2 + g) * 64 + d0 + e)) * SEQ + s_] = f2bf(v[e]);
                    } else if (tn < 10) {
                        const size_t off = (tn == 4) ? R_KC : (tn == 5) ? R_VC : (tn == 6) ? R_KS : R_KW;
                        *(u32x4*)((bf16_t*)(R + off) + (size_t)row * 128 + cl) = o;
                    } else if (tn < 14) {
#pragma unroll
                        for (int e = 0; e < 8; ++e) v[e] = gelu_tanh(v[e]);
                        u32x4 og; og.x = pk_bf16(v[0], v[1]); og.y = pk_bf16(v[2], v[3]); og.z = pk_bf16(v[4], v[5]); og.w = pk_bf16(v[6], v[7]);
                        const int c512 = (tn - 10) * 128 + cl;
                        if (c512 < 256) *(u32x4*)((bf16_t*)(R + R_U) + (size_t)row * 256 + c512) = og;
                        else *(u32x4*)((bf16_t*)(R + R_V) + (size_t)row * 256 + (c512 - 256)) = og;
                    } else {
                        *(u32x4*)((bf16_t*)(R + R_S5IN) + (size_t)row * 256 + (tn - 14) * 128 + cl) = o;
                    }
                }
        }
    }
};
__device__ __forceinline__ void phase_inproj(CKP& p, int l, unsigned char* lds) {
    {
        G8Plain S{(const char*)(p.ws + OFF_X), (const char*)(p.ws + OFF_W + W_IN), 2048u, 16, NTOK / 256, 8};
        EpiInproj E{p.ws + OFF_R, (const float*)(p.ws + OFF_ROPE), (const float*)(p.ws + OFF_RS1)};
        g8_phase(S, E);
    }
    const int tid = opaque_tid(), lane = tid & 63, w = tid >> 6, wm = w >> 1, wn = w & 1, fr = lane & 15, fq = lane >> 4;
    const int half = TIDX() >> 8;
    const bf16_t* A = (const bf16_t*)(p.ws + OFF_X);
    const float* rs1 = (const float*)(p.ws + OFF_RS1);
    const bf16_t* Bt = (const bf16_t*)(p.ws + OFF_W + W_IN) + (size_t)2048 * 1024;
    unsigned char* R = p.ws + OFF_R;
    float* xch = (float*)(lds_base() + VB_LDS);
    for (int tm = blockIdx.x; tm < NTOK / 128; tm += gridDim.x) {
        const int m0 = tm * 128;
        f32x4 acc[4][4]; zero_acc(acc);
        gemm_kloop(acc, [&](int r) { return A + (size_t)(m0 + r) * 1024 + half * 512; }, 64, [&](int v) { return Bt + (size_t)v * 1024 + half * 512; }, 64, 8, lds, tid);
        __syncthreads();
        if (half == 1 && wn == 0 && fq < 2) {
#pragma unroll
            for (int mi = 0; mi < 4; ++mi) {
                const int r = 64 * wm + 16 * mi + fr;
#pragma unroll
                for (int ni = 0; ni < 4; ++ni) *(f32x4*)(xch + r * 32 + 16 * fq + 4 * ni) = acc[mi][ni];
            }
        }
        __syncthreads();
        if (half == 0 && wn == 0 && fq < 2) {
#pragma unroll
            for (int mi = 0; mi < 4; ++mi) {
                const int r = 64 * wm + 16 * mi + fr;
                float* ng = (float*)(R + R_NG) + (size_t)(m0 + r) * 24 + 16 * fq;
#pragma unroll
                for (int ni = 0; ni < 4; ++ni) {
                    const f32x4 o = *(const f32x4*)(xch + r * 32 + 16 * fq + 4 * ni);
#pragma unroll
                    for (int j = 0; j < 4; ++j) if (16 * fq + 4 * ni + j < 24) ng[4 * ni + j] = sigm((acc[mi][ni][j] + o[j]) * rs1[m0 + r]);
                }
            }
        }
        __syncthreads();
    }
}

__device__ __forceinline__ void compress_tile(CKP& p, int job, unsigned char* lds) {
    job_fence();
    const int tid = opaque_tid(), lane = tid & 63, w = tid >> 6, wm = w >> 1, wn = w & 1, fr = lane & 15, fq = lane >> 4;
    const int kv = job >> 5, tm = job & 31, m0 = tm * 128;
    unsigned char* W = p.ws + OFF_W;
    const bf16_t* src = (const bf16_t*)(p.ws + OFF_R + (kv ? R_VC : R_KC));
    const bf16_t* W1 = (const bf16_t*)(W + W_C1) + (size_t)kv * 128 * 2048;
    const bf16_t* W2 = (const bf16_t*)(W + W_C2) + (size_t)kv * 64 * 128;
    const float* pb = (const float*)(W + W_PB) + kv * 128;
    f32x4 acc[4][4]; zero_acc(acc);
    int t512 = TIDX(); asm volatile("" : "+v"(t512));
    const int half = t512 >> 8;
    gemm_kloop(acc, [&](int r) { int Rr = m0 + r; Rr = Rr < 4080 ? Rr : 4079; const int b = Rr / 510, rem = Rr % 510, c = rem >> 1, g = rem & 1;
                                 return src + ((size_t)(b * SEQ + 16 * c + 16 * half)) * 128 + g * 64; }, 128,
               [&](int v) { return W1 + (size_t)v * 2048 + half * 1024; }, 64, 16, lds, tid);
    {
        float* xch = (float*)(lds_base() + VB_LDS);
        __syncthreads();
        if (half == 1) {
#pragma unroll
            for (int mi = 0; mi < 4; ++mi)
#pragma unroll
                for (int ni = 0; ni < 4; ++ni) *(f32x4*)(xch + ((mi * 4 + ni) * 256 + tid) * 4) = acc[mi][ni];
        }
        __syncthreads();
        if (half == 0) {
#pragma unroll
            for (int mi = 0; mi < 4; ++mi)
#pragma unroll
                for (int ni = 0; ni < 4; ++ni) acc[mi][ni] += *(const f32x4*)(xch + ((mi * 4 + ni) * 256 + tid) * 4);
        }
        __syncthreads();
        if (half == 1) return;
    }
#pragma unroll
    for (int mi = 0; mi < 4; ++mi) {
        const int row = 64 * wm + 16 * mi + fr; const int cb = 16 * fq;
        float v[16];
#pragma unroll
        for (int e = 0; e < 16; ++e) v[e] = gelu_tanh(acc[mi][e >> 2][e & 3] + pb[64 * wn + cb + e]);
        u32x4 a, b;
        a.x = pk_bf16(v[0], v[1]); a.y = pk_bf16(v[2], v[3]); a.z = pk_bf16(v[4], v[5]); a.w = pk_bf16(v[6], v[7]);
        b.x = pk_bf16(v[8], v[9]); b.y = pk_bf16(v[10], v[11]); b.z = pk_bf16(v[12], v[13]); b.w = pk_bf16(v[14], v[15]);
        *(u32x4*)(lds + wn * 16384 + row * 128 + (((2 * fq) ^ (row & 7)) << 4)) = a;
        *(u32x4*)(lds + wn * 16384 + row * 128 + (((2 * fq + 1) ^ (row & 7)) << 4)) = b;
    }
#pragma unroll
    for (int j = 0; j < 4; ++j) {
        const int pid = tid + 256 * j, row = pid >> 4, ch = pid & 15;
        const u32x4 v = *(const u32x4*)(W2 + row * 128 + ch * 8);
        *(u32x4*)(lds + 32768 + (ch >> 3) * 16384 + row * 128 + (((ch & 7) ^ (row & 7)) << 4)) = v;
    }
    vb_sync(lds);
    f32x4 a2[4][2];
#pragma unroll
    for (int i = 0; i < 4; ++i) { a2[i][0] = (f32x4){0.f, 0.f, 0.f, 0.f}; a2[i][1] = (f32x4){0.f, 0.f, 0.f, 0.f}; }
#pragma unroll
    for (int kt2 = 0; kt2 < 2; ++kt2)
#pragma unroll
        for (int ks = 0; ks < 2; ++ks) {
            bf16x8 af[4], bf[2];
#pragma unroll
            for (int mi = 0; mi < 4; ++mi) { const int row = 64 * wm + 16 * mi + fr; af[mi] = *(const bf16x8*)(lds + kt2 * 16384 + row * 128 + (((4 * ks + fq) ^ (row & 7)) << 4)); }
#pragma unroll
            for (int ni = 0; ni < 2; ++ni) { const int row = 32 * wn + 8 * (fr >> 2) + 4 * ni + (fr & 3); bf[ni] = *(const bf16x8*)(lds + 32768 + kt2 * 16384 + row * 128 + (((4 * ks + fq) ^ (row & 7)) << 4)); }
#pragma unroll
            for (int mi = 0; mi < 4; ++mi)
#pragma unroll
                for (int ni = 0; ni < 2; ++ni) a2[mi][ni] = mfma16(bf[ni], af[mi], a2[mi][ni]);
        }
    bf16_t* kcmp = (bf16_t*)(p.ws + OFF_C + C_KCMP);
    bf16_t* vct = (bf16_t*)(p.ws + OFF_C + C_VCT);
#pragma unroll
    for (int mi = 0; mi < 4; ++mi) {
        const int Rr = m0 + 64 * wm + 16 * mi + fr;
        if (Rr < 4080) {
            const int b = Rr / 510, rem = Rr % 510, c = rem >> 1, g = rem & 1, d0 = 32 * wn + 8 * fq;
            float v[8];
#pragma unroll
            for (int e = 0; e < 8; ++e) v[e] = a2[mi][e >> 2][e & 3];
            if (DBG_NOCSTORE) { if (v[0] == 123.456f) kcmp[0] = 1; }
            else if (kv == 0) {
                u32x4 o; o.x = pk_bf16(v[0], v[1]); o.y = pk_bf16(v[2], v[3]); o.z = pk_bf16(v[4], v[5]); o.w = pk_bf16(v[6], v[7]);
                *(u32x4*)(kcmp + ((size_t)(b * 256 + c)) * 128 + g * 64 + d0) = o;
                if (c == 254) *(u32x4*)(kcmp + ((size_t)(b * 256 + 255)) * 128 + g * 64 + d0) = (u32x4){0u, 0u, 0u, 0u};
            } else {
#pragma unroll
                for (int e = 0; e < 8; ++e) {
                    vct[((size_t)((b * 2 + g) * 64 + d0 + e)) * 256 + c] = f2bf(v[e]);
                    if (c == 254) vct[((size_t)((b * 2 + g) * 64 + d0 + e)) * 256 + 255] = 0;
                }
            }
        }
    }
    vb_sync(lds);
}

__device__ __forceinline__ void sgu_job(CKP& p, int l, int job, unsigned char* lds) {
    job_fence();
    const int tid = opaque_tid(), lane = tid & 63, w = tid >> 6, fr = lane & 15, fq = lane >> 4;
    const size_t tok0 = (size_t)job * 128;
    const bf16_t* V = (const bf16_t*)(p.ws + OFF_R + R_V) + tok0 * 256;
    const bf16_t* U = (const bf16_t*)(p.ws + OFF_R + R_U) + tok0 * 256;
    bf16_t* O = (bf16_t*)(p.ws + OFF_C + C_SGU) + tok0 * 256;
    const bf16_t* Wt = (const bf16_t*)(p.ws + OFF_W + W_SGU);
    const float* ng = p.in[11] + (size_t)l * 256;
    const float* bs = p.in[13] + (size_t)l * 512;
    vb_sync(lds);
    if (DBG_SGUCUT != 2) {
        const int s = tid >> 1, half = tid & 1;
        const bf16_t* src = V + (size_t)s * 256 + half * 128;
        float ss = 0.f;
#pragma unroll 4
        for (int j = 0; j < 16; ++j) {
            const u32x4 bb = *(const u32x4*)(src + j * 8);
            const unsigned uu[4] = {bb.x, bb.y, bb.z, bb.w};
#pragma unroll
            for (int q = 0; q < 4; ++q) { const float a = bflo(uu[q]), b2 = bfhi(uu[q]); ss += a * a + b2 * b2; }
        }
        ss += __shfl_xor(ss, 1);
        const float rstd = rsqrtf(ss * (1.f / 256.f) + RMS_EPS);
#pragma unroll 1
        for (int j = 0; j < 16; ++j) {
            const u32x4 bb = *(const u32x4*)(src + j * 8);
            const unsigned uu[4] = {bb.x, bb.y, bb.z, bb.w};
            const int cb = half * 128 + j * 8;
#pragma unroll
            for (int q = 0; q < 4; ++q) {
#pragma unroll
                for (int hh = 0; hh < 2; ++hh) {
                    const int c = cb + q * 2 + hh;
                    const float val = (hh ? bfhi(uu[q]) : bflo(uu[q])) * rstd * ng[c];
                    *(bf16_t*)(lds + c * 256 + ((((s >> 3) ^ (c & 15))) << 4) + (s & 7) * 2) = f2bf(val);
                }
            }
        }
    }
    vb_sync(lds);
    const int g = w;
#pragma unroll 1
    for (int th = 0; th < (DBG_SGUCUT == 1 ? 0 : 2); ++th) {
        f32x4 acc[4][4];
        zero_acc(acc);
#pragma unroll
        for (int ks = 0; ks < 4; ++ks) {
            if (32 * ks <= 64 * th + 63) {
                bf16x8 vf[4];
#pragma unroll
                for (int di = 0; di < 4; ++di) { const int c = 64 * g + 16 * di + fr; vf[di] = *(const bf16x8*)(lds + c * 256 + (((4 * ks + fq) ^ (c & 15)) << 4)); }
#pragma unroll
                for (int ti = 0; ti < 4; ++ti) {
                    const int t = 64 * th + 16 * ti + fr;
                    if (32 * ks <= 64 * th + 16 * ti + 15) {
                        const bf16x8 wf = *(const bf16x8*)(Wt + ((size_t)(g * 128 + t)) * 128 + 32 * ks + 8 * fq);
#pragma unroll
                        for (int di = 0; di < 4; ++di) acc[ti][di] = mfma16(vf[di], wf, acc[ti][di]);
                    }
                }
            }
        }
#pragma unroll
        for (int ti = 0; ti < 4; ++ti) {
            const int t = 64 * th + 16 * ti + fr; const float bb = bs[g * 128 + t];
#pragma unroll
            for (int di = 0; di < 4; ++di) {
                const int c = 64 * g + 16 * di + 4 * fq;
                const u32x2 uu = *(const u32x2*)(U + (size_t)t * 256 + c);
                u32x2 o;
                o.x = pk_bf16(bflo(uu.x) * (acc[ti][di][0] + bb), bfhi(uu.x) * (acc[ti][di][1] + bb));
                o.y = pk_bf16(bflo(uu.y) * (acc[ti][di][2] + bb), bfhi(uu.y) * (acc[ti][di][3] + bb));
                *(u32x2*)(O + (size_t)t * 256 + c) = o;
            }
        }
    }
    vb_sync(lds);
}

__device__ __forceinline__ void s5_job(CKP& p, int l, int jb, int pass, unsigned char* lds) {
    job_fence();
    const int tid = opaque_tid(), lane = tid & 63, w = tid >> 6, fr = lane & 15, fq = lane >> 4;
    const int id = ((jb * 4 + w) + DBG_IDROT) & 2047, seq = id >> 4, ch = id & 15, b = seq >> 4, g = seq & 15;
    unsigned char* W = p.ws + OFF_W;
    const float* ab = (const float*)(W + W_S5A) + (g * 64 + lane) * 2;
    float ar = ab[0], ai = ab[1];
    float br[16], bi[16];
    {
        const float* bb = (const float*)(W + W_S5B) + (size_t)(g * 64 + lane) * 32;
#pragma unroll
        for (int h = 0; h < 16; ++h) { br[h] = bb[h]; bi[h] = bb[16 + h]; }
    }
#if DBG_S5CONST >= 2
    { const float q = (float)(lane + 1) * 0.001f; ar = 0.99f - q; ai = 0.05f + q;
      for (int h = 0; h < 16; ++h) { br[h] = 0.01f * (float)(h + 1) + q; bi[h] = -0.02f * (float)(h + 1) + q; } }
#endif
    float* Eb = (float*)(p.ws + OFF_C + C_S5E);
    float hre = 0.f, him = 0.f;
    bf16x8 cf[4]; float dv[4];
    if (pass == 2) {
        const float* a2 = (const float*)(W + W_S5A256) + (g * 64 + lane) * 2;
        const float a2r = a2[0], a2i = a2[1];
        for (int c2 = 0; c2 < ch; ++c2) {
            const float* e = Eb + ((size_t)(seq * 16 + c2) * 64 + lane) * 2;
            const float nr = a2r * hre - a2i * him + e[0], ni = a2r * him + a2i * hre + e[1];
            hre = nr; him = ni;
        }
        const bf16_t* cm = (const bf16_t*)(W + W_S5C) + (size_t)(g * 16 + fr) * 128;
#pragma unroll
        for (int ks = 0; ks < 4; ++ks) cf[ks] = *(const bf16x8*)(cm + 32 * ks + 8 * fq);
#pragma unroll
        for (int r = 0; r < 4; ++r) dv[r] = p.in[22][(size_t)l * 256 + g * 16 + 4 * fq + r];
    }
    const bf16_t* xin = (const bf16_t*)(p.ws + OFF_R + R_S5IN) + ((size_t)(b * SEQ + ch * 256)) * 256 + g * 16;
    bf16_t* yg = (bf16_t*)(p.ws + OFF_C + C_YG) + ((size_t)(b * SEQ + ch * 256)) * 256 + g * 16;
    float* xs = (float*)(lds + w * 10240);
    int ldsbad = 0; (void)ldsbad;
    unsigned char* Hs = lds + w * 10240 + 2048;
#if DBG_TWICE
    float keep_re = 0.f, keep_im = 0.f;
#pragma unroll 1
    for (int rep = 0; rep < 2; ++rep) {
    if (rep == 1) { keep_re = hre; keep_im = him; hre = 0.f; him = 0.f; }
#endif
#pragma unroll 1
    for (int sub = 0; sub < 8; ++sub) {
#if DBG_S5CONST >= 1
        u32x4 xv; { const unsigned q = (unsigned)(sub * 32 + (lane >> 1)) * 2654435761u + (unsigned)id * 40503u + (lane & 1); xv.x = 0x3f803e80u ^ ((q & 0xff) << 16); xv.y = 0x3e003d00u ^ ((q >> 8) & 0x7f); xv.z = 0xbe803f00u ^ ((q >> 16) & 0x3f); xv.w = 0x3d80be00u; }
#else
        const u32x4 xv = *(const u32x4*)(xin + (size_t)(sub * 32 + (lane >> 1)) * 256 + (lane & 1) * 8);
#endif
        vb_sync(lds);
        f32x4 chk_a = {bflo(xv.x), bfhi(xv.x), bflo(xv.y), bfhi(xv.y)}, chk_c = {bflo(xv.z), bfhi(xv.z), bflo(xv.w), bfhi(xv.w)};
        {
            *(f32x4*)(xs + (lane >> 1) * 16 + (lane & 1) * 8) = chk_a;
            *(f32x4*)(xs + (lane >> 1) * 16 + (lane & 1) * 8 + 4) = chk_c;
        }
        vb_sync(lds);
#pragma unroll 4
        for (int st = 0; st < 32; ++st) {
#if DBG_S5CONST == 3
            f32x4 x0, x1, x2, x3;
            { const float t = (float)((sub * 32 + st) & 63) * 0.015625f + (float)(id & 7) * 0.125f;
              x0 = (f32x4){t, t * 0.5f, -t, 0.25f}; x1 = (f32x4){0.5f - t, t * t, 0.125f, t}; x2 = (f32x4){-0.25f, t, 0.75f * t, 1.f - t}; x3 = (f32x4){t, -t, 0.5f, 0.3f * t}; }
#else
            const f32x4 x0 = *(const f32x4*)(xs + st * 16), x1 = *(const f32x4*)(xs + st * 16 + 4), x2 = *(const f32x4*)(xs + st * 16 + 8), x3 = *(const f32x4*)(xs + st * 16 + 12);
#endif
            float ur = 0.f, ui = 0.f;
#pragma unroll
            for (int h = 0; h < 4; ++h) {
                ur += br[h] * x0[h]; ui += bi[h] * x0[h];
                ur += br[4 + h] * x1[h]; ui += bi[4 + h] * x1[h];
                ur += br[8 + h] * x2[h]; ui += bi[8 + h] * x2[h];
                ur += br[12 + h] * x3[h]; ui += bi[12 + h] * x3[h];
            }
            const float nr = ar * hre - ai * him + ur, ni = ar * him + ai * hre + ui;
            hre = nr; him = ni;
            if (pass == 2) {
                *(bf16_t*)(Hs + st * 256 + (((lane >> 3) ^ (st & 15)) << 4) + (lane & 7) * 2) = f2bf(hre);
                *(bf16_t*)(Hs + st * 256 + ((((64 + lane) >> 3) ^ (st & 15)) << 4) + (lane & 7) * 2) = f2bf(him);
            }
        }
#if DBG_LDSCHK
        {
            const f32x4 ra = *(volatile f32x4*)(xs + (lane >> 1) * 16 + (lane & 1) * 8), rc = *(volatile f32x4*)(xs + (lane >> 1) * 16 + (lane & 1) * 8 + 4);
            bool bad = false;
            for (int q = 0; q < 4; ++q) bad |= (__float_as_uint(ra[q]) != __float_as_uint(chk_a[q])) | (__float_as_uint(rc[q]) != __float_as_uint(chk_c[q]));
            if (__any(bad)) ldsbad = 1;
        }
#endif
        if (pass == 2) {
            vb_sync(lds);
#pragma unroll
            for (int tt = 0; tt < 2; ++tt) {
                f32x4 acc = {0.f, 0.f, 0.f, 0.f};
                const int tl = tt * 16 + fr;
#pragma unroll
                for (int ks = 0; ks < 4; ++ks) {
                    const bf16x8 hf = *(const bf16x8*)(Hs + tl * 256 + (((4 * ks + fq) ^ (tl & 15)) << 4));
                    acc = mfma16(cf[ks], hf, acc);
                }
                float y[4];
#pragma unroll
                for (int r = 0; r < 4; ++r) y[r] = gelu_tanh(acc[r] + dv[r] * xs[tl * 16 + 4 * fq + r]);
                u32x2 o; o.x = pk_bf16(y[0], y[1]); o.y = pk_bf16(y[2], y[3]);
                *(u32x2*)(yg + (size_t)(sub * 32 + tl) * 256 + 4 * fq) = o;
            }
        }
    }
#if DBG_TWICE
    }
    if (__float_as_uint(keep_re) != __float_as_uint(hre) || __float_as_uint(keep_im) != __float_as_uint(him)) { hre = __uint_as_float(0x7fc00000u); him = hre; }
#endif
    if (pass == 1) {
        float* e = Eb + ((size_t)(seq * 16 + ch) * 64 + lane) * 2;
#if DBG_LDSCHK
        if (ldsbad) { hre = __uint_as_float(0x7fc00000u); him = hre; }
#endif
#if DBG_ESC1
        { const unsigned long long pk = ((unsigned long long)__float_as_uint(him) << 32) | __float_as_uint(hre);
          __hip_atomic_store((unsigned long long*)e, pk, __ATOMIC_RELAXED, __HIP_MEMORY_SCOPE_AGENT); }
#else
        e[0] = hre; e[1] = him;
#endif
#if DBG_E2
        float* e2 = (float*)(p.ws + OFF_C + C_ATT) + ((size_t)(seq * 16 + ch) * 64 + lane) * 2;
        e2[0] = hre; e2[1] = him;
#endif
    }
    vb_sync(lds);
}

__device__ __forceinline__ void phase_mid1(CKP& p, int l, unsigned char* lds) {
    if (blockIdx.x < 64) { compress_tile(p, (int)blockIdx.x, lds); return; }
    for (int j = VBID() - 128; j < 768; j += VGRID() - 128) {
        if (j < 256) sgu_job(p, l, j, lds);
        else s5_job(p, l, j - 256, 1, lds);
    }
}

constexpr int AL_Q = 0, AL_KV = 32768, AL_IMP = 49152, AL_SEL = 65792, AL_UNI = 66304, AL_JOB = 66336;
constexpr float SM_C = 0.125f * 1.4426950408889634f;

__device__ __forceinline__ void attn_load_q(const bf16_t* Qg, const int* pos, const float (&inv_freq)[8], int b, int g, int t0, bool rope, unsigned char* lds, int tid) {
#pragma unroll 1
    for (int j = 0; j < 8; ++j) {
        const int pid = tid + 256 * j, Rr = pid >> 3, ch = pid & 7;
        const int wq = Rr >> 6, r = (Rr >> 4) & 3, q = Rr & 15, t = t0 + 16 * wq + q;
        const bf16_t* src = Qg + ((size_t)(b * SEQ + t)) * 512 + (g * 4 + r) * 64;
        if (!rope || ch >= 2) {
            *(u32x4*)(lds + AL_Q + Rr * 128 + ((ch ^ (Rr & 7)) << 4)) = *(const u32x4*)(src + ch * 8);
        } else if (ch == 0) {
            const u32x4 a = *(const u32x4*)(src), c = *(const u32x4*)(src + 8);
            float x1[8] = {bflo(a.x), bfhi(a.x), bflo(a.y), bfhi(a.y), bflo(a.z), bfhi(a.z), bflo(a.w), bfhi(a.w)};
            float x2[8] = {bflo(c.x), bfhi(c.x), bflo(c.y), bfhi(c.y), bflo(c.z), bfhi(c.z), bflo(c.w), bfhi(c.w)};
            const float ps = (float)pos[b * SEQ + t];
#pragma unroll
            for (int i = 0; i < 8; ++i) {
                float sn, cs; sincosf(ps * inv_freq[i], &sn, &cs);
                const float u = x1[i], v = x2[i];
                x1[i] = u * cs - v * sn; x2[i] = v * cs + u * sn;
            }
            u32x4 o1, o2;
            o1.x = pk_bf16(x1[0], x1[1]); o1.y = pk_bf16(x1[2], x1[3]); o1.z = pk_bf16(x1[4], x1[5]); o1.w = pk_bf16(x1[6], x1[7]);
            o2.x = pk_bf16(x2[0], x2[1]); o2.y = pk_bf16(x2[2], x2[3]); o2.z = pk_bf16(x2[4], x2[5]); o2.w = pk_bf16(x2[6], x2[7]);
            *(u32x4*)(lds + AL_Q + Rr * 128 + ((0 ^ (Rr & 7)) << 4)) = o1;
            *(u32x4*)(lds + AL_Q + Rr * 128 + ((1 ^ (Rr & 7)) << 4)) = o2;
        }
    }
}
__device__ __forceinline__ void attn_ldg(u32x4 (&kk)[2], u32x4 (&vv)[2], const bf16_t* Kb, const bf16_t* Vb, int vstride, int tid) {
#pragma unroll
    for (int j = 0; j < 2; ++j) {
        const int pid = tid + 256 * j, row = pid >> 3, ch = pid & 7;
        kk[j] = *(const u32x4*)(Kb + (size_t)row * 128 + ch * 8);
        vv[j] = *(const u32x4*)(Vb + (size_t)row * vstride + ch * 8);
    }
}
__device__ __forceinline__ void attn_stl(const u32x4 (&kk)[2], const u32x4 (&vv)[2], unsigned char* lds, int kvoff, int tid) {
#pragma unroll
    for (int j = 0; j < 2; ++j) {
        const int pid = tid + 256 * j, row = pid >> 3, ch = pid & 7;
        *(u32x4*)(lds + kvoff + row * 128 + ((ch ^ (row & 7)) << 4)) = kk[j];
        *(u32x4*)(lds + kvoff + 8192 + row * 128 + ((ch ^ ((row >> 1) & 7)) << 4)) = vv[j];
    }
}
__device__ __forceinline__ void attn_qk(f32x4 (&s)[2][4], const unsigned char* lds, int kvoff, int w, int fr, int fq, int hf) {
    const unsigned char* Qw = lds + AL_Q + w * 8192;
    const unsigned char* Kh = lds + kvoff + hf * 4096;
    const int sw0 = ((fq) ^ (fr & 7)) << 4, sw1 = ((4 + fq) ^ (fr & 7)) << 4;
#pragma unroll
    for (int ki = 0; ki < 2; ++ki)
#pragma unroll
        for (int qi = 0; qi < 4; ++qi) s[ki][qi] = (f32x4){0.f, 0.f, 0.f, 0.f};
#pragma unroll
    for (int ds = 0; ds < 2; ++ds) {
        bf16x8 qf[4];
#pragma unroll
        for (int qi = 0; qi < 4; ++qi) qf[qi] = *(const bf16x8*)(Qw + (qi * 16 + fr) * 128 + (ds ? sw1 : sw0));
#pragma unroll
        for (int ki = 0; ki < 2; ++ki) {
            const bf16x8 kf = *(const bf16x8*)(Kh + (ki * 16 + fr) * 128 + (ds ? sw1 : sw0));
#pragma unroll
            for (int qi = 0; qi < 4; ++qi) s[ki][qi] = mfma16(kf, qf[qi], s[ki][qi]);
        }
    }
}
__device__ __forceinline__ void attn_pv(f32x4 (&o)[4][4], const f32x4 (&s)[2][4], const unsigned char* lds, int kvoff, int fr, int fq, int hf) {
    bf16x8 pf[4];
#pragma unroll
    for (int qi = 0; qi < 4; ++qi) {
        u32x4 u;
        u.x = pk_bf16(s[0][qi][0], s[0][qi][1]); u.y = pk_bf16(s[0][qi][2], s[0][qi][3]);
        u.z = pk_bf16(s[1][qi][0], s[1][qi][1]); u.w = pk_bf16(s[1][qi][2], s[1][qi][3]);
        pf[qi] = as_bf8(u);
    }
    const int c0 = 4 * hf + (fq >> 1);
    const unsigned char* Vt = lds + kvoff + 8192;
#pragma unroll
    for (int di = 0; di < 4; ++di) {
        const int row = di * 16 + fr, key = (row >> 1) & 7;
        const u32x2 lo = *(const u32x2*)(Vt + row * 128 + ((c0 ^ key) << 4) + 8 * (fq & 1));
        const u32x2 hi = *(const u32x2*)(Vt + row * 128 + (((c0 + 2) ^ key) << 4) + 8 * (fq & 1));
        const bf16x8 vf = as_bf8((u32x4){lo.x, lo.y, hi.x, hi.y});
#pragma unroll
        for (int qi = 0; qi < 4; ++qi) o[di][qi] = mfma16(vf, pf[qi], o[di][qi]);
    }
}
__device__ __forceinline__ unsigned attn_vmask(int kb, int fq, int lo, int hi) {
    unsigned vm = 0;
#pragma unroll
    for (int ki = 0; ki < 2; ++ki)
#pragma unroll
        for (int r = 0; r < 4; ++r) { const int key = kb + 16 * ki + 4 * fq + r; if (key >= lo && key <= hi) vm |= 1u << (ki * 4 + r); }
    return vm;
}
__device__ __forceinline__ void attn_softmax(f32x4 (&s)[2][4], f32x4 (&o)[4][4], float (&m)[4], float (&lsum)[4], unsigned vm) {
#pragma unroll
    for (int qi = 0; qi < 4; ++qi) {
        float mx = -1e30f;
#pragma unroll
        for (int ki = 0; ki < 2; ++ki)
#pragma unroll
            for (int r = 0; r < 4; ++r) { const float sv = ((vm >> (ki * 4 + r)) & 1u) ? s[ki][qi][r] * SM_C : -1e30f; s[ki][qi][r] = sv; mx = fmaxf(mx, sv); }
        mx = xmax16(mx); mx = xmax32(mx);
        const float mn = fmaxf(m[qi], mx), alpha = fexp2(m[qi] - mn);
        m[qi] = mn;
        float ls = 0.f;
#pragma unroll
        for (int ki = 0; ki < 2; ++ki)
#pragma unroll
            for (int r = 0; r < 4; ++r) { const float pv = ((vm >> (ki * 4 + r)) & 1u) ? fexp2(s[ki][qi][r] - mn) : 0.f; s[ki][qi][r] = pv; ls += pv; }
        lsum[qi] = lsum[qi] * alpha + ls;
        if (__any(alpha != 1.f)) {
#pragma unroll
            for (int di = 0; di < 4; ++di) o[di][qi] *= alpha;
        }
    }
}
__device__ __forceinline__ void attn_softmax_full(f32x4 (&s)[2][4], f32x4 (&o)[4][4], float (&m)[4], float (&lsum)[4], bool lsel) {
#pragma unroll
    for (int qi = 0; qi < 4; ++qi) {
        float mx = fmaxf(fmaxf(fmaxf(s[0][qi][0], s[0][qi][1]), fmaxf(s[0][qi][2], s[0][qi][3])), fmaxf(fmaxf(s[1][qi][0], s[1][qi][1]), fmaxf(s[1][qi][2], s[1][qi][3])));
        mx = xmax16(mx); mx = xmax32(mx);
        const float mn = fmaxf(m[qi], mx * SM_C);
        const float mnew = lsel ? mn : m[qi];
        const float alpha = fexp2(m[qi] - mnew);
        m[qi] = mnew;
        const float neg = lsel ? -mn : -1e30f;
        float ls = 0.f;
#pragma unroll
        for (int ki = 0; ki < 2; ++ki)
#pragma unroll
            for (int r = 0; r < 4; ++r) { const float pv = fexp2(fmaf(s[ki][qi][r], SM_C, neg)); s[ki][qi][r] = pv; ls += pv; }
        lsum[qi] = lsum[qi] * alpha + ls;
        if (__any(alpha != 1.f)) {
#pragma unroll
            for (int di = 0; di < 4; ++di) o[di][qi] *= alpha;
        }
    }
}
__device__ __forceinline__ void attn_softmax_fast(f32x4 (&s)[2][4], const float (&m)[4], float (&lsum)[4], unsigned vm, bool& ovf) {
#pragma unroll
    for (int qi = 0; qi < 4; ++qi) {
        const float neg = -m[qi]; float l = 0.f;
#pragma unroll
        for (int ki = 0; ki < 2; ++ki)
#pragma unroll
            for (int r = 0; r < 4; ++r) { const float pv = ((vm >> (ki * 4 + r)) & 1u) ? fexp2(fmaf(s[ki][qi][r], SM_C, neg)) : 0.f; s[ki][qi][r] = pv; l += pv; }
        lsum[qi] += l; ovf |= !(l < 1.0e12f);
    }
}
__device__ __forceinline__ void attn_accum(bf16_t* dst, const f32x4 (&o)[4][4], const float (&lsum)[4], const float (&gate)[4], bool first, int fq) {
#pragma unroll
    for (int qi = 0; qi < 4; ++qi) {
        float lt = lsum[qi]; lt = xsum16(lt); lt = xsum32(lt);
        const float sc = gate[qi] / fmaxf(lt, 1e-30f);
#pragma unroll
        for (int di = 0; di < 4; ++di) {
            u32x2* ptr = (u32x2*)(dst + qi * 64 + 16 * di + 4 * fq);
            float a0 = o[di][qi][0] * sc, a1 = o[di][qi][1] * sc, a2 = o[di][qi][2] * sc, a3 = o[di][qi][3] * sc;
            if (!first) { const u32x2 f = *ptr; a0 += bflo(f.x); a1 += bfhi(f.x); a2 += bflo(f.y); a3 += bfhi(f.y); }
            u32x2 r; r.x = pk_bf16(a0, a1); r.y = pk_bf16(a2, a3);
            *ptr = r;
        }
    }
}
__device__ __forceinline__ bool attn_retry(bool ovf, unsigned char* lds, int tid) {
    volatile LAS int* flag = (volatile LAS int*)(LAS unsigned char*)(lds + AL_JOB + 4);
    if (__any(ovf) && (tid & 63) == 0) *flag = 1;
    vb_sync(lds);
    const int rf = *flag;
    vb_sync(lds);
    if (rf && tid == 0) *flag = 0;
    return rf != 0;
}
template <class NextF, class PtrF, class BodyF>
__device__ __forceinline__ void attn_tiles(int first, NextF next, PtrF ptrs, BodyF body, unsigned char* lds, int tid) {
    u32x4 kk[2], vv[2];
    const bf16_t* Kb; const bf16_t* Vb; int vs;
    ptrs(first, Kb, Vb, vs);
    attn_ldg(kk, vv, Kb, Vb, vs, tid);
    int cur = first;
    while (cur >= 0) {
        vb_sync(lds);
        attn_stl(kk, vv, lds, AL_KV, tid);
        vb_sync(lds);
        const int nx = next(cur);
        if (nx >= 0) { ptrs(nx, Kb, Vb, vs); attn_ldg(kk, vv, Kb, Vb, vs, tid); }
        body(cur, AL_KV);
        cur = nx;
    }
}

__device__ __forceinline__ void phase_attn(CKP& p, int l, unsigned char* lds, unsigned* ctl) {
    for (int j = VBID(); j < 512; j += VGRID()) s5_job(p, l, j, 2, lds);

    unsigned char* R = p.ws + OFF_R; unsigned char* C = p.ws + OFF_C;
    const bf16_t* Qg = (const bf16_t*)(R + R_Q);
    const bf16_t* Kc = (const bf16_t*)(C + C_KCMP); const bf16_t* Vc = (const bf16_t*)(C + C_VCT);
    const bf16_t* Ks = (const bf16_t*)(R + R_KS); const bf16_t* Vs = (const bf16_t*)(R + R_VST);
    const bf16_t* Kw = (const bf16_t*)(R + R_KW); const bf16_t* Vw = (const bf16_t*)(R + R_VWT);
    const float* NG = (const float*)(R + R_NG);
    bf16_t* AO = (bf16_t*)(C + C_ATT);
    const int* pos = (const int*)p.in[1];
    unsigned* ctr = ctl + CTL_ATTN + l;
    float invf[8];
#pragma unroll
    for (int q = 0; q < 8; ++q) invf[q] = p.inv_freq[q];

    if (opaque_tid() == 0) { *(volatile int*)(lds + AL_JOB + 8) = 0; *(volatile int*)(lds + AL_JOB + 4) = 0; }
    for (;;) {
        lds = vb_lds();
        volatile int* jobp = (volatile int*)(lds + AL_JOB);
        float* imp = (float*)(lds + AL_IMP);
        unsigned long long* selm = (unsigned long long*)(lds + AL_SEL);
        unsigned long long* uni = (unsigned long long*)(lds + AL_UNI);
        const int tid = opaque_tid(), lane = tid & 63, w = tid >> 6, fr = lane & 15, fq = lane >> 4;
        vb_sync(lds);
        if (tid == 0) { *jobp = (int)atomicAdd(ctr, 1u); *(volatile int*)(lds + AL_JOB + 8) += 1; }
        vb_sync(lds);
        const int job = *jobp, grabs = *(volatile int*)(lds + AL_JOB + 8);
        if (grabs == 2 || (job >= 1024 && grabs == 1)) convert_tiles(p, l, 11, 14, VBID() * 4 + w, VGRID() * 4, lane);
        if (job >= 1024) break;
        const int i = 63 - (job >> 4), bg = job & 15, b = bg >> 1, g = bg & 1, t0 = i * 64;
        const int tq = t0 + 16 * w + fr;
        const size_t kvrow = (size_t)b * SEQ;
        float gate[4]; bf16_t* dstq_;

        attn_load_q(Qg, pos, invf, b, g, t0, false, lds, tid);
        const int ntc = ((4 * i + 2) >> 6) + 1;
        const int hic = (tq >= 31) ? ((tq - 31) >> 4) : -1;
        float m[4], lsum[4];
#pragma unroll
        for (int qi = 0; qi < 4; ++qi) { m[qi] = -1e30f; lsum[qi] = 0.f; }
        auto cmp_next = [&](int ct) { return (ct + 1 < ntc) ? ct + 1 : -1; };
        auto cmp_ptrs = [&](int ct, const bf16_t*& Kb, const bf16_t*& Vb, int& vs) {
            Kb = Kc + ((size_t)(b * 256 + ct * 64)) * 128 + g * 64; Vb = Vc + ((size_t)((b * 2 + g) * 64)) * 256 + ct * 64; vs = 256; };
        attn_tiles(0, cmp_next, cmp_ptrs, [&](int ct, int kvoff) {
#pragma unroll 1
            for (int hf = 0; hf < 2; ++hf) {
                f32x4 s[2][4];
                attn_qk(s, lds, kvoff, w, fr, fq, hf);
                const unsigned vm = attn_vmask(ct * 64 + hf * 32, fq, 0, hic);
#pragma unroll
                for (int qi = 0; qi < 4; ++qi) {
                    float mx = -1e30f;
#pragma unroll
                    for (int ki = 0; ki < 2; ++ki)
#pragma unroll
                        for (int r = 0; r < 4; ++r) { const float sv = ((vm >> (ki * 4 + r)) & 1u) ? s[ki][qi][r] * SM_C : -1e30f; s[ki][qi][r] = sv; mx = fmaxf(mx, sv); }
                    mx = xmax16(mx); mx = xmax32(mx);
                    const float mn = fmaxf(m[qi], mx), alpha = fexp2(m[qi] - mn);
                    m[qi] = mn;
                    float ls = 0.f;
#pragma unroll
                    for (int ki = 0; ki < 2; ++ki)
#pragma unroll
                        for (int r = 0; r < 4; ++r) ls += ((vm >> (ki * 4 + r)) & 1u) ? fexp2(s[ki][qi][r] - mn) : 0.f;
                    lsum[qi] = lsum[qi] * alpha + ls;
                }
            }
        }, lds, tid);
        float invl[4];
#pragma unroll
        for (int qi = 0; qi < 4; ++qi) { float lt = lsum[qi]; lt = xsum16(lt); lt = xsum32(lt); invl[qi] = 1.f / fmaxf(lt, 1e-30f); }
        {
            f32x4 o[4][4]; zero_acc(o);
            float carry = 0.f;
            attn_tiles(0, cmp_next, cmp_ptrs, [&](int ct, int kvoff) {
#pragma unroll 1
                for (int hf = 0; hf < 2; ++hf) {
                    f32x4 s[2][4];
                    attn_qk(s, lds, kvoff, w, fr, fq, hf);
                    const unsigned vm = attn_vmask(ct * 64 + hf * 32, fq, 0, hic);
#pragma unroll
                    for (int qi = 0; qi < 4; ++qi)
#pragma unroll
                        for (int ki = 0; ki < 2; ++ki)
#pragma unroll
                            for (int r = 0; r < 4; ++r) s[ki][qi][r] = ((vm >> (ki * 4 + r)) & 1u) ? fexp2(s[ki][qi][r] * SM_C - m[qi]) * invl[qi] : 0.f;
#pragma unroll
                    for (int ki = 0; ki < 2; ++ki) {
                        float a = 0.f, bq = 0.f;
#pragma unroll
                        for (int qi = 0; qi < 4; ++qi) { a += s[ki][qi][0] + s[ki][qi][1] + s[ki][qi][2] + 0.5f * s[ki][qi][3]; bq += 0.5f * s[ki][qi][3]; }
                        const float up = bperm_f((lane + 48) & 63, bq);
                        const float wrap = bperm_f((lane + 48) & 63, carry);
                        a += (fq >= 1) ? up : wrap;
                        carry = bq;
                        imp[(16 * w + fr) * 65 + 16 * ct + 8 * hf + 4 * ki + fq] = a;
                    }
                    attn_pv(o, s, lds, kvoff, fr, fq, hf);
                }
            }, lds, tid);
#pragma unroll
            for (int qi = 0; qi < 4; ++qi) { int rq = (int)kvrow + tq; asm volatile("" : "+v"(rq)); gate[qi] = NG[(size_t)rq * 24 + (g * 4 + qi) * 3 + 0]; }
            const float quarter[4] = {0.25f, 0.25f, 0.25f, 0.25f};
            { int rq2 = (int)kvrow + tq; asm volatile("" : "+v"(rq2)); dstq_ = AO + (size_t)rq2 * 512 + (g * 4) * 64; } attn_accum(dstq_, o, quarter, gate, true, fq);
        }
        vb_sync(lds);
        {
            const int q = tid >> 2, part = tid & 3;
            unsigned long long mk = 0ull;
            if (i <= 15) { mk = (i == 63) ? ~0ull : ((1ull << (i + 1)) - 1ull); }
            else {
                const float* row = imp + q * 65;
                for (int j = 1 + part; j <= i - 2; j += 4) {
                    const float vj = row[j]; int rank = 0;
                    for (int j2 = 1; j2 <= i - 2; ++j2) { const float v2 = row[j2]; rank += (v2 > vj || (v2 == vj && j2 < j)) ? 1 : 0; }
                    if (rank < 13) mk |= 1ull << j;
                }
                unsigned lo32 = (unsigned)mk, hi32 = (unsigned)(mk >> 32);
                lo32 |= bperm_u(lane ^ 1, lo32); hi32 |= bperm_u(lane ^ 1, hi32);
                lo32 |= bperm_u(lane ^ 2, lo32); hi32 |= bperm_u(lane ^ 2, hi32);
                mk = ((unsigned long long)hi32 << 32) | lo32;
                mk |= 1ull | (1ull << i) | (1ull << (i - 1));
            }
            if (part == 0) selm[q] = mk;
            unsigned lo32 = (unsigned)mk, hi32 = (unsigned)(mk >> 32);
#pragma unroll
            for (int o2 = 32; o2 >= 1; o2 >>= 1) { lo32 |= bperm_u(lane ^ o2, lo32); hi32 |= bperm_u(lane ^ o2, hi32); }
            if (lane == 0) uni[w] = ((unsigned long long)hi32 << 32) | lo32;
        }
        vb_sync(lds);
        const unsigned long long mymask = selm[16 * w + fr];
        const unsigned long long un = uni[0] | uni[1] | uni[2] | uni[3];
        vb_sync(lds);
        attn_load_q((const bf16_t*)(R + R_QR), pos, invf, b, g, t0, false, lds, tid);
        auto sel_branch = [&](auto mode_c) -> bool {
            constexpr int mode = decltype(mode_c)::value;
            int kvr = (int)kvrow, bl = b, gl = g; asm volatile("" : "+v"(kvr), "+v"(bl), "+v"(gl));
            f32x4 o[4][4]; zero_acc(o);
#pragma unroll
            for (int qi = 0; qi < 4; ++qi) { m[qi] = -1e30f; lsum[qi] = 0.f; }
            bool ovf = false;
            attn_tiles(0,
                [&](int j) { const unsigned long long rest = (j >= 63) ? 0ull : (un >> (j + 1)); return rest ? (j + 1 + (int)__ffsll((long long)rest) - 1) : -1; },
                [&](int j, const bf16_t*& Kb, const bf16_t*& Vb, int& vs) { Kb = Ks + ((size_t)kvr + j * 64) * 128 + gl * 64; Vb = Vs + ((size_t)((bl * 2 + gl) * 64)) * SEQ + j * 64; vs = SEQ; },
                [&](int j, int kvoff) {
                    const bool lsel = ((mymask >> j) & 1ull) != 0ull;
                    const int hi = lsel ? tq : -1;
#pragma unroll 1
                    for (int hf = 0; hf < 2; ++hf) {
                        f32x4 s[2][4];
                        attn_qk(s, lds, kvoff, w, fr, fq, hf);
                        if (j == 0 || mode) { if (j < i) attn_softmax_full(s, o, m, lsum, lsel); else { const unsigned vm = attn_vmask(j * 64 + hf * 32, fq, 0, hi); attn_softmax(s, o, m, lsum, vm); } }
                        else { const unsigned vm = (j < i) ? (lsel ? 0xffu : 0u) : attn_vmask(j * 64 + hf * 32, fq, 0, hi); attn_softmax_fast(s, m, lsum, vm, ovf); }
                        attn_pv(o, s, lds, kvoff, fr, fq, hf);
                    }
                }, lds, tid);
            if (mode == 0 && attn_retry(ovf, lds, tid)) return true;
#pragma unroll
            for (int qi = 0; qi < 4; ++qi) { int rq = (int)kvrow + tq; asm volatile("" : "+v"(rq)); gate[qi] = NG[(size_t)rq * 24 + (g * 4 + qi) * 3 + 1]; }
            { int rq2 = (int)kvrow + tq; asm volatile("" : "+v"(rq2)); dstq_ = AO + (size_t)rq2 * 512 + (g * 4) * 64; } attn_accum(dstq_, o, lsum, gate, false, fq);
            return false;
        };
        if (sel_branch(std::integral_constant<int, 0>{})) (void)sel_branch(std::integral_constant<int, 1>{});
        auto win_branch = [&](auto mode_c) -> bool {
            constexpr int mode = decltype(mode_c)::value;
            int kvr = (int)kvrow, bl = b, gl = g; asm volatile("" : "+v"(kvr), "+v"(bl), "+v"(gl));
            f32x4 o[4][4]; zero_acc(o);
#pragma unroll
            for (int qi = 0; qi < 4; ++qi) { m[qi] = -1e30f; lsum[qi] = 0.f; }
            const int j0 = (i >= 8) ? (i - 8) : 0;
            bool ovf = false;
            attn_tiles(j0,
                [&](int j) { return (j + 1 <= i) ? j + 1 : -1; },
                [&](int j, const bf16_t*& Kb, const bf16_t*& Vb, int& vs) { Kb = Kw + ((size_t)kvr + j * 64) * 128 + gl * 64; Vb = Vw + ((size_t)((bl * 2 + gl) * 64)) * SEQ + j * 64; vs = SEQ; },
                [&](int j, int kvoff) {
#pragma unroll 1
                    for (int hf = 0; hf < 2; ++hf) {
                        f32x4 s[2][4];
                        attn_qk(s, lds, kvoff, w, fr, fq, hf);
                        if (j <= j0 + 1 || mode) { const unsigned vm = attn_vmask(j * 64 + hf * 32, fq, tq - 511, tq); attn_softmax(s, o, m, lsum, vm); }
                        else { const unsigned vm = (j >= i - 7 && j < i) ? 0xffu : attn_vmask(j * 64 + hf * 32, fq, tq - 511, tq); attn_softmax_fast(s, m, lsum, vm, ovf); }
                        attn_pv(o, s, lds, kvoff, fr, fq, hf);
                    }
                }, lds, tid);
            if (mode == 0 && attn_retry(ovf, lds, tid)) return true;
#pragma unroll
            for (int qi = 0; qi < 4; ++qi) { int rq = (int)kvrow + tq; asm volatile("" : "+v"(rq)); gate[qi] = NG[(size_t)rq * 24 + (g * 4 + qi) * 3 + 2]; }
            { int rq2 = (int)kvrow + tq; asm volatile("" : "+v"(rq2)); dstq_ = AO + (size_t)rq2 * 512 + (g * 4) * 64; } attn_accum(dstq_, o, lsum, gate, false, fq);
            return false;
        };
        if (win_branch(std::integral_constant<int, 0>{})) (void)win_branch(std::integral_constant<int, 1>{});
    }
}

__device__ __forceinline__ void phase_glu(CKP& p, int l, unsigned char* lds) {
    const int tid = opaque_tid(), lane = tid & 63, w = tid >> 6, wm = w >> 1, wn = w & 1, fr = lane & 15, fq = lane >> 4;
    const bf16_t* A = (const bf16_t*)(p.ws + OFF_C + C_YG);
    const bf16_t* Bt = (const bf16_t*)(p.ws + OFF_W + W_GLU);
    bf16_t* O = (bf16_t*)(p.ws + OFF_C + C_S5O);
    const float* gb = p.in[24] + (size_t)l * 256;
    constexpr int NTM = NTOK / 128, NTN = 2;
    for (int L = VBID(); L < NTM * NTN; L += VGRID()) {
        int tm, tn; tile_coords(L, NTM, NTN, tm, tn);
        const int m0 = tm * 128, n0 = tn * 128;
        f32x4 acc[4][4]; zero_acc(acc);
        gemm_kloop(acc, [&](int r) { return A + (size_t)(m0 + r) * 256; }, 64, [&](int v) { return Bt + (size_t)(n0 + v) * 256; }, 64, 4, lds, tid);
#pragma unroll
        for (int mi = 0; mi < 4; ++mi) {
            const int row = m0 + 64 * wm + 16 * mi + fr, col = n0 + 64 * wn + 16 * fq;
            const u32x4 y0 = *(const u32x4*)(A + (size_t)row * 256 + col), y1 = *(const u32x4*)(A + (size_t)row * 256 + col + 8);
            const unsigned yy[8] = {y0.x, y0.y, y0.z, y0.w, y1.x, y1.y, y1.z, y1.w};
            float v[16];
#pragma unroll
            for (int e = 0; e < 16; ++e) {
                const float y = (e & 1) ? bfhi(yy[e >> 1]) : bflo(yy[e >> 1]);
                v[e] = y * sigm(acc[mi][e >> 2][e & 3] + gb[col + e]);
            }
            store16bf(O + (size_t)row * 256 + col, v);
        }
    }
}

struct G8Branch {
    static constexpr bool GATHER = false;
    const char* ws;
    __device__ __forceinline__ bool next(int i, G8Unit& u, const int (&R)[2], const unsigned (&C2)[2]) const {
        const int T = i / 6, sub = i - T * 6, L = T * (int)gridDim.x + (int)blockIdx.x;
        if (L >= (NTOK / 256) * 4) return false;
        int pm, pn; tile_coords(L, NTOK / 256, 4, pm, pn); pm = __builtin_amdgcn_readfirstlane(pm); pn = __builtin_amdgcn_readfirstlane(pn);
        if (sub == 1 || sub >= 4) {
            u.K2 = 2048u; u.nt = 16; u.A0 = ws + OFF_X + (size_t)pm * 256 * 2048;
            if (sub == 1) { u.B0 = ws + OFF_W + W_GB + (size_t)(pn * 256) * 2048; u.B1 = u.B0 + (size_t)128 * 2048; }
            else { u.B0 = ws + OFF_W + W_GB + (size_t)(1024 + pn * 256 + (sub - 4) * 128) * 2048; u.B1 = u.B0 + (size_t)1024 * 2048; }
        } else {
            const int br = (sub == 0) ? 0 : sub - 1;
            const unsigned k2 = br == 0 ? 1024u : 512u; u.K2 = k2; u.nt = br == 0 ? 8 : 4;
            const size_t b1 = (size_t)(br == 1), b2 = (size_t)(br == 2);
            const char* a = ws + (size_t)(OFF_C + C_ATT) + b1 * (size_t)(C_SGU - C_ATT) + b2 * (size_t)(C_S5O - C_ATT);
            const char* w = ws + (size_t)(OFF_W + W_A) + b1 * (size_t)(W_S - W_A) + b2 * (size_t)(W_5 - W_A);
            u.A0 = a + (size_t)pm * 256 * k2; u.B0 = w + (size_t)pn * 256 * k2; u.B1 = u.B0 + (size_t)128 * k2;
        }
        u.A1 = u.A0 + (size_t)128 * u.K2;
        u.x0 = pm; u.x1 = pn; u.x2 = sub; u.x3 = 0;
#pragma unroll
        for (int h = 0; h < 2; ++h)
#pragma unroll
            for (int k = 0; k < 2; ++k) u.ao[h][k] = (unsigned)R[k] * u.K2 + C2[k];
        return true;
    }
};
struct EpiBranch {
    bf16_t* T1; bf16_t* T2; bf16_t* Mg; const float* rs1;
    __device__ __forceinline__ void operator()(const G8Acc& acc, const G8Unit& u, int wr, int wc, int fr, int fq) const {
        const int sub = u.x2;
        const size_t off0 = (size_t)(u.x0 * 256 + wr * 64 + fr) * 1024 + u.x1 * 256 + wc * 32 + 8 * fq;
        if (sub == 0 || sub == 2 || sub == 3) {
            bf16_t* Tt = (sub == 3) ? T2 : T1;
#pragma unroll
            for (int ai = 0; ai < 2; ++ai)
#pragma unroll
                for (int m = 0; m < 4; ++m)
#pragma unroll
                    for (int bj = 0; bj < 2; ++bj) {
                        const f32x4 v0 = acc[ai][bj][m][0], v1 = acc[ai][bj][m][1];
                        u32x4 o; o.x = pk_bf16(v0[0], v0[1]); o.y = pk_bf16(v0[2], v0[3]); o.z = pk_bf16(v1[0], v1[1]); o.w = pk_bf16(v1[2], v1[3]);
                        *(u32x4*)(Tt + off0 + (size_t)(ai * 128 + m * 16) * 1024 + bj * 128) = o;
                    }
        } else if (sub == 1) {
#pragma unroll
            for (int ai = 0; ai < 2; ++ai) {
                float rsv[4];
#pragma unroll
                for (int m = 0; m < 4; ++m) rsv[m] = rs1[u.x0 * 256 + ai * 128 + wr * 64 + m * 16 + fr];
                u32x4 y[4][2];
#pragma unroll
                for (int m = 0; m < 4; ++m)
#pragma unroll
                    for (int bj = 0; bj < 2; ++bj) y[m][bj] = *(const u32x4*)(T1 + off0 + (size_t)(ai * 128 + m * 16) * 1024 + bj * 128);
#pragma unroll
                for (int m = 0; m < 4; ++m)
#pragma unroll
                    for (int bj = 0; bj < 2; ++bj) {
                        const f32x4 v0 = acc[ai][bj][m][0] * rsv[m], v1 = acc[ai][bj][m][1] * rsv[m];
                        const u32x4 yy = y[m][bj];
                        u32x4 o;
                        o.x = pk_bf16(sigm(v0[0]) * bflo(yy.x), sigm(v0[1]) * bfhi(yy.x));
                        o.y = pk_bf16(sigm(v0[2]) * bflo(yy.y), sigm(v0[3]) * bfhi(yy.y));
                        o.z = pk_bf16(sigm(v1[0]) * bflo(yy.z), sigm(v1[1]) * bfhi(yy.z));
                        o.w = pk_bf16(sigm(v1[2]) * bflo(yy.w), sigm(v1[3]) * bfhi(yy.w));
                        *(u32x4*)(Mg + off0 + (size_t)(ai * 128 + m * 16) * 1024 + bj * 128) = o;
                    }
            }
        } else {
            const size_t offc = off0 + (size_t)(sub - 4) * 128;
#pragma unroll
            for (int ai = 0; ai < 2; ++ai) {
                float rsv[4];
#pragma unroll
                for (int m = 0; m < 4; ++m) rsv[m] = rs1[u.x0 * 256 + ai * 128 + wr * 64 + m * 16 + fr];
                u32x4 y1[4], y2[4], pv[4];
#pragma unroll
                for (int m = 0; m < 4; ++m) {
                    const size_t off = offc + (size_t)(ai * 128 + m * 16) * 1024;
                    y1[m] = *(const u32x4*)(T1 + off); y2[m] = *(const u32x4*)(T2 + off); pv[m] = *(const u32x4*)(Mg + off);
                }
#pragma unroll
                for (int m = 0; m < 4; ++m) {
                    const f32x4 a0 = acc[ai][0][m][0] * rsv[m], a1 = acc[ai][0][m][1] * rsv[m], b0 = acc[ai][1][m][0] * rsv[m], b1 = acc[ai][1][m][1] * rsv[m];
                    const u32x4 p1 = y1[m], p2 = y2[m], pp = pv[m];
                    u32x4 o;
                    o.x = pk_bf16(sigm(a0[0]) * bflo(p1.x) + sigm(b0[0]) * bflo(p2.x) + bflo(pp.x), sigm(a0[1]) * bfhi(p1.x) + sigm(b0[1]) * bfhi(p2.x) + bfhi(pp.x));
                    o.y = pk_bf16(sigm(a0[2]) * bflo(p1.y) + sigm(b0[2]) * bflo(p2.y) + bflo(pp.y), sigm(a0[3]) * bfhi(p1.y) + sigm(b0[3]) * bfhi(p2.y) + bfhi(pp.y));
                    o.z = pk_bf16(sigm(a1[0]) * bflo(p1.z) + sigm(b1[0]) * bflo(p2.z) + bflo(pp.z), sigm(a1[1]) * bfhi(p1.z) + sigm(b1[1]) * bfhi(p2.z) + bfhi(pp.z));
                    o.w = pk_bf16(sigm(a1[2]) * bflo(p1.w) + sigm(b1[2]) * bflo(p2.w) + bflo(pp.w), sigm(a1[3]) * bfhi(p1.w) + sigm(b1[3]) * bfhi(p2.w) + bfhi(pp.w));
                    *(u32x4*)(Mg + offc + (size_t)(ai * 128 + m * 16) * 1024) = o;
                }
            }
        }
    }
};
__device__ __forceinline__ void phase_branch(CKP& p, int l, unsigned char* lds) {
    G8Branch S{(const char*)p.ws};
    EpiBranch E{(bf16_t*)(p.ws + OFF_R), (bf16_t*)(p.ws + OFF_R + 67108864), (bf16_t*)(p.ws + OFF_M), (const float*)(p.ws + OFF_RS1)};
    g8_phase(S, E);
}

struct EpiMix {
    bf16_t* x;
    __device__ __forceinline__ void operator()(const G8Acc& acc, const G8Unit& u, int wr, int wc, int fr, int fq) const {
        bf16_t* xp0 = x + (size_t)(u.x0 * 256 + wr * 64 + fr) * 1024 + u.x1 * 256 + wc * 32 + 8 * fq;
#pragma unroll
        for (int ai = 0; ai < 2; ++ai) {
            u32x4 xv[4][2];
#pragma unroll
            for (int m = 0; m < 4; ++m)
#pragma unroll
                for (int bj = 0; bj < 2; ++bj) xv[m][bj] = *(const u32x4*)(xp0 + (size_t)(ai * 128 + m * 16) * 1024 + bj * 128);
#pragma unroll
            for (int m = 0; m < 4; ++m)
#pragma unroll
                for (int bj = 0; bj < 2; ++bj) {
                    const f32x4 a0 = acc[ai][bj][m][0], a1 = acc[ai][bj][m][1]; const u32x4 xx = xv[m][bj];
                    u32x4 o;
                    o.x = pk_bf16(bflo(xx.x) + a0[0], bfhi(xx.x) + a0[1]); o.y = pk_bf16(bflo(xx.y) + a0[2], bfhi(xx.y) + a0[3]);
                    o.z = pk_bf16(bflo(xx.z) + a1[0], bfhi(xx.z) + a1[1]); o.w = pk_bf16(bflo(xx.w) + a1[2], bfhi(xx.w) + a1[3]);
                    *(u32x4*)(xp0 + (size_t)(ai * 128 + m * 16) * 1024 + bj * 128) = o;
                }
        }
    }
};
__device__ __forceinline__ void phase_mix(CKP& p, int l, unsigned char* lds) {
    G8Plain S{(const char*)(p.ws + OFF_M), (const char*)(p.ws + OFF_W + W_M), 2048u, 16, NTOK / 256, 4};
    EpiMix E{(bf16_t*)(p.ws + OFF_X)};
    g8_phase(S, E);
}

__device__ __forceinline__ void phase_router(CKP& p, int l, unsigned char* lds, unsigned* ctl) {
    const int tid = opaque_tid(), lane = tid & 63, w = tid >> 6, wm = w >> 1, wn = w & 1, fr = lane & 15, fq = lane >> 4;
    int t512 = TIDX(); asm volatile("" : "+v"(t512));
    const int half = t512 >> 8, w8 = t512 >> 6;
    const float* gam = p.in[27] + (size_t)l * 1024;
    const float* bg = p.in[29] + (size_t)l * 4;
    const float* be = p.in[31] + (size_t)l * 32;
    const bf16_t* xres = (const bf16_t*)(p.ws + OFF_X);
    bf16_t* h2 = (bf16_t*)(p.ws + OFF_M);
    bf16_t* hlo = (bf16_t*)(p.ws + OFF_H);
    const bf16_t* Wh = (const bf16_t*)(p.ws + OFF_W + W_RH);
    const bf16_t* Wl = (const bf16_t*)(p.ws + OFF_W + W_RL);
    unsigned* cnt = ctl + CTL_MOECNT + l * 32;
    int* list = (int*)(p.ws + OFF_MOE + MOE_LIST);
    float* wsl = (float*)(p.ws + OFF_MOE + MOE_WS);
    unsigned char* lds0 = lds_base();
    float* lg = (float*)lds0;
    float* xch = (float*)(lds0 + VB_LDS);
    int* lc = (int*)(lds0 + 18432); int* gbs = (int*)(lds0 + 18432 + 128);
    float* rs = (float*)(lds0 + 65536);
    float* rsl = (float*)(p.ws + OFF_MOE + MOE_RS);
    for (int tile = blockIdx.x; tile < NTOK / 128; tile += gridDim.x) {
        const int r0 = tile * 128;
        {
            for (int rr = 0; rr < 16; rr += 2) {
                const int row = r0 + w8 * 16 + rr;
                float sa = 0.f, sb = 0.f;
#pragma unroll
                for (int i = 0; i < 4; ++i) { const u32x2 ua = *(const u32x2*)(xres + (size_t)row * 1024 + 4 * lane + 256 * i), ub = *(const u32x2*)(xres + (size_t)(row + 1) * 1024 + 4 * lane + 256 * i);
                                              sa += bflo(ua.x) * bflo(ua.x) + bfhi(ua.x) * bfhi(ua.x) + bflo(ua.y) * bflo(ua.y) + bfhi(ua.y) * bfhi(ua.y);
                                              sb += bflo(ub.x) * bflo(ub.x) + bfhi(ub.x) * bfhi(ub.x) + bflo(ub.y) * bflo(ub.y) + bfhi(ub.y) * bfhi(ub.y); }
                sa = wave_sum(sa); sb = wave_sum(sb);
                if (lane == 0) { rs[w8 * 16 + rr] = rsqrtf(sa * (1.f / 1024.f) + RMS_EPS); rs[w8 * 16 + rr + 1] = rsqrtf(sb * (1.f / 1024.f) + RMS_EPS); }
            }
        }
        __syncthreads();
        f32x4 acc[4][4]; zero_acc(acc);
        {
            const bf16_t* Wx = half ? Wl : Wh;
            gemm_kloop(acc, [&](int r) { return xres + (size_t)(r0 + r) * 1024; }, 64, [&](int v) { return Wx + (size_t)(v < 63 ? v : 63) * 1024; }, 64, 16, lds, tid);
        }
        __syncthreads();
        int lbase = (64 * wm + fr) * 36 + 16 * fq; asm volatile("" : "+v"(lbase));
        if (half == 1 && wn == 0 && fq < 3) {
#pragma unroll
            for (int mi = 0; mi < 4; ++mi)
#pragma unroll
                for (int e = 0; e < 16; ++e) if (e < 4 || fq < 2) xch[lbase + mi * 576 + e] = acc[mi][e >> 2][e & 3];
        }
        __syncthreads();
        if (half == 0 && tid < 32) lc[tid] = 0;
        if (half == 0 && wn == 0 && fq < 3) {
#pragma unroll
            for (int mi = 0; mi < 4; ++mi)
#pragma unroll
                for (int e = 0; e < 16; ++e) if (e < 4 || fq < 2) lg[lbase + mi * 576 + e] = (acc[mi][e >> 2][e & 3] + xch[lbase + mi * 576 + e]) * rs[64 * wm + 16 * mi + fr];
        }
        __syncthreads();
        int e0 = 0, e1 = 0, lr0 = 0, lr1 = 0; float c0 = 0.f, c1 = 0.f;
        if (half == 0 && tid < 128) {
            const float* lrow = lg + tid * 36;
            float gl[4]; int grp = 0; float gm = -3.4e38f;
#pragma unroll
            for (int q = 0; q < 4; ++q) { gl[q] = lrow[q] + bg[q]; if (gl[q] > gm) { gm = gl[q]; grp = q; } }
            float gsum = 0.f;
#pragma unroll
            for (int q = 0; q < 4; ++q) gsum += expf(gl[q] - gm);
            const float grp_w = 1.f / gsum;
            float el[8]; float em = -3.4e38f;
#pragma unroll
            for (int q = 0; q < 8; ++q) { el[q] = lrow[4 + grp * 8 + q] + be[grp * 8 + q]; em = fmaxf(em, el[q]); }
            float esum = 0.f; float ep[8];
#pragma unroll
            for (int q = 0; q < 8; ++q) { ep[q] = expf(el[q] - em); esum += ep[q]; }
            int j0 = 0; float p0 = -1.f;
#pragma unroll
            for (int q = 0; q < 8; ++q) { const float pq = ep[q] / esum; ep[q] = pq; if (pq > p0) { p0 = pq; j0 = q; } }
            int j1 = 0; float p1 = -1.f;
#pragma unroll
            for (int q = 0; q < 8; ++q) { if (q != j0 && ep[q] > p1) { p1 = ep[q]; j1 = q; } }
            const float den = p0 + p1;
            c0 = grp_w * p0 / den; c1 = grp_w * p1 / den;
            e0 = grp * 8 + j0; e1 = grp * 8 + j1;
            lr0 = atomicAdd(&lc[e0], 1); lr1 = atomicAdd(&lc[e1], 1);
        }
        __syncthreads();
        if (half == 0 && tid < 32) { const int n = lc[tid]; gbs[tid] = n ? (int)atomicAdd(&cnt[tid], (unsigned)n) : 0; }
        __syncthreads();
        if (half == 0 && tid < 128) {
            const int tok = r0 + tid;
            list[e0 * 32768 + gbs[e0] + lr0] = tok * 2; list[e1 * 32768 + gbs[e1] + lr1] = tok * 2 + 1;
            rsl[e0 * 32768 + gbs[e0] + lr0] = rs[tid]; rsl[e1 * 32768 + gbs[e1] + lr1] = rs[tid];
            wsl[tok * 2] = c0; wsl[tok * 2 + 1] = c1;
        }
        __syncthreads();
    }
}

__device__ __forceinline__ bool moe_unit(const unsigned* cnt, int i, int& e, int& mt, int& sub, int& rowbase, int& n) {
    int lane = lane_id(); asm volatile("" : "+v"(lane));
    const int c = (lane < 32) ? (int)cnt[lane] : 0;
    const int nt = (c + 255) >> 8, nt128 = (c + 127) >> 7;
    int pre = nt, pre128 = nt128;
#pragma unroll
    for (int o = 1; o < 32; o <<= 1) {
        const int src = (lane - o) << 2;
        const int v = __builtin_amdgcn_ds_bpermute(src, pre), v2 = __builtin_amdgcn_ds_bpermute(src, pre128);
        if (lane >= o) { pre += v; pre128 += v2; }
    }
    const int total = __builtin_amdgcn_readlane(pre, 31) * 4;
    const int Lp = i * (int)gridDim.x + (int)blockIdx.x, q = (total + 7) >> 3, off = Lp >> 3;
    const int L = (Lp & 7) * q + off;
    if (off >= q || L >= total) return false;
    const int excl = pre - nt;
    const bool mine = (lane < 32) && (L >= excl * 4) && (L < pre * 4);
    const unsigned long long bal = __ballot(mine);
    if (bal == 0ull) return false;
    const int ee = __builtin_amdgcn_readfirstlane(__ffsll((long long)bal) - 1);
    e = ee;
    n = __builtin_amdgcn_readlane(c, ee);
    rowbase = __builtin_amdgcn_readlane(pre128 - nt128, ee) * 128;
    const int r = L - __builtin_amdgcn_readlane(excl, ee) * 4;
    mt = r >> 2; sub = r & 3;
    return true;
}
struct G8Exp1 {
    static constexpr bool GATHER = true;
    const unsigned* cnt; const int* list; const char* h2; const char* Wg; const char* Wu;
    __device__ __forceinline__ bool next(int i, G8Unit& u, const int (&R)[2], const unsigned (&C2)[2]) const {
        int e, mt, sub, rowbase, n;
        if (!moe_unit(cnt, i, e, mt, sub, rowbase, n)) return false;
        u.A0 = h2; u.A1 = h2; u.K2 = 2048u; u.nt = 16;
        u.B0 = Wg + ((size_t)e * 512 + sub * 128) * 2048; u.B1 = Wu + ((size_t)e * 512 + sub * 128) * 2048;
        u.x0 = e; u.x1 = mt; u.x2 = sub; u.x3 = rowbase; u.n = n;
#pragma unroll
        for (int h = 0; h < 2; ++h)
#pragma unroll
            for (int k = 0; k < 2; ++k) { int sidx = mt * 256 + h * 128 + R[k]; sidx = sidx < n ? sidx : n - 1; u.ao[h][k] = (unsigned)(list[e * 32768 + sidx] >> 1) * 2048u + C2[k]; }
        return true;
    }
};
struct EpiExp1 {
    bf16_t* hid; const float* rsl;
    __device__ __forceinline__ void operator()(const G8Acc& acc, const G8Unit& u, int wr, int wc, int fr, int fq) const {
        float rsv[2][4];
#pragma unroll
        for (int ai = 0; ai < 2; ++ai)
#pragma unroll
            for (int m = 0; m < 4; ++m) { int r = u.x1 * 256 + ai * 128 + wr * 64 + m * 16 + fr; r = r < u.n ? r : u.n - 1; rsv[ai][m] = rsl[u.x0 * 32768 + r]; }
#pragma unroll
        for (int ai = 0; ai < 2; ++ai)
#pragma unroll
            for (int m = 0; m < 4; ++m) {
                const int r = u.x1 * 256 + ai * 128 + wr * 64 + m * 16 + fr;
                if (r < u.n) {
                    const float rs = rsv[ai][m];
                    float hv[8];
#pragma unroll
                    for (int j = 0; j < 8; ++j) { const float g = acc[ai][0][m][j >> 2][j & 3] * rs, up = acc[ai][1][m][j >> 2][j & 3] * rs; hv[j] = g * sigm(g) * up; }
                    u32x4 o; o.x = pk_bf16(hv[0], hv[1]); o.y = pk_bf16(hv[2], hv[3]); o.z = pk_bf16(hv[4], hv[5]); o.w = pk_bf16(hv[6], hv[7]);
                    *(u32x4*)(hid + (size_t)(u.x3 + r) * 512 + u.x2 * 128 + wc * 32 + 8 * fq) = o;
                }
            }
    }
};
__device__ __forceinline__ void phase_exp1(CKP& p, int l, unsigned char* lds, unsigned* ctl) {
    G8Exp1 S{ctl + CTL_MOECNT + l * 32, (const int*)(p.ws + OFF_MOE + MOE_LIST), (const char*)(p.ws + OFF_X), (const char*)(p.ws + OFF_W + W_EG), (const char*)(p.ws + OFF_W + W_EU)};
    EpiExp1 E{(bf16_t*)(p.ws + OFF_HID), (const float*)(p.ws + OFF_MOE + MOE_RS)};
    g8_phase(S, E);
}
struct G8Exp2 {
    static constexpr bool GATHER = true;
    const unsigned* cnt; const char* hid; const char* Wd;
    __device__ __forceinline__ bool next(int i, G8Unit& u, const int (&R)[2], const unsigned (&C2)[2]) const {
        int e, mt, sub, rowbase, n;
        if (!moe_unit(cnt, i, e, mt, sub, rowbase, n)) return false;
        u.A0 = hid + (size_t)(rowbase + mt * 256) * 1024; u.A1 = u.A0; u.K2 = 1024u; u.nt = 8;
        u.B0 = Wd + ((size_t)e * 1024 + sub * 256) * 1024; u.B1 = u.B0 + (size_t)128 * 1024;
        u.x0 = e; u.x1 = mt; u.x2 = sub; u.x3 = rowbase; u.n = n;
        const int lim = n - mt * 256 - 1;
#pragma unroll
        for (int h = 0; h < 2; ++h)
#pragma unroll
            for (int k = 0; k < 2; ++k) { const int rr = h * 128 + R[k]; u.ao[h][k] = (unsigned)(rr < lim ? rr : lim) * 1024u + C2[k]; }
        return true;
    }
};
struct EpiExp2 {
    const int* list; const float* wsl; bf16_t* ys;
    __device__ __forceinline__ void operator()(const G8Acc& acc, const G8Unit& u, int wr, int wc, int fr, int fq) const {
        int slot[2][4]; float wt[2][4];
#pragma unroll
        for (int ai = 0; ai < 2; ++ai)
#pragma unroll
            for (int m = 0; m < 4; ++m) { int r = u.x1 * 256 + ai * 128 + wr * 64 + m * 16 + fr; r = r < u.n ? r : u.n - 1; slot[ai][m] = list[u.x0 * 32768 + r]; }
#pragma unroll
        for (int ai = 0; ai < 2; ++ai)
#pragma unroll
            for (int m = 0; m < 4; ++m) wt[ai][m] = wsl[slot[ai][m]];
#pragma unroll
        for (int ai = 0; ai < 2; ++ai)
#pragma unroll
            for (int m = 0; m < 4; ++m) {
                const int r = u.x1 * 256 + ai * 128 + wr * 64 + m * 16 + fr;
                if (r < u.n) {
                    bf16_t* dst = ys + (size_t)slot[ai][m] * 1024 + u.x2 * 256 + wc * 32 + 8 * fq;
                    const float w = wt[ai][m];
#pragma unroll
                    for (int bj = 0; bj < 2; ++bj) {
                        const f32x4 v0 = acc[ai][bj][m][0] * w, v1 = acc[ai][bj][m][1] * w;
                        u32x4 o; o.x = pk_bf16(v0[0], v0[1]); o.y = pk_bf16(v0[2], v0[3]); o.z = pk_bf16(v1[0], v1[1]); o.w = pk_bf16(v1[2], v1[3]);
                        *(u32x4*)(dst + bj * 128) = o;
                    }
                }
            }
    }
};
__device__ __forceinline__ void phase_exp2(CKP& p, int l, unsigned char* lds, unsigned* ctl) {
    G8Exp2 S{ctl + CTL_MOECNT + l * 32, (const char*)(p.ws + OFF_HID), (const char*)(p.ws + OFF_W + W_ED)};
    EpiExp2 E{(const int*)(p.ws + OFF_MOE + MOE_LIST), (const float*)(p.ws + OFF_MOE + MOE_WS), (bf16_t*)(p.ws + OFF_YS)};
    g8_phase(S, E);
}

constexpr int PH_PER_LAYER = 10;
constexpr int NPHASE = PH_PER_LAYER * DEPTH + 1;

__global__ __attribute__((target("no-packed-fp32-ops"))) void __launch_bounds__(NTHR_HW, 1) mega(KP p_unused) {
    extern __shared__ __attribute__((aligned(16))) unsigned char lds_all[];
    if ((threadIdx.x & 255) == 0) *(volatile unsigned*)(lds_all + VB_CTR + ((threadIdx.x >> 8) << 6)) = 0u;
    if ((threadIdx.x & 63) == 0) *(volatile unsigned char*)(lds_all + VB_CTR + 192 + hw_wave_key()) = (unsigned char)(threadIdx.x >> 6);
    __syncthreads();
    unsigned* ctl = (unsigned*)(p_unused.ws + OFF_CTL);
#if ONE_LAUNCH
    XcdBarrier xb = xcd_barrier_post(ctl + CTL_BAR, (volatile LAS unsigned*)(lds_all + VB_CTR + 128));
    if (p_unused.never) cg::this_grid().sync();
#if DBG_PREFLUSH
    __builtin_amdgcn_fence(__ATOMIC_RELEASE, "");
    asm volatile("s_waitcnt vmcnt(0)" ::: "memory");
    __builtin_amdgcn_fence(__ATOMIC_ACQUIRE, "");
    asm volatile("s_waitcnt vmcnt(0)" ::: "memory");
    xcd_barrier(xb);
    { const unsigned long long t0 = __builtin_amdgcn_s_memrealtime(); while (__builtin_amdgcn_s_memrealtime() - t0 < 20000ull) __builtin_amdgcn_s_sleep(8); }
    xcd_barrier(xb);
#endif
#endif
    CKP* kp0 = (CKP*)__builtin_amdgcn_kernarg_segment_ptr();
    const int ph_lo = kp0->ph_lo, ph_hi = kp0->ph_hi;
#if ONE_LAUNCH
#define PH_SYNC(PH) if ((PH) + 1 < ph_hi) xcd_barrier(xb);
#else
#define PH_SYNC(PH)
#endif
#if DBG_TIMEPH >= 0
#define PH_STAMP(PH) if (blockIdx.x == 0 && TIDX() == 0) ((unsigned long long*)(kp0->ws + OFF_CTL + 24576))[(PH)] = __builtin_amdgcn_s_memrealtime();
#else
#define PH_STAMP(PH)
#endif
#define RUN_PHASE(PH, CALL) if (ph_lo <= (PH) && (PH) < ph_hi) { PH_STAMP(PH) CKP* kp = kp0; asm volatile("" : "+s"(kp)); CKP& p = *kp; const int rep_ = 0; (void)rep_; unsigned char* lds = vb_lds(); CALL; \
    if ((PH) == DBG_REPEAT_PH) { xcd_barrier(xb); const int rep_ = 1; (void)rep_; CALL; } PH_SYNC(PH) }
#define RUN_LAYER(L) \
    RUN_PHASE((L) * 10 + 0, phase_prep(p, (L), lds)) \
    RUN_PHASE((L) * 10 + 1, phase_inproj(p, (L), lds)) \
    RUN_PHASE((L) * 10 + 2, phase_mid1(p, (L), lds)) \
    RUN_PHASE((L) * 10 + 3, phase_attn(p, (L), lds, ctl + 2 * rep_)) \
    RUN_PHASE((L) * 10 + 4, phase_glu(p, (L), lds)) \
    RUN_PHASE((L) * 10 + 5, phase_branch(p, (L), lds)) \
    RUN_PHASE((L) * 10 + 6, phase_mix(p, (L), lds)) \
    RUN_PHASE((L) * 10 + 7, phase_router(p, (L), lds, ctl)) \
    RUN_PHASE((L) * 10 + 8, phase_exp1(p, (L), lds, ctl)) \
    RUN_PHASE((L) * 10 + 9, phase_exp2(p, (L), lds, ctl))
#if DBG_SMALLK
    RUN_PHASE(0, phase_prep(p, 0, lds))
    RUN_PHASE(1, phase_inproj(p, 0, lds))
    RUN_PHASE(2, phase_mid1(p, 0, lds))
#else
    RUN_LAYER(0)
    RUN_LAYER(1)
    RUN_PHASE(20, phase_prep(p, 2, lds))
#endif
#if ONE_LAUNCH && DBG_DUMP
    {
        xcd_barrier(xb);
        CKP* kp = kp0; asm volatile("" : "+s"(kp)); CKP& p = *kp;
        const size_t NO = (size_t)NTOK * 1024;
        const unsigned char* src = p.ws + DBG_DUMP_OFF;
        for (size_t i = (size_t)blockIdx.x * NTHR_HW + threadIdx.x; i < NO; i += (size_t)gridDim.x * NTHR_HW) {
            float v = 0.f;
            if (i < (size_t)DBG_DUMP_N) {
                if (DBG_DUMP_F32) {
                    const size_t si = DBG_DUMP_REV ? ((size_t)DBG_DUMP_N - 1 - i) : i;
#if DBG_SC1READ
                    const unsigned fu = __hip_atomic_load((const unsigned*)src + si, __ATOMIC_RELAXED, __HIP_MEMORY_SCOPE_SYSTEM); const float f = __uint_as_float(fu);
#else
                    const float f = ((const float*)src)[si];
#endif
                    v = DBG_HASH ? (float)(__float_as_uint(f) & 0x3ff) : f;
#if DBG_EFILT
                    { const int id_ = (int)(((si >> 7) - DBG_IDROT) & 2047), blk = ((id_ >> 2) + 320) & 511; if (!(blk >= DBG_EFILT_LO && blk < DBG_EFILT_HI)) v = 0.f; }
#endif
#if DBG_E2
                    { const float f2 = ((const float*)(p.ws + OFF_C + C_ATT))[i]; v = (__float_as_uint(f2) == __float_as_uint(f)) ? 0.f : 1000.f; if (i == 0) v += 1.f; }
#endif
                }
                else { const bf16_t h = ((const bf16_t*)src)[i]; v = DBG_HASH ? (float)(h & 0x3ff) : bf2f(h); }
            }
#if DBG_CONSTOUT
            v = 1000.f + (float)(i & 1023);
#endif
            p.xbuf[i] = v;
        }
    }
#endif
}

#if DBG_DUMP
__global__ void dbg_dump(const bf16_t* src, size_t n, float* out, size_t nout) {
    for (size_t i = (size_t)blockIdx.x * blockDim.x + threadIdx.x; i < nout; i += (size_t)gridDim.x * blockDim.x)
        out[i] = i < n ? (DBG_HASH ? (float)(src[i] & 0x3ff) : bf2f(src[i])) : 0.f;
}
__global__ void dbg_dump_f32(const float* src, size_t n, float* out, size_t nout) {
    for (size_t i = (size_t)blockIdx.x * blockDim.x + threadIdx.x; i < nout; i += (size_t)gridDim.x * blockDim.x)
        out[i] = i < n ? (DBG_HASH ? (float)(__float_as_uint(src[i]) & 0x3ff) : src[i]) : 0.f;
}
#endif
extern "C" void kernel_launch(void* const* d_in, const int* in_sizes, int n_in, void* d_out, int out_size, void* d_ws, size_t ws_size, hipStream_t stream) {
    static int grid = 0;
    if (grid == 0) {
        if (n_in != 36 || out_size != NTOK * DM || ws_size < WS_END) { fprintf(stderr, "kernel_launch: unexpected shapes n_in %d out %d ws %zu (need %zu)\n", n_in, out_size, ws_size, (size_t)WS_END); grid = -1; return; }
        int dev = 0, cus = 0, per_cu = 0;
        hipGetDevice(&dev);
        hipDeviceGetAttribute(&cus, hipDeviceAttributeMultiprocessorCount, dev);
        hipFuncSetAttribute((const void*)mega, hipFuncAttributeMaxDynamicSharedMemorySize, LDS_BYTES);
        hipOccupancyMaxActiveBlocksPerMultiprocessor(&per_cu, (const void*)mega, NTHR_HW, LDS_BYTES);
        if (per_cu < 1) { fprintf(stderr, "kernel_launch: occupancy query says %d\n", per_cu); per_cu = 1; }
        if (per_cu > MAX_PER_CU) per_cu = MAX_PER_CU;
        grid = cus * per_cu;
        fprintf(stderr, "kernel_launch: grid %d (%d CUs x %d)\n", grid, cus, per_cu);
    }
    if (grid < 0) return;
    hipMemsetAsync((char*)d_ws + OFF_CTL, 0, CTL_BYTES, stream);
    KP p{};
    for (int i = 0; i < 36; ++i) p.in[i] = (const float*)d_in[i];
    p.xbuf = (float*)d_out; p.ws = (unsigned char*)d_ws;
    for (int i = 0; i < 8; ++i) p.inv_freq[i] = (float)pow(500000.0, -(double)i / 8.0);
    p.never = 0; p.pad = 0;
#if ONE_LAUNCH
    p.ph_lo = 0; p.ph_hi = DBG_PH_HI;
    void* args[] = {&p};
    hipError_t e = hipLaunchCooperativeKernel((const void*)mega, dim3(grid), dim3(NTHR_HW), args, LDS_BYTES, stream);
    if (e != hipSuccess) fprintf(stderr, "cooperative launch failed: %s (grid %d)\n", hipGetErrorString(e), grid);
#else
    for (int ph = 0; ph < NPHASE; ++ph) {
        if (!((DBG_MASK >> ph) & 1)) continue;
        p.ph_lo = ph; p.ph_hi = ph + 1;
        hipLaunchKernelGGL(mega, dim3(grid), dim3(NTHR_HW), LDS_BYTES, stream, p);
    }
#if DBG_DUMP
    {
        const unsigned char* w = (const unsigned char*)d_ws; const size_t NO = (size_t)NTOK * 1024;
        size_t off = 0, n = 0; bool f32 = false;
        switch (DBG_DUMP) {
            case 1: off = OFF_C + C_ATT; n = (size_t)NTOK * 512; break;
            case 2: off = OFF_C + C_SGU; n = (size_t)NTOK * 256; break;
            case 3: off = OFF_C + C_S5O; n = (size_t)NTOK * 256; break;
            case 4: off = OFF_M; n = (size_t)NTOK * 1024; break;
            case 5: off = OFF_R + R_Q; n = (size_t)NTOK * 512; break;
            case 6: off = OFF_H; n = (size_t)NTOK * 1024; break;
            case 7: off = OFF_C + C_YG; n = (size_t)NTOK * 256; break;
            case 8: off = OFF_C + C_KCMP; n = (size_t)2 * 524288 / 2; break;
            case 9: off = OFF_R + R_KC; n = (size_t)NTOK * 128 * 6; break;
            case 10: off = OFF_R + R_NG; n = (size_t)NTOK * 24; f32 = true; break;
            case 11: off = OFF_R + R_U; n = (size_t)NTOK * 768; break;
            case 12: off = OFF_C + C_S5E; n = (size_t)128 * 16 * 64 * 2; f32 = true; break;
            case 15: off = 0; n = (size_t)NTOK * 1024; f32 = true; break;
            case 16: off = OFF_W + W_S5A; n = 36864; f32 = true; break;
            case 13: off = OFF_YS; n = (size_t)NTOK * 1024; break;
            case 14: off = OFF_MOE + MOE_WS; n = 65536; f32 = true; break;
            default: break;
        }
        if (DBG_DUMP == 15) hipLaunchKernelGGL(dbg_dump_f32, dim3(2048), dim3(256), 0, stream, (const float*)d_out, n, (float*)d_out, NO);
        else if (f32) hipLaunchKernelGGL(dbg_dump_f32, dim3(2048), dim3(256), 0, stream, (const float*)(w + off), n, (float*)d_out, NO);
        else hipLaunchKernelGGL(dbg_dump, dim3(2048), dim3(256), 0, stream, (const bf16_t*)(w + off), n, (float*)d_out, NO);
    }
#endif
#endif
}
```

```cpp
#include <hip/hip_runtime.h>
#include <hip/hip_cooperative_groups.h>
#include <cstdio>
#include <cstdint>
#include <cmath>
#include <type_traits>
namespace cg = cooperative_groups;

#ifndef ONE_LAUNCH
#define ONE_LAUNCH 1
#endif
#ifndef DBG_MASK
#define DBG_MASK 0x1fffff
#endif
#ifndef DBG_NOCOMBINE
#define DBG_NOCOMBINE 0
#endif
#ifndef DBG_DUMP
#define DBG_DUMP 0
#endif
#ifndef DBG_HASH
#define DBG_HASH 0
#endif
#ifndef DBG_ONLYS5
#define DBG_ONLYS5 0
#endif
#ifndef DBG_NOCSTORE
#define DBG_NOCSTORE 0
#endif
#ifndef DBG_LDSCHK
#define DBG_LDSCHK 0
#endif
#ifndef DBG_TWICE
#define DBG_TWICE 0
#endif
#ifndef DBG_S5CONST
#define DBG_S5CONST 0
#endif
#ifndef DBG_SC1READ
#define DBG_SC1READ 0
#endif
#ifndef DBG_E2
#define DBG_E2 0
#endif
#ifndef DBG_JOBFENCE
#define DBG_JOBFENCE 0
#endif
#ifndef DBG_CONSTOUT
#define DBG_CONSTOUT 0
#endif
#ifndef DBG_QDELAY
#define DBG_QDELAY 0
#endif
#ifndef DBG_SMALLK
#define DBG_SMALLK 0
#endif
#ifndef DBG_REPEAT_PH
#define DBG_REPEAT_PH -1
#endif
#ifndef DBG_TIMEPH
#define DBG_TIMEPH -1
#endif
#ifndef DBG_TIMEPH2
#define DBG_TIMEPH2 (DBG_TIMEPH + 1)
#endif
#ifndef DBG_PRESPIN
#define DBG_PRESPIN 0
#endif
#ifndef DBG_SGUSPIN
#define DBG_SGUSPIN 0
#endif
#ifndef DBG_PREFLUSH
#define DBG_PREFLUSH 0
#endif
#ifndef DBG_ESC1
#define DBG_ESC1 0
#endif
#ifndef DBG_DELAY
#define DBG_DELAY 0
#endif
#ifndef DBG_IDROT
#define DBG_IDROT 0
#endif
#ifndef DBG_DUMP_REV
#define DBG_DUMP_REV 0
#endif
#ifndef DBG_SGUCUT
#define DBG_SGUCUT 0
#endif
#ifndef DBG_EFILT
#define DBG_EFILT 0
#define DBG_EFILT_LO 0
#define DBG_EFILT_HI 0
#endif
#ifndef DBG_DUMP_OFF
#define DBG_DUMP_OFF 0
#define DBG_DUMP_N 0
#define DBG_DUMP_F32 0
#endif
#ifndef DBG_PH_HI
#define DBG_PH_HI NPHASE
#endif

typedef unsigned short bf16_t;
typedef short bf16x8 __attribute__((ext_vector_type(8)));
typedef float f32x4 __attribute__((ext_vector_type(4)));
typedef unsigned u32x4 __attribute__((ext_vector_type(4)));
typedef unsigned u32x2 __attribute__((ext_vector_type(2)));

constexpr int DM = 1024, NB = 8, SEQ = 4096, NTOK = NB * SEQ, DEPTH = 2;
constexpr int NCMP = 255;
constexpr float RMS_EPS = 1e-6f;
constexpr int NTHR = 256;
constexpr int NTHR_HW = 512;
constexpr int VB_LDS = 68096;
constexpr int LDS_BAR = 67584;
#ifndef MAX_PER_CU
#define MAX_PER_CU 1
#endif
#ifndef LDS_TOTAL
#define LDS_TOTAL (2 * 68096 + 256 + 16384)
#endif
constexpr int LDS_BYTES = LDS_TOTAL;

constexpr size_t OFF_CTL = 0;
constexpr size_t OFF_W = 65536;
constexpr size_t W_IN = 0, W_GB = 4456448, W_A = 10747904, W_S = 11796480, W_5 = 12320768, W_M = 12845056, W_GLU = 14942208,
                 W_C1 = 15073280, W_C2 = 16121856, W_PB = 16154624, W_SGU = 16155648, W_S5A = 16286720, W_S5A256 = 16294912,
                 W_S5B = 16303104, W_S5C = 16434176, W_RH = 16499712, W_RL = 16630784, W_EG = 16777216, W_EU = 50331648, W_ED = 83886080, W_END = 117440512;
constexpr size_t OFF_H = OFF_W + W_END;
constexpr float GQ_SCALE = 32.f, GQ_INV = 1.f / 32.f;
constexpr size_t OFF_XQ = OFF_H;
constexpr size_t OFF_M = OFF_H + 67108864;
constexpr size_t OFF_R = OFF_M + 67108864;
constexpr size_t R_Q = 0, R_KC = 33554432, R_VC = 41943040, R_KS = 50331648, R_KW = 58720256, R_VST = 67108864, R_VWT = 75497472,
                 R_NG = 83886080, R_U = 87031808, R_V = 103809024, R_S5IN = 120586240, R_QR = 137363456, R_END = 170917888;
constexpr size_t OFF_C = OFF_R + R_END;
constexpr size_t C_ATT = 0, C_SGU = 33554432, C_YG = 50331648, C_S5O = 67108864, C_KCMP = 83886080, C_VCT = 84410368, C_S5E = 84934656, C_END = 85983232;
constexpr size_t OFF_MOE = OFF_C + C_END;
constexpr size_t MOE_LIST = 0, MOE_WS = 4194304, MOE_RS = 4456448, MOE_END = 8650752;
constexpr size_t OFF_ROPE = OFF_MOE + MOE_END;
constexpr size_t OFF_X = OFF_ROPE + (size_t)NTOK * 64;
constexpr size_t OFF_RS1 = OFF_X + (size_t)NTOK * 2048;
constexpr size_t WS_END = OFF_RS1 + (size_t)NTOK * 4;
constexpr size_t OFF_HID = OFF_R;
constexpr size_t OFF_YS = OFF_R + 71303168;
static_assert(OFF_YS + 134217728 <= OFF_C + C_KCMP, "alias overflow");

constexpr int CTL_BAR = 0;
constexpr int CTL_MOECNT = 4096;
constexpr int CTL_ATTN = 4096 + 64;
constexpr int CTL_BYTES = 32768;

struct KP {
    const float* in[36];
    float* xbuf;
    unsigned char* ws;
    float inv_freq[8];
    int ph_lo, ph_hi;
    int never;
    int pad;
};

typedef const KP __attribute__((address_space(4))) CKP;

typedef float f32x2_t __attribute__((ext_vector_type(2)));
typedef __bf16 bf16x2_t __attribute__((ext_vector_type(2)));
__device__ __forceinline__ unsigned pk_bf16(float lo, float hi) {
    const f32x2_t v = {lo, hi};
    union { bf16x2_t b; unsigned u; } x; x.b = __builtin_convertvector(v, bf16x2_t); return x.u;
}
__device__ __forceinline__ bf16_t f2bf(float f) { return (bf16_t)(pk_bf16(f, 0.f) & 0xffffu); }
__device__ __forceinline__ float bf2f(bf16_t b) { return __uint_as_float(((unsigned)b) << 16); }
__device__ __forceinline__ float bflo(unsigned u) { return __uint_as_float(u << 16); }
__device__ __forceinline__ float bfhi(unsigned u) { return __uint_as_float(u & 0xffff0000u); }
__device__ __forceinline__ float fexp2(float x) { return __builtin_amdgcn_exp2f(x); }
__device__ __forceinline__ float gelu_tanh(float x) {
    const float u = 0.7978845608028654f * (x + 0.044715f * x * x * x);
    const float e = fexp2(2.885390081777927f * u);
    const float t = 1.f - 2.f * __builtin_amdgcn_rcpf(e + 1.f);
    return 0.5f * x * (1.f + t);
}
__device__ __forceinline__ float sigm(float x) { return __builtin_amdgcn_rcpf(1.f + fexp2(-1.4426950408889634f * x)); }
__device__ __forceinline__ unsigned char* lds_base();
__device__ __forceinline__ int lane_id() { unsigned z = 0u; asm volatile("" : "+v"(z)); return (int)__builtin_amdgcn_mbcnt_hi(~0u, __builtin_amdgcn_mbcnt_lo(~0u, z)); }
__device__ __forceinline__ int hw_wave_key() { return (int)(__builtin_amdgcn_s_getreg((5 << 11) | 4) & 63u); }
__device__ __forceinline__ int TIDX();
__device__ __forceinline__ unsigned bperm_u(int srclane, unsigned v) { return (unsigned)__builtin_amdgcn_ds_bpermute(srclane << 2, (int)v); }
__device__ __forceinline__ float bperm_f(int srclane, float v) { return __uint_as_float(bperm_u(srclane, __float_as_uint(v))); }
__device__ __forceinline__ int opaque_tid() { int t = TIDX() & 255; asm volatile("" : "+v"(t)); return t; }
__device__ __forceinline__ int VBID() { return (int)blockIdx.x * 2 + (TIDX() >> 8); }
__device__ __forceinline__ int VGRID() { return (int)gridDim.x * 2; }
constexpr int ROPE_LDS = 2 * 68096 + 256;
constexpr int VB_CTR = 2 * 68096;
__device__ __forceinline__ unsigned char* lds_base() { extern __shared__ __attribute__((aligned(16))) unsigned char lds_all_[]; return lds_all_; }
__device__ __forceinline__ int TIDX() { const int wv = __builtin_amdgcn_readfirstlane((int)*(volatile __attribute__((address_space(3))) unsigned char*)((__attribute__((address_space(3))) unsigned char*)lds_base() + VB_CTR + 192 + hw_wave_key())); return wv * 64 + lane_id(); }
__device__ __forceinline__ unsigned char* vb_lds() { int t = TIDX(); asm volatile("" : "+v"(t)); return lds_base() + (t >> 8) * VB_LDS; }
__device__ __forceinline__ void vb_sync(unsigned char* lds) {
    asm volatile("s_waitcnt lgkmcnt(0)" ::: "memory");
    if (lane_id() == 0) {
        __attribute__((address_space(3))) unsigned* c = (__attribute__((address_space(3))) unsigned*)(lds_base() + VB_CTR + ((lds != lds_base()) ? 64 : 0));
        const unsigned old = __hip_atomic_fetch_add(c, 1u, __ATOMIC_RELAXED, __HIP_MEMORY_SCOPE_WORKGROUP);
        const unsigned target = (old & ~3u) + 4u;
        while ((int)(__hip_atomic_load(c, __ATOMIC_RELAXED, __HIP_MEMORY_SCOPE_WORKGROUP) - target) < 0) { }
    }
    asm volatile("" ::: "memory");
}
__device__ __forceinline__ void job_fence() {
#if DBG_JOBFENCE
#endif
}
__device__ __forceinline__ float wave_sum(float v) {
#pragma unroll
    for (int o = 32; o >= 1; o >>= 1) v += __shfl_xor(v, o);
    return v;
}
__device__ __forceinline__ float xmax16(float x) { const unsigned u = __float_as_uint(x); auto r = __builtin_amdgcn_permlane16_swap(u, u, false, false); return fmaxf(__uint_as_float(r[0]), __uint_as_float(r[1])); }
__device__ __forceinline__ float xmax32(float x) { const unsigned u = __float_as_uint(x); auto r = __builtin_amdgcn_permlane32_swap(u, u, false, false); return fmaxf(__uint_as_float(r[0]), __uint_as_float(r[1])); }
__device__ __forceinline__ float xsum16(float x) { const unsigned u = __float_as_uint(x); auto r = __builtin_amdgcn_permlane16_swap(u, u, false, false); return __uint_as_float(r[0]) + __uint_as_float(r[1]); }
__device__ __forceinline__ float xsum32(float x) { const unsigned u = __float_as_uint(x); auto r = __builtin_amdgcn_permlane32_swap(u, u, false, false); return __uint_as_float(r[0]) + __uint_as_float(r[1]); }
__device__ __forceinline__ f32x4 mfma16(bf16x8 a, bf16x8 b, f32x4 c) { return __builtin_amdgcn_mfma_f32_16x16x32_bf16(a, b, c, 0, 0, 0); }
__device__ __forceinline__ bf16x8 as_bf8(u32x4 v) { union { u32x4 u; bf16x8 b; } x; x.u = v; return x.b; }
__device__ __forceinline__ void store16bf(bf16_t* dst, const float (&v)[16]) {
    u32x4 a, b;
    a.x = pk_bf16(v[0], v[1]); a.y = pk_bf16(v[2], v[3]); a.z = pk_bf16(v[4], v[5]); a.w = pk_bf16(v[6], v[7]);
    b.x = pk_bf16(v[8], v[9]); b.y = pk_bf16(v[10], v[11]); b.z = pk_bf16(v[12], v[13]); b.w = pk_bf16(v[14], v[15]);
    *(u32x4*)dst = a; *(u32x4*)(dst + 8) = b;
}

#ifndef XB_SCOPE
#define XB_SCOPE "agent"
#endif
#define XB_TMO      128
#define XB_XCNT(j)  (256  + 64 * (j))
#define XB_XSUB(j)  (1280 + 64 * (j))
#define XB_XGEN(j)  (2304 + 64 * (j))
#define XB_TOP      3328
#define XB_TOPGEN   3392
#define XCD_BAR_WORDS 3456
#define XB_SPIN_CAP (1u << 22)
#define LAS __attribute__((address_space(3)))
__device__ __forceinline__ unsigned xb_ld(unsigned* p)              { return __hip_atomic_load(p, __ATOMIC_RELAXED, __HIP_MEMORY_SCOPE_AGENT); }
__device__ __forceinline__ unsigned xb_add(unsigned* p, unsigned v) { return __hip_atomic_fetch_add(p, v, __ATOMIC_RELAXED, __HIP_MEMORY_SCOPE_AGENT); }
__device__ __forceinline__ unsigned xb_xcc_id() { return (unsigned)__builtin_amdgcn_s_getreg((3 << 11) | 20) & 0xFu; }
#define XB_SPIN(cond, bar) do { unsigned _sp = 0; while (cond) { __builtin_amdgcn_s_sleep(1); \
    if ((++_sp & 255u) == 0u) { if (xb_ld(&(bar)[XB_TMO])) break; if (_sp > XB_SPIN_CAP) { atomicAdd(&(bar)[XB_TMO], 1u); break; } } } } while (0)
struct XcdBarrier { unsigned* bar; unsigned x; volatile LAS unsigned* st; };
__device__ __forceinline__ XcdBarrier xcd_barrier_post(unsigned* bar, volatile LAS unsigned* st) {
    XcdBarrier b; b.bar = bar; b.x = xb_xcc_id(); b.st = st;
    if (TIDX() == 0) { st[0] = 0u; st[1] = 0u; (void)xb_add(&bar[XB_XCNT(b.x)], 1u); }
    return b;
}
__device__ __forceinline__ void xcd_barrier_complete(unsigned* bar, unsigned x, unsigned& nloc, unsigned& nx) {
    const unsigned G = gridDim.x * gridDim.y * gridDim.z;
    unsigned sum, cnt, mine, sp = 0u;
    for (;;) {
        sum = 0u; cnt = 0u; mine = 0u;
#pragma unroll
        for (unsigned j = 0; j < 16; ++j) { const unsigned c = xb_ld(&bar[XB_XCNT(j)]); sum += c; cnt += (c > 0u) ? 1u : 0u; mine = (j == x) ? c : mine; }
        if (sum == G) break;
        __builtin_amdgcn_s_sleep(1);
        if ((++sp & 255u) == 0u) { if (xb_ld(&bar[XB_TMO])) break; if (sp > XB_SPIN_CAP) { atomicAdd(&bar[XB_TMO], 1u); break; } }
    }
    nloc = mine > 0u ? mine : 1u; nx = cnt > 0u ? cnt : 1u;
}
__device__ __forceinline__ void xcd_barrier(XcdBarrier& b) {
    asm volatile("s_waitcnt vmcnt(0)" ::: "memory");
    __syncthreads();
    if (TIDX() == 0) {
        unsigned* bar = b.bar;
        __builtin_amdgcn_s_waitcnt(0);
        unsigned nloc = b.st[0], nx = b.st[1];
        if (nloc == 0u) { xcd_barrier_complete(bar, b.x, nloc, nx); b.st[0] = nloc; b.st[1] = nx; }
        const unsigned old = xb_add(&bar[XB_XSUB(b.x)], 1u);
        const unsigned gen = old / nloc;
        if (old + 1u == (gen + 1u) * nloc) {
            __builtin_amdgcn_fence(__ATOMIC_RELEASE, XB_SCOPE);
            asm volatile("s_waitcnt vmcnt(0)" ::: "memory");
            const unsigned og = xb_add(&bar[XB_TOP], 1u);
            const unsigned tg = og / nx;
            if (og + 1u == (tg + 1u) * nx) xb_add(&bar[XB_TOPGEN], 1u);
            else XB_SPIN(xb_ld(&bar[XB_TOPGEN]) == tg, bar);
            __builtin_amdgcn_fence(__ATOMIC_ACQUIRE, XB_SCOPE);
            xb_add(&bar[XB_XGEN(b.x)], 1u);
            asm volatile("s_waitcnt vmcnt(0)" ::: "memory");
        } else {
            XB_SPIN(xb_ld(&bar[XB_XGEN(b.x)]) == gen, bar);
            __builtin_amdgcn_fence(__ATOMIC_ACQUIRE, XB_SCOPE);
            asm volatile("s_waitcnt vmcnt(0)" ::: "memory");
        }
    }
    __syncthreads();
}

__device__ __forceinline__ void tile_coords(int L, int ntm, int ntn, int& tm, int& tn) {
    const int nt = ntm * ntn, q = nt >> 3, r = nt & 7, xcd = L & 7, off = L >> 3;
    const int id = (xcd < r ? xcd * (q + 1) : r * (q + 1) + (xcd - r) * q) + off;
    const int GM = 8, nig = GM * ntn, gid = id / nig, fm = gid * GM, gsz = (ntm - fm) < GM ? (ntm - fm) : GM;
    tm = fm + ((id % nig) % gsz); tn = (id % nig) / gsz;
}

template <class AP, class BP>
__device__ __forceinline__ void gemm_kloop(f32x4 (&acc)[4][4], AP ap, int a_kstep, BP bp, int b_kstep, int nkt, unsigned char* lds, int tid) {
    const int lane = tid & 63, w = tid >> 6, wm = w >> 1, wn = w & 1, fr = lane & 15, fq = lane >> 4;
    const int lr = lane >> 3, lc = (lane & 7) ^ lr;
    const bf16_t* pa[4]; const bf16_t* pb[4];
#pragma unroll
    for (int i = 0; i < 4; ++i) {
        const int row = 8 * (w + 4 * i) + lr;
        pa[i] = ap(row) + lc * 8;
        const int wn_ = row >> 6, ni_ = (row >> 4) & 3, ii = row & 15;
        pb[i] = bp(64 * wn_ + 16 * (ii >> 2) + 4 * ni_ + (ii & 3)) + lc * 8;
    }
    const int ra = (64 * wm + fr) * 128, rb = (64 * wn + fr) * 128;
    const int sw0 = ((fq) ^ (fr & 7)) << 4, sw1 = ((4 + fq) ^ (fr & 7)) << 4;
    auto issue = [&](int buf) {
#pragma unroll
        for (int i = 0; i < 4; ++i) {
            __builtin_amdgcn_global_load_lds((const unsigned*)pa[i], (unsigned*)(lds + buf * 16384 + (w + 4 * i) * 1024), 16, 0, 0);
            __builtin_amdgcn_global_load_lds((const unsigned*)pb[i], (unsigned*)(lds + 32768 + buf * 16384 + (w + 4 * i) * 1024), 16, 0, 0);
            pa[i] += a_kstep; pb[i] += b_kstep;
        }
    };
    auto compute = [&](int buf) {
        const unsigned char* A = lds + buf * 16384;
        const unsigned char* B = lds + 32768 + buf * 16384;
#pragma unroll
        for (int ks = 0; ks < 2; ++ks) {
            const int sw = ks ? sw1 : sw0;
            bf16x8 af[4], bf[4];
#pragma unroll
            for (int mi = 0; mi < 4; ++mi) af[mi] = *(const bf16x8*)(A + ra + mi * 2048 + sw);
#pragma unroll
            for (int ni = 0; ni < 4; ++ni) bf[ni] = *(const bf16x8*)(B + rb + ni * 2048 + sw);
#pragma unroll
            for (int mi = 0; mi < 4; ++mi)
#pragma unroll
                for (int ni = 0; ni < 4; ++ni) acc[mi][ni] = mfma16(bf[ni], af[mi], acc[mi][ni]);
        }
    };
    vb_sync(lds);
    issue(0);
    asm volatile("s_waitcnt vmcnt(0)" ::: "memory");
    vb_sync(lds);
#pragma unroll 1
    for (int kt = 0; kt < nkt; ++kt) {
        const int cur = kt & 1;
        if (kt + 1 < nkt) issue(cur ^ 1);
        compute(cur);
        asm volatile("s_waitcnt vmcnt(0)" ::: "memory");
        vb_sync(lds);
    }
}
__device__ __forceinline__ void zero_acc(f32x4 (&acc)[4][4]) {
#pragma unroll
    for (int i = 0; i < 4; ++i)
#pragma unroll
        for (int j = 0; j < 4; ++j) acc[i][j] = (f32x4){0.f, 0.f, 0.f, 0.f};
}

constexpr int G8_HTB = 16384;
__device__ __forceinline__ int g8_lds_byte(int r, int c) { const int st = (r >> 4) * 2 + (c >> 5), rr = r & 15, cc = c & 31, ob = rr * 64 + cc * 2; return st * 1024 + (ob ^ (((ob >> 9) & 1) << 5)); }
__device__ __forceinline__ void g8_stage_rc(int b, int& R, int& C) { const int st = b / 1024, sb = b % 1024, swz = sb ^ (((sb >> 9) & 1) << 5); R = (st >> 1) * 16 + swz / 64; C = (st & 1) * 32 + (swz % 64) / 2; }
__device__ __forceinline__ int g8_perm32(int rho) { const int n = rho >> 4, i = rho & 15; return 8 * (i >> 2) + 4 * n + (i & 3); }
struct G8Unit {
    const char* A0; const char* A1; const char* B0; const char* B1;
    unsigned K2;
    int nt;
    int x0, x1, x2, x3, n;
    int f8;
    unsigned ao[2][2];
};
typedef f32x4 G8Acc[2][2][4][2];
typedef int i32x4 __attribute__((ext_vector_type(4)));
typedef int i32x8 __attribute__((ext_vector_type(8)));
template <class Sched, class Epi>
__device__ __forceinline__ void g8_phase(Sched& S, Epi& E) {
    LAS unsigned char* lds = (LAS unsigned char*)lds_base();
    int tid = TIDX(); asm volatile("" : "+v"(tid));
    const int wid = __builtin_amdgcn_readfirstlane(tid >> 6), lane = tid & 63, wr = wid >> 2, wc = wid & 3, fr = lane & 15, fq = lane >> 4;
#define G8_GEOM(R, C2, Rb) int R[2]; unsigned C2[2], Rb[2]; { int _t = TIDX(); asm volatile("" : "+v"(_t)); _Pragma("unroll") for (int _i = 0; _i < 2; ++_i) { int _r, _c; g8_stage_rc(_t * 16 + _i * 8192, _r, _c); \
        R[_i] = _r; C2[_i] = (unsigned)_c * 2u; Rb[_i] = (unsigned)((_r & ~31) + g8_perm32(_r & 31)); } }
    const unsigned ldsw = (unsigned)wid * 1024u;
#define G8_SA(b, h) (((b) * 2 + (h)) * G8_HTB)
#define G8_SB(b, h) ((4 + (b) * 2 + (h)) * G8_HTB)
#define G8_STAGE(bufoff, gbase, voff) do { _Pragma("unroll") for (int _i = 0; _i < 2; ++_i) { unsigned _o = (voff)[_i]; asm volatile("" : "+v"(_o)); \
        __builtin_amdgcn_global_load_lds((const unsigned*)((const char*)(gbase) + _o), (LAS unsigned*)(lds + (bufoff) + ldsw + _i * 8192), 16, 0, 0); } } while (0)
#define G8_BOFF(u, bo) do { _Pragma("unroll") for (int _i = 0; _i < 2; ++_i) bo[_i] = __umul24(Rb_[_i], (u).K2) + C2_[_i]; } while (0)
#define G8_CAT(lo, hi) __builtin_shufflevector((lo), (hi), 0, 1, 2, 3, 4, 5, 6, 7)
#define G8_LO(x) __builtin_bit_cast(bf16x8, __builtin_shufflevector((x), (x), 0, 1, 2, 3))
#define G8_HI(x) __builtin_bit_cast(bf16x8, __builtin_shufflevector((x), (x), 4, 5, 6, 7))
#define G8_LDA(dst, b, h) do { _Pragma("unroll") for (int m = 0; m < 4; ++m) dst[m] = G8_CAT(*(const LAS i32x4*)(lds + G8_SA(b, h) + ra0 + m * 2048), *(const LAS i32x4*)(lds + G8_SA(b, h) + ra1 + m * 2048)); } while (0)
#define G8_LDB(dst, b, h) do { _Pragma("unroll") for (int n = 0; n < 2; ++n) dst[n] = G8_CAT(*(const LAS i32x4*)(lds + G8_SB(b, h) + rb0 + n * 2048), *(const LAS i32x4*)(lds + G8_SB(b, h) + rb1 + n * 2048)); } while (0)
#define G8_MMA(ai, bj, At, Bt) do { __builtin_amdgcn_s_setprio(1); \
        if constexpr (F8) { _Pragma("unroll") for (int m = 0; m < 4; ++m) _Pragma("unroll") for (int n = 0; n < 2; ++n) \
            acc[ai][bj][m][n] = __builtin_amdgcn_mfma_scale_f32_16x16x128_f8f6f4(Bt[n], At[m], acc[ai][bj][m][n], 0, 0, 0, 0, 0, 0); } \
        else { _Pragma("unroll") for (int m = 0; m < 4; ++m) _Pragma("unroll") for (int n = 0; n < 2; ++n) { \
            acc[ai][bj][m][n] = __builtin_amdgcn_mfma_f32_16x16x32_bf16(G8_LO(Bt[n]), G8_LO(At[m]), acc[ai][bj][m][n], 0, 0, 0); \
            acc[ai][bj][m][n] = __builtin_amdgcn_mfma_f32_16x16x32_bf16(G8_HI(Bt[n]), G8_HI(At[m]), acc[ai][bj][m][n], 0, 0, 0); } } \
        __builtin_amdgcn_s_setprio(0); } while (0)
#define G8_WAIT_V(n) asm volatile("s_waitcnt vmcnt(" #n ")" ::: "memory")
#define G8_WAIT_L(n) asm volatile("s_waitcnt lgkmcnt(" #n ")" ::: "memory")
#define G8_BAR __builtin_amdgcn_s_barrier()
#define G8_SCHED __builtin_amdgcn_sched_barrier(0)
    G8Unit cur, nxt; int ui = 0; unsigned cbo[2], nbo[2];
    { G8_GEOM(R_, C2_, Rb_) if (!S.next(0, cur, R_, C2_)) return; G8_BOFF(cur, cbo); }
    G8Acc acc;
#pragma unroll
    for (int a = 0; a < 2; ++a)
#pragma unroll
        for (int b = 0; b < 2; ++b)
#pragma unroll
            for (int m = 0; m < 4; ++m)
#pragma unroll
                for (int n = 0; n < 2; ++n) acc[a][b][m][n] = (f32x4){0.f, 0.f, 0.f, 0.f};
    G8_STAGE(G8_SB(0, 0), cur.B0, cbo); G8_STAGE(G8_SA(0, 0), cur.A0, cur.ao[0]); G8_STAGE(G8_SB(0, 1), cur.B1, cbo); G8_STAGE(G8_SA(0, 1), cur.A1, cur.ao[1]);
    if (wr == 1) G8_BAR;
    G8_WAIT_V(4); G8_BAR;
    G8_STAGE(G8_SB(1, 0), cur.B0 + 128, cbo); G8_STAGE(G8_SA(1, 0), cur.A0 + 128, cur.ao[0]); G8_STAGE(G8_SB(1, 1), cur.B1 + 128, cbo);
    G8_WAIT_V(6); G8_BAR;
    for (;;) {
        bool has_next;
        { G8_GEOM(R_, C2_, Rb_) has_next = S.next(ui + 1, nxt, R_, C2_);
          if (!has_next) nxt = cur;
          G8_BOFF(nxt, nbo); }
        const int nt = cur.nt;
        auto kloop = [&](auto f8c) {
        constexpr bool F8 = decltype(f8c)::value;
        i32x8 At[4], B0[2], B1[2];
        int ra0, ra1, rb0, rb1;
        { int t2 = TIDX(); asm volatile("" : "+v"(t2)); const int w2 = t2 >> 6, fr2 = t2 & 15, fq2 = (t2 >> 4) & 3, ce = fq2 * 8;
          ra0 = g8_lds_byte((w2 >> 2) * 64 + fr2, ce); rb0 = g8_lds_byte((w2 & 3) * 32 + fr2, ce); ra1 = ra0 + 1024; rb1 = rb0 + 1024; }
#pragma unroll 1
        for (int t = 0; t < nt; t += 2) {
            const bool last = (t == nt - 2);
            const size_t k1 = (size_t)(t + 1) * 128, k2 = (size_t)(t + 2) * 128;
            const char* a2h0 = last ? nxt.A0 : cur.A0 + k2; const char* a2h1 = last ? nxt.A1 : cur.A1 + k2;
            const char* b2h0 = last ? nxt.B0 : cur.B0 + k2; const char* b2h1 = last ? nxt.B1 : cur.B1 + k2;
            unsigned ao0[2], ao1[2], bo2[2];
#pragma unroll
            for (int i = 0; i < 2; ++i) { ao0[i] = last ? nxt.ao[0][i] : cur.ao[0][i]; ao1[i] = last ? nxt.ao[1][i] : cur.ao[1][i]; bo2[i] = last ? nbo[i] : cbo[i]; }
            G8_LDB(B0, 0, 0); G8_SCHED; G8_LDA(At, 0, 0); G8_STAGE(G8_SA(1, 1), cur.A1 + k1, cur.ao[1]);
            G8_WAIT_L(8); G8_BAR; G8_WAIT_L(0); G8_MMA(0, 0, At, B0); G8_BAR; G8_SCHED;
            G8_LDB(B1, 0, 1); G8_STAGE(G8_SB(0, 0), b2h0, bo2);
            G8_BAR; G8_WAIT_L(0); G8_MMA(0, 1, At, B1); G8_BAR;
            G8_LDA(At, 0, 1); G8_STAGE(G8_SA(0, 0), a2h0, ao0);
            G8_BAR; G8_WAIT_L(0); G8_MMA(1, 0, At, B0); G8_BAR; G8_SCHED;
            G8_STAGE(G8_SB(0, 1), b2h1, bo2);
            G8_WAIT_V(6); G8_BAR; G8_MMA(1, 1, At, B1); G8_BAR;
            G8_LDB(B0, 1, 0); G8_SCHED; G8_LDA(At, 1, 0); G8_STAGE(G8_SA(0, 1), a2h1, ao1);
            G8_WAIT_L(8); G8_BAR; G8_WAIT_L(0); G8_MMA(0, 0, At, B0); G8_BAR; G8_SCHED;
            G8_LDB(B1, 1, 1); G8_STAGE(G8_SB(1, 0), b2h0 + 128, bo2);
            G8_BAR; G8_WAIT_L(0); G8_MMA(0, 1, At, B1); G8_BAR;
            G8_LDA(At, 1, 1); G8_STAGE(G8_SA(1, 0), a2h0 + 128, ao0);
            G8_BAR; G8_WAIT_L(0); G8_MMA(1, 0, At, B0); G8_BAR; G8_SCHED;
            G8_STAGE(G8_SB(1, 1), b2h1 + 128, bo2);
            G8_WAIT_V(6); G8_BAR; G8_MMA(1, 1, At, B1); G8_BAR;
        }
        };
        if (Sched::HAS_F8 && cur.f8 != 0) kloop(std::true_type{}); else kloop(std::false_type{});
        { int t_ = TIDX(); asm volatile("" : "+v"(t_)); const int w_ = __builtin_amdgcn_readfirstlane(t_ >> 6); E(acc, cur, w_ >> 2, w_ & 3, t_ & 15, (t_ >> 4) & 3); }
        if (!has_next) break;
#pragma unroll
        for (int a = 0; a < 2; ++a)
#pragma unroll
            for (int b = 0; b < 2; ++b)
#pragma unroll
                for (int m = 0; m < 4; ++m)
#pragma unroll
                    for (int n = 0; n < 2; ++n) acc[a][b][m][n] = (f32x4){0.f, 0.f, 0.f, 0.f};
        cur = nxt; ++ui; cbo[0] = nbo[0]; cbo[1] = nbo[1];
    }
    G8_WAIT_V(0);
    if (wr == 0) G8_BAR;
    G8_BAR;
}
struct G8Plain {
    static constexpr bool GATHER = false, HAS_F8 = false;
    const char* A; const char* B; unsigned K2; int nt, nM, nN;
    __device__ __forceinline__ bool next(int i, G8Unit& u, const int (&R)[2], const unsigned (&C2)[2]) const {
        const int L = i * (int)gridDim.x + (int)blockIdx.x; if (L >= nM * nN) return false;
        int pm, pn; tile_coords(L, nM, nN, pm, pn); pm = __builtin_amdgcn_readfirstlane(pm); pn = __builtin_amdgcn_readfirstlane(pn);
        u.A0 = A + (size_t)pm * 256 * K2; u.A1 = u.A0 + (size_t)128 * K2; u.B0 = B + (size_t)pn * 256 * K2; u.B1 = u.B0 + (size_t)128 * K2;
        u.K2 = K2; u.nt = nt; u.x0 = pm; u.x1 = pn; u.x2 = 0; u.x3 = 0;
#pragma unroll
        for (int h = 0; h < 2; ++h)
#pragma unroll
            for (int k = 0; k < 2; ++k) u.ao[h][k] = __umul24((unsigned)R[k], u.K2) + C2[k];
        return true;
    }
};

__device__ __forceinline__ void convert_tiles(CKP& p, int l, int e_lo, int e_hi, int first, int stride, int lane) {
    unsigned char* W = p.ws + OFF_W;
    struct E { const float* src; bf16_t* dst; int R, C, nd, mode, nbatch; };
    const int NE = e_hi;
        for (int L = first;; L += stride) {
            int rem = L; int e = e_lo; E d{};
            for (; e < NE; ++e) {
                switch (e) {
                    case 0: d = {p.in[3] + (size_t)l * 1024 * 5144, (bf16_t*)(W + W_IN), 1024, 5144, 2176, 1, 1}; break;
                    case 1: d = {p.in[3] + (size_t)l * 1024 * 5144, (bf16_t*)(W + W_GB), 1024, 5144, 3072, 2, 1}; break;
                    case 2: d = {p.in[10] + (size_t)l * 512 * 1024, (bf16_t*)(W + W_A), 512, 1024, 1024, 0, 1}; break;
                    case 3: d = {p.in[14] + (size_t)l * 256 * 1024, (bf16_t*)(W + W_S), 256, 1024, 1024, 0, 1}; break;
                    case 4: d = {p.in[25] + (size_t)l * 256 * 1024, (bf16_t*)(W + W_5), 256, 1024, 1024, 0, 1}; break;
                    case 5: d = {p.in[26] + (size_t)l * 1024 * 1024, (bf16_t*)(W + W_M), 1024, 1024, 1024, 0, 1}; break;
                    case 6: d = {p.in[23] + (size_t)l * 256 * 256, (bf16_t*)(W + W_GLU), 256, 256, 256, 0, 1}; break;
                    case 7: d = {p.in[6] + (size_t)l * 2048 * 128, (bf16_t*)(W + W_C1), 2048, 128, 128, 0, 1}; break;
                    case 8: d = {p.in[8] + (size_t)l * 2048 * 128, (bf16_t*)(W + W_C1) + 128 * 2048, 2048, 128, 128, 0, 1}; break;
                    case 9: d = {p.in[7] + (size_t)l * 128 * 64, (bf16_t*)(W + W_C2), 128, 64, 64, 0, 1}; break;
                    case 10: d = {p.in[9] + (size_t)l * 128 * 64, (bf16_t*)(W + W_C2) + 64 * 128, 128, 64, 64, 0, 1}; break;
                    case 11: d = {p.in[32] + (size_t)l * 32 * 1024 * 512, (bf16_t*)(W + W_EG), 1024, 512, 512, 3, 32}; break;
                    case 12: d = {p.in[33] + (size_t)l * 32 * 1024 * 512, (bf16_t*)(W + W_EU), 1024, 512, 512, 3, 32}; break;
                    default: d = {p.in[34] + (size_t)l * 32 * 512 * 1024, (bf16_t*)(W + W_ED), 512, 1024, 1024, 0, 32}; break;
                }
                const int per = (d.R >> 6) * (d.nd >> 6), tot = per * d.nbatch;
                if (rem < tot) break;
                rem -= tot;
            }
            if (e >= NE) break;
            const int per = (d.R >> 6) * (d.nd >> 6), bi = rem / per, t = rem % per, ntn = d.nd >> 6;
            const int k0 = (t / ntn) * 64, n = (t % ntn) * 64 + lane;
            int col = n;
            if (d.mode == 1) col = (n < 1280) ? n : ((n < 2048) ? n + 24 : ((n < 2072) ? n - 768 : -1));
            else if (d.mode == 2) col = n + 2072;
            const float* sp = d.src + (size_t)bi * d.R * d.C + (size_t)k0 * d.C + (col >= 0 ? col : 0);
            float v[64];
#pragma unroll
            for (int i = 0; i < 64; ++i) v[i] = sp[(size_t)i * d.C];
            if (d.mode == 1 || d.mode == 2) {
                const float* g1 = p.in[2] + (size_t)l * 1024 + k0;
#pragma unroll
                for (int i = 0; i < 64; ++i) v[i] *= g1[i];
            }
            if (d.mode == 3) {
                const float* g2 = p.in[27] + (size_t)l * 1024 + k0;
#pragma unroll
                for (int i = 0; i < 64; ++i) v[i] *= g2[i];
            }
            if (col < 0) {
#pragma unroll
                for (int i = 0; i < 64; ++i) v[i] = 0.f;
            }
            if (d.mode == 2) {
                unsigned char* dq = (unsigned char*)d.dst + (size_t)n * d.R + k0;
#pragma unroll
                for (int q = 0; q < 4; ++q) {
                    unsigned wds[4];
#pragma unroll
                    for (int j = 0; j < 4; ++j) {
                        int wd = 0;
                        wd = __builtin_amdgcn_cvt_pk_fp8_f32(v[16 * q + 4 * j] * GQ_SCALE, v[16 * q + 4 * j + 1] * GQ_SCALE, wd, false);
                        wd = __builtin_amdgcn_cvt_pk_fp8_f32(v[16 * q + 4 * j + 2] * GQ_SCALE, v[16 * q + 4 * j + 3] * GQ_SCALE, wd, true);
                        wds[j] = (unsigned)wd;
                    }
                    *(u32x4*)(dq + 16 * q) = (u32x4){wds[0], wds[1], wds[2], wds[3]};
                }
                continue;
            }
            bf16_t* dp = d.dst + (size_t)bi * d.R * d.nd + (size_t)n * d.R + k0;
#pragma unroll
            for (int q = 0; q < 8; ++q) {
                u32x4 o;
                o.x = pk_bf16(v[8 * q], v[8 * q + 1]); o.y = pk_bf16(v[8 * q + 2], v[8 * q + 3]);
                o.z = pk_bf16(v[8 * q + 4], v[8 * q + 5]); o.w = pk_bf16(v[8 * q + 6], v[8 * q + 7]);
                *(u32x4*)(dp + 8 * q) = o;
            }
        }
}

__device__ __forceinline__ void phase_prep(CKP& p, int l, unsigned char* lds) {
    const int tid = opaque_tid(), G = VGRID(), lane = tid & 63, w = tid >> 6;
    unsigned char* W = p.ws + OFF_W;
    if (l < DEPTH) {
        convert_tiles(p, l, 0, 11, VBID() * 4 + w, G * 4, lane);
        const int gt = VBID() * NTHR + tid, gs = G * NTHR;
        if (l == 0) {
            const int* pos = (const int*)p.in[1]; float* rt = (float*)(p.ws + OFF_ROPE);
            for (int i = gt; i < NTOK * 8; i += gs) { float sn, cs; sincosf((float)pos[i >> 3] * p.inv_freq[i & 7], &sn, &cs); rt[(i >> 3) * 16 + (i & 7)] = cs; rt[(i >> 3) * 16 + 8 + (i & 7)] = sn; }
        }
        {
            const float* sw = p.in[12] + (size_t)l * 4 * 128 * 128; bf16_t* o = (bf16_t*)(W + W_SGU);
            for (int i = gt; i < 65536; i += gs) { const int t = (i >> 7) & 127, s = i & 127; o[i] = f2bf(s <= t ? sw[i] : 0.f); }
        }
        {
            const float* are = p.in[15] + l * 1024; const float* aim = p.in[16] + l * 1024; const float* ls = p.in[17] + l * 16;
            const float* bre = p.in[18] + (size_t)l * 16384; const float* bim = p.in[19] + (size_t)l * 16384;
            float* oa = (float*)(W + W_S5A); float* oa2 = (float*)(W + W_S5A256); float* ob = (float*)(W + W_S5B);
            for (int i = gt; i < 1024; i += gs) {
                const int g = i >> 6;
                const float step = expf(ls[g]), ar = are[i], ai = aim[i];
                const float mag = expf(ar * step); float sn, cs; sincosf(ai * step, &sn, &cs);
                const float abr = mag * cs, abi = mag * sn;
                const float den = ar * ar + ai * ai, nr = abr - 1.f, ni = abi;
                const float cr = (nr * ar + ni * ai) / den, ci = (ni * ar - nr * ai) / den;
                oa[i * 2] = abr; oa[i * 2 + 1] = abi;
                float pr = abr, pi = abi;
                for (int s = 0; s < 8; ++s) { const float nr2 = pr * pr - pi * pi, ni2 = 2.f * pr * pi; pr = nr2; pi = ni2; }
                oa2[i * 2] = pr; oa2[i * 2 + 1] = pi;
                for (int h = 0; h < 16; ++h) {
                    const float br = bre[i * 16 + h], bi_ = bim[i * 16 + h];
                    ob[i * 32 + h] = cr * br - ci * bi_;
                    ob[i * 32 + 16 + h] = cr * bi_ + ci * br;
                }
            }
            const float* cre = p.in[20] + (size_t)l * 16384; const float* cim = p.in[21] + (size_t)l * 16384; bf16_t* oc = (bf16_t*)(W + W_S5C);
            for (int i = gt; i < 32768; i += gs) {
                const int k = i & 127, gh = i >> 7;
                oc[i] = f2bf(k < 64 ? cre[gh * 64 + k] : -cim[gh * 64 + (k - 64)]);
            }
        }
        {
            const float* wg = p.in[28] + (size_t)l * 1024 * 4; const float* we = p.in[30] + (size_t)l * 1024 * 32;
            bf16_t* oh = (bf16_t*)(W + W_RH); bf16_t* ol = (bf16_t*)(W + W_RL);
            for (int i = gt; i < 65536; i += gs) {
                const int n = i >> 10, k = i & 1023;
                const float v = ((n < 4) ? wg[k * 4 + n] : ((n < 36) ? we[k * 32 + (n - 4)] : 0.f)) * p.in[27][(size_t)l * 1024 + k];
                const bf16_t h = f2bf(v);
                oh[i] = h; ol[i] = f2bf(v - bf2f(h));
            }
        }
        {
            float* pb = (float*)(W + W_PB);
            for (int j = VBID() * 4 + w; j < 256; j += G * 4) {
                const int kv = j >> 7, n = j & 127;
                const float* pos = p.in[kv ? 5 : 4] + (size_t)l * 2048; const float* w1 = p.in[kv ? 8 : 6] + (size_t)l * 2048 * 128;
                float s = 0.f;
                for (int k = lane; k < 2048; k += 64) s += pos[k] * w1[(size_t)k * 128 + n];
                s = wave_sum(s);
                if (lane == 0) pb[j] = s;
            }
        }
    }
    {
        const float* gam = (l < DEPTH) ? (p.in[2] + (size_t)l * 1024) : p.in[35];
        bf16_t* hb = (bf16_t*)(p.ws + OFF_H);
        const bf16_t* ys = (const bf16_t*)(p.ws + OFF_YS);
        bf16_t* xres = (bf16_t*)(p.ws + OFF_X);
        f32x4 gv[4];
#pragma unroll
        for (int i = 0; i < 4; ++i) gv[i] = *(const f32x4*)(gam + 4 * lane + 256 * i);
        for (int row = VBID() * 4 + w; row < NTOK; row += G * 4) {
            f32x4 xv[4]; float ss = 0.f;
#pragma unroll
            for (int i = 0; i < 4; ++i) {
                const int col = 4 * lane + 256 * i;
                if (l == 0) xv[i] = *(const f32x4*)(p.in[0] + (size_t)row * 1024 + col);
                else {
                    { const u32x2 xx = *(const u32x2*)(xres + (size_t)row * 1024 + col); xv[i] = (f32x4){bflo(xx.x), bfhi(xx.x), bflo(xx.y), bfhi(xx.y)}; }
                    const u32x2 y0 = *(const u32x2*)(ys + (size_t)(2 * row) * 1024 + col), y1 = *(const u32x2*)(ys + (size_t)(2 * row + 1) * 1024 + col);
                    xv[i][0] += bflo(y0.x) + bflo(y1.x); xv[i][1] += bfhi(y0.x) + bfhi(y1.x);
                    xv[i][2] += bflo(y0.y) + bflo(y1.y); xv[i][3] += bfhi(y0.y) + bfhi(y1.y);
                }
                ss += xv[i][0] * xv[i][0] + xv[i][1] * xv[i][1] + xv[i][2] * xv[i][2] + xv[i][3] * xv[i][3];
            }
            ss = wave_sum(ss);
            const float rstd = rsqrtf(ss * (1.f / 1024.f) + RMS_EPS);
#pragma unroll
            for (int i = 0; i < 4; ++i) {
                const int col = 4 * lane + 256 * i;
                f32x4 hn = xv[i] * rstd * gv[i];
                if (l < DEPTH) {
                    { u32x2 xo; xo.x = pk_bf16(xv[i][0], xv[i][1]); xo.y = pk_bf16(xv[i][2], xv[i][3]); *(u32x2*)(xres + (size_t)row * 1024 + col) = xo; }
                    if (i == 0 && lane == 0) ((float*)(p.ws + OFF_RS1))[row] = rstd;
                    { int wd = 0; wd = __builtin_amdgcn_cvt_pk_fp8_f32(xv[i][0] * rstd, xv[i][1] * rstd, wd, false); wd = __builtin_amdgcn_cvt_pk_fp8_f32(xv[i][2] * rstd, xv[i][3] * rstd, wd, true);
                      *(unsigned*)(p.ws + OFF_XQ + (size_t)row * 1024 + col) = (unsigned)wd; }
                } else {
#if DBG_TIMEPH >= 0
                    { const unsigned long long* ts = (const unsigned long long*)(p.ws + OFF_CTL + 24576);
                      const float dt_us = (float)(ts[DBG_TIMEPH2] - ts[DBG_TIMEPH]) * 0.01f; hn = hn * (1.f + 1e-3f * dt_us); }
#endif
                    *(f32x4*)(p.xbuf + (size_t)row * 1024 + col) = hn;
                }
            }
        }
    }
}

struct EpiInproj {
    unsigned char* Rb_; const float* rope; const float* rs1;
    __device__ __forceinline__ void operator()(const G8Acc& acc, const G8Unit& u, int wr, int wc, int fr, int fq) const {
        unsigned char* R = Rb_;
        if (u.x1 < 2 || u.x1 == 3 || u.x1 == 4) {
            int t = TIDX(); asm volatile("" : "+v"(t));
            const char* src = (const char*)rope + (size_t)u.x0 * 16384 + t * 16;
            unsigned char* lb = lds_base() + ROPE_LDS + (t >> 6) * 1024;
#pragma unroll
            for (int j = 0; j < 2; ++j) __builtin_amdgcn_global_load_lds((const unsigned*)(src + j * 8192), (unsigned*)(lb + j * 8192), 16, 0, 0);
            asm volatile("s_waitcnt vmcnt(0)" ::: "memory");
            __syncthreads();
        }
        const LAS float* ropel = (const LAS float*)(lds_base() + ROPE_LDS);
        float rsv[2][4];
#pragma unroll
        for (int ai = 0; ai < 2; ++ai)
#pragma unroll
            for (int m = 0; m < 4; ++m) rsv[ai][m] = rs1[u.x0 * 256 + ai * 128 + wr * 64 + m * 16 + fr];
#pragma unroll
        for (int bj = 0; bj < 2; ++bj) {
            const int tn = u.x1 * 2 + bj;
            const int cl = 32 * wc + 8 * fq;
            const bool roped = (tn < 4) || tn == 6 || tn == 8;
#pragma unroll
            for (int ai = 0; ai < 2; ++ai) {
#pragma unroll
              for (int mh = 0; mh < 2; ++mh) {
                f32x4 rc0[4], rc1[4], rs0[4], rs1_[4];
                if (roped && !(wc & 1) && fq < 2) {
#pragma unroll
                    for (int m = 2 * mh; m < 2 * mh + 2; ++m) {
                        const LAS float* rt = ropel + (ai * 128 + wr * 64 + m * 16 + fr) * 16;
                        rc0[m] = *(const LAS f32x4*)rt; rc1[m] = *(const LAS f32x4*)(rt + 4); rs0[m] = *(const LAS f32x4*)(rt + 8); rs1_[m] = *(const LAS f32x4*)(rt + 12);
                    }
                }
#pragma unroll
                for (int m = 2 * mh; m < 2 * mh + 2; ++m) {
                    const int row = u.x0 * 256 + ai * 128 + wr * 64 + m * 16 + fr;
                    float v[8];
#pragma unroll
                    for (int e = 0; e < 8; ++e) v[e] = acc[ai][bj][m][e >> 2][e & 3] * rsv[ai][m];
                    if (tn < 4) { u32x4 o; o.x = pk_bf16(v[0], v[1]); o.y = pk_bf16(v[2], v[3]); o.z = pk_bf16(v[4], v[5]); o.w = pk_bf16(v[6], v[7]);
                                  *(u32x4*)((bf16_t*)(R + R_Q) + (size_t)row * 512 + tn * 128 + cl) = o; }
                    if (roped && !(wc & 1)) {
                        float xo[8];
#pragma unroll
                        for (int i = 0; i < 8; ++i) xo[i] = __shfl_xor(v[i], 16);
                        if (fq < 2) {
                            const f32x4 c0 = rc0[m], c1 = rc1[m], s0 = rs0[m], s1 = rs1_[m];
#pragma unroll
                            for (int i = 0; i < 8; ++i) {
                                const float cs = i < 4 ? c0[i & 3] : c1[i & 3], sn = i < 4 ? s0[i & 3] : s1[i & 3];
                                v[i] = fq == 0 ? (v[i] * cs - xo[i] * sn) : (v[i] * cs + xo[i] * sn);
                            }
                        }
                    }
                    u32x4 o; o.x = pk_bf16(v[0], v[1]); o.y = pk_bf16(v[2], v[3]); o.z = pk_bf16(v[4], v[5]); o.w = pk_bf16(v[6], v[7]);
                    if (tn < 4) *(u32x4*)((bf16_t*)(R + R_QR) + (size_t)row * 512 + tn * 128 + cl) = o;
                    else if (tn == 7 || tn == 9) {
                        bf16_t* dst = (bf16_t*)(R + (tn == 7 ? R_VST : R_VWT));
                        const int b = row >> 12, s_ = row & 4095, g = wc >> 1, d0 = 32 * (wc & 1) + 8 * fq;
#pragma unroll
                        for (int e = 0; e < 8; ++e) dst[((size_t)((b * 2 + g) * 64 + d0 + e)) * SEQ + s_] = f2bf(v[e]);
                    } else if (tn < 10) {
                        const size_t off = (tn == 4) ? R_KC : (tn == 5) ? R_VC : (tn == 6) ? R_KS : R_KW;
                        *(u32x4*)((bf16_t*)(R + off) + (size_t)row * 128 + cl) = o;
                    } else if (tn < 14) {
#pragma unroll
                        for (int e = 0; e < 8; ++e) v[e] = gelu_tanh(v[e]);
                        u32x4 og; og.x = pk_bf16(v[0], v[1]); og.y = pk_bf16(v[2], v[3]); og.z = pk_bf16(v[4], v[5]); og.w = pk_bf16(v[6], v[7]);
                        const int c512 = (tn - 10) * 128 + cl;
                        if (c512 < 256) *(u32x4*)((bf16_t*)(R + R_U) + (size_t)row * 256 + c512) = og;
                        else *(u32x4*)((bf16_t*)(R + R_V) + (size_t)row * 256 + (c512 - 256)) = og;
                    } else {
                        *(u32x4*)((bf16_t*)(R + R_S5IN) + (size_t)row * 256 + (tn - 14) * 128 + cl) = o;
                    }
                }
              }
            }
        }
    }
};
__device__ __forceinline__ void phase_inproj(CKP& p, int l, unsigned char* lds) {
    {
        G8Plain S{(const char*)(p.ws + OFF_X), (const char*)(p.ws + OFF_W + W_IN), 2048u, 16, NTOK / 256, 8};
        EpiInproj E{p.ws + OFF_R, (const float*)(p.ws + OFF_ROPE), (const float*)(p.ws + OFF_RS1)};
        g8_phase(S, E);
    }
    const int tid = opaque_tid(), lane = tid & 63, w = tid >> 6, wm = w >> 1, wn = w & 1, fr = lane & 15, fq = lane >> 4;
    const int half = TIDX() >> 8;
    const bf16_t* A = (const bf16_t*)(p.ws + OFF_X);
    const float* rs1 = (const float*)(p.ws + OFF_RS1);
    const bf16_t* Bt = (const bf16_t*)(p.ws + OFF_W + W_IN) + (size_t)2048 * 1024;
    unsigned char* R = p.ws + OFF_R;
    float* xch = (float*)(lds_base() + VB_LDS);
    for (int tm = blockIdx.x; tm < NTOK / 128; tm += gridDim.x) {
        const int m0 = tm * 128;
        f32x4 acc[4][4]; zero_acc(acc);
        gemm_kloop(acc, [&](int r) { return A + (size_t)(m0 + r) * 1024 + half * 512; }, 64, [&](int v) { return Bt + (size_t)v * 1024 + half * 512; }, 64, 8, lds, tid);
        __syncthreads();
        if (half == 1 && wn == 0 && fq < 2) {
#pragma unroll
            for (int mi = 0; mi < 4; ++mi) {
                const int r = 64 * wm + 16 * mi + fr;
#pragma unroll
                for (int ni = 0; ni < 4; ++ni) *(f32x4*)(xch + r * 32 + 16 * fq + 4 * ni) = acc[mi][ni];
            }
        }
        __syncthreads();
        if (half == 0 && wn == 0 && fq < 2) {
#pragma unroll
            for (int mi = 0; mi < 4; ++mi) {
                const int r = 64 * wm + 16 * mi + fr;
                float* ng = (float*)(R + R_NG) + (size_t)(m0 + r) * 24 + 16 * fq;
#pragma unroll
                for (int ni = 0; ni < 4; ++ni) {
                    const f32x4 o = *(const f32x4*)(xch + r * 32 + 16 * fq + 4 * ni);
#pragma unroll
                    for (int j = 0; j < 4; ++j) if (16 * fq + 4 * ni + j < 24) ng[4 * ni + j] = sigm((acc[mi][ni][j] + o[j]) * rs1[m0 + r]);
                }
            }
        }
        __syncthreads();
    }
}

__device__ __forceinline__ void compress_tile(CKP& p, int job, unsigned char* lds) {
    job_fence();
    const int tid = opaque_tid(), lane = tid & 63, w = tid >> 6, wm = w >> 1, wn = w & 1, fr = lane & 15, fq = lane >> 4;
    const int kv = job >> 5, tm = job & 31, m0 = tm * 128;
    unsigned char* W = p.ws + OFF_W;
    const bf16_t* src = (const bf16_t*)(p.ws + OFF_R + (kv ? R_VC : R_KC));
    const bf16_t* W1 = (const bf16_t*)(W + W_C1) + (size_t)kv * 128 * 2048;
    const bf16_t* W2 = (const bf16_t*)(W + W_C2) + (size_t)kv * 64 * 128;
    const float* pb = (const float*)(W + W_PB) + kv * 128;
    f32x4 acc[4][4]; zero_acc(acc);
    int t512 = TIDX(); asm volatile("" : "+v"(t512));
    const int half = t512 >> 8;
    gemm_kloop(acc, [&](int r) { int Rr = m0 + r; Rr = Rr < 4080 ? Rr : 4079; const int b = Rr / 510, rem = Rr % 510, c = rem >> 1, g = rem & 1;
                                 return src + ((size_t)(b * SEQ + 16 * c + 16 * half)) * 128 + g * 64; }, 128,
               [&](int v) { return W1 + (size_t)v * 2048 + half * 1024; }, 64, 16, lds, tid);
    {
        float* xch = (float*)(lds_base() + VB_LDS);
        __syncthreads();
        if (half == 1) {
#pragma unroll
            for (int mi = 0; mi < 4; ++mi)
#pragma unroll
                for (int ni = 0; ni < 4; ++ni) *(f32x4*)(xch + ((mi * 4 + ni) * 256 + tid) * 4) = acc[mi][ni];
        }
        __syncthreads();
        if (half == 0) {
#pragma unroll
            for (int mi = 0; mi < 4; ++mi)
#pragma unroll
                for (int ni = 0; ni < 4; ++ni) acc[mi][ni] += *(const f32x4*)(xch + ((mi * 4 + ni) * 256 + tid) * 4);
        }
        __syncthreads();
        if (half == 1) return;
    }
#pragma unroll
    for (int mi = 0; mi < 4; ++mi) {
        const int row = 64 * wm + 16 * mi + fr; const int cb = 16 * fq;
        float v[16];
#pragma unroll
        for (int e = 0; e < 16; ++e) v[e] = gelu_tanh(acc[mi][e >> 2][e & 3] + pb[64 * wn + cb + e]);
        u32x4 a, b;
        a.x = pk_bf16(v[0], v[1]); a.y = pk_bf16(v[2], v[3]); a.z = pk_bf16(v[4], v[5]); a.w = pk_bf16(v[6], v[7]);
        b.x = pk_bf16(v[8], v[9]); b.y = pk_bf16(v[10], v[11]); b.z = pk_bf16(v[12], v[13]); b.w = pk_bf16(v[14], v[15]);
        *(u32x4*)(lds + wn * 16384 + row * 128 + (((2 * fq) ^ (row & 7)) << 4)) = a;
        *(u32x4*)(lds + wn * 16384 + row * 128 + (((2 * fq + 1) ^ (row & 7)) << 4)) = b;
    }
#pragma unroll
    for (int j = 0; j < 4; ++j) {
        const int pid = tid + 256 * j, row = pid >> 4, ch = pid & 15;
        const u32x4 v = *(const u32x4*)(W2 + row * 128 + ch * 8);
        *(u32x4*)(lds + 32768 + (ch >> 3) * 16384 + row * 128 + (((ch & 7) ^ (row & 7)) << 4)) = v;
    }
    vb_sync(lds);
    f32x4 a2[4][2];
#pragma unroll
    for (int i = 0; i < 4; ++i) { a2[i][0] = (f32x4){0.f, 0.f, 0.f, 0.f}; a2[i][1] = (f32x4){0.f, 0.f, 0.f, 0.f}; }
#pragma unroll
    for (int kt2 = 0; kt2 < 2; ++kt2)
#pragma unroll
        for (int ks = 0; ks < 2; ++ks) {
            bf16x8 af[4], bf[2];
#pragma unroll
            for (int mi = 0; mi < 4; ++mi) { const int row = 64 * wm + 16 * mi + fr; af[mi] = *(const bf16x8*)(lds + kt2 * 16384 + row * 128 + (((4 * ks + fq) ^ (row & 7)) << 4)); }
#pragma unroll
            for (int ni = 0; ni < 2; ++ni) { const int row = 32 * wn + 8 * (fr >> 2) + 4 * ni + (fr & 3); bf[ni] = *(const bf16x8*)(lds + 32768 + kt2 * 16384 + row * 128 + (((4 * ks + fq) ^ (row & 7)) << 4)); }
#pragma unroll
            for (int mi = 0; mi < 4; ++mi)
#pragma unroll
                for (int ni = 0; ni < 2; ++ni) a2[mi][ni] = mfma16(bf[ni], af[mi], a2[mi][ni]);
        }
    bf16_t* kcmp = (bf16_t*)(p.ws + OFF_C + C_KCMP);
    bf16_t* vct = (bf16_t*)(p.ws + OFF_C + C_VCT);
#pragma unroll
    for (int mi = 0; mi < 4; ++mi) {
        const int Rr = m0 + 64 * wm + 16 * mi + fr;
        if (Rr < 4080) {
            const int b = Rr / 510, rem = Rr % 510, c = rem >> 1, g = rem & 1, d0 = 32 * wn + 8 * fq;
            float v[8];
#pragma unroll
            for (int e = 0; e < 8; ++e) v[e] = a2[mi][e >> 2][e & 3];
            if (DBG_NOCSTORE) { if (v[0] == 123.456f) kcmp[0] = 1; }
            else if (kv == 0) {
                u32x4 o; o.x = pk_bf16(v[0], v[1]); o.y = pk_bf16(v[2], v[3]); o.z = pk_bf16(v[4], v[5]); o.w = pk_bf16(v[6], v[7]);
                *(u32x4*)(kcmp + ((size_t)(b * 256 + c)) * 128 + g * 64 + d0) = o;
                if (c == 254) *(u32x4*)(kcmp + ((size_t)(b * 256 + 255)) * 128 + g * 64 + d0) = (u32x4){0u, 0u, 0u, 0u};
            } else {
#pragma unroll
                for (int e = 0; e < 8; ++e) {
                    vct[((size_t)((b * 2 + g) * 64 + d0 + e)) * 256 + c] = f2bf(v[e]);
                    if (c == 254) vct[((size_t)((b * 2 + g) * 64 + d0 + e)) * 256 + 255] = 0;
                }
            }
        }
    }
    vb_sync(lds);
}

__device__ __forceinline__ void sgu_job(CKP& p, int l, int job, unsigned char* lds) {
    job_fence();
    const int tid = opaque_tid(), lane = tid & 63, w = tid >> 6, fr = lane & 15, fq = lane >> 4;
    const size_t tok0 = (size_t)job * 128;
    const bf16_t* V = (const bf16_t*)(p.ws + OFF_R + R_V) + tok0 * 256;
    const bf16_t* U = (const bf16_t*)(p.ws + OFF_R + R_U) + tok0 * 256;
    bf16_t* O = (bf16_t*)(p.ws + OFF_C + C_SGU) + tok0 * 256;
    const bf16_t* Wt = (const bf16_t*)(p.ws + OFF_W + W_SGU);
    const float* ng = p.in[11] + (size_t)l * 256;
    const float* bs = p.in[13] + (size_t)l * 512;
    vb_sync(lds);
    if (DBG_SGUCUT != 2) {
        const int s = tid >> 1, half = tid & 1;
        const bf16_t* src = V + (size_t)s * 256 + half * 128;
        float ss = 0.f;
#pragma unroll 4
        for (int j = 0; j < 16; ++j) {
            const u32x4 bb = *(const u32x4*)(src + j * 8);
            const unsigned uu[4] = {bb.x, bb.y, bb.z, bb.w};
#pragma unroll
            for (int q = 0; q < 4; ++q) { const float a = bflo(uu[q]), b2 = bfhi(uu[q]); ss += a * a + b2 * b2; }
        }
        ss += __shfl_xor(ss, 1);
        const float rstd = rsqrtf(ss * (1.f / 256.f) + RMS_EPS);
#pragma unroll 1
        for (int j = 0; j < 16; ++j) {
            const u32x4 bb = *(const u32x4*)(src + j * 8);
            const unsigned uu[4] = {bb.x, bb.y, bb.z, bb.w};
            const int cb = half * 128 + j * 8;
#pragma unroll
            for (int q = 0; q < 4; ++q) {
#pragma unroll
                for (int hh = 0; hh < 2; ++hh) {
                    const int c = cb + q * 2 + hh;
                    const float val = (hh ? bfhi(uu[q]) : bflo(uu[q])) * rstd * ng[c];
                    *(bf16_t*)(lds + c * 256 + ((((s >> 3) ^ (c & 15))) << 4) + (s & 7) * 2) = f2bf(val);
                }
            }
        }
    }
    vb_sync(lds);
    const int g = w;
#pragma unroll 1
    for (int th = 0; th < (DBG_SGUCUT == 1 ? 0 : 2); ++th) {
        f32x4 acc[4][4];
        zero_acc(acc);
#pragma unroll
        for (int ks = 0; ks < 4; ++ks) {
            if (32 * ks <= 64 * th + 63) {
                bf16x8 vf[4];
#pragma unroll
                for (int di = 0; di < 4; ++di) { const int c = 64 * g + 16 * di + fr; vf[di] = *(const bf16x8*)(lds + c * 256 + (((4 * ks + fq) ^ (c & 15)) << 4)); }
#pragma unroll
                for (int ti = 0; ti < 4; ++ti) {
                    const int t = 64 * th + 16 * ti + fr;
                    if (32 * ks <= 64 * th + 16 * ti + 15) {
                        const bf16x8 wf = *(const bf16x8*)(Wt + ((size_t)(g * 128 + t)) * 128 + 32 * ks + 8 * fq);
#pragma unroll
                        for (int di = 0; di < 4; ++di) acc[ti][di] = mfma16(vf[di], wf, acc[ti][di]);
                    }
                }
            }
        }
#pragma unroll
        for (int ti = 0; ti < 4; ++ti) {
            const int t = 64 * th + 16 * ti + fr; const float bb = bs[g * 128 + t];
#pragma unroll
            for (int di = 0; di < 4; ++di) {
                const int c = 64 * g + 16 * di + 4 * fq;
                const u32x2 uu = *(const u32x2*)(U + (size_t)t * 256 + c);
                u32x2 o;
                o.x = pk_bf16(bflo(uu.x) * (acc[ti][di][0] + bb), bfhi(uu.x) * (acc[ti][di][1] + bb));
                o.y = pk_bf16(bflo(uu.y) * (acc[ti][di][2] + bb), bfhi(uu.y) * (acc[ti][di][3] + bb));
                *(u32x2*)(O + (size_t)t * 256 + c) = o;
            }
        }
    }
    vb_sync(lds);
}

__device__ __forceinline__ void s5_job(CKP& p, int l, int jb, int pass, unsigned char* lds, int idov = -1) {
    job_fence();
    const int tid = opaque_tid(), lane = tid & 63, w = tid >> 6, fr = lane & 15, fq = lane >> 4;
    const int id = (idov >= 0) ? idov : (((jb * 4 + w) + DBG_IDROT) & 2047), seq = id >> 4, ch = id & 15, b = seq >> 4, g = seq & 15;
    unsigned char* W = p.ws + OFF_W;
    const float* ab = (const float*)(W + W_S5A) + (g * 64 + lane) * 2;
    float ar = ab[0], ai = ab[1];
    float br[16], bi[16];
    {
        const float* bb = (const float*)(W + W_S5B) + (size_t)(g * 64 + lane) * 32;
#pragma unroll
        for (int h = 0; h < 16; ++h) { br[h] = bb[h]; bi[h] = bb[16 + h]; }
    }
#if DBG_S5CONST >= 2
    { const float q = (float)(lane + 1) * 0.001f; ar = 0.99f - q; ai = 0.05f + q;
      for (int h = 0; h < 16; ++h) { br[h] = 0.01f * (float)(h + 1) + q; bi[h] = -0.02f * (float)(h + 1) + q; } }
#endif
    unsigned brp[8], bip[8];
#pragma unroll
    for (int k = 0; k < 8; ++k) { brp[k] = pk_bf16(br[2 * k], br[2 * k + 1]); bip[k] = pk_bf16(bi[2 * k], bi[2 * k + 1]); }
    float* Eb = (float*)(p.ws + OFF_C + C_S5E);
    float hre = 0.f, him = 0.f;
    bf16x8 cf[4]; float dv[4];
    if (pass == 2) {
        const float* a2 = (const float*)(W + W_S5A256) + (g * 64 + lane) * 2;
        const float a2r = a2[0], a2i = a2[1];
        float er[15], ei[15];
#pragma unroll
        for (int c2 = 0; c2 < 15; ++c2) if (c2 < ch) { const float* e = Eb + ((size_t)(seq * 16 + c2) * 64 + lane) * 2; er[c2] = e[0]; ei[c2] = e[1]; }
#pragma unroll
        for (int c2 = 0; c2 < 15; ++c2) if (c2 < ch) {
            const float nr = a2r * hre - a2i * him + er[c2], ni = a2r * him + a2i * hre + ei[c2];
            hre = nr; him = ni;
        }
        const bf16_t* cm = (const bf16_t*)(W + W_S5C) + (size_t)(g * 16 + fr) * 128;
#pragma unroll
        for (int ks = 0; ks < 4; ++ks) cf[ks] = *(const bf16x8*)(cm + 32 * ks + 8 * fq);
#pragma unroll
        for (int r = 0; r < 4; ++r) dv[r] = p.in[22][(size_t)l * 256 + g * 16 + 4 * fq + r];
    }
    const bf16_t* xin = (const bf16_t*)(p.ws + OFF_R + R_S5IN) + ((size_t)(b * SEQ + ch * 256)) * 256 + g * 16;
    bf16_t* yg = (bf16_t*)(p.ws + OFF_C + C_YG) + ((size_t)(b * SEQ + ch * 256)) * 256 + g * 16;
    float* xs = (float*)(lds + w * 10240);
    int ldsbad = 0; (void)ldsbad;
    unsigned char* Hs = lds + w * 10240 + 2048;
#if DBG_TWICE
    float keep_re = 0.f, keep_im = 0.f;
#pragma unroll 1
    for (int rep = 0; rep < 2; ++rep) {
    if (rep == 1) { keep_re = hre; keep_im = him; hre = 0.f; him = 0.f; }
#endif
    u32x4 xnext = *(const u32x4*)(xin + (size_t)(lane >> 1) * 256 + (lane & 1) * 8);
#pragma unroll 1
    for (int sub = 0; sub < 8; ++sub) {
#if DBG_S5CONST >= 1
        u32x4 xv; { const unsigned q = (unsigned)(sub * 32 + (lane >> 1)) * 2654435761u + (unsigned)id * 40503u + (lane & 1); xv.x = 0x3f803e80u ^ ((q & 0xff) << 16); xv.y = 0x3e003d00u ^ ((q >> 8) & 0x7f); xv.z = 0xbe803f00u ^ ((q >> 16) & 0x3f); xv.w = 0x3d80be00u; }
#else
        const u32x4 xv = xnext;
        if (sub + 1 < 8) xnext = *(const u32x4*)(xin + (size_t)((sub + 1) * 32 + (lane >> 1)) * 256 + (lane & 1) * 8);
#endif
        vb_sync(lds);
        *(u32x4*)((unsigned char*)xs + (lane >> 1) * 32 + (lane & 1) * 16) = xv;
        vb_sync(lds);
#pragma unroll 16
        for (int st = 0; st < 32; ++st) {
#if DBG_S5CONST == 3
            f32x4 x0, x1, x2, x3;
            { const float t = (float)((sub * 32 + st) & 63) * 0.015625f + (float)(id & 7) * 0.125f;
              x0 = (f32x4){t, t * 0.5f, -t, 0.25f}; x1 = (f32x4){0.5f - t, t * t, 0.125f, t}; x2 = (f32x4){-0.25f, t, 0.75f * t, 1.f - t}; x3 = (f32x4){t, -t, 0.5f, 0.3f * t}; }
#else
            const u32x4 xa = *(const u32x4*)((const unsigned char*)xs + st * 32), xb = *(const u32x4*)((const unsigned char*)xs + st * 32 + 16);
#endif
            const unsigned xp[8] = {xa.x, xa.y, xa.z, xa.w, xb.x, xb.y, xb.z, xb.w};
            float ur = 0.f, ui = 0.f;
#pragma unroll
            for (int k = 0; k < 8; ++k) {
                ur = __builtin_amdgcn_fdot2_f32_bf16(__builtin_bit_cast(bf16x2_t, brp[k]), __builtin_bit_cast(bf16x2_t, xp[k]), ur, false);
                ui = __builtin_amdgcn_fdot2_f32_bf16(__builtin_bit_cast(bf16x2_t, bip[k]), __builtin_bit_cast(bf16x2_t, xp[k]), ui, false);
            }
            const float nr = ar * hre - ai * him + ur, ni = ar * him + ai * hre + ui;
            hre = nr; him = ni;
            if (pass == 2) {
                *(bf16_t*)(Hs + st * 256 + (((lane >> 3) ^ (st & 15)) << 4) + (lane & 7) * 2) = f2bf(hre);
                *(bf16_t*)(Hs + st * 256 + ((((64 + lane) >> 3) ^ (st & 15)) << 4) + (lane & 7) * 2) = f2bf(him);
            }
        }
#if DBG_LDSCHK
        {
            const f32x4 ra = *(volatile f32x4*)(xs + (lane >> 1) * 16 + (lane & 1) * 8), rc = *(volatile f32x4*)(xs + (lane >> 1) * 16 + (lane & 1) * 8 + 4);
            bool bad = false;
            for (int q = 0; q < 4; ++q) bad |= (__float_as_uint(ra[q]) != __float_as_uint(chk_a[q])) | (__float_as_uint(rc[q]) != __float_as_uint(chk_c[q]));
            if (__any(bad)) ldsbad = 1;
        }
#endif
        if (pass == 2) {
            vb_sync(lds);
#pragma unroll
            for (int tt = 0; tt < 2; ++tt) {
                f32x4 acc = {0.f, 0.f, 0.f, 0.f};
                const int tl = tt * 16 + fr;
#pragma unroll
                for (int ks = 0; ks < 4; ++ks) {
                    const bf16x8 hf = *(const bf16x8*)(Hs + tl * 256 + (((4 * ks + fq) ^ (tl & 15)) << 4));
                    acc = mfma16(cf[ks], hf, acc);
                }
                float y[4];
                const u32x2 xq = *(const u32x2*)((const unsigned char*)xs + tl * 32 + 8 * fq);
                const float xsk[4] = {bflo(xq.x), bfhi(xq.x), bflo(xq.y), bfhi(xq.y)};
#pragma unroll
                for (int r = 0; r < 4; ++r) y[r] = gelu_tanh(acc[r] + dv[r] * xsk[r]);
                u32x2 o; o.x = pk_bf16(y[0], y[1]); o.y = pk_bf16(y[2], y[3]);
                *(u32x2*)(yg + (size_t)(sub * 32 + tl) * 256 + 4 * fq) = o;
            }
        }
    }
#if DBG_TWICE
    }
    if (__float_as_uint(keep_re) != __float_as_uint(hre) || __float_as_uint(keep_im) != __float_as_uint(him)) { hre = __uint_as_float(0x7fc00000u); him = hre; }
#endif
    if (pass == 1) {
        float* e = Eb + ((size_t)(seq * 16 + ch) * 64 + lane) * 2;
#if DBG_LDSCHK
        if (ldsbad) { hre = __uint_as_float(0x7fc00000u); him = hre; }
#endif
#if DBG_ESC1
        { const unsigned long long pk = ((unsigned long long)__float_as_uint(him) << 32) | __float_as_uint(hre);
          __hip_atomic_store((unsigned long long*)e, pk, __ATOMIC_RELAXED, __HIP_MEMORY_SCOPE_AGENT); }
#else
        e[0] = hre; e[1] = him;
#endif
#if DBG_E2
        float* e2 = (float*)(p.ws + OFF_C + C_ATT) + ((size_t)(seq * 16 + ch) * 64 + lane) * 2;
        e2[0] = hre; e2[1] = him;
#endif
    }
    vb_sync(lds);
}

__device__ __forceinline__ void phase_mid1(CKP& p, int l, unsigned char* lds) {
    if (blockIdx.x < 64) { compress_tile(p, (int)blockIdx.x, lds); return; }
    for (int j = VBID() - 128; j < 768; j += VGRID() - 128) {
        if (j < 256) sgu_job(p, l, j, lds);
        else s5_job(p, l, j - 256, 1, lds);
    }
}

constexpr int AL_Q = 0, AL_KV = 32768, AL_IMP = 49152, AL_SEL = 65792, AL_UNI = 66304, AL_JOB = 66336;
constexpr float SM_C = 0.125f * 1.4426950408889634f;

__device__ __forceinline__ void attn_load_q(const bf16_t* Qg, const int* pos, const float (&inv_freq)[8], int b, int g, int t0, bool rope, unsigned char* lds, int tid) {
#pragma unroll 1
    for (int j = 0; j < 8; ++j) {
        const int pid = tid + 256 * j, Rr = pid >> 3, ch = pid & 7;
        const int wq = Rr >> 6, r = (Rr >> 4) & 3, q = Rr & 15, t = t0 + 16 * wq + q;
        const bf16_t* src = Qg + ((size_t)(b * SEQ + t)) * 512 + (g * 4 + r) * 64;
        if (!rope || ch >= 2) {
            *(u32x4*)(lds + AL_Q + Rr * 128 + ((ch ^ (Rr & 7)) << 4)) = *(const u32x4*)(src + ch * 8);
        } else if (ch == 0) {
            const u32x4 a = *(const u32x4*)(src), c = *(const u32x4*)(src + 8);
            float x1[8] = {bflo(a.x), bfhi(a.x), bflo(a.y), bfhi(a.y), bflo(a.z), bfhi(a.z), bflo(a.w), bfhi(a.w)};
            float x2[8] = {bflo(c.x), bfhi(c.x), bflo(c.y), bfhi(c.y), bflo(c.z), bfhi(c.z), bflo(c.w), bfhi(c.w)};
            const float ps = (float)pos[b * SEQ + t];
#pragma unroll
            for (int i = 0; i < 8; ++i) {
                float sn, cs; sincosf(ps * inv_freq[i], &sn, &cs);
                const float u = x1[i], v = x2[i];
                x1[i] = u * cs - v * sn; x2[i] = v * cs + u * sn;
            }
            u32x4 o1, o2;
            o1.x = pk_bf16(x1[0], x1[1]); o1.y = pk_bf16(x1[2], x1[3]); o1.z = pk_bf16(x1[4], x1[5]); o1.w = pk_bf16(x1[6], x1[7]);
            o2.x = pk_bf16(x2[0], x2[1]); o2.y = pk_bf16(x2[2], x2[3]); o2.z = pk_bf16(x2[4], x2[5]); o2.w = pk_bf16(x2[6], x2[7]);
            *(u32x4*)(lds + AL_Q + Rr * 128 + ((0 ^ (Rr & 7)) << 4)) = o1;
            *(u32x4*)(lds + AL_Q + Rr * 128 + ((1 ^ (Rr & 7)) << 4)) = o2;
        }
    }
}
__device__ __forceinline__ void attn_ldg(u32x4 (&kk)[2], u32x4 (&vv)[2], const bf16_t* Kb, const bf16_t* Vb, int vstride, int tid) {
#pragma unroll
    for (int j = 0; j < 2; ++j) {
        const int pid = tid + 256 * j, row = pid >> 3, ch = pid & 7;
        kk[j] = *(const u32x4*)(Kb + (size_t)row * 128 + ch * 8);
        vv[j] = *(const u32x4*)(Vb + (size_t)row * vstride + ch * 8);
    }
}
__device__ __forceinline__ void attn_stl(const u32x4 (&kk)[2], const u32x4 (&vv)[2], unsigned char* lds, int kvoff, int tid) {
#pragma unroll
    for (int j = 0; j < 2; ++j) {
        const int pid = tid + 256 * j, row = pid >> 3, ch = pid & 7;
        *(u32x4*)(lds + kvoff + row * 128 + ((ch ^ (row & 7)) << 4)) = kk[j];
        *(u32x4*)(lds + kvoff + 8192 + row * 128 + ((ch ^ ((row >> 1) & 7)) << 4)) = vv[j];
    }
}
__device__ __forceinline__ void attn_qk(f32x4 (&s)[2][4], const unsigned char* lds, int kvoff, int w, int fr, int fq, int hf) {
    const unsigned char* Qw = lds + AL_Q + w * 8192;
    const unsigned char* Kh = lds + kvoff + hf * 4096;
    const int sw0 = ((fq) ^ (fr & 7)) << 4, sw1 = ((4 + fq) ^ (fr & 7)) << 4;
#pragma unroll
    for (int ki = 0; ki < 2; ++ki)
#pragma unroll
        for (int qi = 0; qi < 4; ++qi) s[ki][qi] = (f32x4){0.f, 0.f, 0.f, 0.f};
#pragma unroll
    for (int ds = 0; ds < 2; ++ds) {
        bf16x8 qf[4];
#pragma unroll
        for (int qi = 0; qi < 4; ++qi) qf[qi] = *(const bf16x8*)(Qw + (qi * 16 + fr) * 128 + (ds ? sw1 : sw0));
#pragma unroll
        for (int ki = 0; ki < 2; ++ki) {
            const bf16x8 kf = *(const bf16x8*)(Kh + (ki * 16 + fr) * 128 + (ds ? sw1 : sw0));
#pragma unroll
            for (int qi = 0; qi < 4; ++qi) s[ki][qi] = mfma16(kf, qf[qi], s[ki][qi]);
        }
    }
}
__device__ __forceinline__ void attn_pv(f32x4 (&o)[4][4], const f32x4 (&s)[2][4], const unsigned char* lds, int kvoff, int fr, int fq, int hf) {
    bf16x8 pf[4];
#pragma unroll
    for (int qi = 0; qi < 4; ++qi) {
        u32x4 u;
        u.x = pk_bf16(s[0][qi][0], s[0][qi][1]); u.y = pk_bf16(s[0][qi][2], s[0][qi][3]);
        u.z = pk_bf16(s[1][qi][0], s[1][qi][1]); u.w = pk_bf16(s[1][qi][2], s[1][qi][3]);
        pf[qi] = as_bf8(u);
    }
    const int c0 = 4 * hf + (fq >> 1);
    const unsigned char* Vt = lds + kvoff + 8192;
#pragma unroll
    for (int di = 0; di < 4; ++di) {
        const int row = di * 16 + fr, key = (row >> 1) & 7;
        const u32x2 lo = *(const u32x2*)(Vt + row * 128 + ((c0 ^ key) << 4) + 8 * (fq & 1));
        const u32x2 hi = *(const u32x2*)(Vt + row * 128 + (((c0 + 2) ^ key) << 4) + 8 * (fq & 1));
        const bf16x8 vf = as_bf8((u32x4){lo.x, lo.y, hi.x, hi.y});
#pragma unroll
        for (int qi = 0; qi < 4; ++qi) o[di][qi] = mfma16(vf, pf[qi], o[di][qi]);
    }
}
__device__ __forceinline__ unsigned attn_vmask(int kb, int fq, int lo, int hi) {
    unsigned vm = 0;
#pragma unroll
    for (int ki = 0; ki < 2; ++ki)
#pragma unroll
        for (int r = 0; r < 4; ++r) { const int key = kb + 16 * ki + 4 * fq + r; if (key >= lo && key <= hi) vm |= 1u << (ki * 4 + r); }
    return vm;
}
__device__ __forceinline__ void attn_softmax(f32x4 (&s)[2][4], f32x4 (&o)[4][4], float (&m)[4], float (&lsum)[4], unsigned vm) {
#pragma unroll
    for (int qi = 0; qi < 4; ++qi) {
        float mx = -1e30f;
#pragma unroll
        for (int ki = 0; ki < 2; ++ki)
#pragma unroll
            for (int r = 0; r < 4; ++r) { const float sv = ((vm >> (ki * 4 + r)) & 1u) ? s[ki][qi][r] * SM_C : -1e30f; s[ki][qi][r] = sv; mx = fmaxf(mx, sv); }
        mx = xmax16(mx); mx = xmax32(mx);
        const float mn = fmaxf(m[qi], mx), alpha = fexp2(m[qi] - mn);
        m[qi] = mn;
        float ls = 0.f;
#pragma unroll
        for (int ki = 0; ki < 2; ++ki)
#pragma unroll
            for (int r = 0; r < 4; ++r) { const float pv = ((vm >> (ki * 4 + r)) & 1u) ? fexp2(s[ki][qi][r] - mn) : 0.f; s[ki][qi][r] = pv; ls += pv; }
        lsum[qi] = lsum[qi] * alpha + ls;
        if (__any(alpha != 1.f)) {
#pragma unroll
            for (int di = 0; di < 4; ++di) o[di][qi] *= alpha;
        }
    }
}
__device__ __forceinline__ void attn_softmax_full(f32x4 (&s)[2][4], f32x4 (&o)[4][4], float (&m)[4], float (&lsum)[4], bool lsel) {
#pragma unroll
    for (int qi = 0; qi < 4; ++qi) {
        float mx = fmaxf(fmaxf(fmaxf(s[0][qi][0], s[0][qi][1]), fmaxf(s[0][qi][2], s[0][qi][3])), fmaxf(fmaxf(s[1][qi][0], s[1][qi][1]), fmaxf(s[1][qi][2], s[1][qi][3])));
        mx = xmax16(mx); mx = xmax32(mx);
        const float mn = fmaxf(m[qi], mx * SM_C);
        const float mnew = lsel ? mn : m[qi];
        const float alpha = fexp2(m[qi] - mnew);
        m[qi] = mnew;
        const float neg = lsel ? -mn : -1e30f;
        float ls = 0.f;
#pragma unroll
        for (int ki = 0; ki < 2; ++ki)
#pragma unroll
            for (int r = 0; r < 4; ++r) { const float pv = fexp2(fmaf(s[ki][qi][r], SM_C, neg)); s[ki][qi][r] = pv; ls += pv; }
        lsum[qi] = lsum[qi] * alpha + ls;
        if (__any(alpha != 1.f)) {
#pragma unroll
            for (int di = 0; di < 4; ++di) o[di][qi] *= alpha;
        }
    }
}
__device__ __forceinline__ void attn_softmax_fast(f32x4 (&s)[2][4], const float (&m)[4], float (&lsum)[4], unsigned vm, bool& ovf) {
#pragma unroll
    for (int qi = 0; qi < 4; ++qi) {
        const float neg = -m[qi]; float l = 0.f;
#pragma unroll
        for (int ki = 0; ki < 2; ++ki)
#pragma unroll
            for (int r = 0; r < 4; ++r) { const float pv = ((vm >> (ki * 4 + r)) & 1u) ? fexp2(fmaf(s[ki][qi][r], SM_C, neg)) : 0.f; s[ki][qi][r] = pv; l += pv; }
        lsum[qi] += l; ovf |= !(l < 1.0e12f);
    }
}
__device__ __forceinline__ void attn_accum(bf16_t* dst, const f32x4 (&o)[4][4], const float (&lsum)[4], const float (&gate)[4], bool first, int fq) {
#pragma unroll
    for (int qi = 0; qi < 4; ++qi) {
        float lt = lsum[qi]; lt = xsum16(lt); lt = xsum32(lt);
        const float sc = gate[qi] / fmaxf(lt, 1e-30f);
#pragma unroll
        for (int di = 0; di < 4; ++di) {
            u32x2* ptr = (u32x2*)(dst + qi * 64 + 16 * di + 4 * fq);
            float a0 = o[di][qi][0] * sc, a1 = o[di][qi][1] * sc, a2 = o[di][qi][2] * sc, a3 = o[di][qi][3] * sc;
            if (!first) { const u32x2 f = *ptr; a0 += bflo(f.x); a1 += bfhi(f.x); a2 += bflo(f.y); a3 += bfhi(f.y); }
            u32x2 r; r.x = pk_bf16(a0, a1); r.y = pk_bf16(a2, a3);
            *ptr = r;
        }
    }
}
__device__ __forceinline__ bool attn_retry(bool ovf, unsigned char* lds, int tid) {
    volatile LAS int* flag = (volatile LAS int*)(LAS unsigned char*)(lds + AL_JOB + 4);
    if (__any(ovf) && (tid & 63) == 0) *flag = 1;
    vb_sync(lds);
    const int rf = *flag;
    vb_sync(lds);
    if (rf && tid == 0) *flag = 0;
    return rf != 0;
}
template <class NextF, class PtrF, class BodyF>
__device__ __forceinline__ void attn_tiles(int first, NextF next, PtrF ptrs, BodyF body, unsigned char* lds, int tid) {
    u32x4 kk[2], vv[2];
    const bf16_t* Kb; const bf16_t* Vb; int vs;
    ptrs(first, Kb, Vb, vs);
    attn_ldg(kk, vv, Kb, Vb, vs, tid);
    int cur = first;
    while (cur >= 0) {
        vb_sync(lds);
        attn_stl(kk, vv, lds, AL_KV, tid);
        vb_sync(lds);
        const int nx = next(cur);
        if (nx >= 0) { ptrs(nx, Kb, Vb, vs); attn_ldg(kk, vv, Kb, Vb, vs, tid); }
        body(cur, AL_KV);
        cur = nx;
    }
}

__device__ __forceinline__ void glu_tile(CKP& p, int l, int m0, int n0, unsigned char* lds) {
    const int tid = opaque_tid(), lane = tid & 63, w = tid >> 6, wm = w >> 1, wn = w & 1, fr = lane & 15, fq = lane >> 4;
    const bf16_t* A = (const bf16_t*)(p.ws + OFF_C + C_YG);
    const bf16_t* Bt = (const bf16_t*)(p.ws + OFF_W + W_GLU);
    bf16_t* O = (bf16_t*)(p.ws + OFF_C + C_S5O);
    const float* gb = p.in[24] + (size_t)l * 256;
    f32x4 acc[4][4]; zero_acc(acc);
    gemm_kloop(acc, [&](int r) { return A + (size_t)(m0 + r) * 256; }, 64, [&](int v) { return Bt + (size_t)(n0 + v) * 256; }, 64, 4, lds, tid);
#pragma unroll
    for (int mi = 0; mi < 4; ++mi) {
        const int row = m0 + 64 * wm + 16 * mi + fr, col = n0 + 64 * wn + 16 * fq;
        const u32x4 y0 = *(const u32x4*)(A + (size_t)row * 256 + col), y1 = *(const u32x4*)(A + (size_t)row * 256 + col + 8);
        const unsigned yy[8] = {y0.x, y0.y, y0.z, y0.w, y1.x, y1.y, y1.z, y1.w};
        float v[16];
#pragma unroll
        for (int e = 0; e < 16; ++e) {
            const float y = (e & 1) ? bfhi(yy[e >> 1]) : bflo(yy[e >> 1]);
            v[e] = y * sigm(acc[mi][e >> 2][e & 3] + gb[col + e]);
        }
        store16bf(O + (size_t)row * 256 + col, v);
    }
}
__device__ __forceinline__ void phase_attn(CKP& p, int l, unsigned char* lds, unsigned* ctl) {
    for (int jb = (int)blockIdx.x; jb < 128; jb += (int)gridDim.x) {
        const int w_ = opaque_tid() >> 6, vbi = TIDX() >> 8, bq = jb >> 4, chq = jb & 15;
#pragma unroll 1
        for (int r = 0; r < 2; ++r) s5_job(p, l, 0, 2, lds, ((bq * 16 + r * 8 + vbi * 4 + w_) << 4) + chq);
        asm volatile("s_waitcnt vmcnt(0)" ::: "memory");
        __syncthreads();
#pragma unroll 1
        for (int nt_ = 0; nt_ < 2; ++nt_) glu_tile(p, l, bq * SEQ + chq * 256 + vbi * 128, nt_ * 128, lds);
    }

    unsigned char* R = p.ws + OFF_R; unsigned char* C = p.ws + OFF_C;
    const bf16_t* Qg = (const bf16_t*)(R + R_Q);
    const bf16_t* Kc = (const bf16_t*)(C + C_KCMP); const bf16_t* Vc = (const bf16_t*)(C + C_VCT);
    const bf16_t* Ks = (const bf16_t*)(R + R_KS); const bf16_t* Vs = (const bf16_t*)(R + R_VST);
    const bf16_t* Kw = (const bf16_t*)(R + R_KW); const bf16_t* Vw = (const bf16_t*)(R + R_VWT);
    const float* NG = (const float*)(R + R_NG);
    bf16_t* AO = (bf16_t*)(C + C_ATT);
    const int* pos = (const int*)p.in[1];
    unsigned* ctr = ctl + CTL_ATTN + l;
    float invf[8];
#pragma unroll
    for (int q = 0; q < 8; ++q) invf[q] = p.inv_freq[q];

    if (opaque_tid() == 0) { *(volatile int*)(lds + AL_JOB + 8) = 0; *(volatile int*)(lds + AL_JOB + 4) = 0; }
    for (;;) {
        lds = vb_lds();
        volatile int* jobp = (volatile int*)(lds + AL_JOB);
        float* imp = (float*)(lds + AL_IMP);
        unsigned long long* selm = (unsigned long long*)(lds + AL_SEL);
        unsigned long long* uni = (unsigned long long*)(lds + AL_UNI);
        const int tid = opaque_tid(), lane = tid & 63, w = tid >> 6, fr = lane & 15, fq = lane >> 4;
        vb_sync(lds);
        if (tid == 0) { *jobp = (int)atomicAdd(ctr, 1u); *(volatile int*)(lds + AL_JOB + 8) += 1; }
        vb_sync(lds);
        const int job = *jobp, grabs = *(volatile int*)(lds + AL_JOB + 8);
        if (grabs == 2 || (job >= 1024 && grabs == 1)) convert_tiles(p, l, 11, 14, VBID() * 4 + w, VGRID() * 4, lane);
        if (job >= 1024) break;
        const int i = 63 - (job >> 4), bg = job & 15, b = bg >> 1, g = bg & 1, t0 = i * 64;
        const int tq = t0 + 16 * w + fr;
        const size_t kvrow = (size_t)b * SEQ;
        float gate[4]; bf16_t* dstq_;

        attn_load_q(Qg, pos, invf, b, g, t0, false, lds, tid);
        const int ntc = ((4 * i + 2) >> 6) + 1;
        const int hic = (tq >= 31) ? ((tq - 31) >> 4) : -1;
        float m[4], lsum[4];
#pragma unroll
        for (int qi = 0; qi < 4; ++qi) { m[qi] = -1e30f; lsum[qi] = 0.f; }
        auto cmp_next = [&](int ct) { return (ct + 1 < ntc) ? ct + 1 : -1; };
        auto cmp_ptrs = [&](int ct, const bf16_t*& Kb, const bf16_t*& Vb, int& vs) {
            Kb = Kc + ((size_t)(b * 256 + ct * 64)) * 128 + g * 64; Vb = Vc + ((size_t)((b * 2 + g) * 64)) * 256 + ct * 64; vs = 256; };
        attn_tiles(0, cmp_next, cmp_ptrs, [&](int ct, int kvoff) {
#pragma unroll 1
            for (int hf = 0; hf < 2; ++hf) {
                f32x4 s[2][4];
                attn_qk(s, lds, kvoff, w, fr, fq, hf);
                const unsigned vm = attn_vmask(ct * 64 + hf * 32, fq, 0, hic);
#pragma unroll
                for (int qi = 0; qi < 4; ++qi) {
                    float mx = -1e30f;
#pragma unroll
                    for (int ki = 0; ki < 2; ++ki)
#pragma unroll
                        for (int r = 0; r < 4; ++r) { const float sv = ((vm >> (ki * 4 + r)) & 1u) ? s[ki][qi][r] * SM_C : -1e30f; s[ki][qi][r] = sv; mx = fmaxf(mx, sv); }
                    mx = xmax16(mx); mx = xmax32(mx);
                    const float mn = fmaxf(m[qi], mx), alpha = fexp2(m[qi] - mn);
                    m[qi] = mn;
                    float ls = 0.f;
#pragma unroll
                    for (int ki = 0; ki < 2; ++ki)
#pragma unroll
                        for (int r = 0; r < 4; ++r) ls += ((vm >> (ki * 4 + r)) & 1u) ? fexp2(s[ki][qi][r] - mn) : 0.f;
                    lsum[qi] = lsum[qi] * alpha + ls;
                }
            }
        }, lds, tid);
        float invl[4];
#pragma unroll
        for (int qi = 0; qi < 4; ++qi) { float lt = lsum[qi]; lt = xsum16(lt); lt = xsum32(lt); invl[qi] = 1.f / fmaxf(lt, 1e-30f); }
        {
            f32x4 o[4][4]; zero_acc(o);
            float carry = 0.f;
            attn_tiles(0, cmp_next, cmp_ptrs, [&](int ct, int kvoff) {
#pragma unroll 1
                for (int hf = 0; hf < 2; ++hf) {
                    f32x4 s[2][4];
                    attn_qk(s, lds, kvoff, w, fr, fq, hf);
                    const unsigned vm = attn_vmask(ct * 64 + hf * 32, fq, 0, hic);
#pragma unroll
                    for (int qi = 0; qi < 4; ++qi)
#pragma unroll
                        for (int ki = 0; ki < 2; ++ki)
#pragma unroll
                            for (int r = 0; r < 4; ++r) s[ki][qi][r] = ((vm >> (ki * 4 + r)) & 1u) ? fexp2(s[ki][qi][r] * SM_C - m[qi]) * invl[qi] : 0.f;
#pragma unroll
                    for (int ki = 0; ki < 2; ++ki) {
                        float a = 0.f, bq = 0.f;
#pragma unroll
                        for (int qi = 0; qi < 4; ++qi) { a += s[ki][qi][0] + s[ki][qi][1] + s[ki][qi][2] + 0.5f * s[ki][qi][3]; bq += 0.5f * s[ki][qi][3]; }
                        const float up = bperm_f((lane + 48) & 63, bq);
                        const float wrap = bperm_f((lane + 48) & 63, carry);
                        a += (fq >= 1) ? up : wrap;
                        carry = bq;
                        imp[(16 * w + fr) * 65 + 16 * ct + 8 * hf + 4 * ki + fq] = a;
                    }
                    attn_pv(o, s, lds, kvoff, fr, fq, hf);
                }
            }, lds, tid);
#pragma unroll
            for (int qi = 0; qi < 4; ++qi) { int rq = (int)kvrow + tq; asm volatile("" : "+v"(rq)); gate[qi] = NG[(size_t)rq * 24 + (g * 4 + qi) * 3 + 0]; }
            const float quarter[4] = {0.25f, 0.25f, 0.25f, 0.25f};
            { int rq2 = (int)kvrow + tq; asm volatile("" : "+v"(rq2)); dstq_ = AO + (size_t)rq2 * 512 + (g * 4) * 64; } attn_accum(dstq_, o, quarter, gate, true, fq);
        }
        vb_sync(lds);
        {
            const int q = tid >> 2, part = tid & 3;
            unsigned long long mk = 0ull;
            if (i <= 15) { mk = (i == 63) ? ~0ull : ((1ull << (i + 1)) - 1ull); }
            else {
                const float* row = imp + q * 65;
                float cv[16];
#pragma unroll
                for (int k = 0; k < 16; ++k) { const int j = 1 + part + 4 * k; cv[k] = (j <= i - 2) ? row[j] : -1.f; }
                unsigned lo32 = 0u, hi32 = 0u;
#pragma unroll 1
                for (int r = 0; r < 13; ++r) {
                    float bv = cv[0]; int bj = 1 + part;
#pragma unroll
                    for (int k = 1; k < 16; ++k) { const bool t = cv[k] > bv; bv = t ? cv[k] : bv; bj = t ? (1 + part + 4 * k) : bj; }
#pragma unroll
                    for (int mm = 1; mm <= 2; mm <<= 1) {
                        const float ov = bperm_f(lane ^ mm, bv); const int oj = (int)bperm_u(lane ^ mm, (unsigned)bj);
                        const bool t = (ov > bv) || (ov == bv && oj < bj);
                        bv = t ? ov : bv; bj = t ? oj : bj;
                    }
#pragma unroll
                    for (int k = 0; k < 16; ++k) cv[k] = (1 + part + 4 * k == bj) ? -1.f : cv[k];
                    if (bj < 32) lo32 |= 1u << bj; else hi32 |= 1u << (bj - 32);
                }
                mk = ((unsigned long long)hi32 << 32) | lo32;
                mk |= 1ull | (1ull << i) | (1ull << (i - 1));
            }
            if (part == 0) selm[q] = mk;
            unsigned lo32 = (unsigned)mk, hi32 = (unsigned)(mk >> 32);
#pragma unroll
            for (int o2 = 32; o2 >= 1; o2 >>= 1) { lo32 |= bperm_u(lane ^ o2, lo32); hi32 |= bperm_u(lane ^ o2, hi32); }
            if (lane == 0) uni[w] = ((unsigned long long)hi32 << 32) | lo32;
        }
        vb_sync(lds);
        const unsigned long long mymask = selm[16 * w + fr];
        const unsigned long long un = uni[0] | uni[1] | uni[2] | uni[3];
        vb_sync(lds);
        attn_load_q((const bf16_t*)(R + R_QR), pos, invf, b, g, t0, false, lds, tid);
        auto sel_branch = [&](auto mode_c) -> bool {
            constexpr int mode = decltype(mode_c)::value;
            int kvr = (int)kvrow, bl = b, gl = g; asm volatile("" : "+v"(kvr), "+v"(bl), "+v"(gl));
            f32x4 o[4][4]; zero_acc(o);
#pragma unroll
            for (int qi = 0; qi < 4; ++qi) { m[qi] = -1e30f; lsum[qi] = 0.f; }
            bool ovf = false;
            attn_tiles(0,
                [&](int j) { const unsigned long long rest = (j >= 63) ? 0ull : (un >> (j + 1)); return rest ? (j + 1 + (int)__ffsll((long long)rest) - 1) : -1; },
                [&](int j, const bf16_t*& Kb, const bf16_t*& Vb, int& vs) { Kb = Ks + ((size_t)kvr + j * 64) * 128 + gl * 64; Vb = Vs + ((size_t)((bl * 2 + gl) * 64)) * SEQ + j * 64; vs = SEQ; },
                [&](int j, int kvoff) {
                    const bool lsel = ((mymask >> j) & 1ull) != 0ull;
                    const int hi = lsel ? tq : -1;
#pragma unroll 1
                    for (int hf = 0; hf < 2; ++hf) {
                        f32x4 s[2][4];
                        attn_qk(s, lds, kvoff, w, fr, fq, hf);
                        if (j == 0 || mode) { if (j < i) attn_softmax_full(s, o, m, lsum, lsel); else { const unsigned vm = attn_vmask(j * 64 + hf * 32, fq, 0, hi); attn_softmax(s, o, m, lsum, vm); } }
                        else { const unsigned vm = (j < i) ? (lsel ? 0xffu : 0u) : attn_vmask(j * 64 + hf * 32, fq, 0, hi); attn_softmax_fast(s, m, lsum, vm, ovf); }
                        attn_pv(o, s, lds, kvoff, fr, fq, hf);
                    }
                }, lds, tid);
            if (mode == 0 && attn_retry(ovf, lds, tid)) return true;
#pragma unroll
            for (int qi = 0; qi < 4; ++qi) { int rq = (int)kvrow + tq; asm volatile("" : "+v"(rq)); gate[qi] = NG[(size_t)rq * 24 + (g * 4 + qi) * 3 + 1]; }
            { int rq2 = (int)kvrow + tq; asm volatile("" : "+v"(rq2)); dstq_ = AO + (size_t)rq2 * 512 + (g * 4) * 64; } attn_accum(dstq_, o, lsum, gate, false, fq);
            return false;
        };
        if (sel_branch(std::integral_constant<int, 0>{})) (void)sel_branch(std::integral_constant<int, 1>{});
        auto win_branch = [&](auto mode_c) -> bool {
            constexpr int mode = decltype(mode_c)::value;
            int kvr = (int)kvrow, bl = b, gl = g; asm volatile("" : "+v"(kvr), "+v"(bl), "+v"(gl));
            f32x4 o[4][4]; zero_acc(o);
#pragma unroll
            for (int qi = 0; qi < 4; ++qi) { m[qi] = -1e30f; lsum[qi] = 0.f; }
            const int j0 = (i >= 8) ? (i - 8) : 0;
            bool ovf = false;
            attn_tiles(j0,
                [&](int j) { return (j + 1 <= i) ? j + 1 : -1; },
                [&](int j, const bf16_t*& Kb, const bf16_t*& Vb, int& vs) { Kb = Kw + ((size_t)kvr + j * 64) * 128 + gl * 64; Vb = Vw + ((size_t)((bl * 2 + gl) * 64)) * SEQ + j * 64; vs = SEQ; },
                [&](int j, int kvoff) {
#pragma unroll 1
                    for (int hf = 0; hf < 2; ++hf) {
                        f32x4 s[2][4];
                        attn_qk(s, lds, kvoff, w, fr, fq, hf);
                        if (j <= j0 + 1 || mode) { const unsigned vm = attn_vmask(j * 64 + hf * 32, fq, tq - 511, tq); attn_softmax(s, o, m, lsum, vm); }
                        else { const unsigned vm = (j >= i - 7 && j < i) ? 0xffu : attn_vmask(j * 64 + hf * 32, fq, tq - 511, tq); attn_softmax_fast(s, m, lsum, vm, ovf); }
                        attn_pv(o, s, lds, kvoff, fr, fq, hf);
                    }
                }, lds, tid);
            if (mode == 0 && attn_retry(ovf, lds, tid)) return true;
#pragma unroll
            for (int qi = 0; qi < 4; ++qi) { int rq = (int)kvrow + tq; asm volatile("" : "+v"(rq)); gate[qi] = NG[(size_t)rq * 24 + (g * 4 + qi) * 3 + 2]; }
            { int rq2 = (int)kvrow + tq; asm volatile("" : "+v"(rq2)); dstq_ = AO + (size_t)rq2 * 512 + (g * 4) * 64; } attn_accum(dstq_, o, lsum, gate, false, fq);
            return false;
        };
        if (win_branch(std::integral_constant<int, 0>{})) (void)win_branch(std::integral_constant<int, 1>{});
    }
}


struct G8Branch {
    static constexpr bool GATHER = false, HAS_F8 = true;
    const char* ws;
    __device__ __forceinline__ bool next(int i, G8Unit& u, const int (&R)[2], const unsigned (&C2)[2]) const {
        const int T = i / 6, sub = i - T * 6, L = T * (int)gridDim.x + (int)blockIdx.x;
        if (L >= (NTOK / 256) * 4) return false;
        int pm, pn; tile_coords(L, NTOK / 256, 4, pm, pn); pm = __builtin_amdgcn_readfirstlane(pm); pn = __builtin_amdgcn_readfirstlane(pn);
        if (sub == 1 || sub >= 4) {
            u.f8 = 1; u.K2 = 1024u; u.nt = 8; u.A0 = ws + OFF_XQ + (size_t)pm * 256 * 1024;
            if (sub == 1) { u.B0 = ws + OFF_W + W_GB + (size_t)(pn * 256) * 1024; u.B1 = u.B0 + (size_t)128 * 1024; }
            else { u.B0 = ws + OFF_W + W_GB + (size_t)(1024 + pn * 256 + (sub - 4) * 128) * 1024; u.B1 = u.B0 + (size_t)1024 * 1024; }
        } else {
            u.f8 = 0;
            const int br = (sub == 0) ? 0 : sub - 1;
            const unsigned k2 = br == 0 ? 1024u : 512u; u.K2 = k2; u.nt = br == 0 ? 8 : 4;
            const size_t b1 = (size_t)(br == 1), b2 = (size_t)(br == 2);
            const char* a = ws + (size_t)(OFF_C + C_ATT) + b1 * (size_t)(C_SGU - C_ATT) + b2 * (size_t)(C_S5O - C_ATT);
            const char* w = ws + (size_t)(OFF_W + W_A) + b1 * (size_t)(W_S - W_A) + b2 * (size_t)(W_5 - W_A);
            u.A0 = a + (size_t)pm * 256 * k2; u.B0 = w + (size_t)pn * 256 * k2; u.B1 = u.B0 + (size_t)128 * k2;
        }
        u.A1 = u.A0 + (size_t)128 * u.K2;
        u.x0 = pm; u.x1 = pn; u.x2 = sub; u.x3 = 0;
#pragma unroll
        for (int h = 0; h < 2; ++h)
#pragma unroll
            for (int k = 0; k < 2; ++k) u.ao[h][k] = __umul24((unsigned)R[k], u.K2) + C2[k];
        return true;
    }
};
struct EpiBranch {
    bf16_t* T1; bf16_t* T2; bf16_t* Mg; const float* rs1;
    __device__ __forceinline__ void operator()(const G8Acc& acc, const G8Unit& u, int wr, int wc, int fr, int fq) const {
        const int sub = u.x2;
        const size_t off0 = (size_t)(u.x0 * 256 + wr * 64 + fr) * 1024 + u.x1 * 256 + wc * 32 + 8 * fq;
        if (sub == 0 || sub == 2 || sub == 3) {
            bf16_t* Tt = (sub == 3) ? T2 : T1;
#pragma unroll
            for (int ai = 0; ai < 2; ++ai)
#pragma unroll
                for (int m = 0; m < 4; ++m)
#pragma unroll
                    for (int bj = 0; bj < 2; ++bj) {
                        const f32x4 v0 = acc[ai][bj][m][0], v1 = acc[ai][bj][m][1];
                        u32x4 o; o.x = pk_bf16(v0[0], v0[1]); o.y = pk_bf16(v0[2], v0[3]); o.z = pk_bf16(v1[0], v1[1]); o.w = pk_bf16(v1[2], v1[3]);
                        *(u32x4*)(Tt + off0 + (size_t)(ai * 128 + m * 16) * 1024 + bj * 128) = o;
                    }
        } else if (sub == 1) {
#pragma unroll
            for (int ai = 0; ai < 2; ++ai) {
                float rsv[4];
#pragma unroll
                for (int m = 0; m < 4; ++m) rsv[m] = rs1[u.x0 * 256 + ai * 128 + wr * 64 + m * 16 + fr];
                u32x4 y[4][2];
#pragma unroll
                for (int m = 0; m < 4; ++m)
#pragma unroll
                    for (int bj = 0; bj < 2; ++bj) y[m][bj] = *(const u32x4*)(T1 + off0 + (size_t)(ai * 128 + m * 16) * 1024 + bj * 128);
#pragma unroll
                for (int m = 0; m < 4; ++m)
#pragma unroll
                    for (int bj = 0; bj < 2; ++bj) {
                        const f32x4 v0 = acc[ai][bj][m][0] * GQ_INV, v1 = acc[ai][bj][m][1] * GQ_INV;
                        const u32x4 yy = y[m][bj];
                        u32x4 o;
                        o.x = pk_bf16(sigm(v0[0]) * bflo(yy.x), sigm(v0[1]) * bfhi(yy.x));
                        o.y = pk_bf16(sigm(v0[2]) * bflo(yy.y), sigm(v0[3]) * bfhi(yy.y));
                        o.z = pk_bf16(sigm(v1[0]) * bflo(yy.z), sigm(v1[1]) * bfhi(yy.z));
                        o.w = pk_bf16(sigm(v1[2]) * bflo(yy.w), sigm(v1[3]) * bfhi(yy.w));
                        *(u32x4*)(Mg + off0 + (size_t)(ai * 128 + m * 16) * 1024 + bj * 128) = o;
                    }
            }
        } else {
            const size_t offc = off0 + (size_t)(sub - 4) * 128;
#pragma unroll
            for (int ai = 0; ai < 2; ++ai) {
                float rsv[4];
#pragma unroll
                for (int m = 0; m < 4; ++m) rsv[m] = rs1[u.x0 * 256 + ai * 128 + wr * 64 + m * 16 + fr];
                u32x4 y1[4], y2[4], pv[4];
#pragma unroll
                for (int m = 0; m < 4; ++m) {
                    const size_t off = offc + (size_t)(ai * 128 + m * 16) * 1024;
                    y1[m] = *(const u32x4*)(T1 + off); y2[m] = *(const u32x4*)(T2 + off); pv[m] = *(const u32x4*)(Mg + off);
                }
#pragma unroll
                for (int m = 0; m < 4; ++m) {
                    const f32x4 a0 = acc[ai][0][m][0] * GQ_INV, a1 = acc[ai][0][m][1] * GQ_INV, b0 = acc[ai][1][m][0] * GQ_INV, b1 = acc[ai][1][m][1] * GQ_INV;
                    const u32x4 p1 = y1[m], p2 = y2[m], pp = pv[m];
                    u32x4 o;
                    o.x = pk_bf16(sigm(a0[0]) * bflo(p1.x) + sigm(b0[0]) * bflo(p2.x) + bflo(pp.x), sigm(a0[1]) * bfhi(p1.x) + sigm(b0[1]) * bfhi(p2.x) + bfhi(pp.x));
                    o.y = pk_bf16(sigm(a0[2]) * bflo(p1.y) + sigm(b0[2]) * bflo(p2.y) + bflo(pp.y), sigm(a0[3]) * bfhi(p1.y) + sigm(b0[3]) * bfhi(p2.y) + bfhi(pp.y));
                    o.z = pk_bf16(sigm(a1[0]) * bflo(p1.z) + sigm(b1[0]) * bflo(p2.z) + bflo(pp.z), sigm(a1[1]) * bfhi(p1.z) + sigm(b1[1]) * bfhi(p2.z) + bfhi(pp.z));
                    o.w = pk_bf16(sigm(a1[2]) * bflo(p1.w) + sigm(b1[2]) * bflo(p2.w) + bflo(pp.w), sigm(a1[3]) * bfhi(p1.w) + sigm(b1[3]) * bfhi(p2.w) + bfhi(pp.w));
                    *(u32x4*)(Mg + offc + (size_t)(ai * 128 + m * 16) * 1024) = o;
                }
            }
        }
    }
};
__device__ __forceinline__ void phase_branch(CKP& p, int l, unsigned char* lds) {
    G8Branch S{(const char*)p.ws};
    EpiBranch E{(bf16_t*)(p.ws + OFF_R), (bf16_t*)(p.ws + OFF_R + 67108864), (bf16_t*)(p.ws + OFF_M), (const float*)(p.ws + OFF_RS1)};
    g8_phase(S, E);
}

struct EpiMix {
    bf16_t* x;
    __device__ __forceinline__ void operator()(const G8Acc& acc, const G8Unit& u, int wr, int wc, int fr, int fq) const {
        bf16_t* xp0 = x + (size_t)(u.x0 * 256 + wr * 64 + fr) * 1024 + u.x1 * 256 + wc * 32 + 8 * fq;
#pragma unroll
        for (int ai = 0; ai < 2; ++ai) {
            u32x4 xv[4][2];
#pragma unroll
            for (int m = 0; m < 4; ++m)
#pragma unroll
                for (int bj = 0; bj < 2; ++bj) xv[m][bj] = *(const u32x4*)(xp0 + (size_t)(ai * 128 + m * 16) * 1024 + bj * 128);
#pragma unroll
            for (int m = 0; m < 4; ++m)
#pragma unroll
                for (int bj = 0; bj < 2; ++bj) {
                    const f32x4 a0 = acc[ai][bj][m][0], a1 = acc[ai][bj][m][1]; const u32x4 xx = xv[m][bj];
                    u32x4 o;
                    o.x = pk_bf16(bflo(xx.x) + a0[0], bfhi(xx.x) + a0[1]); o.y = pk_bf16(bflo(xx.y) + a0[2], bfhi(xx.y) + a0[3]);
                    o.z = pk_bf16(bflo(xx.z) + a1[0], bfhi(xx.z) + a1[1]); o.w = pk_bf16(bflo(xx.w) + a1[2], bfhi(xx.w) + a1[3]);
                    *(u32x4*)(xp0 + (size_t)(ai * 128 + m * 16) * 1024 + bj * 128) = o;
                }
        }
    }
};
__device__ __forceinline__ void phase_mix(CKP& p, int l, unsigned char* lds) {
    G8Plain S{(const char*)(p.ws + OFF_M), (const char*)(p.ws + OFF_W + W_M), 2048u, 16, NTOK / 256, 4};
    EpiMix E{(bf16_t*)(p.ws + OFF_X)};
    g8_phase(S, E);
}

__device__ __forceinline__ void phase_router(CKP& p, int l, unsigned char* lds, unsigned* ctl) {
    const int tid = opaque_tid(), lane = tid & 63, w = tid >> 6, wm = w >> 1, wn = w & 1, fr = lane & 15, fq = lane >> 4;
    int t512 = TIDX(); asm volatile("" : "+v"(t512));
    const int half = t512 >> 8, w8 = t512 >> 6;
    const float* gam = p.in[27] + (size_t)l * 1024;
    const float* bg = p.in[29] + (size_t)l * 4;
    const float* be = p.in[31] + (size_t)l * 32;
    const bf16_t* xres = (const bf16_t*)(p.ws + OFF_X);
    bf16_t* h2 = (bf16_t*)(p.ws + OFF_M);
    bf16_t* hlo = (bf16_t*)(p.ws + OFF_H);
    const bf16_t* Wh = (const bf16_t*)(p.ws + OFF_W + W_RH);
    const bf16_t* Wl = (const bf16_t*)(p.ws + OFF_W + W_RL);
    unsigned* cnt = ctl + CTL_MOECNT + l * 32;
    int* list = (int*)(p.ws + OFF_MOE + MOE_LIST);
    float* wsl = (float*)(p.ws + OFF_MOE + MOE_WS);
    unsigned char* lds0 = lds_base();
    float* lg = (float*)lds0;
    float* xch = (float*)(lds0 + VB_LDS);
    int* lc = (int*)(lds0 + 18432); int* gbs = (int*)(lds0 + 18432 + 128);
    float* rs = (float*)(lds0 + 65536);
    float* rsl = (float*)(p.ws + OFF_MOE + MOE_RS);
    for (int tile = blockIdx.x; tile < NTOK / 128; tile += gridDim.x) {
        const int r0 = tile * 128;
        {
            for (int rr = 0; rr < 16; rr += 2) {
                const int row = r0 + w8 * 16 + rr;
                float sa = 0.f, sb = 0.f;
#pragma unroll
                for (int i = 0; i < 4; ++i) { const u32x2 ua = *(const u32x2*)(xres + (size_t)row * 1024 + 4 * lane + 256 * i), ub = *(const u32x2*)(xres + (size_t)(row + 1) * 1024 + 4 * lane + 256 * i);
                                              sa += bflo(ua.x) * bflo(ua.x) + bfhi(ua.x) * bfhi(ua.x) + bflo(ua.y) * bflo(ua.y) + bfhi(ua.y) * bfhi(ua.y);
                                              sb += bflo(ub.x) * bflo(ub.x) + bfhi(ub.x) * bfhi(ub.x) + bflo(ub.y) * bflo(ub.y) + bfhi(ub.y) * bfhi(ub.y); }
                sa = wave_sum(sa); sb = wave_sum(sb);
                if (lane == 0) { rs[w8 * 16 + rr] = rsqrtf(sa * (1.f / 1024.f) + RMS_EPS); rs[w8 * 16 + rr + 1] = rsqrtf(sb * (1.f / 1024.f) + RMS_EPS); }
            }
        }
        __syncthreads();
        f32x4 acc[4][4]; zero_acc(acc);
        {
            const bf16_t* Wx = half ? Wl : Wh;
            gemm_kloop(acc, [&](int r) { return xres + (size_t)(r0 + r) * 1024; }, 64, [&](int v) { return Wx + (size_t)(v < 63 ? v : 63) * 1024; }, 64, 16, lds, tid);
        }
        __syncthreads();
        int lbase = (64 * wm + fr) * 36 + 16 * fq; asm volatile("" : "+v"(lbase));
        if (half == 1 && wn == 0 && fq < 3) {
#pragma unroll
            for (int mi = 0; mi < 4; ++mi)
#pragma unroll
                for (int e = 0; e < 16; ++e) if (e < 4 || fq < 2) xch[lbase + mi * 576 + e] = acc[mi][e >> 2][e & 3];
        }
        __syncthreads();
        if (half == 0 && tid < 32) lc[tid] = 0;
        if (half == 0 && wn == 0 && fq < 3) {
#pragma unroll
            for (int mi = 0; mi < 4; ++mi)
#pragma unroll
                for (int e = 0; e < 16; ++e) if (e < 4 || fq < 2) lg[lbase + mi * 576 + e] = (acc[mi][e >> 2][e & 3] + xch[lbase + mi * 576 + e]) * rs[64 * wm + 16 * mi + fr];
        }
        __syncthreads();
        int e0 = 0, e1 = 0, lr0 = 0, lr1 = 0; float c0 = 0.f, c1 = 0.f;
        if (half == 0 && tid < 128) {
            const float* lrow = lg + tid * 36;
            float gl[4]; int grp = 0; float gm = -3.4e38f;
#pragma unroll
            for (int q = 0; q < 4; ++q) { gl[q] = lrow[q] + bg[q]; if (gl[q] > gm) { gm = gl[q]; grp = q; } }
            float gsum = 0.f;
#pragma unroll
            for (int q = 0; q < 4; ++q) gsum += expf(gl[q] - gm);
            const float grp_w = 1.f / gsum;
            float el[8]; float em = -3.4e38f;
#pragma unroll
            for (int q = 0; q < 8; ++q) { el[q] = lrow[4 + grp * 8 + q] + be[grp * 8 + q]; em = fmaxf(em, el[q]); }
            float esum = 0.f; float ep[8];
#pragma unroll
            for (int q = 0; q < 8; ++q) { ep[q] = expf(el[q] - em); esum += ep[q]; }
            int j0 = 0; float p0 = -1.f;
#pragma unroll
            for (int q = 0; q < 8; ++q) { const float pq = ep[q] / esum; ep[q] = pq; if (pq > p0) { p0 = pq; j0 = q; } }
            int j1 = 0; float p1 = -1.f;
#pragma unroll
            for (int q = 0; q < 8; ++q) { if (q != j0 && ep[q] > p1) { p1 = ep[q]; j1 = q; } }
            const float den = p0 + p1;
            c0 = grp_w * p0 / den; c1 = grp_w * p1 / den;
            e0 = grp * 8 + j0; e1 = grp * 8 + j1;
            lr0 = atomicAdd(&lc[e0], 1); lr1 = atomicAdd(&lc[e1], 1);
        }
        __syncthreads();
        if (half == 0 && tid < 32) { const int n = lc[tid]; gbs[tid] = n ? (int)atomicAdd(&cnt[tid], (unsigned)n) : 0; }
        __syncthreads();
        if (half == 0 && tid < 128) {
            const int tok = r0 + tid;
            list[e0 * 32768 + gbs[e0] + lr0] = tok * 2; list[e1 * 32768 + gbs[e1] + lr1] = tok * 2 + 1;
            rsl[e0 * 32768 + gbs[e0] + lr0] = rs[tid]; rsl[e1 * 32768 + gbs[e1] + lr1] = rs[tid];
            wsl[tok * 2] = c0; wsl[tok * 2 + 1] = c1;
        }
        __syncthreads();
    }
}

__device__ __forceinline__ bool moe_unit(const unsigned* cnt, int i, int& e, int& mt, int& sub, int& rowbase, int& n) {
    int lane = lane_id(); asm volatile("" : "+v"(lane));
    const int c = (lane < 32) ? (int)cnt[lane] : 0;
    const int nt = (c + 255) >> 8, nt128 = (c + 127) >> 7;
    int pre = nt, pre128 = nt128;
#pragma unroll
    for (int o = 1; o < 32; o <<= 1) {
        const int src = (lane - o) << 2;
        const int v = __builtin_amdgcn_ds_bpermute(src, pre), v2 = __builtin_amdgcn_ds_bpermute(src, pre128);
        if (lane >= o) { pre += v; pre128 += v2; }
    }
    const int total = __builtin_amdgcn_readlane(pre, 31) * 4;
    const int Lp = i * (int)gridDim.x + (int)blockIdx.x, q = (total + 7) >> 3, off = Lp >> 3;
    const int L = (Lp & 7) * q + off;
    if (off >= q || L >= total) return false;
    const int excl = pre - nt;
    const bool mine = (lane < 32) && (L >= excl * 4) && (L < pre * 4);
    const unsigned long long bal = __ballot(mine);
    if (bal == 0ull) return false;
    const int ee = __builtin_amdgcn_readfirstlane(__ffsll((long long)bal) - 1);
    e = ee;
    n = __builtin_amdgcn_readlane(c, ee);
    rowbase = __builtin_amdgcn_readlane(pre128 - nt128, ee) * 128;
    const int r = L - __builtin_amdgcn_readlane(excl, ee) * 4;
    mt = r >> 2; sub = r & 3;
    return true;
}
struct G8Exp1 {
    static constexpr bool GATHER = true, HAS_F8 = false;
    const unsigned* cnt; const int* list; const char* h2; const char* Wg; const char* Wu;
    __device__ __forceinline__ bool next(int i, G8Unit& u, const int (&R)[2], const unsigned (&C2)[2]) const {
        int e, mt, sub, rowbase, n;
        if (!moe_unit(cnt, i, e, mt, sub, rowbase, n)) return false;
        u.A0 = h2; u.A1 = h2; u.K2 = 2048u; u.nt = 16;
        u.B0 = Wg + ((size_t)e * 512 + sub * 128) * 2048; u.B1 = Wu + ((size_t)e * 512 + sub * 128) * 2048;
        u.x0 = e; u.x1 = mt; u.x2 = sub; u.x3 = rowbase; u.n = n;
#pragma unroll
        for (int h = 0; h < 2; ++h)
#pragma unroll
            for (int k = 0; k < 2; ++k) { int sidx = mt * 256 + h * 128 + R[k]; sidx = sidx < n ? sidx : n - 1; u.ao[h][k] = ((unsigned)(list[e * 32768 + sidx] >> 1) << 11) + C2[k]; }
        return true;
    }
};
struct EpiExp1 {
    bf16_t* hid; const float* rsl;
    __device__ __forceinline__ void operator()(const G8Acc& acc, const G8Unit& u, int wr, int wc, int fr, int fq) const {
        float rsv[2][4];
#pragma unroll
        for (int ai = 0; ai < 2; ++ai)
#pragma unroll
            for (int m = 0; m < 4; ++m) { int r = u.x1 * 256 + ai * 128 + wr * 64 + m * 16 + fr; r = r < u.n ? r : u.n - 1; rsv[ai][m] = rsl[u.x0 * 32768 + r]; }
#pragma unroll
        for (int ai = 0; ai < 2; ++ai)
#pragma unroll
            for (int m = 0; m < 4; ++m) {
                const int r = u.x1 * 256 + ai * 128 + wr * 64 + m * 16 + fr;
                if (r < u.n) {
                    const float rs = rsv[ai][m];
                    float hv[8];
#pragma unroll
                    for (int j = 0; j < 8; ++j) { const float g = acc[ai][0][m][j >> 2][j & 3] * rs, up = acc[ai][1][m][j >> 2][j & 3] * rs; hv[j] = g * sigm(g) * up; }
                    u32x4 o; o.x = pk_bf16(hv[0], hv[1]); o.y = pk_bf16(hv[2], hv[3]); o.z = pk_bf16(hv[4], hv[5]); o.w = pk_bf16(hv[6], hv[7]);
                    *(u32x4*)(hid + (size_t)(u.x3 + r) * 512 + u.x2 * 128 + wc * 32 + 8 * fq) = o;
                }
            }
    }
};
__device__ __forceinline__ void phase_exp1(CKP& p, int l, unsigned char* lds, unsigned* ctl) {
    G8Exp1 S{ctl + CTL_MOECNT + l * 32, (const int*)(p.ws + OFF_MOE + MOE_LIST), (const char*)(p.ws + OFF_X), (const char*)(p.ws + OFF_W + W_EG), (const char*)(p.ws + OFF_W + W_EU)};
    EpiExp1 E{(bf16_t*)(p.ws + OFF_HID), (const float*)(p.ws + OFF_MOE + MOE_RS)};
    g8_phase(S, E);
}
struct G8Exp2 {
    static constexpr bool GATHER = true, HAS_F8 = false;
    const unsigned* cnt; const char* hid; const char* Wd;
    __device__ __forceinline__ bool next(int i, G8Unit& u, const int (&R)[2], const unsigned (&C2)[2]) const {
        int e, mt, sub, rowbase, n;
        if (!moe_unit(cnt, i, e, mt, sub, rowbase, n)) return false;
        u.A0 = hid + (size_t)(rowbase + mt * 256) * 1024; u.A1 = u.A0; u.K2 = 1024u; u.nt = 8;
        u.B0 = Wd + ((size_t)e * 1024 + sub * 256) * 1024; u.B1 = u.B0 + (size_t)128 * 1024;
        u.x0 = e; u.x1 = mt; u.x2 = sub; u.x3 = rowbase; u.n = n;
        const int lim = n - mt * 256 - 1;
#pragma unroll
        for (int h = 0; h < 2; ++h)
#pragma unroll
            for (int k = 0; k < 2; ++k) { const int rr = h * 128 + R[k]; u.ao[h][k] = ((unsigned)(rr < lim ? rr : lim) << 10) + C2[k]; }
        return true;
    }
};
struct EpiExp2 {
    const int* list; const float* wsl; bf16_t* ys;
    __device__ __forceinline__ void operator()(const G8Acc& acc, const G8Unit& u, int wr, int wc, int fr, int fq) const {
        int slot[2][4]; float wt[2][4];
#pragma unroll
        for (int ai = 0; ai < 2; ++ai)
#pragma unroll
            for (int m = 0; m < 4; ++m) { int r = u.x1 * 256 + ai * 128 + wr * 64 + m * 16 + fr; r = r < u.n ? r : u.n - 1; slot[ai][m] = list[u.x0 * 32768 + r]; }
#pragma unroll
        for (int ai = 0; ai < 2; ++ai)
#pragma unroll
            for (int m = 0; m < 4; ++m) wt[ai][m] = wsl[slot[ai][m]];
#pragma unroll
        for (int ai = 0; ai < 2; ++ai)
#pragma unroll
            for (int m = 0; m < 4; ++m) {
                const int r = u.x1 * 256 + ai * 128 + wr * 64 + m * 16 + fr;
                if (r < u.n) {
                    bf16_t* dst = ys + (size_t)slot[ai][m] * 1024 + u.x2 * 256 + wc * 32 + 8 * fq;
                    const float w = wt[ai][m];
#pragma unroll
                    for (int bj = 0; bj < 2; ++bj) {
                        const f32x4 v0 = acc[ai][bj][m][0] * w, v1 = acc[ai][bj][m][1] * w;
                        u32x4 o; o.x = pk_bf16(v0[0], v0[1]); o.y = pk_bf16(v0[2], v0[3]); o.z = pk_bf16(v1[0], v1[1]); o.w = pk_bf16(v1[2], v1[3]);
                        *(u32x4*)(dst + bj * 128) = o;
                    }
                }
            }
    }
};
__device__ __forceinline__ void phase_exp2(CKP& p, int l, unsigned char* lds, unsigned* ctl) {
    G8Exp2 S{ctl + CTL_MOECNT + l * 32, (const char*)(p.ws + OFF_HID), (const char*)(p.ws + OFF_W + W_ED)};
    EpiExp2 E{(const int*)(p.ws + OFF_MOE + MOE_LIST), (const float*)(p.ws + OFF_MOE + MOE_WS), (bf16_t*)(p.ws + OFF_YS)};
    g8_phase(S, E);
}

constexpr int PH_PER_LAYER = 10;
constexpr int NPHASE = PH_PER_LAYER * DEPTH + 1;

__global__ __attribute__((target("no-packed-fp32-ops"))) void __launch_bounds__(NTHR_HW, 1) mega(KP p_unused) {
    extern __shared__ __attribute__((aligned(16))) unsigned char lds_all[];
    if ((threadIdx.x & 255) == 0) *(volatile unsigned*)(lds_all + VB_CTR + ((threadIdx.x >> 8) << 6)) = 0u;
    if ((threadIdx.x & 63) == 0) *(volatile unsigned char*)(lds_all + VB_CTR + 192 + hw_wave_key()) = (unsigned char)(threadIdx.x >> 6);
    __syncthreads();
    unsigned* ctl = (unsigned*)(p_unused.ws + OFF_CTL);
#if ONE_LAUNCH
    XcdBarrier xb = xcd_barrier_post(ctl + CTL_BAR, (volatile LAS unsigned*)(lds_all + VB_CTR + 128));
    if (p_unused.never) cg::this_grid().sync();
#if DBG_PREFLUSH
    __builtin_amdgcn_fence(__ATOMIC_RELEASE, "");
    asm volatile("s_waitcnt vmcnt(0)" ::: "memory");
    __builtin_amdgcn_fence(__ATOMIC_ACQUIRE, "");
    asm volatile("s_waitcnt vmcnt(0)" ::: "memory");
    xcd_barrier(xb);
    { const unsigned long long t0 = __builtin_amdgcn_s_memrealtime(); while (__builtin_amdgcn_s_memrealtime() - t0 < 20000ull) __builtin_amdgcn_s_sleep(8); }
    xcd_barrier(xb);
#endif
#endif
    CKP* kp0 = (CKP*)__builtin_amdgcn_kernarg_segment_ptr();
    const int ph_lo = kp0->ph_lo, ph_hi = kp0->ph_hi;
#if ONE_LAUNCH
#define PH_SYNC(PH) if ((PH) + 1 < ph_hi) xcd_barrier(xb);
#else
#define PH_SYNC(PH)
#endif
#if DBG_TIMEPH >= 0
#define PH_STAMP(PH) if (blockIdx.x == 0 && TIDX() == 0) ((unsigned long long*)(kp0->ws + OFF_CTL + 24576))[(PH)] = __builtin_amdgcn_s_memrealtime();
#else
#define PH_STAMP(PH)
#endif
#define RUN_PHASE(PH, CALL) if (ph_lo <= (PH) && (PH) < ph_hi) { PH_STAMP(PH) CKP* kp = kp0; asm volatile("" : "+s"(kp)); CKP& p = *kp; const int rep_ = 0; (void)rep_; unsigned char* lds = vb_lds(); CALL; \
    if ((PH) == DBG_REPEAT_PH) { xcd_barrier(xb); const int rep_ = 1; (void)rep_; CALL; } PH_SYNC(PH) }
#define RUN_LAYER(L) \
    RUN_PHASE((L) * 10 + 0, phase_prep(p, (L), lds)) \
    RUN_PHASE((L) * 10 + 1, phase_inproj(p, (L), lds)) \
    RUN_PHASE((L) * 10 + 2, phase_mid1(p, (L), lds)) \
    RUN_PHASE((L) * 10 + 3, phase_attn(p, (L), lds, ctl + 2 * rep_)) \
    RUN_PHASE((L) * 10 + 5, phase_branch(p, (L), lds)) \
    RUN_PHASE((L) * 10 + 6, phase_mix(p, (L), lds)) \
    RUN_PHASE((L) * 10 + 7, phase_router(p, (L), lds, ctl)) \
    RUN_PHASE((L) * 10 + 8, phase_exp1(p, (L), lds, ctl)) \
    RUN_PHASE((L) * 10 + 9, phase_exp2(p, (L), lds, ctl))
#if DBG_SMALLK
    RUN_PHASE(0, phase_prep(p, 0, lds))
    RUN_PHASE(1, phase_inproj(p, 0, lds))
    RUN_PHASE(2, phase_mid1(p, 0, lds))
#else
    RUN_LAYER(0)
    RUN_LAYER(1)
    RUN_PHASE(20, phase_prep(p, 2, lds))
#endif
#if ONE_LAUNCH && DBG_DUMP
    {
        xcd_barrier(xb);
        CKP* kp = kp0; asm volatile("" : "+s"(kp)); CKP& p = *kp;
        const size_t NO = (size_t)NTOK * 1024;
        const unsigned char* src = p.ws + DBG_DUMP_OFF;
        for (size_t i = (size_t)blockIdx.x * NTHR_HW + threadIdx.x; i < NO; i += (size_t)gridDim.x * NTHR_HW) {
            float v = 0.f;
            if (i < (size_t)DBG_DUMP_N) {
                if (DBG_DUMP_F32) {
                    const size_t si = DBG_DUMP_REV ? ((size_t)DBG_DUMP_N - 1 - i) : i;
#if DBG_SC1READ
                    const unsigned fu = __hip_atomic_load((const unsigned*)src + si, __ATOMIC_RELAXED, __HIP_MEMORY_SCOPE_SYSTEM); const float f = __uint_as_float(fu);
#else
                    const float f = ((const float*)src)[si];
#endif
                    v = DBG_HASH ? (float)(__float_as_uint(f) & 0x3ff) : f;
#if DBG_EFILT
                    { const int id_ = (int)(((si >> 7) - DBG_IDROT) & 2047), blk = ((id_ >> 2) + 320) & 511; if (!(blk >= DBG_EFILT_LO && blk < DBG_EFILT_HI)) v = 0.f; }
#endif
#if DBG_E2
                    { const float f2 = ((const float*)(p.ws + OFF_C + C_ATT))[i]; v = (__float_as_uint(f2) == __float_as_uint(f)) ? 0.f : 1000.f; if (i == 0) v += 1.f; }
#endif
                }
                else { const bf16_t h = ((const bf16_t*)src)[i]; v = DBG_HASH ? (float)(h & 0x3ff) : bf2f(h); }
            }
#if DBG_CONSTOUT
            v = 1000.f + (float)(i & 1023);
#endif
            p.xbuf[i] = v;
        }
    }
#endif
}

#if DBG_DUMP
__global__ void dbg_dump(const bf16_t* src, size_t n, float* out, size_t nout) {
    for (size_t i = (size_t)blockIdx.x * blockDim.x + threadIdx.x; i < nout; i += (size_t)gridDim.x * blockDim.x)
        out[i] = i < n ? (DBG_HASH ? (float)(src[i] & 0x3ff) : bf2f(src[i])) : 0.f;
}
__global__ void dbg_dump_f32(const float* src, size_t n, float* out, size_t nout) {
    for (size_t i = (size_t)blockIdx.x * blockDim.x + threadIdx.x; i < nout; i += (size_t)gridDim.x * blockDim.x)
        out[i] = i < n ? (DBG_HASH ? (float)(__float_as_uint(src[i]) & 0x3ff) : src[i]) : 0.f;
}
#endif
extern "C" void kernel_launch(void* const* d_in, const int* in_sizes, int n_in, void* d_out, int out_size, void* d_ws, size_t ws_size, hipStream_t stream) {
    static int grid = 0;
    if (grid == 0) {
        if (n_in != 36 || out_size != NTOK * DM || ws_size < WS_END) { fprintf(stderr, "kernel_launch: unexpected shapes n_in %d out %d ws %zu (need %zu)\n", n_in, out_size, ws_size, (size_t)WS_END); grid = -1; return; }
        int dev = 0, cus = 0, per_cu = 0;
        hipGetDevice(&dev);
        hipDeviceGetAttribute(&cus, hipDeviceAttributeMultiprocessorCount, dev);
        hipFuncSetAttribute((const void*)mega, hipFuncAttributeMaxDynamicSharedMemorySize, LDS_BYTES);
        hipOccupancyMaxActiveBlocksPerMultiprocessor(&per_cu, (const void*)mega, NTHR_HW, LDS_BYTES);
        if (per_cu < 1) { fprintf(stderr, "kernel_launch: occupancy query says %d\n", per_cu); per_cu = 1; }
        if (per_cu > MAX_PER_CU) per_cu = MAX_PER_CU;
        grid = cus * per_cu;
        fprintf(stderr, "kernel_launch: grid %d (%d CUs x %d)\n", grid, cus, per_cu);
    }
    if (grid < 0) return;
    hipMemsetAsync((char*)d_ws + OFF_CTL, 0, CTL_BYTES, stream);
    KP p{};
    for (int i = 0; i < 36; ++i) p.in[i] = (const float*)d_in[i];
    p.xbuf = (float*)d_out; p.ws = (unsigned char*)d_ws;
    for (int i = 0; i < 8; ++i) p.inv_freq[i] = (float)pow(500000.0, -(double)i / 8.0);
    p.never = 0; p.pad = 0;
#if ONE_LAUNCH
    p.ph_lo = 0; p.ph_hi = DBG_PH_HI;
    void* args[] = {&p};
    hipError_t e = hipLaunchCooperativeKernel((const void*)mega, dim3(grid), dim3(NTHR_HW), args, LDS_BYTES, stream);
    if (e != hipSuccess) fprintf(stderr, "cooperative launch failed: %s (grid %d)\n", hipGetErrorString(e), grid);
#else
    for (int ph = 0; ph < NPHASE; ++ph) {
        if (!((DBG_MASK >> ph) & 1)) continue;
        p.ph_lo = ph; p.ph_hi = ph + 1;
        hipLaunchKernelGGL(mega, dim3(grid), dim3(NTHR_HW), LDS_BYTES, stream, p);
    }
#if DBG_DUMP
    {
        const unsigned char* w = (const unsigned char*)d_ws; const size_t NO = (size_t)NTOK * 1024;
        size_t off = 0, n = 0; bool f32 = false;
        switch (DBG_DUMP) {
            case 1: off = OFF_C + C_ATT; n = (size_t)NTOK * 512; break;
            case 2: off = OFF_C + C_SGU; n = (size_t)NTOK * 256; break;
            case 3: off = OFF_C + C_S5O; n = (size_t)NTOK * 256; break;
            case 4: off = OFF_M; n = (size_t)NTOK * 1024; break;
            case 5: off = OFF_R + R_Q; n = (size_t)NTOK * 512; break;
            case 6: off = OFF_H; n = (size_t)NTOK * 1024; break;
            case 7: off = OFF_C + C_YG; n = (size_t)NTOK * 256; break;
            case 8: off = OFF_C + C_KCMP; n = (size_t)2 * 524288 / 2; break;
            case 9: off = OFF_R + R_KC; n = (size_t)NTOK * 128 * 6; break;
            case 10: off = OFF_R + R_NG; n = (size_t)NTOK * 24; f32 = true; break;
            case 11: off = OFF_R + R_U; n = (size_t)NTOK * 768; break;
            case 12: off = OFF_C + C_S5E; n = (size_t)128 * 16 * 64 * 2; f32 = true; break;
            case 15: off = 0; n = (size_t)NTOK * 1024; f32 = true; break;
            case 16: off = OFF_W + W_S5A; n = 36864; f32 = true; break;
            case 13: off = OFF_YS; n = (size_t)NTOK * 1024; break;
            case 14: off = OFF_MOE + MOE_WS; n = 65536; f32 = true; break;
            default: break;
        }
        if (DBG_DUMP == 15) hipLaunchKernelGGL(dbg_dump_f32, dim3(2048), dim3(256), 0, stream, (const float*)d_out, n, (float*)d_out, NO);
        else if (f32) hipLaunchKernelGGL(dbg_dump_f32, dim3(2048), dim3(256), 0, stream, (const float*)(w + off), n, (float*)d_out, NO);
        else hipLaunchKernelGGL(dbg_dump, dim3(2048), dim3(256), 0, stream, (const bf16_t*)(w + off), n, (float*)d_out, NO);
    }
#endif
#endif
}
```

```cpp
#include <hip/hip_runtime.h>
#include <hip/hip_cooperative_groups.h>
#include <cstdio>
#include <cstdint>
#include <cmath>
#include <type_traits>
namespace cg = cooperative_groups;

#ifndef ONE_LAUNCH
#define ONE_LAUNCH 1
#endif
#ifndef DBG_MASK
#define DBG_MASK 0x1fffff
#endif
#ifndef DBG_NOCOMBINE
#define DBG_NOCOMBINE 0
#endif
#ifndef DBG_DUMP
#define DBG_DUMP 0
#endif
#ifndef DBG_HASH
#define DBG_HASH 0
#endif
#ifndef DBG_ONLYS5
#define DBG_ONLYS5 0
#endif
#ifndef DBG_NOCSTORE
#define DBG_NOCSTORE 0
#endif
#ifndef DBG_LDSCHK
#define DBG_LDSCHK 0
#endif
#ifndef DBG_TWICE
#define DBG_TWICE 0
#endif
#ifndef DBG_S5CONST
#define DBG_S5CONST 0
#endif
#ifndef DBG_SC1READ
#define DBG_SC1READ 0
#endif
#ifndef DBG_E2
#define DBG_E2 0
#endif
#ifndef DBG_JOBFENCE
#define DBG_JOBFENCE 0
#endif
#ifndef DBG_CONSTOUT
#define DBG_CONSTOUT 0
#endif
#ifndef DBG_QDELAY
#define DBG_QDELAY 0
#endif
#ifndef DBG_SMALLK
#define DBG_SMALLK 0
#endif
#ifndef DBG_REPEAT_PH
#define DBG_REPEAT_PH -1
#endif
#ifndef DBG_TIMEPH
#define DBG_TIMEPH -1
#endif
#ifndef DBG_TIMEPH2
#define DBG_TIMEPH2 (DBG_TIMEPH + 1)
#endif
#ifndef DBG_PRESPIN
#define DBG_PRESPIN 0
#endif
#ifndef DBG_SGUSPIN
#define DBG_SGUSPIN 0
#endif
#ifndef DBG_PREFLUSH
#define DBG_PREFLUSH 0
#endif
#ifndef DBG_ESC1
#define DBG_ESC1 0
#endif
#ifndef DBG_DELAY
#define DBG_DELAY 0
#endif
#ifndef DBG_IDROT
#define DBG_IDROT 0
#endif
#ifndef DBG_DUMP_REV
#define DBG_DUMP_REV 0
#endif
#ifndef DBG_SGUCUT
#define DBG_SGUCUT 0
#endif
#ifndef DBG_EFILT
#define DBG_EFILT 0
#define DBG_EFILT_LO 0
#define DBG_EFILT_HI 0
#endif
#ifndef DBG_DUMP_OFF
#define DBG_DUMP_OFF 0
#define DBG_DUMP_N 0
#define DBG_DUMP_F32 0
#endif
#ifndef DBG_PH_HI
#define DBG_PH_HI NPHASE
#endif

typedef unsigned short bf16_t;
typedef short bf16x8 __attribute__((ext_vector_type(8)));
typedef float f32x4 __attribute__((ext_vector_type(4)));
typedef unsigned u32x4 __attribute__((ext_vector_type(4)));
typedef unsigned u32x2 __attribute__((ext_vector_type(2)));

constexpr int DM = 1024, NB = 8, SEQ = 4096, NTOK = NB * SEQ, DEPTH = 2;
constexpr int NCMP = 255;
constexpr float RMS_EPS = 1e-6f;
constexpr int NTHR = 256;
constexpr int NTHR_HW = 512;
constexpr int VB_LDS = 68096;
constexpr int LDS_BAR = 67584;
#ifndef MAX_PER_CU
#define MAX_PER_CU 1
#endif
#ifndef LDS_TOTAL
#define LDS_TOTAL (2 * 68096 + 256 + 16384)
#endif
constexpr int LDS_BYTES = LDS_TOTAL;

constexpr size_t OFF_CTL = 0;
constexpr size_t OFF_W = 65536;
constexpr size_t W_IN = 0, W_GB = 4456448, W_A = 10747904, W_S = 11796480, W_5 = 12320768, W_M = 12845056, W_GLU = 14942208,
                 W_C1 = 15073280, W_C2 = 16121856, W_PB = 16154624, W_SGU = 16155648, W_S5A = 16286720, W_S5A256 = 16294912,
                 W_S5B = 16303104, W_S5C = 16434176, W_RH = 16499712, W_RL = 16630784, W_EG = 16777216, W_EU = 50331648, W_ED = 83886080, W_END = 117440512;
constexpr size_t OFF_H = OFF_W + W_END;
constexpr float GQ_SCALE = 32.f, GQ_INV = 1.f / 32.f;
constexpr size_t OFF_XQ = OFF_H;
constexpr size_t OFF_M = OFF_H + 67108864;
constexpr size_t OFF_R = OFF_M + 67108864;
constexpr size_t R_Q = 0, R_KC = 33554432, R_VC = 41943040, R_KS = 50331648, R_KW = 58720256, R_VST = 67108864, R_VWT = 75497472,
                 R_NG = 83886080, R_U = 87031808, R_V = 103809024, R_S5IN = 120586240, R_QR = 137363456, R_END = 170917888;
constexpr size_t OFF_C = OFF_R + R_END;
constexpr size_t C_ATT = 0, C_SGU = 33554432, C_YG = 50331648, C_S5O = 67108864, C_KCMP = 83886080, C_VCT = 84410368, C_S5E = 84934656, C_END = 85983232;
constexpr size_t OFF_MOE = OFF_C + C_END;
constexpr size_t MOE_LIST = 0, MOE_WS = 4194304, MOE_RS = 4456448, MOE_END = 8650752;
constexpr size_t OFF_ROPE = OFF_MOE + MOE_END;
constexpr size_t OFF_X = OFF_ROPE + (size_t)NTOK * 64;
constexpr size_t OFF_RS1 = OFF_X + (size_t)NTOK * 2048;
constexpr size_t WS_END = OFF_RS1 + (size_t)NTOK * 4;
constexpr size_t OFF_HID = OFF_R;
constexpr size_t OFF_YS = OFF_R + 71303168;
static_assert(OFF_YS + 134217728 <= OFF_C + C_KCMP, "alias overflow");

constexpr int CTL_BAR = 0;
constexpr int CTL_MOECNT = 4096;
constexpr int CTL_ATTN = 4096 + 64;
constexpr int CTL_BYTES = 32768;

struct KP {
    const float* in[36];
    float* xbuf;
    unsigned char* ws;
    float inv_freq[8];
    int ph_lo, ph_hi;
    int never;
    int pad;
};

typedef const KP __attribute__((address_space(4))) CKP;

typedef float f32x2_t __attribute__((ext_vector_type(2)));
typedef __bf16 bf16x2_t __attribute__((ext_vector_type(2)));
__device__ __forceinline__ unsigned pk_bf16(float lo, float hi) {
    const f32x2_t v = {lo, hi};
    union { bf16x2_t b; unsigned u; } x; x.b = __builtin_convertvector(v, bf16x2_t); return x.u;
}
__device__ __forceinline__ bf16_t f2bf(float f) { return (bf16_t)(pk_bf16(f, 0.f) & 0xffffu); }
__device__ __forceinline__ float bf2f(bf16_t b) { return __uint_as_float(((unsigned)b) << 16); }
__device__ __forceinline__ float bflo(unsigned u) { return __uint_as_float(u << 16); }
__device__ __forceinline__ float bfhi(unsigned u) { return __uint_as_float(u & 0xffff0000u); }
__device__ __forceinline__ float fexp2(float x) { return __builtin_amdgcn_exp2f(x); }
__device__ __forceinline__ float gelu_tanh(float x) {
    const float u = 0.7978845608028654f * (x + 0.044715f * x * x * x);
    const float e = fexp2(2.885390081777927f * u);
    const float t = 1.f - 2.f * __builtin_amdgcn_rcpf(e + 1.f);
    return 0.5f * x * (1.f + t);
}
__device__ __forceinline__ float sigm(float x) { return __builtin_amdgcn_rcpf(1.f + fexp2(-1.4426950408889634f * x)); }
__device__ __forceinline__ unsigned char* lds_base();
__device__ __forceinline__ int lane_id() { unsigned z = 0u; asm volatile("" : "+v"(z)); return (int)__builtin_amdgcn_mbcnt_hi(~0u, __builtin_amdgcn_mbcnt_lo(~0u, z)); }
__device__ __forceinline__ int hw_wave_key() { return (int)(__builtin_amdgcn_s_getreg((5 << 11) | 4) & 63u); }
__device__ __forceinline__ int TIDX();
__device__ __forceinline__ unsigned bperm_u(int srclane, unsigned v) { return (unsigned)__builtin_amdgcn_ds_bpermute(srclane << 2, (int)v); }
__device__ __forceinline__ float bperm_f(int srclane, float v) { return __uint_as_float(bperm_u(srclane, __float_as_uint(v))); }
__device__ __forceinline__ int opaque_tid() { int t = TIDX() & 255; asm volatile("" : "+v"(t)); return t; }
__device__ __forceinline__ int VBID() { return (int)blockIdx.x * 2 + (TIDX() >> 8); }
__device__ __forceinline__ int VGRID() { return (int)gridDim.x * 2; }
constexpr int ROPE_LDS = 2 * 68096 + 256;
constexpr int VB_CTR = 2 * 68096;
__device__ __forceinline__ unsigned char* lds_base() { extern __shared__ __attribute__((aligned(16))) unsigned char lds_all_[]; return lds_all_; }
__device__ __forceinline__ int TIDX() { const int wv = __builtin_amdgcn_readfirstlane((int)*(volatile __attribute__((address_space(3))) unsigned char*)((__attribute__((address_space(3))) unsigned char*)lds_base() + VB_CTR + 192 + hw_wave_key())); return wv * 64 + lane_id(); }
__device__ __forceinline__ unsigned char* vb_lds() { int t = TIDX(); asm volatile("" : "+v"(t)); return lds_base() + (t >> 8) * VB_LDS; }
__device__ __forceinline__ void vb_sync(unsigned char* lds) {
    asm volatile("s_waitcnt lgkmcnt(0)" ::: "memory");
    if (lane_id() == 0) {
        __attribute__((address_space(3))) unsigned* c = (__attribute__((address_space(3))) unsigned*)(lds_base() + VB_CTR + ((lds != lds_base()) ? 64 : 0));
        const unsigned old = __hip_atomic_fetch_add(c, 1u, __ATOMIC_RELAXED, __HIP_MEMORY_SCOPE_WORKGROUP);
        const unsigned target = (old & ~3u) + 4u;
        while ((int)(__hip_atomic_load(c, __ATOMIC_RELAXED, __HIP_MEMORY_SCOPE_WORKGROUP) - target) < 0) { }
    }
    asm volatile("" ::: "memory");
}
__device__ __forceinline__ void job_fence() {
#if DBG_JOBFENCE
#endif
}
__device__ __forceinline__ float wave_sum(float v) {
#pragma unroll
    for (int o = 32; o >= 1; o >>= 1) v += __shfl_xor(v, o);
    return v;
}
__device__ __forceinline__ float xmax16(float x) { const unsigned u = __float_as_uint(x); auto r = __builtin_amdgcn_permlane16_swap(u, u, false, false); return fmaxf(__uint_as_float(r[0]), __uint_as_float(r[1])); }
__device__ __forceinline__ float xmax32(float x) { const unsigned u = __float_as_uint(x); auto r = __builtin_amdgcn_permlane32_swap(u, u, false, false); return fmaxf(__uint_as_float(r[0]), __uint_as_float(r[1])); }
__device__ __forceinline__ float xsum16(float x) { const unsigned u = __float_as_uint(x); auto r = __builtin_amdgcn_permlane16_swap(u, u, false, false); return __uint_as_float(r[0]) + __uint_as_float(r[1]); }
__device__ __forceinline__ float xsum32(float x) { const unsigned u = __float_as_uint(x); auto r = __builtin_amdgcn_permlane32_swap(u, u, false, false); return __uint_as_float(r[0]) + __uint_as_float(r[1]); }
__device__ __forceinline__ f32x4 mfma16(bf16x8 a, bf16x8 b, f32x4 c) { return __builtin_amdgcn_mfma_f32_16x16x32_bf16(a, b, c, 0, 0, 0); }
__device__ __forceinline__ bf16x8 as_bf8(u32x4 v) { union { u32x4 u; bf16x8 b; } x; x.u = v; return x.b; }
__device__ __forceinline__ void store16bf(bf16_t* dst, const float (&v)[16]) {
    u32x4 a, b;
    a.x = pk_bf16(v[0], v[1]); a.y = pk_bf16(v[2], v[3]); a.z = pk_bf16(v[4], v[5]); a.w = pk_bf16(v[6], v[7]);
    b.x = pk_bf16(v[8], v[9]); b.y = pk_bf16(v[10], v[11]); b.z = pk_bf16(v[12], v[13]); b.w = pk_bf16(v[14], v[15]);
    *(u32x4*)dst = a; *(u32x4*)(dst + 8) = b;
}

#ifndef XB_SCOPE
#define XB_SCOPE "agent"
#endif
#define XB_TMO      128
#define XB_XCNT(j)  (256  + 64 * (j))
#define XB_XSUB(j)  (1280 + 64 * (j))
#define XB_XGEN(j)  (2304 + 64 * (j))
#define XB_TOP      3328
#define XB_TOPGEN   3392
#define XCD_BAR_WORDS 3456
#define XB_SPIN_CAP (1u << 22)
#define LAS __attribute__((address_space(3)))
__device__ __forceinline__ unsigned xb_ld(unsigned* p)              { return __hip_atomic_load(p, __ATOMIC_RELAXED, __HIP_MEMORY_SCOPE_AGENT); }
__device__ __forceinline__ unsigned xb_add(unsigned* p, unsigned v) { return __hip_atomic_fetch_add(p, v, __ATOMIC_RELAXED, __HIP_MEMORY_SCOPE_AGENT); }
__device__ __forceinline__ unsigned xb_xcc_id() { return (unsigned)__builtin_amdgcn_s_getreg((3 << 11) | 20) & 0xFu; }
#define XB_SPIN(cond, bar) do { unsigned _sp = 0; while (cond) { __builtin_amdgcn_s_sleep(1); \
    if ((++_sp & 255u) == 0u) { if (xb_ld(&(bar)[XB_TMO])) break; if (_sp > XB_SPIN_CAP) { atomicAdd(&(bar)[XB_TMO], 1u); break; } } } } while (0)
struct XcdBarrier { unsigned* bar; unsigned x; volatile LAS unsigned* st; };
__device__ __forceinline__ XcdBarrier xcd_barrier_post(unsigned* bar, volatile LAS unsigned* st) {
    XcdBarrier b; b.bar = bar; b.x = xb_xcc_id(); b.st = st;
    if (TIDX() == 0) { st[0] = 0u; st[1] = 0u; (void)xb_add(&bar[XB_XCNT(b.x)], 1u); }
    return b;
}
__device__ __forceinline__ void xcd_barrier_complete(unsigned* bar, unsigned x, unsigned& nloc, unsigned& nx) {
    const unsigned G = gridDim.x * gridDim.y * gridDim.z;
    unsigned sum, cnt, mine, sp = 0u;
    for (;;) {
        sum = 0u; cnt = 0u; mine = 0u;
#pragma unroll
        for (unsigned j = 0; j < 16; ++j) { const unsigned c = xb_ld(&bar[XB_XCNT(j)]); sum += c; cnt += (c > 0u) ? 1u : 0u; mine = (j == x) ? c : mine; }
        if (sum == G) break;
        __builtin_amdgcn_s_sleep(1);
        if ((++sp & 255u) == 0u) { if (xb_ld(&bar[XB_TMO])) break; if (sp > XB_SPIN_CAP) { atomicAdd(&bar[XB_TMO], 1u); break; } }
    }
    nloc = mine > 0u ? mine : 1u; nx = cnt > 0u ? cnt : 1u;
}
__device__ __forceinline__ void xcd_barrier(XcdBarrier& b) {
    asm volatile("s_waitcnt vmcnt(0)" ::: "memory");
    __syncthreads();
    if (TIDX() == 0) {
        unsigned* bar = b.bar;
        __builtin_amdgcn_s_waitcnt(0);
        unsigned nloc = b.st[0], nx = b.st[1];
        if (nloc == 0u) { xcd_barrier_complete(bar, b.x, nloc, nx); b.st[0] = nloc; b.st[1] = nx; }
        const unsigned old = xb_add(&bar[XB_XSUB(b.x)], 1u);
        const unsigned gen = old / nloc;
        if (old + 1u == (gen + 1u) * nloc) {
            __builtin_amdgcn_fence(__ATOMIC_RELEASE, XB_SCOPE);
            asm volatile("s_waitcnt vmcnt(0)" ::: "memory");
            const unsigned og = xb_add(&bar[XB_TOP], 1u);
            const unsigned tg = og / nx;
            if (og + 1u == (tg + 1u) * nx) xb_add(&bar[XB_TOPGEN], 1u);
            else XB_SPIN(xb_ld(&bar[XB_TOPGEN]) == tg, bar);
            __builtin_amdgcn_fence(__ATOMIC_ACQUIRE, XB_SCOPE);
            xb_add(&bar[XB_XGEN(b.x)], 1u);
            asm volatile("s_waitcnt vmcnt(0)" ::: "memory");
        } else {
            XB_SPIN(xb_ld(&bar[XB_XGEN(b.x)]) == gen, bar);
            __builtin_amdgcn_fence(__ATOMIC_ACQUIRE, XB_SCOPE);
            asm volatile("s_waitcnt vmcnt(0)" ::: "memory");
        }
    }
    __syncthreads();
}

__device__ __forceinline__ void tile_coords(int L, int ntm, int ntn, int& tm, int& tn) {
    const int nt = ntm * ntn, q = nt >> 3, r = nt & 7, xcd = L & 7, off = L >> 3;
    const int id = (xcd < r ? xcd * (q + 1) : r * (q + 1) + (xcd - r) * q) + off;
    const int GM = 8, nig = GM * ntn, gid = id / nig, fm = gid * GM, gsz = (ntm - fm) < GM ? (ntm - fm) : GM;
    tm = fm + ((id % nig) % gsz); tn = (id % nig) / gsz;
}

template <class AP, class BP>
__device__ __forceinline__ void gemm_kloop(f32x4 (&acc)[4][4], AP ap, int a_kstep, BP bp, int b_kstep, int nkt, unsigned char* lds, int tid) {
    const int lane = tid & 63, w = tid >> 6, wm = w >> 1, wn = w & 1, fr = lane & 15, fq = lane >> 4;
    const int lr = lane >> 3, lc = (lane & 7) ^ lr;
    const bf16_t* pa[4]; const bf16_t* pb[4];
#pragma unroll
    for (int i = 0; i < 4; ++i) {
        const int row = 8 * (w + 4 * i) + lr;
        pa[i] = ap(row) + lc * 8;
        const int wn_ = row >> 6, ni_ = (row >> 4) & 3, ii = row & 15;
        pb[i] = bp(64 * wn_ + 16 * (ii >> 2) + 4 * ni_ + (ii & 3)) + lc * 8;
    }
    const int ra = (64 * wm + fr) * 128, rb = (64 * wn + fr) * 128;
    const int sw0 = ((fq) ^ (fr & 7)) << 4, sw1 = ((4 + fq) ^ (fr & 7)) << 4;
    auto issue = [&](int buf) {
#pragma unroll
        for (int i = 0; i < 4; ++i) {
            __builtin_amdgcn_global_load_lds((const unsigned*)pa[i], (unsigned*)(lds + buf * 16384 + (w + 4 * i) * 1024), 16, 0, 0);
            __builtin_amdgcn_global_load_lds((const unsigned*)pb[i], (unsigned*)(lds + 32768 + buf * 16384 + (w + 4 * i) * 1024), 16, 0, 0);
            pa[i] += a_kstep; pb[i] += b_kstep;
        }
    };
    auto compute = [&](int buf) {
        const unsigned char* A = lds + buf * 16384;
        const unsigned char* B = lds + 32768 + buf * 16384;
#pragma unroll
        for (int ks = 0; ks < 2; ++ks) {
            const int sw = ks ? sw1 : sw0;
            bf16x8 af[4], bf[4];
#pragma unroll
            for (int mi = 0; mi < 4; ++mi) af[mi] = *(const bf16x8*)(A + ra + mi * 2048 + sw);
#pragma unroll
            for (int ni = 0; ni < 4; ++ni) bf[ni] = *(const bf16x8*)(B + rb + ni * 2048 + sw);
#pragma unroll
            for (int mi = 0; mi < 4; ++mi)
#pragma unroll
                for (int ni = 0; ni < 4; ++ni) acc[mi][ni] = mfma16(bf[ni], af[mi], acc[mi][ni]);
        }
    };
    vb_sync(lds);
    issue(0);
    asm volatile("s_waitcnt vmcnt(0)" ::: "memory");
    vb_sync(lds);
#pragma unroll 1
    for (int kt = 0; kt < nkt; ++kt) {
        const int cur = kt & 1;
        if (kt + 1 < nkt) issue(cur ^ 1);
        compute(cur);
        asm volatile("s_waitcnt vmcnt(0)" ::: "memory");
        vb_sync(lds);
    }
}
__device__ __forceinline__ void zero_acc(f32x4 (&acc)[4][4]) {
#pragma unroll
    for (int i = 0; i < 4; ++i)
#pragma unroll
        for (int j = 0; j < 4; ++j) acc[i][j] = (f32x4){0.f, 0.f, 0.f, 0.f};
}

constexpr int G8_HTB = 16384;
__device__ __forceinline__ int g8_lds_byte(int r, int c) { const int st = (r >> 4) * 2 + (c >> 5), rr = r & 15, cc = c & 31, ob = rr * 64 + cc * 2; return st * 1024 + (ob ^ (((ob >> 9) & 1) << 5)); }
__device__ __forceinline__ void g8_stage_rc(int b, int& R, int& C) { const int st = b / 1024, sb = b % 1024, swz = sb ^ (((sb >> 9) & 1) << 5); R = (st >> 1) * 16 + swz / 64; C = (st & 1) * 32 + (swz % 64) / 2; }
__device__ __forceinline__ int g8_perm32(int rho) { const int n = rho >> 4, i = rho & 15; return 8 * (i >> 2) + 4 * n + (i & 3); }
struct G8Unit {
    const char* A0; const char* A1; const char* B0; const char* B1;
    unsigned K2;
    int nt;
    int x0, x1, x2, x3, n;
    int f8;
    unsigned ao[2][2];
};
typedef f32x4 G8Acc[2][2][4][2];
typedef int i32x4 __attribute__((ext_vector_type(4)));
typedef int i32x8 __attribute__((ext_vector_type(8)));
template <class Sched, class Epi>
__device__ __forceinline__ void g8_phase(Sched& S, Epi& E) {
    LAS unsigned char* lds = (LAS unsigned char*)lds_base();
    int tid = TIDX(); asm volatile("" : "+v"(tid));
    const int wid = __builtin_amdgcn_readfirstlane(tid >> 6), lane = tid & 63, wr = wid >> 2, wc = wid & 3, fr = lane & 15, fq = lane >> 4;
#define G8_GEOM(R, C2, Rb) int R[2]; unsigned C2[2], Rb[2]; { int _t = TIDX(); asm volatile("" : "+v"(_t)); _Pragma("unroll") for (int _i = 0; _i < 2; ++_i) { int _r, _c; g8_stage_rc(_t * 16 + _i * 8192, _r, _c); \
        R[_i] = _r; C2[_i] = (unsigned)_c * 2u; Rb[_i] = (unsigned)((_r & ~31) + g8_perm32(_r & 31)); } }
    const unsigned ldsw = (unsigned)wid * 1024u;
#define G8_SA(b, h) (((b) * 2 + (h)) * G8_HTB)
#define G8_SB(b, h) ((4 + (b) * 2 + (h)) * G8_HTB)
#define G8_STAGE(bufoff, gbase, voff) do { _Pragma("unroll") for (int _i = 0; _i < 2; ++_i) { unsigned _o = (voff)[_i]; asm volatile("" : "+v"(_o)); \
        __builtin_amdgcn_global_load_lds((const unsigned*)((const char*)(gbase) + _o), (LAS unsigned*)(lds + (bufoff) + ldsw + _i * 8192), 16, 0, 0); } } while (0)
#define G8_BOFF(u, bo) do { _Pragma("unroll") for (int _i = 0; _i < 2; ++_i) bo[_i] = __umul24(Rb_[_i], (u).K2) + C2_[_i]; } while (0)
#define G8_CAT(lo, hi) __builtin_shufflevector((lo), (hi), 0, 1, 2, 3, 4, 5, 6, 7)
#define G8_LO(x) __builtin_bit_cast(bf16x8, __builtin_shufflevector((x), (x), 0, 1, 2, 3))
#define G8_HI(x) __builtin_bit_cast(bf16x8, __builtin_shufflevector((x), (x), 4, 5, 6, 7))
#define G8_LDA(dst, b, h) do { _Pragma("unroll") for (int m = 0; m < 4; ++m) dst[m] = G8_CAT(*(const LAS i32x4*)(lds + G8_SA(b, h) + ra0 + m * 2048), *(const LAS i32x4*)(lds + G8_SA(b, h) + ra1 + m * 2048)); } while (0)
#define G8_LDB(dst, b, h) do { _Pragma("unroll") for (int n = 0; n < 2; ++n) dst[n] = G8_CAT(*(const LAS i32x4*)(lds + G8_SB(b, h) + rb0 + n * 2048), *(const LAS i32x4*)(lds + G8_SB(b, h) + rb1 + n * 2048)); } while (0)
#define G8_MMA(ai, bj, At, Bt) do { __builtin_amdgcn_s_setprio(1); \
        if constexpr (F8) { _Pragma("unroll") for (int m = 0; m < 4; ++m) _Pragma("unroll") for (int n = 0; n < 2; ++n) \
            acc[ai][bj][m][n] = __builtin_amdgcn_mfma_scale_f32_16x16x128_f8f6f4(Bt[n], At[m], acc[ai][bj][m][n], 0, 0, 0, 0, 0, 0); } \
        else { _Pragma("unroll") for (int m = 0; m < 4; ++m) _Pragma("unroll") for (int n = 0; n < 2; ++n) { \
            acc[ai][bj][m][n] = __builtin_amdgcn_mfma_f32_16x16x32_bf16(G8_LO(Bt[n]), G8_LO(At[m]), acc[ai][bj][m][n], 0, 0, 0); \
            acc[ai][bj][m][n] = __builtin_amdgcn_mfma_f32_16x16x32_bf16(G8_HI(Bt[n]), G8_HI(At[m]), acc[ai][bj][m][n], 0, 0, 0); } } \
        __builtin_amdgcn_s_setprio(0); } while (0)
#define G8_WAIT_V(n) asm volatile("s_waitcnt vmcnt(" #n ")" ::: "memory")
#define G8_WAIT_L(n) asm volatile("s_waitcnt lgkmcnt(" #n ")" ::: "memory")
#define G8_BAR __builtin_amdgcn_s_barrier()
#define G8_SCHED __builtin_amdgcn_sched_barrier(0)
    G8Unit cur, nxt; int ui = 0; unsigned cbo[2], nbo[2];
    { G8_GEOM(R_, C2_, Rb_) if (!S.next(0, cur, R_, C2_)) return; G8_BOFF(cur, cbo); }
    G8Acc acc;
#pragma unroll
    for (int a = 0; a < 2; ++a)
#pragma unroll
        for (int b = 0; b < 2; ++b)
#pragma unroll
            for (int m = 0; m < 4; ++m)
#pragma unroll
                for (int n = 0; n < 2; ++n) acc[a][b][m][n] = (f32x4){0.f, 0.f, 0.f, 0.f};
    G8_STAGE(G8_SB(0, 0), cur.B0, cbo); G8_STAGE(G8_SA(0, 0), cur.A0, cur.ao[0]); G8_STAGE(G8_SB(0, 1), cur.B1, cbo); G8_STAGE(G8_SA(0, 1), cur.A1, cur.ao[1]);
    if (wr == 1) G8_BAR;
    G8_WAIT_V(4); G8_BAR;
    G8_STAGE(G8_SB(1, 0), cur.B0 + 128, cbo); G8_STAGE(G8_SA(1, 0), cur.A0 + 128, cur.ao[0]); G8_STAGE(G8_SB(1, 1), cur.B1 + 128, cbo);
    G8_WAIT_V(6); G8_BAR;
    for (;;) {
        bool has_next;
        { G8_GEOM(R_, C2_, Rb_) has_next = S.next(ui + 1, nxt, R_, C2_);
          if (!has_next) nxt = cur;
          G8_BOFF(nxt, nbo); }
        const int nt = cur.nt;
        auto kloop = [&](auto f8c) {
        constexpr bool F8 = decltype(f8c)::value;
        i32x8 At[4], B0[2], B1[2];
        int ra0, ra1, rb0, rb1;
        { int t2 = TIDX(); asm volatile("" : "+v"(t2)); const int w2 = t2 >> 6, fr2 = t2 & 15, fq2 = (t2 >> 4) & 3, ce = fq2 * 8;
          ra0 = g8_lds_byte((w2 >> 2) * 64 + fr2, ce); rb0 = g8_lds_byte((w2 & 3) * 32 + fr2, ce); ra1 = ra0 + 1024; rb1 = rb0 + 1024; }
#pragma unroll 1
        for (int t = 0; t < nt; t += 2) {
            const bool last = (t == nt - 2);
            const size_t k1 = (size_t)(t + 1) * 128, k2 = (size_t)(t + 2) * 128;
            const char* a2h0 = last ? nxt.A0 : cur.A0 + k2; const char* a2h1 = last ? nxt.A1 : cur.A1 + k2;
            const char* b2h0 = last ? nxt.B0 : cur.B0 + k2; const char* b2h1 = last ? nxt.B1 : cur.B1 + k2;
            unsigned ao0[2], ao1[2], bo2[2];
#pragma unroll
            for (int i = 0; i < 2; ++i) { ao0[i] = last ? nxt.ao[0][i] : cur.ao[0][i]; ao1[i] = last ? nxt.ao[1][i] : cur.ao[1][i]; bo2[i] = last ? nbo[i] : cbo[i]; }
            G8_LDB(B0, 0, 0); G8_SCHED; G8_LDA(At, 0, 0); G8_STAGE(G8_SA(1, 1), cur.A1 + k1, cur.ao[1]);
            G8_WAIT_L(8); G8_BAR; G8_WAIT_L(0); G8_MMA(0, 0, At, B0); G8_BAR; G8_SCHED;
            G8_LDB(B1, 0, 1); G8_STAGE(G8_SB(0, 0), b2h0, bo2);
            G8_BAR; G8_WAIT_L(0); G8_MMA(0, 1, At, B1); G8_BAR;
            G8_LDA(At, 0, 1); G8_STAGE(G8_SA(0, 0), a2h0, ao0);
            G8_BAR; G8_WAIT_L(0); G8_MMA(1, 0, At, B0); G8_BAR; G8_SCHED;
            G8_STAGE(G8_SB(0, 1), b2h1, bo2);
            G8_WAIT_V(6); G8_BAR; G8_MMA(1, 1, At, B1); G8_BAR;
            G8_LDB(B0, 1, 0); G8_SCHED; G8_LDA(At, 1, 0); G8_STAGE(G8_SA(0, 1), a2h1, ao1);
            G8_WAIT_L(8); G8_BAR; G8_WAIT_L(0); G8_MMA(0, 0, At, B0); G8_BAR; G8_SCHED;
            G8_LDB(B1, 1, 1); G8_STAGE(G8_SB(1, 0), b2h0 + 128, bo2);
            G8_BAR; G8_WAIT_L(0); G8_MMA(0, 1, At, B1); G8_BAR;
            G8_LDA(At, 1, 1); G8_STAGE(G8_SA(1, 0), a2h0 + 128, ao0);
            G8_BAR; G8_WAIT_L(0); G8_MMA(1, 0, At, B0); G8_BAR; G8_SCHED;
            G8_STAGE(G8_SB(1, 1), b2h1 + 128, bo2);
            G8_WAIT_V(6); G8_BAR; G8_MMA(1, 1, At, B1); G8_BAR;
        }
        };
        if (Sched::HAS_F8 && cur.f8 != 0) kloop(std::true_type{}); else kloop(std::false_type{});
        { int t_ = TIDX(); asm volatile("" : "+v"(t_)); const int w_ = __builtin_amdgcn_readfirstlane(t_ >> 6); E(acc, cur, w_ >> 2, w_ & 3, t_ & 15, (t_ >> 4) & 3); }
        if (!has_next) break;
#pragma unroll
        for (int a = 0; a < 2; ++a)
#pragma unroll
            for (int b = 0; b < 2; ++b)
#pragma unroll
                for (int m = 0; m < 4; ++m)
#pragma unroll
                    for (int n = 0; n < 2; ++n) acc[a][b][m][n] = (f32x4){0.f, 0.f, 0.f, 0.f};
        cur = nxt; ++ui; cbo[0] = nbo[0]; cbo[1] = nbo[1];
    }
    G8_WAIT_V(0);
    if (wr == 0) G8_BAR;
    G8_BAR;
}
struct G8Plain {
    static constexpr bool GATHER = false, HAS_F8 = false;
    const char* A; const char* B; unsigned K2; int nt, nM, nN;
    __device__ __forceinline__ bool next(int i, G8Unit& u, const int (&R)[2], const unsigned (&C2)[2]) const {
        const int L = i * (int)gridDim.x + (int)blockIdx.x; if (L >= nM * nN) return false;
        int pm, pn; tile_coords(L, nM, nN, pm, pn); pm = __builtin_amdgcn_readfirstlane(pm); pn = __builtin_amdgcn_readfirstlane(pn);
        u.A0 = A + (size_t)pm * 256 * K2; u.A1 = u.A0 + (size_t)128 * K2; u.B0 = B + (size_t)pn * 256 * K2; u.B1 = u.B0 + (size_t)128 * K2;
        u.K2 = K2; u.nt = nt; u.x0 = pm; u.x1 = pn; u.x2 = 0; u.x3 = 0;
#pragma unroll
        for (int h = 0; h < 2; ++h)
#pragma unroll
            for (int k = 0; k < 2; ++k) u.ao[h][k] = __umul24((unsigned)R[k], u.K2) + C2[k];
        return true;
    }
};

__device__ __forceinline__ void convert_tiles(CKP& p, int l, int e_lo, int e_hi, int first, int stride, int lane) {
    unsigned char* W = p.ws + OFF_W;
    struct E { const float* src; bf16_t* dst; int R, C, nd, mode, nbatch; };
    const int NE = e_hi;
        for (int L = first;; L += stride) {
            int rem = L; int e = e_lo; E d{};
            for (; e < NE; ++e) {
                switch (e) {
                    case 0: d = {p.in[3] + (size_t)l * 1024 * 5144, (bf16_t*)(W + W_IN), 1024, 5144, 2176, 1, 1}; break;
                    case 1: d = {p.in[3] + (size_t)l * 1024 * 5144, (bf16_t*)(W + W_GB), 1024, 5144, 3072, 2, 1}; break;
                    case 2: d = {p.in[10] + (size_t)l * 512 * 1024, (bf16_t*)(W + W_A), 512, 1024, 1024, 0, 1}; break;
                    case 3: d = {p.in[14] + (size_t)l * 256 * 1024, (bf16_t*)(W + W_S), 256, 1024, 1024, 0, 1}; break;
                    case 4: d = {p.in[25] + (size_t)l * 256 * 1024, (bf16_t*)(W + W_5), 256, 1024, 1024, 0, 1}; break;
                    case 5: d = {p.in[26] + (size_t)l * 1024 * 1024, (bf16_t*)(W + W_M), 1024, 1024, 1024, 0, 1}; break;
                    case 6: d = {p.in[23] + (size_t)l * 256 * 256, (bf16_t*)(W + W_GLU), 256, 256, 256, 0, 1}; break;
                    case 7: d = {p.in[6] + (size_t)l * 2048 * 128, (bf16_t*)(W + W_C1), 2048, 128, 128, 0, 1}; break;
                    case 8: d = {p.in[8] + (size_t)l * 2048 * 128, (bf16_t*)(W + W_C1) + 128 * 2048, 2048, 128, 128, 0, 1}; break;
                    case 9: d = {p.in[7] + (size_t)l * 128 * 64, (bf16_t*)(W + W_C2), 128, 64, 64, 0, 1}; break;
                    case 10: d = {p.in[9] + (size_t)l * 128 * 64, (bf16_t*)(W + W_C2) + 64 * 128, 128, 64, 64, 0, 1}; break;
                    case 11: d = {p.in[32] + (size_t)l * 32 * 1024 * 512, (bf16_t*)(W + W_EG), 1024, 512, 512, 3, 32}; break;
                    case 12: d = {p.in[33] + (size_t)l * 32 * 1024 * 512, (bf16_t*)(W + W_EU), 1024, 512, 512, 3, 32}; break;
                    default: d = {p.in[34] + (size_t)l * 32 * 512 * 1024, (bf16_t*)(W + W_ED), 512, 1024, 1024, 0, 32}; break;
                }
                const int per = (d.R >> 6) * (d.nd >> 6), tot = per * d.nbatch;
                if (rem < tot) break;
                rem -= tot;
            }
            if (e >= NE) break;
            const int per = (d.R >> 6) * (d.nd >> 6), bi = rem / per, t = rem % per, ntn = d.nd >> 6;
            const int k0 = (t / ntn) * 64, n = (t % ntn) * 64 + lane;
            int col = n;
            if (d.mode == 1) col = (n < 1280) ? n : ((n < 2048) ? n + 24 : ((n < 2072) ? n - 768 : -1));
            else if (d.mode == 2) col = n + 2072;
            const float* sp = d.src + (size_t)bi * d.R * d.C + (size_t)k0 * d.C + (col >= 0 ? col : 0);
            float v[64];
#pragma unroll
            for (int i = 0; i < 64; ++i) v[i] = sp[(size_t)i * d.C];
            if (d.mode == 1 || d.mode == 2) {
                const float* g1 = p.in[2] + (size_t)l * 1024 + k0;
#pragma unroll
                for (int i = 0; i < 64; ++i) v[i] *= g1[i];
            }
            if (d.mode == 3) {
                const float* g2 = p.in[27] + (size_t)l * 1024 + k0;
#pragma unroll
                for (int i = 0; i < 64; ++i) v[i] *= g2[i];
            }
            if (col < 0) {
#pragma unroll
                for (int i = 0; i < 64; ++i) v[i] = 0.f;
            }
            if (d.mode == 2) {
                unsigned char* dq = (unsigned char*)d.dst + (size_t)n * d.R + k0;
#pragma unroll
                for (int q = 0; q < 4; ++q) {
                    unsigned wds[4];
#pragma unroll
                    for (int j = 0; j < 4; ++j) {
                        int wd = 0;
                        wd = __builtin_amdgcn_cvt_pk_fp8_f32(v[16 * q + 4 * j] * GQ_SCALE, v[16 * q + 4 * j + 1] * GQ_SCALE, wd, false);
                        wd = __builtin_amdgcn_cvt_pk_fp8_f32(v[16 * q + 4 * j + 2] * GQ_SCALE, v[16 * q + 4 * j + 3] * GQ_SCALE, wd, true);
                        wds[j] = (unsigned)wd;
                    }
                    *(u32x4*)(dq + 16 * q) = (u32x4){wds[0], wds[1], wds[2], wds[3]};
                }
                continue;
            }
            bf16_t* dp = d.dst + (size_t)bi * d.R * d.nd + (size_t)n * d.R + k0;
#pragma unroll
            for (int q = 0; q < 8; ++q) {
                u32x4 o;
                o.x = pk_bf16(v[8 * q], v[8 * q + 1]); o.y = pk_bf16(v[8 * q + 2], v[8 * q + 3]);
                o.z = pk_bf16(v[8 * q + 4], v[8 * q + 5]); o.w = pk_bf16(v[8 * q + 6], v[8 * q + 7]);
                *(u32x4*)(dp + 8 * q) = o;
            }
        }
}

__device__ __forceinline__ void phase_prep(CKP& p, int l, unsigned char* lds) {
    const int tid = opaque_tid(), G = VGRID(), lane = tid & 63, w = tid >> 6;
    unsigned char* W = p.ws + OFF_W;
    if (l < DEPTH) {
        convert_tiles(p, l, 0, 11, VBID() * 4 + w, G * 4, lane);
        const int gt = VBID() * NTHR + tid, gs = G * NTHR;
        if (l == 0) {
            const int* pos = (const int*)p.in[1]; float* rt = (float*)(p.ws + OFF_ROPE);
            for (int i = gt; i < NTOK * 8; i += gs) { float sn, cs; sincosf((float)pos[i >> 3] * p.inv_freq[i & 7], &sn, &cs); rt[(i >> 3) * 16 + (i & 7)] = cs; rt[(i >> 3) * 16 + 8 + (i & 7)] = sn; }
        }
        {
            const float* sw = p.in[12] + (size_t)l * 4 * 128 * 128; bf16_t* o = (bf16_t*)(W + W_SGU);
            for (int i = gt; i < 65536; i += gs) { const int t = (i >> 7) & 127, s = i & 127; o[i] = f2bf(s <= t ? sw[i] : 0.f); }
        }
        {
            const float* are = p.in[15] + l * 1024; const float* aim = p.in[16] + l * 1024; const float* ls = p.in[17] + l * 16;
            const float* bre = p.in[18] + (size_t)l * 16384; const float* bim = p.in[19] + (size_t)l * 16384;
            float* oa = (float*)(W + W_S5A); float* oa2 = (float*)(W + W_S5A256); float* ob = (float*)(W + W_S5B);
            for (int i = gt; i < 1024; i += gs) {
                const int g = i >> 6;
                const float step = expf(ls[g]), ar = are[i], ai = aim[i];
                const float mag = expf(ar * step); float sn, cs; sincosf(ai * step, &sn, &cs);
                const float abr = mag * cs, abi = mag * sn;
                const float den = ar * ar + ai * ai, nr = abr - 1.f, ni = abi;
                const float cr = (nr * ar + ni * ai) / den, ci = (ni * ar - nr * ai) / den;
                oa[i * 2] = abr; oa[i * 2 + 1] = abi;
                float pr = abr, pi = abi;
                for (int s = 0; s < 8; ++s) { const float nr2 = pr * pr - pi * pi, ni2 = 2.f * pr * pi; pr = nr2; pi = ni2; }
                oa2[i * 2] = pr; oa2[i * 2 + 1] = pi;
                for (int h = 0; h < 16; ++h) {
                    const float br = bre[i * 16 + h], bi_ = bim[i * 16 + h];
                    ob[i * 32 + h] = cr * br - ci * bi_;
                    ob[i * 32 + 16 + h] = cr * bi_ + ci * br;
                }
            }
            const float* cre = p.in[20] + (size_t)l * 16384; const float* cim = p.in[21] + (size_t)l * 16384; bf16_t* oc = (bf16_t*)(W + W_S5C);
            for (int i = gt; i < 32768; i += gs) {
                const int k = i & 127, gh = i >> 7;
                oc[i] = f2bf(k < 64 ? cre[gh * 64 + k] : -cim[gh * 64 + (k - 64)]);
            }
        }
        {
            const float* wg = p.in[28] + (size_t)l * 1024 * 4; const float* we = p.in[30] + (size_t)l * 1024 * 32;
            bf16_t* oh = (bf16_t*)(W + W_RH); bf16_t* ol = (bf16_t*)(W + W_RL);
            for (int i = gt; i < 65536; i += gs) {
                const int n = i >> 10, k = i & 1023;
                const float v = ((n < 4) ? wg[k * 4 + n] : ((n < 36) ? we[k * 32 + (n - 4)] : 0.f)) * p.in[27][(size_t)l * 1024 + k];
                const bf16_t h = f2bf(v);
                oh[i] = h; ol[i] = f2bf(v - bf2f(h));
            }
        }
        {
            float* pb = (float*)(W + W_PB);
            for (int j = VBID() * 4 + w; j < 256; j += G * 4) {
                const int kv = j >> 7, n = j & 127;
                const float* pos = p.in[kv ? 5 : 4] + (size_t)l * 2048; const float* w1 = p.in[kv ? 8 : 6] + (size_t)l * 2048 * 128;
                float s = 0.f;
                for (int k = lane; k < 2048; k += 64) s += pos[k] * w1[(size_t)k * 128 + n];
                s = wave_sum(s);
                if (lane == 0) pb[j] = s;
            }
        }
    }
    {
        const float* gam = (l < DEPTH) ? (p.in[2] + (size_t)l * 1024) : p.in[35];
        bf16_t* hb = (bf16_t*)(p.ws + OFF_H);
        const bf16_t* ys = (const bf16_t*)(p.ws + OFF_YS);
        bf16_t* xres = (bf16_t*)(p.ws + OFF_X);
        f32x4 gv[4];
#pragma unroll
        for (int i = 0; i < 4; ++i) gv[i] = *(const f32x4*)(gam + 4 * lane + 256 * i);
        for (int row = VBID() * 4 + w; row < NTOK; row += G * 4) {
            f32x4 xv[4]; float ss = 0.f;
#pragma unroll
            for (int i = 0; i < 4; ++i) {
                const int col = 4 * lane + 256 * i;
                if (l == 0) xv[i] = *(const f32x4*)(p.in[0] + (size_t)row * 1024 + col);
                else {
                    { const u32x2 xx = *(const u32x2*)(xres + (size_t)row * 1024 + col); xv[i] = (f32x4){bflo(xx.x), bfhi(xx.x), bflo(xx.y), bfhi(xx.y)}; }
                    const u32x2 y0 = *(const u32x2*)(ys + (size_t)(2 * row) * 1024 + col), y1 = *(const u32x2*)(ys + (size_t)(2 * row + 1) * 1024 + col);
                    xv[i][0] += bflo(y0.x) + bflo(y1.x); xv[i][1] += bfhi(y0.x) + bfhi(y1.x);
                    xv[i][2] += bflo(y0.y) + bflo(y1.y); xv[i][3] += bfhi(y0.y) + bfhi(y1.y);
                }
                ss += xv[i][0] * xv[i][0] + xv[i][1] * xv[i][1] + xv[i][2] * xv[i][2] + xv[i][3] * xv[i][3];
            }
            ss = wave_sum(ss);
            const float rstd = rsqrtf(ss * (1.f / 1024.f) + RMS_EPS);
#pragma unroll
            for (int i = 0; i < 4; ++i) {
                const int col = 4 * lane + 256 * i;
                f32x4 hn = xv[i] * rstd * gv[i];
                if (l < DEPTH) {
                    { u32x2 xo; xo.x = pk_bf16(xv[i][0], xv[i][1]); xo.y = pk_bf16(xv[i][2], xv[i][3]); *(u32x2*)(xres + (size_t)row * 1024 + col) = xo; }
                    if (i == 0 && lane == 0) ((float*)(p.ws + OFF_RS1))[row] = rstd;
                    { int wd = 0; wd = __builtin_amdgcn_cvt_pk_fp8_f32(xv[i][0] * rstd, xv[i][1] * rstd, wd, false); wd = __builtin_amdgcn_cvt_pk_fp8_f32(xv[i][2] * rstd, xv[i][3] * rstd, wd, true);
                      *(unsigned*)(p.ws + OFF_XQ + (size_t)row * 1024 + col) = (unsigned)wd; }
                } else {
#if DBG_TIMEPH >= 0
                    { const unsigned long long* ts = (const unsigned long long*)(p.ws + OFF_CTL + 24576);
                      const float dt_us = (float)(ts[DBG_TIMEPH2] - ts[DBG_TIMEPH]) * 0.01f; hn = hn * (1.f + 1e-3f * dt_us); }
#endif
                    *(f32x4*)(p.xbuf + (size_t)row * 1024 + col) = hn;
                }
            }
        }
    }
}

struct EpiInproj {
    unsigned char* Rb_; const float* rope; const float* rs1;
    __device__ __forceinline__ void operator()(const G8Acc& acc, const G8Unit& u, int wr, int wc, int fr, int fq) const {
        unsigned char* R = Rb_;
        if (u.x1 < 2 || u.x1 == 3 || u.x1 == 4) {
            int t = TIDX(); asm volatile("" : "+v"(t));
            const char* src = (const char*)rope + (size_t)u.x0 * 16384 + t * 16;
            unsigned char* lb = lds_base() + ROPE_LDS + (t >> 6) * 1024;
#pragma unroll
            for (int j = 0; j < 2; ++j) __builtin_amdgcn_global_load_lds((const unsigned*)(src + j * 8192), (unsigned*)(lb + j * 8192), 16, 0, 0);
            asm volatile("s_waitcnt vmcnt(0)" ::: "memory");
            __syncthreads();
        }
        const LAS float* ropel = (const LAS float*)(lds_base() + ROPE_LDS);
        float rsv[2][4];
#pragma unroll
        for (int ai = 0; ai < 2; ++ai)
#pragma unroll
            for (int m = 0; m < 4; ++m) rsv[ai][m] = rs1[u.x0 * 256 + ai * 128 + wr * 64 + m * 16 + fr];
#pragma unroll
        for (int bj = 0; bj < 2; ++bj) {
            const int tn = u.x1 * 2 + bj;
            const int cl = 32 * wc + 8 * fq;
            const bool roped = (tn < 4) || tn == 6 || tn == 8;
#pragma unroll
            for (int ai = 0; ai < 2; ++ai) {
#pragma unroll
              for (int mh = 0; mh < 2; ++mh) {
                f32x4 rc0[4], rc1[4], rs0[4], rs1_[4];
                if (roped && !(wc & 1) && fq < 2) {
#pragma unroll
                    for (int m = 2 * mh; m < 2 * mh + 2; ++m) {
                        const LAS float* rt = ropel + (ai * 128 + wr * 64 + m * 16 + fr) * 16;
                        rc0[m] = *(const LAS f32x4*)rt; rc1[m] = *(const LAS f32x4*)(rt + 4); rs0[m] = *(const LAS f32x4*)(rt + 8); rs1_[m] = *(const LAS f32x4*)(rt + 12);
                    }
                }
#pragma unroll
                for (int m = 2 * mh; m < 2 * mh + 2; ++m) {
                    const int row = u.x0 * 256 + ai * 128 + wr * 64 + m * 16 + fr;
                    float v[8];
#pragma unroll
                    for (int e = 0; e < 8; ++e) v[e] = acc[ai][bj][m][e >> 2][e & 3] * rsv[ai][m];
                    if (tn < 4) { u32x4 o; o.x = pk_bf16(v[0], v[1]); o.y = pk_bf16(v[2], v[3]); o.z = pk_bf16(v[4], v[5]); o.w = pk_bf16(v[6], v[7]);
                                  *(u32x4*)((bf16_t*)(R + R_Q) + (size_t)row * 512 + tn * 128 + cl) = o; }
                    if (roped && !(wc & 1)) {
                        float xo[8];
#pragma unroll
                        for (int i = 0; i < 8; ++i) xo[i] = __shfl_xor(v[i], 16);
                        if (fq < 2) {
                            const f32x4 c0 = rc0[m], c1 = rc1[m], s0 = rs0[m], s1 = rs1_[m];
#pragma unroll
                            for (int i = 0; i < 8; ++i) {
                                const float cs = i < 4 ? c0[i & 3] : c1[i & 3], sn = i < 4 ? s0[i & 3] : s1[i & 3];
                                v[i] = fq == 0 ? (v[i] * cs - xo[i] * sn) : (v[i] * cs + xo[i] * sn);
                            }
                        }
                    }
                    u32x4 o; o.x = pk_bf16(v[0], v[1]); o.y = pk_bf16(v[2], v[3]); o.z = pk_bf16(v[4], v[5]); o.w = pk_bf16(v[6], v[7]);
                    if (tn < 4) *(u32x4*)((bf16_t*)(R + R_QR) + (size_t)row * 512 + tn * 128 + cl) = o;
                    else if (tn == 7 || tn == 9) {
                        bf16_t* dst = (bf16_t*)(R + (tn == 7 ? R_VST : R_VWT));
                        const int b = row >> 12, s_ = row & 4095, g = wc >> 1, d0 = 32 * (wc & 1) + 8 * fq;
#pragma unroll
                        for (int e = 0; e < 8; ++e) dst[((size_t)((b * 2 + g) * 64 + d0 + e)) * SEQ + s_] = f2bf(v[e]);
                    } else if (tn < 10) {
                        const size_t off = (tn == 4) ? R_KC : (tn == 5) ? R_VC : (tn == 6) ? R_KS : R_KW;
                        *(u32x4*)((bf16_t*)(R + off) + (size_t)row * 128 + cl) = o;
                    } else if (tn < 14) {
#pragma unroll
                        for (int e = 0; e < 8; ++e) v[e] = gelu_tanh(v[e]);
                        u32x4 og; og.x = pk_bf16(v[0], v[1]); og.y = pk_bf16(v[2], v[3]); og.z = pk_bf16(v[4], v[5]); og.w = pk_bf16(v[6], v[7]);
                        const int c512 = (tn - 10) * 128 + cl;
                        if (c512 < 256) *(u32x4*)((bf16_t*)(R + R_U) + (size_t)row * 256 + c512) = og;
                        else *(u32x4*)((bf16_t*)(R + R_V) + (size_t)row * 256 + (c512 - 256)) = og;
                    } else {
                        *(u32x4*)((bf16_t*)(R + R_S5IN) + (size_t)row * 256 + (tn - 14) * 128 + cl) = o;
                    }
                }
              }
            }
        }
    }
};
__device__ __forceinline__ void phase_inproj(CKP& p, int l, unsigned char* lds) {
    {
        G8Plain S{(const char*)(p.ws + OFF_X), (const char*)(p.ws + OFF_W + W_IN), 2048u, 16, NTOK / 256, 8};
        EpiInproj E{p.ws + OFF_R, (const float*)(p.ws + OFF_ROPE), (const float*)(p.ws + OFF_RS1)};
        g8_phase(S, E);
    }
    const int tid = opaque_tid(), lane = tid & 63, w = tid >> 6, wm = w >> 1, wn = w & 1, fr = lane & 15, fq = lane >> 4;
    const int half = TIDX() >> 8;
    const bf16_t* A = (const bf16_t*)(p.ws + OFF_X);
    const float* rs1 = (const float*)(p.ws + OFF_RS1);
    const bf16_t* Bt = (const bf16_t*)(p.ws + OFF_W + W_IN) + (size_t)2048 * 1024;
    unsigned char* R = p.ws + OFF_R;
    float* xch = (float*)(lds_base() + VB_LDS);
    for (int tm = blockIdx.x; tm < NTOK / 128; tm += gridDim.x) {
        const int m0 = tm * 128;
        f32x4 acc[4][4]; zero_acc(acc);
        gemm_kloop(acc, [&](int r) { return A + (size_t)(m0 + r) * 1024 + half * 512; }, 64, [&](int v) { return Bt + (size_t)v * 1024 + half * 512; }, 64, 8, lds, tid);
        __syncthreads();
        if (half == 1 && wn == 0 && fq < 2) {
#pragma unroll
            for (int mi = 0; mi < 4; ++mi) {
                const int r = 64 * wm + 16 * mi + fr;
#pragma unroll
                for (int ni = 0; ni < 4; ++ni) *(f32x4*)(xch + r * 32 + 16 * fq + 4 * ni) = acc[mi][ni];
            }
        }
        __syncthreads();
        if (half == 0 && wn == 0 && fq < 2) {
#pragma unroll
            for (int mi = 0; mi < 4; ++mi) {
                const int r = 64 * wm + 16 * mi + fr;
                float* ng = (float*)(R + R_NG) + (size_t)(m0 + r) * 24 + 16 * fq;
#pragma unroll
                for (int ni = 0; ni < 4; ++ni) {
                    const f32x4 o = *(const f32x4*)(xch + r * 32 + 16 * fq + 4 * ni);
#pragma unroll
                    for (int j = 0; j < 4; ++j) if (16 * fq + 4 * ni + j < 24) ng[4 * ni + j] = sigm((acc[mi][ni][j] + o[j]) * rs1[m0 + r]);
                }
            }
        }
        __syncthreads();
    }
}

__device__ __forceinline__ void compress_tile(CKP& p, int job, unsigned char* lds) {
    job_fence();
    const int tid = opaque_tid(), lane = tid & 63, w = tid >> 6, wm = w >> 1, wn = w & 1, fr = lane & 15, fq = lane >> 4;
    const int kv = job >> 5, tm = job & 31, m0 = tm * 128;
    unsigned char* W = p.ws + OFF_W;
    const bf16_t* src = (const bf16_t*)(p.ws + OFF_R + (kv ? R_VC : R_KC));
    const bf16_t* W1 = (const bf16_t*)(W + W_C1) + (size_t)kv * 128 * 2048;
    const bf16_t* W2 = (const bf16_t*)(W + W_C2) + (size_t)kv * 64 * 128;
    const float* pb = (const float*)(W + W_PB) + kv * 128;
    f32x4 acc[4][4]; zero_acc(acc);
    int t512 = TIDX(); asm volatile("" : "+v"(t512));
    const int half = t512 >> 8;
    gemm_kloop(acc, [&](int r) { int Rr = m0 + r; Rr = Rr < 4080 ? Rr : 4079; const int b = Rr / 510, rem = Rr % 510, c = rem >> 1, g = rem & 1;
                                 return src + ((size_t)(b * SEQ + 16 * c + 16 * half)) * 128 + g * 64; }, 128,
               [&](int v) { return W1 + (size_t)v * 2048 + half * 1024; }, 64, 16, lds, tid);
    {
        float* xch = (float*)(lds_base() + VB_LDS);
        __syncthreads();
        if (half == 1) {
#pragma unroll
            for (int mi = 0; mi < 4; ++mi)
#pragma unroll
                for (int ni = 0; ni < 4; ++ni) *(f32x4*)(xch + ((mi * 4 + ni) * 256 + tid) * 4) = acc[mi][ni];
        }
        __syncthreads();
        if (half == 0) {
#pragma unroll
            for (int mi = 0; mi < 4; ++mi)
#pragma unroll
                for (int ni = 0; ni < 4; ++ni) acc[mi][ni] += *(const f32x4*)(xch + ((mi * 4 + ni) * 256 + tid) * 4);
        }
        __syncthreads();
        if (half == 1) return;
    }
#pragma unroll
    for (int mi = 0; mi < 4; ++mi) {
        const int row = 64 * wm + 16 * mi + fr; const int cb = 16 * fq;
        float v[16];
#pragma unroll
        for (int e = 0; e < 16; ++e) v[e] = gelu_tanh(acc[mi][e >> 2][e & 3] + pb[64 * wn + cb + e]);
        u32x4 a, b;
        a.x = pk_bf16(v[0], v[1]); a.y = pk_bf16(v[2], v[3]); a.z = pk_bf16(v[4], v[5]); a.w = pk_bf16(v[6], v[7]);
        b.x = pk_bf16(v[8], v[9]); b.y = pk_bf16(v[10], v[11]); b.z = pk_bf16(v[12], v[13]); b.w = pk_bf16(v[14], v[15]);
        *(u32x4*)(lds + wn * 16384 + row * 128 + (((2 * fq) ^ (row & 7)) << 4)) = a;
        *(u32x4*)(lds + wn * 16384 + row * 128 + (((2 * fq + 1) ^ (row & 7)) << 4)) = b;
    }
#pragma unroll
    for (int j = 0; j < 4; ++j) {
        const int pid = tid + 256 * j, row = pid >> 4, ch = pid & 15;
        const u32x4 v = *(const u32x4*)(W2 + row * 128 + ch * 8);
        *(u32x4*)(lds + 32768 + (ch >> 3) * 16384 + row * 128 + (((ch & 7) ^ (row & 7)) << 4)) = v;
    }
    vb_sync(lds);
    f32x4 a2[4][2];
#pragma unroll
    for (int i = 0; i < 4; ++i) { a2[i][0] = (f32x4){0.f, 0.f, 0.f, 0.f}; a2[i][1] = (f32x4){0.f, 0.f, 0.f, 0.f}; }
#pragma unroll
    for (int kt2 = 0; kt2 < 2; ++kt2)
#pragma unroll
        for (int ks = 0; ks < 2; ++ks) {
            bf16x8 af[4], bf[2];
#pragma unroll
            for (int mi = 0; mi < 4; ++mi) { const int row = 64 * wm + 16 * mi + fr; af[mi] = *(const bf16x8*)(lds + kt2 * 16384 + row * 128 + (((4 * ks + fq) ^ (row & 7)) << 4)); }
#pragma unroll
            for (int ni = 0; ni < 2; ++ni) { const int row = 32 * wn + 8 * (fr >> 2) + 4 * ni + (fr & 3); bf[ni] = *(const bf16x8*)(lds + 32768 + kt2 * 16384 + row * 128 + (((4 * ks + fq) ^ (row & 7)) << 4)); }
#pragma unroll
            for (int mi = 0; mi < 4; ++mi)
#pragma unroll
                for (int ni = 0; ni < 2; ++ni) a2[mi][ni] = mfma16(bf[ni], af[mi], a2[mi][ni]);
        }
    bf16_t* kcmp = (bf16_t*)(p.ws + OFF_C + C_KCMP);
    bf16_t* vct = (bf16_t*)(p.ws + OFF_C + C_VCT);
#pragma unroll
    for (int mi = 0; mi < 4; ++mi) {
        const int Rr = m0 + 64 * wm + 16 * mi + fr;
        if (Rr < 4080) {
            const int b = Rr / 510, rem = Rr % 510, c = rem >> 1, g = rem & 1, d0 = 32 * wn + 8 * fq;
            float v[8];
#pragma unroll
            for (int e = 0; e < 8; ++e) v[e] = a2[mi][e >> 2][e & 3];
            if (DBG_NOCSTORE) { if (v[0] == 123.456f) kcmp[0] = 1; }
            else if (kv == 0) {
                u32x4 o; o.x = pk_bf16(v[0], v[1]); o.y = pk_bf16(v[2], v[3]); o.z = pk_bf16(v[4], v[5]); o.w = pk_bf16(v[6], v[7]);
                *(u32x4*)(kcmp + ((size_t)(b * 256 + c)) * 128 + g * 64 + d0) = o;
                if (c == 254) *(u32x4*)(kcmp + ((size_t)(b * 256 + 255)) * 128 + g * 64 + d0) = (u32x4){0u, 0u, 0u, 0u};
            } else {
#pragma unroll
                for (int e = 0; e < 8; ++e) {
                    vct[((size_t)((b * 2 + g) * 64 + d0 + e)) * 256 + c] = f2bf(v[e]);
                    if (c == 254) vct[((size_t)((b * 2 + g) * 64 + d0 + e)) * 256 + 255] = 0;
                }
            }
        }
    }
    vb_sync(lds);
}

__device__ __forceinline__ void sgu_job(CKP& p, int l, int job, unsigned char* lds) {
    job_fence();
    const int tid = opaque_tid(), lane = tid & 63, w = tid >> 6, fr = lane & 15, fq = lane >> 4;
    const size_t tok0 = (size_t)job * 128;
    const bf16_t* V = (const bf16_t*)(p.ws + OFF_R + R_V) + tok0 * 256;
    const bf16_t* U = (const bf16_t*)(p.ws + OFF_R + R_U) + tok0 * 256;
    bf16_t* O = (bf16_t*)(p.ws + OFF_C + C_SGU) + tok0 * 256;
    const bf16_t* Wt = (const bf16_t*)(p.ws + OFF_W + W_SGU);
    const float* ng = p.in[11] + (size_t)l * 256;
    const float* bs = p.in[13] + (size_t)l * 512;
    vb_sync(lds);
    if (DBG_SGUCUT != 2) {
        const int s = tid >> 1, half = tid & 1;
        const bf16_t* src = V + (size_t)s * 256 + half * 128;
        float ss = 0.f;
#pragma unroll 4
        for (int j = 0; j < 16; ++j) {
            const u32x4 bb = *(const u32x4*)(src + j * 8);
            const unsigned uu[4] = {bb.x, bb.y, bb.z, bb.w};
#pragma unroll
            for (int q = 0; q < 4; ++q) { const float a = bflo(uu[q]), b2 = bfhi(uu[q]); ss += a * a + b2 * b2; }
        }
        ss += __shfl_xor(ss, 1);
        const float rstd = rsqrtf(ss * (1.f / 256.f) + RMS_EPS);
#pragma unroll 1
        for (int j = 0; j < 16; ++j) {
            const u32x4 bb = *(const u32x4*)(src + j * 8);
            const unsigned uu[4] = {bb.x, bb.y, bb.z, bb.w};
            const int cb = half * 128 + j * 8;
#pragma unroll
            for (int q = 0; q < 4; ++q) {
#pragma unroll
                for (int hh = 0; hh < 2; ++hh) {
                    const int c = cb + q * 2 + hh;
                    const float val = (hh ? bfhi(uu[q]) : bflo(uu[q])) * rstd * ng[c];
                    *(bf16_t*)(lds + c * 256 + ((((s >> 3) ^ (c & 15))) << 4) + (s & 7) * 2) = f2bf(val);
                }
            }
        }
    }
    vb_sync(lds);
    const int g = w;
#pragma unroll 1
    for (int th = 0; th < (DBG_SGUCUT == 1 ? 0 : 2); ++th) {
        f32x4 acc[4][4];
        zero_acc(acc);
#pragma unroll
        for (int ks = 0; ks < 4; ++ks) {
            if (32 * ks <= 64 * th + 63) {
                bf16x8 vf[4];
#pragma unroll
                for (int di = 0; di < 4; ++di) { const int c = 64 * g + 16 * di + fr; vf[di] = *(const bf16x8*)(lds + c * 256 + (((4 * ks + fq) ^ (c & 15)) << 4)); }
#pragma unroll
                for (int ti = 0; ti < 4; ++ti) {
                    const int t = 64 * th + 16 * ti + fr;
                    if (32 * ks <= 64 * th + 16 * ti + 15) {
                        const bf16x8 wf = *(const bf16x8*)(Wt + ((size_t)(g * 128 + t)) * 128 + 32 * ks + 8 * fq);
#pragma unroll
                        for (int di = 0; di < 4; ++di) acc[ti][di] = mfma16(vf[di], wf, acc[ti][di]);
                    }
                }
            }
        }
#pragma unroll
        for (int ti = 0; ti < 4; ++ti) {
            const int t = 64 * th + 16 * ti + fr; const float bb = bs[g * 128 + t];
#pragma unroll
            for (int di = 0; di < 4; ++di) {
                const int c = 64 * g + 16 * di + 4 * fq;
                const u32x2 uu = *(const u32x2*)(U + (size_t)t * 256 + c);
                u32x2 o;
                o.x = pk_bf16(bflo(uu.x) * (acc[ti][di][0] + bb), bfhi(uu.x) * (acc[ti][di][1] + bb));
                o.y = pk_bf16(bflo(uu.y) * (acc[ti][di][2] + bb), bfhi(uu.y) * (acc[ti][di][3] + bb));
                *(u32x2*)(O + (size_t)t * 256 + c) = o;
            }
        }
    }
    vb_sync(lds);
}

__device__ __forceinline__ void s5_job(CKP& p, int l, int jb, int pass, unsigned char* lds, int idov = -1) {
    job_fence();
    const int tid = opaque_tid(), lane = tid & 63, w = tid >> 6, fr = lane & 15, fq = lane >> 4;
    const int id = (idov >= 0) ? idov : (((jb * 4 + w) + DBG_IDROT) & 2047), seq = id >> 4, ch = id & 15, b = seq >> 4, g = seq & 15;
    unsigned char* W = p.ws + OFF_W;
    const float* ab = (const float*)(W + W_S5A) + (g * 64 + lane) * 2;
    float ar = ab[0], ai = ab[1];
    float br[16], bi[16];
    {
        const float* bb = (const float*)(W + W_S5B) + (size_t)(g * 64 + lane) * 32;
#pragma unroll
        for (int h = 0; h < 16; ++h) { br[h] = bb[h]; bi[h] = bb[16 + h]; }
    }
#if DBG_S5CONST >= 2
    { const float q = (float)(lane + 1) * 0.001f; ar = 0.99f - q; ai = 0.05f + q;
      for (int h = 0; h < 16; ++h) { br[h] = 0.01f * (float)(h + 1) + q; bi[h] = -0.02f * (float)(h + 1) + q; } }
#endif
    unsigned brp[8], bip[8];
#pragma unroll
    for (int k = 0; k < 8; ++k) { brp[k] = pk_bf16(br[2 * k], br[2 * k + 1]); bip[k] = pk_bf16(bi[2 * k], bi[2 * k + 1]); }
    float* Eb = (float*)(p.ws + OFF_C + C_S5E);
    float hre = 0.f, him = 0.f;
    bf16x8 cf[4]; float dv[4];
    if (pass == 2) {
        const float* a2 = (const float*)(W + W_S5A256) + (g * 64 + lane) * 2;
        const float a2r = a2[0], a2i = a2[1];
        for (int c2 = 0; c2 < ch; ++c2) {
            const float* e = Eb + ((size_t)(seq * 16 + c2) * 64 + lane) * 2;
            const float nr = a2r * hre - a2i * him + e[0], ni = a2r * him + a2i * hre + e[1];
            hre = nr; him = ni;
        }
        const bf16_t* cm = (const bf16_t*)(W + W_S5C) + (size_t)(g * 16 + fr) * 128;
#pragma unroll
        for (int ks = 0; ks < 4; ++ks) cf[ks] = *(const bf16x8*)(cm + 32 * ks + 8 * fq);
#pragma unroll
        for (int r = 0; r < 4; ++r) dv[r] = p.in[22][(size_t)l * 256 + g * 16 + 4 * fq + r];
    }
    const bf16_t* xin = (const bf16_t*)(p.ws + OFF_R + R_S5IN) + ((size_t)(b * SEQ + ch * 256)) * 256 + g * 16;
    bf16_t* yg = (bf16_t*)(p.ws + OFF_C + C_YG) + ((size_t)(b * SEQ + ch * 256)) * 256 + g * 16;
    float* xs = (float*)(lds + w * 10240);
    int ldsbad = 0; (void)ldsbad;
    unsigned char* Hs = lds + w * 10240 + 2048;
#if DBG_TWICE
    float keep_re = 0.f, keep_im = 0.f;
#pragma unroll 1
    for (int rep = 0; rep < 2; ++rep) {
    if (rep == 1) { keep_re = hre; keep_im = him; hre = 0.f; him = 0.f; }
#endif
    u32x4 xnext = *(const u32x4*)(xin + (size_t)(lane >> 1) * 256 + (lane & 1) * 8);
#pragma unroll 1
    for (int sub = 0; sub < 8; ++sub) {
#if DBG_S5CONST >= 1
        u32x4 xv; { const unsigned q = (unsigned)(sub * 32 + (lane >> 1)) * 2654435761u + (unsigned)id * 40503u + (lane & 1); xv.x = 0x3f803e80u ^ ((q & 0xff) << 16); xv.y = 0x3e003d00u ^ ((q >> 8) & 0x7f); xv.z = 0xbe803f00u ^ ((q >> 16) & 0x3f); xv.w = 0x3d80be00u; }
#else
        const u32x4 xv = xnext;
        if (sub + 1 < 8) xnext = *(const u32x4*)(xin + (size_t)((sub + 1) * 32 + (lane >> 1)) * 256 + (lane & 1) * 8);
#endif
        if (sub == 0) vb_sync(lds); else asm volatile("s_waitcnt lgkmcnt(0)" ::: "memory");
        *(u32x4*)((unsigned char*)xs + (lane >> 1) * 32 + (lane & 1) * 16) = xv;
        asm volatile("s_waitcnt lgkmcnt(0)" ::: "memory");
#pragma unroll 4
        for (int st = 0; st < 32; ++st) {
#if DBG_S5CONST == 3
            f32x4 x0, x1, x2, x3;
            { const float t = (float)((sub * 32 + st) & 63) * 0.015625f + (float)(id & 7) * 0.125f;
              x0 = (f32x4){t, t * 0.5f, -t, 0.25f}; x1 = (f32x4){0.5f - t, t * t, 0.125f, t}; x2 = (f32x4){-0.25f, t, 0.75f * t, 1.f - t}; x3 = (f32x4){t, -t, 0.5f, 0.3f * t}; }
#else
            const u32x4 xa = *(const u32x4*)((const unsigned char*)xs + st * 32), xb = *(const u32x4*)((const unsigned char*)xs + st * 32 + 16);
#endif
            const unsigned xp[8] = {xa.x, xa.y, xa.z, xa.w, xb.x, xb.y, xb.z, xb.w};
            float ur = 0.f, ui = 0.f;
#pragma unroll
            for (int k = 0; k < 8; ++k) {
                ur = __builtin_amdgcn_fdot2_f32_bf16(__builtin_bit_cast(bf16x2_t, brp[k]), __builtin_bit_cast(bf16x2_t, xp[k]), ur, false);
                ui = __builtin_amdgcn_fdot2_f32_bf16(__builtin_bit_cast(bf16x2_t, bip[k]), __builtin_bit_cast(bf16x2_t, xp[k]), ui, false);
            }
            const float nr = ar * hre - ai * him + ur, ni = ar * him + ai * hre + ui;
            hre = nr; him = ni;
            if (pass == 2) {
                *(bf16_t*)(Hs + st * 256 + (((lane >> 3) ^ (st & 15)) << 4) + (lane & 7) * 2) = f2bf(hre);
                *(bf16_t*)(Hs + st * 256 + ((((64 + lane) >> 3) ^ (st & 15)) << 4) + (lane & 7) * 2) = f2bf(him);
            }
        }
#if DBG_LDSCHK
        {
            const f32x4 ra = *(volatile f32x4*)(xs + (lane >> 1) * 16 + (lane & 1) * 8), rc = *(volatile f32x4*)(xs + (lane >> 1) * 16 + (lane & 1) * 8 + 4);
            bool bad = false;
            for (int q = 0; q < 4; ++q) bad |= (__float_as_uint(ra[q]) != __float_as_uint(chk_a[q])) | (__float_as_uint(rc[q]) != __float_as_uint(chk_c[q]));
            if (__any(bad)) ldsbad = 1;
        }
#endif
        if (pass == 2) {
            asm volatile("s_waitcnt lgkmcnt(0)" ::: "memory");
#pragma unroll
            for (int tt = 0; tt < 2; ++tt) {
                f32x4 acc = {0.f, 0.f, 0.f, 0.f};
                const int tl = tt * 16 + fr;
#pragma unroll
                for (int ks = 0; ks < 4; ++ks) {
                    const bf16x8 hf = *(const bf16x8*)(Hs + tl * 256 + (((4 * ks + fq) ^ (tl & 15)) << 4));
                    acc = mfma16(cf[ks], hf, acc);
                }
                float y[4];
                const u32x2 xq = *(const u32x2*)((const unsigned char*)xs + tl * 32 + 8 * fq);
                const float xsk[4] = {bflo(xq.x), bfhi(xq.x), bflo(xq.y), bfhi(xq.y)};
#pragma unroll
                for (int r = 0; r < 4; ++r) y[r] = gelu_tanh(acc[r] + dv[r] * xsk[r]);
                u32x2 o; o.x = pk_bf16(y[0], y[1]); o.y = pk_bf16(y[2], y[3]);
                *(u32x2*)(yg + (size_t)(sub * 32 + tl) * 256 + 4 * fq) = o;
            }
        }
    }
#if DBG_TWICE
    }
    if (__float_as_uint(keep_re) != __float_as_uint(hre) || __float_as_uint(keep_im) != __float_as_uint(him)) { hre = __uint_as_float(0x7fc00000u); him = hre; }
#endif
    if (pass == 1) {
        float* e = Eb + ((size_t)(seq * 16 + ch) * 64 + lane) * 2;
#if DBG_LDSCHK
        if (ldsbad) { hre = __uint_as_float(0x7fc00000u); him = hre; }
#endif
#if DBG_ESC1
        { const unsigned long long pk = ((unsigned long long)__float_as_uint(him) << 32) | __float_as_uint(hre);
          __hip_atomic_store((unsigned long long*)e, pk, __ATOMIC_RELAXED, __HIP_MEMORY_SCOPE_AGENT); }
#else
        e[0] = hre; e[1] = him;
#endif
#if DBG_E2
        float* e2 = (float*)(p.ws + OFF_C + C_ATT) + ((size_t)(seq * 16 + ch) * 64 + lane) * 2;
        e2[0] = hre; e2[1] = him;
#endif
    }
    vb_sync(lds);
}

__device__ __forceinline__ void phase_mid1(CKP& p, int l, unsigned char* lds) {
    if (blockIdx.x < 64) { compress_tile(p, (int)blockIdx.x, lds); return; }
    for (int j = VBID() - 128; j < 768; j += VGRID() - 128) {
        if (j < 256) sgu_job(p, l, j, lds);
        else s5_job(p, l, j - 256, 1, lds);
    }
}

constexpr int AL_Q = 0, AL_KV = 32768, AL_IMP = 49152, AL_SEL = 65792, AL_UNI = 66304, AL_JOB = 66336;
constexpr float SM_C = 0.125f * 1.4426950408889634f;

__device__ __forceinline__ void attn_load_q(const bf16_t* Qg, const int* pos, const float (&inv_freq)[8], int b, int g, int t0, bool rope, unsigned char* lds, int tid) {
#pragma unroll 1
    for (int j = 0; j < 8; ++j) {
        const int pid = tid + 256 * j, Rr = pid >> 3, ch = pid & 7;
        const int wq = Rr >> 6, r = (Rr >> 4) & 3, q = Rr & 15, t = t0 + 16 * wq + q;
        const bf16_t* src = Qg + ((size_t)(b * SEQ + t)) * 512 + (g * 4 + r) * 64;
        if (!rope || ch >= 2) {
            *(u32x4*)(lds + AL_Q + Rr * 128 + ((ch ^ (Rr & 7)) << 4)) = *(const u32x4*)(src + ch * 8);
        } else if (ch == 0) {
            const u32x4 a = *(const u32x4*)(src), c = *(const u32x4*)(src + 8);
            float x1[8] = {bflo(a.x), bfhi(a.x), bflo(a.y), bfhi(a.y), bflo(a.z), bfhi(a.z), bflo(a.w), bfhi(a.w)};
            float x2[8] = {bflo(c.x), bfhi(c.x), bflo(c.y), bfhi(c.y), bflo(c.z), bfhi(c.z), bflo(c.w), bfhi(c.w)};
            const float ps = (float)pos[b * SEQ + t];
#pragma unroll
            for (int i = 0; i < 8; ++i) {
                float sn, cs; sincosf(ps * inv_freq[i], &sn, &cs);
                const float u = x1[i], v = x2[i];
                x1[i] = u * cs - v * sn; x2[i] = v * cs + u * sn;
            }
            u32x4 o1, o2;
            o1.x = pk_bf16(x1[0], x1[1]); o1.y = pk_bf16(x1[2], x1[3]); o1.z = pk_bf16(x1[4], x1[5]); o1.w = pk_bf16(x1[6], x1[7]);
            o2.x = pk_bf16(x2[0], x2[1]); o2.y = pk_bf16(x2[2], x2[3]); o2.z = pk_bf16(x2[4], x2[5]); o2.w = pk_bf16(x2[6], x2[7]);
            *(u32x4*)(lds + AL_Q + Rr * 128 + ((0 ^ (Rr & 7)) << 4)) = o1;
            *(u32x4*)(lds + AL_Q + Rr * 128 + ((1 ^ (Rr & 7)) << 4)) = o2;
        }
    }
}
__device__ __forceinline__ void attn_ldg(u32x4 (&kk)[2], u32x4 (&vv)[2], const bf16_t* Kb, const bf16_t* Vb, int vstride, int tid) {
#pragma unroll
    for (int j = 0; j < 2; ++j) {
        const int pid = tid + 256 * j, row = pid >> 3, ch = pid & 7;
        kk[j] = *(const u32x4*)(Kb + (size_t)row * 128 + ch * 8);
        vv[j] = *(const u32x4*)(Vb + (size_t)row * vstride + ch * 8);
    }
}
__device__ __forceinline__ void attn_stl(const u32x4 (&kk)[2], const u32x4 (&vv)[2], unsigned char* lds, int kvoff, int tid) {
#pragma unroll
    for (int j = 0; j < 2; ++j) {
        const int pid = tid + 256 * j, row = pid >> 3, ch = pid & 7;
        *(u32x4*)(lds + kvoff + row * 128 + ((ch ^ (row & 7)) << 4)) = kk[j];
        *(u32x4*)(lds + kvoff + 8192 + row * 128 + ((ch ^ ((row >> 1) & 7)) << 4)) = vv[j];
    }
}
__device__ __forceinline__ void attn_qk(f32x4 (&s)[2][4], const unsigned char* lds, int kvoff, int w, int fr, int fq, int hf) {
    const unsigned char* Qw = lds + AL_Q + w * 8192;
    const unsigned char* Kh = lds + kvoff + hf * 4096;
    const int sw0 = ((fq) ^ (fr & 7)) << 4, sw1 = ((4 + fq) ^ (fr & 7)) << 4;
#pragma unroll
    for (int ki = 0; ki < 2; ++ki)
#pragma unroll
        for (int qi = 0; qi < 4; ++qi) s[ki][qi] = (f32x4){0.f, 0.f, 0.f, 0.f};
#pragma unroll
    for (int ds = 0; ds < 2; ++ds) {
        bf16x8 qf[4];
#pragma unroll
        for (int qi = 0; qi < 4; ++qi) qf[qi] = *(const bf16x8*)(Qw + (qi * 16 + fr) * 128 + (ds ? sw1 : sw0));
#pragma unroll
        for (int ki = 0; ki < 2; ++ki) {
            const bf16x8 kf = *(const bf16x8*)(Kh + (ki * 16 + fr) * 128 + (ds ? sw1 : sw0));
#pragma unroll
            for (int qi = 0; qi < 4; ++qi) s[ki][qi] = mfma16(kf, qf[qi], s[ki][qi]);
        }
    }
}
__device__ __forceinline__ void attn_pv(f32x4 (&o)[4][4], const f32x4 (&s)[2][4], const unsigned char* lds, int kvoff, int fr, int fq, int hf) {
    bf16x8 pf[4];
#pragma unroll
    for (int qi = 0; qi < 4; ++qi) {
        u32x4 u;
        u.x = pk_bf16(s[0][qi][0], s[0][qi][1]); u.y = pk_bf16(s[0][qi][2], s[0][qi][3]);
        u.z = pk_bf16(s[1][qi][0], s[1][qi][1]); u.w = pk_bf16(s[1][qi][2], s[1][qi][3]);
        pf[qi] = as_bf8(u);
    }
    const int c0 = 4 * hf + (fq >> 1);
    const unsigned char* Vt = lds + kvoff + 8192;
#pragma unroll
    for (int di = 0; di < 4; ++di) {
        const int row = di * 16 + fr, key = (row >> 1) & 7;
        const u32x2 lo = *(const u32x2*)(Vt + row * 128 + ((c0 ^ key) << 4) + 8 * (fq & 1));
        const u32x2 hi = *(const u32x2*)(Vt + row * 128 + (((c0 + 2) ^ key) << 4) + 8 * (fq & 1));
        const bf16x8 vf = as_bf8((u32x4){lo.x, lo.y, hi.x, hi.y});
#pragma unroll
        for (int qi = 0; qi < 4; ++qi) o[di][qi] = mfma16(vf, pf[qi], o[di][qi]);
    }
}
__device__ __forceinline__ unsigned attn_vmask(int kb, int fq, int lo, int hi) {
    unsigned vm = 0;
#pragma unroll
    for (int ki = 0; ki < 2; ++ki)
#pragma unroll
        for (int r = 0; r < 4; ++r) { const int key = kb + 16 * ki + 4 * fq + r; if (key >= lo && key <= hi) vm |= 1u << (ki * 4 + r); }
    return vm;
}
__device__ __forceinline__ void attn_softmax(f32x4 (&s)[2][4], f32x4 (&o)[4][4], float (&m)[4], float (&lsum)[4], unsigned vm) {
#pragma unroll
    for (int qi = 0; qi < 4; ++qi) {
        float mx = -1e30f;
#pragma unroll
        for (int ki = 0; ki < 2; ++ki)
#pragma unroll
            for (int r = 0; r < 4; ++r) { const float sv = ((vm >> (ki * 4 + r)) & 1u) ? s[ki][qi][r] * SM_C : -1e30f; s[ki][qi][r] = sv; mx = fmaxf(mx, sv); }
        mx = xmax16(mx); mx = xmax32(mx);
        const float mn = fmaxf(m[qi], mx), alpha = fexp2(m[qi] - mn);
        m[qi] = mn;
        float ls = 0.f;
#pragma unroll
        for (int ki = 0; ki < 2; ++ki)
#pragma unroll
            for (int r = 0; r < 4; ++r) { const float pv = ((vm >> (ki * 4 + r)) & 1u) ? fexp2(s[ki][qi][r] - mn) : 0.f; s[ki][qi][r] = pv; ls += pv; }
        lsum[qi] = lsum[qi] * alpha + ls;
        if (__any(alpha != 1.f)) {
#pragma unroll
            for (int di = 0; di < 4; ++di) o[di][qi] *= alpha;
        }
    }
}
__device__ __forceinline__ void attn_softmax_full(f32x4 (&s)[2][4], f32x4 (&o)[4][4], float (&m)[4], float (&lsum)[4], bool lsel) {
#pragma unroll
    for (int qi = 0; qi < 4; ++qi) {
        float mx = fmaxf(fmaxf(fmaxf(s[0][qi][0], s[0][qi][1]), fmaxf(s[0][qi][2], s[0][qi][3])), fmaxf(fmaxf(s[1][qi][0], s[1][qi][1]), fmaxf(s[1][qi][2], s[1][qi][3])));
        mx = xmax16(mx); mx = xmax32(mx);
        const float mn = fmaxf(m[qi], mx * SM_C);
        const float mnew = lsel ? mn : m[qi];
        const float alpha = fexp2(m[qi] - mnew);
        m[qi] = mnew;
        const float neg = lsel ? -mn : -1e30f;
        float ls = 0.f;
#pragma unroll
        for (int ki = 0; ki < 2; ++ki)
#pragma unroll
            for (int r = 0; r < 4; ++r) { const float pv = fexp2(fmaf(s[ki][qi][r], SM_C, neg)); s[ki][qi][r] = pv; ls += pv; }
        lsum[qi] = lsum[qi] * alpha + ls;
        if (__any(alpha != 1.f)) {
#pragma unroll
            for (int di = 0; di < 4; ++di) o[di][qi] *= alpha;
        }
    }
}
__device__ __forceinline__ void attn_softmax_fast(f32x4 (&s)[2][4], const float (&m)[4], float (&lsum)[4], unsigned vm, bool& ovf) {
#pragma unroll
    for (int qi = 0; qi < 4; ++qi) {
        const float neg = -m[qi]; float l = 0.f;
#pragma unroll
        for (int ki = 0; ki < 2; ++ki)
#pragma unroll
            for (int r = 0; r < 4; ++r) { const float pv = ((vm >> (ki * 4 + r)) & 1u) ? fexp2(fmaf(s[ki][qi][r], SM_C, neg)) : 0.f; s[ki][qi][r] = pv; l += pv; }
        lsum[qi] += l; ovf |= !(l < 1.0e12f);
    }
}
__device__ __forceinline__ void attn_accum(bf16_t* dst, const f32x4 (&o)[4][4], const float (&lsum)[4], const float (&gate)[4], bool first, int fq) {
#pragma unroll
    for (int qi = 0; qi < 4; ++qi) {
        float lt = lsum[qi]; lt = xsum16(lt); lt = xsum32(lt);
        const float sc = gate[qi] / fmaxf(lt, 1e-30f);
#pragma unroll
        for (int di = 0; di < 4; ++di) {
            u32x2* ptr = (u32x2*)(dst + qi * 64 + 16 * di + 4 * fq);
            float a0 = o[di][qi][0] * sc, a1 = o[di][qi][1] * sc, a2 = o[di][qi][2] * sc, a3 = o[di][qi][3] * sc;
            if (!first) { const u32x2 f = *ptr; a0 += bflo(f.x); a1 += bfhi(f.x); a2 += bflo(f.y); a3 += bfhi(f.y); }
            u32x2 r; r.x = pk_bf16(a0, a1); r.y = pk_bf16(a2, a3);
            *ptr = r;
        }
    }
}
__device__ __forceinline__ bool attn_retry(bool ovf, unsigned char* lds, int tid) {
    volatile LAS int* flag = (volatile LAS int*)(LAS unsigned char*)(lds + AL_JOB + 4);
    if (__any(ovf) && (tid & 63) == 0) *flag = 1;
    vb_sync(lds);
    const int rf = *flag;
    vb_sync(lds);
    if (rf && tid == 0) *flag = 0;
    return rf != 0;
}
template <class NextF, class PtrF, class BodyF>
__device__ __forceinline__ void attn_tiles(int first, NextF next, PtrF ptrs, BodyF body, unsigned char* lds, int tid) {
    u32x4 kk[2], vv[2];
    const bf16_t* Kb; const bf16_t* Vb; int vs;
    ptrs(first, Kb, Vb, vs);
    attn_ldg(kk, vv, Kb, Vb, vs, tid);
    int cur = first;
    while (cur >= 0) {
        vb_sync(lds);
        attn_stl(kk, vv, lds, AL_KV, tid);
        vb_sync(lds);
        const int nx = next(cur);
        if (nx >= 0) { ptrs(nx, Kb, Vb, vs); attn_ldg(kk, vv, Kb, Vb, vs, tid); }
        body(cur, AL_KV);
        cur = nx;
    }
}

__device__ __forceinline__ void glu_tile(CKP& p, int l, int m0, int n0, unsigned char* lds) {
    const int tid = opaque_tid(), lane = tid & 63, w = tid >> 6, wm = w >> 1, wn = w & 1, fr = lane & 15, fq = lane >> 4;
    const bf16_t* A = (const bf16_t*)(p.ws + OFF_C + C_YG);
    const bf16_t* Bt = (const bf16_t*)(p.ws + OFF_W + W_GLU);
    bf16_t* O = (bf16_t*)(p.ws + OFF_C + C_S5O);
    const float* gb = p.in[24] + (size_t)l * 256;
    f32x4 acc[4][4]; zero_acc(acc);
    gemm_kloop(acc, [&](int r) { return A + (size_t)(m0 + r) * 256; }, 64, [&](int v) { return Bt + (size_t)(n0 + v) * 256; }, 64, 4, lds, tid);
#pragma unroll
    for (int mi = 0; mi < 4; ++mi) {
        const int row = m0 + 64 * wm + 16 * mi + fr, col = n0 + 64 * wn + 16 * fq;
        const u32x4 y0 = *(const u32x4*)(A + (size_t)row * 256 + col), y1 = *(const u32x4*)(A + (size_t)row * 256 + col + 8);
        const unsigned yy[8] = {y0.x, y0.y, y0.z, y0.w, y1.x, y1.y, y1.z, y1.w};
        float v[16];
#pragma unroll
        for (int e = 0; e < 16; ++e) {
            const float y = (e & 1) ? bfhi(yy[e >> 1]) : bflo(yy[e >> 1]);
            v[e] = y * sigm(acc[mi][e >> 2][e & 3] + gb[col + e]);
        }
        store16bf(O + (size_t)row * 256 + col, v);
    }
}
__device__ __forceinline__ void phase_attn(CKP& p, int l, unsigned char* lds, unsigned* ctl) {
    for (int jb = (int)blockIdx.x; jb < 128; jb += (int)gridDim.x) {
        const int w_ = opaque_tid() >> 6, vbi = TIDX() >> 8, bq = jb >> 4, chq = jb & 15;
#pragma unroll 1
        for (int r = 0; r < 2; ++r) s5_job(p, l, 0, 2, lds, ((bq * 16 + r * 8 + vbi * 4 + w_) << 4) + chq);
        asm volatile("s_waitcnt vmcnt(0)" ::: "memory");
        __syncthreads();
#pragma unroll 1
        for (int nt_ = 0; nt_ < 2; ++nt_) glu_tile(p, l, bq * SEQ + chq * 256 + vbi * 128, nt_ * 128, lds);
    }

    unsigned char* R = p.ws + OFF_R; unsigned char* C = p.ws + OFF_C;
    const bf16_t* Qg = (const bf16_t*)(R + R_Q);
    const bf16_t* Kc = (const bf16_t*)(C + C_KCMP); const bf16_t* Vc = (const bf16_t*)(C + C_VCT);
    const bf16_t* Ks = (const bf16_t*)(R + R_KS); const bf16_t* Vs = (const bf16_t*)(R + R_VST);
    const bf16_t* Kw = (const bf16_t*)(R + R_KW); const bf16_t* Vw = (const bf16_t*)(R + R_VWT);
    const float* NG = (const float*)(R + R_NG);
    bf16_t* AO = (bf16_t*)(C + C_ATT);
    const int* pos = (const int*)p.in[1];
    unsigned* ctr = ctl + CTL_ATTN + l;
    float invf[8];
#pragma unroll
    for (int q = 0; q < 8; ++q) invf[q] = p.inv_freq[q];

    if (opaque_tid() == 0) { *(volatile int*)(lds + AL_JOB + 8) = 0; *(volatile int*)(lds + AL_JOB + 4) = 0; }
    for (;;) {
        lds = vb_lds();
        volatile int* jobp = (volatile int*)(lds + AL_JOB);
        float* imp = (float*)(lds + AL_IMP);
        unsigned long long* selm = (unsigned long long*)(lds + AL_SEL);
        unsigned long long* uni = (unsigned long long*)(lds + AL_UNI);
        const int tid = opaque_tid(), lane = tid & 63, w = tid >> 6, fr = lane & 15, fq = lane >> 4;
        vb_sync(lds);
        if (tid == 0) { *jobp = (int)atomicAdd(ctr, 1u); *(volatile int*)(lds + AL_JOB + 8) += 1; }
        vb_sync(lds);
        const int job = *jobp, grabs = *(volatile int*)(lds + AL_JOB + 8);
        if (grabs == 2 || (job >= 1024 && grabs == 1)) convert_tiles(p, l, 11, 14, VBID() * 4 + w, VGRID() * 4, lane);
        if (job >= 1024) break;
        const int i = 63 - (job >> 4), bg = job & 15, b = bg >> 1, g = bg & 1, t0 = i * 64;
        const int tq = t0 + 16 * w + fr;
        const size_t kvrow = (size_t)b * SEQ;
        float gate[4]; bf16_t* dstq_;

        attn_load_q(Qg, pos, invf, b, g, t0, false, lds, tid);
        const int ntc = ((4 * i + 2) >> 6) + 1;
        const int hic = (tq >= 31) ? ((tq - 31) >> 4) : -1;
        float m[4], lsum[4];
#pragma unroll
        for (int qi = 0; qi < 4; ++qi) { m[qi] = -1e30f; lsum[qi] = 0.f; }
        auto cmp_next = [&](int ct) { return (ct + 1 < ntc) ? ct + 1 : -1; };
        auto cmp_ptrs = [&](int ct, const bf16_t*& Kb, const bf16_t*& Vb, int& vs) {
            Kb = Kc + ((size_t)(b * 256 + ct * 64)) * 128 + g * 64; Vb = Vc + ((size_t)((b * 2 + g) * 64)) * 256 + ct * 64; vs = 256; };
        attn_tiles(0, cmp_next, cmp_ptrs, [&](int ct, int kvoff) {
#pragma unroll 1
            for (int hf = 0; hf < 2; ++hf) {
                f32x4 s[2][4];
                attn_qk(s, lds, kvoff, w, fr, fq, hf);
                const unsigned vm = attn_vmask(ct * 64 + hf * 32, fq, 0, hic);
#pragma unroll
                for (int qi = 0; qi < 4; ++qi) {
                    float mx = -1e30f;
#pragma unroll
                    for (int ki = 0; ki < 2; ++ki)
#pragma unroll
                        for (int r = 0; r < 4; ++r) { const float sv = ((vm >> (ki * 4 + r)) & 1u) ? s[ki][qi][r] * SM_C : -1e30f; s[ki][qi][r] = sv; mx = fmaxf(mx, sv); }
                    mx = xmax16(mx); mx = xmax32(mx);
                    const float mn = fmaxf(m[qi], mx), alpha = fexp2(m[qi] - mn);
                    m[qi] = mn;
                    float ls = 0.f;
#pragma unroll
                    for (int ki = 0; ki < 2; ++ki)
#pragma unroll
                        for (int r = 0; r < 4; ++r) ls += ((vm >> (ki * 4 + r)) & 1u) ? fexp2(s[ki][qi][r] - mn) : 0.f;
                    lsum[qi] = lsum[qi] * alpha + ls;
                }
            }
        }, lds, tid);
        float invl[4];
#pragma unroll
        for (int qi = 0; qi < 4; ++qi) { float lt = lsum[qi]; lt = xsum16(lt); lt = xsum32(lt); invl[qi] = 1.f / fmaxf(lt, 1e-30f); }
        {
            f32x4 o[4][4]; zero_acc(o);
            float carry = 0.f;
            attn_tiles(0, cmp_next, cmp_ptrs, [&](int ct, int kvoff) {
#pragma unroll 1
                for (int hf = 0; hf < 2; ++hf) {
                    f32x4 s[2][4];
                    attn_qk(s, lds, kvoff, w, fr, fq, hf);
                    const unsigned vm = attn_vmask(ct * 64 + hf * 32, fq, 0, hic);
#pragma unroll
                    for (int qi = 0; qi < 4; ++qi)
#pragma unroll
                        for (int ki = 0; ki < 2; ++ki)
#pragma unroll
                            for (int r = 0; r < 4; ++r) s[ki][qi][r] = ((vm >> (ki * 4 + r)) & 1u) ? fexp2(s[ki][qi][r] * SM_C - m[qi]) * invl[qi] : 0.f;
#pragma unroll
                    for (int ki = 0; ki < 2; ++ki) {
                        float a = 0.f, bq = 0.f;
#pragma unroll
                        for (int qi = 0; qi < 4; ++qi) { a += s[ki][qi][0] + s[ki][qi][1] + s[ki][qi][2] + 0.5f * s[ki][qi][3]; bq += 0.5f * s[ki][qi][3]; }
                        const float up = bperm_f((lane + 48) & 63, bq);
                        const float wrap = bperm_f((lane + 48) & 63, carry);
                        a += (fq >= 1) ? up : wrap;
                        carry = bq;
                        imp[(16 * w + fr) * 65 + 16 * ct + 8 * hf + 4 * ki + fq] = a;
                    }
                    attn_pv(o, s, lds, kvoff, fr, fq, hf);
                }
            }, lds, tid);
#pragma unroll
            for (int qi = 0; qi < 4; ++qi) { int rq = (int)kvrow + tq; asm volatile("" : "+v"(rq)); gate[qi] = NG[(size_t)rq * 24 + (g * 4 + qi) * 3 + 0]; }
            const float quarter[4] = {0.25f, 0.25f, 0.25f, 0.25f};
            { int rq2 = (int)kvrow + tq; asm volatile("" : "+v"(rq2)); dstq_ = AO + (size_t)rq2 * 512 + (g * 4) * 64; } attn_accum(dstq_, o, quarter, gate, true, fq);
        }
        vb_sync(lds);
        {
            const int q = tid >> 2, part = tid & 3;
            unsigned long long mk = 0ull;
            if (i <= 15) { mk = (i == 63) ? ~0ull : ((1ull << (i + 1)) - 1ull); }
            else {
                const float* row = imp + q * 65;
                float cv[16];
#pragma unroll
                for (int k = 0; k < 16; ++k) { const int j = 1 + part + 4 * k; cv[k] = (j <= i - 2) ? row[j] : -1.f; }
                unsigned lo32 = 0u, hi32 = 0u;
#pragma unroll 1
                for (int r = 0; r < 13; ++r) {
                    float bv = cv[0]; int bj = 1 + part;
#pragma unroll
                    for (int k = 1; k < 16; ++k) { const bool t = cv[k] > bv; bv = t ? cv[k] : bv; bj = t ? (1 + part + 4 * k) : bj; }
#pragma unroll
                    for (int mm = 1; mm <= 2; mm <<= 1) {
                        const float ov = bperm_f(lane ^ mm, bv); const int oj = (int)bperm_u(lane ^ mm, (unsigned)bj);
                        const bool t = (ov > bv) || (ov == bv && oj < bj);
                        bv = t ? ov : bv; bj = t ? oj : bj;
                    }
#pragma unroll
                    for (int k = 0; k < 16; ++k) cv[k] = (1 + part + 4 * k == bj) ? -1.f : cv[k];
                    if (bj < 32) lo32 |= 1u << bj; else hi32 |= 1u << (bj - 32);
                }
                mk = ((unsigned long long)hi32 << 32) | lo32;
                mk |= 1ull | (1ull << i) | (1ull << (i - 1));
            }
            if (part == 0) selm[q] = mk;
            unsigned lo32 = (unsigned)mk, hi32 = (unsigned)(mk >> 32);
#pragma unroll
            for (int o2 = 32; o2 >= 1; o2 >>= 1) { lo32 |= bperm_u(lane ^ o2, lo32); hi32 |= bperm_u(lane ^ o2, hi32); }
            if (lane == 0) uni[w] = ((unsigned long long)hi32 << 32) | lo32;
        }
        vb_sync(lds);
        const unsigned long long mymask = selm[16 * w + fr];
        const unsigned long long un = uni[0] | uni[1] | uni[2] | uni[3];
        vb_sync(lds);
        attn_load_q((const bf16_t*)(R + R_QR), pos, invf, b, g, t0, false, lds, tid);
        auto sel_branch = [&](auto mode_c) -> bool {
            constexpr int mode = decltype(mode_c)::value;
            int kvr = (int)kvrow, bl = b, gl = g; asm volatile("" : "+v"(kvr), "+v"(bl), "+v"(gl));
            f32x4 o[4][4]; zero_acc(o);
#pragma unroll
            for (int qi = 0; qi < 4; ++qi) { m[qi] = -1e30f; lsum[qi] = 0.f; }
            bool ovf = false;
            attn_tiles(0,
                [&](int j) { const unsigned long long rest = (j >= 63) ? 0ull : (un >> (j + 1)); return rest ? (j + 1 + (int)__ffsll((long long)rest) - 1) : -1; },
                [&](int j, const bf16_t*& Kb, const bf16_t*& Vb, int& vs) { Kb = Ks + ((size_t)kvr + j * 64) * 128 + gl * 64; Vb = Vs + ((size_t)((bl * 2 + gl) * 64)) * SEQ + j * 64; vs = SEQ; },
                [&](int j, int kvoff) {
                    const bool lsel = ((mymask >> j) & 1ull) != 0ull;
                    const int hi = lsel ? tq : -1;
#pragma unroll 1
                    for (int hf = 0; hf < 2; ++hf) {
                        f32x4 s[2][4];
                        attn_qk(s, lds, kvoff, w, fr, fq, hf);
                        if (j == 0 || mode) { if (j < i) attn_softmax_full(s, o, m, lsum, lsel); else { const unsigned vm = attn_vmask(j * 64 + hf * 32, fq, 0, hi); attn_softmax(s, o, m, lsum, vm); } }
                        else { const unsigned vm = (j < i) ? (lsel ? 0xffu : 0u) : attn_vmask(j * 64 + hf * 32, fq, 0, hi); attn_softmax_fast(s, m, lsum, vm, ovf); }
                        attn_pv(o, s, lds, kvoff, fr, fq, hf);
                    }
                }, lds, tid);
            if (mode == 0 && attn_retry(ovf, lds, tid)) return true;
#pragma unroll
            for (int qi = 0; qi < 4; ++qi) { int rq = (int)kvrow + tq; asm volatile("" : "+v"(rq)); gate[qi] = NG[(size_t)rq * 24 + (g * 4 + qi) * 3 + 1]; }
            { int rq2 = (int)kvrow + tq; asm volatile("" : "+v"(rq2)); dstq_ = AO + (size_t)rq2 * 512 + (g * 4) * 64; } attn_accum(dstq_, o, lsum, gate, false, fq);
            return false;
        };
        if (sel_branch(std::integral_constant<int, 0>{})) (void)sel_branch(std::integral_constant<int, 1>{});
        auto win_branch = [&](auto mode_c) -> bool {
            constexpr int mode = decltype(mode_c)::value;
            int kvr = (int)kvrow, bl = b, gl = g; asm volatile("" : "+v"(kvr), "+v"(bl), "+v"(gl));
            f32x4 o[4][4]; zero_acc(o);
#pragma unroll
            for (int qi = 0; qi < 4; ++qi) { m[qi] = -1e30f; lsum[qi] = 0.f; }
            const int j0 = (i >= 8) ? (i - 8) : 0;
            bool ovf = false;
            attn_tiles(j0,
                [&](int j) { return (j + 1 <= i) ? j + 1 : -1; },
                [&](int j, const bf16_t*& Kb, const bf16_t*& Vb, int& vs) { Kb = Kw + ((size_t)kvr + j * 64) * 128 + gl * 64; Vb = Vw + ((size_t)((bl * 2 + gl) * 64)) * SEQ + j * 64; vs = SEQ; },
                [&](int j, int kvoff) {
#pragma unroll 1
                    for (int hf = 0; hf < 2; ++hf) {
                        f32x4 s[2][4];
                        attn_qk(s, lds, kvoff, w, fr, fq, hf);
                        if (j <= j0 + 1 || mode) { const unsigned vm = attn_vmask(j * 64 + hf * 32, fq, tq - 511, tq); attn_softmax(s, o, m, lsum, vm); }
                        else { const unsigned vm = (j >= i - 7 && j < i) ? 0xffu : attn_vmask(j * 64 + hf * 32, fq, tq - 511, tq); attn_softmax_fast(s, m, lsum, vm, ovf); }
                        attn_pv(o, s, lds, kvoff, fr, fq, hf);
                    }
                }, lds, tid);
            if (mode == 0 && attn_retry(ovf, lds, tid)) return true;
#pragma unroll
            for (int qi = 0; qi < 4; ++qi) { int rq = (int)kvrow + tq; asm volatile("" : "+v"(rq)); gate[qi] = NG[(size_t)rq * 24 + (g * 4 + qi) * 3 + 2]; }
            { int rq2 = (int)kvrow + tq; asm volatile("" : "+v"(rq2)); dstq_ = AO + (size_t)rq2 * 512 + (g * 4) * 64; } attn_accum(dstq_, o, lsum, gate, false, fq);
            return false;
        };
        if (win_branch(std::integral_constant<int, 0>{})) (void)win_branch(std::integral_constant<int, 1>{});
    }
}


struct G8Branch {
    static constexpr bool GATHER = false, HAS_F8 = true;
    const char* ws;
    __device__ __forceinline__ bool next(int i, G8Unit& u, const int (&R)[2], const unsigned (&C2)[2]) const {
        const int T = i / 6, sub = i - T * 6, L = T * (int)gridDim.x + (int)blockIdx.x;
        if (L >= (NTOK / 256) * 4) return false;
        int pm, pn; tile_coords(L, NTOK / 256, 4, pm, pn); pm = __builtin_amdgcn_readfirstlane(pm); pn = __builtin_amdgcn_readfirstlane(pn);
        if (sub == 1 || sub >= 4) {
            u.f8 = 1; u.K2 = 1024u; u.nt = 8; u.A0 = ws + OFF_XQ + (size_t)pm * 256 * 1024;
            if (sub == 1) { u.B0 = ws + OFF_W + W_GB + (size_t)(pn * 256) * 1024; u.B1 = u.B0 + (size_t)128 * 1024; }
            else { u.B0 = ws + OFF_W + W_GB + (size_t)(1024 + pn * 256 + (sub - 4) * 128) * 1024; u.B1 = u.B0 + (size_t)1024 * 1024; }
        } else {
            u.f8 = 0;
            const int br = (sub == 0) ? 0 : sub - 1;
            const unsigned k2 = br == 0 ? 1024u : 512u; u.K2 = k2; u.nt = br == 0 ? 8 : 4;
            const size_t b1 = (size_t)(br == 1), b2 = (size_t)(br == 2);
            const char* a = ws + (size_t)(OFF_C + C_ATT) + b1 * (size_t)(C_SGU - C_ATT) + b2 * (size_t)(C_S5O - C_ATT);
            const char* w = ws + (size_t)(OFF_W + W_A) + b1 * (size_t)(W_S - W_A) + b2 * (size_t)(W_5 - W_A);
            u.A0 = a + (size_t)pm * 256 * k2; u.B0 = w + (size_t)pn * 256 * k2; u.B1 = u.B0 + (size_t)128 * k2;
        }
        u.A1 = u.A0 + (size_t)128 * u.K2;
        u.x0 = pm; u.x1 = pn; u.x2 = sub; u.x3 = 0;
#pragma unroll
        for (int h = 0; h < 2; ++h)
#pragma unroll
            for (int k = 0; k < 2; ++k) u.ao[h][k] = __umul24((unsigned)R[k], u.K2) + C2[k];
        return true;
    }
};
struct EpiBranch {
    bf16_t* T1; bf16_t* T2; bf16_t* Mg; const float* rs1;
    __device__ __forceinline__ void operator()(const G8Acc& acc, const G8Unit& u, int wr, int wc, int fr, int fq) const {
        const int sub = u.x2;
        const size_t off0 = (size_t)(u.x0 * 256 + wr * 64 + fr) * 1024 + u.x1 * 256 + wc * 32 + 8 * fq;
        if (sub == 0 || sub == 2 || sub == 3) {
            bf16_t* Tt = (sub == 3) ? T2 : T1;
#pragma unroll
            for (int ai = 0; ai < 2; ++ai)
#pragma unroll
                for (int m = 0; m < 4; ++m)
#pragma unroll
                    for (int bj = 0; bj < 2; ++bj) {
                        const f32x4 v0 = acc[ai][bj][m][0], v1 = acc[ai][bj][m][1];
                        u32x4 o; o.x = pk_bf16(v0[0], v0[1]); o.y = pk_bf16(v0[2], v0[3]); o.z = pk_bf16(v1[0], v1[1]); o.w = pk_bf16(v1[2], v1[3]);
                        *(u32x4*)(Tt + off0 + (size_t)(ai * 128 + m * 16) * 1024 + bj * 128) = o;
                    }
        } else if (sub == 1) {
#pragma unroll
            for (int ai = 0; ai < 2; ++ai) {
                float rsv[4];
#pragma unroll
                for (int m = 0; m < 4; ++m) rsv[m] = rs1[u.x0 * 256 + ai * 128 + wr * 64 + m * 16 + fr];
                u32x4 y[4][2];
#pragma unroll
                for (int m = 0; m < 4; ++m)
#pragma unroll
                    for (int bj = 0; bj < 2; ++bj) y[m][bj] = *(const u32x4*)(T1 + off0 + (size_t)(ai * 128 + m * 16) * 1024 + bj * 128);
#pragma unroll
                for (int m = 0; m < 4; ++m)
#pragma unroll
                    for (int bj = 0; bj < 2; ++bj) {
                        const f32x4 v0 = acc[ai][bj][m][0] * GQ_INV, v1 = acc[ai][bj][m][1] * GQ_INV;
                        const u32x4 yy = y[m][bj];
                        u32x4 o;
                        o.x = pk_bf16(sigm(v0[0]) * bflo(yy.x), sigm(v0[1]) * bfhi(yy.x));
                        o.y = pk_bf16(sigm(v0[2]) * bflo(yy.y), sigm(v0[3]) * bfhi(yy.y));
                        o.z = pk_bf16(sigm(v1[0]) * bflo(yy.z), sigm(v1[1]) * bfhi(yy.z));
                        o.w = pk_bf16(sigm(v1[2]) * bflo(yy.w), sigm(v1[3]) * bfhi(yy.w));
                        *(u32x4*)(Mg + off0 + (size_t)(ai * 128 + m * 16) * 1024 + bj * 128) = o;
                    }
            }
        } else {
            const size_t offc = off0 + (size_t)(sub - 4) * 128;
#pragma unroll
            for (int ai = 0; ai < 2; ++ai) {
                float rsv[4];
#pragma unroll
                for (int m = 0; m < 4; ++m) rsv[m] = rs1[u.x0 * 256 + ai * 128 + wr * 64 + m * 16 + fr];
                u32x4 y1[4], y2[4], pv[4];
#pragma unroll
                for (int m = 0; m < 4; ++m) {
                    const size_t off = offc + (size_t)(ai * 128 + m * 16) * 1024;
                    y1[m] = *(const u32x4*)(T1 + off); y2[m] = *(const u32x4*)(T2 + off); pv[m] = *(const u32x4*)(Mg + off);
                }
#pragma unroll
                for (int m = 0; m < 4; ++m) {
                    const f32x4 a0 = acc[ai][0][m][0] * GQ_INV, a1 = acc[ai][0][m][1] * GQ_INV, b0 = acc[ai][1][m][0] * GQ_INV, b1 = acc[ai][1][m][1] * GQ_INV;
                    const u32x4 p1 = y1[m], p2 = y2[m], pp = pv[m];
                    u32x4 o;
                    o.x = pk_bf16(sigm(a0[0]) * bflo(p1.x) + sigm(b0[0]) * bflo(p2.x) + bflo(pp.x), sigm(a0[1]) * bfhi(p1.x) + sigm(b0[1]) * bfhi(p2.x) + bfhi(pp.x));
                    o.y = pk_bf16(sigm(a0[2]) * bflo(p1.y) + sigm(b0[2]) * bflo(p2.y) + bflo(pp.y), sigm(a0[3]) * bfhi(p1.y) + sigm(b0[3]) * bfhi(p2.y) + bfhi(pp.y));
                    o.z = pk_bf16(sigm(a1[0]) * bflo(p1.z) + sigm(b1[0]) * bflo(p2.z) + bflo(pp.z), sigm(a1[1]) * bfhi(p1.z) + sigm(b1[1]) * bfhi(p2.z) + bfhi(pp.z));
                    o.w = pk_bf16(sigm(a1[2]) * bflo(p1.w) + sigm(b1[2]) * bflo(p2.w) + bflo(pp.w), sigm(a1[3]) * bfhi(p1.w) + sigm(b1[3]) * bfhi(p2.w) + bfhi(pp.w));
                    *(u32x4*)(Mg + offc + (size_t)(ai * 128 + m * 16) * 1024) = o;
                }
            }
        }
    }
};
__device__ __forceinline__ void phase_branch(CKP& p, int l, unsigned char* lds) {
    G8Branch S{(const char*)p.ws};
    EpiBranch E{(bf16_t*)(p.ws + OFF_R), (bf16_t*)(p.ws + OFF_R + 67108864), (bf16_t*)(p.ws + OFF_M), (const float*)(p.ws + OFF_RS1)};
    g8_phase(S, E);
}

struct EpiMix {
    bf16_t* x;
    __device__ __forceinline__ void operator()(const G8Acc& acc, const G8Unit& u, int wr, int wc, int fr, int fq) const {
        bf16_t* xp0 = x + (size_t)(u.x0 * 256 + wr * 64 + fr) * 1024 + u.x1 * 256 + wc * 32 + 8 * fq;
#pragma unroll
        for (int ai = 0; ai < 2; ++ai) {
            u32x4 xv[4][2];
#pragma unroll
            for (int m = 0; m < 4; ++m)
#pragma unroll
                for (int bj = 0; bj < 2; ++bj) xv[m][bj] = *(const u32x4*)(xp0 + (size_t)(ai * 128 + m * 16) * 1024 + bj * 128);
#pragma unroll
            for (int m = 0; m < 4; ++m)
#pragma unroll
                for (int bj = 0; bj < 2; ++bj) {
                    const f32x4 a0 = acc[ai][bj][m][0], a1 = acc[ai][bj][m][1]; const u32x4 xx = xv[m][bj];
                    u32x4 o;
                    o.x = pk_bf16(bflo(xx.x) + a0[0], bfhi(xx.x) + a0[1]); o.y = pk_bf16(bflo(xx.y) + a0[2], bfhi(xx.y) + a0[3]);
                    o.z = pk_bf16(bflo(xx.z) + a1[0], bfhi(xx.z) + a1[1]); o.w = pk_bf16(bflo(xx.w) + a1[2], bfhi(xx.w) + a1[3]);
                    *(u32x4*)(xp0 + (size_t)(ai * 128 + m * 16) * 1024 + bj * 128) = o;
                }
        }
    }
};
__device__ __forceinline__ void phase_mix(CKP& p, int l, unsigned char* lds) {
    G8Plain S{(const char*)(p.ws + OFF_M), (const char*)(p.ws + OFF_W + W_M), 2048u, 16, NTOK / 256, 4};
    EpiMix E{(bf16_t*)(p.ws + OFF_X)};
    g8_phase(S, E);
}

__device__ __forceinline__ void phase_router(CKP& p, int l, unsigned char* lds, unsigned* ctl) {
    const int tid = opaque_tid(), lane = tid & 63, w = tid >> 6, wm = w >> 1, wn = w & 1, fr = lane & 15, fq = lane >> 4;
    int t512 = TIDX(); asm volatile("" : "+v"(t512));
    const int half = t512 >> 8, w8 = t512 >> 6;
    const float* gam = p.in[27] + (size_t)l * 1024;
    const float* bg = p.in[29] + (size_t)l * 4;
    const float* be = p.in[31] + (size_t)l * 32;
    const bf16_t* xres = (const bf16_t*)(p.ws + OFF_X);
    bf16_t* h2 = (bf16_t*)(p.ws + OFF_M);
    bf16_t* hlo = (bf16_t*)(p.ws + OFF_H);
    const bf16_t* Wh = (const bf16_t*)(p.ws + OFF_W + W_RH);
    const bf16_t* Wl = (const bf16_t*)(p.ws + OFF_W + W_RL);
    unsigned* cnt = ctl + CTL_MOECNT + l * 32;
    int* list = (int*)(p.ws + OFF_MOE + MOE_LIST);
    float* wsl = (float*)(p.ws + OFF_MOE + MOE_WS);
    unsigned char* lds0 = lds_base();
    float* lg = (float*)lds0;
    float* xch = (float*)(lds0 + VB_LDS);
    int* lc = (int*)(lds0 + 18432); int* gbs = (int*)(lds0 + 18432 + 128);
    float* rs = (float*)(lds0 + 65536);
    float* rsl = (float*)(p.ws + OFF_MOE + MOE_RS);
    for (int tile = blockIdx.x; tile < NTOK / 128; tile += gridDim.x) {
        const int r0 = tile * 128;
        {
            for (int rr = 0; rr < 16; rr += 2) {
                const int row = r0 + w8 * 16 + rr;
                float sa = 0.f, sb = 0.f;
#pragma unroll
                for (int i = 0; i < 4; ++i) { const u32x2 ua = *(const u32x2*)(xres + (size_t)row * 1024 + 4 * lane + 256 * i), ub = *(const u32x2*)(xres + (size_t)(row + 1) * 1024 + 4 * lane + 256 * i);
                                              sa += bflo(ua.x) * bflo(ua.x) + bfhi(ua.x) * bfhi(ua.x) + bflo(ua.y) * bflo(ua.y) + bfhi(ua.y) * bfhi(ua.y);
                                              sb += bflo(ub.x) * bflo(ub.x) + bfhi(ub.x) * bfhi(ub.x) + bflo(ub.y) * bflo(ub.y) + bfhi(ub.y) * bfhi(ub.y); }
                sa = wave_sum(sa); sb = wave_sum(sb);
                if (lane == 0) { rs[w8 * 16 + rr] = rsqrtf(sa * (1.f / 1024.f) + RMS_EPS); rs[w8 * 16 + rr + 1] = rsqrtf(sb * (1.f / 1024.f) + RMS_EPS); }
            }
        }
        __syncthreads();
        f32x4 acc[4][4]; zero_acc(acc);
        {
            const bf16_t* Wx = half ? Wl : Wh;
            gemm_kloop(acc, [&](int r) { return xres + (size_t)(r0 + r) * 1024; }, 64, [&](int v) { return Wx + (size_t)(v < 63 ? v : 63) * 1024; }, 64, 16, lds, tid);
        }
        __syncthreads();
        int lbase = (64 * wm + fr) * 36 + 16 * fq; asm volatile("" : "+v"(lbase));
        if (half == 1 && wn == 0 && fq < 3) {
#pragma unroll
            for (int mi = 0; mi < 4; ++mi)
#pragma unroll
                for (int e = 0; e < 16; ++e) if (e < 4 || fq < 2) xch[lbase + mi * 576 + e] = acc[mi][e >> 2][e & 3];
        }
        __syncthreads();
        if (half == 0 && tid < 32) lc[tid] = 0;
        if (half == 0 && wn == 0 && fq < 3) {
#pragma unroll
            for (int mi = 0; mi < 4; ++mi)
#pragma unroll
                for (int e = 0; e < 16; ++e) if (e < 4 || fq < 2) lg[lbase + mi * 576 + e] = (acc[mi][e >> 2][e & 3] + xch[lbase + mi * 576 + e]) * rs[64 * wm + 16 * mi + fr];
        }
        __syncthreads();
        int e0 = 0, e1 = 0, lr0 = 0, lr1 = 0; float c0 = 0.f, c1 = 0.f;
        if (half == 0 && tid < 128) {
            const float* lrow = lg + tid * 36;
            float gl[4]; int grp = 0; float gm = -3.4e38f;
#pragma unroll
            for (int q = 0; q < 4; ++q) { gl[q] = lrow[q] + bg[q]; if (gl[q] > gm) { gm = gl[q]; grp = q; } }
            float gsum = 0.f;
#pragma unroll
            for (int q = 0; q < 4; ++q) gsum += expf(gl[q] - gm);
            const float grp_w = 1.f / gsum;
            float el[8]; float em = -3.4e38f;
#pragma unroll
            for (int q = 0; q < 8; ++q) { el[q] = lrow[4 + grp * 8 + q] + be[grp * 8 + q]; em = fmaxf(em, el[q]); }
            float esum = 0.f; float ep[8];
#pragma unroll
            for (int q = 0; q < 8; ++q) { ep[q] = expf(el[q] - em); esum += ep[q]; }
            int j0 = 0; float p0 = -1.f;
#pragma unroll
            for (int q = 0; q < 8; ++q) { const float pq = ep[q] / esum; ep[q] = pq; if (pq > p0) { p0 = pq; j0 = q; } }
            int j1 = 0; float p1 = -1.f;
#pragma unroll
            for (int q = 0; q < 8; ++q) { if (q != j0 && ep[q] > p1) { p1 = ep[q]; j1 = q; } }
            const float den = p0 + p1;
            c0 = grp_w * p0 / den; c1 = grp_w * p1 / den;
            e0 = grp * 8 + j0; e1 = grp * 8 + j1;
            lr0 = atomicAdd(&lc[e0], 1); lr1 = atomicAdd(&lc[e1], 1);
        }
        __syncthreads();
        if (half == 0 && tid < 32) { const int n = lc[tid]; gbs[tid] = n ? (int)atomicAdd(&cnt[tid], (unsigned)n) : 0; }
        __syncthreads();
        if (half == 0 && tid < 128) {
            const int tok = r0 + tid;
            list[e0 * 32768 + gbs[e0] + lr0] = tok * 2; list[e1 * 32768 + gbs[e1] + lr1] = tok * 2 + 1;
            rsl[e0 * 32768 + gbs[e0] + lr0] = rs[tid]; rsl[e1 * 32768 + gbs[e1] + lr1] = rs[tid];
            wsl[tok * 2] = c0; wsl[tok * 2 + 1] = c1;
        }
        __syncthreads();
    }
}

__device__ __forceinline__ bool moe_unit(const unsigned* cnt, int i, int& e, int& mt, int& sub, int& rowbase, int& n) {
    int lane = lane_id(); asm volatile("" : "+v"(lane));
    const int c = (lane < 32) ? (int)cnt[lane] : 0;
    const int nt = (c + 255) >> 8, nt128 = (c + 127) >> 7;
    int pre = nt, pre128 = nt128;
#pragma unroll
    for (int o = 1; o < 32; o <<= 1) {
        const int src = (lane - o) << 2;
        const int v = __builtin_amdgcn_ds_bpermute(src, pre), v2 = __builtin_amdgcn_ds_bpermute(src, pre128);
        if (lane >= o) { pre += v; pre128 += v2; }
    }
    const int total = __builtin_amdgcn_readlane(pre, 31) * 4;
    const int Lp = i * (int)gridDim.x + (int)blockIdx.x, q = (total + 7) >> 3, off = Lp >> 3;
    const int L = (Lp & 7) * q + off;
    if (off >= q || L >= total) return false;
    const int excl = pre - nt;
    const bool mine = (lane < 32) && (L >= excl * 4) && (L < pre * 4);
    const unsigned long long bal = __ballot(mine);
    if (bal == 0ull) return false;
    const int ee = __builtin_amdgcn_readfirstlane(__ffsll((long long)bal) - 1);
    e = ee;
    n = __builtin_amdgcn_readlane(c, ee);
    rowbase = __builtin_amdgcn_readlane(pre128 - nt128, ee) * 128;
    const int r = L - __builtin_amdgcn_readlane(excl, ee) * 4;
    mt = r >> 2; sub = r & 3;
    return true;
}
struct G8Exp1 {
    static constexpr bool GATHER = true, HAS_F8 = false;
    const unsigned* cnt; const int* list; const char* h2; const char* Wg; const char* Wu;
    __device__ __forceinline__ bool next(int i, G8Unit& u, const int (&R)[2], const unsigned (&C2)[2]) const {
        int e, mt, sub, rowbase, n;
        if (!moe_unit(cnt, i, e, mt, sub, rowbase, n)) return false;
        u.A0 = h2; u.A1 = h2; u.K2 = 2048u; u.nt = 16;
        u.B0 = Wg + ((size_t)e * 512 + sub * 128) * 2048; u.B1 = Wu + ((size_t)e * 512 + sub * 128) * 2048;
        u.x0 = e; u.x1 = mt; u.x2 = sub; u.x3 = rowbase; u.n = n;
#pragma unroll
        for (int h = 0; h < 2; ++h)
#pragma unroll
            for (int k = 0; k < 2; ++k) { int sidx = mt * 256 + h * 128 + R[k]; sidx = sidx < n ? sidx : n - 1; u.ao[h][k] = ((unsigned)(list[e * 32768 + sidx] >> 1) << 11) + C2[k]; }
        return true;
    }
};
struct EpiExp1 {
    bf16_t* hid; const float* rsl;
    __device__ __forceinline__ void operator()(const G8Acc& acc, const G8Unit& u, int wr, int wc, int fr, int fq) const {
        float rsv[2][4];
#pragma unroll
        for (int ai = 0; ai < 2; ++ai)
#pragma unroll
            for (int m = 0; m < 4; ++m) { int r = u.x1 * 256 + ai * 128 + wr * 64 + m * 16 + fr; r = r < u.n ? r : u.n - 1; rsv[ai][m] = rsl[u.x0 * 32768 + r]; }
#pragma unroll
        for (int ai = 0; ai < 2; ++ai)
#pragma unroll
            for (int m = 0; m < 4; ++m) {
                const int r = u.x1 * 256 + ai * 128 + wr * 64 + m * 16 + fr;
                if (r < u.n) {
                    const float rs = rsv[ai][m];
                    float hv[8];
#pragma unroll
                    for (int j = 0; j < 8; ++j) { const float g = acc[ai][0][m][j >> 2][j & 3] * rs, up = acc[ai][1][m][j >> 2][j & 3] * rs; hv[j] = g * sigm(g) * up; }
                    u32x4 o; o.x = pk_bf16(hv[0], hv[1]); o.y = pk_bf16(hv[2], hv[3]); o.z = pk_bf16(hv[4], hv[5]); o.w = pk_bf16(hv[6], hv[7]);
                    *(u32x4*)(hid + (size_t)(u.x3 + r) * 512 + u.x2 * 128 + wc * 32 + 8 * fq) = o;
                }
            }
    }
};
__device__ __forceinline__ void phase_exp1(CKP& p, int l, unsigned char* lds, unsigned* ctl) {
    G8Exp1 S{ctl + CTL_MOECNT + l * 32, (const int*)(p.ws + OFF_MOE + MOE_LIST), (const char*)(p.ws + OFF_X), (const char*)(p.ws + OFF_W + W_EG), (const char*)(p.ws + OFF_W + W_EU)};
    EpiExp1 E{(bf16_t*)(p.ws + OFF_HID), (const float*)(p.ws + OFF_MOE + MOE_RS)};
    g8_phase(S, E);
}
struct G8Exp2 {
    static constexpr bool GATHER = true, HAS_F8 = false;
    const unsigned* cnt; const char* hid; const char* Wd;
    __device__ __forceinline__ bool next(int i, G8Unit& u, const int (&R)[2], const unsigned (&C2)[2]) const {
        int e, mt, sub, rowbase, n;
        if (!moe_unit(cnt, i, e, mt, sub, rowbase, n)) return false;
        u.A0 = hid + (size_t)(rowbase + mt * 256) * 1024; u.A1 = u.A0; u.K2 = 1024u; u.nt = 8;
        u.B0 = Wd + ((size_t)e * 1024 + sub * 256) * 1024; u.B1 = u.B0 + (size_t)128 * 1024;
        u.x0 = e; u.x1 = mt; u.x2 = sub; u.x3 = rowbase; u.n = n;
        const int lim = n - mt * 256 - 1;
#pragma unroll
        for (int h = 0; h < 2; ++h)
#pragma unroll
            for (int k = 0; k < 2; ++k) { const int rr = h * 128 + R[k]; u.ao[h][k] = ((unsigned)(rr < lim ? rr : lim) << 10) + C2[k]; }
        return true;
    }
};
struct EpiExp2 {
    const int* list; const float* wsl; bf16_t* ys;
    __device__ __forceinline__ void operator()(const G8Acc& acc, const G8Unit& u, int wr, int wc, int fr, int fq) const {
        int slot[2][4]; float wt[2][4];
#pragma unroll
        for (int ai = 0; ai < 2; ++ai)
#pragma unroll
            for (int m = 0; m < 4; ++m) { int r = u.x1 * 256 + ai * 128 + wr * 64 + m * 16 + fr; r = r < u.n ? r : u.n - 1; slot[ai][m] = list[u.x0 * 32768 + r]; }
#pragma unroll
        for (int ai = 0; ai < 2; ++ai)
#pragma unroll
            for (int m = 0; m < 4; ++m) wt[ai][m] = wsl[slot[ai][m]];
#pragma unroll
        for (int ai = 0; ai < 2; ++ai)
#pragma unroll
            for (int m = 0; m < 4; ++m) {
                const int r = u.x1 * 256 + ai * 128 + wr * 64 + m * 16 + fr;
                if (r < u.n) {
                    bf16_t* dst = ys + (size_t)slot[ai][m] * 1024 + u.x2 * 256 + wc * 32 + 8 * fq;
                    const float w = wt[ai][m];
#pragma unroll
                    for (int bj = 0; bj < 2; ++bj) {
                        const f32x4 v0 = acc[ai][bj][m][0] * w, v1 = acc[ai][bj][m][1] * w;
                        u32x4 o; o.x = pk_bf16(v0[0], v0[1]); o.y = pk_bf16(v0[2], v0[3]); o.z = pk_bf16(v1[0], v1[1]); o.w = pk_bf16(v1[2], v1[3]);
                        *(u32x4*)(dst + bj * 128) = o;
                    }
                }
            }
    }
};
__device__ __forceinline__ void phase_exp2(CKP& p, int l, unsigned char* lds, unsigned* ctl) {
    G8Exp2 S{ctl + CTL_MOECNT + l * 32, (const char*)(p.ws + OFF_HID), (const char*)(p.ws + OFF_W + W_ED)};
    EpiExp2 E{(const int*)(p.ws + OFF_MOE + MOE_LIST), (const float*)(p.ws + OFF_MOE + MOE_WS), (bf16_t*)(p.ws + OFF_YS)};
    g8_phase(S, E);
}

constexpr int PH_PER_LAYER = 10;
constexpr int NPHASE = PH_PER_LAYER * DEPTH + 1;

__global__ __attribute__((target("no-packed-fp32-ops"))) void __launch_bounds__(NTHR_HW, 1) mega(KP p_unused) {
    extern __shared__ __attribute__((aligned(16))) unsigned char lds_all[];
    if ((threadIdx.x & 255) == 0) *(volatile unsigned*)(lds_all + VB_CTR + ((threadIdx.x >> 8) << 6)) = 0u;
    if ((threadIdx.x & 63) == 0) *(volatile unsigned char*)(lds_all + VB_CTR + 192 + hw_wave_key()) = (unsigned char)(threadIdx.x >> 6);
    __syncthreads();
    unsigned* ctl = (unsigned*)(p_unused.ws + OFF_CTL);
#if ONE_LAUNCH
    XcdBarrier xb = xcd_barrier_post(ctl + CTL_BAR, (volatile LAS unsigned*)(lds_all + VB_CTR + 128));
    if (p_unused.never) cg::this_grid().sync();
#if DBG_PREFLUSH
    __builtin_amdgcn_fence(__ATOMIC_RELEASE, "");
    asm volatile("s_waitcnt vmcnt(0)" ::: "memory");
    __builtin_amdgcn_fence(__ATOMIC_ACQUIRE, "");
    asm volatile("s_waitcnt vmcnt(0)" ::: "memory");
    xcd_barrier(xb);
    { const unsigned long long t0 = __builtin_amdgcn_s_memrealtime(); while (__builtin_amdgcn_s_memrealtime() - t0 < 20000ull) __builtin_amdgcn_s_sleep(8); }
    xcd_barrier(xb);
#endif
#endif
    CKP* kp0 = (CKP*)__builtin_amdgcn_kernarg_segment_ptr();
    const int ph_lo = kp0->ph_lo, ph_hi = kp0->ph_hi;
#if ONE_LAUNCH
#define PH_SYNC(PH) if ((PH) + 1 < ph_hi) xcd_barrier(xb);
#else
#define PH_SYNC(PH)
#endif
#if DBG_TIMEPH >= 0
#define PH_STAMP(PH) if (blockIdx.x == 0 && TIDX() == 0) ((unsigned long long*)(kp0->ws + OFF_CTL + 24576))[(PH)] = __builtin_amdgcn_s_memrealtime();
#else
#define PH_STAMP(PH)
#endif
#define RUN_PHASE(PH, CALL) if (ph_lo <= (PH) && (PH) < ph_hi) { PH_STAMP(PH) CKP* kp = kp0; asm volatile("" : "+s"(kp)); CKP& p = *kp; const int rep_ = 0; (void)rep_; unsigned char* lds = vb_lds(); CALL; \
    if ((PH) == DBG_REPEAT_PH) { xcd_barrier(xb); const int rep_ = 1; (void)rep_; CALL; } PH_SYNC(PH) }
#define RUN_LAYER(L) \
    RUN_PHASE((L) * 10 + 0, phase_prep(p, (L), lds)) \
    RUN_PHASE((L) * 10 + 1, phase_inproj(p, (L), lds)) \
    RUN_PHASE((L) * 10 + 2, phase_mid1(p, (L), lds)) \
    RUN_PHASE((L) * 10 + 3, phase_attn(p, (L), lds, ctl + 2 * rep_)) \
    RUN_PHASE((L) * 10 + 5, phase_branch(p, (L), lds)) \
    RUN_PHASE((L) * 10 + 6, phase_mix(p, (L), lds)) \
    RUN_PHASE((L) * 10 + 7, phase_router(p, (L), lds, ctl)) \
    RUN_PHASE((L) * 10 + 8, phase_exp1(p, (L), lds, ctl)) \
    RUN_PHASE((L) * 10 + 9, phase_exp2(p, (L), lds, ctl))
#if DBG_SMALLK
    RUN_PHASE(0, phase_prep(p, 0, lds))
    RUN_PHASE(1, phase_inproj(p, 0, lds))
    RUN_PHASE(2, phase_mid1(p, 0, lds))
#else
    RUN_LAYER(0)
    RUN_LAYER(1)
    RUN_PHASE(20, phase_prep(p, 2, lds))
#endif
#if ONE_LAUNCH && DBG_DUMP
    {
        xcd_barrier(xb);
        CKP* kp = kp0; asm volatile("" : "+s"(kp)); CKP& p = *kp;
        const size_t NO = (size_t)NTOK * 1024;
        const unsigned char* src = p.ws + DBG_DUMP_OFF;
        for (size_t i = (size_t)blockIdx.x * NTHR_HW + threadIdx.x; i < NO; i += (size_t)gridDim.x * NTHR_HW) {
            float v = 0.f;
            if (i < (size_t)DBG_DUMP_N) {
                if (DBG_DUMP_F32) {
                    const size_t si = DBG_DUMP_REV ? ((size_t)DBG_DUMP_N - 1 - i) : i;
#if DBG_SC1READ
                    const unsigned fu = __hip_atomic_load((const unsigned*)src + si, __ATOMIC_RELAXED, __HIP_MEMORY_SCOPE_SYSTEM); const float f = __uint_as_float(fu);
#else
                    const float f = ((const float*)src)[si];
#endif
                    v = DBG_HASH ? (float)(__float_as_uint(f) & 0x3ff) : f;
#if DBG_EFILT
                    { const int id_ = (int)(((si >> 7) - DBG_IDROT) & 2047), blk = ((id_ >> 2) + 320) & 511; if (!(blk >= DBG_EFILT_LO && blk < DBG_EFILT_HI)) v = 0.f; }
#endif
#if DBG_E2
                    { const float f2 = ((const float*)(p.ws + OFF_C + C_ATT))[i]; v = (__float_as_uint(f2) == __float_as_uint(f)) ? 0.f : 1000.f; if (i == 0) v += 1.f; }
#endif
                }
                else { const bf16_t h = ((const bf16_t*)src)[i]; v = DBG_HASH ? (float)(h & 0x3ff) : bf2f(h); }
            }
#if DBG_CONSTOUT
            v = 1000.f + (float)(i & 1023);
#endif
            p.xbuf[i] = v;
        }
    }
#endif
}

#if DBG_DUMP
__global__ void dbg_dump(const bf16_t* src, size_t n, float* out, size_t nout) {
    for (size_t i = (size_t)blockIdx.x * blockDim.x + threadIdx.x; i < nout; i += (size_t)gridDim.x * blockDim.x)
        out[i] = i < n ? (DBG_HASH ? (float)(src[i] & 0x3ff) : bf2f(src[i])) : 0.f;
}
__global__ void dbg_dump_f32(const float* src, size_t n, float* out, size_t nout) {
    for (size_t i = (size_t)blockIdx.x * blockDim.x + threadIdx.x; i < nout; i += (size_t)gridDim.x * blockDim.x)
        out[i] = i < n ? (DBG_HASH ? (float)(__float_as_uint(src[i]) & 0x3ff) : src[i]) : 0.f;
}
#endif
extern "C" void kernel_launch(void* const* d_in, const int* in_sizes, int n_in, void* d_out, int out_size, void* d_ws, size_t ws_size, hipStream_t stream) {
    static int grid = 0;
    if (grid == 0) {
        if (n_in != 36 || out_size != NTOK * DM || ws_size < WS_END) { fprintf(stderr, "kernel_launch: unexpected shapes n_in %d out %d ws %zu (need %zu)\n", n_in, out_size, ws_size, (size_t)WS_END); grid = -1; return; }
        int dev = 0, cus = 0, per_cu = 0;
        hipGetDevice(&dev);
        hipDeviceGetAttribute(&cus, hipDeviceAttributeMultiprocessorCount, dev);
        hipFuncSetAttribute((const void*)mega, hipFuncAttributeMaxDynamicSharedMemorySize, LDS_BYTES);
        hipOccupancyMaxActiveBlocksPerMultiprocessor(&per_cu, (const void*)mega, NTHR_HW, LDS_BYTES);
        if (per_cu < 1) { fprintf(stderr, "kernel_launch: occupancy query says %d\n", per_cu); per_cu = 1; }
        if (per_cu > MAX_PER_CU) per_cu = MAX_PER_CU;
        grid = cus * per_cu;
        fprintf(stderr, "kernel_launch: grid %d (%d CUs x %d)\n", grid, cus, per_cu);
    }
    if (grid < 0) return;
    hipMemsetAsync((char*)d_ws + OFF_CTL, 0, CTL_BYTES, stream);
    KP p{};
    for (int i = 0; i < 36; ++i) p.in[i] = (const float*)d_in[i];
    p.xbuf = (float*)d_out; p.ws = (unsigned char*)d_ws;
    for (int i = 0; i < 8; ++i) p.inv_freq[i] = (float)pow(500000.0, -(double)i / 8.0);
    p.never = 0; p.pad = 0;
#if ONE_LAUNCH
    p.ph_lo = 0; p.ph_hi = DBG_PH_HI;
    void* args[] = {&p};
    hipError_t e = hipLaunchCooperativeKernel((const void*)mega, dim3(grid), dim3(NTHR_HW), args, LDS_BYTES, stream);
    if (e != hipSuccess) fprintf(stderr, "cooperative launch failed: %s (grid %d)\n", hipGetErrorString(e), grid);
#else
    for (int ph = 0; ph < NPHASE; ++ph) {
        if (!((DBG_MASK >> ph) & 1)) continue;
        p.ph_lo = ph; p.ph_hi = ph + 1;
        hipLaunchKernelGGL(mega, dim3(grid), dim3(NTHR_HW), LDS_BYTES, stream, p);
    }
#if DBG_DUMP
    {
        const unsigned char* w = (const unsigned char*)d_ws; const size_t NO = (size_t)NTOK * 1024;
        size_t off = 0, n = 0; bool f32 = false;
        switch (DBG_DUMP) {
            case 1: off = OFF_C + C_ATT; n = (size_t)NTOK * 512; break;
            case 2: off = OFF_C + C_SGU; n = (size_t)NTOK * 256; break;
            case 3: off = OFF_C + C_S5O; n = (size_t)NTOK * 256; break;
            case 4: off = OFF_M; n = (size_t)NTOK * 1024; break;
            case 5: off = OFF_R + R_Q; n = (size_t)NTOK * 512; break;
            case 6: off = OFF_H; n = (size_t)NTOK * 1024; break;
            case 7: off = OFF_C + C_YG; n = (size_t)NTOK * 256; break;
            case 8: off = OFF_C + C_KCMP; n = (size_t)2 * 524288 / 2; break;
            case 9: off = OFF_R + R_KC; n = (size_t)NTOK * 128 * 6; break;
            case 10: off = OFF_R + R_NG; n = (size_t)NTOK * 24; f32 = true; break;
            case 11: off = OFF_R + R_U; n = (size_t)NTOK * 768; break;
            case 12: off = OFF_C + C_S5E; n = (size_t)128 * 16 * 64 * 2; f32 = true; break;
            case 15: off = 0; n = (size_t)NTOK * 1024; f32 = true; break;
            case 16: off = OFF_W + W_S5A; n = 36864; f32 = true; break;
            case 13: off = OFF_YS; n = (size_t)NTOK * 1024; break;
            case 14: off = OFF_MOE + MOE_WS; n = 65536; f32 = true; break;
            default: break;
        }
        if (DBG_DUMP == 15) hipLaunchKernelGGL(dbg_dump_f32, dim3(2048), dim3(256), 0, stream, (const float*)d_out, n, (float*)d_out, NO);
        else if (f32) hipLaunchKernelGGL(dbg_dump_f32, dim3(2048), dim3(256), 0, stream, (const float*)(w + off), n, (float*)d_out, NO);
        else hipLaunchKernelGGL(dbg_dump, dim3(2048), dim3(256), 0, stream, (const bf16_t*)(w + off), n, (float*)d_out, NO);
    }
#endif
#endif
}
```
